# Optimizing an MI355X kernel written in HIP

```python
import jax, jax.numpy as jnp
from jax import lax
import numpy as np

D_MODEL = 1024
BATCH = 4
SEQ = 4096
DEPTH = 1

PLE_DIM = 256
ATTN_HEADS = 8
ATTN_HEAD_DIM = 64
ATTN_WIDTH = ATTN_HEADS * ATTN_HEAD_DIM
Q_BLOCK = 128
CONV_WIDTH = ATTN_WIDTH
CONV_K = 3
N_BRANCH = 2
PEER_HEADS = 8
PEER_NKEYS = 128
PEER_N_EXPERTS = PEER_NKEYS * PEER_NKEYS
PEER_QDIM = 256
PEER_HALF = PEER_QDIM // 2
PEER_TOPK = 16
TOKEN_CHUNK = 128
EPS = 1e-6

IN_SIZES = [ATTN_WIDTH, ATTN_WIDTH, ATTN_WIDTH, ATTN_HEADS,
            CONV_WIDTH, CONV_WIDTH, CONV_WIDTH, D_MODEL, D_MODEL]
IN_TOTAL = sum(IN_SIZES)
IN_SPLITS = np.cumsum(IN_SIZES)[:-1].tolist()

kernel_name = "fox_shortconv_peer_hybrid"


def rmsnorm(x, g):
    xf = x.astype(jnp.float32)
    y = xf * lax.rsqrt(jnp.mean(xf * xf, axis=-1, keepdims=True) + EPS) * g.astype(jnp.float32)
    return y.astype(x.dtype)


def forgetting_attention(q, k, v, f_logit):
    B, S, H, Dh = q.shape
    nb = S // Q_BLOCK
    log_f = jax.nn.log_sigmoid(f_logit.astype(jnp.float32))
    c = jnp.cumsum(log_f, axis=1).transpose(0, 2, 1)
    qb = q.reshape(B, nb, Q_BLOCK, H, Dh).transpose(1, 0, 3, 2, 4)
    cqb = c.reshape(B, H, nb, Q_BLOCK).transpose(2, 0, 1, 3)
    kt = k.transpose(0, 2, 1, 3)
    vt = v.transpose(0, 2, 1, 3)
    k_pos = jnp.arange(S)
    scale = ATTN_HEAD_DIM ** -0.5

    def block(args):
        qi, cqi, i = args
        logits = (jnp.einsum('bhqd,bhkd->bhqk', qi, kt).astype(jnp.float32) * scale
                  + cqi[..., :, None] - c[:, :, None, :])
        q_pos = i * Q_BLOCK + jnp.arange(Q_BLOCK)
        mask = k_pos[None, :] <= q_pos[:, None]
        logits = jnp.where(mask, logits, -jnp.inf)
        w = jax.nn.softmax(logits, axis=-1)
        return jnp.einsum('bhqk,bhkd->bhqd', w.astype(vt.dtype), vt)

    out = lax.map(block, (qb, cqb, jnp.arange(nb)))
    return out.transpose(1, 0, 3, 2, 4).reshape(B, S, H * Dh)


def causal_depthwise_conv(z, w):
    C = z.shape[-1]
    return lax.conv_general_dilated(
        z, w[:, None, :].astype(z.dtype), window_strides=(1,),
        padding=[(CONV_K - 1, 0)], dimension_numbers=('NWC', 'WIO', 'NWC'),
        feature_group_count=C)


def peer(h, w_q, k1, k2, u, v):
    B, S, D = h.shape
    q = jnp.einsum('bsd,dhe->bshe', h, w_q)
    s1 = jnp.einsum('bshe,hne->bshn', q[..., :PEER_HALF], k1).astype(jnp.float32)
    s2 = jnp.einsum('bshe,hne->bshn', q[..., PEER_HALF:], k2).astype(jnp.float32)
    v1, i1 = lax.top_k(s1, PEER_TOPK)
    v2, i2 = lax.top_k(s2, PEER_TOPK)
    cand_s = (v1[..., :, None] + v2[..., None, :]).reshape(B, S, PEER_HEADS, PEER_TOPK * PEER_TOPK)
    cand_i = (i1[..., :, None] * PEER_NKEYS + i2[..., None, :]).reshape(B, S, PEER_HEADS, PEER_TOPK * PEER_TOPK)
    top_s, top_j = lax.top_k(cand_s, PEER_TOPK)
    ids = jnp.take_along_axis(cand_i, top_j, axis=-1)
    gates = jax.nn.softmax(top_s, axis=-1)
    T = B * S
    nc = T // TOKEN_CHUNK
    hf = h.reshape(nc, TOKEN_CHUNK, D)
    idf = ids.reshape(nc, TOKEN_CHUNK, PEER_HEADS, PEER_TOPK)
    gf = gates.reshape(nc, TOKEN_CHUNK, PEER_HEADS, PEER_TOPK)

    def chunk(args):
        hc, ic, gc = args
        u_sel = u[ic]
        act = jax.nn.gelu(jnp.einsum('td,thkd->thk', hc, u_sel), approximate=False)
        wgt = gc.astype(hc.dtype) * act
        return jnp.einsum('thk,thkd->td', wgt, v[ic])

    return lax.map(chunk, (hf, idf, gf)).reshape(B, S, D)


def setup_inputs(seed: int = 0) -> dict:
    key = jax.random.key(seed)
    ks = jax.random.split(key, 20)
    D = D_MODEL
    f32 = jnp.float32
    nrm = lambda k, shape, s: jax.random.normal(k, shape, f32) * s
    return {
        "x": nrm(ks[0], (BATCH, SEQ, D), 1.0),
        "p": nrm(ks[1], (DEPTH, BATCH, SEQ, PLE_DIM), 1.0),
        "g_mix": 1.0 + nrm(ks[2], (DEPTH, D), 0.02),
        "w_in": nrm(ks[3], (DEPTH, D, IN_TOTAL), D ** -0.5),
        "b_f": jax.random.uniform(ks[4], (DEPTH, ATTN_HEADS), f32, 1.0, 6.0),
        "conv_w": nrm(ks[5], (DEPTH, CONV_K, CONV_WIDTH), CONV_K ** -0.5),
        "w_branch": nrm(ks[6], (DEPTH, N_BRANCH, ATTN_WIDTH, D), ATTN_WIDTH ** -0.5),
        "w_out": nrm(ks[7], (DEPTH, D, D), D ** -0.5),
        "g_ffn": 1.0 + nrm(ks[8], (DEPTH, D), 0.02),
        "w_peer_q": nrm(ks[9], (DEPTH, D, PEER_HEADS, PEER_QDIM), D ** -0.5),
        "peer_k1": nrm(ks[10], (DEPTH, PEER_HEADS, PEER_NKEYS, PEER_HALF), PEER_HALF ** -0.5),
        "peer_k2": nrm(ks[11], (DEPTH, PEER_HEADS, PEER_NKEYS, PEER_HALF), PEER_HALF ** -0.5),
        "peer_u": nrm(ks[12], (DEPTH, PEER_N_EXPERTS, D), D ** -0.5),
        "peer_v": nrm(ks[13], (DEPTH, PEER_N_EXPERTS, D), PEER_HEADS ** -0.5),
        "g_ple": 1.0 + nrm(ks[14], (DEPTH, D), 0.02),
        "w_ple_gate": nrm(ks[15], (DEPTH, D, D), D ** -0.5),
        "w_ple_proj": nrm(ks[16], (DEPTH, PLE_DIM, D), PLE_DIM ** -0.5),
        "g_final": 1.0 + nrm(ks[17], (D,), 0.02),
    }


def reference(x, p, g_mix, w_in, b_f, conv_w, w_branch, w_out, g_ffn, w_peer_q,
              peer_k1, peer_k2, peer_u, peer_v, g_ple, w_ple_gate, w_ple_proj, g_final):
    B, S, D = x.shape
    for i in range(DEPTH):
        h = rmsnorm(x, g_mix[i])
        proj = h @ w_in[i]
        q, k, v, f_logit, gb, gc_in, xc, g_attn, g_conv = jnp.split(proj, IN_SPLITS, axis=-1)
        attn = forgetting_attention(
            q.reshape(B, S, ATTN_HEADS, ATTN_HEAD_DIM),
            k.reshape(B, S, ATTN_HEADS, ATTN_HEAD_DIM),
            v.reshape(B, S, ATTN_HEADS, ATTN_HEAD_DIM),
            f_logit + b_f[i])
        conv = gb * causal_depthwise_conv(gc_in * xc, conv_w[i])
        branches = jnp.stack([attn, conv], axis=0)
        y_br = jnp.einsum('nbsc,ncd->nbsd', branches, w_branch[i])
        gates = jax.nn.sigmoid(jnp.stack([g_attn, g_conv], axis=0))
        merged = jnp.sum(gates * y_br, axis=0)
        x = x + merged @ w_out[i]
        x = x + peer(rmsnorm(x, g_ffn[i]), w_peer_q[i], peer_k1[i], peer_k2[i], peer_u[i], peer_v[i])
        ple_gate = jax.nn.sigmoid(rmsnorm(x, g_ple[i]) @ w_ple_gate[i])
        x = x + ple_gate * (p[i] @ w_ple_proj[i])
    return rmsnorm(x, g_final)
```

```cpp
#include <hip/hip_runtime.h>
#include <cstdint>
#include <cstdio>

typedef unsigned short bf16;
typedef unsigned u32x4 __attribute__((ext_vector_type(4)));
typedef unsigned u32x2 __attribute__((ext_vector_type(2)));
typedef float f32x4 __attribute__((ext_vector_type(4)));

constexpr int BATCH = 4, SEQ = 4096, D = 1024, M = BATCH * SEQ, NH = 8, HD = 64, AW = 512, PLE = 256;
constexpr int NIN = 5120, INTOT = 5128, NKEYS = 128, NEXP = 16384, TOPK = 16, PH = 8, NS = 2048;
constexpr float EPS = 1e-6f, LOG2E = 1.4426950408889634f, C2 = 0.125f * LOG2E;

constexpr size_t MiB = 1u << 20;
constexpr size_t WS_CTL = 0;
constexpr size_t WS_RSTD1 = 1 * MiB, WS_RSTD3 = WS_RSTD1 + 65536, WS_SS2 = WS_RSTD3 + 65536, WS_SS4 = WS_SS2 + 262144, WS_LF = WS_SS4 + 262144, WS_CS = WS_LF + 524288, WS_WF = WS_CS + 524288;
static_assert(WS_WF + 32768 <= 3 * MiB, "small region");
constexpr size_t WS_WIN = 3 * MiB, WS_WBR = 13 * MiB, WS_WOUT = 15 * MiB, WS_WS = 17 * MiB, WS_WPG = 21 * MiB, WS_WPP = 23 * MiB, WS_PB = 24 * MiB;
constexpr size_t WS_UB = 32 * MiB, WS_VB = 64 * MiB;
constexpr size_t WS_A = 96 * MiB;
constexpr size_t WS_PP = 128 * MiB;
constexpr size_t WS_Q = 160 * MiB, WS_K = 176 * MiB, WS_V = 192 * MiB, WS_GB = 208 * MiB, WS_Z = 224 * MiB;
constexpr size_t WS_MERGED = 160 * MiB, WS_XB2 = 192 * MiB, WS_IDS = 224 * MiB, WS_GATES = 232 * MiB;
constexpr size_t WS_END = 256 * MiB;
constexpr size_t WS_TGC = 32 * MiB, WS_TXC = 64 * MiB;
constexpr size_t WS_SC = 32 * MiB;

__device__ __forceinline__ float bf2f(bf16 v) { return __uint_as_float((unsigned)v << 16); }
__device__ __forceinline__ unsigned f2bf(float f) { unsigned u = __float_as_uint(f); return (u + 0x7fffu + ((u >> 16) & 1u)) >> 16; }
__device__ __forceinline__ unsigned pk2(float lo, float hi) { return f2bf(lo) | (f2bf(hi) << 16); }
__device__ __forceinline__ float wave_sum(float v) {
#pragma unroll
    for (int o = 1; o < 64; o <<= 1) v += __shfl_xor(v, o);
    return v;
}
__device__ __forceinline__ float sigmoidf_(float v) { return 1.0f / (1.0f + __expf(-v)); }
__device__ __forceinline__ int src_in(int n) {
    const int pn = n >> 8, l = n & 255;
    if (pn < 6) return n;
    if (pn < 8) return 1544 + (n - 1536);
    if (pn < 12) { const int j = pn - 8; return (l < 128) ? 2056 + 128 * j + l : 2568 + 128 * j + (l - 128); }
    if (pn < 16) return 3080 + (n - 3072);
    return 4104 + (n - 4096);
}

__global__ void __launch_bounds__(256) k_rows0(const float* x, const float* w_in, const float* g_mix, const float* b_f, bf16* XB, float* RSTD1, float* LF) {
    const int lane = threadIdx.x & 63, row = blockIdx.x * 4 + (threadIdx.x >> 6);
    const f32x4* xr = (const f32x4*)(x + (size_t)row * D);
    f32x4 v[4]; float ss = 0.f;
#pragma unroll
    for (int j = 0; j < 4; ++j) { v[j] = xr[lane + 64 * j]; ss += v[j].x * v[j].x + v[j].y * v[j].y + v[j].z * v[j].z + v[j].w * v[j].w; }
    ss = wave_sum(ss);
    const float rstd = 1.0f / sqrtf(ss * (1.0f / D) + EPS);
    u32x2* o = (u32x2*)(XB + (size_t)row * D);
#pragma unroll
    for (int j = 0; j < 4; ++j) { u32x2 w; w.x = pk2(v[j].x, v[j].y); w.y = pk2(v[j].z, v[j].w); o[lane + 64 * j] = w; }
    if (lane == 0) RSTD1[row] = rstd;
    float f[8];
#pragma unroll
    for (int h = 0; h < 8; ++h) f[h] = 0.f;
#pragma unroll
    for (int j = 0; j < 4; ++j)
#pragma unroll
        for (int e = 0; e < 4; ++e) {
            const int k = 4 * (lane + 64 * j) + e; const float xv = v[j][e] * g_mix[k];
            const f32x4 w0 = *(const f32x4*)(w_in + (size_t)k * INTOT + 1536), w1 = *(const f32x4*)(w_in + (size_t)k * INTOT + 1540);
            f[0] += xv * w0.x; f[1] += xv * w0.y; f[2] += xv * w0.z; f[3] += xv * w0.w; f[4] += xv * w1.x; f[5] += xv * w1.y; f[6] += xv * w1.z; f[7] += xv * w1.w;
        }
    const int b = row / SEQ, t = row % SEQ;
#pragma unroll
    for (int h = 0; h < 8; ++h) {
        const float tot = wave_sum(f[h]) * rstd + b_f[h];
        const float ls = fminf(tot, 0.f) - log1pf(__expf(-fabsf(tot)));
        if (lane == 0) LF[(size_t)(b * NH + h) * SEQ + t] = ls * LOG2E;
    }
}
template <int MODE> __global__ void k_wt(const float* W, int ldw, const float* g, bf16* Wt, int N, int K, int koff, int ldt) {
    const size_t i = (size_t)blockIdx.x * blockDim.x + threadIdx.x; if (i >= (size_t)N * K) return;
    const int n = (int)(i / K), k = (int)(i % K);
    const int s = MODE == 1 ? src_in(n) : n;
    const float gv = g ? g[k] : 1.f;
    Wt[(size_t)n * ldt + koff + k] = (bf16)f2bf(gv * W[(size_t)k * ldw + s]);
}
__global__ void k_ws(const float* wq, const float* k1, const float* k2, const float* g, bf16* WST) {
    const size_t i = (size_t)blockIdx.x * blockDim.x + threadIdx.x; if (i >= (size_t)NS * D) return;
    const int n = (int)(i / D), d = (int)(i % D), head = n >> 8, half = (n >> 7) & 1, key = n & 127;
    const float* kr = (half ? k2 : k1) + ((size_t)head * NKEYS + key) * 128;
    const float* qr = wq + (size_t)d * NS + head * 256 + half * 128;
    float s = 0.f;
    for (int e = 0; e < 128; ++e) s += qr[e] * kr[e];
    WST[(size_t)n * D + d] = (bf16)f2bf(g[d] * s);
}
__global__ void k_cvt(const float* in, const float* g, bf16* out, size_t n, int gmask) {
    const size_t i = (size_t)blockIdx.x * blockDim.x + threadIdx.x; if (i >= n) return;
    out[i] = (bf16)f2bf(in[i] * (g ? g[i & gmask] : 1.f));
}

template <class Epi, bool SPLIT2>
__global__ void __launch_bounds__(256) ng(const bf16* A, int lda, const bf16* Bt, int ldb, int K, Epi E) {
    __shared__ float As[32][68], Bs[32][68];
    const int tid = threadIdx.x, tx = tid & 15, ty = tid >> 4, m0 = blockIdx.y * 64, n0 = blockIdx.x * 64;
    float acc[4][4], acc2[4][4];
#pragma unroll
    for (int i = 0; i < 4; ++i)
#pragma unroll
        for (int j = 0; j < 4; ++j) { acc[i][j] = 0.f; acc2[i][j] = 0.f; }
    const int lr = tid >> 2, lk = (tid & 3) * 8;
    for (int k0 = 0; k0 < K; k0 += 32) {
        const u32x4 av = *(const u32x4*)(A + (size_t)(m0 + lr) * lda + k0 + lk), bv = *(const u32x4*)(Bt + (size_t)(n0 + lr) * ldb + k0 + lk);
#pragma unroll
        for (int e = 0; e < 4; ++e) {
            As[lk + 2 * e][lr] = __uint_as_float(av[e] << 16); As[lk + 2 * e + 1][lr] = __uint_as_float(av[e] & 0xffff0000u);
            Bs[lk + 2 * e][lr] = __uint_as_float(bv[e] << 16); Bs[lk + 2 * e + 1][lr] = __uint_as_float(bv[e] & 0xffff0000u);
        }
        __syncthreads();
        const bool second = SPLIT2 && (k0 >= K / 2);
#pragma unroll 8
        for (int kk = 0; kk < 32; ++kk) {
            float a[4], b[4];
#pragma unroll
            for (int i = 0; i < 4; ++i) { a[i] = As[kk][ty * 4 + i]; b[i] = Bs[kk][tx * 4 + i]; }
            if (second) {
#pragma unroll
                for (int i = 0; i < 4; ++i)
#pragma unroll
                    for (int j = 0; j < 4; ++j) acc2[i][j] += a[i] * b[j];
            } else {
#pragma unroll
                for (int i = 0; i < 4; ++i)
#pragma unroll
                    for (int j = 0; j < 4; ++j) acc[i][j] += a[i] * b[j];
            }
        }
        __syncthreads();
    }
#pragma unroll
    for (int i = 0; i < 4; ++i)
#pragma unroll
        for (int j = 0; j < 4; ++j) E(m0 + ty * 4 + i, n0 + tx * 4 + j, acc[i][j], acc2[i][j]);
}
struct E1 {
    const float* RSTD1; bf16 *Q, *K, *V, *GB, *SGA, *SGC; float *TGC, *TXC;
    __device__ void operator()(int row, int col, float a, float) const {
        const float v = RSTD1[row] * a; const int pn = col >> 8;
        if (pn < 2) Q[(size_t)row * AW + col] = (bf16)f2bf(v * C2);
        else if (pn < 4) K[(size_t)row * AW + col - 512] = (bf16)f2bf(v);
        else if (pn < 6) V[(size_t)row * AW + col - 1024] = (bf16)f2bf(v);
        else if (pn < 8) GB[(size_t)row * AW + col - 1536] = (bf16)f2bf(v);
        else if (pn < 12) { const int j = pn - 8, l = col & 255; if (l < 128) TGC[(size_t)row * AW + 128 * j + l] = v; else TXC[(size_t)row * AW + 128 * j + l - 128] = v; }
        else if (pn < 16) SGA[(size_t)row * D + col - 3072] = (bf16)f2bf(sigmoidf_(v));
        else SGC[(size_t)row * D + col - 4096] = (bf16)f2bf(sigmoidf_(v));
    }
};
struct EPP { bf16* PP; __device__ void operator()(int row, int col, float a, float) const { PP[(size_t)row * D + col] = (bf16)f2bf(a); } };
struct E3 { const bf16 *SGA, *SGC; bf16* MG;
    __device__ void operator()(int row, int col, float a, float a2) const { const size_t i = (size_t)row * D + col; MG[i] = (bf16)f2bf(bf2f(SGA[i]) * a + bf2f(SGC[i]) * a2); } };
struct E4 { const float* x; float* X1; bf16* XB1;
    __device__ void operator()(int row, int col, float a, float) const { const size_t i = (size_t)row * D + col; const float v = x[i] + a; X1[i] = v; XB1[i] = (bf16)f2bf(v); } };
struct E5 { float* SC; __device__ void operator()(int row, int col, float a, float) const { SC[(size_t)row * 1024 + col] = a; } };
struct E7 { const float* RSTD3; const bf16* PP; float* X;
    __device__ void operator()(int row, int col, float a, float) const { const size_t i = (size_t)row * D + col; X[i] = X[i] + sigmoidf_(RSTD3[row] * a) * bf2f(PP[i]); } };

__global__ void k_z(const float* TGC, const float* TXC, bf16* Z) { const size_t i = (size_t)blockIdx.x * blockDim.x + threadIdx.x; if (i < (size_t)M * AW) Z[i] = (bf16)f2bf(TGC[i] * TXC[i]); }
__global__ void k_cumsum(const float* LF, float* CS) { const int bh = threadIdx.x; if (bh >= 32) return; float s = 0.f; for (int t = 0; t < SEQ; ++t) { s += LF[(size_t)bh * SEQ + t]; CS[(size_t)bh * SEQ + t] = s; } }
__global__ void k_conv(const bf16* GB, const bf16* Z, const float* cw, bf16* AC) {
    const size_t i = (size_t)blockIdx.x * blockDim.x + threadIdx.x; if (i >= (size_t)M * AW) return;
    const int row = (int)(i / AW), c = (int)(i % AW), t = row % SEQ;
    float s = cw[2 * AW + c] * bf2f(Z[i]);
    if (t >= 1) s += cw[1 * AW + c] * bf2f(Z[i - AW]);
    if (t >= 2) s += cw[0 * AW + c] * bf2f(Z[i - 2 * AW]);
    AC[(size_t)row * D + AW + c] = (bf16)f2bf(bf2f(GB[i]) * s);
}
__global__ void __launch_bounds__(64) k_attn(const bf16* Q, const bf16* K, const bf16* V, const float* CS, bf16* AC) {
    const int bh = blockIdx.y, b = bh / NH, h = bh % NH, q = blockIdx.x * 64 + threadIdx.x;
    const size_t rq = (size_t)b * SEQ + q;
    float qv[64], o[64];
#pragma unroll
    for (int d = 0; d < 64; ++d) { qv[d] = bf2f(Q[rq * AW + h * 64 + d]); o[d] = 0.f; }
    const float cq = CS[(size_t)bh * SEQ + q];
    float m = -INFINITY, l = 0.f;
    const int kvmax = blockIdx.x * 64 + 63;
    for (int kv = 0; kv <= kvmax; ++kv) {
        const size_t rk = (size_t)b * SEQ + kv;
        const u32x4* kp = (const u32x4*)(K + rk * AW + h * 64);
        float s = 0.f;
#pragma unroll
        for (int c = 0; c < 8; ++c) { const u32x4 w = kp[c];
#pragma unroll
            for (int e = 0; e < 4; ++e) { s += qv[c * 8 + 2 * e] * __uint_as_float(w[e] << 16) + qv[c * 8 + 2 * e + 1] * __uint_as_float(w[e] & 0xffff0000u); } }
        s += cq - CS[(size_t)bh * SEQ + kv];
        if (kv > q) s = -INFINITY;
        const float mn = fmaxf(m, s);
        const float al = (m == -INFINITY) ? 0.f : exp2f(m - mn), p = (s == -INFINITY) ? 0.f : exp2f(s - mn);
        l = l * al + p; m = mn;
        const u32x4* vp = (const u32x4*)(V + rk * AW + h * 64);
#pragma unroll
        for (int c = 0; c < 8; ++c) { const u32x4 w = vp[c];
#pragma unroll
            for (int e = 0; e < 4; ++e) { o[c * 8 + 2 * e] = o[c * 8 + 2 * e] * al + p * __uint_as_float(w[e] << 16); o[c * 8 + 2 * e + 1] = o[c * 8 + 2 * e + 1] * al + p * __uint_as_float(w[e] & 0xffff0000u); } }
    }
    const float il = 1.0f / l;
#pragma unroll
    for (int d = 0; d < 64; ++d) AC[rq * D + h * 64 + d] = (bf16)f2bf(o[d] * il);
}
__global__ void __launch_bounds__(256) k_rowss(const float* X, float* SS) {
    const int lane = threadIdx.x & 63, row = blockIdx.x * 4 + (threadIdx.x >> 6);
    const f32x4* xr = (const f32x4*)(X + (size_t)row * D); float ss = 0.f;
#pragma unroll
    for (int j = 0; j < 4; ++j) { const f32x4 v = xr[lane + 64 * j]; ss += v.x * v.x + v.y * v.y + v.z * v.z + v.w * v.w; }
    ss = wave_sum(ss);
    if (lane < 4) SS[(size_t)row * 4 + lane] = lane == 0 ? ss : 0.f;
}
__global__ void __launch_bounds__(64) k_topk(const float* SC, const float* SS2, int hg, int* IDS, float* GATES) {
    __shared__ float s[128][64]; __shared__ float tv[16][64]; __shared__ int ti[16][64];
    const int tid = threadIdx.x, pair = blockIdx.x * 32 + (tid >> 1), half = tid & 1, token = pair >> 2, hl = pair & 3;
    const float* src = SC + (size_t)token * 1024 + hl * 256 + half * 128;
    for (int k = 0; k < 128; ++k) s[k][tid] = src[k];
    float pv = INFINITY; int pk = -1;
    for (int r = 0; r < 16; ++r) {
        float best = -INFINITY; int bi = 0;
        for (int k = 0; k < 128; ++k) { const float v = s[k][tid]; const bool elig = (v < pv) || (v == pv && k > pk); if (elig && v > best) { best = v; bi = k; } }
        tv[r][tid] = best; ti[r][tid] = bi; pv = best; pk = bi;
    }
    __syncthreads();
    if (half == 0) {
        const float* ss = SS2 + (size_t)token * 4; const float rstd = 1.0f / sqrtf((ss[0] + ss[1] + ss[2] + ss[3]) * (1.0f / D) + EPS);
        float ts[16]; int tf[16];
        float cpv = INFINITY; int cpf = -1;
#pragma unroll
        for (int r = 0; r < 16; ++r) {
            float best = -INFINITY; int bf_ = 0;
            for (int c = 0; c < 256; ++c) { const float v = tv[c >> 4][tid] + tv[c & 15][tid + 1]; const bool elig = (v < cpv) || (v == cpv && c > cpf); if (elig && v > best) { best = v; bf_ = c; } }
            ts[r] = best; tf[r] = bf_; cpv = best; cpf = bf_;
        }
        float e[16], sum = 0.f;
#pragma unroll
        for (int r = 0; r < 16; ++r) { e[r] = __expf(rstd * (ts[r] - ts[0])); sum += e[r]; }
        const float inv = 1.0f / sum; const int head = hg * 4 + hl;
#pragma unroll
        for (int r = 0; r < 16; ++r) { IDS[(size_t)token * 128 + head * 16 + r] = ti[tf[r] >> 4][tid] * 128 + ti[tf[r] & 15][tid + 1]; GATES[(size_t)token * 128 + head * 16 + r] = e[r] * inv; }
    }
}
__global__ void __launch_bounds__(256) k_peer(const bf16* XB1, const float* SS2, const int* IDS, const float* GATES, const bf16* UB, const bf16* VB, float* X, bf16* XB2, float* RSTD3) {
    const int lane = threadIdx.x & 63, token = blockIdx.x * 4 + (threadIdx.x >> 6);
    const float* ss = SS2 + (size_t)token * 4; const float rstd = 1.0f / sqrtf((ss[0] + ss[1] + ss[2] + ss[3]) * (1.0f / D) + EPS);
    float xf[16], out[16];
    { const u32x4 a = *(const u32x4*)(XB1 + (size_t)token * D + 8 * lane), b = *(const u32x4*)(XB1 + (size_t)token * D + 512 + 8 * lane);
#pragma unroll
      for (int e = 0; e < 4; ++e) { xf[2 * e] = __uint_as_float(a[e] << 16); xf[2 * e + 1] = __uint_as_float(a[e] & 0xffff0000u); xf[8 + 2 * e] = __uint_as_float(b[e] << 16); xf[8 + 2 * e + 1] = __uint_as_float(b[e] & 0xffff0000u); } }
#pragma unroll
    for (int i = 0; i < 16; ++i) out[i] = 0.f;
    for (int hk = 0; hk < 128; ++hk) {
        const int id = IDS[(size_t)token * 128 + hk]; const float g = GATES[(size_t)token * 128 + hk];
        const u32x4 a = *(const u32x4*)(UB + (size_t)id * D + 8 * lane), b = *(const u32x4*)(UB + (size_t)id * D + 512 + 8 * lane);
        float dot = 0.f;
#pragma unroll
        for (int e = 0; e < 4; ++e) { dot += xf[2 * e] * __uint_as_float(a[e] << 16) + xf[2 * e + 1] * __uint_as_float(a[e] & 0xffff0000u) + xf[8 + 2 * e] * __uint_as_float(b[e] << 16) + xf[8 + 2 * e + 1] * __uint_as_float(b[e] & 0xffff0000u); }
        dot = wave_sum(dot) * rstd;
        const float w = g * 0.5f * dot * (1.0f + erff(dot * 0.70710678118654752f));
        const u32x4 va = *(const u32x4*)(VB + (size_t)id * D + 8 * lane), vb = *(const u32x4*)(VB + (size_t)id * D + 512 + 8 * lane);
#pragma unroll
        for (int e = 0; e < 4; ++e) { out[2 * e] += w * __uint_as_float(va[e] << 16); out[2 * e + 1] += w * __uint_as_float(va[e] & 0xffff0000u); out[8 + 2 * e] += w * __uint_as_float(vb[e] << 16); out[8 + 2 * e + 1] += w * __uint_as_float(vb[e] & 0xffff0000u); }
    }
    float* xr = X + (size_t)token * D; float s2 = 0.f;
    f32x4 x0 = *(f32x4*)(xr + 8 * lane), x1 = *(f32x4*)(xr + 8 * lane + 4), x2 = *(f32x4*)(xr + 512 + 8 * lane), x3 = *(f32x4*)(xr + 512 + 8 * lane + 4);
#pragma unroll
    for (int e = 0; e < 4; ++e) { x0[e] += out[e]; x1[e] += out[4 + e]; x2[e] += out[8 + e]; x3[e] += out[12 + e]; s2 += x0[e] * x0[e] + x1[e] * x1[e] + x2[e] * x2[e] + x3[e] * x3[e]; }
    *(f32x4*)(xr + 8 * lane) = x0; *(f32x4*)(xr + 8 * lane + 4) = x1; *(f32x4*)(xr + 512 + 8 * lane) = x2; *(f32x4*)(xr + 512 + 8 * lane + 4) = x3;
    u32x4 w0, w1; w0.x = pk2(x0.x, x0.y); w0.y = pk2(x0.z, x0.w); w0.z = pk2(x1.x, x1.y); w0.w = pk2(x1.z, x1.w); w1.x = pk2(x2.x, x2.y); w1.y = pk2(x2.z, x2.w); w1.z = pk2(x3.x, x3.y); w1.w = pk2(x3.z, x3.w);
    *(u32x4*)(XB2 + (size_t)token * D + 8 * lane) = w0; *(u32x4*)(XB2 + (size_t)token * D + 512 + 8 * lane) = w1;
    s2 = wave_sum(s2);
    if (lane == 0) RSTD3[token] = 1.0f / sqrtf(s2 * (1.0f / D) + EPS);
}
__global__ void __launch_bounds__(256) k_final(float* X, const float* g) {
    const int lane = threadIdx.x & 63, row = blockIdx.x * 4 + (threadIdx.x >> 6);
    f32x4* xr = (f32x4*)(X + (size_t)row * D); f32x4 v[4]; float ss = 0.f;
#pragma unroll
    for (int j = 0; j < 4; ++j) { v[j] = xr[lane + 64 * j]; ss += v[j].x * v[j].x + v[j].y * v[j].y + v[j].z * v[j].z + v[j].w * v[j].w; }
    ss = wave_sum(ss); const float rstd = 1.0f / sqrtf(ss * (1.0f / D) + EPS);
#pragma unroll
    for (int j = 0; j < 4; ++j) { const f32x4 gv = ((const f32x4*)g)[lane + 64 * j]; xr[lane + 64 * j] = v[j] * rstd * gv; }
}

extern "C" void kernel_launch(void* const* d_in, const int* in_sizes, int n_in, void* d_out, int out_size, void* d_ws, size_t ws_size, hipStream_t stream) {
    const float* x = (const float*)d_in[0]; const float* p = (const float*)d_in[1]; const float* g_mix = (const float*)d_in[2]; const float* w_in = (const float*)d_in[3];
    const float* b_f = (const float*)d_in[4]; const float* conv_w = (const float*)d_in[5]; const float* w_branch = (const float*)d_in[6]; const float* w_out = (const float*)d_in[7];
    const float* g_ffn = (const float*)d_in[8]; const float* w_peer_q = (const float*)d_in[9]; const float* peer_k1 = (const float*)d_in[10]; const float* peer_k2 = (const float*)d_in[11];
    const float* peer_u = (const float*)d_in[12]; const float* peer_v = (const float*)d_in[13]; const float* g_ple = (const float*)d_in[14]; const float* w_ple_gate = (const float*)d_in[15];
    const float* w_ple_proj = (const float*)d_in[16]; const float* g_final = (const float*)d_in[17];
    unsigned char* ws = (unsigned char*)d_ws; float* out = (float*)d_out;
    if (ws_size < WS_END) { fprintf(stderr, "ws too small %zu\n", ws_size); return; }
    float *RSTD1 = (float*)(ws + WS_RSTD1), *RSTD3 = (float*)(ws + WS_RSTD3), *SS2 = (float*)(ws + WS_SS2), *LF = (float*)(ws + WS_LF), *CS = (float*)(ws + WS_CS);
    bf16 *WIN = (bf16*)(ws + WS_WIN), *WBR = (bf16*)(ws + WS_WBR), *WOUT = (bf16*)(ws + WS_WOUT), *WST = (bf16*)(ws + WS_WS), *WPG = (bf16*)(ws + WS_WPG), *WPP = (bf16*)(ws + WS_WPP), *PB = (bf16*)(ws + WS_PB);
    bf16 *UB = (bf16*)(ws + WS_UB), *VB = (bf16*)(ws + WS_VB), *XB = (bf16*)(ws + WS_A), *AC = (bf16*)(ws + WS_A), *XB1 = (bf16*)(ws + WS_A), *PP = (bf16*)(ws + WS_PP);
    bf16 *Q = (bf16*)(ws + WS_Q), *K = (bf16*)(ws + WS_K), *V = (bf16*)(ws + WS_V), *GB = (bf16*)(ws + WS_GB), *Z = (bf16*)(ws + WS_Z), *MG = (bf16*)(ws + WS_MERGED), *XB2 = (bf16*)(ws + WS_XB2);
    int* IDS = (int*)(ws + WS_IDS); float* GATES = (float*)(ws + WS_GATES);
    bf16 *SGA = (bf16*)out, *SGC = (bf16*)out + (size_t)M * D;
    float *TGC = (float*)(ws + WS_TGC), *TXC = (float*)(ws + WS_TXC), *SC = (float*)(ws + WS_SC);
    auto nb = [](size_t n) { return (unsigned)((n + 255) / 256); };
    k_rows0<<<M / 4, 256, 0, stream>>>(x, w_in, g_mix, b_f, XB, RSTD1, LF);
    k_wt<1><<<nb((size_t)NIN * D), 256, 0, stream>>>(w_in, INTOT, g_mix, WIN, NIN, D, 0, D);
    k_wt<0><<<nb((size_t)D * AW), 256, 0, stream>>>(w_branch, D, nullptr, WBR, D, AW, 0, D);
    k_wt<0><<<nb((size_t)D * AW), 256, 0, stream>>>(w_branch + (size_t)AW * D, D, nullptr, WBR, D, AW, AW, D);
    k_wt<0><<<nb((size_t)D * D), 256, 0, stream>>>(w_out, D, nullptr, WOUT, D, D, 0, D);
    k_wt<0><<<nb((size_t)D * D), 256, 0, stream>>>(w_ple_gate, D, g_ple, WPG, D, D, 0, D);
    k_wt<0><<<nb((size_t)D * PLE), 256, 0, stream>>>(w_ple_proj, D, nullptr, WPP, D, PLE, 0, PLE);
    k_ws<<<nb((size_t)NS * D), 256, 0, stream>>>(w_peer_q, peer_k1, peer_k2, g_ffn, WST);
    k_cvt<<<nb((size_t)M * PLE), 256, 0, stream>>>(p, nullptr, PB, (size_t)M * PLE, 0);
    ng<E1, false><<<dim3(NIN / 64, M / 64), 256, 0, stream>>>(XB, D, WIN, D, D, E1{RSTD1, Q, K, V, GB, SGA, SGC, TGC, TXC});
    ng<EPP, false><<<dim3(D / 64, M / 64), 256, 0, stream>>>(PB, PLE, WPP, PLE, PLE, EPP{PP});
    k_z<<<nb((size_t)M * AW), 256, 0, stream>>>(TGC, TXC, Z);
    k_cumsum<<<1, 64, 0, stream>>>(LF, CS);
    k_conv<<<nb((size_t)M * AW), 256, 0, stream>>>(GB, Z, conv_w, AC);
    k_attn<<<dim3(SEQ / 64, BATCH * NH), 64, 0, stream>>>(Q, K, V, CS, AC);
    ng<E3, true><<<dim3(D / 64, M / 64), 256, 0, stream>>>(AC, D, WBR, D, D, E3{SGA, SGC, MG});
    ng<E4, false><<<dim3(D / 64, M / 64), 256, 0, stream>>>(MG, D, WOUT, D, D, E4{x, out, XB1});
    k_rowss<<<M / 4, 256, 0, stream>>>(out, SS2);
    for (int hg = 0; hg < 2; ++hg) {
        ng<E5, false><<<dim3(1024 / 64, M / 64), 256, 0, stream>>>(XB1, D, WST + (size_t)hg * 1024 * D, D, D, E5{SC});
        k_topk<<<M * 4 / 32, 64, 0, stream>>>(SC, SS2, hg, IDS, GATES);
    }
    k_cvt<<<nb((size_t)NEXP * D), 256, 0, stream>>>(peer_u, g_ffn, UB, (size_t)NEXP * D, D - 1);
    k_cvt<<<nb((size_t)NEXP * D), 256, 0, stream>>>(peer_v, nullptr, VB, (size_t)NEXP * D, 0);
    k_peer<<<M / 4, 256, 0, stream>>>(XB1, SS2, IDS, GATES, UB, VB, out, XB2, RSTD3);
    ng<E7, false><<<dim3(D / 64, M / 64), 256, 0, stream>>>(XB2, D, WPG, D, D, E7{RSTD3, PP, out});
    k_final<<<M / 4, 256, 0, stream>>>(out, g_final);
}
```

```cpp
#include <hip/hip_runtime.h>
#include <hip/hip_bf16.h>
#include <cstdio>
#include <cstdint>
#include <cmath>
#define MK_FUSED_MASK 0x1ff
namespace pg8 {
#define PG8_LAS __attribute__((address_space(3)))
typedef unsigned short bf16_t;
typedef short bf16x8 __attribute__((ext_vector_type(8)));
typedef float f32x4 __attribute__((ext_vector_type(4)));
typedef unsigned u32x4 __attribute__((ext_vector_type(4)));
constexpr int BM = 256, BK = 64, HALF = 128, HTB = HALF * BK * 2  , STAGE_BYTES = 8 * HTB, NXCD = 8, WGM = 8;

__host__ __device__ __forceinline__ int lds_byte(int r, int c) { const int st = (r >> 4) * 2 + (c >> 5), rr = r & 15, cc = c & 31, ob = rr * 64 + cc * 2; return st * 1024 + (ob ^ (((ob >> 9) & 1) << 5)); }
__host__ __device__ __forceinline__ void stage_rc(int b, int& R, int& C) { const int st = b / 1024, sb = b % 1024, swz = sb ^ (((sb >> 9) & 1) << 5); R = (st >> 1) * 16 + swz / 64; C = (st & 1) * 32 + (swz % 64) / 2; }
__host__ __device__ __forceinline__ int perm32(int rho) { const int n = rho >> 4, i = rho & 15; return 8 * (i >> 2) + 4 * n + (i & 3); }

struct Unit { int pm, pn; };
struct Gemm { const bf16_t* A; const bf16_t* Bt; int M, N, K; };

struct StaticOrder {
    int nM, nN, nwg, G, c;
    __host__ __device__ void init(int M, int N, int G_, int c_) { nM = M / BM; nN = N / BM; nwg = nM * nN; G = G_; c = c_; }
    __host__ __device__ bool next(int i, Unit& u) const {
        const long L = (long)i * G + c; if (L >= nwg) return false;
        int wgid = (int)L; { const int q = nwg / NXCD, r = nwg % NXCD, xcd = wgid % NXCD, off = wgid / NXCD; wgid = (xcd < r ? xcd * (q + 1) : r * (q + 1) + (xcd - r) * q) + off; }
        const int nig = WGM * nN, gid = wgid / nig, fm = gid * WGM, gsz = (nM - fm) < WGM ? (nM - fm) : WGM;
        u.pm = fm + ((wgid % nig) % gsz); u.pn = (wgid % nig) / gsz; return true;
    }
    __device__ __forceinline__ void a_ready(const Unit&) const {}
    __device__ __forceinline__ void done(const Unit&) const {}
};


__device__ __forceinline__ unsigned cvt_pk_bf16(float lo, float hi) { unsigned r; asm volatile("v_cvt_pk_bf16_f32 %0, %1, %2" : "=v"(r) : "v"(lo), "v"(hi)); return r; }
__device__ __forceinline__ u32x4 pack8(const f32x4 v0, const f32x4 v1) { u32x4 w; w.x = cvt_pk_bf16(v0[0], v0[1]); w.y = cvt_pk_bf16(v0[2], v0[3]); w.z = cvt_pk_bf16(v1[0], v1[1]); w.w = cvt_pk_bf16(v1[2], v1[3]); return w; }
__device__ __forceinline__ float bflo(unsigned w) { return __uint_as_float(w << 16); }
__device__ __forceinline__ float bfhi(unsigned w) { return __uint_as_float(w & 0xffff0000u); }
__device__ __forceinline__ float sigm(float v) { return __builtin_amdgcn_rcpf(1.0f + __builtin_amdgcn_exp2f(v * -1.4426950408889634f)); }
__device__ __forceinline__ f32x4 sigm4(const f32x4 v) { return (f32x4){sigm(v[0]), sigm(v[1]), sigm(v[2]), sigm(v[3])}; }

struct EpiIn {
    static constexpr bool PERM = true, AFTER_DRAIN = false; static constexpr int MID_T = 0;
    const float* rstd; bf16_t* QKVG; size_t stride4; bf16_t* Z; bf16_t* SG; size_t strideSG; float c2;
    __device__ __forceinline__ void operator()(const f32x4 (&acc)[2][2][4][2], const Unit& u, int wr, int wc, int fr, int fq) const {
        int row0 = u.pm * BM + wr * 64 + fr; asm volatile("" : "+v"(row0)); const int cl = wc * 32 + 8 * fq, pn = u.pn;
        if (pn < 8) {
            bf16_t* base = QKVG + (size_t)(pn >> 1) * stride4; const int colt = (pn & 1) * 256 + cl; const float s0 = pn < 2 ? c2 : 1.f;
#pragma unroll
            for (int ai = 0; ai < 2; ++ai)
#pragma unroll
                for (int m = 0; m < 4; ++m) { const int row = row0 + ai * HALF + m * 16; const float sc = rstd[row] * s0; bf16_t* rowp = base + (size_t)row * 512 + colt;
#pragma unroll
                    for (int bj = 0; bj < 2; ++bj) *(u32x4*)(rowp + bj * HALF) = pack8(acc[ai][bj][m][0] * sc, acc[ai][bj][m][1] * sc);
                    asm volatile("" ::: "memory"); }
        } else if (pn < 12) {
            const int colt = (pn - 8) * 128 + cl;
#pragma unroll
            for (int ai = 0; ai < 2; ++ai)
#pragma unroll
                for (int m = 0; m < 4; ++m) { const int row = row0 + ai * HALF + m * 16; const float r = rstd[row], sc = r * r;
                    *(u32x4*)(Z + (size_t)row * 512 + colt) = pack8(acc[ai][0][m][0] * acc[ai][1][m][0] * sc, acc[ai][0][m][1] * acc[ai][1][m][1] * sc);
                    asm volatile("" ::: "memory"); }
        } else {
            bf16_t* base = SG + (size_t)((pn - 12) >> 2) * strideSG; const int colt = ((pn - 12) & 3) * 256 + cl;
#pragma unroll
            for (int ai = 0; ai < 2; ++ai)
#pragma unroll
                for (int m = 0; m < 4; ++m) { const int row = row0 + ai * HALF + m * 16; const float r = rstd[row]; bf16_t* rowp = base + (size_t)row * 1024 + colt;
#pragma unroll
                    for (int bj = 0; bj < 2; ++bj) { *(u32x4*)(rowp + bj * HALF) = pack8(sigm4(acc[ai][bj][m][0] * r), sigm4(acc[ai][bj][m][1] * r)); asm volatile("" ::: "memory"); } }
        }
    }
};
struct EpiPlain {
    static constexpr bool PERM = true, AFTER_DRAIN = false; static constexpr int MID_T = 0;
    bf16_t* O; int ldc;
    __device__ __forceinline__ void operator()(const f32x4 (&acc)[2][2][4][2], const Unit& u, int wr, int wc, int fr, int fq) const {
        int row0 = u.pm * BM + wr * 64 + fr; asm volatile("" : "+v"(row0)); const int col0 = u.pn * BM + wc * 32 + 8 * fq;
#pragma unroll
        for (int ai = 0; ai < 2; ++ai)
#pragma unroll
            for (int m = 0; m < 4; ++m) { bf16_t* rowp = O + (size_t)(row0 + ai * HALF + m * 16) * ldc + col0;
#pragma unroll
                for (int bj = 0; bj < 2; ++bj) *(u32x4*)(rowp + bj * HALF) = pack8(acc[ai][bj][m][0], acc[ai][bj][m][1]); }
    }
};
struct EpiBranch {
    static constexpr bool PERM = true, AFTER_DRAIN = false; static constexpr int MID_T = 8;
    const bf16_t *SGA, *SGC; bf16_t* MG;
    __device__ __forceinline__ void mid(f32x4 (&acc)[2][2][4][2], const Unit& u, int wr, int wc, int fr, int fq) const {
        int row0 = u.pm * BM + wr * 64 + fr; asm volatile("" : "+v"(row0)); const int col0 = u.pn * BM + wc * 32 + 8 * fq;
#pragma unroll
        for (int ai = 0; ai < 2; ++ai)
#pragma unroll
            for (int m = 0; m < 4; ++m) { const size_t off = (size_t)(row0 + ai * HALF + m * 16) * 1024 + col0;
#pragma unroll
                for (int bj = 0; bj < 2; ++bj) { const u32x4 a = *(const u32x4*)(SGA + off + bj * HALF), c = *(const u32x4*)(SGC + off + bj * HALF);
                    f32x4 r0, r1;
                    r0[0] = bflo(a[0]) * __builtin_amdgcn_rcpf(bflo(c[0])); r0[1] = bfhi(a[0]) * __builtin_amdgcn_rcpf(bfhi(c[0])); r0[2] = bflo(a[1]) * __builtin_amdgcn_rcpf(bflo(c[1])); r0[3] = bfhi(a[1]) * __builtin_amdgcn_rcpf(bfhi(c[1]));
                    r1[0] = bflo(a[2]) * __builtin_amdgcn_rcpf(bflo(c[2])); r1[1] = bfhi(a[2]) * __builtin_amdgcn_rcpf(bfhi(c[2])); r1[2] = bflo(a[3]) * __builtin_amdgcn_rcpf(bflo(c[3])); r1[3] = bfhi(a[3]) * __builtin_amdgcn_rcpf(bfhi(c[3]));
                    acc[ai][bj][m][0] *= r0; acc[ai][bj][m][1] *= r1; asm volatile("" ::: "memory"); } }
    }
    __device__ __forceinline__ void operator()(const f32x4 (&acc)[2][2][4][2], const Unit& u, int wr, int wc, int fr, int fq) const {
        int row0 = u.pm * BM + wr * 64 + fr; asm volatile("" : "+v"(row0)); const int col0 = u.pn * BM + wc * 32 + 8 * fq;
#pragma unroll
        for (int ai = 0; ai < 2; ++ai)
#pragma unroll
            for (int m = 0; m < 4; ++m) { const size_t off = (size_t)(row0 + ai * HALF + m * 16) * 1024 + col0;
#pragma unroll
                for (int bj = 0; bj < 2; ++bj) { const u32x4 c = *(const u32x4*)(SGC + off + bj * HALF);
                    const f32x4 s0 = {bflo(c[0]), bfhi(c[0]), bflo(c[1]), bfhi(c[1])}, s1 = {bflo(c[2]), bfhi(c[2]), bflo(c[3]), bfhi(c[3])};
                    *(u32x4*)(MG + off + bj * HALF) = pack8(acc[ai][bj][m][0] * s0, acc[ai][bj][m][1] * s1); asm volatile("" ::: "memory"); } }
    }
};
struct EpiOut {
    static constexpr bool PERM = true, AFTER_DRAIN = false; static constexpr int MID_T = 0;
    const float* x; float* X1; bf16_t* XB1; float* SS2;
    __device__ __forceinline__ void operator()(const f32x4 (&acc)[2][2][4][2], const Unit& u, int wr, int wc, int fr, int fq) const {
        int row0 = u.pm * BM + wr * 64 + fr; asm volatile("" : "+v"(row0)); const int col0 = u.pn * BM + wc * 32 + 8 * fq;
#pragma unroll
        for (int ai = 0; ai < 2; ++ai)
#pragma unroll
            for (int m = 0; m < 4; ++m) { const int row = row0 + ai * HALF + m * 16; const size_t off = (size_t)row * 1024 + col0; float ss = 0.f;
#pragma unroll
                for (int bj = 0; bj < 2; ++bj) { const f32x4 v0 = acc[ai][bj][m][0] + *(const f32x4*)(x + off + bj * HALF), v1 = acc[ai][bj][m][1] + *(const f32x4*)(x + off + bj * HALF + 4);
                    *(f32x4*)(X1 + off + bj * HALF) = v0; *(f32x4*)(X1 + off + bj * HALF + 4) = v1; *(u32x4*)(XB1 + off + bj * HALF) = pack8(v0, v1);
                    ss += (v0[0] * v0[0] + v0[1] * v0[1]) + (v0[2] * v0[2] + v0[3] * v0[3]) + (v1[0] * v1[0] + v1[1] * v1[1]) + (v1[2] * v1[2] + v1[3] * v1[3]); }
                ss += __shfl_xor(ss, 16); ss += __shfl_xor(ss, 32);
                if (fq == 0) SS2[(size_t)row * 16 + u.pn * 4 + wc] = ss;
                if (m & 1) asm volatile("" ::: "memory"); }
    }
};
struct EpiPle {
    static constexpr bool PERM = true, AFTER_DRAIN = false; static constexpr int MID_T = 0;
    const float* rstd3; const bf16_t* PP; float* X;
    __device__ __forceinline__ void operator()(const f32x4 (&acc)[2][2][4][2], const Unit& u, int wr, int wc, int fr, int fq) const {
        int row0 = u.pm * BM + wr * 64 + fr; asm volatile("" : "+v"(row0)); const int col0 = u.pn * BM + wc * 32 + 8 * fq;
#pragma unroll
        for (int ai = 0; ai < 2; ++ai)
#pragma unroll
            for (int m = 0; m < 4; ++m) { const int row = row0 + ai * HALF + m * 16; const size_t off = (size_t)row * 1024 + col0; const float r = rstd3[row];
#pragma unroll
                for (int bj = 0; bj < 2; ++bj) { const u32x4 c = *(const u32x4*)(PP + off + bj * HALF);
                    const f32x4 p0 = {bflo(c[0]), bfhi(c[0]), bflo(c[1]), bfhi(c[1])}, p1 = {bflo(c[2]), bfhi(c[2]), bflo(c[3]), bfhi(c[3])};
                    const f32x4 x0 = *(const f32x4*)(X + off + bj * HALF), x1 = *(const f32x4*)(X + off + bj * HALF + 4);
                    *(f32x4*)(X + off + bj * HALF) = x0 + sigm4(acc[ai][bj][m][0] * r) * p0; *(f32x4*)(X + off + bj * HALF + 4) = x1 + sigm4(acc[ai][bj][m][1] * r) * p1; }
                if (m & 1) asm volatile("" ::: "memory"); }
    }
};

__device__ __forceinline__ float vmaxf(float a, float b) { float r; asm("v_max_f32_e32 %0, %1, %2" : "=v"(r) : "v"(a), "v"(b)); return r; }
__device__ __forceinline__ float vminf(float a, float b) { float r; asm("v_min_f32_e32 %0, %1, %2" : "=v"(r) : "v"(a), "v"(b)); return r; }
__device__ __forceinline__ void sort16_desc(float (&a)[16]) {
#pragma unroll
    for (int k = 2; k <= 16; k <<= 1)
#pragma unroll
        for (int j = k >> 1; j > 0; j >>= 1)
#pragma unroll
            for (int i = 0; i < 16; ++i) { const int l = i ^ j; if (l > i) { const float hi = vmaxf(a[i], a[l]), lo = vminf(a[i], a[l]); if ((i & k) == 0) { a[i] = hi; a[l] = lo; } else { a[i] = lo; a[l] = hi; } } }
}
template <int L> __device__ __forceinline__ void merge16(float (&a)[16], const float (&b)[16]) {
#pragma unroll
    for (int i = 0; i < 16; ++i) if (15 - i < L) a[i] = vmaxf(a[i], b[15 - i]);
#pragma unroll
    for (int j = 8; j > 0; j >>= 1)
#pragma unroll
        for (int i = 0; i < 16; ++i) { const int l = i ^ j; if (l > i) { const float hi = vmaxf(a[i], a[l]), lo = vminf(a[i], a[l]); a[i] = hi; a[l] = lo; } }
}
struct EpiTopK {
    static constexpr bool PERM = true, AFTER_DRAIN = true; static constexpr int MID_T = 0;
    static constexpr int RS = 260;
    const float* SS2; int* IDS; float* GATES; float eps;
    __device__ __forceinline__ void fused(f32x4 (&acc)[2][2][4][2], const Unit& u, int wr, int wc, int fr, int fq, PG8_LAS unsigned char* lds, int wid, int lane) const {
        PG8_LAS float* S = (PG8_LAS float*)lds;
        const int tid = wid * 64 + lane, row = tid & 127, grp = tid >> 7, half = grp >> 1, part = grp & 1;
#define TK_BAR() do { asm volatile("s_waitcnt vmcnt(0) lgkmcnt(0)" ::: "memory"); __builtin_amdgcn_s_barrier(); asm volatile("" ::: "memory"); } while (0)
#pragma unroll
        for (int ai = 0; ai < 2; ++ai) {
#pragma unroll
            for (int m = 0; m < 4; ++m)
#pragma unroll
                for (int bj = 0; bj < 2; ++bj)
#pragma unroll
                    for (int n = 0; n < 2; ++n) *(PG8_LAS f32x4*)(S + (wr * 64 + m * 16 + fr) * RS + bj * HALF + wc * 32 + 8 * fq + 4 * n) = acc[ai][bj][m][n];
            TK_BAR();
            float T[16];
#pragma unroll
            for (int b = 0; b < 4; ++b) {
                float c[16];
#pragma unroll
                for (int q = 0; q < 4; ++q) { const f32x4 v = *(const PG8_LAS f32x4*)(S + row * RS + half * 128 + part * 64 + b * 16 + q * 4);
#pragma unroll
                    for (int e = 0; e < 4; ++e) c[q * 4 + e] = __uint_as_float((__float_as_uint(v[e]) & ~127u) | (unsigned)(part * 64 + b * 16 + q * 4 + e)); }
                sort16_desc(c);
                if (b == 0) {
#pragma unroll
                    for (int i = 0; i < 16; ++i) T[i] = c[i];
                } else merge16<16>(T, c);
            }
            TK_BAR();
#pragma unroll
            for (int q = 0; q < 4; ++q) *(PG8_LAS f32x4*)(S + tid * 16 + q * 4) = (f32x4){T[q * 4], T[q * 4 + 1], T[q * 4 + 2], T[q * 4 + 3]};
            TK_BAR();
            if (part == 0) {
                float c[16];
#pragma unroll
                for (int q = 0; q < 4; ++q) { const f32x4 v = *(const PG8_LAS f32x4*)(S + (tid + 128) * 16 + q * 4); c[q * 4] = v[0]; c[q * 4 + 1] = v[1]; c[q * 4 + 2] = v[2]; c[q * 4 + 3] = v[3]; }
                merge16<16>(T, c);
            }
            TK_BAR();
            if (part == 0) {
#pragma unroll
                for (int q = 0; q < 4; ++q) *(PG8_LAS f32x4*)(S + tid * 16 + q * 4) = (f32x4){T[q * 4], T[q * 4 + 1], T[q * 4 + 2], T[q * 4 + 3]};
            }
            TK_BAR();
            if (tid < 128) {
                float a1[16], a2[16];
#pragma unroll
                for (int q = 0; q < 4; ++q) { const f32x4 v = *(const PG8_LAS f32x4*)(S + (tid + 256) * 16 + q * 4);
#pragma unroll
                    for (int e = 0; e < 4; ++e) a2[q * 4 + e] = __uint_as_float(__float_as_uint(v[e]) & ~127u); }
#pragma unroll
                for (int i = 0; i < 16; ++i) a1[i] = __uint_as_float(__float_as_uint(T[i]) & ~127u);
#define TK_SUM(i, j) __uint_as_float((__float_as_uint(a1[i] + a2[j]) & ~255u) | (unsigned)((i) * 16 + (j)))
                float R[16], C[16];
#pragma unroll
                for (int j = 0; j < 16; ++j) R[j] = TK_SUM(0, j);
#pragma unroll
                for (int i = 1; i < 16; ++i) C[i - 1] = TK_SUM(i, 0);
                C[15] = 0.f;
                merge16<15>(R, C);
                C[0] = TK_SUM(1, 1); C[1] = TK_SUM(1, 2); C[2] = TK_SUM(1, 3); C[3] = TK_SUM(1, 4); C[4] = TK_SUM(1, 5); C[5] = TK_SUM(1, 6); C[6] = TK_SUM(1, 7);
                C[7] = TK_SUM(2, 1); C[8] = TK_SUM(2, 2); C[9] = TK_SUM(2, 3); C[10] = TK_SUM(2, 4); C[11] = TK_SUM(3, 1); C[12] = TK_SUM(3, 2); C[13] = TK_SUM(3, 3);
                C[14] = TK_SUM(4, 1); C[15] = TK_SUM(4, 2);
                sort16_desc(C);
                merge16<16>(R, C);
                C[0] = TK_SUM(5, 1); C[1] = TK_SUM(6, 1); C[2] = TK_SUM(7, 1);
                merge16<3>(R, C);
#undef TK_SUM
                const int rowg = u.pm * BM + ai * HALF + row;
                const f32x4* ssp = (const f32x4*)(SS2 + (size_t)rowg * 16); const f32x4 s0 = ssp[0], s1 = ssp[1], s2 = ssp[2], s3 = ssp[3];
                const float ssum = ((s0[0] + s0[1]) + (s0[2] + s0[3])) + ((s1[0] + s1[1]) + (s1[2] + s1[3])) + ((s2[0] + s2[1]) + (s2[2] + s2[3])) + ((s3[0] + s3[1]) + (s3[2] + s3[3]));
                const float rl = 1.4426950408889634f / sqrtf(ssum * (1.0f / 1024.0f) + eps);
                float ev[16], esum = 0.f; int idv[16];
#pragma unroll
                for (int r = 0; r < 16; ++r) { ev[r] = __builtin_amdgcn_exp2f((R[r] - R[0]) * rl); esum += ev[r];
                    const unsigned code = __float_as_uint(R[r]) & 255u;
                    const unsigned k1 = __float_as_uint(S[tid * 16 + (code >> 4)]) & 127u, k2 = __float_as_uint(S[(tid + 256) * 16 + (code & 15u)]) & 127u;
                    idv[r] = (int)(k1 * 128u + k2); }
                const float inv = 1.0f / esum;
                int* ip = IDS + (size_t)rowg * 128 + u.pn * 16; float* gp = GATES + (size_t)rowg * 128 + u.pn * 16;
#pragma unroll
                for (int q = 0; q < 4; ++q) { *(int4*)(ip + q * 4) = make_int4(idv[q * 4], idv[q * 4 + 1], idv[q * 4 + 2], idv[q * 4 + 3]);
                    *(f32x4*)(gp + q * 4) = (f32x4){ev[q * 4] * inv, ev[q * 4 + 1] * inv, ev[q * 4 + 2] * inv, ev[q * 4 + 3] * inv}; }
            }
            TK_BAR();
        }
#undef TK_BAR
    }
};
template <class Epi, class Sched, bool ALIGN_EPI = false, bool SP2 = false>
__device__ __forceinline__ void gemm_phase(PG8_LAS unsigned char* lds, const Gemm g, const Sched& S, const Epi& E) {
    const int tid = threadIdx.x, wid = __builtin_amdgcn_readfirstlane(tid >> 6), lane = tid & 63, wr = wid >> 2, wc = wid & 3, fr = lane & 15, fq = lane >> 4;
    const int K = g.K, nt = K / BK;
    unsigned voffA[2], voffB[2];
#pragma unroll
    for (int i = 0; i < 2; ++i) { int R, C; stage_rc(tid * 16 + i * 8192, R, C); const int Rb = Epi::PERM ? ((R & ~31) + perm32(R & 31)) : R;
        voffA[i] = (unsigned)(R * K + C) * 2u; voffB[i] = (unsigned)(Rb * K + C) * 2u; }
    const size_t kstep = (size_t)(BK * 2);
    const size_t hstep = (size_t)HALF * K * 2;
    const size_t tstep = 2 * hstep;
    const unsigned ldsw = (unsigned)wid * 1024u;
    const int aoff = lds_byte(wr * 64 + fr, fq * 8), boff = lds_byte(wc * 32 + fr, fq * 8);
#define PG8_SA(b, h) (((b) * 2 + (h)) * HTB)
#define PG8_SB(b, h) ((4 + (b) * 2 + (h)) * HTB)
#define PG8_STAGE(bufoff, gbase, voff) do { _Pragma("unroll") for (int _i = 0; _i < 2; ++_i) \
        __builtin_amdgcn_global_load_lds((const unsigned*)((const char*)(gbase) + (voff)[_i]), (PG8_LAS unsigned*)(lds + (bufoff) + ldsw + _i * 8192), 16, 0, 0); } while (0)
#define PG8_LDA(dst, b, h) do { _Pragma("unroll") for (int m = 0; m < 4; ++m) _Pragma("unroll") for (int k = 0; k < 2; ++k) dst[m][k] = *(const PG8_LAS bf16x8*)(lds + PG8_SA(b, h) + aoff + m * 2048 + k * 1024); } while (0)
#define PG8_LDB(dst, b, h) do { _Pragma("unroll") for (int n = 0; n < 2; ++n) _Pragma("unroll") for (int k = 0; k < 2; ++k) dst[n][k] = *(const PG8_LAS bf16x8*)(lds + PG8_SB(b, h) + boff + n * 2048 + k * 1024); } while (0)
#define PG8_MMA(ai, bj, At, Bt) do { __builtin_amdgcn_s_setprio(1); _Pragma("unroll") for (int m = 0; m < 4; ++m) _Pragma("unroll") for (int n = 0; n < 2; ++n) _Pragma("unroll") for (int k = 0; k < 2; ++k) \
        acc[ai][bj][m][n] = __builtin_amdgcn_mfma_f32_16x16x32_bf16(Bt[n][k], At[m][k], acc[ai][bj][m][n], 0, 0, 0); __builtin_amdgcn_s_setprio(0); } while (0)
#define PG8_WAIT_V(n) asm volatile("s_waitcnt vmcnt(" #n ")" ::: "memory")
#define PG8_WAIT_L(n) asm volatile("s_waitcnt lgkmcnt(" #n ")" ::: "memory")
#define PG8_BAR __builtin_amdgcn_s_barrier()
#define PG8_SCHED __builtin_amdgcn_sched_barrier(0)
    Unit cur, nxt; int ui = 0;
    if (!S.next(0, cur)) return;
    f32x4 acc[2][2][4][2];
#pragma unroll
    for (int a = 0; a < 2; ++a)
#pragma unroll
        for (int b = 0; b < 2; ++b)
#pragma unroll
            for (int m = 0; m < 4; ++m)
#pragma unroll
                for (int n = 0; n < 2; ++n) acc[a][b][m][n] = (f32x4){0.f, 0.f, 0.f, 0.f};
    bf16x8 At[4][2], B0[2][2], B1[2][2];
    const char* cA = (const char*)g.A + (size_t)cur.pm * tstep; const char* cB = (const char*)g.Bt + (size_t)cur.pn * tstep;
    S.a_ready(cur);
    if constexpr (SP2) {
        PG8_STAGE(PG8_SB(0, 0), cB, voffB); PG8_STAGE(PG8_SB(0, 1), cB + hstep, voffB); PG8_STAGE(PG8_SA(0, 0), cA, voffA); PG8_STAGE(PG8_SA(0, 1), cA + hstep, voffA);
        if (wr == 1) PG8_BAR;
        PG8_WAIT_V(2); PG8_BAR;
        PG8_STAGE(PG8_SB(1, 0), cB + kstep, voffB); PG8_STAGE(PG8_SA(1, 0), cA + kstep, voffA); PG8_STAGE(PG8_SB(1, 1), cB + hstep + kstep, voffB);
        PG8_WAIT_V(6); PG8_BAR;
    } else {
        PG8_STAGE(PG8_SB(0, 0), cB, voffB); PG8_STAGE(PG8_SA(0, 0), cA, voffA); PG8_STAGE(PG8_SB(0, 1), cB + hstep, voffB); PG8_STAGE(PG8_SA(0, 1), cA + hstep, voffA);
        if (wr == 1) PG8_BAR;
        PG8_WAIT_V(4); PG8_BAR;
        PG8_STAGE(PG8_SB(1, 0), cB + kstep, voffB); PG8_STAGE(PG8_SA(1, 0), cA + kstep, voffA); PG8_STAGE(PG8_SB(1, 1), cB + hstep + kstep, voffB);
        PG8_WAIT_V(6); PG8_BAR;
    }
    for (;;) {
        const bool has_next = S.next(ui + 1, nxt);
        const char* nA = has_next ? (const char*)g.A + (size_t)nxt.pm * tstep : cA; const char* nB = has_next ? (const char*)g.Bt + (size_t)nxt.pn * tstep : cB;
        for (int t = 0; t < nt; t += 2) {
            if constexpr (Epi::MID_T > 0) { if (t == Epi::MID_T) E.mid(acc, cur, wr, wc, fr, fq); }
            const bool last = (t == nt - 2);
            const char* a1 = cA + (size_t)(t + 1) * kstep;
            const char* a2 = last ? nA : cA + (size_t)(t + 2) * kstep; const char* b2 = last ? nB : cB + (size_t)(t + 2) * kstep;
            const char* a3 = a2 + kstep; const char* b3 = b2 + kstep;
            if (last && has_next) S.a_ready(nxt);
            if constexpr (SP2) {
            PG8_LDB(B0, 0, 0); PG8_LDB(B1, 0, 1); PG8_SCHED; PG8_LDA(At, 0, 0); PG8_STAGE(PG8_SA(1, 1), a1 + hstep, voffA);
            PG8_WAIT_V(8); PG8_WAIT_L(0); PG8_BAR; PG8_MMA(0, 0, At, B0); PG8_MMA(0, 1, At, B1); PG8_BAR; PG8_SCHED;
            PG8_LDA(At, 0, 1); PG8_STAGE(PG8_SB(0, 0), b2, voffB); PG8_STAGE(PG8_SB(0, 1), b2 + hstep, voffB); PG8_STAGE(PG8_SA(0, 0), a2, voffA);
            PG8_WAIT_V(8); PG8_WAIT_L(0); PG8_BAR; PG8_MMA(1, 0, At, B0); PG8_MMA(1, 1, At, B1); PG8_BAR; PG8_SCHED;
            PG8_LDB(B0, 1, 0); PG8_LDB(B1, 1, 1); PG8_SCHED; PG8_LDA(At, 1, 0); PG8_STAGE(PG8_SA(0, 1), a2 + hstep, voffA);
            PG8_WAIT_V(8); PG8_WAIT_L(0); PG8_BAR; PG8_MMA(0, 0, At, B0); PG8_MMA(0, 1, At, B1); PG8_BAR; PG8_SCHED;
            PG8_LDA(At, 1, 1); PG8_STAGE(PG8_SB(1, 0), b3, voffB); PG8_STAGE(PG8_SB(1, 1), b3 + hstep, voffB); PG8_STAGE(PG8_SA(1, 0), a3, voffA);
            PG8_WAIT_V(8); PG8_WAIT_L(0); PG8_BAR; PG8_MMA(1, 0, At, B0); PG8_MMA(1, 1, At, B1); PG8_BAR; PG8_SCHED;
            } else {
            PG8_LDB(B0, 0, 0); PG8_SCHED; PG8_LDA(At, 0, 0); PG8_STAGE(PG8_SA(1, 1), a1 + hstep, voffA);
            PG8_WAIT_L(8); PG8_BAR; PG8_WAIT_L(0); PG8_MMA(0, 0, At, B0); PG8_BAR; PG8_SCHED;
            PG8_LDB(B1, 0, 1); PG8_STAGE(PG8_SB(0, 0), b2, voffB);
            PG8_BAR; PG8_WAIT_L(0); PG8_MMA(0, 1, At, B1); PG8_BAR;
            PG8_LDA(At, 0, 1); PG8_STAGE(PG8_SA(0, 0), a2, voffA);
            PG8_BAR; PG8_WAIT_L(0); PG8_MMA(1, 0, At, B0); PG8_BAR; PG8_SCHED;
            PG8_STAGE(PG8_SB(0, 1), b2 + hstep, voffB);
            PG8_WAIT_V(6); PG8_BAR; PG8_MMA(1, 1, At, B1); PG8_BAR;
            PG8_LDB(B0, 1, 0); PG8_SCHED; PG8_LDA(At, 1, 0); PG8_STAGE(PG8_SA(0, 1), a2 + hstep, voffA);
            PG8_WAIT_L(8); PG8_BAR; PG8_WAIT_L(0); PG8_MMA(0, 0, At, B0); PG8_BAR; PG8_SCHED;
            PG8_LDB(B1, 1, 1); PG8_STAGE(PG8_SB(1, 0), b3, voffB);
            PG8_BAR; PG8_WAIT_L(0); PG8_MMA(0, 1, At, B1); PG8_BAR;
            PG8_LDA(At, 1, 1); PG8_STAGE(PG8_SA(1, 0), a3, voffA);
            PG8_BAR; PG8_WAIT_L(0); PG8_MMA(1, 0, At, B0); PG8_BAR; PG8_SCHED;
            PG8_STAGE(PG8_SB(1, 1), b3 + hstep, voffB);
            PG8_WAIT_V(6); PG8_BAR; PG8_MMA(1, 1, At, B1); PG8_BAR;
            }
        }
        if constexpr (ALIGN_EPI) { if (wr == 0) PG8_BAR; }
        if constexpr (!Epi::AFTER_DRAIN) { E(acc, cur, wr, wc, fr, fq); S.done(cur); }
        if (!has_next) break;
#pragma unroll
        for (int a = 0; a < 2; ++a)
#pragma unroll
            for (int b = 0; b < 2; ++b)
#pragma unroll
                for (int m = 0; m < 4; ++m)
#pragma unroll
                    for (int n = 0; n < 2; ++n) acc[a][b][m][n] = (f32x4){0.f, 0.f, 0.f, 0.f};
        cur = nxt; cA = nA; cB = nB; ++ui;
        if constexpr (ALIGN_EPI) { if (wr == 1) PG8_BAR; }
    }
    PG8_WAIT_V(0);
    if constexpr (!ALIGN_EPI) { if (wr == 0) PG8_BAR; }
    PG8_BAR;
    if constexpr (Epi::AFTER_DRAIN) { E.fused(acc, cur, wr, wc, fr, fq, lds, wid, lane); S.done(cur); }
#undef PG8_SA
#undef PG8_SB
#undef PG8_STAGE
#undef PG8_LDA
#undef PG8_LDB
#undef PG8_MMA
#undef PG8_WAIT_V
#undef PG8_WAIT_L
#undef PG8_BAR
#undef PG8_SCHED
}
}
#ifndef PG8_SP2
#define PG8_SP2 true
#endif
#ifndef PG8_ALIGN
#define PG8_ALIGN true
#endif
namespace attn_body {
using bf16=__hip_bfloat16;
using bf16x8=__attribute__((ext_vector_type(8)))short;
using s16x4=__attribute__((ext_vector_type(4)))short;
using f32x16=__attribute__((ext_vector_type(16)))float;
using u32x4=__attribute__((ext_vector_type(4)))unsigned;
using f32x4v=__attribute__((ext_vector_type(4)))float;
constexpr int BATCH=4,NHEAD=8,SEQ=4096,D=64,DM=NHEAD*D,DMO=1024;
constexpr int NW=8,QBLK=32,QB=QBLK*NW,KVBLK=64,NQB=SEQ/QB;
constexpr int ATTN_PITCH=DM, ATTN_UNIT_ROWS=QB;
__device__ __forceinline__ int crow(int r,int hi){return (r&3)+8*(r>>2)+4*hi;}
#define SBAR() __builtin_amdgcn_sched_barrier(0)
__device__ __forceinline__ void cmask(f32x16&p0,f32x16&p1,int jb,int qrel,int hi){
  const float NEG=-INFINITY; int kb=64*jb+4*hi;
  #pragma unroll
  for(int r=0;r<16;++r){int kv=kb+(r&3)+8*(r>>2); if(kv>qrel)p0[r]=NEG; if(kv+32>qrel)p1[r]=NEG;}
}

constexpr int NSLOT=3, SLOTB=8192;
constexpr int LDS_K=0, LDS_V=NSLOT*SLOTB, LDS_WS=2*NSLOT*SLOTB, LDS_OST=LDS_WS+NW*64*4, LDS_CS=LDS_OST+NW*4096, LDS_BYTES=LDS_CS+SEQ*4+64;
constexpr float C2=0.125f*1.4426950408889634f;
__device__ __forceinline__ void glds16(const void*gsrc,unsigned lds_dst){unsigned keep;
  asm volatile("s_mov_b32 %0, m0\n\ts_mov_b32 m0, %2\n\ts_nop 0\n\tglobal_load_lds_dwordx4 %1, off\n\ts_mov_b32 m0, %0":"=&s"(keep):"v"(gsrc),"s"(lds_dst):"memory");}
__device__ __forceinline__ float max3f(float a,float b,float c){float r;asm("v_max3_f32 %0, %1, %2, %3":"=v"(r):"v"(a),"v"(b),"v"(c));return r;}
__device__ __forceinline__ float max2f(float a,float b){float r;asm("v_max_f32_e32 %0, %1, %2":"=v"(r):"v"(a),"v"(b));return r;}
__device__ __forceinline__ float fadd_s(float a,float b){float r;asm("v_add_f32_e32 %0, %1, %2":"=v"(r):"v"(a),"v"(b));return r;}
__device__ __forceinline__ float fsub_s(float a,float b){float r;asm("v_sub_f32_e32 %0, %1, %2":"=v"(r):"v"(a),"v"(b));return r;}
typedef float f32x2_t __attribute__((ext_vector_type(2))); typedef __bf16 bf16x2_t __attribute__((ext_vector_type(2)));
__device__ __forceinline__ unsigned cvtpk_s(float lo,float hi){f32x2_t v={lo,hi};bf16x2_t b=__builtin_convertvector(v,bf16x2_t);return __builtin_bit_cast(unsigned,b);}
#define WAIT_BAR(N) asm volatile("s_waitcnt vmcnt(" #N ") lgkmcnt(0)\n\ts_barrier":::"memory")

__device__ __forceinline__ void qkt(f32x16&p0,f32x16&p1,const char*Kslot,const bf16x8*qr,const f32x16&c0,const f32x16&c1,int r32,int hi){
  const char*kb=Kslot+hi*1024+r32*16;
  #pragma unroll
  for(int d0=0;d0<4;++d0){
    const bf16x8 b0=*reinterpret_cast<const bf16x8*>(kb+d0*2048);
    const bf16x8 b1=*reinterpret_cast<const bf16x8*>(kb+d0*2048+512);
    if(d0==0){p0=__builtin_amdgcn_mfma_f32_32x32x16_bf16(b0,qr[0],c0,0,0,0);p1=__builtin_amdgcn_mfma_f32_32x32x16_bf16(b1,qr[0],c1,0,0,0);}
    else{p0=__builtin_amdgcn_mfma_f32_32x32x16_bf16(b0,qr[d0],p0,0,0,0);p1=__builtin_amdgcn_mfma_f32_32x32x16_bf16(b1,qr[d0],p1,0,0,0);}}
}
typedef __attribute__((address_space(3))) const char* lds_cptr;
typedef short v4i16_t __attribute__((ext_vector_type(4)));
__device__ __forceinline__ void kload8(bf16x8*kf,lds_cptr kp){
  kf[0]=*(const __attribute__((address_space(3))) bf16x8*)(kp);      kf[1]=*(const __attribute__((address_space(3))) bf16x8*)(kp+512);
  kf[2]=*(const __attribute__((address_space(3))) bf16x8*)(kp+2048); kf[3]=*(const __attribute__((address_space(3))) bf16x8*)(kp+2560);
  kf[4]=*(const __attribute__((address_space(3))) bf16x8*)(kp+4096); kf[5]=*(const __attribute__((address_space(3))) bf16x8*)(kp+4608);
  kf[6]=*(const __attribute__((address_space(3))) bf16x8*)(kp+6144); kf[7]=*(const __attribute__((address_space(3))) bf16x8*)(kp+6656);
}
__device__ __forceinline__ void kload2(bf16x8*kf,lds_cptr kp,int j){ kf[2*j]=*(const __attribute__((address_space(3))) bf16x8*)(kp+j*2048); kf[2*j+1]=*(const __attribute__((address_space(3))) bf16x8*)(kp+j*2048+512); }
__device__ __forceinline__ s16x4 vtr(lds_cptr p){ return __builtin_bit_cast(s16x4,__builtin_amdgcn_ds_read_tr16_b64_v4i16((__attribute__((address_space(3))) v4i16_t*)p)); }
__device__ __forceinline__ float rowmax(const f32x16&p0,const f32x16&p1){
  float a=max3f(p0[0],p0[1],p1[0]),b=max3f(p0[2],p0[3],p1[1]);a=max3f(a,p1[2],p1[3]);
  #pragma unroll
  for(int r=4;r<16;r+=4){a=max3f(a,p0[r],p0[r+1]);b=max3f(b,p0[r+2],p0[r+3]);a=max3f(a,p1[r],p1[r+1]);b=max3f(b,p1[r+2],p1[r+3]);}
  const float m=max2f(a,b);
  auto rr=__builtin_amdgcn_permlane32_swap(__float_as_uint(m),__float_as_uint(m),false,false);
  return max2f(__uint_as_float(rr[0]),__uint_as_float(rr[1]));
}
__device__ __forceinline__ void pv(f32x16*o,int vb,bf16x8 pa0,bf16x8 pa1,bf16x8 pa2,bf16x8 pa3){
  #pragma unroll
  for(int d0=0;d0<2;++d0){s16x4 lo[4],hi[4];
    #pragma unroll
    for(int ks=0;ks<4;++ks){
      asm volatile("ds_read_b64_tr_b16 %0,%1 offset:%c2":"=&v"(lo[ks]):"v"(vb),"i"(d0*4096+ks*1024):"memory");
      asm volatile("ds_read_b64_tr_b16 %0,%1 offset:%c2":"=&v"(hi[ks]):"v"(vb),"i"(d0*4096+ks*1024+512):"memory");}
    asm volatile("s_waitcnt lgkmcnt(0)":::"memory");SBAR();
    #define PK(k) (bf16x8){lo[k][0],lo[k][1],lo[k][2],lo[k][3],hi[k][0],hi[k][1],hi[k][2],hi[k][3]}
    o[d0]=__builtin_amdgcn_mfma_f32_32x32x16_bf16(pa0,PK(0),o[d0],0,0,0);
    o[d0]=__builtin_amdgcn_mfma_f32_32x32x16_bf16(pa1,PK(1),o[d0],0,0,0);
    o[d0]=__builtin_amdgcn_mfma_f32_32x32x16_bf16(pa2,PK(2),o[d0],0,0,0);
    o[d0]=__builtin_amdgcn_mfma_f32_32x32x16_bf16(pa3,PK(3),o[d0],0,0,0);
    #undef PK
  }
}

#ifndef ATTN_STORE16
#define ATTN_STORE16(p,v) (*(u32x4*)(p)=(v))
#endif
template<int THRL> __device__ __forceinline__ void attn_unit(int b,int h,int qb,const bf16*Q,const bf16*__restrict__ K,const bf16*__restrict__ V,bf16*O,const float*__restrict__ LFrow,char*shm){
  const int tid=threadIdx.x,lane=tid&63,r32=lane&31,hi=lane>>5; const int wid=__builtin_amdgcn_readfirstlane(tid>>6);
  const long rowbase=(long)b*SEQ; const int q0=qb*QB;
  const bf16*Qw=Q+(rowbase+q0+wid*QBLK)*DM+h*D;
  const bf16*Kh=K+rowbase*DM+h*D,*Vh=V+rowbase*DM+h*D;
  const lds_cptr shm3=(lds_cptr)shm;
  const unsigned lds0=(unsigned)(uintptr_t)shm;
  float*wsf=(float*)(shm+LDS_WS)+wid*64;
  const bf16*ksrc=Kh+(long)lane*DM+wid*8;
  const bf16*vsrc=Vh+(long)(16*(wid&3)+(lane>>2))*DM+(wid>>2)*32+(lane&3)*8;
  const unsigned kdst=lds0+LDS_K+wid*1024, vdst=lds0+LDS_V+wid*1024;
  #define DMA_K(t,slot) glds16(ksrc+(long)(t)*KVBLK*DM,(unsigned)__builtin_amdgcn_readfirstlane(kdst+(slot)))
  #define DMA_V(t,slot) glds16(vsrc+(long)(t)*KVBLK*DM,(unsigned)__builtin_amdgcn_readfirstlane(vdst+(slot)))
  const int vb0=(int)(lds0+LDS_V)+((lane>>4)&1)*32+(lane&3)*8+(4*hi+((lane&15)>>2))*64;
  const char*Kbase=shm+LDS_K; bf16x8 kf[8];
  const lds_cptr kp0=shm3+LDS_K+hi*1024+r32*16; const lds_cptr vp0=shm3+LDS_V+((lane>>4)&1)*32+(lane&3)*8+(4*hi+((lane&15)>>2))*64;
  const int NT=(q0+QB)/KVBLK;
  typedef __attribute__((address_space(3))) float lds_f32; typedef __attribute__((address_space(3))) f32x4v lds_f32x4;
  lds_f32* const csl=(lds_f32*)(shm3+LDS_CS);
  { const int ncs=q0+QB, i0=tid*8; f32x4v ca={0.f,0.f,0.f,0.f},cb={0.f,0.f,0.f,0.f};
    if(i0<ncs){ca=*(const f32x4v*)(LFrow+i0);cb=*(const f32x4v*)(LFrow+i0+4);}
    ca.y+=ca.x;ca.z+=ca.y;ca.w+=ca.z;cb.x+=ca.w;cb.y+=cb.x;cb.z+=cb.y;cb.w+=cb.z;
    const float tot=cb.w; float inc=tot;
    _Pragma("unroll") for(int o_=1;o_<64;o_<<=1){const float v_=__shfl_up(inc,o_);if(lane>=o_)inc+=v_;}
    if(lane==63)csl[SEQ+wid]=inc;
    asm volatile("s_waitcnt vmcnt(0) lgkmcnt(0)\n\ts_barrier":::"memory");
    float base_=inc-tot;
    _Pragma("unroll") for(int w_=0;w_<NW;++w_){const float t_=csl[SEQ+w_];if(w_<wid)base_+=t_;}
    if(i0<ncs){*(lds_f32x4*)(csl+i0)=ca+base_;*(lds_f32x4*)(csl+i0+4)=cb+base_;}
    asm volatile("s_waitcnt vmcnt(0) lgkmcnt(0)\n\ts_barrier":::"memory"); }
  const float cq=csl[q0+wid*QBLK+r32];
  const lds_cptr csb=shm3+LDS_CS+hi*16;
  #define CINIT(C0,C1,t) do{ _Pragma("unroll") for(int g_=0;g_<4;++g_){ const f32x4v a_=*(const lds_f32x4*)(csb+(t)*256+g_*32), b_=*(const lds_f32x4*)(csb+(t)*256+128+g_*32); \
      C0[4*g_]=cqm-a_.x;C0[4*g_+1]=cqm-a_.y;C0[4*g_+2]=cqm-a_.z;C0[4*g_+3]=cqm-a_.w; C1[4*g_]=cqm-b_.x;C1[4*g_+1]=cqm-b_.y;C1[4*g_+2]=cqm-b_.z;C1[4*g_+3]=cqm-b_.w; } }while(0)
  DMA_K(0,0);DMA_V(0,0);DMA_K(1,SLOTB);
  bf16x8 qr[4];
  #pragma unroll
  for(int d0=0;d0<4;++d0)qr[d0]=*reinterpret_cast<const bf16x8*>(&Qw[(long)r32*DM+d0*16+hi*8]);
  float mhat=0.f,l_reg=0.f,cqm=cq;f32x16 o[2];o[0]=f32x16{};o[1]=f32x16{};
  const int qrel=wid*QBLK+r32;
  #define CMASK(P0,P1,t) do{int jb_=(t)-(NT-4); if(jb_>=0)cmask(P0,P1,jb_,qrel,hi);}while(0)
  bool resc=false;
  #define START(P0,P1) do{ const float rm=rowmax(P0,P1); resc=false; \
    { const float dl=rm; mhat=fadd_s(mhat,dl); \
      _Pragma("unroll") for(int r=0;r<16;++r){P0[r]=fsub_s(P0[r],dl);P1[r]=fsub_s(P1[r],dl);} \
      cqm=cq-mhat; } \
    _Pragma("unroll") for(int r=0;r<16;++r)P0[r]=__builtin_amdgcn_exp2f(P0[r]); }while(0)
  #define RESC() do{ if(resc){ asm volatile("s_waitcnt lgkmcnt(0)":::"memory"); \
      _Pragma("unroll") for(int d_=0;d_<2;++d_) _Pragma("unroll") for(int r=0;r<16;++r)o[d_][r]*=wsf[crow(r,hi)]; } }while(0)
  f32x16 pA0,pA1,pB0,pB1;
  int sl_prev=0,sl_cur=0,sl_next=SLOTB;
  #define ROT() do{sl_prev=sl_cur;sl_cur=sl_next;sl_next=(sl_next==(NSLOT-1)*SLOTB)?0:sl_next+SLOTB;}while(0)
  DMA_K(2,2*SLOTB);
  WAIT_BAR(3);
  { f32x16 ci0,ci1; CINIT(ci0,ci1,0); qkt(pA0,pA1,Kbase,qr,ci0,ci1,r32,hi); } asm volatile("s_nop 15\n\ts_nop 7":"+v"(pA0),"+v"(pA1));CMASK(pA0,pA1,0);
  START(pA0,pA1);
  _Pragma("unroll") for(int r=0;r<16;++r)pA1[r]=__builtin_amdgcn_exp2f(pA1[r]);
  WAIT_BAR(0);
  DMA_K(3,0);DMA_V(1,SLOTB);
  ROT();
  kload8(kf,kp0+sl_cur);
  WAIT_BAR(2);
  s16x4 vlo[8],vhi[8]; u32x4 pw0,pw1,pw2,pw3;
  #define PKW(P,B) cvtpk_s(P[B],P[B+1])
  #define PAF(k) __builtin_bit_cast(bf16x8,pw##k)
  #define VFR(i) (bf16x8){vlo[i][0],vlo[i][1],vlo[i][2],vlo[i][3],vhi[i][0],vhi[i][1],vhi[i][2],vhi[i][3]}
  #define PIN(x) asm volatile("":"+v"(x))
  #define MX3(a,b,c) __builtin_fmaxf(__builtin_fmaxf((a),(b)),(c))
  #define GAPA(MF,A0,A1,A2,A3,W0,W1,PW) do{ MF; sacc+=A0; sacc+=A1; sacc+=A2; sacc+=A3; PIN(sacc); W0; W1; PIN(PW); SBAR(); }while(0)
  #define EX(v) __builtin_amdgcn_exp2f(v)
  #define GAPB(MF,X,B) do{ MF; X[B]=EX(X[B]); X[B+1]=EX(X[B+1]); X[B+2]=EX(X[B+2]); X[B+3]=EX(X[B+3]); PIN(X); SBAR(); }while(0)
  #define VRD(i) do{ vlo[i]=vtr(vp_+(((i)>>2)*4096+((i)&3)*1024)); vhi[i]=vtr(vp_+(((i)>>2)*4096+((i)&3)*1024+512)); }while(0)
  #define KRD(G,j) do{ if(G){ kload2(kf,kp0+sl_next,j); SBAR(); } }while(0)
  #define STEP(C0,C1,P0,P1,t,GK,GV,GL) do{ SBAR(); \
    CINIT(C0,C1,t); SBAR(); \
    const lds_cptr vp_=vp0+sl_prev; \
    VRD(0); SBAR(); float sacc=(P0[0]+P0[1]); \
    GAPA(C0=__builtin_amdgcn_mfma_f32_32x32x16_bf16(kf[0],qr[0],C0,0,0,0), P0[2],P0[3],P0[4],P0[5],     pw0[0]=PKW(P0,0), pw0[1]=PKW(P0,2), pw0); \
    VRD(4); SBAR(); GAPA(C1=__builtin_amdgcn_mfma_f32_32x32x16_bf16(kf[1],qr[0],C1,0,0,0), P0[6],P0[7],P0[8],P0[9],     pw0[2]=PKW(P0,4), pw0[3]=PKW(P0,6), pw0); \
    VRD(1); SBAR(); GAPA(C0=__builtin_amdgcn_mfma_f32_32x32x16_bf16(kf[2],qr[1],C0,0,0,0),   P0[10],P0[11],P0[12],P0[13], pw1[0]=PKW(P0,8), pw1[1]=PKW(P0,10), pw1); \
    VRD(5); SBAR(); GAPA(C1=__builtin_amdgcn_mfma_f32_32x32x16_bf16(kf[3],qr[1],C1,0,0,0),   P0[14],P0[15],P1[0],P1[1],   pw1[2]=PKW(P0,12),pw1[3]=PKW(P0,14), pw1); \
    VRD(2); SBAR(); GAPA(C0=__builtin_amdgcn_mfma_f32_32x32x16_bf16(kf[4],qr[2],C0,0,0,0),   P1[2],P1[3],P1[4],P1[5],     pw2[0]=PKW(P1,0), pw2[1]=PKW(P1,2), pw2); \
    VRD(6); SBAR(); GAPA(C1=__builtin_amdgcn_mfma_f32_32x32x16_bf16(kf[5],qr[2],C1,0,0,0),   P1[6],P1[7],P1[8],P1[9],     pw2[2]=PKW(P1,4), pw2[3]=PKW(P1,6), pw2); \
    VRD(3); SBAR(); GAPA(C0=__builtin_amdgcn_mfma_f32_32x32x16_bf16(kf[6],qr[3],C0,0,0,0),   P1[10],P1[11],P1[12],P1[13], pw3[0]=PKW(P1,8), pw3[1]=PKW(P1,10), pw3); \
    VRD(7); SBAR(); GAPA(C1=__builtin_amdgcn_mfma_f32_32x32x16_bf16(kf[7],qr[3],C1,0,0,0),   P1[14],P1[15],0.f,0.f,       pw3[2]=PKW(P1,12),pw3[3]=PKW(P1,14), pw3); \
    l_reg+=sacc; \
    if(GK){DMA_K((t)+3,sl_cur);} if(GV){DMA_V((t)+1,sl_next);} \
    CMASK(C0,C1,t); \
    { float a=MX3(C0[0],C0[1],C1[0]),b=MX3(C0[2],C0[3],C1[1]); a=MX3(a,C1[2],C1[3]); \
      _Pragma("unroll") for(int r=4;r<16;r+=4){a=MX3(a,C0[r],C0[r+1]);b=MX3(b,C0[r+2],C0[r+3]);a=MX3(a,C1[r],C1[r+1]);b=MX3(b,C1[r+2],C1[r+3]);} \
      float rm=__builtin_fmaxf(a,b); { auto rr=__builtin_amdgcn_permlane32_swap(__float_as_uint(rm),__float_as_uint(rm),false,false); rm=__builtin_fmaxf(__uint_as_float(rr[0]),__uint_as_float(rr[1])); } \
      resc=false; \
      if(__builtin_expect(__any(rm>(float)THRL),0)){ const float dl=__builtin_fmaxf(rm,0.f); mhat+=dl; \
        _Pragma("unroll") for(int r=0;r<16;++r){C0[r]-=dl;C1[r]-=dl;} \
        cqm=cq-mhat; \
        const float f=__builtin_amdgcn_exp2f(-dl); l_reg*=f; if(hi==0)wsf[r32]=f; resc=true; } } \
    SBAR(); \
    GAPB(o[0]=__builtin_amdgcn_mfma_f32_32x32x16_bf16(PAF(0),VFR(0),o[0],0,0,0), C0,0); \
    GAPB(o[1]=__builtin_amdgcn_mfma_f32_32x32x16_bf16(PAF(0),VFR(4),o[1],0,0,0), C0,4); \
    KRD(GL,0); GAPB(o[0]=__builtin_amdgcn_mfma_f32_32x32x16_bf16(PAF(1),VFR(1),o[0],0,0,0), C0,8); \
    KRD(GL,1); GAPB(o[1]=__builtin_amdgcn_mfma_f32_32x32x16_bf16(PAF(1),VFR(5),o[1],0,0,0), C0,12); \
    KRD(GL,2); GAPB(o[0]=__builtin_amdgcn_mfma_f32_32x32x16_bf16(PAF(2),VFR(2),o[0],0,0,0), C1,0); \
    KRD(GL,3); GAPB(o[1]=__builtin_amdgcn_mfma_f32_32x32x16_bf16(PAF(2),VFR(6),o[1],0,0,0), C1,4); \
    GAPB(o[0]=__builtin_amdgcn_mfma_f32_32x32x16_bf16(PAF(3),VFR(3),o[0],0,0,0), C1,8); \
    GAPB(o[1]=__builtin_amdgcn_mfma_f32_32x32x16_bf16(PAF(3),VFR(7),o[1],0,0,0), C1,12); \
    }while(0)
  int t=1;
  #undef CMASK
  #define CMASK(P0,P1,t) do{}while(0)
  for(;t+5<NT;t+=2){
    STEP(pB0,pB1,pA0,pA1,t,true,true,true);     WAIT_BAR(2); RESC(); ROT();
    STEP(pA0,pA1,pB0,pB1,t+1,true,true,true);   WAIT_BAR(2); RESC(); ROT();
  }
  #undef CMASK
  #define CMASK(P0,P1,t) do{int jb_=(t)-(NT-4); if(jb_>=0)cmask(P0,P1,jb_,qrel,hi);}while(0)
  #define ENDW(tt) do{ if((tt)+3<NT){WAIT_BAR(2);} else if((tt)+2<NT){WAIT_BAR(1);} else {WAIT_BAR(0);} }while(0)
  for(;t+1<NT;t+=2){
    STEP(pB0,pB1,pA0,pA1,t,(t+3<NT),(t+1<NT),(t+1<NT));       ENDW(t);   RESC(); ROT();
    STEP(pA0,pA1,pB0,pB1,t+1,(t+4<NT),(t+2<NT),(t+2<NT));     ENDW(t+1); RESC(); ROT();
  }
  STEP(pB0,pB1,pA0,pA1,NT-1,false,false,false); RESC();
  { float sacc=pB0[0]+pB0[1]; _Pragma("unroll") for(int r=2;r<16;++r)sacc+=pB0[r]; _Pragma("unroll") for(int r=0;r<16;++r)sacc+=pB1[r]; l_reg+=sacc;
    pw0=(u32x4){PKW(pB0,0),PKW(pB0,2),PKW(pB0,4),PKW(pB0,6)};pw1=(u32x4){PKW(pB0,8),PKW(pB0,10),PKW(pB0,12),PKW(pB0,14)};pw2=(u32x4){PKW(pB1,0),PKW(pB1,2),PKW(pB1,4),PKW(pB1,6)};pw3=(u32x4){PKW(pB1,8),PKW(pB1,10),PKW(pB1,12),PKW(pB1,14)};
    SBAR(); pv(o,vb0+sl_cur,PAF(0),PAF(1),PAF(2),PAF(3)); }
  #undef PKW
  #undef PAF
  #undef VFR
  #undef PIN
  #undef MX3
  #undef GAPA
  #undef GAPB
  #undef EX
  #undef VRD
  #undef KRD
  #undef STEP
  #undef ENDW
  {auto rr=__builtin_amdgcn_permlane32_swap(__float_as_uint(l_reg),__float_as_uint(l_reg),false,false);l_reg=__uint_as_float(rr[0])+__uint_as_float(rr[1]);}
  if(hi==0)wsf[32+r32]=l_reg;asm volatile("s_waitcnt lgkmcnt(0)":::"memory");
  float rli[16];
  #pragma unroll
  for(int r=0;r<16;++r)rli[r]=__builtin_amdgcn_rcpf(wsf[32+crow(r,hi)]);
  bf16*Ow=O+(rowbase+q0+wid*QBLK)*DMO+h*D;
  { bf16*stg=(bf16*)(shm+LDS_OST)+wid*2048;
    #pragma unroll
    for(int r=0;r<16;++r){const int orow=crow(r,hi);
      #pragma unroll
      for(int d0=0;d0<2;++d0)stg[orow*64+d0*32+r32]=__float2bfloat16(o[d0][r]*rli[r]);}
    asm volatile("s_waitcnt lgkmcnt(0)":::"memory");
    #pragma unroll
    for(int i=0;i<4;++i){const int row=i*8+(lane>>3),ch=lane&7; const u32x4 v=*(const u32x4*)(stg+row*64+ch*8); ATTN_STORE16(Ow+(long)row*DMO+ch*8,v);} }
  asm volatile("s_waitcnt lgkmcnt(0)\n\ts_barrier":::"memory");
  #undef DMA_K
  #undef DMA_V
  #undef CMASK
  #undef START
  #undef RESC
  #undef ROT
  #undef CINIT
}
constexpr int ATTN_LDS_BYTES=LDS_BYTES;
struct AttnTensors { const bf16* Q; const bf16* K; const bf16* V; bf16* O; const float* LF; };
struct AttnUnit { int bh; int qb; };
struct StaticOrder {
  int vcu, G;
  __device__ __forceinline__ StaticOrder(int grid,int vcu_):vcu(vcu_),G(grid){}
  __device__ __forceinline__ bool next(int i,AttnUnit&u)const{
    if(G==256){ if(i>=2)return false; const int s=vcu&7; u.bh=vcu>>3; u.qb=(i==0)?15-s:s; return true; }
    const int idx=i*G+vcu; if(idx>=BATCH*NHEAD*NQB)return false; u.qb=NQB-1-idx/(BATCH*NHEAD); u.bh=idx%(BATCH*NHEAD); return true; }
  __device__ __forceinline__ void a_ready(const AttnUnit&)const{}
  __device__ __forceinline__ void done(const AttnUnit&)const{}
};
template<class Sched,int THRL=8> __device__ __forceinline__ void attn_phase(char*lds,const AttnTensors&T,const Sched&S){
  AttnUnit u;
  for(int i=0;S.next(i,u);++i){ S.a_ready(u); attn_unit<THRL>(u.bh/NHEAD,u.bh%NHEAD,u.qb,T.Q,T.K,T.V,T.O,T.LF+(size_t)u.bh*SEQ,lds); S.done(u); }
}
#undef SBAR
#undef WAIT_BAR
}
#define GAS __attribute__((address_space(1)))
#define LAS __attribute__((address_space(3)))
typedef unsigned short bf16;
typedef unsigned v4u __attribute__((ext_vector_type(4)));
typedef float f32x4 __attribute__((ext_vector_type(4)));
typedef short bf16x8 __attribute__((ext_vector_type(8)));
typedef GAS unsigned gu32;
typedef GAS unsigned long long gu64;
#define RLX_AGENT __ATOMIC_RELAXED, __HIP_MEMORY_SCOPE_AGENT
#define LDS_WAIT() asm volatile("s_waitcnt lgkmcnt(0)" ::: "memory")
#define VM_WAIT() asm volatile("s_waitcnt vmcnt(0)" ::: "memory")
__device__ __forceinline__ unsigned long long rt() { return __builtin_amdgcn_s_memrealtime(); }
__device__ __forceinline__ unsigned f2bf(float f) { unsigned u = __builtin_bit_cast(unsigned, f); return (u + 0x7fffu + ((u >> 16) & 1u)) >> 16; }
__device__ __forceinline__ unsigned pk2(float lo, float hi) { return f2bf(lo) | (f2bf(hi) << 16); }

#define XB_TMO      128
#define XB_XCNT(j)  (256  + 64 * (j))
#define XB_XSUB(j)  (1280 + 64 * (j))
#define XB_XGEN(j)  (2304 + 64 * (j))
#define XB_TOP      3328
#define XB_TOPGEN   3392
#define XCD_BAR_WORDS 3456
#define XB_SPIN_CAP (1u << 18)

__device__ __forceinline__ unsigned xb_ld(unsigned* p)              { return __hip_atomic_load(p, __ATOMIC_RELAXED, __HIP_MEMORY_SCOPE_AGENT); }
__device__ __forceinline__ unsigned xb_add(unsigned* p, unsigned v) { return __hip_atomic_fetch_add(p, v, __ATOMIC_RELAXED, __HIP_MEMORY_SCOPE_AGENT); }
__device__ __forceinline__ unsigned xb_xcc_id() { return (unsigned)__builtin_amdgcn_s_getreg((3 << 11) | 20) & 0xFu; }
#define XB_SPIN(cond, bar) do { unsigned _sp = 0; while (cond) { __builtin_amdgcn_s_sleep(1); \
    if ((++_sp & 255u) == 0u) { if (xb_ld(&(bar)[XB_TMO])) break; if (_sp > XB_SPIN_CAP) { atomicAdd(&(bar)[XB_TMO], 1u); break; } } } } while (0)

struct XcdBarrier {
    unsigned* bar; unsigned x;
    volatile LAS unsigned* st;
};

__device__ __forceinline__ XcdBarrier xcd_barrier_post(unsigned* bar, volatile LAS unsigned* st) {
    XcdBarrier b; b.bar = bar; b.x = xb_xcc_id(); b.st = st;
    if (threadIdx.x == 0) (void)xb_add(&bar[XB_XCNT(b.x)], 1u);
    return b;
}
__device__ __forceinline__ void xcd_barrier_complete(unsigned* bar, unsigned x, unsigned& nloc, unsigned& nx) {
    const unsigned G = gridDim.x * gridDim.y * gridDim.z;
    unsigned sum, cnt, mine, sp = 0u;
    for (;;) {
        sum = 0u; cnt = 0u; mine = 0u;
#pragma unroll
        for (unsigned j = 0; j < 16; ++j) { const unsigned c = xb_ld(&bar[XB_XCNT(j)]); sum += c; cnt += (c > 0u) ? 1u : 0u; mine = (j == x) ? c : mine; }
        if (sum == G) break;
        __builtin_amdgcn_s_sleep(1);
        if ((++sp & 255u) == 0u) { if (xb_ld(&bar[XB_TMO])) break; if (sp > XB_SPIN_CAP) { atomicAdd(&bar[XB_TMO], 1u); break; } }
    }
    nloc = mine > 0u ? mine : 1u; nx = cnt > 0u ? cnt : 1u;
}

__device__ __forceinline__ void xcd_barrier(const XcdBarrier& b) {
    asm volatile("s_waitcnt vmcnt(0)" ::: "memory");
    __syncthreads();
    if (threadIdx.x == 0) {
        unsigned* bar = b.bar;
        __builtin_amdgcn_s_waitcnt(0);
        unsigned nloc = b.st[0], nx = b.st[1];
        if (nloc == 0u) { xcd_barrier_complete(bar, b.x, nloc, nx); b.st[0] = nloc; b.st[1] = nx; }
        const unsigned old = xb_add(&bar[XB_XSUB(b.x)], 1u);
        const unsigned gen = old / nloc;
        if (old + 1u == (gen + 1u) * nloc) {
            __builtin_amdgcn_fence(__ATOMIC_RELEASE, "agent");
            asm volatile("s_waitcnt vmcnt(0)" ::: "memory");
            const unsigned og = xb_add(&bar[XB_TOP], 1u);
            const unsigned tg = og / nx;
            if (og + 1u == (tg + 1u) * nx) xb_add(&bar[XB_TOPGEN], 1u);
            else XB_SPIN(xb_ld(&bar[XB_TOPGEN]) == tg, bar);
            __builtin_amdgcn_fence(__ATOMIC_ACQUIRE, "agent");
            xb_add(&bar[XB_XGEN(b.x)], 1u);
            asm volatile("s_waitcnt vmcnt(0)" ::: "memory");
        } else {
            XB_SPIN(xb_ld(&bar[XB_XGEN(b.x)]) == gen, bar);
            __builtin_amdgcn_fence(__ATOMIC_ACQUIRE, "agent");
            asm volatile("s_waitcnt vmcnt(0)" ::: "memory");
        }
    }
    __syncthreads();
}

constexpr int NWAVES = 8;
constexpr int BATCH = 4, SEQ = 4096, D = 1024, M = BATCH * SEQ, NH = 8, HD = 64, AW = 512, PLE = 256;
constexpr int NIN = 5120, INTOT = 5128, NKEYS = 128, NEXP = 16384, NS = 2048;
constexpr float EPS = 1e-6f, LOG2E = 1.4426950408889634f, C2 = 0.125f * LOG2E;
constexpr int NPHASE = 9;

constexpr size_t MiB = 1u << 20;
constexpr size_t WS_CTL = 0, CTL_ZERO_BYTES = 64 * 1024;
constexpr size_t WS_RSTD1 = 1 * MiB, WS_RSTD3 = WS_RSTD1 + 65536, WS_LF = WS_RSTD3 + 65536, WS_CS = WS_LF + 524288, WS_SS2 = WS_CS + 524288, WS_WPP = WS_SS2 + 1048576;
static_assert(WS_WPP + 524288 <= 4 * MiB, "small region");
constexpr size_t WS_WIN = 4 * MiB, WS_WBR = 14 * MiB, WS_WOUT = 16 * MiB, WS_WS = 18 * MiB, WS_WPG = 22 * MiB, WS_PB = 24 * MiB;
constexpr size_t WS_UB = 32 * MiB, WS_VB = 64 * MiB;
constexpr size_t WS_A = 96 * MiB;
constexpr size_t WS_PP = 128 * MiB;
constexpr size_t WS_Q = 160 * MiB, WS_K = 176 * MiB, WS_V = 192 * MiB, WS_GB = 208 * MiB, WS_Z = 224 * MiB;
constexpr size_t WS_MERGED = 160 * MiB, WS_XB2 = 192 * MiB, WS_IDS = 224 * MiB, WS_GATES = 232 * MiB;
constexpr size_t WS_END = 256 * MiB;
constexpr size_t WS_TGC = 32 * MiB, WS_TXC = 64 * MiB, WS_SC = 32 * MiB;
constexpr int CW_BAR = 1024;

constexpr int RING_OFF = 0, RING_BYTES = 135168;
constexpr int LDSCTL_OFF = RING_BYTES, MISC_OFF = LDSCTL_OFF + 320;
constexpr int LDS_BYTES = RING_BYTES + 1024;
static_assert(attn_body::ATTN_LDS_BYTES <= RING_BYTES && pg8::STAGE_BYTES <= RING_BYTES && 128 * pg8::EpiTopK::RS * 4 <= RING_BYTES, "LDS map");

typedef unsigned u32x4 __attribute__((ext_vector_type(4)));
typedef unsigned u32x2 __attribute__((ext_vector_type(2)));
__device__ __forceinline__ float bf2f(bf16 v) { return __uint_as_float((unsigned)v << 16); }
__device__ __forceinline__ float wave_sum(float v) {
#pragma unroll
    for (int o = 1; o < 64; o <<= 1) v += __shfl_xor(v, o);
    return v;
}
__device__ __forceinline__ float sigmoidf_(float v) { return 1.0f / (1.0f + __expf(-v)); }
__host__ __device__ __forceinline__ int src_in(int n) {
    const int pn = n >> 8, l = n & 255;
    if (pn < 6) return n;
    if (pn < 8) return 1544 + (n - 1536);
    if (pn < 12) { const int j = pn - 8; return (l < 128) ? 2056 + 128 * j + l : 2568 + 128 * j + (l - 128); }
    if (pn < 16) return 3080 + (n - 3072);
    return 4104 + (n - 4096);
}

struct Args { const float* in[18]; float* out; unsigned char* ws; int ph_lo, ph_hi, li, pad; };
struct Ctx {
    LAS unsigned char* lds; int tid, lane, wave, vcu, G;
};

__device__ __forceinline__ void tr_item(const float* __restrict__ W, int ldw, int k0, int scol0, const float* __restrict__ g, bf16* WT, int ldt, int drow0, int dk0, LAS float* scr, int lane) {
#pragma unroll 8
    for (int i = 0; i < 32; ++i) { const int kk = 2 * i + (lane >> 5); float v = W[(size_t)(k0 + kk) * ldw + scol0 + (lane & 31)]; if (g) v *= g[k0 + kk]; scr[kk * 33 + (lane & 31)] = v; }
    LDS_WAIT(); asm volatile("" ::: "memory");
    const int c = lane & 7;
#pragma unroll
    for (int j = 0; j < 4; ++j) { const int n = (lane >> 3) + 8 * j; const LAS float* s = scr + (8 * c) * 33 + n;
        v4u o; o.x = pk2(s[0 * 33], s[1 * 33]); o.y = pk2(s[2 * 33], s[3 * 33]); o.z = pk2(s[4 * 33], s[5 * 33]); o.w = pk2(s[6 * 33], s[7 * 33]);
        *(GAS v4u*)(WT + (size_t)(drow0 + n) * ldt + dk0 + 8 * c) = o; }
    LDS_WAIT(); asm volatile("" ::: "memory");
}
__device__ __forceinline__ void p0_prologue(const Ctx& F, const Args& a) {
    unsigned char* ws = a.ws;
    const float *x = a.in[0], *p = a.in[1], *g_mix = a.in[2], *w_in = a.in[3], *b_f = a.in[4], *w_branch = a.in[6], *w_out = a.in[7], *g_ffn = a.in[8], *w_peer_q = a.in[9],
                *pk1 = a.in[10], *pk2_ = a.in[11], *peer_u = a.in[12], *peer_v = a.in[13], *g_ple = a.in[14], *w_ple_gate = a.in[15], *w_ple_proj = a.in[16];
    bf16 *WIN = (bf16*)(ws + WS_WIN), *WBR = (bf16*)(ws + WS_WBR), *WOUT = (bf16*)(ws + WS_WOUT), *WST = (bf16*)(ws + WS_WS), *WPG = (bf16*)(ws + WS_WPG), *WPP = (bf16*)(ws + WS_WPP);
    bf16 *PB = (bf16*)(ws + WS_PB), *UB = (bf16*)(ws + WS_UB), *VB = (bf16*)(ws + WS_VB), *XB = (bf16*)(ws + WS_A);
    float *RSTD1 = (float*)(ws + WS_RSTD1), *LF = (float*)(ws + WS_LF);
    const int gw = F.vcu * NWAVES + F.wave, NGW = F.G * NWAVES, gt = F.vcu * 512 + F.tid, NGT = F.G * 512;
    {
        LAS float* KH = (LAS float*)(F.lds + RING_OFF); LAS float* WQ = KH + 128 * 129;
        for (int item = F.vcu; item < 512; item += F.G) {
            const int hh = item >> 5, head = hh >> 1, half = hh & 1, d0 = (item & 31) * 32;
            const float* kh = (half ? pk2_ : pk1) + (size_t)head * 128 * 128;
#pragma unroll 4
            for (int i = 0; i < 32; ++i) { const int idx = i * 512 + F.tid; KH[(idx >> 7) * 129 + (idx & 127)] = kh[idx]; }
#pragma unroll
            for (int i = 0; i < 8; ++i) { const int idx = i * 512 + F.tid; WQ[idx] = w_peer_q[(size_t)(d0 + (idx >> 7)) * NS + head * 256 + half * 128 + (idx & 127)]; }
            __syncthreads();
            const int key = F.tid & 127, dg = F.tid >> 7;
            float acc[8];
#pragma unroll
            for (int i = 0; i < 8; ++i) acc[i] = 0.f;
            for (int e = 0; e < 128; e += 4) {
                const float k0 = KH[key * 129 + e], k1 = KH[key * 129 + e + 1], k2 = KH[key * 129 + e + 2], k3 = KH[key * 129 + e + 3];
#pragma unroll
                for (int i = 0; i < 8; ++i) { const f32x4 w = *(const LAS f32x4*)(WQ + (dg * 8 + i) * 128 + e); acc[i] += (k0 * w[0] + k1 * w[1]) + (k2 * w[2] + k3 * w[3]); }
            }
            const int dd = d0 + dg * 8;
            v4u o; o.x = pk2(acc[0] * g_ffn[dd], acc[1] * g_ffn[dd + 1]); o.y = pk2(acc[2] * g_ffn[dd + 2], acc[3] * g_ffn[dd + 3]); o.z = pk2(acc[4] * g_ffn[dd + 4], acc[5] * g_ffn[dd + 5]); o.w = pk2(acc[6] * g_ffn[dd + 6], acc[7] * g_ffn[dd + 7]);
            *(GAS v4u*)(WST + (size_t)(head * 256 + half * 128 + key) * D + dd) = o;
            __syncthreads();
        }
    }
    {
        LAS float* scr = (LAS float*)(F.lds + RING_OFF + F.wave * 16384);
        constexpr int I_IN = 16 * 160, I_BR = 8 * 32, I_SQ = 16 * 32, I_PP = 4 * 32, NITEMS = I_IN + 2 * I_BR + 2 * I_SQ + I_PP;
        for (int it = gw; it < NITEMS; it += NGW) {
            int r = it;
            if (r < I_IN) { const int kb = r / 160, nb = r % 160; tr_item(w_in, INTOT, 64 * kb, src_in(32 * nb), g_mix, WIN, D, 32 * nb, 64 * kb, scr, F.lane); continue; } r -= I_IN;
            if (r < 2 * I_BR) { const int br = r / I_BR, q = r % I_BR, kb = q / 32, nb = q % 32; tr_item(w_branch + (size_t)br * AW * D, D, 64 * kb, 32 * nb, nullptr, WBR, D, 32 * nb, br * AW + 64 * kb, scr, F.lane); continue; } r -= 2 * I_BR;
            if (r < I_SQ) { const int kb = r / 32, nb = r % 32; tr_item(w_out, D, 64 * kb, 32 * nb, nullptr, WOUT, D, 32 * nb, 64 * kb, scr, F.lane); continue; } r -= I_SQ;
            if (r < I_SQ) { const int kb = r / 32, nb = r % 32; tr_item(w_ple_gate, D, 64 * kb, 32 * nb, g_ple, WPG, D, 32 * nb, 64 * kb, scr, F.lane); continue; } r -= I_SQ;
            { const int kb = r / 32, nb = r % 32; tr_item(w_ple_proj, D, 64 * kb, 32 * nb, nullptr, WPP, PLE, 32 * nb, 64 * kb, scr, F.lane); }
        }
    }
    __syncthreads();
    {
        LAS float* WFL = (LAS float*)(F.lds + RING_OFF);
#pragma unroll 4
        for (int i = 0; i < 16; ++i) { const int idx = i * 512 + F.tid, k = idx >> 3, h = idx & 7; WFL[h * 1024 + k] = g_mix[k] * w_in[(size_t)k * INTOT + 1536 + h]; }
        __syncthreads();
        for (int row = gw; row < M; row += NGW) {
            const GAS f32x4* xr = (const GAS f32x4*)(x + (size_t)row * D);
            f32x4 v[4]; float ss = 0.f;
#pragma unroll
            for (int j = 0; j < 4; ++j) { v[j] = xr[F.lane + 64 * j]; ss += (v[j].x * v[j].x + v[j].y * v[j].y) + (v[j].z * v[j].z + v[j].w * v[j].w); }
            ss = wave_sum(ss);
            const float rstd = 1.0f / sqrtf(ss * (1.0f / D) + EPS);
            GAS u32x2* o = (GAS u32x2*)(XB + (size_t)row * D);
#pragma unroll
            for (int j = 0; j < 4; ++j) { u32x2 w; w.x = pk2(v[j].x, v[j].y); w.y = pk2(v[j].z, v[j].w); o[F.lane + 64 * j] = w; }
            if (F.lane == 0) RSTD1[row] = rstd;
            float f[8];
#pragma unroll
            for (int h = 0; h < 8; ++h) { float s = 0.f;
#pragma unroll
                for (int j = 0; j < 4; ++j) { const f32x4 w = *(const LAS f32x4*)(WFL + h * 1024 + 4 * (F.lane + 64 * j)); s += (v[j].x * w[0] + v[j].y * w[1]) + (v[j].z * w[2] + v[j].w * w[3]); }
                f[h] = s; }
            const int b = row / SEQ, t = row % SEQ;
#pragma unroll
            for (int h = 0; h < 8; ++h) {
                const float tot = wave_sum(f[h]) * rstd + b_f[h];
                const float ls = fminf(tot, 0.f) - log1pf(__expf(-fabsf(tot)));
                if (F.lane == 0) LF[(size_t)(b * NH + h) * SEQ + t] = ls * LOG2E;
            }
        }
    }
    {
        constexpr int NU = NEXP * D / 8, NP = M * PLE / 8;
        for (int i = gt; i < NU; i += NGT) { const int d = (i * 8) & (D - 1);
            const f32x4 a = ((const GAS f32x4*)peer_u)[2 * (size_t)i], b = ((const GAS f32x4*)peer_u)[2 * (size_t)i + 1], ga = *(const GAS f32x4*)(g_ffn + d), gb = *(const GAS f32x4*)(g_ffn + d + 4);
            v4u o; o.x = pk2(a.x * ga.x, a.y * ga.y); o.y = pk2(a.z * ga.z, a.w * ga.w); o.z = pk2(b.x * gb.x, b.y * gb.y); o.w = pk2(b.z * gb.z, b.w * gb.w); ((GAS v4u*)UB)[i] = o; }
        for (int i = gt; i < NU; i += NGT) { const f32x4 a = ((const GAS f32x4*)peer_v)[2 * (size_t)i], b = ((const GAS f32x4*)peer_v)[2 * (size_t)i + 1];
            v4u o; o.x = pk2(a.x, a.y); o.y = pk2(a.z, a.w); o.z = pk2(b.x, b.y); o.w = pk2(b.z, b.w); ((GAS v4u*)VB)[i] = o; }
        for (int i = gt; i < NP; i += NGT) { const f32x4 a = ((const GAS f32x4*)p)[2 * (size_t)i], b = ((const GAS f32x4*)p)[2 * (size_t)i + 1];
            v4u o; o.x = pk2(a.x, a.y); o.y = pk2(a.z, a.w); o.z = pk2(b.x, b.y); o.w = pk2(b.z, b.w); ((GAS v4u*)PB)[i] = o; }
    }
}
__device__ __forceinline__ void p2_conv(const Ctx& F, const bf16* GB, const bf16* Z, const float* cw, bf16* AC) {
    const int gt = F.vcu * 512 + F.tid, NGT = F.G * 512;
    for (int i = gt; i < M * AW / 8; i += NGT) {
        const int row = i >> 6, c = (i & 63) * 8, t = row & (SEQ - 1);
        const v4u z2 = *(const GAS v4u*)(Z + (size_t)row * AW + c), g = *(const GAS v4u*)(GB + (size_t)row * AW + c);
        v4u z1 = {0u, 0u, 0u, 0u}, z0 = {0u, 0u, 0u, 0u};
        if (t >= 1) z1 = *(const GAS v4u*)(Z + (size_t)(row - 1) * AW + c);
        if (t >= 2) z0 = *(const GAS v4u*)(Z + (size_t)(row - 2) * AW + c);
        float r[8];
#pragma unroll
        for (int e = 0; e < 4; ++e) {
            const float w0a = cw[c + 2 * e], w0b = cw[c + 2 * e + 1], w1a = cw[AW + c + 2 * e], w1b = cw[AW + c + 2 * e + 1], w2a = cw[2 * AW + c + 2 * e], w2b = cw[2 * AW + c + 2 * e + 1];
            r[2 * e] = __uint_as_float(g[e] << 16) * (w0a * __uint_as_float(z0[e] << 16) + w1a * __uint_as_float(z1[e] << 16) + w2a * __uint_as_float(z2[e] << 16));
            r[2 * e + 1] = __uint_as_float(g[e] & 0xffff0000u) * (w0b * __uint_as_float(z0[e] & 0xffff0000u) + w1b * __uint_as_float(z1[e] & 0xffff0000u) + w2b * __uint_as_float(z2[e] & 0xffff0000u));
        }
        v4u o; o.x = pk2(r[0], r[1]); o.y = pk2(r[2], r[3]); o.z = pk2(r[4], r[5]); o.w = pk2(r[6], r[7]);
        *(GAS v4u*)(AC + (size_t)row * D + AW + c) = o;
    }
}
typedef __bf16 bf16x2_t __attribute__((ext_vector_type(2)));
__device__ __forceinline__ float dot2bf(unsigned a, unsigned b, float c) { return __builtin_amdgcn_fdot2_f32_bf16(__builtin_bit_cast(bf16x2_t, a), __builtin_bit_cast(bf16x2_t, b), c, false); }
__device__ __forceinline__ void p6_peer(const Ctx& F, const bf16* XB1, const float* SS2, const int* IDS, const float* GATES, const bf16* UB, const bf16* VB, float* X, bf16* XB2, float* RSTD3) {
    const int gw = F.vcu * NWAVES + F.wave, NGW = F.G * NWAVES, lane = F.lane;
    const int kL = ((lane >> 5) & 1) * 8 + ((lane >> 4) & 1) * 4 + ((lane >> 3) & 1) * 2 + ((lane >> 2) & 1);
    for (int token = gw; token < M; token += NGW) {
        const int id0 = IDS[(size_t)token * 128 + lane], id1 = IDS[(size_t)token * 128 + 64 + lane];
        const float rstd = 1.0f / sqrtf(wave_sum(lane < 16 ? SS2[(size_t)token * 16 + lane] : 0.f) * (1.0f / D) + EPS);
        const v4u xa = *(const GAS v4u*)(XB1 + (size_t)token * D + 8 * lane), xb = *(const GAS v4u*)(XB1 + (size_t)token * D + 512 + 8 * lane);
        float out[16];
#pragma unroll
        for (int i = 0; i < 16; ++i) out[i] = 0.f;
        for (int h = 0; h < 8; ++h) {
            const int idr = h < 4 ? id0 : id1, lb = (h & 3) * 16;
            float d[16];
#pragma unroll
            for (int hf = 0; hf < 2; ++hf) {
                v4u ua[8], ub[8];
#pragma unroll
                for (int k = 0; k < 8; ++k) { const int id = __builtin_amdgcn_readlane(idr, lb + hf * 8 + k); const GAS v4u* up = (const GAS v4u*)(UB + (size_t)id * D); ua[k] = up[lane]; ub[k] = up[64 + lane]; }
#pragma unroll
                for (int k = 0; k < 8; ++k) { float s = 0.f;
#pragma unroll
                    for (int e = 0; e < 4; ++e) { s = dot2bf(xa[e], ua[k][e], s); s = dot2bf(xb[e], ub[k][e], s); }
                    d[hf * 8 + k] = s; }
            }
            float r8[8], r4[4], r2[2], r1;
#pragma unroll
            for (int i = 0; i < 8; ++i) { const float send = (lane & 32) ? d[i] : d[i + 8], keep = (lane & 32) ? d[i + 8] : d[i]; r8[i] = keep + __shfl_xor(send, 32); }
#pragma unroll
            for (int i = 0; i < 4; ++i) { const float send = (lane & 16) ? r8[i] : r8[i + 4], keep = (lane & 16) ? r8[i + 4] : r8[i]; r4[i] = keep + __shfl_xor(send, 16); }
#pragma unroll
            for (int i = 0; i < 2; ++i) { const float send = (lane & 8) ? r4[i] : r4[i + 2], keep = (lane & 8) ? r4[i + 2] : r4[i]; r2[i] = keep + __shfl_xor(send, 8); }
            { const float send = (lane & 4) ? r2[0] : r2[1], keep = (lane & 4) ? r2[1] : r2[0]; r1 = keep + __shfl_xor(send, 4); }
            r1 += __shfl_xor(r1, 2); r1 += __shfl_xor(r1, 1);
            const float av = r1 * rstd;
            const float w = GATES[(size_t)token * 128 + h * 16 + kL] * 0.5f * av * (1.0f + erff(av * 0.70710678118654752f));
#pragma unroll
            for (int hf = 0; hf < 2; ++hf) {
                v4u va[8], vb[8];
#pragma unroll
                for (int k = 0; k < 8; ++k) { const int id = __builtin_amdgcn_readlane(idr, lb + hf * 8 + k); const GAS v4u* vp = (const GAS v4u*)(VB + (size_t)id * D); va[k] = vp[lane]; vb[k] = vp[64 + lane]; }
#pragma unroll
                for (int k = 0; k < 8; ++k) { const int kk = hf * 8 + k; const float wk = __uint_as_float((unsigned)__builtin_amdgcn_readlane((int)__float_as_uint(w), ((kk >> 3) & 1) * 32 + ((kk >> 2) & 1) * 16 + ((kk >> 1) & 1) * 8 + (kk & 1) * 4));
#pragma unroll
                    for (int e = 0; e < 4; ++e) { out[2 * e] += wk * __uint_as_float(va[k][e] << 16); out[2 * e + 1] += wk * __uint_as_float(va[k][e] & 0xffff0000u);
                        out[8 + 2 * e] += wk * __uint_as_float(vb[k][e] << 16); out[8 + 2 * e + 1] += wk * __uint_as_float(vb[k][e] & 0xffff0000u); } }
            }
        }
        float* xr = X + (size_t)token * D; float s2 = 0.f;
        f32x4 x0 = *(GAS f32x4*)(xr + 8 * lane), x1 = *(GAS f32x4*)(xr + 8 * lane + 4), x2 = *(GAS f32x4*)(xr + 512 + 8 * lane), x3 = *(GAS f32x4*)(xr + 512 + 8 * lane + 4);
#pragma unroll
        for (int e = 0; e < 4; ++e) { x0[e] += out[e]; x1[e] += out[4 + e]; x2[e] += out[8 + e]; x3[e] += out[12 + e]; s2 += (x0[e] * x0[e] + x1[e] * x1[e]) + (x2[e] * x2[e] + x3[e] * x3[e]); }
        *(GAS f32x4*)(xr + 8 * lane) = x0; *(GAS f32x4*)(xr + 8 * lane + 4) = x1; *(GAS f32x4*)(xr + 512 + 8 * lane) = x2; *(GAS f32x4*)(xr + 512 + 8 * lane + 4) = x3;
        v4u w0, w1; w0.x = pk2(x0.x, x0.y); w0.y = pk2(x0.z, x0.w); w0.z = pk2(x1.x, x1.y); w0.w = pk2(x1.z, x1.w); w1.x = pk2(x2.x, x2.y); w1.y = pk2(x2.z, x2.w); w1.z = pk2(x3.x, x3.y); w1.w = pk2(x3.z, x3.w);
        *(GAS v4u*)(XB2 + (size_t)token * D + 8 * lane) = w0; *(GAS v4u*)(XB2 + (size_t)token * D + 512 + 8 * lane) = w1;
        s2 = wave_sum(s2);
        if (lane == 0) RSTD3[token] = 1.0f / sqrtf(s2 * (1.0f / D) + EPS);
    }
}
__device__ __forceinline__ void p8_final(const Ctx& F, float* X, const float* g) {
    const int gw = F.vcu * NWAVES + F.wave, NGW = F.G * NWAVES;
    for (int row = gw; row < M; row += NGW) {
        GAS f32x4* xr = (GAS f32x4*)(X + (size_t)row * D); f32x4 v[4]; float ss = 0.f;
#pragma unroll
        for (int j = 0; j < 4; ++j) { v[j] = xr[F.lane + 64 * j]; ss += (v[j].x * v[j].x + v[j].y * v[j].y) + (v[j].z * v[j].z + v[j].w * v[j].w); }
        ss = wave_sum(ss); const float rstd = 1.0f / sqrtf(ss * (1.0f / D) + EPS);
#pragma unroll
        for (int j = 0; j < 4; ++j) { const f32x4 gv = ((const GAS f32x4*)g)[F.lane + 64 * j]; xr[F.lane + 64 * j] = v[j] * rstd * gv; }
    }
}
struct OneUnit {
    pg8::Unit u;
    __device__ __forceinline__ bool next(int i, pg8::Unit& o) const { if (i != 0) return false; o = u; return true; }
    __device__ __forceinline__ void a_ready(const pg8::Unit&) const {}
    __device__ __forceinline__ void done(const pg8::Unit&) const {}
};

__global__ void __launch_bounds__(NWAVES * 64, 2) mk_fwd(Args args) {
    extern __shared__ __attribute__((aligned(16))) unsigned char lds[];
    Ctx F;
    F.lds = (LAS unsigned char*)lds;
    F.tid = threadIdx.x; F.lane = F.tid & 63; F.wave = __builtin_amdgcn_readfirstlane(F.tid >> 6);
    F.G = gridDim.x; { const int bx = blockIdx.x; F.vcu = (F.G % 8 == 0) ? (bx % 8) * (F.G / 8) + bx / 8 : bx; }
    volatile LAS unsigned* MISC = (volatile LAS unsigned*)(F.lds + MISC_OFF);
    unsigned char* ws = args.ws;
    gu32* ctl = (gu32*)(ws + WS_CTL);
    for (int u = F.tid; u < (LDS_BYTES - LDSCTL_OFF) / 4; u += NWAVES * 64) ((LAS unsigned*)(F.lds + LDSCTL_OFF))[u] = 0u;
    __syncthreads();
    const int lo = args.ph_lo, hi = args.ph_hi;
    const bool multi = (hi - lo) > 1;
    XcdBarrier bar; bar.bar = (unsigned*)(ctl + CW_BAR) + args.li * XCD_BAR_WORDS; bar.x = 0; bar.st = nullptr;
    if (multi) bar = xcd_barrier_post((unsigned*)(ctl + CW_BAR) + args.li * XCD_BAR_WORDS, MISC + 8);
#ifndef MK_CMASK
#define MK_CMASK 0x1ff
#endif
#define IN(k) (((MK_CMASK >> (k)) & 1) && lo <= (k) && (k) < hi)
#define SEAM(k) do { if (IN(k) && IN((k) + 1)) xcd_barrier(bar); } while (0)
    float* out = args.out;
    float *RSTD1 = (float*)(ws + WS_RSTD1), *RSTD3 = (float*)(ws + WS_RSTD3), *SS2 = (float*)(ws + WS_SS2), *LF = (float*)(ws + WS_LF);
    bf16 *WIN = (bf16*)(ws + WS_WIN), *WBR = (bf16*)(ws + WS_WBR), *WOUT = (bf16*)(ws + WS_WOUT), *WST = (bf16*)(ws + WS_WS), *WPG = (bf16*)(ws + WS_WPG), *WPP = (bf16*)(ws + WS_WPP), *PB = (bf16*)(ws + WS_PB);
    bf16 *UB = (bf16*)(ws + WS_UB), *VB = (bf16*)(ws + WS_VB), *XB = (bf16*)(ws + WS_A), *AC = (bf16*)(ws + WS_A), *XB1 = (bf16*)(ws + WS_A), *PP = (bf16*)(ws + WS_PP);
    bf16 *Q = (bf16*)(ws + WS_Q), *K = (bf16*)(ws + WS_K), *V = (bf16*)(ws + WS_V), *GB = (bf16*)(ws + WS_GB), *Z = (bf16*)(ws + WS_Z), *MG = (bf16*)(ws + WS_MERGED), *XB2 = (bf16*)(ws + WS_XB2);
    int* IDS = (int*)(ws + WS_IDS); float* GATES = (float*)(ws + WS_GATES);
    bf16 *SGA = (bf16*)out, *SGC = (bf16*)out + (size_t)M * D;

    if (IN(0)) { p0_prologue(F, args); }
    SEAM(0);
    if (IN(1)) {
        { pg8::Gemm g{XB, WIN, M, NIN, D}; pg8::StaticOrder S; S.init(M, NIN, F.G, (int)blockIdx.x);
          pg8::EpiIn E{RSTD1, Q, (size_t)(WS_K - WS_Q) / 2, Z, SGA, (size_t)M * D, C2};
          static_assert(WS_V - WS_K == WS_K - WS_Q && WS_GB - WS_V == WS_K - WS_Q, "Q | K | V | GB equally spaced");
          pg8::gemm_phase<pg8::EpiIn, pg8::StaticOrder, PG8_ALIGN, PG8_SP2>(F.lds + RING_OFF, g, S, E); }
        { pg8::Gemm g{PB, WPP, M, D, PLE}; pg8::StaticOrder S; S.init(M, D, F.G, (int)blockIdx.x);
          pg8::EpiPlain E{PP, D};
          pg8::gemm_phase<pg8::EpiPlain, pg8::StaticOrder, PG8_ALIGN, PG8_SP2>(F.lds + RING_OFF, g, S, E); }
    }
    SEAM(1);
    if (IN(2)) {
        p2_conv(F, GB, Z, args.in[5], AC);
        const attn_body::AttnTensors AT{(const attn_body::bf16*)Q, (const attn_body::bf16*)K, (const attn_body::bf16*)V, (attn_body::bf16*)AC, LF};
        const attn_body::StaticOrder S((int)F.G, F.vcu);
        attn_body::attn_phase<attn_body::StaticOrder>((char*)lds + RING_OFF, AT, S);
    }
    SEAM(2);
    if (IN(3)) {
        pg8::Gemm g{AC, WBR, M, D, D}; pg8::StaticOrder S; S.init(M, D, F.G, (int)blockIdx.x);
        pg8::EpiBranch E{SGA, SGC, MG};
        pg8::gemm_phase<pg8::EpiBranch, pg8::StaticOrder, PG8_ALIGN, PG8_SP2>(F.lds + RING_OFF, g, S, E);
    }
    SEAM(3);
    if (IN(4)) {
        pg8::Gemm g{MG, WOUT, M, D, D}; pg8::StaticOrder S; S.init(M, D, F.G, (int)blockIdx.x);
        pg8::EpiOut E{args.in[0], out, XB1, SS2};
        pg8::gemm_phase<pg8::EpiOut, pg8::StaticOrder, PG8_ALIGN, PG8_SP2>(F.lds + RING_OFF, g, S, E);
    }
    SEAM(4);
    if (IN(5)) {
        pg8::Gemm g{XB1, WST, M, NS, D}; pg8::StaticOrder S; S.init(M, NS, F.G, (int)blockIdx.x);
        pg8::EpiTopK E{SS2, IDS, GATES, EPS};
        pg8::Unit u;
        for (int i = 0; S.next(i, u); ++i) { OneUnit O{u}; pg8::gemm_phase<pg8::EpiTopK, OneUnit, false, PG8_SP2>(F.lds + RING_OFF, g, O, E); }
    }
    SEAM(5);
    if (IN(6)) { p6_peer(F, XB1, SS2, IDS, GATES, UB, VB, out, XB2, RSTD3); }
    SEAM(6);
    if (IN(7)) {
        pg8::Gemm g{XB2, WPG, M, D, D}; pg8::StaticOrder S; S.init(M, D, F.G, (int)blockIdx.x);
        pg8::EpiPle E{RSTD3, PP, out};
        pg8::gemm_phase<pg8::EpiPle, pg8::StaticOrder, PG8_ALIGN, PG8_SP2>(F.lds + RING_OFF, g, S, E);
    }
    SEAM(7);
    if (IN(8)) { p8_final(F, out, args.in[17]); }
#undef IN
#undef SEAM
}
namespace gold {
__global__ void __launch_bounds__(256) k_rows0(const float* x, const float* w_in, const float* g_mix, const float* b_f, bf16* XB, float* RSTD1, float* LF) {
    const int lane = threadIdx.x & 63, row = blockIdx.x * 4 + (threadIdx.x >> 6);
    const f32x4* xr = (const f32x4*)(x + (size_t)row * D);
    f32x4 v[4]; float ss = 0.f;
#pragma unroll
    for (int j = 0; j < 4; ++j) { v[j] = xr[lane + 64 * j]; ss += v[j].x * v[j].x + v[j].y * v[j].y + v[j].z * v[j].z + v[j].w * v[j].w; }
    ss = wave_sum(ss);
    const float rstd = 1.0f / sqrtf(ss * (1.0f / D) + EPS);
    u32x2* o = (u32x2*)(XB + (size_t)row * D);
#pragma unroll
    for (int j = 0; j < 4; ++j) { u32x2 w; w.x = pk2(v[j].x, v[j].y); w.y = pk2(v[j].z, v[j].w); o[lane + 64 * j] = w; }
    if (lane == 0) RSTD1[row] = rstd;
    float f[8];
#pragma unroll
    for (int h = 0; h < 8; ++h) f[h] = 0.f;
#pragma unroll
    for (int j = 0; j < 4; ++j)
#pragma unroll
        for (int e = 0; e < 4; ++e) {
            const int k = 4 * (lane + 64 * j) + e; const float xv = v[j][e] * g_mix[k];
            const f32x4 w0 = *(const f32x4*)(w_in + (size_t)k * INTOT + 1536), w1 = *(const f32x4*)(w_in + (size_t)k * INTOT + 1540);
            f[0] += xv * w0.x; f[1] += xv * w0.y; f[2] += xv * w0.z; f[3] += xv * w0.w; f[4] += xv * w1.x; f[5] += xv * w1.y; f[6] += xv * w1.z; f[7] += xv * w1.w;
        }
    const int b = row / SEQ, t = row % SEQ;
#pragma unroll
    for (int h = 0; h < 8; ++h) {
        const float tot = wave_sum(f[h]) * rstd + b_f[h];
        const float ls = fminf(tot, 0.f) - log1pf(__expf(-fabsf(tot)));
        if (lane == 0) LF[(size_t)(b * NH + h) * SEQ + t] = ls * LOG2E;
    }
}
template <int MODE> __global__ void k_wt(const float* W, int ldw, const float* g, bf16* Wt, int N, int K, int koff, int ldt) {
    const size_t i = (size_t)blockIdx.x * blockDim.x + threadIdx.x; if (i >= (size_t)N * K) return;
    const int n = (int)(i / K), k = (int)(i % K);
    const int s = MODE == 1 ? src_in(n) : n;
    const float gv = g ? g[k] : 1.f;
    Wt[(size_t)n * ldt + koff + k] = (bf16)f2bf(gv * W[(size_t)k * ldw + s]);
}
__global__ void k_ws(const float* wq, const float* k1, const float* k2, const float* g, bf16* WST) {
    const size_t i = (size_t)blockIdx.x * blockDim.x + threadIdx.x; if (i >= (size_t)NS * D) return;
    const int n = (int)(i / D), d = (int)(i % D), head = n >> 8, half = (n >> 7) & 1, key = n & 127;
    const float* kr = (half ? k2 : k1) + ((size_t)head * NKEYS + key) * 128;
    const float* qr = wq + (size_t)d * NS + head * 256 + half * 128;
    float s = 0.f;
    for (int e = 0; e < 128; ++e) s += qr[e] * kr[e];
    WST[(size_t)n * D + d] = (bf16)f2bf(g[d] * s);
}
__global__ void k_cvt(const float* in, const float* g, bf16* out, size_t n, int gmask) {
    const size_t i = (size_t)blockIdx.x * blockDim.x + threadIdx.x; if (i >= n) return;
    out[i] = (bf16)f2bf(in[i] * (g ? g[i & gmask] : 1.f));
}

template <class Epi, bool SPLIT2>
__global__ void __launch_bounds__(256) ng(const bf16* A, int lda, const bf16* Bt, int ldb, int K, Epi E) {
    __shared__ float As[32][68], Bs[32][68];
    const int tid = threadIdx.x, tx = tid & 15, ty = tid >> 4, m0 = blockIdx.y * 64, n0 = blockIdx.x * 64;
    float acc[4][4], acc2[4][4];
#pragma unroll
    for (int i = 0; i < 4; ++i)
#pragma unroll
        for (int j = 0; j < 4; ++j) { acc[i][j] = 0.f; acc2[i][j] = 0.f; }
    const int lr = tid >> 2, lk = (tid & 3) * 8;
    for (int k0 = 0; k0 < K; k0 += 32) {
        const u32x4 av = *(const u32x4*)(A + (size_t)(m0 + lr) * lda + k0 + lk), bv = *(const u32x4*)(Bt + (size_t)(n0 + lr) * ldb + k0 + lk);
#pragma unroll
        for (int e = 0; e < 4; ++e) {
            As[lk + 2 * e][lr] = __uint_as_float(av[e] << 16); As[lk + 2 * e + 1][lr] = __uint_as_float(av[e] & 0xffff0000u);
            Bs[lk + 2 * e][lr] = __uint_as_float(bv[e] << 16); Bs[lk + 2 * e + 1][lr] = __uint_as_float(bv[e] & 0xffff0000u);
        }
        __syncthreads();
        const bool second = SPLIT2 && (k0 >= K / 2);
#pragma unroll 8
        for (int kk = 0; kk < 32; ++kk) {
            float a[4], b[4];
#pragma unroll
            for (int i = 0; i < 4; ++i) { a[i] = As[kk][ty * 4 + i]; b[i] = Bs[kk][tx * 4 + i]; }
            if (second) {
#pragma unroll
                for (int i = 0; i < 4; ++i)
#pragma unroll
                    for (int j = 0; j < 4; ++j) acc2[i][j] += a[i] * b[j];
            } else {
#pragma unroll
                for (int i = 0; i < 4; ++i)
#pragma unroll
                    for (int j = 0; j < 4; ++j) acc[i][j] += a[i] * b[j];
            }
        }
        __syncthreads();
    }
#pragma unroll
    for (int i = 0; i < 4; ++i)
#pragma unroll
        for (int j = 0; j < 4; ++j) E(m0 + ty * 4 + i, n0 + tx * 4 + j, acc[i][j], acc2[i][j]);
}
struct E1 {
    const float* RSTD1; bf16 *Q, *K, *V, *GB, *SGA, *SGC; float *TGC, *TXC;
    __device__ void operator()(int row, int col, float a, float) const {
        const float v = RSTD1[row] * a; const int pn = col >> 8;
        if (pn < 2) Q[(size_t)row * AW + col] = (bf16)f2bf(v * C2);
        else if (pn < 4) K[(size_t)row * AW + col - 512] = (bf16)f2bf(v);
        else if (pn < 6) V[(size_t)row * AW + col - 1024] = (bf16)f2bf(v);
        else if (pn < 8) GB[(size_t)row * AW + col - 1536] = (bf16)f2bf(v);
        else if (pn < 12) { const int j = pn - 8, l = col & 255; if (l < 128) TGC[(size_t)row * AW + 128 * j + l] = v; else TXC[(size_t)row * AW + 128 * j + l - 128] = v; }
        else if (pn < 16) SGA[(size_t)row * D + col - 3072] = (bf16)f2bf(sigmoidf_(v));
        else SGC[(size_t)row * D + col - 4096] = (bf16)f2bf(sigmoidf_(v));
    }
};
struct EPP { bf16* PP; __device__ void operator()(int row, int col, float a, float) const { PP[(size_t)row * D + col] = (bf16)f2bf(a); } };
struct E3 { const bf16 *SGA, *SGC; bf16* MG;
    __device__ void operator()(int row, int col, float a, float a2) const { const size_t i = (size_t)row * D + col; MG[i] = (bf16)f2bf(bf2f(SGA[i]) * a + bf2f(SGC[i]) * a2); } };
struct E4 { const float* x; float* X1; bf16* XB1;
    __device__ void operator()(int row, int col, float a, float) const { const size_t i = (size_t)row * D + col; const float v = x[i] + a; X1[i] = v; XB1[i] = (bf16)f2bf(v); } };
struct E5 { float* SC; __device__ void operator()(int row, int col, float a, float) const { SC[(size_t)row * 1024 + col] = a; } };
struct E7 { const float* RSTD3; const bf16* PP; float* X;
    __device__ void operator()(int row, int col, float a, float) const { const size_t i = (size_t)row * D + col; X[i] = X[i] + sigmoidf_(RSTD3[row] * a) * bf2f(PP[i]); } };

__global__ void k_z(const float* TGC, const float* TXC, bf16* Z) { const size_t i = (size_t)blockIdx.x * blockDim.x + threadIdx.x; if (i < (size_t)M * AW) Z[i] = (bf16)f2bf(TGC[i] * TXC[i]); }
__global__ void k_cumsum(const float* LF, float* CS) { const int bh = threadIdx.x; if (bh >= 32) return; float s = 0.f; for (int t = 0; t < SEQ; ++t) { s += LF[(size_t)bh * SEQ + t]; CS[(size_t)bh * SEQ + t] = s; } }
__global__ void k_conv(const bf16* GB, const bf16* Z, const float* cw, bf16* AC) {
    const size_t i = (size_t)blockIdx.x * blockDim.x + threadIdx.x; if (i >= (size_t)M * AW) return;
    const int row = (int)(i / AW), c = (int)(i % AW), t = row % SEQ;
    float s = cw[2 * AW + c] * bf2f(Z[i]);
    if (t >= 1) s += cw[1 * AW + c] * bf2f(Z[i - AW]);
    if (t >= 2) s += cw[0 * AW + c] * bf2f(Z[i - 2 * AW]);
    AC[(size_t)row * D + AW + c] = (bf16)f2bf(bf2f(GB[i]) * s);
}
__global__ void __launch_bounds__(64) k_attn(const bf16* Q, const bf16* K, const bf16* V, const float* CS, bf16* AC) {
    const int bh = blockIdx.y, b = bh / NH, h = bh % NH, q = blockIdx.x * 64 + threadIdx.x;
    const size_t rq = (size_t)b * SEQ + q;
    float qv[64], o[64];
#pragma unroll
    for (int d = 0; d < 64; ++d) { qv[d] = bf2f(Q[rq * AW + h * 64 + d]); o[d] = 0.f; }
    const float cq = CS[(size_t)bh * SEQ + q];
    float m = -INFINITY, l = 0.f;
    const int kvmax = blockIdx.x * 64 + 63;
    for (int kv = 0; kv <= kvmax; ++kv) {
        const size_t rk = (size_t)b * SEQ + kv;
        const u32x4* kp = (const u32x4*)(K + rk * AW + h * 64);
        float s = 0.f;
#pragma unroll
        for (int c = 0; c < 8; ++c) { const u32x4 w = kp[c];
#pragma unroll
            for (int e = 0; e < 4; ++e) { s += qv[c * 8 + 2 * e] * __uint_as_float(w[e] << 16) + qv[c * 8 + 2 * e + 1] * __uint_as_float(w[e] & 0xffff0000u); } }
        s += cq - CS[(size_t)bh * SEQ + kv];
        if (kv > q) s = -INFINITY;
        const float mn = fmaxf(m, s);
        const float al = (m == -INFINITY) ? 0.f : exp2f(m - mn), p = (s == -INFINITY) ? 0.f : exp2f(s - mn);
        l = l * al + p; m = mn;
        const u32x4* vp = (const u32x4*)(V + rk * AW + h * 64);
#pragma unroll
        for (int c = 0; c < 8; ++c) { const u32x4 w = vp[c];
#pragma unroll
            for (int e = 0; e < 4; ++e) { o[c * 8 + 2 * e] = o[c * 8 + 2 * e] * al + p * __uint_as_float(w[e] << 16); o[c * 8 + 2 * e + 1] = o[c * 8 + 2 * e + 1] * al + p * __uint_as_float(w[e] & 0xffff0000u); } }
    }
    const float il = 1.0f / l;
#pragma unroll
    for (int d = 0; d < 64; ++d) AC[rq * D + h * 64 + d] = (bf16)f2bf(o[d] * il);
}
__global__ void __launch_bounds__(256) k_rowss(const float* X, float* SS) {
    const int lane = threadIdx.x & 63, row = blockIdx.x * 4 + (threadIdx.x >> 6);
    const f32x4* xr = (const f32x4*)(X + (size_t)row * D); float ss = 0.f;
#pragma unroll
    for (int j = 0; j < 4; ++j) { const f32x4 v = xr[lane + 64 * j]; ss += v.x * v.x + v.y * v.y + v.z * v.z + v.w * v.w; }
    ss = wave_sum(ss);
    if (lane < 16) SS[(size_t)row * 16 + lane] = lane == 0 ? ss : 0.f;
}
__global__ void __launch_bounds__(64) k_topk(const float* SC, const float* SS2, int hg, int* IDS, float* GATES) {
    __shared__ float s[128][64]; __shared__ float tv[16][64]; __shared__ int ti[16][64];
    const int tid = threadIdx.x, pair = blockIdx.x * 32 + (tid >> 1), half = tid & 1, token = pair >> 2, hl = pair & 3;
    const float* src = SC + (size_t)token * 1024 + hl * 256 + half * 128;
    for (int k = 0; k < 128; ++k) s[k][tid] = src[k];
    float pv = INFINITY; int pk = -1;
    for (int r = 0; r < 16; ++r) {
        float best = -INFINITY; int bi = 0;
        for (int k = 0; k < 128; ++k) { const float v = s[k][tid]; const bool elig = (v < pv) || (v == pv && k > pk); if (elig && v > best) { best = v; bi = k; } }
        tv[r][tid] = best; ti[r][tid] = bi; pv = best; pk = bi;
    }
    __syncthreads();
    if (half == 0) {
        const float* ss = SS2 + (size_t)token * 16; float sst = 0.f; for (int q_ = 0; q_ < 16; ++q_) sst += ss[q_]; const float rstd = 1.0f / sqrtf(sst * (1.0f / D) + EPS);
        float ts[16]; int tf[16];
        float cpv = INFINITY; int cpf = -1;
#pragma unroll
        for (int r = 0; r < 16; ++r) {
            float best = -INFINITY; int bf_ = 0;
            for (int c = 0; c < 256; ++c) { const float v = tv[c >> 4][tid] + tv[c & 15][tid + 1]; const bool elig = (v < cpv) || (v == cpv && c > cpf); if (elig && v > best) { best = v; bf_ = c; } }
            ts[r] = best; tf[r] = bf_; cpv = best; cpf = bf_;
        }
        float e[16], sum = 0.f;
#pragma unroll
        for (int r = 0; r < 16; ++r) { e[r] = __expf(rstd * (ts[r] - ts[0])); sum += e[r]; }
        const float inv = 1.0f / sum; const int head = hg * 4 + hl;
#pragma unroll
        for (int r = 0; r < 16; ++r) { IDS[(size_t)token * 128 + head * 16 + r] = ti[tf[r] >> 4][tid] * 128 + ti[tf[r] & 15][tid + 1]; GATES[(size_t)token * 128 + head * 16 + r] = e[r] * inv; }
    }
}
__global__ void __launch_bounds__(256) k_peer(const bf16* XB1, const float* SS2, const int* IDS, const float* GATES, const bf16* UB, const bf16* VB, float* X, bf16* XB2, float* RSTD3) {
    const int lane = threadIdx.x & 63, token = blockIdx.x * 4 + (threadIdx.x >> 6);
    const float* ss = SS2 + (size_t)token * 16; float sst = 0.f; for (int q_ = 0; q_ < 16; ++q_) sst += ss[q_]; const float rstd = 1.0f / sqrtf(sst * (1.0f / D) + EPS);
    float xf[16], out[16];
    { const u32x4 a = *(const u32x4*)(XB1 + (size_t)token * D + 8 * lane), b = *(const u32x4*)(XB1 + (size_t)token * D + 512 + 8 * lane);
#pragma unroll
      for (int e = 0; e < 4; ++e) { xf[2 * e] = __uint_as_float(a[e] << 16); xf[2 * e + 1] = __uint_as_float(a[e] & 0xffff0000u); xf[8 + 2 * e] = __uint_as_float(b[e] << 16); xf[8 + 2 * e + 1] = __uint_as_float(b[e] & 0xffff0000u); } }
#pragma unroll
    for (int i = 0; i < 16; ++i) out[i] = 0.f;
    for (int hk = 0; hk < 128; ++hk) {
        const int id = IDS[(size_t)token * 128 + hk]; const float g = GATES[(size_t)token * 128 + hk];
        const u32x4 a = *(const u32x4*)(UB + (size_t)id * D + 8 * lane), b = *(const u32x4*)(UB + (size_t)id * D + 512 + 8 * lane);
        float dot = 0.f;
#pragma unroll
        for (int e = 0; e < 4; ++e) { dot += xf[2 * e] * __uint_as_float(a[e] << 16) + xf[2 * e + 1] * __uint_as_float(a[e] & 0xffff0000u) + xf[8 + 2 * e] * __uint_as_float(b[e] << 16) + xf[8 + 2 * e + 1] * __uint_as_float(b[e] & 0xffff0000u); }
        dot = wave_sum(dot) * rstd;
        const float w = g * 0.5f * dot * (1.0f + erff(dot * 0.70710678118654752f));
        const u32x4 va = *(const u32x4*)(VB + (size_t)id * D + 8 * lane), vb = *(const u32x4*)(VB + (size_t)id * D + 512 + 8 * lane);
#pragma unroll
        for (int e = 0; e < 4; ++e) { out[2 * e] += w * __uint_as_float(va[e] << 16); out[2 * e + 1] += w * __uint_as_float(va[e] & 0xffff0000u); out[8 + 2 * e] += w * __uint_as_float(vb[e] << 16); out[8 + 2 * e + 1] += w * __uint_as_float(vb[e] & 0xffff0000u); }
    }
    float* xr = X + (size_t)token * D; float s2 = 0.f;
    f32x4 x0 = *(f32x4*)(xr + 8 * lane), x1 = *(f32x4*)(xr + 8 * lane + 4), x2 = *(f32x4*)(xr + 512 + 8 * lane), x3 = *(f32x4*)(xr + 512 + 8 * lane + 4);
#pragma unroll
    for (int e = 0; e < 4; ++e) { x0[e] += out[e]; x1[e] += out[4 + e]; x2[e] += out[8 + e]; x3[e] += out[12 + e]; s2 += x0[e] * x0[e] + x1[e] * x1[e] + x2[e] * x2[e] + x3[e] * x3[e]; }
    *(f32x4*)(xr + 8 * lane) = x0; *(f32x4*)(xr + 8 * lane + 4) = x1; *(f32x4*)(xr + 512 + 8 * lane) = x2; *(f32x4*)(xr + 512 + 8 * lane + 4) = x3;
    u32x4 w0, w1; w0.x = pk2(x0.x, x0.y); w0.y = pk2(x0.z, x0.w); w0.z = pk2(x1.x, x1.y); w0.w = pk2(x1.z, x1.w); w1.x = pk2(x2.x, x2.y); w1.y = pk2(x2.z, x2.w); w1.z = pk2(x3.x, x3.y); w1.w = pk2(x3.z, x3.w);
    *(u32x4*)(XB2 + (size_t)token * D + 8 * lane) = w0; *(u32x4*)(XB2 + (size_t)token * D + 512 + 8 * lane) = w1;
    s2 = wave_sum(s2);
    if (lane == 0) RSTD3[token] = 1.0f / sqrtf(s2 * (1.0f / D) + EPS);
}
__global__ void __launch_bounds__(256) k_final(float* X, const float* g) {
    const int lane = threadIdx.x & 63, row = blockIdx.x * 4 + (threadIdx.x >> 6);
    f32x4* xr = (f32x4*)(X + (size_t)row * D); f32x4 v[4]; float ss = 0.f;
#pragma unroll
    for (int j = 0; j < 4; ++j) { v[j] = xr[lane + 64 * j]; ss += v[j].x * v[j].x + v[j].y * v[j].y + v[j].z * v[j].z + v[j].w * v[j].w; }
    ss = wave_sum(ss); const float rstd = 1.0f / sqrtf(ss * (1.0f / D) + EPS);
#pragma unroll
    for (int j = 0; j < 4; ++j) { const f32x4 gv = ((const f32x4*)g)[lane + 64 * j]; xr[lane + 64 * j] = v[j] * rstd * gv; }
}

}

#ifndef MK_FUSED_MASK
#define MK_FUSED_MASK 0x1ff
#endif
static void golden_phase(int ph, void* const* d_in, float* out, unsigned char* ws, hipStream_t stream) {
    using namespace gold;
    const float* x = (const float*)d_in[0]; const float* p = (const float*)d_in[1]; const float* g_mix = (const float*)d_in[2]; const float* w_in = (const float*)d_in[3];
    const float* b_f = (const float*)d_in[4]; const float* conv_w = (const float*)d_in[5]; const float* w_branch = (const float*)d_in[6]; const float* w_out = (const float*)d_in[7];
    const float* g_ffn = (const float*)d_in[8]; const float* w_peer_q = (const float*)d_in[9]; const float* peer_k1 = (const float*)d_in[10]; const float* peer_k2 = (const float*)d_in[11];
    const float* peer_u = (const float*)d_in[12]; const float* peer_v = (const float*)d_in[13]; const float* g_ple = (const float*)d_in[14]; const float* w_ple_gate = (const float*)d_in[15];
    const float* w_ple_proj = (const float*)d_in[16]; const float* g_final = (const float*)d_in[17];
    float *RSTD1 = (float*)(ws + WS_RSTD1), *RSTD3 = (float*)(ws + WS_RSTD3), *SS2 = (float*)(ws + WS_SS2), *LF = (float*)(ws + WS_LF), *CS = (float*)(ws + WS_CS);
    bf16 *WIN = (bf16*)(ws + WS_WIN), *WBR = (bf16*)(ws + WS_WBR), *WOUT = (bf16*)(ws + WS_WOUT), *WST = (bf16*)(ws + WS_WS), *WPG = (bf16*)(ws + WS_WPG), *WPP = (bf16*)(ws + WS_WPP), *PB = (bf16*)(ws + WS_PB);
    bf16 *UB = (bf16*)(ws + WS_UB), *VB = (bf16*)(ws + WS_VB), *XB = (bf16*)(ws + WS_A), *AC = (bf16*)(ws + WS_A), *XB1 = (bf16*)(ws + WS_A), *PP = (bf16*)(ws + WS_PP);
    bf16 *Q = (bf16*)(ws + WS_Q), *K = (bf16*)(ws + WS_K), *V = (bf16*)(ws + WS_V), *GB = (bf16*)(ws + WS_GB), *Z = (bf16*)(ws + WS_Z), *MG = (bf16*)(ws + WS_MERGED), *XB2 = (bf16*)(ws + WS_XB2);
    int* IDS = (int*)(ws + WS_IDS); float* GATES = (float*)(ws + WS_GATES);
    bf16 *SGA = (bf16*)out, *SGC = (bf16*)out + (size_t)M * D;
    float *TGC = (float*)(ws + WS_TGC), *TXC = (float*)(ws + WS_TXC), *SC = (float*)(ws + WS_SC);
    auto nb = [](size_t n) { return (unsigned)((n + 255) / 256); };
    switch (ph) {
    case 0:
        k_rows0<<<M / 4, 256, 0, stream>>>(x, w_in, g_mix, b_f, XB, RSTD1, LF);
        k_wt<1><<<nb((size_t)NIN * D), 256, 0, stream>>>(w_in, INTOT, g_mix, WIN, NIN, D, 0, D);
        k_wt<0><<<nb((size_t)D * AW), 256, 0, stream>>>(w_branch, D, nullptr, WBR, D, AW, 0, D);
        k_wt<0><<<nb((size_t)D * AW), 256, 0, stream>>>(w_branch + (size_t)AW * D, D, nullptr, WBR, D, AW, AW, D);
        k_wt<0><<<nb((size_t)D * D), 256, 0, stream>>>(w_out, D, nullptr, WOUT, D, D, 0, D);
        k_wt<0><<<nb((size_t)D * D), 256, 0, stream>>>(w_ple_gate, D, g_ple, WPG, D, D, 0, D);
        k_wt<0><<<nb((size_t)D * PLE), 256, 0, stream>>>(w_ple_proj, D, nullptr, WPP, D, PLE, 0, PLE);
        k_ws<<<nb((size_t)NS * D), 256, 0, stream>>>(w_peer_q, peer_k1, peer_k2, g_ffn, WST);
        k_cvt<<<nb((size_t)M * PLE), 256, 0, stream>>>(p, nullptr, PB, (size_t)M * PLE, 0);
        break;
    case 1:
        ng<E1, false><<<dim3(NIN / 64, M / 64), 256, 0, stream>>>(XB, D, WIN, D, D, E1{RSTD1, Q, K, V, GB, SGA, SGC, TGC, TXC});
        ng<EPP, false><<<dim3(D / 64, M / 64), 256, 0, stream>>>(PB, PLE, WPP, PLE, PLE, EPP{PP});
        k_z<<<nb((size_t)M * AW), 256, 0, stream>>>(TGC, TXC, Z);
        break;
    case 2:
        k_cumsum<<<1, 64, 0, stream>>>(LF, CS);
        k_conv<<<nb((size_t)M * AW), 256, 0, stream>>>(GB, Z, conv_w, AC);
        k_attn<<<dim3(SEQ / 64, BATCH * NH), 64, 0, stream>>>(Q, K, V, CS, AC);
        break;
    case 3: ng<E3, true><<<dim3(D / 64, M / 64), 256, 0, stream>>>(AC, D, WBR, D, D, E3{SGA, SGC, MG}); break;
    case 4:
        ng<E4, false><<<dim3(D / 64, M / 64), 256, 0, stream>>>(MG, D, WOUT, D, D, E4{x, out, XB1});
        k_rowss<<<M / 4, 256, 0, stream>>>(out, SS2);
        break;
    case 5:
        for (int hg = 0; hg < 2; ++hg) {
            ng<E5, false><<<dim3(1024 / 64, M / 64), 256, 0, stream>>>(XB1, D, WST + (size_t)hg * 1024 * D, D, D, E5{SC});
            k_topk<<<M * 4 / 32, 64, 0, stream>>>(SC, SS2, hg, IDS, GATES);
        }
        break;
    case 6:
        k_cvt<<<nb((size_t)NEXP * D), 256, 0, stream>>>(peer_u, g_ffn, UB, (size_t)NEXP * D, D - 1);
        k_cvt<<<nb((size_t)NEXP * D), 256, 0, stream>>>(peer_v, nullptr, VB, (size_t)NEXP * D, 0);
        k_peer<<<M / 4, 256, 0, stream>>>(XB1, SS2, IDS, GATES, UB, VB, out, XB2, RSTD3);
        break;
    case 7: ng<E7, false><<<dim3(D / 64, M / 64), 256, 0, stream>>>(XB2, D, WPG, D, D, E7{RSTD3, PP, out}); break;
    case 8: k_final<<<M / 4, 256, 0, stream>>>(out, g_final); break;
    }
}
extern "C" void kernel_launch(void* const* d_in, const int* in_sizes, int n_in, void* d_out, int out_size, void* d_ws, size_t ws_size, hipStream_t stream) {
    static int grid = 0;
    if (grid == 0) {
        if (n_in != 18 || in_sizes[0] != M * D || out_size != M * D || ws_size < WS_END) { fprintf(stderr, "kernel_launch: unexpected shapes (n_in %d, in0 %d, out %d, ws %zu); nothing launched\n", n_in, n_in > 0 ? in_sizes[0] : -1, out_size, ws_size); grid = -1; return; }
        int dev = 0, cus = 0, per_cu = 0;
        if (hipGetDevice(&dev) != hipSuccess || hipDeviceGetAttribute(&cus, hipDeviceAttributeMultiprocessorCount, dev) != hipSuccess) { fprintf(stderr, "kernel_launch: device query failed\n"); grid = -1; return; }
        if (hipFuncSetAttribute((const void*)mk_fwd, hipFuncAttributeMaxDynamicSharedMemorySize, LDS_BYTES) != hipSuccess) { fprintf(stderr, "kernel_launch: hipFuncSetAttribute failed\n"); grid = -1; return; }
        if (hipOccupancyMaxActiveBlocksPerMultiprocessor(&per_cu, (const void*)mk_fwd, NWAVES * 64, LDS_BYTES) != hipSuccess || per_cu < 1) { fprintf(stderr, "kernel_launch: occupancy query says %d workgroups per CU; nothing launched\n", per_cu); (void)hipGetLastError(); grid = -1; return; }
        grid = cus;
    }
    if (grid < 0) return;
    if (hipMemsetAsync((char*)d_ws + WS_CTL, 0, CTL_ZERO_BYTES, stream) != hipSuccess) { fprintf(stderr, "kernel_launch: hipMemsetAsync failed\n"); return; }
    Args a{};
    for (int i = 0; i < 18; ++i) a.in[i] = (const float*)d_in[i];
    a.out = (float*)d_out; a.ws = (unsigned char*)d_ws;
    int li = 0;
    for (int ph = 0; ph < NPHASE;) {
        if ((MK_FUSED_MASK >> ph) & 1) {
            int hi = ph; while (hi < NPHASE && ((MK_FUSED_MASK >> hi) & 1)) ++hi;
            a.ph_lo = ph; a.ph_hi = hi; a.li = li++; a.pad = 0;
            hipLaunchKernelGGL(mk_fwd, dim3(grid), dim3(NWAVES * 64), LDS_BYTES, stream, a);
            const hipError_t le = hipPeekAtLastError();
            if (le != hipSuccess) { fprintf(stderr, "kernel_launch: launch failed: %s\n", hipGetErrorName(le)); return; }
            ph = hi;
        } else {
            golden_phase(ph, d_in, (float*)d_out, (unsigned char*)d_ws, stream);
            if ((ph == 1 || ph == 5) && (MK_FUSED_MASK & 1) && ((MK_FUSED_MASK >> 6) & 1)) {
                gold::k_cvt<<<(unsigned)(((size_t)NEXP * D + 255) / 256), 256, 0, stream>>>((const float*)d_in[12], (const float*)d_in[8], (bf16*)((unsigned char*)d_ws + WS_UB), (size_t)NEXP * D, D - 1);
                gold::k_cvt<<<(unsigned)(((size_t)NEXP * D + 255) / 256), 256, 0, stream>>>((const float*)d_in[13], nullptr, (bf16*)((unsigned char*)d_ws + WS_VB), (size_t)NEXP * D, 0);
            }
            ++ph;
        }
    }
}
```

```cpp
#include <hip/hip_runtime.h>
#include <hip/hip_bf16.h>
#include <cstdio>
#include <cstdint>
#include <cmath>
#define MK_FUSED_MASK 0x1ff
namespace pg8 {
#define PG8_LAS __attribute__((address_space(3)))
typedef unsigned short bf16_t;
typedef short bf16x8 __attribute__((ext_vector_type(8)));
typedef float f32x4 __attribute__((ext_vector_type(4)));
typedef unsigned u32x4 __attribute__((ext_vector_type(4)));
constexpr int BM = 256, BK = 64, HALF = 128, HTB = HALF * BK * 2  , STAGE_BYTES = 8 * HTB, NXCD = 8, WGM = 8;

__host__ __device__ __forceinline__ int lds_byte(int r, int c) { const int st = (r >> 4) * 2 + (c >> 5), rr = r & 15, cc = c & 31, ob = rr * 64 + cc * 2; return st * 1024 + (ob ^ (((ob >> 9) & 1) << 5)); }
__host__ __device__ __forceinline__ void stage_rc(int b, int& R, int& C) { const int st = b / 1024, sb = b % 1024, swz = sb ^ (((sb >> 9) & 1) << 5); R = (st >> 1) * 16 + swz / 64; C = (st & 1) * 32 + (swz % 64) / 2; }
__host__ __device__ __forceinline__ int perm32(int rho) { const int n = rho >> 4, i = rho & 15; return 8 * (i >> 2) + 4 * n + (i & 3); }

struct Unit { int pm, pn; };
struct Gemm { const bf16_t* A; const bf16_t* Bt; int M, N, K; };

struct StaticOrder {
    int nM, nN, nwg, G, c;
    __host__ __device__ void init(int M, int N, int G_, int c_) { nM = M / BM; nN = N / BM; nwg = nM * nN; G = G_; c = c_; }
    __host__ __device__ bool next(int i, Unit& u) const {
        const long L = (long)i * G + c; if (L >= nwg) return false;
        int wgid = (int)L; { const int q = nwg / NXCD, r = nwg % NXCD, xcd = wgid % NXCD, off = wgid / NXCD; wgid = (xcd < r ? xcd * (q + 1) : r * (q + 1) + (xcd - r) * q) + off; }
        const int nig = WGM * nN, gid = wgid / nig, fm = gid * WGM, gsz = (nM - fm) < WGM ? (nM - fm) : WGM;
        u.pm = fm + ((wgid % nig) % gsz); u.pn = (wgid % nig) / gsz; return true;
    }
    __device__ __forceinline__ void a_ready(const Unit&) const {}
    __device__ __forceinline__ void done(const Unit&) const {}
};


__device__ __forceinline__ unsigned cvt_pk_bf16(float lo, float hi) { unsigned r; asm volatile("v_cvt_pk_bf16_f32 %0, %1, %2" : "=v"(r) : "v"(lo), "v"(hi)); return r; }
__device__ __forceinline__ u32x4 pack8(const f32x4 v0, const f32x4 v1) { u32x4 w; w.x = cvt_pk_bf16(v0[0], v0[1]); w.y = cvt_pk_bf16(v0[2], v0[3]); w.z = cvt_pk_bf16(v1[0], v1[1]); w.w = cvt_pk_bf16(v1[2], v1[3]); return w; }
__device__ __forceinline__ float bflo(unsigned w) { return __uint_as_float(w << 16); }
__device__ __forceinline__ float bfhi(unsigned w) { return __uint_as_float(w & 0xffff0000u); }
__device__ __forceinline__ float sigm(float v) { return __builtin_amdgcn_rcpf(1.0f + __builtin_amdgcn_exp2f(v * -1.4426950408889634f)); }
__device__ __forceinline__ f32x4 sigm4(const f32x4 v) { return (f32x4){sigm(v[0]), sigm(v[1]), sigm(v[2]), sigm(v[3])}; }

struct EpiIn {
    static constexpr bool PERM = true, AFTER_DRAIN = false; static constexpr int MID_T = 0;
    const float* rstd; bf16_t* QKVG; size_t stride4; bf16_t* Z; bf16_t* SG; size_t strideSG; float c2;
    __device__ __forceinline__ void operator()(const f32x4 (&acc)[2][2][4][2], const Unit& u, int wr, int wc, int fr, int fq) const {
        int row0 = u.pm * BM + wr * 64 + fr; asm volatile("" : "+v"(row0)); const int cl = wc * 32 + 8 * fq, pn = u.pn;
        if (pn < 8) {
            bf16_t* base = QKVG + (size_t)(pn >> 1) * stride4; const int colt = (pn & 1) * 256 + cl; const float s0 = pn < 2 ? c2 : 1.f;
#pragma unroll
            for (int ai = 0; ai < 2; ++ai)
#pragma unroll
                for (int m = 0; m < 4; ++m) { const int row = row0 + ai * HALF + m * 16; const float sc = rstd[row] * s0; bf16_t* rowp = base + (size_t)row * 512 + colt;
#pragma unroll
                    for (int bj = 0; bj < 2; ++bj) *(u32x4*)(rowp + bj * HALF) = pack8(acc[ai][bj][m][0] * sc, acc[ai][bj][m][1] * sc);
                    asm volatile("" ::: "memory"); }
        } else if (pn < 12) {
            const int colt = (pn - 8) * 128 + cl;
#pragma unroll
            for (int ai = 0; ai < 2; ++ai)
#pragma unroll
                for (int m = 0; m < 4; ++m) { const int row = row0 + ai * HALF + m * 16; const float r = rstd[row], sc = r * r;
                    *(u32x4*)(Z + (size_t)row * 512 + colt) = pack8(acc[ai][0][m][0] * acc[ai][1][m][0] * sc, acc[ai][0][m][1] * acc[ai][1][m][1] * sc);
                    asm volatile("" ::: "memory"); }
        } else {
            bf16_t* base = SG + (size_t)((pn - 12) >> 2) * strideSG; const int colt = ((pn - 12) & 3) * 256 + cl;
#pragma unroll
            for (int ai = 0; ai < 2; ++ai)
#pragma unroll
                for (int m = 0; m < 4; ++m) { const int row = row0 + ai * HALF + m * 16; const float r = rstd[row]; bf16_t* rowp = base + (size_t)row * 1024 + colt;
#pragma unroll
                    for (int bj = 0; bj < 2; ++bj) { *(u32x4*)(rowp + bj * HALF) = pack8(sigm4(acc[ai][bj][m][0] * r), sigm4(acc[ai][bj][m][1] * r)); asm volatile("" ::: "memory"); } }
        }
    }
};
struct EpiPlain {
    static constexpr bool PERM = true, AFTER_DRAIN = false; static constexpr int MID_T = 0;
    bf16_t* O; int ldc;
    __device__ __forceinline__ void operator()(const f32x4 (&acc)[2][2][4][2], const Unit& u, int wr, int wc, int fr, int fq) const {
        int row0 = u.pm * BM + wr * 64 + fr; asm volatile("" : "+v"(row0)); const int col0 = u.pn * BM + wc * 32 + 8 * fq;
#pragma unroll
        for (int ai = 0; ai < 2; ++ai)
#pragma unroll
            for (int m = 0; m < 4; ++m) { bf16_t* rowp = O + (size_t)(row0 + ai * HALF + m * 16) * ldc + col0;
#pragma unroll
                for (int bj = 0; bj < 2; ++bj) *(u32x4*)(rowp + bj * HALF) = pack8(acc[ai][bj][m][0], acc[ai][bj][m][1]); }
    }
};
struct EpiBranch {
    static constexpr bool PERM = true, AFTER_DRAIN = false; static constexpr int MID_T = 8;
    const bf16_t *SGA, *SGC; bf16_t* MG;
    __device__ __forceinline__ void mid(f32x4 (&acc)[2][2][4][2], const Unit& u, int wr, int wc, int fr, int fq) const {
        int row0 = u.pm * BM + wr * 64 + fr; asm volatile("" : "+v"(row0)); const int col0 = u.pn * BM + wc * 32 + 8 * fq;
#pragma unroll
        for (int ai = 0; ai < 2; ++ai)
#pragma unroll
            for (int m = 0; m < 4; ++m) { const size_t off = (size_t)(row0 + ai * HALF + m * 16) * 1024 + col0;
#pragma unroll
                for (int bj = 0; bj < 2; ++bj) { const u32x4 a = *(const u32x4*)(SGA + off + bj * HALF), c = *(const u32x4*)(SGC + off + bj * HALF);
                    f32x4 r0, r1;
                    r0[0] = bflo(a[0]) * __builtin_amdgcn_rcpf(bflo(c[0])); r0[1] = bfhi(a[0]) * __builtin_amdgcn_rcpf(bfhi(c[0])); r0[2] = bflo(a[1]) * __builtin_amdgcn_rcpf(bflo(c[1])); r0[3] = bfhi(a[1]) * __builtin_amdgcn_rcpf(bfhi(c[1]));
                    r1[0] = bflo(a[2]) * __builtin_amdgcn_rcpf(bflo(c[2])); r1[1] = bfhi(a[2]) * __builtin_amdgcn_rcpf(bfhi(c[2])); r1[2] = bflo(a[3]) * __builtin_amdgcn_rcpf(bflo(c[3])); r1[3] = bfhi(a[3]) * __builtin_amdgcn_rcpf(bfhi(c[3]));
                    acc[ai][bj][m][0] *= r0; acc[ai][bj][m][1] *= r1; asm volatile("" ::: "memory"); } }
    }
    __device__ __forceinline__ void operator()(const f32x4 (&acc)[2][2][4][2], const Unit& u, int wr, int wc, int fr, int fq) const {
        int row0 = u.pm * BM + wr * 64 + fr; asm volatile("" : "+v"(row0)); const int col0 = u.pn * BM + wc * 32 + 8 * fq;
#pragma unroll
        for (int ai = 0; ai < 2; ++ai)
#pragma unroll
            for (int m = 0; m < 4; ++m) { const size_t off = (size_t)(row0 + ai * HALF + m * 16) * 1024 + col0;
#pragma unroll
                for (int bj = 0; bj < 2; ++bj) { const u32x4 c = *(const u32x4*)(SGC + off + bj * HALF);
                    const f32x4 s0 = {bflo(c[0]), bfhi(c[0]), bflo(c[1]), bfhi(c[1])}, s1 = {bflo(c[2]), bfhi(c[2]), bflo(c[3]), bfhi(c[3])};
                    *(u32x4*)(MG + off + bj * HALF) = pack8(acc[ai][bj][m][0] * s0, acc[ai][bj][m][1] * s1); asm volatile("" ::: "memory"); } }
    }
};
struct EpiOut {
    static constexpr bool PERM = true, AFTER_DRAIN = false; static constexpr int MID_T = 0;
    const float* x; float* X1; bf16_t* XB1; float* SS2;
    __device__ __forceinline__ void operator()(const f32x4 (&acc)[2][2][4][2], const Unit& u, int wr, int wc, int fr, int fq) const {
        int row0 = u.pm * BM + wr * 64 + fr; asm volatile("" : "+v"(row0)); const int col0 = u.pn * BM + wc * 32 + 8 * fq;
#pragma unroll
        for (int ai = 0; ai < 2; ++ai)
#pragma unroll
            for (int m = 0; m < 4; ++m) { const int row = row0 + ai * HALF + m * 16; const size_t off = (size_t)row * 1024 + col0; float ss = 0.f;
#pragma unroll
                for (int bj = 0; bj < 2; ++bj) { const f32x4 v0 = acc[ai][bj][m][0] + *(const f32x4*)(x + off + bj * HALF), v1 = acc[ai][bj][m][1] + *(const f32x4*)(x + off + bj * HALF + 4);
                    *(f32x4*)(X1 + off + bj * HALF) = v0; *(f32x4*)(X1 + off + bj * HALF + 4) = v1; *(u32x4*)(XB1 + off + bj * HALF) = pack8(v0, v1);
                    ss += (v0[0] * v0[0] + v0[1] * v0[1]) + (v0[2] * v0[2] + v0[3] * v0[3]) + (v1[0] * v1[0] + v1[1] * v1[1]) + (v1[2] * v1[2] + v1[3] * v1[3]); }
                ss += __shfl_xor(ss, 16); ss += __shfl_xor(ss, 32);
                if (fq == 0) SS2[(size_t)row * 16 + u.pn * 4 + wc] = ss;
                if (m & 1) asm volatile("" ::: "memory"); }
    }
};
struct EpiPle {
    static constexpr bool PERM = true, AFTER_DRAIN = false; static constexpr int MID_T = 0;
    const float* SS3; const bf16_t* PP; float* X; float eps;
    __device__ __forceinline__ void operator()(const f32x4 (&acc)[2][2][4][2], const Unit& u, int wr, int wc, int fr, int fq) const {
        int row0 = u.pm * BM + wr * 64 + fr; asm volatile("" : "+v"(row0)); const int col0 = u.pn * BM + wc * 32 + 8 * fq;
#pragma unroll
        for (int ai = 0; ai < 2; ++ai)
#pragma unroll
            for (int m = 0; m < 4; ++m) { const int row = row0 + ai * HALF + m * 16; const size_t off = (size_t)row * 1024 + col0;
                const f32x4* sp = (const f32x4*)(SS3 + (size_t)row * 16); const f32x4 q0 = sp[0], q1 = sp[1], q2 = sp[2], q3 = sp[3];
                const float r = 1.0f / sqrtf((((q0[0] + q0[1]) + (q0[2] + q0[3])) + ((q1[0] + q1[1]) + (q1[2] + q1[3])) + ((q2[0] + q2[1]) + (q2[2] + q2[3])) + ((q3[0] + q3[1]) + (q3[2] + q3[3]))) * (1.0f / 1024.0f) + eps);
#pragma unroll
                for (int bj = 0; bj < 2; ++bj) { const u32x4 c = *(const u32x4*)(PP + off + bj * HALF);
                    const f32x4 p0 = {bflo(c[0]), bfhi(c[0]), bflo(c[1]), bfhi(c[1])}, p1 = {bflo(c[2]), bfhi(c[2]), bflo(c[3]), bfhi(c[3])};
                    const f32x4 x0 = *(const f32x4*)(X + off + bj * HALF), x1 = *(const f32x4*)(X + off + bj * HALF + 4);
                    *(f32x4*)(X + off + bj * HALF) = x0 + sigm4(acc[ai][bj][m][0] * r) * p0; *(f32x4*)(X + off + bj * HALF + 4) = x1 + sigm4(acc[ai][bj][m][1] * r) * p1; }
                if (m & 1) asm volatile("" ::: "memory"); }
    }
};

__device__ __forceinline__ float vmaxf(float a, float b) { float r; asm("v_max_f32_e32 %0, %1, %2" : "=v"(r) : "v"(a), "v"(b)); return r; }
__device__ __forceinline__ float vminf(float a, float b) { float r; asm("v_min_f32_e32 %0, %1, %2" : "=v"(r) : "v"(a), "v"(b)); return r; }
__device__ __forceinline__ void sort16_desc(float (&a)[16]) {
#pragma unroll
    for (int k = 2; k <= 16; k <<= 1)
#pragma unroll
        for (int j = k >> 1; j > 0; j >>= 1)
#pragma unroll
            for (int i = 0; i < 16; ++i) { const int l = i ^ j; if (l > i) { const float hi = vmaxf(a[i], a[l]), lo = vminf(a[i], a[l]); if ((i & k) == 0) { a[i] = hi; a[l] = lo; } else { a[i] = lo; a[l] = hi; } } }
}
template <int L> __device__ __forceinline__ void merge16(float (&a)[16], const float (&b)[16]) {
#pragma unroll
    for (int i = 0; i < 16; ++i) if (15 - i < L) a[i] = vmaxf(a[i], b[15 - i]);
#pragma unroll
    for (int j = 8; j > 0; j >>= 1)
#pragma unroll
        for (int i = 0; i < 16; ++i) { const int l = i ^ j; if (l > i) { const float hi = vmaxf(a[i], a[l]), lo = vminf(a[i], a[l]); a[i] = hi; a[l] = lo; } }
}
struct EpiTopK {
    static constexpr bool PERM = true, AFTER_DRAIN = true; static constexpr int MID_T = 0;
    static constexpr int RS = 260;
    const float* SS2; int* IDS; float* GATES; float eps;
    __device__ __forceinline__ void fused(f32x4 (&acc)[2][2][4][2], const Unit& u, int wr, int wc, int fr, int fq, PG8_LAS unsigned char* lds, int wid, int lane) const {
        PG8_LAS float* S = (PG8_LAS float*)lds;
        const int tid = wid * 64 + lane, row = tid & 127, grp = tid >> 7, half = grp >> 1, part = grp & 1;
#define TK_BAR() do { asm volatile("s_waitcnt vmcnt(0) lgkmcnt(0)" ::: "memory"); __builtin_amdgcn_s_barrier(); asm volatile("" ::: "memory"); } while (0)
#pragma unroll
        for (int ai = 0; ai < 2; ++ai) {
#pragma unroll
            for (int m = 0; m < 4; ++m)
#pragma unroll
                for (int bj = 0; bj < 2; ++bj)
#pragma unroll
                    for (int n = 0; n < 2; ++n) *(PG8_LAS f32x4*)(S + (wr * 64 + m * 16 + fr) * RS + bj * HALF + wc * 32 + 8 * fq + 4 * n) = acc[ai][bj][m][n];
            TK_BAR();
            float T[16];
#pragma unroll
            for (int b = 0; b < 4; ++b) {
                float c[16];
#pragma unroll
                for (int q = 0; q < 4; ++q) { const f32x4 v = *(const PG8_LAS f32x4*)(S + row * RS + half * 128 + part * 64 + b * 16 + q * 4);
#pragma unroll
                    for (int e = 0; e < 4; ++e) c[q * 4 + e] = __uint_as_float((__float_as_uint(v[e]) & ~127u) | (unsigned)(part * 64 + b * 16 + q * 4 + e)); }
                sort16_desc(c);
                if (b == 0) {
#pragma unroll
                    for (int i = 0; i < 16; ++i) T[i] = c[i];
                } else merge16<16>(T, c);
            }
            TK_BAR();
#pragma unroll
            for (int q = 0; q < 4; ++q) *(PG8_LAS f32x4*)(S + tid * 16 + q * 4) = (f32x4){T[q * 4], T[q * 4 + 1], T[q * 4 + 2], T[q * 4 + 3]};
            TK_BAR();
            if (part == 0) {
                float c[16];
#pragma unroll
                for (int q = 0; q < 4; ++q) { const f32x4 v = *(const PG8_LAS f32x4*)(S + (tid + 128) * 16 + q * 4); c[q * 4] = v[0]; c[q * 4 + 1] = v[1]; c[q * 4 + 2] = v[2]; c[q * 4 + 3] = v[3]; }
                merge16<16>(T, c);
            }
            TK_BAR();
            if (part == 0) {
#pragma unroll
                for (int q = 0; q < 4; ++q) *(PG8_LAS f32x4*)(S + tid * 16 + q * 4) = (f32x4){T[q * 4], T[q * 4 + 1], T[q * 4 + 2], T[q * 4 + 3]};
            }
            TK_BAR();
            if (tid < 128) {
                float a1[16], a2[16];
#pragma unroll
                for (int q = 0; q < 4; ++q) { const f32x4 v = *(const PG8_LAS f32x4*)(S + (tid + 256) * 16 + q * 4);
#pragma unroll
                    for (int e = 0; e < 4; ++e) a2[q * 4 + e] = __uint_as_float(__float_as_uint(v[e]) & ~127u); }
#pragma unroll
                for (int i = 0; i < 16; ++i) a1[i] = __uint_as_float(__float_as_uint(T[i]) & ~127u);
#define TK_SUM(i, j) __uint_as_float((__float_as_uint(a1[i] + a2[j]) & ~255u) | (unsigned)((i) * 16 + (j)))
                float R[16], C[16];
#pragma unroll
                for (int j = 0; j < 16; ++j) R[j] = TK_SUM(0, j);
#pragma unroll
                for (int i = 1; i < 16; ++i) C[i - 1] = TK_SUM(i, 0);
                C[15] = 0.f;
                merge16<15>(R, C);
                C[0] = TK_SUM(1, 1); C[1] = TK_SUM(1, 2); C[2] = TK_SUM(1, 3); C[3] = TK_SUM(1, 4); C[4] = TK_SUM(1, 5); C[5] = TK_SUM(1, 6); C[6] = TK_SUM(1, 7);
                C[7] = TK_SUM(2, 1); C[8] = TK_SUM(2, 2); C[9] = TK_SUM(2, 3); C[10] = TK_SUM(2, 4); C[11] = TK_SUM(3, 1); C[12] = TK_SUM(3, 2); C[13] = TK_SUM(3, 3);
                C[14] = TK_SUM(4, 1); C[15] = TK_SUM(4, 2);
                sort16_desc(C);
                merge16<16>(R, C);
                C[0] = TK_SUM(5, 1); C[1] = TK_SUM(6, 1); C[2] = TK_SUM(7, 1);
                merge16<3>(R, C);
#undef TK_SUM
                const int rowg = u.pm * BM + ai * HALF + row;
                const f32x4* ssp = (const f32x4*)(SS2 + (size_t)rowg * 16); const f32x4 s0 = ssp[0], s1 = ssp[1], s2 = ssp[2], s3 = ssp[3];
                const float ssum = ((s0[0] + s0[1]) + (s0[2] + s0[3])) + ((s1[0] + s1[1]) + (s1[2] + s1[3])) + ((s2[0] + s2[1]) + (s2[2] + s2[3])) + ((s3[0] + s3[1]) + (s3[2] + s3[3]));
                const float rl = 1.4426950408889634f / sqrtf(ssum * (1.0f / 1024.0f) + eps);
                float ev[16], esum = 0.f; int idv[16];
#pragma unroll
                for (int r = 0; r < 16; ++r) { ev[r] = __builtin_amdgcn_exp2f((R[r] - R[0]) * rl); esum += ev[r];
                    const unsigned code = __float_as_uint(R[r]) & 255u;
                    const unsigned k1 = __float_as_uint(S[tid * 16 + (code >> 4)]) & 127u, k2 = __float_as_uint(S[(tid + 256) * 16 + (code & 15u)]) & 127u;
                    idv[r] = (int)(k1 * 128u + k2); }
                const float inv = 1.0f / esum;
                int* ip = IDS + (size_t)rowg * 128 + u.pn * 16; float* gp = GATES + (size_t)rowg * 128 + u.pn * 16;
#pragma unroll
                for (int q = 0; q < 4; ++q) { *(int4*)(ip + q * 4) = make_int4(idv[q * 4], idv[q * 4 + 1], idv[q * 4 + 2], idv[q * 4 + 3]);
                    *(f32x4*)(gp + q * 4) = (f32x4){ev[q * 4] * inv, ev[q * 4 + 1] * inv, ev[q * 4 + 2] * inv, ev[q * 4 + 3] * inv}; }
            }
            TK_BAR();
        }
#undef TK_BAR
    }
};
template <class Epi, class Sched, bool ALIGN_EPI = false, bool SP2 = false>
__device__ __forceinline__ void gemm_phase(PG8_LAS unsigned char* lds, const Gemm g, const Sched& S, const Epi& E) {
    const int tid = threadIdx.x, wid = __builtin_amdgcn_readfirstlane(tid >> 6), lane = tid & 63, wr = wid >> 2, wc = wid & 3, fr = lane & 15, fq = lane >> 4;
    const int K = g.K, nt = K / BK;
    unsigned voffA[2], voffB[2];
#pragma unroll
    for (int i = 0; i < 2; ++i) { int R, C; stage_rc(tid * 16 + i * 8192, R, C); const int Rb = Epi::PERM ? ((R & ~31) + perm32(R & 31)) : R;
        voffA[i] = (unsigned)(R * K + C) * 2u; voffB[i] = (unsigned)(Rb * K + C) * 2u; }
    const size_t kstep = (size_t)(BK * 2);
    const size_t hstep = (size_t)HALF * K * 2;
    const size_t tstep = 2 * hstep;
    const unsigned ldsw = (unsigned)wid * 1024u;
    const int aoff = lds_byte(wr * 64 + fr, fq * 8), boff = lds_byte(wc * 32 + fr, fq * 8);
#define PG8_SA(b, h) (((b) * 2 + (h)) * HTB)
#define PG8_SB(b, h) ((4 + (b) * 2 + (h)) * HTB)
#define PG8_STAGE(bufoff, gbase, voff) do { _Pragma("unroll") for (int _i = 0; _i < 2; ++_i) \
        __builtin_amdgcn_global_load_lds((const unsigned*)((const char*)(gbase) + (voff)[_i]), (PG8_LAS unsigned*)(lds + (bufoff) + ldsw + _i * 8192), 16, 0, 0); } while (0)
#define PG8_LDA(dst, b, h) do { _Pragma("unroll") for (int m = 0; m < 4; ++m) _Pragma("unroll") for (int k = 0; k < 2; ++k) dst[m][k] = *(const PG8_LAS bf16x8*)(lds + PG8_SA(b, h) + aoff + m * 2048 + k * 1024); } while (0)
#define PG8_LDB(dst, b, h) do { _Pragma("unroll") for (int n = 0; n < 2; ++n) _Pragma("unroll") for (int k = 0; k < 2; ++k) dst[n][k] = *(const PG8_LAS bf16x8*)(lds + PG8_SB(b, h) + boff + n * 2048 + k * 1024); } while (0)
#define PG8_MMA(ai, bj, At, Bt) do { __builtin_amdgcn_s_setprio(1); _Pragma("unroll") for (int m = 0; m < 4; ++m) _Pragma("unroll") for (int n = 0; n < 2; ++n) _Pragma("unroll") for (int k = 0; k < 2; ++k) \
        acc[ai][bj][m][n] = __builtin_amdgcn_mfma_f32_16x16x32_bf16(Bt[n][k], At[m][k], acc[ai][bj][m][n], 0, 0, 0); __builtin_amdgcn_s_setprio(0); } while (0)
#define PG8_WAIT_V(n) asm volatile("s_waitcnt vmcnt(" #n ")" ::: "memory")
#define PG8_WAIT_L(n) asm volatile("s_waitcnt lgkmcnt(" #n ")" ::: "memory")
#define PG8_BAR __builtin_amdgcn_s_barrier()
#define PG8_SCHED __builtin_amdgcn_sched_barrier(0)
    Unit cur, nxt; int ui = 0;
    if (!S.next(0, cur)) return;
    f32x4 acc[2][2][4][2];
#pragma unroll
    for (int a = 0; a < 2; ++a)
#pragma unroll
        for (int b = 0; b < 2; ++b)
#pragma unroll
            for (int m = 0; m < 4; ++m)
#pragma unroll
                for (int n = 0; n < 2; ++n) acc[a][b][m][n] = (f32x4){0.f, 0.f, 0.f, 0.f};
    bf16x8 At[4][2], B0[2][2], B1[2][2];
    const char* cA = (const char*)g.A + (size_t)cur.pm * tstep; const char* cB = (const char*)g.Bt + (size_t)cur.pn * tstep;
    S.a_ready(cur);
    if constexpr (SP2) {
        PG8_STAGE(PG8_SB(0, 0), cB, voffB); PG8_STAGE(PG8_SB(0, 1), cB + hstep, voffB); PG8_STAGE(PG8_SA(0, 0), cA, voffA); PG8_STAGE(PG8_SA(0, 1), cA + hstep, voffA);
        if (wr == 1) PG8_BAR;
        PG8_WAIT_V(2); PG8_BAR;
        PG8_STAGE(PG8_SB(1, 0), cB + kstep, voffB); PG8_STAGE(PG8_SA(1, 0), cA + kstep, voffA); PG8_STAGE(PG8_SB(1, 1), cB + hstep + kstep, voffB);
        PG8_WAIT_V(6); PG8_BAR;
    } else {
        PG8_STAGE(PG8_SB(0, 0), cB, voffB); PG8_STAGE(PG8_SA(0, 0), cA, voffA); PG8_STAGE(PG8_SB(0, 1), cB + hstep, voffB); PG8_STAGE(PG8_SA(0, 1), cA + hstep, voffA);
        if (wr == 1) PG8_BAR;
        PG8_WAIT_V(4); PG8_BAR;
        PG8_STAGE(PG8_SB(1, 0), cB + kstep, voffB); PG8_STAGE(PG8_SA(1, 0), cA + kstep, voffA); PG8_STAGE(PG8_SB(1, 1), cB + hstep + kstep, voffB);
        PG8_WAIT_V(6); PG8_BAR;
    }
    for (;;) {
        const bool has_next = S.next(ui + 1, nxt);
        const char* nA = has_next ? (const char*)g.A + (size_t)nxt.pm * tstep : cA; const char* nB = has_next ? (const char*)g.Bt + (size_t)nxt.pn * tstep : cB;
        for (int t = 0; t < nt; t += 2) {
            if constexpr (Epi::MID_T > 0) { if (t == Epi::MID_T) E.mid(acc, cur, wr, wc, fr, fq); }
            const bool last = (t == nt - 2);
            const char* a1 = cA + (size_t)(t + 1) * kstep;
            const char* a2 = last ? nA : cA + (size_t)(t + 2) * kstep; const char* b2 = last ? nB : cB + (size_t)(t + 2) * kstep;
            const char* a3 = a2 + kstep; const char* b3 = b2 + kstep;
            if (last && has_next) S.a_ready(nxt);
            if constexpr (SP2) {
            PG8_LDB(B0, 0, 0); PG8_LDB(B1, 0, 1); PG8_SCHED; PG8_LDA(At, 0, 0); PG8_STAGE(PG8_SA(1, 1), a1 + hstep, voffA);
            PG8_WAIT_V(8); PG8_WAIT_L(0); PG8_BAR; PG8_MMA(0, 0, At, B0); PG8_MMA(0, 1, At, B1); PG8_BAR; PG8_SCHED;
            PG8_LDA(At, 0, 1); PG8_STAGE(PG8_SB(0, 0), b2, voffB); PG8_STAGE(PG8_SB(0, 1), b2 + hstep, voffB); PG8_STAGE(PG8_SA(0, 0), a2, voffA);
            PG8_WAIT_V(8); PG8_WAIT_L(0); PG8_BAR; PG8_MMA(1, 0, At, B0); PG8_MMA(1, 1, At, B1); PG8_BAR; PG8_SCHED;
            PG8_LDB(B0, 1, 0); PG8_LDB(B1, 1, 1); PG8_SCHED; PG8_LDA(At, 1, 0); PG8_STAGE(PG8_SA(0, 1), a2 + hstep, voffA);
            PG8_WAIT_V(8); PG8_WAIT_L(0); PG8_BAR; PG8_MMA(0, 0, At, B0); PG8_MMA(0, 1, At, B1); PG8_BAR; PG8_SCHED;
            PG8_LDA(At, 1, 1); PG8_STAGE(PG8_SB(1, 0), b3, voffB); PG8_STAGE(PG8_SB(1, 1), b3 + hstep, voffB); PG8_STAGE(PG8_SA(1, 0), a3, voffA);
            PG8_WAIT_V(8); PG8_WAIT_L(0); PG8_BAR; PG8_MMA(1, 0, At, B0); PG8_MMA(1, 1, At, B1); PG8_BAR; PG8_SCHED;
            } else {
            PG8_LDB(B0, 0, 0); PG8_SCHED; PG8_LDA(At, 0, 0); PG8_STAGE(PG8_SA(1, 1), a1 + hstep, voffA);
            PG8_WAIT_L(8); PG8_BAR; PG8_WAIT_L(0); PG8_MMA(0, 0, At, B0); PG8_BAR; PG8_SCHED;
            PG8_LDB(B1, 0, 1); PG8_STAGE(PG8_SB(0, 0), b2, voffB);
            PG8_BAR; PG8_WAIT_L(0); PG8_MMA(0, 1, At, B1); PG8_BAR;
            PG8_LDA(At, 0, 1); PG8_STAGE(PG8_SA(0, 0), a2, voffA);
            PG8_BAR; PG8_WAIT_L(0); PG8_MMA(1, 0, At, B0); PG8_BAR; PG8_SCHED;
            PG8_STAGE(PG8_SB(0, 1), b2 + hstep, voffB);
            PG8_WAIT_V(6); PG8_BAR; PG8_MMA(1, 1, At, B1); PG8_BAR;
            PG8_LDB(B0, 1, 0); PG8_SCHED; PG8_LDA(At, 1, 0); PG8_STAGE(PG8_SA(0, 1), a2 + hstep, voffA);
            PG8_WAIT_L(8); PG8_BAR; PG8_WAIT_L(0); PG8_MMA(0, 0, At, B0); PG8_BAR; PG8_SCHED;
            PG8_LDB(B1, 1, 1); PG8_STAGE(PG8_SB(1, 0), b3, voffB);
            PG8_BAR; PG8_WAIT_L(0); PG8_MMA(0, 1, At, B1); PG8_BAR;
            PG8_LDA(At, 1, 1); PG8_STAGE(PG8_SA(1, 0), a3, voffA);
            PG8_BAR; PG8_WAIT_L(0); PG8_MMA(1, 0, At, B0); PG8_BAR; PG8_SCHED;
            PG8_STAGE(PG8_SB(1, 1), b3 + hstep, voffB);
            PG8_WAIT_V(6); PG8_BAR; PG8_MMA(1, 1, At, B1); PG8_BAR;
            }
        }
        if constexpr (ALIGN_EPI) { if (wr == 0) PG8_BAR; }
        if constexpr (!Epi::AFTER_DRAIN) { E(acc, cur, wr, wc, fr, fq); S.done(cur); }
        if (!has_next) break;
#pragma unroll
        for (int a = 0; a < 2; ++a)
#pragma unroll
            for (int b = 0; b < 2; ++b)
#pragma unroll
                for (int m = 0; m < 4; ++m)
#pragma unroll
                    for (int n = 0; n < 2; ++n) acc[a][b][m][n] = (f32x4){0.f, 0.f, 0.f, 0.f};
        cur = nxt; cA = nA; cB = nB; ++ui;
        if constexpr (ALIGN_EPI) { if (wr == 1) PG8_BAR; }
    }
    PG8_WAIT_V(0);
    if constexpr (!ALIGN_EPI) { if (wr == 0) PG8_BAR; }
    PG8_BAR;
    if constexpr (Epi::AFTER_DRAIN) { E.fused(acc, cur, wr, wc, fr, fq, lds, wid, lane); S.done(cur); }
#undef PG8_SA
#undef PG8_SB
#undef PG8_STAGE
#undef PG8_LDA
#undef PG8_LDB
#undef PG8_MMA
#undef PG8_WAIT_V
#undef PG8_WAIT_L
#undef PG8_BAR
#undef PG8_SCHED
}
}
#ifndef PG8_SP2
#define PG8_SP2 true
#endif
#ifndef PG8_ALIGN
#define PG8_ALIGN true
#endif
namespace attn_body {
using bf16=__hip_bfloat16;
using bf16x8=__attribute__((ext_vector_type(8)))short;
using s16x4=__attribute__((ext_vector_type(4)))short;
using f32x16=__attribute__((ext_vector_type(16)))float;
using u32x4=__attribute__((ext_vector_type(4)))unsigned;
using f32x4v=__attribute__((ext_vector_type(4)))float;
constexpr int BATCH=4,NHEAD=8,SEQ=4096,D=64,DM=NHEAD*D,DMO=1024;
constexpr int NW=8,QBLK=32,QB=QBLK*NW,KVBLK=64,NQB=SEQ/QB;
constexpr int ATTN_PITCH=DM, ATTN_UNIT_ROWS=QB;
__device__ __forceinline__ int crow(int r,int hi){return (r&3)+8*(r>>2)+4*hi;}
#define SBAR() __builtin_amdgcn_sched_barrier(0)
__device__ __forceinline__ void cmask(f32x16&p0,f32x16&p1,int jb,int qrel,int hi){
  const float NEG=-INFINITY; int kb=64*jb+4*hi;
  #pragma unroll
  for(int r=0;r<16;++r){int kv=kb+(r&3)+8*(r>>2); if(kv>qrel)p0[r]=NEG; if(kv+32>qrel)p1[r]=NEG;}
}

constexpr int NSLOT=3, SLOTB=8192;
constexpr int LDS_K=0, LDS_V=NSLOT*SLOTB, LDS_WS=2*NSLOT*SLOTB, LDS_OST=LDS_WS+NW*64*4, LDS_CS=LDS_OST+NW*4096, LDS_BYTES=LDS_CS+SEQ*4+64;
constexpr float C2=0.125f*1.4426950408889634f;
__device__ __forceinline__ void glds16(const void*gsrc,unsigned lds_dst){unsigned keep;
  asm volatile("s_mov_b32 %0, m0\n\ts_mov_b32 m0, %2\n\ts_nop 0\n\tglobal_load_lds_dwordx4 %1, off\n\ts_mov_b32 m0, %0":"=&s"(keep):"v"(gsrc),"s"(lds_dst):"memory");}
__device__ __forceinline__ float max3f(float a,float b,float c){float r;asm("v_max3_f32 %0, %1, %2, %3":"=v"(r):"v"(a),"v"(b),"v"(c));return r;}
__device__ __forceinline__ float max2f(float a,float b){float r;asm("v_max_f32_e32 %0, %1, %2":"=v"(r):"v"(a),"v"(b));return r;}
__device__ __forceinline__ float fadd_s(float a,float b){float r;asm("v_add_f32_e32 %0, %1, %2":"=v"(r):"v"(a),"v"(b));return r;}
__device__ __forceinline__ float fsub_s(float a,float b){float r;asm("v_sub_f32_e32 %0, %1, %2":"=v"(r):"v"(a),"v"(b));return r;}
typedef float f32x2_t __attribute__((ext_vector_type(2))); typedef __bf16 bf16x2_t __attribute__((ext_vector_type(2)));
__device__ __forceinline__ unsigned cvtpk_s(float lo,float hi){f32x2_t v={lo,hi};bf16x2_t b=__builtin_convertvector(v,bf16x2_t);return __builtin_bit_cast(unsigned,b);}
#define WAIT_BAR(N) asm volatile("s_waitcnt vmcnt(" #N ") lgkmcnt(0)\n\ts_barrier":::"memory")

__device__ __forceinline__ void qkt(f32x16&p0,f32x16&p1,const char*Kslot,const bf16x8*qr,const f32x16&c0,const f32x16&c1,int r32,int hi){
  const char*kb=Kslot+hi*1024+r32*16;
  #pragma unroll
  for(int d0=0;d0<4;++d0){
    const bf16x8 b0=*reinterpret_cast<const bf16x8*>(kb+d0*2048);
    const bf16x8 b1=*reinterpret_cast<const bf16x8*>(kb+d0*2048+512);
    if(d0==0){p0=__builtin_amdgcn_mfma_f32_32x32x16_bf16(b0,qr[0],c0,0,0,0);p1=__builtin_amdgcn_mfma_f32_32x32x16_bf16(b1,qr[0],c1,0,0,0);}
    else{p0=__builtin_amdgcn_mfma_f32_32x32x16_bf16(b0,qr[d0],p0,0,0,0);p1=__builtin_amdgcn_mfma_f32_32x32x16_bf16(b1,qr[d0],p1,0,0,0);}}
}
typedef __attribute__((address_space(3))) const char* lds_cptr;
typedef short v4i16_t __attribute__((ext_vector_type(4)));
__device__ __forceinline__ void kload8(bf16x8*kf,lds_cptr kp){
  kf[0]=*(const __attribute__((address_space(3))) bf16x8*)(kp);      kf[1]=*(const __attribute__((address_space(3))) bf16x8*)(kp+512);
  kf[2]=*(const __attribute__((address_space(3))) bf16x8*)(kp+2048); kf[3]=*(const __attribute__((address_space(3))) bf16x8*)(kp+2560);
  kf[4]=*(const __attribute__((address_space(3))) bf16x8*)(kp+4096); kf[5]=*(const __attribute__((address_space(3))) bf16x8*)(kp+4608);
  kf[6]=*(const __attribute__((address_space(3))) bf16x8*)(kp+6144); kf[7]=*(const __attribute__((address_space(3))) bf16x8*)(kp+6656);
}
__device__ __forceinline__ void kload2(bf16x8*kf,lds_cptr kp,int j){ kf[2*j]=*(const __attribute__((address_space(3))) bf16x8*)(kp+j*2048); kf[2*j+1]=*(const __attribute__((address_space(3))) bf16x8*)(kp+j*2048+512); }
__device__ __forceinline__ s16x4 vtr(lds_cptr p){ return __builtin_bit_cast(s16x4,__builtin_amdgcn_ds_read_tr16_b64_v4i16((__attribute__((address_space(3))) v4i16_t*)p)); }
__device__ __forceinline__ float rowmax(const f32x16&p0,const f32x16&p1){
  float a=max3f(p0[0],p0[1],p1[0]),b=max3f(p0[2],p0[3],p1[1]);a=max3f(a,p1[2],p1[3]);
  #pragma unroll
  for(int r=4;r<16;r+=4){a=max3f(a,p0[r],p0[r+1]);b=max3f(b,p0[r+2],p0[r+3]);a=max3f(a,p1[r],p1[r+1]);b=max3f(b,p1[r+2],p1[r+3]);}
  const float m=max2f(a,b);
  auto rr=__builtin_amdgcn_permlane32_swap(__float_as_uint(m),__float_as_uint(m),false,false);
  return max2f(__uint_as_float(rr[0]),__uint_as_float(rr[1]));
}
__device__ __forceinline__ void pv(f32x16*o,int vb,bf16x8 pa0,bf16x8 pa1,bf16x8 pa2,bf16x8 pa3){
  #pragma unroll
  for(int d0=0;d0<2;++d0){s16x4 lo[4],hi[4];
    #pragma unroll
    for(int ks=0;ks<4;++ks){
      asm volatile("ds_read_b64_tr_b16 %0,%1 offset:%c2":"=&v"(lo[ks]):"v"(vb),"i"(d0*4096+ks*1024):"memory");
      asm volatile("ds_read_b64_tr_b16 %0,%1 offset:%c2":"=&v"(hi[ks]):"v"(vb),"i"(d0*4096+ks*1024+512):"memory");}
    asm volatile("s_waitcnt lgkmcnt(0)":::"memory");SBAR();
    #define PK(k) (bf16x8){lo[k][0],lo[k][1],lo[k][2],lo[k][3],hi[k][0],hi[k][1],hi[k][2],hi[k][3]}
    o[d0]=__builtin_amdgcn_mfma_f32_32x32x16_bf16(pa0,PK(0),o[d0],0,0,0);
    o[d0]=__builtin_amdgcn_mfma_f32_32x32x16_bf16(pa1,PK(1),o[d0],0,0,0);
    o[d0]=__builtin_amdgcn_mfma_f32_32x32x16_bf16(pa2,PK(2),o[d0],0,0,0);
    o[d0]=__builtin_amdgcn_mfma_f32_32x32x16_bf16(pa3,PK(3),o[d0],0,0,0);
    #undef PK
  }
}

#ifndef ATTN_STORE16
#define ATTN_STORE16(p,v) (*(u32x4*)(p)=(v))
#endif
template<int THRL> __device__ __forceinline__ void attn_unit(int b,int h,int qb,const bf16*Q,const bf16*__restrict__ K,const bf16*__restrict__ V,bf16*O,const float*__restrict__ LFrow,char*shm){
  const int tid=threadIdx.x,lane=tid&63,r32=lane&31,hi=lane>>5; const int wid=__builtin_amdgcn_readfirstlane(tid>>6);
  const long rowbase=(long)b*SEQ; const int q0=qb*QB;
  const bf16*Qw=Q+(rowbase+q0+wid*QBLK)*DM+h*D;
  const bf16*Kh=K+rowbase*DM+h*D,*Vh=V+rowbase*DM+h*D;
  const lds_cptr shm3=(lds_cptr)shm;
  const unsigned lds0=(unsigned)(uintptr_t)shm;
  float*wsf=(float*)(shm+LDS_WS)+wid*64;
  const bf16*ksrc=Kh+(long)lane*DM+wid*8;
  const bf16*vsrc=Vh+(long)(16*(wid&3)+(lane>>2))*DM+(wid>>2)*32+(lane&3)*8;
  const unsigned kdst=lds0+LDS_K+wid*1024, vdst=lds0+LDS_V+wid*1024;
  #define DMA_K(t,slot) glds16(ksrc+(long)(t)*KVBLK*DM,(unsigned)__builtin_amdgcn_readfirstlane(kdst+(slot)))
  #define DMA_V(t,slot) glds16(vsrc+(long)(t)*KVBLK*DM,(unsigned)__builtin_amdgcn_readfirstlane(vdst+(slot)))
  const int vb0=(int)(lds0+LDS_V)+((lane>>4)&1)*32+(lane&3)*8+(4*hi+((lane&15)>>2))*64;
  const char*Kbase=shm+LDS_K; bf16x8 kf[8];
  const lds_cptr kp0=shm3+LDS_K+hi*1024+r32*16; const lds_cptr vp0=shm3+LDS_V+((lane>>4)&1)*32+(lane&3)*8+(4*hi+((lane&15)>>2))*64;
  const int NT=(q0+QB)/KVBLK;
  typedef __attribute__((address_space(3))) float lds_f32; typedef __attribute__((address_space(3))) f32x4v lds_f32x4;
  lds_f32* const csl=(lds_f32*)(shm3+LDS_CS);
  { const int ncs=q0+QB, i0=tid*8; f32x4v ca={0.f,0.f,0.f,0.f},cb={0.f,0.f,0.f,0.f};
    if(i0<ncs){ca=*(const f32x4v*)(LFrow+i0);cb=*(const f32x4v*)(LFrow+i0+4);}
    ca.y+=ca.x;ca.z+=ca.y;ca.w+=ca.z;cb.x+=ca.w;cb.y+=cb.x;cb.z+=cb.y;cb.w+=cb.z;
    const float tot=cb.w; float inc=tot;
    _Pragma("unroll") for(int o_=1;o_<64;o_<<=1){const float v_=__shfl_up(inc,o_);if(lane>=o_)inc+=v_;}
    if(lane==63)csl[SEQ+wid]=inc;
    asm volatile("s_waitcnt vmcnt(0) lgkmcnt(0)\n\ts_barrier":::"memory");
    float base_=inc-tot;
    _Pragma("unroll") for(int w_=0;w_<NW;++w_){const float t_=csl[SEQ+w_];if(w_<wid)base_+=t_;}
    if(i0<ncs){*(lds_f32x4*)(csl+i0)=ca+base_;*(lds_f32x4*)(csl+i0+4)=cb+base_;}
    asm volatile("s_waitcnt vmcnt(0) lgkmcnt(0)\n\ts_barrier":::"memory"); }
  const float cq=csl[q0+wid*QBLK+r32];
  const lds_cptr csb=shm3+LDS_CS+hi*16;
  #define CINIT(C0,C1,t) do{ _Pragma("unroll") for(int g_=0;g_<4;++g_){ const f32x4v a_=*(const lds_f32x4*)(csb+(t)*256+g_*32), b_=*(const lds_f32x4*)(csb+(t)*256+128+g_*32); \
      C0[4*g_]=cqm-a_.x;C0[4*g_+1]=cqm-a_.y;C0[4*g_+2]=cqm-a_.z;C0[4*g_+3]=cqm-a_.w; C1[4*g_]=cqm-b_.x;C1[4*g_+1]=cqm-b_.y;C1[4*g_+2]=cqm-b_.z;C1[4*g_+3]=cqm-b_.w; } }while(0)
  DMA_K(0,0);DMA_V(0,0);DMA_K(1,SLOTB);
  bf16x8 qr[4];
  #pragma unroll
  for(int d0=0;d0<4;++d0)qr[d0]=*reinterpret_cast<const bf16x8*>(&Qw[(long)r32*DM+d0*16+hi*8]);
  float mhat=0.f,l_reg=0.f,cqm=cq;f32x16 o[2];o[0]=f32x16{};o[1]=f32x16{};
  const int qrel=wid*QBLK+r32;
  #define CMASK(P0,P1,t) do{int jb_=(t)-(NT-4); if(jb_>=0)cmask(P0,P1,jb_,qrel,hi);}while(0)
  bool resc=false;
  #define START(P0,P1) do{ const float rm=rowmax(P0,P1); resc=false; \
    { const float dl=rm; mhat=fadd_s(mhat,dl); \
      _Pragma("unroll") for(int r=0;r<16;++r){P0[r]=fsub_s(P0[r],dl);P1[r]=fsub_s(P1[r],dl);} \
      cqm=cq-mhat; } \
    _Pragma("unroll") for(int r=0;r<16;++r)P0[r]=__builtin_amdgcn_exp2f(P0[r]); }while(0)
  #define RESC() do{ if(resc){ asm volatile("s_waitcnt lgkmcnt(0)":::"memory"); \
      _Pragma("unroll") for(int d_=0;d_<2;++d_) _Pragma("unroll") for(int r=0;r<16;++r)o[d_][r]*=wsf[crow(r,hi)]; } }while(0)
  f32x16 pA0,pA1,pB0,pB1;
  int sl_prev=0,sl_cur=0,sl_next=SLOTB;
  #define ROT() do{sl_prev=sl_cur;sl_cur=sl_next;sl_next=(sl_next==(NSLOT-1)*SLOTB)?0:sl_next+SLOTB;}while(0)
  DMA_K(2,2*SLOTB);
  WAIT_BAR(3);
  { f32x16 ci0,ci1; CINIT(ci0,ci1,0); qkt(pA0,pA1,Kbase,qr,ci0,ci1,r32,hi); } asm volatile("s_nop 15\n\ts_nop 7":"+v"(pA0),"+v"(pA1));CMASK(pA0,pA1,0);
  START(pA0,pA1);
  _Pragma("unroll") for(int r=0;r<16;++r)pA1[r]=__builtin_amdgcn_exp2f(pA1[r]);
  WAIT_BAR(0);
  DMA_K(3,0);DMA_V(1,SLOTB);
  ROT();
  kload8(kf,kp0+sl_cur);
  WAIT_BAR(2);
  s16x4 vlo[8],vhi[8]; u32x4 pw0,pw1,pw2,pw3;
  #define PKW(P,B) cvtpk_s(P[B],P[B+1])
  #define PAF(k) __builtin_bit_cast(bf16x8,pw##k)
  #define VFR(i) (bf16x8){vlo[i][0],vlo[i][1],vlo[i][2],vlo[i][3],vhi[i][0],vhi[i][1],vhi[i][2],vhi[i][3]}
  #define PIN(x) asm volatile("":"+v"(x))
  #define MX3(a,b,c) __builtin_fmaxf(__builtin_fmaxf((a),(b)),(c))
  #define GAPA(MF,A0,A1,A2,A3,W0,W1,PW) do{ MF; sacc+=A0; sacc+=A1; sacc+=A2; sacc+=A3; PIN(sacc); W0; W1; PIN(PW); SBAR(); }while(0)
  #define EX(v) __builtin_amdgcn_exp2f(v)
  #define GAPB(MF,X,B) do{ MF; X[B]=EX(X[B]); X[B+1]=EX(X[B+1]); X[B+2]=EX(X[B+2]); X[B+3]=EX(X[B+3]); PIN(X); SBAR(); }while(0)
  #define VRD(i) do{ vlo[i]=vtr(vp_+(((i)>>2)*4096+((i)&3)*1024)); vhi[i]=vtr(vp_+(((i)>>2)*4096+((i)&3)*1024+512)); }while(0)
  #define KRD(G,j) do{ if(G){ kload2(kf,kp0+sl_next,j); SBAR(); } }while(0)
  #define STEP(C0,C1,P0,P1,t,GK,GV,GL) do{ SBAR(); \
    CINIT(C0,C1,t); SBAR(); \
    const lds_cptr vp_=vp0+sl_prev; \
    VRD(0); SBAR(); float sacc=(P0[0]+P0[1]); \
    GAPA(C0=__builtin_amdgcn_mfma_f32_32x32x16_bf16(kf[0],qr[0],C0,0,0,0), P0[2],P0[3],P0[4],P0[5],     pw0[0]=PKW(P0,0), pw0[1]=PKW(P0,2), pw0); \
    VRD(4); SBAR(); GAPA(C1=__builtin_amdgcn_mfma_f32_32x32x16_bf16(kf[1],qr[0],C1,0,0,0), P0[6],P0[7],P0[8],P0[9],     pw0[2]=PKW(P0,4), pw0[3]=PKW(P0,6), pw0); \
    VRD(1); SBAR(); GAPA(C0=__builtin_amdgcn_mfma_f32_32x32x16_bf16(kf[2],qr[1],C0,0,0,0),   P0[10],P0[11],P0[12],P0[13], pw1[0]=PKW(P0,8), pw1[1]=PKW(P0,10), pw1); \
    VRD(5); SBAR(); GAPA(C1=__builtin_amdgcn_mfma_f32_32x32x16_bf16(kf[3],qr[1],C1,0,0,0),   P0[14],P0[15],P1[0],P1[1],   pw1[2]=PKW(P0,12),pw1[3]=PKW(P0,14), pw1); \
    VRD(2); SBAR(); GAPA(C0=__builtin_amdgcn_mfma_f32_32x32x16_bf16(kf[4],qr[2],C0,0,0,0),   P1[2],P1[3],P1[4],P1[5],     pw2[0]=PKW(P1,0), pw2[1]=PKW(P1,2), pw2); \
    VRD(6); SBAR(); GAPA(C1=__builtin_amdgcn_mfma_f32_32x32x16_bf16(kf[5],qr[2],C1,0,0,0),   P1[6],P1[7],P1[8],P1[9],     pw2[2]=PKW(P1,4), pw2[3]=PKW(P1,6), pw2); \
    VRD(3); SBAR(); GAPA(C0=__builtin_amdgcn_mfma_f32_32x32x16_bf16(kf[6],qr[3],C0,0,0,0),   P1[10],P1[11],P1[12],P1[13], pw3[0]=PKW(P1,8), pw3[1]=PKW(P1,10), pw3); \
    VRD(7); SBAR(); GAPA(C1=__builtin_amdgcn_mfma_f32_32x32x16_bf16(kf[7],qr[3],C1,0,0,0),   P1[14],P1[15],0.f,0.f,       pw3[2]=PKW(P1,12),pw3[3]=PKW(P1,14), pw3); \
    l_reg+=sacc; \
    if(GK){DMA_K((t)+3,sl_cur);} if(GV){DMA_V((t)+1,sl_next);} \
    CMASK(C0,C1,t); \
    { float a=MX3(C0[0],C0[1],C1[0]),b=MX3(C0[2],C0[3],C1[1]); a=MX3(a,C1[2],C1[3]); \
      _Pragma("unroll") for(int r=4;r<16;r+=4){a=MX3(a,C0[r],C0[r+1]);b=MX3(b,C0[r+2],C0[r+3]);a=MX3(a,C1[r],C1[r+1]);b=MX3(b,C1[r+2],C1[r+3]);} \
      float rm=__builtin_fmaxf(a,b); { auto rr=__builtin_amdgcn_permlane32_swap(__float_as_uint(rm),__float_as_uint(rm),false,false); rm=__builtin_fmaxf(__uint_as_float(rr[0]),__uint_as_float(rr[1])); } \
      resc=false; \
      if(__builtin_expect(__any(rm>(float)THRL),0)){ const float dl=__builtin_fmaxf(rm,0.f); mhat+=dl; \
        _Pragma("unroll") for(int r=0;r<16;++r){C0[r]-=dl;C1[r]-=dl;} \
        cqm=cq-mhat; \
        const float f=__builtin_amdgcn_exp2f(-dl); l_reg*=f; if(hi==0)wsf[r32]=f; resc=true; } } \
    SBAR(); \
    GAPB(o[0]=__builtin_amdgcn_mfma_f32_32x32x16_bf16(PAF(0),VFR(0),o[0],0,0,0), C0,0); \
    GAPB(o[1]=__builtin_amdgcn_mfma_f32_32x32x16_bf16(PAF(0),VFR(4),o[1],0,0,0), C0,4); \
    KRD(GL,0); GAPB(o[0]=__builtin_amdgcn_mfma_f32_32x32x16_bf16(PAF(1),VFR(1),o[0],0,0,0), C0,8); \
    KRD(GL,1); GAPB(o[1]=__builtin_amdgcn_mfma_f32_32x32x16_bf16(PAF(1),VFR(5),o[1],0,0,0), C0,12); \
    KRD(GL,2); GAPB(o[0]=__builtin_amdgcn_mfma_f32_32x32x16_bf16(PAF(2),VFR(2),o[0],0,0,0), C1,0); \
    KRD(GL,3); GAPB(o[1]=__builtin_amdgcn_mfma_f32_32x32x16_bf16(PAF(2),VFR(6),o[1],0,0,0), C1,4); \
    GAPB(o[0]=__builtin_amdgcn_mfma_f32_32x32x16_bf16(PAF(3),VFR(3),o[0],0,0,0), C1,8); \
    GAPB(o[1]=__builtin_amdgcn_mfma_f32_32x32x16_bf16(PAF(3),VFR(7),o[1],0,0,0), C1,12); \
    }while(0)
  int t=1;
  #undef CMASK
  #define CMASK(P0,P1,t) do{}while(0)
  for(;t+5<NT;t+=2){
    STEP(pB0,pB1,pA0,pA1,t,true,true,true);     WAIT_BAR(2); RESC(); ROT();
    STEP(pA0,pA1,pB0,pB1,t+1,true,true,true);   WAIT_BAR(2); RESC(); ROT();
  }
  #undef CMASK
  #define CMASK(P0,P1,t) do{int jb_=(t)-(NT-4); if(jb_>=0)cmask(P0,P1,jb_,qrel,hi);}while(0)
  #define ENDW(tt) do{ if((tt)+3<NT){WAIT_BAR(2);} else if((tt)+2<NT){WAIT_BAR(1);} else {WAIT_BAR(0);} }while(0)
  for(;t+1<NT;t+=2){
    STEP(pB0,pB1,pA0,pA1,t,(t+3<NT),(t+1<NT),(t+1<NT));       ENDW(t);   RESC(); ROT();
    STEP(pA0,pA1,pB0,pB1,t+1,(t+4<NT),(t+2<NT),(t+2<NT));     ENDW(t+1); RESC(); ROT();
  }
  STEP(pB0,pB1,pA0,pA1,NT-1,false,false,false); RESC();
  { float sacc=pB0[0]+pB0[1]; _Pragma("unroll") for(int r=2;r<16;++r)sacc+=pB0[r]; _Pragma("unroll") for(int r=0;r<16;++r)sacc+=pB1[r]; l_reg+=sacc;
    pw0=(u32x4){PKW(pB0,0),PKW(pB0,2),PKW(pB0,4),PKW(pB0,6)};pw1=(u32x4){PKW(pB0,8),PKW(pB0,10),PKW(pB0,12),PKW(pB0,14)};pw2=(u32x4){PKW(pB1,0),PKW(pB1,2),PKW(pB1,4),PKW(pB1,6)};pw3=(u32x4){PKW(pB1,8),PKW(pB1,10),PKW(pB1,12),PKW(pB1,14)};
    SBAR(); pv(o,vb0+sl_cur,PAF(0),PAF(1),PAF(2),PAF(3)); }
  #undef PKW
  #undef PAF
  #undef VFR
  #undef PIN
  #undef MX3
  #undef GAPA
  #undef GAPB
  #undef EX
  #undef VRD
  #undef KRD
  #undef STEP
  #undef ENDW
  {auto rr=__builtin_amdgcn_permlane32_swap(__float_as_uint(l_reg),__float_as_uint(l_reg),false,false);l_reg=__uint_as_float(rr[0])+__uint_as_float(rr[1]);}
  if(hi==0)wsf[32+r32]=l_reg;asm volatile("s_waitcnt lgkmcnt(0)":::"memory");
  float rli[16];
  #pragma unroll
  for(int r=0;r<16;++r)rli[r]=__builtin_amdgcn_rcpf(wsf[32+crow(r,hi)]);
  bf16*Ow=O+(rowbase+q0+wid*QBLK)*DMO+h*D;
  { bf16*stg=(bf16*)(shm+LDS_OST)+wid*2048;
    #pragma unroll
    for(int r=0;r<16;++r){const int orow=crow(r,hi);
      #pragma unroll
      for(int d0=0;d0<2;++d0)stg[orow*64+d0*32+r32]=__float2bfloat16(o[d0][r]*rli[r]);}
    asm volatile("s_waitcnt lgkmcnt(0)":::"memory");
    #pragma unroll
    for(int i=0;i<4;++i){const int row=i*8+(lane>>3),ch=lane&7; const u32x4 v=*(const u32x4*)(stg+row*64+ch*8); ATTN_STORE16(Ow+(long)row*DMO+ch*8,v);} }
  asm volatile("s_waitcnt lgkmcnt(0)\n\ts_barrier":::"memory");
  #undef DMA_K
  #undef DMA_V
  #undef CMASK
  #undef START
  #undef RESC
  #undef ROT
  #undef CINIT
}
constexpr int ATTN_LDS_BYTES=LDS_BYTES;
struct AttnTensors { const bf16* Q; const bf16* K; const bf16* V; bf16* O; const float* LF; };
struct AttnUnit { int bh; int qb; };
struct StaticOrder {
  int vcu, G;
  __device__ __forceinline__ StaticOrder(int grid,int vcu_):vcu(vcu_),G(grid){}
  __device__ __forceinline__ bool next(int i,AttnUnit&u)const{
    if(G==256){ if(i>=2)return false; const int s=vcu&7; u.bh=vcu>>3; u.qb=(i==0)?15-s:s; return true; }
    const int idx=i*G+vcu; if(idx>=BATCH*NHEAD*NQB)return false; u.qb=NQB-1-idx/(BATCH*NHEAD); u.bh=idx%(BATCH*NHEAD); return true; }
  __device__ __forceinline__ void a_ready(const AttnUnit&)const{}
  __device__ __forceinline__ void done(const AttnUnit&)const{}
};
template<class Sched,int THRL=8> __device__ __forceinline__ void attn_phase(char*lds,const AttnTensors&T,const Sched&S){
  AttnUnit u;
  for(int i=0;S.next(i,u);++i){ S.a_ready(u); attn_unit<THRL>(u.bh/NHEAD,u.bh%NHEAD,u.qb,T.Q,T.K,T.V,T.O,T.LF+(size_t)u.bh*SEQ,lds); S.done(u); }
}
#undef SBAR
#undef WAIT_BAR
}
#define GAS __attribute__((address_space(1)))
#define LAS __attribute__((address_space(3)))
typedef unsigned short bf16;
typedef unsigned v4u __attribute__((ext_vector_type(4)));
typedef float f32x4 __attribute__((ext_vector_type(4)));
typedef short bf16x8 __attribute__((ext_vector_type(8)));
typedef GAS unsigned gu32;
typedef GAS unsigned long long gu64;
#define RLX_AGENT __ATOMIC_RELAXED, __HIP_MEMORY_SCOPE_AGENT
#define LDS_WAIT() asm volatile("s_waitcnt lgkmcnt(0)" ::: "memory")
#define VM_WAIT() asm volatile("s_waitcnt vmcnt(0)" ::: "memory")
__device__ __forceinline__ unsigned long long rt() { return __builtin_amdgcn_s_memrealtime(); }
__device__ __forceinline__ unsigned f2bf(float f) { unsigned u = __builtin_bit_cast(unsigned, f); return (u + 0x7fffu + ((u >> 16) & 1u)) >> 16; }
__device__ __forceinline__ unsigned pk2(float lo, float hi) { return f2bf(lo) | (f2bf(hi) << 16); }

#define XB_TMO      128
#define XB_XCNT(j)  (256  + 64 * (j))
#define XB_XSUB(j)  (1280 + 64 * (j))
#define XB_XGEN(j)  (2304 + 64 * (j))
#define XB_TOP      3328
#define XB_TOPGEN   3392
#define XCD_BAR_WORDS 3456
#define XB_SPIN_CAP (1u << 18)

__device__ __forceinline__ unsigned xb_ld(unsigned* p)              { return __hip_atomic_load(p, __ATOMIC_RELAXED, __HIP_MEMORY_SCOPE_AGENT); }
__device__ __forceinline__ unsigned xb_add(unsigned* p, unsigned v) { return __hip_atomic_fetch_add(p, v, __ATOMIC_RELAXED, __HIP_MEMORY_SCOPE_AGENT); }
__device__ __forceinline__ unsigned xb_xcc_id() { return (unsigned)__builtin_amdgcn_s_getreg((3 << 11) | 20) & 0xFu; }
#define XB_SPIN(cond, bar) do { unsigned _sp = 0; while (cond) { __builtin_amdgcn_s_sleep(1); \
    if ((++_sp & 255u) == 0u) { if (xb_ld(&(bar)[XB_TMO])) break; if (_sp > XB_SPIN_CAP) { atomicAdd(&(bar)[XB_TMO], 1u); break; } } } } while (0)

struct XcdBarrier {
    unsigned* bar; unsigned x;
    volatile LAS unsigned* st;
};

__device__ __forceinline__ XcdBarrier xcd_barrier_post(unsigned* bar, volatile LAS unsigned* st) {
    XcdBarrier b; b.bar = bar; b.x = xb_xcc_id(); b.st = st;
    if (threadIdx.x == 0) (void)xb_add(&bar[XB_XCNT(b.x)], 1u);
    return b;
}
__device__ __forceinline__ void xcd_barrier_complete(unsigned* bar, unsigned x, unsigned& nloc, unsigned& nx) {
    const unsigned G = gridDim.x * gridDim.y * gridDim.z;
    unsigned sum, cnt, mine, sp = 0u;
    for (;;) {
        sum = 0u; cnt = 0u; mine = 0u;
#pragma unroll
        for (unsigned j = 0; j < 16; ++j) { const unsigned c = xb_ld(&bar[XB_XCNT(j)]); sum += c; cnt += (c > 0u) ? 1u : 0u; mine = (j == x) ? c : mine; }
        if (sum == G) break;
        __builtin_amdgcn_s_sleep(1);
        if ((++sp & 255u) == 0u) { if (xb_ld(&bar[XB_TMO])) break; if (sp > XB_SPIN_CAP) { atomicAdd(&bar[XB_TMO], 1u); break; } }
    }
    nloc = mine > 0u ? mine : 1u; nx = cnt > 0u ? cnt : 1u;
}

__device__ __forceinline__ void xcd_barrier(const XcdBarrier& b) {
    asm volatile("s_waitcnt vmcnt(0)" ::: "memory");
    __syncthreads();
    if (threadIdx.x == 0) {
        unsigned* bar = b.bar;
        __builtin_amdgcn_s_waitcnt(0);
        unsigned nloc = b.st[0], nx = b.st[1];
        if (nloc == 0u) { xcd_barrier_complete(bar, b.x, nloc, nx); b.st[0] = nloc; b.st[1] = nx; }
        const unsigned old = xb_add(&bar[XB_XSUB(b.x)], 1u);
        const unsigned gen = old / nloc;
        if (old + 1u == (gen + 1u) * nloc) {
            __builtin_amdgcn_fence(__ATOMIC_RELEASE, "agent");
            asm volatile("s_waitcnt vmcnt(0)" ::: "memory");
            const unsigned og = xb_add(&bar[XB_TOP], 1u);
            const unsigned tg = og / nx;
            if (og + 1u == (tg + 1u) * nx) xb_add(&bar[XB_TOPGEN], 1u);
            else XB_SPIN(xb_ld(&bar[XB_TOPGEN]) == tg, bar);
            __builtin_amdgcn_fence(__ATOMIC_ACQUIRE, "agent");
            xb_add(&bar[XB_XGEN(b.x)], 1u);
            asm volatile("s_waitcnt vmcnt(0)" ::: "memory");
        } else {
            XB_SPIN(xb_ld(&bar[XB_XGEN(b.x)]) == gen, bar);
            __builtin_amdgcn_fence(__ATOMIC_ACQUIRE, "agent");
            asm volatile("s_waitcnt vmcnt(0)" ::: "memory");
        }
    }
    __syncthreads();
}

constexpr int NWAVES = 8;
constexpr int BATCH = 4, SEQ = 4096, D = 1024, M = BATCH * SEQ, NH = 8, HD = 64, AW = 512, PLE = 256;
constexpr int NIN = 5120, INTOT = 5128, NKEYS = 128, NEXP = 16384, NS = 2048;
constexpr float EPS = 1e-6f, LOG2E = 1.4426950408889634f, C2 = 0.125f * LOG2E;
constexpr int NPHASE = 9;
constexpr int SLW = 64, NSL = D / SLW;
static_assert(NSL % 8 == 0 && NSL <= 16, "slices are dealt to 8 XCD groups; SS3 has 16 slots");

constexpr size_t MiB = 1u << 20;
constexpr size_t WS_CTL = 0, CTL_ZERO_BYTES = 64 * 1024;
constexpr size_t WS_RSTD1 = 1 * MiB, WS_RSTD3 = WS_RSTD1 + 65536, WS_LF = WS_RSTD3 + 65536, WS_CS = WS_LF + 524288, WS_SS2 = WS_CS + 524288, WS_WPP = WS_SS2 + 1048576;
static_assert(WS_WPP + 524288 <= 4 * MiB, "small region");
constexpr size_t WS_WIN = 4 * MiB, WS_WBR = 14 * MiB, WS_WOUT = 16 * MiB, WS_WS = 18 * MiB, WS_WPG = 22 * MiB, WS_PB = 24 * MiB;
constexpr size_t WS_UB = 32 * MiB, WS_VB = 64 * MiB;
constexpr size_t WS_A = 96 * MiB;
constexpr size_t WS_PP = 128 * MiB;
constexpr size_t WS_Q = 160 * MiB, WS_K = 176 * MiB, WS_V = 192 * MiB, WS_GB = 208 * MiB, WS_Z = 224 * MiB;
constexpr size_t WS_MERGED = 160 * MiB, WS_XB2 = 192 * MiB, WS_IDS = 224 * MiB, WS_GATES = 232 * MiB;
constexpr size_t WS_END = 256 * MiB;
constexpr size_t WS_PART0 = 4 * MiB, WS_PART1 = 160 * MiB, WS_PART2 = 240 * MiB;
constexpr size_t WS_TGC = 32 * MiB, WS_TXC = 64 * MiB, WS_SC = 32 * MiB;
constexpr int CW_BAR = 1024;

constexpr int RING_OFF = 0, RING_BYTES = 135168;
constexpr int LDSCTL_OFF = RING_BYTES, MISC_OFF = LDSCTL_OFF + 320;
constexpr int LDS_BYTES = RING_BYTES + 1024;
static_assert(attn_body::ATTN_LDS_BYTES <= RING_BYTES && pg8::STAGE_BYTES <= RING_BYTES && 128 * pg8::EpiTopK::RS * 4 <= RING_BYTES, "LDS map");

typedef unsigned u32x4 __attribute__((ext_vector_type(4)));
typedef unsigned u32x2 __attribute__((ext_vector_type(2)));
__device__ __forceinline__ float bf2f(bf16 v) { return __uint_as_float((unsigned)v << 16); }
__device__ __forceinline__ float wave_sum(float v) {
#pragma unroll
    for (int o = 1; o < 64; o <<= 1) v += __shfl_xor(v, o);
    return v;
}
__device__ __forceinline__ float sigmoidf_(float v) { return 1.0f / (1.0f + __expf(-v)); }
__host__ __device__ __forceinline__ int src_in(int n) {
    const int pn = n >> 8, l = n & 255;
    if (pn < 6) return n;
    if (pn < 8) return 1544 + (n - 1536);
    if (pn < 12) { const int j = pn - 8; return (l < 128) ? 2056 + 128 * j + l : 2568 + 128 * j + (l - 128); }
    if (pn < 16) return 3080 + (n - 3072);
    return 4104 + (n - 4096);
}

struct Args { const float* in[18]; float* out; unsigned char* ws; int ph_lo, ph_hi, li, pad; };
struct Ctx {
    LAS unsigned char* lds; int tid, lane, wave, vcu, G;
};

__device__ __forceinline__ void tr_item(const float* __restrict__ W, int ldw, int k0, int scol0, const float* __restrict__ g, bf16* WT, int ldt, int drow0, int dk0, LAS float* scr, int lane) {
#pragma unroll 8
    for (int i = 0; i < 32; ++i) { const int kk = 2 * i + (lane >> 5); float v = W[(size_t)(k0 + kk) * ldw + scol0 + (lane & 31)]; if (g) v *= g[k0 + kk]; scr[kk * 33 + (lane & 31)] = v; }
    LDS_WAIT(); asm volatile("" ::: "memory");
    const int c = lane & 7;
#pragma unroll
    for (int j = 0; j < 4; ++j) { const int n = (lane >> 3) + 8 * j; const LAS float* s = scr + (8 * c) * 33 + n;
        v4u o; o.x = pk2(s[0 * 33], s[1 * 33]); o.y = pk2(s[2 * 33], s[3 * 33]); o.z = pk2(s[4 * 33], s[5 * 33]); o.w = pk2(s[6 * 33], s[7 * 33]);
        *(GAS v4u*)(WT + (size_t)(drow0 + n) * ldt + dk0 + 8 * c) = o; }
    LDS_WAIT(); asm volatile("" ::: "memory");
}
__device__ __forceinline__ void p0_prologue(const Ctx& F, const Args& a) {
    unsigned char* ws = a.ws;
    const float *x = a.in[0], *p = a.in[1], *g_mix = a.in[2], *w_in = a.in[3], *b_f = a.in[4], *w_branch = a.in[6], *w_out = a.in[7], *g_ffn = a.in[8], *w_peer_q = a.in[9],
                *pk1 = a.in[10], *pk2_ = a.in[11], *peer_u = a.in[12], *peer_v = a.in[13], *g_ple = a.in[14], *w_ple_gate = a.in[15], *w_ple_proj = a.in[16];
    bf16 *WIN = (bf16*)(ws + WS_WIN), *WBR = (bf16*)(ws + WS_WBR), *WOUT = (bf16*)(ws + WS_WOUT), *WST = (bf16*)(ws + WS_WS), *WPG = (bf16*)(ws + WS_WPG), *WPP = (bf16*)(ws + WS_WPP);
    bf16 *PB = (bf16*)(ws + WS_PB), *UB = (bf16*)(ws + WS_UB), *VB = (bf16*)(ws + WS_VB), *XB = (bf16*)(ws + WS_A);
    float *RSTD1 = (float*)(ws + WS_RSTD1), *LF = (float*)(ws + WS_LF);
    const int gw = F.vcu * NWAVES + F.wave, NGW = F.G * NWAVES, gt = F.vcu * 512 + F.tid, NGT = F.G * 512;
    {
        LAS float* KH = (LAS float*)(F.lds + RING_OFF); LAS float* WQ = KH + 128 * 129;
        for (int item = F.vcu; item < 512; item += F.G) {
            const int hh = item >> 5, head = hh >> 1, half = hh & 1, d0 = (item & 31) * 32;
            const float* kh = (half ? pk2_ : pk1) + (size_t)head * 128 * 128;
#pragma unroll 4
            for (int i = 0; i < 32; ++i) { const int idx = i * 512 + F.tid; KH[(idx >> 7) * 129 + (idx & 127)] = kh[idx]; }
#pragma unroll
            for (int i = 0; i < 8; ++i) { const int idx = i * 512 + F.tid; WQ[idx] = w_peer_q[(size_t)(d0 + (idx >> 7)) * NS + head * 256 + half * 128 + (idx & 127)]; }
            __syncthreads();
            const int key = F.tid & 127, dg = F.tid >> 7;
            float acc[8];
#pragma unroll
            for (int i = 0; i < 8; ++i) acc[i] = 0.f;
            for (int e = 0; e < 128; e += 4) {
                const float k0 = KH[key * 129 + e], k1 = KH[key * 129 + e + 1], k2 = KH[key * 129 + e + 2], k3 = KH[key * 129 + e + 3];
#pragma unroll
                for (int i = 0; i < 8; ++i) { const f32x4 w = *(const LAS f32x4*)(WQ + (dg * 8 + i) * 128 + e); acc[i] += (k0 * w[0] + k1 * w[1]) + (k2 * w[2] + k3 * w[3]); }
            }
            const int dd = d0 + dg * 8;
            v4u o; o.x = pk2(acc[0] * g_ffn[dd], acc[1] * g_ffn[dd + 1]); o.y = pk2(acc[2] * g_ffn[dd + 2], acc[3] * g_ffn[dd + 3]); o.z = pk2(acc[4] * g_ffn[dd + 4], acc[5] * g_ffn[dd + 5]); o.w = pk2(acc[6] * g_ffn[dd + 6], acc[7] * g_ffn[dd + 7]);
            *(GAS v4u*)(WST + (size_t)(head * 256 + half * 128 + key) * D + dd) = o;
            __syncthreads();
        }
    }
    {
        LAS float* scr = (LAS float*)(F.lds + RING_OFF + F.wave * 16384);
        constexpr int I_IN = 16 * 160, I_BR = 8 * 32, I_SQ = 16 * 32, I_PP = 4 * 32, NITEMS = I_IN + 2 * I_BR + 2 * I_SQ + I_PP;
        for (int it = gw; it < NITEMS; it += NGW) {
            int r = it;
            if (r < I_IN) { const int kb = r / 160, nb = r % 160; tr_item(w_in, INTOT, 64 * kb, src_in(32 * nb), g_mix, WIN, D, 32 * nb, 64 * kb, scr, F.lane); continue; } r -= I_IN;
            if (r < 2 * I_BR) { const int br = r / I_BR, q = r % I_BR, kb = q / 32, nb = q % 32; tr_item(w_branch + (size_t)br * AW * D, D, 64 * kb, 32 * nb, nullptr, WBR, D, 32 * nb, br * AW + 64 * kb, scr, F.lane); continue; } r -= 2 * I_BR;
            if (r < I_SQ) { const int kb = r / 32, nb = r % 32; tr_item(w_out, D, 64 * kb, 32 * nb, nullptr, WOUT, D, 32 * nb, 64 * kb, scr, F.lane); continue; } r -= I_SQ;
            if (r < I_SQ) { const int kb = r / 32, nb = r % 32; tr_item(w_ple_gate, D, 64 * kb, 32 * nb, g_ple, WPG, D, 32 * nb, 64 * kb, scr, F.lane); continue; } r -= I_SQ;
            { const int kb = r / 32, nb = r % 32; tr_item(w_ple_proj, D, 64 * kb, 32 * nb, nullptr, WPP, PLE, 32 * nb, 64 * kb, scr, F.lane); }
        }
    }
    __syncthreads();
    {
        LAS float* WFL = (LAS float*)(F.lds + RING_OFF);
#pragma unroll 4
        for (int i = 0; i < 16; ++i) { const int idx = i * 512 + F.tid, k = idx >> 3, h = idx & 7; WFL[h * 1024 + k] = g_mix[k] * w_in[(size_t)k * INTOT + 1536 + h]; }
        __syncthreads();
        for (int row = gw; row < M; row += NGW) {
            const GAS f32x4* xr = (const GAS f32x4*)(x + (size_t)row * D);
            f32x4 v[4]; float ss = 0.f;
#pragma unroll
            for (int j = 0; j < 4; ++j) { v[j] = xr[F.lane + 64 * j]; ss += (v[j].x * v[j].x + v[j].y * v[j].y) + (v[j].z * v[j].z + v[j].w * v[j].w); }
            ss = wave_sum(ss);
            const float rstd = 1.0f / sqrtf(ss * (1.0f / D) + EPS);
            GAS u32x2* o = (GAS u32x2*)(XB + (size_t)row * D);
#pragma unroll
            for (int j = 0; j < 4; ++j) { u32x2 w; w.x = pk2(v[j].x, v[j].y); w.y = pk2(v[j].z, v[j].w); o[F.lane + 64 * j] = w; }
            if (F.lane == 0) RSTD1[row] = rstd;
            float f[8];
#pragma unroll
            for (int h = 0; h < 8; ++h) { float s = 0.f;
#pragma unroll
                for (int j = 0; j < 4; ++j) { const f32x4 w = *(const LAS f32x4*)(WFL + h * 1024 + 4 * (F.lane + 64 * j)); s += (v[j].x * w[0] + v[j].y * w[1]) + (v[j].z * w[2] + v[j].w * w[3]); }
                f[h] = s; }
            const int b = row / SEQ, t = row % SEQ;
#pragma unroll
            for (int h = 0; h < 8; ++h) {
                const float tot = wave_sum(f[h]) * rstd + b_f[h];
                const float ls = fminf(tot, 0.f) - log1pf(__expf(-fabsf(tot)));
                if (F.lane == 0) LF[(size_t)(b * NH + h) * SEQ + t] = ls * LOG2E;
            }
        }
    }
    {
        constexpr int NU = NEXP * D / 8, NP = M * PLE / 8;
        for (int i = gt; i < NU; i += NGT) { const int d = (i * 8) & (D - 1), e = i >> 7; const size_t dst = ((size_t)(d / SLW) * NEXP + e) * SLW + (d % SLW);
            const f32x4 a = ((const GAS f32x4*)peer_u)[2 * (size_t)i], b = ((const GAS f32x4*)peer_u)[2 * (size_t)i + 1], ga = *(const GAS f32x4*)(g_ffn + d), gb = *(const GAS f32x4*)(g_ffn + d + 4);
            v4u o; o.x = pk2(a.x * ga.x, a.y * ga.y); o.y = pk2(a.z * ga.z, a.w * ga.w); o.z = pk2(b.x * gb.x, b.y * gb.y); o.w = pk2(b.z * gb.z, b.w * gb.w); *(GAS v4u*)(UB + dst) = o; }
        for (int i = gt; i < NU; i += NGT) { const int d = (i * 8) & (D - 1), e = i >> 7; const size_t dst = ((size_t)(d / SLW) * NEXP + e) * SLW + (d % SLW);
            const f32x4 a = ((const GAS f32x4*)peer_v)[2 * (size_t)i], b = ((const GAS f32x4*)peer_v)[2 * (size_t)i + 1];
            v4u o; o.x = pk2(a.x, a.y); o.y = pk2(a.z, a.w); o.z = pk2(b.x, b.y); o.w = pk2(b.z, b.w); *(GAS v4u*)(VB + dst) = o; }
        for (int i = gt; i < NP; i += NGT) { const f32x4 a = ((const GAS f32x4*)p)[2 * (size_t)i], b = ((const GAS f32x4*)p)[2 * (size_t)i + 1];
            v4u o; o.x = pk2(a.x, a.y); o.y = pk2(a.z, a.w); o.z = pk2(b.x, b.y); o.w = pk2(b.z, b.w); ((GAS v4u*)PB)[i] = o; }
    }
}
__device__ __forceinline__ void p2_conv(const Ctx& F, const bf16* GB, const bf16* Z, const float* cw, bf16* AC) {
    const int gt = F.vcu * 512 + F.tid, NGT = F.G * 512;
    for (int i = gt; i < M * AW / 8; i += NGT) {
        const int row = i >> 6, c = (i & 63) * 8, t = row & (SEQ - 1);
        const v4u z2 = *(const GAS v4u*)(Z + (size_t)row * AW + c), g = *(const GAS v4u*)(GB + (size_t)row * AW + c);
        v4u z1 = {0u, 0u, 0u, 0u}, z0 = {0u, 0u, 0u, 0u};
        if (t >= 1) z1 = *(const GAS v4u*)(Z + (size_t)(row - 1) * AW + c);
        if (t >= 2) z0 = *(const GAS v4u*)(Z + (size_t)(row - 2) * AW + c);
        float r[8];
#pragma unroll
        for (int e = 0; e < 4; ++e) {
            const float w0a = cw[c + 2 * e], w0b = cw[c + 2 * e + 1], w1a = cw[AW + c + 2 * e], w1b = cw[AW + c + 2 * e + 1], w2a = cw[2 * AW + c + 2 * e], w2b = cw[2 * AW + c + 2 * e + 1];
            r[2 * e] = __uint_as_float(g[e] << 16) * (w0a * __uint_as_float(z0[e] << 16) + w1a * __uint_as_float(z1[e] << 16) + w2a * __uint_as_float(z2[e] << 16));
            r[2 * e + 1] = __uint_as_float(g[e] & 0xffff0000u) * (w0b * __uint_as_float(z0[e] & 0xffff0000u) + w1b * __uint_as_float(z1[e] & 0xffff0000u) + w2b * __uint_as_float(z2[e] & 0xffff0000u));
        }
        v4u o; o.x = pk2(r[0], r[1]); o.y = pk2(r[2], r[3]); o.z = pk2(r[4], r[5]); o.w = pk2(r[6], r[7]);
        *(GAS v4u*)(AC + (size_t)row * D + AW + c) = o;
    }
}
typedef __bf16 bf16x2_t __attribute__((ext_vector_type(2)));
__device__ __forceinline__ float dot2bf(unsigned a, unsigned b, float c) { return __builtin_amdgcn_fdot2_f32_bf16(__builtin_bit_cast(bf16x2_t, a), __builtin_bit_cast(bf16x2_t, b), c, false); }
template <int CTRL> __device__ __forceinline__ float dpp_f(float v) { return __uint_as_float((unsigned)__builtin_amdgcn_update_dpp(0, (int)__float_as_uint(v), CTRL, 0xf, 0xf, true)); }
__device__ __forceinline__ float sum8(float v) { v += dpp_f<0x141>(v); v += dpp_f<0xB1>(v); v += dpp_f<0x4E>(v); return v; }
__device__ __forceinline__ size_t part_slab(int j) { return j < 2 ? WS_PART0 + (size_t)j * 8 * MiB : j < 6 ? WS_PART1 + (size_t)(j - 2) * 8 * MiB : WS_PART2 + (size_t)(j - 6) * 8 * MiB; }
struct P6Geo { int xg, wi, nwv; };
__device__ __forceinline__ P6Geo p6_geo(const Ctx& F) { P6Geo g; const int bx = blockIdx.x; g.xg = bx & 7; g.wi = (bx >> 3) * NWAVES + F.wave; g.nwv = ((F.G - g.xg + 7) >> 3) * NWAVES; return g; }
__device__ __forceinline__ void p6a_upass(const Ctx& F, unsigned char* ws, const bf16* XB1, const int* IDS, const bf16* UB) {
    const P6Geo G = p6_geo(F); const int lane = F.lane, g = lane >> 3, c = lane & 7;
    float* PART = (float*)(ws + part_slab(G.xg));
    for (int si = 0; si < NSL / 8; ++si) {
        const int sl = G.xg + 8 * si;
        const GAS unsigned char* Ts = (const GAS unsigned char*)(UB + (size_t)sl * NEXP * SLW) + 16 * c;
        for (int t = G.wi; t < M; t += G.nwv) {
            const v4u xc = *(const GAS v4u*)(XB1 + (size_t)t * D + sl * SLW + 8 * c);
            int id[16];
#pragma unroll
            for (int q = 0; q < 4; ++q) { const v4u v = *(const GAS v4u*)(IDS + (size_t)t * 128 + 16 * g + 4 * q); id[4 * q] = (int)v.x; id[4 * q + 1] = (int)v.y; id[4 * q + 2] = (int)v.z; id[4 * q + 3] = (int)v.w; }
            v4u u[16];
#pragma unroll
            for (int i = 0; i < 16; ++i) u[i] = *(const GAS v4u*)(Ts + ((unsigned)id[i] << 7));
            float r0 = 0.f, r1 = 0.f;
#pragma unroll
            for (int i = 0; i < 16; ++i) { float sacc = dot2bf(xc[0], u[i][0], 0.f); sacc = dot2bf(xc[1], u[i][1], sacc); sacc = dot2bf(xc[2], u[i][2], sacc); sacc = dot2bf(xc[3], u[i][3], sacc);
                sacc = sum8(sacc);
                if (i < 8) r0 = (c == i) ? sacc : r0; else r1 = (c == i - 8) ? sacc : r1; }
            float* pp = PART + (size_t)t * 128 + 16 * g + c;
            if (si == 0) { pp[0] = r0; pp[8] = r1; } else { pp[0] += r0; pp[8] += r1; }
        }
    }
}
__device__ __forceinline__ void p6b_combine(const Ctx& F, unsigned char* ws, float* SS2, float* GATES) {
    const int gw = F.vcu * NWAVES + F.wave, NGW = F.G * NWAVES, lane = F.lane;
    for (int t = gw; t < M; t += NGW) {
        const float rstd = 1.0f / sqrtf(wave_sum(lane < 16 ? SS2[(size_t)t * 16 + lane] : 0.f) * (1.0f / D) + EPS);
        float a0 = 0.f, a1 = 0.f;
#pragma unroll
        for (int j = 0; j < 8; ++j) { const float* pp = (const float*)(ws + part_slab(j)) + (size_t)t * 128; a0 += pp[lane]; a1 += pp[64 + lane]; }
        a0 *= rstd; a1 *= rstd;
        float* gp = GATES + (size_t)t * 128;
        gp[lane] = gp[lane] * 0.5f * a0 * (1.0f + erff(a0 * 0.70710678118654752f));
        gp[64 + lane] = gp[64 + lane] * 0.5f * a1 * (1.0f + erff(a1 * 0.70710678118654752f));
        if (lane < 16) SS2[(size_t)t * 16 + lane] = 0.f;
    }
}
__device__ __forceinline__ void p6c_vpass(const Ctx& F, const int* IDS, const float* W, const bf16* VB, float* X, bf16* XB2, float* SS3) {
    const P6Geo G = p6_geo(F); const int lane = F.lane, g = lane >> 3, c = lane & 7;
    const int ecol = 8 * c + ((lane >> 5) & 1) * 4 + ((lane >> 4) & 1) * 2 + ((lane >> 3) & 1);
    for (int si = 0; si < NSL / 8; ++si) {
        const int sl = G.xg + 8 * si;
        const GAS unsigned char* Ts = (const GAS unsigned char*)(VB + (size_t)sl * NEXP * SLW) + 16 * c;
        for (int t = G.wi; t < M; t += G.nwv) {
            int id[16]; float w[16];
#pragma unroll
            for (int q = 0; q < 4; ++q) { const v4u v = *(const GAS v4u*)(IDS + (size_t)t * 128 + 16 * g + 4 * q); id[4 * q] = (int)v.x; id[4 * q + 1] = (int)v.y; id[4 * q + 2] = (int)v.z; id[4 * q + 3] = (int)v.w;
                const f32x4 wv = *(const GAS f32x4*)(W + (size_t)t * 128 + 16 * g + 4 * q); w[4 * q] = wv.x; w[4 * q + 1] = wv.y; w[4 * q + 2] = wv.z; w[4 * q + 3] = wv.w; }
            v4u v[16];
#pragma unroll
            for (int i = 0; i < 16; ++i) v[i] = *(const GAS v4u*)(Ts + ((unsigned)id[i] << 7));
            float acc[8];
#pragma unroll
            for (int e = 0; e < 8; ++e) acc[e] = 0.f;
#pragma unroll
            for (int i = 0; i < 16; ++i)
#pragma unroll
                for (int e = 0; e < 4; ++e) { acc[2 * e] += w[i] * __uint_as_float(v[i][e] << 16); acc[2 * e + 1] += w[i] * __uint_as_float(v[i][e] & 0xffff0000u); }
            float r4[4], r2[2], r1;
#pragma unroll
            for (int i = 0; i < 4; ++i) { const float send = (lane & 32) ? acc[i] : acc[i + 4], keep = (lane & 32) ? acc[i + 4] : acc[i]; r4[i] = keep + __shfl_xor(send, 32); }
#pragma unroll
            for (int i = 0; i < 2; ++i) { const float send = (lane & 16) ? r4[i] : r4[i + 2], keep = (lane & 16) ? r4[i + 2] : r4[i]; r2[i] = keep + __shfl_xor(send, 16); }
            { const float send = (lane & 8) ? r2[0] : r2[1], keep = (lane & 8) ? r2[1] : r2[0]; r1 = keep + __shfl_xor(send, 8); }
            const size_t o = (size_t)t * D + sl * SLW + ecol;
            const float x2 = X[o] + r1;
            X[o] = x2; XB2[o] = (bf16)f2bf(x2);
            const float ss = wave_sum(x2 * x2);
            if (lane == 0) SS3[(size_t)t * 16 + sl] = ss;
        }
    }
}
__device__ __forceinline__ void p8_final(const Ctx& F, float* X, const float* g) {
    const int gw = F.vcu * NWAVES + F.wave, NGW = F.G * NWAVES;
    for (int row = gw; row < M; row += NGW) {
        GAS f32x4* xr = (GAS f32x4*)(X + (size_t)row * D); f32x4 v[4]; float ss = 0.f;
#pragma unroll
        for (int j = 0; j < 4; ++j) { v[j] = xr[F.lane + 64 * j]; ss += (v[j].x * v[j].x + v[j].y * v[j].y) + (v[j].z * v[j].z + v[j].w * v[j].w); }
        ss = wave_sum(ss); const float rstd = 1.0f / sqrtf(ss * (1.0f / D) + EPS);
#pragma unroll
        for (int j = 0; j < 4; ++j) { const f32x4 gv = ((const GAS f32x4*)g)[F.lane + 64 * j]; xr[F.lane + 64 * j] = v[j] * rstd * gv; }
    }
}
struct OneUnit {
    pg8::Unit u;
    __device__ __forceinline__ bool next(int i, pg8::Unit& o) const { if (i != 0) return false; o = u; return true; }
    __device__ __forceinline__ void a_ready(const pg8::Unit&) const {}
    __device__ __forceinline__ void done(const pg8::Unit&) const {}
};

__global__ void __launch_bounds__(NWAVES * 64, 2) mk_fwd(Args args) {
    extern __shared__ __attribute__((aligned(16))) unsigned char lds[];
    Ctx F;
    F.lds = (LAS unsigned char*)lds;
    F.tid = threadIdx.x; F.lane = F.tid & 63; F.wave = __builtin_amdgcn_readfirstlane(F.tid >> 6);
    F.G = gridDim.x; { const int bx = blockIdx.x; F.vcu = (F.G % 8 == 0) ? (bx % 8) * (F.G / 8) + bx / 8 : bx; }
    volatile LAS unsigned* MISC = (volatile LAS unsigned*)(F.lds + MISC_OFF);
    unsigned char* ws = args.ws;
    gu32* ctl = (gu32*)(ws + WS_CTL);
    for (int u = F.tid; u < (LDS_BYTES - LDSCTL_OFF) / 4; u += NWAVES * 64) ((LAS unsigned*)(F.lds + LDSCTL_OFF))[u] = 0u;
    __syncthreads();
    const int lo = args.ph_lo, hi = args.ph_hi;
    const bool multi = (hi - lo) > 1 || (lo <= 6 && 6 < hi);
    XcdBarrier bar; bar.bar = (unsigned*)(ctl + CW_BAR) + args.li * XCD_BAR_WORDS; bar.x = 0; bar.st = nullptr;
    if (multi) bar = xcd_barrier_post((unsigned*)(ctl + CW_BAR) + args.li * XCD_BAR_WORDS, MISC + 8);
#ifndef MK_CMASK
#define MK_CMASK 0x1ff
#endif
#define IN(k) (((MK_CMASK >> (k)) & 1) && lo <= (k) && (k) < hi)
#define SEAM(k) do { if (IN(k) && IN((k) + 1)) xcd_barrier(bar); } while (0)
    float* out = args.out;
    float *RSTD1 = (float*)(ws + WS_RSTD1), *SS2 = (float*)(ws + WS_SS2), *LF = (float*)(ws + WS_LF);
    bf16 *WIN = (bf16*)(ws + WS_WIN), *WBR = (bf16*)(ws + WS_WBR), *WOUT = (bf16*)(ws + WS_WOUT), *WST = (bf16*)(ws + WS_WS), *WPG = (bf16*)(ws + WS_WPG), *WPP = (bf16*)(ws + WS_WPP), *PB = (bf16*)(ws + WS_PB);
    bf16 *UB = (bf16*)(ws + WS_UB), *VB = (bf16*)(ws + WS_VB), *XB = (bf16*)(ws + WS_A), *AC = (bf16*)(ws + WS_A), *XB1 = (bf16*)(ws + WS_A), *PP = (bf16*)(ws + WS_PP);
    bf16 *Q = (bf16*)(ws + WS_Q), *K = (bf16*)(ws + WS_K), *V = (bf16*)(ws + WS_V), *GB = (bf16*)(ws + WS_GB), *Z = (bf16*)(ws + WS_Z), *MG = (bf16*)(ws + WS_MERGED), *XB2 = (bf16*)(ws + WS_XB2);
    int* IDS = (int*)(ws + WS_IDS); float* GATES = (float*)(ws + WS_GATES);
    bf16 *SGA = (bf16*)out, *SGC = (bf16*)out + (size_t)M * D;

    if (IN(0)) { p0_prologue(F, args); }
    SEAM(0);
    if (IN(1)) {
        { pg8::Gemm g{XB, WIN, M, NIN, D}; pg8::StaticOrder S; S.init(M, NIN, F.G, (int)blockIdx.x);
          pg8::EpiIn E{RSTD1, Q, (size_t)(WS_K - WS_Q) / 2, Z, SGA, (size_t)M * D, C2};
          static_assert(WS_V - WS_K == WS_K - WS_Q && WS_GB - WS_V == WS_K - WS_Q, "Q | K | V | GB equally spaced");
          pg8::gemm_phase<pg8::EpiIn, pg8::StaticOrder, PG8_ALIGN, PG8_SP2>(F.lds + RING_OFF, g, S, E); }
        { pg8::Gemm g{PB, WPP, M, D, PLE}; pg8::StaticOrder S; S.init(M, D, F.G, (int)blockIdx.x);
          pg8::EpiPlain E{PP, D};
          pg8::gemm_phase<pg8::EpiPlain, pg8::StaticOrder, PG8_ALIGN, PG8_SP2>(F.lds + RING_OFF, g, S, E); }
    }
    SEAM(1);
    if (IN(2)) {
        p2_conv(F, GB, Z, args.in[5], AC);
        const attn_body::AttnTensors AT{(const attn_body::bf16*)Q, (const attn_body::bf16*)K, (const attn_body::bf16*)V, (attn_body::bf16*)AC, LF};
        const attn_body::StaticOrder S((int)F.G, F.vcu);
        attn_body::attn_phase<attn_body::StaticOrder>((char*)lds + RING_OFF, AT, S);
    }
    SEAM(2);
    if (IN(3)) {
        pg8::Gemm g{AC, WBR, M, D, D}; pg8::StaticOrder S; S.init(M, D, F.G, (int)blockIdx.x);
        pg8::EpiBranch E{SGA, SGC, MG};
        pg8::gemm_phase<pg8::EpiBranch, pg8::StaticOrder, PG8_ALIGN, PG8_SP2>(F.lds + RING_OFF, g, S, E);
    }
    SEAM(3);
    if (IN(4)) {
        pg8::Gemm g{MG, WOUT, M, D, D}; pg8::StaticOrder S; S.init(M, D, F.G, (int)blockIdx.x);
        pg8::EpiOut E{args.in[0], out, XB1, SS2};
        pg8::gemm_phase<pg8::EpiOut, pg8::StaticOrder, PG8_ALIGN, PG8_SP2>(F.lds + RING_OFF, g, S, E);
    }
    SEAM(4);
    if (IN(5)) {
        pg8::Gemm g{XB1, WST, M, NS, D}; pg8::StaticOrder S; S.init(M, NS, F.G, (int)blockIdx.x);
        pg8::EpiTopK E{SS2, IDS, GATES, EPS};
        pg8::Unit u;
        for (int i = 0; S.next(i, u); ++i) { OneUnit O{u}; pg8::gemm_phase<pg8::EpiTopK, OneUnit, false, PG8_SP2>(F.lds + RING_OFF, g, O, E); }
    }
    SEAM(5);
    if (IN(6)) { p6a_upass(F, ws, XB1, IDS, UB); xcd_barrier(bar); p6b_combine(F, ws, SS2, GATES); xcd_barrier(bar); p6c_vpass(F, IDS, GATES, VB, out, XB2, SS2); }
    SEAM(6);
    if (IN(7)) {
        pg8::Gemm g{XB2, WPG, M, D, D}; pg8::StaticOrder S; S.init(M, D, F.G, (int)blockIdx.x);
        pg8::EpiPle E{SS2, PP, out, EPS};
        pg8::gemm_phase<pg8::EpiPle, pg8::StaticOrder, PG8_ALIGN, PG8_SP2>(F.lds + RING_OFF, g, S, E);
    }
    SEAM(7);
    if (IN(8)) { p8_final(F, out, args.in[17]); }
#undef IN
#undef SEAM
}
namespace gold {
__global__ void __launch_bounds__(256) k_rows0(const float* x, const float* w_in, const float* g_mix, const float* b_f, bf16* XB, float* RSTD1, float* LF) {
    const int lane = threadIdx.x & 63, row = blockIdx.x * 4 + (threadIdx.x >> 6);
    const f32x4* xr = (const f32x4*)(x + (size_t)row * D);
    f32x4 v[4]; float ss = 0.f;
#pragma unroll
    for (int j = 0; j < 4; ++j) { v[j] = xr[lane + 64 * j]; ss += v[j].x * v[j].x + v[j].y * v[j].y + v[j].z * v[j].z + v[j].w * v[j].w; }
    ss = wave_sum(ss);
    const float rstd = 1.0f / sqrtf(ss * (1.0f / D) + EPS);
    u32x2* o = (u32x2*)(XB + (size_t)row * D);
#pragma unroll
    for (int j = 0; j < 4; ++j) { u32x2 w; w.x = pk2(v[j].x, v[j].y); w.y = pk2(v[j].z, v[j].w); o[lane + 64 * j] = w; }
    if (lane == 0) RSTD1[row] = rstd;
    float f[8];
#pragma unroll
    for (int h = 0; h < 8; ++h) f[h] = 0.f;
#pragma unroll
    for (int j = 0; j < 4; ++j)
#pragma unroll
        for (int e = 0; e < 4; ++e) {
            const int k = 4 * (lane + 64 * j) + e; const float xv = v[j][e] * g_mix[k];
            const f32x4 w0 = *(const f32x4*)(w_in + (size_t)k * INTOT + 1536), w1 = *(const f32x4*)(w_in + (size_t)k * INTOT + 1540);
            f[0] += xv * w0.x; f[1] += xv * w0.y; f[2] += xv * w0.z; f[3] += xv * w0.w; f[4] += xv * w1.x; f[5] += xv * w1.y; f[6] += xv * w1.z; f[7] += xv * w1.w;
        }
    const int b = row / SEQ, t = row % SEQ;
#pragma unroll
    for (int h = 0; h < 8; ++h) {
        const float tot = wave_sum(f[h]) * rstd + b_f[h];
        const float ls = fminf(tot, 0.f) - log1pf(__expf(-fabsf(tot)));
        if (lane == 0) LF[(size_t)(b * NH + h) * SEQ + t] = ls * LOG2E;
    }
}
template <int MODE> __global__ void k_wt(const float* W, int ldw, const float* g, bf16* Wt, int N, int K, int koff, int ldt) {
    const size_t i = (size_t)blockIdx.x * blockDim.x + threadIdx.x; if (i >= (size_t)N * K) return;
    const int n = (int)(i / K), k = (int)(i % K);
    const int s = MODE == 1 ? src_in(n) : n;
    const float gv = g ? g[k] : 1.f;
    Wt[(size_t)n * ldt + koff + k] = (bf16)f2bf(gv * W[(size_t)k * ldw + s]);
}
__global__ void k_ws(const float* wq, const float* k1, const float* k2, const float* g, bf16* WST) {
    const size_t i = (size_t)blockIdx.x * blockDim.x + threadIdx.x; if (i >= (size_t)NS * D) return;
    const int n = (int)(i / D), d = (int)(i % D), head = n >> 8, half = (n >> 7) & 1, key = n & 127;
    const float* kr = (half ? k2 : k1) + ((size_t)head * NKEYS + key) * 128;
    const float* qr = wq + (size_t)d * NS + head * 256 + half * 128;
    float s = 0.f;
    for (int e = 0; e < 128; ++e) s += qr[e] * kr[e];
    WST[(size_t)n * D + d] = (bf16)f2bf(g[d] * s);
}
__global__ void k_cvt(const float* in, const float* g, bf16* out, size_t n, int gmask) {
    const size_t i = (size_t)blockIdx.x * blockDim.x + threadIdx.x; if (i >= n) return;
    out[i] = (bf16)f2bf(in[i] * (g ? g[i & gmask] : 1.f));
}

template <class Epi, bool SPLIT2>
__global__ void __launch_bounds__(256) ng(const bf16* A, int lda, const bf16* Bt, int ldb, int K, Epi E) {
    __shared__ float As[32][68], Bs[32][68];
    const int tid = threadIdx.x, tx = tid & 15, ty = tid >> 4, m0 = blockIdx.y * 64, n0 = blockIdx.x * 64;
    float acc[4][4], acc2[4][4];
#pragma unroll
    for (int i = 0; i < 4; ++i)
#pragma unroll
        for (int j = 0; j < 4; ++j) { acc[i][j] = 0.f; acc2[i][j] = 0.f; }
    const int lr = tid >> 2, lk = (tid & 3) * 8;
    for (int k0 = 0; k0 < K; k0 += 32) {
        const u32x4 av = *(const u32x4*)(A + (size_t)(m0 + lr) * lda + k0 + lk), bv = *(const u32x4*)(Bt + (size_t)(n0 + lr) * ldb + k0 + lk);
#pragma unroll
        for (int e = 0; e < 4; ++e) {
            As[lk + 2 * e][lr] = __uint_as_float(av[e] << 16); As[lk + 2 * e + 1][lr] = __uint_as_float(av[e] & 0xffff0000u);
            Bs[lk + 2 * e][lr] = __uint_as_float(bv[e] << 16); Bs[lk + 2 * e + 1][lr] = __uint_as_float(bv[e] & 0xffff0000u);
        }
        __syncthreads();
        const bool second = SPLIT2 && (k0 >= K / 2);
#pragma unroll 8
        for (int kk = 0; kk < 32; ++kk) {
            float a[4], b[4];
#pragma unroll
            for (int i = 0; i < 4; ++i) { a[i] = As[kk][ty * 4 + i]; b[i] = Bs[kk][tx * 4 + i]; }
            if (second) {
#pragma unroll
                for (int i = 0; i < 4; ++i)
#pragma unroll
                    for (int j = 0; j < 4; ++j) acc2[i][j] += a[i] * b[j];
            } else {
#pragma unroll
                for (int i = 0; i < 4; ++i)
#pragma unroll
                    for (int j = 0; j < 4; ++j) acc[i][j] += a[i] * b[j];
            }
        }
        __syncthreads();
    }
#pragma unroll
    for (int i = 0; i < 4; ++i)
#pragma unroll
        for (int j = 0; j < 4; ++j) E(m0 + ty * 4 + i, n0 + tx * 4 + j, acc[i][j], acc2[i][j]);
}
struct E1 {
    const float* RSTD1; bf16 *Q, *K, *V, *GB, *SGA, *SGC; float *TGC, *TXC;
    __device__ void operator()(int row, int col, float a, float) const {
        const float v = RSTD1[row] * a; const int pn = col >> 8;
        if (pn < 2) Q[(size_t)row * AW + col] = (bf16)f2bf(v * C2);
        else if (pn < 4) K[(size_t)row * AW + col - 512] = (bf16)f2bf(v);
        else if (pn < 6) V[(size_t)row * AW + col - 1024] = (bf16)f2bf(v);
        else if (pn < 8) GB[(size_t)row * AW + col - 1536] = (bf16)f2bf(v);
        else if (pn < 12) { const int j = pn - 8, l = col & 255; if (l < 128) TGC[(size_t)row * AW + 128 * j + l] = v; else TXC[(size_t)row * AW + 128 * j + l - 128] = v; }
        else if (pn < 16) SGA[(size_t)row * D + col - 3072] = (bf16)f2bf(sigmoidf_(v));
        else SGC[(size_t)row * D + col - 4096] = (bf16)f2bf(sigmoidf_(v));
    }
};
struct EPP { bf16* PP; __device__ void operator()(int row, int col, float a, float) const { PP[(size_t)row * D + col] = (bf16)f2bf(a); } };
struct E3 { const bf16 *SGA, *SGC; bf16* MG;
    __device__ void operator()(int row, int col, float a, float a2) const { const size_t i = (size_t)row * D + col; MG[i] = (bf16)f2bf(bf2f(SGA[i]) * a + bf2f(SGC[i]) * a2); } };
struct E4 { const float* x; float* X1; bf16* XB1;
    __device__ void operator()(int row, int col, float a, float) const { const size_t i = (size_t)row * D + col; const float v = x[i] + a; X1[i] = v; XB1[i] = (bf16)f2bf(v); } };
struct E5 { float* SC; __device__ void operator()(int row, int col, float a, float) const { SC[(size_t)row * 1024 + col] = a; } };
struct E7 { const float* SS3; const bf16* PP; float* X;
    __device__ void operator()(int row, int col, float a, float) const { const size_t i = (size_t)row * D + col; float q_ = 0.f; for (int j_ = 0; j_ < 16; ++j_) q_ += SS3[(size_t)row * 16 + j_]; X[i] = X[i] + sigmoidf_(a / sqrtf(q_ * (1.0f / D) + EPS)) * bf2f(PP[i]); } };

__global__ void k_z(const float* TGC, const float* TXC, bf16* Z) { const size_t i = (size_t)blockIdx.x * blockDim.x + threadIdx.x; if (i < (size_t)M * AW) Z[i] = (bf16)f2bf(TGC[i] * TXC[i]); }
__global__ void k_cumsum(const float* LF, float* CS) { const int bh = threadIdx.x; if (bh >= 32) return; float s = 0.f; for (int t = 0; t < SEQ; ++t) { s += LF[(size_t)bh * SEQ + t]; CS[(size_t)bh * SEQ + t] = s; } }
__global__ void k_conv(const bf16* GB, const bf16* Z, const float* cw, bf16* AC) {
    const size_t i = (size_t)blockIdx.x * blockDim.x + threadIdx.x; if (i >= (size_t)M * AW) return;
    const int row = (int)(i / AW), c = (int)(i % AW), t = row % SEQ;
    float s = cw[2 * AW + c] * bf2f(Z[i]);
    if (t >= 1) s += cw[1 * AW + c] * bf2f(Z[i - AW]);
    if (t >= 2) s += cw[0 * AW + c] * bf2f(Z[i - 2 * AW]);
    AC[(size_t)row * D + AW + c] = (bf16)f2bf(bf2f(GB[i]) * s);
}
__global__ void __launch_bounds__(64) k_attn(const bf16* Q, const bf16* K, const bf16* V, const float* CS, bf16* AC) {
    const int bh = blockIdx.y, b = bh / NH, h = bh % NH, q = blockIdx.x * 64 + threadIdx.x;
    const size_t rq = (size_t)b * SEQ + q;
    float qv[64], o[64];
#pragma unroll
    for (int d = 0; d < 64; ++d) { qv[d] = bf2f(Q[rq * AW + h * 64 + d]); o[d] = 0.f; }
    const float cq = CS[(size_t)bh * SEQ + q];
    float m = -INFINITY, l = 0.f;
    const int kvmax = blockIdx.x * 64 + 63;
    for (int kv = 0; kv <= kvmax; ++kv) {
        const size_t rk = (size_t)b * SEQ + kv;
        const u32x4* kp = (const u32x4*)(K + rk * AW + h * 64);
        float s = 0.f;
#pragma unroll
        for (int c = 0; c < 8; ++c) { const u32x4 w = kp[c];
#pragma unroll
            for (int e = 0; e < 4; ++e) { s += qv[c * 8 + 2 * e] * __uint_as_float(w[e] << 16) + qv[c * 8 + 2 * e + 1] * __uint_as_float(w[e] & 0xffff0000u); } }
        s += cq - CS[(size_t)bh * SEQ + kv];
        if (kv > q) s = -INFINITY;
        const float mn = fmaxf(m, s);
        const float al = (m == -INFINITY) ? 0.f : exp2f(m - mn), p = (s == -INFINITY) ? 0.f : exp2f(s - mn);
        l = l * al + p; m = mn;
        const u32x4* vp = (const u32x4*)(V + rk * AW + h * 64);
#pragma unroll
        for (int c = 0; c < 8; ++c) { const u32x4 w = vp[c];
#pragma unroll
            for (int e = 0; e < 4; ++e) { o[c * 8 + 2 * e] = o[c * 8 + 2 * e] * al + p * __uint_as_float(w[e] << 16); o[c * 8 + 2 * e + 1] = o[c * 8 + 2 * e + 1] * al + p * __uint_as_float(w[e] & 0xffff0000u); } }
    }
    const float il = 1.0f / l;
#pragma unroll
    for (int d = 0; d < 64; ++d) AC[rq * D + h * 64 + d] = (bf16)f2bf(o[d] * il);
}
__global__ void __launch_bounds__(256) k_rowss(const float* X, float* SS) {
    const int lane = threadIdx.x & 63, row = blockIdx.x * 4 + (threadIdx.x >> 6);
    const f32x4* xr = (const f32x4*)(X + (size_t)row * D); float ss = 0.f;
#pragma unroll
    for (int j = 0; j < 4; ++j) { const f32x4 v = xr[lane + 64 * j]; ss += v.x * v.x + v.y * v.y + v.z * v.z + v.w * v.w; }
    ss = wave_sum(ss);
    if (lane < 16) SS[(size_t)row * 16 + lane] = lane == 0 ? ss : 0.f;
}
__global__ void __launch_bounds__(64) k_topk(const float* SC, const float* SS2, int hg, int* IDS, float* GATES) {
    __shared__ float s[128][64]; __shared__ float tv[16][64]; __shared__ int ti[16][64];
    const int tid = threadIdx.x, pair = blockIdx.x * 32 + (tid >> 1), half = tid & 1, token = pair >> 2, hl = pair & 3;
    const float* src = SC + (size_t)token * 1024 + hl * 256 + half * 128;
    for (int k = 0; k < 128; ++k) s[k][tid] = src[k];
    float pv = INFINITY; int pk = -1;
    for (int r = 0; r < 16; ++r) {
        float best = -INFINITY; int bi = 0;
        for (int k = 0; k < 128; ++k) { const float v = s[k][tid]; const bool elig = (v < pv) || (v == pv && k > pk); if (elig && v > best) { best = v; bi = k; } }
        tv[r][tid] = best; ti[r][tid] = bi; pv = best; pk = bi;
    }
    __syncthreads();
    if (half == 0) {
        const float* ss = SS2 + (size_t)token * 16; float sst = 0.f; for (int q_ = 0; q_ < 16; ++q_) sst += ss[q_]; const float rstd = 1.0f / sqrtf(sst * (1.0f / D) + EPS);
        float ts[16]; int tf[16];
        float cpv = INFINITY; int cpf = -1;
#pragma unroll
        for (int r = 0; r < 16; ++r) {
            float best = -INFINITY; int bf_ = 0;
            for (int c = 0; c < 256; ++c) { const float v = tv[c >> 4][tid] + tv[c & 15][tid + 1]; const bool elig = (v < cpv) || (v == cpv && c > cpf); if (elig && v > best) { best = v; bf_ = c; } }
            ts[r] = best; tf[r] = bf_; cpv = best; cpf = bf_;
        }
        float e[16], sum = 0.f;
#pragma unroll
        for (int r = 0; r < 16; ++r) { e[r] = __expf(rstd * (ts[r] - ts[0])); sum += e[r]; }
        const float inv = 1.0f / sum; const int head = hg * 4 + hl;
#pragma unroll
        for (int r = 0; r < 16; ++r) { IDS[(size_t)token * 128 + head * 16 + r] = ti[tf[r] >> 4][tid] * 128 + ti[tf[r] & 15][tid + 1]; GATES[(size_t)token * 128 + head * 16 + r] = e[r] * inv; }
    }
}
__global__ void __launch_bounds__(256) k_peer(const bf16* XB1, const float* SS2, const int* IDS, const float* GATES, const bf16* UB, const bf16* VB, float* X, bf16* XB2, float* RSTD3) {
    const int lane = threadIdx.x & 63, token = blockIdx.x * 4 + (threadIdx.x >> 6);
    const float* ss = SS2 + (size_t)token * 16; float sst = 0.f; for (int q_ = 0; q_ < 16; ++q_) sst += ss[q_]; const float rstd = 1.0f / sqrtf(sst * (1.0f / D) + EPS);
    float xf[16], out[16];
    { const u32x4 a = *(const u32x4*)(XB1 + (size_t)token * D + 8 * lane), b = *(const u32x4*)(XB1 + (size_t)token * D + 512 + 8 * lane);
#pragma unroll
      for (int e = 0; e < 4; ++e) { xf[2 * e] = __uint_as_float(a[e] << 16); xf[2 * e + 1] = __uint_as_float(a[e] & 0xffff0000u); xf[8 + 2 * e] = __uint_as_float(b[e] << 16); xf[8 + 2 * e + 1] = __uint_as_float(b[e] & 0xffff0000u); } }
#pragma unroll
    for (int i = 0; i < 16; ++i) out[i] = 0.f;
    for (int hk = 0; hk < 128; ++hk) {
        const int id = IDS[(size_t)token * 128 + hk]; const float g = GATES[(size_t)token * 128 + hk];
        const u32x4 a = *(const u32x4*)(UB + (size_t)id * D + 8 * lane), b = *(const u32x4*)(UB + (size_t)id * D + 512 + 8 * lane);
        float dot = 0.f;
#pragma unroll
        for (int e = 0; e < 4; ++e) { dot += xf[2 * e] * __uint_as_float(a[e] << 16) + xf[2 * e + 1] * __uint_as_float(a[e] & 0xffff0000u) + xf[8 + 2 * e] * __uint_as_float(b[e] << 16) + xf[8 + 2 * e + 1] * __uint_as_float(b[e] & 0xffff0000u); }
        dot = wave_sum(dot) * rstd;
        const float w = g * 0.5f * dot * (1.0f + erff(dot * 0.70710678118654752f));
        const u32x4 va = *(const u32x4*)(VB + (size_t)id * D + 8 * lane), vb = *(const u32x4*)(VB + (size_t)id * D + 512 + 8 * lane);
#pragma unroll
        for (int e = 0; e < 4; ++e) { out[2 * e] += w * __uint_as_float(va[e] << 16); out[2 * e + 1] += w * __uint_as_float(va[e] & 0xffff0000u); out[8 + 2 * e] += w * __uint_as_float(vb[e] << 16); out[8 + 2 * e + 1] += w * __uint_as_float(vb[e] & 0xffff0000u); }
    }
    float* xr = X + (size_t)token * D; float s2 = 0.f;
    f32x4 x0 = *(f32x4*)(xr + 8 * lane), x1 = *(f32x4*)(xr + 8 * lane + 4), x2 = *(f32x4*)(xr + 512 + 8 * lane), x3 = *(f32x4*)(xr + 512 + 8 * lane + 4);
#pragma unroll
    for (int e = 0; e < 4; ++e) { x0[e] += out[e]; x1[e] += out[4 + e]; x2[e] += out[8 + e]; x3[e] += out[12 + e]; s2 += x0[e] * x0[e] + x1[e] * x1[e] + x2[e] * x2[e] + x3[e] * x3[e]; }
    *(f32x4*)(xr + 8 * lane) = x0; *(f32x4*)(xr + 8 * lane + 4) = x1; *(f32x4*)(xr + 512 + 8 * lane) = x2; *(f32x4*)(xr + 512 + 8 * lane + 4) = x3;
    u32x4 w0, w1; w0.x = pk2(x0.x, x0.y); w0.y = pk2(x0.z, x0.w); w0.z = pk2(x1.x, x1.y); w0.w = pk2(x1.z, x1.w); w1.x = pk2(x2.x, x2.y); w1.y = pk2(x2.z, x2.w); w1.z = pk2(x3.x, x3.y); w1.w = pk2(x3.z, x3.w);
    *(u32x4*)(XB2 + (size_t)token * D + 8 * lane) = w0; *(u32x4*)(XB2 + (size_t)token * D + 512 + 8 * lane) = w1;
    s2 = wave_sum(s2);
    if (lane < 16) RSTD3[(size_t)token * 16 + lane] = lane == 0 ? s2 : 0.f;
}
__global__ void __launch_bounds__(256) k_final(float* X, const float* g) {
    const int lane = threadIdx.x & 63, row = blockIdx.x * 4 + (threadIdx.x >> 6);
    f32x4* xr = (f32x4*)(X + (size_t)row * D); f32x4 v[4]; float ss = 0.f;
#pragma unroll
    for (int j = 0; j < 4; ++j) { v[j] = xr[lane + 64 * j]; ss += v[j].x * v[j].x + v[j].y * v[j].y + v[j].z * v[j].z + v[j].w * v[j].w; }
    ss = wave_sum(ss); const float rstd = 1.0f / sqrtf(ss * (1.0f / D) + EPS);
#pragma unroll
    for (int j = 0; j < 4; ++j) { const f32x4 gv = ((const f32x4*)g)[lane + 64 * j]; xr[lane + 64 * j] = v[j] * rstd * gv; }
}

}

#ifndef MK_FUSED_MASK
#define MK_FUSED_MASK 0x1ff
#endif
static void golden_phase(int ph, void* const* d_in, float* out, unsigned char* ws, hipStream_t stream) {
    using namespace gold;
    const float* x = (const float*)d_in[0]; const float* p = (const float*)d_in[1]; const float* g_mix = (const float*)d_in[2]; const float* w_in = (const float*)d_in[3];
    const float* b_f = (const float*)d_in[4]; const float* conv_w = (const float*)d_in[5]; const float* w_branch = (const float*)d_in[6]; const float* w_out = (const float*)d_in[7];
    const float* g_ffn = (const float*)d_in[8]; const float* w_peer_q = (const float*)d_in[9]; const float* peer_k1 = (const float*)d_in[10]; const float* peer_k2 = (const float*)d_in[11];
    const float* peer_u = (const float*)d_in[12]; const float* peer_v = (const float*)d_in[13]; const float* g_ple = (const float*)d_in[14]; const float* w_ple_gate = (const float*)d_in[15];
    const float* w_ple_proj = (const float*)d_in[16]; const float* g_final = (const float*)d_in[17];
    float *RSTD1 = (float*)(ws + WS_RSTD1), *SS2 = (float*)(ws + WS_SS2), *LF = (float*)(ws + WS_LF), *CS = (float*)(ws + WS_CS);
    bf16 *WIN = (bf16*)(ws + WS_WIN), *WBR = (bf16*)(ws + WS_WBR), *WOUT = (bf16*)(ws + WS_WOUT), *WST = (bf16*)(ws + WS_WS), *WPG = (bf16*)(ws + WS_WPG), *WPP = (bf16*)(ws + WS_WPP), *PB = (bf16*)(ws + WS_PB);
    bf16 *UB = (bf16*)(ws + WS_UB), *VB = (bf16*)(ws + WS_VB), *XB = (bf16*)(ws + WS_A), *AC = (bf16*)(ws + WS_A), *XB1 = (bf16*)(ws + WS_A), *PP = (bf16*)(ws + WS_PP);
    bf16 *Q = (bf16*)(ws + WS_Q), *K = (bf16*)(ws + WS_K), *V = (bf16*)(ws + WS_V), *GB = (bf16*)(ws + WS_GB), *Z = (bf16*)(ws + WS_Z), *MG = (bf16*)(ws + WS_MERGED), *XB2 = (bf16*)(ws + WS_XB2);
    int* IDS = (int*)(ws + WS_IDS); float* GATES = (float*)(ws + WS_GATES);
    bf16 *SGA = (bf16*)out, *SGC = (bf16*)out + (size_t)M * D;
    float *TGC = (float*)(ws + WS_TGC), *TXC = (float*)(ws + WS_TXC), *SC = (float*)(ws + WS_SC);
    auto nb = [](size_t n) { return (unsigned)((n + 255) / 256); };
    switch (ph) {
    case 0:
        k_rows0<<<M / 4, 256, 0, stream>>>(x, w_in, g_mix, b_f, XB, RSTD1, LF);
        k_wt<1><<<nb((size_t)NIN * D), 256, 0, stream>>>(w_in, INTOT, g_mix, WIN, NIN, D, 0, D);
        k_wt<0><<<nb((size_t)D * AW), 256, 0, stream>>>(w_branch, D, nullptr, WBR, D, AW, 0, D);
        k_wt<0><<<nb((size_t)D * AW), 256, 0, stream>>>(w_branch + (size_t)AW * D, D, nullptr, WBR, D, AW, AW, D);
        k_wt<0><<<nb((size_t)D * D), 256, 0, stream>>>(w_out, D, nullptr, WOUT, D, D, 0, D);
        k_wt<0><<<nb((size_t)D * D), 256, 0, stream>>>(w_ple_gate, D, g_ple, WPG, D, D, 0, D);
        k_wt<0><<<nb((size_t)D * PLE), 256, 0, stream>>>(w_ple_proj, D, nullptr, WPP, D, PLE, 0, PLE);
        k_ws<<<nb((size_t)NS * D), 256, 0, stream>>>(w_peer_q, peer_k1, peer_k2, g_ffn, WST);
        k_cvt<<<nb((size_t)M * PLE), 256, 0, stream>>>(p, nullptr, PB, (size_t)M * PLE, 0);
        break;
    case 1:
        ng<E1, false><<<dim3(NIN / 64, M / 64), 256, 0, stream>>>(XB, D, WIN, D, D, E1{RSTD1, Q, K, V, GB, SGA, SGC, TGC, TXC});
        ng<EPP, false><<<dim3(D / 64, M / 64), 256, 0, stream>>>(PB, PLE, WPP, PLE, PLE, EPP{PP});
        k_z<<<nb((size_t)M * AW), 256, 0, stream>>>(TGC, TXC, Z);
        break;
    case 2:
        k_cumsum<<<1, 64, 0, stream>>>(LF, CS);
        k_conv<<<nb((size_t)M * AW), 256, 0, stream>>>(GB, Z, conv_w, AC);
        k_attn<<<dim3(SEQ / 64, BATCH * NH), 64, 0, stream>>>(Q, K, V, CS, AC);
        break;
    case 3: ng<E3, true><<<dim3(D / 64, M / 64), 256, 0, stream>>>(AC, D, WBR, D, D, E3{SGA, SGC, MG}); break;
    case 4:
        ng<E4, false><<<dim3(D / 64, M / 64), 256, 0, stream>>>(MG, D, WOUT, D, D, E4{x, out, XB1});
        k_rowss<<<M / 4, 256, 0, stream>>>(out, SS2);
        break;
    case 5:
        for (int hg = 0; hg < 2; ++hg) {
            ng<E5, false><<<dim3(1024 / 64, M / 64), 256, 0, stream>>>(XB1, D, WST + (size_t)hg * 1024 * D, D, D, E5{SC});
            k_topk<<<M * 4 / 32, 64, 0, stream>>>(SC, SS2, hg, IDS, GATES);
        }
        break;
    case 6:
        k_cvt<<<nb((size_t)NEXP * D), 256, 0, stream>>>(peer_u, g_ffn, UB, (size_t)NEXP * D, D - 1);
        k_cvt<<<nb((size_t)NEXP * D), 256, 0, stream>>>(peer_v, nullptr, VB, (size_t)NEXP * D, 0);
        k_peer<<<M / 4, 256, 0, stream>>>(XB1, SS2, IDS, GATES, UB, VB, out, XB2, SS2);
        break;
    case 7: ng<E7, false><<<dim3(D / 64, M / 64), 256, 0, stream>>>(XB2, D, WPG, D, D, E7{SS2, PP, out}); break;
    case 8: k_final<<<M / 4, 256, 0, stream>>>(out, g_final); break;
    }
}
extern "C" void kernel_launch(void* const* d_in, const int* in_sizes, int n_in, void* d_out, int out_size, void* d_ws, size_t ws_size, hipStream_t stream) {
    static int grid = 0;
    if (grid == 0) {
        if (n_in != 18 || in_sizes[0] != M * D || out_size != M * D || ws_size < WS_END) { fprintf(stderr, "kernel_launch: unexpected shapes (n_in %d, in0 %d, out %d, ws %zu); nothing launched\n", n_in, n_in > 0 ? in_sizes[0] : -1, out_size, ws_size); grid = -1; return; }
        int dev = 0, cus = 0, per_cu = 0;
        if (hipGetDevice(&dev) != hipSuccess || hipDeviceGetAttribute(&cus, hipDeviceAttributeMultiprocessorCount, dev) != hipSuccess) { fprintf(stderr, "kernel_launch: device query failed\n"); grid = -1; return; }
        if (hipFuncSetAttribute((const void*)mk_fwd, hipFuncAttributeMaxDynamicSharedMemorySize, LDS_BYTES) != hipSuccess) { fprintf(stderr, "kernel_launch: hipFuncSetAttribute failed\n"); grid = -1; return; }
        if (hipOccupancyMaxActiveBlocksPerMultiprocessor(&per_cu, (const void*)mk_fwd, NWAVES * 64, LDS_BYTES) != hipSuccess || per_cu < 1) { fprintf(stderr, "kernel_launch: occupancy query says %d workgroups per CU; nothing launched\n", per_cu); (void)hipGetLastError(); grid = -1; return; }
        grid = cus;
    }
    if (grid < 0) return;
    if (hipMemsetAsync((char*)d_ws + WS_CTL, 0, CTL_ZERO_BYTES, stream) != hipSuccess) { fprintf(stderr, "kernel_launch: hipMemsetAsync failed\n"); return; }
    Args a{};
    for (int i = 0; i < 18; ++i) a.in[i] = (const float*)d_in[i];
    a.out = (float*)d_out; a.ws = (unsigned char*)d_ws;
    int li = 0;
    for (int ph = 0; ph < NPHASE;) {
        if ((MK_FUSED_MASK >> ph) & 1) {
            int hi = ph; while (hi < NPHASE && ((MK_FUSED_MASK >> hi) & 1)) ++hi;
            a.ph_lo = ph; a.ph_hi = hi; a.li = li++; a.pad = 0;
            hipLaunchKernelGGL(mk_fwd, dim3(grid), dim3(NWAVES * 64), LDS_BYTES, stream, a);
            const hipError_t le = hipPeekAtLastError();
            if (le != hipSuccess) { fprintf(stderr, "kernel_launch: launch failed: %s\n", hipGetErrorName(le)); return; }
            ph = hi;
        } else {
            golden_phase(ph, d_in, (float*)d_out, (unsigned char*)d_ws, stream);
            if ((ph == 1 || ph == 5) && (MK_FUSED_MASK & 1) && ((MK_FUSED_MASK >> 6) & 1)) {
                gold::k_cvt<<<(unsigned)(((size_t)NEXP * D + 255) / 256), 256, 0, stream>>>((const float*)d_in[12], (const float*)d_in[8], (bf16*)((unsigned char*)d_ws + WS_UB), (size_t)NEXP * D, D - 1);
                gold::k_cvt<<<(unsigned)(((size_t)NEXP * D + 255) / 256), 256, 0, stream>>>((const float*)d_in[13], nullptr, (bf16*)((unsigned char*)d_ws + WS_VB), (size_t)NEXP * D, 0);
            }
            ++ph;
        }
    }
}
```

```cpp
#include <hip/hip_runtime.h>
#include <hip/hip_bf16.h>
#include <cstdio>
#include <cstdint>
#include <cmath>
#define MK_FUSED_MASK 0x1ff
namespace pg8 {
#define PG8_LAS __attribute__((address_space(3)))
typedef unsigned short bf16_t;
typedef short bf16x8 __attribute__((ext_vector_type(8)));
typedef float f32x4 __attribute__((ext_vector_type(4)));
typedef unsigned u32x4 __attribute__((ext_vector_type(4)));
constexpr int BM = 256, BK = 64, HALF = 128, HTB = HALF * BK * 2  , STAGE_BYTES = 8 * HTB, NXCD = 8, WGM = 8;

__host__ __device__ __forceinline__ int lds_byte(int r, int c) { const int st = (r >> 4) * 2 + (c >> 5), rr = r & 15, cc = c & 31, ob = rr * 64 + cc * 2; return st * 1024 + (ob ^ (((ob >> 9) & 1) << 5)); }
__host__ __device__ __forceinline__ void stage_rc(int b, int& R, int& C) { const int st = b / 1024, sb = b % 1024, swz = sb ^ (((sb >> 9) & 1) << 5); R = (st >> 1) * 16 + swz / 64; C = (st & 1) * 32 + (swz % 64) / 2; }
__host__ __device__ __forceinline__ int perm32(int rho) { const int n = rho >> 4, i = rho & 15; return 8 * (i >> 2) + 4 * n + (i & 3); }

struct Unit { int pm, pn; };
struct Gemm { const bf16_t* A; const bf16_t* Bt; int M, N, K; };

struct StaticOrder {
    int nM, nN, nwg, G, c;
    __host__ __device__ void init(int M, int N, int G_, int c_) { nM = M / BM; nN = N / BM; nwg = nM * nN; G = G_; c = c_; }
    __host__ __device__ bool next(int i, Unit& u) const {
        const long L = (long)i * G + c; if (L >= nwg) return false;
        int wgid = (int)L; { const int q = nwg / NXCD, r = nwg % NXCD, xcd = wgid % NXCD, off = wgid / NXCD; wgid = (xcd < r ? xcd * (q + 1) : r * (q + 1) + (xcd - r) * q) + off; }
        const int nig = WGM * nN, gid = wgid / nig, fm = gid * WGM, gsz = (nM - fm) < WGM ? (nM - fm) : WGM;
        u.pm = fm + ((wgid % nig) % gsz); u.pn = (wgid % nig) / gsz; return true;
    }
    __device__ __forceinline__ void a_ready(const Unit&) const {}
    __device__ __forceinline__ void done(const Unit&) const {}
};


__device__ __forceinline__ unsigned cvt_pk_bf16(float lo, float hi) { unsigned r; asm volatile("v_cvt_pk_bf16_f32 %0, %1, %2" : "=v"(r) : "v"(lo), "v"(hi)); return r; }
__device__ __forceinline__ u32x4 pack8(const f32x4 v0, const f32x4 v1) { u32x4 w; w.x = cvt_pk_bf16(v0[0], v0[1]); w.y = cvt_pk_bf16(v0[2], v0[3]); w.z = cvt_pk_bf16(v1[0], v1[1]); w.w = cvt_pk_bf16(v1[2], v1[3]); return w; }
__device__ __forceinline__ float bflo(unsigned w) { return __uint_as_float(w << 16); }
__device__ __forceinline__ float bfhi(unsigned w) { return __uint_as_float(w & 0xffff0000u); }
__device__ __forceinline__ float sigm(float v) { return __builtin_amdgcn_rcpf(1.0f + __builtin_amdgcn_exp2f(v * -1.4426950408889634f)); }
__device__ __forceinline__ f32x4 sigm4(const f32x4 v) { return (f32x4){sigm(v[0]), sigm(v[1]), sigm(v[2]), sigm(v[3])}; }

struct EpiIn {
    static constexpr bool PERM = true, AFTER_DRAIN = false; static constexpr int MID_T = 0;
    const float* rstd; bf16_t* QKVG; size_t stride4; bf16_t* Z; bf16_t* SG; size_t strideSG; float c2;
    __device__ __forceinline__ void operator()(const f32x4 (&acc)[2][2][4][2], const Unit& u, int wr, int wc, int fr, int fq) const {
        int row0 = u.pm * BM + wr * 64 + fr; asm volatile("" : "+v"(row0)); const int cl = wc * 32 + 8 * fq, pn = u.pn;
        if (pn < 8) {
            bf16_t* base = QKVG + (size_t)(pn >> 1) * stride4; const int colt = (pn & 1) * 256 + cl; const float s0 = pn < 2 ? c2 : 1.f;
#pragma unroll
            for (int ai = 0; ai < 2; ++ai)
#pragma unroll
                for (int m = 0; m < 4; ++m) { const int row = row0 + ai * HALF + m * 16; const float sc = rstd[row] * s0; bf16_t* rowp = base + (size_t)row * 512 + colt;
#pragma unroll
                    for (int bj = 0; bj < 2; ++bj) *(u32x4*)(rowp + bj * HALF) = pack8(acc[ai][bj][m][0] * sc, acc[ai][bj][m][1] * sc);
                    asm volatile("" ::: "memory"); }
        } else if (pn < 12) {
            const int colt = (pn - 8) * 128 + cl;
#pragma unroll
            for (int ai = 0; ai < 2; ++ai)
#pragma unroll
                for (int m = 0; m < 4; ++m) { const int row = row0 + ai * HALF + m * 16; const float r = rstd[row], sc = r * r;
                    *(u32x4*)(Z + (size_t)row * 512 + colt) = pack8(acc[ai][0][m][0] * acc[ai][1][m][0] * sc, acc[ai][0][m][1] * acc[ai][1][m][1] * sc);
                    asm volatile("" ::: "memory"); }
        } else {
            bf16_t* base = SG + (size_t)((pn - 12) >> 2) * strideSG; const int colt = ((pn - 12) & 3) * 256 + cl;
#pragma unroll
            for (int ai = 0; ai < 2; ++ai)
#pragma unroll
                for (int m = 0; m < 4; ++m) { const int row = row0 + ai * HALF + m * 16; const float r = rstd[row]; bf16_t* rowp = base + (size_t)row * 1024 + colt;
#pragma unroll
                    for (int bj = 0; bj < 2; ++bj) { *(u32x4*)(rowp + bj * HALF) = pack8(sigm4(acc[ai][bj][m][0] * r), sigm4(acc[ai][bj][m][1] * r)); asm volatile("" ::: "memory"); } }
        }
    }
};
struct EpiPlain {
    static constexpr bool PERM = true, AFTER_DRAIN = false; static constexpr int MID_T = 0;
    bf16_t* O; int ldc;
    __device__ __forceinline__ void operator()(const f32x4 (&acc)[2][2][4][2], const Unit& u, int wr, int wc, int fr, int fq) const {
        int row0 = u.pm * BM + wr * 64 + fr; asm volatile("" : "+v"(row0)); const int col0 = u.pn * BM + wc * 32 + 8 * fq;
#pragma unroll
        for (int ai = 0; ai < 2; ++ai)
#pragma unroll
            for (int m = 0; m < 4; ++m) { bf16_t* rowp = O + (size_t)(row0 + ai * HALF + m * 16) * ldc + col0;
#pragma unroll
                for (int bj = 0; bj < 2; ++bj) *(u32x4*)(rowp + bj * HALF) = pack8(acc[ai][bj][m][0], acc[ai][bj][m][1]); }
    }
};
struct EpiBranch {
    static constexpr bool PERM = true, AFTER_DRAIN = false; static constexpr int MID_T = 8;
    const bf16_t *SGA, *SGC; bf16_t* MG;
    __device__ __forceinline__ void mid(f32x4 (&acc)[2][2][4][2], const Unit& u, int wr, int wc, int fr, int fq) const {
        int row0 = u.pm * BM + wr * 64 + fr; asm volatile("" : "+v"(row0)); const int col0 = u.pn * BM + wc * 32 + 8 * fq;
#pragma unroll
        for (int ai = 0; ai < 2; ++ai)
#pragma unroll
            for (int m = 0; m < 4; ++m) { const size_t off = (size_t)(row0 + ai * HALF + m * 16) * 1024 + col0;
#pragma unroll
                for (int bj = 0; bj < 2; ++bj) { const u32x4 a = *(const u32x4*)(SGA + off + bj * HALF), c = *(const u32x4*)(SGC + off + bj * HALF);
                    f32x4 r0, r1;
                    r0[0] = bflo(a[0]) * __builtin_amdgcn_rcpf(bflo(c[0])); r0[1] = bfhi(a[0]) * __builtin_amdgcn_rcpf(bfhi(c[0])); r0[2] = bflo(a[1]) * __builtin_amdgcn_rcpf(bflo(c[1])); r0[3] = bfhi(a[1]) * __builtin_amdgcn_rcpf(bfhi(c[1]));
                    r1[0] = bflo(a[2]) * __builtin_amdgcn_rcpf(bflo(c[2])); r1[1] = bfhi(a[2]) * __builtin_amdgcn_rcpf(bfhi(c[2])); r1[2] = bflo(a[3]) * __builtin_amdgcn_rcpf(bflo(c[3])); r1[3] = bfhi(a[3]) * __builtin_amdgcn_rcpf(bfhi(c[3]));
                    acc[ai][bj][m][0] *= r0; acc[ai][bj][m][1] *= r1; asm volatile("" ::: "memory"); } }
    }
    __device__ __forceinline__ void operator()(const f32x4 (&acc)[2][2][4][2], const Unit& u, int wr, int wc, int fr, int fq) const {
        int row0 = u.pm * BM + wr * 64 + fr; asm volatile("" : "+v"(row0)); const int col0 = u.pn * BM + wc * 32 + 8 * fq;
#pragma unroll
        for (int ai = 0; ai < 2; ++ai)
#pragma unroll
            for (int m = 0; m < 4; ++m) { const size_t off = (size_t)(row0 + ai * HALF + m * 16) * 1024 + col0;
#pragma unroll
                for (int bj = 0; bj < 2; ++bj) { const u32x4 c = *(const u32x4*)(SGC + off + bj * HALF);
                    const f32x4 s0 = {bflo(c[0]), bfhi(c[0]), bflo(c[1]), bfhi(c[1])}, s1 = {bflo(c[2]), bfhi(c[2]), bflo(c[3]), bfhi(c[3])};
                    *(u32x4*)(MG + off + bj * HALF) = pack8(acc[ai][bj][m][0] * s0, acc[ai][bj][m][1] * s1); asm volatile("" ::: "memory"); } }
    }
};
struct EpiOut {
    static constexpr bool PERM = true, AFTER_DRAIN = false; static constexpr int MID_T = 0;
    const float* x; float* X1; bf16_t* XB1; float* SS2;
    __device__ __forceinline__ void operator()(const f32x4 (&acc)[2][2][4][2], const Unit& u, int wr, int wc, int fr, int fq) const {
        int row0 = u.pm * BM + wr * 64 + fr; asm volatile("" : "+v"(row0)); const int col0 = u.pn * BM + wc * 32 + 8 * fq;
#pragma unroll
        for (int ai = 0; ai < 2; ++ai)
#pragma unroll
            for (int m = 0; m < 4; ++m) { const int row = row0 + ai * HALF + m * 16; const size_t off = (size_t)row * 1024 + col0; float ss = 0.f;
#pragma unroll
                for (int bj = 0; bj < 2; ++bj) { const f32x4 v0 = acc[ai][bj][m][0] + *(const f32x4*)(x + off + bj * HALF), v1 = acc[ai][bj][m][1] + *(const f32x4*)(x + off + bj * HALF + 4);
                    *(f32x4*)(X1 + off + bj * HALF) = v0; *(f32x4*)(X1 + off + bj * HALF + 4) = v1; *(u32x4*)(XB1 + off + bj * HALF) = pack8(v0, v1);
                    ss += (v0[0] * v0[0] + v0[1] * v0[1]) + (v0[2] * v0[2] + v0[3] * v0[3]) + (v1[0] * v1[0] + v1[1] * v1[1]) + (v1[2] * v1[2] + v1[3] * v1[3]); }
                ss += __shfl_xor(ss, 16); ss += __shfl_xor(ss, 32);
                if (fq == 0) SS2[(size_t)row * 16 + u.pn * 4 + wc] = ss;
                if (m & 1) asm volatile("" ::: "memory"); }
    }
};
struct EpiPle {
    static constexpr bool PERM = true, AFTER_DRAIN = false; static constexpr int MID_T = 0;
    const float* SS3; const bf16_t* PP; float* X; float eps;
    __device__ __forceinline__ void operator()(const f32x4 (&acc)[2][2][4][2], const Unit& u, int wr, int wc, int fr, int fq) const {
        int row0 = u.pm * BM + wr * 64 + fr; asm volatile("" : "+v"(row0)); const int col0 = u.pn * BM + wc * 32 + 8 * fq;
#pragma unroll
        for (int ai = 0; ai < 2; ++ai)
#pragma unroll
            for (int m = 0; m < 4; ++m) { const int row = row0 + ai * HALF + m * 16; const size_t off = (size_t)row * 1024 + col0;
                const f32x4* sp = (const f32x4*)(SS3 + (size_t)row * 16); const f32x4 q0 = sp[0], q1 = sp[1], q2 = sp[2], q3 = sp[3];
                const float r = 1.0f / sqrtf((((q0[0] + q0[1]) + (q0[2] + q0[3])) + ((q1[0] + q1[1]) + (q1[2] + q1[3])) + ((q2[0] + q2[1]) + (q2[2] + q2[3])) + ((q3[0] + q3[1]) + (q3[2] + q3[3]))) * (1.0f / 1024.0f) + eps);
#pragma unroll
                for (int bj = 0; bj < 2; ++bj) { const u32x4 c = *(const u32x4*)(PP + off + bj * HALF);
                    const f32x4 p0 = {bflo(c[0]), bfhi(c[0]), bflo(c[1]), bfhi(c[1])}, p1 = {bflo(c[2]), bfhi(c[2]), bflo(c[3]), bfhi(c[3])};
                    const f32x4 x0 = *(const f32x4*)(X + off + bj * HALF), x1 = *(const f32x4*)(X + off + bj * HALF + 4);
                    *(f32x4*)(X + off + bj * HALF) = x0 + sigm4(acc[ai][bj][m][0] * r) * p0; *(f32x4*)(X + off + bj * HALF + 4) = x1 + sigm4(acc[ai][bj][m][1] * r) * p1; }
                if (m & 1) asm volatile("" ::: "memory"); }
    }
};

__device__ __forceinline__ float vmaxf(float a, float b) { float r; asm("v_max_f32_e32 %0, %1, %2" : "=v"(r) : "v"(a), "v"(b)); return r; }
__device__ __forceinline__ float vminf(float a, float b) { float r; asm("v_min_f32_e32 %0, %1, %2" : "=v"(r) : "v"(a), "v"(b)); return r; }
__device__ __forceinline__ void sort16_desc(float (&a)[16]) {
#pragma unroll
    for (int k = 2; k <= 16; k <<= 1)
#pragma unroll
        for (int j = k >> 1; j > 0; j >>= 1)
#pragma unroll
            for (int i = 0; i < 16; ++i) { const int l = i ^ j; if (l > i) { const float hi = vmaxf(a[i], a[l]), lo = vminf(a[i], a[l]); if ((i & k) == 0) { a[i] = hi; a[l] = lo; } else { a[i] = lo; a[l] = hi; } } }
}
template <int L> __device__ __forceinline__ void merge16(float (&a)[16], const float (&b)[16]) {
#pragma unroll
    for (int i = 0; i < 16; ++i) if (15 - i < L) a[i] = vmaxf(a[i], b[15 - i]);
#pragma unroll
    for (int j = 8; j > 0; j >>= 1)
#pragma unroll
        for (int i = 0; i < 16; ++i) { const int l = i ^ j; if (l > i) { const float hi = vmaxf(a[i], a[l]), lo = vminf(a[i], a[l]); a[i] = hi; a[l] = lo; } }
}
struct EpiTopK {
    static constexpr bool PERM = true, AFTER_DRAIN = true; static constexpr int MID_T = 0;
    static constexpr int RS = 260;
    const float* SS2; int* IDS; float* GATES; float eps;
    __device__ __forceinline__ void fused(f32x4 (&acc)[2][2][4][2], const Unit& u, int wr, int wc, int fr, int fq, PG8_LAS unsigned char* lds, int wid, int lane) const {
        PG8_LAS float* S = (PG8_LAS float*)lds;
        const int tid = wid * 64 + lane, row = tid & 127, grp = tid >> 7, half = grp >> 1, part = grp & 1;
#define TK_BAR() do { asm volatile("s_waitcnt vmcnt(0) lgkmcnt(0)" ::: "memory"); __builtin_amdgcn_s_barrier(); asm volatile("" ::: "memory"); } while (0)
#pragma unroll
        for (int ai = 0; ai < 2; ++ai) {
#pragma unroll
            for (int m = 0; m < 4; ++m)
#pragma unroll
                for (int bj = 0; bj < 2; ++bj)
#pragma unroll
                    for (int n = 0; n < 2; ++n) *(PG8_LAS f32x4*)(S + (wr * 64 + m * 16 + fr) * RS + bj * HALF + wc * 32 + 8 * fq + 4 * n) = acc[ai][bj][m][n];
            TK_BAR();
            float T[16];
#pragma unroll
            for (int b = 0; b < 4; ++b) {
                float c[16];
#pragma unroll
                for (int q = 0; q < 4; ++q) { const f32x4 v = *(const PG8_LAS f32x4*)(S + row * RS + half * 128 + part * 64 + b * 16 + q * 4);
#pragma unroll
                    for (int e = 0; e < 4; ++e) c[q * 4 + e] = __uint_as_float((__float_as_uint(v[e]) & ~127u) | (unsigned)(part * 64 + b * 16 + q * 4 + e)); }
                sort16_desc(c);
                if (b == 0) {
#pragma unroll
                    for (int i = 0; i < 16; ++i) T[i] = c[i];
                } else merge16<16>(T, c);
            }
            TK_BAR();
#pragma unroll
            for (int q = 0; q < 4; ++q) *(PG8_LAS f32x4*)(S + tid * 16 + q * 4) = (f32x4){T[q * 4], T[q * 4 + 1], T[q * 4 + 2], T[q * 4 + 3]};
            TK_BAR();
            if (part == 0) {
                float c[16];
#pragma unroll
                for (int q = 0; q < 4; ++q) { const f32x4 v = *(const PG8_LAS f32x4*)(S + (tid + 128) * 16 + q * 4); c[q * 4] = v[0]; c[q * 4 + 1] = v[1]; c[q * 4 + 2] = v[2]; c[q * 4 + 3] = v[3]; }
                merge16<16>(T, c);
            }
            TK_BAR();
            if (part == 0) {
#pragma unroll
                for (int q = 0; q < 4; ++q) *(PG8_LAS f32x4*)(S + tid * 16 + q * 4) = (f32x4){T[q * 4], T[q * 4 + 1], T[q * 4 + 2], T[q * 4 + 3]};
            }
            TK_BAR();
            if (tid < 128) {
                float a1[16], a2[16];
#pragma unroll
                for (int q = 0; q < 4; ++q) { const f32x4 v = *(const PG8_LAS f32x4*)(S + (tid + 256) * 16 + q * 4);
#pragma unroll
                    for (int e = 0; e < 4; ++e) a2[q * 4 + e] = __uint_as_float(__float_as_uint(v[e]) & ~127u); }
#pragma unroll
                for (int i = 0; i < 16; ++i) a1[i] = __uint_as_float(__float_as_uint(T[i]) & ~127u);
#define TK_SUM(i, j) __uint_as_float((__float_as_uint(a1[i] + a2[j]) & ~255u) | (unsigned)((i) * 16 + (j)))
                float R[16], C[16];
#pragma unroll
                for (int j = 0; j < 16; ++j) R[j] = TK_SUM(0, j);
#pragma unroll
                for (int i = 1; i < 16; ++i) C[i - 1] = TK_SUM(i, 0);
                C[15] = 0.f;
                merge16<15>(R, C);
                C[0] = TK_SUM(1, 1); C[1] = TK_SUM(1, 2); C[2] = TK_SUM(1, 3); C[3] = TK_SUM(1, 4); C[4] = TK_SUM(1, 5); C[5] = TK_SUM(1, 6); C[6] = TK_SUM(1, 7);
                C[7] = TK_SUM(2, 1); C[8] = TK_SUM(2, 2); C[9] = TK_SUM(2, 3); C[10] = TK_SUM(2, 4); C[11] = TK_SUM(3, 1); C[12] = TK_SUM(3, 2); C[13] = TK_SUM(3, 3);
                C[14] = TK_SUM(4, 1); C[15] = TK_SUM(4, 2);
                sort16_desc(C);
                merge16<16>(R, C);
                C[0] = TK_SUM(5, 1); C[1] = TK_SUM(6, 1); C[2] = TK_SUM(7, 1);
                merge16<3>(R, C);
#undef TK_SUM
                const int rowg = u.pm * BM + ai * HALF + row;
                const f32x4* ssp = (const f32x4*)(SS2 + (size_t)rowg * 16); const f32x4 s0 = ssp[0], s1 = ssp[1], s2 = ssp[2], s3 = ssp[3];
                const float ssum = ((s0[0] + s0[1]) + (s0[2] + s0[3])) + ((s1[0] + s1[1]) + (s1[2] + s1[3])) + ((s2[0] + s2[1]) + (s2[2] + s2[3])) + ((s3[0] + s3[1]) + (s3[2] + s3[3]));
                const float rl = 1.4426950408889634f / sqrtf(ssum * (1.0f / 1024.0f) + eps);
                float ev[16], esum = 0.f; int idv[16];
#pragma unroll
                for (int r = 0; r < 16; ++r) { ev[r] = __builtin_amdgcn_exp2f((R[r] - R[0]) * rl); esum += ev[r];
                    const unsigned code = __float_as_uint(R[r]) & 255u;
                    const unsigned k1 = __float_as_uint(S[tid * 16 + (code >> 4)]) & 127u, k2 = __float_as_uint(S[(tid + 256) * 16 + (code & 15u)]) & 127u;
                    idv[r] = (int)(k1 * 128u + k2); }
                const float inv = 1.0f / esum;
                int* ip = IDS + (size_t)rowg * 128 + u.pn * 16; float* gp = GATES + (size_t)rowg * 128 + u.pn * 16;
#pragma unroll
                for (int q = 0; q < 4; ++q) { *(int4*)(ip + q * 4) = make_int4(idv[q * 4], idv[q * 4 + 1], idv[q * 4 + 2], idv[q * 4 + 3]);
                    *(f32x4*)(gp + q * 4) = (f32x4){ev[q * 4] * inv, ev[q * 4 + 1] * inv, ev[q * 4 + 2] * inv, ev[q * 4 + 3] * inv}; }
            }
            TK_BAR();
        }
#undef TK_BAR
    }
};
template <class Epi, class Sched, bool ALIGN_EPI = false, bool SP2 = false>
__device__ __forceinline__ void gemm_phase(PG8_LAS unsigned char* lds, const Gemm g, const Sched& S, const Epi& E) {
    const int tid = threadIdx.x, wid = __builtin_amdgcn_readfirstlane(tid >> 6), lane = tid & 63, wr = wid >> 2, wc = wid & 3, fr = lane & 15, fq = lane >> 4;
    const int K = g.K, nt = K / BK;
    unsigned voffA[2], voffB[2];
#pragma unroll
    for (int i = 0; i < 2; ++i) { int R, C; stage_rc(tid * 16 + i * 8192, R, C); const int Rb = Epi::PERM ? ((R & ~31) + perm32(R & 31)) : R;
        voffA[i] = (unsigned)(R * K + C) * 2u; voffB[i] = (unsigned)(Rb * K + C) * 2u; }
    const size_t kstep = (size_t)(BK * 2);
    const size_t hstep = (size_t)HALF * K * 2;
    const size_t tstep = 2 * hstep;
    const unsigned ldsw = (unsigned)wid * 1024u;
    const int aoff = lds_byte(wr * 64 + fr, fq * 8), boff = lds_byte(wc * 32 + fr, fq * 8);
#define PG8_SA(b, h) (((b) * 2 + (h)) * HTB)
#define PG8_SB(b, h) ((4 + (b) * 2 + (h)) * HTB)
#define PG8_STAGE(bufoff, gbase, voff) do { _Pragma("unroll") for (int _i = 0; _i < 2; ++_i) \
        __builtin_amdgcn_global_load_lds((const unsigned*)((const char*)(gbase) + (voff)[_i]), (PG8_LAS unsigned*)(lds + (bufoff) + ldsw + _i * 8192), 16, 0, 0); } while (0)
#define PG8_LDA(dst, b, h) do { _Pragma("unroll") for (int m = 0; m < 4; ++m) _Pragma("unroll") for (int k = 0; k < 2; ++k) dst[m][k] = *(const PG8_LAS bf16x8*)(lds + PG8_SA(b, h) + aoff + m * 2048 + k * 1024); } while (0)
#define PG8_LDB(dst, b, h) do { _Pragma("unroll") for (int n = 0; n < 2; ++n) _Pragma("unroll") for (int k = 0; k < 2; ++k) dst[n][k] = *(const PG8_LAS bf16x8*)(lds + PG8_SB(b, h) + boff + n * 2048 + k * 1024); } while (0)
#define PG8_MMA(ai, bj, At, Bt) do { __builtin_amdgcn_s_setprio(1); _Pragma("unroll") for (int m = 0; m < 4; ++m) _Pragma("unroll") for (int n = 0; n < 2; ++n) _Pragma("unroll") for (int k = 0; k < 2; ++k) \
        acc[ai][bj][m][n] = __builtin_amdgcn_mfma_f32_16x16x32_bf16(Bt[n][k], At[m][k], acc[ai][bj][m][n], 0, 0, 0); __builtin_amdgcn_s_setprio(0); } while (0)
#define PG8_WAIT_V(n) asm volatile("s_waitcnt vmcnt(" #n ")" ::: "memory")
#define PG8_WAIT_L(n) asm volatile("s_waitcnt lgkmcnt(" #n ")" ::: "memory")
#define PG8_BAR __builtin_amdgcn_s_barrier()
#define PG8_SCHED __builtin_amdgcn_sched_barrier(0)
    Unit cur, nxt; int ui = 0;
    if (!S.next(0, cur)) return;
    f32x4 acc[2][2][4][2];
#pragma unroll
    for (int a = 0; a < 2; ++a)
#pragma unroll
        for (int b = 0; b < 2; ++b)
#pragma unroll
            for (int m = 0; m < 4; ++m)
#pragma unroll
                for (int n = 0; n < 2; ++n) acc[a][b][m][n] = (f32x4){0.f, 0.f, 0.f, 0.f};
    bf16x8 At[4][2], B0[2][2], B1[2][2];
    const char* cA = (const char*)g.A + (size_t)cur.pm * tstep; const char* cB = (const char*)g.Bt + (size_t)cur.pn * tstep;
    S.a_ready(cur);
    if constexpr (SP2) {
        PG8_STAGE(PG8_SB(0, 0), cB, voffB); PG8_STAGE(PG8_SB(0, 1), cB + hstep, voffB); PG8_STAGE(PG8_SA(0, 0), cA, voffA); PG8_STAGE(PG8_SA(0, 1), cA + hstep, voffA);
        if (wr == 1) PG8_BAR;
        PG8_WAIT_V(2); PG8_BAR;
        PG8_STAGE(PG8_SB(1, 0), cB + kstep, voffB); PG8_STAGE(PG8_SA(1, 0), cA + kstep, voffA); PG8_STAGE(PG8_SB(1, 1), cB + hstep + kstep, voffB);
        PG8_WAIT_V(6); PG8_BAR;
    } else {
        PG8_STAGE(PG8_SB(0, 0), cB, voffB); PG8_STAGE(PG8_SA(0, 0), cA, voffA); PG8_STAGE(PG8_SB(0, 1), cB + hstep, voffB); PG8_STAGE(PG8_SA(0, 1), cA + hstep, voffA);
        if (wr == 1) PG8_BAR;
        PG8_WAIT_V(4); PG8_BAR;
        PG8_STAGE(PG8_SB(1, 0), cB + kstep, voffB); PG8_STAGE(PG8_SA(1, 0), cA + kstep, voffA); PG8_STAGE(PG8_SB(1, 1), cB + hstep + kstep, voffB);
        PG8_WAIT_V(6); PG8_BAR;
    }
    for (;;) {
        const bool has_next = S.next(ui + 1, nxt);
        const char* nA = has_next ? (const char*)g.A + (size_t)nxt.pm * tstep : cA; const char* nB = has_next ? (const char*)g.Bt + (size_t)nxt.pn * tstep : cB;
        for (int t = 0; t < nt; t += 2) {
            if constexpr (Epi::MID_T > 0) { if (t == Epi::MID_T) E.mid(acc, cur, wr, wc, fr, fq); }
            const bool last = (t == nt - 2);
            const char* a1 = cA + (size_t)(t + 1) * kstep;
            const char* a2 = last ? nA : cA + (size_t)(t + 2) * kstep; const char* b2 = last ? nB : cB + (size_t)(t + 2) * kstep;
            const char* a3 = a2 + kstep; const char* b3 = b2 + kstep;
            if (last && has_next) S.a_ready(nxt);
            if constexpr (SP2) {
            PG8_LDB(B0, 0, 0); PG8_LDB(B1, 0, 1); PG8_SCHED; PG8_LDA(At, 0, 0); PG8_STAGE(PG8_SA(1, 1), a1 + hstep, voffA);
            PG8_WAIT_V(8); PG8_WAIT_L(0); PG8_BAR; PG8_MMA(0, 0, At, B0); PG8_MMA(0, 1, At, B1); PG8_BAR; PG8_SCHED;
            PG8_LDA(At, 0, 1); PG8_STAGE(PG8_SB(0, 0), b2, voffB); PG8_STAGE(PG8_SB(0, 1), b2 + hstep, voffB); PG8_STAGE(PG8_SA(0, 0), a2, voffA);
            PG8_WAIT_V(8); PG8_WAIT_L(0); PG8_BAR; PG8_MMA(1, 0, At, B0); PG8_MMA(1, 1, At, B1); PG8_BAR; PG8_SCHED;
            PG8_LDB(B0, 1, 0); PG8_LDB(B1, 1, 1); PG8_SCHED; PG8_LDA(At, 1, 0); PG8_STAGE(PG8_SA(0, 1), a2 + hstep, voffA);
            PG8_WAIT_V(8); PG8_WAIT_L(0); PG8_BAR; PG8_MMA(0, 0, At, B0); PG8_MMA(0, 1, At, B1); PG8_BAR; PG8_SCHED;
            PG8_LDA(At, 1, 1); PG8_STAGE(PG8_SB(1, 0), b3, voffB); PG8_STAGE(PG8_SB(1, 1), b3 + hstep, voffB); PG8_STAGE(PG8_SA(1, 0), a3, voffA);
            PG8_WAIT_V(8); PG8_WAIT_L(0); PG8_BAR; PG8_MMA(1, 0, At, B0); PG8_MMA(1, 1, At, B1); PG8_BAR; PG8_SCHED;
            } else {
            PG8_LDB(B0, 0, 0); PG8_SCHED; PG8_LDA(At, 0, 0); PG8_STAGE(PG8_SA(1, 1), a1 + hstep, voffA);
            PG8_WAIT_L(8); PG8_BAR; PG8_WAIT_L(0); PG8_MMA(0, 0, At, B0); PG8_BAR; PG8_SCHED;
            PG8_LDB(B1, 0, 1); PG8_STAGE(PG8_SB(0, 0), b2, voffB);
            PG8_BAR; PG8_WAIT_L(0); PG8_MMA(0, 1, At, B1); PG8_BAR;
            PG8_LDA(At, 0, 1); PG8_STAGE(PG8_SA(0, 0), a2, voffA);
            PG8_BAR; PG8_WAIT_L(0); PG8_MMA(1, 0, At, B0); PG8_BAR; PG8_SCHED;
            PG8_STAGE(PG8_SB(0, 1), b2 + hstep, voffB);
            PG8_WAIT_V(6); PG8_BAR; PG8_MMA(1, 1, At, B1); PG8_BAR;
            PG8_LDB(B0, 1, 0); PG8_SCHED; PG8_LDA(At, 1, 0); PG8_STAGE(PG8_SA(0, 1), a2 + hstep, voffA);
            PG8_WAIT_L(8); PG8_BAR; PG8_WAIT_L(0); PG8_MMA(0, 0, At, B0); PG8_BAR; PG8_SCHED;
            PG8_LDB(B1, 1, 1); PG8_STAGE(PG8_SB(1, 0), b3, voffB);
            PG8_BAR; PG8_WAIT_L(0); PG8_MMA(0, 1, At, B1); PG8_BAR;
            PG8_LDA(At, 1, 1); PG8_STAGE(PG8_SA(1, 0), a3, voffA);
            PG8_BAR; PG8_WAIT_L(0); PG8_MMA(1, 0, At, B0); PG8_BAR; PG8_SCHED;
            PG8_STAGE(PG8_SB(1, 1), b3 + hstep, voffB);
            PG8_WAIT_V(6); PG8_BAR; PG8_MMA(1, 1, At, B1); PG8_BAR;
            }
        }
        if constexpr (ALIGN_EPI) { if (wr == 0) PG8_BAR; }
        if constexpr (!Epi::AFTER_DRAIN) { E(acc, cur, wr, wc, fr, fq); S.done(cur); }
        if (!has_next) break;
#pragma unroll
        for (int a = 0; a < 2; ++a)
#pragma unroll
            for (int b = 0; b < 2; ++b)
#pragma unroll
                for (int m = 0; m < 4; ++m)
#pragma unroll
                    for (int n = 0; n < 2; ++n) acc[a][b][m][n] = (f32x4){0.f, 0.f, 0.f, 0.f};
        cur = nxt; cA = nA; cB = nB; ++ui;
        if constexpr (ALIGN_EPI) { if (wr == 1) PG8_BAR; }
    }
    PG8_WAIT_V(0);
    if constexpr (!ALIGN_EPI) { if (wr == 0) PG8_BAR; }
    PG8_BAR;
    if constexpr (Epi::AFTER_DRAIN) { E.fused(acc, cur, wr, wc, fr, fq, lds, wid, lane); S.done(cur); }
#undef PG8_SA
#undef PG8_SB
#undef PG8_STAGE
#undef PG8_LDA
#undef PG8_LDB
#undef PG8_MMA
#undef PG8_WAIT_V
#undef PG8_WAIT_L
#undef PG8_BAR
#undef PG8_SCHED
}
}
#ifndef PG8_SP2
#define PG8_SP2 true
#endif
#ifndef PG8_ALIGN
#define PG8_ALIGN true
#endif
namespace attn_body {
using bf16=__hip_bfloat16;
using bf16x8=__attribute__((ext_vector_type(8)))short;
using s16x4=__attribute__((ext_vector_type(4)))short;
using f32x16=__attribute__((ext_vector_type(16)))float;
using u32x4=__attribute__((ext_vector_type(4)))unsigned;
using f32x4v=__attribute__((ext_vector_type(4)))float;
constexpr int BATCH=4,NHEAD=8,SEQ=4096,D=64,DM=NHEAD*D,DMO=1024;
constexpr int NW=8,QBLK=32,QB=QBLK*NW,KVBLK=64,NQB=SEQ/QB;
constexpr int ATTN_PITCH=DM, ATTN_UNIT_ROWS=QB;
__device__ __forceinline__ int crow(int r,int hi){return (r&3)+8*(r>>2)+4*hi;}
#define SBAR() __builtin_amdgcn_sched_barrier(0)
__device__ __forceinline__ void cmask(f32x16&p0,f32x16&p1,int jb,int qrel,int hi){
  const float NEG=-INFINITY; int kb=64*jb+4*hi;
  #pragma unroll
  for(int r=0;r<16;++r){int kv=kb+(r&3)+8*(r>>2); if(kv>qrel)p0[r]=NEG; if(kv+32>qrel)p1[r]=NEG;}
}

constexpr int NSLOT=3, SLOTB=8192;
constexpr int LDS_K=0, LDS_V=NSLOT*SLOTB, LDS_WS=2*NSLOT*SLOTB, LDS_OST=LDS_WS+NW*64*4, LDS_CS=LDS_OST+NW*4096, LDS_BYTES=LDS_CS+SEQ*4+64;
constexpr float C2=0.125f*1.4426950408889634f;
__device__ __forceinline__ void glds16(const void*gsrc,unsigned lds_dst){unsigned keep;
  asm volatile("s_mov_b32 %0, m0\n\ts_mov_b32 m0, %2\n\ts_nop 0\n\tglobal_load_lds_dwordx4 %1, off\n\ts_mov_b32 m0, %0":"=&s"(keep):"v"(gsrc),"s"(lds_dst):"memory");}
__device__ __forceinline__ float max3f(float a,float b,float c){float r;asm("v_max3_f32 %0, %1, %2, %3":"=v"(r):"v"(a),"v"(b),"v"(c));return r;}
__device__ __forceinline__ float max2f(float a,float b){float r;asm("v_max_f32_e32 %0, %1, %2":"=v"(r):"v"(a),"v"(b));return r;}
__device__ __forceinline__ float fadd_s(float a,float b){float r;asm("v_add_f32_e32 %0, %1, %2":"=v"(r):"v"(a),"v"(b));return r;}
__device__ __forceinline__ float fsub_s(float a,float b){float r;asm("v_sub_f32_e32 %0, %1, %2":"=v"(r):"v"(a),"v"(b));return r;}
typedef float f32x2_t __attribute__((ext_vector_type(2))); typedef __bf16 bf16x2_t __attribute__((ext_vector_type(2)));
__device__ __forceinline__ unsigned cvtpk_s(float lo,float hi){f32x2_t v={lo,hi};bf16x2_t b=__builtin_convertvector(v,bf16x2_t);return __builtin_bit_cast(unsigned,b);}
#define WAIT_BAR(N) asm volatile("s_waitcnt vmcnt(" #N ") lgkmcnt(0)\n\ts_barrier":::"memory")

__device__ __forceinline__ void qkt(f32x16&p0,f32x16&p1,const char*Kslot,const bf16x8*qr,const f32x16&c0,const f32x16&c1,int r32,int hi){
  const char*kb=Kslot+hi*1024+r32*16;
  #pragma unroll
  for(int d0=0;d0<4;++d0){
    const bf16x8 b0=*reinterpret_cast<const bf16x8*>(kb+d0*2048);
    const bf16x8 b1=*reinterpret_cast<const bf16x8*>(kb+d0*2048+512);
    if(d0==0){p0=__builtin_amdgcn_mfma_f32_32x32x16_bf16(b0,qr[0],c0,0,0,0);p1=__builtin_amdgcn_mfma_f32_32x32x16_bf16(b1,qr[0],c1,0,0,0);}
    else{p0=__builtin_amdgcn_mfma_f32_32x32x16_bf16(b0,qr[d0],p0,0,0,0);p1=__builtin_amdgcn_mfma_f32_32x32x16_bf16(b1,qr[d0],p1,0,0,0);}}
}
typedef __attribute__((address_space(3))) const char* lds_cptr;
typedef short v4i16_t __attribute__((ext_vector_type(4)));
__device__ __forceinline__ void kload8(bf16x8*kf,lds_cptr kp){
  kf[0]=*(const __attribute__((address_space(3))) bf16x8*)(kp);      kf[1]=*(const __attribute__((address_space(3))) bf16x8*)(kp+512);
  kf[2]=*(const __attribute__((address_space(3))) bf16x8*)(kp+2048); kf[3]=*(const __attribute__((address_space(3))) bf16x8*)(kp+2560);
  kf[4]=*(const __attribute__((address_space(3))) bf16x8*)(kp+4096); kf[5]=*(const __attribute__((address_space(3))) bf16x8*)(kp+4608);
  kf[6]=*(const __attribute__((address_space(3))) bf16x8*)(kp+6144); kf[7]=*(const __attribute__((address_space(3))) bf16x8*)(kp+6656);
}
__device__ __forceinline__ void kload2(bf16x8*kf,lds_cptr kp,int j){ kf[2*j]=*(const __attribute__((address_space(3))) bf16x8*)(kp+j*2048); kf[2*j+1]=*(const __attribute__((address_space(3))) bf16x8*)(kp+j*2048+512); }
__device__ __forceinline__ s16x4 vtr(lds_cptr p){ return __builtin_bit_cast(s16x4,__builtin_amdgcn_ds_read_tr16_b64_v4i16((__attribute__((address_space(3))) v4i16_t*)p)); }
__device__ __forceinline__ float rowmax(const f32x16&p0,const f32x16&p1){
  float a=max3f(p0[0],p0[1],p1[0]),b=max3f(p0[2],p0[3],p1[1]);a=max3f(a,p1[2],p1[3]);
  #pragma unroll
  for(int r=4;r<16;r+=4){a=max3f(a,p0[r],p0[r+1]);b=max3f(b,p0[r+2],p0[r+3]);a=max3f(a,p1[r],p1[r+1]);b=max3f(b,p1[r+2],p1[r+3]);}
  const float m=max2f(a,b);
  auto rr=__builtin_amdgcn_permlane32_swap(__float_as_uint(m),__float_as_uint(m),false,false);
  return max2f(__uint_as_float(rr[0]),__uint_as_float(rr[1]));
}
__device__ __forceinline__ void pv(f32x16*o,int vb,bf16x8 pa0,bf16x8 pa1,bf16x8 pa2,bf16x8 pa3){
  #pragma unroll
  for(int d0=0;d0<2;++d0){s16x4 lo[4],hi[4];
    #pragma unroll
    for(int ks=0;ks<4;++ks){
      asm volatile("ds_read_b64_tr_b16 %0,%1 offset:%c2":"=&v"(lo[ks]):"v"(vb),"i"(d0*4096+ks*1024):"memory");
      asm volatile("ds_read_b64_tr_b16 %0,%1 offset:%c2":"=&v"(hi[ks]):"v"(vb),"i"(d0*4096+ks*1024+512):"memory");}
    asm volatile("s_waitcnt lgkmcnt(0)":::"memory");SBAR();
    #define PK(k) (bf16x8){lo[k][0],lo[k][1],lo[k][2],lo[k][3],hi[k][0],hi[k][1],hi[k][2],hi[k][3]}
    o[d0]=__builtin_amdgcn_mfma_f32_32x32x16_bf16(pa0,PK(0),o[d0],0,0,0);
    o[d0]=__builtin_amdgcn_mfma_f32_32x32x16_bf16(pa1,PK(1),o[d0],0,0,0);
    o[d0]=__builtin_amdgcn_mfma_f32_32x32x16_bf16(pa2,PK(2),o[d0],0,0,0);
    o[d0]=__builtin_amdgcn_mfma_f32_32x32x16_bf16(pa3,PK(3),o[d0],0,0,0);
    #undef PK
  }
}

#ifndef ATTN_STORE16
#define ATTN_STORE16(p,v) (*(u32x4*)(p)=(v))
#endif
template<int THRL> __device__ __forceinline__ void attn_unit(int b,int h,int qb,const bf16*Q,const bf16*__restrict__ K,const bf16*__restrict__ V,bf16*O,const float*__restrict__ LFrow,char*shm){
  const int tid=threadIdx.x,lane=tid&63,r32=lane&31,hi=lane>>5; const int wid=__builtin_amdgcn_readfirstlane(tid>>6);
  const long rowbase=(long)b*SEQ; const int q0=qb*QB;
  const bf16*Qw=Q+(rowbase+q0+wid*QBLK)*DM+h*D;
  const bf16*Kh=K+rowbase*DM+h*D,*Vh=V+rowbase*DM+h*D;
  const lds_cptr shm3=(lds_cptr)shm;
  const unsigned lds0=(unsigned)(uintptr_t)shm;
  float*wsf=(float*)(shm+LDS_WS)+wid*64;
  const bf16*ksrc=Kh+(long)lane*DM+wid*8;
  const bf16*vsrc=Vh+(long)(16*(wid&3)+(lane>>2))*DM+(wid>>2)*32+(lane&3)*8;
  const unsigned kdst=lds0+LDS_K+wid*1024, vdst=lds0+LDS_V+wid*1024;
  #define DMA_K(t,slot) glds16(ksrc+(long)(t)*KVBLK*DM,(unsigned)__builtin_amdgcn_readfirstlane(kdst+(slot)))
  #define DMA_V(t,slot) glds16(vsrc+(long)(t)*KVBLK*DM,(unsigned)__builtin_amdgcn_readfirstlane(vdst+(slot)))
  const int vb0=(int)(lds0+LDS_V)+((lane>>4)&1)*32+(lane&3)*8+(4*hi+((lane&15)>>2))*64;
  const char*Kbase=shm+LDS_K; bf16x8 kf[8];
  const lds_cptr kp0=shm3+LDS_K+hi*1024+r32*16; const lds_cptr vp0=shm3+LDS_V+((lane>>4)&1)*32+(lane&3)*8+(4*hi+((lane&15)>>2))*64;
  const int NT=(q0+QB)/KVBLK;
  typedef __attribute__((address_space(3))) float lds_f32; typedef __attribute__((address_space(3))) f32x4v lds_f32x4;
  lds_f32* const csl=(lds_f32*)(shm3+LDS_CS);
  { const int ncs=q0+QB, i0=tid*8; f32x4v ca={0.f,0.f,0.f,0.f},cb={0.f,0.f,0.f,0.f};
    if(i0<ncs){ca=*(const f32x4v*)(LFrow+i0);cb=*(const f32x4v*)(LFrow+i0+4);}
    ca.y+=ca.x;ca.z+=ca.y;ca.w+=ca.z;cb.x+=ca.w;cb.y+=cb.x;cb.z+=cb.y;cb.w+=cb.z;
    const float tot=cb.w; float inc=tot;
    _Pragma("unroll") for(int o_=1;o_<64;o_<<=1){const float v_=__shfl_up(inc,o_);if(lane>=o_)inc+=v_;}
    if(lane==63)csl[SEQ+wid]=inc;
    asm volatile("s_waitcnt vmcnt(0) lgkmcnt(0)\n\ts_barrier":::"memory");
    float base_=inc-tot;
    _Pragma("unroll") for(int w_=0;w_<NW;++w_){const float t_=csl[SEQ+w_];if(w_<wid)base_+=t_;}
    if(i0<ncs){*(lds_f32x4*)(csl+i0)=ca+base_;*(lds_f32x4*)(csl+i0+4)=cb+base_;}
    asm volatile("s_waitcnt vmcnt(0) lgkmcnt(0)\n\ts_barrier":::"memory"); }
  const float cq=csl[q0+wid*QBLK+r32];
  const lds_cptr csb=shm3+LDS_CS+hi*16;
  #define CINIT(C0,C1,t) do{ _Pragma("unroll") for(int g_=0;g_<4;++g_){ const f32x4v a_=*(const lds_f32x4*)(csb+(t)*256+g_*32), b_=*(const lds_f32x4*)(csb+(t)*256+128+g_*32); \
      C0[4*g_]=cqm-a_.x;C0[4*g_+1]=cqm-a_.y;C0[4*g_+2]=cqm-a_.z;C0[4*g_+3]=cqm-a_.w; C1[4*g_]=cqm-b_.x;C1[4*g_+1]=cqm-b_.y;C1[4*g_+2]=cqm-b_.z;C1[4*g_+3]=cqm-b_.w; } }while(0)
  DMA_K(0,0);DMA_V(0,0);DMA_K(1,SLOTB);
  bf16x8 qr[4];
  #pragma unroll
  for(int d0=0;d0<4;++d0)qr[d0]=*reinterpret_cast<const bf16x8*>(&Qw[(long)r32*DM+d0*16+hi*8]);
  float mhat=0.f,l_reg=0.f,cqm=cq;f32x16 o[2];o[0]=f32x16{};o[1]=f32x16{};
  const int qrel=wid*QBLK+r32;
  #define CMASK(P0,P1,t) do{int jb_=(t)-(NT-4); if(jb_>=0)cmask(P0,P1,jb_,qrel,hi);}while(0)
  bool resc=false;
  #define START(P0,P1) do{ const float rm=rowmax(P0,P1); resc=false; \
    { const float dl=rm; mhat=fadd_s(mhat,dl); \
      _Pragma("unroll") for(int r=0;r<16;++r){P0[r]=fsub_s(P0[r],dl);P1[r]=fsub_s(P1[r],dl);} \
      cqm=cq-mhat; } \
    _Pragma("unroll") for(int r=0;r<16;++r)P0[r]=__builtin_amdgcn_exp2f(P0[r]); }while(0)
  #define RESC() do{ if(resc){ asm volatile("s_waitcnt lgkmcnt(0)":::"memory"); \
      _Pragma("unroll") for(int d_=0;d_<2;++d_) _Pragma("unroll") for(int r=0;r<16;++r)o[d_][r]*=wsf[crow(r,hi)]; } }while(0)
  f32x16 pA0,pA1,pB0,pB1;
  int sl_prev=0,sl_cur=0,sl_next=SLOTB;
  #define ROT() do{sl_prev=sl_cur;sl_cur=sl_next;sl_next=(sl_next==(NSLOT-1)*SLOTB)?0:sl_next+SLOTB;}while(0)
  DMA_K(2,2*SLOTB);
  WAIT_BAR(3);
  { f32x16 ci0,ci1; CINIT(ci0,ci1,0); qkt(pA0,pA1,Kbase,qr,ci0,ci1,r32,hi); } asm volatile("s_nop 15\n\ts_nop 7":"+v"(pA0),"+v"(pA1));CMASK(pA0,pA1,0);
  START(pA0,pA1);
  _Pragma("unroll") for(int r=0;r<16;++r)pA1[r]=__builtin_amdgcn_exp2f(pA1[r]);
  WAIT_BAR(0);
  DMA_K(3,0);DMA_V(1,SLOTB);
  ROT();
  kload8(kf,kp0+sl_cur);
  WAIT_BAR(2);
  s16x4 vlo[8],vhi[8]; u32x4 pw0,pw1,pw2,pw3;
  #define PKW(P,B) cvtpk_s(P[B],P[B+1])
  #define PAF(k) __builtin_bit_cast(bf16x8,pw##k)
  #define VFR(i) (bf16x8){vlo[i][0],vlo[i][1],vlo[i][2],vlo[i][3],vhi[i][0],vhi[i][1],vhi[i][2],vhi[i][3]}
  #define PIN(x) asm volatile("":"+v"(x))
  #define MX3(a,b,c) __builtin_fmaxf(__builtin_fmaxf((a),(b)),(c))
  #define GAPA(MF,A0,A1,A2,A3,W0,W1,PW) do{ MF; sacc+=A0; sacc+=A1; sacc+=A2; sacc+=A3; PIN(sacc); W0; W1; PIN(PW); SBAR(); }while(0)
  #define EX(v) __builtin_amdgcn_exp2f(v)
  #define GAPB(MF,X,B) do{ MF; X[B]=EX(X[B]); X[B+1]=EX(X[B+1]); X[B+2]=EX(X[B+2]); X[B+3]=EX(X[B+3]); PIN(X); SBAR(); }while(0)
  #define VRD(i) do{ vlo[i]=vtr(vp_+(((i)>>2)*4096+((i)&3)*1024)); vhi[i]=vtr(vp_+(((i)>>2)*4096+((i)&3)*1024+512)); }while(0)
  #define KRD(G,j) do{ if(G){ kload2(kf,kp0+sl_next,j); SBAR(); } }while(0)
  #define STEP(C0,C1,P0,P1,t,GK,GV,GL) do{ SBAR(); \
    CINIT(C0,C1,t); SBAR(); \
    const lds_cptr vp_=vp0+sl_prev; \
    VRD(0); SBAR(); float sacc=(P0[0]+P0[1]); \
    GAPA(C0=__builtin_amdgcn_mfma_f32_32x32x16_bf16(kf[0],qr[0],C0,0,0,0), P0[2],P0[3],P0[4],P0[5],     pw0[0]=PKW(P0,0), pw0[1]=PKW(P0,2), pw0); \
    VRD(4); SBAR(); GAPA(C1=__builtin_amdgcn_mfma_f32_32x32x16_bf16(kf[1],qr[0],C1,0,0,0), P0[6],P0[7],P0[8],P0[9],     pw0[2]=PKW(P0,4), pw0[3]=PKW(P0,6), pw0); \
    VRD(1); SBAR(); GAPA(C0=__builtin_amdgcn_mfma_f32_32x32x16_bf16(kf[2],qr[1],C0,0,0,0),   P0[10],P0[11],P0[12],P0[13], pw1[0]=PKW(P0,8), pw1[1]=PKW(P0,10), pw1); \
    VRD(5); SBAR(); GAPA(C1=__builtin_amdgcn_mfma_f32_32x32x16_bf16(kf[3],qr[1],C1,0,0,0),   P0[14],P0[15],P1[0],P1[1],   pw1[2]=PKW(P0,12),pw1[3]=PKW(P0,14), pw1); \
    VRD(2); SBAR(); GAPA(C0=__builtin_amdgcn_mfma_f32_32x32x16_bf16(kf[4],qr[2],C0,0,0,0),   P1[2],P1[3],P1[4],P1[5],     pw2[0]=PKW(P1,0), pw2[1]=PKW(P1,2), pw2); \
    VRD(6); SBAR(); GAPA(C1=__builtin_amdgcn_mfma_f32_32x32x16_bf16(kf[5],qr[2],C1,0,0,0),   P1[6],P1[7],P1[8],P1[9],     pw2[2]=PKW(P1,4), pw2[3]=PKW(P1,6), pw2); \
    VRD(3); SBAR(); GAPA(C0=__builtin_amdgcn_mfma_f32_32x32x16_bf16(kf[6],qr[3],C0,0,0,0),   P1[10],P1[11],P1[12],P1[13], pw3[0]=PKW(P1,8), pw3[1]=PKW(P1,10), pw3); \
    VRD(7); SBAR(); GAPA(C1=__builtin_amdgcn_mfma_f32_32x32x16_bf16(kf[7],qr[3],C1,0,0,0),   P1[14],P1[15],0.f,0.f,       pw3[2]=PKW(P1,12),pw3[3]=PKW(P1,14), pw3); \
    l_reg+=sacc; \
    if(GK){DMA_K((t)+3,sl_cur);} if(GV){DMA_V((t)+1,sl_next);} \
    CMASK(C0,C1,t); \
    { float a=MX3(C0[0],C0[1],C1[0]),b=MX3(C0[2],C0[3],C1[1]); a=MX3(a,C1[2],C1[3]); \
      _Pragma("unroll") for(int r=4;r<16;r+=4){a=MX3(a,C0[r],C0[r+1]);b=MX3(b,C0[r+2],C0[r+3]);a=MX3(a,C1[r],C1[r+1]);b=MX3(b,C1[r+2],C1[r+3]);} \
      float rm=__builtin_fmaxf(a,b); { auto rr=__builtin_amdgcn_permlane32_swap(__float_as_uint(rm),__float_as_uint(rm),false,false); rm=__builtin_fmaxf(__uint_as_float(rr[0]),__uint_as_float(rr[1])); } \
      resc=false; \
      if(__builtin_expect(__any(rm>(float)THRL),0)){ const float dl=__builtin_fmaxf(rm,0.f); mhat+=dl; \
        _Pragma("unroll") for(int r=0;r<16;++r){C0[r]-=dl;C1[r]-=dl;} \
        cqm=cq-mhat; \
        const float f=__builtin_amdgcn_exp2f(-dl); l_reg*=f; if(hi==0)wsf[r32]=f; resc=true; } } \
    SBAR(); \
    GAPB(o[0]=__builtin_amdgcn_mfma_f32_32x32x16_bf16(PAF(0),VFR(0),o[0],0,0,0), C0,0); \
    GAPB(o[1]=__builtin_amdgcn_mfma_f32_32x32x16_bf16(PAF(0),VFR(4),o[1],0,0,0), C0,4); \
    KRD(GL,0); GAPB(o[0]=__builtin_amdgcn_mfma_f32_32x32x16_bf16(PAF(1),VFR(1),o[0],0,0,0), C0,8); \
    KRD(GL,1); GAPB(o[1]=__builtin_amdgcn_mfma_f32_32x32x16_bf16(PAF(1),VFR(5),o[1],0,0,0), C0,12); \
    KRD(GL,2); GAPB(o[0]=__builtin_amdgcn_mfma_f32_32x32x16_bf16(PAF(2),VFR(2),o[0],0,0,0), C1,0); \
    KRD(GL,3); GAPB(o[1]=__builtin_amdgcn_mfma_f32_32x32x16_bf16(PAF(2),VFR(6),o[1],0,0,0), C1,4); \
    GAPB(o[0]=__builtin_amdgcn_mfma_f32_32x32x16_bf16(PAF(3),VFR(3),o[0],0,0,0), C1,8); \
    GAPB(o[1]=__builtin_amdgcn_mfma_f32_32x32x16_bf16(PAF(3),VFR(7),o[1],0,0,0), C1,12); \
    }while(0)
  int t=1;
  #undef CMASK
  #define CMASK(P0,P1,t) do{}while(0)
  for(;t+5<NT;t+=2){
    STEP(pB0,pB1,pA0,pA1,t,true,true,true);     WAIT_BAR(2); RESC(); ROT();
    STEP(pA0,pA1,pB0,pB1,t+1,true,true,true);   WAIT_BAR(2); RESC(); ROT();
  }
  #undef CMASK
  #define CMASK(P0,P1,t) do{int jb_=(t)-(NT-4); if(jb_>=0)cmask(P0,P1,jb_,qrel,hi);}while(0)
  #define ENDW(tt) do{ if((tt)+3<NT){WAIT_BAR(2);} else if((tt)+2<NT){WAIT_BAR(1);} else {WAIT_BAR(0);} }while(0)
  for(;t+1<NT;t+=2){
    STEP(pB0,pB1,pA0,pA1,t,(t+3<NT),(t+1<NT),(t+1<NT));       ENDW(t);   RESC(); ROT();
    STEP(pA0,pA1,pB0,pB1,t+1,(t+4<NT),(t+2<NT),(t+2<NT));     ENDW(t+1); RESC(); ROT();
  }
  STEP(pB0,pB1,pA0,pA1,NT-1,false,false,false); RESC();
  { float sacc=pB0[0]+pB0[1]; _Pragma("unroll") for(int r=2;r<16;++r)sacc+=pB0[r]; _Pragma("unroll") for(int r=0;r<16;++r)sacc+=pB1[r]; l_reg+=sacc;
    pw0=(u32x4){PKW(pB0,0),PKW(pB0,2),PKW(pB0,4),PKW(pB0,6)};pw1=(u32x4){PKW(pB0,8),PKW(pB0,10),PKW(pB0,12),PKW(pB0,14)};pw2=(u32x4){PKW(pB1,0),PKW(pB1,2),PKW(pB1,4),PKW(pB1,6)};pw3=(u32x4){PKW(pB1,8),PKW(pB1,10),PKW(pB1,12),PKW(pB1,14)};
    SBAR(); pv(o,vb0+sl_cur,PAF(0),PAF(1),PAF(2),PAF(3)); }
  #undef PKW
  #undef PAF
  #undef VFR
  #undef PIN
  #undef MX3
  #undef GAPA
  #undef GAPB
  #undef EX
  #undef VRD
  #undef KRD
  #undef STEP
  #undef ENDW
  {auto rr=__builtin_amdgcn_permlane32_swap(__float_as_uint(l_reg),__float_as_uint(l_reg),false,false);l_reg=__uint_as_float(rr[0])+__uint_as_float(rr[1]);}
  if(hi==0)wsf[32+r32]=l_reg;asm volatile("s_waitcnt lgkmcnt(0)":::"memory");
  float rli[16];
  #pragma unroll
  for(int r=0;r<16;++r)rli[r]=__builtin_amdgcn_rcpf(wsf[32+crow(r,hi)]);
  bf16*Ow=O+(rowbase+q0+wid*QBLK)*DMO+h*D;
  { bf16*stg=(bf16*)(shm+LDS_OST)+wid*2048;
    #pragma unroll
    for(int r=0;r<16;++r){const int orow=crow(r,hi);
      #pragma unroll
      for(int d0=0;d0<2;++d0)stg[orow*64+d0*32+r32]=__float2bfloat16(o[d0][r]*rli[r]);}
    asm volatile("s_waitcnt lgkmcnt(0)":::"memory");
    #pragma unroll
    for(int i=0;i<4;++i){const int row=i*8+(lane>>3),ch=lane&7; const u32x4 v=*(const u32x4*)(stg+row*64+ch*8); ATTN_STORE16(Ow+(long)row*DMO+ch*8,v);} }
  asm volatile("s_waitcnt lgkmcnt(0)\n\ts_barrier":::"memory");
  #undef DMA_K
  #undef DMA_V
  #undef CMASK
  #undef START
  #undef RESC
  #undef ROT
  #undef CINIT
}
constexpr int ATTN_LDS_BYTES=LDS_BYTES;
struct AttnTensors { const bf16* Q; const bf16* K; const bf16* V; bf16* O; const float* LF; };
struct AttnUnit { int bh; int qb; };
struct StaticOrder {
  int vcu, G;
  __device__ __forceinline__ StaticOrder(int grid,int vcu_):vcu(vcu_),G(grid){}
  __device__ __forceinline__ bool next(int i,AttnUnit&u)const{
    if(G==256){ if(i>=2)return false; const int s=vcu&7; u.bh=vcu>>3; u.qb=(i==0)?15-s:s; return true; }
    const int idx=i*G+vcu; if(idx>=BATCH*NHEAD*NQB)return false; u.qb=NQB-1-idx/(BATCH*NHEAD); u.bh=idx%(BATCH*NHEAD); return true; }
  __device__ __forceinline__ void a_ready(const AttnUnit&)const{}
  __device__ __forceinline__ void done(const AttnUnit&)const{}
};
template<class Sched,int THRL=8> __device__ __forceinline__ void attn_phase(char*lds,const AttnTensors&T,const Sched&S){
  AttnUnit u;
  for(int i=0;S.next(i,u);++i){ S.a_ready(u); attn_unit<THRL>(u.bh/NHEAD,u.bh%NHEAD,u.qb,T.Q,T.K,T.V,T.O,T.LF+(size_t)u.bh*SEQ,lds); S.done(u); }
}
#undef SBAR
#undef WAIT_BAR
}
#define GAS __attribute__((address_space(1)))
#define LAS __attribute__((address_space(3)))
typedef unsigned short bf16;
typedef unsigned v4u __attribute__((ext_vector_type(4)));
typedef float f32x4 __attribute__((ext_vector_type(4)));
typedef short bf16x8 __attribute__((ext_vector_type(8)));
typedef GAS unsigned gu32;
typedef GAS unsigned long long gu64;
#define RLX_AGENT __ATOMIC_RELAXED, __HIP_MEMORY_SCOPE_AGENT
#define LDS_WAIT() asm volatile("s_waitcnt lgkmcnt(0)" ::: "memory")
#define VM_WAIT() asm volatile("s_waitcnt vmcnt(0)" ::: "memory")
__device__ __forceinline__ unsigned long long rt() { return __builtin_amdgcn_s_memrealtime(); }
__device__ __forceinline__ unsigned f2bf(float f) { unsigned u = __builtin_bit_cast(unsigned, f); return (u + 0x7fffu + ((u >> 16) & 1u)) >> 16; }
__device__ __forceinline__ unsigned pk2(float lo, float hi) { return f2bf(lo) | (f2bf(hi) << 16); }

#define XB_TMO      128
#define XB_XCNT(j)  (256  + 64 * (j))
#define XB_XSUB(j)  (1280 + 64 * (j))
#define XB_XGEN(j)  (2304 + 64 * (j))
#define XB_TOP      3328
#define XB_TOPGEN   3392
#define XCD_BAR_WORDS 3456
#define XB_SPIN_CAP (1u << 18)

__device__ __forceinline__ unsigned xb_ld(unsigned* p)              { return __hip_atomic_load(p, __ATOMIC_RELAXED, __HIP_MEMORY_SCOPE_AGENT); }
__device__ __forceinline__ unsigned xb_add(unsigned* p, unsigned v) { return __hip_atomic_fetch_add(p, v, __ATOMIC_RELAXED, __HIP_MEMORY_SCOPE_AGENT); }
__device__ __forceinline__ unsigned xb_xcc_id() { return (unsigned)__builtin_amdgcn_s_getreg((3 << 11) | 20) & 0xFu; }
#define XB_SPIN(cond, bar) do { unsigned _sp = 0; while (cond) { __builtin_amdgcn_s_sleep(1); \
    if ((++_sp & 255u) == 0u) { if (xb_ld(&(bar)[XB_TMO])) break; if (_sp > XB_SPIN_CAP) { atomicAdd(&(bar)[XB_TMO], 1u); break; } } } } while (0)

struct XcdBarrier {
    unsigned* bar; unsigned x;
    volatile LAS unsigned* st;
};

__device__ __forceinline__ XcdBarrier xcd_barrier_post(unsigned* bar, volatile LAS unsigned* st) {
    XcdBarrier b; b.bar = bar; b.x = xb_xcc_id(); b.st = st;
    if (threadIdx.x == 0) (void)xb_add(&bar[XB_XCNT(b.x)], 1u);
    return b;
}
__device__ __forceinline__ void xcd_barrier_complete(unsigned* bar, unsigned x, unsigned& nloc, unsigned& nx) {
    const unsigned G = gridDim.x * gridDim.y * gridDim.z;
    unsigned sum, cnt, mine, sp = 0u;
    for (;;) {
        sum = 0u; cnt = 0u; mine = 0u;
#pragma unroll
        for (unsigned j = 0; j < 16; ++j) { const unsigned c = xb_ld(&bar[XB_XCNT(j)]); sum += c; cnt += (c > 0u) ? 1u : 0u; mine = (j == x) ? c : mine; }
        if (sum == G) break;
        __builtin_amdgcn_s_sleep(1);
        if ((++sp & 255u) == 0u) { if (xb_ld(&bar[XB_TMO])) break; if (sp > XB_SPIN_CAP) { atomicAdd(&bar[XB_TMO], 1u); break; } }
    }
    nloc = mine > 0u ? mine : 1u; nx = cnt > 0u ? cnt : 1u;
}

__device__ __forceinline__ void xcd_barrier(const XcdBarrier& b) {
    asm volatile("s_waitcnt vmcnt(0)" ::: "memory");
    __syncthreads();
    if (threadIdx.x == 0) {
        unsigned* bar = b.bar;
        __builtin_amdgcn_s_waitcnt(0);
        unsigned nloc = b.st[0], nx = b.st[1];
        if (nloc == 0u) { xcd_barrier_complete(bar, b.x, nloc, nx); b.st[0] = nloc; b.st[1] = nx; }
        const unsigned old = xb_add(&bar[XB_XSUB(b.x)], 1u);
        const unsigned gen = old / nloc;
        if (old + 1u == (gen + 1u) * nloc) {
            __builtin_amdgcn_fence(__ATOMIC_RELEASE, "agent");
            asm volatile("s_waitcnt vmcnt(0)" ::: "memory");
            const unsigned og = xb_add(&bar[XB_TOP], 1u);
            const unsigned tg = og / nx;
            if (og + 1u == (tg + 1u) * nx) xb_add(&bar[XB_TOPGEN], 1u);
            else XB_SPIN(xb_ld(&bar[XB_TOPGEN]) == tg, bar);
            __builtin_amdgcn_fence(__ATOMIC_ACQUIRE, "agent");
            xb_add(&bar[XB_XGEN(b.x)], 1u);
            asm volatile("s_waitcnt vmcnt(0)" ::: "memory");
        } else {
            XB_SPIN(xb_ld(&bar[XB_XGEN(b.x)]) == gen, bar);
            __builtin_amdgcn_fence(__ATOMIC_ACQUIRE, "agent");
            asm volatile("s_waitcnt vmcnt(0)" ::: "memory");
        }
    }
    __syncthreads();
}

constexpr int NWAVES = 8;
constexpr int BATCH = 4, SEQ = 4096, D = 1024, M = BATCH * SEQ, NH = 8, HD = 64, AW = 512, PLE = 256;
constexpr int NIN = 5120, INTOT = 5128, NKEYS = 128, NEXP = 16384, NS = 2048;
constexpr float EPS = 1e-6f, LOG2E = 1.4426950408889634f, C2 = 0.125f * LOG2E;
constexpr int NPHASE = 9;
constexpr int SLW = 128, NSL = D / SLW;
static_assert(NSL == 8, "one slice per XCD group; SS3 has 16 slots");

constexpr size_t MiB = 1u << 20;
constexpr size_t WS_CTL = 0, CTL_ZERO_BYTES = 64 * 1024;
constexpr size_t WS_RSTD1 = 1 * MiB, WS_RSTD3 = WS_RSTD1 + 65536, WS_LF = WS_RSTD3 + 65536, WS_CS = WS_LF + 524288, WS_SS2 = WS_CS + 524288, WS_WPP = WS_SS2 + 1048576;
constexpr size_t WS_SU = WS_RSTD3, WS_SV = WS_WPP + 524288;
static_assert(WS_SV + 65536 <= 4 * MiB, "small region");
constexpr size_t WS_WIN = 4 * MiB, WS_WBR = 14 * MiB, WS_WOUT = 16 * MiB, WS_WS = 18 * MiB, WS_WPG = 22 * MiB, WS_PB = 24 * MiB;
constexpr size_t WS_UB = 32 * MiB, WS_VB = 64 * MiB;
constexpr size_t WS_A = 96 * MiB;
constexpr size_t WS_PP = 128 * MiB;
constexpr size_t WS_Q = 160 * MiB, WS_K = 176 * MiB, WS_V = 192 * MiB, WS_GB = 208 * MiB, WS_Z = 224 * MiB;
constexpr size_t WS_MERGED = 160 * MiB, WS_XB2 = 192 * MiB, WS_IDS = 224 * MiB, WS_GATES = 232 * MiB;
constexpr size_t WS_END = 256 * MiB;
constexpr size_t WS_PART0 = 4 * MiB, WS_PART1 = 160 * MiB, WS_PART2 = 240 * MiB;
constexpr size_t WS_TGC = 32 * MiB, WS_TXC = 64 * MiB, WS_SC = 32 * MiB;
constexpr int CW_BAR = 1024;

constexpr int RING_OFF = 0, RING_BYTES = 135168;
constexpr int LDSCTL_OFF = RING_BYTES, MISC_OFF = LDSCTL_OFF + 320;
constexpr int LDS_BYTES = RING_BYTES + 1024;
static_assert(attn_body::ATTN_LDS_BYTES <= RING_BYTES && pg8::STAGE_BYTES <= RING_BYTES && 128 * pg8::EpiTopK::RS * 4 <= RING_BYTES, "LDS map");

typedef unsigned u32x4 __attribute__((ext_vector_type(4)));
typedef unsigned u32x2 __attribute__((ext_vector_type(2)));
__device__ __forceinline__ float bf2f(bf16 v) { return __uint_as_float((unsigned)v << 16); }
__device__ __forceinline__ float wave_sum(float v) {
#pragma unroll
    for (int o = 1; o < 64; o <<= 1) v += __shfl_xor(v, o);
    return v;
}
__device__ __forceinline__ float sigmoidf_(float v) { return 1.0f / (1.0f + __expf(-v)); }
__host__ __device__ __forceinline__ int src_in(int n) {
    const int pn = n >> 8, l = n & 255;
    if (pn < 6) return n;
    if (pn < 8) return 1544 + (n - 1536);
    if (pn < 12) { const int j = pn - 8; return (l < 128) ? 2056 + 128 * j + l : 2568 + 128 * j + (l - 128); }
    if (pn < 16) return 3080 + (n - 3072);
    return 4104 + (n - 4096);
}

struct Args { const float* in[18]; float* out; unsigned char* ws; int ph_lo, ph_hi, li, pad; };
struct Ctx {
    LAS unsigned char* lds; int tid, lane, wave, vcu, G;
};

__device__ __forceinline__ void tr_item(const float* __restrict__ W, int ldw, int k0, int scol0, const float* __restrict__ g, bf16* WT, int ldt, int drow0, int dk0, LAS float* scr, int lane) {
#pragma unroll 8
    for (int i = 0; i < 32; ++i) { const int kk = 2 * i + (lane >> 5); float v = W[(size_t)(k0 + kk) * ldw + scol0 + (lane & 31)]; if (g) v *= g[k0 + kk]; scr[kk * 33 + (lane & 31)] = v; }
    LDS_WAIT(); asm volatile("" ::: "memory");
    const int c = lane & 7;
#pragma unroll
    for (int j = 0; j < 4; ++j) { const int n = (lane >> 3) + 8 * j; const LAS float* s = scr + (8 * c) * 33 + n;
        v4u o; o.x = pk2(s[0 * 33], s[1 * 33]); o.y = pk2(s[2 * 33], s[3 * 33]); o.z = pk2(s[4 * 33], s[5 * 33]); o.w = pk2(s[6 * 33], s[7 * 33]);
        *(GAS v4u*)(WT + (size_t)(drow0 + n) * ldt + dk0 + 8 * c) = o; }
    LDS_WAIT(); asm volatile("" ::: "memory");
}
__device__ __forceinline__ void p0_prologue(const Ctx& F, const Args& a) {
    unsigned char* ws = a.ws;
    const float *x = a.in[0], *p = a.in[1], *g_mix = a.in[2], *w_in = a.in[3], *b_f = a.in[4], *w_branch = a.in[6], *w_out = a.in[7], *g_ffn = a.in[8], *w_peer_q = a.in[9],
                *pk1 = a.in[10], *pk2_ = a.in[11], *peer_u = a.in[12], *peer_v = a.in[13], *g_ple = a.in[14], *w_ple_gate = a.in[15], *w_ple_proj = a.in[16];
    bf16 *WIN = (bf16*)(ws + WS_WIN), *WBR = (bf16*)(ws + WS_WBR), *WOUT = (bf16*)(ws + WS_WOUT), *WST = (bf16*)(ws + WS_WS), *WPG = (bf16*)(ws + WS_WPG), *WPP = (bf16*)(ws + WS_WPP);
    bf16 *PB = (bf16*)(ws + WS_PB), *UB = (bf16*)(ws + WS_UB), *VB = (bf16*)(ws + WS_VB), *XB = (bf16*)(ws + WS_A);
    float *RSTD1 = (float*)(ws + WS_RSTD1), *LF = (float*)(ws + WS_LF);
    const int gw = F.vcu * NWAVES + F.wave, NGW = F.G * NWAVES, gt = F.vcu * 512 + F.tid, NGT = F.G * 512;
    {
        LAS float* KH = (LAS float*)(F.lds + RING_OFF); LAS float* WQ = KH + 128 * 129;
        for (int item = F.vcu; item < 512; item += F.G) {
            const int hh = item >> 5, head = hh >> 1, half = hh & 1, d0 = (item & 31) * 32;
            const float* kh = (half ? pk2_ : pk1) + (size_t)head * 128 * 128;
#pragma unroll 4
            for (int i = 0; i < 32; ++i) { const int idx = i * 512 + F.tid; KH[(idx >> 7) * 129 + (idx & 127)] = kh[idx]; }
#pragma unroll
            for (int i = 0; i < 8; ++i) { const int idx = i * 512 + F.tid; WQ[idx] = w_peer_q[(size_t)(d0 + (idx >> 7)) * NS + head * 256 + half * 128 + (idx & 127)]; }
            __syncthreads();
            const int key = F.tid & 127, dg = F.tid >> 7;
            float acc[8];
#pragma unroll
            for (int i = 0; i < 8; ++i) acc[i] = 0.f;
            for (int e = 0; e < 128; e += 4) {
                const float k0 = KH[key * 129 + e], k1 = KH[key * 129 + e + 1], k2 = KH[key * 129 + e + 2], k3 = KH[key * 129 + e + 3];
#pragma unroll
                for (int i = 0; i < 8; ++i) { const f32x4 w = *(const LAS f32x4*)(WQ + (dg * 8 + i) * 128 + e); acc[i] += (k0 * w[0] + k1 * w[1]) + (k2 * w[2] + k3 * w[3]); }
            }
            const int dd = d0 + dg * 8;
            v4u o; o.x = pk2(acc[0] * g_ffn[dd], acc[1] * g_ffn[dd + 1]); o.y = pk2(acc[2] * g_ffn[dd + 2], acc[3] * g_ffn[dd + 3]); o.z = pk2(acc[4] * g_ffn[dd + 4], acc[5] * g_ffn[dd + 5]); o.w = pk2(acc[6] * g_ffn[dd + 6], acc[7] * g_ffn[dd + 7]);
            *(GAS v4u*)(WST + (size_t)(head * 256 + half * 128 + key) * D + dd) = o;
            __syncthreads();
        }
    }
    {
        LAS float* scr = (LAS float*)(F.lds + RING_OFF + F.wave * 16384);
        constexpr int I_IN = 16 * 160, I_BR = 8 * 32, I_SQ = 16 * 32, I_PP = 4 * 32, NITEMS = I_IN + 2 * I_BR + 2 * I_SQ + I_PP;
        for (int it = gw; it < NITEMS; it += NGW) {
            int r = it;
            if (r < I_IN) { const int kb = r / 160, nb = r % 160; tr_item(w_in, INTOT, 64 * kb, src_in(32 * nb), g_mix, WIN, D, 32 * nb, 64 * kb, scr, F.lane); continue; } r -= I_IN;
            if (r < 2 * I_BR) { const int br = r / I_BR, q = r % I_BR, kb = q / 32, nb = q % 32; tr_item(w_branch + (size_t)br * AW * D, D, 64 * kb, 32 * nb, nullptr, WBR, D, 32 * nb, br * AW + 64 * kb, scr, F.lane); continue; } r -= 2 * I_BR;
            if (r < I_SQ) { const int kb = r / 32, nb = r % 32; tr_item(w_out, D, 64 * kb, 32 * nb, nullptr, WOUT, D, 32 * nb, 64 * kb, scr, F.lane); continue; } r -= I_SQ;
            if (r < I_SQ) { const int kb = r / 32, nb = r % 32; tr_item(w_ple_gate, D, 64 * kb, 32 * nb, g_ple, WPG, D, 32 * nb, 64 * kb, scr, F.lane); continue; } r -= I_SQ;
            { const int kb = r / 32, nb = r % 32; tr_item(w_ple_proj, D, 64 * kb, 32 * nb, nullptr, WPP, PLE, 32 * nb, 64 * kb, scr, F.lane); }
        }
    }
    __syncthreads();
    {
        LAS float* WFL = (LAS float*)(F.lds + RING_OFF);
#pragma unroll 4
        for (int i = 0; i < 16; ++i) { const int idx = i * 512 + F.tid, k = idx >> 3, h = idx & 7; WFL[h * 1024 + k] = g_mix[k] * w_in[(size_t)k * INTOT + 1536 + h]; }
        __syncthreads();
        for (int row = gw; row < M; row += NGW) {
            const GAS f32x4* xr = (const GAS f32x4*)(x + (size_t)row * D);
            f32x4 v[4]; float ss = 0.f;
#pragma unroll
            for (int j = 0; j < 4; ++j) { v[j] = xr[F.lane + 64 * j]; ss += (v[j].x * v[j].x + v[j].y * v[j].y) + (v[j].z * v[j].z + v[j].w * v[j].w); }
            ss = wave_sum(ss);
            const float rstd = 1.0f / sqrtf(ss * (1.0f / D) + EPS);
            GAS u32x2* o = (GAS u32x2*)(XB + (size_t)row * D);
#pragma unroll
            for (int j = 0; j < 4; ++j) { u32x2 w; w.x = pk2(v[j].x, v[j].y); w.y = pk2(v[j].z, v[j].w); o[F.lane + 64 * j] = w; }
            if (F.lane == 0) RSTD1[row] = rstd;
            float f[8];
#pragma unroll
            for (int h = 0; h < 8; ++h) { float s = 0.f;
#pragma unroll
                for (int j = 0; j < 4; ++j) { const f32x4 w = *(const LAS f32x4*)(WFL + h * 1024 + 4 * (F.lane + 64 * j)); s += (v[j].x * w[0] + v[j].y * w[1]) + (v[j].z * w[2] + v[j].w * w[3]); }
                f[h] = s; }
            const int b = row / SEQ, t = row % SEQ;
#pragma unroll
            for (int h = 0; h < 8; ++h) {
                const float tot = wave_sum(f[h]) * rstd + b_f[h];
                const float ls = fminf(tot, 0.f) - log1pf(__expf(-fabsf(tot)));
                if (F.lane == 0) LF[(size_t)(b * NH + h) * SEQ + t] = ls * LOG2E;
            }
        }
    }
    {
        constexpr int NU = NEXP * D / 8, NP = M * PLE / 8;
        {
            signed char* UQ = (signed char*)(ws + WS_UB); unsigned char* VQ = (unsigned char*)(ws + WS_VB); float *SU = (float*)(ws + WS_SU), *SV = (float*)(ws + WS_SV);
            f32x4 gq[4];
#pragma unroll
            for (int j = 0; j < 4; ++j) gq[j] = *(const GAS f32x4*)(g_ffn + 16 * F.lane + 4 * j);
            for (int r = gw; r < 2 * NEXP; r += NGW) {
                const bool isv = r >= NEXP; const int e = isv ? r - NEXP : r;
                const GAS f32x4* src = (const GAS f32x4*)((isv ? peer_v : peer_u) + (size_t)e * D + 16 * F.lane);
                f32x4 v[4]; float am = 0.f;
#pragma unroll
                for (int j = 0; j < 4; ++j) { v[j] = src[j]; if (!isv) v[j] = v[j] * gq[j]; am = fmaxf(am, fmaxf(fmaxf(fabsf(v[j].x), fabsf(v[j].y)), fmaxf(fabsf(v[j].z), fabsf(v[j].w)))); }
#pragma unroll
                for (int o = 1; o < 64; o <<= 1) am = fmaxf(am, __shfl_xor(am, o));
                const float sc = am > 0.f ? 127.0f / am : 0.f; const int off = isv ? 128 : 0;
                v4u o;
#pragma unroll
                for (int j = 0; j < 4; ++j) { const int q0 = (int)rintf(v[j].x * sc) + off, q1 = (int)rintf(v[j].y * sc) + off, q2 = (int)rintf(v[j].z * sc) + off, q3 = (int)rintf(v[j].w * sc) + off;
                    o[j] = (unsigned)(q0 & 255) | ((unsigned)(q1 & 255) << 8) | ((unsigned)(q2 & 255) << 16) | ((unsigned)(q3 & 255) << 24); }
                unsigned char* dst = (isv ? VQ : (unsigned char*)UQ) + ((size_t)(F.lane >> 3) * NEXP + e) * SLW + 16 * (F.lane & 7);
                *(GAS v4u*)dst = o;
                if (F.lane == 0) (isv ? SV : SU)[e] = am * (1.0f / 127.0f);
            }
        }
        for (int i = gt; i < NP; i += NGT) { const f32x4 a = ((const GAS f32x4*)p)[2 * (size_t)i], b = ((const GAS f32x4*)p)[2 * (size_t)i + 1];
            v4u o; o.x = pk2(a.x, a.y); o.y = pk2(a.z, a.w); o.z = pk2(b.x, b.y); o.w = pk2(b.z, b.w); ((GAS v4u*)PB)[i] = o; }
    }
}
__device__ __forceinline__ void p2_conv(const Ctx& F, const bf16* GB, const bf16* Z, const float* cw, bf16* AC) {
    const int gt = F.vcu * 512 + F.tid, NGT = F.G * 512;
    for (int i = gt; i < M * AW / 8; i += NGT) {
        const int row = i >> 6, c = (i & 63) * 8, t = row & (SEQ - 1);
        const v4u z2 = *(const GAS v4u*)(Z + (size_t)row * AW + c), g = *(const GAS v4u*)(GB + (size_t)row * AW + c);
        v4u z1 = {0u, 0u, 0u, 0u}, z0 = {0u, 0u, 0u, 0u};
        if (t >= 1) z1 = *(const GAS v4u*)(Z + (size_t)(row - 1) * AW + c);
        if (t >= 2) z0 = *(const GAS v4u*)(Z + (size_t)(row - 2) * AW + c);
        float r[8];
#pragma unroll
        for (int e = 0; e < 4; ++e) {
            const float w0a = cw[c + 2 * e], w0b = cw[c + 2 * e + 1], w1a = cw[AW + c + 2 * e], w1b = cw[AW + c + 2 * e + 1], w2a = cw[2 * AW + c + 2 * e], w2b = cw[2 * AW + c + 2 * e + 1];
            r[2 * e] = __uint_as_float(g[e] << 16) * (w0a * __uint_as_float(z0[e] << 16) + w1a * __uint_as_float(z1[e] << 16) + w2a * __uint_as_float(z2[e] << 16));
            r[2 * e + 1] = __uint_as_float(g[e] & 0xffff0000u) * (w0b * __uint_as_float(z0[e] & 0xffff0000u) + w1b * __uint_as_float(z1[e] & 0xffff0000u) + w2b * __uint_as_float(z2[e] & 0xffff0000u));
        }
        v4u o; o.x = pk2(r[0], r[1]); o.y = pk2(r[2], r[3]); o.z = pk2(r[4], r[5]); o.w = pk2(r[6], r[7]);
        *(GAS v4u*)(AC + (size_t)row * D + AW + c) = o;
    }
}
template <int CTRL> __device__ __forceinline__ int dpp_i(int v) { return __builtin_amdgcn_update_dpp(0, v, CTRL, 0xf, 0xf, true); }
__device__ __forceinline__ int sum8i(int v) { v += dpp_i<0x141>(v); v += dpp_i<0xB1>(v); v += dpp_i<0x4E>(v); return v; }
__device__ __forceinline__ float max8f(float v) { v = fmaxf(v, __uint_as_float((unsigned)dpp_i<0x141>((int)__float_as_uint(v)))); v = fmaxf(v, __uint_as_float((unsigned)dpp_i<0xB1>((int)__float_as_uint(v)))); v = fmaxf(v, __uint_as_float((unsigned)dpp_i<0x4E>((int)__float_as_uint(v)))); return v; }
__device__ __forceinline__ size_t part_slab(int j) { return j < 2 ? WS_PART0 + (size_t)j * 8 * MiB : j < 6 ? WS_PART1 + (size_t)(j - 2) * 8 * MiB : WS_PART2 + (size_t)(j - 6) * 8 * MiB; }
struct P6Geo { int xg, wi, nwv; };
__device__ __forceinline__ P6Geo p6_geo(const Ctx& F) { P6Geo g; const int bx = blockIdx.x; g.xg = bx & 7; g.wi = (bx >> 3) * NWAVES + F.wave; g.nwv = ((F.G - g.xg + 7) >> 3) * NWAVES; return g; }
__device__ __forceinline__ void p6a_upass(const Ctx& F, unsigned char* ws, const bf16* XB1, const int* IDS) {
    const P6Geo G = p6_geo(F); const int lane = F.lane, g = lane >> 3, c = lane & 7;
    for (int sl = G.xg; sl < NSL; sl += 8) {
        float* PART = (float*)(ws + part_slab(sl));
        const GAS unsigned char* Ts = (const GAS unsigned char*)(ws + WS_UB) + (size_t)sl * NEXP * SLW + 16 * c;
        for (int t = G.wi; t < M; t += G.nwv) {
            const v4u xa = *(const GAS v4u*)(XB1 + (size_t)t * D + sl * SLW + 16 * c), xb = *(const GAS v4u*)(XB1 + (size_t)t * D + sl * SLW + 16 * c + 8);
            int id[16];
#pragma unroll
            for (int q = 0; q < 4; ++q) { const v4u v = *(const GAS v4u*)(IDS + (size_t)t * 128 + 16 * g + 4 * q); id[4 * q] = (int)v.x; id[4 * q + 1] = (int)v.y; id[4 * q + 2] = (int)v.z; id[4 * q + 3] = (int)v.w; }
            v4u u[16];
#pragma unroll
            for (int i = 0; i < 16; ++i) u[i] = *(const GAS v4u*)(Ts + ((unsigned)id[i] << 7));
            float xf[16];
#pragma unroll
            for (int e = 0; e < 4; ++e) { xf[2 * e] = __uint_as_float(xa[e] << 16); xf[2 * e + 1] = __uint_as_float(xa[e] & 0xffff0000u); xf[8 + 2 * e] = __uint_as_float(xb[e] << 16); xf[8 + 2 * e + 1] = __uint_as_float(xb[e] & 0xffff0000u); }
            float am = 0.f;
#pragma unroll
            for (int e = 0; e < 16; ++e) am = fmaxf(am, fabsf(xf[e]));
            am = max8f(am);
            const float sc = am > 0.f ? 127.0f / am : 0.f, sx = am * (1.0f / 127.0f);
            int qx[4];
#pragma unroll
            for (int j = 0; j < 4; ++j) qx[j] = (int)(((unsigned)((int)rintf(xf[4 * j] * sc) & 255)) | ((unsigned)((int)rintf(xf[4 * j + 1] * sc) & 255) << 8) | ((unsigned)((int)rintf(xf[4 * j + 2] * sc) & 255) << 16) | ((unsigned)((int)rintf(xf[4 * j + 3] * sc) & 255) << 24));
            int r0 = 0, r1 = 0;
#pragma unroll
            for (int i = 0; i < 16; ++i) { int sacc = __builtin_amdgcn_sdot4(qx[0], (int)u[i][0], 0, false); sacc = __builtin_amdgcn_sdot4(qx[1], (int)u[i][1], sacc, false); sacc = __builtin_amdgcn_sdot4(qx[2], (int)u[i][2], sacc, false); sacc = __builtin_amdgcn_sdot4(qx[3], (int)u[i][3], sacc, false);
                sacc = sum8i(sacc);
                if (i < 8) r0 = (c == i) ? sacc : r0; else r1 = (c == i - 8) ? sacc : r1; }
            float* pp = PART + (size_t)t * 128 + 16 * g + c;
            pp[0] = (float)r0 * sx; pp[8] = (float)r1 * sx;
        }
    }
}
__device__ __forceinline__ void p6b_combine(const Ctx& F, unsigned char* ws, float* SS2, const int* IDS, float* GATES) {
    const int gw = F.vcu * NWAVES + F.wave, NGW = F.G * NWAVES, lane = F.lane;
    const float *SU = (const float*)(ws + WS_SU), *SV = (const float*)(ws + WS_SV);
    for (int t = gw; t < M; t += NGW) {
        const float rstd = 1.0f / sqrtf(wave_sum(lane < 16 ? SS2[(size_t)t * 16 + lane] : 0.f) * (1.0f / D) + EPS);
        const int i0 = IDS[(size_t)t * 128 + lane], i1 = IDS[(size_t)t * 128 + 64 + lane];
        float a0 = 0.f, a1 = 0.f;
#pragma unroll
        for (int j = 0; j < 8; ++j) { const float* pp = (const float*)(ws + part_slab(j)) + (size_t)t * 128; a0 += pp[lane]; a1 += pp[64 + lane]; }
        a0 *= rstd * SU[i0]; a1 *= rstd * SU[i1];
        float* gp = GATES + (size_t)t * 128;
        gp[lane] = gp[lane] * 0.5f * a0 * (1.0f + erff(a0 * 0.70710678118654752f)) * SV[i0];
        gp[64 + lane] = gp[64 + lane] * 0.5f * a1 * (1.0f + erff(a1 * 0.70710678118654752f)) * SV[i1];
        if (lane < 16) SS2[(size_t)t * 16 + lane] = 0.f;
    }
}
__device__ __forceinline__ void p6c_vpass(const Ctx& F, unsigned char* ws, const int* IDS, const float* W, float* X, bf16* XB2, float* SS3) {
    const P6Geo G = p6_geo(F); const int lane = F.lane, g = lane >> 3, c = lane & 7;
    const int ecol = 16 * c + ((lane >> 5) & 1) * 8 + ((lane >> 4) & 1) * 4 + ((lane >> 3) & 1) * 2;
    for (int sl = G.xg; sl < NSL; sl += 8) {
        const GAS unsigned char* Ts = (const GAS unsigned char*)(ws + WS_VB) + (size_t)sl * NEXP * SLW + 16 * c;
        for (int t = G.wi; t < M; t += G.nwv) {
            int id[16]; float w[16];
#pragma unroll
            for (int q = 0; q < 4; ++q) { const v4u v = *(const GAS v4u*)(IDS + (size_t)t * 128 + 16 * g + 4 * q); id[4 * q] = (int)v.x; id[4 * q + 1] = (int)v.y; id[4 * q + 2] = (int)v.z; id[4 * q + 3] = (int)v.w;
                const f32x4 wv = *(const GAS f32x4*)(W + (size_t)t * 128 + 16 * g + 4 * q); w[4 * q] = wv.x; w[4 * q + 1] = wv.y; w[4 * q + 2] = wv.z; w[4 * q + 3] = wv.w; }
            v4u v[16];
#pragma unroll
            for (int i = 0; i < 16; ++i) v[i] = *(const GAS v4u*)(Ts + ((unsigned)id[i] << 7));
            float acc[16], wsum = 0.f;
#pragma unroll
            for (int e = 0; e < 16; ++e) acc[e] = 0.f;
#pragma unroll
            for (int i = 0; i < 16; ++i) { wsum += w[i];
#pragma unroll
                for (int b = 0; b < 4; ++b) { const unsigned q = v[i][b]; acc[4 * b] += w[i] * (float)(q & 255u); acc[4 * b + 1] += w[i] * (float)((q >> 8) & 255u); acc[4 * b + 2] += w[i] * (float)((q >> 16) & 255u); acc[4 * b + 3] += w[i] * (float)(q >> 24); } }
            float r8[8], r4[4], r2[2];
#pragma unroll
            for (int i = 0; i < 8; ++i) { const float send = (lane & 32) ? acc[i] : acc[i + 8], keep = (lane & 32) ? acc[i + 8] : acc[i]; r8[i] = keep + __shfl_xor(send, 32); }
#pragma unroll
            for (int i = 0; i < 4; ++i) { const float send = (lane & 16) ? r8[i] : r8[i + 4], keep = (lane & 16) ? r8[i + 4] : r8[i]; r4[i] = keep + __shfl_xor(send, 16); }
#pragma unroll
            for (int i = 0; i < 2; ++i) { const float send = (lane & 8) ? r4[i] : r4[i + 2], keep = (lane & 8) ? r4[i + 2] : r4[i]; r2[i] = keep + __shfl_xor(send, 8); }
            wsum += __shfl_xor(wsum, 32); wsum += __shfl_xor(wsum, 16); wsum += __shfl_xor(wsum, 8);
            const size_t o = (size_t)t * D + sl * SLW + ecol;
            typedef float f32x2g __attribute__((ext_vector_type(2)));
            f32x2g xv = *(const GAS f32x2g*)(X + o);
            xv.x += r2[0] - 128.0f * wsum; xv.y += r2[1] - 128.0f * wsum;
            *(GAS f32x2g*)(X + o) = xv; *(GAS unsigned*)(XB2 + o) = pk2(xv.x, xv.y);
            const float ss = wave_sum(xv.x * xv.x + xv.y * xv.y);
            if (lane == 0) SS3[(size_t)t * 16 + sl] = ss;
        }
    }
}
__device__ __forceinline__ void p8_final(const Ctx& F, float* X, const float* g) {
    const int gw = F.vcu * NWAVES + F.wave, NGW = F.G * NWAVES;
    for (int row = gw; row < M; row += NGW) {
        GAS f32x4* xr = (GAS f32x4*)(X + (size_t)row * D); f32x4 v[4]; float ss = 0.f;
#pragma unroll
        for (int j = 0; j < 4; ++j) { v[j] = xr[F.lane + 64 * j]; ss += (v[j].x * v[j].x + v[j].y * v[j].y) + (v[j].z * v[j].z + v[j].w * v[j].w); }
        ss = wave_sum(ss); const float rstd = 1.0f / sqrtf(ss * (1.0f / D) + EPS);
#pragma unroll
        for (int j = 0; j < 4; ++j) { const f32x4 gv = ((const GAS f32x4*)g)[F.lane + 64 * j]; xr[F.lane + 64 * j] = v[j] * rstd * gv; }
    }
}
struct OneUnit {
    pg8::Unit u;
    __device__ __forceinline__ bool next(int i, pg8::Unit& o) const { if (i != 0) return false; o = u; return true; }
    __device__ __forceinline__ void a_ready(const pg8::Unit&) const {}
    __device__ __forceinline__ void done(const pg8::Unit&) const {}
};

__global__ void __launch_bounds__(NWAVES * 64, 2) mk_fwd(Args args) {
    extern __shared__ __attribute__((aligned(16))) unsigned char lds[];
    Ctx F;
    F.lds = (LAS unsigned char*)lds;
    F.tid = threadIdx.x; F.lane = F.tid & 63; F.wave = __builtin_amdgcn_readfirstlane(F.tid >> 6);
    F.G = gridDim.x; { const int bx = blockIdx.x; F.vcu = (F.G % 8 == 0) ? (bx % 8) * (F.G / 8) + bx / 8 : bx; }
    volatile LAS unsigned* MISC = (volatile LAS unsigned*)(F.lds + MISC_OFF);
    unsigned char* ws = args.ws;
    gu32* ctl = (gu32*)(ws + WS_CTL);
    for (int u = F.tid; u < (LDS_BYTES - LDSCTL_OFF) / 4; u += NWAVES * 64) ((LAS unsigned*)(F.lds + LDSCTL_OFF))[u] = 0u;
    __syncthreads();
    const int lo = args.ph_lo, hi = args.ph_hi;
    const bool multi = (hi - lo) > 1 || (lo <= 6 && 6 < hi);
    XcdBarrier bar; bar.bar = (unsigned*)(ctl + CW_BAR) + args.li * XCD_BAR_WORDS; bar.x = 0; bar.st = nullptr;
    if (multi) bar = xcd_barrier_post((unsigned*)(ctl + CW_BAR) + args.li * XCD_BAR_WORDS, MISC + 8);
#ifndef MK_CMASK
#define MK_CMASK 0x1ff
#endif
#define IN(k) (((MK_CMASK >> (k)) & 1) && lo <= (k) && (k) < hi)
#define SEAM(k) do { if (IN(k) && IN((k) + 1)) xcd_barrier(bar); STAMP(); } while (0)
#ifdef MK_PROBE_SEG
    int n_stamp = 0;
#define STAMP() do { if (blockIdx.x == 0 && F.tid == 0) { const unsigned long long t_ = __builtin_amdgcn_s_memrealtime(); MISC[16 + 2 * n_stamp] = (unsigned)t_; MISC[17 + 2 * n_stamp] = (unsigned)(t_ >> 32); } ++n_stamp; } while (0)
    STAMP();
#else
#define STAMP() do { } while (0)
#endif
    float* out = args.out;
    float *RSTD1 = (float*)(ws + WS_RSTD1), *SS2 = (float*)(ws + WS_SS2), *LF = (float*)(ws + WS_LF);
    bf16 *WIN = (bf16*)(ws + WS_WIN), *WBR = (bf16*)(ws + WS_WBR), *WOUT = (bf16*)(ws + WS_WOUT), *WST = (bf16*)(ws + WS_WS), *WPG = (bf16*)(ws + WS_WPG), *WPP = (bf16*)(ws + WS_WPP), *PB = (bf16*)(ws + WS_PB);
    bf16 *UB = (bf16*)(ws + WS_UB), *VB = (bf16*)(ws + WS_VB), *XB = (bf16*)(ws + WS_A), *AC = (bf16*)(ws + WS_A), *XB1 = (bf16*)(ws + WS_A), *PP = (bf16*)(ws + WS_PP);
    bf16 *Q = (bf16*)(ws + WS_Q), *K = (bf16*)(ws + WS_K), *V = (bf16*)(ws + WS_V), *GB = (bf16*)(ws + WS_GB), *Z = (bf16*)(ws + WS_Z), *MG = (bf16*)(ws + WS_MERGED), *XB2 = (bf16*)(ws + WS_XB2);
    int* IDS = (int*)(ws + WS_IDS); float* GATES = (float*)(ws + WS_GATES);
    bf16 *SGA = (bf16*)out, *SGC = (bf16*)out + (size_t)M * D;

    if (IN(0)) { p0_prologue(F, args); }
    SEAM(0);
    if (IN(1)) {
        { pg8::Gemm g{XB, WIN, M, NIN, D}; pg8::StaticOrder S; S.init(M, NIN, F.G, (int)blockIdx.x);
          pg8::EpiIn E{RSTD1, Q, (size_t)(WS_K - WS_Q) / 2, Z, SGA, (size_t)M * D, C2};
          static_assert(WS_V - WS_K == WS_K - WS_Q && WS_GB - WS_V == WS_K - WS_Q, "Q | K | V | GB equally spaced");
          pg8::gemm_phase<pg8::EpiIn, pg8::StaticOrder, PG8_ALIGN, PG8_SP2>(F.lds + RING_OFF, g, S, E); }
        { pg8::Gemm g{PB, WPP, M, D, PLE}; pg8::StaticOrder S; S.init(M, D, F.G, (int)blockIdx.x);
          pg8::EpiPlain E{PP, D};
          pg8::gemm_phase<pg8::EpiPlain, pg8::StaticOrder, PG8_ALIGN, PG8_SP2>(F.lds + RING_OFF, g, S, E); }
    }
    SEAM(1);
    if (IN(2)) {
        p2_conv(F, GB, Z, args.in[5], AC);
        const attn_body::AttnTensors AT{(const attn_body::bf16*)Q, (const attn_body::bf16*)K, (const attn_body::bf16*)V, (attn_body::bf16*)AC, LF};
        const attn_body::StaticOrder S((int)F.G, F.vcu);
        attn_body::attn_phase<attn_body::StaticOrder>((char*)lds + RING_OFF, AT, S);
    }
    SEAM(2);
    if (IN(3)) {
        pg8::Gemm g{AC, WBR, M, D, D}; pg8::StaticOrder S; S.init(M, D, F.G, (int)blockIdx.x);
        pg8::EpiBranch E{SGA, SGC, MG};
        pg8::gemm_phase<pg8::EpiBranch, pg8::StaticOrder, PG8_ALIGN, PG8_SP2>(F.lds + RING_OFF, g, S, E);
    }
    SEAM(3);
    if (IN(4)) {
        pg8::Gemm g{MG, WOUT, M, D, D}; pg8::StaticOrder S; S.init(M, D, F.G, (int)blockIdx.x);
        pg8::EpiOut E{args.in[0], out, XB1, SS2};
        pg8::gemm_phase<pg8::EpiOut, pg8::StaticOrder, PG8_ALIGN, PG8_SP2>(F.lds + RING_OFF, g, S, E);
    }
    SEAM(4);
    if (IN(5)) {
        pg8::Gemm g{XB1, WST, M, NS, D}; pg8::StaticOrder S; S.init(M, NS, F.G, (int)blockIdx.x);
        pg8::EpiTopK E{SS2, IDS, GATES, EPS};
        pg8::Unit u;
        for (int i = 0; S.next(i, u); ++i) { OneUnit O{u}; pg8::gemm_phase<pg8::EpiTopK, OneUnit, false, PG8_SP2>(F.lds + RING_OFF, g, O, E); }
    }
    SEAM(5);
    if (IN(6)) { p6a_upass(F, ws, XB1, IDS); xcd_barrier(bar); STAMP(); p6b_combine(F, ws, SS2, IDS, GATES); xcd_barrier(bar); STAMP(); p6c_vpass(F, ws, IDS, GATES, out, XB2, SS2); }
    SEAM(6);
    if (IN(7)) {
        pg8::Gemm g{XB2, WPG, M, D, D}; pg8::StaticOrder S; S.init(M, D, F.G, (int)blockIdx.x);
        pg8::EpiPle E{SS2, PP, out, EPS};
        pg8::gemm_phase<pg8::EpiPle, pg8::StaticOrder, PG8_ALIGN, PG8_SP2>(F.lds + RING_OFF, g, S, E);
    }
    SEAM(7);
    if (IN(8)) { p8_final(F, out, args.in[17]); }
    STAMP();
#ifdef MK_PROBE_SEG
    if (blockIdx.x == 0 && F.tid == 0) {
        const unsigned long long a_ = ((unsigned long long)MISC[17 + 2 * MK_PROBE_SEG] << 32) | MISC[16 + 2 * MK_PROBE_SEG], b_ = ((unsigned long long)MISC[19 + 2 * MK_PROBE_SEG] << 32) | MISC[18 + 2 * MK_PROBE_SEG];
        const unsigned long long dt_ = (b_ - a_) * MK_PROBE_MULT, t0_ = __builtin_amdgcn_s_memrealtime();
        while (__builtin_amdgcn_s_memrealtime() - t0_ < dt_) __builtin_amdgcn_s_sleep(8);
    }
#endif
#undef IN
#undef SEAM
}
namespace gold {
__global__ void __launch_bounds__(256) k_rows0(const float* x, const float* w_in, const float* g_mix, const float* b_f, bf16* XB, float* RSTD1, float* LF) {
    const int lane = threadIdx.x & 63, row = blockIdx.x * 4 + (threadIdx.x >> 6);
    const f32x4* xr = (const f32x4*)(x + (size_t)row * D);
    f32x4 v[4]; float ss = 0.f;
#pragma unroll
    for (int j = 0; j < 4; ++j) { v[j] = xr[lane + 64 * j]; ss += v[j].x * v[j].x + v[j].y * v[j].y + v[j].z * v[j].z + v[j].w * v[j].w; }
    ss = wave_sum(ss);
    const float rstd = 1.0f / sqrtf(ss * (1.0f / D) + EPS);
    u32x2* o = (u32x2*)(XB + (size_t)row * D);
#pragma unroll
    for (int j = 0; j < 4; ++j) { u32x2 w; w.x = pk2(v[j].x, v[j].y); w.y = pk2(v[j].z, v[j].w); o[lane + 64 * j] = w; }
    if (lane == 0) RSTD1[row] = rstd;
    float f[8];
#pragma unroll
    for (int h = 0; h < 8; ++h) f[h] = 0.f;
#pragma unroll
    for (int j = 0; j < 4; ++j)
#pragma unroll
        for (int e = 0; e < 4; ++e) {
            const int k = 4 * (lane + 64 * j) + e; const float xv = v[j][e] * g_mix[k];
            const f32x4 w0 = *(const f32x4*)(w_in + (size_t)k * INTOT + 1536), w1 = *(const f32x4*)(w_in + (size_t)k * INTOT + 1540);
            f[0] += xv * w0.x; f[1] += xv * w0.y; f[2] += xv * w0.z; f[3] += xv * w0.w; f[4] += xv * w1.x; f[5] += xv * w1.y; f[6] += xv * w1.z; f[7] += xv * w1.w;
        }
    const int b = row / SEQ, t = row % SEQ;
#pragma unroll
    for (int h = 0; h < 8; ++h) {
        const float tot = wave_sum(f[h]) * rstd + b_f[h];
        const float ls = fminf(tot, 0.f) - log1pf(__expf(-fabsf(tot)));
        if (lane == 0) LF[(size_t)(b * NH + h) * SEQ + t] = ls * LOG2E;
    }
}
template <int MODE> __global__ void k_wt(const float* W, int ldw, const float* g, bf16* Wt, int N, int K, int koff, int ldt) {
    const size_t i = (size_t)blockIdx.x * blockDim.x + threadIdx.x; if (i >= (size_t)N * K) return;
    const int n = (int)(i / K), k = (int)(i % K);
    const int s = MODE == 1 ? src_in(n) : n;
    const float gv = g ? g[k] : 1.f;
    Wt[(size_t)n * ldt + koff + k] = (bf16)f2bf(gv * W[(size_t)k * ldw + s]);
}
__global__ void k_ws(const float* wq, const float* k1, const float* k2, const float* g, bf16* WST) {
    const size_t i = (size_t)blockIdx.x * blockDim.x + threadIdx.x; if (i >= (size_t)NS * D) return;
    const int n = (int)(i / D), d = (int)(i % D), head = n >> 8, half = (n >> 7) & 1, key = n & 127;
    const float* kr = (half ? k2 : k1) + ((size_t)head * NKEYS + key) * 128;
    const float* qr = wq + (size_t)d * NS + head * 256 + half * 128;
    float s = 0.f;
    for (int e = 0; e < 128; ++e) s += qr[e] * kr[e];
    WST[(size_t)n * D + d] = (bf16)f2bf(g[d] * s);
}
__global__ void k_cvt(const float* in, const float* g, bf16* out, size_t n, int gmask) {
    const size_t i = (size_t)blockIdx.x * blockDim.x + threadIdx.x; if (i >= n) return;
    out[i] = (bf16)f2bf(in[i] * (g ? g[i & gmask] : 1.f));
}

template <class Epi, bool SPLIT2>
__global__ void __launch_bounds__(256) ng(const bf16* A, int lda, const bf16* Bt, int ldb, int K, Epi E) {
    __shared__ float As[32][68], Bs[32][68];
    const int tid = threadIdx.x, tx = tid & 15, ty = tid >> 4, m0 = blockIdx.y * 64, n0 = blockIdx.x * 64;
    float acc[4][4], acc2[4][4];
#pragma unroll
    for (int i = 0; i < 4; ++i)
#pragma unroll
        for (int j = 0; j < 4; ++j) { acc[i][j] = 0.f; acc2[i][j] = 0.f; }
    const int lr = tid >> 2, lk = (tid & 3) * 8;
    for (int k0 = 0; k0 < K; k0 += 32) {
        const u32x4 av = *(const u32x4*)(A + (size_t)(m0 + lr) * lda + k0 + lk), bv = *(const u32x4*)(Bt + (size_t)(n0 + lr) * ldb + k0 + lk);
#pragma unroll
        for (int e = 0; e < 4; ++e) {
            As[lk + 2 * e][lr] = __uint_as_float(av[e] << 16); As[lk + 2 * e + 1][lr] = __uint_as_float(av[e] & 0xffff0000u);
            Bs[lk + 2 * e][lr] = __uint_as_float(bv[e] << 16); Bs[lk + 2 * e + 1][lr] = __uint_as_float(bv[e] & 0xffff0000u);
        }
        __syncthreads();
        const bool second = SPLIT2 && (k0 >= K / 2);
#pragma unroll 8
        for (int kk = 0; kk < 32; ++kk) {
            float a[4], b[4];
#pragma unroll
            for (int i = 0; i < 4; ++i) { a[i] = As[kk][ty * 4 + i]; b[i] = Bs[kk][tx * 4 + i]; }
            if (second) {
#pragma unroll
                for (int i = 0; i < 4; ++i)
#pragma unroll
                    for (int j = 0; j < 4; ++j) acc2[i][j] += a[i] * b[j];
            } else {
#pragma unroll
                for (int i = 0; i < 4; ++i)
#pragma unroll
                    for (int j = 0; j < 4; ++j) acc[i][j] += a[i] * b[j];
            }
        }
        __syncthreads();
    }
#pragma unroll
    for (int i = 0; i < 4; ++i)
#pragma unroll
        for (int j = 0; j < 4; ++j) E(m0 + ty * 4 + i, n0 + tx * 4 + j, acc[i][j], acc2[i][j]);
}
struct E1 {
    const float* RSTD1; bf16 *Q, *K, *V, *GB, *SGA, *SGC; float *TGC, *TXC;
    __device__ void operator()(int row, int col, float a, float) const {
        const float v = RSTD1[row] * a; const int pn = col >> 8;
        if (pn < 2) Q[(size_t)row * AW + col] = (bf16)f2bf(v * C2);
        else if (pn < 4) K[(size_t)row * AW + col - 512] = (bf16)f2bf(v);
        else if (pn < 6) V[(size_t)row * AW + col - 1024] = (bf16)f2bf(v);
        else if (pn < 8) GB[(size_t)row * AW + col - 1536] = (bf16)f2bf(v);
        else if (pn < 12) { const int j = pn - 8, l = col & 255; if (l < 128) TGC[(size_t)row * AW + 128 * j + l] = v; else TXC[(size_t)row * AW + 128 * j + l - 128] = v; }
        else if (pn < 16) SGA[(size_t)row * D + col - 3072] = (bf16)f2bf(sigmoidf_(v));
        else SGC[(size_t)row * D + col - 4096] = (bf16)f2bf(sigmoidf_(v));
    }
};
struct EPP { bf16* PP; __device__ void operator()(int row, int col, float a, float) const { PP[(size_t)row * D + col] = (bf16)f2bf(a); } };
struct E3 { const bf16 *SGA, *SGC; bf16* MG;
    __device__ void operator()(int row, int col, float a, float a2) const { const size_t i = (size_t)row * D + col; MG[i] = (bf16)f2bf(bf2f(SGA[i]) * a + bf2f(SGC[i]) * a2); } };
struct E4 { const float* x; float* X1; bf16* XB1;
    __device__ void operator()(int row, int col, float a, float) const { const size_t i = (size_t)row * D + col; const float v = x[i] + a; X1[i] = v; XB1[i] = (bf16)f2bf(v); } };
struct E5 { float* SC; __device__ void operator()(int row, int col, float a, float) const { SC[(size_t)row * 1024 + col] = a; } };
struct E7 { const float* SS3; const bf16* PP; float* X;
    __device__ void operator()(int row, int col, float a, float) const { const size_t i = (size_t)row * D + col; float q_ = 0.f; for (int j_ = 0; j_ < 16; ++j_) q_ += SS3[(size_t)row * 16 + j_]; X[i] = X[i] + sigmoidf_(a / sqrtf(q_ * (1.0f / D) + EPS)) * bf2f(PP[i]); } };

__global__ void k_z(const float* TGC, const float* TXC, bf16* Z) { const size_t i = (size_t)blockIdx.x * blockDim.x + threadIdx.x; if (i < (size_t)M * AW) Z[i] = (bf16)f2bf(TGC[i] * TXC[i]); }
__global__ void k_cumsum(const float* LF, float* CS) { const int bh = threadIdx.x; if (bh >= 32) return; float s = 0.f; for (int t = 0; t < SEQ; ++t) { s += LF[(size_t)bh * SEQ + t]; CS[(size_t)bh * SEQ + t] = s; } }
__global__ void k_conv(const bf16* GB, const bf16* Z, const float* cw, bf16* AC) {
    const size_t i = (size_t)blockIdx.x * blockDim.x + threadIdx.x; if (i >= (size_t)M * AW) return;
    const int row = (int)(i / AW), c = (int)(i % AW), t = row % SEQ;
    float s = cw[2 * AW + c] * bf2f(Z[i]);
    if (t >= 1) s += cw[1 * AW + c] * bf2f(Z[i - AW]);
    if (t >= 2) s += cw[0 * AW + c] * bf2f(Z[i - 2 * AW]);
    AC[(size_t)row * D + AW + c] = (bf16)f2bf(bf2f(GB[i]) * s);
}
__global__ void __launch_bounds__(64) k_attn(const bf16* Q, const bf16* K, const bf16* V, const float* CS, bf16* AC) {
    const int bh = blockIdx.y, b = bh / NH, h = bh % NH, q = blockIdx.x * 64 + threadIdx.x;
    const size_t rq = (size_t)b * SEQ + q;
    float qv[64], o[64];
#pragma unroll
    for (int d = 0; d < 64; ++d) { qv[d] = bf2f(Q[rq * AW + h * 64 + d]); o[d] = 0.f; }
    const float cq = CS[(size_t)bh * SEQ + q];
    float m = -INFINITY, l = 0.f;
    const int kvmax = blockIdx.x * 64 + 63;
    for (int kv = 0; kv <= kvmax; ++kv) {
        const size_t rk = (size_t)b * SEQ + kv;
        const u32x4* kp = (const u32x4*)(K + rk * AW + h * 64);
        float s = 0.f;
#pragma unroll
        for (int c = 0; c < 8; ++c) { const u32x4 w = kp[c];
#pragma unroll
            for (int e = 0; e < 4; ++e) { s += qv[c * 8 + 2 * e] * __uint_as_float(w[e] << 16) + qv[c * 8 + 2 * e + 1] * __uint_as_float(w[e] & 0xffff0000u); } }
        s += cq - CS[(size_t)bh * SEQ + kv];
        if (kv > q) s = -INFINITY;
        const float mn = fmaxf(m, s);
        const float al = (m == -INFINITY) ? 0.f : exp2f(m - mn), p = (s == -INFINITY) ? 0.f : exp2f(s - mn);
        l = l * al + p; m = mn;
        const u32x4* vp = (const u32x4*)(V + rk * AW + h * 64);
#pragma unroll
        for (int c = 0; c < 8; ++c) { const u32x4 w = vp[c];
#pragma unroll
            for (int e = 0; e < 4; ++e) { o[c * 8 + 2 * e] = o[c * 8 + 2 * e] * al + p * __uint_as_float(w[e] << 16); o[c * 8 + 2 * e + 1] = o[c * 8 + 2 * e + 1] * al + p * __uint_as_float(w[e] & 0xffff0000u); } }
    }
    const float il = 1.0f / l;
#pragma unroll
    for (int d = 0; d < 64; ++d) AC[rq * D + h * 64 + d] = (bf16)f2bf(o[d] * il);
}
__global__ void __launch_bounds__(256) k_rowss(const float* X, float* SS) {
    const int lane = threadIdx.x & 63, row = blockIdx.x * 4 + (threadIdx.x >> 6);
    const f32x4* xr = (const f32x4*)(X + (size_t)row * D); float ss = 0.f;
#pragma unroll
    for (int j = 0; j < 4; ++j) { const f32x4 v = xr[lane + 64 * j]; ss += v.x * v.x + v.y * v.y + v.z * v.z + v.w * v.w; }
    ss = wave_sum(ss);
    if (lane < 16) SS[(size_t)row * 16 + lane] = lane == 0 ? ss : 0.f;
}
__global__ void __launch_bounds__(64) k_topk(const float* SC, const float* SS2, int hg, int* IDS, float* GATES) {
    __shared__ float s[128][64]; __shared__ float tv[16][64]; __shared__ int ti[16][64];
    const int tid = threadIdx.x, pair = blockIdx.x * 32 + (tid >> 1), half = tid & 1, token = pair >> 2, hl = pair & 3;
    const float* src = SC + (size_t)token * 1024 + hl * 256 + half * 128;
    for (int k = 0; k < 128; ++k) s[k][tid] = src[k];
    float pv = INFINITY; int pk = -1;
    for (int r = 0; r < 16; ++r) {
        float best = -INFINITY; int bi = 0;
        for (int k = 0; k < 128; ++k) { const float v = s[k][tid]; const bool elig = (v < pv) || (v == pv && k > pk); if (elig && v > best) { best = v; bi = k; } }
        tv[r][tid] = best; ti[r][tid] = bi; pv = best; pk = bi;
    }
    __syncthreads();
    if (half == 0) {
        const float* ss = SS2 + (size_t)token * 16; float sst = 0.f; for (int q_ = 0; q_ < 16; ++q_) sst += ss[q_]; const float rstd = 1.0f / sqrtf(sst * (1.0f / D) + EPS);
        float ts[16]; int tf[16];
        float cpv = INFINITY; int cpf = -1;
#pragma unroll
        for (int r = 0; r < 16; ++r) {
            float best = -INFINITY; int bf_ = 0;
            for (int c = 0; c < 256; ++c) { const float v = tv[c >> 4][tid] + tv[c & 15][tid + 1]; const bool elig = (v < cpv) || (v == cpv && c > cpf); if (elig && v > best) { best = v; bf_ = c; } }
            ts[r] = best; tf[r] = bf_; cpv = best; cpf = bf_;
        }
        float e[16], sum = 0.f;
#pragma unroll
        for (int r = 0; r < 16; ++r) { e[r] = __expf(rstd * (ts[r] - ts[0])); sum += e[r]; }
        const float inv = 1.0f / sum; const int head = hg * 4 + hl;
#pragma unroll
        for (int r = 0; r < 16; ++r) { IDS[(size_t)token * 128 + head * 16 + r] = ti[tf[r] >> 4][tid] * 128 + ti[tf[r] & 15][tid + 1]; GATES[(size_t)token * 128 + head * 16 + r] = e[r] * inv; }
    }
}
__global__ void __launch_bounds__(256) k_peer(const bf16* XB1, const float* SS2, const int* IDS, const float* GATES, const bf16* UB, const bf16* VB, float* X, bf16* XB2, float* RSTD3) {
    const int lane = threadIdx.x & 63, token = blockIdx.x * 4 + (threadIdx.x >> 6);
    const float* ss = SS2 + (size_t)token * 16; float sst = 0.f; for (int q_ = 0; q_ < 16; ++q_) sst += ss[q_]; const float rstd = 1.0f / sqrtf(sst * (1.0f / D) + EPS);
    float xf[16], out[16];
    { const u32x4 a = *(const u32x4*)(XB1 + (size_t)token * D + 8 * lane), b = *(const u32x4*)(XB1 + (size_t)token * D + 512 + 8 * lane);
#pragma unroll
      for (int e = 0; e < 4; ++e) { xf[2 * e] = __uint_as_float(a[e] << 16); xf[2 * e + 1] = __uint_as_float(a[e] & 0xffff0000u); xf[8 + 2 * e] = __uint_as_float(b[e] << 16); xf[8 + 2 * e + 1] = __uint_as_float(b[e] & 0xffff0000u); } }
#pragma unroll
    for (int i = 0; i < 16; ++i) out[i] = 0.f;
    for (int hk = 0; hk < 128; ++hk) {
        const int id = IDS[(size_t)token * 128 + hk]; const float g = GATES[(size_t)token * 128 + hk];
        const u32x4 a = *(const u32x4*)(UB + (size_t)id * D + 8 * lane), b = *(const u32x4*)(UB + (size_t)id * D + 512 + 8 * lane);
        float dot = 0.f;
#pragma unroll
        for (int e = 0; e < 4; ++e) { dot += xf[2 * e] * __uint_as_float(a[e] << 16) + xf[2 * e + 1] * __uint_as_float(a[e] & 0xffff0000u) + xf[8 + 2 * e] * __uint_as_float(b[e] << 16) + xf[8 + 2 * e + 1] * __uint_as_float(b[e] & 0xffff0000u); }
        dot = wave_sum(dot) * rstd;
        const float w = g * 0.5f * dot * (1.0f + erff(dot * 0.70710678118654752f));
        const u32x4 va = *(const u32x4*)(VB + (size_t)id * D + 8 * lane), vb = *(const u32x4*)(VB + (size_t)id * D + 512 + 8 * lane);
#pragma unroll
        for (int e = 0; e < 4; ++e) { out[2 * e] += w * __uint_as_float(va[e] << 16); out[2 * e + 1] += w * __uint_as_float(va[e] & 0xffff0000u); out[8 + 2 * e] += w * __uint_as_float(vb[e] << 16); out[8 + 2 * e + 1] += w * __uint_as_float(vb[e] & 0xffff0000u); }
    }
    float* xr = X + (size_t)token * D; float s2 = 0.f;
    f32x4 x0 = *(f32x4*)(xr + 8 * lane), x1 = *(f32x4*)(xr + 8 * lane + 4), x2 = *(f32x4*)(xr + 512 + 8 * lane), x3 = *(f32x4*)(xr + 512 + 8 * lane + 4);
#pragma unroll
    for (int e = 0; e < 4; ++e) { x0[e] += out[e]; x1[e] += out[4 + e]; x2[e] += out[8 + e]; x3[e] += out[12 + e]; s2 += x0[e] * x0[e] + x1[e] * x1[e] + x2[e] * x2[e] + x3[e] * x3[e]; }
    *(f32x4*)(xr + 8 * lane) = x0; *(f32x4*)(xr + 8 * lane + 4) = x1; *(f32x4*)(xr + 512 + 8 * lane) = x2; *(f32x4*)(xr + 512 + 8 * lane + 4) = x3;
    u32x4 w0, w1; w0.x = pk2(x0.x, x0.y); w0.y = pk2(x0.z, x0.w); w0.z = pk2(x1.x, x1.y); w0.w = pk2(x1.z, x1.w); w1.x = pk2(x2.x, x2.y); w1.y = pk2(x2.z, x2.w); w1.z = pk2(x3.x, x3.y); w1.w = pk2(x3.z, x3.w);
    *(u32x4*)(XB2 + (size_t)token * D + 8 * lane) = w0; *(u32x4*)(XB2 + (size_t)token * D + 512 + 8 * lane) = w1;
    s2 = wave_sum(s2);
    if (lane < 16) RSTD3[(size_t)token * 16 + lane] = lane == 0 ? s2 : 0.f;
}
__global__ void __launch_bounds__(256) k_final(float* X, const float* g) {
    const int lane = threadIdx.x & 63, row = blockIdx.x * 4 + (threadIdx.x >> 6);
    f32x4* xr = (f32x4*)(X + (size_t)row * D); f32x4 v[4]; float ss = 0.f;
#pragma unroll
    for (int j = 0; j < 4; ++j) { v[j] = xr[lane + 64 * j]; ss += v[j].x * v[j].x + v[j].y * v[j].y + v[j].z * v[j].z + v[j].w * v[j].w; }
    ss = wave_sum(ss); const float rstd = 1.0f / sqrtf(ss * (1.0f / D) + EPS);
#pragma unroll
    for (int j = 0; j < 4; ++j) { const f32x4 gv = ((const f32x4*)g)[lane + 64 * j]; xr[lane + 64 * j] = v[j] * rstd * gv; }
}

}

#ifndef MK_FUSED_MASK
#define MK_FUSED_MASK 0x1ff
#endif
static void golden_phase(int ph, void* const* d_in, float* out, unsigned char* ws, hipStream_t stream) {
    using namespace gold;
    const float* x = (const float*)d_in[0]; const float* p = (const float*)d_in[1]; const float* g_mix = (const float*)d_in[2]; const float* w_in = (const float*)d_in[3];
    const float* b_f = (const float*)d_in[4]; const float* conv_w = (const float*)d_in[5]; const float* w_branch = (const float*)d_in[6]; const float* w_out = (const float*)d_in[7];
    const float* g_ffn = (const float*)d_in[8]; const float* w_peer_q = (const float*)d_in[9]; const float* peer_k1 = (const float*)d_in[10]; const float* peer_k2 = (const float*)d_in[11];
    const float* peer_u = (const float*)d_in[12]; const float* peer_v = (const float*)d_in[13]; const float* g_ple = (const float*)d_in[14]; const float* w_ple_gate = (const float*)d_in[15];
    const float* w_ple_proj = (const float*)d_in[16]; const float* g_final = (const float*)d_in[17];
    float *RSTD1 = (float*)(ws + WS_RSTD1), *SS2 = (float*)(ws + WS_SS2), *LF = (float*)(ws + WS_LF), *CS = (float*)(ws + WS_CS);
    bf16 *WIN = (bf16*)(ws + WS_WIN), *WBR = (bf16*)(ws + WS_WBR), *WOUT = (bf16*)(ws + WS_WOUT), *WST = (bf16*)(ws + WS_WS), *WPG = (bf16*)(ws + WS_WPG), *WPP = (bf16*)(ws + WS_WPP), *PB = (bf16*)(ws + WS_PB);
    bf16 *UB = (bf16*)(ws + WS_UB), *VB = (bf16*)(ws + WS_VB), *XB = (bf16*)(ws + WS_A), *AC = (bf16*)(ws + WS_A), *XB1 = (bf16*)(ws + WS_A), *PP = (bf16*)(ws + WS_PP);
    bf16 *Q = (bf16*)(ws + WS_Q), *K = (bf16*)(ws + WS_K), *V = (bf16*)(ws + WS_V), *GB = (bf16*)(ws + WS_GB), *Z = (bf16*)(ws + WS_Z), *MG = (bf16*)(ws + WS_MERGED), *XB2 = (bf16*)(ws + WS_XB2);
    int* IDS = (int*)(ws + WS_IDS); float* GATES = (float*)(ws + WS_GATES);
    bf16 *SGA = (bf16*)out, *SGC = (bf16*)out + (size_t)M * D;
    float *TGC = (float*)(ws + WS_TGC), *TXC = (float*)(ws + WS_TXC), *SC = (float*)(ws + WS_SC);
    auto nb = [](size_t n) { return (unsigned)((n + 255) / 256); };
    switch (ph) {
    case 0:
        k_rows0<<<M / 4, 256, 0, stream>>>(x, w_in, g_mix, b_f, XB, RSTD1, LF);
        k_wt<1><<<nb((size_t)NIN * D), 256, 0, stream>>>(w_in, INTOT, g_mix, WIN, NIN, D, 0, D);
        k_wt<0><<<nb((size_t)D * AW), 256, 0, stream>>>(w_branch, D, nullptr, WBR, D, AW, 0, D);
        k_wt<0><<<nb((size_t)D * AW), 256, 0, stream>>>(w_branch + (size_t)AW * D, D, nullptr, WBR, D, AW, AW, D);
        k_wt<0><<<nb((size_t)D * D), 256, 0, stream>>>(w_out, D, nullptr, WOUT, D, D, 0, D);
        k_wt<0><<<nb((size_t)D * D), 256, 0, stream>>>(w_ple_gate, D, g_ple, WPG, D, D, 0, D);
        k_wt<0><<<nb((size_t)D * PLE), 256, 0, stream>>>(w_ple_proj, D, nullptr, WPP, D, PLE, 0, PLE);
        k_ws<<<nb((size_t)NS * D), 256, 0, stream>>>(w_peer_q, peer_k1, peer_k2, g_ffn, WST);
        k_cvt<<<nb((size_t)M * PLE), 256, 0, stream>>>(p, nullptr, PB, (size_t)M * PLE, 0);
        break;
    case 1:
        ng<E1, false><<<dim3(NIN / 64, M / 64), 256, 0, stream>>>(XB, D, WIN, D, D, E1{RSTD1, Q, K, V, GB, SGA, SGC, TGC, TXC});
        ng<EPP, false><<<dim3(D / 64, M / 64), 256, 0, stream>>>(PB, PLE, WPP, PLE, PLE, EPP{PP});
        k_z<<<nb((size_t)M * AW), 256, 0, stream>>>(TGC, TXC, Z);
        break;
    case 2:
        k_cumsum<<<1, 64, 0, stream>>>(LF, CS);
        k_conv<<<nb((size_t)M * AW), 256, 0, stream>>>(GB, Z, conv_w, AC);
        k_attn<<<dim3(SEQ / 64, BATCH * NH), 64, 0, stream>>>(Q, K, V, CS, AC);
        break;
    case 3: ng<E3, true><<<dim3(D / 64, M / 64), 256, 0, stream>>>(AC, D, WBR, D, D, E3{SGA, SGC, MG}); break;
    case 4:
        ng<E4, false><<<dim3(D / 64, M / 64), 256, 0, stream>>>(MG, D, WOUT, D, D, E4{x, out, XB1});
        k_rowss<<<M / 4, 256, 0, stream>>>(out, SS2);
        break;
    case 5:
        for (int hg = 0; hg < 2; ++hg) {
            ng<E5, false><<<dim3(1024 / 64, M / 64), 256, 0, stream>>>(XB1, D, WST + (size_t)hg * 1024 * D, D, D, E5{SC});
            k_topk<<<M * 4 / 32, 64, 0, stream>>>(SC, SS2, hg, IDS, GATES);
        }
        break;
    case 6:
        k_cvt<<<nb((size_t)NEXP * D), 256, 0, stream>>>(peer_u, g_ffn, UB, (size_t)NEXP * D, D - 1);
        k_cvt<<<nb((size_t)NEXP * D), 256, 0, stream>>>(peer_v, nullptr, VB, (size_t)NEXP * D, 0);
        k_peer<<<M / 4, 256, 0, stream>>>(XB1, SS2, IDS, GATES, UB, VB, out, XB2, SS2);
        break;
    case 7: ng<E7, false><<<dim3(D / 64, M / 64), 256, 0, stream>>>(XB2, D, WPG, D, D, E7{SS2, PP, out}); break;
    case 8: k_final<<<M / 4, 256, 0, stream>>>(out, g_final); break;
    }
}
extern "C" void kernel_launch(void* const* d_in, const int* in_sizes, int n_in, void* d_out, int out_size, void* d_ws, size_t ws_size, hipStream_t stream) {
    static int grid = 0;
    if (grid == 0) {
        if (n_in != 18 || in_sizes[0] != M * D || out_size != M * D || ws_size < WS_END) { fprintf(stderr, "kernel_launch: unexpected shapes (n_in %d, in0 %d, out %d, ws %zu); nothing launched\n", n_in, n_in > 0 ? in_sizes[0] : -1, out_size, ws_size); grid = -1; return; }
        int dev = 0, cus = 0, per_cu = 0;
        if (hipGetDevice(&dev) != hipSuccess || hipDeviceGetAttribute(&cus, hipDeviceAttributeMultiprocessorCount, dev) != hipSuccess) { fprintf(stderr, "kernel_launch: device query failed\n"); grid = -1; return; }
        if (hipFuncSetAttribute((const void*)mk_fwd, hipFuncAttributeMaxDynamicSharedMemorySize, LDS_BYTES) != hipSuccess) { fprintf(stderr, "kernel_launch: hipFuncSetAttribute failed\n"); grid = -1; return; }
        if (hipOccupancyMaxActiveBlocksPerMultiprocessor(&per_cu, (const void*)mk_fwd, NWAVES * 64, LDS_BYTES) != hipSuccess || per_cu < 1) { fprintf(stderr, "kernel_launch: occupancy query says %d workgroups per CU; nothing launched\n", per_cu); (void)hipGetLastError(); grid = -1; return; }
        grid = cus;
    }
    if (grid < 0) return;
    if (hipMemsetAsync((char*)d_ws + WS_CTL, 0, CTL_ZERO_BYTES, stream) != hipSuccess) { fprintf(stderr, "kernel_launch: hipMemsetAsync failed\n"); return; }
    Args a{};
    for (int i = 0; i < 18; ++i) a.in[i] = (const float*)d_in[i];
    a.out = (float*)d_out; a.ws = (unsigned char*)d_ws;
    int li = 0;
    for (int ph = 0; ph < NPHASE;) {
        if ((MK_FUSED_MASK >> ph) & 1) {
            int hi = ph; while (hi < NPHASE && ((MK_FUSED_MASK >> hi) & 1)) ++hi;
            a.ph_lo = ph; a.ph_hi = hi; a.li = li++; a.pad = 0;
            hipLaunchKernelGGL(mk_fwd, dim3(grid), dim3(NWAVES * 64), LDS_BYTES, stream, a);
            const hipError_t le = hipPeekAtLastError();
            if (le != hipSuccess) { fprintf(stderr, "kernel_launch: launch failed: %s\n", hipGetErrorName(le)); return; }
            ph = hi;
        } else {
            golden_phase(ph, d_in, (float*)d_out, (unsigned char*)d_ws, stream);
            if ((ph == 1 || ph == 5) && (MK_FUSED_MASK & 1) && ((MK_FUSED_MASK >> 6) & 1)) {
                gold::k_cvt<<<(unsigned)(((size_t)NEXP * D + 255) / 256), 256, 0, stream>>>((const float*)d_in[12], (const float*)d_in[8], (bf16*)((unsigned char*)d_ws + WS_UB), (size_t)NEXP * D, D - 1);
                gold::k_cvt<<<(unsigned)(((size_t)NEXP * D + 255) / 256), 256, 0, stream>>>((const float*)d_in[13], nullptr, (bf16*)((unsigned char*)d_ws + WS_VB), (size_t)NEXP * D, 0);
            }
            ++ph;
        }
    }
}
```

```cpp
#include <hip/hip_runtime.h>
#include <hip/hip_bf16.h>
#include <cstdio>
#include <cstdint>
#include <cmath>
#define MK_FUSED_MASK 0x1ff
namespace pg8 {
#define PG8_LAS __attribute__((address_space(3)))
typedef unsigned short bf16_t;
typedef short bf16x8 __attribute__((ext_vector_type(8)));
typedef float f32x4 __attribute__((ext_vector_type(4)));
typedef unsigned u32x4 __attribute__((ext_vector_type(4)));
constexpr int BM = 256, BK = 64, HALF = 128, HTB = HALF * BK * 2  , STAGE_BYTES = 8 * HTB, NXCD = 8, WGM = 8;

__host__ __device__ __forceinline__ int lds_byte(int r, int c) { const int st = (r >> 4) * 2 + (c >> 5), rr = r & 15, cc = c & 31, ob = rr * 64 + cc * 2; return st * 1024 + (ob ^ (((ob >> 9) & 1) << 5)); }
__host__ __device__ __forceinline__ void stage_rc(int b, int& R, int& C) { const int st = b / 1024, sb = b % 1024, swz = sb ^ (((sb >> 9) & 1) << 5); R = (st >> 1) * 16 + swz / 64; C = (st & 1) * 32 + (swz % 64) / 2; }
__host__ __device__ __forceinline__ int perm32(int rho) { const int n = rho >> 4, i = rho & 15; return 8 * (i >> 2) + 4 * n + (i & 3); }

struct Unit { int pm, pn; };
struct Gemm { const bf16_t* A; const bf16_t* Bt; int M, N, K; };

struct StaticOrder {
    int nM, nN, nwg, G, c;
    __host__ __device__ void init(int M, int N, int G_, int c_) { nM = M / BM; nN = N / BM; nwg = nM * nN; G = G_; c = c_; }
    __host__ __device__ bool next(int i, Unit& u) const {
        const long L = (long)i * G + c; if (L >= nwg) return false;
        int wgid = (int)L; { const int q = nwg / NXCD, r = nwg % NXCD, xcd = wgid % NXCD, off = wgid / NXCD; wgid = (xcd < r ? xcd * (q + 1) : r * (q + 1) + (xcd - r) * q) + off; }
        const int nig = WGM * nN, gid = wgid / nig, fm = gid * WGM, gsz = (nM - fm) < WGM ? (nM - fm) : WGM;
        u.pm = fm + ((wgid % nig) % gsz); u.pn = (wgid % nig) / gsz; return true;
    }
    __device__ __forceinline__ void a_ready(const Unit&) const {}
    __device__ __forceinline__ void done(const Unit&) const {}
};


__device__ __forceinline__ unsigned cvt_pk_bf16(float lo, float hi) { unsigned r; asm volatile("v_cvt_pk_bf16_f32 %0, %1, %2" : "=v"(r) : "v"(lo), "v"(hi)); return r; }
__device__ __forceinline__ u32x4 pack8(const f32x4 v0, const f32x4 v1) { u32x4 w; w.x = cvt_pk_bf16(v0[0], v0[1]); w.y = cvt_pk_bf16(v0[2], v0[3]); w.z = cvt_pk_bf16(v1[0], v1[1]); w.w = cvt_pk_bf16(v1[2], v1[3]); return w; }
__device__ __forceinline__ float bflo(unsigned w) { return __uint_as_float(w << 16); }
__device__ __forceinline__ float bfhi(unsigned w) { return __uint_as_float(w & 0xffff0000u); }
__device__ __forceinline__ float sigm(float v) { return __builtin_amdgcn_rcpf(1.0f + __builtin_amdgcn_exp2f(v * -1.4426950408889634f)); }
__device__ __forceinline__ f32x4 sigm4(const f32x4 v) { return (f32x4){sigm(v[0]), sigm(v[1]), sigm(v[2]), sigm(v[3])}; }

struct EpiIn {
    static constexpr bool PERM = true, AFTER_DRAIN = false; static constexpr int MID_T = 0;
    const float* rstd; bf16_t* QKVG; size_t stride4; bf16_t* Z; bf16_t* SG; size_t strideSG; float c2;
    __device__ __forceinline__ void operator()(const f32x4 (&acc)[2][2][4][2], const Unit& u, int wr, int wc, int fr, int fq) const {
        int row0 = u.pm * BM + wr * 64 + fr; asm volatile("" : "+v"(row0)); const int cl = wc * 32 + 8 * fq, pn = u.pn;
        if (pn < 8) {
            bf16_t* base = QKVG + (size_t)(pn >> 1) * stride4; const int colt = (pn & 1) * 256 + cl; const float s0 = pn < 2 ? c2 : 1.f;
#pragma unroll
            for (int ai = 0; ai < 2; ++ai)
#pragma unroll
                for (int m = 0; m < 4; ++m) { const int row = row0 + ai * HALF + m * 16; const float sc = rstd[row] * s0; bf16_t* rowp = base + (size_t)row * 512 + colt;
#pragma unroll
                    for (int bj = 0; bj < 2; ++bj) *(u32x4*)(rowp + bj * HALF) = pack8(acc[ai][bj][m][0] * sc, acc[ai][bj][m][1] * sc);
                    asm volatile("" ::: "memory"); }
        } else if (pn < 12) {
            const int colt = (pn - 8) * 128 + cl;
#pragma unroll
            for (int ai = 0; ai < 2; ++ai)
#pragma unroll
                for (int m = 0; m < 4; ++m) { const int row = row0 + ai * HALF + m * 16; const float r = rstd[row], sc = r * r;
                    *(u32x4*)(Z + (size_t)row * 512 + colt) = pack8(acc[ai][0][m][0] * acc[ai][1][m][0] * sc, acc[ai][0][m][1] * acc[ai][1][m][1] * sc);
                    asm volatile("" ::: "memory"); }
        } else {
            bf16_t* base = SG + (size_t)((pn - 12) >> 2) * strideSG; const int colt = ((pn - 12) & 3) * 256 + cl;
#pragma unroll
            for (int ai = 0; ai < 2; ++ai)
#pragma unroll
                for (int m = 0; m < 4; ++m) { const int row = row0 + ai * HALF + m * 16; const float r = rstd[row]; bf16_t* rowp = base + (size_t)row * 1024 + colt;
#pragma unroll
                    for (int bj = 0; bj < 2; ++bj) { *(u32x4*)(rowp + bj * HALF) = pack8(sigm4(acc[ai][bj][m][0] * r), sigm4(acc[ai][bj][m][1] * r)); asm volatile("" ::: "memory"); } }
        }
    }
};
struct EpiPlain {
    static constexpr bool PERM = true, AFTER_DRAIN = false; static constexpr int MID_T = 0;
    bf16_t* O; int ldc;
    __device__ __forceinline__ void operator()(const f32x4 (&acc)[2][2][4][2], const Unit& u, int wr, int wc, int fr, int fq) const {
        int row0 = u.pm * BM + wr * 64 + fr; asm volatile("" : "+v"(row0)); const int col0 = u.pn * BM + wc * 32 + 8 * fq;
#pragma unroll
        for (int ai = 0; ai < 2; ++ai)
#pragma unroll
            for (int m = 0; m < 4; ++m) { bf16_t* rowp = O + (size_t)(row0 + ai * HALF + m * 16) * ldc + col0;
#pragma unroll
                for (int bj = 0; bj < 2; ++bj) *(u32x4*)(rowp + bj * HALF) = pack8(acc[ai][bj][m][0], acc[ai][bj][m][1]); }
    }
};
struct EpiBranch {
    static constexpr bool PERM = true, AFTER_DRAIN = false; static constexpr int MID_T = 8;
    const bf16_t *SGA, *SGC; bf16_t* MG;
    __device__ __forceinline__ void mid(f32x4 (&acc)[2][2][4][2], const Unit& u, int wr, int wc, int fr, int fq) const {
        int row0 = u.pm * BM + wr * 64 + fr; asm volatile("" : "+v"(row0)); const int col0 = u.pn * BM + wc * 32 + 8 * fq;
#pragma unroll
        for (int ai = 0; ai < 2; ++ai)
#pragma unroll
            for (int m = 0; m < 4; ++m) { const size_t off = (size_t)(row0 + ai * HALF + m * 16) * 1024 + col0;
#pragma unroll
                for (int bj = 0; bj < 2; ++bj) { const u32x4 a = *(const u32x4*)(SGA + off + bj * HALF), c = *(const u32x4*)(SGC + off + bj * HALF);
                    f32x4 r0, r1;
                    r0[0] = bflo(a[0]) * __builtin_amdgcn_rcpf(bflo(c[0])); r0[1] = bfhi(a[0]) * __builtin_amdgcn_rcpf(bfhi(c[0])); r0[2] = bflo(a[1]) * __builtin_amdgcn_rcpf(bflo(c[1])); r0[3] = bfhi(a[1]) * __builtin_amdgcn_rcpf(bfhi(c[1]));
                    r1[0] = bflo(a[2]) * __builtin_amdgcn_rcpf(bflo(c[2])); r1[1] = bfhi(a[2]) * __builtin_amdgcn_rcpf(bfhi(c[2])); r1[2] = bflo(a[3]) * __builtin_amdgcn_rcpf(bflo(c[3])); r1[3] = bfhi(a[3]) * __builtin_amdgcn_rcpf(bfhi(c[3]));
                    acc[ai][bj][m][0] *= r0; acc[ai][bj][m][1] *= r1; asm volatile("" ::: "memory"); } }
    }
    __device__ __forceinline__ void operator()(const f32x4 (&acc)[2][2][4][2], const Unit& u, int wr, int wc, int fr, int fq) const {
        int row0 = u.pm * BM + wr * 64 + fr; asm volatile("" : "+v"(row0)); const int col0 = u.pn * BM + wc * 32 + 8 * fq;
#pragma unroll
        for (int ai = 0; ai < 2; ++ai)
#pragma unroll
            for (int m = 0; m < 4; ++m) { const size_t off = (size_t)(row0 + ai * HALF + m * 16) * 1024 + col0;
#pragma unroll
                for (int bj = 0; bj < 2; ++bj) { const u32x4 c = *(const u32x4*)(SGC + off + bj * HALF);
                    const f32x4 s0 = {bflo(c[0]), bfhi(c[0]), bflo(c[1]), bfhi(c[1])}, s1 = {bflo(c[2]), bfhi(c[2]), bflo(c[3]), bfhi(c[3])};
                    *(u32x4*)(MG + off + bj * HALF) = pack8(acc[ai][bj][m][0] * s0, acc[ai][bj][m][1] * s1); asm volatile("" ::: "memory"); } }
    }
};
struct EpiOut {
    static constexpr bool PERM = true, AFTER_DRAIN = false; static constexpr int MID_T = 0;
    const float* x; float* X1; bf16_t* XB1; float* SS2;
    __device__ __forceinline__ void operator()(const f32x4 (&acc)[2][2][4][2], const Unit& u, int wr, int wc, int fr, int fq) const {
        int row0 = u.pm * BM + wr * 64 + fr; asm volatile("" : "+v"(row0)); const int col0 = u.pn * BM + wc * 32 + 8 * fq;
#pragma unroll
        for (int ai = 0; ai < 2; ++ai)
#pragma unroll
            for (int m = 0; m < 4; ++m) { const int row = row0 + ai * HALF + m * 16; const size_t off = (size_t)row * 1024 + col0; float ss = 0.f;
#pragma unroll
                for (int bj = 0; bj < 2; ++bj) { const f32x4 v0 = acc[ai][bj][m][0] + *(const f32x4*)(x + off + bj * HALF), v1 = acc[ai][bj][m][1] + *(const f32x4*)(x + off + bj * HALF + 4);
                    *(f32x4*)(X1 + off + bj * HALF) = v0; *(f32x4*)(X1 + off + bj * HALF + 4) = v1; *(u32x4*)(XB1 + off + bj * HALF) = pack8(v0, v1);
                    ss += (v0[0] * v0[0] + v0[1] * v0[1]) + (v0[2] * v0[2] + v0[3] * v0[3]) + (v1[0] * v1[0] + v1[1] * v1[1]) + (v1[2] * v1[2] + v1[3] * v1[3]); }
                ss += __shfl_xor(ss, 16); ss += __shfl_xor(ss, 32);
                if (fq == 0) SS2[(size_t)row * 16 + u.pn * 4 + wc] = ss;
                if (m & 1) asm volatile("" ::: "memory"); }
    }
};
struct EpiPle {
    static constexpr bool PERM = true, AFTER_DRAIN = false; static constexpr int MID_T = 0;
    const float* SS3; const bf16_t* PP; float* X; float eps;
    __device__ __forceinline__ void operator()(const f32x4 (&acc)[2][2][4][2], const Unit& u, int wr, int wc, int fr, int fq) const {
        int row0 = u.pm * BM + wr * 64 + fr; asm volatile("" : "+v"(row0)); const int col0 = u.pn * BM + wc * 32 + 8 * fq;
#pragma unroll
        for (int ai = 0; ai < 2; ++ai)
#pragma unroll
            for (int m = 0; m < 4; ++m) { const int row = row0 + ai * HALF + m * 16; const size_t off = (size_t)row * 1024 + col0;
                const f32x4* sp = (const f32x4*)(SS3 + (size_t)row * 16); const f32x4 q0 = sp[0], q1 = sp[1], q2 = sp[2], q3 = sp[3];
                const float r = 1.0f / sqrtf((((q0[0] + q0[1]) + (q0[2] + q0[3])) + ((q1[0] + q1[1]) + (q1[2] + q1[3])) + ((q2[0] + q2[1]) + (q2[2] + q2[3])) + ((q3[0] + q3[1]) + (q3[2] + q3[3]))) * (1.0f / 1024.0f) + eps);
#pragma unroll
                for (int bj = 0; bj < 2; ++bj) { const u32x4 c = *(const u32x4*)(PP + off + bj * HALF);
                    const f32x4 p0 = {bflo(c[0]), bfhi(c[0]), bflo(c[1]), bfhi(c[1])}, p1 = {bflo(c[2]), bfhi(c[2]), bflo(c[3]), bfhi(c[3])};
                    const f32x4 x0 = *(const f32x4*)(X + off + bj * HALF), x1 = *(const f32x4*)(X + off + bj * HALF + 4);
                    *(f32x4*)(X + off + bj * HALF) = x0 + sigm4(acc[ai][bj][m][0] * r) * p0; *(f32x4*)(X + off + bj * HALF + 4) = x1 + sigm4(acc[ai][bj][m][1] * r) * p1; }
                if (m & 1) asm volatile("" ::: "memory"); }
    }
};

__device__ __forceinline__ float vmaxf(float a, float b) { float r; asm("v_max_f32_e32 %0, %1, %2" : "=v"(r) : "v"(a), "v"(b)); return r; }
__device__ __forceinline__ float vminf(float a, float b) { float r; asm("v_min_f32_e32 %0, %1, %2" : "=v"(r) : "v"(a), "v"(b)); return r; }
__device__ __forceinline__ void sort16_desc(float (&a)[16]) {
#pragma unroll
    for (int k = 2; k <= 16; k <<= 1)
#pragma unroll
        for (int j = k >> 1; j > 0; j >>= 1)
#pragma unroll
            for (int i = 0; i < 16; ++i) { const int l = i ^ j; if (l > i) { const float hi = vmaxf(a[i], a[l]), lo = vminf(a[i], a[l]); if ((i & k) == 0) { a[i] = hi; a[l] = lo; } else { a[i] = lo; a[l] = hi; } } }
}
template <int L> __device__ __forceinline__ void merge16(float (&a)[16], const float (&b)[16]) {
#pragma unroll
    for (int i = 0; i < 16; ++i) if (15 - i < L) a[i] = vmaxf(a[i], b[15 - i]);
#pragma unroll
    for (int j = 8; j > 0; j >>= 1)
#pragma unroll
        for (int i = 0; i < 16; ++i) { const int l = i ^ j; if (l > i) { const float hi = vmaxf(a[i], a[l]), lo = vminf(a[i], a[l]); a[i] = hi; a[l] = lo; } }
}
struct EpiTopK {
    static constexpr bool PERM = true, AFTER_DRAIN = true; static constexpr int MID_T = 0;
    static constexpr int RS = 260;
    const float* SS2; unsigned short* IDS; float* GATES; float eps;
    __device__ __forceinline__ void fused(f32x4 (&acc)[2][2][4][2], const Unit& u, int wr, int wc, int fr, int fq, PG8_LAS unsigned char* lds, int wid, int lane) const {
        PG8_LAS float* S = (PG8_LAS float*)lds;
        const int tid = wid * 64 + lane, row = tid & 127, grp = tid >> 7, half = grp >> 1, part = grp & 1;
#define TK_BAR() do { asm volatile("s_waitcnt vmcnt(0) lgkmcnt(0)" ::: "memory"); __builtin_amdgcn_s_barrier(); asm volatile("" ::: "memory"); } while (0)
#pragma unroll
        for (int ai = 0; ai < 2; ++ai) {
#pragma unroll
            for (int m = 0; m < 4; ++m)
#pragma unroll
                for (int bj = 0; bj < 2; ++bj)
#pragma unroll
                    for (int n = 0; n < 2; ++n) *(PG8_LAS f32x4*)(S + (wr * 64 + m * 16 + fr) * RS + bj * HALF + wc * 32 + 8 * fq + 4 * n) = acc[ai][bj][m][n];
            TK_BAR();
            float T[16];
#pragma unroll
            for (int b = 0; b < 4; ++b) {
                float c[16];
#pragma unroll
                for (int q = 0; q < 4; ++q) { const f32x4 v = *(const PG8_LAS f32x4*)(S + row * RS + half * 128 + part * 64 + b * 16 + q * 4);
#pragma unroll
                    for (int e = 0; e < 4; ++e) c[q * 4 + e] = __uint_as_float((__float_as_uint(v[e]) & ~127u) | (unsigned)(part * 64 + b * 16 + q * 4 + e)); }
                sort16_desc(c);
                if (b == 0) {
#pragma unroll
                    for (int i = 0; i < 16; ++i) T[i] = c[i];
                } else merge16<16>(T, c);
            }
            TK_BAR();
#pragma unroll
            for (int q = 0; q < 4; ++q) *(PG8_LAS f32x4*)(S + tid * 16 + q * 4) = (f32x4){T[q * 4], T[q * 4 + 1], T[q * 4 + 2], T[q * 4 + 3]};
            TK_BAR();
            if (part == 0) {
                float c[16];
#pragma unroll
                for (int q = 0; q < 4; ++q) { const f32x4 v = *(const PG8_LAS f32x4*)(S + (tid + 128) * 16 + q * 4); c[q * 4] = v[0]; c[q * 4 + 1] = v[1]; c[q * 4 + 2] = v[2]; c[q * 4 + 3] = v[3]; }
                merge16<16>(T, c);
            }
            TK_BAR();
            if (part == 0) {
#pragma unroll
                for (int q = 0; q < 4; ++q) *(PG8_LAS f32x4*)(S + tid * 16 + q * 4) = (f32x4){T[q * 4], T[q * 4 + 1], T[q * 4 + 2], T[q * 4 + 3]};
            }
            TK_BAR();
            if (tid < 128) {
                float a1[16], a2[16];
#pragma unroll
                for (int q = 0; q < 4; ++q) { const f32x4 v = *(const PG8_LAS f32x4*)(S + (tid + 256) * 16 + q * 4);
#pragma unroll
                    for (int e = 0; e < 4; ++e) a2[q * 4 + e] = __uint_as_float(__float_as_uint(v[e]) & ~127u); }
#pragma unroll
                for (int i = 0; i < 16; ++i) a1[i] = __uint_as_float(__float_as_uint(T[i]) & ~127u);
#define TK_SUM(i, j) __uint_as_float((__float_as_uint(a1[i] + a2[j]) & ~255u) | (unsigned)((i) * 16 + (j)))
                float R[16], C[16];
#pragma unroll
                for (int j = 0; j < 16; ++j) R[j] = TK_SUM(0, j);
#pragma unroll
                for (int i = 1; i < 16; ++i) C[i - 1] = TK_SUM(i, 0);
                C[15] = 0.f;
                merge16<15>(R, C);
                C[0] = TK_SUM(1, 1); C[1] = TK_SUM(1, 2); C[2] = TK_SUM(1, 3); C[3] = TK_SUM(1, 4); C[4] = TK_SUM(1, 5); C[5] = TK_SUM(1, 6); C[6] = TK_SUM(1, 7);
                C[7] = TK_SUM(2, 1); C[8] = TK_SUM(2, 2); C[9] = TK_SUM(2, 3); C[10] = TK_SUM(2, 4); C[11] = TK_SUM(3, 1); C[12] = TK_SUM(3, 2); C[13] = TK_SUM(3, 3);
                C[14] = TK_SUM(4, 1); C[15] = TK_SUM(4, 2);
                sort16_desc(C);
                merge16<16>(R, C);
                C[0] = TK_SUM(5, 1); C[1] = TK_SUM(6, 1); C[2] = TK_SUM(7, 1);
                merge16<3>(R, C);
#undef TK_SUM
                const int rowg = u.pm * BM + ai * HALF + row;
                const f32x4* ssp = (const f32x4*)(SS2 + (size_t)rowg * 16); const f32x4 s0 = ssp[0], s1 = ssp[1], s2 = ssp[2], s3 = ssp[3];
                const float ssum = ((s0[0] + s0[1]) + (s0[2] + s0[3])) + ((s1[0] + s1[1]) + (s1[2] + s1[3])) + ((s2[0] + s2[1]) + (s2[2] + s2[3])) + ((s3[0] + s3[1]) + (s3[2] + s3[3]));
                const float rl = 1.4426950408889634f / sqrtf(ssum * (1.0f / 1024.0f) + eps);
                float ev[16], esum = 0.f; int idv[16];
#pragma unroll
                for (int r = 0; r < 16; ++r) { ev[r] = __builtin_amdgcn_exp2f((R[r] - R[0]) * rl); esum += ev[r];
                    const unsigned code = __float_as_uint(R[r]) & 255u;
                    const unsigned k1 = __float_as_uint(S[tid * 16 + (code >> 4)]) & 127u, k2 = __float_as_uint(S[(tid + 256) * 16 + (code & 15u)]) & 127u;
                    idv[r] = (int)(k1 * 128u + k2); }
                const float inv = 1.0f / esum;
                unsigned short* ip = IDS + (size_t)rowg * 128 + u.pn * 16; float* gp = GATES + (size_t)rowg * 128 + u.pn * 16;
#pragma unroll
                for (int q = 0; q < 2; ++q) { u32x4 w; w.x = (unsigned)idv[q * 8] | ((unsigned)idv[q * 8 + 1] << 16); w.y = (unsigned)idv[q * 8 + 2] | ((unsigned)idv[q * 8 + 3] << 16); w.z = (unsigned)idv[q * 8 + 4] | ((unsigned)idv[q * 8 + 5] << 16); w.w = (unsigned)idv[q * 8 + 6] | ((unsigned)idv[q * 8 + 7] << 16);
                    *(u32x4*)(ip + q * 8) = w; }
#pragma unroll
                for (int q = 0; q < 4; ++q) *(f32x4*)(gp + q * 4) = (f32x4){ev[q * 4] * inv, ev[q * 4 + 1] * inv, ev[q * 4 + 2] * inv, ev[q * 4 + 3] * inv};
            }
            TK_BAR();
        }
#undef TK_BAR
    }
};
template <class Epi, class Sched, bool ALIGN_EPI = false, bool SP2 = false>
__device__ __forceinline__ void gemm_phase(PG8_LAS unsigned char* lds, const Gemm g, const Sched& S, const Epi& E) {
    const int tid = threadIdx.x, wid = __builtin_amdgcn_readfirstlane(tid >> 6), lane = tid & 63, wr = wid >> 2, wc = wid & 3, fr = lane & 15, fq = lane >> 4;
    const int K = g.K, nt = K / BK;
    unsigned voffA[2], voffB[2];
#pragma unroll
    for (int i = 0; i < 2; ++i) { int R, C; stage_rc(tid * 16 + i * 8192, R, C); const int Rb = Epi::PERM ? ((R & ~31) + perm32(R & 31)) : R;
        voffA[i] = (unsigned)(R * K + C) * 2u; voffB[i] = (unsigned)(Rb * K + C) * 2u; }
    const size_t kstep = (size_t)(BK * 2);
    const size_t hstep = (size_t)HALF * K * 2;
    const size_t tstep = 2 * hstep;
    const unsigned ldsw = (unsigned)wid * 1024u;
    const int aoff = lds_byte(wr * 64 + fr, fq * 8), boff = lds_byte(wc * 32 + fr, fq * 8);
#define PG8_SA(b, h) (((b) * 2 + (h)) * HTB)
#define PG8_SB(b, h) ((4 + (b) * 2 + (h)) * HTB)
#define PG8_STAGE(bufoff, gbase, voff) do { _Pragma("unroll") for (int _i = 0; _i < 2; ++_i) \
        __builtin_amdgcn_global_load_lds((const unsigned*)((const char*)(gbase) + (voff)[_i]), (PG8_LAS unsigned*)(lds + (bufoff) + ldsw + _i * 8192), 16, 0, 0); } while (0)
#define PG8_LDA(dst, b, h) do { _Pragma("unroll") for (int m = 0; m < 4; ++m) _Pragma("unroll") for (int k = 0; k < 2; ++k) dst[m][k] = *(const PG8_LAS bf16x8*)(lds + PG8_SA(b, h) + aoff + m * 2048 + k * 1024); } while (0)
#define PG8_LDB(dst, b, h) do { _Pragma("unroll") for (int n = 0; n < 2; ++n) _Pragma("unroll") for (int k = 0; k < 2; ++k) dst[n][k] = *(const PG8_LAS bf16x8*)(lds + PG8_SB(b, h) + boff + n * 2048 + k * 1024); } while (0)
#define PG8_MMA(ai, bj, At, Bt) do { __builtin_amdgcn_s_setprio(1); _Pragma("unroll") for (int m = 0; m < 4; ++m) _Pragma("unroll") for (int n = 0; n < 2; ++n) _Pragma("unroll") for (int k = 0; k < 2; ++k) \
        acc[ai][bj][m][n] = __builtin_amdgcn_mfma_f32_16x16x32_bf16(Bt[n][k], At[m][k], acc[ai][bj][m][n], 0, 0, 0); __builtin_amdgcn_s_setprio(0); } while (0)
#define PG8_WAIT_V(n) asm volatile("s_waitcnt vmcnt(" #n ")" ::: "memory")
#define PG8_WAIT_L(n) asm volatile("s_waitcnt lgkmcnt(" #n ")" ::: "memory")
#define PG8_BAR __builtin_amdgcn_s_barrier()
#define PG8_SCHED __builtin_amdgcn_sched_barrier(0)
    Unit cur, nxt; int ui = 0;
    if (!S.next(0, cur)) return;
    f32x4 acc[2][2][4][2];
#pragma unroll
    for (int a = 0; a < 2; ++a)
#pragma unroll
        for (int b = 0; b < 2; ++b)
#pragma unroll
            for (int m = 0; m < 4; ++m)
#pragma unroll
                for (int n = 0; n < 2; ++n) acc[a][b][m][n] = (f32x4){0.f, 0.f, 0.f, 0.f};
    bf16x8 At[4][2], B0[2][2], B1[2][2];
    const char* cA = (const char*)g.A + (size_t)cur.pm * tstep; const char* cB = (const char*)g.Bt + (size_t)cur.pn * tstep;
    S.a_ready(cur);
    if constexpr (SP2) {
        PG8_STAGE(PG8_SB(0, 0), cB, voffB); PG8_STAGE(PG8_SB(0, 1), cB + hstep, voffB); PG8_STAGE(PG8_SA(0, 0), cA, voffA); PG8_STAGE(PG8_SA(0, 1), cA + hstep, voffA);
        if (wr == 1) PG8_BAR;
        PG8_WAIT_V(2); PG8_BAR;
        PG8_STAGE(PG8_SB(1, 0), cB + kstep, voffB); PG8_STAGE(PG8_SA(1, 0), cA + kstep, voffA); PG8_STAGE(PG8_SB(1, 1), cB + hstep + kstep, voffB);
        PG8_WAIT_V(6); PG8_BAR;
    } else {
        PG8_STAGE(PG8_SB(0, 0), cB, voffB); PG8_STAGE(PG8_SA(0, 0), cA, voffA); PG8_STAGE(PG8_SB(0, 1), cB + hstep, voffB); PG8_STAGE(PG8_SA(0, 1), cA + hstep, voffA);
        if (wr == 1) PG8_BAR;
        PG8_WAIT_V(4); PG8_BAR;
        PG8_STAGE(PG8_SB(1, 0), cB + kstep, voffB); PG8_STAGE(PG8_SA(1, 0), cA + kstep, voffA); PG8_STAGE(PG8_SB(1, 1), cB + hstep + kstep, voffB);
        PG8_WAIT_V(6); PG8_BAR;
    }
    for (;;) {
        const bool has_next = S.next(ui + 1, nxt);
        const char* nA = has_next ? (const char*)g.A + (size_t)nxt.pm * tstep : cA; const char* nB = has_next ? (const char*)g.Bt + (size_t)nxt.pn * tstep : cB;
        for (int t = 0; t < nt; t += 2) {
            if constexpr (Epi::MID_T > 0) { if (t == Epi::MID_T) E.mid(acc, cur, wr, wc, fr, fq); }
            const bool last = (t == nt - 2);
            const char* a1 = cA + (size_t)(t + 1) * kstep;
            const char* a2 = last ? nA : cA + (size_t)(t + 2) * kstep; const char* b2 = last ? nB : cB + (size_t)(t + 2) * kstep;
            const char* a3 = a2 + kstep; const char* b3 = b2 + kstep;
            if (last && has_next) S.a_ready(nxt);
            if constexpr (SP2) {
            PG8_LDB(B0, 0, 0); PG8_LDB(B1, 0, 1); PG8_SCHED; PG8_LDA(At, 0, 0); PG8_STAGE(PG8_SA(1, 1), a1 + hstep, voffA);
            PG8_WAIT_V(8); PG8_WAIT_L(0); PG8_BAR; PG8_MMA(0, 0, At, B0); PG8_MMA(0, 1, At, B1); PG8_BAR; PG8_SCHED;
            PG8_LDA(At, 0, 1); PG8_STAGE(PG8_SB(0, 0), b2, voffB); PG8_STAGE(PG8_SB(0, 1), b2 + hstep, voffB); PG8_STAGE(PG8_SA(0, 0), a2, voffA);
            PG8_WAIT_V(8); PG8_WAIT_L(0); PG8_BAR; PG8_MMA(1, 0, At, B0); PG8_MMA(1, 1, At, B1); PG8_BAR; PG8_SCHED;
            PG8_LDB(B0, 1, 0); PG8_LDB(B1, 1, 1); PG8_SCHED; PG8_LDA(At, 1, 0); PG8_STAGE(PG8_SA(0, 1), a2 + hstep, voffA);
            PG8_WAIT_V(8); PG8_WAIT_L(0); PG8_BAR; PG8_MMA(0, 0, At, B0); PG8_MMA(0, 1, At, B1); PG8_BAR; PG8_SCHED;
            PG8_LDA(At, 1, 1); PG8_STAGE(PG8_SB(1, 0), b3, voffB); PG8_STAGE(PG8_SB(1, 1), b3 + hstep, voffB); PG8_STAGE(PG8_SA(1, 0), a3, voffA);
            PG8_WAIT_V(8); PG8_WAIT_L(0); PG8_BAR; PG8_MMA(1, 0, At, B0); PG8_MMA(1, 1, At, B1); PG8_BAR; PG8_SCHED;
            } else {
            PG8_LDB(B0, 0, 0); PG8_SCHED; PG8_LDA(At, 0, 0); PG8_STAGE(PG8_SA(1, 1), a1 + hstep, voffA);
            PG8_WAIT_L(8); PG8_BAR; PG8_WAIT_L(0); PG8_MMA(0, 0, At, B0); PG8_BAR; PG8_SCHED;
            PG8_LDB(B1, 0, 1); PG8_STAGE(PG8_SB(0, 0), b2, voffB);
            PG8_BAR; PG8_WAIT_L(0); PG8_MMA(0, 1, At, B1); PG8_BAR;
            PG8_LDA(At, 0, 1); PG8_STAGE(PG8_SA(0, 0), a2, voffA);
            PG8_BAR; PG8_WAIT_L(0); PG8_MMA(1, 0, At, B0); PG8_BAR; PG8_SCHED;
            PG8_STAGE(PG8_SB(0, 1), b2 + hstep, voffB);
            PG8_WAIT_V(6); PG8_BAR; PG8_MMA(1, 1, At, B1); PG8_BAR;
            PG8_LDB(B0, 1, 0); PG8_SCHED; PG8_LDA(At, 1, 0); PG8_STAGE(PG8_SA(0, 1), a2 + hstep, voffA);
            PG8_WAIT_L(8); PG8_BAR; PG8_WAIT_L(0); PG8_MMA(0, 0, At, B0); PG8_BAR; PG8_SCHED;
            PG8_LDB(B1, 1, 1); PG8_STAGE(PG8_SB(1, 0), b3, voffB);
            PG8_BAR; PG8_WAIT_L(0); PG8_MMA(0, 1, At, B1); PG8_BAR;
            PG8_LDA(At, 1, 1); PG8_STAGE(PG8_SA(1, 0), a3, voffA);
            PG8_BAR; PG8_WAIT_L(0); PG8_MMA(1, 0, At, B0); PG8_BAR; PG8_SCHED;
            PG8_STAGE(PG8_SB(1, 1), b3 + hstep, voffB);
            PG8_WAIT_V(6); PG8_BAR; PG8_MMA(1, 1, At, B1); PG8_BAR;
            }
        }
        if constexpr (ALIGN_EPI) { if (wr == 0) PG8_BAR; }
        if constexpr (!Epi::AFTER_DRAIN) { E(acc, cur, wr, wc, fr, fq); S.done(cur); }
        if (!has_next) break;
#pragma unroll
        for (int a = 0; a < 2; ++a)
#pragma unroll
            for (int b = 0; b < 2; ++b)
#pragma unroll
                for (int m = 0; m < 4; ++m)
#pragma unroll
                    for (int n = 0; n < 2; ++n) acc[a][b][m][n] = (f32x4){0.f, 0.f, 0.f, 0.f};
        cur = nxt; cA = nA; cB = nB; ++ui;
        if constexpr (ALIGN_EPI) { if (wr == 1) PG8_BAR; }
    }
    PG8_WAIT_V(0);
    if constexpr (!ALIGN_EPI) { if (wr == 0) PG8_BAR; }
    PG8_BAR;
    if constexpr (Epi::AFTER_DRAIN) { E.fused(acc, cur, wr, wc, fr, fq, lds, wid, lane); S.done(cur); }
#undef PG8_SA
#undef PG8_SB
#undef PG8_STAGE
#undef PG8_LDA
#undef PG8_LDB
#undef PG8_MMA
#undef PG8_WAIT_V
#undef PG8_WAIT_L
#undef PG8_BAR
#undef PG8_SCHED
}
}
#ifndef PG8_SP2
#define PG8_SP2 true
#endif
#ifndef PG8_ALIGN
#define PG8_ALIGN true
#endif
namespace attn_body {
using bf16=__hip_bfloat16;
using bf16x8=__attribute__((ext_vector_type(8)))short;
using s16x4=__attribute__((ext_vector_type(4)))short;
using f32x16=__attribute__((ext_vector_type(16)))float;
using u32x4=__attribute__((ext_vector_type(4)))unsigned;
using f32x4v=__attribute__((ext_vector_type(4)))float;
constexpr int BATCH=4,NHEAD=8,SEQ=4096,D=64,DM=NHEAD*D,DMO=1024;
constexpr int NW=8,QBLK=32,QB=QBLK*NW,KVBLK=64,NQB=SEQ/QB;
constexpr int ATTN_PITCH=DM, ATTN_UNIT_ROWS=QB;
__device__ __forceinline__ int crow(int r,int hi){return (r&3)+8*(r>>2)+4*hi;}
#define SBAR() __builtin_amdgcn_sched_barrier(0)
__device__ __forceinline__ void cmask(f32x16&p0,f32x16&p1,int jb,int qrel,int hi){
  const float NEG=-INFINITY; int kb=64*jb+4*hi;
  #pragma unroll
  for(int r=0;r<16;++r){int kv=kb+(r&3)+8*(r>>2); if(kv>qrel)p0[r]=NEG; if(kv+32>qrel)p1[r]=NEG;}
}

constexpr int NSLOT=3, SLOTB=8192;
constexpr int LDS_K=0, LDS_V=NSLOT*SLOTB, LDS_WS=2*NSLOT*SLOTB, LDS_OST=LDS_WS+NW*64*4, LDS_CS=LDS_OST+NW*4096, LDS_BYTES=LDS_CS+SEQ*4+64;
constexpr float C2=0.125f*1.4426950408889634f;
__device__ __forceinline__ void glds16(const void*gsrc,unsigned lds_dst){unsigned keep;
  asm volatile("s_mov_b32 %0, m0\n\ts_mov_b32 m0, %2\n\ts_nop 0\n\tglobal_load_lds_dwordx4 %1, off\n\ts_mov_b32 m0, %0":"=&s"(keep):"v"(gsrc),"s"(lds_dst):"memory");}
__device__ __forceinline__ float max3f(float a,float b,float c){float r;asm("v_max3_f32 %0, %1, %2, %3":"=v"(r):"v"(a),"v"(b),"v"(c));return r;}
__device__ __forceinline__ float max2f(float a,float b){float r;asm("v_max_f32_e32 %0, %1, %2":"=v"(r):"v"(a),"v"(b));return r;}
__device__ __forceinline__ float fadd_s(float a,float b){float r;asm("v_add_f32_e32 %0, %1, %2":"=v"(r):"v"(a),"v"(b));return r;}
__device__ __forceinline__ float fsub_s(float a,float b){float r;asm("v_sub_f32_e32 %0, %1, %2":"=v"(r):"v"(a),"v"(b));return r;}
typedef float f32x2_t __attribute__((ext_vector_type(2))); typedef __bf16 bf16x2_t __attribute__((ext_vector_type(2)));
__device__ __forceinline__ unsigned cvtpk_s(float lo,float hi){f32x2_t v={lo,hi};bf16x2_t b=__builtin_convertvector(v,bf16x2_t);return __builtin_bit_cast(unsigned,b);}
#define WAIT_BAR(N) asm volatile("s_waitcnt vmcnt(" #N ") lgkmcnt(0)\n\ts_barrier":::"memory")

__device__ __forceinline__ void qkt(f32x16&p0,f32x16&p1,const char*Kslot,const bf16x8*qr,const f32x16&c0,const f32x16&c1,int r32,int hi){
  const char*kb=Kslot+hi*1024+r32*16;
  #pragma unroll
  for(int d0=0;d0<4;++d0){
    const bf16x8 b0=*reinterpret_cast<const bf16x8*>(kb+d0*2048);
    const bf16x8 b1=*reinterpret_cast<const bf16x8*>(kb+d0*2048+512);
    if(d0==0){p0=__builtin_amdgcn_mfma_f32_32x32x16_bf16(b0,qr[0],c0,0,0,0);p1=__builtin_amdgcn_mfma_f32_32x32x16_bf16(b1,qr[0],c1,0,0,0);}
    else{p0=__builtin_amdgcn_mfma_f32_32x32x16_bf16(b0,qr[d0],p0,0,0,0);p1=__builtin_amdgcn_mfma_f32_32x32x16_bf16(b1,qr[d0],p1,0,0,0);}}
}
typedef __attribute__((address_space(3))) const char* lds_cptr;
typedef short v4i16_t __attribute__((ext_vector_type(4)));
__device__ __forceinline__ void kload8(bf16x8*kf,lds_cptr kp){
  kf[0]=*(const __attribute__((address_space(3))) bf16x8*)(kp);      kf[1]=*(const __attribute__((address_space(3))) bf16x8*)(kp+512);
  kf[2]=*(const __attribute__((address_space(3))) bf16x8*)(kp+2048); kf[3]=*(const __attribute__((address_space(3))) bf16x8*)(kp+2560);
  kf[4]=*(const __attribute__((address_space(3))) bf16x8*)(kp+4096); kf[5]=*(const __attribute__((address_space(3))) bf16x8*)(kp+4608);
  kf[6]=*(const __attribute__((address_space(3))) bf16x8*)(kp+6144); kf[7]=*(const __attribute__((address_space(3))) bf16x8*)(kp+6656);
}
__device__ __forceinline__ void kload2(bf16x8*kf,lds_cptr kp,int j){ kf[2*j]=*(const __attribute__((address_space(3))) bf16x8*)(kp+j*2048); kf[2*j+1]=*(const __attribute__((address_space(3))) bf16x8*)(kp+j*2048+512); }
__device__ __forceinline__ s16x4 vtr(lds_cptr p){ return __builtin_bit_cast(s16x4,__builtin_amdgcn_ds_read_tr16_b64_v4i16((__attribute__((address_space(3))) v4i16_t*)p)); }
__device__ __forceinline__ float rowmax(const f32x16&p0,const f32x16&p1){
  float a=max3f(p0[0],p0[1],p1[0]),b=max3f(p0[2],p0[3],p1[1]);a=max3f(a,p1[2],p1[3]);
  #pragma unroll
  for(int r=4;r<16;r+=4){a=max3f(a,p0[r],p0[r+1]);b=max3f(b,p0[r+2],p0[r+3]);a=max3f(a,p1[r],p1[r+1]);b=max3f(b,p1[r+2],p1[r+3]);}
  const float m=max2f(a,b);
  auto rr=__builtin_amdgcn_permlane32_swap(__float_as_uint(m),__float_as_uint(m),false,false);
  return max2f(__uint_as_float(rr[0]),__uint_as_float(rr[1]));
}
__device__ __forceinline__ void pv(f32x16*o,int vb,bf16x8 pa0,bf16x8 pa1,bf16x8 pa2,bf16x8 pa3){
  #pragma unroll
  for(int d0=0;d0<2;++d0){s16x4 lo[4],hi[4];
    #pragma unroll
    for(int ks=0;ks<4;++ks){
      asm volatile("ds_read_b64_tr_b16 %0,%1 offset:%c2":"=&v"(lo[ks]):"v"(vb),"i"(d0*4096+ks*1024):"memory");
      asm volatile("ds_read_b64_tr_b16 %0,%1 offset:%c2":"=&v"(hi[ks]):"v"(vb),"i"(d0*4096+ks*1024+512):"memory");}
    asm volatile("s_waitcnt lgkmcnt(0)":::"memory");SBAR();
    #define PK(k) (bf16x8){lo[k][0],lo[k][1],lo[k][2],lo[k][3],hi[k][0],hi[k][1],hi[k][2],hi[k][3]}
    o[d0]=__builtin_amdgcn_mfma_f32_32x32x16_bf16(pa0,PK(0),o[d0],0,0,0);
    o[d0]=__builtin_amdgcn_mfma_f32_32x32x16_bf16(pa1,PK(1),o[d0],0,0,0);
    o[d0]=__builtin_amdgcn_mfma_f32_32x32x16_bf16(pa2,PK(2),o[d0],0,0,0);
    o[d0]=__builtin_amdgcn_mfma_f32_32x32x16_bf16(pa3,PK(3),o[d0],0,0,0);
    #undef PK
  }
}

#ifndef ATTN_STORE16
#define ATTN_STORE16(p,v) (*(u32x4*)(p)=(v))
#endif
template<int THRL> __device__ __forceinline__ void attn_unit(int b,int h,int qb,const bf16*Q,const bf16*__restrict__ K,const bf16*__restrict__ V,bf16*O,const float*__restrict__ LFrow,char*shm){
  const int tid=threadIdx.x,lane=tid&63,r32=lane&31,hi=lane>>5; const int wid=__builtin_amdgcn_readfirstlane(tid>>6);
  const long rowbase=(long)b*SEQ; const int q0=qb*QB;
  const bf16*Qw=Q+(rowbase+q0+wid*QBLK)*DM+h*D;
  const bf16*Kh=K+rowbase*DM+h*D,*Vh=V+rowbase*DM+h*D;
  const lds_cptr shm3=(lds_cptr)shm;
  const unsigned lds0=(unsigned)(uintptr_t)shm;
  float*wsf=(float*)(shm+LDS_WS)+wid*64;
  const bf16*ksrc=Kh+(long)lane*DM+wid*8;
  const bf16*vsrc=Vh+(long)(16*(wid&3)+(lane>>2))*DM+(wid>>2)*32+(lane&3)*8;
  const unsigned kdst=lds0+LDS_K+wid*1024, vdst=lds0+LDS_V+wid*1024;
  #define DMA_K(t,slot) glds16(ksrc+(long)(t)*KVBLK*DM,(unsigned)__builtin_amdgcn_readfirstlane(kdst+(slot)))
  #define DMA_V(t,slot) glds16(vsrc+(long)(t)*KVBLK*DM,(unsigned)__builtin_amdgcn_readfirstlane(vdst+(slot)))
  const int vb0=(int)(lds0+LDS_V)+((lane>>4)&1)*32+(lane&3)*8+(4*hi+((lane&15)>>2))*64;
  const char*Kbase=shm+LDS_K; bf16x8 kf[8];
  const lds_cptr kp0=shm3+LDS_K+hi*1024+r32*16; const lds_cptr vp0=shm3+LDS_V+((lane>>4)&1)*32+(lane&3)*8+(4*hi+((lane&15)>>2))*64;
  const int NT=(q0+QB)/KVBLK;
  typedef __attribute__((address_space(3))) float lds_f32; typedef __attribute__((address_space(3))) f32x4v lds_f32x4;
  lds_f32* const csl=(lds_f32*)(shm3+LDS_CS);
  { const int ncs=q0+QB, i0=tid*8; f32x4v ca={0.f,0.f,0.f,0.f},cb={0.f,0.f,0.f,0.f};
    if(i0<ncs){ca=*(const f32x4v*)(LFrow+i0);cb=*(const f32x4v*)(LFrow+i0+4);}
    ca.y+=ca.x;ca.z+=ca.y;ca.w+=ca.z;cb.x+=ca.w;cb.y+=cb.x;cb.z+=cb.y;cb.w+=cb.z;
    const float tot=cb.w; float inc=tot;
    _Pragma("unroll") for(int o_=1;o_<64;o_<<=1){const float v_=__shfl_up(inc,o_);if(lane>=o_)inc+=v_;}
    if(lane==63)csl[SEQ+wid]=inc;
    asm volatile("s_waitcnt vmcnt(0) lgkmcnt(0)\n\ts_barrier":::"memory");
    float base_=inc-tot;
    _Pragma("unroll") for(int w_=0;w_<NW;++w_){const float t_=csl[SEQ+w_];if(w_<wid)base_+=t_;}
    if(i0<ncs){*(lds_f32x4*)(csl+i0)=ca+base_;*(lds_f32x4*)(csl+i0+4)=cb+base_;}
    asm volatile("s_waitcnt vmcnt(0) lgkmcnt(0)\n\ts_barrier":::"memory"); }
  const float cq=csl[q0+wid*QBLK+r32];
  const lds_cptr csb=shm3+LDS_CS+hi*16;
  #define CINIT(C0,C1,t) do{ _Pragma("unroll") for(int g_=0;g_<4;++g_){ const f32x4v a_=*(const lds_f32x4*)(csb+(t)*256+g_*32), b_=*(const lds_f32x4*)(csb+(t)*256+128+g_*32); \
      C0[4*g_]=cqm-a_.x;C0[4*g_+1]=cqm-a_.y;C0[4*g_+2]=cqm-a_.z;C0[4*g_+3]=cqm-a_.w; C1[4*g_]=cqm-b_.x;C1[4*g_+1]=cqm-b_.y;C1[4*g_+2]=cqm-b_.z;C1[4*g_+3]=cqm-b_.w; } }while(0)
  DMA_K(0,0);DMA_V(0,0);DMA_K(1,SLOTB);
  bf16x8 qr[4];
  #pragma unroll
  for(int d0=0;d0<4;++d0)qr[d0]=*reinterpret_cast<const bf16x8*>(&Qw[(long)r32*DM+d0*16+hi*8]);
  float mhat=0.f,l_reg=0.f,cqm=cq;f32x16 o[2];o[0]=f32x16{};o[1]=f32x16{};
  const int qrel=wid*QBLK+r32;
  #define CMASK(P0,P1,t) do{int jb_=(t)-(NT-4); if(jb_>=0)cmask(P0,P1,jb_,qrel,hi);}while(0)
  bool resc=false;
  #define START(P0,P1) do{ const float rm=rowmax(P0,P1); resc=false; \
    { const float dl=rm; mhat=fadd_s(mhat,dl); \
      _Pragma("unroll") for(int r=0;r<16;++r){P0[r]=fsub_s(P0[r],dl);P1[r]=fsub_s(P1[r],dl);} \
      cqm=cq-mhat; } \
    _Pragma("unroll") for(int r=0;r<16;++r)P0[r]=__builtin_amdgcn_exp2f(P0[r]); }while(0)
  #define RESC() do{ if(resc){ asm volatile("s_waitcnt lgkmcnt(0)":::"memory"); \
      _Pragma("unroll") for(int d_=0;d_<2;++d_) _Pragma("unroll") for(int r=0;r<16;++r)o[d_][r]*=wsf[crow(r,hi)]; } }while(0)
  f32x16 pA0,pA1,pB0,pB1;
  int sl_prev=0,sl_cur=0,sl_next=SLOTB;
  #define ROT() do{sl_prev=sl_cur;sl_cur=sl_next;sl_next=(sl_next==(NSLOT-1)*SLOTB)?0:sl_next+SLOTB;}while(0)
  DMA_K(2,2*SLOTB);
  WAIT_BAR(3);
  { f32x16 ci0,ci1; CINIT(ci0,ci1,0); qkt(pA0,pA1,Kbase,qr,ci0,ci1,r32,hi); } asm volatile("s_nop 15\n\ts_nop 7":"+v"(pA0),"+v"(pA1));CMASK(pA0,pA1,0);
  START(pA0,pA1);
  _Pragma("unroll") for(int r=0;r<16;++r)pA1[r]=__builtin_amdgcn_exp2f(pA1[r]);
  WAIT_BAR(0);
  DMA_K(3,0);DMA_V(1,SLOTB);
  ROT();
  kload8(kf,kp0+sl_cur);
  WAIT_BAR(2);
  s16x4 vlo[8],vhi[8]; u32x4 pw0,pw1,pw2,pw3;
  #define PKW(P,B) cvtpk_s(P[B],P[B+1])
  #define PAF(k) __builtin_bit_cast(bf16x8,pw##k)
  #define VFR(i) (bf16x8){vlo[i][0],vlo[i][1],vlo[i][2],vlo[i][3],vhi[i][0],vhi[i][1],vhi[i][2],vhi[i][3]}
  #define PIN(x) asm volatile("":"+v"(x))
  #define MX3(a,b,c) __builtin_fmaxf(__builtin_fmaxf((a),(b)),(c))
  #define GAPA(MF,A0,A1,A2,A3,W0,W1,PW) do{ MF; sacc+=A0; sacc+=A1; sacc+=A2; sacc+=A3; PIN(sacc); W0; W1; PIN(PW); SBAR(); }while(0)
  #define EX(v) __builtin_amdgcn_exp2f(v)
  #define GAPB(MF,X,B) do{ MF; X[B]=EX(X[B]); X[B+1]=EX(X[B+1]); X[B+2]=EX(X[B+2]); X[B+3]=EX(X[B+3]); PIN(X); SBAR(); }while(0)
  #define VRD(i) do{ vlo[i]=vtr(vp_+(((i)>>2)*4096+((i)&3)*1024)); vhi[i]=vtr(vp_+(((i)>>2)*4096+((i)&3)*1024+512)); }while(0)
  #define KRD(G,j) do{ if(G){ kload2(kf,kp0+sl_next,j); SBAR(); } }while(0)
  #define STEP(C0,C1,P0,P1,t,GK,GV,GL) do{ SBAR(); \
    CINIT(C0,C1,t); SBAR(); \
    const lds_cptr vp_=vp0+sl_prev; \
    VRD(0); SBAR(); float sacc=(P0[0]+P0[1]); \
    GAPA(C0=__builtin_amdgcn_mfma_f32_32x32x16_bf16(kf[0],qr[0],C0,0,0,0), P0[2],P0[3],P0[4],P0[5],     pw0[0]=PKW(P0,0), pw0[1]=PKW(P0,2), pw0); \
    VRD(4); SBAR(); GAPA(C1=__builtin_amdgcn_mfma_f32_32x32x16_bf16(kf[1],qr[0],C1,0,0,0), P0[6],P0[7],P0[8],P0[9],     pw0[2]=PKW(P0,4), pw0[3]=PKW(P0,6), pw0); \
    VRD(1); SBAR(); GAPA(C0=__builtin_amdgcn_mfma_f32_32x32x16_bf16(kf[2],qr[1],C0,0,0,0),   P0[10],P0[11],P0[12],P0[13], pw1[0]=PKW(P0,8), pw1[1]=PKW(P0,10), pw1); \
    VRD(5); SBAR(); GAPA(C1=__builtin_amdgcn_mfma_f32_32x32x16_bf16(kf[3],qr[1],C1,0,0,0),   P0[14],P0[15],P1[0],P1[1],   pw1[2]=PKW(P0,12),pw1[3]=PKW(P0,14), pw1); \
    VRD(2); SBAR(); GAPA(C0=__builtin_amdgcn_mfma_f32_32x32x16_bf16(kf[4],qr[2],C0,0,0,0),   P1[2],P1[3],P1[4],P1[5],     pw2[0]=PKW(P1,0), pw2[1]=PKW(P1,2), pw2); \
    VRD(6); SBAR(); GAPA(C1=__builtin_amdgcn_mfma_f32_32x32x16_bf16(kf[5],qr[2],C1,0,0,0),   P1[6],P1[7],P1[8],P1[9],     pw2[2]=PKW(P1,4), pw2[3]=PKW(P1,6), pw2); \
    VRD(3); SBAR(); GAPA(C0=__builtin_amdgcn_mfma_f32_32x32x16_bf16(kf[6],qr[3],C0,0,0,0),   P1[10],P1[11],P1[12],P1[13], pw3[0]=PKW(P1,8), pw3[1]=PKW(P1,10), pw3); \
    VRD(7); SBAR(); GAPA(C1=__builtin_amdgcn_mfma_f32_32x32x16_bf16(kf[7],qr[3],C1,0,0,0),   P1[14],P1[15],0.f,0.f,       pw3[2]=PKW(P1,12),pw3[3]=PKW(P1,14), pw3); \
    l_reg+=sacc; \
    if(GK){DMA_K((t)+3,sl_cur);} if(GV){DMA_V((t)+1,sl_next);} \
    CMASK(C0,C1,t); \
    { float a=MX3(C0[0],C0[1],C1[0]),b=MX3(C0[2],C0[3],C1[1]); a=MX3(a,C1[2],C1[3]); \
      _Pragma("unroll") for(int r=4;r<16;r+=4){a=MX3(a,C0[r],C0[r+1]);b=MX3(b,C0[r+2],C0[r+3]);a=MX3(a,C1[r],C1[r+1]);b=MX3(b,C1[r+2],C1[r+3]);} \
      float rm=__builtin_fmaxf(a,b); { auto rr=__builtin_amdgcn_permlane32_swap(__float_as_uint(rm),__float_as_uint(rm),false,false); rm=__builtin_fmaxf(__uint_as_float(rr[0]),__uint_as_float(rr[1])); } \
      resc=false; \
      if(__builtin_expect(__any(rm>(float)THRL),0)){ const float dl=__builtin_fmaxf(rm,0.f); mhat+=dl; \
        _Pragma("unroll") for(int r=0;r<16;++r){C0[r]-=dl;C1[r]-=dl;} \
        cqm=cq-mhat; \
        const float f=__builtin_amdgcn_exp2f(-dl); l_reg*=f; if(hi==0)wsf[r32]=f; resc=true; } } \
    SBAR(); \
    GAPB(o[0]=__builtin_amdgcn_mfma_f32_32x32x16_bf16(PAF(0),VFR(0),o[0],0,0,0), C0,0); \
    GAPB(o[1]=__builtin_amdgcn_mfma_f32_32x32x16_bf16(PAF(0),VFR(4),o[1],0,0,0), C0,4); \
    KRD(GL,0); GAPB(o[0]=__builtin_amdgcn_mfma_f32_32x32x16_bf16(PAF(1),VFR(1),o[0],0,0,0), C0,8); \
    KRD(GL,1); GAPB(o[1]=__builtin_amdgcn_mfma_f32_32x32x16_bf16(PAF(1),VFR(5),o[1],0,0,0), C0,12); \
    KRD(GL,2); GAPB(o[0]=__builtin_amdgcn_mfma_f32_32x32x16_bf16(PAF(2),VFR(2),o[0],0,0,0), C1,0); \
    KRD(GL,3); GAPB(o[1]=__builtin_amdgcn_mfma_f32_32x32x16_bf16(PAF(2),VFR(6),o[1],0,0,0), C1,4); \
    GAPB(o[0]=__builtin_amdgcn_mfma_f32_32x32x16_bf16(PAF(3),VFR(3),o[0],0,0,0), C1,8); \
    GAPB(o[1]=__builtin_amdgcn_mfma_f32_32x32x16_bf16(PAF(3),VFR(7),o[1],0,0,0), C1,12); \
    }while(0)
  int t=1;
  #undef CMASK
  #define CMASK(P0,P1,t) do{}while(0)
  for(;t+5<NT;t+=2){
    STEP(pB0,pB1,pA0,pA1,t,true,true,true);     WAIT_BAR(2); RESC(); ROT();
    STEP(pA0,pA1,pB0,pB1,t+1,true,true,true);   WAIT_BAR(2); RESC(); ROT();
  }
  #undef CMASK
  #define CMASK(P0,P1,t) do{int jb_=(t)-(NT-4); if(jb_>=0)cmask(P0,P1,jb_,qrel,hi);}while(0)
  #define ENDW(tt) do{ if((tt)+3<NT){WAIT_BAR(2);} else if((tt)+2<NT){WAIT_BAR(1);} else {WAIT_BAR(0);} }while(0)
  for(;t+1<NT;t+=2){
    STEP(pB0,pB1,pA0,pA1,t,(t+3<NT),(t+1<NT),(t+1<NT));       ENDW(t);   RESC(); ROT();
    STEP(pA0,pA1,pB0,pB1,t+1,(t+4<NT),(t+2<NT),(t+2<NT));     ENDW(t+1); RESC(); ROT();
  }
  STEP(pB0,pB1,pA0,pA1,NT-1,false,false,false); RESC();
  { float sacc=pB0[0]+pB0[1]; _Pragma("unroll") for(int r=2;r<16;++r)sacc+=pB0[r]; _Pragma("unroll") for(int r=0;r<16;++r)sacc+=pB1[r]; l_reg+=sacc;
    pw0=(u32x4){PKW(pB0,0),PKW(pB0,2),PKW(pB0,4),PKW(pB0,6)};pw1=(u32x4){PKW(pB0,8),PKW(pB0,10),PKW(pB0,12),PKW(pB0,14)};pw2=(u32x4){PKW(pB1,0),PKW(pB1,2),PKW(pB1,4),PKW(pB1,6)};pw3=(u32x4){PKW(pB1,8),PKW(pB1,10),PKW(pB1,12),PKW(pB1,14)};
    SBAR(); pv(o,vb0+sl_cur,PAF(0),PAF(1),PAF(2),PAF(3)); }
  #undef PKW
  #undef PAF
  #undef VFR
  #undef PIN
  #undef MX3
  #undef GAPA
  #undef GAPB
  #undef EX
  #undef VRD
  #undef KRD
  #undef STEP
  #undef ENDW
  {auto rr=__builtin_amdgcn_permlane32_swap(__float_as_uint(l_reg),__float_as_uint(l_reg),false,false);l_reg=__uint_as_float(rr[0])+__uint_as_float(rr[1]);}
  if(hi==0)wsf[32+r32]=l_reg;asm volatile("s_waitcnt lgkmcnt(0)":::"memory");
  float rli[16];
  #pragma unroll
  for(int r=0;r<16;++r)rli[r]=__builtin_amdgcn_rcpf(wsf[32+crow(r,hi)]);
  bf16*Ow=O+(rowbase+q0+wid*QBLK)*DMO+h*D;
  { bf16*stg=(bf16*)(shm+LDS_OST)+wid*2048;
    #pragma unroll
    for(int r=0;r<16;++r){const int orow=crow(r,hi);
      #pragma unroll
      for(int d0=0;d0<2;++d0)stg[orow*64+d0*32+r32]=__float2bfloat16(o[d0][r]*rli[r]);}
    asm volatile("s_waitcnt lgkmcnt(0)":::"memory");
    #pragma unroll
    for(int i=0;i<4;++i){const int row=i*8+(lane>>3),ch=lane&7; const u32x4 v=*(const u32x4*)(stg+row*64+ch*8); ATTN_STORE16(Ow+(long)row*DMO+ch*8,v);} }
  asm volatile("s_waitcnt lgkmcnt(0)\n\ts_barrier":::"memory");
  #undef DMA_K
  #undef DMA_V
  #undef CMASK
  #undef START
  #undef RESC
  #undef ROT
  #undef CINIT
}
constexpr int ATTN_LDS_BYTES=LDS_BYTES;
struct AttnTensors { const bf16* Q; const bf16* K; const bf16* V; bf16* O; const float* LF; };
struct AttnUnit { int bh; int qb; };
struct StaticOrder {
  int vcu, G;
  __device__ __forceinline__ StaticOrder(int grid,int vcu_):vcu(vcu_),G(grid){}
  __device__ __forceinline__ bool next(int i,AttnUnit&u)const{
    if(G==256){ if(i>=2)return false; const int s=vcu&7; u.bh=vcu>>3; u.qb=(i==0)?15-s:s; return true; }
    const int idx=i*G+vcu; if(idx>=BATCH*NHEAD*NQB)return false; u.qb=NQB-1-idx/(BATCH*NHEAD); u.bh=idx%(BATCH*NHEAD); return true; }
  __device__ __forceinline__ void a_ready(const AttnUnit&)const{}
  __device__ __forceinline__ void done(const AttnUnit&)const{}
};
template<class Sched,int THRL=8> __device__ __forceinline__ void attn_phase(char*lds,const AttnTensors&T,const Sched&S){
  AttnUnit u;
  for(int i=0;S.next(i,u);++i){ S.a_ready(u); attn_unit<THRL>(u.bh/NHEAD,u.bh%NHEAD,u.qb,T.Q,T.K,T.V,T.O,T.LF+(size_t)u.bh*SEQ,lds); S.done(u); }
}
#undef SBAR
#undef WAIT_BAR
}
#define GAS __attribute__((address_space(1)))
#define LAS __attribute__((address_space(3)))
typedef unsigned short bf16;
typedef unsigned v4u __attribute__((ext_vector_type(4)));
typedef float f32x4 __attribute__((ext_vector_type(4)));
typedef short bf16x8 __attribute__((ext_vector_type(8)));
typedef GAS unsigned gu32;
typedef GAS unsigned long long gu64;
#define RLX_AGENT __ATOMIC_RELAXED, __HIP_MEMORY_SCOPE_AGENT
#define LDS_WAIT() asm volatile("s_waitcnt lgkmcnt(0)" ::: "memory")
#define VM_WAIT() asm volatile("s_waitcnt vmcnt(0)" ::: "memory")
__device__ __forceinline__ unsigned long long rt() { return __builtin_amdgcn_s_memrealtime(); }
__device__ __forceinline__ unsigned f2bf(float f) { unsigned u = __builtin_bit_cast(unsigned, f); return (u + 0x7fffu + ((u >> 16) & 1u)) >> 16; }
__device__ __forceinline__ unsigned pk2(float lo, float hi) { return f2bf(lo) | (f2bf(hi) << 16); }

#define XB_TMO      128
#define XB_XCNT(j)  (256  + 64 * (j))
#define XB_XSUB(j)  (1280 + 64 * (j))
#define XB_XGEN(j)  (2304 + 64 * (j))
#define XB_TOP      3328
#define XB_TOPGEN   3392
#define XCD_BAR_WORDS 3456
#define XB_SPIN_CAP (1u << 18)

__device__ __forceinline__ unsigned xb_ld(unsigned* p)              { return __hip_atomic_load(p, __ATOMIC_RELAXED, __HIP_MEMORY_SCOPE_AGENT); }
__device__ __forceinline__ unsigned xb_add(unsigned* p, unsigned v) { return __hip_atomic_fetch_add(p, v, __ATOMIC_RELAXED, __HIP_MEMORY_SCOPE_AGENT); }
__device__ __forceinline__ unsigned xb_xcc_id() { return (unsigned)__builtin_amdgcn_s_getreg((3 << 11) | 20) & 0xFu; }
#define XB_SPIN(cond, bar) do { unsigned _sp = 0; while (cond) { __builtin_amdgcn_s_sleep(1); \
    if ((++_sp & 255u) == 0u) { if (xb_ld(&(bar)[XB_TMO])) break; if (_sp > XB_SPIN_CAP) { atomicAdd(&(bar)[XB_TMO], 1u); break; } } } } while (0)

struct XcdBarrier {
    unsigned* bar; unsigned x;
    volatile LAS unsigned* st;
};

__device__ __forceinline__ XcdBarrier xcd_barrier_post(unsigned* bar, volatile LAS unsigned* st) {
    XcdBarrier b; b.bar = bar; b.x = xb_xcc_id(); b.st = st;
    if (threadIdx.x == 0) (void)xb_add(&bar[XB_XCNT(b.x)], 1u);
    return b;
}
__device__ __forceinline__ void xcd_barrier_complete(unsigned* bar, unsigned x, unsigned& nloc, unsigned& nx) {
    const unsigned G = gridDim.x * gridDim.y * gridDim.z;
    unsigned sum, cnt, mine, sp = 0u;
    for (;;) {
        sum = 0u; cnt = 0u; mine = 0u;
#pragma unroll
        for (unsigned j = 0; j < 16; ++j) { const unsigned c = xb_ld(&bar[XB_XCNT(j)]); sum += c; cnt += (c > 0u) ? 1u : 0u; mine = (j == x) ? c : mine; }
        if (sum == G) break;
        __builtin_amdgcn_s_sleep(1);
        if ((++sp & 255u) == 0u) { if (xb_ld(&bar[XB_TMO])) break; if (sp > XB_SPIN_CAP) { atomicAdd(&bar[XB_TMO], 1u); break; } }
    }
    nloc = mine > 0u ? mine : 1u; nx = cnt > 0u ? cnt : 1u;
}

__device__ __forceinline__ void xcd_barrier(const XcdBarrier& b) {
    asm volatile("s_waitcnt vmcnt(0)" ::: "memory");
    __syncthreads();
    if (threadIdx.x == 0) {
        unsigned* bar = b.bar;
        __builtin_amdgcn_s_waitcnt(0);
        unsigned nloc = b.st[0], nx = b.st[1];
        if (nloc == 0u) { xcd_barrier_complete(bar, b.x, nloc, nx); b.st[0] = nloc; b.st[1] = nx; }
        const unsigned old = xb_add(&bar[XB_XSUB(b.x)], 1u);
        const unsigned gen = old / nloc;
        if (old + 1u == (gen + 1u) * nloc) {
            __builtin_amdgcn_fence(__ATOMIC_RELEASE, "agent");
            asm volatile("s_waitcnt vmcnt(0)" ::: "memory");
            const unsigned og = xb_add(&bar[XB_TOP], 1u);
            const unsigned tg = og / nx;
            if (og + 1u == (tg + 1u) * nx) xb_add(&bar[XB_TOPGEN], 1u);
            else XB_SPIN(xb_ld(&bar[XB_TOPGEN]) == tg, bar);
            __builtin_amdgcn_fence(__ATOMIC_ACQUIRE, "agent");
            xb_add(&bar[XB_XGEN(b.x)], 1u);
            asm volatile("s_waitcnt vmcnt(0)" ::: "memory");
        } else {
            XB_SPIN(xb_ld(&bar[XB_XGEN(b.x)]) == gen, bar);
            __builtin_amdgcn_fence(__ATOMIC_ACQUIRE, "agent");
            asm volatile("s_waitcnt vmcnt(0)" ::: "memory");
        }
    }
    __syncthreads();
}

constexpr int NWAVES = 8;
constexpr int BATCH = 4, SEQ = 4096, D = 1024, M = BATCH * SEQ, NH = 8, HD = 64, AW = 512, PLE = 256;
constexpr int NIN = 5120, INTOT = 5128, NKEYS = 128, NEXP = 16384, NS = 2048;
constexpr float EPS = 1e-6f, LOG2E = 1.4426950408889634f, C2 = 0.125f * LOG2E;
constexpr int NPHASE = 9;
constexpr int SLW = 128, NSL = D / SLW;
static_assert(NSL == 8, "one slice per XCD group; SS3 has 16 slots");

constexpr size_t MiB = 1u << 20;
constexpr size_t WS_CTL = 0, CTL_ZERO_BYTES = 64 * 1024;
constexpr size_t WS_RSTD1 = 1 * MiB, WS_RSTD3 = WS_RSTD1 + 65536, WS_LF = WS_RSTD3 + 65536, WS_CS = WS_LF + 524288, WS_SS2 = WS_CS + 524288, WS_WPP = WS_SS2 + 1048576;
constexpr size_t WS_SU = WS_RSTD3, WS_SV = WS_WPP + 524288;
static_assert(WS_SV + 65536 <= 4 * MiB, "small region");
constexpr size_t WS_WIN = 4 * MiB, WS_WBR = 14 * MiB, WS_WOUT = 16 * MiB, WS_WS = 18 * MiB, WS_WPG = 22 * MiB, WS_PB = 24 * MiB;
constexpr size_t WS_UB = 32 * MiB, WS_VB = 64 * MiB;
constexpr size_t WS_A = 96 * MiB;
constexpr size_t WS_PP = 128 * MiB;
constexpr size_t WS_Q = 160 * MiB, WS_K = 176 * MiB, WS_V = 192 * MiB, WS_GB = 208 * MiB, WS_Z = 224 * MiB;
constexpr size_t WS_MERGED = 160 * MiB, WS_XB2 = 192 * MiB, WS_IDS = 224 * MiB, WS_GATES = 232 * MiB;
constexpr size_t WS_END = 256 * MiB;
constexpr size_t WS_PART0 = 4 * MiB, WS_PART1 = 160 * MiB, WS_PART2 = 240 * MiB;
constexpr size_t WS_TGC = 32 * MiB, WS_TXC = 64 * MiB, WS_SC = 32 * MiB;
constexpr int CW_BAR = 1024;

constexpr int RING_OFF = 0, RING_BYTES = 135168;
constexpr int LDSCTL_OFF = RING_BYTES, MISC_OFF = LDSCTL_OFF + 320;
constexpr int LDS_BYTES = RING_BYTES + 1024;
static_assert(attn_body::ATTN_LDS_BYTES <= RING_BYTES && pg8::STAGE_BYTES <= RING_BYTES && 128 * pg8::EpiTopK::RS * 4 <= RING_BYTES, "LDS map");

typedef unsigned u32x4 __attribute__((ext_vector_type(4)));
typedef unsigned u32x2 __attribute__((ext_vector_type(2)));
__device__ __forceinline__ float bf2f(bf16 v) { return __uint_as_float((unsigned)v << 16); }
__device__ __forceinline__ float wave_sum(float v) {
#pragma unroll
    for (int o = 1; o < 64; o <<= 1) v += __shfl_xor(v, o);
    return v;
}
__device__ __forceinline__ float sigmoidf_(float v) { return 1.0f / (1.0f + __expf(-v)); }
__host__ __device__ __forceinline__ int src_in(int n) {
    const int pn = n >> 8, l = n & 255;
    if (pn < 6) return n;
    if (pn < 8) return 1544 + (n - 1536);
    if (pn < 12) { const int j = pn - 8; return (l < 128) ? 2056 + 128 * j + l : 2568 + 128 * j + (l - 128); }
    if (pn < 16) return 3080 + (n - 3072);
    return 4104 + (n - 4096);
}

struct Args { const float* in[18]; float* out; unsigned char* ws; int ph_lo, ph_hi, li, pad; };
struct Ctx {
    LAS unsigned char* lds; int tid, lane, wave, vcu, G;
};

__device__ __forceinline__ void tr_item(const float* __restrict__ W, int ldw, int k0, int scol0, const float* __restrict__ g, bf16* WT, int ldt, int drow0, int dk0, LAS float* scr, int lane) {
    float tv[32];
#pragma unroll
    for (int i = 0; i < 32; ++i) { const int kk = 2 * i + (lane >> 5); tv[i] = W[(size_t)(k0 + kk) * ldw + scol0 + (lane & 31)]; }
#pragma unroll
    for (int i = 0; i < 32; ++i) { const int kk = 2 * i + (lane >> 5); float v = tv[i]; if (g) v *= g[k0 + kk]; scr[kk * 33 + (lane & 31)] = v; }
    LDS_WAIT(); asm volatile("" ::: "memory");
    const int c = lane & 7;
#pragma unroll
    for (int j = 0; j < 4; ++j) { const int n = (lane >> 3) + 8 * j; const LAS float* s = scr + (8 * c) * 33 + n;
        v4u o; o.x = pk2(s[0 * 33], s[1 * 33]); o.y = pk2(s[2 * 33], s[3 * 33]); o.z = pk2(s[4 * 33], s[5 * 33]); o.w = pk2(s[6 * 33], s[7 * 33]);
        *(GAS v4u*)(WT + (size_t)(drow0 + n) * ldt + dk0 + 8 * c) = o; }
    LDS_WAIT(); asm volatile("" ::: "memory");
}
__device__ __forceinline__ void p0_prologue(const Ctx& F, const Args& a) {
    unsigned char* ws = a.ws;
    const float *x = a.in[0], *p = a.in[1], *g_mix = a.in[2], *w_in = a.in[3], *b_f = a.in[4], *w_branch = a.in[6], *w_out = a.in[7], *g_ffn = a.in[8], *w_peer_q = a.in[9],
                *pk1 = a.in[10], *pk2_ = a.in[11], *peer_u = a.in[12], *peer_v = a.in[13], *g_ple = a.in[14], *w_ple_gate = a.in[15], *w_ple_proj = a.in[16];
    bf16 *WIN = (bf16*)(ws + WS_WIN), *WBR = (bf16*)(ws + WS_WBR), *WOUT = (bf16*)(ws + WS_WOUT), *WST = (bf16*)(ws + WS_WS), *WPG = (bf16*)(ws + WS_WPG), *WPP = (bf16*)(ws + WS_WPP);
    bf16 *PB = (bf16*)(ws + WS_PB), *UB = (bf16*)(ws + WS_UB), *VB = (bf16*)(ws + WS_VB), *XB = (bf16*)(ws + WS_A);
    float *RSTD1 = (float*)(ws + WS_RSTD1), *LF = (float*)(ws + WS_LF);
    const int gw = F.vcu * NWAVES + F.wave, NGW = F.G * NWAVES, gt = F.vcu * 512 + F.tid, NGT = F.G * 512;
    {
        LAS float* KH = (LAS float*)(F.lds + RING_OFF); LAS float* WQ = KH + 128 * 129;
        for (int item = F.vcu; item < 512; item += F.G) {
            const int hh = item >> 5, head = hh >> 1, half = hh & 1, d0 = (item & 31) * 32;
            const float* kh = (half ? pk2_ : pk1) + (size_t)head * 128 * 128;
#pragma unroll 4
            for (int i = 0; i < 32; ++i) { const int idx = i * 512 + F.tid; KH[(idx >> 7) * 129 + (idx & 127)] = kh[idx]; }
#pragma unroll
            for (int i = 0; i < 8; ++i) { const int idx = i * 512 + F.tid; WQ[idx] = w_peer_q[(size_t)(d0 + (idx >> 7)) * NS + head * 256 + half * 128 + (idx & 127)]; }
            __syncthreads();
            const int key = F.tid & 127, dg = F.tid >> 7;
            float acc[8];
#pragma unroll
            for (int i = 0; i < 8; ++i) acc[i] = 0.f;
            for (int e = 0; e < 128; e += 4) {
                const float k0 = KH[key * 129 + e], k1 = KH[key * 129 + e + 1], k2 = KH[key * 129 + e + 2], k3 = KH[key * 129 + e + 3];
#pragma unroll
                for (int i = 0; i < 8; ++i) { const f32x4 w = *(const LAS f32x4*)(WQ + (dg * 8 + i) * 128 + e); acc[i] += (k0 * w[0] + k1 * w[1]) + (k2 * w[2] + k3 * w[3]); }
            }
            const int dd = d0 + dg * 8;
            v4u o; o.x = pk2(acc[0] * g_ffn[dd], acc[1] * g_ffn[dd + 1]); o.y = pk2(acc[2] * g_ffn[dd + 2], acc[3] * g_ffn[dd + 3]); o.z = pk2(acc[4] * g_ffn[dd + 4], acc[5] * g_ffn[dd + 5]); o.w = pk2(acc[6] * g_ffn[dd + 6], acc[7] * g_ffn[dd + 7]);
            *(GAS v4u*)(WST + (size_t)(head * 256 + half * 128 + key) * D + dd) = o;
            __syncthreads();
        }
    }
    {
        LAS float* scr = (LAS float*)(F.lds + RING_OFF + F.wave * 16384);
        constexpr int I_IN = 16 * 160, I_BR = 8 * 32, I_SQ = 16 * 32, I_PP = 4 * 32, NITEMS = I_IN + 2 * I_BR + 2 * I_SQ + I_PP;
        for (int it = gw; it < NITEMS; it += NGW) {
            int r = it;
            if (r < I_IN) { const int kb = r / 160, nb = r % 160; tr_item(w_in, INTOT, 64 * kb, src_in(32 * nb), g_mix, WIN, D, 32 * nb, 64 * kb, scr, F.lane); continue; } r -= I_IN;
            if (r < 2 * I_BR) { const int br = r / I_BR, q = r % I_BR, kb = q / 32, nb = q % 32; tr_item(w_branch + (size_t)br * AW * D, D, 64 * kb, 32 * nb, nullptr, WBR, D, 32 * nb, br * AW + 64 * kb, scr, F.lane); continue; } r -= 2 * I_BR;
            if (r < I_SQ) { const int kb = r / 32, nb = r % 32; tr_item(w_out, D, 64 * kb, 32 * nb, nullptr, WOUT, D, 32 * nb, 64 * kb, scr, F.lane); continue; } r -= I_SQ;
            if (r < I_SQ) { const int kb = r / 32, nb = r % 32; tr_item(w_ple_gate, D, 64 * kb, 32 * nb, g_ple, WPG, D, 32 * nb, 64 * kb, scr, F.lane); continue; } r -= I_SQ;
            { const int kb = r / 32, nb = r % 32; tr_item(w_ple_proj, D, 64 * kb, 32 * nb, nullptr, WPP, PLE, 32 * nb, 64 * kb, scr, F.lane); }
        }
    }
    __syncthreads();
    {
        LAS float* WFL = (LAS float*)(F.lds + RING_OFF);
#pragma unroll 4
        for (int i = 0; i < 16; ++i) { const int idx = i * 512 + F.tid, k = idx >> 3, h = idx & 7; WFL[h * 1024 + k] = g_mix[k] * w_in[(size_t)k * INTOT + 1536 + h]; }
        __syncthreads();
        for (int rb = gw; rb < M; rb += 4 * NGW) {
            f32x4 v[4][4];
#pragma unroll
            for (int r = 0; r < 4; ++r) { const int row = rb + r * NGW; if (row < M) { const GAS f32x4* xr = (const GAS f32x4*)(x + (size_t)row * D);
#pragma unroll
                for (int j = 0; j < 4; ++j) v[r][j] = xr[F.lane + 64 * j]; } }
#pragma unroll
            for (int r = 0; r < 4; ++r) { const int row = rb + r * NGW; if (row < M) {
                float ss = 0.f;
#pragma unroll
                for (int j = 0; j < 4; ++j) ss += (v[r][j].x * v[r][j].x + v[r][j].y * v[r][j].y) + (v[r][j].z * v[r][j].z + v[r][j].w * v[r][j].w);
                ss = wave_sum(ss);
                const float rstd = 1.0f / sqrtf(ss * (1.0f / D) + EPS);
                GAS u32x2* o = (GAS u32x2*)(XB + (size_t)row * D);
#pragma unroll
                for (int j = 0; j < 4; ++j) { u32x2 w; w.x = pk2(v[r][j].x, v[r][j].y); w.y = pk2(v[r][j].z, v[r][j].w); o[F.lane + 64 * j] = w; }
                if (F.lane == 0) RSTD1[row] = rstd;
                float f[8];
#pragma unroll
                for (int h = 0; h < 8; ++h) { float s_ = 0.f;
#pragma unroll
                    for (int j = 0; j < 4; ++j) { const f32x4 w = *(const LAS f32x4*)(WFL + h * 1024 + 4 * (F.lane + 64 * j)); s_ += (v[r][j].x * w[0] + v[r][j].y * w[1]) + (v[r][j].z * w[2] + v[r][j].w * w[3]); }
                    f[h] = s_; }
                float r4[4], r2[2], r1;
#pragma unroll
                for (int i = 0; i < 4; ++i) { const float send = (F.lane & 32) ? f[i] : f[i + 4], keep = (F.lane & 32) ? f[i + 4] : f[i]; r4[i] = keep + __shfl_xor(send, 32); }
#pragma unroll
                for (int i = 0; i < 2; ++i) { const float send = (F.lane & 16) ? r4[i] : r4[i + 2], keep = (F.lane & 16) ? r4[i + 2] : r4[i]; r2[i] = keep + __shfl_xor(send, 16); }
                { const float send = (F.lane & 8) ? r2[0] : r2[1], keep = (F.lane & 8) ? r2[1] : r2[0]; r1 = keep + __shfl_xor(send, 8); }
                r1 += __shfl_xor(r1, 4); r1 += __shfl_xor(r1, 2); r1 += __shfl_xor(r1, 1);
                const int hL = ((F.lane >> 5) & 1) * 4 + ((F.lane >> 4) & 1) * 2 + ((F.lane >> 3) & 1);
                const float tot = r1 * rstd + b_f[hL];
                const float ls = fminf(tot, 0.f) - log1pf(__expf(-fabsf(tot)));
                const int b = row / SEQ, t = row % SEQ;
                if ((F.lane & 7) == 0) LF[(size_t)(b * NH + hL) * SEQ + t] = ls * LOG2E;
            } }
        }
    }
    {
        constexpr int NU = NEXP * D / 8, NP = M * PLE / 8;
        {
            signed char* UQ = (signed char*)(ws + WS_UB); unsigned char* VQ = (unsigned char*)(ws + WS_VB); float *SU = (float*)(ws + WS_SU), *SV = (float*)(ws + WS_SV);
            f32x4 gq[4];
#pragma unroll
            for (int j = 0; j < 4; ++j) gq[j] = *(const GAS f32x4*)(g_ffn + 16 * F.lane + 4 * j);
            for (int rb = gw; rb < 2 * NEXP; rb += 4 * NGW) {
                f32x4 v[4][4];
#pragma unroll
                for (int r = 0; r < 4; ++r) { const int rr = rb + r * NGW; if (rr < 2 * NEXP) { const bool isv = rr >= NEXP; const int e = isv ? rr - NEXP : rr;
                    const GAS f32x4* src = (const GAS f32x4*)((isv ? peer_v : peer_u) + (size_t)e * D + 16 * F.lane);
#pragma unroll
                    for (int j = 0; j < 4; ++j) v[r][j] = src[j]; } }
#pragma unroll
                for (int r = 0; r < 4; ++r) { const int rr = rb + r * NGW; if (rr < 2 * NEXP) { const bool isv = rr >= NEXP; const int e = isv ? rr - NEXP : rr;
                    float am = 0.f;
#pragma unroll
                    for (int j = 0; j < 4; ++j) { if (!isv) v[r][j] = v[r][j] * gq[j]; am = fmaxf(am, fmaxf(fmaxf(fabsf(v[r][j].x), fabsf(v[r][j].y)), fmaxf(fabsf(v[r][j].z), fabsf(v[r][j].w)))); }
#pragma unroll
                    for (int o = 1; o < 64; o <<= 1) am = fmaxf(am, __shfl_xor(am, o));
                    const float sc = am > 0.f ? 127.0f / am : 0.f; const int off = isv ? 128 : 0;
                    v4u o;
#pragma unroll
                    for (int j = 0; j < 4; ++j) { const int q0 = (int)rintf(v[r][j].x * sc) + off, q1 = (int)rintf(v[r][j].y * sc) + off, q2 = (int)rintf(v[r][j].z * sc) + off, q3 = (int)rintf(v[r][j].w * sc) + off;
                        o[j] = (unsigned)(q0 & 255) | ((unsigned)(q1 & 255) << 8) | ((unsigned)(q2 & 255) << 16) | ((unsigned)(q3 & 255) << 24); }
                    unsigned char* dst = (isv ? VQ : (unsigned char*)UQ) + ((size_t)(F.lane >> 3) * NEXP + e) * SLW + 16 * (F.lane & 7);
                    *(GAS v4u*)dst = o;
                    if (F.lane == 0) (isv ? SV : SU)[e] = am * (1.0f / 127.0f);
                } }
            }
        }
        for (int i = gt; i < NP; i += NGT) { const f32x4 a = ((const GAS f32x4*)p)[2 * (size_t)i], b = ((const GAS f32x4*)p)[2 * (size_t)i + 1];
            v4u o; o.x = pk2(a.x, a.y); o.y = pk2(a.z, a.w); o.z = pk2(b.x, b.y); o.w = pk2(b.z, b.w); ((GAS v4u*)PB)[i] = o; }
    }
}
__device__ __forceinline__ void p2_conv(const Ctx& F, const bf16* GB, const bf16* Z, const float* cw, bf16* AC) {
    const int gt = F.vcu * 512 + F.tid, NGT = F.G * 512;
    for (int i = gt; i < M * AW / 8; i += NGT) {
        const int row = i >> 6, c = (i & 63) * 8, t = row & (SEQ - 1);
        const v4u z2 = *(const GAS v4u*)(Z + (size_t)row * AW + c), g = *(const GAS v4u*)(GB + (size_t)row * AW + c);
        v4u z1 = {0u, 0u, 0u, 0u}, z0 = {0u, 0u, 0u, 0u};
        if (t >= 1) z1 = *(const GAS v4u*)(Z + (size_t)(row - 1) * AW + c);
        if (t >= 2) z0 = *(const GAS v4u*)(Z + (size_t)(row - 2) * AW + c);
        float r[8];
#pragma unroll
        for (int e = 0; e < 4; ++e) {
            const float w0a = cw[c + 2 * e], w0b = cw[c + 2 * e + 1], w1a = cw[AW + c + 2 * e], w1b = cw[AW + c + 2 * e + 1], w2a = cw[2 * AW + c + 2 * e], w2b = cw[2 * AW + c + 2 * e + 1];
            r[2 * e] = __uint_as_float(g[e] << 16) * (w0a * __uint_as_float(z0[e] << 16) + w1a * __uint_as_float(z1[e] << 16) + w2a * __uint_as_float(z2[e] << 16));
            r[2 * e + 1] = __uint_as_float(g[e] & 0xffff0000u) * (w0b * __uint_as_float(z0[e] & 0xffff0000u) + w1b * __uint_as_float(z1[e] & 0xffff0000u) + w2b * __uint_as_float(z2[e] & 0xffff0000u));
        }
        v4u o; o.x = pk2(r[0], r[1]); o.y = pk2(r[2], r[3]); o.z = pk2(r[4], r[5]); o.w = pk2(r[6], r[7]);
        *(GAS v4u*)(AC + (size_t)row * D + AW + c) = o;
    }
}
template <int CTRL> __device__ __forceinline__ int dpp_i(int v) { return __builtin_amdgcn_update_dpp(0, v, CTRL, 0xf, 0xf, true); }
__device__ __forceinline__ int sum8i(int v) { v += dpp_i<0x141>(v); v += dpp_i<0xB1>(v); v += dpp_i<0x4E>(v); return v; }
__device__ __forceinline__ float max8f(float v) { v = fmaxf(v, __uint_as_float((unsigned)dpp_i<0x141>((int)__float_as_uint(v)))); v = fmaxf(v, __uint_as_float((unsigned)dpp_i<0xB1>((int)__float_as_uint(v)))); v = fmaxf(v, __uint_as_float((unsigned)dpp_i<0x4E>((int)__float_as_uint(v)))); return v; }
__device__ __forceinline__ size_t part_slab(int j) { return j < 2 ? WS_PART0 + (size_t)j * 8 * MiB : j < 6 ? WS_PART1 + (size_t)(j - 2) * 8 * MiB : WS_PART2 + (size_t)(j - 6) * 8 * MiB; }
struct P6Geo { int xg, wi, nwv; };
__device__ __forceinline__ P6Geo p6_geo(const Ctx& F) { P6Geo g; const int bx = blockIdx.x; g.xg = bx & 7; g.wi = (bx >> 3) * NWAVES + F.wave; g.nwv = ((F.G - g.xg + 7) >> 3) * NWAVES; return g; }
__device__ __forceinline__ void p6a_upass(const Ctx& F, unsigned char* ws, const bf16* XB1, const unsigned short* IDS) {
    const P6Geo G = p6_geo(F); const int lane = F.lane, g = lane >> 3, c = lane & 7;
    for (int sl = G.xg; sl < NSL; sl += 8) {
        float* PART = (float*)(ws + part_slab(sl));
        const GAS unsigned char* Ts = (const GAS unsigned char*)(ws + WS_UB) + (size_t)sl * NEXP * SLW + 16 * c;
        for (int t = G.wi; t < M; t += G.nwv) {
            const v4u xa = *(const GAS v4u*)(XB1 + (size_t)t * D + sl * SLW + 16 * c), xb = *(const GAS v4u*)(XB1 + (size_t)t * D + sl * SLW + 16 * c + 8);
            v4u idp[2];
#pragma unroll
            for (int q = 0; q < 2; ++q) idp[q] = *(const GAS v4u*)(IDS + (size_t)t * 128 + 16 * g + 8 * q);
            v4u u[16];
#pragma unroll
            for (int i = 0; i < 16; ++i) { const unsigned w_ = idp[i >> 3][(i >> 1) & 3]; u[i] = *(const GAS v4u*)(Ts + ((i & 1) ? ((w_ >> 9) & 0x7fff80u) : ((w_ << 7) & 0x7fff80u))); }
            float xf[16];
#pragma unroll
            for (int e = 0; e < 4; ++e) { xf[2 * e] = __uint_as_float(xa[e] << 16); xf[2 * e + 1] = __uint_as_float(xa[e] & 0xffff0000u); xf[8 + 2 * e] = __uint_as_float(xb[e] << 16); xf[8 + 2 * e + 1] = __uint_as_float(xb[e] & 0xffff0000u); }
            float am = 0.f;
#pragma unroll
            for (int e = 0; e < 16; ++e) am = fmaxf(am, fabsf(xf[e]));
            am = max8f(am);
            const float sc = am > 0.f ? 127.0f / am : 0.f, sx = am * (1.0f / 127.0f);
            int qx[4];
#pragma unroll
            for (int j = 0; j < 4; ++j) qx[j] = (int)(((unsigned)((int)rintf(xf[4 * j] * sc) & 255)) | ((unsigned)((int)rintf(xf[4 * j + 1] * sc) & 255) << 8) | ((unsigned)((int)rintf(xf[4 * j + 2] * sc) & 255) << 16) | ((unsigned)((int)rintf(xf[4 * j + 3] * sc) & 255) << 24));
            int r0 = 0, r1 = 0;
#pragma unroll
            for (int i = 0; i < 16; ++i) { int sacc = __builtin_amdgcn_sdot4(qx[0], (int)u[i][0], 0, false); sacc = __builtin_amdgcn_sdot4(qx[1], (int)u[i][1], sacc, false); sacc = __builtin_amdgcn_sdot4(qx[2], (int)u[i][2], sacc, false); sacc = __builtin_amdgcn_sdot4(qx[3], (int)u[i][3], sacc, false);
                sacc = sum8i(sacc);
                if (i < 8) r0 = (c == i) ? sacc : r0; else r1 = (c == i - 8) ? sacc : r1; }
            float* pp = PART + (size_t)t * 128 + 16 * g + c;
            pp[0] = (float)r0 * sx; pp[8] = (float)r1 * sx;
        }
    }
}
__device__ __forceinline__ void p6b_combine(const Ctx& F, unsigned char* ws, float* SS2, const unsigned short* IDS, float* GATES) {
    const int gw = F.vcu * NWAVES + F.wave, NGW = F.G * NWAVES, lane = F.lane;
    const float *SU = (const float*)(ws + WS_SU), *SV = (const float*)(ws + WS_SV);
    for (int t = gw; t < M; t += NGW) {
        const float rstd = 1.0f / sqrtf(wave_sum(lane < 16 ? SS2[(size_t)t * 16 + lane] : 0.f) * (1.0f / D) + EPS);
        const int i0 = (int)IDS[(size_t)t * 128 + lane], i1 = (int)IDS[(size_t)t * 128 + 64 + lane];
        float a0 = 0.f, a1 = 0.f;
#pragma unroll
        for (int j = 0; j < 8; ++j) { const float* pp = (const float*)(ws + part_slab(j)) + (size_t)t * 128; a0 += pp[lane]; a1 += pp[64 + lane]; }
        a0 *= rstd * SU[i0]; a1 *= rstd * SU[i1];
        float* gp = GATES + (size_t)t * 128;
        gp[lane] = gp[lane] * 0.5f * a0 * (1.0f + erff(a0 * 0.70710678118654752f)) * SV[i0];
        gp[64 + lane] = gp[64 + lane] * 0.5f * a1 * (1.0f + erff(a1 * 0.70710678118654752f)) * SV[i1];
        if (lane < 16) SS2[(size_t)t * 16 + lane] = 0.f;
    }
}
__device__ __forceinline__ void p6c_vpass(const Ctx& F, unsigned char* ws, const unsigned short* IDS, const float* W, float* X, bf16* XB2, float* SS3) {
    const P6Geo G = p6_geo(F); const int lane = F.lane, g = lane >> 3, c = lane & 7;
    const int ecol = 16 * c + ((lane >> 5) & 1) * 8 + ((lane >> 4) & 1) * 4 + ((lane >> 3) & 1) * 2;
    typedef float f32x2g __attribute__((ext_vector_type(2)));
#define V_IDS(ID, t_) do { _Pragma("unroll") for (int q = 0; q < 2; ++q) ID[q] = *(const GAS v4u*)(IDS + (size_t)(t_) * 128 + 16 * g + 8 * q); } while (0)
#define V_W(WV, t_) do { _Pragma("unroll") for (int q = 0; q < 4; ++q) WV[q] = *(const GAS f32x4*)(W + (size_t)(t_) * 128 + 16 * g + 4 * q); } while (0)
#define V_GATHER(R, ID) do { _Pragma("unroll") for (int i = 0; i < 16; ++i) { const unsigned w_ = ID[i >> 3][(i >> 1) & 3]; R[i] = *(const GAS v4u*)(Ts + (size_t)((((i & 1) ? (w_ >> 9) : (w_ << 7)) & 0x7fff80u) | c16)); } } while (0)
#define V_COMPUTE(R, WV, t_) do { \
        const size_t o_ = (size_t)(t_) * D + sl * SLW + ecol; \
        f32x2g xv = *(const GAS f32x2g*)(X + o_); \
        float acc[16], wsum = 0.f; \
        _Pragma("unroll") for (int e = 0; e < 16; ++e) acc[e] = 0.f; \
        _Pragma("unroll") for (int i = 0; i < 16; ++i) { const float w_ = WV[i >> 2][i & 3]; wsum += w_; \
            _Pragma("unroll") for (int b = 0; b < 4; ++b) { const unsigned q = R[i][b]; acc[4 * b] += w_ * (float)(q & 255u); acc[4 * b + 1] += w_ * (float)((q >> 8) & 255u); acc[4 * b + 2] += w_ * (float)((q >> 16) & 255u); acc[4 * b + 3] += w_ * (float)(q >> 24); } } \
        float r8[8], r4[4], r2[2]; \
        _Pragma("unroll") for (int i = 0; i < 8; ++i) { const float send = (lane & 32) ? acc[i] : acc[i + 8], keep = (lane & 32) ? acc[i + 8] : acc[i]; r8[i] = keep + __shfl_xor(send, 32); } \
        _Pragma("unroll") for (int i = 0; i < 4; ++i) { const float send = (lane & 16) ? r8[i] : r8[i + 4], keep = (lane & 16) ? r8[i + 4] : r8[i]; r4[i] = keep + __shfl_xor(send, 16); } \
        _Pragma("unroll") for (int i = 0; i < 2; ++i) { const float send = (lane & 8) ? r4[i] : r4[i + 2], keep = (lane & 8) ? r4[i + 2] : r4[i]; r2[i] = keep + __shfl_xor(send, 8); } \
        wsum += __shfl_xor(wsum, 32); wsum += __shfl_xor(wsum, 16); wsum += __shfl_xor(wsum, 8); \
        xv.x += r2[0] - 128.0f * wsum; xv.y += r2[1] - 128.0f * wsum; \
        *(GAS f32x2g*)(X + o_) = xv; *(GAS unsigned*)(XB2 + o_) = pk2(xv.x, xv.y); \
        const float ss = wave_sum(xv.x * xv.x + xv.y * xv.y); \
        if (lane == 0) SS3[(size_t)(t_) * 16 + sl] = ss; } while (0)
#define V_FENCE() asm volatile("" ::: "memory")
    for (int sl = G.xg; sl < NSL; sl += 8) {
        const GAS unsigned char* Ts = (const GAS unsigned char*)(ws + WS_VB) + (size_t)sl * NEXP * SLW; const unsigned c16 = 16u * (unsigned)c;
        const int nk = (M - G.wi + G.nwv - 1) / G.nwv, t0 = G.wi, dt = G.nwv;
        v4u idA[2], idB[2]; f32x4 wA[4], wB[4]; v4u rA[16], rB[16];
        if (nk > 0) { V_IDS(idA, t0); V_GATHER(rA, idA); V_W(wA, t0); }
        if (nk > 1) V_IDS(idB, t0 + dt);
        V_FENCE();
        for (int k = 0; k < nk; k += 2) {
            if (k + 1 < nk) { V_GATHER(rB, idB); V_W(wB, t0 + (k + 1) * dt); }
            if (k + 2 < nk) V_IDS(idA, t0 + (k + 2) * dt);
            V_FENCE();
            V_COMPUTE(rA, wA, t0 + k * dt);
            V_FENCE();
            if (k + 2 < nk) { V_GATHER(rA, idA); V_W(wA, t0 + (k + 2) * dt); }
            if (k + 3 < nk) V_IDS(idB, t0 + (k + 3) * dt);
            V_FENCE();
            if (k + 1 < nk) V_COMPUTE(rB, wB, t0 + (k + 1) * dt);
            V_FENCE();
        }
    }
#undef V_IDS
#undef V_W
#undef V_GATHER
#undef V_COMPUTE
#undef V_FENCE
}
__device__ __forceinline__ void p8_final(const Ctx& F, float* X, const float* g) {
    const int gw = F.vcu * NWAVES + F.wave, NGW = F.G * NWAVES;
    for (int row = gw; row < M; row += NGW) {
        GAS f32x4* xr = (GAS f32x4*)(X + (size_t)row * D); f32x4 v[4]; float ss = 0.f;
#pragma unroll
        for (int j = 0; j < 4; ++j) { v[j] = xr[F.lane + 64 * j]; ss += (v[j].x * v[j].x + v[j].y * v[j].y) + (v[j].z * v[j].z + v[j].w * v[j].w); }
        ss = wave_sum(ss); const float rstd = 1.0f / sqrtf(ss * (1.0f / D) + EPS);
#pragma unroll
        for (int j = 0; j < 4; ++j) { const f32x4 gv = ((const GAS f32x4*)g)[F.lane + 64 * j]; xr[F.lane + 64 * j] = v[j] * rstd * gv; }
    }
}
struct OneUnit {
    pg8::Unit u;
    __device__ __forceinline__ bool next(int i, pg8::Unit& o) const { if (i != 0) return false; o = u; return true; }
    __device__ __forceinline__ void a_ready(const pg8::Unit&) const {}
    __device__ __forceinline__ void done(const pg8::Unit&) const {}
};

__global__ void __launch_bounds__(NWAVES * 64, 2) mk_fwd(Args args) {
    extern __shared__ __attribute__((aligned(16))) unsigned char lds[];
    Ctx F;
    F.lds = (LAS unsigned char*)lds;
    F.tid = threadIdx.x; F.lane = F.tid & 63; F.wave = __builtin_amdgcn_readfirstlane(F.tid >> 6);
    F.G = gridDim.x; { const int bx = blockIdx.x; F.vcu = (F.G % 8 == 0) ? (bx % 8) * (F.G / 8) + bx / 8 : bx; }
    volatile LAS unsigned* MISC = (volatile LAS unsigned*)(F.lds + MISC_OFF);
    unsigned char* ws = args.ws;
    gu32* ctl = (gu32*)(ws + WS_CTL);
    for (int u = F.tid; u < (LDS_BYTES - LDSCTL_OFF) / 4; u += NWAVES * 64) ((LAS unsigned*)(F.lds + LDSCTL_OFF))[u] = 0u;
    __syncthreads();
    const int lo = args.ph_lo, hi = args.ph_hi;
    const bool multi = (hi - lo) > 1 || (lo <= 6 && 6 < hi);
    XcdBarrier bar; bar.bar = (unsigned*)(ctl + CW_BAR) + args.li * XCD_BAR_WORDS; bar.x = 0; bar.st = nullptr;
    if (multi) bar = xcd_barrier_post((unsigned*)(ctl + CW_BAR) + args.li * XCD_BAR_WORDS, MISC + 8);
#ifndef MK_CMASK
#define MK_CMASK 0x1ff
#endif
#define IN(k) (((MK_CMASK >> (k)) & 1) && lo <= (k) && (k) < hi)
#define SEAM(k) do { if (IN(k) && IN((k) + 1)) xcd_barrier(bar); STAMP(); } while (0)
#ifdef MK_PROBE_SEG
    int n_stamp = 0;
#define STAMP() do { if (blockIdx.x == 0 && F.tid == 0) { const unsigned long long t_ = __builtin_amdgcn_s_memrealtime(); MISC[16 + 2 * n_stamp] = (unsigned)t_; MISC[17 + 2 * n_stamp] = (unsigned)(t_ >> 32); } ++n_stamp; } while (0)
    STAMP();
#else
#define STAMP() do { } while (0)
#endif
    float* out = args.out;
    float *RSTD1 = (float*)(ws + WS_RSTD1), *SS2 = (float*)(ws + WS_SS2), *LF = (float*)(ws + WS_LF);
    bf16 *WIN = (bf16*)(ws + WS_WIN), *WBR = (bf16*)(ws + WS_WBR), *WOUT = (bf16*)(ws + WS_WOUT), *WST = (bf16*)(ws + WS_WS), *WPG = (bf16*)(ws + WS_WPG), *WPP = (bf16*)(ws + WS_WPP), *PB = (bf16*)(ws + WS_PB);
    bf16 *UB = (bf16*)(ws + WS_UB), *VB = (bf16*)(ws + WS_VB), *XB = (bf16*)(ws + WS_A), *AC = (bf16*)(ws + WS_A), *XB1 = (bf16*)(ws + WS_A), *PP = (bf16*)(ws + WS_PP);
    bf16 *Q = (bf16*)(ws + WS_Q), *K = (bf16*)(ws + WS_K), *V = (bf16*)(ws + WS_V), *GB = (bf16*)(ws + WS_GB), *Z = (bf16*)(ws + WS_Z), *MG = (bf16*)(ws + WS_MERGED), *XB2 = (bf16*)(ws + WS_XB2);
    unsigned short* IDS = (unsigned short*)(ws + WS_IDS); float* GATES = (float*)(ws + WS_GATES);
    bf16 *SGA = (bf16*)out, *SGC = (bf16*)out + (size_t)M * D;

    if (IN(0)) { p0_prologue(F, args); }
    SEAM(0);
    if (IN(1)) {
        { pg8::Gemm g{XB, WIN, M, NIN, D}; pg8::StaticOrder S; S.init(M, NIN, F.G, (int)blockIdx.x);
          pg8::EpiIn E{RSTD1, Q, (size_t)(WS_K - WS_Q) / 2, Z, SGA, (size_t)M * D, C2};
          static_assert(WS_V - WS_K == WS_K - WS_Q && WS_GB - WS_V == WS_K - WS_Q, "Q | K | V | GB equally spaced");
          pg8::gemm_phase<pg8::EpiIn, pg8::StaticOrder, PG8_ALIGN, PG8_SP2>(F.lds + RING_OFF, g, S, E); }
        { pg8::Gemm g{PB, WPP, M, D, PLE}; pg8::StaticOrder S; S.init(M, D, F.G, (int)blockIdx.x);
          pg8::EpiPlain E{PP, D};
          pg8::gemm_phase<pg8::EpiPlain, pg8::StaticOrder, PG8_ALIGN, PG8_SP2>(F.lds + RING_OFF, g, S, E); }
    }
    SEAM(1);
    if (IN(2)) {
        p2_conv(F, GB, Z, args.in[5], AC);
        const attn_body::AttnTensors AT{(const attn_body::bf16*)Q, (const attn_body::bf16*)K, (const attn_body::bf16*)V, (attn_body::bf16*)AC, LF};
        const attn_body::StaticOrder S((int)F.G, F.vcu);
        attn_body::attn_phase<attn_body::StaticOrder>((char*)lds + RING_OFF, AT, S);
    }
    SEAM(2);
    if (IN(3)) {
        pg8::Gemm g{AC, WBR, M, D, D}; pg8::StaticOrder S; S.init(M, D, F.G, (int)blockIdx.x);
        pg8::EpiBranch E{SGA, SGC, MG};
        pg8::gemm_phase<pg8::EpiBranch, pg8::StaticOrder, PG8_ALIGN, PG8_SP2>(F.lds + RING_OFF, g, S, E);
    }
    SEAM(3);
    if (IN(4)) {
        pg8::Gemm g{MG, WOUT, M, D, D}; pg8::StaticOrder S; S.init(M, D, F.G, (int)blockIdx.x);
        pg8::EpiOut E{args.in[0], out, XB1, SS2};
        pg8::gemm_phase<pg8::EpiOut, pg8::StaticOrder, PG8_ALIGN, PG8_SP2>(F.lds + RING_OFF, g, S, E);
    }
    SEAM(4);
    if (IN(5)) {
        pg8::Gemm g{XB1, WST, M, NS, D}; pg8::StaticOrder S; S.init(M, NS, F.G, (int)blockIdx.x);
        pg8::EpiTopK E{SS2, IDS, GATES, EPS};
        pg8::Unit u;
        for (int i = 0; S.next(i, u); ++i) { OneUnit O{u}; pg8::gemm_phase<pg8::EpiTopK, OneUnit, false, PG8_SP2>(F.lds + RING_OFF, g, O, E); }
    }
    SEAM(5);
    if (IN(6)) { p6a_upass(F, ws, XB1, IDS); xcd_barrier(bar); STAMP(); p6b_combine(F, ws, SS2, IDS, GATES); xcd_barrier(bar); STAMP(); p6c_vpass(F, ws, IDS, GATES, out, XB2, SS2); }
    SEAM(6);
    if (IN(7)) {
        pg8::Gemm g{XB2, WPG, M, D, D}; pg8::StaticOrder S; S.init(M, D, F.G, (int)blockIdx.x);
        pg8::EpiPle E{SS2, PP, out, EPS};
        pg8::gemm_phase<pg8::EpiPle, pg8::StaticOrder, PG8_ALIGN, PG8_SP2>(F.lds + RING_OFF, g, S, E);
    }
    SEAM(7);
    if (IN(8)) { p8_final(F, out, args.in[17]); }
    STAMP();
#ifdef MK_PROBE_SEG
    if (blockIdx.x == 0 && F.tid == 0) {
        const unsigned long long a_ = ((unsigned long long)MISC[17 + 2 * MK_PROBE_SEG] << 32) | MISC[16 + 2 * MK_PROBE_SEG], b_ = ((unsigned long long)MISC[19 + 2 * MK_PROBE_SEG] << 32) | MISC[18 + 2 * MK_PROBE_SEG];
        const unsigned long long dt_ = (b_ - a_) * MK_PROBE_MULT, t0_ = __builtin_amdgcn_s_memrealtime();
        while (__builtin_amdgcn_s_memrealtime() - t0_ < dt_) __builtin_amdgcn_s_sleep(8);
    }
#endif
#undef IN
#undef SEAM
}
namespace gold {
__global__ void __launch_bounds__(256) k_rows0(const float* x, const float* w_in, const float* g_mix, const float* b_f, bf16* XB, float* RSTD1, float* LF) {
    const int lane = threadIdx.x & 63, row = blockIdx.x * 4 + (threadIdx.x >> 6);
    const f32x4* xr = (const f32x4*)(x + (size_t)row * D);
    f32x4 v[4]; float ss = 0.f;
#pragma unroll
    for (int j = 0; j < 4; ++j) { v[j] = xr[lane + 64 * j]; ss += v[j].x * v[j].x + v[j].y * v[j].y + v[j].z * v[j].z + v[j].w * v[j].w; }
    ss = wave_sum(ss);
    const float rstd = 1.0f / sqrtf(ss * (1.0f / D) + EPS);
    u32x2* o = (u32x2*)(XB + (size_t)row * D);
#pragma unroll
    for (int j = 0; j < 4; ++j) { u32x2 w; w.x = pk2(v[j].x, v[j].y); w.y = pk2(v[j].z, v[j].w); o[lane + 64 * j] = w; }
    if (lane == 0) RSTD1[row] = rstd;
    float f[8];
#pragma unroll
    for (int h = 0; h < 8; ++h) f[h] = 0.f;
#pragma unroll
    for (int j = 0; j < 4; ++j)
#pragma unroll
        for (int e = 0; e < 4; ++e) {
            const int k = 4 * (lane + 64 * j) + e; const float xv = v[j][e] * g_mix[k];
            const f32x4 w0 = *(const f32x4*)(w_in + (size_t)k * INTOT + 1536), w1 = *(const f32x4*)(w_in + (size_t)k * INTOT + 1540);
            f[0] += xv * w0.x; f[1] += xv * w0.y; f[2] += xv * w0.z; f[3] += xv * w0.w; f[4] += xv * w1.x; f[5] += xv * w1.y; f[6] += xv * w1.z; f[7] += xv * w1.w;
        }
    const int b = row / SEQ, t = row % SEQ;
#pragma unroll
    for (int h = 0; h < 8; ++h) {
        const float tot = wave_sum(f[h]) * rstd + b_f[h];
        const float ls = fminf(tot, 0.f) - log1pf(__expf(-fabsf(tot)));
        if (lane == 0) LF[(size_t)(b * NH + h) * SEQ + t] = ls * LOG2E;
    }
}
template <int MODE> __global__ void k_wt(const float* W, int ldw, const float* g, bf16* Wt, int N, int K, int koff, int ldt) {
    const size_t i = (size_t)blockIdx.x * blockDim.x + threadIdx.x; if (i >= (size_t)N * K) return;
    const int n = (int)(i / K), k = (int)(i % K);
    const int s = MODE == 1 ? src_in(n) : n;
    const float gv = g ? g[k] : 1.f;
    Wt[(size_t)n * ldt + koff + k] = (bf16)f2bf(gv * W[(size_t)k * ldw + s]);
}
__global__ void k_ws(const float* wq, const float* k1, const float* k2, const float* g, bf16* WST) {
    const size_t i = (size_t)blockIdx.x * blockDim.x + threadIdx.x; if (i >= (size_t)NS * D) return;
    const int n = (int)(i / D), d = (int)(i % D), head = n >> 8, half = (n >> 7) & 1, key = n & 127;
    const float* kr = (half ? k2 : k1) + ((size_t)head * NKEYS + key) * 128;
    const float* qr = wq + (size_t)d * NS + head * 256 + half * 128;
    float s = 0.f;
    for (int e = 0; e < 128; ++e) s += qr[e] * kr[e];
    WST[(size_t)n * D + d] = (bf16)f2bf(g[d] * s);
}
__global__ void k_cvt(const float* in, const float* g, bf16* out, size_t n, int gmask) {
    const size_t i = (size_t)blockIdx.x * blockDim.x + threadIdx.x; if (i >= n) return;
    out[i] = (bf16)f2bf(in[i] * (g ? g[i & gmask] : 1.f));
}

template <class Epi, bool SPLIT2>
__global__ void __launch_bounds__(256) ng(const bf16* A, int lda, const bf16* Bt, int ldb, int K, Epi E) {
    __shared__ float As[32][68], Bs[32][68];
    const int tid = threadIdx.x, tx = tid & 15, ty = tid >> 4, m0 = blockIdx.y * 64, n0 = blockIdx.x * 64;
    float acc[4][4], acc2[4][4];
#pragma unroll
    for (int i = 0; i < 4; ++i)
#pragma unroll
        for (int j = 0; j < 4; ++j) { acc[i][j] = 0.f; acc2[i][j] = 0.f; }
    const int lr = tid >> 2, lk = (tid & 3) * 8;
    for (int k0 = 0; k0 < K; k0 += 32) {
        const u32x4 av = *(const u32x4*)(A + (size_t)(m0 + lr) * lda + k0 + lk), bv = *(const u32x4*)(Bt + (size_t)(n0 + lr) * ldb + k0 + lk);
#pragma unroll
        for (int e = 0; e < 4; ++e) {
            As[lk + 2 * e][lr] = __uint_as_float(av[e] << 16); As[lk + 2 * e + 1][lr] = __uint_as_float(av[e] & 0xffff0000u);
            Bs[lk + 2 * e][lr] = __uint_as_float(bv[e] << 16); Bs[lk + 2 * e + 1][lr] = __uint_as_float(bv[e] & 0xffff0000u);
        }
        __syncthreads();
        const bool second = SPLIT2 && (k0 >= K / 2);
#pragma unroll 8
        for (int kk = 0; kk < 32; ++kk) {
            float a[4], b[4];
#pragma unroll
            for (int i = 0; i < 4; ++i) { a[i] = As[kk][ty * 4 + i]; b[i] = Bs[kk][tx * 4 + i]; }
            if (second) {
#pragma unroll
                for (int i = 0; i < 4; ++i)
#pragma unroll
                    for (int j = 0; j < 4; ++j) acc2[i][j] += a[i] * b[j];
            } else {
#pragma unroll
                for (int i = 0; i < 4; ++i)
#pragma unroll
                    for (int j = 0; j < 4; ++j) acc[i][j] += a[i] * b[j];
            }
        }
        __syncthreads();
    }
#pragma unroll
    for (int i = 0; i < 4; ++i)
#pragma unroll
        for (int j = 0; j < 4; ++j) E(m0 + ty * 4 + i, n0 + tx * 4 + j, acc[i][j], acc2[i][j]);
}
struct E1 {
    const float* RSTD1; bf16 *Q, *K, *V, *GB, *SGA, *SGC; float *TGC, *TXC;
    __device__ void operator()(int row, int col, float a, float) const {
        const float v = RSTD1[row] * a; const int pn = col >> 8;
        if (pn < 2) Q[(size_t)row * AW + col] = (bf16)f2bf(v * C2);
        else if (pn < 4) K[(size_t)row * AW + col - 512] = (bf16)f2bf(v);
        else if (pn < 6) V[(size_t)row * AW + col - 1024] = (bf16)f2bf(v);
        else if (pn < 8) GB[(size_t)row * AW + col - 1536] = (bf16)f2bf(v);
        else if (pn < 12) { const int j = pn - 8, l = col & 255; if (l < 128) TGC[(size_t)row * AW + 128 * j + l] = v; else TXC[(size_t)row * AW + 128 * j + l - 128] = v; }
        else if (pn < 16) SGA[(size_t)row * D + col - 3072] = (bf16)f2bf(sigmoidf_(v));
        else SGC[(size_t)row * D + col - 4096] = (bf16)f2bf(sigmoidf_(v));
    }
};
struct EPP { bf16* PP; __device__ void operator()(int row, int col, float a, float) const { PP[(size_t)row * D + col] = (bf16)f2bf(a); } };
struct E3 { const bf16 *SGA, *SGC; bf16* MG;
    __device__ void operator()(int row, int col, float a, float a2) const { const size_t i = (size_t)row * D + col; MG[i] = (bf16)f2bf(bf2f(SGA[i]) * a + bf2f(SGC[i]) * a2); } };
struct E4 { const float* x; float* X1; bf16* XB1;
    __device__ void operator()(int row, int col, float a, float) const { const size_t i = (size_t)row * D + col; const float v = x[i] + a; X1[i] = v; XB1[i] = (bf16)f2bf(v); } };
struct E5 { float* SC; __device__ void operator()(int row, int col, float a, float) const { SC[(size_t)row * 1024 + col] = a; } };
struct E7 { const float* SS3; const bf16* PP; float* X;
    __device__ void operator()(int row, int col, float a, float) const { const size_t i = (size_t)row * D + col; float q_ = 0.f; for (int j_ = 0; j_ < 16; ++j_) q_ += SS3[(size_t)row * 16 + j_]; X[i] = X[i] + sigmoidf_(a / sqrtf(q_ * (1.0f / D) + EPS)) * bf2f(PP[i]); } };

__global__ void k_z(const float* TGC, const float* TXC, bf16* Z) { const size_t i = (size_t)blockIdx.x * blockDim.x + threadIdx.x; if (i < (size_t)M * AW) Z[i] = (bf16)f2bf(TGC[i] * TXC[i]); }
__global__ void k_cumsum(const float* LF, float* CS) { const int bh = threadIdx.x; if (bh >= 32) return; float s = 0.f; for (int t = 0; t < SEQ; ++t) { s += LF[(size_t)bh * SEQ + t]; CS[(size_t)bh * SEQ + t] = s; } }
__global__ void k_conv(const bf16* GB, const bf16* Z, const float* cw, bf16* AC) {
    const size_t i = (size_t)blockIdx.x * blockDim.x + threadIdx.x; if (i >= (size_t)M * AW) return;
    const int row = (int)(i / AW), c = (int)(i % AW), t = row % SEQ;
    float s = cw[2 * AW + c] * bf2f(Z[i]);
    if (t >= 1) s += cw[1 * AW + c] * bf2f(Z[i - AW]);
    if (t >= 2) s += cw[0 * AW + c] * bf2f(Z[i - 2 * AW]);
    AC[(size_t)row * D + AW + c] = (bf16)f2bf(bf2f(GB[i]) * s);
}
__global__ void __launch_bounds__(64) k_attn(const bf16* Q, const bf16* K, const bf16* V, const float* CS, bf16* AC) {
    const int bh = blockIdx.y, b = bh / NH, h = bh % NH, q = blockIdx.x * 64 + threadIdx.x;
    const size_t rq = (size_t)b * SEQ + q;
    float qv[64], o[64];
#pragma unroll
    for (int d = 0; d < 64; ++d) { qv[d] = bf2f(Q[rq * AW + h * 64 + d]); o[d] = 0.f; }
    const float cq = CS[(size_t)bh * SEQ + q];
    float m = -INFINITY, l = 0.f;
    const int kvmax = blockIdx.x * 64 + 63;
    for (int kv = 0; kv <= kvmax; ++kv) {
        const size_t rk = (size_t)b * SEQ + kv;
        const u32x4* kp = (const u32x4*)(K + rk * AW + h * 64);
        float s = 0.f;
#pragma unroll
        for (int c = 0; c < 8; ++c) { const u32x4 w = kp[c];
#pragma unroll
            for (int e = 0; e < 4; ++e) { s += qv[c * 8 + 2 * e] * __uint_as_float(w[e] << 16) + qv[c * 8 + 2 * e + 1] * __uint_as_float(w[e] & 0xffff0000u); } }
        s += cq - CS[(size_t)bh * SEQ + kv];
        if (kv > q) s = -INFINITY;
        const float mn = fmaxf(m, s);
        const float al = (m == -INFINITY) ? 0.f : exp2f(m - mn), p = (s == -INFINITY) ? 0.f : exp2f(s - mn);
        l = l * al + p; m = mn;
        const u32x4* vp = (const u32x4*)(V + rk * AW + h * 64);
#pragma unroll
        for (int c = 0; c < 8; ++c) { const u32x4 w = vp[c];
#pragma unroll
            for (int e = 0; e < 4; ++e) { o[c * 8 + 2 * e] = o[c * 8 + 2 * e] * al + p * __uint_as_float(w[e] << 16); o[c * 8 + 2 * e + 1] = o[c * 8 + 2 * e + 1] * al + p * __uint_as_float(w[e] & 0xffff0000u); } }
    }
    const float il = 1.0f / l;
#pragma unroll
    for (int d = 0; d < 64; ++d) AC[rq * D + h * 64 + d] = (bf16)f2bf(o[d] * il);
}
__global__ void __launch_bounds__(256) k_rowss(const float* X, float* SS) {
    const int lane = threadIdx.x & 63, row = blockIdx.x * 4 + (threadIdx.x >> 6);
    const f32x4* xr = (const f32x4*)(X + (size_t)row * D); float ss = 0.f;
#pragma unroll
    for (int j = 0; j < 4; ++j) { const f32x4 v = xr[lane + 64 * j]; ss += v.x * v.x + v.y * v.y + v.z * v.z + v.w * v.w; }
    ss = wave_sum(ss);
    if (lane < 16) SS[(size_t)row * 16 + lane] = lane == 0 ? ss : 0.f;
}
__global__ void __launch_bounds__(64) k_topk(const float* SC, const float* SS2, int hg, unsigned short* IDS, float* GATES) {
    __shared__ float s[128][64]; __shared__ float tv[16][64]; __shared__ int ti[16][64];
    const int tid = threadIdx.x, pair = blockIdx.x * 32 + (tid >> 1), half = tid & 1, token = pair >> 2, hl = pair & 3;
    const float* src = SC + (size_t)token * 1024 + hl * 256 + half * 128;
    for (int k = 0; k < 128; ++k) s[k][tid] = src[k];
    float pv = INFINITY; int pk = -1;
    for (int r = 0; r < 16; ++r) {
        float best = -INFINITY; int bi = 0;
        for (int k = 0; k < 128; ++k) { const float v = s[k][tid]; const bool elig = (v < pv) || (v == pv && k > pk); if (elig && v > best) { best = v; bi = k; } }
        tv[r][tid] = best; ti[r][tid] = bi; pv = best; pk = bi;
    }
    __syncthreads();
    if (half == 0) {
        const float* ss = SS2 + (size_t)token * 16; float sst = 0.f; for (int q_ = 0; q_ < 16; ++q_) sst += ss[q_]; const float rstd = 1.0f / sqrtf(sst * (1.0f / D) + EPS);
        float ts[16]; int tf[16];
        float cpv = INFINITY; int cpf = -1;
#pragma unroll
        for (int r = 0; r < 16; ++r) {
            float best = -INFINITY; int bf_ = 0;
            for (int c = 0; c < 256; ++c) { const float v = tv[c >> 4][tid] + tv[c & 15][tid + 1]; const bool elig = (v < cpv) || (v == cpv && c > cpf); if (elig && v > best) { best = v; bf_ = c; } }
            ts[r] = best; tf[r] = bf_; cpv = best; cpf = bf_;
        }
        float e[16], sum = 0.f;
#pragma unroll
        for (int r = 0; r < 16; ++r) { e[r] = __expf(rstd * (ts[r] - ts[0])); sum += e[r]; }
        const float inv = 1.0f / sum; const int head = hg * 4 + hl;
#pragma unroll
        for (int r = 0; r < 16; ++r) { IDS[(size_t)token * 128 + head * 16 + r] = (unsigned short)(ti[tf[r] >> 4][tid] * 128 + ti[tf[r] & 15][tid + 1]); GATES[(size_t)token * 128 + head * 16 + r] = e[r] * inv; }
    }
}
__global__ void __launch_bounds__(256) k_peer(const bf16* XB1, const float* SS2, const unsigned short* IDS, const float* GATES, const bf16* UB, const bf16* VB, float* X, bf16* XB2, float* RSTD3) {
    const int lane = threadIdx.x & 63, token = blockIdx.x * 4 + (threadIdx.x >> 6);
    const float* ss = SS2 + (size_t)token * 16; float sst = 0.f; for (int q_ = 0; q_ < 16; ++q_) sst += ss[q_]; const float rstd = 1.0f / sqrtf(sst * (1.0f / D) + EPS);
    float xf[16], out[16];
    { const u32x4 a = *(const u32x4*)(XB1 + (size_t)token * D + 8 * lane), b = *(const u32x4*)(XB1 + (size_t)token * D + 512 + 8 * lane);
#pragma unroll
      for (int e = 0; e < 4; ++e) { xf[2 * e] = __uint_as_float(a[e] << 16); xf[2 * e + 1] = __uint_as_float(a[e] & 0xffff0000u); xf[8 + 2 * e] = __uint_as_float(b[e] << 16); xf[8 + 2 * e + 1] = __uint_as_float(b[e] & 0xffff0000u); } }
#pragma unroll
    for (int i = 0; i < 16; ++i) out[i] = 0.f;
    for (int hk = 0; hk < 128; ++hk) {
        const int id = IDS[(size_t)token * 128 + hk]; const float g = GATES[(size_t)token * 128 + hk];
        const u32x4 a = *(const u32x4*)(UB + (size_t)id * D + 8 * lane), b = *(const u32x4*)(UB + (size_t)id * D + 512 + 8 * lane);
        float dot = 0.f;
#pragma unroll
        for (int e = 0; e < 4; ++e) { dot += xf[2 * e] * __uint_as_float(a[e] << 16) + xf[2 * e + 1] * __uint_as_float(a[e] & 0xffff0000u) + xf[8 + 2 * e] * __uint_as_float(b[e] << 16) + xf[8 + 2 * e + 1] * __uint_as_float(b[e] & 0xffff0000u); }
        dot = wave_sum(dot) * rstd;
        const float w = g * 0.5f * dot * (1.0f + erff(dot * 0.70710678118654752f));
        const u32x4 va = *(const u32x4*)(VB + (size_t)id * D + 8 * lane), vb = *(const u32x4*)(VB + (size_t)id * D + 512 + 8 * lane);
#pragma unroll
        for (int e = 0; e < 4; ++e) { out[2 * e] += w * __uint_as_float(va[e] << 16); out[2 * e + 1] += w * __uint_as_float(va[e] & 0xffff0000u); out[8 + 2 * e] += w * __uint_as_float(vb[e] << 16); out[8 + 2 * e + 1] += w * __uint_as_float(vb[e] & 0xffff0000u); }
    }
    float* xr = X + (size_t)token * D; float s2 = 0.f;
    f32x4 x0 = *(f32x4*)(xr + 8 * lane), x1 = *(f32x4*)(xr + 8 * lane + 4), x2 = *(f32x4*)(xr + 512 + 8 * lane), x3 = *(f32x4*)(xr + 512 + 8 * lane + 4);
#pragma unroll
    for (int e = 0; e < 4; ++e) { x0[e] += out[e]; x1[e] += out[4 + e]; x2[e] += out[8 + e]; x3[e] += out[12 + e]; s2 += x0[e] * x0[e] + x1[e] * x1[e] + x2[e] * x2[e] + x3[e] * x3[e]; }
    *(f32x4*)(xr + 8 * lane) = x0; *(f32x4*)(xr + 8 * lane + 4) = x1; *(f32x4*)(xr + 512 + 8 * lane) = x2; *(f32x4*)(xr + 512 + 8 * lane + 4) = x3;
    u32x4 w0, w1; w0.x = pk2(x0.x, x0.y); w0.y = pk2(x0.z, x0.w); w0.z = pk2(x1.x, x1.y); w0.w = pk2(x1.z, x1.w); w1.x = pk2(x2.x, x2.y); w1.y = pk2(x2.z, x2.w); w1.z = pk2(x3.x, x3.y); w1.w = pk2(x3.z, x3.w);
    *(u32x4*)(XB2 + (size_t)token * D + 8 * lane) = w0; *(u32x4*)(XB2 + (size_t)token * D + 512 + 8 * lane) = w1;
    s2 = wave_sum(s2);
    if (lane < 16) RSTD3[(size_t)token * 16 + lane] = lane == 0 ? s2 : 0.f;
}
__global__ void __launch_bounds__(256) k_final(float* X, const float* g) {
    const int lane = threadIdx.x & 63, row = blockIdx.x * 4 + (threadIdx.x >> 6);
    f32x4* xr = (f32x4*)(X + (size_t)row * D); f32x4 v[4]; float ss = 0.f;
#pragma unroll
    for (int j = 0; j < 4; ++j) { v[j] = xr[lane + 64 * j]; ss += v[j].x * v[j].x + v[j].y * v[j].y + v[j].z * v[j].z + v[j].w * v[j].w; }
    ss = wave_sum(ss); const float rstd = 1.0f / sqrtf(ss * (1.0f / D) + EPS);
#pragma unroll
    for (int j = 0; j < 4; ++j) { const f32x4 gv = ((const f32x4*)g)[lane + 64 * j]; xr[lane + 64 * j] = v[j] * rstd * gv; }
}

}

#ifndef MK_FUSED_MASK
#define MK_FUSED_MASK 0x1ff
#endif
static void golden_phase(int ph, void* const* d_in, float* out, unsigned char* ws, hipStream_t stream) {
    using namespace gold;
    const float* x = (const float*)d_in[0]; const float* p = (const float*)d_in[1]; const float* g_mix = (const float*)d_in[2]; const float* w_in = (const float*)d_in[3];
    const float* b_f = (const float*)d_in[4]; const float* conv_w = (const float*)d_in[5]; const float* w_branch = (const float*)d_in[6]; const float* w_out = (const float*)d_in[7];
    const float* g_ffn = (const float*)d_in[8]; const float* w_peer_q = (const float*)d_in[9]; const float* peer_k1 = (const float*)d_in[10]; const float* peer_k2 = (const float*)d_in[11];
    const float* peer_u = (const float*)d_in[12]; const float* peer_v = (const float*)d_in[13]; const float* g_ple = (const float*)d_in[14]; const float* w_ple_gate = (const float*)d_in[15];
    const float* w_ple_proj = (const float*)d_in[16]; const float* g_final = (const float*)d_in[17];
    float *RSTD1 = (float*)(ws + WS_RSTD1), *SS2 = (float*)(ws + WS_SS2), *LF = (float*)(ws + WS_LF), *CS = (float*)(ws + WS_CS);
    bf16 *WIN = (bf16*)(ws + WS_WIN), *WBR = (bf16*)(ws + WS_WBR), *WOUT = (bf16*)(ws + WS_WOUT), *WST = (bf16*)(ws + WS_WS), *WPG = (bf16*)(ws + WS_WPG), *WPP = (bf16*)(ws + WS_WPP), *PB = (bf16*)(ws + WS_PB);
    bf16 *UB = (bf16*)(ws + WS_UB), *VB = (bf16*)(ws + WS_VB), *XB = (bf16*)(ws + WS_A), *AC = (bf16*)(ws + WS_A), *XB1 = (bf16*)(ws + WS_A), *PP = (bf16*)(ws + WS_PP);
    bf16 *Q = (bf16*)(ws + WS_Q), *K = (bf16*)(ws + WS_K), *V = (bf16*)(ws + WS_V), *GB = (bf16*)(ws + WS_GB), *Z = (bf16*)(ws + WS_Z), *MG = (bf16*)(ws + WS_MERGED), *XB2 = (bf16*)(ws + WS_XB2);
    unsigned short* IDS = (unsigned short*)(ws + WS_IDS); float* GATES = (float*)(ws + WS_GATES);
    bf16 *SGA = (bf16*)out, *SGC = (bf16*)out + (size_t)M * D;
    float *TGC = (float*)(ws + WS_TGC), *TXC = (float*)(ws + WS_TXC), *SC = (float*)(ws + WS_SC);
    auto nb = [](size_t n) { return (unsigned)((n + 255) / 256); };
    switch (ph) {
    case 0:
        k_rows0<<<M / 4, 256, 0, stream>>>(x, w_in, g_mix, b_f, XB, RSTD1, LF);
        k_wt<1><<<nb((size_t)NIN * D), 256, 0, stream>>>(w_in, INTOT, g_mix, WIN, NIN, D, 0, D);
        k_wt<0><<<nb((size_t)D * AW), 256, 0, stream>>>(w_branch, D, nullptr, WBR, D, AW, 0, D);
        k_wt<0><<<nb((size_t)D * AW), 256, 0, stream>>>(w_branch + (size_t)AW * D, D, nullptr, WBR, D, AW, AW, D);
        k_wt<0><<<nb((size_t)D * D), 256, 0, stream>>>(w_out, D, nullptr, WOUT, D, D, 0, D);
        k_wt<0><<<nb((size_t)D * D), 256, 0, stream>>>(w_ple_gate, D, g_ple, WPG, D, D, 0, D);
        k_wt<0><<<nb((size_t)D * PLE), 256, 0, stream>>>(w_ple_proj, D, nullptr, WPP, D, PLE, 0, PLE);
        k_ws<<<nb((size_t)NS * D), 256, 0, stream>>>(w_peer_q, peer_k1, peer_k2, g_ffn, WST);
        k_cvt<<<nb((size_t)M * PLE), 256, 0, stream>>>(p, nullptr, PB, (size_t)M * PLE, 0);
        break;
    case 1:
        ng<E1, false><<<dim3(NIN / 64, M / 64), 256, 0, stream>>>(XB, D, WIN, D, D, E1{RSTD1, Q, K, V, GB, SGA, SGC, TGC, TXC});
        ng<EPP, false><<<dim3(D / 64, M / 64), 256, 0, stream>>>(PB, PLE, WPP, PLE, PLE, EPP{PP});
        k_z<<<nb((size_t)M * AW), 256, 0, stream>>>(TGC, TXC, Z);
        break;
    case 2:
        k_cumsum<<<1, 64, 0, stream>>>(LF, CS);
        k_conv<<<nb((size_t)M * AW), 256, 0, stream>>>(GB, Z, conv_w, AC);
        k_attn<<<dim3(SEQ / 64, BATCH * NH), 64, 0, stream>>>(Q, K, V, CS, AC);
        break;
    case 3: ng<E3, true><<<dim3(D / 64, M / 64), 256, 0, stream>>>(AC, D, WBR, D, D, E3{SGA, SGC, MG}); break;
    case 4:
        ng<E4, false><<<dim3(D / 64, M / 64), 256, 0, stream>>>(MG, D, WOUT, D, D, E4{x, out, XB1});
        k_rowss<<<M / 4, 256, 0, stream>>>(out, SS2);
        break;
    case 5:
        for (int hg = 0; hg < 2; ++hg) {
            ng<E5, false><<<dim3(1024 / 64, M / 64), 256, 0, stream>>>(XB1, D, WST + (size_t)hg * 1024 * D, D, D, E5{SC});
            k_topk<<<M * 4 / 32, 64, 0, stream>>>(SC, SS2, hg, IDS, GATES);
        }
        break;
    case 6:
        k_cvt<<<nb((size_t)NEXP * D), 256, 0, stream>>>(peer_u, g_ffn, UB, (size_t)NEXP * D, D - 1);
        k_cvt<<<nb((size_t)NEXP * D), 256, 0, stream>>>(peer_v, nullptr, VB, (size_t)NEXP * D, 0);
        k_peer<<<M / 4, 256, 0, stream>>>(XB1, SS2, IDS, GATES, UB, VB, out, XB2, SS2);
        break;
    case 7: ng<E7, false><<<dim3(D / 64, M / 64), 256, 0, stream>>>(XB2, D, WPG, D, D, E7{SS2, PP, out}); break;
    case 8: k_final<<<M / 4, 256, 0, stream>>>(out, g_final); break;
    }
}
extern "C" void kernel_launch(void* const* d_in, const int* in_sizes, int n_in, void* d_out, int out_size, void* d_ws, size_t ws_size, hipStream_t stream) {
    static int grid = 0;
    if (grid == 0) {
        if (n_in != 18 || in_sizes[0] != M * D || out_size != M * D || ws_size < WS_END) { fprintf(stderr, "kernel_launch: unexpected shapes (n_in %d, in0 %d, out %d, ws %zu); nothing launched\n", n_in, n_in > 0 ? in_sizes[0] : -1, out_size, ws_size); grid = -1; return; }
        int dev = 0, cus = 0, per_cu = 0;
        if (hipGetDevice(&dev) != hipSuccess || hipDeviceGetAttribute(&cus, hipDeviceAttributeMultiprocessorCount, dev) != hipSuccess) { fprintf(stderr, "kernel_launch: device query failed\n"); grid = -1; return; }
        if (hipFuncSetAttribute((const void*)mk_fwd, hipFuncAttributeMaxDynamicSharedMemorySize, LDS_BYTES) != hipSuccess) { fprintf(stderr, "kernel_launch: hipFuncSetAttribute failed\n"); grid = -1; return; }
        if (hipOccupancyMaxActiveBlocksPerMultiprocessor(&per_cu, (const void*)mk_fwd, NWAVES * 64, LDS_BYTES) != hipSuccess || per_cu < 1) { fprintf(stderr, "kernel_launch: occupancy query says %d workgroups per CU; nothing launched\n", per_cu); (void)hipGetLastError(); grid = -1; return; }
        grid = cus;
    }
    if (grid < 0) return;
    if (hipMemsetAsync((char*)d_ws + WS_CTL, 0, CTL_ZERO_BYTES, stream) != hipSuccess) { fprintf(stderr, "kernel_launch: hipMemsetAsync failed\n"); return; }
    Args a{};
    for (int i = 0; i < 18; ++i) a.in[i] = (const float*)d_in[i];
    a.out = (float*)d_out; a.ws = (unsigned char*)d_ws;
    int li = 0;
    for (int ph = 0; ph < NPHASE;) {
        if ((MK_FUSED_MASK >> ph) & 1) {
            int hi = ph; while (hi < NPHASE && ((MK_FUSED_MASK >> hi) & 1)) ++hi;
            a.ph_lo = ph; a.ph_hi = hi; a.li = li++; a.pad = 0;
            hipLaunchKernelGGL(mk_fwd, dim3(grid), dim3(NWAVES * 64), LDS_BYTES, stream, a);
            const hipError_t le = hipPeekAtLastError();
            if (le != hipSuccess) { fprintf(stderr, "kernel_launch: launch failed: %s\n", hipGetErrorName(le)); return; }
            ph = hi;
        } else {
            golden_phase(ph, d_in, (float*)d_out, (unsigned char*)d_ws, stream);
            if ((ph == 1 || ph == 5) && (MK_FUSED_MASK & 1) && ((MK_FUSED_MASK >> 6) & 1)) {
                gold::k_cvt<<<(unsigned)(((size_t)NEXP * D + 255) / 256), 256, 0, stream>>>((const float*)d_in[12], (const float*)d_in[8], (bf16*)((unsigned char*)d_ws + WS_UB), (size_t)NEXP * D, D - 1);
                gold::k_cvt<<<(unsigned)(((size_t)NEXP * D + 255) / 256), 256, 0, stream>>>((const float*)d_in[13], nullptr, (bf16*)((unsigned char*)d_ws + WS_VB), (size_t)NEXP * D, 0);
            }
            ++ph;
        }
    }
}
```

```cpp
#include <hip/hip_runtime.h>
#include <hip/hip_bf16.h>
#include <cstdio>
#include <cstdint>
#include <cmath>
#define MK_FUSED_MASK 0x1ff
namespace pg8 {
#define PG8_LAS __attribute__((address_space(3)))
typedef unsigned short bf16_t;
typedef short bf16x8 __attribute__((ext_vector_type(8)));
typedef float f32x4 __attribute__((ext_vector_type(4)));
typedef unsigned u32x4 __attribute__((ext_vector_type(4)));
constexpr int BM = 256, BK = 64, HALF = 128, HTB = HALF * BK * 2  , STAGE_BYTES = 8 * HTB, NXCD = 8, WGM = 8;

__host__ __device__ __forceinline__ int lds_byte(int r, int c) { const int st = (r >> 4) * 2 + (c >> 5), rr = r & 15, cc = c & 31, ob = rr * 64 + cc * 2; return st * 1024 + (ob ^ (((ob >> 9) & 1) << 5)); }
__host__ __device__ __forceinline__ void stage_rc(int b, int& R, int& C) { const int st = b / 1024, sb = b % 1024, swz = sb ^ (((sb >> 9) & 1) << 5); R = (st >> 1) * 16 + swz / 64; C = (st & 1) * 32 + (swz % 64) / 2; }
__host__ __device__ __forceinline__ int perm32(int rho) { const int n = rho >> 4, i = rho & 15; return 8 * (i >> 2) + 4 * n + (i & 3); }

struct Unit { int pm, pn; };
struct Gemm { const bf16_t* A; const bf16_t* Bt; int M, N, K; };

struct StaticOrder {
    int nM, nN, nwg, G, c;
    __host__ __device__ void init(int M, int N, int G_, int c_) { nM = M / BM; nN = N / BM; nwg = nM * nN; G = G_; c = c_; }
    __host__ __device__ bool next(int i, Unit& u) const {
        const long L = (long)i * G + c; if (L >= nwg) return false;
        int wgid = (int)L; { const int q = nwg / NXCD, r = nwg % NXCD, xcd = wgid % NXCD, off = wgid / NXCD; wgid = (xcd < r ? xcd * (q + 1) : r * (q + 1) + (xcd - r) * q) + off; }
        const int nig = WGM * nN, gid = wgid / nig, fm = gid * WGM, gsz = (nM - fm) < WGM ? (nM - fm) : WGM;
        u.pm = fm + ((wgid % nig) % gsz); u.pn = (wgid % nig) / gsz; return true;
    }
    __device__ __forceinline__ void a_ready(const Unit&) const {}
    __device__ __forceinline__ void done(const Unit&) const {}
};


__device__ __forceinline__ unsigned cvt_pk_bf16(float lo, float hi) { unsigned r; asm volatile("v_cvt_pk_bf16_f32 %0, %1, %2" : "=v"(r) : "v"(lo), "v"(hi)); return r; }
__device__ __forceinline__ u32x4 pack8(const f32x4 v0, const f32x4 v1) { u32x4 w; w.x = cvt_pk_bf16(v0[0], v0[1]); w.y = cvt_pk_bf16(v0[2], v0[3]); w.z = cvt_pk_bf16(v1[0], v1[1]); w.w = cvt_pk_bf16(v1[2], v1[3]); return w; }
__device__ __forceinline__ float bflo(unsigned w) { return __uint_as_float(w << 16); }
__device__ __forceinline__ float bfhi(unsigned w) { return __uint_as_float(w & 0xffff0000u); }
__device__ __forceinline__ float sigm(float v) { return __builtin_amdgcn_rcpf(1.0f + __builtin_amdgcn_exp2f(v * -1.4426950408889634f)); }
__device__ __forceinline__ f32x4 sigm4(const f32x4 v) { return (f32x4){sigm(v[0]), sigm(v[1]), sigm(v[2]), sigm(v[3])}; }

struct EpiIn {
    static constexpr bool PERM = true, AFTER_DRAIN = false; static constexpr int MID_T = 0;
    const float* rstd; bf16_t* QKVG; size_t stride4; bf16_t* Z; bf16_t* SG; size_t strideSG; float c2;
    __device__ __forceinline__ void operator()(const f32x4 (&acc)[2][2][4][2], const Unit& u, int wr, int wc, int fr, int fq) const {
        int row0 = u.pm * BM + wr * 64 + fr; asm volatile("" : "+v"(row0)); const int cl = wc * 32 + 8 * fq, pn = u.pn;
        if (pn < 8) {
            bf16_t* base = QKVG + (size_t)(pn >> 1) * stride4; const int colt = (pn & 1) * 256 + cl; const float s0 = pn < 2 ? c2 : 1.f;
#pragma unroll
            for (int ai = 0; ai < 2; ++ai)
#pragma unroll
                for (int m = 0; m < 4; ++m) { const int row = row0 + ai * HALF + m * 16; const float sc = rstd[row] * s0; bf16_t* rowp = base + (size_t)row * 512 + colt;
#pragma unroll
                    for (int bj = 0; bj < 2; ++bj) *(u32x4*)(rowp + bj * HALF) = pack8(acc[ai][bj][m][0] * sc, acc[ai][bj][m][1] * sc);
                    asm volatile("" ::: "memory"); }
        } else if (pn < 12) {
            const int colt = (pn - 8) * 128 + cl;
#pragma unroll
            for (int ai = 0; ai < 2; ++ai)
#pragma unroll
                for (int m = 0; m < 4; ++m) { const int row = row0 + ai * HALF + m * 16; const float r = rstd[row], sc = r * r;
                    *(u32x4*)(Z + (size_t)row * 512 + colt) = pack8(acc[ai][0][m][0] * acc[ai][1][m][0] * sc, acc[ai][0][m][1] * acc[ai][1][m][1] * sc);
                    asm volatile("" ::: "memory"); }
        } else {
            bf16_t* base = SG + (size_t)((pn - 12) >> 2) * strideSG; const int colt = ((pn - 12) & 3) * 256 + cl;
#pragma unroll
            for (int ai = 0; ai < 2; ++ai)
#pragma unroll
                for (int m = 0; m < 4; ++m) { const int row = row0 + ai * HALF + m * 16; const float r = rstd[row]; bf16_t* rowp = base + (size_t)row * 1024 + colt;
#pragma unroll
                    for (int bj = 0; bj < 2; ++bj) { *(u32x4*)(rowp + bj * HALF) = pack8(sigm4(acc[ai][bj][m][0] * r), sigm4(acc[ai][bj][m][1] * r)); asm volatile("" ::: "memory"); } }
        }
    }
};
struct EpiPlain {
    static constexpr bool PERM = true, AFTER_DRAIN = false; static constexpr int MID_T = 0;
    bf16_t* O; int ldc;
    __device__ __forceinline__ void operator()(const f32x4 (&acc)[2][2][4][2], const Unit& u, int wr, int wc, int fr, int fq) const {
        int row0 = u.pm * BM + wr * 64 + fr; asm volatile("" : "+v"(row0)); const int col0 = u.pn * BM + wc * 32 + 8 * fq;
#pragma unroll
        for (int ai = 0; ai < 2; ++ai)
#pragma unroll
            for (int m = 0; m < 4; ++m) { bf16_t* rowp = O + (size_t)(row0 + ai * HALF + m * 16) * ldc + col0;
#pragma unroll
                for (int bj = 0; bj < 2; ++bj) *(u32x4*)(rowp + bj * HALF) = pack8(acc[ai][bj][m][0], acc[ai][bj][m][1]); }
    }
};
struct EpiBranch {
    static constexpr bool PERM = true, AFTER_DRAIN = false; static constexpr int MID_T = 8;
    const bf16_t *SGA, *SGC; bf16_t* MG;
    __device__ __forceinline__ void mid(f32x4 (&acc)[2][2][4][2], const Unit& u, int wr, int wc, int fr, int fq) const {
        int row0 = u.pm * BM + wr * 64 + fr; asm volatile("" : "+v"(row0)); const int col0 = u.pn * BM + wc * 32 + 8 * fq;
#pragma unroll
        for (int ai = 0; ai < 2; ++ai) {
            u32x4 a[4][2], c[4][2];
#pragma unroll
            for (int m = 0; m < 4; ++m)
#pragma unroll
                for (int bj = 0; bj < 2; ++bj) { const size_t off = (size_t)(row0 + ai * HALF + m * 16) * 1024 + col0 + bj * HALF; a[m][bj] = *(const u32x4*)(SGA + off); c[m][bj] = *(const u32x4*)(SGC + off); }
#pragma unroll
            for (int m = 0; m < 4; ++m)
#pragma unroll
                for (int bj = 0; bj < 2; ++bj) { const u32x4 av = a[m][bj], cv = c[m][bj]; f32x4 r0, r1;
                    r0[0] = bflo(av[0]) * __builtin_amdgcn_rcpf(bflo(cv[0])); r0[1] = bfhi(av[0]) * __builtin_amdgcn_rcpf(bfhi(cv[0])); r0[2] = bflo(av[1]) * __builtin_amdgcn_rcpf(bflo(cv[1])); r0[3] = bfhi(av[1]) * __builtin_amdgcn_rcpf(bfhi(cv[1]));
                    r1[0] = bflo(av[2]) * __builtin_amdgcn_rcpf(bflo(cv[2])); r1[1] = bfhi(av[2]) * __builtin_amdgcn_rcpf(bfhi(cv[2])); r1[2] = bflo(av[3]) * __builtin_amdgcn_rcpf(bflo(cv[3])); r1[3] = bfhi(av[3]) * __builtin_amdgcn_rcpf(bfhi(cv[3]));
                    acc[ai][bj][m][0] *= r0; acc[ai][bj][m][1] *= r1; }
            asm volatile("" ::: "memory");
        }
    }
    __device__ __forceinline__ void operator()(const f32x4 (&acc)[2][2][4][2], const Unit& u, int wr, int wc, int fr, int fq) const {
        int row0 = u.pm * BM + wr * 64 + fr; asm volatile("" : "+v"(row0)); const int col0 = u.pn * BM + wc * 32 + 8 * fq;
#pragma unroll
        for (int ai = 0; ai < 2; ++ai) {
            u32x4 c[4][2];
#pragma unroll
            for (int m = 0; m < 4; ++m)
#pragma unroll
                for (int bj = 0; bj < 2; ++bj) c[m][bj] = *(const u32x4*)(SGC + (size_t)(row0 + ai * HALF + m * 16) * 1024 + col0 + bj * HALF);
#pragma unroll
            for (int m = 0; m < 4; ++m)
#pragma unroll
                for (int bj = 0; bj < 2; ++bj) { const u32x4 cv = c[m][bj];
                    const f32x4 s0 = {bflo(cv[0]), bfhi(cv[0]), bflo(cv[1]), bfhi(cv[1])}, s1 = {bflo(cv[2]), bfhi(cv[2]), bflo(cv[3]), bfhi(cv[3])};
                    *(u32x4*)(MG + (size_t)(row0 + ai * HALF + m * 16) * 1024 + col0 + bj * HALF) = pack8(acc[ai][bj][m][0] * s0, acc[ai][bj][m][1] * s1); }
            asm volatile("" ::: "memory");
        }
    }
};
struct EpiOut {
    static constexpr bool PERM = true, AFTER_DRAIN = false; static constexpr int MID_T = 0;
    const float* x; bf16_t* XB1; float* SS2;
    __device__ __forceinline__ void operator()(const f32x4 (&acc)[2][2][4][2], const Unit& u, int wr, int wc, int fr, int fq) const {
        int row0 = u.pm * BM + wr * 64 + fr; asm volatile("" : "+v"(row0)); const int col0 = u.pn * BM + wc * 32 + 8 * fq;
#pragma unroll
        for (int ai = 0; ai < 2; ++ai) {
            f32x4 xv[4][2][2];
#pragma unroll
            for (int m = 0; m < 4; ++m)
#pragma unroll
                for (int bj = 0; bj < 2; ++bj) { const float* xp = x + (size_t)(row0 + ai * HALF + m * 16) * 1024 + col0 + bj * HALF; xv[m][bj][0] = *(const f32x4*)xp; xv[m][bj][1] = *(const f32x4*)(xp + 4); }
#pragma unroll
            for (int m = 0; m < 4; ++m) { const int row = row0 + ai * HALF + m * 16; float ss = 0.f;
#pragma unroll
                for (int bj = 0; bj < 2; ++bj) { const f32x4 v0 = acc[ai][bj][m][0] + xv[m][bj][0], v1 = acc[ai][bj][m][1] + xv[m][bj][1];
                    *(u32x4*)(XB1 + (size_t)row * 1024 + col0 + bj * HALF) = pack8(v0, v1);
                    ss += (v0[0] * v0[0] + v0[1] * v0[1]) + (v0[2] * v0[2] + v0[3] * v0[3]) + (v1[0] * v1[0] + v1[1] * v1[1]) + (v1[2] * v1[2] + v1[3] * v1[3]); }
                ss += __shfl_xor(ss, 16); ss += __shfl_xor(ss, 32);
                if (fq == 0) SS2[(size_t)row * 16 + u.pn * 4 + wc] = ss; }
            asm volatile("" ::: "memory");
        }
    }
};
struct EpiPle {
    static constexpr bool PERM = true, AFTER_DRAIN = false; static constexpr int MID_T = 0;
    const float* SS3; const bf16_t* PP; const bf16_t* XB2; float* X; float eps; const PG8_LAS float* rtab;
    __device__ __forceinline__ void operator()(const f32x4 (&acc)[2][2][4][2], const Unit& u, int wr, int wc, int fr, int fq) const {
        int row0 = u.pm * BM + wr * 64 + fr; asm volatile("" : "+v"(row0)); const int col0 = u.pn * BM + wc * 32 + 8 * fq;
#pragma unroll
        for (int ai = 0; ai < 2; ++ai) {
            u32x4 pv[4][2], xb[4][2]; float rr[4];
#pragma unroll
            for (int m = 0; m < 4; ++m) { const int row = row0 + ai * HALF + m * 16;
#pragma unroll
                for (int bj = 0; bj < 2; ++bj) { const size_t off = (size_t)row * 1024 + col0 + bj * HALF; pv[m][bj] = *(const u32x4*)(PP + off); xb[m][bj] = *(const u32x4*)(XB2 + off); }
                if (rtab) rr[m] = rtab[wr * 64 + fr + ai * HALF + m * 16];
                else { const f32x4* sp = (const f32x4*)(SS3 + (size_t)row * 16); const f32x4 q0 = sp[0], q1 = sp[1]; rr[m] = 1.0f / sqrtf((((q0[0] + q0[1]) + (q0[2] + q0[3])) + ((q1[0] + q1[1]) + (q1[2] + q1[3]))) * (1.0f / 1024.0f) + eps); } }
#pragma unroll
            for (int m = 0; m < 4; ++m) { const int row = row0 + ai * HALF + m * 16; const float r = rr[m];
#pragma unroll
                for (int bj = 0; bj < 2; ++bj) { const u32x4 c = pv[m][bj], xq = xb[m][bj]; const size_t off = (size_t)row * 1024 + col0 + bj * HALF;
                    const f32x4 p0 = {bflo(c[0]), bfhi(c[0]), bflo(c[1]), bfhi(c[1])}, p1 = {bflo(c[2]), bfhi(c[2]), bflo(c[3]), bfhi(c[3])};
                    const f32x4 x0 = {bflo(xq[0]), bfhi(xq[0]), bflo(xq[1]), bfhi(xq[1])}, x1 = {bflo(xq[2]), bfhi(xq[2]), bflo(xq[3]), bfhi(xq[3])};
                    *(f32x4*)(X + off) = x0 + sigm4(acc[ai][bj][m][0] * r) * p0; *(f32x4*)(X + off + 4) = x1 + sigm4(acc[ai][bj][m][1] * r) * p1; } }
            asm volatile("" ::: "memory");
        }
    }
};

__device__ __forceinline__ float vmaxf(float a, float b) { float r; asm("v_max_f32_e32 %0, %1, %2" : "=v"(r) : "v"(a), "v"(b)); return r; }
__device__ __forceinline__ float vminf(float a, float b) { float r; asm("v_min_f32_e32 %0, %1, %2" : "=v"(r) : "v"(a), "v"(b)); return r; }
__device__ __forceinline__ void sort16_desc(float (&a)[16]) {
#pragma unroll
    for (int k = 2; k <= 16; k <<= 1)
#pragma unroll
        for (int j = k >> 1; j > 0; j >>= 1)
#pragma unroll
            for (int i = 0; i < 16; ++i) { const int l = i ^ j; if (l > i) { const float hi = vmaxf(a[i], a[l]), lo = vminf(a[i], a[l]); if ((i & k) == 0) { a[i] = hi; a[l] = lo; } else { a[i] = lo; a[l] = hi; } } }
}
template <int L> __device__ __forceinline__ void merge16(float (&a)[16], const float (&b)[16]) {
#pragma unroll
    for (int i = 0; i < 16; ++i) if (15 - i < L) a[i] = vmaxf(a[i], b[15 - i]);
#pragma unroll
    for (int j = 8; j > 0; j >>= 1)
#pragma unroll
        for (int i = 0; i < 16; ++i) { const int l = i ^ j; if (l > i) { const float hi = vmaxf(a[i], a[l]), lo = vminf(a[i], a[l]); a[i] = hi; a[l] = lo; } }
}
struct EpiTopK {
    static constexpr bool PERM = true, AFTER_DRAIN = true; static constexpr int MID_T = 0;
    static constexpr int RS = 260;
    const float* SS2; unsigned short* IDS; float* GATES; float eps;
    __device__ __forceinline__ void fused(f32x4 (&acc)[2][2][4][2], const Unit& u, int wr, int wc, int fr, int fq, PG8_LAS unsigned char* lds, int wid, int lane) const {
        PG8_LAS float* S = (PG8_LAS float*)lds;
        const int tid = wid * 64 + lane, row = tid & 127, grp = tid >> 7, half = grp >> 1, part = grp & 1;
#define TK_BAR() do { asm volatile("s_waitcnt vmcnt(0) lgkmcnt(0)" ::: "memory"); __builtin_amdgcn_s_barrier(); asm volatile("" ::: "memory"); } while (0)
#pragma unroll
        for (int ai = 0; ai < 2; ++ai) {
#pragma unroll
            for (int m = 0; m < 4; ++m)
#pragma unroll
                for (int bj = 0; bj < 2; ++bj)
#pragma unroll
                    for (int n = 0; n < 2; ++n) *(PG8_LAS f32x4*)(S + (wr * 64 + m * 16 + fr) * RS + bj * HALF + wc * 32 + 8 * fq + 4 * n) = acc[ai][bj][m][n];
            TK_BAR();
            float T[16];
#pragma unroll
            for (int b = 0; b < 4; ++b) {
                float c[16];
#pragma unroll
                for (int q = 0; q < 4; ++q) { const f32x4 v = *(const PG8_LAS f32x4*)(S + row * RS + half * 128 + part * 64 + b * 16 + q * 4);
#pragma unroll
                    for (int e = 0; e < 4; ++e) c[q * 4 + e] = __uint_as_float((__float_as_uint(v[e]) & ~127u) | (unsigned)(part * 64 + b * 16 + q * 4 + e)); }
                sort16_desc(c);
                if (b == 0) {
#pragma unroll
                    for (int i = 0; i < 16; ++i) T[i] = c[i];
                } else merge16<16>(T, c);
            }
            TK_BAR();
#pragma unroll
            for (int q = 0; q < 4; ++q) *(PG8_LAS f32x4*)(S + tid * 16 + q * 4) = (f32x4){T[q * 4], T[q * 4 + 1], T[q * 4 + 2], T[q * 4 + 3]};
            TK_BAR();
            if (part == 0) {
                float c[16];
#pragma unroll
                for (int q = 0; q < 4; ++q) { const f32x4 v = *(const PG8_LAS f32x4*)(S + (tid + 128) * 16 + q * 4); c[q * 4] = v[0]; c[q * 4 + 1] = v[1]; c[q * 4 + 2] = v[2]; c[q * 4 + 3] = v[3]; }
                merge16<16>(T, c);
            }
            TK_BAR();
            if (part == 0) {
#pragma unroll
                for (int q = 0; q < 4; ++q) *(PG8_LAS f32x4*)(S + tid * 16 + q * 4) = (f32x4){T[q * 4], T[q * 4 + 1], T[q * 4 + 2], T[q * 4 + 3]};
            }
            TK_BAR();
            if (tid < 128) {
                float a1[16], a2[16];
#pragma unroll
                for (int q = 0; q < 4; ++q) { const f32x4 v = *(const PG8_LAS f32x4*)(S + (tid + 256) * 16 + q * 4);
#pragma unroll
                    for (int e = 0; e < 4; ++e) a2[q * 4 + e] = __uint_as_float(__float_as_uint(v[e]) & ~127u); }
#pragma unroll
                for (int i = 0; i < 16; ++i) a1[i] = __uint_as_float(__float_as_uint(T[i]) & ~127u);
#define TK_SUM(i, j) __uint_as_float((__float_as_uint(a1[i] + a2[j]) & ~255u) | (unsigned)((i) * 16 + (j)))
                float R[16], C[16];
#pragma unroll
                for (int j = 0; j < 16; ++j) R[j] = TK_SUM(0, j);
#pragma unroll
                for (int i = 1; i < 16; ++i) C[i - 1] = TK_SUM(i, 0);
                C[15] = 0.f;
                merge16<15>(R, C);
                C[0] = TK_SUM(1, 1); C[1] = TK_SUM(1, 2); C[2] = TK_SUM(1, 3); C[3] = TK_SUM(1, 4); C[4] = TK_SUM(1, 5); C[5] = TK_SUM(1, 6); C[6] = TK_SUM(1, 7);
                C[7] = TK_SUM(2, 1); C[8] = TK_SUM(2, 2); C[9] = TK_SUM(2, 3); C[10] = TK_SUM(2, 4); C[11] = TK_SUM(3, 1); C[12] = TK_SUM(3, 2); C[13] = TK_SUM(3, 3);
                C[14] = TK_SUM(4, 1); C[15] = TK_SUM(4, 2);
                sort16_desc(C);
                merge16<16>(R, C);
                C[0] = TK_SUM(5, 1); C[1] = TK_SUM(6, 1); C[2] = TK_SUM(7, 1);
                merge16<3>(R, C);
#undef TK_SUM
                const int rowg = u.pm * BM + ai * HALF + row;
                const f32x4* ssp = (const f32x4*)(SS2 + (size_t)rowg * 16); const f32x4 s0 = ssp[0], s1 = ssp[1], s2 = ssp[2], s3 = ssp[3];
                const float ssum = ((s0[0] + s0[1]) + (s0[2] + s0[3])) + ((s1[0] + s1[1]) + (s1[2] + s1[3])) + ((s2[0] + s2[1]) + (s2[2] + s2[3])) + ((s3[0] + s3[1]) + (s3[2] + s3[3]));
                const float rl = 1.4426950408889634f / sqrtf(ssum * (1.0f / 1024.0f) + eps);
                float ev[16], esum = 0.f; int idv[16];
#pragma unroll
                for (int r = 0; r < 16; ++r) { ev[r] = __builtin_amdgcn_exp2f((R[r] - R[0]) * rl); esum += ev[r];
                    const unsigned code = __float_as_uint(R[r]) & 255u;
                    const unsigned k1 = __float_as_uint(S[tid * 16 + (code >> 4)]) & 127u, k2 = __float_as_uint(S[(tid + 256) * 16 + (code & 15u)]) & 127u;
                    idv[r] = (int)(k1 * 128u + k2); }
                const float inv = 1.0f / esum;
                unsigned short* ip = IDS + (size_t)rowg * 128 + u.pn * 16; float* gp = GATES + (size_t)rowg * 128 + u.pn * 16;
#pragma unroll
                for (int q = 0; q < 2; ++q) { u32x4 w; w.x = (unsigned)idv[q * 8] | ((unsigned)idv[q * 8 + 1] << 16); w.y = (unsigned)idv[q * 8 + 2] | ((unsigned)idv[q * 8 + 3] << 16); w.z = (unsigned)idv[q * 8 + 4] | ((unsigned)idv[q * 8 + 5] << 16); w.w = (unsigned)idv[q * 8 + 6] | ((unsigned)idv[q * 8 + 7] << 16);
                    *(u32x4*)(ip + q * 8) = w; }
#pragma unroll
                for (int q = 0; q < 4; ++q) *(f32x4*)(gp + q * 4) = (f32x4){ev[q * 4] * inv, ev[q * 4 + 1] * inv, ev[q * 4 + 2] * inv, ev[q * 4 + 3] * inv};
            }
            TK_BAR();
        }
#undef TK_BAR
    }
};
template <class Epi, class Sched, bool ALIGN_EPI = false, bool SP2 = false>
__device__ __forceinline__ void gemm_phase(PG8_LAS unsigned char* lds, const Gemm g, const Sched& S, const Epi& E) {
    const int tid = threadIdx.x, wid = __builtin_amdgcn_readfirstlane(tid >> 6), lane = tid & 63, wr = wid >> 2, wc = wid & 3, fr = lane & 15, fq = lane >> 4;
    const int K = g.K, nt = K / BK;
    unsigned voffA[2], voffB[2];
#pragma unroll
    for (int i = 0; i < 2; ++i) { int R, C; stage_rc(tid * 16 + i * 8192, R, C); const int Rb = Epi::PERM ? ((R & ~31) + perm32(R & 31)) : R;
        voffA[i] = (unsigned)(R * K + C) * 2u; voffB[i] = (unsigned)(Rb * K + C) * 2u; }
    const size_t kstep = (size_t)(BK * 2);
    const size_t hstep = (size_t)HALF * K * 2;
    const size_t tstep = 2 * hstep;
    const unsigned ldsw = (unsigned)wid * 1024u;
    const int aoff = lds_byte(wr * 64 + fr, fq * 8), boff = lds_byte(wc * 32 + fr, fq * 8);
#define PG8_SA(b, h) (((b) * 2 + (h)) * HTB)
#define PG8_SB(b, h) ((4 + (b) * 2 + (h)) * HTB)
#define PG8_STAGE(bufoff, gbase, voff) do { _Pragma("unroll") for (int _i = 0; _i < 2; ++_i) \
        __builtin_amdgcn_global_load_lds((const unsigned*)((const char*)(gbase) + (voff)[_i]), (PG8_LAS unsigned*)(lds + (bufoff) + ldsw + _i * 8192), 16, 0, 0); } while (0)
#define PG8_LDA(dst, b, h) do { _Pragma("unroll") for (int m = 0; m < 4; ++m) _Pragma("unroll") for (int k = 0; k < 2; ++k) dst[m][k] = *(const PG8_LAS bf16x8*)(lds + PG8_SA(b, h) + aoff + m * 2048 + k * 1024); } while (0)
#define PG8_LDB(dst, b, h) do { _Pragma("unroll") for (int n = 0; n < 2; ++n) _Pragma("unroll") for (int k = 0; k < 2; ++k) dst[n][k] = *(const PG8_LAS bf16x8*)(lds + PG8_SB(b, h) + boff + n * 2048 + k * 1024); } while (0)
#define PG8_MMA(ai, bj, At, Bt) do { __builtin_amdgcn_s_setprio(1); _Pragma("unroll") for (int m = 0; m < 4; ++m) _Pragma("unroll") for (int n = 0; n < 2; ++n) _Pragma("unroll") for (int k = 0; k < 2; ++k) \
        acc[ai][bj][m][n] = __builtin_amdgcn_mfma_f32_16x16x32_bf16(Bt[n][k], At[m][k], acc[ai][bj][m][n], 0, 0, 0); __builtin_amdgcn_s_setprio(0); } while (0)
#define PG8_WAIT_V(n) asm volatile("s_waitcnt vmcnt(" #n ")" ::: "memory")
#define PG8_WAIT_L(n) asm volatile("s_waitcnt lgkmcnt(" #n ")" ::: "memory")
#define PG8_BAR __builtin_amdgcn_s_barrier()
#define PG8_SCHED __builtin_amdgcn_sched_barrier(0)
    Unit cur, nxt; int ui = 0;
    if (!S.next(0, cur)) return;
    f32x4 acc[2][2][4][2];
#pragma unroll
    for (int a = 0; a < 2; ++a)
#pragma unroll
        for (int b = 0; b < 2; ++b)
#pragma unroll
            for (int m = 0; m < 4; ++m)
#pragma unroll
                for (int n = 0; n < 2; ++n) acc[a][b][m][n] = (f32x4){0.f, 0.f, 0.f, 0.f};
    bf16x8 At[4][2], B0[2][2], B1[2][2];
    const char* cA = (const char*)g.A + (size_t)cur.pm * tstep; const char* cB = (const char*)g.Bt + (size_t)cur.pn * tstep;
    S.a_ready(cur);
    if constexpr (SP2) {
        PG8_STAGE(PG8_SB(0, 0), cB, voffB); PG8_STAGE(PG8_SB(0, 1), cB + hstep, voffB); PG8_STAGE(PG8_SA(0, 0), cA, voffA); PG8_STAGE(PG8_SA(0, 1), cA + hstep, voffA);
        if (wr == 1) PG8_BAR;
        PG8_WAIT_V(2); PG8_BAR;
        PG8_STAGE(PG8_SB(1, 0), cB + kstep, voffB); PG8_STAGE(PG8_SA(1, 0), cA + kstep, voffA); PG8_STAGE(PG8_SB(1, 1), cB + hstep + kstep, voffB);
        PG8_WAIT_V(6); PG8_BAR;
    } else {
        PG8_STAGE(PG8_SB(0, 0), cB, voffB); PG8_STAGE(PG8_SA(0, 0), cA, voffA); PG8_STAGE(PG8_SB(0, 1), cB + hstep, voffB); PG8_STAGE(PG8_SA(0, 1), cA + hstep, voffA);
        if (wr == 1) PG8_BAR;
        PG8_WAIT_V(4); PG8_BAR;
        PG8_STAGE(PG8_SB(1, 0), cB + kstep, voffB); PG8_STAGE(PG8_SA(1, 0), cA + kstep, voffA); PG8_STAGE(PG8_SB(1, 1), cB + hstep + kstep, voffB);
        PG8_WAIT_V(6); PG8_BAR;
    }
    for (;;) {
        const bool has_next = S.next(ui + 1, nxt);
        const char* nA = has_next ? (const char*)g.A + (size_t)nxt.pm * tstep : cA; const char* nB = has_next ? (const char*)g.Bt + (size_t)nxt.pn * tstep : cB;
        for (int t = 0; t < nt; t += 2) {
            if constexpr (Epi::MID_T > 0) { if (t == Epi::MID_T) E.mid(acc, cur, wr, wc, fr, fq); }
            const bool last = (t == nt - 2);
            const char* a1 = cA + (size_t)(t + 1) * kstep;
            const char* a2 = last ? nA : cA + (size_t)(t + 2) * kstep; const char* b2 = last ? nB : cB + (size_t)(t + 2) * kstep;
            const char* a3 = a2 + kstep; const char* b3 = b2 + kstep;
            if (last && has_next) S.a_ready(nxt);
            if constexpr (SP2) {
            PG8_LDB(B0, 0, 0); PG8_LDB(B1, 0, 1); PG8_SCHED; PG8_LDA(At, 0, 0); PG8_STAGE(PG8_SA(1, 1), a1 + hstep, voffA);
            PG8_WAIT_V(8); PG8_WAIT_L(0); PG8_BAR; PG8_MMA(0, 0, At, B0); PG8_MMA(0, 1, At, B1); PG8_BAR; PG8_SCHED;
            PG8_LDA(At, 0, 1); PG8_STAGE(PG8_SB(0, 0), b2, voffB); PG8_STAGE(PG8_SB(0, 1), b2 + hstep, voffB); PG8_STAGE(PG8_SA(0, 0), a2, voffA);
            PG8_WAIT_V(8); PG8_WAIT_L(0); PG8_BAR; PG8_MMA(1, 0, At, B0); PG8_MMA(1, 1, At, B1); PG8_BAR; PG8_SCHED;
            PG8_LDB(B0, 1, 0); PG8_LDB(B1, 1, 1); PG8_SCHED; PG8_LDA(At, 1, 0); PG8_STAGE(PG8_SA(0, 1), a2 + hstep, voffA);
            PG8_WAIT_V(8); PG8_WAIT_L(0); PG8_BAR; PG8_MMA(0, 0, At, B0); PG8_MMA(0, 1, At, B1); PG8_BAR; PG8_SCHED;
            PG8_LDA(At, 1, 1); PG8_STAGE(PG8_SB(1, 0), b3, voffB); PG8_STAGE(PG8_SB(1, 1), b3 + hstep, voffB); PG8_STAGE(PG8_SA(1, 0), a3, voffA);
            PG8_WAIT_V(8); PG8_WAIT_L(0); PG8_BAR; PG8_MMA(1, 0, At, B0); PG8_MMA(1, 1, At, B1); PG8_BAR; PG8_SCHED;
            } else {
            PG8_LDB(B0, 0, 0); PG8_SCHED; PG8_LDA(At, 0, 0); PG8_STAGE(PG8_SA(1, 1), a1 + hstep, voffA);
            PG8_WAIT_L(8); PG8_BAR; PG8_WAIT_L(0); PG8_MMA(0, 0, At, B0); PG8_BAR; PG8_SCHED;
            PG8_LDB(B1, 0, 1); PG8_STAGE(PG8_SB(0, 0), b2, voffB);
            PG8_BAR; PG8_WAIT_L(0); PG8_MMA(0, 1, At, B1); PG8_BAR;
            PG8_LDA(At, 0, 1); PG8_STAGE(PG8_SA(0, 0), a2, voffA);
            PG8_BAR; PG8_WAIT_L(0); PG8_MMA(1, 0, At, B0); PG8_BAR; PG8_SCHED;
            PG8_STAGE(PG8_SB(0, 1), b2 + hstep, voffB);
            PG8_WAIT_V(6); PG8_BAR; PG8_MMA(1, 1, At, B1); PG8_BAR;
            PG8_LDB(B0, 1, 0); PG8_SCHED; PG8_LDA(At, 1, 0); PG8_STAGE(PG8_SA(0, 1), a2 + hstep, voffA);
            PG8_WAIT_L(8); PG8_BAR; PG8_WAIT_L(0); PG8_MMA(0, 0, At, B0); PG8_BAR; PG8_SCHED;
            PG8_LDB(B1, 1, 1); PG8_STAGE(PG8_SB(1, 0), b3, voffB);
            PG8_BAR; PG8_WAIT_L(0); PG8_MMA(0, 1, At, B1); PG8_BAR;
            PG8_LDA(At, 1, 1); PG8_STAGE(PG8_SA(1, 0), a3, voffA);
            PG8_BAR; PG8_WAIT_L(0); PG8_MMA(1, 0, At, B0); PG8_BAR; PG8_SCHED;
            PG8_STAGE(PG8_SB(1, 1), b3 + hstep, voffB);
            PG8_WAIT_V(6); PG8_BAR; PG8_MMA(1, 1, At, B1); PG8_BAR;
            }
        }
        if constexpr (ALIGN_EPI) { if (wr == 0) PG8_BAR; }
        if constexpr (!Epi::AFTER_DRAIN) { E(acc, cur, wr, wc, fr, fq); S.done(cur); }
        if (!has_next) break;
#pragma unroll
        for (int a = 0; a < 2; ++a)
#pragma unroll
            for (int b = 0; b < 2; ++b)
#pragma unroll
                for (int m = 0; m < 4; ++m)
#pragma unroll
                    for (int n = 0; n < 2; ++n) acc[a][b][m][n] = (f32x4){0.f, 0.f, 0.f, 0.f};
        cur = nxt; cA = nA; cB = nB; ++ui;
        if constexpr (ALIGN_EPI) { if (wr == 1) PG8_BAR; }
    }
    PG8_WAIT_V(0);
    if constexpr (!ALIGN_EPI) { if (wr == 0) PG8_BAR; }
    PG8_BAR;
    if constexpr (Epi::AFTER_DRAIN) { E.fused(acc, cur, wr, wc, fr, fq, lds, wid, lane); S.done(cur); }
#undef PG8_SA
#undef PG8_SB
#undef PG8_STAGE
#undef PG8_LDA
#undef PG8_LDB
#undef PG8_MMA
#undef PG8_WAIT_V
#undef PG8_WAIT_L
#undef PG8_BAR
#undef PG8_SCHED
}
}
#ifndef PG8_SP2
#define PG8_SP2 true
#endif
#ifndef PG8_ALIGN
#define PG8_ALIGN true
#endif
namespace attn_body {
using bf16=__hip_bfloat16;
using bf16x8=__attribute__((ext_vector_type(8)))short;
using s16x4=__attribute__((ext_vector_type(4)))short;
using f32x16=__attribute__((ext_vector_type(16)))float;
using u32x4=__attribute__((ext_vector_type(4)))unsigned;
using f32x4v=__attribute__((ext_vector_type(4)))float;
constexpr int BATCH=4,NHEAD=8,SEQ=4096,D=64,DM=NHEAD*D,DMO=1024;
constexpr int NW=8,QBLK=32,QB=QBLK*NW,KVBLK=64,NQB=SEQ/QB;
constexpr int ATTN_PITCH=DM, ATTN_UNIT_ROWS=QB;
__device__ __forceinline__ int crow(int r,int hi){return (r&3)+8*(r>>2)+4*hi;}
#define SBAR() __builtin_amdgcn_sched_barrier(0)
__device__ __forceinline__ void cmask(f32x16&p0,f32x16&p1,int jb,int qrel,int hi){
  const float NEG=-INFINITY; int kb=64*jb+4*hi;
  #pragma unroll
  for(int r=0;r<16;++r){int kv=kb+(r&3)+8*(r>>2); if(kv>qrel)p0[r]=NEG; if(kv+32>qrel)p1[r]=NEG;}
}

constexpr int NSLOT=3, SLOTB=8192;
constexpr int LDS_K=0, LDS_V=NSLOT*SLOTB, LDS_WS=2*NSLOT*SLOTB, LDS_OST=LDS_WS+NW*64*4, LDS_CS=LDS_OST+NW*4096, LDS_BYTES=LDS_CS+SEQ*4+64;
constexpr float C2=0.125f*1.4426950408889634f;
__device__ __forceinline__ void glds16(const void*gsrc,unsigned lds_dst){unsigned keep;
  asm volatile("s_mov_b32 %0, m0\n\ts_mov_b32 m0, %2\n\ts_nop 0\n\tglobal_load_lds_dwordx4 %1, off\n\ts_mov_b32 m0, %0":"=&s"(keep):"v"(gsrc),"s"(lds_dst):"memory");}
__device__ __forceinline__ float max3f(float a,float b,float c){float r;asm("v_max3_f32 %0, %1, %2, %3":"=v"(r):"v"(a),"v"(b),"v"(c));return r;}
__device__ __forceinline__ float max2f(float a,float b){float r;asm("v_max_f32_e32 %0, %1, %2":"=v"(r):"v"(a),"v"(b));return r;}
__device__ __forceinline__ float fadd_s(float a,float b){float r;asm("v_add_f32_e32 %0, %1, %2":"=v"(r):"v"(a),"v"(b));return r;}
__device__ __forceinline__ float fsub_s(float a,float b){float r;asm("v_sub_f32_e32 %0, %1, %2":"=v"(r):"v"(a),"v"(b));return r;}
typedef float f32x2_t __attribute__((ext_vector_type(2))); typedef __bf16 bf16x2_t __attribute__((ext_vector_type(2)));
__device__ __forceinline__ unsigned cvtpk_s(float lo,float hi){f32x2_t v={lo,hi};bf16x2_t b=__builtin_convertvector(v,bf16x2_t);return __builtin_bit_cast(unsigned,b);}
#define WAIT_BAR(N) asm volatile("s_waitcnt vmcnt(" #N ") lgkmcnt(0)\n\ts_barrier":::"memory")

__device__ __forceinline__ void qkt(f32x16&p0,f32x16&p1,const char*Kslot,const bf16x8*qr,const f32x16&c0,const f32x16&c1,int r32,int hi){
  const char*kb=Kslot+hi*1024+r32*16;
  #pragma unroll
  for(int d0=0;d0<4;++d0){
    const bf16x8 b0=*reinterpret_cast<const bf16x8*>(kb+d0*2048);
    const bf16x8 b1=*reinterpret_cast<const bf16x8*>(kb+d0*2048+512);
    if(d0==0){p0=__builtin_amdgcn_mfma_f32_32x32x16_bf16(b0,qr[0],c0,0,0,0);p1=__builtin_amdgcn_mfma_f32_32x32x16_bf16(b1,qr[0],c1,0,0,0);}
    else{p0=__builtin_amdgcn_mfma_f32_32x32x16_bf16(b0,qr[d0],p0,0,0,0);p1=__builtin_amdgcn_mfma_f32_32x32x16_bf16(b1,qr[d0],p1,0,0,0);}}
}
typedef __attribute__((address_space(3))) const char* lds_cptr;
typedef short v4i16_t __attribute__((ext_vector_type(4)));
__device__ __forceinline__ void kload8(bf16x8*kf,lds_cptr kp){
  kf[0]=*(const __attribute__((address_space(3))) bf16x8*)(kp);      kf[1]=*(const __attribute__((address_space(3))) bf16x8*)(kp+512);
  kf[2]=*(const __attribute__((address_space(3))) bf16x8*)(kp+2048); kf[3]=*(const __attribute__((address_space(3))) bf16x8*)(kp+2560);
  kf[4]=*(const __attribute__((address_space(3))) bf16x8*)(kp+4096); kf[5]=*(const __attribute__((address_space(3))) bf16x8*)(kp+4608);
  kf[6]=*(const __attribute__((address_space(3))) bf16x8*)(kp+6144); kf[7]=*(const __attribute__((address_space(3))) bf16x8*)(kp+6656);
}
__device__ __forceinline__ void kload2(bf16x8*kf,lds_cptr kp,int j){ kf[2*j]=*(const __attribute__((address_space(3))) bf16x8*)(kp+j*2048); kf[2*j+1]=*(const __attribute__((address_space(3))) bf16x8*)(kp+j*2048+512); }
__device__ __forceinline__ s16x4 vtr(lds_cptr p){ return __builtin_bit_cast(s16x4,__builtin_amdgcn_ds_read_tr16_b64_v4i16((__attribute__((address_space(3))) v4i16_t*)p)); }
__device__ __forceinline__ float rowmax(const f32x16&p0,const f32x16&p1){
  float a=max3f(p0[0],p0[1],p1[0]),b=max3f(p0[2],p0[3],p1[1]);a=max3f(a,p1[2],p1[3]);
  #pragma unroll
  for(int r=4;r<16;r+=4){a=max3f(a,p0[r],p0[r+1]);b=max3f(b,p0[r+2],p0[r+3]);a=max3f(a,p1[r],p1[r+1]);b=max3f(b,p1[r+2],p1[r+3]);}
  const float m=max2f(a,b);
  auto rr=__builtin_amdgcn_permlane32_swap(__float_as_uint(m),__float_as_uint(m),false,false);
  return max2f(__uint_as_float(rr[0]),__uint_as_float(rr[1]));
}
__device__ __forceinline__ void pv(f32x16*o,int vb,bf16x8 pa0,bf16x8 pa1,bf16x8 pa2,bf16x8 pa3){
  #pragma unroll
  for(int d0=0;d0<2;++d0){s16x4 lo[4],hi[4];
    #pragma unroll
    for(int ks=0;ks<4;++ks){
      asm volatile("ds_read_b64_tr_b16 %0,%1 offset:%c2":"=&v"(lo[ks]):"v"(vb),"i"(d0*4096+ks*1024):"memory");
      asm volatile("ds_read_b64_tr_b16 %0,%1 offset:%c2":"=&v"(hi[ks]):"v"(vb),"i"(d0*4096+ks*1024+512):"memory");}
    asm volatile("s_waitcnt lgkmcnt(0)":::"memory");SBAR();
    #define PK(k) (bf16x8){lo[k][0],lo[k][1],lo[k][2],lo[k][3],hi[k][0],hi[k][1],hi[k][2],hi[k][3]}
    o[d0]=__builtin_amdgcn_mfma_f32_32x32x16_bf16(pa0,PK(0),o[d0],0,0,0);
    o[d0]=__builtin_amdgcn_mfma_f32_32x32x16_bf16(pa1,PK(1),o[d0],0,0,0);
    o[d0]=__builtin_amdgcn_mfma_f32_32x32x16_bf16(pa2,PK(2),o[d0],0,0,0);
    o[d0]=__builtin_amdgcn_mfma_f32_32x32x16_bf16(pa3,PK(3),o[d0],0,0,0);
    #undef PK
  }
}

#ifndef ATTN_STORE16
#define ATTN_STORE16(p,v) (*(u32x4*)(p)=(v))
#endif
template<int THRL> __device__ __forceinline__ void attn_unit(int b,int h,int qb,const bf16*Q,const bf16*__restrict__ K,const bf16*__restrict__ V,bf16*O,const float*__restrict__ LFrow,char*shm){
  const int tid=threadIdx.x,lane=tid&63,r32=lane&31,hi=lane>>5; const int wid=__builtin_amdgcn_readfirstlane(tid>>6);
  const long rowbase=(long)b*SEQ; const int q0=qb*QB;
  const bf16*Qw=Q+(rowbase+q0+wid*QBLK)*DM+h*D;
  const bf16*Kh=K+rowbase*DM+h*D,*Vh=V+rowbase*DM+h*D;
  const lds_cptr shm3=(lds_cptr)shm;
  const unsigned lds0=(unsigned)(uintptr_t)shm;
  float*wsf=(float*)(shm+LDS_WS)+wid*64;
  const bf16*ksrc=Kh+(long)lane*DM+wid*8;
  const bf16*vsrc=Vh+(long)(16*(wid&3)+(lane>>2))*DM+(wid>>2)*32+(lane&3)*8;
  const unsigned kdst=lds0+LDS_K+wid*1024, vdst=lds0+LDS_V+wid*1024;
  #define DMA_K(t,slot) glds16(ksrc+(long)(t)*KVBLK*DM,(unsigned)__builtin_amdgcn_readfirstlane(kdst+(slot)))
  #define DMA_V(t,slot) glds16(vsrc+(long)(t)*KVBLK*DM,(unsigned)__builtin_amdgcn_readfirstlane(vdst+(slot)))
  const int vb0=(int)(lds0+LDS_V)+((lane>>4)&1)*32+(lane&3)*8+(4*hi+((lane&15)>>2))*64;
  const char*Kbase=shm+LDS_K; bf16x8 kf[8];
  const lds_cptr kp0=shm3+LDS_K+hi*1024+r32*16; const lds_cptr vp0=shm3+LDS_V+((lane>>4)&1)*32+(lane&3)*8+(4*hi+((lane&15)>>2))*64;
  const int NT=(q0+QB)/KVBLK;
  typedef __attribute__((address_space(3))) float lds_f32; typedef __attribute__((address_space(3))) f32x4v lds_f32x4;
  lds_f32* const csl=(lds_f32*)(shm3+LDS_CS);
  { const int ncs=q0+QB, i0=tid*8; f32x4v ca={0.f,0.f,0.f,0.f},cb={0.f,0.f,0.f,0.f};
    if(i0<ncs){ca=*(const f32x4v*)(LFrow+i0);cb=*(const f32x4v*)(LFrow+i0+4);}
    ca.y+=ca.x;ca.z+=ca.y;ca.w+=ca.z;cb.x+=ca.w;cb.y+=cb.x;cb.z+=cb.y;cb.w+=cb.z;
    const float tot=cb.w; float inc=tot;
    _Pragma("unroll") for(int o_=1;o_<64;o_<<=1){const float v_=__shfl_up(inc,o_);if(lane>=o_)inc+=v_;}
    if(lane==63)csl[SEQ+wid]=inc;
    asm volatile("s_waitcnt vmcnt(0) lgkmcnt(0)\n\ts_barrier":::"memory");
    float base_=inc-tot;
    _Pragma("unroll") for(int w_=0;w_<NW;++w_){const float t_=csl[SEQ+w_];if(w_<wid)base_+=t_;}
    if(i0<ncs){*(lds_f32x4*)(csl+i0)=ca+base_;*(lds_f32x4*)(csl+i0+4)=cb+base_;}
    asm volatile("s_waitcnt vmcnt(0) lgkmcnt(0)\n\ts_barrier":::"memory"); }
  const float cq=csl[q0+wid*QBLK+r32];
  const lds_cptr csb=shm3+LDS_CS+hi*16;
  #define CINIT(C0,C1,t) do{ _Pragma("unroll") for(int g_=0;g_<4;++g_){ const f32x4v a_=*(const lds_f32x4*)(csb+(t)*256+g_*32), b_=*(const lds_f32x4*)(csb+(t)*256+128+g_*32); \
      C0[4*g_]=cqm-a_.x;C0[4*g_+1]=cqm-a_.y;C0[4*g_+2]=cqm-a_.z;C0[4*g_+3]=cqm-a_.w; C1[4*g_]=cqm-b_.x;C1[4*g_+1]=cqm-b_.y;C1[4*g_+2]=cqm-b_.z;C1[4*g_+3]=cqm-b_.w; } }while(0)
  DMA_K(0,0);DMA_V(0,0);DMA_K(1,SLOTB);
  bf16x8 qr[4];
  #pragma unroll
  for(int d0=0;d0<4;++d0)qr[d0]=*reinterpret_cast<const bf16x8*>(&Qw[(long)r32*DM+d0*16+hi*8]);
  float mhat=0.f,l_reg=0.f,cqm=cq;f32x16 o[2];o[0]=f32x16{};o[1]=f32x16{};
  const int qrel=wid*QBLK+r32;
  #define CMASK(P0,P1,t) do{int jb_=(t)-(NT-4); if(jb_>=0)cmask(P0,P1,jb_,qrel,hi);}while(0)
  bool resc=false;
  #define START(P0,P1) do{ const float rm=rowmax(P0,P1); resc=false; \
    { const float dl=rm; mhat=fadd_s(mhat,dl); \
      _Pragma("unroll") for(int r=0;r<16;++r){P0[r]=fsub_s(P0[r],dl);P1[r]=fsub_s(P1[r],dl);} \
      cqm=cq-mhat; } \
    _Pragma("unroll") for(int r=0;r<16;++r)P0[r]=__builtin_amdgcn_exp2f(P0[r]); }while(0)
  #define RESC() do{ if(resc){ asm volatile("s_waitcnt lgkmcnt(0)":::"memory"); \
      _Pragma("unroll") for(int d_=0;d_<2;++d_) _Pragma("unroll") for(int r=0;r<16;++r)o[d_][r]*=wsf[crow(r,hi)]; } }while(0)
  f32x16 pA0,pA1,pB0,pB1;
  int sl_prev=0,sl_cur=0,sl_next=SLOTB;
  #define ROT() do{sl_prev=sl_cur;sl_cur=sl_next;sl_next=(sl_next==(NSLOT-1)*SLOTB)?0:sl_next+SLOTB;}while(0)
  DMA_K(2,2*SLOTB);
  WAIT_BAR(3);
  { f32x16 ci0,ci1; CINIT(ci0,ci1,0); qkt(pA0,pA1,Kbase,qr,ci0,ci1,r32,hi); } asm volatile("s_nop 15\n\ts_nop 7":"+v"(pA0),"+v"(pA1));CMASK(pA0,pA1,0);
  START(pA0,pA1);
  _Pragma("unroll") for(int r=0;r<16;++r)pA1[r]=__builtin_amdgcn_exp2f(pA1[r]);
  WAIT_BAR(0);
  DMA_K(3,0);DMA_V(1,SLOTB);
  ROT();
  kload8(kf,kp0+sl_cur);
  WAIT_BAR(2);
  s16x4 vlo[8],vhi[8]; u32x4 pw0,pw1,pw2,pw3;
  #define PKW(P,B) cvtpk_s(P[B],P[B+1])
  #define PAF(k) __builtin_bit_cast(bf16x8,pw##k)
  #define VFR(i) (bf16x8){vlo[i][0],vlo[i][1],vlo[i][2],vlo[i][3],vhi[i][0],vhi[i][1],vhi[i][2],vhi[i][3]}
  #define PIN(x) asm volatile("":"+v"(x))
  #define MX3(a,b,c) __builtin_fmaxf(__builtin_fmaxf((a),(b)),(c))
  #define GAPA(MF,A0,A1,A2,A3,W0,W1,PW) do{ MF; sacc+=A0; sacc+=A1; sacc+=A2; sacc+=A3; PIN(sacc); W0; W1; PIN(PW); SBAR(); }while(0)
  #define EX(v) __builtin_amdgcn_exp2f(v)
  #define GAPB(MF,X,B) do{ MF; X[B]=EX(X[B]); X[B+1]=EX(X[B+1]); X[B+2]=EX(X[B+2]); X[B+3]=EX(X[B+3]); PIN(X); SBAR(); }while(0)
  #define VRD(i) do{ vlo[i]=vtr(vp_+(((i)>>2)*4096+((i)&3)*1024)); vhi[i]=vtr(vp_+(((i)>>2)*4096+((i)&3)*1024+512)); }while(0)
  #define KRD(G,j) do{ if(G){ kload2(kf,kp0+sl_next,j); SBAR(); } }while(0)
  #define STEP(C0,C1,P0,P1,t,GK,GV,GL) do{ SBAR(); \
    CINIT(C0,C1,t); SBAR(); \
    const lds_cptr vp_=vp0+sl_prev; \
    VRD(0); SBAR(); float sacc=(P0[0]+P0[1]); \
    GAPA(C0=__builtin_amdgcn_mfma_f32_32x32x16_bf16(kf[0],qr[0],C0,0,0,0), P0[2],P0[3],P0[4],P0[5],     pw0[0]=PKW(P0,0), pw0[1]=PKW(P0,2), pw0); \
    VRD(4); SBAR(); GAPA(C1=__builtin_amdgcn_mfma_f32_32x32x16_bf16(kf[1],qr[0],C1,0,0,0), P0[6],P0[7],P0[8],P0[9],     pw0[2]=PKW(P0,4), pw0[3]=PKW(P0,6), pw0); \
    VRD(1); SBAR(); GAPA(C0=__builtin_amdgcn_mfma_f32_32x32x16_bf16(kf[2],qr[1],C0,0,0,0),   P0[10],P0[11],P0[12],P0[13], pw1[0]=PKW(P0,8), pw1[1]=PKW(P0,10), pw1); \
    VRD(5); SBAR(); GAPA(C1=__builtin_amdgcn_mfma_f32_32x32x16_bf16(kf[3],qr[1],C1,0,0,0),   P0[14],P0[15],P1[0],P1[1],   pw1[2]=PKW(P0,12),pw1[3]=PKW(P0,14), pw1); \
    VRD(2); SBAR(); GAPA(C0=__builtin_amdgcn_mfma_f32_32x32x16_bf16(kf[4],qr[2],C0,0,0,0),   P1[2],P1[3],P1[4],P1[5],     pw2[0]=PKW(P1,0), pw2[1]=PKW(P1,2), pw2); \
    VRD(6); SBAR(); GAPA(C1=__builtin_amdgcn_mfma_f32_32x32x16_bf16(kf[5],qr[2],C1,0,0,0),   P1[6],P1[7],P1[8],P1[9],     pw2[2]=PKW(P1,4), pw2[3]=PKW(P1,6), pw2); \
    VRD(3); SBAR(); GAPA(C0=__builtin_amdgcn_mfma_f32_32x32x16_bf16(kf[6],qr[3],C0,0,0,0),   P1[10],P1[11],P1[12],P1[13], pw3[0]=PKW(P1,8), pw3[1]=PKW(P1,10), pw3); \
    VRD(7); SBAR(); GAPA(C1=__builtin_amdgcn_mfma_f32_32x32x16_bf16(kf[7],qr[3],C1,0,0,0),   P1[14],P1[15],0.f,0.f,       pw3[2]=PKW(P1,12),pw3[3]=PKW(P1,14), pw3); \
    l_reg+=sacc; \
    if(GK){DMA_K((t)+3,sl_cur);} if(GV){DMA_V((t)+1,sl_next);} \
    CMASK(C0,C1,t); \
    { float a=MX3(C0[0],C0[1],C1[0]),b=MX3(C0[2],C0[3],C1[1]); a=MX3(a,C1[2],C1[3]); \
      _Pragma("unroll") for(int r=4;r<16;r+=4){a=MX3(a,C0[r],C0[r+1]);b=MX3(b,C0[r+2],C0[r+3]);a=MX3(a,C1[r],C1[r+1]);b=MX3(b,C1[r+2],C1[r+3]);} \
      float rm=__builtin_fmaxf(a,b); { auto rr=__builtin_amdgcn_permlane32_swap(__float_as_uint(rm),__float_as_uint(rm),false,false); rm=__builtin_fmaxf(__uint_as_float(rr[0]),__uint_as_float(rr[1])); } \
      resc=false; \
      if(__builtin_expect(__any(rm>(float)THRL),0)){ const float dl=__builtin_fmaxf(rm,0.f); mhat+=dl; \
        _Pragma("unroll") for(int r=0;r<16;++r){C0[r]-=dl;C1[r]-=dl;} \
        cqm=cq-mhat; \
        const float f=__builtin_amdgcn_exp2f(-dl); l_reg*=f; if(hi==0)wsf[r32]=f; resc=true; } } \
    SBAR(); \
    GAPB(o[0]=__builtin_amdgcn_mfma_f32_32x32x16_bf16(PAF(0),VFR(0),o[0],0,0,0), C0,0); \
    GAPB(o[1]=__builtin_amdgcn_mfma_f32_32x32x16_bf16(PAF(0),VFR(4),o[1],0,0,0), C0,4); \
    KRD(GL,0); GAPB(o[0]=__builtin_amdgcn_mfma_f32_32x32x16_bf16(PAF(1),VFR(1),o[0],0,0,0), C0,8); \
    KRD(GL,1); GAPB(o[1]=__builtin_amdgcn_mfma_f32_32x32x16_bf16(PAF(1),VFR(5),o[1],0,0,0), C0,12); \
    KRD(GL,2); GAPB(o[0]=__builtin_amdgcn_mfma_f32_32x32x16_bf16(PAF(2),VFR(2),o[0],0,0,0), C1,0); \
    KRD(GL,3); GAPB(o[1]=__builtin_amdgcn_mfma_f32_32x32x16_bf16(PAF(2),VFR(6),o[1],0,0,0), C1,4); \
    GAPB(o[0]=__builtin_amdgcn_mfma_f32_32x32x16_bf16(PAF(3),VFR(3),o[0],0,0,0), C1,8); \
    GAPB(o[1]=__builtin_amdgcn_mfma_f32_32x32x16_bf16(PAF(3),VFR(7),o[1],0,0,0), C1,12); \
    }while(0)
  int t=1;
  #undef CMASK
  #define CMASK(P0,P1,t) do{}while(0)
  for(;t+5<NT;t+=2){
    STEP(pB0,pB1,pA0,pA1,t,true,true,true);     WAIT_BAR(2); RESC(); ROT();
    STEP(pA0,pA1,pB0,pB1,t+1,true,true,true);   WAIT_BAR(2); RESC(); ROT();
  }
  #undef CMASK
  #define CMASK(P0,P1,t) do{int jb_=(t)-(NT-4); if(jb_>=0)cmask(P0,P1,jb_,qrel,hi);}while(0)
  #define ENDW(tt) do{ if((tt)+3<NT){WAIT_BAR(2);} else if((tt)+2<NT){WAIT_BAR(1);} else {WAIT_BAR(0);} }while(0)
  for(;t+1<NT;t+=2){
    STEP(pB0,pB1,pA0,pA1,t,(t+3<NT),(t+1<NT),(t+1<NT));       ENDW(t);   RESC(); ROT();
    STEP(pA0,pA1,pB0,pB1,t+1,(t+4<NT),(t+2<NT),(t+2<NT));     ENDW(t+1); RESC(); ROT();
  }
  STEP(pB0,pB1,pA0,pA1,NT-1,false,false,false); RESC();
  { float sacc=pB0[0]+pB0[1]; _Pragma("unroll") for(int r=2;r<16;++r)sacc+=pB0[r]; _Pragma("unroll") for(int r=0;r<16;++r)sacc+=pB1[r]; l_reg+=sacc;
    pw0=(u32x4){PKW(pB0,0),PKW(pB0,2),PKW(pB0,4),PKW(pB0,6)};pw1=(u32x4){PKW(pB0,8),PKW(pB0,10),PKW(pB0,12),PKW(pB0,14)};pw2=(u32x4){PKW(pB1,0),PKW(pB1,2),PKW(pB1,4),PKW(pB1,6)};pw3=(u32x4){PKW(pB1,8),PKW(pB1,10),PKW(pB1,12),PKW(pB1,14)};
    SBAR(); pv(o,vb0+sl_cur,PAF(0),PAF(1),PAF(2),PAF(3)); }
  #undef PKW
  #undef PAF
  #undef VFR
  #undef PIN
  #undef MX3
  #undef GAPA
  #undef GAPB
  #undef EX
  #undef VRD
  #undef KRD
  #undef STEP
  #undef ENDW
  {auto rr=__builtin_amdgcn_permlane32_swap(__float_as_uint(l_reg),__float_as_uint(l_reg),false,false);l_reg=__uint_as_float(rr[0])+__uint_as_float(rr[1]);}
  if(hi==0)wsf[32+r32]=l_reg;asm volatile("s_waitcnt lgkmcnt(0)":::"memory");
  float rli[16];
  #pragma unroll
  for(int r=0;r<16;++r)rli[r]=__builtin_amdgcn_rcpf(wsf[32+crow(r,hi)]);
  bf16*Ow=O+(rowbase+q0+wid*QBLK)*DMO+h*D;
  { bf16*stg=(bf16*)(shm+LDS_OST)+wid*2048;
    #pragma unroll
    for(int r=0;r<16;++r){const int orow=crow(r,hi);
      #pragma unroll
      for(int d0=0;d0<2;++d0)stg[orow*64+d0*32+r32]=__float2bfloat16(o[d0][r]*rli[r]);}
    asm volatile("s_waitcnt lgkmcnt(0)":::"memory");
    #pragma unroll
    for(int i=0;i<4;++i){const int row=i*8+(lane>>3),ch=lane&7; const u32x4 v=*(const u32x4*)(stg+row*64+ch*8); ATTN_STORE16(Ow+(long)row*DMO+ch*8,v);} }
  asm volatile("s_waitcnt lgkmcnt(0)\n\ts_barrier":::"memory");
  #undef DMA_K
  #undef DMA_V
  #undef CMASK
  #undef START
  #undef RESC
  #undef ROT
  #undef CINIT
}
constexpr int ATTN_LDS_BYTES=LDS_BYTES;
struct AttnTensors { const bf16* Q; const bf16* K; const bf16* V; bf16* O; const float* LF; };
struct AttnUnit { int bh; int qb; };
struct StaticOrder {
  int vcu, G;
  __device__ __forceinline__ StaticOrder(int grid,int vcu_):vcu(vcu_),G(grid){}
  __device__ __forceinline__ bool next(int i,AttnUnit&u)const{
    if(G==256){ if(i>=2)return false; const int s=vcu&7; u.bh=vcu>>3; u.qb=(i==0)?15-s:s; return true; }
    const int idx=i*G+vcu; if(idx>=BATCH*NHEAD*NQB)return false; u.qb=NQB-1-idx/(BATCH*NHEAD); u.bh=idx%(BATCH*NHEAD); return true; }
  __device__ __forceinline__ void a_ready(const AttnUnit&)const{}
  __device__ __forceinline__ void done(const AttnUnit&)const{}
};
template<class Sched,int THRL=8> __device__ __forceinline__ void attn_phase(char*lds,const AttnTensors&T,const Sched&S){
  AttnUnit u;
  for(int i=0;S.next(i,u);++i){ S.a_ready(u); attn_unit<THRL>(u.bh/NHEAD,u.bh%NHEAD,u.qb,T.Q,T.K,T.V,T.O,T.LF+(size_t)u.bh*SEQ,lds); S.done(u); }
}
#undef SBAR
#undef WAIT_BAR
}
#define GAS __attribute__((address_space(1)))
#define LAS __attribute__((address_space(3)))
typedef unsigned short bf16;
typedef unsigned v4u __attribute__((ext_vector_type(4)));
typedef float f32x4 __attribute__((ext_vector_type(4)));
typedef short bf16x8 __attribute__((ext_vector_type(8)));
typedef GAS unsigned gu32;
typedef GAS unsigned long long gu64;
#define RLX_AGENT __ATOMIC_RELAXED, __HIP_MEMORY_SCOPE_AGENT
#define LDS_WAIT() asm volatile("s_waitcnt lgkmcnt(0)" ::: "memory")
#define VM_WAIT() asm volatile("s_waitcnt vmcnt(0)" ::: "memory")
__device__ __forceinline__ unsigned long long rt() { return __builtin_amdgcn_s_memrealtime(); }
__device__ __forceinline__ unsigned f2bf(float f) { unsigned u = __builtin_bit_cast(unsigned, f); return (u + 0x7fffu + ((u >> 16) & 1u)) >> 16; }
__device__ __forceinline__ unsigned pk2(float lo, float hi) { return f2bf(lo) | (f2bf(hi) << 16); }

#define XB_TMO      128
#define XB_XCNT(j)  (256  + 64 * (j))
#define XB_XSUB(j)  (1280 + 64 * (j))
#define XB_XGEN(j)  (2304 + 64 * (j))
#define XB_TOP      3328
#define XB_TOPGEN   3392
#define XCD_BAR_WORDS 3456
#define XB_SPIN_CAP (1u << 18)

__device__ __forceinline__ unsigned xb_ld(unsigned* p)              { return __hip_atomic_load(p, __ATOMIC_RELAXED, __HIP_MEMORY_SCOPE_AGENT); }
__device__ __forceinline__ unsigned xb_add(unsigned* p, unsigned v) { return __hip_atomic_fetch_add(p, v, __ATOMIC_RELAXED, __HIP_MEMORY_SCOPE_AGENT); }
__device__ __forceinline__ unsigned xb_xcc_id() { return (unsigned)__builtin_amdgcn_s_getreg((3 << 11) | 20) & 0xFu; }
#define XB_SPIN(cond, bar) do { unsigned _sp = 0; while (cond) { __builtin_amdgcn_s_sleep(1); \
    if ((++_sp & 255u) == 0u) { if (xb_ld(&(bar)[XB_TMO])) break; if (_sp > XB_SPIN_CAP) { atomicAdd(&(bar)[XB_TMO], 1u); break; } } } } while (0)

struct XcdBarrier {
    unsigned* bar; unsigned x;
    volatile LAS unsigned* st;
};

__device__ __forceinline__ XcdBarrier xcd_barrier_post(unsigned* bar, volatile LAS unsigned* st) {
    XcdBarrier b; b.bar = bar; b.x = xb_xcc_id(); b.st = st;
    if (threadIdx.x == 0) (void)xb_add(&bar[XB_XCNT(b.x)], 1u);
    return b;
}
__device__ __forceinline__ void xcd_barrier_complete(unsigned* bar, unsigned x, unsigned& nloc, unsigned& nx) {
    const unsigned G = gridDim.x * gridDim.y * gridDim.z;
    unsigned sum, cnt, mine, sp = 0u;
    for (;;) {
        sum = 0u; cnt = 0u; mine = 0u;
#pragma unroll
        for (unsigned j = 0; j < 16; ++j) { const unsigned c = xb_ld(&bar[XB_XCNT(j)]); sum += c; cnt += (c > 0u) ? 1u : 0u; mine = (j == x) ? c : mine; }
        if (sum == G) break;
        __builtin_amdgcn_s_sleep(1);
        if ((++sp & 255u) == 0u) { if (xb_ld(&bar[XB_TMO])) break; if (sp > XB_SPIN_CAP) { atomicAdd(&bar[XB_TMO], 1u); break; } }
    }
    nloc = mine > 0u ? mine : 1u; nx = cnt > 0u ? cnt : 1u;
}

__device__ __forceinline__ void xcd_barrier(const XcdBarrier& b) {
    asm volatile("s_waitcnt vmcnt(0)" ::: "memory");
    __syncthreads();
    if (threadIdx.x == 0) {
        unsigned* bar = b.bar;
        __builtin_amdgcn_s_waitcnt(0);
        unsigned nloc = b.st[0], nx = b.st[1];
        if (nloc == 0u) { xcd_barrier_complete(bar, b.x, nloc, nx); b.st[0] = nloc; b.st[1] = nx; }
        const unsigned old = xb_add(&bar[XB_XSUB(b.x)], 1u);
        const unsigned gen = old / nloc;
        if (old + 1u == (gen + 1u) * nloc) {
            __builtin_amdgcn_fence(__ATOMIC_RELEASE, "agent");
            asm volatile("s_waitcnt vmcnt(0)" ::: "memory");
            const unsigned og = xb_add(&bar[XB_TOP], 1u);
            const unsigned tg = og / nx;
            if (og + 1u == (tg + 1u) * nx) xb_add(&bar[XB_TOPGEN], 1u);
            else XB_SPIN(xb_ld(&bar[XB_TOPGEN]) == tg, bar);
            __builtin_amdgcn_fence(__ATOMIC_ACQUIRE, "agent");
            xb_add(&bar[XB_XGEN(b.x)], 1u);
            asm volatile("s_waitcnt vmcnt(0)" ::: "memory");
        } else {
            XB_SPIN(xb_ld(&bar[XB_XGEN(b.x)]) == gen, bar);
            __builtin_amdgcn_fence(__ATOMIC_ACQUIRE, "agent");
            asm volatile("s_waitcnt vmcnt(0)" ::: "memory");
        }
    }
    __syncthreads();
}

constexpr int NWAVES = 8;
constexpr int BATCH = 4, SEQ = 4096, D = 1024, M = BATCH * SEQ, NH = 8, HD = 64, AW = 512, PLE = 256;
constexpr int NIN = 5120, INTOT = 5128, NKEYS = 128, NEXP = 16384, NS = 2048;
constexpr float EPS = 1e-6f, LOG2E = 1.4426950408889634f, C2 = 0.125f * LOG2E;
constexpr int NPHASE = 9;
constexpr int SLW = 128, NSL = D / SLW;
static_assert(NSL == 8, "one slice per XCD group; SS3 has 16 slots");

constexpr size_t MiB = 1u << 20;
constexpr size_t WS_CTL = 0, CTL_ZERO_BYTES = 64 * 1024;
constexpr size_t WS_RSTD1 = 1 * MiB, WS_RSTD3 = WS_RSTD1 + 65536, WS_LF = WS_RSTD3 + 65536, WS_CS = WS_LF + 524288, WS_SS2 = WS_CS + 524288, WS_WPP = WS_SS2 + 1048576;
constexpr size_t WS_WQ8 = 20 * MiB, WS_SW = WS_RSTD1;
constexpr size_t WS_SU = WS_RSTD3, WS_SV = WS_WPP + 524288;
static_assert(WS_SV + 65536 <= 4 * MiB, "small region");
constexpr size_t WS_WIN = 4 * MiB, WS_WBR = 14 * MiB, WS_WOUT = 16 * MiB, WS_WS = 18 * MiB, WS_WPG = 22 * MiB, WS_PB = 24 * MiB;
constexpr size_t WS_UB = 32 * MiB, WS_VB = 64 * MiB;
constexpr size_t WS_A = 96 * MiB;
constexpr size_t WS_PP = 128 * MiB;
constexpr size_t WS_Q = 160 * MiB, WS_K = 176 * MiB, WS_V = 192 * MiB, WS_GB = 208 * MiB, WS_Z = 224 * MiB;
constexpr size_t WS_MERGED = 160 * MiB, WS_XB2 = 192 * MiB, WS_IDS = 224 * MiB, WS_GATES = 232 * MiB;
constexpr size_t WS_END = 256 * MiB;
constexpr size_t WS_PART0 = 4 * MiB, WS_PART1 = 160 * MiB, WS_PART2 = 240 * MiB;
constexpr size_t WS_TGC = 32 * MiB, WS_TXC = 64 * MiB, WS_SC = 32 * MiB;
constexpr int CW_BAR = 1024;

constexpr int RING_OFF = 0, RING_BYTES = 135168;
constexpr int LDSCTL_OFF = RING_BYTES, MISC_OFF = LDSCTL_OFF + 320;
constexpr int LDS_BYTES = RING_BYTES + 1024;
static_assert(attn_body::ATTN_LDS_BYTES <= RING_BYTES && pg8::STAGE_BYTES <= RING_BYTES && 128 * pg8::EpiTopK::RS * 4 <= RING_BYTES, "LDS map");

typedef unsigned u32x4 __attribute__((ext_vector_type(4)));
typedef unsigned u32x2 __attribute__((ext_vector_type(2)));
__device__ __forceinline__ float bf2f(bf16 v) { return __uint_as_float((unsigned)v << 16); }
__device__ __forceinline__ float wave_sum(float v) {
#pragma unroll
    for (int o = 1; o < 64; o <<= 1) v += __shfl_xor(v, o);
    return v;
}
__device__ __forceinline__ float sigmoidf_(float v) { return 1.0f / (1.0f + __expf(-v)); }
__host__ __device__ __forceinline__ int src_in(int n) {
    const int pn = n >> 8, l = n & 255;
    if (pn < 6) return n;
    if (pn < 8) return 1544 + (n - 1536);
    if (pn < 12) { const int j = pn - 8; return (l < 128) ? 2056 + 128 * j + l : 2568 + 128 * j + (l - 128); }
    if (pn < 16) return 3080 + (n - 3072);
    return 4104 + (n - 4096);
}

struct Args { const float* in[18]; float* out; unsigned char* ws; int ph_lo, ph_hi, li, pad; };
struct Ctx {
    LAS unsigned char* lds; int wave, vcu, G;
    __device__ __forceinline__ int tid_() const { return (int)threadIdx.x; }
    __device__ __forceinline__ int lane_() const { return (int)threadIdx.x & 63; }
};

__device__ __forceinline__ void tr_item(const float* __restrict__ W, int ldw, int k0, int scol0, const float* __restrict__ g, bf16* WT, int ldt, int drow0, int dk0, LAS float* scr, int lane) {
    float tv[32];
#pragma unroll
    for (int i = 0; i < 32; ++i) { const int kk = 2 * i + (lane >> 5); tv[i] = W[(size_t)(k0 + kk) * ldw + scol0 + (lane & 31)]; }
#pragma unroll
    for (int i = 0; i < 32; ++i) { const int kk = 2 * i + (lane >> 5); float v = tv[i]; if (g) v *= g[k0 + kk]; scr[kk * 33 + (lane & 31)] = v; }
    LDS_WAIT(); asm volatile("" ::: "memory");
    const int c = lane & 7;
#pragma unroll
    for (int j = 0; j < 4; ++j) { const int n = (lane >> 3) + 8 * j; const LAS float* s = scr + (8 * c) * 33 + n;
        v4u o; o.x = pk2(s[0 * 33], s[1 * 33]); o.y = pk2(s[2 * 33], s[3 * 33]); o.z = pk2(s[4 * 33], s[5 * 33]); o.w = pk2(s[6 * 33], s[7 * 33]);
        *(GAS v4u*)(WT + (size_t)(drow0 + n) * ldt + dk0 + 8 * c) = o; }
    LDS_WAIT(); asm volatile("" ::: "memory");
}
__device__ __forceinline__ void p0_prologue(const Ctx& F, const Args& a) {
    unsigned char* ws = a.ws;
    const float *x = a.in[0], *p = a.in[1], *g_mix = a.in[2], *w_in = a.in[3], *b_f = a.in[4], *w_branch = a.in[6], *w_out = a.in[7], *g_ffn = a.in[8], *w_peer_q = a.in[9],
                *pk1 = a.in[10], *pk2_ = a.in[11], *peer_u = a.in[12], *peer_v = a.in[13], *g_ple = a.in[14], *w_ple_gate = a.in[15], *w_ple_proj = a.in[16];
    bf16 *WIN = (bf16*)(ws + WS_WIN), *WBR = (bf16*)(ws + WS_WBR), *WOUT = (bf16*)(ws + WS_WOUT), *WST = (bf16*)(ws + WS_WS), *WPG = (bf16*)(ws + WS_WPG), *WPP = (bf16*)(ws + WS_WPP);
    bf16 *PB = (bf16*)(ws + WS_PB), *UB = (bf16*)(ws + WS_UB), *VB = (bf16*)(ws + WS_VB), *XB = (bf16*)(ws + WS_A);
    float *RSTD1 = (float*)(ws + WS_RSTD1), *LF = (float*)(ws + WS_LF);
    const int gw = F.vcu * NWAVES + F.wave, NGW = F.G * NWAVES, gt = F.vcu * 512 + F.tid_(), NGT = F.G * 512;
    {
        LAS float* KH = (LAS float*)(F.lds + RING_OFF); LAS float* WQ = KH + 128 * 129;
        for (int item = F.vcu; item < 256; item += F.G) {
            const int hh = item >> 4, head = hh >> 1, half = hh & 1, d0 = (item & 15) * 64;
            const float* kh = (half ? pk2_ : pk1) + (size_t)head * 128 * 128;
            float tk[32], tq[16];
#pragma unroll
            for (int i = 0; i < 32; ++i) tk[i] = kh[i * 512 + F.tid_()];
#pragma unroll
            for (int i = 0; i < 16; ++i) { const int idx = i * 512 + F.tid_(); tq[i] = w_peer_q[(size_t)(d0 + (idx >> 7)) * NS + head * 256 + half * 128 + (idx & 127)]; }
#pragma unroll
            for (int i = 0; i < 32; ++i) { const int idx = i * 512 + F.tid_(); KH[(idx >> 7) * 129 + (idx & 127)] = tk[i]; }
#pragma unroll
            for (int i = 0; i < 16; ++i) WQ[i * 512 + F.tid_()] = tq[i];
            __syncthreads();
            const int key = F.tid_() & 127, dg = F.tid_() >> 7;
            float acc[16];
#pragma unroll
            for (int i = 0; i < 16; ++i) acc[i] = 0.f;
            for (int e = 0; e < 128; e += 4) {
                const float k0 = KH[key * 129 + e], k1 = KH[key * 129 + e + 1], k2 = KH[key * 129 + e + 2], k3 = KH[key * 129 + e + 3];
#pragma unroll
                for (int i = 0; i < 16; ++i) { const f32x4 w = *(const LAS f32x4*)(WQ + (dg * 16 + i) * 128 + e); acc[i] += (k0 * w[0] + k1 * w[1]) + (k2 * w[2] + k3 * w[3]); }
            }
            const int dd = d0 + dg * 16;
#pragma unroll
            for (int q = 0; q < 2; ++q) { v4u o; o.x = pk2(acc[8 * q] * g_ffn[dd + 8 * q], acc[8 * q + 1] * g_ffn[dd + 8 * q + 1]); o.y = pk2(acc[8 * q + 2] * g_ffn[dd + 8 * q + 2], acc[8 * q + 3] * g_ffn[dd + 8 * q + 3]);
                o.z = pk2(acc[8 * q + 4] * g_ffn[dd + 8 * q + 4], acc[8 * q + 5] * g_ffn[dd + 8 * q + 5]); o.w = pk2(acc[8 * q + 6] * g_ffn[dd + 8 * q + 6], acc[8 * q + 7] * g_ffn[dd + 8 * q + 7]);
                *(GAS v4u*)(WST + (size_t)(head * 256 + half * 128 + key) * D + dd + 8 * q) = o; }
            __syncthreads();
        }
    }
    {
        LAS float* scr = (LAS float*)(F.lds + RING_OFF + F.wave * 16384);
        constexpr int I_IN = 16 * 160, I_BR = 8 * 32, I_SQ = 16 * 32, I_PP = 4 * 32, NITEMS = I_IN + 2 * I_BR + 2 * I_SQ + I_PP;
        for (int it = gw; it < NITEMS; it += NGW) {
            int r = it;
            if (r < I_IN) { const int kb = r / 160, nb = r % 160; tr_item(w_in, INTOT, 64 * kb, src_in(32 * nb), g_mix, WIN, D, 32 * nb, 64 * kb, scr, F.lane_()); continue; } r -= I_IN;
            if (r < 2 * I_BR) { const int br = r / I_BR, q = r % I_BR, kb = q / 32, nb = q % 32; tr_item(w_branch + (size_t)br * AW * D, D, 64 * kb, 32 * nb, nullptr, WBR, D, 32 * nb, br * AW + 64 * kb, scr, F.lane_()); continue; } r -= 2 * I_BR;
            if (r < I_SQ) { const int kb = r / 32, nb = r % 32; tr_item(w_out, D, 64 * kb, 32 * nb, nullptr, WOUT, D, 32 * nb, 64 * kb, scr, F.lane_()); continue; } r -= I_SQ;
            if (r < I_SQ) { const int kb = r / 32, nb = r % 32; tr_item(w_ple_gate, D, 64 * kb, 32 * nb, g_ple, WPG, D, 32 * nb, 64 * kb, scr, F.lane_()); continue; } r -= I_SQ;
            { const int kb = r / 32, nb = r % 32; tr_item(w_ple_proj, D, 64 * kb, 32 * nb, nullptr, WPP, PLE, 32 * nb, 64 * kb, scr, F.lane_()); }
        }
    }
    __syncthreads();
    {
        LAS float* WFL = (LAS float*)(F.lds + RING_OFF);
#pragma unroll 4
        for (int i = 0; i < 16; ++i) { const int idx = i * 512 + F.tid_(), k = idx >> 3, h = idx & 7; WFL[h * 1024 + k] = g_mix[k] * w_in[(size_t)k * INTOT + 1536 + h]; }
        __syncthreads();
        for (int rb = gw; rb < M; rb += 4 * NGW) {
            f32x4 v[4][4];
#pragma unroll
            for (int r = 0; r < 4; ++r) { const int row = rb + r * NGW; if (row < M) { const GAS f32x4* xr = (const GAS f32x4*)(x + (size_t)row * D);
#pragma unroll
                for (int j = 0; j < 4; ++j) v[r][j] = xr[F.lane_() + 64 * j]; } }
#pragma unroll
            for (int r = 0; r < 4; ++r) { const int row = rb + r * NGW; if (row < M) {
                float ss = 0.f;
#pragma unroll
                for (int j = 0; j < 4; ++j) ss += (v[r][j].x * v[r][j].x + v[r][j].y * v[r][j].y) + (v[r][j].z * v[r][j].z + v[r][j].w * v[r][j].w);
                ss = wave_sum(ss);
                const float rstd = 1.0f / sqrtf(ss * (1.0f / D) + EPS);
                GAS u32x2* o = (GAS u32x2*)(XB + (size_t)row * D);
#pragma unroll
                for (int j = 0; j < 4; ++j) { u32x2 w; w.x = pk2(v[r][j].x, v[r][j].y); w.y = pk2(v[r][j].z, v[r][j].w); o[F.lane_() + 64 * j] = w; }
                if (F.lane_() == 0) RSTD1[row] = rstd;
                float f[8];
#pragma unroll
                for (int h = 0; h < 8; ++h) { float s_ = 0.f;
#pragma unroll
                    for (int j = 0; j < 4; ++j) { const f32x4 w = *(const LAS f32x4*)(WFL + h * 1024 + 4 * (F.lane_() + 64 * j)); s_ += (v[r][j].x * w[0] + v[r][j].y * w[1]) + (v[r][j].z * w[2] + v[r][j].w * w[3]); }
                    f[h] = s_; }
                float r4[4], r2[2], r1;
#pragma unroll
                for (int i = 0; i < 4; ++i) { const float send = (F.lane_() & 32) ? f[i] : f[i + 4], keep = (F.lane_() & 32) ? f[i + 4] : f[i]; r4[i] = keep + __shfl_xor(send, 32); }
#pragma unroll
                for (int i = 0; i < 2; ++i) { const float send = (F.lane_() & 16) ? r4[i] : r4[i + 2], keep = (F.lane_() & 16) ? r4[i + 2] : r4[i]; r2[i] = keep + __shfl_xor(send, 16); }
                { const float send = (F.lane_() & 8) ? r2[0] : r2[1], keep = (F.lane_() & 8) ? r2[1] : r2[0]; r1 = keep + __shfl_xor(send, 8); }
                r1 += __shfl_xor(r1, 4); r1 += __shfl_xor(r1, 2); r1 += __shfl_xor(r1, 1);
                const int hL = ((F.lane_() >> 5) & 1) * 4 + ((F.lane_() >> 4) & 1) * 2 + ((F.lane_() >> 3) & 1);
                const float tot = r1 * rstd + b_f[hL];
                const float ls = fminf(tot, 0.f) - log1pf(__expf(-fabsf(tot)));
                const int b = row / SEQ, t = row % SEQ;
                if ((F.lane_() & 7) == 0) LF[(size_t)(b * NH + hL) * SEQ + t] = ls * LOG2E;
            } }
        }
    }
    {
        constexpr int NU = NEXP * D / 8, NP = M * PLE / 8;
        {
            signed char* UQ = (signed char*)(ws + WS_UB); unsigned char* VQ = (unsigned char*)(ws + WS_VB); float *SU = (float*)(ws + WS_SU), *SV = (float*)(ws + WS_SV);
            f32x4 gq[4];
#pragma unroll
            for (int j = 0; j < 4; ++j) gq[j] = *(const GAS f32x4*)(g_ffn + 16 * F.lane_() + 4 * j);
            for (int rb = gw; rb < 2 * NEXP; rb += 4 * NGW) {
                f32x4 v[4][4];
#pragma unroll
                for (int r = 0; r < 4; ++r) { const int rr = rb + r * NGW; if (rr < 2 * NEXP) { const bool isv = rr >= NEXP; const int e = isv ? rr - NEXP : rr;
                    const GAS f32x4* src = (const GAS f32x4*)((isv ? peer_v : peer_u) + (size_t)e * D + 16 * F.lane_());
#pragma unroll
                    for (int j = 0; j < 4; ++j) v[r][j] = src[j]; } }
#pragma unroll
                for (int r = 0; r < 4; ++r) { const int rr = rb + r * NGW; if (rr < 2 * NEXP) { const bool isv = rr >= NEXP; const int e = isv ? rr - NEXP : rr;
                    float am = 0.f;
#pragma unroll
                    for (int j = 0; j < 4; ++j) { if (!isv) v[r][j] = v[r][j] * gq[j]; am = fmaxf(am, fmaxf(fmaxf(fabsf(v[r][j].x), fabsf(v[r][j].y)), fmaxf(fabsf(v[r][j].z), fabsf(v[r][j].w)))); }
#pragma unroll
                    for (int o = 1; o < 64; o <<= 1) am = fmaxf(am, __shfl_xor(am, o));
                    const float sc = am > 0.f ? 127.0f / am : 0.f; const int off = 0;
                    v4u o;
#pragma unroll
                    for (int j = 0; j < 4; ++j) { const int q0 = (int)rintf(v[r][j].x * sc) + off, q1 = (int)rintf(v[r][j].y * sc) + off, q2 = (int)rintf(v[r][j].z * sc) + off, q3 = (int)rintf(v[r][j].w * sc) + off;
                        o[j] = (unsigned)(q0 & 255) | ((unsigned)(q1 & 255) << 8) | ((unsigned)(q2 & 255) << 16) | ((unsigned)(q3 & 255) << 24); }
                    unsigned char* dst = (isv ? VQ : (unsigned char*)UQ) + ((size_t)(F.lane_() >> 3) * NEXP + e) * SLW + 16 * (F.lane_() & 7);
                    *(GAS v4u*)dst = o;
                    if (F.lane_() == 0) (isv ? SV : SU)[e] = am * (1.0f / 127.0f);
                } }
            }
        }
        for (int i = gt; i < NP; i += NGT) { const f32x4 a = ((const GAS f32x4*)p)[2 * (size_t)i], b = ((const GAS f32x4*)p)[2 * (size_t)i + 1];
            v4u o; o.x = pk2(a.x, a.y); o.y = pk2(a.z, a.w); o.z = pk2(b.x, b.y); o.w = pk2(b.z, b.w); ((GAS v4u*)PB)[i] = o; }
    }
}
__device__ __forceinline__ void p2_conv(const Ctx& F, const bf16* GB, const bf16* Z, const float* cw, bf16* AC) {
    const int gt = F.vcu * 512 + F.tid_(), NGT = F.G * 512;
    for (int i = gt; i < M * AW / 8; i += NGT) {
        const int row = i >> 6, c = (i & 63) * 8, t = row & (SEQ - 1);
        const v4u z2 = *(const GAS v4u*)(Z + (size_t)row * AW + c), g = *(const GAS v4u*)(GB + (size_t)row * AW + c);
        v4u z1 = {0u, 0u, 0u, 0u}, z0 = {0u, 0u, 0u, 0u};
        if (t >= 1) z1 = *(const GAS v4u*)(Z + (size_t)(row - 1) * AW + c);
        if (t >= 2) z0 = *(const GAS v4u*)(Z + (size_t)(row - 2) * AW + c);
        float r[8];
#pragma unroll
        for (int e = 0; e < 4; ++e) {
            const float w0a = cw[c + 2 * e], w0b = cw[c + 2 * e + 1], w1a = cw[AW + c + 2 * e], w1b = cw[AW + c + 2 * e + 1], w2a = cw[2 * AW + c + 2 * e], w2b = cw[2 * AW + c + 2 * e + 1];
            r[2 * e] = __uint_as_float(g[e] << 16) * (w0a * __uint_as_float(z0[e] << 16) + w1a * __uint_as_float(z1[e] << 16) + w2a * __uint_as_float(z2[e] << 16));
            r[2 * e + 1] = __uint_as_float(g[e] & 0xffff0000u) * (w0b * __uint_as_float(z0[e] & 0xffff0000u) + w1b * __uint_as_float(z1[e] & 0xffff0000u) + w2b * __uint_as_float(z2[e] & 0xffff0000u));
        }
        v4u o; o.x = pk2(r[0], r[1]); o.y = pk2(r[2], r[3]); o.z = pk2(r[4], r[5]); o.w = pk2(r[6], r[7]);
        *(GAS v4u*)(AC + (size_t)row * D + AW + c) = o;
    }
}
template <int CTRL> __device__ __forceinline__ int dpp_i(int v) { return __builtin_amdgcn_update_dpp(0, v, CTRL, 0xf, 0xf, true); }
__device__ __forceinline__ int sum8i(int v) { v += dpp_i<0x141>(v); v += dpp_i<0xB1>(v); v += dpp_i<0x4E>(v); return v; }
__device__ __forceinline__ float max8f(float v) { v = fmaxf(v, __uint_as_float((unsigned)dpp_i<0x141>((int)__float_as_uint(v)))); v = fmaxf(v, __uint_as_float((unsigned)dpp_i<0xB1>((int)__float_as_uint(v)))); v = fmaxf(v, __uint_as_float((unsigned)dpp_i<0x4E>((int)__float_as_uint(v)))); return v; }
__device__ __forceinline__ size_t part_slab(int j) { return j < 2 ? WS_PART0 + (size_t)j * 8 * MiB : j < 6 ? WS_PART1 + (size_t)(j - 2) * 8 * MiB : WS_PART2 + (size_t)(j - 6) * 8 * MiB; }
struct P6Geo { int xg, wi, nwv; };
__device__ __forceinline__ P6Geo p6_geo(const Ctx& F) { P6Geo g; const int bx = blockIdx.x; g.xg = bx & 7; g.wi = (bx >> 3) * NWAVES + F.wave; g.nwv = ((F.G - g.xg + 7) >> 3) * NWAVES; return g; }
__device__ __forceinline__ void p6a_upass(const Ctx& F, unsigned char* ws, const bf16* XB1, const unsigned short* IDS) {
    const P6Geo G = p6_geo(F); const int lane = F.lane_(), g = lane >> 3, c = lane & 7;
    for (int sl = G.xg; sl < NSL; sl += 8) {
        float* PART = (float*)(ws + part_slab(sl));
        const GAS unsigned char* Ts = (const GAS unsigned char*)(ws + WS_UB) + (size_t)sl * NEXP * SLW + 16 * c;
        for (int t = G.wi; t < M; t += G.nwv) {
            const v4u xa = *(const GAS v4u*)(XB1 + (size_t)t * D + sl * SLW + 16 * c), xb = *(const GAS v4u*)(XB1 + (size_t)t * D + sl * SLW + 16 * c + 8);
            v4u idp[2];
#pragma unroll
            for (int q = 0; q < 2; ++q) idp[q] = *(const GAS v4u*)(IDS + (size_t)t * 128 + 16 * g + 8 * q);
            v4u u[16];
#pragma unroll
            for (int i = 0; i < 16; ++i) { const unsigned w_ = idp[i >> 3][(i >> 1) & 3]; u[i] = *(const GAS v4u*)(Ts + ((i & 1) ? ((w_ >> 9) & 0x7fff80u) : ((w_ << 7) & 0x7fff80u))); }
            float xf[16];
#pragma unroll
            for (int e = 0; e < 4; ++e) { xf[2 * e] = __uint_as_float(xa[e] << 16); xf[2 * e + 1] = __uint_as_float(xa[e] & 0xffff0000u); xf[8 + 2 * e] = __uint_as_float(xb[e] << 16); xf[8 + 2 * e + 1] = __uint_as_float(xb[e] & 0xffff0000u); }
            float am = 0.f;
#pragma unroll
            for (int e = 0; e < 16; ++e) am = fmaxf(am, fabsf(xf[e]));
            am = max8f(am);
            const float sc = am > 0.f ? 127.0f / am : 0.f, sx = am * (1.0f / 127.0f);
            int qx[4];
#pragma unroll
            for (int j = 0; j < 4; ++j) qx[j] = (int)(((unsigned)((int)rintf(xf[4 * j] * sc) & 255)) | ((unsigned)((int)rintf(xf[4 * j + 1] * sc) & 255) << 8) | ((unsigned)((int)rintf(xf[4 * j + 2] * sc) & 255) << 16) | ((unsigned)((int)rintf(xf[4 * j + 3] * sc) & 255) << 24));
            int r0 = 0, r1 = 0;
#pragma unroll
            for (int i = 0; i < 16; ++i) { int sacc = __builtin_amdgcn_sdot4(qx[0], (int)u[i][0], 0, false); sacc = __builtin_amdgcn_sdot4(qx[1], (int)u[i][1], sacc, false); sacc = __builtin_amdgcn_sdot4(qx[2], (int)u[i][2], sacc, false); sacc = __builtin_amdgcn_sdot4(qx[3], (int)u[i][3], sacc, false);
                sacc = sum8i(sacc);
                if (i < 8) r0 = (c == i) ? sacc : r0; else r1 = (c == i - 8) ? sacc : r1; }
            float* pp = PART + (size_t)t * 128 + 16 * g + c;
            pp[0] = (float)r0 * sx; pp[8] = (float)r1 * sx;
        }
    }
}
__device__ __forceinline__ void p6b_combine(const Ctx& F, unsigned char* ws, float* SS2, const unsigned short* IDS, const float* GATES) {
    const int gw = F.vcu * NWAVES + F.wave, NGW = F.G * NWAVES, lane = F.lane_();
    const float *SU = (const float*)(ws + WS_SU), *SV = (const float*)(ws + WS_SV);
    signed char* WQ8 = (signed char*)(ws + WS_WQ8); float* SW = (float*)(ws + WS_SW);
    for (int tb = gw; tb < M; tb += 2 * NGW) {
        float ssv[2], a0[2], a1[2], g0[2], g1[2]; int i0[2], i1[2];
#pragma unroll
        for (int r = 0; r < 2; ++r) { const int t = tb + r * NGW; if (t < M) {
            ssv[r] = lane < 16 ? SS2[(size_t)t * 16 + lane] : 0.f;
            i0[r] = (int)IDS[(size_t)t * 128 + lane]; i1[r] = (int)IDS[(size_t)t * 128 + 64 + lane];
            g0[r] = GATES[(size_t)t * 128 + lane]; g1[r] = GATES[(size_t)t * 128 + 64 + lane];
            a0[r] = 0.f; a1[r] = 0.f;
#pragma unroll
            for (int j = 0; j < 8; ++j) { const float* pp = (const float*)(ws + part_slab(j)) + (size_t)t * 128; a0[r] += pp[lane]; a1[r] += pp[64 + lane]; } } }
#pragma unroll
        for (int r = 0; r < 2; ++r) { const int t = tb + r * NGW; if (t < M) {
            const float rstd = 1.0f / sqrtf(wave_sum(ssv[r]) * (1.0f / D) + EPS);
            const float x0 = a0[r] * rstd * SU[i0[r]], x1 = a1[r] * rstd * SU[i1[r]];
            const float w0 = g0[r] * 0.5f * x0 * (1.0f + erff(x0 * 0.70710678118654752f)) * SV[i0[r]], w1 = g1[r] * 0.5f * x1 * (1.0f + erff(x1 * 0.70710678118654752f)) * SV[i1[r]];
            float am = fmaxf(fabsf(w0), fabsf(w1));
#pragma unroll
            for (int o = 1; o < 64; o <<= 1) am = fmaxf(am, __shfl_xor(am, o));
            const float sc = am > 0.f ? 127.0f / am : 0.f;
            WQ8[(size_t)t * 128 + lane] = (signed char)(int)rintf(w0 * sc); WQ8[(size_t)t * 128 + 64 + lane] = (signed char)(int)rintf(w1 * sc);
            if (lane == 0) SW[t] = am * (1.0f / 127.0f);
            if (lane < 16) SS2[(size_t)t * 16 + lane] = 0.f;
        } }
    }
}
__device__ __forceinline__ int pl32_sum(int a, int b) { const auto s_ = __builtin_amdgcn_permlane32_swap((unsigned)a, (unsigned)b, false, false); return (int)(s_[0] + s_[1]); }
__device__ __forceinline__ int pl16_sum(int a, int b) { const auto s_ = __builtin_amdgcn_permlane16_swap((unsigned)a, (unsigned)b, false, false); return (int)(s_[0] + s_[1]); }
__device__ __forceinline__ float wave_sum_valu(float v) {
    { const auto s_ = __builtin_amdgcn_permlane32_swap(__float_as_uint(v), __float_as_uint(v), false, false); v = __uint_as_float(s_[0]) + __uint_as_float(s_[1]); }
    { const auto s_ = __builtin_amdgcn_permlane16_swap(__float_as_uint(v), __float_as_uint(v), false, false); v = __uint_as_float(s_[0]) + __uint_as_float(s_[1]); }
    v += __uint_as_float((unsigned)dpp_i<0x128>((int)__float_as_uint(v))); v += __uint_as_float((unsigned)dpp_i<0x124>((int)__float_as_uint(v)));
    v += __uint_as_float((unsigned)dpp_i<0x122>((int)__float_as_uint(v))); v += __uint_as_float((unsigned)dpp_i<0x121>((int)__float_as_uint(v))); return v;
}
__device__ __forceinline__ void p6c_vpass(const Ctx& F, unsigned char* ws, const unsigned short* IDS, const bf16* XB1, bf16* XB2, float* SS3) {
    const P6Geo G = p6_geo(F); const int lane = F.lane_(), g = lane >> 3, c = lane & 7;
    const int ecol = 16 * c + ((lane >> 5) & 1) * 8 + ((lane >> 4) & 1) * 4 + ((lane >> 3) & 1) * 2;
    const signed char* WQ8 = (const signed char*)(ws + WS_WQ8); const float* SW = (const float*)(ws + WS_SW);
#define V_IDS(ID, t_) do { _Pragma("unroll") for (int q = 0; q < 2; ++q) ID[q] = *(const GAS v4u*)(IDS + (size_t)(t_) * 128 + 16 * g + 8 * q); } while (0)
#define V_W(WV, t_) do { WV = *(const GAS v4u*)(WQ8 + (size_t)(t_) * 128 + 16 * g); } while (0)
#define V_GATHER(R, ID) do { _Pragma("unroll") for (int i = 0; i < 16; ++i) { const unsigned w_ = ID[i >> 3][(i >> 1) & 3]; R[i] = *(const GAS v4u*)(Ts + (size_t)((((i & 1) ? (w_ >> 9) : (w_ << 7)) & 0x7fff80u) | c16)); } } while (0)
#define V_COMPUTE(R, WV, t_) do { \
        const size_t o_ = (size_t)(t_) * D + sl * SLW + ecol; \
        const unsigned xq_ = *(const GAS unsigned*)(XB1 + o_); const float sw_ = SW[t_]; \
        int acc[16]; \
        _Pragma("unroll") for (int e = 0; e < 16; ++e) acc[e] = 0; \
        _Pragma("unroll") for (int j = 0; j < 4; ++j) \
            _Pragma("unroll") for (int b = 0; b < 4; ++b) { \
                const unsigned r0_ = R[4 * j][b], r1_ = R[4 * j + 1][b], r2_ = R[4 * j + 2][b], r3_ = R[4 * j + 3][b]; \
                const unsigned x01 = __builtin_amdgcn_perm(r1_, r0_, 0x05010400u), y01 = __builtin_amdgcn_perm(r1_, r0_, 0x07030602u), x23 = __builtin_amdgcn_perm(r3_, r2_, 0x05010400u), y23 = __builtin_amdgcn_perm(r3_, r2_, 0x07030602u); \
                acc[4 * b]     = __builtin_amdgcn_sdot4((int)__builtin_amdgcn_perm(x23, x01, 0x05040100u), (int)WV[j], acc[4 * b], false); \
                acc[4 * b + 1] = __builtin_amdgcn_sdot4((int)__builtin_amdgcn_perm(x23, x01, 0x07060302u), (int)WV[j], acc[4 * b + 1], false); \
                acc[4 * b + 2] = __builtin_amdgcn_sdot4((int)__builtin_amdgcn_perm(y23, y01, 0x05040100u), (int)WV[j], acc[4 * b + 2], false); \
                acc[4 * b + 3] = __builtin_amdgcn_sdot4((int)__builtin_amdgcn_perm(y23, y01, 0x07060302u), (int)WV[j], acc[4 * b + 3], false); } \
        int r8[8], r4[4], r2[2]; \
        _Pragma("unroll") for (int i = 0; i < 8; ++i) r8[i] = pl32_sum(acc[i], acc[i + 8]); \
        _Pragma("unroll") for (int i = 0; i < 4; ++i) r4[i] = pl16_sum(r8[i], r8[i + 4]); \
        _Pragma("unroll") for (int i = 0; i < 2; ++i) { const int send = (lane & 8) ? r4[i] : r4[i + 2], keep = (lane & 8) ? r4[i + 2] : r4[i]; r2[i] = keep + dpp_i<0x128>(send); } \
        const float x0_ = __uint_as_float(xq_ << 16) + sw_ * (float)r2[0], x1_ = __uint_as_float(xq_ & 0xffff0000u) + sw_ * (float)r2[1]; \
        *(GAS unsigned*)(XB2 + o_) = pk2(x0_, x1_); \
        const float ss = wave_sum_valu(x0_ * x0_ + x1_ * x1_); \
        if (lane == 0) SS3[(size_t)(t_) * 16 + sl] = ss; } while (0)
#define V_FENCE() asm volatile("" ::: "memory")
    for (int sl = G.xg; sl < NSL; sl += 8) {
        const GAS unsigned char* Ts = (const GAS unsigned char*)(ws + WS_VB) + (size_t)sl * NEXP * SLW; const unsigned c16 = 16u * (unsigned)c;
        const int nk = (M - G.wi + G.nwv - 1) / G.nwv, t0 = G.wi, dt = G.nwv;
        v4u idA[2], idB[2]; v4u wA, wB; v4u rA[16], rB[16];
        if (nk > 0) { V_IDS(idA, t0); V_GATHER(rA, idA); V_W(wA, t0); }
        if (nk > 1) V_IDS(idB, t0 + dt);
        V_FENCE();
        for (int k = 0; k < nk; k += 2) {
            if (k + 1 < nk) { V_GATHER(rB, idB); V_W(wB, t0 + (k + 1) * dt); }
            if (k + 2 < nk) V_IDS(idA, t0 + (k + 2) * dt);
            V_FENCE();
            V_COMPUTE(rA, wA, t0 + k * dt);
            V_FENCE();
            if (k + 2 < nk) { V_GATHER(rA, idA); V_W(wA, t0 + (k + 2) * dt); }
            if (k + 3 < nk) V_IDS(idB, t0 + (k + 3) * dt);
            V_FENCE();
            if (k + 1 < nk) V_COMPUTE(rB, wB, t0 + (k + 1) * dt);
            V_FENCE();
        }
    }
#undef V_IDS
#undef V_W
#undef V_GATHER
#undef V_COMPUTE
#undef V_FENCE
}
__device__ __forceinline__ void p8_final(const Ctx& F, float* X, const float* g) {
    const int gw = F.vcu * NWAVES + F.wave, NGW = F.G * NWAVES;
    for (int row = gw; row < M; row += NGW) {
        GAS f32x4* xr = (GAS f32x4*)(X + (size_t)row * D); f32x4 v[4]; float ss = 0.f;
#pragma unroll
        for (int j = 0; j < 4; ++j) { v[j] = xr[F.lane_() + 64 * j]; ss += (v[j].x * v[j].x + v[j].y * v[j].y) + (v[j].z * v[j].z + v[j].w * v[j].w); }
        ss = wave_sum(ss); const float rstd = 1.0f / sqrtf(ss * (1.0f / D) + EPS);
#pragma unroll
        for (int j = 0; j < 4; ++j) { const f32x4 gv = ((const GAS f32x4*)g)[F.lane_() + 64 * j]; xr[F.lane_() + 64 * j] = v[j] * rstd * gv; }
    }
}
struct OneUnit {
    pg8::Unit u;
    __device__ __forceinline__ bool next(int i, pg8::Unit& o) const { if (i != 0) return false; o = u; return true; }
    __device__ __forceinline__ void a_ready(const pg8::Unit&) const {}
    __device__ __forceinline__ void done(const pg8::Unit&) const {}
};

__global__ void __launch_bounds__(NWAVES * 64, 2) mk_fwd(Args args) {
    extern __shared__ __attribute__((aligned(16))) unsigned char lds[];
    Ctx F;
    F.lds = (LAS unsigned char*)lds;
    F.wave = __builtin_amdgcn_readfirstlane((int)threadIdx.x >> 6);
    F.G = gridDim.x; { const int bx = blockIdx.x; F.vcu = (F.G % 8 == 0) ? (bx % 8) * (F.G / 8) + bx / 8 : bx; }
    volatile LAS unsigned* MISC = (volatile LAS unsigned*)(F.lds + MISC_OFF);
    unsigned char* ws = args.ws;
    gu32* ctl = (gu32*)(ws + WS_CTL);
    for (int u = F.tid_(); u < (LDS_BYTES - LDSCTL_OFF) / 4; u += NWAVES * 64) ((LAS unsigned*)(F.lds + LDSCTL_OFF))[u] = 0u;
    __syncthreads();
    const int lo = args.ph_lo, hi = args.ph_hi;
    const bool multi = (hi - lo) > 1 || (lo <= 6 && 6 < hi);
    XcdBarrier bar; bar.bar = (unsigned*)(ctl + CW_BAR) + args.li * XCD_BAR_WORDS; bar.x = 0; bar.st = nullptr;
    if (multi) bar = xcd_barrier_post((unsigned*)(ctl + CW_BAR) + args.li * XCD_BAR_WORDS, MISC + 8);
#ifndef MK_CMASK
#define MK_CMASK 0x1ff
#endif
#define IN(k) (((MK_CMASK >> (k)) & 1) && lo <= (k) && (k) < hi)
#define SEAM(k) do { if (IN(k) && IN((k) + 1)) xcd_barrier(bar); STAMP(); } while (0)
#ifdef MK_PROBE_SEG
    int n_stamp = 0;
#define STAMP() do { if (blockIdx.x == 0 && F.tid_() == 0) { const unsigned long long t_ = __builtin_amdgcn_s_memrealtime(); MISC[16 + 2 * n_stamp] = (unsigned)t_; MISC[17 + 2 * n_stamp] = (unsigned)(t_ >> 32); } ++n_stamp; } while (0)
    STAMP();
#else
#define STAMP() do { } while (0)
#endif
    float* out = args.out;
#define WSP(T, off) ((T*)(ws + (off)))
#define RSTD1 WSP(float, WS_RSTD1)
#define SS2 WSP(float, WS_SS2)
#define LF WSP(float, WS_LF)
#define WIN WSP(bf16, WS_WIN)
#define WBR WSP(bf16, WS_WBR)
#define WOUT WSP(bf16, WS_WOUT)
#define WST WSP(bf16, WS_WS)
#define WPG WSP(bf16, WS_WPG)
#define WPP WSP(bf16, WS_WPP)
#define PB WSP(bf16, WS_PB)
#define XB WSP(bf16, WS_A)
#define AC WSP(bf16, WS_A)
#define XB1 WSP(bf16, WS_A)
#define PP WSP(bf16, WS_PP)
#define Q WSP(bf16, WS_Q)
#define K WSP(bf16, WS_K)
#define V WSP(bf16, WS_V)
#define GB WSP(bf16, WS_GB)
#define Z WSP(bf16, WS_Z)
#define MG WSP(bf16, WS_MERGED)
#define XB2 WSP(bf16, WS_XB2)
#define IDS WSP(unsigned short, WS_IDS)
#define GATES WSP(float, WS_GATES)
#define SGA ((bf16*)out)
#define SGC ((bf16*)out + (size_t)M * D)

    if (IN(0)) { p0_prologue(F, args); }
    SEAM(0);
    if (IN(1)) {
        { pg8::Gemm g{XB, WIN, M, NIN, D}; pg8::StaticOrder S; S.init(M, NIN, F.G, (int)blockIdx.x);
          pg8::EpiIn E{RSTD1, Q, (size_t)(WS_K - WS_Q) / 2, Z, SGA, (size_t)M * D, C2};
          static_assert(WS_V - WS_K == WS_K - WS_Q && WS_GB - WS_V == WS_K - WS_Q, "Q | K | V | GB equally spaced");
          pg8::gemm_phase<pg8::EpiIn, pg8::StaticOrder, PG8_ALIGN, PG8_SP2>(F.lds + RING_OFF, g, S, E); }
        { pg8::Gemm g{PB, WPP, M, D, PLE}; pg8::StaticOrder S; S.init(M, D, F.G, (int)blockIdx.x);
          pg8::EpiPlain E{PP, D};
          pg8::gemm_phase<pg8::EpiPlain, pg8::StaticOrder, PG8_ALIGN, PG8_SP2>(F.lds + RING_OFF, g, S, E); }
    }
    SEAM(1);
    if (IN(2)) {
        p2_conv(F, GB, Z, args.in[5], AC);
        const attn_body::AttnTensors AT{(const attn_body::bf16*)Q, (const attn_body::bf16*)K, (const attn_body::bf16*)V, (attn_body::bf16*)AC, LF};
        const attn_body::StaticOrder S((int)F.G, F.vcu);
        attn_body::attn_phase<attn_body::StaticOrder>((char*)lds + RING_OFF, AT, S);
    }
    SEAM(2);
    if (IN(3)) {
        pg8::Gemm g{AC, WBR, M, D, D}; pg8::StaticOrder S; S.init(M, D, F.G, (int)blockIdx.x);
        pg8::EpiBranch E{SGA, SGC, MG};
        pg8::gemm_phase<pg8::EpiBranch, pg8::StaticOrder, PG8_ALIGN, PG8_SP2>(F.lds + RING_OFF, g, S, E);
    }
    SEAM(3);
    if (IN(4)) {
        pg8::Gemm g{MG, WOUT, M, D, D}; pg8::StaticOrder S; S.init(M, D, F.G, (int)blockIdx.x);
        pg8::EpiOut E{args.in[0], XB1, SS2};
        pg8::gemm_phase<pg8::EpiOut, pg8::StaticOrder, PG8_ALIGN, PG8_SP2>(F.lds + RING_OFF, g, S, E);
    }
    SEAM(4);
    if (IN(5)) {
        pg8::Gemm g{XB1, WST, M, NS, D}; pg8::StaticOrder S; S.init(M, NS, F.G, (int)blockIdx.x);
        pg8::EpiTopK E{SS2, IDS, GATES, EPS};
        pg8::Unit u;
        for (int i = 0; S.next(i, u); ++i) { OneUnit O{u}; pg8::gemm_phase<pg8::EpiTopK, OneUnit, false, PG8_SP2>(F.lds + RING_OFF, g, O, E); }
    }
    SEAM(5);
    if (IN(6)) { p6a_upass(F, ws, XB1, IDS); xcd_barrier(bar); STAMP(); p6b_combine(F, ws, SS2, IDS, GATES); xcd_barrier(bar); STAMP(); p6c_vpass(F, ws, IDS, XB1, XB2, SS2); }
    SEAM(6);
    if (IN(7)) {
        pg8::Gemm g{XB2, WPG, M, D, D}; pg8::StaticOrder S; S.init(M, D, F.G, (int)blockIdx.x);
        LAS float* rtab = (LAS float*)(F.lds + RING_OFF + pg8::STAGE_BYTES);
        const bool one = (M / 256) * (D / 256) <= F.G; pg8::Unit u0;
        if (one && S.next(0, u0) && F.tid_() < 256) { const float* sp = SS2 + (size_t)(u0.pm * 256 + F.tid_()) * 16; float q = 0.f;
#pragma unroll
            for (int j = 0; j < NSL; ++j) q += sp[j];
            rtab[F.tid_()] = 1.0f / sqrtf(q * (1.0f / D) + EPS); }
        __syncthreads();
        pg8::EpiPle E{SS2, PP, XB2, out, EPS, one ? (const LAS float*)rtab : (const LAS float*)nullptr};
        pg8::gemm_phase<pg8::EpiPle, pg8::StaticOrder, PG8_ALIGN, PG8_SP2>(F.lds + RING_OFF, g, S, E);
    }
    SEAM(7);
    if (IN(8)) { p8_final(F, out, args.in[17]); }
    STAMP();
#ifdef MK_PROBE_SEG
    if (blockIdx.x == 0 && F.tid_() == 0) {
        const unsigned long long a_ = ((unsigned long long)MISC[17 + 2 * MK_PROBE_SEG] << 32) | MISC[16 + 2 * MK_PROBE_SEG], b_ = ((unsigned long long)MISC[19 + 2 * MK_PROBE_SEG] << 32) | MISC[18 + 2 * MK_PROBE_SEG];
        const unsigned long long dt_ = (b_ - a_) * MK_PROBE_MULT, t0_ = __builtin_amdgcn_s_memrealtime();
        while (__builtin_amdgcn_s_memrealtime() - t0_ < dt_) __builtin_amdgcn_s_sleep(8);
    }
#endif
#undef IN
#undef SEAM
#undef WSP
#undef RSTD1
#undef SS2
#undef LF
#undef WIN
#undef WBR
#undef WOUT
#undef WST
#undef WPG
#undef WPP
#undef PB
#undef XB
#undef AC
#undef XB1
#undef PP
#undef Q
#undef K
#undef V
#undef GB
#undef Z
#undef MG
#undef XB2
#undef IDS
#undef GATES
#undef SGA
#undef SGC
}
namespace gold {
__global__ void __launch_bounds__(256) k_rows0(const float* x, const float* w_in, const float* g_mix, const float* b_f, bf16* XB, float* RSTD1, float* LF) {
    const int lane = threadIdx.x & 63, row = blockIdx.x * 4 + (threadIdx.x >> 6);
    const f32x4* xr = (const f32x4*)(x + (size_t)row * D);
    f32x4 v[4]; float ss = 0.f;
#pragma unroll
    for (int j = 0; j < 4; ++j) { v[j] = xr[lane + 64 * j]; ss += v[j].x * v[j].x + v[j].y * v[j].y + v[j].z * v[j].z + v[j].w * v[j].w; }
    ss = wave_sum(ss);
    const float rstd = 1.0f / sqrtf(ss * (1.0f / D) + EPS);
    u32x2* o = (u32x2*)(XB + (size_t)row * D);
#pragma unroll
    for (int j = 0; j < 4; ++j) { u32x2 w; w.x = pk2(v[j].x, v[j].y); w.y = pk2(v[j].z, v[j].w); o[lane + 64 * j] = w; }
    if (lane == 0) RSTD1[row] = rstd;
    float f[8];
#pragma unroll
    for (int h = 0; h < 8; ++h) f[h] = 0.f;
#pragma unroll
    for (int j = 0; j < 4; ++j)
#pragma unroll
        for (int e = 0; e < 4; ++e) {
            const int k = 4 * (lane + 64 * j) + e; const float xv = v[j][e] * g_mix[k];
            const f32x4 w0 = *(const f32x4*)(w_in + (size_t)k * INTOT + 1536), w1 = *(const f32x4*)(w_in + (size_t)k * INTOT + 1540);
            f[0] += xv * w0.x; f[1] += xv * w0.y; f[2] += xv * w0.z; f[3] += xv * w0.w; f[4] += xv * w1.x; f[5] += xv * w1.y; f[6] += xv * w1.z; f[7] += xv * w1.w;
        }
    const int b = row / SEQ, t = row % SEQ;
#pragma unroll
    for (int h = 0; h < 8; ++h) {
        const float tot = wave_sum(f[h]) * rstd + b_f[h];
        const float ls = fminf(tot, 0.f) - log1pf(__expf(-fabsf(tot)));
        if (lane == 0) LF[(size_t)(b * NH + h) * SEQ + t] = ls * LOG2E;
    }
}
template <int MODE> __global__ void k_wt(const float* W, int ldw, const float* g, bf16* Wt, int N, int K, int koff, int ldt) {
    const size_t i = (size_t)blockIdx.x * blockDim.x + threadIdx.x; if (i >= (size_t)N * K) return;
    const int n = (int)(i / K), k = (int)(i % K);
    const int s = MODE == 1 ? src_in(n) : n;
    const float gv = g ? g[k] : 1.f;
    Wt[(size_t)n * ldt + koff + k] = (bf16)f2bf(gv * W[(size_t)k * ldw + s]);
}
__global__ void k_ws(const float* wq, const float* k1, const float* k2, const float* g, bf16* WST) {
    const size_t i = (size_t)blockIdx.x * blockDim.x + threadIdx.x; if (i >= (size_t)NS * D) return;
    const int n = (int)(i / D), d = (int)(i % D), head = n >> 8, half = (n >> 7) & 1, key = n & 127;
    const float* kr = (half ? k2 : k1) + ((size_t)head * NKEYS + key) * 128;
    const float* qr = wq + (size_t)d * NS + head * 256 + half * 128;
    float s = 0.f;
    for (int e = 0; e < 128; ++e) s += qr[e] * kr[e];
    WST[(size_t)n * D + d] = (bf16)f2bf(g[d] * s);
}
__global__ void k_cvt(const float* in, const float* g, bf16* out, size_t n, int gmask) {
    const size_t i = (size_t)blockIdx.x * blockDim.x + threadIdx.x; if (i >= n) return;
    out[i] = (bf16)f2bf(in[i] * (g ? g[i & gmask] : 1.f));
}

template <class Epi, bool SPLIT2>
__global__ void __launch_bounds__(256) ng(const bf16* A, int lda, const bf16* Bt, int ldb, int K, Epi E) {
    __shared__ float As[32][68], Bs[32][68];
    const int tid = threadIdx.x, tx = tid & 15, ty = tid >> 4, m0 = blockIdx.y * 64, n0 = blockIdx.x * 64;
    float acc[4][4], acc2[4][4];
#pragma unroll
    for (int i = 0; i < 4; ++i)
#pragma unroll
        for (int j = 0; j < 4; ++j) { acc[i][j] = 0.f; acc2[i][j] = 0.f; }
    const int lr = tid >> 2, lk = (tid & 3) * 8;
    for (int k0 = 0; k0 < K; k0 += 32) {
        const u32x4 av = *(const u32x4*)(A + (size_t)(m0 + lr) * lda + k0 + lk), bv = *(const u32x4*)(Bt + (size_t)(n0 + lr) * ldb + k0 + lk);
#pragma unroll
        for (int e = 0; e < 4; ++e) {
            As[lk + 2 * e][lr] = __uint_as_float(av[e] << 16); As[lk + 2 * e + 1][lr] = __uint_as_float(av[e] & 0xffff0000u);
            Bs[lk + 2 * e][lr] = __uint_as_float(bv[e] << 16); Bs[lk + 2 * e + 1][lr] = __uint_as_float(bv[e] & 0xffff0000u);
        }
        __syncthreads();
        const bool second = SPLIT2 && (k0 >= K / 2);
#pragma unroll 8
        for (int kk = 0; kk < 32; ++kk) {
            float a[4], b[4];
#pragma unroll
            for (int i = 0; i < 4; ++i) { a[i] = As[kk][ty * 4 + i]; b[i] = Bs[kk][tx * 4 + i]; }
            if (second) {
#pragma unroll
                for (int i = 0; i < 4; ++i)
#pragma unroll
                    for (int j = 0; j < 4; ++j) acc2[i][j] += a[i] * b[j];
            } else {
#pragma unroll
                for (int i = 0; i < 4; ++i)
#pragma unroll
                    for (int j = 0; j < 4; ++j) acc[i][j] += a[i] * b[j];
            }
        }
        __syncthreads();
    }
#pragma unroll
    for (int i = 0; i < 4; ++i)
#pragma unroll
        for (int j = 0; j < 4; ++j) E(m0 + ty * 4 + i, n0 + tx * 4 + j, acc[i][j], acc2[i][j]);
}
struct E1 {
    const float* RSTD1; bf16 *Q, *K, *V, *GB, *SGA, *SGC; float *TGC, *TXC;
    __device__ void operator()(int row, int col, float a, float) const {
        const float v = RSTD1[row] * a; const int pn = col >> 8;
        if (pn < 2) Q[(size_t)row * AW + col] = (bf16)f2bf(v * C2);
        else if (pn < 4) K[(size_t)row * AW + col - 512] = (bf16)f2bf(v);
        else if (pn < 6) V[(size_t)row * AW + col - 1024] = (bf16)f2bf(v);
        else if (pn < 8) GB[(size_t)row * AW + col - 1536] = (bf16)f2bf(v);
        else if (pn < 12) { const int j = pn - 8, l = col & 255; if (l < 128) TGC[(size_t)row * AW + 128 * j + l] = v; else TXC[(size_t)row * AW + 128 * j + l - 128] = v; }
        else if (pn < 16) SGA[(size_t)row * D + col - 3072] = (bf16)f2bf(sigmoidf_(v));
        else SGC[(size_t)row * D + col - 4096] = (bf16)f2bf(sigmoidf_(v));
    }
};
struct EPP { bf16* PP; __device__ void operator()(int row, int col, float a, float) const { PP[(size_t)row * D + col] = (bf16)f2bf(a); } };
struct E3 { const bf16 *SGA, *SGC; bf16* MG;
    __device__ void operator()(int row, int col, float a, float a2) const { const size_t i = (size_t)row * D + col; MG[i] = (bf16)f2bf(bf2f(SGA[i]) * a + bf2f(SGC[i]) * a2); } };
struct E4 { const float* x; float* X1; bf16* XB1;
    __device__ void operator()(int row, int col, float a, float) const { const size_t i = (size_t)row * D + col; const float v = x[i] + a; X1[i] = v; XB1[i] = (bf16)f2bf(v); } };
struct E5 { float* SC; __device__ void operator()(int row, int col, float a, float) const { SC[(size_t)row * 1024 + col] = a; } };
struct E7 { const float* SS3; const bf16* PP; float* X; const bf16* XB2;
    __device__ void operator()(int row, int col, float a, float) const { const size_t i = (size_t)row * D + col; float q_ = 0.f; for (int j_ = 0; j_ < 16; ++j_) q_ += SS3[(size_t)row * 16 + j_]; X[i] = bf2f(XB2[i]) + sigmoidf_(a / sqrtf(q_ * (1.0f / D) + EPS)) * bf2f(PP[i]); } };

__global__ void k_z(const float* TGC, const float* TXC, bf16* Z) { const size_t i = (size_t)blockIdx.x * blockDim.x + threadIdx.x; if (i < (size_t)M * AW) Z[i] = (bf16)f2bf(TGC[i] * TXC[i]); }
__global__ void k_cumsum(const float* LF, float* CS) { const int bh = threadIdx.x; if (bh >= 32) return; float s = 0.f; for (int t = 0; t < SEQ; ++t) { s += LF[(size_t)bh * SEQ + t]; CS[(size_t)bh * SEQ + t] = s; } }
__global__ void k_conv(const bf16* GB, const bf16* Z, const float* cw, bf16* AC) {
    const size_t i = (size_t)blockIdx.x * blockDim.x + threadIdx.x; if (i >= (size_t)M * AW) return;
    const int row = (int)(i / AW), c = (int)(i % AW), t = row % SEQ;
    float s = cw[2 * AW + c] * bf2f(Z[i]);
    if (t >= 1) s += cw[1 * AW + c] * bf2f(Z[i - AW]);
    if (t >= 2) s += cw[0 * AW + c] * bf2f(Z[i - 2 * AW]);
    AC[(size_t)row * D + AW + c] = (bf16)f2bf(bf2f(GB[i]) * s);
}
__global__ void __launch_bounds__(64) k_attn(const bf16* Q, const bf16* K, const bf16* V, const float* CS, bf16* AC) {
    const int bh = blockIdx.y, b = bh / NH, h = bh % NH, q = blockIdx.x * 64 + threadIdx.x;
    const size_t rq = (size_t)b * SEQ + q;
    float qv[64], o[64];
#pragma unroll
    for (int d = 0; d < 64; ++d) { qv[d] = bf2f(Q[rq * AW + h * 64 + d]); o[d] = 0.f; }
    const float cq = CS[(size_t)bh * SEQ + q];
    float m = -INFINITY, l = 0.f;
    const int kvmax = blockIdx.x * 64 + 63;
    for (int kv = 0; kv <= kvmax; ++kv) {
        const size_t rk = (size_t)b * SEQ + kv;
        const u32x4* kp = (const u32x4*)(K + rk * AW + h * 64);
        float s = 0.f;
#pragma unroll
        for (int c = 0; c < 8; ++c) { const u32x4 w = kp[c];
#pragma unroll
            for (int e = 0; e < 4; ++e) { s += qv[c * 8 + 2 * e] * __uint_as_float(w[e] << 16) + qv[c * 8 + 2 * e + 1] * __uint_as_float(w[e] & 0xffff0000u); } }
        s += cq - CS[(size_t)bh * SEQ + kv];
        if (kv > q) s = -INFINITY;
        const float mn = fmaxf(m, s);
        const float al = (m == -INFINITY) ? 0.f : exp2f(m - mn), p = (s == -INFINITY) ? 0.f : exp2f(s - mn);
        l = l * al + p; m = mn;
        const u32x4* vp = (const u32x4*)(V + rk * AW + h * 64);
#pragma unroll
        for (int c = 0; c < 8; ++c) { const u32x4 w = vp[c];
#pragma unroll
            for (int e = 0; e < 4; ++e) { o[c * 8 + 2 * e] = o[c * 8 + 2 * e] * al + p * __uint_as_float(w[e] << 16); o[c * 8 + 2 * e + 1] = o[c * 8 + 2 * e + 1] * al + p * __uint_as_float(w[e] & 0xffff0000u); } }
    }
    const float il = 1.0f / l;
#pragma unroll
    for (int d = 0; d < 64; ++d) AC[rq * D + h * 64 + d] = (bf16)f2bf(o[d] * il);
}
__global__ void __launch_bounds__(256) k_rowss(const float* X, float* SS) {
    const int lane = threadIdx.x & 63, row = blockIdx.x * 4 + (threadIdx.x >> 6);
    const f32x4* xr = (const f32x4*)(X + (size_t)row * D); float ss = 0.f;
#pragma unroll
    for (int j = 0; j < 4; ++j) { const f32x4 v = xr[lane + 64 * j]; ss += v.x * v.x + v.y * v.y + v.z * v.z + v.w * v.w; }
    ss = wave_sum(ss);
    if (lane < 16) SS[(size_t)row * 16 + lane] = lane == 0 ? ss : 0.f;
}
__global__ void __launch_bounds__(64) k_topk(const float* SC, const float* SS2, int hg, unsigned short* IDS, float* GATES) {
    __shared__ float s[128][64]; __shared__ float tv[16][64]; __shared__ int ti[16][64];
    const int tid = threadIdx.x, pair = blockIdx.x * 32 + (tid >> 1), half = tid & 1, token = pair >> 2, hl = pair & 3;
    const float* src = SC + (size_t)token * 1024 + hl * 256 + half * 128;
    for (int k = 0; k < 128; ++k) s[k][tid] = src[k];
    float pv = INFINITY; int pk = -1;
    for (int r = 0; r < 16; ++r) {
        float best = -INFINITY; int bi = 0;
        for (int k = 0; k < 128; ++k) { const float v = s[k][tid]; const bool elig = (v < pv) || (v == pv && k > pk); if (elig && v > best) { best = v; bi = k; } }
        tv[r][tid] = best; ti[r][tid] = bi; pv = best; pk = bi;
    }
    __syncthreads();
    if (half == 0) {
        const float* ss = SS2 + (size_t)token * 16; float sst = 0.f; for (int q_ = 0; q_ < 16; ++q_) sst += ss[q_]; const float rstd = 1.0f / sqrtf(sst * (1.0f / D) + EPS);
        float ts[16]; int tf[16];
        float cpv = INFINITY; int cpf = -1;
#pragma unroll
        for (int r = 0; r < 16; ++r) {
            float best = -INFINITY; int bf_ = 0;
            for (int c = 0; c < 256; ++c) { const float v = tv[c >> 4][tid] + tv[c & 15][tid + 1]; const bool elig = (v < cpv) || (v == cpv && c > cpf); if (elig && v > best) { best = v; bf_ = c; } }
            ts[r] = best; tf[r] = bf_; cpv = best; cpf = bf_;
        }
        float e[16], sum = 0.f;
#pragma unroll
        for (int r = 0; r < 16; ++r) { e[r] = __expf(rstd * (ts[r] - ts[0])); sum += e[r]; }
        const float inv = 1.0f / sum; const int head = hg * 4 + hl;
#pragma unroll
        for (int r = 0; r < 16; ++r) { IDS[(size_t)token * 128 + head * 16 + r] = (unsigned short)(ti[tf[r] >> 4][tid] * 128 + ti[tf[r] & 15][tid + 1]); GATES[(size_t)token * 128 + head * 16 + r] = e[r] * inv; }
    }
}
__global__ void __launch_bounds__(256) k_peer(const bf16* XB1, const float* SS2, const unsigned short* IDS, const float* GATES, const bf16* UB, const bf16* VB, float* X, bf16* XB2, float* RSTD3) {
    const int lane = threadIdx.x & 63, token = blockIdx.x * 4 + (threadIdx.x >> 6);
    const float* ss = SS2 + (size_t)token * 16; float sst = 0.f; for (int q_ = 0; q_ < 16; ++q_) sst += ss[q_]; const float rstd = 1.0f / sqrtf(sst * (1.0f / D) + EPS);
    float xf[16], out[16];
    { const u32x4 a = *(const u32x4*)(XB1 + (size_t)token * D + 8 * lane), b = *(const u32x4*)(XB1 + (size_t)token * D + 512 + 8 * lane);
#pragma unroll
      for (int e = 0; e < 4; ++e) { xf[2 * e] = __uint_as_float(a[e] << 16); xf[2 * e + 1] = __uint_as_float(a[e] & 0xffff0000u); xf[8 + 2 * e] = __uint_as_float(b[e] << 16); xf[8 + 2 * e + 1] = __uint_as_float(b[e] & 0xffff0000u); } }
#pragma unroll
    for (int i = 0; i < 16; ++i) out[i] = 0.f;
    for (int hk = 0; hk < 128; ++hk) {
        const int id = IDS[(size_t)token * 128 + hk]; const float g = GATES[(size_t)token * 128 + hk];
        const u32x4 a = *(const u32x4*)(UB + (size_t)id * D + 8 * lane), b = *(const u32x4*)(UB + (size_t)id * D + 512 + 8 * lane);
        float dot = 0.f;
#pragma unroll
        for (int e = 0; e < 4; ++e) { dot += xf[2 * e] * __uint_as_float(a[e] << 16) + xf[2 * e + 1] * __uint_as_float(a[e] & 0xffff0000u) + xf[8 + 2 * e] * __uint_as_float(b[e] << 16) + xf[8 + 2 * e + 1] * __uint_as_float(b[e] & 0xffff0000u); }
        dot = wave_sum(dot) * rstd;
        const float w = g * 0.5f * dot * (1.0f + erff(dot * 0.70710678118654752f));
        const u32x4 va = *(const u32x4*)(VB + (size_t)id * D + 8 * lane), vb = *(const u32x4*)(VB + (size_t)id * D + 512 + 8 * lane);
#pragma unroll
        for (int e = 0; e < 4; ++e) { out[2 * e] += w * __uint_as_float(va[e] << 16); out[2 * e + 1] += w * __uint_as_float(va[e] & 0xffff0000u); out[8 + 2 * e] += w * __uint_as_float(vb[e] << 16); out[8 + 2 * e + 1] += w * __uint_as_float(vb[e] & 0xffff0000u); }
    }
    float* xr = X + (size_t)token * D; float s2 = 0.f;
    f32x4 x0, x1, x2, x3;
    for (int e = 0; e < 4; ++e) { x0[e] = xf[e]; x1[e] = xf[4 + e]; x2[e] = xf[8 + e]; x3[e] = xf[12 + e]; }
#pragma unroll
    for (int e = 0; e < 4; ++e) { x0[e] += out[e]; x1[e] += out[4 + e]; x2[e] += out[8 + e]; x3[e] += out[12 + e]; s2 += x0[e] * x0[e] + x1[e] * x1[e] + x2[e] * x2[e] + x3[e] * x3[e]; }
    *(f32x4*)(xr + 8 * lane) = x0; *(f32x4*)(xr + 8 * lane + 4) = x1; *(f32x4*)(xr + 512 + 8 * lane) = x2; *(f32x4*)(xr + 512 + 8 * lane + 4) = x3;
    u32x4 w0, w1; w0.x = pk2(x0.x, x0.y); w0.y = pk2(x0.z, x0.w); w0.z = pk2(x1.x, x1.y); w0.w = pk2(x1.z, x1.w); w1.x = pk2(x2.x, x2.y); w1.y = pk2(x2.z, x2.w); w1.z = pk2(x3.x, x3.y); w1.w = pk2(x3.z, x3.w);
    *(u32x4*)(XB2 + (size_t)token * D + 8 * lane) = w0; *(u32x4*)(XB2 + (size_t)token * D + 512 + 8 * lane) = w1;
    s2 = wave_sum(s2);
    if (lane < 16) RSTD3[(size_t)token * 16 + lane] = lane == 0 ? s2 : 0.f;
}
__global__ void __launch_bounds__(256) k_final(float* X, const float* g) {
    const int lane = threadIdx.x & 63, row = blockIdx.x * 4 + (threadIdx.x >> 6);
    f32x4* xr = (f32x4*)(X + (size_t)row * D); f32x4 v[4]; float ss = 0.f;
#pragma unroll
    for (int j = 0; j < 4; ++j) { v[j] = xr[lane + 64 * j]; ss += v[j].x * v[j].x + v[j].y * v[j].y + v[j].z * v[j].z + v[j].w * v[j].w; }
    ss = wave_sum(ss); const float rstd = 1.0f / sqrtf(ss * (1.0f / D) + EPS);
#pragma unroll
    for (int j = 0; j < 4; ++j) { const f32x4 gv = ((const f32x4*)g)[lane + 64 * j]; xr[lane + 64 * j] = v[j] * rstd * gv; }
}

}

#ifndef MK_FUSED_MASK
#define MK_FUSED_MASK 0x1ff
#endif
static void golden_phase(int ph, void* const* d_in, float* out, unsigned char* ws, hipStream_t stream) {
    using namespace gold;
    const float* x = (const float*)d_in[0]; const float* p = (const float*)d_in[1]; const float* g_mix = (const float*)d_in[2]; const float* w_in = (const float*)d_in[3];
    const float* b_f = (const float*)d_in[4]; const float* conv_w = (const float*)d_in[5]; const float* w_branch = (const float*)d_in[6]; const float* w_out = (const float*)d_in[7];
    const float* g_ffn = (const float*)d_in[8]; const float* w_peer_q = (const float*)d_in[9]; const float* peer_k1 = (const float*)d_in[10]; const float* peer_k2 = (const float*)d_in[11];
    const float* peer_u = (const float*)d_in[12]; const float* peer_v = (const float*)d_in[13]; const float* g_ple = (const float*)d_in[14]; const float* w_ple_gate = (const float*)d_in[15];
    const float* w_ple_proj = (const float*)d_in[16]; const float* g_final = (const float*)d_in[17];
    float *RSTD1 = (float*)(ws + WS_RSTD1), *SS2 = (float*)(ws + WS_SS2), *LF = (float*)(ws + WS_LF), *CS = (float*)(ws + WS_CS);
    bf16 *WIN = (bf16*)(ws + WS_WIN), *WBR = (bf16*)(ws + WS_WBR), *WOUT = (bf16*)(ws + WS_WOUT), *WST = (bf16*)(ws + WS_WS), *WPG = (bf16*)(ws + WS_WPG), *WPP = (bf16*)(ws + WS_WPP), *PB = (bf16*)(ws + WS_PB);
    bf16 *UB = (bf16*)(ws + WS_UB), *VB = (bf16*)(ws + WS_VB), *XB = (bf16*)(ws + WS_A), *AC = (bf16*)(ws + WS_A), *XB1 = (bf16*)(ws + WS_A), *PP = (bf16*)(ws + WS_PP);
    bf16 *Q = (bf16*)(ws + WS_Q), *K = (bf16*)(ws + WS_K), *V = (bf16*)(ws + WS_V), *GB = (bf16*)(ws + WS_GB), *Z = (bf16*)(ws + WS_Z), *MG = (bf16*)(ws + WS_MERGED), *XB2 = (bf16*)(ws + WS_XB2);
    unsigned short* IDS = (unsigned short*)(ws + WS_IDS); float* GATES = (float*)(ws + WS_GATES);
    bf16 *SGA = (bf16*)out, *SGC = (bf16*)out + (size_t)M * D;
    float *TGC = (float*)(ws + WS_TGC), *TXC = (float*)(ws + WS_TXC), *SC = (float*)(ws + WS_SC);
    auto nb = [](size_t n) { return (unsigned)((n + 255) / 256); };
    switch (ph) {
    case 0:
        k_rows0<<<M / 4, 256, 0, stream>>>(x, w_in, g_mix, b_f, XB, RSTD1, LF);
        k_wt<1><<<nb((size_t)NIN * D), 256, 0, stream>>>(w_in, INTOT, g_mix, WIN, NIN, D, 0, D);
        k_wt<0><<<nb((size_t)D * AW), 256, 0, stream>>>(w_branch, D, nullptr, WBR, D, AW, 0, D);
        k_wt<0><<<nb((size_t)D * AW), 256, 0, stream>>>(w_branch + (size_t)AW * D, D, nullptr, WBR, D, AW, AW, D);
        k_wt<0><<<nb((size_t)D * D), 256, 0, stream>>>(w_out, D, nullptr, WOUT, D, D, 0, D);
        k_wt<0><<<nb((size_t)D * D), 256, 0, stream>>>(w_ple_gate, D, g_ple, WPG, D, D, 0, D);
        k_wt<0><<<nb((size_t)D * PLE), 256, 0, stream>>>(w_ple_proj, D, nullptr, WPP, D, PLE, 0, PLE);
        k_ws<<<nb((size_t)NS * D), 256, 0, stream>>>(w_peer_q, peer_k1, peer_k2, g_ffn, WST);
        k_cvt<<<nb((size_t)M * PLE), 256, 0, stream>>>(p, nullptr, PB, (size_t)M * PLE, 0);
        break;
    case 1:
        ng<E1, false><<<dim3(NIN / 64, M / 64), 256, 0, stream>>>(XB, D, WIN, D, D, E1{RSTD1, Q, K, V, GB, SGA, SGC, TGC, TXC});
        ng<EPP, false><<<dim3(D / 64, M / 64), 256, 0, stream>>>(PB, PLE, WPP, PLE, PLE, EPP{PP});
        k_z<<<nb((size_t)M * AW), 256, 0, stream>>>(TGC, TXC, Z);
        break;
    case 2:
        k_cumsum<<<1, 64, 0, stream>>>(LF, CS);
        k_conv<<<nb((size_t)M * AW), 256, 0, stream>>>(GB, Z, conv_w, AC);
        k_attn<<<dim3(SEQ / 64, BATCH * NH), 64, 0, stream>>>(Q, K, V, CS, AC);
        break;
    case 3: ng<E3, true><<<dim3(D / 64, M / 64), 256, 0, stream>>>(AC, D, WBR, D, D, E3{SGA, SGC, MG}); break;
    case 4:
        ng<E4, false><<<dim3(D / 64, M / 64), 256, 0, stream>>>(MG, D, WOUT, D, D, E4{x, out, XB1});
        k_rowss<<<M / 4, 256, 0, stream>>>(out, SS2);
        break;
    case 5:
        for (int hg = 0; hg < 2; ++hg) {
            ng<E5, false><<<dim3(1024 / 64, M / 64), 256, 0, stream>>>(XB1, D, WST + (size_t)hg * 1024 * D, D, D, E5{SC});
            k_topk<<<M * 4 / 32, 64, 0, stream>>>(SC, SS2, hg, IDS, GATES);
        }
        break;
    case 6:
        k_cvt<<<nb((size_t)NEXP * D), 256, 0, stream>>>(peer_u, g_ffn, UB, (size_t)NEXP * D, D - 1);
        k_cvt<<<nb((size_t)NEXP * D), 256, 0, stream>>>(peer_v, nullptr, VB, (size_t)NEXP * D, 0);
        k_peer<<<M / 4, 256, 0, stream>>>(XB1, SS2, IDS, GATES, UB, VB, out, XB2, SS2);
        break;
    case 7: ng<E7, false><<<dim3(D / 64, M / 64), 256, 0, stream>>>(XB2, D, WPG, D, D, E7{SS2, PP, out, XB2}); break;
    case 8: k_final<<<M / 4, 256, 0, stream>>>(out, g_final); break;
    }
}
extern "C" void kernel_launch(void* const* d_in, const int* in_sizes, int n_in, void* d_out, int out_size, void* d_ws, size_t ws_size, hipStream_t stream) {
    static int grid = 0;
    if (grid == 0) {
        if (n_in != 18 || in_sizes[0] != M * D || out_size != M * D || ws_size < WS_END) { fprintf(stderr, "kernel_launch: unexpected shapes (n_in %d, in0 %d, out %d, ws %zu); nothing launched\n", n_in, n_in > 0 ? in_sizes[0] : -1, out_size, ws_size); grid = -1; return; }
        int dev = 0, cus = 0, per_cu = 0;
        if (hipGetDevice(&dev) != hipSuccess || hipDeviceGetAttribute(&cus, hipDeviceAttributeMultiprocessorCount, dev) != hipSuccess) { fprintf(stderr, "kernel_launch: device query failed\n"); grid = -1; return; }
        if (hipFuncSetAttribute((const void*)mk_fwd, hipFuncAttributeMaxDynamicSharedMemorySize, LDS_BYTES) != hipSuccess) { fprintf(stderr, "kernel_launch: hipFuncSetAttribute failed\n"); grid = -1; return; }
        if (hipOccupancyMaxActiveBlocksPerMultiprocessor(&per_cu, (const void*)mk_fwd, NWAVES * 64, LDS_BYTES) != hipSuccess || per_cu < 1) { fprintf(stderr, "kernel_launch: occupancy query says %d workgroups per CU; nothing launched\n", per_cu); (void)hipGetLastError(); grid = -1; return; }
        grid = cus;
    }
    if (grid < 0) return;
    if (hipMemsetAsync((char*)d_ws + WS_CTL, 0, CTL_ZERO_BYTES, stream) != hipSuccess) { fprintf(stderr, "kernel_launch: hipMemsetAsync failed\n"); return; }
    Args a{};
    for (int i = 0; i < 18; ++i) a.in[i] = (const float*)d_in[i];
    a.out = (float*)d_out; a.ws = (unsigned char*)d_ws;
    int li = 0;
    for (int ph = 0; ph < NPHASE;) {
        if ((MK_FUSED_MASK >> ph) & 1) {
            int hi = ph; while (hi < NPHASE && ((MK_FUSED_MASK >> hi) & 1)) ++hi;
            a.ph_lo = ph; a.ph_hi = hi; a.li = li++; a.pad = 0;
            hipLaunchKernelGGL(mk_fwd, dim3(grid), dim3(NWAVES * 64), LDS_BYTES, stream, a);
            const hipError_t le = hipPeekAtLastError();
            if (le != hipSuccess) { fprintf(stderr, "kernel_launch: launch failed: %s\n", hipGetErrorName(le)); return; }
            ph = hi;
        } else {
            golden_phase(ph, d_in, (float*)d_out, (unsigned char*)d_ws, stream);
            if ((ph == 1 || ph == 5) && (MK_FUSED_MASK & 1) && ((MK_FUSED_MASK >> 6) & 1)) {
                gold::k_cvt<<<(unsigned)(((size_t)NEXP * D + 255) / 256), 256, 0, stream>>>((const float*)d_in[12], (const float*)d_in[8], (bf16*)((unsigned char*)d_ws + WS_UB), (size_t)NEXP * D, D - 1);
                gold::k_cvt<<<(unsigned)(((size_t)NEXP * D + 255) / 256), 256, 0, stream>>>((const float*)d_in[13], nullptr, (bf16*)((unsigned char*)d_ws + WS_VB), (size_t)NEXP * D, 0);
            }
            ++ph;
        }
    }
}
```

```cpp
#include <hip/hip_runtime.h>
#include <hip/hip_bf16.h>
#include <cstdio>
#include <cstdint>
#include <cmath>
#define MK_FUSED_MASK 0x1ff
namespace pg8 {
#define PG8_LAS __attribute__((address_space(3)))
typedef unsigned short bf16_t;
typedef short bf16x8 __attribute__((ext_vector_type(8)));
typedef float f32x4 __attribute__((ext_vector_type(4)));
typedef unsigned u32x4 __attribute__((ext_vector_type(4)));
constexpr int BM = 256, BK = 64, HALF = 128, HTB = HALF * BK * 2  , STAGE_BYTES = 8 * HTB, NXCD = 8, WGM = 8;

__host__ __device__ __forceinline__ int lds_byte(int r, int c) { const int st = (r >> 4) * 2 + (c >> 5), rr = r & 15, cc = c & 31, ob = rr * 64 + cc * 2; return st * 1024 + (ob ^ (((ob >> 9) & 1) << 5)); }
__host__ __device__ __forceinline__ void stage_rc(int b, int& R, int& C) { const int st = b / 1024, sb = b % 1024, swz = sb ^ (((sb >> 9) & 1) << 5); R = (st >> 1) * 16 + swz / 64; C = (st & 1) * 32 + (swz % 64) / 2; }
__host__ __device__ __forceinline__ int perm32(int rho) { const int n = rho >> 4, i = rho & 15; return 8 * (i >> 2) + 4 * n + (i & 3); }

struct Unit { int pm, pn; };
struct Gemm { const bf16_t* A; const bf16_t* Bt; int M, N, K; };

struct StaticOrder {
    int nM, nN, nwg, G, c;
    __host__ __device__ void init(int M, int N, int G_, int c_) { nM = M / BM; nN = N / BM; nwg = nM * nN; G = G_; c = c_; }
    __host__ __device__ bool next(int i, Unit& u) const {
        const long L = (long)i * G + c; if (L >= nwg) return false;
        int wgid = (int)L; { const int q = nwg / NXCD, r = nwg % NXCD, xcd = wgid % NXCD, off = wgid / NXCD; wgid = (xcd < r ? xcd * (q + 1) : r * (q + 1) + (xcd - r) * q) + off; }
        const int nig = WGM * nN, gid = wgid / nig, fm = gid * WGM, gsz = (nM - fm) < WGM ? (nM - fm) : WGM;
        u.pm = fm + ((wgid % nig) % gsz); u.pn = (wgid % nig) / gsz; return true;
    }
    __device__ __forceinline__ void a_ready(const Unit&) const {}
    __device__ __forceinline__ void done(const Unit&) const {}
};


__device__ __forceinline__ unsigned cvt_pk_bf16(float lo, float hi) { unsigned r; asm volatile("v_cvt_pk_bf16_f32 %0, %1, %2" : "=v"(r) : "v"(lo), "v"(hi)); return r; }
__device__ __forceinline__ u32x4 pack8(const f32x4 v0, const f32x4 v1) { u32x4 w; w.x = cvt_pk_bf16(v0[0], v0[1]); w.y = cvt_pk_bf16(v0[2], v0[3]); w.z = cvt_pk_bf16(v1[0], v1[1]); w.w = cvt_pk_bf16(v1[2], v1[3]); return w; }
__device__ __forceinline__ float bflo(unsigned w) { return __uint_as_float(w << 16); }
__device__ __forceinline__ float bfhi(unsigned w) { return __uint_as_float(w & 0xffff0000u); }
__device__ __forceinline__ float sigm(float v) { return __builtin_amdgcn_rcpf(1.0f + __builtin_amdgcn_exp2f(v * -1.4426950408889634f)); }
__device__ __forceinline__ f32x4 sigm4(const f32x4 v) { return (f32x4){sigm(v[0]), sigm(v[1]), sigm(v[2]), sigm(v[3])}; }

struct EpiIn {
    static constexpr bool PERM = true, AFTER_DRAIN = false; static constexpr int MID_T = 0;
    const float* rstd; bf16_t* QKVG; size_t stride4; bf16_t* Z; bf16_t* SG; size_t strideSG; float c2;
    __device__ __forceinline__ void operator()(const f32x4 (&acc)[2][2][4][2], const Unit& u, int wr, int wc, int fr, int fq) const {
        int row0 = u.pm * BM + wr * 64 + fr; asm volatile("" : "+v"(row0)); const int cl = wc * 32 + 8 * fq, pn = u.pn;
        if (pn < 8) {
            bf16_t* base = QKVG + (size_t)(pn >> 1) * stride4; const int colt = (pn & 1) * 256 + cl; const float s0 = pn < 2 ? c2 : 1.f;
#pragma unroll
            for (int ai = 0; ai < 2; ++ai)
#pragma unroll
                for (int m = 0; m < 4; ++m) { const int row = row0 + ai * HALF + m * 16; const float sc = rstd[row] * s0; bf16_t* rowp = base + (size_t)row * 512 + colt;
#pragma unroll
                    for (int bj = 0; bj < 2; ++bj) *(u32x4*)(rowp + bj * HALF) = pack8(acc[ai][bj][m][0] * sc, acc[ai][bj][m][1] * sc);
                    asm volatile("" ::: "memory"); }
        } else if (pn < 12) {
            const int colt = (pn - 8) * 128 + cl;
#pragma unroll
            for (int ai = 0; ai < 2; ++ai)
#pragma unroll
                for (int m = 0; m < 4; ++m) { const int row = row0 + ai * HALF + m * 16; const float r = rstd[row], sc = r * r;
                    *(u32x4*)(Z + (size_t)row * 512 + colt) = pack8(acc[ai][0][m][0] * acc[ai][1][m][0] * sc, acc[ai][0][m][1] * acc[ai][1][m][1] * sc);
                    asm volatile("" ::: "memory"); }
        } else {
            bf16_t* base = SG + (size_t)((pn - 12) >> 2) * strideSG; const int colt = ((pn - 12) & 3) * 256 + cl;
#pragma unroll
            for (int ai = 0; ai < 2; ++ai)
#pragma unroll
                for (int m = 0; m < 4; ++m) { const int row = row0 + ai * HALF + m * 16; const float r = rstd[row]; bf16_t* rowp = base + (size_t)row * 1024 + colt;
#pragma unroll
                    for (int bj = 0; bj < 2; ++bj) { *(u32x4*)(rowp + bj * HALF) = pack8(sigm4(acc[ai][bj][m][0] * r), sigm4(acc[ai][bj][m][1] * r)); asm volatile("" ::: "memory"); } }
        }
    }
};
struct EpiPlain {
    static constexpr bool PERM = true, AFTER_DRAIN = false; static constexpr int MID_T = 0;
    bf16_t* O; int ldc;
    __device__ __forceinline__ void operator()(const f32x4 (&acc)[2][2][4][2], const Unit& u, int wr, int wc, int fr, int fq) const {
        int row0 = u.pm * BM + wr * 64 + fr; asm volatile("" : "+v"(row0)); const int col0 = u.pn * BM + wc * 32 + 8 * fq;
#pragma unroll
        for (int ai = 0; ai < 2; ++ai)
#pragma unroll
            for (int m = 0; m < 4; ++m) { bf16_t* rowp = O + (size_t)(row0 + ai * HALF + m * 16) * ldc + col0;
#pragma unroll
                for (int bj = 0; bj < 2; ++bj) *(u32x4*)(rowp + bj * HALF) = pack8(acc[ai][bj][m][0], acc[ai][bj][m][1]); }
    }
};
struct EpiBranch {
    static constexpr bool PERM = true, AFTER_DRAIN = false; static constexpr int MID_T = 8;
    const bf16_t *SGA, *SGC; bf16_t* MG;
    __device__ __forceinline__ void mid(f32x4 (&acc)[2][2][4][2], const Unit& u, int wr, int wc, int fr, int fq) const {
        int row0 = u.pm * BM + wr * 64 + fr; asm volatile("" : "+v"(row0)); const int col0 = u.pn * BM + wc * 32 + 8 * fq;
#pragma unroll
        for (int ai = 0; ai < 2; ++ai) {
            u32x4 a[4][2], c[4][2];
#pragma unroll
            for (int m = 0; m < 4; ++m)
#pragma unroll
                for (int bj = 0; bj < 2; ++bj) { const size_t off = (size_t)(row0 + ai * HALF + m * 16) * 1024 + col0 + bj * HALF; a[m][bj] = *(const u32x4*)(SGA + off); c[m][bj] = *(const u32x4*)(SGC + off); }
#pragma unroll
            for (int m = 0; m < 4; ++m)
#pragma unroll
                for (int bj = 0; bj < 2; ++bj) { const u32x4 av = a[m][bj], cv = c[m][bj]; f32x4 r0, r1;
                    r0[0] = bflo(av[0]) * __builtin_amdgcn_rcpf(bflo(cv[0])); r0[1] = bfhi(av[0]) * __builtin_amdgcn_rcpf(bfhi(cv[0])); r0[2] = bflo(av[1]) * __builtin_amdgcn_rcpf(bflo(cv[1])); r0[3] = bfhi(av[1]) * __builtin_amdgcn_rcpf(bfhi(cv[1]));
                    r1[0] = bflo(av[2]) * __builtin_amdgcn_rcpf(bflo(cv[2])); r1[1] = bfhi(av[2]) * __builtin_amdgcn_rcpf(bfhi(cv[2])); r1[2] = bflo(av[3]) * __builtin_amdgcn_rcpf(bflo(cv[3])); r1[3] = bfhi(av[3]) * __builtin_amdgcn_rcpf(bfhi(cv[3]));
                    acc[ai][bj][m][0] *= r0; acc[ai][bj][m][1] *= r1; }
            asm volatile("" ::: "memory");
        }
    }
    __device__ __forceinline__ void operator()(const f32x4 (&acc)[2][2][4][2], const Unit& u, int wr, int wc, int fr, int fq) const {
        int row0 = u.pm * BM + wr * 64 + fr; asm volatile("" : "+v"(row0)); const int col0 = u.pn * BM + wc * 32 + 8 * fq;
#pragma unroll
        for (int ai = 0; ai < 2; ++ai) {
            u32x4 c[4][2];
#pragma unroll
            for (int m = 0; m < 4; ++m)
#pragma unroll
                for (int bj = 0; bj < 2; ++bj) c[m][bj] = *(const u32x4*)(SGC + (size_t)(row0 + ai * HALF + m * 16) * 1024 + col0 + bj * HALF);
#pragma unroll
            for (int m = 0; m < 4; ++m)
#pragma unroll
                for (int bj = 0; bj < 2; ++bj) { const u32x4 cv = c[m][bj];
                    const f32x4 s0 = {bflo(cv[0]), bfhi(cv[0]), bflo(cv[1]), bfhi(cv[1])}, s1 = {bflo(cv[2]), bfhi(cv[2]), bflo(cv[3]), bfhi(cv[3])};
                    *(u32x4*)(MG + (size_t)(row0 + ai * HALF + m * 16) * 1024 + col0 + bj * HALF) = pack8(acc[ai][bj][m][0] * s0, acc[ai][bj][m][1] * s1); }
            asm volatile("" ::: "memory");
        }
    }
};
struct EpiOut {
    static constexpr bool PERM = true, AFTER_DRAIN = false; static constexpr int MID_T = 0;
    const float* x; bf16_t* XB1; float* SS2;
    __device__ __forceinline__ void operator()(const f32x4 (&acc)[2][2][4][2], const Unit& u, int wr, int wc, int fr, int fq) const {
        int row0 = u.pm * BM + wr * 64 + fr; asm volatile("" : "+v"(row0)); const int col0 = u.pn * BM + wc * 32 + 8 * fq;
#pragma unroll
        for (int ai = 0; ai < 2; ++ai) {
            f32x4 xv[4][2][2];
#pragma unroll
            for (int m = 0; m < 4; ++m)
#pragma unroll
                for (int bj = 0; bj < 2; ++bj) { const float* xp = x + (size_t)(row0 + ai * HALF + m * 16) * 1024 + col0 + bj * HALF; xv[m][bj][0] = *(const f32x4*)xp; xv[m][bj][1] = *(const f32x4*)(xp + 4); }
#pragma unroll
            for (int m = 0; m < 4; ++m) { const int row = row0 + ai * HALF + m * 16; float ss = 0.f;
#pragma unroll
                for (int bj = 0; bj < 2; ++bj) { const f32x4 v0 = acc[ai][bj][m][0] + xv[m][bj][0], v1 = acc[ai][bj][m][1] + xv[m][bj][1];
                    *(u32x4*)(XB1 + (size_t)row * 1024 + col0 + bj * HALF) = pack8(v0, v1);
                    ss += (v0[0] * v0[0] + v0[1] * v0[1]) + (v0[2] * v0[2] + v0[3] * v0[3]) + (v1[0] * v1[0] + v1[1] * v1[1]) + (v1[2] * v1[2] + v1[3] * v1[3]); }
                ss += __shfl_xor(ss, 16); ss += __shfl_xor(ss, 32);
                if (fq == 0) SS2[(size_t)row * 16 + u.pn * 4 + wc] = ss; }
            asm volatile("" ::: "memory");
        }
    }
};
struct EpiPle {
    static constexpr bool PERM = true, AFTER_DRAIN = false; static constexpr int MID_T = 0;
    const float* SS3; const bf16_t* PP; const bf16_t* XB2; float* X; float eps; const PG8_LAS float* rtab;
    __device__ __forceinline__ void operator()(const f32x4 (&acc)[2][2][4][2], const Unit& u, int wr, int wc, int fr, int fq) const {
        int row0 = u.pm * BM + wr * 64 + fr; asm volatile("" : "+v"(row0)); const int col0 = u.pn * BM + wc * 32 + 8 * fq;
#pragma unroll
        for (int ai = 0; ai < 2; ++ai) {
            u32x4 pv[4][2], xb[4][2]; float rr[4];
#pragma unroll
            for (int m = 0; m < 4; ++m) { const int row = row0 + ai * HALF + m * 16;
#pragma unroll
                for (int bj = 0; bj < 2; ++bj) { const size_t off = (size_t)row * 1024 + col0 + bj * HALF; pv[m][bj] = *(const u32x4*)(PP + off); xb[m][bj] = *(const u32x4*)(XB2 + off); }
                if (rtab) rr[m] = rtab[wr * 64 + fr + ai * HALF + m * 16];
                else { const f32x4* sp = (const f32x4*)(SS3 + (size_t)row * 16); const f32x4 q0 = sp[0], q1 = sp[1]; rr[m] = 1.0f / sqrtf((((q0[0] + q0[1]) + (q0[2] + q0[3])) + ((q1[0] + q1[1]) + (q1[2] + q1[3]))) * (1.0f / 1024.0f) + eps); } }
#pragma unroll
            for (int m = 0; m < 4; ++m) { const int row = row0 + ai * HALF + m * 16; const float r = rr[m];
#pragma unroll
                for (int bj = 0; bj < 2; ++bj) { const u32x4 c = pv[m][bj], xq = xb[m][bj]; const size_t off = (size_t)row * 1024 + col0 + bj * HALF;
                    const f32x4 p0 = {bflo(c[0]), bfhi(c[0]), bflo(c[1]), bfhi(c[1])}, p1 = {bflo(c[2]), bfhi(c[2]), bflo(c[3]), bfhi(c[3])};
                    const f32x4 x0 = {bflo(xq[0]), bfhi(xq[0]), bflo(xq[1]), bfhi(xq[1])}, x1 = {bflo(xq[2]), bfhi(xq[2]), bflo(xq[3]), bfhi(xq[3])};
                    *(f32x4*)(X + off) = x0 + sigm4(acc[ai][bj][m][0] * r) * p0; *(f32x4*)(X + off + 4) = x1 + sigm4(acc[ai][bj][m][1] * r) * p1; } }
            asm volatile("" ::: "memory");
        }
    }
};

__device__ __forceinline__ float vmaxf(float a, float b) { float r; asm("v_max_f32_e32 %0, %1, %2" : "=v"(r) : "v"(a), "v"(b)); return r; }
__device__ __forceinline__ float vminf(float a, float b) { float r; asm("v_min_f32_e32 %0, %1, %2" : "=v"(r) : "v"(a), "v"(b)); return r; }
__device__ __forceinline__ void sort16_desc(float (&a)[16]) {
#pragma unroll
    for (int k = 2; k <= 16; k <<= 1)
#pragma unroll
        for (int j = k >> 1; j > 0; j >>= 1)
#pragma unroll
            for (int i = 0; i < 16; ++i) { const int l = i ^ j; if (l > i) { const float hi = vmaxf(a[i], a[l]), lo = vminf(a[i], a[l]); if ((i & k) == 0) { a[i] = hi; a[l] = lo; } else { a[i] = lo; a[l] = hi; } } }
}
template <int L> __device__ __forceinline__ void merge16(float (&a)[16], const float (&b)[16]) {
#pragma unroll
    for (int i = 0; i < 16; ++i) if (15 - i < L) a[i] = vmaxf(a[i], b[15 - i]);
#pragma unroll
    for (int j = 8; j > 0; j >>= 1)
#pragma unroll
        for (int i = 0; i < 16; ++i) { const int l = i ^ j; if (l > i) { const float hi = vmaxf(a[i], a[l]), lo = vminf(a[i], a[l]); a[i] = hi; a[l] = lo; } }
}
struct EpiTopK {
    static constexpr bool PERM = true, AFTER_DRAIN = true; static constexpr int MID_T = 0;
    static constexpr int RS = 260;
    const float* SS2; unsigned short* IDS; float* GATES; float eps;
    __device__ __forceinline__ void fused(f32x4 (&acc)[2][2][4][2], const Unit& u, int wr, int wc, int fr, int fq, PG8_LAS unsigned char* lds, int wid, int lane) const {
        PG8_LAS float* S = (PG8_LAS float*)lds;
        const int tid = wid * 64 + lane, row = tid & 127, grp = tid >> 7, half = grp >> 1, part = grp & 1;
#define TK_BAR() do { asm volatile("s_waitcnt vmcnt(0) lgkmcnt(0)" ::: "memory"); __builtin_amdgcn_s_barrier(); asm volatile("" ::: "memory"); } while (0)
#pragma unroll
        for (int ai = 0; ai < 2; ++ai) {
#pragma unroll
            for (int m = 0; m < 4; ++m)
#pragma unroll
                for (int bj = 0; bj < 2; ++bj)
#pragma unroll
                    for (int n = 0; n < 2; ++n) *(PG8_LAS f32x4*)(S + (wr * 64 + m * 16 + fr) * RS + bj * HALF + wc * 32 + 8 * fq + 4 * n) = acc[ai][bj][m][n];
            TK_BAR();
            float T[16];
#pragma unroll
            for (int b = 0; b < 4; ++b) {
                float c[16];
#pragma unroll
                for (int q = 0; q < 4; ++q) { const f32x4 v = *(const PG8_LAS f32x4*)(S + row * RS + half * 128 + part * 64 + b * 16 + q * 4);
#pragma unroll
                    for (int e = 0; e < 4; ++e) c[q * 4 + e] = __uint_as_float((__float_as_uint(v[e]) & ~127u) | (unsigned)(part * 64 + b * 16 + q * 4 + e)); }
                sort16_desc(c);
                if (b == 0) {
#pragma unroll
                    for (int i = 0; i < 16; ++i) T[i] = c[i];
                } else merge16<16>(T, c);
            }
            TK_BAR();
#pragma unroll
            for (int q = 0; q < 4; ++q) *(PG8_LAS f32x4*)(S + tid * 16 + q * 4) = (f32x4){T[q * 4], T[q * 4 + 1], T[q * 4 + 2], T[q * 4 + 3]};
            TK_BAR();
            if (part == 0) {
                float c[16];
#pragma unroll
                for (int q = 0; q < 4; ++q) { const f32x4 v = *(const PG8_LAS f32x4*)(S + (tid + 128) * 16 + q * 4); c[q * 4] = v[0]; c[q * 4 + 1] = v[1]; c[q * 4 + 2] = v[2]; c[q * 4 + 3] = v[3]; }
                merge16<16>(T, c);
            }
            TK_BAR();
            if (part == 0) {
#pragma unroll
                for (int q = 0; q < 4; ++q) *(PG8_LAS f32x4*)(S + tid * 16 + q * 4) = (f32x4){T[q * 4], T[q * 4 + 1], T[q * 4 + 2], T[q * 4 + 3]};
            }
            TK_BAR();
            if (tid < 128) {
                float a1[16], a2[16];
#pragma unroll
                for (int q = 0; q < 4; ++q) { const f32x4 v = *(const PG8_LAS f32x4*)(S + (tid + 256) * 16 + q * 4);
#pragma unroll
                    for (int e = 0; e < 4; ++e) a2[q * 4 + e] = __uint_as_float(__float_as_uint(v[e]) & ~127u); }
#pragma unroll
                for (int i = 0; i < 16; ++i) a1[i] = __uint_as_float(__float_as_uint(T[i]) & ~127u);
#define TK_SUM(i, j) __uint_as_float((__float_as_uint(a1[i] + a2[j]) & ~255u) | (unsigned)((i) * 16 + (j)))
                float R[16], C[16];
#pragma unroll
                for (int j = 0; j < 16; ++j) R[j] = TK_SUM(0, j);
#pragma unroll
                for (int i = 1; i < 16; ++i) C[i - 1] = TK_SUM(i, 0);
                C[15] = 0.f;
                merge16<15>(R, C);
                C[0] = TK_SUM(1, 1); C[1] = TK_SUM(1, 2); C[2] = TK_SUM(1, 3); C[3] = TK_SUM(1, 4); C[4] = TK_SUM(1, 5); C[5] = TK_SUM(1, 6); C[6] = TK_SUM(1, 7);
                C[7] = TK_SUM(2, 1); C[8] = TK_SUM(2, 2); C[9] = TK_SUM(2, 3); C[10] = TK_SUM(2, 4); C[11] = TK_SUM(3, 1); C[12] = TK_SUM(3, 2); C[13] = TK_SUM(3, 3);
                C[14] = TK_SUM(4, 1); C[15] = TK_SUM(4, 2);
                sort16_desc(C);
                merge16<16>(R, C);
                C[0] = TK_SUM(5, 1); C[1] = TK_SUM(6, 1); C[2] = TK_SUM(7, 1);
                merge16<3>(R, C);
#undef TK_SUM
                const int rowg = u.pm * BM + ai * HALF + row;
                const f32x4* ssp = (const f32x4*)(SS2 + (size_t)rowg * 16); const f32x4 s0 = ssp[0], s1 = ssp[1], s2 = ssp[2], s3 = ssp[3];
                const float ssum = ((s0[0] + s0[1]) + (s0[2] + s0[3])) + ((s1[0] + s1[1]) + (s1[2] + s1[3])) + ((s2[0] + s2[1]) + (s2[2] + s2[3])) + ((s3[0] + s3[1]) + (s3[2] + s3[3]));
                const float rl = 1.4426950408889634f / sqrtf(ssum * (1.0f / 1024.0f) + eps);
                float ev[16], esum = 0.f; int idv[16];
#pragma unroll
                for (int r = 0; r < 16; ++r) { ev[r] = __builtin_amdgcn_exp2f((R[r] - R[0]) * rl); esum += ev[r];
                    const unsigned code = __float_as_uint(R[r]) & 255u;
                    const unsigned k1 = __float_as_uint(S[tid * 16 + (code >> 4)]) & 127u, k2 = __float_as_uint(S[(tid + 256) * 16 + (code & 15u)]) & 127u;
                    idv[r] = (int)(k1 * 128u + k2); }
                const float inv = 1.0f / esum;
                unsigned short* ip = IDS + (size_t)rowg * 128 + u.pn * 16; float* gp = GATES + (size_t)rowg * 128 + u.pn * 16;
#pragma unroll
                for (int q = 0; q < 2; ++q) { u32x4 w; w.x = (unsigned)idv[q * 8] | ((unsigned)idv[q * 8 + 1] << 16); w.y = (unsigned)idv[q * 8 + 2] | ((unsigned)idv[q * 8 + 3] << 16); w.z = (unsigned)idv[q * 8 + 4] | ((unsigned)idv[q * 8 + 5] << 16); w.w = (unsigned)idv[q * 8 + 6] | ((unsigned)idv[q * 8 + 7] << 16);
                    *(u32x4*)(ip + q * 8) = w; }
#pragma unroll
                for (int q = 0; q < 4; ++q) *(f32x4*)(gp + q * 4) = (f32x4){ev[q * 4] * inv, ev[q * 4 + 1] * inv, ev[q * 4 + 2] * inv, ev[q * 4 + 3] * inv};
            }
            TK_BAR();
        }
#undef TK_BAR
    }
};
template <class Epi, class Sched, bool ALIGN_EPI = false, bool SP2 = false>
__device__ __forceinline__ void gemm_phase(PG8_LAS unsigned char* lds, const Gemm g, const Sched& S, const Epi& E) {
    const int tid = threadIdx.x, wid = __builtin_amdgcn_readfirstlane(tid >> 6), lane = tid & 63, wr = wid >> 2, wc = wid & 3, fr = lane & 15, fq = lane >> 4;
    const int K = g.K, nt = K / BK;
    unsigned voffA[2], voffB[2];
#pragma unroll
    for (int i = 0; i < 2; ++i) { int R, C; stage_rc(tid * 16 + i * 8192, R, C); const int Rb = Epi::PERM ? ((R & ~31) + perm32(R & 31)) : R;
        voffA[i] = (unsigned)(R * K + C) * 2u; voffB[i] = (unsigned)(Rb * K + C) * 2u; }
    const size_t kstep = (size_t)(BK * 2);
    const size_t hstep = (size_t)HALF * K * 2;
    const size_t tstep = 2 * hstep;
    const unsigned ldsw = (unsigned)wid * 1024u;
    const int aoff = lds_byte(wr * 64 + fr, fq * 8), boff = lds_byte(wc * 32 + fr, fq * 8);
#define PG8_SA(b, h) (((b) * 2 + (h)) * HTB)
#define PG8_SB(b, h) ((4 + (b) * 2 + (h)) * HTB)
#define PG8_STAGE(bufoff, gbase, voff) do { _Pragma("unroll") for (int _i = 0; _i < 2; ++_i) \
        __builtin_amdgcn_global_load_lds((const unsigned*)((const char*)(gbase) + (voff)[_i]), (PG8_LAS unsigned*)(lds + (bufoff) + ldsw + _i * 8192), 16, 0, 0); } while (0)
#define PG8_LDA(dst, b, h) do { _Pragma("unroll") for (int m = 0; m < 4; ++m) _Pragma("unroll") for (int k = 0; k < 2; ++k) dst[m][k] = *(const PG8_LAS bf16x8*)(lds + PG8_SA(b, h) + aoff + m * 2048 + k * 1024); } while (0)
#define PG8_LDB(dst, b, h) do { _Pragma("unroll") for (int n = 0; n < 2; ++n) _Pragma("unroll") for (int k = 0; k < 2; ++k) dst[n][k] = *(const PG8_LAS bf16x8*)(lds + PG8_SB(b, h) + boff + n * 2048 + k * 1024); } while (0)
#define PG8_MMA(ai, bj, At, Bt) do { __builtin_amdgcn_s_setprio(1); _Pragma("unroll") for (int m = 0; m < 4; ++m) _Pragma("unroll") for (int n = 0; n < 2; ++n) _Pragma("unroll") for (int k = 0; k < 2; ++k) \
        acc[ai][bj][m][n] = __builtin_amdgcn_mfma_f32_16x16x32_bf16(Bt[n][k], At[m][k], acc[ai][bj][m][n], 0, 0, 0); __builtin_amdgcn_s_setprio(0); } while (0)
#define PG8_WAIT_V(n) asm volatile("s_waitcnt vmcnt(" #n ")" ::: "memory")
#define PG8_WAIT_L(n) asm volatile("s_waitcnt lgkmcnt(" #n ")" ::: "memory")
#define PG8_BAR __builtin_amdgcn_s_barrier()
#define PG8_SCHED __builtin_amdgcn_sched_barrier(0)
    Unit cur, nxt; int ui = 0;
    if (!S.next(0, cur)) return;
    f32x4 acc[2][2][4][2];
#pragma unroll
    for (int a = 0; a < 2; ++a)
#pragma unroll
        for (int b = 0; b < 2; ++b)
#pragma unroll
            for (int m = 0; m < 4; ++m)
#pragma unroll
                for (int n = 0; n < 2; ++n) acc[a][b][m][n] = (f32x4){0.f, 0.f, 0.f, 0.f};
    bf16x8 At[4][2], B0[2][2], B1[2][2];
    const char* cA = (const char*)g.A + (size_t)cur.pm * tstep; const char* cB = (const char*)g.Bt + (size_t)cur.pn * tstep;
    S.a_ready(cur);
    if constexpr (SP2) {
        PG8_STAGE(PG8_SB(0, 0), cB, voffB); PG8_STAGE(PG8_SB(0, 1), cB + hstep, voffB); PG8_STAGE(PG8_SA(0, 0), cA, voffA); PG8_STAGE(PG8_SA(0, 1), cA + hstep, voffA);
        if (wr == 1) PG8_BAR;
        PG8_WAIT_V(2); PG8_BAR;
        PG8_STAGE(PG8_SB(1, 0), cB + kstep, voffB); PG8_STAGE(PG8_SA(1, 0), cA + kstep, voffA); PG8_STAGE(PG8_SB(1, 1), cB + hstep + kstep, voffB);
        PG8_WAIT_V(6); PG8_BAR;
    } else {
        PG8_STAGE(PG8_SB(0, 0), cB, voffB); PG8_STAGE(PG8_SA(0, 0), cA, voffA); PG8_STAGE(PG8_SB(0, 1), cB + hstep, voffB); PG8_STAGE(PG8_SA(0, 1), cA + hstep, voffA);
        if (wr == 1) PG8_BAR;
        PG8_WAIT_V(4); PG8_BAR;
        PG8_STAGE(PG8_SB(1, 0), cB + kstep, voffB); PG8_STAGE(PG8_SA(1, 0), cA + kstep, voffA); PG8_STAGE(PG8_SB(1, 1), cB + hstep + kstep, voffB);
        PG8_WAIT_V(6); PG8_BAR;
    }
    for (;;) {
        const bool has_next = S.next(ui + 1, nxt);
        const char* nA = has_next ? (const char*)g.A + (size_t)nxt.pm * tstep : cA; const char* nB = has_next ? (const char*)g.Bt + (size_t)nxt.pn * tstep : cB;
        for (int t = 0; t < nt; t += 2) {
            if constexpr (Epi::MID_T > 0) { if (t == Epi::MID_T) E.mid(acc, cur, wr, wc, fr, fq); }
            const bool last = (t == nt - 2);
            const char* a1 = cA + (size_t)(t + 1) * kstep;
            const char* a2 = last ? nA : cA + (size_t)(t + 2) * kstep; const char* b2 = last ? nB : cB + (size_t)(t + 2) * kstep;
            const char* a3 = a2 + kstep; const char* b3 = b2 + kstep;
            if (last && has_next) S.a_ready(nxt);
            if constexpr (SP2) {
            PG8_LDB(B0, 0, 0); PG8_LDB(B1, 0, 1); PG8_SCHED; PG8_LDA(At, 0, 0); PG8_STAGE(PG8_SA(1, 1), a1 + hstep, voffA);
            PG8_WAIT_V(8); PG8_WAIT_L(0); PG8_BAR; PG8_MMA(0, 0, At, B0); PG8_MMA(0, 1, At, B1); PG8_BAR; PG8_SCHED;
            PG8_LDA(At, 0, 1); PG8_STAGE(PG8_SB(0, 0), b2, voffB); PG8_STAGE(PG8_SB(0, 1), b2 + hstep, voffB); PG8_STAGE(PG8_SA(0, 0), a2, voffA);
            PG8_WAIT_V(8); PG8_WAIT_L(0); PG8_BAR; PG8_MMA(1, 0, At, B0); PG8_MMA(1, 1, At, B1); PG8_BAR; PG8_SCHED;
            PG8_LDB(B0, 1, 0); PG8_LDB(B1, 1, 1); PG8_SCHED; PG8_LDA(At, 1, 0); PG8_STAGE(PG8_SA(0, 1), a2 + hstep, voffA);
            PG8_WAIT_V(8); PG8_WAIT_L(0); PG8_BAR; PG8_MMA(0, 0, At, B0); PG8_MMA(0, 1, At, B1); PG8_BAR; PG8_SCHED;
            PG8_LDA(At, 1, 1); PG8_STAGE(PG8_SB(1, 0), b3, voffB); PG8_STAGE(PG8_SB(1, 1), b3 + hstep, voffB); PG8_STAGE(PG8_SA(1, 0), a3, voffA);
            PG8_WAIT_V(8); PG8_WAIT_L(0); PG8_BAR; PG8_MMA(1, 0, At, B0); PG8_MMA(1, 1, At, B1); PG8_BAR; PG8_SCHED;
            } else {
            PG8_LDB(B0, 0, 0); PG8_SCHED; PG8_LDA(At, 0, 0); PG8_STAGE(PG8_SA(1, 1), a1 + hstep, voffA);
            PG8_WAIT_L(8); PG8_BAR; PG8_WAIT_L(0); PG8_MMA(0, 0, At, B0); PG8_BAR; PG8_SCHED;
            PG8_LDB(B1, 0, 1); PG8_STAGE(PG8_SB(0, 0), b2, voffB);
            PG8_BAR; PG8_WAIT_L(0); PG8_MMA(0, 1, At, B1); PG8_BAR;
            PG8_LDA(At, 0, 1); PG8_STAGE(PG8_SA(0, 0), a2, voffA);
            PG8_BAR; PG8_WAIT_L(0); PG8_MMA(1, 0, At, B0); PG8_BAR; PG8_SCHED;
            PG8_STAGE(PG8_SB(0, 1), b2 + hstep, voffB);
            PG8_WAIT_V(6); PG8_BAR; PG8_MMA(1, 1, At, B1); PG8_BAR;
            PG8_LDB(B0, 1, 0); PG8_SCHED; PG8_LDA(At, 1, 0); PG8_STAGE(PG8_SA(0, 1), a2 + hstep, voffA);
            PG8_WAIT_L(8); PG8_BAR; PG8_WAIT_L(0); PG8_MMA(0, 0, At, B0); PG8_BAR; PG8_SCHED;
            PG8_LDB(B1, 1, 1); PG8_STAGE(PG8_SB(1, 0), b3, voffB);
            PG8_BAR; PG8_WAIT_L(0); PG8_MMA(0, 1, At, B1); PG8_BAR;
            PG8_LDA(At, 1, 1); PG8_STAGE(PG8_SA(1, 0), a3, voffA);
            PG8_BAR; PG8_WAIT_L(0); PG8_MMA(1, 0, At, B0); PG8_BAR; PG8_SCHED;
            PG8_STAGE(PG8_SB(1, 1), b3 + hstep, voffB);
            PG8_WAIT_V(6); PG8_BAR; PG8_MMA(1, 1, At, B1); PG8_BAR;
            }
        }
        if constexpr (ALIGN_EPI) { if (wr == 0) PG8_BAR; }
        if constexpr (!Epi::AFTER_DRAIN) { E(acc, cur, wr, wc, fr, fq); S.done(cur); }
        if (!has_next) break;
#pragma unroll
        for (int a = 0; a < 2; ++a)
#pragma unroll
            for (int b = 0; b < 2; ++b)
#pragma unroll
                for (int m = 0; m < 4; ++m)
#pragma unroll
                    for (int n = 0; n < 2; ++n) acc[a][b][m][n] = (f32x4){0.f, 0.f, 0.f, 0.f};
        cur = nxt; cA = nA; cB = nB; ++ui;
        if constexpr (ALIGN_EPI) { if (wr == 1) PG8_BAR; }
    }
    PG8_WAIT_V(0);
    if constexpr (!ALIGN_EPI) { if (wr == 0) PG8_BAR; }
    PG8_BAR;
    if constexpr (Epi::AFTER_DRAIN) { E.fused(acc, cur, wr, wc, fr, fq, lds, wid, lane); S.done(cur); }
#undef PG8_SA
#undef PG8_SB
#undef PG8_STAGE
#undef PG8_LDA
#undef PG8_LDB
#undef PG8_MMA
#undef PG8_WAIT_V
#undef PG8_WAIT_L
#undef PG8_BAR
#undef PG8_SCHED
}
}
#ifndef PG8_SP2
#define PG8_SP2 true
#endif
#ifndef PG8_ALIGN
#define PG8_ALIGN true
#endif
namespace attn_body {
using bf16=__hip_bfloat16;
using bf16x8=__attribute__((ext_vector_type(8)))short;
using s16x4=__attribute__((ext_vector_type(4)))short;
using f32x16=__attribute__((ext_vector_type(16)))float;
using u32x4=__attribute__((ext_vector_type(4)))unsigned;
using f32x4v=__attribute__((ext_vector_type(4)))float;
constexpr int BATCH=4,NHEAD=8,SEQ=4096,D=64,DM=NHEAD*D,DMO=1024;
constexpr int NW=8,QBLK=32,QB=QBLK*NW,KVBLK=64,NQB=SEQ/QB;
constexpr int ATTN_PITCH=DM, ATTN_UNIT_ROWS=QB;
__device__ __forceinline__ int crow(int r,int hi){return (r&3)+8*(r>>2)+4*hi;}
#define SBAR() __builtin_amdgcn_sched_barrier(0)
__device__ __forceinline__ void cmask(f32x16&p0,f32x16&p1,int jb,int qrel,int hi){
  const float NEG=-INFINITY; int kb=64*jb+4*hi;
  #pragma unroll
  for(int r=0;r<16;++r){int kv=kb+(r&3)+8*(r>>2); if(kv>qrel)p0[r]=NEG; if(kv+32>qrel)p1[r]=NEG;}
}

constexpr int NSLOT=3, SLOTB=8192;
constexpr int LDS_K=0, LDS_V=NSLOT*SLOTB, LDS_WS=2*NSLOT*SLOTB, LDS_OST=LDS_WS+NW*64*4, LDS_CS=LDS_OST+NW*4096, LDS_BYTES=LDS_CS+SEQ*4+64;
constexpr float C2=0.125f*1.4426950408889634f;
__device__ __forceinline__ void glds16(const void*gsrc,unsigned lds_dst){unsigned keep;
  asm volatile("s_mov_b32 %0, m0\n\ts_mov_b32 m0, %2\n\ts_nop 0\n\tglobal_load_lds_dwordx4 %1, off\n\ts_mov_b32 m0, %0":"=&s"(keep):"v"(gsrc),"s"(lds_dst):"memory");}
__device__ __forceinline__ float max3f(float a,float b,float c){float r;asm("v_max3_f32 %0, %1, %2, %3":"=v"(r):"v"(a),"v"(b),"v"(c));return r;}
__device__ __forceinline__ float max2f(float a,float b){float r;asm("v_max_f32_e32 %0, %1, %2":"=v"(r):"v"(a),"v"(b));return r;}
__device__ __forceinline__ float fadd_s(float a,float b){float r;asm("v_add_f32_e32 %0, %1, %2":"=v"(r):"v"(a),"v"(b));return r;}
__device__ __forceinline__ float fsub_s(float a,float b){float r;asm("v_sub_f32_e32 %0, %1, %2":"=v"(r):"v"(a),"v"(b));return r;}
typedef float f32x2_t __attribute__((ext_vector_type(2))); typedef __bf16 bf16x2_t __attribute__((ext_vector_type(2)));
__device__ __forceinline__ unsigned cvtpk_s(float lo,float hi){f32x2_t v={lo,hi};bf16x2_t b=__builtin_convertvector(v,bf16x2_t);return __builtin_bit_cast(unsigned,b);}
#define WAIT_BAR(N) asm volatile("s_waitcnt vmcnt(" #N ") lgkmcnt(0)\n\ts_barrier":::"memory")

__device__ __forceinline__ void qkt(f32x16&p0,f32x16&p1,const char*Kslot,const bf16x8*qr,const f32x16&c0,const f32x16&c1,int r32,int hi){
  const char*kb=Kslot+hi*1024+r32*16;
  #pragma unroll
  for(int d0=0;d0<4;++d0){
    const bf16x8 b0=*reinterpret_cast<const bf16x8*>(kb+d0*2048);
    const bf16x8 b1=*reinterpret_cast<const bf16x8*>(kb+d0*2048+512);
    if(d0==0){p0=__builtin_amdgcn_mfma_f32_32x32x16_bf16(b0,qr[0],c0,0,0,0);p1=__builtin_amdgcn_mfma_f32_32x32x16_bf16(b1,qr[0],c1,0,0,0);}
    else{p0=__builtin_amdgcn_mfma_f32_32x32x16_bf16(b0,qr[d0],p0,0,0,0);p1=__builtin_amdgcn_mfma_f32_32x32x16_bf16(b1,qr[d0],p1,0,0,0);}}
}
typedef __attribute__((address_space(3))) const char* lds_cptr;
typedef short v4i16_t __attribute__((ext_vector_type(4)));
__device__ __forceinline__ void kload8(bf16x8*kf,lds_cptr kp){
  kf[0]=*(const __attribute__((address_space(3))) bf16x8*)(kp);      kf[1]=*(const __attribute__((address_space(3))) bf16x8*)(kp+512);
  kf[2]=*(const __attribute__((address_space(3))) bf16x8*)(kp+2048); kf[3]=*(const __attribute__((address_space(3))) bf16x8*)(kp+2560);
  kf[4]=*(const __attribute__((address_space(3))) bf16x8*)(kp+4096); kf[5]=*(const __attribute__((address_space(3))) bf16x8*)(kp+4608);
  kf[6]=*(const __attribute__((address_space(3))) bf16x8*)(kp+6144); kf[7]=*(const __attribute__((address_space(3))) bf16x8*)(kp+6656);
}
__device__ __forceinline__ void kload2(bf16x8*kf,lds_cptr kp,int j){ kf[2*j]=*(const __attribute__((address_space(3))) bf16x8*)(kp+j*2048); kf[2*j+1]=*(const __attribute__((address_space(3))) bf16x8*)(kp+j*2048+512); }
__device__ __forceinline__ s16x4 vtr(lds_cptr p){ return __builtin_bit_cast(s16x4,__builtin_amdgcn_ds_read_tr16_b64_v4i16((__attribute__((address_space(3))) v4i16_t*)p)); }
__device__ __forceinline__ float rowmax(const f32x16&p0,const f32x16&p1){
  float a=max3f(p0[0],p0[1],p1[0]),b=max3f(p0[2],p0[3],p1[1]);a=max3f(a,p1[2],p1[3]);
  #pragma unroll
  for(int r=4;r<16;r+=4){a=max3f(a,p0[r],p0[r+1]);b=max3f(b,p0[r+2],p0[r+3]);a=max3f(a,p1[r],p1[r+1]);b=max3f(b,p1[r+2],p1[r+3]);}
  const float m=max2f(a,b);
  auto rr=__builtin_amdgcn_permlane32_swap(__float_as_uint(m),__float_as_uint(m),false,false);
  return max2f(__uint_as_float(rr[0]),__uint_as_float(rr[1]));
}
__device__ __forceinline__ void pv(f32x16*o,int vb,bf16x8 pa0,bf16x8 pa1,bf16x8 pa2,bf16x8 pa3){
  #pragma unroll
  for(int d0=0;d0<2;++d0){s16x4 lo[4],hi[4];
    #pragma unroll
    for(int ks=0;ks<4;++ks){
      asm volatile("ds_read_b64_tr_b16 %0,%1 offset:%c2":"=&v"(lo[ks]):"v"(vb),"i"(d0*4096+ks*1024):"memory");
      asm volatile("ds_read_b64_tr_b16 %0,%1 offset:%c2":"=&v"(hi[ks]):"v"(vb),"i"(d0*4096+ks*1024+512):"memory");}
    asm volatile("s_waitcnt lgkmcnt(0)":::"memory");SBAR();
    #define PK(k) (bf16x8){lo[k][0],lo[k][1],lo[k][2],lo[k][3],hi[k][0],hi[k][1],hi[k][2],hi[k][3]}
    o[d0]=__builtin_amdgcn_mfma_f32_32x32x16_bf16(pa0,PK(0),o[d0],0,0,0);
    o[d0]=__builtin_amdgcn_mfma_f32_32x32x16_bf16(pa1,PK(1),o[d0],0,0,0);
    o[d0]=__builtin_amdgcn_mfma_f32_32x32x16_bf16(pa2,PK(2),o[d0],0,0,0);
    o[d0]=__builtin_amdgcn_mfma_f32_32x32x16_bf16(pa3,PK(3),o[d0],0,0,0);
    #undef PK
  }
}

#ifndef ATTN_STORE16
#define ATTN_STORE16(p,v) (*(u32x4*)(p)=(v))
#endif
template<int THRL> __device__ __forceinline__ void attn_unit(int b,int h,int qb,const bf16*Q,const bf16*__restrict__ K,const bf16*__restrict__ V,bf16*O,const float*__restrict__ LFrow,char*shm){
  const int tid=threadIdx.x,lane=tid&63,r32=lane&31,hi=lane>>5; const int wid=__builtin_amdgcn_readfirstlane(tid>>6);
  const long rowbase=(long)b*SEQ; const int q0=qb*QB;
  const bf16*Qw=Q+(rowbase+q0+wid*QBLK)*DM+h*D;
  const bf16*Kh=K+rowbase*DM+h*D,*Vh=V+rowbase*DM+h*D;
  const lds_cptr shm3=(lds_cptr)shm;
  const unsigned lds0=(unsigned)(uintptr_t)shm;
  float*wsf=(float*)(shm+LDS_WS)+wid*64;
  const bf16*ksrc=Kh+(long)lane*DM+wid*8;
  const bf16*vsrc=Vh+(long)(16*(wid&3)+(lane>>2))*DM+(wid>>2)*32+(lane&3)*8;
  const unsigned kdst=lds0+LDS_K+wid*1024, vdst=lds0+LDS_V+wid*1024;
  #define DMA_K(t,slot) glds16(ksrc+(long)(t)*KVBLK*DM,(unsigned)__builtin_amdgcn_readfirstlane(kdst+(slot)))
  #define DMA_V(t,slot) glds16(vsrc+(long)(t)*KVBLK*DM,(unsigned)__builtin_amdgcn_readfirstlane(vdst+(slot)))
  const int vb0=(int)(lds0+LDS_V)+((lane>>4)&1)*32+(lane&3)*8+(4*hi+((lane&15)>>2))*64;
  const char*Kbase=shm+LDS_K; bf16x8 kf[8];
  const lds_cptr kp0=shm3+LDS_K+hi*1024+r32*16; const lds_cptr vp0=shm3+LDS_V+((lane>>4)&1)*32+(lane&3)*8+(4*hi+((lane&15)>>2))*64;
  const int NT=(q0+QB)/KVBLK;
  typedef __attribute__((address_space(3))) float lds_f32; typedef __attribute__((address_space(3))) f32x4v lds_f32x4;
  lds_f32* const csl=(lds_f32*)(shm3+LDS_CS);
  { const int ncs=q0+QB, i0=tid*8; f32x4v ca={0.f,0.f,0.f,0.f},cb={0.f,0.f,0.f,0.f};
    if(i0<ncs){ca=*(const f32x4v*)(LFrow+i0);cb=*(const f32x4v*)(LFrow+i0+4);}
    ca.y+=ca.x;ca.z+=ca.y;ca.w+=ca.z;cb.x+=ca.w;cb.y+=cb.x;cb.z+=cb.y;cb.w+=cb.z;
    const float tot=cb.w; float inc=tot;
    _Pragma("unroll") for(int o_=1;o_<64;o_<<=1){const float v_=__shfl_up(inc,o_);if(lane>=o_)inc+=v_;}
    if(lane==63)csl[SEQ+wid]=inc;
    asm volatile("s_waitcnt vmcnt(0) lgkmcnt(0)\n\ts_barrier":::"memory");
    float base_=inc-tot;
    _Pragma("unroll") for(int w_=0;w_<NW;++w_){const float t_=csl[SEQ+w_];if(w_<wid)base_+=t_;}
    if(i0<ncs){*(lds_f32x4*)(csl+i0)=ca+base_;*(lds_f32x4*)(csl+i0+4)=cb+base_;}
    asm volatile("s_waitcnt vmcnt(0) lgkmcnt(0)\n\ts_barrier":::"memory"); }
  const float cq=csl[q0+wid*QBLK+r32];
  const lds_cptr csb=shm3+LDS_CS+hi*16;
  #define CINIT(C0,C1,t) do{ _Pragma("unroll") for(int g_=0;g_<4;++g_){ const f32x4v a_=*(const lds_f32x4*)(csb+(t)*256+g_*32), b_=*(const lds_f32x4*)(csb+(t)*256+128+g_*32); \
      C0[4*g_]=cqm-a_.x;C0[4*g_+1]=cqm-a_.y;C0[4*g_+2]=cqm-a_.z;C0[4*g_+3]=cqm-a_.w; C1[4*g_]=cqm-b_.x;C1[4*g_+1]=cqm-b_.y;C1[4*g_+2]=cqm-b_.z;C1[4*g_+3]=cqm-b_.w; } }while(0)
  DMA_K(0,0);DMA_V(0,0);DMA_K(1,SLOTB);
  bf16x8 qr[4];
  #pragma unroll
  for(int d0=0;d0<4;++d0)qr[d0]=*reinterpret_cast<const bf16x8*>(&Qw[(long)r32*DM+d0*16+hi*8]);
  float mhat=0.f,l_reg=0.f,cqm=cq;f32x16 o[2];o[0]=f32x16{};o[1]=f32x16{};
  const int qrel=wid*QBLK+r32;
  #define CMASK(P0,P1,t) do{int jb_=(t)-(NT-4); if(jb_>=0)cmask(P0,P1,jb_,qrel,hi);}while(0)
  bool resc=false;
  #define START(P0,P1) do{ const float rm=rowmax(P0,P1); resc=false; \
    { const float dl=rm; mhat=fadd_s(mhat,dl); \
      _Pragma("unroll") for(int r=0;r<16;++r){P0[r]=fsub_s(P0[r],dl);P1[r]=fsub_s(P1[r],dl);} \
      cqm=cq-mhat; } \
    _Pragma("unroll") for(int r=0;r<16;++r)P0[r]=__builtin_amdgcn_exp2f(P0[r]); }while(0)
  #define RESC() do{ if(resc){ asm volatile("s_waitcnt lgkmcnt(0)":::"memory"); \
      _Pragma("unroll") for(int d_=0;d_<2;++d_) _Pragma("unroll") for(int r=0;r<16;++r)o[d_][r]*=wsf[crow(r,hi)]; } }while(0)
  f32x16 pA0,pA1,pB0,pB1;
  int sl_prev=0,sl_cur=0,sl_next=SLOTB;
  #define ROT() do{sl_prev=sl_cur;sl_cur=sl_next;sl_next=(sl_next==(NSLOT-1)*SLOTB)?0:sl_next+SLOTB;}while(0)
  DMA_K(2,2*SLOTB);
  WAIT_BAR(3);
  { f32x16 ci0,ci1; CINIT(ci0,ci1,0); qkt(pA0,pA1,Kbase,qr,ci0,ci1,r32,hi); } asm volatile("s_nop 15\n\ts_nop 7":"+v"(pA0),"+v"(pA1));CMASK(pA0,pA1,0);
  START(pA0,pA1);
  _Pragma("unroll") for(int r=0;r<16;++r)pA1[r]=__builtin_amdgcn_exp2f(pA1[r]);
  WAIT_BAR(0);
  DMA_K(3,0);DMA_V(1,SLOTB);
  ROT();
  kload8(kf,kp0+sl_cur);
  WAIT_BAR(2);
  s16x4 vlo[8],vhi[8]; u32x4 pw0,pw1,pw2,pw3;
  #define PKW(P,B) cvtpk_s(P[B],P[B+1])
  #define PAF(k) __builtin_bit_cast(bf16x8,pw##k)
  #define VFR(i) (bf16x8){vlo[i][0],vlo[i][1],vlo[i][2],vlo[i][3],vhi[i][0],vhi[i][1],vhi[i][2],vhi[i][3]}
  #define PIN(x) asm volatile("":"+v"(x))
  #define MX3(a,b,c) __builtin_fmaxf(__builtin_fmaxf((a),(b)),(c))
  #define GAPA(MF,A0,A1,A2,A3,W0,W1,PW) do{ MF; sacc+=A0; sacc+=A1; sacc+=A2; sacc+=A3; PIN(sacc); W0; W1; PIN(PW); SBAR(); }while(0)
  #define EX(v) __builtin_amdgcn_exp2f(v)
  #define GAPB(MF,X,B) do{ MF; X[B]=EX(X[B]); X[B+1]=EX(X[B+1]); X[B+2]=EX(X[B+2]); X[B+3]=EX(X[B+3]); PIN(X); SBAR(); }while(0)
  #define VRD(i) do{ vlo[i]=vtr(vp_+(((i)>>2)*4096+((i)&3)*1024)); vhi[i]=vtr(vp_+(((i)>>2)*4096+((i)&3)*1024+512)); }while(0)
  #define KRD(G,j) do{ if(G){ kload2(kf,kp0+sl_next,j); SBAR(); } }while(0)
  #define STEP(C0,C1,P0,P1,t,GK,GV,GL) do{ SBAR(); \
    CINIT(C0,C1,t); SBAR(); \
    const lds_cptr vp_=vp0+sl_prev; \
    VRD(0); SBAR(); float sacc=(P0[0]+P0[1]); \
    GAPA(C0=__builtin_amdgcn_mfma_f32_32x32x16_bf16(kf[0],qr[0],C0,0,0,0), P0[2],P0[3],P0[4],P0[5],     pw0[0]=PKW(P0,0), pw0[1]=PKW(P0,2), pw0); \
    VRD(4); SBAR(); GAPA(C1=__builtin_amdgcn_mfma_f32_32x32x16_bf16(kf[1],qr[0],C1,0,0,0), P0[6],P0[7],P0[8],P0[9],     pw0[2]=PKW(P0,4), pw0[3]=PKW(P0,6), pw0); \
    VRD(1); SBAR(); GAPA(C0=__builtin_amdgcn_mfma_f32_32x32x16_bf16(kf[2],qr[1],C0,0,0,0),   P0[10],P0[11],P0[12],P0[13], pw1[0]=PKW(P0,8), pw1[1]=PKW(P0,10), pw1); \
    VRD(5); SBAR(); GAPA(C1=__builtin_amdgcn_mfma_f32_32x32x16_bf16(kf[3],qr[1],C1,0,0,0),   P0[14],P0[15],P1[0],P1[1],   pw1[2]=PKW(P0,12),pw1[3]=PKW(P0,14), pw1); \
    VRD(2); SBAR(); GAPA(C0=__builtin_amdgcn_mfma_f32_32x32x16_bf16(kf[4],qr[2],C0,0,0,0),   P1[2],P1[3],P1[4],P1[5],     pw2[0]=PKW(P1,0), pw2[1]=PKW(P1,2), pw2); \
    VRD(6); SBAR(); GAPA(C1=__builtin_amdgcn_mfma_f32_32x32x16_bf16(kf[5],qr[2],C1,0,0,0),   P1[6],P1[7],P1[8],P1[9],     pw2[2]=PKW(P1,4), pw2[3]=PKW(P1,6), pw2); \
    VRD(3); SBAR(); GAPA(C0=__builtin_amdgcn_mfma_f32_32x32x16_bf16(kf[6],qr[3],C0,0,0,0),   P1[10],P1[11],P1[12],P1[13], pw3[0]=PKW(P1,8), pw3[1]=PKW(P1,10), pw3); \
    VRD(7); SBAR(); GAPA(C1=__builtin_amdgcn_mfma_f32_32x32x16_bf16(kf[7],qr[3],C1,0,0,0),   P1[14],P1[15],0.f,0.f,       pw3[2]=PKW(P1,12),pw3[3]=PKW(P1,14), pw3); \
    l_reg+=sacc; \
    if(GK){DMA_K((t)+3,sl_cur);} if(GV){DMA_V((t)+1,sl_next);} \
    CMASK(C0,C1,t); \
    { float a=MX3(C0[0],C0[1],C1[0]),b=MX3(C0[2],C0[3],C1[1]); a=MX3(a,C1[2],C1[3]); \
      _Pragma("unroll") for(int r=4;r<16;r+=4){a=MX3(a,C0[r],C0[r+1]);b=MX3(b,C0[r+2],C0[r+3]);a=MX3(a,C1[r],C1[r+1]);b=MX3(b,C1[r+2],C1[r+3]);} \
      float rm=__builtin_fmaxf(a,b); { auto rr=__builtin_amdgcn_permlane32_swap(__float_as_uint(rm),__float_as_uint(rm),false,false); rm=__builtin_fmaxf(__uint_as_float(rr[0]),__uint_as_float(rr[1])); } \
      resc=false; \
      if(__builtin_expect(__any(rm>(float)THRL),0)){ const float dl=__builtin_fmaxf(rm,0.f); mhat+=dl; \
        _Pragma("unroll") for(int r=0;r<16;++r){C0[r]-=dl;C1[r]-=dl;} \
        cqm=cq-mhat; \
        const float f=__builtin_amdgcn_exp2f(-dl); l_reg*=f; if(hi==0)wsf[r32]=f; resc=true; } } \
    SBAR(); \
    GAPB(o[0]=__builtin_amdgcn_mfma_f32_32x32x16_bf16(PAF(0),VFR(0),o[0],0,0,0), C0,0); \
    GAPB(o[1]=__builtin_amdgcn_mfma_f32_32x32x16_bf16(PAF(0),VFR(4),o[1],0,0,0), C0,4); \
    KRD(GL,0); GAPB(o[0]=__builtin_amdgcn_mfma_f32_32x32x16_bf16(PAF(1),VFR(1),o[0],0,0,0), C0,8); \
    KRD(GL,1); GAPB(o[1]=__builtin_amdgcn_mfma_f32_32x32x16_bf16(PAF(1),VFR(5),o[1],0,0,0), C0,12); \
    KRD(GL,2); GAPB(o[0]=__builtin_amdgcn_mfma_f32_32x32x16_bf16(PAF(2),VFR(2),o[0],0,0,0), C1,0); \
    KRD(GL,3); GAPB(o[1]=__builtin_amdgcn_mfma_f32_32x32x16_bf16(PAF(2),VFR(6),o[1],0,0,0), C1,4); \
    GAPB(o[0]=__builtin_amdgcn_mfma_f32_32x32x16_bf16(PAF(3),VFR(3),o[0],0,0,0), C1,8); \
    GAPB(o[1]=__builtin_amdgcn_mfma_f32_32x32x16_bf16(PAF(3),VFR(7),o[1],0,0,0), C1,12); \
    }while(0)
  int t=1;
  #undef CMASK
  #define CMASK(P0,P1,t) do{}while(0)
  for(;t+5<NT;t+=2){
    STEP(pB0,pB1,pA0,pA1,t,true,true,true);     WAIT_BAR(2); RESC(); ROT();
    STEP(pA0,pA1,pB0,pB1,t+1,true,true,true);   WAIT_BAR(2); RESC(); ROT();
  }
  #undef CMASK
  #define CMASK(P0,P1,t) do{int jb_=(t)-(NT-4); if(jb_>=0)cmask(P0,P1,jb_,qrel,hi);}while(0)
  #define ENDW(tt) do{ if((tt)+3<NT){WAIT_BAR(2);} else if((tt)+2<NT){WAIT_BAR(1);} else {WAIT_BAR(0);} }while(0)
  for(;t+1<NT;t+=2){
    STEP(pB0,pB1,pA0,pA1,t,(t+3<NT),(t+1<NT),(t+1<NT));       ENDW(t);   RESC(); ROT();
    STEP(pA0,pA1,pB0,pB1,t+1,(t+4<NT),(t+2<NT),(t+2<NT));     ENDW(t+1); RESC(); ROT();
  }
  STEP(pB0,pB1,pA0,pA1,NT-1,false,false,false); RESC();
  { float sacc=pB0[0]+pB0[1]; _Pragma("unroll") for(int r=2;r<16;++r)sacc+=pB0[r]; _Pragma("unroll") for(int r=0;r<16;++r)sacc+=pB1[r]; l_reg+=sacc;
    pw0=(u32x4){PKW(pB0,0),PKW(pB0,2),PKW(pB0,4),PKW(pB0,6)};pw1=(u32x4){PKW(pB0,8),PKW(pB0,10),PKW(pB0,12),PKW(pB0,14)};pw2=(u32x4){PKW(pB1,0),PKW(pB1,2),PKW(pB1,4),PKW(pB1,6)};pw3=(u32x4){PKW(pB1,8),PKW(pB1,10),PKW(pB1,12),PKW(pB1,14)};
    SBAR(); pv(o,vb0+sl_cur,PAF(0),PAF(1),PAF(2),PAF(3)); }
  #undef PKW
  #undef PAF
  #undef VFR
  #undef PIN
  #undef MX3
  #undef GAPA
  #undef GAPB
  #undef EX
  #undef VRD
  #undef KRD
  #undef STEP
  #undef ENDW
  {auto rr=__builtin_amdgcn_permlane32_swap(__float_as_uint(l_reg),__float_as_uint(l_reg),false,false);l_reg=__uint_as_float(rr[0])+__uint_as_float(rr[1]);}
  if(hi==0)wsf[32+r32]=l_reg;asm volatile("s_waitcnt lgkmcnt(0)":::"memory");
  float rli[16];
  #pragma unroll
  for(int r=0;r<16;++r)rli[r]=__builtin_amdgcn_rcpf(wsf[32+crow(r,hi)]);
  bf16*Ow=O+(rowbase+q0+wid*QBLK)*DMO+h*D;
  { bf16*stg=(bf16*)(shm+LDS_OST)+wid*2048;
    #pragma unroll
    for(int r=0;r<16;++r){const int orow=crow(r,hi);
      #pragma unroll
      for(int d0=0;d0<2;++d0)stg[orow*64+d0*32+r32]=__float2bfloat16(o[d0][r]*rli[r]);}
    asm volatile("s_waitcnt lgkmcnt(0)":::"memory");
    #pragma unroll
    for(int i=0;i<4;++i){const int row=i*8+(lane>>3),ch=lane&7; const u32x4 v=*(const u32x4*)(stg+row*64+ch*8); ATTN_STORE16(Ow+(long)row*DMO+ch*8,v);} }
  asm volatile("s_waitcnt lgkmcnt(0)\n\ts_barrier":::"memory");
  #undef DMA_K
  #undef DMA_V
  #undef CMASK
  #undef START
  #undef RESC
  #undef ROT
  #undef CINIT
}
constexpr int ATTN_LDS_BYTES=LDS_BYTES;
struct AttnTensors { const bf16* Q; const bf16* K; const bf16* V; bf16* O; const float* LF; };
struct AttnUnit { int bh; int qb; };
struct StaticOrder {
  int vcu, G;
  __device__ __forceinline__ StaticOrder(int grid,int vcu_):vcu(vcu_),G(grid){}
  __device__ __forceinline__ bool next(int i,AttnUnit&u)const{
    if(G==256){ if(i>=2)return false; const int s=vcu&7; u.bh=vcu>>3; u.qb=(i==0)?15-s:s; return true; }
    const int idx=i*G+vcu; if(idx>=BATCH*NHEAD*NQB)return false; u.qb=NQB-1-idx/(BATCH*NHEAD); u.bh=idx%(BATCH*NHEAD); return true; }
  __device__ __forceinline__ void a_ready(const AttnUnit&)const{}
  __device__ __forceinline__ void done(const AttnUnit&)const{}
};
template<class Sched,int THRL=8> __device__ __forceinline__ void attn_phase(char*lds,const AttnTensors&T,const Sched&S){
  AttnUnit u;
  for(int i=0;S.next(i,u);++i){ S.a_ready(u); attn_unit<THRL>(u.bh/NHEAD,u.bh%NHEAD,u.qb,T.Q,T.K,T.V,T.O,T.LF+(size_t)u.bh*SEQ,lds); S.done(u); }
}
#undef SBAR
#undef WAIT_BAR
}
#define GAS __attribute__((address_space(1)))
#define LAS __attribute__((address_space(3)))
typedef unsigned short bf16;
typedef unsigned v4u __attribute__((ext_vector_type(4)));
typedef float f32x4 __attribute__((ext_vector_type(4)));
typedef short bf16x8 __attribute__((ext_vector_type(8)));
typedef GAS unsigned gu32;
typedef GAS unsigned long long gu64;
#define RLX_AGENT __ATOMIC_RELAXED, __HIP_MEMORY_SCOPE_AGENT
#define LDS_WAIT() asm volatile("s_waitcnt lgkmcnt(0)" ::: "memory")
#define VM_WAIT() asm volatile("s_waitcnt vmcnt(0)" ::: "memory")
__device__ __forceinline__ unsigned long long rt() { return __builtin_amdgcn_s_memrealtime(); }
__device__ __forceinline__ unsigned f2bf(float f) { unsigned u = __builtin_bit_cast(unsigned, f); return (u + 0x7fffu + ((u >> 16) & 1u)) >> 16; }
__device__ __forceinline__ unsigned pk2(float lo, float hi) { return f2bf(lo) | (f2bf(hi) << 16); }

#define XB_TMO      128
#define XB_XCNT(j)  (256  + 64 * (j))
#define XB_XSUB(j)  (1280 + 64 * (j))
#define XB_XGEN(j)  (2304 + 64 * (j))
#define XB_TOP      3328
#define XB_TOPGEN   3392
#define XCD_BAR_WORDS 3456
#define XB_SPIN_CAP (1u << 18)

__device__ __forceinline__ unsigned xb_ld(unsigned* p)              { return __hip_atomic_load(p, __ATOMIC_RELAXED, __HIP_MEMORY_SCOPE_AGENT); }
__device__ __forceinline__ unsigned xb_add(unsigned* p, unsigned v) { return __hip_atomic_fetch_add(p, v, __ATOMIC_RELAXED, __HIP_MEMORY_SCOPE_AGENT); }
__device__ __forceinline__ unsigned xb_xcc_id() { return (unsigned)__builtin_amdgcn_s_getreg((3 << 11) | 20) & 0xFu; }
#define XB_SPIN(cond, bar) do { unsigned _sp = 0; while (cond) { __builtin_amdgcn_s_sleep(1); \
    if ((++_sp & 255u) == 0u) { if (xb_ld(&(bar)[XB_TMO])) break; if (_sp > XB_SPIN_CAP) { atomicAdd(&(bar)[XB_TMO], 1u); break; } } } } while (0)

struct XcdBarrier {
    unsigned* bar; unsigned x;
    volatile LAS unsigned* st;
};

__device__ __forceinline__ XcdBarrier xcd_barrier_post(unsigned* bar, volatile LAS unsigned* st) {
    XcdBarrier b; b.bar = bar; b.x = xb_xcc_id(); b.st = st;
    if (threadIdx.x == 0) (void)xb_add(&bar[XB_XCNT(b.x)], 1u);
    return b;
}
__device__ __forceinline__ void xcd_barrier_complete(unsigned* bar, unsigned x, unsigned& nloc, unsigned& nx) {
    const unsigned G = gridDim.x * gridDim.y * gridDim.z;
    unsigned sum, cnt, mine, sp = 0u;
    for (;;) {
        sum = 0u; cnt = 0u; mine = 0u;
#pragma unroll
        for (unsigned j = 0; j < 16; ++j) { const unsigned c = xb_ld(&bar[XB_XCNT(j)]); sum += c; cnt += (c > 0u) ? 1u : 0u; mine = (j == x) ? c : mine; }
        if (sum == G) break;
        __builtin_amdgcn_s_sleep(1);
        if ((++sp & 255u) == 0u) { if (xb_ld(&bar[XB_TMO])) break; if (sp > XB_SPIN_CAP) { atomicAdd(&bar[XB_TMO], 1u); break; } }
    }
    nloc = mine > 0u ? mine : 1u; nx = cnt > 0u ? cnt : 1u;
}

__device__ __forceinline__ void xcd_barrier(const XcdBarrier& b) {
    asm volatile("s_waitcnt vmcnt(0)" ::: "memory");
    __syncthreads();
    if (threadIdx.x == 0) {
        unsigned* bar = b.bar;
        __builtin_amdgcn_s_waitcnt(0);
        unsigned nloc = b.st[0], nx = b.st[1];
        if (nloc == 0u) { xcd_barrier_complete(bar, b.x, nloc, nx); b.st[0] = nloc; b.st[1] = nx; }
        const unsigned old = xb_add(&bar[XB_XSUB(b.x)], 1u);
        const unsigned gen = old / nloc;
        if (old + 1u == (gen + 1u) * nloc) {
            __builtin_amdgcn_fence(__ATOMIC_RELEASE, "agent");
            asm volatile("s_waitcnt vmcnt(0)" ::: "memory");
            const unsigned og = xb_add(&bar[XB_TOP], 1u);
            const unsigned tg = og / nx;
            if (og + 1u == (tg + 1u) * nx) xb_add(&bar[XB_TOPGEN], 1u);
            else XB_SPIN(xb_ld(&bar[XB_TOPGEN]) == tg, bar);
            __builtin_amdgcn_fence(__ATOMIC_ACQUIRE, "agent");
            xb_add(&bar[XB_XGEN(b.x)], 1u);
            asm volatile("s_waitcnt vmcnt(0)" ::: "memory");
        } else {
            XB_SPIN(xb_ld(&bar[XB_XGEN(b.x)]) == gen, bar);
            __builtin_amdgcn_fence(__ATOMIC_ACQUIRE, "agent");
            asm volatile("s_waitcnt vmcnt(0)" ::: "memory");
        }
    }
    __syncthreads();
}

constexpr int NWAVES = 8;
constexpr int BATCH = 4, SEQ = 4096, D = 1024, M = BATCH * SEQ, NH = 8, HD = 64, AW = 512, PLE = 256;
constexpr int NIN = 5120, INTOT = 5128, NKEYS = 128, NEXP = 16384, NS = 2048;
constexpr float EPS = 1e-6f, LOG2E = 1.4426950408889634f, C2 = 0.125f * LOG2E;
constexpr int NPHASE = 9;
constexpr int SLW = 128, NSL = D / SLW;
static_assert(NSL == 8, "one slice per XCD group; SS3 has 16 slots");

constexpr size_t MiB = 1u << 20;
constexpr size_t WS_CTL = 0, CTL_ZERO_BYTES = 64 * 1024;
constexpr size_t WS_RSTD1 = 1 * MiB, WS_RSTD3 = WS_RSTD1 + 65536, WS_LF = WS_RSTD3 + 65536, WS_CS = WS_LF + 524288, WS_SS2 = WS_CS + 524288, WS_WPP = WS_SS2 + 1048576;
constexpr size_t WS_WQ8 = 20 * MiB, WS_SW = WS_RSTD1;
constexpr size_t WS_SU = WS_RSTD3, WS_SV = WS_WPP + 524288;
static_assert(WS_SV + 65536 <= 4 * MiB, "small region");
constexpr size_t WS_WIN = 4 * MiB, WS_WBR = 14 * MiB, WS_WOUT = 16 * MiB, WS_WS = 18 * MiB, WS_WPG = 22 * MiB, WS_PB = 24 * MiB;
constexpr size_t WS_UB = 32 * MiB, WS_VB = 64 * MiB;
constexpr size_t WS_A = 96 * MiB;
constexpr size_t WS_PP = 128 * MiB;
constexpr size_t WS_Q = 160 * MiB, WS_K = 176 * MiB, WS_V = 192 * MiB, WS_GB = 208 * MiB, WS_Z = 224 * MiB;
constexpr size_t WS_MERGED = 160 * MiB, WS_XB2 = 192 * MiB, WS_IDS = 224 * MiB, WS_GATES = 232 * MiB;
constexpr size_t WS_END = 256 * MiB;
constexpr size_t WS_PART0 = 4 * MiB, WS_PART1 = 160 * MiB, WS_PART2 = 240 * MiB;
constexpr size_t WS_TGC = 32 * MiB, WS_TXC = 64 * MiB, WS_SC = 32 * MiB;
constexpr int CW_BAR = 1024;

constexpr int RING_OFF = 0, RING_BYTES = 135168;
constexpr int LDSCTL_OFF = RING_BYTES, MISC_OFF = LDSCTL_OFF + 320;
constexpr int LDS_BYTES = RING_BYTES + 1024;
static_assert(attn_body::ATTN_LDS_BYTES <= RING_BYTES && pg8::STAGE_BYTES <= RING_BYTES && 128 * pg8::EpiTopK::RS * 4 <= RING_BYTES, "LDS map");

typedef unsigned u32x4 __attribute__((ext_vector_type(4)));
typedef unsigned u32x2 __attribute__((ext_vector_type(2)));
__device__ __forceinline__ float bf2f(bf16 v) { return __uint_as_float((unsigned)v << 16); }
__device__ __forceinline__ float wave_sum(float v) {
#pragma unroll
    for (int o = 1; o < 64; o <<= 1) v += __shfl_xor(v, o);
    return v;
}
__device__ __forceinline__ float sigmoidf_(float v) { return 1.0f / (1.0f + __expf(-v)); }
__host__ __device__ __forceinline__ int src_in(int n) {
    const int pn = n >> 8, l = n & 255;
    if (pn < 6) return n;
    if (pn < 8) return 1544 + (n - 1536);
    if (pn < 12) { const int j = pn - 8; return (l < 128) ? 2056 + 128 * j + l : 2568 + 128 * j + (l - 128); }
    if (pn < 16) return 3080 + (n - 3072);
    return 4104 + (n - 4096);
}

struct Args { const float* in[18]; float* out; unsigned char* ws; int ph_lo, ph_hi, li, pad; };
struct Ctx {
    LAS unsigned char* lds; int wave, vcu, G;
    __device__ __forceinline__ int tid_() const { return (int)threadIdx.x; }
    __device__ __forceinline__ int lane_() const { return (int)threadIdx.x & 63; }
};

struct TrItem { const float* W; const float* g; bf16* WT; int ldw, k0, scol0, ldt, drow0, dk0; };
__device__ __forceinline__ void tr_load(const TrItem& I, float (&tv)[32], int lane) {
#pragma unroll
    for (int i = 0; i < 32; ++i) { const int kk = 2 * i + (lane >> 5); tv[i] = I.W[(size_t)(I.k0 + kk) * I.ldw + I.scol0 + (lane & 31)]; }
}
__device__ __forceinline__ void tr_finish(const TrItem& I, const float (&tv)[32], LAS float* scr, int lane) {
#pragma unroll
    for (int i = 0; i < 32; ++i) { const int kk = 2 * i + (lane >> 5); float v = tv[i]; if (I.g) v *= I.g[I.k0 + kk]; scr[kk * 33 + (lane & 31)] = v; }
    LDS_WAIT(); asm volatile("" ::: "memory");
    const int c = lane & 7;
#pragma unroll
    for (int j = 0; j < 4; ++j) { const int n = (lane >> 3) + 8 * j; const LAS float* s = scr + (8 * c) * 33 + n;
        v4u o; o.x = pk2(s[0 * 33], s[1 * 33]); o.y = pk2(s[2 * 33], s[3 * 33]); o.z = pk2(s[4 * 33], s[5 * 33]); o.w = pk2(s[6 * 33], s[7 * 33]);
        *(GAS v4u*)(I.WT + (size_t)(I.drow0 + n) * I.ldt + I.dk0 + 8 * c) = o; }
    LDS_WAIT(); asm volatile("" ::: "memory");
}
__device__ __forceinline__ void p0_prologue(const Ctx& F, const Args& a, volatile LAS unsigned* MISC) {
#ifdef MK_PROBE_SEG
    int n_sub = 0;
#define SUBSYNC() __syncthreads()
#define SUBSTAMP() do { if (blockIdx.x == 0 && threadIdx.x == 0) { const unsigned long long t_ = __builtin_amdgcn_s_memrealtime(); MISC[64 + 2 * n_sub] = (unsigned)t_; MISC[65 + 2 * n_sub] = (unsigned)(t_ >> 32); } ++n_sub; } while (0)
#else
#define SUBSTAMP() do { } while (0)
#define SUBSYNC() do { } while (0)
#endif
    SUBSTAMP();
    unsigned char* ws = a.ws;
    const float *x = a.in[0], *p = a.in[1], *g_mix = a.in[2], *w_in = a.in[3], *b_f = a.in[4], *w_branch = a.in[6], *w_out = a.in[7], *g_ffn = a.in[8], *w_peer_q = a.in[9],
                *pk1 = a.in[10], *pk2_ = a.in[11], *peer_u = a.in[12], *peer_v = a.in[13], *g_ple = a.in[14], *w_ple_gate = a.in[15], *w_ple_proj = a.in[16];
    bf16 *WIN = (bf16*)(ws + WS_WIN), *WBR = (bf16*)(ws + WS_WBR), *WOUT = (bf16*)(ws + WS_WOUT), *WST = (bf16*)(ws + WS_WS), *WPG = (bf16*)(ws + WS_WPG), *WPP = (bf16*)(ws + WS_WPP);
    bf16 *PB = (bf16*)(ws + WS_PB), *UB = (bf16*)(ws + WS_UB), *VB = (bf16*)(ws + WS_VB), *XB = (bf16*)(ws + WS_A);
    float *RSTD1 = (float*)(ws + WS_RSTD1), *LF = (float*)(ws + WS_LF);
    const int gw0 = F.vcu * NWAVES + F.wave, NGW = F.G * NWAVES, NGT = F.G * 512;
    const int tid_ = (int)threadIdx.x, lane_ = tid_ & 63, gw = gw0, gt = F.vcu * 512 + tid_; (void)gt;
    auto stepA = [&]() __attribute__((always_inline)) {
    {
        LAS float* KH = (LAS float*)(F.lds + RING_OFF); LAS float* WQ = KH + 128 * 129;
        for (int item = F.vcu; item < 256; item += F.G) {
            const int hh = item >> 4, head = hh >> 1, half = hh & 1, d0 = (item & 15) * 64;
            const float* kh = (half ? pk2_ : pk1) + (size_t)head * 128 * 128;
            float tk[32], tq[16];
#pragma unroll
            for (int i = 0; i < 32; ++i) tk[i] = kh[i * 512 + tid_];
#pragma unroll
            for (int i = 0; i < 16; ++i) { const int idx = i * 512 + tid_; tq[i] = w_peer_q[(size_t)(d0 + (idx >> 7)) * NS + head * 256 + half * 128 + (idx & 127)]; }
#pragma unroll
            for (int i = 0; i < 32; ++i) { const int idx = i * 512 + tid_; KH[(idx >> 7) * 129 + (idx & 127)] = tk[i]; }
#pragma unroll
            for (int i = 0; i < 16; ++i) WQ[i * 512 + tid_] = tq[i];
            __syncthreads();
            const int key = tid_ & 127, dg = tid_ >> 7;
            float acc[16];
#pragma unroll
            for (int i = 0; i < 16; ++i) acc[i] = 0.f;
            for (int e = 0; e < 128; e += 4) {
                const float k0 = KH[key * 129 + e], k1 = KH[key * 129 + e + 1], k2 = KH[key * 129 + e + 2], k3 = KH[key * 129 + e + 3];
#pragma unroll
                for (int i = 0; i < 16; ++i) { const f32x4 w = *(const LAS f32x4*)(WQ + (dg * 16 + i) * 128 + e); acc[i] += (k0 * w[0] + k1 * w[1]) + (k2 * w[2] + k3 * w[3]); }
            }
            const int dd = d0 + dg * 16;
#pragma unroll
            for (int q = 0; q < 2; ++q) { v4u o; o.x = pk2(acc[8 * q] * g_ffn[dd + 8 * q], acc[8 * q + 1] * g_ffn[dd + 8 * q + 1]); o.y = pk2(acc[8 * q + 2] * g_ffn[dd + 8 * q + 2], acc[8 * q + 3] * g_ffn[dd + 8 * q + 3]);
                o.z = pk2(acc[8 * q + 4] * g_ffn[dd + 8 * q + 4], acc[8 * q + 5] * g_ffn[dd + 8 * q + 5]); o.w = pk2(acc[8 * q + 6] * g_ffn[dd + 8 * q + 6], acc[8 * q + 7] * g_ffn[dd + 8 * q + 7]);
                *(GAS v4u*)(WST + (size_t)(head * 256 + half * 128 + key) * D + dd + 8 * q) = o; }
            __syncthreads();
        }
    }
    };
    auto stepB = [&]() __attribute__((always_inline)) {
    {
        LAS float* scr = (LAS float*)(F.lds + RING_OFF + F.wave * 16384);
        constexpr int I_IN = 16 * 160, I_BR = 8 * 32, I_SQ = 16 * 32, I_PP = 4 * 32, NITEMS = I_IN + 2 * I_BR + 2 * I_SQ + I_PP;
        auto decode = [&](int r) -> TrItem {
            TrItem I;
            if (r < I_IN) { const int kb = r / 160, nb = r % 160; I = TrItem{w_in, g_mix, WIN, INTOT, 64 * kb, src_in(32 * nb), D, 32 * nb, 64 * kb}; return I; } r -= I_IN;
            if (r < 2 * I_BR) { const int br = r / I_BR, q = r % I_BR, kb = q / 32, nb = q % 32; I = TrItem{w_branch + (size_t)br * AW * D, nullptr, WBR, D, 64 * kb, 32 * nb, D, 32 * nb, br * AW + 64 * kb}; return I; } r -= 2 * I_BR;
            if (r < I_SQ) { const int kb = r / 32, nb = r % 32; I = TrItem{w_out, nullptr, WOUT, D, 64 * kb, 32 * nb, D, 32 * nb, 64 * kb}; return I; } r -= I_SQ;
            if (r < I_SQ) { const int kb = r / 32, nb = r % 32; I = TrItem{w_ple_gate, g_ple, WPG, D, 64 * kb, 32 * nb, D, 32 * nb, 64 * kb}; return I; } r -= I_SQ;
            { const int kb = r / 32, nb = r % 32; I = TrItem{w_ple_proj, nullptr, WPP, D, 64 * kb, 32 * nb, PLE, 32 * nb, 64 * kb}; return I; }
        };
        for (int it = gw; it < NITEMS; it += 2 * NGW) {
            const bool two = it + NGW < NITEMS;
            const TrItem A = decode(it), B = decode(two ? it + NGW : it);
            float ta[32], tb[32];
            tr_load(A, ta, lane_); if (two) tr_load(B, tb, lane_);
            tr_finish(A, ta, scr, lane_); if (two) tr_finish(B, tb, scr, lane_);
        }
    }
    };
    auto stepC = [&]() __attribute__((always_inline)) {
    {
        LAS float* WFL = (LAS float*)(F.lds + RING_OFF);
        { float tw[16], tg[16];
#pragma unroll
          for (int i = 0; i < 16; ++i) { const int idx = i * 512 + tid_, k = idx >> 3, h = idx & 7; tw[i] = w_in[(size_t)k * INTOT + 1536 + h]; tg[i] = g_mix[k]; }
#pragma unroll
          for (int i = 0; i < 16; ++i) { const int idx = i * 512 + tid_, k = idx >> 3, h = idx & 7; WFL[h * 1024 + k] = tg[i] * tw[i]; } }
        __syncthreads();
        for (int rb = gw; rb < M; rb += 4 * NGW) {
            f32x4 v[4][4];
#pragma unroll
            for (int r = 0; r < 4; ++r) { const int row = rb + r * NGW; if (row < M) { const GAS f32x4* xr = (const GAS f32x4*)(x + (size_t)row * D);
#pragma unroll
                for (int j = 0; j < 4; ++j) v[r][j] = xr[lane_ + 64 * j]; } }
#pragma unroll
            for (int r = 0; r < 4; ++r) { const int row = rb + r * NGW; if (row < M) {
                float ss = 0.f;
#pragma unroll
                for (int j = 0; j < 4; ++j) ss += (v[r][j].x * v[r][j].x + v[r][j].y * v[r][j].y) + (v[r][j].z * v[r][j].z + v[r][j].w * v[r][j].w);
                ss = wave_sum(ss);
                const float rstd = 1.0f / sqrtf(ss * (1.0f / D) + EPS);
                GAS u32x2* o = (GAS u32x2*)(XB + (size_t)row * D);
#pragma unroll
                for (int j = 0; j < 4; ++j) { u32x2 w; w.x = pk2(v[r][j].x, v[r][j].y); w.y = pk2(v[r][j].z, v[r][j].w); o[lane_ + 64 * j] = w; }
                if (lane_ == 0) RSTD1[row] = rstd;
                float f[8];
#pragma unroll
                for (int h = 0; h < 8; ++h) { float s_ = 0.f;
#pragma unroll
                    for (int j = 0; j < 4; ++j) { const f32x4 w = *(const LAS f32x4*)(WFL + h * 1024 + 4 * (lane_ + 64 * j)); s_ += (v[r][j].x * w[0] + v[r][j].y * w[1]) + (v[r][j].z * w[2] + v[r][j].w * w[3]); }
                    f[h] = s_; }
                float r4[4], r2[2], r1;
#pragma unroll
                for (int i = 0; i < 4; ++i) { const float send = (lane_ & 32) ? f[i] : f[i + 4], keep = (lane_ & 32) ? f[i + 4] : f[i]; r4[i] = keep + __shfl_xor(send, 32); }
#pragma unroll
                for (int i = 0; i < 2; ++i) { const float send = (lane_ & 16) ? r4[i] : r4[i + 2], keep = (lane_ & 16) ? r4[i + 2] : r4[i]; r2[i] = keep + __shfl_xor(send, 16); }
                { const float send = (lane_ & 8) ? r2[0] : r2[1], keep = (lane_ & 8) ? r2[1] : r2[0]; r1 = keep + __shfl_xor(send, 8); }
                r1 += __shfl_xor(r1, 4); r1 += __shfl_xor(r1, 2); r1 += __shfl_xor(r1, 1);
                const int hL = ((lane_ >> 5) & 1) * 4 + ((lane_ >> 4) & 1) * 2 + ((lane_ >> 3) & 1);
                const float tot = r1 * rstd + b_f[hL];
                const float ls = fminf(tot, 0.f) - log1pf(__expf(-fabsf(tot)));
                const int b = row / SEQ, t = row % SEQ;
                if ((lane_ & 7) == 0) LF[(size_t)(b * NH + hL) * SEQ + t] = ls * LOG2E;
            } }
        }
    }
    };
    auto stepD = [&]() __attribute__((always_inline)) {
    {
        constexpr int NU = NEXP * D / 8, NP = M * PLE / 8;
        {
            signed char* UQ = (signed char*)(ws + WS_UB); unsigned char* VQ = (unsigned char*)(ws + WS_VB); float *SU = (float*)(ws + WS_SU), *SV = (float*)(ws + WS_SV);
            f32x4 gq[4];
#pragma unroll
            for (int j = 0; j < 4; ++j) gq[j] = *(const GAS f32x4*)(g_ffn + 256 * j + 4 * lane_);
            for (int rb = gw; rb < 2 * NEXP; rb += 4 * NGW) {
                f32x4 v[4][4];
#pragma unroll
                for (int r = 0; r < 4; ++r) { const int rr = rb + r * NGW; if (rr < 2 * NEXP) { const bool isv = rr >= NEXP; const int e = isv ? rr - NEXP : rr;
                    const GAS f32x4* src = (const GAS f32x4*)((isv ? peer_v : peer_u) + (size_t)e * D) + lane_;
#pragma unroll
                    for (int j = 0; j < 4; ++j) v[r][j] = src[64 * j]; } }
#pragma unroll
                for (int r = 0; r < 4; ++r) { const int rr = rb + r * NGW; if (rr < 2 * NEXP) { const bool isv = rr >= NEXP; const int e = isv ? rr - NEXP : rr;
                    float am = 0.f;
#pragma unroll
                    for (int j = 0; j < 4; ++j) { if (!isv) v[r][j] = v[r][j] * gq[j]; am = fmaxf(am, fmaxf(fmaxf(fabsf(v[r][j].x), fabsf(v[r][j].y)), fmaxf(fabsf(v[r][j].z), fabsf(v[r][j].w)))); }
#pragma unroll
                    for (int o = 1; o < 64; o <<= 1) am = fmaxf(am, __shfl_xor(am, o));
                    const float sc = am > 0.f ? 127.0f / am : 0.f;
                    unsigned char* tb = isv ? VQ : (unsigned char*)UQ;
#pragma unroll
                    for (int j = 0; j < 4; ++j) { const int q0 = (int)rintf(v[r][j].x * sc), q1 = (int)rintf(v[r][j].y * sc), q2 = (int)rintf(v[r][j].z * sc), q3 = (int)rintf(v[r][j].w * sc);
                        const unsigned o = (unsigned)(q0 & 255) | ((unsigned)(q1 & 255) << 8) | ((unsigned)(q2 & 255) << 16) | ((unsigned)(q3 & 255) << 24);
                        *(GAS unsigned*)(tb + ((size_t)(2 * j + (lane_ >> 5)) * NEXP + e) * SLW + ((4 * lane_) & 127)) = o; }
                    if (lane_ == 0) (isv ? SV : SU)[e] = am * (1.0f / 127.0f);
                } }
            }
        }
    }
    };
    if (F.vcu & 1) { stepD(); __syncthreads(); SUBSTAMP(); stepC(); __syncthreads(); SUBSTAMP(); stepB(); __syncthreads(); SUBSTAMP(); stepA(); __syncthreads(); SUBSTAMP(); }
    else           { stepA(); __syncthreads(); SUBSTAMP(); stepB(); __syncthreads(); SUBSTAMP(); stepC(); __syncthreads(); SUBSTAMP(); stepD(); __syncthreads(); SUBSTAMP(); }
    { constexpr int NP = M * PLE / 8;
        for (int i = F.vcu * 512 + F.tid_(); i < NP; i += NGT) { const f32x4 a = ((const GAS f32x4*)p)[2 * (size_t)i], b = ((const GAS f32x4*)p)[2 * (size_t)i + 1];
            v4u o; o.x = pk2(a.x, a.y); o.y = pk2(a.z, a.w); o.z = pk2(b.x, b.y); o.w = pk2(b.z, b.w); ((GAS v4u*)PB)[i] = o; }
    }
}
__device__ __forceinline__ void p2_conv(const Ctx& F, const bf16* GB, const bf16* Z, const float* cw, bf16* AC) {
    const int gt = F.vcu * 512 + F.tid_(), NGT = F.G * 512;
    for (int i = gt; i < M * AW / 8; i += NGT) {
        const int row = i >> 6, c = (i & 63) * 8, t = row & (SEQ - 1);
        const v4u z2 = *(const GAS v4u*)(Z + (size_t)row * AW + c), g = *(const GAS v4u*)(GB + (size_t)row * AW + c);
        v4u z1 = {0u, 0u, 0u, 0u}, z0 = {0u, 0u, 0u, 0u};
        if (t >= 1) z1 = *(const GAS v4u*)(Z + (size_t)(row - 1) * AW + c);
        if (t >= 2) z0 = *(const GAS v4u*)(Z + (size_t)(row - 2) * AW + c);
        float r[8];
#pragma unroll
        for (int e = 0; e < 4; ++e) {
            const float w0a = cw[c + 2 * e], w0b = cw[c + 2 * e + 1], w1a = cw[AW + c + 2 * e], w1b = cw[AW + c + 2 * e + 1], w2a = cw[2 * AW + c + 2 * e], w2b = cw[2 * AW + c + 2 * e + 1];
            r[2 * e] = __uint_as_float(g[e] << 16) * (w0a * __uint_as_float(z0[e] << 16) + w1a * __uint_as_float(z1[e] << 16) + w2a * __uint_as_float(z2[e] << 16));
            r[2 * e + 1] = __uint_as_float(g[e] & 0xffff0000u) * (w0b * __uint_as_float(z0[e] & 0xffff0000u) + w1b * __uint_as_float(z1[e] & 0xffff0000u) + w2b * __uint_as_float(z2[e] & 0xffff0000u));
        }
        v4u o; o.x = pk2(r[0], r[1]); o.y = pk2(r[2], r[3]); o.z = pk2(r[4], r[5]); o.w = pk2(r[6], r[7]);
        *(GAS v4u*)(AC + (size_t)row * D + AW + c) = o;
    }
}
template <int CTRL> __device__ __forceinline__ int dpp_i(int v) { return __builtin_amdgcn_update_dpp(0, v, CTRL, 0xf, 0xf, true); }
__device__ __forceinline__ int sum8i(int v) { v += dpp_i<0x141>(v); v += dpp_i<0xB1>(v); v += dpp_i<0x4E>(v); return v; }
__device__ __forceinline__ float max8f(float v) { v = fmaxf(v, __uint_as_float((unsigned)dpp_i<0x141>((int)__float_as_uint(v)))); v = fmaxf(v, __uint_as_float((unsigned)dpp_i<0xB1>((int)__float_as_uint(v)))); v = fmaxf(v, __uint_as_float((unsigned)dpp_i<0x4E>((int)__float_as_uint(v)))); return v; }
__device__ __forceinline__ size_t part_slab(int j) { return j < 2 ? WS_PART0 + (size_t)j * 8 * MiB : j < 6 ? WS_PART1 + (size_t)(j - 2) * 8 * MiB : WS_PART2 + (size_t)(j - 6) * 8 * MiB; }
struct P6Geo { int xg, wi, nwv; };
__device__ __forceinline__ P6Geo p6_geo(const Ctx& F) { P6Geo g; const int bx = blockIdx.x; g.xg = bx & 7; g.wi = (bx >> 3) * NWAVES + F.wave; g.nwv = ((F.G - g.xg + 7) >> 3) * NWAVES; return g; }
__device__ __forceinline__ void p6a_upass(const Ctx& F, unsigned char* ws, const bf16* XB1, const unsigned short* IDS) {
    const P6Geo G = p6_geo(F); const int lane = F.lane_(), g = lane >> 3, c = lane & 7;
    for (int sl = G.xg; sl < NSL; sl += 8) {
        float* PART = (float*)(ws + part_slab(sl));
        const GAS unsigned char* Ts = (const GAS unsigned char*)(ws + WS_UB) + (size_t)sl * NEXP * SLW + 16 * c;
        for (int t = G.wi; t < M; t += G.nwv) {
            const v4u xa = *(const GAS v4u*)(XB1 + (size_t)t * D + sl * SLW + 16 * c), xb = *(const GAS v4u*)(XB1 + (size_t)t * D + sl * SLW + 16 * c + 8);
            v4u idp[2];
#pragma unroll
            for (int q = 0; q < 2; ++q) idp[q] = *(const GAS v4u*)(IDS + (size_t)t * 128 + 16 * g + 8 * q);
            v4u u[16];
#pragma unroll
            for (int i = 0; i < 16; ++i) { const unsigned w_ = idp[i >> 3][(i >> 1) & 3]; u[i] = *(const GAS v4u*)(Ts + ((i & 1) ? ((w_ >> 9) & 0x7fff80u) : ((w_ << 7) & 0x7fff80u))); }
            float xf[16];
#pragma unroll
            for (int e = 0; e < 4; ++e) { xf[2 * e] = __uint_as_float(xa[e] << 16); xf[2 * e + 1] = __uint_as_float(xa[e] & 0xffff0000u); xf[8 + 2 * e] = __uint_as_float(xb[e] << 16); xf[8 + 2 * e + 1] = __uint_as_float(xb[e] & 0xffff0000u); }
            float am = 0.f;
#pragma unroll
            for (int e = 0; e < 16; ++e) am = fmaxf(am, fabsf(xf[e]));
            am = max8f(am);
            const float sc = am > 0.f ? 127.0f / am : 0.f, sx = am * (1.0f / 127.0f);
            int qx[4];
#pragma unroll
            for (int j = 0; j < 4; ++j) qx[j] = (int)(((unsigned)((int)rintf(xf[4 * j] * sc) & 255)) | ((unsigned)((int)rintf(xf[4 * j + 1] * sc) & 255) << 8) | ((unsigned)((int)rintf(xf[4 * j + 2] * sc) & 255) << 16) | ((unsigned)((int)rintf(xf[4 * j + 3] * sc) & 255) << 24));
            int r0 = 0, r1 = 0;
#pragma unroll
            for (int i = 0; i < 16; ++i) { int sacc = __builtin_amdgcn_sdot4(qx[0], (int)u[i][0], 0, false); sacc = __builtin_amdgcn_sdot4(qx[1], (int)u[i][1], sacc, false); sacc = __builtin_amdgcn_sdot4(qx[2], (int)u[i][2], sacc, false); sacc = __builtin_amdgcn_sdot4(qx[3], (int)u[i][3], sacc, false);
                sacc = sum8i(sacc);
                if (i < 8) r0 = (c == i) ? sacc : r0; else r1 = (c == i - 8) ? sacc : r1; }
            float* pp = PART + (size_t)t * 128 + 16 * g + c;
            pp[0] = (float)r0 * sx; pp[8] = (float)r1 * sx;
        }
    }
}
__device__ __forceinline__ void p6b_combine(const Ctx& F, unsigned char* ws, float* SS2, const unsigned short* IDS, const float* GATES) {
    const int gw = F.vcu * NWAVES + F.wave, NGW = F.G * NWAVES, lane = F.lane_();
    const float *SU = (const float*)(ws + WS_SU), *SV = (const float*)(ws + WS_SV);
    signed char* WQ8 = (signed char*)(ws + WS_WQ8); float* SW = (float*)(ws + WS_SW);
    for (int tb = gw; tb < M; tb += 2 * NGW) {
        float ssv[2], a0[2], a1[2], g0[2], g1[2]; int i0[2], i1[2];
#pragma unroll
        for (int r = 0; r < 2; ++r) { const int t = tb + r * NGW; if (t < M) {
            ssv[r] = lane < 16 ? SS2[(size_t)t * 16 + lane] : 0.f;
            i0[r] = (int)IDS[(size_t)t * 128 + lane]; i1[r] = (int)IDS[(size_t)t * 128 + 64 + lane];
            g0[r] = GATES[(size_t)t * 128 + lane]; g1[r] = GATES[(size_t)t * 128 + 64 + lane];
            a0[r] = 0.f; a1[r] = 0.f;
#pragma unroll
            for (int j = 0; j < 8; ++j) { const float* pp = (const float*)(ws + part_slab(j)) + (size_t)t * 128; a0[r] += pp[lane]; a1[r] += pp[64 + lane]; } } }
#pragma unroll
        for (int r = 0; r < 2; ++r) { const int t = tb + r * NGW; if (t < M) {
            const float rstd = 1.0f / sqrtf(wave_sum(ssv[r]) * (1.0f / D) + EPS);
            const float x0 = a0[r] * rstd * SU[i0[r]], x1 = a1[r] * rstd * SU[i1[r]];
            const float w0 = g0[r] * 0.5f * x0 * (1.0f + erff(x0 * 0.70710678118654752f)) * SV[i0[r]], w1 = g1[r] * 0.5f * x1 * (1.0f + erff(x1 * 0.70710678118654752f)) * SV[i1[r]];
            float am = fmaxf(fabsf(w0), fabsf(w1));
#pragma unroll
            for (int o = 1; o < 64; o <<= 1) am = fmaxf(am, __shfl_xor(am, o));
            const float sc = am > 0.f ? 127.0f / am : 0.f;
            WQ8[(size_t)t * 128 + lane] = (signed char)(int)rintf(w0 * sc); WQ8[(size_t)t * 128 + 64 + lane] = (signed char)(int)rintf(w1 * sc);
            if (lane == 0) SW[t] = am * (1.0f / 127.0f);
            if (lane < 16) SS2[(size_t)t * 16 + lane] = 0.f;
        } }
    }
}
__device__ __forceinline__ int pl32_sum(int a, int b) { const auto s_ = __builtin_amdgcn_permlane32_swap((unsigned)a, (unsigned)b, false, false); return (int)(s_[0] + s_[1]); }
__device__ __forceinline__ int pl16_sum(int a, int b) { const auto s_ = __builtin_amdgcn_permlane16_swap((unsigned)a, (unsigned)b, false, false); return (int)(s_[0] + s_[1]); }
__device__ __forceinline__ float wave_sum_valu(float v) {
    { const auto s_ = __builtin_amdgcn_permlane32_swap(__float_as_uint(v), __float_as_uint(v), false, false); v = __uint_as_float(s_[0]) + __uint_as_float(s_[1]); }
    { const auto s_ = __builtin_amdgcn_permlane16_swap(__float_as_uint(v), __float_as_uint(v), false, false); v = __uint_as_float(s_[0]) + __uint_as_float(s_[1]); }
    v += __uint_as_float((unsigned)dpp_i<0x128>((int)__float_as_uint(v))); v += __uint_as_float((unsigned)dpp_i<0x124>((int)__float_as_uint(v)));
    v += __uint_as_float((unsigned)dpp_i<0x122>((int)__float_as_uint(v))); v += __uint_as_float((unsigned)dpp_i<0x121>((int)__float_as_uint(v))); return v;
}
__device__ __forceinline__ void p6c_vpass(const Ctx& F, unsigned char* ws, const unsigned short* IDS, const bf16* XB1, bf16* XB2, float* SS3) {
    const P6Geo G = p6_geo(F); const int lane = F.lane_(), g = lane >> 3, c = lane & 7;
    const int ecol = 16 * c + ((lane >> 5) & 1) * 8 + ((lane >> 4) & 1) * 4 + ((lane >> 3) & 1) * 2;
    const signed char* WQ8 = (const signed char*)(ws + WS_WQ8); const float* SW = (const float*)(ws + WS_SW);
#define V_IDS(ID, t_) do { _Pragma("unroll") for (int q = 0; q < 2; ++q) ID[q] = *(const GAS v4u*)(IDS + (size_t)(t_) * 128 + 16 * g + 8 * q); } while (0)
#define V_W(WV, t_) do { WV = *(const GAS v4u*)(WQ8 + (size_t)(t_) * 128 + 16 * g); } while (0)
#define V_GATHER(R, ID) do { _Pragma("unroll") for (int i = 0; i < 16; ++i) { const unsigned w_ = ID[i >> 3][(i >> 1) & 3]; R[i] = *(const GAS v4u*)(Ts + (size_t)((((i & 1) ? (w_ >> 9) : (w_ << 7)) & 0x7fff80u) | c16)); } } while (0)
#define V_COMPUTE(R, WV, t_) do { \
        const size_t o_ = (size_t)(t_) * D + sl * SLW + ecol; \
        const unsigned xq_ = *(const GAS unsigned*)(XB1 + o_); const float sw_ = SW[t_]; \
        int acc[16]; \
        _Pragma("unroll") for (int e = 0; e < 16; ++e) acc[e] = 0; \
        _Pragma("unroll") for (int j = 0; j < 4; ++j) \
            _Pragma("unroll") for (int b = 0; b < 4; ++b) { \
                const unsigned r0_ = R[4 * j][b], r1_ = R[4 * j + 1][b], r2_ = R[4 * j + 2][b], r3_ = R[4 * j + 3][b]; \
                const unsigned x01 = __builtin_amdgcn_perm(r1_, r0_, 0x05010400u), y01 = __builtin_amdgcn_perm(r1_, r0_, 0x07030602u), x23 = __builtin_amdgcn_perm(r3_, r2_, 0x05010400u), y23 = __builtin_amdgcn_perm(r3_, r2_, 0x07030602u); \
                acc[4 * b]     = __builtin_amdgcn_sdot4((int)__builtin_amdgcn_perm(x23, x01, 0x05040100u), (int)WV[j], acc[4 * b], false); \
                acc[4 * b + 1] = __builtin_amdgcn_sdot4((int)__builtin_amdgcn_perm(x23, x01, 0x07060302u), (int)WV[j], acc[4 * b + 1], false); \
                acc[4 * b + 2] = __builtin_amdgcn_sdot4((int)__builtin_amdgcn_perm(y23, y01, 0x05040100u), (int)WV[j], acc[4 * b + 2], false); \
                acc[4 * b + 3] = __builtin_amdgcn_sdot4((int)__builtin_amdgcn_perm(y23, y01, 0x07060302u), (int)WV[j], acc[4 * b + 3], false); } \
        int r8[8], r4[4], r2[2]; \
        _Pragma("unroll") for (int i = 0; i < 8; ++i) r8[i] = pl32_sum(acc[i], acc[i + 8]); \
        _Pragma("unroll") for (int i = 0; i < 4; ++i) r4[i] = pl16_sum(r8[i], r8[i + 4]); \
        _Pragma("unroll") for (int i = 0; i < 2; ++i) { const int send = (lane & 8) ? r4[i] : r4[i + 2], keep = (lane & 8) ? r4[i + 2] : r4[i]; r2[i] = keep + dpp_i<0x128>(send); } \
        const float x0_ = __uint_as_float(xq_ << 16) + sw_ * (float)r2[0], x1_ = __uint_as_float(xq_ & 0xffff0000u) + sw_ * (float)r2[1]; \
        *(GAS unsigned*)(XB2 + o_) = pk2(x0_, x1_); \
        const float ss = wave_sum_valu(x0_ * x0_ + x1_ * x1_); \
        if (lane == 0) SS3[(size_t)(t_) * 16 + sl] = ss; } while (0)
#define V_FENCE() asm volatile("" ::: "memory")
    for (int sl = G.xg; sl < NSL; sl += 8) {
        const GAS unsigned char* Ts = (const GAS unsigned char*)(ws + WS_VB) + (size_t)sl * NEXP * SLW; const unsigned c16 = 16u * (unsigned)c;
        const int nk = (M - G.wi + G.nwv - 1) / G.nwv, t0 = G.wi, dt = G.nwv;
        v4u idA[2], idB[2]; v4u wA, wB; v4u rA[16], rB[16];
        if (nk > 0) { V_IDS(idA, t0); V_GATHER(rA, idA); V_W(wA, t0); }
        if (nk > 1) V_IDS(idB, t0 + dt);
        V_FENCE();
        for (int k = 0; k < nk; k += 2) {
            if (k + 1 < nk) { V_GATHER(rB, idB); V_W(wB, t0 + (k + 1) * dt); }
            if (k + 2 < nk) V_IDS(idA, t0 + (k + 2) * dt);
            V_FENCE();
            V_COMPUTE(rA, wA, t0 + k * dt);
            V_FENCE();
            if (k + 2 < nk) { V_GATHER(rA, idA); V_W(wA, t0 + (k + 2) * dt); }
            if (k + 3 < nk) V_IDS(idB, t0 + (k + 3) * dt);
            V_FENCE();
            if (k + 1 < nk) V_COMPUTE(rB, wB, t0 + (k + 1) * dt);
            V_FENCE();
        }
    }
#undef V_IDS
#undef V_W
#undef V_GATHER
#undef V_COMPUTE
#undef V_FENCE
}
__device__ __forceinline__ void p8_final(const Ctx& F, float* X, const float* g) {
    const int gw = F.vcu * NWAVES + F.wave, NGW = F.G * NWAVES;
    for (int row = gw; row < M; row += NGW) {
        GAS f32x4* xr = (GAS f32x4*)(X + (size_t)row * D); f32x4 v[4]; float ss = 0.f;
#pragma unroll
        for (int j = 0; j < 4; ++j) { v[j] = xr[F.lane_() + 64 * j]; ss += (v[j].x * v[j].x + v[j].y * v[j].y) + (v[j].z * v[j].z + v[j].w * v[j].w); }
        ss = wave_sum(ss); const float rstd = 1.0f / sqrtf(ss * (1.0f / D) + EPS);
#pragma unroll
        for (int j = 0; j < 4; ++j) { const f32x4 gv = ((const GAS f32x4*)g)[F.lane_() + 64 * j]; xr[F.lane_() + 64 * j] = v[j] * rstd * gv; }
    }
}
struct OneUnit {
    pg8::Unit u;
    __device__ __forceinline__ bool next(int i, pg8::Unit& o) const { if (i != 0) return false; o = u; return true; }
    __device__ __forceinline__ void a_ready(const pg8::Unit&) const {}
    __device__ __forceinline__ void done(const pg8::Unit&) const {}
};

__global__ void __launch_bounds__(NWAVES * 64, 2) mk_fwd(Args args) {
    extern __shared__ __attribute__((aligned(16))) unsigned char lds[];
    Ctx F;
    F.lds = (LAS unsigned char*)lds;
    F.wave = __builtin_amdgcn_readfirstlane((int)threadIdx.x >> 6);
    F.G = gridDim.x; { const int bx = blockIdx.x; F.vcu = (F.G % 8 == 0) ? (bx % 8) * (F.G / 8) + bx / 8 : bx; }
    volatile LAS unsigned* MISC = (volatile LAS unsigned*)(F.lds + MISC_OFF);
    unsigned char* ws = args.ws;
    gu32* ctl = (gu32*)(ws + WS_CTL);
    for (int u = F.tid_(); u < (LDS_BYTES - LDSCTL_OFF) / 4; u += NWAVES * 64) ((LAS unsigned*)(F.lds + LDSCTL_OFF))[u] = 0u;
    __syncthreads();
    const int lo = args.ph_lo, hi = args.ph_hi;
    const bool multi = (hi - lo) > 1 || (lo <= 6 && 6 < hi);
    XcdBarrier bar; bar.bar = (unsigned*)(ctl + CW_BAR) + args.li * XCD_BAR_WORDS; bar.x = 0; bar.st = nullptr;
    if (multi) bar = xcd_barrier_post((unsigned*)(ctl + CW_BAR) + args.li * XCD_BAR_WORDS, MISC + 8);
#ifndef MK_CMASK
#define MK_CMASK 0x1ff
#endif
#define IN(k) (((MK_CMASK >> (k)) & 1) && lo <= (k) && (k) < hi)
#define SEAM(k) do { if (IN(k) && IN((k) + 1)) xcd_barrier(bar); STAMP(); } while (0)
#ifdef MK_PROBE_SEG
    int n_stamp = 0;
#define STAMP() do { if (blockIdx.x == 0 && F.tid_() == 0) { const unsigned long long t_ = __builtin_amdgcn_s_memrealtime(); MISC[16 + 2 * n_stamp] = (unsigned)t_; MISC[17 + 2 * n_stamp] = (unsigned)(t_ >> 32); } ++n_stamp; } while (0)
    STAMP();
#else
#define STAMP() do { } while (0)
#endif
    float* out = args.out;
#define WSP(T, off) ((T*)(ws + (off)))
#define RSTD1 WSP(float, WS_RSTD1)
#define SS2 WSP(float, WS_SS2)
#define LF WSP(float, WS_LF)
#define WIN WSP(bf16, WS_WIN)
#define WBR WSP(bf16, WS_WBR)
#define WOUT WSP(bf16, WS_WOUT)
#define WST WSP(bf16, WS_WS)
#define WPG WSP(bf16, WS_WPG)
#define WPP WSP(bf16, WS_WPP)
#define PB WSP(bf16, WS_PB)
#define XB WSP(bf16, WS_A)
#define AC WSP(bf16, WS_A)
#define XB1 WSP(bf16, WS_A)
#define PP WSP(bf16, WS_PP)
#define Q WSP(bf16, WS_Q)
#define K WSP(bf16, WS_K)
#define V WSP(bf16, WS_V)
#define GB WSP(bf16, WS_GB)
#define Z WSP(bf16, WS_Z)
#define MG WSP(bf16, WS_MERGED)
#define XB2 WSP(bf16, WS_XB2)
#define IDS WSP(unsigned short, WS_IDS)
#define GATES WSP(float, WS_GATES)
#define SGA ((bf16*)out)
#define SGC ((bf16*)out + (size_t)M * D)

    if (IN(0)) { p0_prologue(F, args, MISC); }
    SEAM(0);
    if (IN(1)) {
        { pg8::Gemm g{XB, WIN, M, NIN, D}; pg8::StaticOrder S; S.init(M, NIN, F.G, (int)blockIdx.x);
          pg8::EpiIn E{RSTD1, Q, (size_t)(WS_K - WS_Q) / 2, Z, SGA, (size_t)M * D, C2};
          static_assert(WS_V - WS_K == WS_K - WS_Q && WS_GB - WS_V == WS_K - WS_Q, "Q | K | V | GB equally spaced");
          pg8::gemm_phase<pg8::EpiIn, pg8::StaticOrder, PG8_ALIGN, PG8_SP2>(F.lds + RING_OFF, g, S, E); }
        { pg8::Gemm g{PB, WPP, M, D, PLE}; pg8::StaticOrder S; S.init(M, D, F.G, (int)blockIdx.x);
          pg8::EpiPlain E{PP, D};
          pg8::gemm_phase<pg8::EpiPlain, pg8::StaticOrder, PG8_ALIGN, PG8_SP2>(F.lds + RING_OFF, g, S, E); }
    }
    SEAM(1);
    if (IN(2)) {
        p2_conv(F, GB, Z, args.in[5], AC);
        const attn_body::AttnTensors AT{(const attn_body::bf16*)Q, (const attn_body::bf16*)K, (const attn_body::bf16*)V, (attn_body::bf16*)AC, LF};
        const attn_body::StaticOrder S((int)F.G, F.vcu);
        attn_body::attn_phase<attn_body::StaticOrder>((char*)lds + RING_OFF, AT, S);
    }
    SEAM(2);
    if (IN(3)) {
        pg8::Gemm g{AC, WBR, M, D, D}; pg8::StaticOrder S; S.init(M, D, F.G, (int)blockIdx.x);
        pg8::EpiBranch E{SGA, SGC, MG};
        pg8::gemm_phase<pg8::EpiBranch, pg8::StaticOrder, PG8_ALIGN, PG8_SP2>(F.lds + RING_OFF, g, S, E);
    }
    SEAM(3);
    if (IN(4)) {
        pg8::Gemm g{MG, WOUT, M, D, D}; pg8::StaticOrder S; S.init(M, D, F.G, (int)blockIdx.x);
        pg8::EpiOut E{args.in[0], XB1, SS2};
        pg8::gemm_phase<pg8::EpiOut, pg8::StaticOrder, PG8_ALIGN, PG8_SP2>(F.lds + RING_OFF, g, S, E);
    }
    SEAM(4);
    if (IN(5)) {
        pg8::Gemm g{XB1, WST, M, NS, D}; pg8::StaticOrder S; S.init(M, NS, F.G, (int)blockIdx.x);
        pg8::EpiTopK E{SS2, IDS, GATES, EPS};
        pg8::Unit u;
        for (int i = 0; S.next(i, u); ++i) { OneUnit O{u}; pg8::gemm_phase<pg8::EpiTopK, OneUnit, false, PG8_SP2>(F.lds + RING_OFF, g, O, E); }
    }
    SEAM(5);
    if (IN(6)) { p6a_upass(F, ws, XB1, IDS); xcd_barrier(bar); STAMP(); p6b_combine(F, ws, SS2, IDS, GATES); xcd_barrier(bar); STAMP(); p6c_vpass(F, ws, IDS, XB1, XB2, SS2); }
    SEAM(6);
    if (IN(7)) {
        pg8::Gemm g{XB2, WPG, M, D, D}; pg8::StaticOrder S; S.init(M, D, F.G, (int)blockIdx.x);
        LAS float* rtab = (LAS float*)(F.lds + RING_OFF + pg8::STAGE_BYTES);
        const bool one = (M / 256) * (D / 256) <= F.G; pg8::Unit u0;
        if (one && S.next(0, u0) && F.tid_() < 256) { const float* sp = SS2 + (size_t)(u0.pm * 256 + F.tid_()) * 16; float q = 0.f;
#pragma unroll
            for (int j = 0; j < NSL; ++j) q += sp[j];
            rtab[F.tid_()] = 1.0f / sqrtf(q * (1.0f / D) + EPS); }
        __syncthreads();
        pg8::EpiPle E{SS2, PP, XB2, out, EPS, one ? (const LAS float*)rtab : (const LAS float*)nullptr};
        pg8::gemm_phase<pg8::EpiPle, pg8::StaticOrder, PG8_ALIGN, PG8_SP2>(F.lds + RING_OFF, g, S, E);
    }
    SEAM(7);
    if (IN(8)) { p8_final(F, out, args.in[17]); }
    STAMP();
#ifdef MK_PROBE_SEG
    if (blockIdx.x == 0 && F.tid_() == 0) {
#if MK_PROBE_SEG >= 100
        const unsigned long long a_ = ((unsigned long long)MISC[65 + 2 * (MK_PROBE_SEG - 100)] << 32) | MISC[64 + 2 * (MK_PROBE_SEG - 100)], b_ = (MK_PROBE_SEG - 100 == 4) ? (((unsigned long long)MISC[19] << 32) | MISC[18]) : (((unsigned long long)MISC[67 + 2 * (MK_PROBE_SEG - 100)] << 32) | MISC[66 + 2 * (MK_PROBE_SEG - 100)]);
#else
        const unsigned long long a_ = ((unsigned long long)MISC[17 + 2 * MK_PROBE_SEG] << 32) | MISC[16 + 2 * MK_PROBE_SEG], b_ = ((unsigned long long)MISC[19 + 2 * MK_PROBE_SEG] << 32) | MISC[18 + 2 * MK_PROBE_SEG];
#endif
        const unsigned long long dt_ = (b_ - a_) * MK_PROBE_MULT, t0_ = __builtin_amdgcn_s_memrealtime();
        while (__builtin_amdgcn_s_memrealtime() - t0_ < dt_) __builtin_amdgcn_s_sleep(8);
    }
#endif
#undef IN
#undef SEAM
#undef WSP
#undef RSTD1
#undef SS2
#undef LF
#undef WIN
#undef WBR
#undef WOUT
#undef WST
#undef WPG
#undef WPP
#undef PB
#undef XB
#undef AC
#undef XB1
#undef PP
#undef Q
#undef K
#undef V
#undef GB
#undef Z
#undef MG
#undef XB2
#undef IDS
#undef GATES
#undef SGA
#undef SGC
}
namespace gold {
__global__ void __launch_bounds__(256) k_rows0(const float* x, const float* w_in, const float* g_mix, const float* b_f, bf16* XB, float* RSTD1, float* LF) {
    const int lane = threadIdx.x & 63, row = blockIdx.x * 4 + (threadIdx.x >> 6);
    const f32x4* xr = (const f32x4*)(x + (size_t)row * D);
    f32x4 v[4]; float ss = 0.f;
#pragma unroll
    for (int j = 0; j < 4; ++j) { v[j] = xr[lane + 64 * j]; ss += v[j].x * v[j].x + v[j].y * v[j].y + v[j].z * v[j].z + v[j].w * v[j].w; }
    ss = wave_sum(ss);
    const float rstd = 1.0f / sqrtf(ss * (1.0f / D) + EPS);
    u32x2* o = (u32x2*)(XB + (size_t)row * D);
#pragma unroll
    for (int j = 0; j < 4; ++j) { u32x2 w; w.x = pk2(v[j].x, v[j].y); w.y = pk2(v[j].z, v[j].w); o[lane + 64 * j] = w; }
    if (lane == 0) RSTD1[row] = rstd;
    float f[8];
#pragma unroll
    for (int h = 0; h < 8; ++h) f[h] = 0.f;
#pragma unroll
    for (int j = 0; j < 4; ++j)
#pragma unroll
        for (int e = 0; e < 4; ++e) {
            const int k = 4 * (lane + 64 * j) + e; const float xv = v[j][e] * g_mix[k];
            const f32x4 w0 = *(const f32x4*)(w_in + (size_t)k * INTOT + 1536), w1 = *(const f32x4*)(w_in + (size_t)k * INTOT + 1540);
            f[0] += xv * w0.x; f[1] += xv * w0.y; f[2] += xv * w0.z; f[3] += xv * w0.w; f[4] += xv * w1.x; f[5] += xv * w1.y; f[6] += xv * w1.z; f[7] += xv * w1.w;
        }
    const int b = row / SEQ, t = row % SEQ;
#pragma unroll
    for (int h = 0; h < 8; ++h) {
        const float tot = wave_sum(f[h]) * rstd + b_f[h];
        const float ls = fminf(tot, 0.f) - log1pf(__expf(-fabsf(tot)));
        if (lane == 0) LF[(size_t)(b * NH + h) * SEQ + t] = ls * LOG2E;
    }
}
template <int MODE> __global__ void k_wt(const float* W, int ldw, const float* g, bf16* Wt, int N, int K, int koff, int ldt) {
    const size_t i = (size_t)blockIdx.x * blockDim.x + threadIdx.x; if (i >= (size_t)N * K) return;
    const int n = (int)(i / K), k = (int)(i % K);
    const int s = MODE == 1 ? src_in(n) : n;
    const float gv = g ? g[k] : 1.f;
    Wt[(size_t)n * ldt + koff + k] = (bf16)f2bf(gv * W[(size_t)k * ldw + s]);
}
__global__ void k_ws(const float* wq, const float* k1, const float* k2, const float* g, bf16* WST) {
    const size_t i = (size_t)blockIdx.x * blockDim.x + threadIdx.x; if (i >= (size_t)NS * D) return;
    const int n = (int)(i / D), d = (int)(i % D), head = n >> 8, half = (n >> 7) & 1, key = n & 127;
    const float* kr = (half ? k2 : k1) + ((size_t)head * NKEYS + key) * 128;
    const float* qr = wq + (size_t)d * NS + head * 256 + half * 128;
    float s = 0.f;
    for (int e = 0; e < 128; ++e) s += qr[e] * kr[e];
    WST[(size_t)n * D + d] = (bf16)f2bf(g[d] * s);
}
__global__ void k_cvt(const float* in, const float* g, bf16* out, size_t n, int gmask) {
    const size_t i = (size_t)blockIdx.x * blockDim.x + threadIdx.x; if (i >= n) return;
    out[i] = (bf16)f2bf(in[i] * (g ? g[i & gmask] : 1.f));
}

template <class Epi, bool SPLIT2>
__global__ void __launch_bounds__(256) ng(const bf16* A, int lda, const bf16* Bt, int ldb, int K, Epi E) {
    __shared__ float As[32][68], Bs[32][68];
    const int tid = threadIdx.x, tx = tid & 15, ty = tid >> 4, m0 = blockIdx.y * 64, n0 = blockIdx.x * 64;
    float acc[4][4], acc2[4][4];
#pragma unroll
    for (int i = 0; i < 4; ++i)
#pragma unroll
        for (int j = 0; j < 4; ++j) { acc[i][j] = 0.f; acc2[i][j] = 0.f; }
    const int lr = tid >> 2, lk = (tid & 3) * 8;
    for (int k0 = 0; k0 < K; k0 += 32) {
        const u32x4 av = *(const u32x4*)(A + (size_t)(m0 + lr) * lda + k0 + lk), bv = *(const u32x4*)(Bt + (size_t)(n0 + lr) * ldb + k0 + lk);
#pragma unroll
        for (int e = 0; e < 4; ++e) {
            As[lk + 2 * e][lr] = __uint_as_float(av[e] << 16); As[lk + 2 * e + 1][lr] = __uint_as_float(av[e] & 0xffff0000u);
            Bs[lk + 2 * e][lr] = __uint_as_float(bv[e] << 16); Bs[lk + 2 * e + 1][lr] = __uint_as_float(bv[e] & 0xffff0000u);
        }
        __syncthreads();
        const bool second = SPLIT2 && (k0 >= K / 2);
#pragma unroll 8
        for (int kk = 0; kk < 32; ++kk) {
            float a[4], b[4];
#pragma unroll
            for (int i = 0; i < 4; ++i) { a[i] = As[kk][ty * 4 + i]; b[i] = Bs[kk][tx * 4 + i]; }
            if (second) {
#pragma unroll
                for (int i = 0; i < 4; ++i)
#pragma unroll
                    for (int j = 0; j < 4; ++j) acc2[i][j] += a[i] * b[j];
            } else {
#pragma unroll
                for (int i = 0; i < 4; ++i)
#pragma unroll
                    for (int j = 0; j < 4; ++j) acc[i][j] += a[i] * b[j];
            }
        }
        __syncthreads();
    }
#pragma unroll
    for (int i = 0; i < 4; ++i)
#pragma unroll
        for (int j = 0; j < 4; ++j) E(m0 + ty * 4 + i, n0 + tx * 4 + j, acc[i][j], acc2[i][j]);
}
struct E1 {
    const float* RSTD1; bf16 *Q, *K, *V, *GB, *SGA, *SGC; float *TGC, *TXC;
    __device__ void operator()(int row, int col, float a, float) const {
        const float v = RSTD1[row] * a; const int pn = col >> 8;
        if (pn < 2) Q[(size_t)row * AW + col] = (bf16)f2bf(v * C2);
        else if (pn < 4) K[(size_t)row * AW + col - 512] = (bf16)f2bf(v);
        else if (pn < 6) V[(size_t)row * AW + col - 1024] = (bf16)f2bf(v);
        else if (pn < 8) GB[(size_t)row * AW + col - 1536] = (bf16)f2bf(v);
        else if (pn < 12) { const int j = pn - 8, l = col & 255; if (l < 128) TGC[(size_t)row * AW + 128 * j + l] = v; else TXC[(size_t)row * AW + 128 * j + l - 128] = v; }
        else if (pn < 16) SGA[(size_t)row * D + col - 3072] = (bf16)f2bf(sigmoidf_(v));
        else SGC[(size_t)row * D + col - 4096] = (bf16)f2bf(sigmoidf_(v));
    }
};
struct EPP { bf16* PP; __device__ void operator()(int row, int col, float a, float) const { PP[(size_t)row * D + col] = (bf16)f2bf(a); } };
struct E3 { const bf16 *SGA, *SGC; bf16* MG;
    __device__ void operator()(int row, int col, float a, float a2) const { const size_t i = (size_t)row * D + col; MG[i] = (bf16)f2bf(bf2f(SGA[i]) * a + bf2f(SGC[i]) * a2); } };
struct E4 { const float* x; float* X1; bf16* XB1;
    __device__ void operator()(int row, int col, float a, float) const { const size_t i = (size_t)row * D + col; const float v = x[i] + a; X1[i] = v; XB1[i] = (bf16)f2bf(v); } };
struct E5 { float* SC; __device__ void operator()(int row, int col, float a, float) const { SC[(size_t)row * 1024 + col] = a; } };
struct E7 { const float* SS3; const bf16* PP; float* X; const bf16* XB2;
    __device__ void operator()(int row, int col, float a, float) const { const size_t i = (size_t)row * D + col; float q_ = 0.f; for (int j_ = 0; j_ < 16; ++j_) q_ += SS3[(size_t)row * 16 + j_]; X[i] = bf2f(XB2[i]) + sigmoidf_(a / sqrtf(q_ * (1.0f / D) + EPS)) * bf2f(PP[i]); } };

__global__ void k_z(const float* TGC, const float* TXC, bf16* Z) { const size_t i = (size_t)blockIdx.x * blockDim.x + threadIdx.x; if (i < (size_t)M * AW) Z[i] = (bf16)f2bf(TGC[i] * TXC[i]); }
__global__ void k_cumsum(const float* LF, float* CS) { const int bh = threadIdx.x; if (bh >= 32) return; float s = 0.f; for (int t = 0; t < SEQ; ++t) { s += LF[(size_t)bh * SEQ + t]; CS[(size_t)bh * SEQ + t] = s; } }
__global__ void k_conv(const bf16* GB, const bf16* Z, const float* cw, bf16* AC) {
    const size_t i = (size_t)blockIdx.x * blockDim.x + threadIdx.x; if (i >= (size_t)M * AW) return;
    const int row = (int)(i / AW), c = (int)(i % AW), t = row % SEQ;
    float s = cw[2 * AW + c] * bf2f(Z[i]);
    if (t >= 1) s += cw[1 * AW + c] * bf2f(Z[i - AW]);
    if (t >= 2) s += cw[0 * AW + c] * bf2f(Z[i - 2 * AW]);
    AC[(size_t)row * D + AW + c] = (bf16)f2bf(bf2f(GB[i]) * s);
}
__global__ void __launch_bounds__(64) k_attn(const bf16* Q, const bf16* K, const bf16* V, const float* CS, bf16* AC) {
    const int bh = blockIdx.y, b = bh / NH, h = bh % NH, q = blockIdx.x * 64 + threadIdx.x;
    const size_t rq = (size_t)b * SEQ + q;
    float qv[64], o[64];
#pragma unroll
    for (int d = 0; d < 64; ++d) { qv[d] = bf2f(Q[rq * AW + h * 64 + d]); o[d] = 0.f; }
    const float cq = CS[(size_t)bh * SEQ + q];
    float m = -INFINITY, l = 0.f;
    const int kvmax = blockIdx.x * 64 + 63;
    for (int kv = 0; kv <= kvmax; ++kv) {
        const size_t rk = (size_t)b * SEQ + kv;
        const u32x4* kp = (const u32x4*)(K + rk * AW + h * 64);
        float s = 0.f;
#pragma unroll
        for (int c = 0; c < 8; ++c) { const u32x4 w = kp[c];
#pragma unroll
            for (int e = 0; e < 4; ++e) { s += qv[c * 8 + 2 * e] * __uint_as_float(w[e] << 16) + qv[c * 8 + 2 * e + 1] * __uint_as_float(w[e] & 0xffff0000u); } }
        s += cq - CS[(size_t)bh * SEQ + kv];
        if (kv > q) s = -INFINITY;
        const float mn = fmaxf(m, s);
        const float al = (m == -INFINITY) ? 0.f : exp2f(m - mn), p = (s == -INFINITY) ? 0.f : exp2f(s - mn);
        l = l * al + p; m = mn;
        const u32x4* vp = (const u32x4*)(V + rk * AW + h * 64);
#pragma unroll
        for (int c = 0; c < 8; ++c) { const u32x4 w = vp[c];
#pragma unroll
            for (int e = 0; e < 4; ++e) { o[c * 8 + 2 * e] = o[c * 8 + 2 * e] * al + p * __uint_as_float(w[e] << 16); o[c * 8 + 2 * e + 1] = o[c * 8 + 2 * e + 1] * al + p * __uint_as_float(w[e] & 0xffff0000u); } }
    }
    const float il = 1.0f / l;
#pragma unroll
    for (int d = 0; d < 64; ++d) AC[rq * D + h * 64 + d] = (bf16)f2bf(o[d] * il);
}
__global__ void __launch_bounds__(256) k_rowss(const float* X, float* SS) {
    const int lane = threadIdx.x & 63, row = blockIdx.x * 4 + (threadIdx.x >> 6);
    const f32x4* xr = (const f32x4*)(X + (size_t)row * D); float ss = 0.f;
#pragma unroll
    for (int j = 0; j < 4; ++j) { const f32x4 v = xr[lane + 64 * j]; ss += v.x * v.x + v.y * v.y + v.z * v.z + v.w * v.w; }
    ss = wave_sum(ss);
    if (lane < 16) SS[(size_t)row * 16 + lane] = lane == 0 ? ss : 0.f;
}
__global__ void __launch_bounds__(64) k_topk(const float* SC, const float* SS2, int hg, unsigned short* IDS, float* GATES) {
    __shared__ float s[128][64]; __shared__ float tv[16][64]; __shared__ int ti[16][64];
    const int tid = threadIdx.x, pair = blockIdx.x * 32 + (tid >> 1), half = tid & 1, token = pair >> 2, hl = pair & 3;
    const float* src = SC + (size_t)token * 1024 + hl * 256 + half * 128;
    for (int k = 0; k < 128; ++k) s[k][tid] = src[k];
    float pv = INFINITY; int pk = -1;
    for (int r = 0; r < 16; ++r) {
        float best = -INFINITY; int bi = 0;
        for (int k = 0; k < 128; ++k) { const float v = s[k][tid]; const bool elig = (v < pv) || (v == pv && k > pk); if (elig && v > best) { best = v; bi = k; } }
        tv[r][tid] = best; ti[r][tid] = bi; pv = best; pk = bi;
    }
    __syncthreads();
    if (half == 0) {
        const float* ss = SS2 + (size_t)token * 16; float sst = 0.f; for (int q_ = 0; q_ < 16; ++q_) sst += ss[q_]; const float rstd = 1.0f / sqrtf(sst * (1.0f / D) + EPS);
        float ts[16]; int tf[16];
        float cpv = INFINITY; int cpf = -1;
#pragma unroll
        for (int r = 0; r < 16; ++r) {
            float best = -INFINITY; int bf_ = 0;
            for (int c = 0; c < 256; ++c) { const float v = tv[c >> 4][tid] + tv[c & 15][tid + 1]; const bool elig = (v < cpv) || (v == cpv && c > cpf); if (elig && v > best) { best = v; bf_ = c; } }
            ts[r] = best; tf[r] = bf_; cpv = best; cpf = bf_;
        }
        float e[16], sum = 0.f;
#pragma unroll
        for (int r = 0; r < 16; ++r) { e[r] = __expf(rstd * (ts[r] - ts[0])); sum += e[r]; }
        const float inv = 1.0f / sum; const int head = hg * 4 + hl;
#pragma unroll
        for (int r = 0; r < 16; ++r) { IDS[(size_t)token * 128 + head * 16 + r] = (unsigned short)(ti[tf[r] >> 4][tid] * 128 + ti[tf[r] & 15][tid + 1]); GATES[(size_t)token * 128 + head * 16 + r] = e[r] * inv; }
    }
}
__global__ void __launch_bounds__(256) k_peer(const bf16* XB1, const float* SS2, const unsigned short* IDS, const float* GATES, const bf16* UB, const bf16* VB, float* X, bf16* XB2, float* RSTD3) {
    const int lane = threadIdx.x & 63, token = blockIdx.x * 4 + (threadIdx.x >> 6);
    const float* ss = SS2 + (size_t)token * 16; float sst = 0.f; for (int q_ = 0; q_ < 16; ++q_) sst += ss[q_]; const float rstd = 1.0f / sqrtf(sst * (1.0f / D) + EPS);
    float xf[16], out[16];
    { const u32x4 a = *(const u32x4*)(XB1 + (size_t)token * D + 8 * lane), b = *(const u32x4*)(XB1 + (size_t)token * D + 512 + 8 * lane);
#pragma unroll
      for (int e = 0; e < 4; ++e) { xf[2 * e] = __uint_as_float(a[e] << 16); xf[2 * e + 1] = __uint_as_float(a[e] & 0xffff0000u); xf[8 + 2 * e] = __uint_as_float(b[e] << 16); xf[8 + 2 * e + 1] = __uint_as_float(b[e] & 0xffff0000u); } }
#pragma unroll
    for (int i = 0; i < 16; ++i) out[i] = 0.f;
    for (int hk = 0; hk < 128; ++hk) {
        const int id = IDS[(size_t)token * 128 + hk]; const float g = GATES[(size_t)token * 128 + hk];
        const u32x4 a = *(const u32x4*)(UB + (size_t)id * D + 8 * lane), b = *(const u32x4*)(UB + (size_t)id * D + 512 + 8 * lane);
        float dot = 0.f;
#pragma unroll
        for (int e = 0; e < 4; ++e) { dot += xf[2 * e] * __uint_as_float(a[e] << 16) + xf[2 * e + 1] * __uint_as_float(a[e] & 0xffff0000u) + xf[8 + 2 * e] * __uint_as_float(b[e] << 16) + xf[8 + 2 * e + 1] * __uint_as_float(b[e] & 0xffff0000u); }
        dot = wave_sum(dot) * rstd;
        const float w = g * 0.5f * dot * (1.0f + erff(dot * 0.70710678118654752f));
        const u32x4 va = *(const u32x4*)(VB + (size_t)id * D + 8 * lane), vb = *(const u32x4*)(VB + (size_t)id * D + 512 + 8 * lane);
#pragma unroll
        for (int e = 0; e < 4; ++e) { out[2 * e] += w * __uint_as_float(va[e] << 16); out[2 * e + 1] += w * __uint_as_float(va[e] & 0xffff0000u); out[8 + 2 * e] += w * __uint_as_float(vb[e] << 16); out[8 + 2 * e + 1] += w * __uint_as_float(vb[e] & 0xffff0000u); }
    }
    float* xr = X + (size_t)token * D; float s2 = 0.f;
    f32x4 x0, x1, x2, x3;
    for (int e = 0; e < 4; ++e) { x0[e] = xf[e]; x1[e] = xf[4 + e]; x2[e] = xf[8 + e]; x3[e] = xf[12 + e]; }
#pragma unroll
    for (int e = 0; e < 4; ++e) { x0[e] += out[e]; x1[e] += out[4 + e]; x2[e] += out[8 + e]; x3[e] += out[12 + e]; s2 += x0[e] * x0[e] + x1[e] * x1[e] + x2[e] * x2[e] + x3[e] * x3[e]; }
    *(f32x4*)(xr + 8 * lane) = x0; *(f32x4*)(xr + 8 * lane + 4) = x1; *(f32x4*)(xr + 512 + 8 * lane) = x2; *(f32x4*)(xr + 512 + 8 * lane + 4) = x3;
    u32x4 w0, w1; w0.x = pk2(x0.x, x0.y); w0.y = pk2(x0.z, x0.w); w0.z = pk2(x1.x, x1.y); w0.w = pk2(x1.z, x1.w); w1.x = pk2(x2.x, x2.y); w1.y = pk2(x2.z, x2.w); w1.z = pk2(x3.x, x3.y); w1.w = pk2(x3.z, x3.w);
    *(u32x4*)(XB2 + (size_t)token * D + 8 * lane) = w0; *(u32x4*)(XB2 + (size_t)token * D + 512 + 8 * lane) = w1;
    s2 = wave_sum(s2);
    if (lane < 16) RSTD3[(size_t)token * 16 + lane] = lane == 0 ? s2 : 0.f;
}
__global__ void __launch_bounds__(256) k_final(float* X, const float* g) {
    const int lane = threadIdx.x & 63, row = blockIdx.x * 4 + (threadIdx.x >> 6);
    f32x4* xr = (f32x4*)(X + (size_t)row * D); f32x4 v[4]; float ss = 0.f;
#pragma unroll
    for (int j = 0; j < 4; ++j) { v[j] = xr[lane + 64 * j]; ss += v[j].x * v[j].x + v[j].y * v[j].y + v[j].z * v[j].z + v[j].w * v[j].w; }
    ss = wave_sum(ss); const float rstd = 1.0f / sqrtf(ss * (1.0f / D) + EPS);
#pragma unroll
    for (int j = 0; j < 4; ++j) { const f32x4 gv = ((const f32x4*)g)[lane + 64 * j]; xr[lane + 64 * j] = v[j] * rstd * gv; }
}

}

#ifndef MK_FUSED_MASK
#define MK_FUSED_MASK 0x1ff
#endif
static void golden_phase(int ph, void* const* d_in, float* out, unsigned char* ws, hipStream_t stream) {
    using namespace gold;
    const float* x = (const float*)d_in[0]; const float* p = (const float*)d_in[1]; const float* g_mix = (const float*)d_in[2]; const float* w_in = (const float*)d_in[3];
    const float* b_f = (const float*)d_in[4]; const float* conv_w = (const float*)d_in[5]; const float* w_branch = (const float*)d_in[6]; const float* w_out = (const float*)d_in[7];
    const float* g_ffn = (const float*)d_in[8]; const float* w_peer_q = (const float*)d_in[9]; const float* peer_k1 = (const float*)d_in[10]; const float* peer_k2 = (const float*)d_in[11];
    const float* peer_u = (const float*)d_in[12]; const float* peer_v = (const float*)d_in[13]; const float* g_ple = (const float*)d_in[14]; const float* w_ple_gate = (const float*)d_in[15];
    const float* w_ple_proj = (const float*)d_in[16]; const float* g_final = (const float*)d_in[17];
    float *RSTD1 = (float*)(ws + WS_RSTD1), *SS2 = (float*)(ws + WS_SS2), *LF = (float*)(ws + WS_LF), *CS = (float*)(ws + WS_CS);
    bf16 *WIN = (bf16*)(ws + WS_WIN), *WBR = (bf16*)(ws + WS_WBR), *WOUT = (bf16*)(ws + WS_WOUT), *WST = (bf16*)(ws + WS_WS), *WPG = (bf16*)(ws + WS_WPG), *WPP = (bf16*)(ws + WS_WPP), *PB = (bf16*)(ws + WS_PB);
    bf16 *UB = (bf16*)(ws + WS_UB), *VB = (bf16*)(ws + WS_VB), *XB = (bf16*)(ws + WS_A), *AC = (bf16*)(ws + WS_A), *XB1 = (bf16*)(ws + WS_A), *PP = (bf16*)(ws + WS_PP);
    bf16 *Q = (bf16*)(ws + WS_Q), *K = (bf16*)(ws + WS_K), *V = (bf16*)(ws + WS_V), *GB = (bf16*)(ws + WS_GB), *Z = (bf16*)(ws + WS_Z), *MG = (bf16*)(ws + WS_MERGED), *XB2 = (bf16*)(ws + WS_XB2);
    unsigned short* IDS = (unsigned short*)(ws + WS_IDS); float* GATES = (float*)(ws + WS_GATES);
    bf16 *SGA = (bf16*)out, *SGC = (bf16*)out + (size_t)M * D;
    float *TGC = (float*)(ws + WS_TGC), *TXC = (float*)(ws + WS_TXC), *SC = (float*)(ws + WS_SC);
    auto nb = [](size_t n) { return (unsigned)((n + 255) / 256); };
    switch (ph) {
    case 0:
        k_rows0<<<M / 4, 256, 0, stream>>>(x, w_in, g_mix, b_f, XB, RSTD1, LF);
        k_wt<1><<<nb((size_t)NIN * D), 256, 0, stream>>>(w_in, INTOT, g_mix, WIN, NIN, D, 0, D);
        k_wt<0><<<nb((size_t)D * AW), 256, 0, stream>>>(w_branch, D, nullptr, WBR, D, AW, 0, D);
        k_wt<0><<<nb((size_t)D * AW), 256, 0, stream>>>(w_branch + (size_t)AW * D, D, nullptr, WBR, D, AW, AW, D);
        k_wt<0><<<nb((size_t)D * D), 256, 0, stream>>>(w_out, D, nullptr, WOUT, D, D, 0, D);
        k_wt<0><<<nb((size_t)D * D), 256, 0, stream>>>(w_ple_gate, D, g_ple, WPG, D, D, 0, D);
        k_wt<0><<<nb((size_t)D * PLE), 256, 0, stream>>>(w_ple_proj, D, nullptr, WPP, D, PLE, 0, PLE);
        k_ws<<<nb((size_t)NS * D), 256, 0, stream>>>(w_peer_q, peer_k1, peer_k2, g_ffn, WST);
        k_cvt<<<nb((size_t)M * PLE), 256, 0, stream>>>(p, nullptr, PB, (size_t)M * PLE, 0);
        break;
    case 1:
        ng<E1, false><<<dim3(NIN / 64, M / 64), 256, 0, stream>>>(XB, D, WIN, D, D, E1{RSTD1, Q, K, V, GB, SGA, SGC, TGC, TXC});
        ng<EPP, false><<<dim3(D / 64, M / 64), 256, 0, stream>>>(PB, PLE, WPP, PLE, PLE, EPP{PP});
        k_z<<<nb((size_t)M * AW), 256, 0, stream>>>(TGC, TXC, Z);
        break;
    case 2:
        k_cumsum<<<1, 64, 0, stream>>>(LF, CS);
        k_conv<<<nb((size_t)M * AW), 256, 0, stream>>>(GB, Z, conv_w, AC);
        k_attn<<<dim3(SEQ / 64, BATCH * NH), 64, 0, stream>>>(Q, K, V, CS, AC);
        break;
    case 3: ng<E3, true><<<dim3(D / 64, M / 64), 256, 0, stream>>>(AC, D, WBR, D, D, E3{SGA, SGC, MG}); break;
    case 4:
        ng<E4, false><<<dim3(D / 64, M / 64), 256, 0, stream>>>(MG, D, WOUT, D, D, E4{x, out, XB1});
        k_rowss<<<M / 4, 256, 0, stream>>>(out, SS2);
        break;
    case 5:
        for (int hg = 0; hg < 2; ++hg) {
            ng<E5, false><<<dim3(1024 / 64, M / 64), 256, 0, stream>>>(XB1, D, WST + (size_t)hg * 1024 * D, D, D, E5{SC});
            k_topk<<<M * 4 / 32, 64, 0, stream>>>(SC, SS2, hg, IDS, GATES);
        }
        break;
    case 6:
        k_cvt<<<nb((size_t)NEXP * D), 256, 0, stream>>>(peer_u, g_ffn, UB, (size_t)NEXP * D, D - 1);
        k_cvt<<<nb((size_t)NEXP * D), 256, 0, stream>>>(peer_v, nullptr, VB, (size_t)NEXP * D, 0);
        k_peer<<<M / 4, 256, 0, stream>>>(XB1, SS2, IDS, GATES, UB, VB, out, XB2, SS2);
        break;
    case 7: ng<E7, false><<<dim3(D / 64, M / 64), 256, 0, stream>>>(XB2, D, WPG, D, D, E7{SS2, PP, out, XB2}); break;
    case 8: k_final<<<M / 4, 256, 0, stream>>>(out, g_final); break;
    }
}
extern "C" void kernel_launch(void* const* d_in, const int* in_sizes, int n_in, void* d_out, int out_size, void* d_ws, size_t ws_size, hipStream_t stream) {
    static int grid = 0;
    if (grid == 0) {
        if (n_in != 18 || in_sizes[0] != M * D || out_size != M * D || ws_size < WS_END) { fprintf(stderr, "kernel_launch: unexpected shapes (n_in %d, in0 %d, out %d, ws %zu); nothing launched\n", n_in, n_in > 0 ? in_sizes[0] : -1, out_size, ws_size); grid = -1; return; }
        int dev = 0, cus = 0, per_cu = 0;
        if (hipGetDevice(&dev) != hipSuccess || hipDeviceGetAttribute(&cus, hipDeviceAttributeMultiprocessorCount, dev) != hipSuccess) { fprintf(stderr, "kernel_launch: device query failed\n"); grid = -1; return; }
        if (hipFuncSetAttribute((const void*)mk_fwd, hipFuncAttributeMaxDynamicSharedMemorySize, LDS_BYTES) != hipSuccess) { fprintf(stderr, "kernel_launch: hipFuncSetAttribute failed\n"); grid = -1; return; }
        if (hipOccupancyMaxActiveBlocksPerMultiprocessor(&per_cu, (const void*)mk_fwd, NWAVES * 64, LDS_BYTES) != hipSuccess || per_cu < 1) { fprintf(stderr, "kernel_launch: occupancy query says %d workgroups per CU; nothing launched\n", per_cu); (void)hipGetLastError(); grid = -1; return; }
        grid = cus;
    }
    if (grid < 0) return;
    if (hipMemsetAsync((char*)d_ws + WS_CTL, 0, CTL_ZERO_BYTES, stream) != hipSuccess) { fprintf(stderr, "kernel_launch: hipMemsetAsync failed\n"); return; }
    Args a{};
    for (int i = 0; i < 18; ++i) a.in[i] = (const float*)d_in[i];
    a.out = (float*)d_out; a.ws = (unsigned char*)d_ws;
    int li = 0;
    for (int ph = 0; ph < NPHASE;) {
        if ((MK_FUSED_MASK >> ph) & 1) {
            int hi = ph; while (hi < NPHASE && ((MK_FUSED_MASK >> hi) & 1)) ++hi;
            a.ph_lo = ph; a.ph_hi = hi; a.li = li++; a.pad = 0;
            hipLaunchKernelGGL(mk_fwd, dim3(grid), dim3(NWAVES * 64), LDS_BYTES, stream, a);
            const hipError_t le = hipPeekAtLastError();
            if (le != hipSuccess) { fprintf(stderr, "kernel_launch: launch failed: %s\n", hipGetErrorName(le)); return; }
            ph = hi;
        } else {
            golden_phase(ph, d_in, (float*)d_out, (unsigned char*)d_ws, stream);
            if ((ph == 1 || ph == 5) && (MK_FUSED_MASK & 1) && ((MK_FUSED_MASK >> 6) & 1)) {
                gold::k_cvt<<<(unsigned)(((size_t)NEXP * D + 255) / 256), 256, 0, stream>>>((const float*)d_in[12], (const float*)d_in[8], (bf16*)((unsigned char*)d_ws + WS_UB), (size_t)NEXP * D, D - 1);
                gold::k_cvt<<<(unsigned)(((size_t)NEXP * D + 255) / 256), 256, 0, stream>>>((const float*)d_in[13], nullptr, (bf16*)((unsigned char*)d_ws + WS_VB), (size_t)NEXP * D, 0);
            }
            ++ph;
        }
    }
}
```

```cpp
#include <hip/hip_runtime.h>
#include <hip/hip_bf16.h>
#include <cstdio>
#include <cstdint>
#include <cmath>
#define MK_FUSED_MASK 0x1ff
namespace pg8 {
#define PG8_LAS __attribute__((address_space(3)))
typedef unsigned short bf16_t;
typedef short bf16x8 __attribute__((ext_vector_type(8)));
typedef float f32x4 __attribute__((ext_vector_type(4)));
typedef unsigned u32x4 __attribute__((ext_vector_type(4)));
constexpr int BM = 256, BK = 64, HALF = 128, HTB = HALF * BK * 2  , STAGE_BYTES = 8 * HTB, NXCD = 8, WGM = 8;

__host__ __device__ __forceinline__ int lds_byte(int r, int c) { const int st = (r >> 4) * 2 + (c >> 5), rr = r & 15, cc = c & 31, ob = rr * 64 + cc * 2; return st * 1024 + (ob ^ (((ob >> 9) & 1) << 5)); }
__host__ __device__ __forceinline__ void stage_rc(int b, int& R, int& C) { const int st = b / 1024, sb = b % 1024, swz = sb ^ (((sb >> 9) & 1) << 5); R = (st >> 1) * 16 + swz / 64; C = (st & 1) * 32 + (swz % 64) / 2; }
__host__ __device__ __forceinline__ int perm32(int rho) { const int n = rho >> 4, i = rho & 15; return 8 * (i >> 2) + 4 * n + (i & 3); }

struct Unit { int pm, pn; };
struct Gemm { const bf16_t* A; const bf16_t* Bt; int M, N, K; };

struct StaticOrder {
    int nM, nN, nwg, G, c;
    __host__ __device__ void init(int M, int N, int G_, int c_) { nM = M / BM; nN = N / BM; nwg = nM * nN; G = G_; c = c_; }
    __host__ __device__ bool next(int i, Unit& u) const {
        const long L = (long)i * G + c; if (L >= nwg) return false;
        int wgid = (int)L; { const int q = nwg / NXCD, r = nwg % NXCD, xcd = wgid % NXCD, off = wgid / NXCD; wgid = (xcd < r ? xcd * (q + 1) : r * (q + 1) + (xcd - r) * q) + off; }
        const int nig = WGM * nN, gid = wgid / nig, fm = gid * WGM, gsz = (nM - fm) < WGM ? (nM - fm) : WGM;
        u.pm = fm + ((wgid % nig) % gsz); u.pn = (wgid % nig) / gsz; return true;
    }
    __device__ __forceinline__ void a_ready(const Unit&) const {}
    __device__ __forceinline__ void done(const Unit&) const {}
};


__device__ __forceinline__ unsigned cvt_pk_bf16(float lo, float hi) { unsigned r; asm volatile("v_cvt_pk_bf16_f32 %0, %1, %2" : "=v"(r) : "v"(lo), "v"(hi)); return r; }
__device__ __forceinline__ u32x4 pack8(const f32x4 v0, const f32x4 v1) { u32x4 w; w.x = cvt_pk_bf16(v0[0], v0[1]); w.y = cvt_pk_bf16(v0[2], v0[3]); w.z = cvt_pk_bf16(v1[0], v1[1]); w.w = cvt_pk_bf16(v1[2], v1[3]); return w; }
__device__ __forceinline__ float bflo(unsigned w) { return __uint_as_float(w << 16); }
__device__ __forceinline__ float bfhi(unsigned w) { return __uint_as_float(w & 0xffff0000u); }
__device__ __forceinline__ float sigm(float v) { return __builtin_amdgcn_rcpf(1.0f + __builtin_amdgcn_exp2f(v * -1.4426950408889634f)); }
__device__ __forceinline__ f32x4 sigm4(const f32x4 v) { return (f32x4){sigm(v[0]), sigm(v[1]), sigm(v[2]), sigm(v[3])}; }

struct EpiIn {
    static constexpr bool PERM = true, AFTER_DRAIN = false; static constexpr int MID_T = 0;
    const float* rstd; bf16_t* QKVG; size_t stride4; bf16_t* Z; bf16_t* SG; size_t strideSG; float c2;
    __device__ __forceinline__ void operator()(const f32x4 (&acc)[2][2][4][2], const Unit& u, int wr, int wc, int fr, int fq) const {
        int row0 = u.pm * BM + wr * 64 + fr; asm volatile("" : "+v"(row0)); const int cl = wc * 32 + 8 * fq, pn = u.pn;
        if (pn < 8) {
            bf16_t* base = QKVG + (size_t)(pn >> 1) * stride4; const int colt = (pn & 1) * 256 + cl; const float s0 = pn < 2 ? c2 : 1.f;
#pragma unroll
            for (int ai = 0; ai < 2; ++ai)
#pragma unroll
                for (int m = 0; m < 4; ++m) { const int row = row0 + ai * HALF + m * 16; const float sc = rstd[row] * s0; bf16_t* rowp = base + (size_t)row * 512 + colt;
#pragma unroll
                    for (int bj = 0; bj < 2; ++bj) *(u32x4*)(rowp + bj * HALF) = pack8(acc[ai][bj][m][0] * sc, acc[ai][bj][m][1] * sc);
                    asm volatile("" ::: "memory"); }
        } else if (pn < 12) {
            const int colt = (pn - 8) * 128 + cl;
#pragma unroll
            for (int ai = 0; ai < 2; ++ai)
#pragma unroll
                for (int m = 0; m < 4; ++m) { const int row = row0 + ai * HALF + m * 16; const float r = rstd[row], sc = r * r;
                    *(u32x4*)(Z + (size_t)row * 512 + colt) = pack8(acc[ai][0][m][0] * acc[ai][1][m][0] * sc, acc[ai][0][m][1] * acc[ai][1][m][1] * sc);
                    asm volatile("" ::: "memory"); }
        } else {
            bf16_t* base = SG + (size_t)((pn - 12) >> 2) * strideSG; const int colt = ((pn - 12) & 3) * 256 + cl;
#pragma unroll
            for (int ai = 0; ai < 2; ++ai)
#pragma unroll
                for (int m = 0; m < 4; ++m) { const int row = row0 + ai * HALF + m * 16; const float r = rstd[row]; bf16_t* rowp = base + (size_t)row * 1024 + colt;
#pragma unroll
                    for (int bj = 0; bj < 2; ++bj) { *(u32x4*)(rowp + bj * HALF) = pack8(sigm4(acc[ai][bj][m][0] * r), sigm4(acc[ai][bj][m][1] * r)); asm volatile("" ::: "memory"); } }
        }
    }
};
struct EpiPlain {
    static constexpr bool PERM = true, AFTER_DRAIN = false; static constexpr int MID_T = 0;
    bf16_t* O; int ldc;
    __device__ __forceinline__ void operator()(const f32x4 (&acc)[2][2][4][2], const Unit& u, int wr, int wc, int fr, int fq) const {
        int row0 = u.pm * BM + wr * 64 + fr; asm volatile("" : "+v"(row0)); const int col0 = u.pn * BM + wc * 32 + 8 * fq;
#pragma unroll
        for (int ai = 0; ai < 2; ++ai)
#pragma unroll
            for (int m = 0; m < 4; ++m) { bf16_t* rowp = O + (size_t)(row0 + ai * HALF + m * 16) * ldc + col0;
#pragma unroll
                for (int bj = 0; bj < 2; ++bj) *(u32x4*)(rowp + bj * HALF) = pack8(acc[ai][bj][m][0], acc[ai][bj][m][1]); }
    }
};
struct EpiBranch {
    static constexpr bool PERM = true, AFTER_DRAIN = false; static constexpr int MID_T = 8;
    const bf16_t *SGA, *SGC; bf16_t* MG;
    __device__ __forceinline__ void mid(f32x4 (&acc)[2][2][4][2], const Unit& u, int wr, int wc, int fr, int fq) const {
        int row0 = u.pm * BM + wr * 64 + fr; asm volatile("" : "+v"(row0)); const int col0 = u.pn * BM + wc * 32 + 8 * fq;
#pragma unroll
        for (int ai = 0; ai < 2; ++ai) {
            u32x4 a[4][2], c[4][2];
#pragma unroll
            for (int m = 0; m < 4; ++m)
#pragma unroll
                for (int bj = 0; bj < 2; ++bj) { const size_t off = (size_t)(row0 + ai * HALF + m * 16) * 1024 + col0 + bj * HALF; a[m][bj] = *(const u32x4*)(SGA + off); c[m][bj] = *(const u32x4*)(SGC + off); }
#pragma unroll
            for (int m = 0; m < 4; ++m)
#pragma unroll
                for (int bj = 0; bj < 2; ++bj) { const u32x4 av = a[m][bj], cv = c[m][bj]; f32x4 r0, r1;
                    r0[0] = bflo(av[0]) * __builtin_amdgcn_rcpf(bflo(cv[0])); r0[1] = bfhi(av[0]) * __builtin_amdgcn_rcpf(bfhi(cv[0])); r0[2] = bflo(av[1]) * __builtin_amdgcn_rcpf(bflo(cv[1])); r0[3] = bfhi(av[1]) * __builtin_amdgcn_rcpf(bfhi(cv[1]));
                    r1[0] = bflo(av[2]) * __builtin_amdgcn_rcpf(bflo(cv[2])); r1[1] = bfhi(av[2]) * __builtin_amdgcn_rcpf(bfhi(cv[2])); r1[2] = bflo(av[3]) * __builtin_amdgcn_rcpf(bflo(cv[3])); r1[3] = bfhi(av[3]) * __builtin_amdgcn_rcpf(bfhi(cv[3]));
                    acc[ai][bj][m][0] *= r0; acc[ai][bj][m][1] *= r1; }
            asm volatile("" ::: "memory");
        }
    }
    __device__ __forceinline__ void operator()(const f32x4 (&acc)[2][2][4][2], const Unit& u, int wr, int wc, int fr, int fq) const {
        int row0 = u.pm * BM + wr * 64 + fr; asm volatile("" : "+v"(row0)); const int col0 = u.pn * BM + wc * 32 + 8 * fq;
#pragma unroll
        for (int ai = 0; ai < 2; ++ai) {
            u32x4 c[4][2];
#pragma unroll
            for (int m = 0; m < 4; ++m)
#pragma unroll
                for (int bj = 0; bj < 2; ++bj) c[m][bj] = *(const u32x4*)(SGC + (size_t)(row0 + ai * HALF + m * 16) * 1024 + col0 + bj * HALF);
#pragma unroll
            for (int m = 0; m < 4; ++m)
#pragma unroll
                for (int bj = 0; bj < 2; ++bj) { const u32x4 cv = c[m][bj];
                    const f32x4 s0 = {bflo(cv[0]), bfhi(cv[0]), bflo(cv[1]), bfhi(cv[1])}, s1 = {bflo(cv[2]), bfhi(cv[2]), bflo(cv[3]), bfhi(cv[3])};
                    *(u32x4*)(MG + (size_t)(row0 + ai * HALF + m * 16) * 1024 + col0 + bj * HALF) = pack8(acc[ai][bj][m][0] * s0, acc[ai][bj][m][1] * s1); }
            asm volatile("" ::: "memory");
        }
    }
};
struct EpiOut {
    static constexpr bool PERM = true, AFTER_DRAIN = false; static constexpr int MID_T = 0;
    const float* x; bf16_t* XB1; float* SS2;
    __device__ __forceinline__ void operator()(const f32x4 (&acc)[2][2][4][2], const Unit& u, int wr, int wc, int fr, int fq) const {
        int row0 = u.pm * BM + wr * 64 + fr; asm volatile("" : "+v"(row0)); const int col0 = u.pn * BM + wc * 32 + 8 * fq;
#pragma unroll
        for (int ai = 0; ai < 2; ++ai) {
            f32x4 xv[4][2][2];
#pragma unroll
            for (int m = 0; m < 4; ++m)
#pragma unroll
                for (int bj = 0; bj < 2; ++bj) { const float* xp = x + (size_t)(row0 + ai * HALF + m * 16) * 1024 + col0 + bj * HALF; xv[m][bj][0] = *(const f32x4*)xp; xv[m][bj][1] = *(const f32x4*)(xp + 4); }
#pragma unroll
            for (int m = 0; m < 4; ++m) { const int row = row0 + ai * HALF + m * 16; float ss = 0.f;
#pragma unroll
                for (int bj = 0; bj < 2; ++bj) { const f32x4 v0 = acc[ai][bj][m][0] + xv[m][bj][0], v1 = acc[ai][bj][m][1] + xv[m][bj][1];
                    *(u32x4*)(XB1 + (size_t)row * 1024 + col0 + bj * HALF) = pack8(v0, v1);
                    ss += (v0[0] * v0[0] + v0[1] * v0[1]) + (v0[2] * v0[2] + v0[3] * v0[3]) + (v1[0] * v1[0] + v1[1] * v1[1]) + (v1[2] * v1[2] + v1[3] * v1[3]); }
                ss += __shfl_xor(ss, 16); ss += __shfl_xor(ss, 32);
                if (fq == 0) SS2[(size_t)row * 16 + u.pn * 4 + wc] = ss; }
            asm volatile("" ::: "memory");
        }
    }
};
struct EpiPle {
    static constexpr bool PERM = true, AFTER_DRAIN = false; static constexpr int MID_T = 0;
    const float* SS3; const bf16_t* PP; const bf16_t* XB2; float* X; float eps; const PG8_LAS float* rtab;
    __device__ __forceinline__ void operator()(const f32x4 (&acc)[2][2][4][2], const Unit& u, int wr, int wc, int fr, int fq) const {
        int row0 = u.pm * BM + wr * 64 + fr; asm volatile("" : "+v"(row0)); const int col0 = u.pn * BM + wc * 32 + 8 * fq;
#pragma unroll
        for (int ai = 0; ai < 2; ++ai) {
            u32x4 pv[4][2], xb[4][2]; float rr[4];
#pragma unroll
            for (int m = 0; m < 4; ++m) { const int row = row0 + ai * HALF + m * 16;
#pragma unroll
                for (int bj = 0; bj < 2; ++bj) { const size_t off = (size_t)row * 1024 + col0 + bj * HALF; pv[m][bj] = *(const u32x4*)(PP + off); xb[m][bj] = *(const u32x4*)(XB2 + off); }
                if (rtab) rr[m] = rtab[wr * 64 + fr + ai * HALF + m * 16];
                else { const f32x4* sp = (const f32x4*)(SS3 + (size_t)row * 16); const f32x4 q0 = sp[0], q1 = sp[1]; rr[m] = 1.0f / sqrtf((((q0[0] + q0[1]) + (q0[2] + q0[3])) + ((q1[0] + q1[1]) + (q1[2] + q1[3]))) * (1.0f / 1024.0f) + eps); } }
#pragma unroll
            for (int m = 0; m < 4; ++m) { const int row = row0 + ai * HALF + m * 16; const float r = rr[m];
#pragma unroll
                for (int bj = 0; bj < 2; ++bj) { const u32x4 c = pv[m][bj], xq = xb[m][bj]; const size_t off = (size_t)row * 1024 + col0 + bj * HALF;
                    const f32x4 p0 = {bflo(c[0]), bfhi(c[0]), bflo(c[1]), bfhi(c[1])}, p1 = {bflo(c[2]), bfhi(c[2]), bflo(c[3]), bfhi(c[3])};
                    const f32x4 x0 = {bflo(xq[0]), bfhi(xq[0]), bflo(xq[1]), bfhi(xq[1])}, x1 = {bflo(xq[2]), bfhi(xq[2]), bflo(xq[3]), bfhi(xq[3])};
                    *(f32x4*)(X + off) = x0 + sigm4(acc[ai][bj][m][0] * r) * p0; *(f32x4*)(X + off + 4) = x1 + sigm4(acc[ai][bj][m][1] * r) * p1; } }
            asm volatile("" ::: "memory");
        }
    }
};

__device__ __forceinline__ float vmaxf(float a, float b) { float r; asm("v_max_f32_e32 %0, %1, %2" : "=v"(r) : "v"(a), "v"(b)); return r; }
__device__ __forceinline__ float vminf(float a, float b) { float r; asm("v_min_f32_e32 %0, %1, %2" : "=v"(r) : "v"(a), "v"(b)); return r; }
__device__ __forceinline__ void sort16_desc(float (&a)[16]) {
#pragma unroll
    for (int k = 2; k <= 16; k <<= 1)
#pragma unroll
        for (int j = k >> 1; j > 0; j >>= 1)
#pragma unroll
            for (int i = 0; i < 16; ++i) { const int l = i ^ j; if (l > i) { const float hi = vmaxf(a[i], a[l]), lo = vminf(a[i], a[l]); if ((i & k) == 0) { a[i] = hi; a[l] = lo; } else { a[i] = lo; a[l] = hi; } } }
}
template <int L> __device__ __forceinline__ void merge16(float (&a)[16], const float (&b)[16]) {
#pragma unroll
    for (int i = 0; i < 16; ++i) if (15 - i < L) a[i] = vmaxf(a[i], b[15 - i]);
#pragma unroll
    for (int j = 8; j > 0; j >>= 1)
#pragma unroll
        for (int i = 0; i < 16; ++i) { const int l = i ^ j; if (l > i) { const float hi = vmaxf(a[i], a[l]), lo = vminf(a[i], a[l]); a[i] = hi; a[l] = lo; } }
}
struct EpiTopK {
    static constexpr bool PERM = true, AFTER_DRAIN = true; static constexpr int MID_T = 0;
    static constexpr int RS = 260;
    const float* SS2; unsigned short* IDS; float* GATES; float eps;
    __device__ __forceinline__ void fused(f32x4 (&acc)[2][2][4][2], const Unit& u, int wr, int wc, int fr, int fq, PG8_LAS unsigned char* lds, int wid, int lane) const {
        PG8_LAS float* S = (PG8_LAS float*)lds;
        const int tid = wid * 64 + lane, row = tid & 127, grp = tid >> 7, half = grp >> 1, part = grp & 1;
#define TK_BAR() do { asm volatile("s_waitcnt vmcnt(0) lgkmcnt(0)" ::: "memory"); __builtin_amdgcn_s_barrier(); asm volatile("" ::: "memory"); } while (0)
#pragma unroll
        for (int ai = 0; ai < 2; ++ai) {
#pragma unroll
            for (int m = 0; m < 4; ++m)
#pragma unroll
                for (int bj = 0; bj < 2; ++bj)
#pragma unroll
                    for (int n = 0; n < 2; ++n) *(PG8_LAS f32x4*)(S + (wr * 64 + m * 16 + fr) * RS + bj * HALF + wc * 32 + 8 * fq + 4 * n) = acc[ai][bj][m][n];
            TK_BAR();
            float T[16];
#pragma unroll
            for (int b = 0; b < 4; ++b) {
                float c[16];
#pragma unroll
                for (int q = 0; q < 4; ++q) { const f32x4 v = *(const PG8_LAS f32x4*)(S + row * RS + half * 128 + part * 64 + b * 16 + q * 4);
#pragma unroll
                    for (int e = 0; e < 4; ++e) c[q * 4 + e] = __uint_as_float((__float_as_uint(v[e]) & ~127u) | (unsigned)(part * 64 + b * 16 + q * 4 + e)); }
                sort16_desc(c);
                if (b == 0) {
#pragma unroll
                    for (int i = 0; i < 16; ++i) T[i] = c[i];
                } else merge16<16>(T, c);
            }
            TK_BAR();
#pragma unroll
            for (int q = 0; q < 4; ++q) *(PG8_LAS f32x4*)(S + tid * 16 + q * 4) = (f32x4){T[q * 4], T[q * 4 + 1], T[q * 4 + 2], T[q * 4 + 3]};
            TK_BAR();
            if (part == 0) {
                float c[16];
#pragma unroll
                for (int q = 0; q < 4; ++q) { const f32x4 v = *(const PG8_LAS f32x4*)(S + (tid + 128) * 16 + q * 4); c[q * 4] = v[0]; c[q * 4 + 1] = v[1]; c[q * 4 + 2] = v[2]; c[q * 4 + 3] = v[3]; }
                merge16<16>(T, c);
            }
            TK_BAR();
            if (part == 0) {
#pragma unroll
                for (int q = 0; q < 4; ++q) *(PG8_LAS f32x4*)(S + tid * 16 + q * 4) = (f32x4){T[q * 4], T[q * 4 + 1], T[q * 4 + 2], T[q * 4 + 3]};
            }
            TK_BAR();
            if (tid < 128) {
                float a1[16], a2[16];
#pragma unroll
                for (int q = 0; q < 4; ++q) { const f32x4 v = *(const PG8_LAS f32x4*)(S + (tid + 256) * 16 + q * 4);
#pragma unroll
                    for (int e = 0; e < 4; ++e) a2[q * 4 + e] = __uint_as_float(__float_as_uint(v[e]) & ~127u); }
#pragma unroll
                for (int i = 0; i < 16; ++i) a1[i] = __uint_as_float(__float_as_uint(T[i]) & ~127u);
#define TK_SUM(i, j) __uint_as_float((__float_as_uint(a1[i] + a2[j]) & ~255u) | (unsigned)((i) * 16 + (j)))
                float R[16], C[16];
#pragma unroll
                for (int j = 0; j < 16; ++j) R[j] = TK_SUM(0, j);
#pragma unroll
                for (int i = 1; i < 16; ++i) C[i - 1] = TK_SUM(i, 0);
                C[15] = 0.f;
                merge16<15>(R, C);
                C[0] = TK_SUM(1, 1); C[1] = TK_SUM(1, 2); C[2] = TK_SUM(1, 3); C[3] = TK_SUM(1, 4); C[4] = TK_SUM(1, 5); C[5] = TK_SUM(1, 6); C[6] = TK_SUM(1, 7);
                C[7] = TK_SUM(2, 1); C[8] = TK_SUM(2, 2); C[9] = TK_SUM(2, 3); C[10] = TK_SUM(2, 4); C[11] = TK_SUM(3, 1); C[12] = TK_SUM(3, 2); C[13] = TK_SUM(3, 3);
                C[14] = TK_SUM(4, 1); C[15] = TK_SUM(4, 2);
                sort16_desc(C);
                merge16<16>(R, C);
                C[0] = TK_SUM(5, 1); C[1] = TK_SUM(6, 1); C[2] = TK_SUM(7, 1);
                merge16<3>(R, C);
#undef TK_SUM
                const int rowg = u.pm * BM + ai * HALF + row;
                const f32x4* ssp = (const f32x4*)(SS2 + (size_t)rowg * 16); const f32x4 s0 = ssp[0], s1 = ssp[1], s2 = ssp[2], s3 = ssp[3];
                const float ssum = ((s0[0] + s0[1]) + (s0[2] + s0[3])) + ((s1[0] + s1[1]) + (s1[2] + s1[3])) + ((s2[0] + s2[1]) + (s2[2] + s2[3])) + ((s3[0] + s3[1]) + (s3[2] + s3[3]));
                const float rl = 1.4426950408889634f / sqrtf(ssum * (1.0f / 1024.0f) + eps);
                float ev[16], esum = 0.f; int idv[16];
#pragma unroll
                for (int r = 0; r < 16; ++r) { ev[r] = __builtin_amdgcn_exp2f((R[r] - R[0]) * rl); esum += ev[r];
                    const unsigned code = __float_as_uint(R[r]) & 255u;
                    const unsigned k1 = __float_as_uint(S[tid * 16 + (code >> 4)]) & 127u, k2 = __float_as_uint(S[(tid + 256) * 16 + (code & 15u)]) & 127u;
                    idv[r] = (int)(k1 * 128u + k2); }
                const float inv = 1.0f / esum;
                unsigned short* ip = IDS + (size_t)rowg * 128 + u.pn * 16; float* gp = GATES + (size_t)rowg * 128 + u.pn * 16;
#pragma unroll
                for (int q = 0; q < 2; ++q) { u32x4 w; w.x = (unsigned)idv[q * 8] | ((unsigned)idv[q * 8 + 1] << 16); w.y = (unsigned)idv[q * 8 + 2] | ((unsigned)idv[q * 8 + 3] << 16); w.z = (unsigned)idv[q * 8 + 4] | ((unsigned)idv[q * 8 + 5] << 16); w.w = (unsigned)idv[q * 8 + 6] | ((unsigned)idv[q * 8 + 7] << 16);
                    *(u32x4*)(ip + q * 8) = w; }
#pragma unroll
                for (int q = 0; q < 4; ++q) *(f32x4*)(gp + q * 4) = (f32x4){ev[q * 4] * inv, ev[q * 4 + 1] * inv, ev[q * 4 + 2] * inv, ev[q * 4 + 3] * inv};
            }
            TK_BAR();
        }
#undef TK_BAR
    }
};
template <class Epi, class Sched, bool ALIGN_EPI = false, bool SP2 = false>
__device__ __forceinline__ void gemm_phase(PG8_LAS unsigned char* lds, const Gemm g, const Sched& S, const Epi& E) {
    const int tid = threadIdx.x, wid = __builtin_amdgcn_readfirstlane(tid >> 6), lane = tid & 63, wr = wid >> 2, wc = wid & 3, fr = lane & 15, fq = lane >> 4;
    const int K = g.K, nt = K / BK;
    unsigned voffA[2], voffB[2];
#pragma unroll
    for (int i = 0; i < 2; ++i) { int R, C; stage_rc(tid * 16 + i * 8192, R, C); const int Rb = Epi::PERM ? ((R & ~31) + perm32(R & 31)) : R;
        voffA[i] = (unsigned)(R * K + C) * 2u; voffB[i] = (unsigned)(Rb * K + C) * 2u; }
    const size_t kstep = (size_t)(BK * 2);
    const size_t hstep = (size_t)HALF * K * 2;
    const size_t tstep = 2 * hstep;
    const unsigned ldsw = (unsigned)wid * 1024u;
    const int aoff = lds_byte(wr * 64 + fr, fq * 8), boff = lds_byte(wc * 32 + fr, fq * 8);
#define PG8_SA(b, h) (((b) * 2 + (h)) * HTB)
#define PG8_SB(b, h) ((4 + (b) * 2 + (h)) * HTB)
#define PG8_STAGE(bufoff, gbase, voff) do { _Pragma("unroll") for (int _i = 0; _i < 2; ++_i) \
        __builtin_amdgcn_global_load_lds((const unsigned*)((const char*)(gbase) + (voff)[_i]), (PG8_LAS unsigned*)(lds + (bufoff) + ldsw + _i * 8192), 16, 0, 0); } while (0)
#define PG8_LDA(dst, b, h) do { _Pragma("unroll") for (int m = 0; m < 4; ++m) _Pragma("unroll") for (int k = 0; k < 2; ++k) dst[m][k] = *(const PG8_LAS bf16x8*)(lds + PG8_SA(b, h) + aoff + m * 2048 + k * 1024); } while (0)
#define PG8_LDB(dst, b, h) do { _Pragma("unroll") for (int n = 0; n < 2; ++n) _Pragma("unroll") for (int k = 0; k < 2; ++k) dst[n][k] = *(const PG8_LAS bf16x8*)(lds + PG8_SB(b, h) + boff + n * 2048 + k * 1024); } while (0)
#define PG8_MMA(ai, bj, At, Bt) do { __builtin_amdgcn_s_setprio(1); _Pragma("unroll") for (int m = 0; m < 4; ++m) _Pragma("unroll") for (int n = 0; n < 2; ++n) _Pragma("unroll") for (int k = 0; k < 2; ++k) \
        acc[ai][bj][m][n] = __builtin_amdgcn_mfma_f32_16x16x32_bf16(Bt[n][k], At[m][k], acc[ai][bj][m][n], 0, 0, 0); __builtin_amdgcn_s_setprio(0); } while (0)
#define PG8_WAIT_V(n) asm volatile("s_waitcnt vmcnt(" #n ")" ::: "memory")
#define PG8_WAIT_L(n) asm volatile("s_waitcnt lgkmcnt(" #n ")" ::: "memory")
#define PG8_BAR __builtin_amdgcn_s_barrier()
#define PG8_SCHED __builtin_amdgcn_sched_barrier(0)
    Unit cur, nxt; int ui = 0;
    if (!S.next(0, cur)) return;
    f32x4 acc[2][2][4][2];
#pragma unroll
    for (int a = 0; a < 2; ++a)
#pragma unroll
        for (int b = 0; b < 2; ++b)
#pragma unroll
            for (int m = 0; m < 4; ++m)
#pragma unroll
                for (int n = 0; n < 2; ++n) acc[a][b][m][n] = (f32x4){0.f, 0.f, 0.f, 0.f};
    bf16x8 At[4][2], B0[2][2], B1[2][2];
    const char* cA = (const char*)g.A + (size_t)cur.pm * tstep; const char* cB = (const char*)g.Bt + (size_t)cur.pn * tstep;
    S.a_ready(cur);
    if constexpr (SP2) {
        PG8_STAGE(PG8_SB(0, 0), cB, voffB); PG8_STAGE(PG8_SB(0, 1), cB + hstep, voffB); PG8_STAGE(PG8_SA(0, 0), cA, voffA); PG8_STAGE(PG8_SA(0, 1), cA + hstep, voffA);
        if (wr == 1) PG8_BAR;
        PG8_WAIT_V(2); PG8_BAR;
        PG8_STAGE(PG8_SB(1, 0), cB + kstep, voffB); PG8_STAGE(PG8_SA(1, 0), cA + kstep, voffA); PG8_STAGE(PG8_SB(1, 1), cB + hstep + kstep, voffB);
        PG8_WAIT_V(6); PG8_BAR;
    } else {
        PG8_STAGE(PG8_SB(0, 0), cB, voffB); PG8_STAGE(PG8_SA(0, 0), cA, voffA); PG8_STAGE(PG8_SB(0, 1), cB + hstep, voffB); PG8_STAGE(PG8_SA(0, 1), cA + hstep, voffA);
        if (wr == 1) PG8_BAR;
        PG8_WAIT_V(4); PG8_BAR;
        PG8_STAGE(PG8_SB(1, 0), cB + kstep, voffB); PG8_STAGE(PG8_SA(1, 0), cA + kstep, voffA); PG8_STAGE(PG8_SB(1, 1), cB + hstep + kstep, voffB);
        PG8_WAIT_V(6); PG8_BAR;
    }
    for (;;) {
        const bool has_next = S.next(ui + 1, nxt);
        const char* nA = has_next ? (const char*)g.A + (size_t)nxt.pm * tstep : cA; const char* nB = has_next ? (const char*)g.Bt + (size_t)nxt.pn * tstep : cB;
        for (int t = 0; t < nt; t += 2) {
            if constexpr (Epi::MID_T > 0) { if (t == Epi::MID_T) E.mid(acc, cur, wr, wc, fr, fq); }
            const bool last = (t == nt - 2);
            const char* a1 = cA + (size_t)(t + 1) * kstep;
            const char* a2 = last ? nA : cA + (size_t)(t + 2) * kstep; const char* b2 = last ? nB : cB + (size_t)(t + 2) * kstep;
            const char* a3 = a2 + kstep; const char* b3 = b2 + kstep;
            if (last && has_next) S.a_ready(nxt);
            if constexpr (SP2) {
            PG8_LDB(B0, 0, 0); PG8_LDB(B1, 0, 1); PG8_SCHED; PG8_LDA(At, 0, 0); PG8_STAGE(PG8_SA(1, 1), a1 + hstep, voffA);
            PG8_WAIT_V(8); PG8_WAIT_L(0); PG8_BAR; PG8_MMA(0, 0, At, B0); PG8_MMA(0, 1, At, B1); PG8_BAR; PG8_SCHED;
            PG8_LDA(At, 0, 1); PG8_STAGE(PG8_SB(0, 0), b2, voffB); PG8_STAGE(PG8_SB(0, 1), b2 + hstep, voffB); PG8_STAGE(PG8_SA(0, 0), a2, voffA);
            PG8_WAIT_V(8); PG8_WAIT_L(0); PG8_BAR; PG8_MMA(1, 0, At, B0); PG8_MMA(1, 1, At, B1); PG8_BAR; PG8_SCHED;
            PG8_LDB(B0, 1, 0); PG8_LDB(B1, 1, 1); PG8_SCHED; PG8_LDA(At, 1, 0); PG8_STAGE(PG8_SA(0, 1), a2 + hstep, voffA);
            PG8_WAIT_V(8); PG8_WAIT_L(0); PG8_BAR; PG8_MMA(0, 0, At, B0); PG8_MMA(0, 1, At, B1); PG8_BAR; PG8_SCHED;
            PG8_LDA(At, 1, 1); PG8_STAGE(PG8_SB(1, 0), b3, voffB); PG8_STAGE(PG8_SB(1, 1), b3 + hstep, voffB); PG8_STAGE(PG8_SA(1, 0), a3, voffA);
            PG8_WAIT_V(8); PG8_WAIT_L(0); PG8_BAR; PG8_MMA(1, 0, At, B0); PG8_MMA(1, 1, At, B1); PG8_BAR; PG8_SCHED;
            } else {
            PG8_LDB(B0, 0, 0); PG8_SCHED; PG8_LDA(At, 0, 0); PG8_STAGE(PG8_SA(1, 1), a1 + hstep, voffA);
            PG8_WAIT_L(8); PG8_BAR; PG8_WAIT_L(0); PG8_MMA(0, 0, At, B0); PG8_BAR; PG8_SCHED;
            PG8_LDB(B1, 0, 1); PG8_STAGE(PG8_SB(0, 0), b2, voffB);
            PG8_BAR; PG8_WAIT_L(0); PG8_MMA(0, 1, At, B1); PG8_BAR;
            PG8_LDA(At, 0, 1); PG8_STAGE(PG8_SA(0, 0), a2, voffA);
            PG8_BAR; PG8_WAIT_L(0); PG8_MMA(1, 0, At, B0); PG8_BAR; PG8_SCHED;
            PG8_STAGE(PG8_SB(0, 1), b2 + hstep, voffB);
            PG8_WAIT_V(6); PG8_BAR; PG8_MMA(1, 1, At, B1); PG8_BAR;
            PG8_LDB(B0, 1, 0); PG8_SCHED; PG8_LDA(At, 1, 0); PG8_STAGE(PG8_SA(0, 1), a2 + hstep, voffA);
            PG8_WAIT_L(8); PG8_BAR; PG8_WAIT_L(0); PG8_MMA(0, 0, At, B0); PG8_BAR; PG8_SCHED;
            PG8_LDB(B1, 1, 1); PG8_STAGE(PG8_SB(1, 0), b3, voffB);
            PG8_BAR; PG8_WAIT_L(0); PG8_MMA(0, 1, At, B1); PG8_BAR;
            PG8_LDA(At, 1, 1); PG8_STAGE(PG8_SA(1, 0), a3, voffA);
            PG8_BAR; PG8_WAIT_L(0); PG8_MMA(1, 0, At, B0); PG8_BAR; PG8_SCHED;
            PG8_STAGE(PG8_SB(1, 1), b3 + hstep, voffB);
            PG8_WAIT_V(6); PG8_BAR; PG8_MMA(1, 1, At, B1); PG8_BAR;
            }
        }
        if constexpr (ALIGN_EPI) { if (wr == 0) PG8_BAR; }
        if constexpr (!Epi::AFTER_DRAIN) { E(acc, cur, wr, wc, fr, fq); S.done(cur); }
        if (!has_next) break;
#pragma unroll
        for (int a = 0; a < 2; ++a)
#pragma unroll
            for (int b = 0; b < 2; ++b)
#pragma unroll
                for (int m = 0; m < 4; ++m)
#pragma unroll
                    for (int n = 0; n < 2; ++n) acc[a][b][m][n] = (f32x4){0.f, 0.f, 0.f, 0.f};
        cur = nxt; cA = nA; cB = nB; ++ui;
        if constexpr (ALIGN_EPI) { if (wr == 1) PG8_BAR; }
    }
    PG8_WAIT_V(0);
    if constexpr (!ALIGN_EPI) { if (wr == 0) PG8_BAR; }
    PG8_BAR;
    if constexpr (Epi::AFTER_DRAIN) { E.fused(acc, cur, wr, wc, fr, fq, lds, wid, lane); S.done(cur); }
#undef PG8_SA
#undef PG8_SB
#undef PG8_STAGE
#undef PG8_LDA
#undef PG8_LDB
#undef PG8_MMA
#undef PG8_WAIT_V
#undef PG8_WAIT_L
#undef PG8_BAR
#undef PG8_SCHED
}
}
#ifndef PG8_SP2
#define PG8_SP2 true
#endif
#ifndef PG8_ALIGN
#define PG8_ALIGN true
#endif
namespace attn_body {
using bf16=__hip_bfloat16;
using bf16x8=__attribute__((ext_vector_type(8)))short;
using s16x4=__attribute__((ext_vector_type(4)))short;
using f32x16=__attribute__((ext_vector_type(16)))float;
using u32x4=__attribute__((ext_vector_type(4)))unsigned;
using f32x4v=__attribute__((ext_vector_type(4)))float;
constexpr int BATCH=4,NHEAD=8,SEQ=4096,D=64,DM=NHEAD*D,DMO=1024;
constexpr int NW=8,QBLK=32,QB=QBLK*NW,KVBLK=64,NQB=SEQ/QB;
constexpr int ATTN_PITCH=DM, ATTN_UNIT_ROWS=QB;
__device__ __forceinline__ int crow(int r,int hi){return (r&3)+8*(r>>2)+4*hi;}
#define SBAR() __builtin_amdgcn_sched_barrier(0)
__device__ __forceinline__ void cmask(f32x16&p0,f32x16&p1,int jb,int qrel,int hi){
  const float NEG=-INFINITY; int kb=64*jb+4*hi;
  #pragma unroll
  for(int r=0;r<16;++r){int kv=kb+(r&3)+8*(r>>2); if(kv>qrel)p0[r]=NEG; if(kv+32>qrel)p1[r]=NEG;}
}

constexpr int NSLOT=3, SLOTB=8192;
constexpr float SKIP_TH=64.0f;
constexpr int LDS_K=0, LDS_V=NSLOT*SLOTB, LDS_WS=2*NSLOT*SLOTB, LDS_OST=LDS_WS+NW*64*4, LDS_CS=LDS_OST+NW*4096, LDS_BYTES=LDS_CS+SEQ*4+64;
constexpr float C2=0.125f*1.4426950408889634f;
__device__ __forceinline__ void glds16(const void*gsrc,unsigned lds_dst){unsigned keep;
  asm volatile("s_mov_b32 %0, m0\n\ts_mov_b32 m0, %2\n\ts_nop 0\n\tglobal_load_lds_dwordx4 %1, off\n\ts_mov_b32 m0, %0":"=&s"(keep):"v"(gsrc),"s"(lds_dst):"memory");}
__device__ __forceinline__ float max3f(float a,float b,float c){float r;asm("v_max3_f32 %0, %1, %2, %3":"=v"(r):"v"(a),"v"(b),"v"(c));return r;}
__device__ __forceinline__ float max2f(float a,float b){float r;asm("v_max_f32_e32 %0, %1, %2":"=v"(r):"v"(a),"v"(b));return r;}
__device__ __forceinline__ float fadd_s(float a,float b){float r;asm("v_add_f32_e32 %0, %1, %2":"=v"(r):"v"(a),"v"(b));return r;}
__device__ __forceinline__ float fsub_s(float a,float b){float r;asm("v_sub_f32_e32 %0, %1, %2":"=v"(r):"v"(a),"v"(b));return r;}
typedef float f32x2_t __attribute__((ext_vector_type(2))); typedef __bf16 bf16x2_t __attribute__((ext_vector_type(2)));
__device__ __forceinline__ unsigned cvtpk_s(float lo,float hi){f32x2_t v={lo,hi};bf16x2_t b=__builtin_convertvector(v,bf16x2_t);return __builtin_bit_cast(unsigned,b);}
#define WAIT_BAR(N) asm volatile("s_waitcnt vmcnt(" #N ") lgkmcnt(0)\n\ts_barrier":::"memory")

__device__ __forceinline__ void qkt(f32x16&p0,f32x16&p1,const char*Kslot,const bf16x8*qr,const f32x16&c0,const f32x16&c1,int r32,int hi){
  const char*kb=Kslot+hi*1024+r32*16;
  #pragma unroll
  for(int d0=0;d0<4;++d0){
    const bf16x8 b0=*reinterpret_cast<const bf16x8*>(kb+d0*2048);
    const bf16x8 b1=*reinterpret_cast<const bf16x8*>(kb+d0*2048+512);
    if(d0==0){p0=__builtin_amdgcn_mfma_f32_32x32x16_bf16(b0,qr[0],c0,0,0,0);p1=__builtin_amdgcn_mfma_f32_32x32x16_bf16(b1,qr[0],c1,0,0,0);}
    else{p0=__builtin_amdgcn_mfma_f32_32x32x16_bf16(b0,qr[d0],p0,0,0,0);p1=__builtin_amdgcn_mfma_f32_32x32x16_bf16(b1,qr[d0],p1,0,0,0);}}
}
typedef __attribute__((address_space(3))) const char* lds_cptr;
typedef short v4i16_t __attribute__((ext_vector_type(4)));
__device__ __forceinline__ void kload8(bf16x8*kf,lds_cptr kp){
  kf[0]=*(const __attribute__((address_space(3))) bf16x8*)(kp);      kf[1]=*(const __attribute__((address_space(3))) bf16x8*)(kp+512);
  kf[2]=*(const __attribute__((address_space(3))) bf16x8*)(kp+2048); kf[3]=*(const __attribute__((address_space(3))) bf16x8*)(kp+2560);
  kf[4]=*(const __attribute__((address_space(3))) bf16x8*)(kp+4096); kf[5]=*(const __attribute__((address_space(3))) bf16x8*)(kp+4608);
  kf[6]=*(const __attribute__((address_space(3))) bf16x8*)(kp+6144); kf[7]=*(const __attribute__((address_space(3))) bf16x8*)(kp+6656);
}
__device__ __forceinline__ void kload2(bf16x8*kf,lds_cptr kp,int j){ kf[2*j]=*(const __attribute__((address_space(3))) bf16x8*)(kp+j*2048); kf[2*j+1]=*(const __attribute__((address_space(3))) bf16x8*)(kp+j*2048+512); }
__device__ __forceinline__ s16x4 vtr(lds_cptr p){ return __builtin_bit_cast(s16x4,__builtin_amdgcn_ds_read_tr16_b64_v4i16((__attribute__((address_space(3))) v4i16_t*)p)); }
__device__ __forceinline__ float rowmax(const f32x16&p0,const f32x16&p1){
  float a=max3f(p0[0],p0[1],p1[0]),b=max3f(p0[2],p0[3],p1[1]);a=max3f(a,p1[2],p1[3]);
  #pragma unroll
  for(int r=4;r<16;r+=4){a=max3f(a,p0[r],p0[r+1]);b=max3f(b,p0[r+2],p0[r+3]);a=max3f(a,p1[r],p1[r+1]);b=max3f(b,p1[r+2],p1[r+3]);}
  const float m=max2f(a,b);
  auto rr=__builtin_amdgcn_permlane32_swap(__float_as_uint(m),__float_as_uint(m),false,false);
  return max2f(__uint_as_float(rr[0]),__uint_as_float(rr[1]));
}
__device__ __forceinline__ void pv(f32x16*o,int vb,bf16x8 pa0,bf16x8 pa1,bf16x8 pa2,bf16x8 pa3){
  #pragma unroll
  for(int d0=0;d0<2;++d0){s16x4 lo[4],hi[4];
    #pragma unroll
    for(int ks=0;ks<4;++ks){
      asm volatile("ds_read_b64_tr_b16 %0,%1 offset:%c2":"=&v"(lo[ks]):"v"(vb),"i"(d0*4096+ks*1024):"memory");
      asm volatile("ds_read_b64_tr_b16 %0,%1 offset:%c2":"=&v"(hi[ks]):"v"(vb),"i"(d0*4096+ks*1024+512):"memory");}
    asm volatile("s_waitcnt lgkmcnt(0)":::"memory");SBAR();
    #define PK(k) (bf16x8){lo[k][0],lo[k][1],lo[k][2],lo[k][3],hi[k][0],hi[k][1],hi[k][2],hi[k][3]}
    o[d0]=__builtin_amdgcn_mfma_f32_32x32x16_bf16(pa0,PK(0),o[d0],0,0,0);
    o[d0]=__builtin_amdgcn_mfma_f32_32x32x16_bf16(pa1,PK(1),o[d0],0,0,0);
    o[d0]=__builtin_amdgcn_mfma_f32_32x32x16_bf16(pa2,PK(2),o[d0],0,0,0);
    o[d0]=__builtin_amdgcn_mfma_f32_32x32x16_bf16(pa3,PK(3),o[d0],0,0,0);
    #undef PK
  }
}

#ifndef ATTN_STORE16
#define ATTN_STORE16(p,v) (*(u32x4*)(p)=(v))
#endif
template<int THRL> __device__ __forceinline__ void attn_unit(int b,int h,int qb,const bf16*Q,const bf16*__restrict__ K,const bf16*__restrict__ V,bf16*O,const float*__restrict__ LFrow,char*shm){
  int tid_l=threadIdx.x; asm volatile("":"+v"(tid_l));
  const int tid=tid_l,lane=tid&63,r32=lane&31,hi=lane>>5; const int wid=__builtin_amdgcn_readfirstlane(tid>>6);
  const long rowbase=(long)b*SEQ; const int q0=qb*QB;
  const lds_cptr shm3=(lds_cptr)shm;
  typedef __attribute__((address_space(3))) float lds_f32; typedef __attribute__((address_space(3))) f32x4v lds_f32x4;
  lds_f32* const csl=(lds_f32*)(shm3+LDS_CS);
  { const int ncs=q0+QB, i0=tid*8; f32x4v ca={0.f,0.f,0.f,0.f},cb={0.f,0.f,0.f,0.f};
    if(i0<ncs){ca=*(const f32x4v*)(LFrow+i0);cb=*(const f32x4v*)(LFrow+i0+4);}
    ca.y+=ca.x;ca.z+=ca.y;ca.w+=ca.z;cb.x+=ca.w;cb.y+=cb.x;cb.z+=cb.y;cb.w+=cb.z;
    const float tot=cb.w; float inc=tot;
    _Pragma("unroll") for(int o_=1;o_<64;o_<<=1){const float v_=__shfl_up(inc,o_);if(lane>=o_)inc+=v_;}
    if(lane==63)csl[SEQ+wid]=inc;
    asm volatile("s_waitcnt vmcnt(0) lgkmcnt(0)\n\ts_barrier":::"memory");
    float base_=inc-tot;
    _Pragma("unroll") for(int w_=0;w_<NW;++w_){const float t_=csl[SEQ+w_];if(w_<wid)base_+=t_;}
    if(i0<ncs){*(lds_f32x4*)(csl+i0)=ca+base_;*(lds_f32x4*)(csl+i0+4)=cb+base_;}
    asm volatile("s_waitcnt vmcnt(0) lgkmcnt(0)\n\ts_barrier":::"memory"); }
  int ts; { const int NT0=(q0+QB)/KVBLK, cand=2*lane; bool ok=false;
    if(lane<32&&cand<=NT0-4) ok=(cand==0)||(csl[q0]-csl[64*cand-1]<=-SKIP_TH);
    const unsigned long long mk=__ballot(ok); ts=__builtin_amdgcn_readfirstlane(2*(63-__builtin_clzll(mk|1ull))); }
  const bf16*Qw=Q+(rowbase+q0+wid*QBLK)*DM+h*D;
  const bf16*Kh=K+(rowbase+(long)ts*KVBLK)*DM+h*D,*Vh=V+(rowbase+(long)ts*KVBLK)*DM+h*D;
  const unsigned lds0=(unsigned)(uintptr_t)shm;
  float*wsf=(float*)(shm+LDS_WS)+wid*64;
  const bf16*ksrc=Kh+(long)lane*DM+wid*8;
  const bf16*vsrc=Vh+(long)(16*(wid&3)+(lane>>2))*DM+(wid>>2)*32+(lane&3)*8;
  const unsigned kdst=lds0+LDS_K+wid*1024, vdst=lds0+LDS_V+wid*1024;
  #define DMA_K(t,slot) glds16(ksrc+(long)(t)*KVBLK*DM,(unsigned)__builtin_amdgcn_readfirstlane(kdst+(slot)))
  #define DMA_V(t,slot) glds16(vsrc+(long)(t)*KVBLK*DM,(unsigned)__builtin_amdgcn_readfirstlane(vdst+(slot)))
  const int vb0=(int)(lds0+LDS_V)+((lane>>4)&1)*32+(lane&3)*8+(4*hi+((lane&15)>>2))*64;
  const char*Kbase=shm+LDS_K; bf16x8 kf[8];
  const lds_cptr kp0=shm3+LDS_K+hi*1024+r32*16; const lds_cptr vp0=shm3+LDS_V+((lane>>4)&1)*32+(lane&3)*8+(4*hi+((lane&15)>>2))*64;
  const int NT=(q0+QB)/KVBLK-ts;
  const float cq=csl[q0+wid*QBLK+r32];
  const lds_cptr csb=shm3+LDS_CS+hi*16+ts*256;
  #define CINIT(C0,C1,t) do{ _Pragma("unroll") for(int g_=0;g_<4;++g_){ const f32x4v a_=*(const lds_f32x4*)(csb+(t)*256+g_*32), b_=*(const lds_f32x4*)(csb+(t)*256+128+g_*32); \
      C0[4*g_]=cqm-a_.x;C0[4*g_+1]=cqm-a_.y;C0[4*g_+2]=cqm-a_.z;C0[4*g_+3]=cqm-a_.w; C1[4*g_]=cqm-b_.x;C1[4*g_+1]=cqm-b_.y;C1[4*g_+2]=cqm-b_.z;C1[4*g_+3]=cqm-b_.w; } }while(0)
  DMA_K(0,0);DMA_V(0,0);DMA_K(1,SLOTB);
  bf16x8 qr[4];
  #pragma unroll
  for(int d0=0;d0<4;++d0)qr[d0]=*reinterpret_cast<const bf16x8*>(&Qw[(long)r32*DM+d0*16+hi*8]);
  float mhat=0.f,l_reg=0.f,cqm=cq;f32x16 o[2];o[0]=f32x16{};o[1]=f32x16{};
  const int qrel=wid*QBLK+r32;
  #define CMASK(P0,P1,t) do{int jb_=(t)-(NT-4); if(jb_>=0)cmask(P0,P1,jb_,qrel,hi);}while(0)
  bool resc=false;
  #define START(P0,P1) do{ const float rm=rowmax(P0,P1); resc=false; \
    { const float dl=rm; mhat=fadd_s(mhat,dl); \
      _Pragma("unroll") for(int r=0;r<16;++r){P0[r]=fsub_s(P0[r],dl);P1[r]=fsub_s(P1[r],dl);} \
      cqm=cq-mhat; } \
    _Pragma("unroll") for(int r=0;r<16;++r)P0[r]=__builtin_amdgcn_exp2f(P0[r]); }while(0)
  #define RESC() do{ if(resc){ asm volatile("s_waitcnt lgkmcnt(0)":::"memory"); \
      _Pragma("unroll") for(int d_=0;d_<2;++d_) _Pragma("unroll") for(int r=0;r<16;++r)o[d_][r]*=wsf[crow(r,hi)]; } }while(0)
  f32x16 pA0,pA1,pB0,pB1;
  int sl_prev=0,sl_cur=0,sl_next=SLOTB;
  #define ROT() do{sl_prev=sl_cur;sl_cur=sl_next;sl_next=(sl_next==(NSLOT-1)*SLOTB)?0:sl_next+SLOTB;}while(0)
  DMA_K(2,2*SLOTB);
  WAIT_BAR(3);
  { f32x16 ci0,ci1; CINIT(ci0,ci1,0); qkt(pA0,pA1,Kbase,qr,ci0,ci1,r32,hi); } asm volatile("s_nop 15\n\ts_nop 7":"+v"(pA0),"+v"(pA1));CMASK(pA0,pA1,0);
  START(pA0,pA1);
  _Pragma("unroll") for(int r=0;r<16;++r)pA1[r]=__builtin_amdgcn_exp2f(pA1[r]);
  WAIT_BAR(0);
  DMA_K(3,0);DMA_V(1,SLOTB);
  ROT();
  kload8(kf,kp0+sl_cur);
  WAIT_BAR(2);
  s16x4 vlo[8],vhi[8]; u32x4 pw0,pw1,pw2,pw3;
  #define PKW(P,B) cvtpk_s(P[B],P[B+1])
  #define PAF(k) __builtin_bit_cast(bf16x8,pw##k)
  #define VFR(i) (bf16x8){vlo[i][0],vlo[i][1],vlo[i][2],vlo[i][3],vhi[i][0],vhi[i][1],vhi[i][2],vhi[i][3]}
  #define PIN(x) asm volatile("":"+v"(x))
  #define MX3(a,b,c) __builtin_fmaxf(__builtin_fmaxf((a),(b)),(c))
  #define GAPA(MF,A0,A1,A2,A3,W0,W1,PW) do{ MF; sacc+=A0; sacc+=A1; sacc+=A2; sacc+=A3; PIN(sacc); W0; W1; PIN(PW); SBAR(); }while(0)
  #define EX(v) __builtin_amdgcn_exp2f(v)
  #define GAPB(MF,X,B) do{ MF; X[B]=EX(X[B]); X[B+1]=EX(X[B+1]); X[B+2]=EX(X[B+2]); X[B+3]=EX(X[B+3]); PIN(X); SBAR(); }while(0)
  #define VRD(i) do{ vlo[i]=vtr(vp_+(((i)>>2)*4096+((i)&3)*1024)); vhi[i]=vtr(vp_+(((i)>>2)*4096+((i)&3)*1024+512)); }while(0)
  #define KRD(G,j) do{ if(G){ kload2(kf,kp0+sl_next,j); SBAR(); } }while(0)
  #define STEP(C0,C1,P0,P1,t,GK,GV,GL) do{ SBAR(); \
    CINIT(C0,C1,t); SBAR(); \
    const lds_cptr vp_=vp0+sl_prev; \
    VRD(0); SBAR(); float sacc=(P0[0]+P0[1]); \
    GAPA(C0=__builtin_amdgcn_mfma_f32_32x32x16_bf16(kf[0],qr[0],C0,0,0,0), P0[2],P0[3],P0[4],P0[5],     pw0[0]=PKW(P0,0), pw0[1]=PKW(P0,2), pw0); \
    VRD(4); SBAR(); GAPA(C1=__builtin_amdgcn_mfma_f32_32x32x16_bf16(kf[1],qr[0],C1,0,0,0), P0[6],P0[7],P0[8],P0[9],     pw0[2]=PKW(P0,4), pw0[3]=PKW(P0,6), pw0); \
    VRD(1); SBAR(); GAPA(C0=__builtin_amdgcn_mfma_f32_32x32x16_bf16(kf[2],qr[1],C0,0,0,0),   P0[10],P0[11],P0[12],P0[13], pw1[0]=PKW(P0,8), pw1[1]=PKW(P0,10), pw1); \
    VRD(5); SBAR(); GAPA(C1=__builtin_amdgcn_mfma_f32_32x32x16_bf16(kf[3],qr[1],C1,0,0,0),   P0[14],P0[15],P1[0],P1[1],   pw1[2]=PKW(P0,12),pw1[3]=PKW(P0,14), pw1); \
    VRD(2); SBAR(); GAPA(C0=__builtin_amdgcn_mfma_f32_32x32x16_bf16(kf[4],qr[2],C0,0,0,0),   P1[2],P1[3],P1[4],P1[5],     pw2[0]=PKW(P1,0), pw2[1]=PKW(P1,2), pw2); \
    VRD(6); SBAR(); GAPA(C1=__builtin_amdgcn_mfma_f32_32x32x16_bf16(kf[5],qr[2],C1,0,0,0),   P1[6],P1[7],P1[8],P1[9],     pw2[2]=PKW(P1,4), pw2[3]=PKW(P1,6), pw2); \
    VRD(3); SBAR(); GAPA(C0=__builtin_amdgcn_mfma_f32_32x32x16_bf16(kf[6],qr[3],C0,0,0,0),   P1[10],P1[11],P1[12],P1[13], pw3[0]=PKW(P1,8), pw3[1]=PKW(P1,10), pw3); \
    VRD(7); SBAR(); GAPA(C1=__builtin_amdgcn_mfma_f32_32x32x16_bf16(kf[7],qr[3],C1,0,0,0),   P1[14],P1[15],0.f,0.f,       pw3[2]=PKW(P1,12),pw3[3]=PKW(P1,14), pw3); \
    l_reg+=sacc; \
    if(GK){DMA_K((t)+3,sl_cur);} if(GV){DMA_V((t)+1,sl_next);} \
    CMASK(C0,C1,t); \
    { float a=MX3(C0[0],C0[1],C1[0]),b=MX3(C0[2],C0[3],C1[1]); a=MX3(a,C1[2],C1[3]); \
      _Pragma("unroll") for(int r=4;r<16;r+=4){a=MX3(a,C0[r],C0[r+1]);b=MX3(b,C0[r+2],C0[r+3]);a=MX3(a,C1[r],C1[r+1]);b=MX3(b,C1[r+2],C1[r+3]);} \
      float rm=__builtin_fmaxf(a,b); { auto rr=__builtin_amdgcn_permlane32_swap(__float_as_uint(rm),__float_as_uint(rm),false,false); rm=__builtin_fmaxf(__uint_as_float(rr[0]),__uint_as_float(rr[1])); } \
      resc=false; \
      if(__builtin_expect(__any(rm>(float)THRL),0)){ const float dl=__builtin_fmaxf(rm,0.f); mhat+=dl; \
        _Pragma("unroll") for(int r=0;r<16;++r){C0[r]-=dl;C1[r]-=dl;} \
        cqm=cq-mhat; \
        const float f=__builtin_amdgcn_exp2f(-dl); l_reg*=f; if(hi==0)wsf[r32]=f; resc=true; } } \
    SBAR(); \
    GAPB(o[0]=__builtin_amdgcn_mfma_f32_32x32x16_bf16(PAF(0),VFR(0),o[0],0,0,0), C0,0); \
    GAPB(o[1]=__builtin_amdgcn_mfma_f32_32x32x16_bf16(PAF(0),VFR(4),o[1],0,0,0), C0,4); \
    KRD(GL,0); GAPB(o[0]=__builtin_amdgcn_mfma_f32_32x32x16_bf16(PAF(1),VFR(1),o[0],0,0,0), C0,8); \
    KRD(GL,1); GAPB(o[1]=__builtin_amdgcn_mfma_f32_32x32x16_bf16(PAF(1),VFR(5),o[1],0,0,0), C0,12); \
    KRD(GL,2); GAPB(o[0]=__builtin_amdgcn_mfma_f32_32x32x16_bf16(PAF(2),VFR(2),o[0],0,0,0), C1,0); \
    KRD(GL,3); GAPB(o[1]=__builtin_amdgcn_mfma_f32_32x32x16_bf16(PAF(2),VFR(6),o[1],0,0,0), C1,4); \
    GAPB(o[0]=__builtin_amdgcn_mfma_f32_32x32x16_bf16(PAF(3),VFR(3),o[0],0,0,0), C1,8); \
    GAPB(o[1]=__builtin_amdgcn_mfma_f32_32x32x16_bf16(PAF(3),VFR(7),o[1],0,0,0), C1,12); \
    }while(0)
  int t=1;
  #undef CMASK
  #define CMASK(P0,P1,t) do{}while(0)
  for(;t+5<NT;t+=2){
    STEP(pB0,pB1,pA0,pA1,t,true,true,true);     WAIT_BAR(2); RESC(); ROT();
    STEP(pA0,pA1,pB0,pB1,t+1,true,true,true);   WAIT_BAR(2); RESC(); ROT();
  }
  #undef CMASK
  #define CMASK(P0,P1,t) do{int jb_=(t)-(NT-4); if(jb_>=0)cmask(P0,P1,jb_,qrel,hi);}while(0)
  #define ENDW(tt) do{ if((tt)+3<NT){WAIT_BAR(2);} else if((tt)+2<NT){WAIT_BAR(1);} else {WAIT_BAR(0);} }while(0)
  for(;t+1<NT;t+=2){
    STEP(pB0,pB1,pA0,pA1,t,(t+3<NT),(t+1<NT),(t+1<NT));       ENDW(t);   RESC(); ROT();
    STEP(pA0,pA1,pB0,pB1,t+1,(t+4<NT),(t+2<NT),(t+2<NT));     ENDW(t+1); RESC(); ROT();
  }
  STEP(pB0,pB1,pA0,pA1,NT-1,false,false,false); RESC();
  { float sacc=pB0[0]+pB0[1]; _Pragma("unroll") for(int r=2;r<16;++r)sacc+=pB0[r]; _Pragma("unroll") for(int r=0;r<16;++r)sacc+=pB1[r]; l_reg+=sacc;
    pw0=(u32x4){PKW(pB0,0),PKW(pB0,2),PKW(pB0,4),PKW(pB0,6)};pw1=(u32x4){PKW(pB0,8),PKW(pB0,10),PKW(pB0,12),PKW(pB0,14)};pw2=(u32x4){PKW(pB1,0),PKW(pB1,2),PKW(pB1,4),PKW(pB1,6)};pw3=(u32x4){PKW(pB1,8),PKW(pB1,10),PKW(pB1,12),PKW(pB1,14)};
    SBAR(); pv(o,vb0+sl_cur,PAF(0),PAF(1),PAF(2),PAF(3)); }
  #undef PKW
  #undef PAF
  #undef VFR
  #undef PIN
  #undef MX3
  #undef GAPA
  #undef GAPB
  #undef EX
  #undef VRD
  #undef KRD
  #undef STEP
  #undef ENDW
  {auto rr=__builtin_amdgcn_permlane32_swap(__float_as_uint(l_reg),__float_as_uint(l_reg),false,false);l_reg=__uint_as_float(rr[0])+__uint_as_float(rr[1]);}
  if(hi==0)wsf[32+r32]=l_reg;asm volatile("s_waitcnt lgkmcnt(0)":::"memory");
  float rli[16];
  #pragma unroll
  for(int r=0;r<16;++r)rli[r]=__builtin_amdgcn_rcpf(wsf[32+crow(r,hi)]);
  bf16*Ow=O+(rowbase+q0+wid*QBLK)*DMO+h*D;
  { bf16*stg=(bf16*)(shm+LDS_OST)+wid*2048;
    #pragma unroll
    for(int r=0;r<16;++r){const int orow=crow(r,hi);
      #pragma unroll
      for(int d0=0;d0<2;++d0)stg[orow*64+d0*32+r32]=__float2bfloat16(o[d0][r]*rli[r]);}
    asm volatile("s_waitcnt lgkmcnt(0)":::"memory");
    #pragma unroll
    for(int i=0;i<4;++i){const int row=i*8+(lane>>3),ch=lane&7; const u32x4 v=*(const u32x4*)(stg+row*64+ch*8); ATTN_STORE16(Ow+(long)row*DMO+ch*8,v);} }
  asm volatile("s_waitcnt lgkmcnt(0)\n\ts_barrier":::"memory");
  #undef DMA_K
  #undef DMA_V
  #undef CMASK
  #undef START
  #undef RESC
  #undef ROT
  #undef CINIT
}
constexpr int ATTN_LDS_BYTES=LDS_BYTES;
struct AttnTensors { const bf16* Q; const bf16* K; const bf16* V; bf16* O; const float* LF; };
struct AttnUnit { int bh; int qb; };
struct StaticOrder {
  int vcu, G;
  __device__ __forceinline__ StaticOrder(int grid,int vcu_):vcu(vcu_),G(grid){}
  __device__ __forceinline__ bool next(int i,AttnUnit&u)const{
    if(G==256){ if(i>=2)return false; const int s=vcu&7; u.bh=vcu>>3; u.qb=(i==0)?15-s:s; return true; }
    const int idx=i*G+vcu; if(idx>=BATCH*NHEAD*NQB)return false; u.qb=NQB-1-idx/(BATCH*NHEAD); u.bh=idx%(BATCH*NHEAD); return true; }
  __device__ __forceinline__ void a_ready(const AttnUnit&)const{}
  __device__ __forceinline__ void done(const AttnUnit&)const{}
};
template<class Sched,int THRL=8> __device__ __forceinline__ void attn_phase(char*lds,const AttnTensors&T,const Sched&S){
  AttnUnit u;
  for(int i=0;S.next(i,u);++i){ S.a_ready(u); attn_unit<THRL>(u.bh/NHEAD,u.bh%NHEAD,u.qb,T.Q,T.K,T.V,T.O,T.LF+(size_t)u.bh*SEQ,lds); S.done(u); }
}
#undef SBAR
#undef WAIT_BAR
}
#define GAS __attribute__((address_space(1)))
#define LAS __attribute__((address_space(3)))
typedef unsigned short bf16;
typedef unsigned v4u __attribute__((ext_vector_type(4)));
typedef float f32x4 __attribute__((ext_vector_type(4)));
typedef short bf16x8 __attribute__((ext_vector_type(8)));
typedef GAS unsigned gu32;
typedef GAS unsigned long long gu64;
#define RLX_AGENT __ATOMIC_RELAXED, __HIP_MEMORY_SCOPE_AGENT
#define LDS_WAIT() asm volatile("s_waitcnt lgkmcnt(0)" ::: "memory")
#define VM_WAIT() asm volatile("s_waitcnt vmcnt(0)" ::: "memory")
__device__ __forceinline__ unsigned long long rt() { return __builtin_amdgcn_s_memrealtime(); }
__device__ __forceinline__ unsigned f2bf(float f) { unsigned u = __builtin_bit_cast(unsigned, f); return (u + 0x7fffu + ((u >> 16) & 1u)) >> 16; }
__device__ __forceinline__ unsigned pk2(float lo, float hi) { return f2bf(lo) | (f2bf(hi) << 16); }

#define XB_TMO      128
#define XB_XCNT(j)  (256  + 64 * (j))
#define XB_XSUB(j)  (1280 + 64 * (j))
#define XB_XGEN(j)  (2304 + 64 * (j))
#define XB_TOP      3328
#define XB_TOPGEN   3392
#define XCD_BAR_WORDS 3456
#define XB_SPIN_CAP (1u << 18)

__device__ __forceinline__ unsigned xb_ld(unsigned* p)              { return __hip_atomic_load(p, __ATOMIC_RELAXED, __HIP_MEMORY_SCOPE_AGENT); }
__device__ __forceinline__ unsigned xb_add(unsigned* p, unsigned v) { return __hip_atomic_fetch_add(p, v, __ATOMIC_RELAXED, __HIP_MEMORY_SCOPE_AGENT); }
__device__ __forceinline__ unsigned xb_xcc_id() { return (unsigned)__builtin_amdgcn_s_getreg((3 << 11) | 20) & 0xFu; }
#define XB_SPIN(cond, bar) do { unsigned _sp = 0; while (cond) { __builtin_amdgcn_s_sleep(1); \
    if ((++_sp & 255u) == 0u) { if (xb_ld(&(bar)[XB_TMO])) break; if (_sp > XB_SPIN_CAP) { atomicAdd(&(bar)[XB_TMO], 1u); break; } } } } while (0)

struct XcdBarrier {
    unsigned* bar; unsigned x;
    volatile LAS unsigned* st;
};

__device__ __forceinline__ XcdBarrier xcd_barrier_post(unsigned* bar, volatile LAS unsigned* st) {
    XcdBarrier b; b.bar = bar; b.x = xb_xcc_id(); b.st = st;
    if (threadIdx.x == 0) (void)xb_add(&bar[XB_XCNT(b.x)], 1u);
    return b;
}
__device__ __forceinline__ void xcd_barrier_complete(unsigned* bar, unsigned x, unsigned& nloc, unsigned& nx) {
    const unsigned G = gridDim.x * gridDim.y * gridDim.z;
    unsigned sum, cnt, mine, sp = 0u;
    for (;;) {
        sum = 0u; cnt = 0u; mine = 0u;
#pragma unroll
        for (unsigned j = 0; j < 16; ++j) { const unsigned c = xb_ld(&bar[XB_XCNT(j)]); sum += c; cnt += (c > 0u) ? 1u : 0u; mine = (j == x) ? c : mine; }
        if (sum == G) break;
        __builtin_amdgcn_s_sleep(1);
        if ((++sp & 255u) == 0u) { if (xb_ld(&bar[XB_TMO])) break; if (sp > XB_SPIN_CAP) { atomicAdd(&bar[XB_TMO], 1u); break; } }
    }
    nloc = mine > 0u ? mine : 1u; nx = cnt > 0u ? cnt : 1u;
}

__device__ __forceinline__ void xcd_barrier(const XcdBarrier& b) {
    asm volatile("s_waitcnt vmcnt(0)" ::: "memory");
    __syncthreads();
    if (threadIdx.x == 0) {
        unsigned* bar = b.bar;
        __builtin_amdgcn_s_waitcnt(0);
        unsigned nloc = b.st[0], nx = b.st[1];
        if (nloc == 0u) { xcd_barrier_complete(bar, b.x, nloc, nx); b.st[0] = nloc; b.st[1] = nx; }
        const unsigned old = xb_add(&bar[XB_XSUB(b.x)], 1u);
        const unsigned gen = old / nloc;
        if (old + 1u == (gen + 1u) * nloc) {
            __builtin_amdgcn_fence(__ATOMIC_RELEASE, "agent");
            asm volatile("s_waitcnt vmcnt(0)" ::: "memory");
            const unsigned og = xb_add(&bar[XB_TOP], 1u);
            const unsigned tg = og / nx;
            if (og + 1u == (tg + 1u) * nx) xb_add(&bar[XB_TOPGEN], 1u);
            else XB_SPIN(xb_ld(&bar[XB_TOPGEN]) == tg, bar);
            __builtin_amdgcn_fence(__ATOMIC_ACQUIRE, "agent");
            xb_add(&bar[XB_XGEN(b.x)], 1u);
            asm volatile("s_waitcnt vmcnt(0)" ::: "memory");
        } else {
            XB_SPIN(xb_ld(&bar[XB_XGEN(b.x)]) == gen, bar);
            __builtin_amdgcn_fence(__ATOMIC_ACQUIRE, "agent");
            asm volatile("s_waitcnt vmcnt(0)" ::: "memory");
        }
    }
    __syncthreads();
}

constexpr int NWAVES = 8;
constexpr int BATCH = 4, SEQ = 4096, D = 1024, M = BATCH * SEQ, NH = 8, HD = 64, AW = 512, PLE = 256;
constexpr int NIN = 5120, INTOT = 5128, NKEYS = 128, NEXP = 16384, NS = 2048;
constexpr float EPS = 1e-6f, LOG2E = 1.4426950408889634f, C2 = 0.125f * LOG2E;
constexpr int NPHASE = 9;
constexpr int SLW = 128, NSL = D / SLW;
static_assert(NSL == 8, "one slice per XCD group; SS3 has 16 slots");

constexpr size_t MiB = 1u << 20;
constexpr size_t WS_CTL = 0, CTL_ZERO_BYTES = 64 * 1024;
constexpr size_t WS_RSTD1 = 1 * MiB, WS_RSTD3 = WS_RSTD1 + 65536, WS_LF = WS_RSTD3 + 65536, WS_CS = WS_LF + 524288, WS_SS2 = WS_CS + 524288, WS_WPP = WS_SS2 + 1048576;
constexpr size_t WS_WQ8 = 20 * MiB, WS_SW = WS_RSTD1;
constexpr size_t WS_SU = WS_RSTD3, WS_SV = WS_WPP + 524288;
static_assert(WS_SV + 65536 <= 4 * MiB, "small region");
constexpr size_t WS_WIN = 4 * MiB, WS_WBR = 14 * MiB, WS_WOUT = 16 * MiB, WS_WS = 18 * MiB, WS_WPG = 22 * MiB, WS_PB = 24 * MiB;
constexpr size_t WS_UB = 32 * MiB, WS_VB = 64 * MiB;
constexpr size_t WS_A = 96 * MiB;
constexpr size_t WS_PP = 128 * MiB;
constexpr size_t WS_Q = 160 * MiB, WS_K = 176 * MiB, WS_V = 192 * MiB, WS_GB = 208 * MiB, WS_Z = 224 * MiB;
constexpr size_t WS_MERGED = 160 * MiB, WS_XB2 = 192 * MiB, WS_IDS = 224 * MiB, WS_GATES = 232 * MiB;
constexpr size_t WS_END = 256 * MiB;
constexpr size_t WS_PART0 = 4 * MiB, WS_PART1 = 160 * MiB, WS_PART2 = 240 * MiB;
constexpr size_t WS_TGC = 32 * MiB, WS_TXC = 64 * MiB, WS_SC = 32 * MiB;
constexpr int CW_BAR = 1024;

constexpr int RING_OFF = 0, RING_BYTES = 135168;
constexpr int LDSCTL_OFF = RING_BYTES, MISC_OFF = LDSCTL_OFF + 320;
constexpr int LDS_BYTES = RING_BYTES + 1024;
static_assert(attn_body::ATTN_LDS_BYTES <= RING_BYTES && pg8::STAGE_BYTES <= RING_BYTES && 128 * pg8::EpiTopK::RS * 4 <= RING_BYTES, "LDS map");

typedef unsigned u32x4 __attribute__((ext_vector_type(4)));
typedef unsigned u32x2 __attribute__((ext_vector_type(2)));
__device__ __forceinline__ float bf2f(bf16 v) { return __uint_as_float((unsigned)v << 16); }
__device__ __forceinline__ float wave_sum(float v) {
#pragma unroll
    for (int o = 1; o < 64; o <<= 1) v += __shfl_xor(v, o);
    return v;
}
__device__ __forceinline__ float sigmoidf_(float v) { return 1.0f / (1.0f + __expf(-v)); }
__host__ __device__ __forceinline__ int src_in(int n) {
    const int pn = n >> 8, l = n & 255;
    if (pn < 6) return n;
    if (pn < 8) return 1544 + (n - 1536);
    if (pn < 12) { const int j = pn - 8; return (l < 128) ? 2056 + 128 * j + l : 2568 + 128 * j + (l - 128); }
    if (pn < 16) return 3080 + (n - 3072);
    return 4104 + (n - 4096);
}

struct Args { const float* in[18]; float* out; unsigned char* ws; int ph_lo, ph_hi, li, pad; };
struct Ctx {
    LAS unsigned char* lds; int wave, vcu, G;
    __device__ __forceinline__ int tid_() const { return (int)threadIdx.x; }
    __device__ __forceinline__ int lane_() const { return (int)threadIdx.x & 63; }
};

struct TrItem { const float* W; const float* g; bf16* WT; int ldw, k0, scol0, ldt, drow0, dk0; };
__device__ __forceinline__ void tr_load(const TrItem& I, float (&tv)[32], int lane) {
#pragma unroll
    for (int i = 0; i < 32; ++i) { const int kk = 2 * i + (lane >> 5); tv[i] = I.W[(size_t)(I.k0 + kk) * I.ldw + I.scol0 + (lane & 31)]; }
}
__device__ __forceinline__ void tr_finish(const TrItem& I, const float (&tv)[32], LAS float* scr, int lane) {
#pragma unroll
    for (int i = 0; i < 32; ++i) { const int kk = 2 * i + (lane >> 5); float v = tv[i]; if (I.g) v *= I.g[I.k0 + kk]; scr[kk * 33 + (lane & 31)] = v; }
    LDS_WAIT(); asm volatile("" ::: "memory");
    const int c = lane & 7;
#pragma unroll
    for (int j = 0; j < 4; ++j) { const int n = (lane >> 3) + 8 * j; const LAS float* s = scr + (8 * c) * 33 + n;
        v4u o; o.x = pk2(s[0 * 33], s[1 * 33]); o.y = pk2(s[2 * 33], s[3 * 33]); o.z = pk2(s[4 * 33], s[5 * 33]); o.w = pk2(s[6 * 33], s[7 * 33]);
        *(GAS v4u*)(I.WT + (size_t)(I.drow0 + n) * I.ldt + I.dk0 + 8 * c) = o; }
    LDS_WAIT(); asm volatile("" ::: "memory");
}
__device__ __forceinline__ void p0_prologue(const Ctx& F, const Args& a, volatile LAS unsigned* MISC) {
#ifdef MK_PROBE_SEG
    int n_sub = 0;
#define SUBSYNC() __syncthreads()
#define SUBSTAMP() do { if (blockIdx.x == 0 && threadIdx.x == 0) { const unsigned long long t_ = __builtin_amdgcn_s_memrealtime(); MISC[64 + 2 * n_sub] = (unsigned)t_; MISC[65 + 2 * n_sub] = (unsigned)(t_ >> 32); } ++n_sub; } while (0)
#else
#define SUBSTAMP() do { } while (0)
#define SUBSYNC() do { } while (0)
#endif
    SUBSTAMP();
    unsigned char* ws = a.ws;
    const float *x = a.in[0], *p = a.in[1], *g_mix = a.in[2], *w_in = a.in[3], *b_f = a.in[4], *w_branch = a.in[6], *w_out = a.in[7], *g_ffn = a.in[8], *w_peer_q = a.in[9],
                *pk1 = a.in[10], *pk2_ = a.in[11], *peer_u = a.in[12], *peer_v = a.in[13], *g_ple = a.in[14], *w_ple_gate = a.in[15], *w_ple_proj = a.in[16];
    bf16 *WIN = (bf16*)(ws + WS_WIN), *WBR = (bf16*)(ws + WS_WBR), *WOUT = (bf16*)(ws + WS_WOUT), *WST = (bf16*)(ws + WS_WS), *WPG = (bf16*)(ws + WS_WPG), *WPP = (bf16*)(ws + WS_WPP);
    bf16 *PB = (bf16*)(ws + WS_PB), *UB = (bf16*)(ws + WS_UB), *VB = (bf16*)(ws + WS_VB), *XB = (bf16*)(ws + WS_A);
    float *RSTD1 = (float*)(ws + WS_RSTD1), *LF = (float*)(ws + WS_LF);
    const int gw0 = F.vcu * NWAVES + F.wave, NGW = F.G * NWAVES, NGT = F.G * 512;
    const int tid_ = (int)threadIdx.x, lane_ = tid_ & 63, gw = gw0, gt = F.vcu * 512 + tid_; (void)gt;
    auto stepA = [&]() __attribute__((always_inline)) {
    {
        LAS float* KH = (LAS float*)(F.lds + RING_OFF); LAS float* WQ = KH + 128 * 129;
        for (int item = F.vcu; item < 256; item += F.G) {
            const int hh = item >> 4, head = hh >> 1, half = hh & 1, d0 = (item & 15) * 64;
            const float* kh = (half ? pk2_ : pk1) + (size_t)head * 128 * 128;
            float tk[32], tq[16];
#pragma unroll
            for (int i = 0; i < 32; ++i) tk[i] = kh[i * 512 + tid_];
#pragma unroll
            for (int i = 0; i < 16; ++i) { const int idx = i * 512 + tid_; tq[i] = w_peer_q[(size_t)(d0 + (idx >> 7)) * NS + head * 256 + half * 128 + (idx & 127)]; }
#pragma unroll
            for (int i = 0; i < 32; ++i) { const int idx = i * 512 + tid_; KH[(idx >> 7) * 129 + (idx & 127)] = tk[i]; }
#pragma unroll
            for (int i = 0; i < 16; ++i) WQ[i * 512 + tid_] = tq[i];
            __syncthreads();
            const int key = tid_ & 127, dg = tid_ >> 7;
            float acc[16];
#pragma unroll
            for (int i = 0; i < 16; ++i) acc[i] = 0.f;
            for (int e = 0; e < 128; e += 4) {
                const float k0 = KH[key * 129 + e], k1 = KH[key * 129 + e + 1], k2 = KH[key * 129 + e + 2], k3 = KH[key * 129 + e + 3];
#pragma unroll
                for (int i = 0; i < 16; ++i) { const f32x4 w = *(const LAS f32x4*)(WQ + (dg * 16 + i) * 128 + e); acc[i] += (k0 * w[0] + k1 * w[1]) + (k2 * w[2] + k3 * w[3]); }
            }
            const int dd = d0 + dg * 16;
#pragma unroll
            for (int q = 0; q < 2; ++q) { v4u o; o.x = pk2(acc[8 * q] * g_ffn[dd + 8 * q], acc[8 * q + 1] * g_ffn[dd + 8 * q + 1]); o.y = pk2(acc[8 * q + 2] * g_ffn[dd + 8 * q + 2], acc[8 * q + 3] * g_ffn[dd + 8 * q + 3]);
                o.z = pk2(acc[8 * q + 4] * g_ffn[dd + 8 * q + 4], acc[8 * q + 5] * g_ffn[dd + 8 * q + 5]); o.w = pk2(acc[8 * q + 6] * g_ffn[dd + 8 * q + 6], acc[8 * q + 7] * g_ffn[dd + 8 * q + 7]);
                *(GAS v4u*)(WST + (size_t)(head * 256 + half * 128 + key) * D + dd + 8 * q) = o; }
            __syncthreads();
        }
    }
    };
    auto stepB = [&]() __attribute__((always_inline)) {
    {
        LAS float* scr = (LAS float*)(F.lds + RING_OFF + F.wave * 16384);
        constexpr int I_IN = 16 * 160, I_BR = 8 * 32, I_SQ = 16 * 32, I_PP = 4 * 32, NITEMS = I_IN + 2 * I_BR + 2 * I_SQ + I_PP;
        auto decode = [&](int r) -> TrItem {
            TrItem I;
            if (r < I_IN) { const int kb = r / 160, nb = r % 160; I = TrItem{w_in, g_mix, WIN, INTOT, 64 * kb, src_in(32 * nb), D, 32 * nb, 64 * kb}; return I; } r -= I_IN;
            if (r < 2 * I_BR) { const int br = r / I_BR, q = r % I_BR, kb = q / 32, nb = q % 32; I = TrItem{w_branch + (size_t)br * AW * D, nullptr, WBR, D, 64 * kb, 32 * nb, D, 32 * nb, br * AW + 64 * kb}; return I; } r -= 2 * I_BR;
            if (r < I_SQ) { const int kb = r / 32, nb = r % 32; I = TrItem{w_out, nullptr, WOUT, D, 64 * kb, 32 * nb, D, 32 * nb, 64 * kb}; return I; } r -= I_SQ;
            if (r < I_SQ) { const int kb = r / 32, nb = r % 32; I = TrItem{w_ple_gate, g_ple, WPG, D, 64 * kb, 32 * nb, D, 32 * nb, 64 * kb}; return I; } r -= I_SQ;
            { const int kb = r / 32, nb = r % 32; I = TrItem{w_ple_proj, nullptr, WPP, D, 64 * kb, 32 * nb, PLE, 32 * nb, 64 * kb}; return I; }
        };
        for (int it = gw; it < NITEMS; it += 2 * NGW) {
            const bool two = it + NGW < NITEMS;
            const TrItem A = decode(it), B = decode(two ? it + NGW : it);
            float ta[32], tb[32];
            tr_load(A, ta, lane_); if (two) tr_load(B, tb, lane_);
            tr_finish(A, ta, scr, lane_); if (two) tr_finish(B, tb, scr, lane_);
        }
    }
    };
    auto stepC = [&]() __attribute__((always_inline)) {
    {
        LAS float* WFL = (LAS float*)(F.lds + RING_OFF);
        { float tw[16], tg[16];
#pragma unroll
          for (int i = 0; i < 16; ++i) { const int idx = i * 512 + tid_, k = idx >> 3, h = idx & 7; tw[i] = w_in[(size_t)k * INTOT + 1536 + h]; tg[i] = g_mix[k]; }
#pragma unroll
          for (int i = 0; i < 16; ++i) { const int idx = i * 512 + tid_, k = idx >> 3, h = idx & 7; WFL[h * 1024 + k] = tg[i] * tw[i]; } }
        __syncthreads();
        for (int rb = gw; rb < M; rb += 4 * NGW) {
            f32x4 v[4][4];
#pragma unroll
            for (int r = 0; r < 4; ++r) { const int row = rb + r * NGW; if (row < M) { const GAS f32x4* xr = (const GAS f32x4*)(x + (size_t)row * D);
#pragma unroll
                for (int j = 0; j < 4; ++j) v[r][j] = xr[lane_ + 64 * j]; } }
#pragma unroll
            for (int r = 0; r < 4; ++r) { const int row = rb + r * NGW; if (row < M) {
                float ss = 0.f;
#pragma unroll
                for (int j = 0; j < 4; ++j) ss += (v[r][j].x * v[r][j].x + v[r][j].y * v[r][j].y) + (v[r][j].z * v[r][j].z + v[r][j].w * v[r][j].w);
                ss = wave_sum(ss);
                const float rstd = 1.0f / sqrtf(ss * (1.0f / D) + EPS);
                GAS u32x2* o = (GAS u32x2*)(XB + (size_t)row * D);
#pragma unroll
                for (int j = 0; j < 4; ++j) { u32x2 w; w.x = pk2(v[r][j].x, v[r][j].y); w.y = pk2(v[r][j].z, v[r][j].w); o[lane_ + 64 * j] = w; }
                if (lane_ == 0) RSTD1[row] = rstd;
                float f[8];
#pragma unroll
                for (int h = 0; h < 8; ++h) { float s_ = 0.f;
#pragma unroll
                    for (int j = 0; j < 4; ++j) { const f32x4 w = *(const LAS f32x4*)(WFL + h * 1024 + 4 * (lane_ + 64 * j)); s_ += (v[r][j].x * w[0] + v[r][j].y * w[1]) + (v[r][j].z * w[2] + v[r][j].w * w[3]); }
                    f[h] = s_; }
                float r4[4], r2[2], r1;
#pragma unroll
                for (int i = 0; i < 4; ++i) { const float send = (lane_ & 32) ? f[i] : f[i + 4], keep = (lane_ & 32) ? f[i + 4] : f[i]; r4[i] = keep + __shfl_xor(send, 32); }
#pragma unroll
                for (int i = 0; i < 2; ++i) { const float send = (lane_ & 16) ? r4[i] : r4[i + 2], keep = (lane_ & 16) ? r4[i + 2] : r4[i]; r2[i] = keep + __shfl_xor(send, 16); }
                { const float send = (lane_ & 8) ? r2[0] : r2[1], keep = (lane_ & 8) ? r2[1] : r2[0]; r1 = keep + __shfl_xor(send, 8); }
                r1 += __shfl_xor(r1, 4); r1 += __shfl_xor(r1, 2); r1 += __shfl_xor(r1, 1);
                const int hL = ((lane_ >> 5) & 1) * 4 + ((lane_ >> 4) & 1) * 2 + ((lane_ >> 3) & 1);
                const float tot = r1 * rstd + b_f[hL];
                const float ls = fminf(tot, 0.f) - log1pf(__expf(-fabsf(tot)));
                const int b = row / SEQ, t = row % SEQ;
                if ((lane_ & 7) == 0) LF[(size_t)(b * NH + hL) * SEQ + t] = ls * LOG2E;
            } }
        }
    }
    };
    auto stepD = [&]() __attribute__((always_inline)) {
    {
        constexpr int NU = NEXP * D / 8, NP = M * PLE / 8;
        {
            signed char* UQ = (signed char*)(ws + WS_UB); unsigned char* VQ = (unsigned char*)(ws + WS_VB); float *SU = (float*)(ws + WS_SU), *SV = (float*)(ws + WS_SV);
            f32x4 gq[4];
#pragma unroll
            for (int j = 0; j < 4; ++j) gq[j] = *(const GAS f32x4*)(g_ffn + 256 * j + 4 * lane_);
            for (int rb = gw; rb < 2 * NEXP; rb += 4 * NGW) {
                f32x4 v[4][4];
#pragma unroll
                for (int r = 0; r < 4; ++r) { const int rr = rb + r * NGW; if (rr < 2 * NEXP) { const bool isv = rr >= NEXP; const int e = isv ? rr - NEXP : rr;
                    const GAS f32x4* src = (const GAS f32x4*)((isv ? peer_v : peer_u) + (size_t)e * D) + lane_;
#pragma unroll
                    for (int j = 0; j < 4; ++j) v[r][j] = src[64 * j]; } }
#pragma unroll
                for (int r = 0; r < 4; ++r) { const int rr = rb + r * NGW; if (rr < 2 * NEXP) { const bool isv = rr >= NEXP; const int e = isv ? rr - NEXP : rr;
                    float am = 0.f;
#pragma unroll
                    for (int j = 0; j < 4; ++j) { if (!isv) v[r][j] = v[r][j] * gq[j]; am = fmaxf(am, fmaxf(fmaxf(fabsf(v[r][j].x), fabsf(v[r][j].y)), fmaxf(fabsf(v[r][j].z), fabsf(v[r][j].w)))); }
#pragma unroll
                    for (int o = 1; o < 64; o <<= 1) am = fmaxf(am, __shfl_xor(am, o));
                    const float sc = am > 0.f ? 127.0f / am : 0.f;
                    unsigned char* tb = isv ? VQ : (unsigned char*)UQ;
#pragma unroll
                    for (int j = 0; j < 4; ++j) { const int q0 = (int)rintf(v[r][j].x * sc), q1 = (int)rintf(v[r][j].y * sc), q2 = (int)rintf(v[r][j].z * sc), q3 = (int)rintf(v[r][j].w * sc);
                        const unsigned o = (unsigned)(q0 & 255) | ((unsigned)(q1 & 255) << 8) | ((unsigned)(q2 & 255) << 16) | ((unsigned)(q3 & 255) << 24);
                        *(GAS unsigned*)(tb + ((size_t)(2 * j + (lane_ >> 5)) * NEXP + e) * SLW + ((4 * lane_) & 127)) = o; }
                    if (lane_ == 0) (isv ? SV : SU)[e] = am * (1.0f / 127.0f);
                } }
            }
        }
    }
    };
    if (F.vcu & 1) { stepD(); __syncthreads(); SUBSTAMP(); stepC(); __syncthreads(); SUBSTAMP(); stepB(); __syncthreads(); SUBSTAMP(); stepA(); __syncthreads(); SUBSTAMP(); }
    else           { stepA(); __syncthreads(); SUBSTAMP(); stepB(); __syncthreads(); SUBSTAMP(); stepC(); __syncthreads(); SUBSTAMP(); stepD(); __syncthreads(); SUBSTAMP(); }
    { constexpr int NP = M * PLE / 8;
        for (int i = F.vcu * 512 + F.tid_(); i < NP; i += NGT) { const f32x4 a = ((const GAS f32x4*)p)[2 * (size_t)i], b = ((const GAS f32x4*)p)[2 * (size_t)i + 1];
            v4u o; o.x = pk2(a.x, a.y); o.y = pk2(a.z, a.w); o.z = pk2(b.x, b.y); o.w = pk2(b.z, b.w); ((GAS v4u*)PB)[i] = o; }
    }
}
__device__ __forceinline__ void p2_conv_chunk(int chunk, const bf16* GB, const bf16* Z, const float* cw, bf16* AC) {
    int tid_l = (int)threadIdx.x; asm volatile("" : "+v"(tid_l));
#pragma unroll
    for (int k = 0; k < 4; ++k) {
        const int i = chunk * 2048 + k * 512 + tid_l;
        const int row = i >> 6, c = (i & 63) * 8, t = row & (SEQ - 1);
        const v4u z2 = *(const GAS v4u*)(Z + (size_t)row * AW + c), g = *(const GAS v4u*)(GB + (size_t)row * AW + c);
        v4u z1 = {0u, 0u, 0u, 0u}, z0 = {0u, 0u, 0u, 0u};
        if (t >= 1) z1 = *(const GAS v4u*)(Z + (size_t)(row - 1) * AW + c);
        if (t >= 2) z0 = *(const GAS v4u*)(Z + (size_t)(row - 2) * AW + c);
        float r[8];
#pragma unroll
        for (int e = 0; e < 4; ++e) {
            const float w0a = cw[c + 2 * e], w0b = cw[c + 2 * e + 1], w1a = cw[AW + c + 2 * e], w1b = cw[AW + c + 2 * e + 1], w2a = cw[2 * AW + c + 2 * e], w2b = cw[2 * AW + c + 2 * e + 1];
            r[2 * e] = __uint_as_float(g[e] << 16) * (w0a * __uint_as_float(z0[e] << 16) + w1a * __uint_as_float(z1[e] << 16) + w2a * __uint_as_float(z2[e] << 16));
            r[2 * e + 1] = __uint_as_float(g[e] & 0xffff0000u) * (w0b * __uint_as_float(z0[e] & 0xffff0000u) + w1b * __uint_as_float(z1[e] & 0xffff0000u) + w2b * __uint_as_float(z2[e] & 0xffff0000u));
        }
        v4u o; o.x = pk2(r[0], r[1]); o.y = pk2(r[2], r[3]); o.z = pk2(r[4], r[5]); o.w = pk2(r[6], r[7]);
        *(GAS v4u*)(AC + (size_t)row * D + AW + c) = o;
    }
}
constexpr int P2_NATT = 512, P2_NCONV = M * AW / 8 / 2048, CW_QUEUE = 512;
__device__ __forceinline__ int p2_dequeue(unsigned* ctr, volatile LAS unsigned* slot) {
    if (threadIdx.x == 0) *slot = __hip_atomic_fetch_add(ctr, 1u, __ATOMIC_RELAXED, __HIP_MEMORY_SCOPE_AGENT);
    asm volatile("s_waitcnt vmcnt(0) lgkmcnt(0)\n\ts_barrier" ::: "memory");
    const unsigned v = *slot;
    asm volatile("s_waitcnt lgkmcnt(0)\n\ts_barrier" ::: "memory");
    return (int)v;
}
template <int CTRL> __device__ __forceinline__ int dpp_i(int v) { return __builtin_amdgcn_update_dpp(0, v, CTRL, 0xf, 0xf, true); }
__device__ __forceinline__ int sum8i(int v) { v += dpp_i<0x141>(v); v += dpp_i<0xB1>(v); v += dpp_i<0x4E>(v); return v; }
__device__ __forceinline__ float max8f(float v) { v = fmaxf(v, __uint_as_float((unsigned)dpp_i<0x141>((int)__float_as_uint(v)))); v = fmaxf(v, __uint_as_float((unsigned)dpp_i<0xB1>((int)__float_as_uint(v)))); v = fmaxf(v, __uint_as_float((unsigned)dpp_i<0x4E>((int)__float_as_uint(v)))); return v; }
__device__ __forceinline__ size_t part_slab(int j) { return j < 2 ? WS_PART0 + (size_t)j * 8 * MiB : j < 6 ? WS_PART1 + (size_t)(j - 2) * 8 * MiB : WS_PART2 + (size_t)(j - 6) * 8 * MiB; }
struct P6Geo { int xg, wi, nwv; };
__device__ __forceinline__ P6Geo p6_geo(const Ctx& F) { P6Geo g; const int bx = blockIdx.x; g.xg = bx & 7; g.wi = (bx >> 3) * NWAVES + F.wave; g.nwv = ((F.G - g.xg + 7) >> 3) * NWAVES; return g; }
__device__ __forceinline__ void p6a_upass(const Ctx& F, unsigned char* ws, const bf16* XB1, const unsigned short* IDS) {
    const P6Geo G = p6_geo(F); const int lane = F.lane_(), g = lane >> 3, c = lane & 7;
    for (int sl = G.xg; sl < NSL; sl += 8) {
        float* PART = (float*)(ws + part_slab(sl));
        const GAS unsigned char* Ts = (const GAS unsigned char*)(ws + WS_UB) + (size_t)sl * NEXP * SLW + 16 * c;
        for (int t = G.wi; t < M; t += G.nwv) {
            const v4u xa = *(const GAS v4u*)(XB1 + (size_t)t * D + sl * SLW + 16 * c), xb = *(const GAS v4u*)(XB1 + (size_t)t * D + sl * SLW + 16 * c + 8);
            v4u idp[2];
#pragma unroll
            for (int q = 0; q < 2; ++q) idp[q] = *(const GAS v4u*)(IDS + (size_t)t * 128 + 16 * g + 8 * q);
            v4u u[16];
#pragma unroll
            for (int i = 0; i < 16; ++i) { const unsigned w_ = idp[i >> 3][(i >> 1) & 3]; u[i] = *(const GAS v4u*)(Ts + ((i & 1) ? ((w_ >> 9) & 0x7fff80u) : ((w_ << 7) & 0x7fff80u))); }
            float xf[16];
#pragma unroll
            for (int e = 0; e < 4; ++e) { xf[2 * e] = __uint_as_float(xa[e] << 16); xf[2 * e + 1] = __uint_as_float(xa[e] & 0xffff0000u); xf[8 + 2 * e] = __uint_as_float(xb[e] << 16); xf[8 + 2 * e + 1] = __uint_as_float(xb[e] & 0xffff0000u); }
            float am = 0.f;
#pragma unroll
            for (int e = 0; e < 16; ++e) am = fmaxf(am, fabsf(xf[e]));
            am = max8f(am);
            const float sc = am > 0.f ? 127.0f / am : 0.f, sx = am * (1.0f / 127.0f);
            int qx[4];
#pragma unroll
            for (int j = 0; j < 4; ++j) qx[j] = (int)(((unsigned)((int)rintf(xf[4 * j] * sc) & 255)) | ((unsigned)((int)rintf(xf[4 * j + 1] * sc) & 255) << 8) | ((unsigned)((int)rintf(xf[4 * j + 2] * sc) & 255) << 16) | ((unsigned)((int)rintf(xf[4 * j + 3] * sc) & 255) << 24));
            int r0 = 0, r1 = 0;
#pragma unroll
            for (int i = 0; i < 16; ++i) { int sacc = __builtin_amdgcn_sdot4(qx[0], (int)u[i][0], 0, false); sacc = __builtin_amdgcn_sdot4(qx[1], (int)u[i][1], sacc, false); sacc = __builtin_amdgcn_sdot4(qx[2], (int)u[i][2], sacc, false); sacc = __builtin_amdgcn_sdot4(qx[3], (int)u[i][3], sacc, false);
                sacc = sum8i(sacc);
                if (i < 8) r0 = (c == i) ? sacc : r0; else r1 = (c == i - 8) ? sacc : r1; }
            float* pp = PART + (size_t)t * 128 + 16 * g + c;
            pp[0] = (float)r0 * sx; pp[8] = (float)r1 * sx;
        }
    }
}
__device__ __forceinline__ void p6b_combine(const Ctx& F, unsigned char* ws, float* SS2, const unsigned short* IDS, const float* GATES) {
    const int gw = F.vcu * NWAVES + F.wave, NGW = F.G * NWAVES, lane = F.lane_();
    const float *SU = (const float*)(ws + WS_SU), *SV = (const float*)(ws + WS_SV);
    signed char* WQ8 = (signed char*)(ws + WS_WQ8); float* SW = (float*)(ws + WS_SW);
    for (int tb = gw; tb < M; tb += 2 * NGW) {
        float ssv[2], a0[2], a1[2], g0[2], g1[2]; int i0[2], i1[2];
#pragma unroll
        for (int r = 0; r < 2; ++r) { const int t = tb + r * NGW; if (t < M) {
            ssv[r] = lane < 16 ? SS2[(size_t)t * 16 + lane] : 0.f;
            i0[r] = (int)IDS[(size_t)t * 128 + lane]; i1[r] = (int)IDS[(size_t)t * 128 + 64 + lane];
            g0[r] = GATES[(size_t)t * 128 + lane]; g1[r] = GATES[(size_t)t * 128 + 64 + lane];
            a0[r] = 0.f; a1[r] = 0.f;
#pragma unroll
            for (int j = 0; j < 8; ++j) { const float* pp = (const float*)(ws + part_slab(j)) + (size_t)t * 128; a0[r] += pp[lane]; a1[r] += pp[64 + lane]; } } }
#pragma unroll
        for (int r = 0; r < 2; ++r) { const int t = tb + r * NGW; if (t < M) {
            const float rstd = 1.0f / sqrtf(wave_sum(ssv[r]) * (1.0f / D) + EPS);
            const float x0 = a0[r] * rstd * SU[i0[r]], x1 = a1[r] * rstd * SU[i1[r]];
            const float w0 = g0[r] * 0.5f * x0 * (1.0f + erff(x0 * 0.70710678118654752f)) * SV[i0[r]], w1 = g1[r] * 0.5f * x1 * (1.0f + erff(x1 * 0.70710678118654752f)) * SV[i1[r]];
            float am = fmaxf(fabsf(w0), fabsf(w1));
#pragma unroll
            for (int o = 1; o < 64; o <<= 1) am = fmaxf(am, __shfl_xor(am, o));
            const float sc = am > 0.f ? 127.0f / am : 0.f;
            WQ8[(size_t)t * 128 + lane] = (signed char)(int)rintf(w0 * sc); WQ8[(size_t)t * 128 + 64 + lane] = (signed char)(int)rintf(w1 * sc);
            if (lane == 0) SW[t] = am * (1.0f / 127.0f);
            if (lane < 16) SS2[(size_t)t * 16 + lane] = 0.f;
        } }
    }
}
__device__ __forceinline__ int pl32_sum(int a, int b) { const auto s_ = __builtin_amdgcn_permlane32_swap((unsigned)a, (unsigned)b, false, false); return (int)(s_[0] + s_[1]); }
__device__ __forceinline__ int pl16_sum(int a, int b) { const auto s_ = __builtin_amdgcn_permlane16_swap((unsigned)a, (unsigned)b, false, false); return (int)(s_[0] + s_[1]); }
__device__ __forceinline__ float wave_sum_valu(float v) {
    { const auto s_ = __builtin_amdgcn_permlane32_swap(__float_as_uint(v), __float_as_uint(v), false, false); v = __uint_as_float(s_[0]) + __uint_as_float(s_[1]); }
    { const auto s_ = __builtin_amdgcn_permlane16_swap(__float_as_uint(v), __float_as_uint(v), false, false); v = __uint_as_float(s_[0]) + __uint_as_float(s_[1]); }
    v += __uint_as_float((unsigned)dpp_i<0x128>((int)__float_as_uint(v))); v += __uint_as_float((unsigned)dpp_i<0x124>((int)__float_as_uint(v)));
    v += __uint_as_float((unsigned)dpp_i<0x122>((int)__float_as_uint(v))); v += __uint_as_float((unsigned)dpp_i<0x121>((int)__float_as_uint(v))); return v;
}
__device__ __forceinline__ void p6c_vpass(const Ctx& F, unsigned char* ws, const unsigned short* IDS, const bf16* XB1, bf16* XB2, float* SS3) {
    const P6Geo G = p6_geo(F); const int lane = F.lane_(), g = lane >> 3, c = lane & 7;
    const int ecol = 16 * c + ((lane >> 5) & 1) * 8 + ((lane >> 4) & 1) * 4 + ((lane >> 3) & 1) * 2;
    const signed char* WQ8 = (const signed char*)(ws + WS_WQ8); const float* SW = (const float*)(ws + WS_SW);
#define V_IDS(ID, t_) do { _Pragma("unroll") for (int q = 0; q < 2; ++q) ID[q] = *(const GAS v4u*)(IDS + (size_t)(t_) * 128 + 16 * g + 8 * q); } while (0)
#define V_W(WV, t_) do { WV = *(const GAS v4u*)(WQ8 + (size_t)(t_) * 128 + 16 * g); } while (0)
#define V_GATHER(R, ID) do { _Pragma("unroll") for (int i = 0; i < 16; ++i) { const unsigned w_ = ID[i >> 3][(i >> 1) & 3]; R[i] = *(const GAS v4u*)(Ts + (size_t)((((i & 1) ? (w_ >> 9) : (w_ << 7)) & 0x7fff80u) | c16)); } } while (0)
#define V_COMPUTE(R, WV, t_) do { \
        const size_t o_ = (size_t)(t_) * D + sl * SLW + ecol; \
        const unsigned xq_ = *(const GAS unsigned*)(XB1 + o_); const float sw_ = SW[t_]; \
        int acc[16]; \
        _Pragma("unroll") for (int e = 0; e < 16; ++e) acc[e] = 0; \
        _Pragma("unroll") for (int j = 0; j < 4; ++j) \
            _Pragma("unroll") for (int b = 0; b < 4; ++b) { \
                const unsigned r0_ = R[4 * j][b], r1_ = R[4 * j + 1][b], r2_ = R[4 * j + 2][b], r3_ = R[4 * j + 3][b]; \
                const unsigned x01 = __builtin_amdgcn_perm(r1_, r0_, 0x05010400u), y01 = __builtin_amdgcn_perm(r1_, r0_, 0x07030602u), x23 = __builtin_amdgcn_perm(r3_, r2_, 0x05010400u), y23 = __builtin_amdgcn_perm(r3_, r2_, 0x07030602u); \
                acc[4 * b]     = __builtin_amdgcn_sdot4((int)__builtin_amdgcn_perm(x23, x01, 0x05040100u), (int)WV[j], acc[4 * b], false); \
                acc[4 * b + 1] = __builtin_amdgcn_sdot4((int)__builtin_amdgcn_perm(x23, x01, 0x07060302u), (int)WV[j], acc[4 * b + 1], false); \
                acc[4 * b + 2] = __builtin_amdgcn_sdot4((int)__builtin_amdgcn_perm(y23, y01, 0x05040100u), (int)WV[j], acc[4 * b + 2], false); \
                acc[4 * b + 3] = __builtin_amdgcn_sdot4((int)__builtin_amdgcn_perm(y23, y01, 0x07060302u), (int)WV[j], acc[4 * b + 3], false); } \
        int r8[8], r4[4], r2[2]; \
        _Pragma("unroll") for (int i = 0; i < 8; ++i) r8[i] = pl32_sum(acc[i], acc[i + 8]); \
        _Pragma("unroll") for (int i = 0; i < 4; ++i) r4[i] = pl16_sum(r8[i], r8[i + 4]); \
        _Pragma("unroll") for (int i = 0; i < 2; ++i) { const int send = (lane & 8) ? r4[i] : r4[i + 2], keep = (lane & 8) ? r4[i + 2] : r4[i]; r2[i] = keep + dpp_i<0x128>(send); } \
        const float x0_ = __uint_as_float(xq_ << 16) + sw_ * (float)r2[0], x1_ = __uint_as_float(xq_ & 0xffff0000u) + sw_ * (float)r2[1]; \
        *(GAS unsigned*)(XB2 + o_) = pk2(x0_, x1_); \
        const float ss = wave_sum_valu(x0_ * x0_ + x1_ * x1_); \
        if (lane == 0) SS3[(size_t)(t_) * 16 + sl] = ss; } while (0)
#define V_FENCE() asm volatile("" ::: "memory")
    for (int sl = G.xg; sl < NSL; sl += 8) {
        const GAS unsigned char* Ts = (const GAS unsigned char*)(ws + WS_VB) + (size_t)sl * NEXP * SLW; const unsigned c16 = 16u * (unsigned)c;
        const int nk = (M - G.wi + G.nwv - 1) / G.nwv, t0 = G.wi, dt = G.nwv;
        v4u idA[2], idB[2]; v4u wA, wB; v4u rA[16], rB[16];
        if (nk > 0) { V_IDS(idA, t0); V_GATHER(rA, idA); V_W(wA, t0); }
        if (nk > 1) V_IDS(idB, t0 + dt);
        V_FENCE();
        for (int k = 0; k < nk; k += 2) {
            if (k + 1 < nk) { V_GATHER(rB, idB); V_W(wB, t0 + (k + 1) * dt); }
            if (k + 2 < nk) V_IDS(idA, t0 + (k + 2) * dt);
            V_FENCE();
            V_COMPUTE(rA, wA, t0 + k * dt);
            V_FENCE();
            if (k + 2 < nk) { V_GATHER(rA, idA); V_W(wA, t0 + (k + 2) * dt); }
            if (k + 3 < nk) V_IDS(idB, t0 + (k + 3) * dt);
            V_FENCE();
            if (k + 1 < nk) V_COMPUTE(rB, wB, t0 + (k + 1) * dt);
            V_FENCE();
        }
    }
#undef V_IDS
#undef V_W
#undef V_GATHER
#undef V_COMPUTE
#undef V_FENCE
}
__device__ __forceinline__ void p8_final(const Ctx& F, float* X, const float* g) {
    const int gw = F.vcu * NWAVES + F.wave, NGW = F.G * NWAVES;
    for (int row = gw; row < M; row += NGW) {
        GAS f32x4* xr = (GAS f32x4*)(X + (size_t)row * D); f32x4 v[4]; float ss = 0.f;
#pragma unroll
        for (int j = 0; j < 4; ++j) { v[j] = xr[F.lane_() + 64 * j]; ss += (v[j].x * v[j].x + v[j].y * v[j].y) + (v[j].z * v[j].z + v[j].w * v[j].w); }
        ss = wave_sum(ss); const float rstd = 1.0f / sqrtf(ss * (1.0f / D) + EPS);
#pragma unroll
        for (int j = 0; j < 4; ++j) { const f32x4 gv = ((const GAS f32x4*)g)[F.lane_() + 64 * j]; xr[F.lane_() + 64 * j] = v[j] * rstd * gv; }
    }
}
struct OneUnit {
    pg8::Unit u;
    __device__ __forceinline__ bool next(int i, pg8::Unit& o) const { if (i != 0) return false; o = u; return true; }
    __device__ __forceinline__ void a_ready(const pg8::Unit&) const {}
    __device__ __forceinline__ void done(const pg8::Unit&) const {}
};

__global__ void __launch_bounds__(NWAVES * 64, 2) mk_fwd(Args args) {
    extern __shared__ __attribute__((aligned(16))) unsigned char lds[];
    Ctx F;
    F.lds = (LAS unsigned char*)lds;
    F.wave = __builtin_amdgcn_readfirstlane((int)threadIdx.x >> 6);
    F.G = gridDim.x; { const int bx = blockIdx.x; F.vcu = (F.G % 8 == 0) ? (bx % 8) * (F.G / 8) + bx / 8 : bx; }
    volatile LAS unsigned* MISC = (volatile LAS unsigned*)(F.lds + MISC_OFF);
    unsigned char* ws = args.ws;
    gu32* ctl = (gu32*)(ws + WS_CTL);
    for (int u = F.tid_(); u < (LDS_BYTES - LDSCTL_OFF) / 4; u += NWAVES * 64) ((LAS unsigned*)(F.lds + LDSCTL_OFF))[u] = 0u;
    __syncthreads();
    const int lo = args.ph_lo, hi = args.ph_hi;
    const bool multi = (hi - lo) > 1 || (lo <= 6 && 6 < hi);
    XcdBarrier bar; bar.bar = (unsigned*)(ctl + CW_BAR) + args.li * XCD_BAR_WORDS; bar.x = 0; bar.st = nullptr;
    if (multi) bar = xcd_barrier_post((unsigned*)(ctl + CW_BAR) + args.li * XCD_BAR_WORDS, MISC + 8);
#ifndef MK_CMASK
#define MK_CMASK 0x1ff
#endif
#define IN(k) (((MK_CMASK >> (k)) & 1) && lo <= (k) && (k) < hi)
#define SEAM(k) do { if (IN(k) && IN((k) + 1)) xcd_barrier(bar); STAMP(); } while (0)
#ifdef MK_PROBE_SEG
    int n_stamp = 0;
#define STAMP() do { if (blockIdx.x == 0 && F.tid_() == 0) { const unsigned long long t_ = __builtin_amdgcn_s_memrealtime(); MISC[16 + 2 * n_stamp] = (unsigned)t_; MISC[17 + 2 * n_stamp] = (unsigned)(t_ >> 32); } ++n_stamp; } while (0)
    STAMP();
#else
#define STAMP() do { } while (0)
#endif
    float* out = args.out;
#define WSP(T, off) ((T*)(ws + (off)))
#define RSTD1 WSP(float, WS_RSTD1)
#define SS2 WSP(float, WS_SS2)
#define LF WSP(float, WS_LF)
#define WIN WSP(bf16, WS_WIN)
#define WBR WSP(bf16, WS_WBR)
#define WOUT WSP(bf16, WS_WOUT)
#define WST WSP(bf16, WS_WS)
#define WPG WSP(bf16, WS_WPG)
#define WPP WSP(bf16, WS_WPP)
#define PB WSP(bf16, WS_PB)
#define XB WSP(bf16, WS_A)
#define AC WSP(bf16, WS_A)
#define XB1 WSP(bf16, WS_A)
#define PP WSP(bf16, WS_PP)
#define Q WSP(bf16, WS_Q)
#define K WSP(bf16, WS_K)
#define V WSP(bf16, WS_V)
#define GB WSP(bf16, WS_GB)
#define Z WSP(bf16, WS_Z)
#define MG WSP(bf16, WS_MERGED)
#define XB2 WSP(bf16, WS_XB2)
#define IDS WSP(unsigned short, WS_IDS)
#define GATES WSP(float, WS_GATES)
#define SGA ((bf16*)out)
#define SGC ((bf16*)out + (size_t)M * D)

    if (IN(0)) { p0_prologue(F, args, MISC); }
    SEAM(0);
    if (IN(1)) {
        { pg8::Gemm g{XB, WIN, M, NIN, D}; pg8::StaticOrder S; S.init(M, NIN, F.G, (int)blockIdx.x);
          pg8::EpiIn E{RSTD1, Q, (size_t)(WS_K - WS_Q) / 2, Z, SGA, (size_t)M * D, C2};
          static_assert(WS_V - WS_K == WS_K - WS_Q && WS_GB - WS_V == WS_K - WS_Q, "Q | K | V | GB equally spaced");
          pg8::gemm_phase<pg8::EpiIn, pg8::StaticOrder, PG8_ALIGN, PG8_SP2>(F.lds + RING_OFF, g, S, E); }
        { pg8::Gemm g{PB, WPP, M, D, PLE}; pg8::StaticOrder S; S.init(M, D, F.G, (int)blockIdx.x);
          pg8::EpiPlain E{PP, D};
          pg8::gemm_phase<pg8::EpiPlain, pg8::StaticOrder, PG8_ALIGN, PG8_SP2>(F.lds + RING_OFF, g, S, E); }
    }
    SEAM(1);
    if (IN(2)) {
        unsigned* qctr = (unsigned*)(ctl + CW_QUEUE);
        for (;;) {
            const int idx = p2_dequeue(qctr, MISC + 12);
            if (idx >= P2_NATT + P2_NCONV) break;
            if (idx < P2_NATT) { const int qb = 15 - (idx >> 5), bh = idx & 31;
                attn_body::attn_unit<8>(bh >> 3, bh & 7, qb, (const attn_body::bf16*)Q, (const attn_body::bf16*)K, (const attn_body::bf16*)V, (attn_body::bf16*)AC, LF + (size_t)bh * SEQ, (char*)lds + RING_OFF); }
            else p2_conv_chunk(idx - P2_NATT, GB, Z, args.in[5], AC);
        }
    }
    SEAM(2);
    if (IN(3)) {
        pg8::Gemm g{AC, WBR, M, D, D}; pg8::StaticOrder S; S.init(M, D, F.G, (int)blockIdx.x);
        pg8::EpiBranch E{SGA, SGC, MG};
        pg8::gemm_phase<pg8::EpiBranch, pg8::StaticOrder, PG8_ALIGN, PG8_SP2>(F.lds + RING_OFF, g, S, E);
    }
    SEAM(3);
    if (IN(4)) {
        pg8::Gemm g{MG, WOUT, M, D, D}; pg8::StaticOrder S; S.init(M, D, F.G, (int)blockIdx.x);
        pg8::EpiOut E{args.in[0], XB1, SS2};
        pg8::gemm_phase<pg8::EpiOut, pg8::StaticOrder, PG8_ALIGN, PG8_SP2>(F.lds + RING_OFF, g, S, E);
    }
    SEAM(4);
    if (IN(5)) {
        pg8::Gemm g{XB1, WST, M, NS, D}; pg8::StaticOrder S; S.init(M, NS, F.G, (int)blockIdx.x);
        pg8::EpiTopK E{SS2, IDS, GATES, EPS};
        pg8::Unit u;
        for (int i = 0; S.next(i, u); ++i) { OneUnit O{u}; pg8::gemm_phase<pg8::EpiTopK, OneUnit, false, PG8_SP2>(F.lds + RING_OFF, g, O, E); }
    }
    SEAM(5);
    if (IN(6)) { p6a_upass(F, ws, XB1, IDS); xcd_barrier(bar); STAMP(); p6b_combine(F, ws, SS2, IDS, GATES); xcd_barrier(bar); STAMP(); p6c_vpass(F, ws, IDS, XB1, XB2, SS2); }
    SEAM(6);
    if (IN(7)) {
        pg8::Gemm g{XB2, WPG, M, D, D}; pg8::StaticOrder S; S.init(M, D, F.G, (int)blockIdx.x);
        LAS float* rtab = (LAS float*)(F.lds + RING_OFF + pg8::STAGE_BYTES);
        const bool one = (M / 256) * (D / 256) <= F.G; pg8::Unit u0;
        if (one && S.next(0, u0) && F.tid_() < 256) { const float* sp = SS2 + (size_t)(u0.pm * 256 + F.tid_()) * 16; float q = 0.f;
#pragma unroll
            for (int j = 0; j < NSL; ++j) q += sp[j];
            rtab[F.tid_()] = 1.0f / sqrtf(q * (1.0f / D) + EPS); }
        __syncthreads();
        pg8::EpiPle E{SS2, PP, XB2, out, EPS, one ? (const LAS float*)rtab : (const LAS float*)nullptr};
        pg8::gemm_phase<pg8::EpiPle, pg8::StaticOrder, PG8_ALIGN, PG8_SP2>(F.lds + RING_OFF, g, S, E);
    }
    SEAM(7);
    if (IN(8)) { p8_final(F, out, args.in[17]); }
    STAMP();
#ifdef MK_PROBE_SEG
    if (blockIdx.x == 0 && F.tid_() == 0) {
#if MK_PROBE_SEG >= 100
        const unsigned long long a_ = ((unsigned long long)MISC[65 + 2 * (MK_PROBE_SEG - 100)] << 32) | MISC[64 + 2 * (MK_PROBE_SEG - 100)], b_ = (MK_PROBE_SEG - 100 == 4) ? (((unsigned long long)MISC[19] << 32) | MISC[18]) : (((unsigned long long)MISC[67 + 2 * (MK_PROBE_SEG - 100)] << 32) | MISC[66 + 2 * (MK_PROBE_SEG - 100)]);
#else
        const unsigned long long a_ = ((unsigned long long)MISC[17 + 2 * MK_PROBE_SEG] << 32) | MISC[16 + 2 * MK_PROBE_SEG], b_ = ((unsigned long long)MISC[19 + 2 * MK_PROBE_SEG] << 32) | MISC[18 + 2 * MK_PROBE_SEG];
#endif
        const unsigned long long dt_ = (b_ - a_) * MK_PROBE_MULT, t0_ = __builtin_amdgcn_s_memrealtime();
        while (__builtin_amdgcn_s_memrealtime() - t0_ < dt_) __builtin_amdgcn_s_sleep(8);
    }
#endif
#undef IN
#undef SEAM
#undef WSP
#undef RSTD1
#undef SS2
#undef LF
#undef WIN
#undef WBR
#undef WOUT
#undef WST
#undef WPG
#undef WPP
#undef PB
#undef XB
#undef AC
#undef XB1
#undef PP
#undef Q
#undef K
#undef V
#undef GB
#undef Z
#undef MG
#undef XB2
#undef IDS
#undef GATES
#undef SGA
#undef SGC
}
namespace gold {
__global__ void __launch_bounds__(256) k_rows0(const float* x, const float* w_in, const float* g_mix, const float* b_f, bf16* XB, float* RSTD1, float* LF) {
    const int lane = threadIdx.x & 63, row = blockIdx.x * 4 + (threadIdx.x >> 6);
    const f32x4* xr = (const f32x4*)(x + (size_t)row * D);
    f32x4 v[4]; float ss = 0.f;
#pragma unroll
    for (int j = 0; j < 4; ++j) { v[j] = xr[lane + 64 * j]; ss += v[j].x * v[j].x + v[j].y * v[j].y + v[j].z * v[j].z + v[j].w * v[j].w; }
    ss = wave_sum(ss);
    const float rstd = 1.0f / sqrtf(ss * (1.0f / D) + EPS);
    u32x2* o = (u32x2*)(XB + (size_t)row * D);
#pragma unroll
    for (int j = 0; j < 4; ++j) { u32x2 w; w.x = pk2(v[j].x, v[j].y); w.y = pk2(v[j].z, v[j].w); o[lane + 64 * j] = w; }
    if (lane == 0) RSTD1[row] = rstd;
    float f[8];
#pragma unroll
    for (int h = 0; h < 8; ++h) f[h] = 0.f;
#pragma unroll
    for (int j = 0; j < 4; ++j)
#pragma unroll
        for (int e = 0; e < 4; ++e) {
            const int k = 4 * (lane + 64 * j) + e; const float xv = v[j][e] * g_mix[k];
            const f32x4 w0 = *(const f32x4*)(w_in + (size_t)k * INTOT + 1536), w1 = *(const f32x4*)(w_in + (size_t)k * INTOT + 1540);
            f[0] += xv * w0.x; f[1] += xv * w0.y; f[2] += xv * w0.z; f[3] += xv * w0.w; f[4] += xv * w1.x; f[5] += xv * w1.y; f[6] += xv * w1.z; f[7] += xv * w1.w;
        }
    const int b = row / SEQ, t = row % SEQ;
#pragma unroll
    for (int h = 0; h < 8; ++h) {
        const float tot = wave_sum(f[h]) * rstd + b_f[h];
        const float ls = fminf(tot, 0.f) - log1pf(__expf(-fabsf(tot)));
        if (lane == 0) LF[(size_t)(b * NH + h) * SEQ + t] = ls * LOG2E;
    }
}
template <int MODE> __global__ void k_wt(const float* W, int ldw, const float* g, bf16* Wt, int N, int K, int koff, int ldt) {
    const size_t i = (size_t)blockIdx.x * blockDim.x + threadIdx.x; if (i >= (size_t)N * K) return;
    const int n = (int)(i / K), k = (int)(i % K);
    const int s = MODE == 1 ? src_in(n) : n;
    const float gv = g ? g[k] : 1.f;
    Wt[(size_t)n * ldt + koff + k] = (bf16)f2bf(gv * W[(size_t)k * ldw + s]);
}
__global__ void k_ws(const float* wq, const float* k1, const float* k2, const float* g, bf16* WST) {
    const size_t i = (size_t)blockIdx.x * blockDim.x + threadIdx.x; if (i >= (size_t)NS * D) return;
    const int n = (int)(i / D), d = (int)(i % D), head = n >> 8, half = (n >> 7) & 1, key = n & 127;
    const float* kr = (half ? k2 : k1) + ((size_t)head * NKEYS + key) * 128;
    const float* qr = wq + (size_t)d * NS + head * 256 + half * 128;
    float s = 0.f;
    for (int e = 0; e < 128; ++e) s += qr[e] * kr[e];
    WST[(size_t)n * D + d] = (bf16)f2bf(g[d] * s);
}
__global__ void k_cvt(const float* in, const float* g, bf16* out, size_t n, int gmask) {
    const size_t i = (size_t)blockIdx.x * blockDim.x + threadIdx.x; if (i >= n) return;
    out[i] = (bf16)f2bf(in[i] * (g ? g[i & gmask] : 1.f));
}

template <class Epi, bool SPLIT2>
__global__ void __launch_bounds__(256) ng(const bf16* A, int lda, const bf16* Bt, int ldb, int K, Epi E) {
    __shared__ float As[32][68], Bs[32][68];
    const int tid = threadIdx.x, tx = tid & 15, ty = tid >> 4, m0 = blockIdx.y * 64, n0 = blockIdx.x * 64;
    float acc[4][4], acc2[4][4];
#pragma unroll
    for (int i = 0; i < 4; ++i)
#pragma unroll
        for (int j = 0; j < 4; ++j) { acc[i][j] = 0.f; acc2[i][j] = 0.f; }
    const int lr = tid >> 2, lk = (tid & 3) * 8;
    for (int k0 = 0; k0 < K; k0 += 32) {
        const u32x4 av = *(const u32x4*)(A + (size_t)(m0 + lr) * lda + k0 + lk), bv = *(const u32x4*)(Bt + (size_t)(n0 + lr) * ldb + k0 + lk);
#pragma unroll
        for (int e = 0; e < 4; ++e) {
            As[lk + 2 * e][lr] = __uint_as_float(av[e] << 16); As[lk + 2 * e + 1][lr] = __uint_as_float(av[e] & 0xffff0000u);
            Bs[lk + 2 * e][lr] = __uint_as_float(bv[e] << 16); Bs[lk + 2 * e + 1][lr] = __uint_as_float(bv[e] & 0xffff0000u);
        }
        __syncthreads();
        const bool second = SPLIT2 && (k0 >= K / 2);
#pragma unroll 8
        for (int kk = 0; kk < 32; ++kk) {
            float a[4], b[4];
#pragma unroll
            for (int i = 0; i < 4; ++i) { a[i] = As[kk][ty * 4 + i]; b[i] = Bs[kk][tx * 4 + i]; }
            if (second) {
#pragma unroll
                for (int i = 0; i < 4; ++i)
#pragma unroll
                    for (int j = 0; j < 4; ++j) acc2[i][j] += a[i] * b[j];
            } else {
#pragma unroll
                for (int i = 0; i < 4; ++i)
#pragma unroll
                    for (int j = 0; j < 4; ++j) acc[i][j] += a[i] * b[j];
            }
        }
        __syncthreads();
    }
#pragma unroll
    for (int i = 0; i < 4; ++i)
#pragma unroll
        for (int j = 0; j < 4; ++j) E(m0 + ty * 4 + i, n0 + tx * 4 + j, acc[i][j], acc2[i][j]);
}
struct E1 {
    const float* RSTD1; bf16 *Q, *K, *V, *GB, *SGA, *SGC; float *TGC, *TXC;
    __device__ void operator()(int row, int col, float a, float) const {
        const float v = RSTD1[row] * a; const int pn = col >> 8;
        if (pn < 2) Q[(size_t)row * AW + col] = (bf16)f2bf(v * C2);
        else if (pn < 4) K[(size_t)row * AW + col - 512] = (bf16)f2bf(v);
        else if (pn < 6) V[(size_t)row * AW + col - 1024] = (bf16)f2bf(v);
        else if (pn < 8) GB[(size_t)row * AW + col - 1536] = (bf16)f2bf(v);
        else if (pn < 12) { const int j = pn - 8, l = col & 255; if (l < 128) TGC[(size_t)row * AW + 128 * j + l] = v; else TXC[(size_t)row * AW + 128 * j + l - 128] = v; }
        else if (pn < 16) SGA[(size_t)row * D + col - 3072] = (bf16)f2bf(sigmoidf_(v));
        else SGC[(size_t)row * D + col - 4096] = (bf16)f2bf(sigmoidf_(v));
    }
};
struct EPP { bf16* PP; __device__ void operator()(int row, int col, float a, float) const { PP[(size_t)row * D + col] = (bf16)f2bf(a); } };
struct E3 { const bf16 *SGA, *SGC; bf16* MG;
    __device__ void operator()(int row, int col, float a, float a2) const { const size_t i = (size_t)row * D + col; MG[i] = (bf16)f2bf(bf2f(SGA[i]) * a + bf2f(SGC[i]) * a2); } };
struct E4 { const float* x; float* X1; bf16* XB1;
    __device__ void operator()(int row, int col, float a, float) const { const size_t i = (size_t)row * D + col; const float v = x[i] + a; X1[i] = v; XB1[i] = (bf16)f2bf(v); } };
struct E5 { float* SC; __device__ void operator()(int row, int col, float a, float) const { SC[(size_t)row * 1024 + col] = a; } };
struct E7 { const float* SS3; const bf16* PP; float* X; const bf16* XB2;
    __device__ void operator()(int row, int col, float a, float) const { const size_t i = (size_t)row * D + col; float q_ = 0.f; for (int j_ = 0; j_ < 16; ++j_) q_ += SS3[(size_t)row * 16 + j_]; X[i] = bf2f(XB2[i]) + sigmoidf_(a / sqrtf(q_ * (1.0f / D) + EPS)) * bf2f(PP[i]); } };

__global__ void k_z(const float* TGC, const float* TXC, bf16* Z) { const size_t i = (size_t)blockIdx.x * blockDim.x + threadIdx.x; if (i < (size_t)M * AW) Z[i] = (bf16)f2bf(TGC[i] * TXC[i]); }
__global__ void k_cumsum(const float* LF, float* CS) { const int bh = threadIdx.x; if (bh >= 32) return; float s = 0.f; for (int t = 0; t < SEQ; ++t) { s += LF[(size_t)bh * SEQ + t]; CS[(size_t)bh * SEQ + t] = s; } }
__global__ void k_conv(const bf16* GB, const bf16* Z, const float* cw, bf16* AC) {
    const size_t i = (size_t)blockIdx.x * blockDim.x + threadIdx.x; if (i >= (size_t)M * AW) return;
    const int row = (int)(i / AW), c = (int)(i % AW), t = row % SEQ;
    float s = cw[2 * AW + c] * bf2f(Z[i]);
    if (t >= 1) s += cw[1 * AW + c] * bf2f(Z[i - AW]);
    if (t >= 2) s += cw[0 * AW + c] * bf2f(Z[i - 2 * AW]);
    AC[(size_t)row * D + AW + c] = (bf16)f2bf(bf2f(GB[i]) * s);
}
__global__ void __launch_bounds__(64) k_attn(const bf16* Q, const bf16* K, const bf16* V, const float* CS, bf16* AC) {
    const int bh = blockIdx.y, b = bh / NH, h = bh % NH, q = blockIdx.x * 64 + threadIdx.x;
    const size_t rq = (size_t)b * SEQ + q;
    float qv[64], o[64];
#pragma unroll
    for (int d = 0; d < 64; ++d) { qv[d] = bf2f(Q[rq * AW + h * 64 + d]); o[d] = 0.f; }
    const float cq = CS[(size_t)bh * SEQ + q];
    float m = -INFINITY, l = 0.f;
    const int kvmax = blockIdx.x * 64 + 63;
    for (int kv = 0; kv <= kvmax; ++kv) {
        const size_t rk = (size_t)b * SEQ + kv;
        const u32x4* kp = (const u32x4*)(K + rk * AW + h * 64);
        float s = 0.f;
#pragma unroll
        for (int c = 0; c < 8; ++c) { const u32x4 w = kp[c];
#pragma unroll
            for (int e = 0; e < 4; ++e) { s += qv[c * 8 + 2 * e] * __uint_as_float(w[e] << 16) + qv[c * 8 + 2 * e + 1] * __uint_as_float(w[e] & 0xffff0000u); } }
        s += cq - CS[(size_t)bh * SEQ + kv];
        if (kv > q) s = -INFINITY;
        const float mn = fmaxf(m, s);
        const float al = (m == -INFINITY) ? 0.f : exp2f(m - mn), p = (s == -INFINITY) ? 0.f : exp2f(s - mn);
        l = l * al + p; m = mn;
        const u32x4* vp = (const u32x4*)(V + rk * AW + h * 64);
#pragma unroll
        for (int c = 0; c < 8; ++c) { const u32x4 w = vp[c];
#pragma unroll
            for (int e = 0; e < 4; ++e) { o[c * 8 + 2 * e] = o[c * 8 + 2 * e] * al + p * __uint_as_float(w[e] << 16); o[c * 8 + 2 * e + 1] = o[c * 8 + 2 * e + 1] * al + p * __uint_as_float(w[e] & 0xffff0000u); } }
    }
    const float il = 1.0f / l;
#pragma unroll
    for (int d = 0; d < 64; ++d) AC[rq * D + h * 64 + d] = (bf16)f2bf(o[d] * il);
}
__global__ void __launch_bounds__(256) k_rowss(const float* X, float* SS) {
    const int lane = threadIdx.x & 63, row = blockIdx.x * 4 + (threadIdx.x >> 6);
    const f32x4* xr = (const f32x4*)(X + (size_t)row * D); float ss = 0.f;
#pragma unroll
    for (int j = 0; j < 4; ++j) { const f32x4 v = xr[lane + 64 * j]; ss += v.x * v.x + v.y * v.y + v.z * v.z + v.w * v.w; }
    ss = wave_sum(ss);
    if (lane < 16) SS[(size_t)row * 16 + lane] = lane == 0 ? ss : 0.f;
}
__global__ void __launch_bounds__(64) k_topk(const float* SC, const float* SS2, int hg, unsigned short* IDS, float* GATES) {
    __shared__ float s[128][64]; __shared__ float tv[16][64]; __shared__ int ti[16][64];
    const int tid = threadIdx.x, pair = blockIdx.x * 32 + (tid >> 1), half = tid & 1, token = pair >> 2, hl = pair & 3;
    const float* src = SC + (size_t)token * 1024 + hl * 256 + half * 128;
    for (int k = 0; k < 128; ++k) s[k][tid] = src[k];
    float pv = INFINITY; int pk = -1;
    for (int r = 0; r < 16; ++r) {
        float best = -INFINITY; int bi = 0;
        for (int k = 0; k < 128; ++k) { const float v = s[k][tid]; const bool elig = (v < pv) || (v == pv && k > pk); if (elig && v > best) { best = v; bi = k; } }
        tv[r][tid] = best; ti[r][tid] = bi; pv = best; pk = bi;
    }
    __syncthreads();
    if (half == 0) {
        const float* ss = SS2 + (size_t)token * 16; float sst = 0.f; for (int q_ = 0; q_ < 16; ++q_) sst += ss[q_]; const float rstd = 1.0f / sqrtf(sst * (1.0f / D) + EPS);
        float ts[16]; int tf[16];
        float cpv = INFINITY; int cpf = -1;
#pragma unroll
        for (int r = 0; r < 16; ++r) {
            float best = -INFINITY; int bf_ = 0;
            for (int c = 0; c < 256; ++c) { const float v = tv[c >> 4][tid] + tv[c & 15][tid + 1]; const bool elig = (v < cpv) || (v == cpv && c > cpf); if (elig && v > best) { best = v; bf_ = c; } }
            ts[r] = best; tf[r] = bf_; cpv = best; cpf = bf_;
        }
        float e[16], sum = 0.f;
#pragma unroll
        for (int r = 0; r < 16; ++r) { e[r] = __expf(rstd * (ts[r] - ts[0])); sum += e[r]; }
        const float inv = 1.0f / sum; const int head = hg * 4 + hl;
#pragma unroll
        for (int r = 0; r < 16; ++r) { IDS[(size_t)token * 128 + head * 16 + r] = (unsigned short)(ti[tf[r] >> 4][tid] * 128 + ti[tf[r] & 15][tid + 1]); GATES[(size_t)token * 128 + head * 16 + r] = e[r] * inv; }
    }
}
__global__ void __launch_bounds__(256) k_peer(const bf16* XB1, const float* SS2, const unsigned short* IDS, const float* GATES, const bf16* UB, const bf16* VB, float* X, bf16* XB2, float* RSTD3) {
    const int lane = threadIdx.x & 63, token = blockIdx.x * 4 + (threadIdx.x >> 6);
    const float* ss = SS2 + (size_t)token * 16; float sst = 0.f; for (int q_ = 0; q_ < 16; ++q_) sst += ss[q_]; const float rstd = 1.0f / sqrtf(sst * (1.0f / D) + EPS);
    float xf[16], out[16];
    { const u32x4 a = *(const u32x4*)(XB1 + (size_t)token * D + 8 * lane), b = *(const u32x4*)(XB1 + (size_t)token * D + 512 + 8 * lane);
#pragma unroll
      for (int e = 0; e < 4; ++e) { xf[2 * e] = __uint_as_float(a[e] << 16); xf[2 * e + 1] = __uint_as_float(a[e] & 0xffff0000u); xf[8 + 2 * e] = __uint_as_float(b[e] << 16); xf[8 + 2 * e + 1] = __uint_as_float(b[e] & 0xffff0000u); } }
#pragma unroll
    for (int i = 0; i < 16; ++i) out[i] = 0.f;
    for (int hk = 0; hk < 128; ++hk) {
        const int id = IDS[(size_t)token * 128 + hk]; const float g = GATES[(size_t)token * 128 + hk];
        const u32x4 a = *(const u32x4*)(UB + (size_t)id * D + 8 * lane), b = *(const u32x4*)(UB + (size_t)id * D + 512 + 8 * lane);
        float dot = 0.f;
#pragma unroll
        for (int e = 0; e < 4; ++e) { dot += xf[2 * e] * __uint_as_float(a[e] << 16) + xf[2 * e + 1] * __uint_as_float(a[e] & 0xffff0000u) + xf[8 + 2 * e] * __uint_as_float(b[e] << 16) + xf[8 + 2 * e + 1] * __uint_as_float(b[e] & 0xffff0000u); }
        dot = wave_sum(dot) * rstd;
        const float w = g * 0.5f * dot * (1.0f + erff(dot * 0.70710678118654752f));
        const u32x4 va = *(const u32x4*)(VB + (size_t)id * D + 8 * lane), vb = *(const u32x4*)(VB + (size_t)id * D + 512 + 8 * lane);
#pragma unroll
        for (int e = 0; e < 4; ++e) { out[2 * e] += w * __uint_as_float(va[e] << 16); out[2 * e + 1] += w * __uint_as_float(va[e] & 0xffff0000u); out[8 + 2 * e] += w * __uint_as_float(vb[e] << 16); out[8 + 2 * e + 1] += w * __uint_as_float(vb[e] & 0xffff0000u); }
    }
    float* xr = X + (size_t)token * D; float s2 = 0.f;
    f32x4 x0, x1, x2, x3;
    for (int e = 0; e < 4; ++e) { x0[e] = xf[e]; x1[e] = xf[4 + e]; x2[e] = xf[8 + e]; x3[e] = xf[12 + e]; }
#pragma unroll
    for (int e = 0; e < 4; ++e) { x0[e] += out[e]; x1[e] += out[4 + e]; x2[e] += out[8 + e]; x3[e] += out[12 + e]; s2 += x0[e] * x0[e] + x1[e] * x1[e] + x2[e] * x2[e] + x3[e] * x3[e]; }
    *(f32x4*)(xr + 8 * lane) = x0; *(f32x4*)(xr + 8 * lane + 4) = x1; *(f32x4*)(xr + 512 + 8 * lane) = x2; *(f32x4*)(xr + 512 + 8 * lane + 4) = x3;
    u32x4 w0, w1; w0.x = pk2(x0.x, x0.y); w0.y = pk2(x0.z, x0.w); w0.z = pk2(x1.x, x1.y); w0.w = pk2(x1.z, x1.w); w1.x = pk2(x2.x, x2.y); w1.y = pk2(x2.z, x2.w); w1.z = pk2(x3.x, x3.y); w1.w = pk2(x3.z, x3.w);
    *(u32x4*)(XB2 + (size_t)token * D + 8 * lane) = w0; *(u32x4*)(XB2 + (size_t)token * D + 512 + 8 * lane) = w1;
    s2 = wave_sum(s2);
    if (lane < 16) RSTD3[(size_t)token * 16 + lane] = lane == 0 ? s2 : 0.f;
}
__global__ void __launch_bounds__(256) k_final(float* X, const float* g) {
    const int lane = threadIdx.x & 63, row = blockIdx.x * 4 + (threadIdx.x >> 6);
    f32x4* xr = (f32x4*)(X + (size_t)row * D); f32x4 v[4]; float ss = 0.f;
#pragma unroll
    for (int j = 0; j < 4; ++j) { v[j] = xr[lane + 64 * j]; ss += v[j].x * v[j].x + v[j].y * v[j].y + v[j].z * v[j].z + v[j].w * v[j].w; }
    ss = wave_sum(ss); const float rstd = 1.0f / sqrtf(ss * (1.0f / D) + EPS);
#pragma unroll
    for (int j = 0; j < 4; ++j) { const f32x4 gv = ((const f32x4*)g)[lane + 64 * j]; xr[lane + 64 * j] = v[j] * rstd * gv; }
}

}

#ifndef MK_FUSED_MASK
#define MK_FUSED_MASK 0x1ff
#endif
static void golden_phase(int ph, void* const* d_in, float* out, unsigned char* ws, hipStream_t stream) {
    using namespace gold;
    const float* x = (const float*)d_in[0]; const float* p = (const float*)d_in[1]; const float* g_mix = (const float*)d_in[2]; const float* w_in = (const float*)d_in[3];
    const float* b_f = (const float*)d_in[4]; const float* conv_w = (const float*)d_in[5]; const float* w_branch = (const float*)d_in[6]; const float* w_out = (const float*)d_in[7];
    const float* g_ffn = (const float*)d_in[8]; const float* w_peer_q = (const float*)d_in[9]; const float* peer_k1 = (const float*)d_in[10]; const float* peer_k2 = (const float*)d_in[11];
    const float* peer_u = (const float*)d_in[12]; const float* peer_v = (const float*)d_in[13]; const float* g_ple = (const float*)d_in[14]; const float* w_ple_gate = (const float*)d_in[15];
    const float* w_ple_proj = (const float*)d_in[16]; const float* g_final = (const float*)d_in[17];
    float *RSTD1 = (float*)(ws + WS_RSTD1), *SS2 = (float*)(ws + WS_SS2), *LF = (float*)(ws + WS_LF), *CS = (float*)(ws + WS_CS);
    bf16 *WIN = (bf16*)(ws + WS_WIN), *WBR = (bf16*)(ws + WS_WBR), *WOUT = (bf16*)(ws + WS_WOUT), *WST = (bf16*)(ws + WS_WS), *WPG = (bf16*)(ws + WS_WPG), *WPP = (bf16*)(ws + WS_WPP), *PB = (bf16*)(ws + WS_PB);
    bf16 *UB = (bf16*)(ws + WS_UB), *VB = (bf16*)(ws + WS_VB), *XB = (bf16*)(ws + WS_A), *AC = (bf16*)(ws + WS_A), *XB1 = (bf16*)(ws + WS_A), *PP = (bf16*)(ws + WS_PP);
    bf16 *Q = (bf16*)(ws + WS_Q), *K = (bf16*)(ws + WS_K), *V = (bf16*)(ws + WS_V), *GB = (bf16*)(ws + WS_GB), *Z = (bf16*)(ws + WS_Z), *MG = (bf16*)(ws + WS_MERGED), *XB2 = (bf16*)(ws + WS_XB2);
    unsigned short* IDS = (unsigned short*)(ws + WS_IDS); float* GATES = (float*)(ws + WS_GATES);
    bf16 *SGA = (bf16*)out, *SGC = (bf16*)out + (size_t)M * D;
    float *TGC = (float*)(ws + WS_TGC), *TXC = (float*)(ws + WS_TXC), *SC = (float*)(ws + WS_SC);
    auto nb = [](size_t n) { return (unsigned)((n + 255) / 256); };
    switch (ph) {
    case 0:
        k_rows0<<<M / 4, 256, 0, stream>>>(x, w_in, g_mix, b_f, XB, RSTD1, LF);
        k_wt<1><<<nb((size_t)NIN * D), 256, 0, stream>>>(w_in, INTOT, g_mix, WIN, NIN, D, 0, D);
        k_wt<0><<<nb((size_t)D * AW), 256, 0, stream>>>(w_branch, D, nullptr, WBR, D, AW, 0, D);
        k_wt<0><<<nb((size_t)D * AW), 256, 0, stream>>>(w_branch + (size_t)AW * D, D, nullptr, WBR, D, AW, AW, D);
        k_wt<0><<<nb((size_t)D * D), 256, 0, stream>>>(w_out, D, nullptr, WOUT, D, D, 0, D);
        k_wt<0><<<nb((size_t)D * D), 256, 0, stream>>>(w_ple_gate, D, g_ple, WPG, D, D, 0, D);
        k_wt<0><<<nb((size_t)D * PLE), 256, 0, stream>>>(w_ple_proj, D, nullptr, WPP, D, PLE, 0, PLE);
        k_ws<<<nb((size_t)NS * D), 256, 0, stream>>>(w_peer_q, peer_k1, peer_k2, g_ffn, WST);
        k_cvt<<<nb((size_t)M * PLE), 256, 0, stream>>>(p, nullptr, PB, (size_t)M * PLE, 0);
        break;
    case 1:
        ng<E1, false><<<dim3(NIN / 64, M / 64), 256, 0, stream>>>(XB, D, WIN, D, D, E1{RSTD1, Q, K, V, GB, SGA, SGC, TGC, TXC});
        ng<EPP, false><<<dim3(D / 64, M / 64), 256, 0, stream>>>(PB, PLE, WPP, PLE, PLE, EPP{PP});
        k_z<<<nb((size_t)M * AW), 256, 0, stream>>>(TGC, TXC, Z);
        break;
    case 2:
        k_cumsum<<<1, 64, 0, stream>>>(LF, CS);
        k_conv<<<nb((size_t)M * AW), 256, 0, stream>>>(GB, Z, conv_w, AC);
        k_attn<<<dim3(SEQ / 64, BATCH * NH), 64, 0, stream>>>(Q, K, V, CS, AC);
        break;
    case 3: ng<E3, true><<<dim3(D / 64, M / 64), 256, 0, stream>>>(AC, D, WBR, D, D, E3{SGA, SGC, MG}); break;
    case 4:
        ng<E4, false><<<dim3(D / 64, M / 64), 256, 0, stream>>>(MG, D, WOUT, D, D, E4{x, out, XB1});
        k_rowss<<<M / 4, 256, 0, stream>>>(out, SS2);
        break;
    case 5:
        for (int hg = 0; hg < 2; ++hg) {
            ng<E5, false><<<dim3(1024 / 64, M / 64), 256, 0, stream>>>(XB1, D, WST + (size_t)hg * 1024 * D, D, D, E5{SC});
            k_topk<<<M * 4 / 32, 64, 0, stream>>>(SC, SS2, hg, IDS, GATES);
        }
        break;
    case 6:
        k_cvt<<<nb((size_t)NEXP * D), 256, 0, stream>>>(peer_u, g_ffn, UB, (size_t)NEXP * D, D - 1);
        k_cvt<<<nb((size_t)NEXP * D), 256, 0, stream>>>(peer_v, nullptr, VB, (size_t)NEXP * D, 0);
        k_peer<<<M / 4, 256, 0, stream>>>(XB1, SS2, IDS, GATES, UB, VB, out, XB2, SS2);
        break;
    case 7: ng<E7, false><<<dim3(D / 64, M / 64), 256, 0, stream>>>(XB2, D, WPG, D, D, E7{SS2, PP, out, XB2}); break;
    case 8: k_final<<<M / 4, 256, 0, stream>>>(out, g_final); break;
    }
}
extern "C" void kernel_launch(void* const* d_in, const int* in_sizes, int n_in, void* d_out, int out_size, void* d_ws, size_t ws_size, hipStream_t stream) {
    static int grid = 0;
    if (grid == 0) {
        if (n_in != 18 || in_sizes[0] != M * D || out_size != M * D || ws_size < WS_END) { fprintf(stderr, "kernel_launch: unexpected shapes (n_in %d, in0 %d, out %d, ws %zu); nothing launched\n", n_in, n_in > 0 ? in_sizes[0] : -1, out_size, ws_size); grid = -1; return; }
        int dev = 0, cus = 0, per_cu = 0;
        if (hipGetDevice(&dev) != hipSuccess || hipDeviceGetAttribute(&cus, hipDeviceAttributeMultiprocessorCount, dev) != hipSuccess) { fprintf(stderr, "kernel_launch: device query failed\n"); grid = -1; return; }
        if (hipFuncSetAttribute((const void*)mk_fwd, hipFuncAttributeMaxDynamicSharedMemorySize, LDS_BYTES) != hipSuccess) { fprintf(stderr, "kernel_launch: hipFuncSetAttribute failed\n"); grid = -1; return; }
        if (hipOccupancyMaxActiveBlocksPerMultiprocessor(&per_cu, (const void*)mk_fwd, NWAVES * 64, LDS_BYTES) != hipSuccess || per_cu < 1) { fprintf(stderr, "kernel_launch: occupancy query says %d workgroups per CU; nothing launched\n", per_cu); (void)hipGetLastError(); grid = -1; return; }
        grid = cus;
    }
    if (grid < 0) return;
    if (hipMemsetAsync((char*)d_ws + WS_CTL, 0, CTL_ZERO_BYTES, stream) != hipSuccess) { fprintf(stderr, "kernel_launch: hipMemsetAsync failed\n"); return; }
    Args a{};
    for (int i = 0; i < 18; ++i) a.in[i] = (const float*)d_in[i];
    a.out = (float*)d_out; a.ws = (unsigned char*)d_ws;
    int li = 0;
    for (int ph = 0; ph < NPHASE;) {
        if ((MK_FUSED_MASK >> ph) & 1) {
            int hi = ph; while (hi < NPHASE && ((MK_FUSED_MASK >> hi) & 1)) ++hi;
            a.ph_lo = ph; a.ph_hi = hi; a.li = li++; a.pad = 0;
            hipLaunchKernelGGL(mk_fwd, dim3(grid), dim3(NWAVES * 64), LDS_BYTES, stream, a);
            const hipError_t le = hipPeekAtLastError();
            if (le != hipSuccess) { fprintf(stderr, "kernel_launch: launch failed: %s\n", hipGetErrorName(le)); return; }
            ph = hi;
        } else {
            golden_phase(ph, d_in, (float*)d_out, (unsigned char*)d_ws, stream);
            if ((ph == 1 || ph == 5) && (MK_FUSED_MASK & 1) && ((MK_FUSED_MASK >> 6) & 1)) {
                gold::k_cvt<<<(unsigned)(((size_t)NEXP * D + 255) / 256), 256, 0, stream>>>((const float*)d_in[12], (const float*)d_in[8], (bf16*)((unsigned char*)d_ws + WS_UB), (size_t)NEXP * D, D - 1);
                gold::k_cvt<<<(unsigned)(((size_t)NEXP * D + 255) / 256), 256, 0, stream>>>((const float*)d_in[13], nullptr, (bf16*)((unsigned char*)d_ws + WS_VB), (size_t)NEXP * D, 0);
            }
            ++ph;
        }
    }
}
```

```cpp
#include <hip/hip_runtime.h>
#include <hip/hip_bf16.h>
#include <cstdio>
#include <cstdint>
#include <cmath>
#define MK_FUSED_MASK 0x1ff
namespace pg8 {
#define PG8_LAS __attribute__((address_space(3)))
typedef unsigned short bf16_t;
typedef short bf16x8 __attribute__((ext_vector_type(8)));
typedef float f32x4 __attribute__((ext_vector_type(4)));
typedef unsigned u32x4 __attribute__((ext_vector_type(4)));
constexpr int BM = 256, BK = 64, HALF = 128, HTB = HALF * BK * 2  , STAGE_BYTES = 8 * HTB, NXCD = 8, WGM = 8;

__host__ __device__ __forceinline__ int lds_byte(int r, int c) { const int st = (r >> 4) * 2 + (c >> 5), rr = r & 15, cc = c & 31, ob = rr * 64 + cc * 2; return st * 1024 + (ob ^ (((ob >> 9) & 1) << 5)); }
__host__ __device__ __forceinline__ void stage_rc(int b, int& R, int& C) { const int st = b / 1024, sb = b % 1024, swz = sb ^ (((sb >> 9) & 1) << 5); R = (st >> 1) * 16 + swz / 64; C = (st & 1) * 32 + (swz % 64) / 2; }
__host__ __device__ __forceinline__ int perm32(int rho) { const int n = rho >> 4, i = rho & 15; return 8 * (i >> 2) + 4 * n + (i & 3); }

struct Unit { int pm, pn; };
struct Gemm { const bf16_t* A; const bf16_t* Bt; int M, N, K; };

struct StaticOrder {
    int nM, nN, nwg, G, c;
    __host__ __device__ __forceinline__ void init(int M, int N, int G_, int c_) { nM = M / BM; nN = N / BM; nwg = nM * nN; G = G_; c = c_; }
    __host__ __device__ __forceinline__ bool next(int i, Unit& u) const {
        const long L = (long)i * G + c; if (L >= nwg) return false;
        int wgid = (int)L; { const int q = nwg / NXCD, r = nwg % NXCD, xcd = wgid % NXCD, off = wgid / NXCD; wgid = (xcd < r ? xcd * (q + 1) : r * (q + 1) + (xcd - r) * q) + off; }
        const int nig = WGM * nN, gid = wgid / nig, fm = gid * WGM, gsz = (nM - fm) < WGM ? (nM - fm) : WGM;
        u.pm = fm + ((wgid % nig) % gsz); u.pn = (wgid % nig) / gsz; return true;
    }
    __device__ __forceinline__ void a_ready(const Unit&) const {}
    __device__ __forceinline__ void done(const Unit&) const {}
};


__device__ __forceinline__ unsigned cvt_pk_bf16(float lo, float hi) { unsigned r; asm volatile("v_cvt_pk_bf16_f32 %0, %1, %2" : "=v"(r) : "v"(lo), "v"(hi)); return r; }
__device__ __forceinline__ u32x4 pack8(const f32x4 v0, const f32x4 v1) { u32x4 w; w.x = cvt_pk_bf16(v0[0], v0[1]); w.y = cvt_pk_bf16(v0[2], v0[3]); w.z = cvt_pk_bf16(v1[0], v1[1]); w.w = cvt_pk_bf16(v1[2], v1[3]); return w; }
__device__ __forceinline__ float bflo(unsigned w) { return __uint_as_float(w << 16); }
__device__ __forceinline__ float bfhi(unsigned w) { return __uint_as_float(w & 0xffff0000u); }
__device__ __forceinline__ float sigm(float v) { return __builtin_amdgcn_rcpf(1.0f + __builtin_amdgcn_exp2f(v * -1.4426950408889634f)); }
__device__ __forceinline__ f32x4 sigm4(const f32x4 v) { return (f32x4){sigm(v[0]), sigm(v[1]), sigm(v[2]), sigm(v[3])}; }

struct EpiIn {
    static constexpr int PROBE_ID = 1;
    static constexpr bool PERM = true, AFTER_DRAIN = false; static constexpr int MID_T = 0;
    const float* rstd; bf16_t* QKVG; size_t stride4; bf16_t* Z; bf16_t* SG; size_t strideSG; float c2;
    __device__ __forceinline__ void operator()(const f32x4 (&acc)[2][2][4][2], const Unit& u, int wr, int wc, int fr, int fq) const {
        int row0 = u.pm * BM + wr * 64 + fr; asm volatile("" : "+v"(row0)); const int cl = wc * 32 + 8 * fq, pn = u.pn;
        if (pn < 8) {
            bf16_t* base = QKVG + (size_t)(pn >> 1) * stride4; const int colt = (pn & 1) * 256 + cl; const float s0 = pn < 2 ? c2 : 1.f;
#pragma unroll
            for (int ai = 0; ai < 2; ++ai)
#pragma unroll
                for (int m = 0; m < 4; ++m) { const int row = row0 + ai * HALF + m * 16; const float sc = rstd[row] * s0; bf16_t* rowp = base + (size_t)row * 512 + colt;
#pragma unroll
                    for (int bj = 0; bj < 2; ++bj) *(u32x4*)(rowp + bj * HALF) = pack8(acc[ai][bj][m][0] * sc, acc[ai][bj][m][1] * sc);
                    asm volatile("" ::: "memory"); }
        } else if (pn < 12) {
            const int colt = (pn - 8) * 128 + cl;
#pragma unroll
            for (int ai = 0; ai < 2; ++ai)
#pragma unroll
                for (int m = 0; m < 4; ++m) { const int row = row0 + ai * HALF + m * 16; const float r = rstd[row], sc = r * r;
                    *(u32x4*)(Z + (size_t)row * 512 + colt) = pack8(acc[ai][0][m][0] * acc[ai][1][m][0] * sc, acc[ai][0][m][1] * acc[ai][1][m][1] * sc);
                    asm volatile("" ::: "memory"); }
        } else {
            bf16_t* base = SG + (size_t)((pn - 12) >> 2) * strideSG; const int colt = ((pn - 12) & 3) * 256 + cl;
#pragma unroll
            for (int ai = 0; ai < 2; ++ai)
#pragma unroll
                for (int m = 0; m < 4; ++m) { const int row = row0 + ai * HALF + m * 16; const float r = rstd[row]; bf16_t* rowp = base + (size_t)row * 1024 + colt;
#pragma unroll
                    for (int bj = 0; bj < 2; ++bj) { *(u32x4*)(rowp + bj * HALF) = pack8(sigm4(acc[ai][bj][m][0] * r), sigm4(acc[ai][bj][m][1] * r)); asm volatile("" ::: "memory"); } }
        }
    }
};
struct EpiPlain {
    static constexpr int PROBE_ID = 2;
    static constexpr bool PERM = true, AFTER_DRAIN = false; static constexpr int MID_T = 0;
    bf16_t* O; int ldc;
    __device__ __forceinline__ void operator()(const f32x4 (&acc)[2][2][4][2], const Unit& u, int wr, int wc, int fr, int fq) const {
        int row0 = u.pm * BM + wr * 64 + fr; asm volatile("" : "+v"(row0)); const int col0 = u.pn * BM + wc * 32 + 8 * fq;
#pragma unroll
        for (int ai = 0; ai < 2; ++ai)
#pragma unroll
            for (int m = 0; m < 4; ++m) { bf16_t* rowp = O + (size_t)(row0 + ai * HALF + m * 16) * ldc + col0;
#pragma unroll
                for (int bj = 0; bj < 2; ++bj) *(u32x4*)(rowp + bj * HALF) = pack8(acc[ai][bj][m][0], acc[ai][bj][m][1]); }
    }
};
struct EpiBranch {
    static constexpr int PROBE_ID = 3;
    static constexpr bool PERM = true, AFTER_DRAIN = false; static constexpr int MID_T = 8;
    const bf16_t *SGA, *SGC; bf16_t* MG;
    __device__ __forceinline__ void mid(f32x4 (&acc)[2][2][4][2], const Unit& u, int wr, int wc, int fr, int fq) const {
        int row0 = u.pm * BM + wr * 64 + fr; asm volatile("" : "+v"(row0)); const int col0 = u.pn * BM + wc * 32 + 8 * fq;
#pragma unroll
        for (int ai = 0; ai < 2; ++ai) {
            u32x4 a[4][2], c[4][2];
#pragma unroll
            for (int m = 0; m < 4; ++m)
#pragma unroll
                for (int bj = 0; bj < 2; ++bj) { const size_t off = (size_t)(row0 + ai * HALF + m * 16) * 1024 + col0 + bj * HALF; a[m][bj] = *(const u32x4*)(SGA + off); c[m][bj] = *(const u32x4*)(SGC + off); }
#pragma unroll
            for (int m = 0; m < 4; ++m)
#pragma unroll
                for (int bj = 0; bj < 2; ++bj) { const u32x4 av = a[m][bj], cv = c[m][bj]; f32x4 r0, r1;
                    r0[0] = bflo(av[0]) * __builtin_amdgcn_rcpf(bflo(cv[0])); r0[1] = bfhi(av[0]) * __builtin_amdgcn_rcpf(bfhi(cv[0])); r0[2] = bflo(av[1]) * __builtin_amdgcn_rcpf(bflo(cv[1])); r0[3] = bfhi(av[1]) * __builtin_amdgcn_rcpf(bfhi(cv[1]));
                    r1[0] = bflo(av[2]) * __builtin_amdgcn_rcpf(bflo(cv[2])); r1[1] = bfhi(av[2]) * __builtin_amdgcn_rcpf(bfhi(cv[2])); r1[2] = bflo(av[3]) * __builtin_amdgcn_rcpf(bflo(cv[3])); r1[3] = bfhi(av[3]) * __builtin_amdgcn_rcpf(bfhi(cv[3]));
                    acc[ai][bj][m][0] *= r0; acc[ai][bj][m][1] *= r1; }
            asm volatile("" ::: "memory");
        }
    }
    __device__ __forceinline__ void operator()(const f32x4 (&acc)[2][2][4][2], const Unit& u, int wr, int wc, int fr, int fq) const {
        int row0 = u.pm * BM + wr * 64 + fr; asm volatile("" : "+v"(row0)); const int col0 = u.pn * BM + wc * 32 + 8 * fq;
#pragma unroll
        for (int ai = 0; ai < 2; ++ai) {
            u32x4 c[4][2];
#pragma unroll
            for (int m = 0; m < 4; ++m)
#pragma unroll
                for (int bj = 0; bj < 2; ++bj) c[m][bj] = *(const u32x4*)(SGC + (size_t)(row0 + ai * HALF + m * 16) * 1024 + col0 + bj * HALF);
#pragma unroll
            for (int m = 0; m < 4; ++m)
#pragma unroll
                for (int bj = 0; bj < 2; ++bj) { const u32x4 cv = c[m][bj];
                    const f32x4 s0 = {bflo(cv[0]), bfhi(cv[0]), bflo(cv[1]), bfhi(cv[1])}, s1 = {bflo(cv[2]), bfhi(cv[2]), bflo(cv[3]), bfhi(cv[3])};
                    *(u32x4*)(MG + (size_t)(row0 + ai * HALF + m * 16) * 1024 + col0 + bj * HALF) = pack8(acc[ai][bj][m][0] * s0, acc[ai][bj][m][1] * s1); }
            asm volatile("" ::: "memory");
        }
    }
};
struct EpiOut {
    static constexpr int PROBE_ID = 4;
    static constexpr bool PERM = true, AFTER_DRAIN = false; static constexpr int MID_T = 0;
    const bf16_t* XBin; bf16_t* XB1; float* SS2;
    __device__ __forceinline__ void operator()(const f32x4 (&acc)[2][2][4][2], const Unit& u, int wr, int wc, int fr, int fq) const {
        int row0 = u.pm * BM + wr * 64 + fr; asm volatile("" : "+v"(row0)); const int col0 = u.pn * BM + wc * 32 + 8 * fq;
#pragma unroll
        for (int ai = 0; ai < 2; ++ai) {
            u32x4 xq[4][2];
#pragma unroll
            for (int m = 0; m < 4; ++m)
#pragma unroll
                for (int bj = 0; bj < 2; ++bj) xq[m][bj] = *(const u32x4*)(XBin + (size_t)(row0 + ai * HALF + m * 16) * 1024 + col0 + bj * HALF);
#pragma unroll
            for (int m = 0; m < 4; ++m) { const int row = row0 + ai * HALF + m * 16; float ss = 0.f;
#pragma unroll
                for (int bj = 0; bj < 2; ++bj) { const u32x4 q = xq[m][bj];
                    const f32x4 v0 = acc[ai][bj][m][0] + (f32x4){bflo(q[0]), bfhi(q[0]), bflo(q[1]), bfhi(q[1])}, v1 = acc[ai][bj][m][1] + (f32x4){bflo(q[2]), bfhi(q[2]), bflo(q[3]), bfhi(q[3])};
                    *(u32x4*)(XB1 + (size_t)row * 1024 + col0 + bj * HALF) = pack8(v0, v1);
                    ss += (v0[0] * v0[0] + v0[1] * v0[1]) + (v0[2] * v0[2] + v0[3] * v0[3]) + (v1[0] * v1[0] + v1[1] * v1[1]) + (v1[2] * v1[2] + v1[3] * v1[3]); }
                ss += __shfl_xor(ss, 16); ss += __shfl_xor(ss, 32);
                if (fq == 0) SS2[(size_t)row * 16 + u.pn * 4 + wc] = ss; }
            asm volatile("" ::: "memory");
        }
    }
};
struct EpiPle {
    static constexpr int PROBE_ID = 7;
    static constexpr bool PERM = true, AFTER_DRAIN = false; static constexpr int MID_T = 0;
    const float* SS3; const bf16_t* PP; const bf16_t* XB2; bf16_t* XB3; float* SS4; float eps; const PG8_LAS float* rtab;
    __device__ __forceinline__ void operator()(const f32x4 (&acc)[2][2][4][2], const Unit& u, int wr, int wc, int fr, int fq) const {
        int row0 = u.pm * BM + wr * 64 + fr; asm volatile("" : "+v"(row0)); const int col0 = u.pn * BM + wc * 32 + 8 * fq;
#pragma unroll
        for (int ai = 0; ai < 2; ++ai) {
            u32x4 pv[4][2], xb[4][2]; float rr[4];
#pragma unroll
            for (int m = 0; m < 4; ++m) { const int row = row0 + ai * HALF + m * 16;
#pragma unroll
                for (int bj = 0; bj < 2; ++bj) { const size_t off = (size_t)row * 1024 + col0 + bj * HALF; pv[m][bj] = *(const u32x4*)(PP + off); xb[m][bj] = *(const u32x4*)(XB2 + off); }
                if (rtab) rr[m] = rtab[wr * 64 + fr + ai * HALF + m * 16];
                else { const f32x4* sp = (const f32x4*)(SS3 + (size_t)row * 16); const f32x4 q0 = sp[0], q1 = sp[1]; rr[m] = 1.0f / sqrtf((((q0[0] + q0[1]) + (q0[2] + q0[3])) + ((q1[0] + q1[1]) + (q1[2] + q1[3]))) * (1.0f / 1024.0f) + eps); } }
#pragma unroll
            for (int m = 0; m < 4; ++m) { const int row = row0 + ai * HALF + m * 16; const float r = rr[m]; float ss = 0.f;
#pragma unroll
                for (int bj = 0; bj < 2; ++bj) { const u32x4 c = pv[m][bj], xq = xb[m][bj]; const size_t off = (size_t)row * 1024 + col0 + bj * HALF;
                    const f32x4 p0 = {bflo(c[0]), bfhi(c[0]), bflo(c[1]), bfhi(c[1])}, p1 = {bflo(c[2]), bfhi(c[2]), bflo(c[3]), bfhi(c[3])};
                    const f32x4 x0 = {bflo(xq[0]), bfhi(xq[0]), bflo(xq[1]), bfhi(xq[1])}, x1 = {bflo(xq[2]), bfhi(xq[2]), bflo(xq[3]), bfhi(xq[3])};
                    const f32x4 v0 = x0 + sigm4(acc[ai][bj][m][0] * r) * p0, v1 = x1 + sigm4(acc[ai][bj][m][1] * r) * p1;
                    *(u32x4*)(XB3 + off) = pack8(v0, v1);
                    ss += (v0[0] * v0[0] + v0[1] * v0[1]) + (v0[2] * v0[2] + v0[3] * v0[3]) + (v1[0] * v1[0] + v1[1] * v1[1]) + (v1[2] * v1[2] + v1[3] * v1[3]); }
                ss += __shfl_xor(ss, 16); ss += __shfl_xor(ss, 32);
                if (fq == 0) SS4[(size_t)row * 16 + u.pn * 4 + wc] = ss; }
            asm volatile("" ::: "memory");
        }
    }
};

__device__ __forceinline__ float vmaxf(float a, float b) { float r; asm("v_max_f32_e32 %0, %1, %2" : "=v"(r) : "v"(a), "v"(b)); return r; }
__device__ __forceinline__ float vminf(float a, float b) { float r; asm("v_min_f32_e32 %0, %1, %2" : "=v"(r) : "v"(a), "v"(b)); return r; }
__device__ __forceinline__ void sort16_desc(float (&a)[16]) {
#pragma unroll
    for (int k = 2; k <= 16; k <<= 1)
#pragma unroll
        for (int j = k >> 1; j > 0; j >>= 1)
#pragma unroll
            for (int i = 0; i < 16; ++i) { const int l = i ^ j; if (l > i) { const float hi = vmaxf(a[i], a[l]), lo = vminf(a[i], a[l]); if ((i & k) == 0) { a[i] = hi; a[l] = lo; } else { a[i] = lo; a[l] = hi; } } }
}
template <int L> __device__ __forceinline__ void merge16(float (&a)[16], const float (&b)[16]) {
#pragma unroll
    for (int i = 0; i < 16; ++i) if (15 - i < L) a[i] = vmaxf(a[i], b[15 - i]);
#pragma unroll
    for (int j = 8; j > 0; j >>= 1)
#pragma unroll
        for (int i = 0; i < 16; ++i) { const int l = i ^ j; if (l > i) { const float hi = vmaxf(a[i], a[l]), lo = vminf(a[i], a[l]); a[i] = hi; a[l] = lo; } }
}
struct EpiTopK {
    static constexpr int PROBE_ID = 5;
    static constexpr bool PERM = true, AFTER_DRAIN = true; static constexpr int MID_T = 0;
    static constexpr int RS = 260;
    const float* SS2; unsigned short* IDS; float* GATES; float eps;
    __device__ __forceinline__ void fused(f32x4 (&acc)[2][2][4][2], const Unit& u, int wr, int wc, int fr, int fq, PG8_LAS unsigned char* lds, int wid, int lane) const {
        PG8_LAS float* S = (PG8_LAS float*)lds;
        const int tid = wid * 64 + lane, row = tid & 127, grp = tid >> 7, half = grp >> 1, part = grp & 1;
#define TK_BAR() do { asm volatile("s_waitcnt vmcnt(0) lgkmcnt(0)" ::: "memory"); __builtin_amdgcn_s_barrier(); asm volatile("" ::: "memory"); } while (0)
#ifdef MK_PROBE_TOPK2
        for (int rep_ = 0; rep_ < MK_PROBE_TOPK2; ++rep_)
#endif
#pragma unroll
        for (int ai = 0; ai < 2; ++ai) {
#pragma unroll
            for (int m = 0; m < 4; ++m)
#pragma unroll
                for (int bj = 0; bj < 2; ++bj)
#pragma unroll
                    for (int n = 0; n < 2; ++n) *(PG8_LAS f32x4*)(S + (wr * 64 + m * 16 + fr) * RS + bj * HALF + wc * 32 + 8 * fq + 4 * n) = acc[ai][bj][m][n];
            TK_BAR();
            float T[16];
#pragma unroll
            for (int b = 0; b < 4; ++b) {
                float c[16];
#pragma unroll
                for (int q = 0; q < 4; ++q) { const f32x4 v = *(const PG8_LAS f32x4*)(S + row * RS + half * 128 + part * 64 + b * 16 + q * 4);
#pragma unroll
                    for (int e = 0; e < 4; ++e) c[q * 4 + e] = __uint_as_float((__float_as_uint(v[e]) & ~127u) | (unsigned)(part * 64 + b * 16 + q * 4 + e)); }
                sort16_desc(c);
                if (b == 0) {
#pragma unroll
                    for (int i = 0; i < 16; ++i) T[i] = c[i];
                } else merge16<16>(T, c);
            }
            TK_BAR();
#pragma unroll
            for (int q = 0; q < 4; ++q) *(PG8_LAS f32x4*)(S + tid * 16 + q * 4) = (f32x4){T[q * 4], T[q * 4 + 1], T[q * 4 + 2], T[q * 4 + 3]};
            TK_BAR();
            if (part == 0) {
                float c[16];
#pragma unroll
                for (int q = 0; q < 4; ++q) { const f32x4 v = *(const PG8_LAS f32x4*)(S + (tid + 128) * 16 + q * 4); c[q * 4] = v[0]; c[q * 4 + 1] = v[1]; c[q * 4 + 2] = v[2]; c[q * 4 + 3] = v[3]; }
                merge16<16>(T, c);
            }
            TK_BAR();
            if (part == 0) {
#pragma unroll
                for (int q = 0; q < 4; ++q) *(PG8_LAS f32x4*)(S + tid * 16 + q * 4) = (f32x4){T[q * 4], T[q * 4 + 1], T[q * 4 + 2], T[q * 4 + 3]};
            }
            TK_BAR();
            if (tid < 128) {
                float a1[16], a2[16];
#pragma unroll
                for (int q = 0; q < 4; ++q) { const f32x4 v = *(const PG8_LAS f32x4*)(S + (tid + 256) * 16 + q * 4);
#pragma unroll
                    for (int e = 0; e < 4; ++e) a2[q * 4 + e] = __uint_as_float(__float_as_uint(v[e]) & ~127u); }
#pragma unroll
                for (int i = 0; i < 16; ++i) a1[i] = __uint_as_float(__float_as_uint(T[i]) & ~127u);
#define TK_SUM(i, j) __uint_as_float((__float_as_uint(a1[i] + a2[j]) & ~255u) | (unsigned)((i) * 16 + (j)))
                float R[16], C[16];
#pragma unroll
                for (int j = 0; j < 16; ++j) R[j] = TK_SUM(0, j);
#pragma unroll
                for (int i = 1; i < 16; ++i) C[i - 1] = TK_SUM(i, 0);
                C[15] = 0.f;
                merge16<15>(R, C);
                C[0] = TK_SUM(1, 1); C[1] = TK_SUM(1, 2); C[2] = TK_SUM(1, 3); C[3] = TK_SUM(1, 4); C[4] = TK_SUM(1, 5); C[5] = TK_SUM(1, 6); C[6] = TK_SUM(1, 7);
                C[7] = TK_SUM(2, 1); C[8] = TK_SUM(2, 2); C[9] = TK_SUM(2, 3); C[10] = TK_SUM(2, 4); C[11] = TK_SUM(3, 1); C[12] = TK_SUM(3, 2); C[13] = TK_SUM(3, 3);
                C[14] = TK_SUM(4, 1); C[15] = TK_SUM(4, 2);
                sort16_desc(C);
                merge16<16>(R, C);
                C[0] = TK_SUM(5, 1); C[1] = TK_SUM(6, 1); C[2] = TK_SUM(7, 1);
                merge16<3>(R, C);
#undef TK_SUM
                const int rowg = u.pm * BM + ai * HALF + row;
                const f32x4* ssp = (const f32x4*)(SS2 + (size_t)rowg * 16); const f32x4 s0 = ssp[0], s1 = ssp[1], s2 = ssp[2], s3 = ssp[3];
                const float ssum = ((s0[0] + s0[1]) + (s0[2] + s0[3])) + ((s1[0] + s1[1]) + (s1[2] + s1[3])) + ((s2[0] + s2[1]) + (s2[2] + s2[3])) + ((s3[0] + s3[1]) + (s3[2] + s3[3]));
                const float rl = 1.4426950408889634f / sqrtf(ssum * (1.0f / 1024.0f) + eps);
                float ev[16], esum = 0.f; int idv[16];
#pragma unroll
                for (int r = 0; r < 16; ++r) { ev[r] = __builtin_amdgcn_exp2f((R[r] - R[0]) * rl); esum += ev[r];
                    const unsigned code = __float_as_uint(R[r]) & 255u;
                    const unsigned k1 = __float_as_uint(S[tid * 16 + (code >> 4)]) & 127u, k2 = __float_as_uint(S[(tid + 256) * 16 + (code & 15u)]) & 127u;
                    idv[r] = (int)(k1 * 128u + k2); }
                const float inv = 1.0f / esum;
                unsigned short* ip = IDS + (size_t)rowg * 128 + u.pn * 16; float* gp = GATES + (size_t)rowg * 128 + u.pn * 16;
#pragma unroll
                for (int q = 0; q < 2; ++q) { u32x4 w; w.x = (unsigned)idv[q * 8] | ((unsigned)idv[q * 8 + 1] << 16); w.y = (unsigned)idv[q * 8 + 2] | ((unsigned)idv[q * 8 + 3] << 16); w.z = (unsigned)idv[q * 8 + 4] | ((unsigned)idv[q * 8 + 5] << 16); w.w = (unsigned)idv[q * 8 + 6] | ((unsigned)idv[q * 8 + 7] << 16);
                    *(u32x4*)(ip + q * 8) = w; }
#pragma unroll
                for (int q = 0; q < 4; ++q) *(f32x4*)(gp + q * 4) = (f32x4){ev[q * 4] * inv, ev[q * 4 + 1] * inv, ev[q * 4 + 2] * inv, ev[q * 4 + 3] * inv};
            }
            TK_BAR();
        }
#undef TK_BAR
    }
};
template <class Epi, class Sched, bool ALIGN_EPI = false, bool SP2 = false>
__device__ __forceinline__ void gemm_phase(PG8_LAS unsigned char* lds, const Gemm g, const Sched& S, const Epi& E) {
    const int tid = threadIdx.x, wid = __builtin_amdgcn_readfirstlane(tid >> 6), lane = tid & 63, wr = wid >> 2, wc = wid & 3, fr = lane & 15, fq = lane >> 4;
    const int K = g.K, nt = K / BK;
    unsigned voffA[2], voffB[2];
#pragma unroll
    for (int i = 0; i < 2; ++i) { int R, C; stage_rc(tid * 16 + i * 8192, R, C); const int Rb = Epi::PERM ? ((R & ~31) + perm32(R & 31)) : R;
        voffA[i] = (unsigned)(R * K + C) * 2u; voffB[i] = (unsigned)(Rb * K + C) * 2u; }
    const size_t kstep = (size_t)(BK * 2);
    const size_t hstep = (size_t)HALF * K * 2;
    const size_t tstep = 2 * hstep;
    const unsigned ldsw = (unsigned)wid * 1024u;
    const int aoff = lds_byte(wr * 64 + fr, fq * 8), boff = lds_byte(wc * 32 + fr, fq * 8);
#define PG8_SA(b, h) (((b) * 2 + (h)) * HTB)
#define PG8_SB(b, h) ((4 + (b) * 2 + (h)) * HTB)
#define PG8_STAGE(bufoff, gbase, voff) do { _Pragma("unroll") for (int _i = 0; _i < 2; ++_i) \
        __builtin_amdgcn_global_load_lds((const unsigned*)((const char*)(gbase) + (voff)[_i]), (PG8_LAS unsigned*)(lds + (bufoff) + ldsw + _i * 8192), 16, 0, 0); } while (0)
#define PG8_LDA(dst, b, h) do { _Pragma("unroll") for (int m = 0; m < 4; ++m) _Pragma("unroll") for (int k = 0; k < 2; ++k) dst[m][k] = *(const PG8_LAS bf16x8*)(lds + PG8_SA(b, h) + aoff + m * 2048 + k * 1024); } while (0)
#define PG8_LDB(dst, b, h) do { _Pragma("unroll") for (int n = 0; n < 2; ++n) _Pragma("unroll") for (int k = 0; k < 2; ++k) dst[n][k] = *(const PG8_LAS bf16x8*)(lds + PG8_SB(b, h) + boff + n * 2048 + k * 1024); } while (0)
#define PG8_MMA(ai, bj, At, Bt) do { __builtin_amdgcn_s_setprio(1); _Pragma("unroll") for (int m = 0; m < 4; ++m) _Pragma("unroll") for (int n = 0; n < 2; ++n) _Pragma("unroll") for (int k = 0; k < 2; ++k) \
        acc[ai][bj][m][n] = __builtin_amdgcn_mfma_f32_16x16x32_bf16(Bt[n][k], At[m][k], acc[ai][bj][m][n], 0, 0, 0); __builtin_amdgcn_s_setprio(0); } while (0)
#define PG8_WAIT_V(n) asm volatile("s_waitcnt vmcnt(" #n ")" ::: "memory")
#define PG8_WAIT_L(n) asm volatile("s_waitcnt lgkmcnt(" #n ")" ::: "memory")
#define PG8_BAR __builtin_amdgcn_s_barrier()
#define PG8_SCHED __builtin_amdgcn_sched_barrier(0)
    Unit cur, nxt; int ui = 0;
    if (!S.next(0, cur)) return;
    f32x4 acc[2][2][4][2];
#pragma unroll
    for (int a = 0; a < 2; ++a)
#pragma unroll
        for (int b = 0; b < 2; ++b)
#pragma unroll
            for (int m = 0; m < 4; ++m)
#pragma unroll
                for (int n = 0; n < 2; ++n) acc[a][b][m][n] = (f32x4){0.f, 0.f, 0.f, 0.f};
    bf16x8 At[4][2], B0[2][2], B1[2][2];
    const char* cA = (const char*)g.A + (size_t)cur.pm * tstep; const char* cB = (const char*)g.Bt + (size_t)cur.pn * tstep;
    S.a_ready(cur);
    if constexpr (SP2) {
        PG8_STAGE(PG8_SB(0, 0), cB, voffB); PG8_STAGE(PG8_SB(0, 1), cB + hstep, voffB); PG8_STAGE(PG8_SA(0, 0), cA, voffA); PG8_STAGE(PG8_SA(0, 1), cA + hstep, voffA);
        if (wr == 1) PG8_BAR;
        PG8_WAIT_V(2); PG8_BAR;
        PG8_STAGE(PG8_SB(1, 0), cB + kstep, voffB); PG8_STAGE(PG8_SA(1, 0), cA + kstep, voffA); PG8_STAGE(PG8_SB(1, 1), cB + hstep + kstep, voffB);
        PG8_WAIT_V(6); PG8_BAR;
    } else {
        PG8_STAGE(PG8_SB(0, 0), cB, voffB); PG8_STAGE(PG8_SA(0, 0), cA, voffA); PG8_STAGE(PG8_SB(0, 1), cB + hstep, voffB); PG8_STAGE(PG8_SA(0, 1), cA + hstep, voffA);
        if (wr == 1) PG8_BAR;
        PG8_WAIT_V(4); PG8_BAR;
        PG8_STAGE(PG8_SB(1, 0), cB + kstep, voffB); PG8_STAGE(PG8_SA(1, 0), cA + kstep, voffA); PG8_STAGE(PG8_SB(1, 1), cB + hstep + kstep, voffB);
        PG8_WAIT_V(6); PG8_BAR;
    }
    for (;;) {
        const bool has_next = S.next(ui + 1, nxt);
        const char* nA = has_next ? (const char*)g.A + (size_t)nxt.pm * tstep : cA; const char* nB = has_next ? (const char*)g.Bt + (size_t)nxt.pn * tstep : cB;
        for (int t = 0; t < nt; t += 2) {
            if constexpr (Epi::MID_T > 0) { if (t == Epi::MID_T) E.mid(acc, cur, wr, wc, fr, fq); }
            const bool last = (t == nt - 2);
            const char* a1 = cA + (size_t)(t + 1) * kstep;
            const char* a2 = last ? nA : cA + (size_t)(t + 2) * kstep; const char* b2 = last ? nB : cB + (size_t)(t + 2) * kstep;
            const char* a3 = a2 + kstep; const char* b3 = b2 + kstep;
            if (last && has_next) S.a_ready(nxt);
            if constexpr (SP2) {
            PG8_LDB(B0, 0, 0); PG8_LDB(B1, 0, 1); PG8_SCHED; PG8_LDA(At, 0, 0); PG8_STAGE(PG8_SA(1, 1), a1 + hstep, voffA);
            PG8_WAIT_V(8); PG8_WAIT_L(0); PG8_BAR; PG8_MMA(0, 0, At, B0); PG8_MMA(0, 1, At, B1); PG8_BAR; PG8_SCHED;
            PG8_LDA(At, 0, 1); PG8_STAGE(PG8_SB(0, 0), b2, voffB); PG8_STAGE(PG8_SB(0, 1), b2 + hstep, voffB); PG8_STAGE(PG8_SA(0, 0), a2, voffA);
            PG8_WAIT_V(8); PG8_WAIT_L(0); PG8_BAR; PG8_MMA(1, 0, At, B0); PG8_MMA(1, 1, At, B1); PG8_BAR; PG8_SCHED;
            PG8_LDB(B0, 1, 0); PG8_LDB(B1, 1, 1); PG8_SCHED; PG8_LDA(At, 1, 0); PG8_STAGE(PG8_SA(0, 1), a2 + hstep, voffA);
            PG8_WAIT_V(8); PG8_WAIT_L(0); PG8_BAR; PG8_MMA(0, 0, At, B0); PG8_MMA(0, 1, At, B1); PG8_BAR; PG8_SCHED;
            PG8_LDA(At, 1, 1); PG8_STAGE(PG8_SB(1, 0), b3, voffB); PG8_STAGE(PG8_SB(1, 1), b3 + hstep, voffB); PG8_STAGE(PG8_SA(1, 0), a3, voffA);
            PG8_WAIT_V(8); PG8_WAIT_L(0); PG8_BAR; PG8_MMA(1, 0, At, B0); PG8_MMA(1, 1, At, B1); PG8_BAR; PG8_SCHED;
            } else {
            PG8_LDB(B0, 0, 0); PG8_SCHED; PG8_LDA(At, 0, 0); PG8_STAGE(PG8_SA(1, 1), a1 + hstep, voffA);
            PG8_WAIT_L(8); PG8_BAR; PG8_WAIT_L(0); PG8_MMA(0, 0, At, B0); PG8_BAR; PG8_SCHED;
            PG8_LDB(B1, 0, 1); PG8_STAGE(PG8_SB(0, 0), b2, voffB);
            PG8_BAR; PG8_WAIT_L(0); PG8_MMA(0, 1, At, B1); PG8_BAR;
            PG8_LDA(At, 0, 1); PG8_STAGE(PG8_SA(0, 0), a2, voffA);
            PG8_BAR; PG8_WAIT_L(0); PG8_MMA(1, 0, At, B0); PG8_BAR; PG8_SCHED;
            PG8_STAGE(PG8_SB(0, 1), b2 + hstep, voffB);
            PG8_WAIT_V(6); PG8_BAR; PG8_MMA(1, 1, At, B1); PG8_BAR;
            PG8_LDB(B0, 1, 0); PG8_SCHED; PG8_LDA(At, 1, 0); PG8_STAGE(PG8_SA(0, 1), a2 + hstep, voffA);
            PG8_WAIT_L(8); PG8_BAR; PG8_WAIT_L(0); PG8_MMA(0, 0, At, B0); PG8_BAR; PG8_SCHED;
            PG8_LDB(B1, 1, 1); PG8_STAGE(PG8_SB(1, 0), b3, voffB);
            PG8_BAR; PG8_WAIT_L(0); PG8_MMA(0, 1, At, B1); PG8_BAR;
            PG8_LDA(At, 1, 1); PG8_STAGE(PG8_SA(1, 0), a3, voffA);
            PG8_BAR; PG8_WAIT_L(0); PG8_MMA(1, 0, At, B0); PG8_BAR; PG8_SCHED;
            PG8_STAGE(PG8_SB(1, 1), b3 + hstep, voffB);
            PG8_WAIT_V(6); PG8_BAR; PG8_MMA(1, 1, At, B1); PG8_BAR;
            }
        }
        if constexpr (ALIGN_EPI) { if (wr == 0) PG8_BAR; }
#ifdef MK_PROBE_EPI2
        if constexpr (!Epi::AFTER_DRAIN && Epi::PROBE_ID == MK_PROBE_EPI_ID) { for (int rep_ = 1; rep_ < MK_PROBE_EPI2; ++rep_) E(acc, cur, wr, wc, fr, fq); }
#endif
        if constexpr (!Epi::AFTER_DRAIN) { E(acc, cur, wr, wc, fr, fq); S.done(cur); }
        if (!has_next) break;
#pragma unroll
        for (int a = 0; a < 2; ++a)
#pragma unroll
            for (int b = 0; b < 2; ++b)
#pragma unroll
                for (int m = 0; m < 4; ++m)
#pragma unroll
                    for (int n = 0; n < 2; ++n) acc[a][b][m][n] = (f32x4){0.f, 0.f, 0.f, 0.f};
        cur = nxt; cA = nA; cB = nB; ++ui;
        if constexpr (ALIGN_EPI) { if (wr == 1) PG8_BAR; }
    }
    PG8_WAIT_V(0);
    if constexpr (!ALIGN_EPI) { if (wr == 0) PG8_BAR; }
    PG8_BAR;
    if constexpr (Epi::AFTER_DRAIN) { E.fused(acc, cur, wr, wc, fr, fq, lds, wid, lane); S.done(cur); }
#undef PG8_SA
#undef PG8_SB
#undef PG8_STAGE
#undef PG8_LDA
#undef PG8_LDB
#undef PG8_MMA
#undef PG8_WAIT_V
#undef PG8_WAIT_L
#undef PG8_BAR
#undef PG8_SCHED
}
}
#ifndef PG8_SP2
#define PG8_SP2 true
#endif
#ifndef PG8_ALIGN
#define PG8_ALIGN true
#endif
namespace attn_body {
using bf16=__hip_bfloat16;
using bf16x8=__attribute__((ext_vector_type(8)))short;
using s16x4=__attribute__((ext_vector_type(4)))short;
using f32x16=__attribute__((ext_vector_type(16)))float;
using u32x4=__attribute__((ext_vector_type(4)))unsigned;
using f32x4v=__attribute__((ext_vector_type(4)))float;
constexpr int BATCH=4,NHEAD=8,SEQ=4096,D=64,DM=NHEAD*D,DMO=1024;
constexpr int NW=8,QBLK=32,QB=QBLK*NW,KVBLK=64,NQB=SEQ/QB;
constexpr int ATTN_PITCH=DM, ATTN_UNIT_ROWS=QB;
__device__ __forceinline__ int crow(int r,int hi){return (r&3)+8*(r>>2)+4*hi;}
#define SBAR() __builtin_amdgcn_sched_barrier(0)
__device__ __forceinline__ void cmask(f32x16&p0,f32x16&p1,int jb,int qrel,int hi){
  const float NEG=-INFINITY; int kb=64*jb+4*hi;
  #pragma unroll
  for(int r=0;r<16;++r){int kv=kb+(r&3)+8*(r>>2); if(kv>qrel)p0[r]=NEG; if(kv+32>qrel)p1[r]=NEG;}
}

constexpr int NSLOT=3, SLOTB=8192;
constexpr float SKIP_TH=64.0f;
constexpr int LDS_K=0, LDS_V=NSLOT*SLOTB, LDS_WS=2*NSLOT*SLOTB, LDS_OST=LDS_WS+NW*64*4, LDS_CS=LDS_OST+NW*4096, LDS_BYTES=LDS_CS+SEQ*4+64;
constexpr float C2=0.125f*1.4426950408889634f;
__device__ __forceinline__ void glds16(const void*gsrc,unsigned lds_dst){unsigned keep;
  asm volatile("s_mov_b32 %0, m0\n\ts_mov_b32 m0, %2\n\ts_nop 0\n\tglobal_load_lds_dwordx4 %1, off\n\ts_mov_b32 m0, %0":"=&s"(keep):"v"(gsrc),"s"(lds_dst):"memory");}
__device__ __forceinline__ float max3f(float a,float b,float c){float r;asm("v_max3_f32 %0, %1, %2, %3":"=v"(r):"v"(a),"v"(b),"v"(c));return r;}
__device__ __forceinline__ float max2f(float a,float b){float r;asm("v_max_f32_e32 %0, %1, %2":"=v"(r):"v"(a),"v"(b));return r;}
__device__ __forceinline__ float fadd_s(float a,float b){float r;asm("v_add_f32_e32 %0, %1, %2":"=v"(r):"v"(a),"v"(b));return r;}
__device__ __forceinline__ float fsub_s(float a,float b){float r;asm("v_sub_f32_e32 %0, %1, %2":"=v"(r):"v"(a),"v"(b));return r;}
typedef float f32x2_t __attribute__((ext_vector_type(2))); typedef __bf16 bf16x2_t __attribute__((ext_vector_type(2)));
__device__ __forceinline__ unsigned cvtpk_s(float lo,float hi){f32x2_t v={lo,hi};bf16x2_t b=__builtin_convertvector(v,bf16x2_t);return __builtin_bit_cast(unsigned,b);}
#define WAIT_BAR(N) asm volatile("s_waitcnt vmcnt(" #N ") lgkmcnt(0)\n\ts_barrier":::"memory")

__device__ __forceinline__ void qkt(f32x16&p0,f32x16&p1,const char*Kslot,const bf16x8*qr,const f32x16&c0,const f32x16&c1,int r32,int hi){
  const char*kb=Kslot+hi*1024+r32*16;
  #pragma unroll
  for(int d0=0;d0<4;++d0){
    const bf16x8 b0=*reinterpret_cast<const bf16x8*>(kb+d0*2048);
    const bf16x8 b1=*reinterpret_cast<const bf16x8*>(kb+d0*2048+512);
    if(d0==0){p0=__builtin_amdgcn_mfma_f32_32x32x16_bf16(b0,qr[0],c0,0,0,0);p1=__builtin_amdgcn_mfma_f32_32x32x16_bf16(b1,qr[0],c1,0,0,0);}
    else{p0=__builtin_amdgcn_mfma_f32_32x32x16_bf16(b0,qr[d0],p0,0,0,0);p1=__builtin_amdgcn_mfma_f32_32x32x16_bf16(b1,qr[d0],p1,0,0,0);}}
}
typedef __attribute__((address_space(3))) const char* lds_cptr;
typedef short v4i16_t __attribute__((ext_vector_type(4)));
__device__ __forceinline__ void kload8(bf16x8*kf,lds_cptr kp){
  kf[0]=*(const __attribute__((address_space(3))) bf16x8*)(kp);      kf[1]=*(const __attribute__((address_space(3))) bf16x8*)(kp+512);
  kf[2]=*(const __attribute__((address_space(3))) bf16x8*)(kp+2048); kf[3]=*(const __attribute__((address_space(3))) bf16x8*)(kp+2560);
  kf[4]=*(const __attribute__((address_space(3))) bf16x8*)(kp+4096); kf[5]=*(const __attribute__((address_space(3))) bf16x8*)(kp+4608);
  kf[6]=*(const __attribute__((address_space(3))) bf16x8*)(kp+6144); kf[7]=*(const __attribute__((address_space(3))) bf16x8*)(kp+6656);
}
__device__ __forceinline__ void kload2(bf16x8*kf,lds_cptr kp,int j){ kf[2*j]=*(const __attribute__((address_space(3))) bf16x8*)(kp+j*2048); kf[2*j+1]=*(const __attribute__((address_space(3))) bf16x8*)(kp+j*2048+512); }
__device__ __forceinline__ s16x4 vtr(lds_cptr p){ return __builtin_bit_cast(s16x4,__builtin_amdgcn_ds_read_tr16_b64_v4i16((__attribute__((address_space(3))) v4i16_t*)p)); }
__device__ __forceinline__ float rowmax(const f32x16&p0,const f32x16&p1){
  float a=max3f(p0[0],p0[1],p1[0]),b=max3f(p0[2],p0[3],p1[1]);a=max3f(a,p1[2],p1[3]);
  #pragma unroll
  for(int r=4;r<16;r+=4){a=max3f(a,p0[r],p0[r+1]);b=max3f(b,p0[r+2],p0[r+3]);a=max3f(a,p1[r],p1[r+1]);b=max3f(b,p1[r+2],p1[r+3]);}
  const float m=max2f(a,b);
  auto rr=__builtin_amdgcn_permlane32_swap(__float_as_uint(m),__float_as_uint(m),false,false);
  return max2f(__uint_as_float(rr[0]),__uint_as_float(rr[1]));
}
__device__ __forceinline__ void pv(f32x16*o,int vb,bf16x8 pa0,bf16x8 pa1,bf16x8 pa2,bf16x8 pa3){
  #pragma unroll
  for(int d0=0;d0<2;++d0){s16x4 lo[4],hi[4];
    #pragma unroll
    for(int ks=0;ks<4;++ks){
      asm volatile("ds_read_b64_tr_b16 %0,%1 offset:%c2":"=&v"(lo[ks]):"v"(vb),"i"(d0*4096+ks*1024):"memory");
      asm volatile("ds_read_b64_tr_b16 %0,%1 offset:%c2":"=&v"(hi[ks]):"v"(vb),"i"(d0*4096+ks*1024+512):"memory");}
    asm volatile("s_waitcnt lgkmcnt(0)":::"memory");SBAR();
    #define PK(k) (bf16x8){lo[k][0],lo[k][1],lo[k][2],lo[k][3],hi[k][0],hi[k][1],hi[k][2],hi[k][3]}
    o[d0]=__builtin_amdgcn_mfma_f32_32x32x16_bf16(pa0,PK(0),o[d0],0,0,0);
    o[d0]=__builtin_amdgcn_mfma_f32_32x32x16_bf16(pa1,PK(1),o[d0],0,0,0);
    o[d0]=__builtin_amdgcn_mfma_f32_32x32x16_bf16(pa2,PK(2),o[d0],0,0,0);
    o[d0]=__builtin_amdgcn_mfma_f32_32x32x16_bf16(pa3,PK(3),o[d0],0,0,0);
    #undef PK
  }
}

#ifndef ATTN_STORE16
#define ATTN_STORE16(p,v) (*(u32x4*)(p)=(v))
#endif
template<int THRL> __device__ __forceinline__ void attn_unit(int b,int h,int qb,const bf16*Q,const bf16*__restrict__ K,const bf16*__restrict__ V,bf16*O,const float*__restrict__ LFrow,char*shm){
  int tid_l=threadIdx.x; asm volatile("":"+v"(tid_l));
  const int tid=tid_l,lane=tid&63,r32=lane&31,hi=lane>>5; const int wid=__builtin_amdgcn_readfirstlane(tid>>6);
  const long rowbase=(long)b*SEQ; const int q0=qb*QB;
  const lds_cptr shm3=(lds_cptr)shm;
  typedef __attribute__((address_space(3))) float lds_f32; typedef __attribute__((address_space(3))) f32x4v lds_f32x4;
  lds_f32* const csl=(lds_f32*)(shm3+LDS_CS);
  { const int ncs=q0+QB, i0=tid*8; f32x4v ca={0.f,0.f,0.f,0.f},cb={0.f,0.f,0.f,0.f};
    if(i0<ncs){ca=*(const f32x4v*)(LFrow+i0);cb=*(const f32x4v*)(LFrow+i0+4);}
    ca.y+=ca.x;ca.z+=ca.y;ca.w+=ca.z;cb.x+=ca.w;cb.y+=cb.x;cb.z+=cb.y;cb.w+=cb.z;
    const float tot=cb.w; float inc=tot;
    _Pragma("unroll") for(int o_=1;o_<64;o_<<=1){const float v_=__shfl_up(inc,o_);if(lane>=o_)inc+=v_;}
    if(lane==63)csl[SEQ+wid]=inc;
    asm volatile("s_waitcnt vmcnt(0) lgkmcnt(0)\n\ts_barrier":::"memory");
    float base_=inc-tot;
    _Pragma("unroll") for(int w_=0;w_<NW;++w_){const float t_=csl[SEQ+w_];if(w_<wid)base_+=t_;}
    if(i0<ncs){*(lds_f32x4*)(csl+i0)=ca+base_;*(lds_f32x4*)(csl+i0+4)=cb+base_;}
    asm volatile("s_waitcnt vmcnt(0) lgkmcnt(0)\n\ts_barrier":::"memory"); }
  int ts; { const int NT0=(q0+QB)/KVBLK, cand=2*lane; bool ok=false;
    if(lane<32&&cand<=NT0-4) ok=(cand==0)||(csl[q0]-csl[64*cand-1]<=-SKIP_TH);
    const unsigned long long mk=__ballot(ok); ts=__builtin_amdgcn_readfirstlane(2*(63-__builtin_clzll(mk|1ull))); }
  const bf16*Qw=Q+(rowbase+q0+wid*QBLK)*DM+h*D;
  const bf16*Kh=K+(rowbase+(long)ts*KVBLK)*DM+h*D,*Vh=V+(rowbase+(long)ts*KVBLK)*DM+h*D;
  const unsigned lds0=(unsigned)(uintptr_t)shm;
  float*wsf=(float*)(shm+LDS_WS)+wid*64;
  const bf16*ksrc=Kh+(long)lane*DM+wid*8;
  const bf16*vsrc=Vh+(long)(16*(wid&3)+(lane>>2))*DM+(wid>>2)*32+(lane&3)*8;
  const unsigned kdst=lds0+LDS_K+wid*1024, vdst=lds0+LDS_V+wid*1024;
  #define DMA_K(t,slot) glds16(ksrc+(long)(t)*KVBLK*DM,(unsigned)__builtin_amdgcn_readfirstlane(kdst+(slot)))
  #define DMA_V(t,slot) glds16(vsrc+(long)(t)*KVBLK*DM,(unsigned)__builtin_amdgcn_readfirstlane(vdst+(slot)))
  const int vb0=(int)(lds0+LDS_V)+((lane>>4)&1)*32+(lane&3)*8+(4*hi+((lane&15)>>2))*64;
  const char*Kbase=shm+LDS_K; bf16x8 kf[8];
  const lds_cptr kp0=shm3+LDS_K+hi*1024+r32*16; const lds_cptr vp0=shm3+LDS_V+((lane>>4)&1)*32+(lane&3)*8+(4*hi+((lane&15)>>2))*64;
  const int NT=(q0+QB)/KVBLK-ts;
  const float cq=csl[q0+wid*QBLK+r32];
  const lds_cptr csb=shm3+LDS_CS+hi*16+ts*256;
  #define CINIT(C0,C1,t) do{ _Pragma("unroll") for(int g_=0;g_<4;++g_){ const f32x4v a_=*(const lds_f32x4*)(csb+(t)*256+g_*32), b_=*(const lds_f32x4*)(csb+(t)*256+128+g_*32); \
      C0[4*g_]=cqm-a_.x;C0[4*g_+1]=cqm-a_.y;C0[4*g_+2]=cqm-a_.z;C0[4*g_+3]=cqm-a_.w; C1[4*g_]=cqm-b_.x;C1[4*g_+1]=cqm-b_.y;C1[4*g_+2]=cqm-b_.z;C1[4*g_+3]=cqm-b_.w; } }while(0)
  DMA_K(0,0);DMA_V(0,0);DMA_K(1,SLOTB);
  bf16x8 qr[4];
  #pragma unroll
  for(int d0=0;d0<4;++d0)qr[d0]=*reinterpret_cast<const bf16x8*>(&Qw[(long)r32*DM+d0*16+hi*8]);
  float mhat=0.f,l_reg=0.f,cqm=cq;f32x16 o[2];o[0]=f32x16{};o[1]=f32x16{};
  const int qrel=wid*QBLK+r32;
  #define CMASK(P0,P1,t) do{int jb_=(t)-(NT-4); if(jb_>=0)cmask(P0,P1,jb_,qrel,hi);}while(0)
  bool resc=false;
  #define START(P0,P1) do{ const float rm=rowmax(P0,P1); resc=false; \
    { const float dl=rm; mhat=fadd_s(mhat,dl); \
      _Pragma("unroll") for(int r=0;r<16;++r){P0[r]=fsub_s(P0[r],dl);P1[r]=fsub_s(P1[r],dl);} \
      cqm=cq-mhat; } \
    _Pragma("unroll") for(int r=0;r<16;++r)P0[r]=__builtin_amdgcn_exp2f(P0[r]); }while(0)
  #define RESC() do{ if(resc){ asm volatile("s_waitcnt lgkmcnt(0)":::"memory"); \
      _Pragma("unroll") for(int d_=0;d_<2;++d_) _Pragma("unroll") for(int r=0;r<16;++r)o[d_][r]*=wsf[crow(r,hi)]; } }while(0)
  f32x16 pA0,pA1,pB0,pB1;
  int sl_prev=0,sl_cur=0,sl_next=SLOTB;
  #define ROT() do{sl_prev=sl_cur;sl_cur=sl_next;sl_next=(sl_next==(NSLOT-1)*SLOTB)?0:sl_next+SLOTB;}while(0)
  DMA_K(2,2*SLOTB);
  WAIT_BAR(3);
  { f32x16 ci0,ci1; CINIT(ci0,ci1,0); qkt(pA0,pA1,Kbase,qr,ci0,ci1,r32,hi); } asm volatile("s_nop 15\n\ts_nop 7":"+v"(pA0),"+v"(pA1));CMASK(pA0,pA1,0);
  START(pA0,pA1);
  _Pragma("unroll") for(int r=0;r<16;++r)pA1[r]=__builtin_amdgcn_exp2f(pA1[r]);
  WAIT_BAR(0);
  DMA_K(3,0);DMA_V(1,SLOTB);
  ROT();
  kload8(kf,kp0+sl_cur);
  WAIT_BAR(2);
  s16x4 vlo[8],vhi[8]; u32x4 pw0,pw1,pw2,pw3;
  #define PKW(P,B) cvtpk_s(P[B],P[B+1])
  #define PAF(k) __builtin_bit_cast(bf16x8,pw##k)
  #define VFR(i) (bf16x8){vlo[i][0],vlo[i][1],vlo[i][2],vlo[i][3],vhi[i][0],vhi[i][1],vhi[i][2],vhi[i][3]}
  #define PIN(x) asm volatile("":"+v"(x))
  #define MX3(a,b,c) __builtin_fmaxf(__builtin_fmaxf((a),(b)),(c))
  #define GAPA(MF,A0,A1,A2,A3,W0,W1,PW) do{ MF; sacc+=A0; sacc+=A1; sacc+=A2; sacc+=A3; PIN(sacc); W0; W1; PIN(PW); SBAR(); }while(0)
  #define EX(v) __builtin_amdgcn_exp2f(v)
  #define GAPB(MF,X,B) do{ MF; X[B]=EX(X[B]); X[B+1]=EX(X[B+1]); X[B+2]=EX(X[B+2]); X[B+3]=EX(X[B+3]); PIN(X); SBAR(); }while(0)
  #define VRD(i) do{ vlo[i]=vtr(vp_+(((i)>>2)*4096+((i)&3)*1024)); vhi[i]=vtr(vp_+(((i)>>2)*4096+((i)&3)*1024+512)); }while(0)
  #define KRD(G,j) do{ if(G){ kload2(kf,kp0+sl_next,j); SBAR(); } }while(0)
  #define STEP(C0,C1,P0,P1,t,GK,GV,GL) do{ SBAR(); \
    CINIT(C0,C1,t); SBAR(); \
    const lds_cptr vp_=vp0+sl_prev; \
    VRD(0); SBAR(); float sacc=(P0[0]+P0[1]); \
    GAPA(C0=__builtin_amdgcn_mfma_f32_32x32x16_bf16(kf[0],qr[0],C0,0,0,0), P0[2],P0[3],P0[4],P0[5],     pw0[0]=PKW(P0,0), pw0[1]=PKW(P0,2), pw0); \
    VRD(4); SBAR(); GAPA(C1=__builtin_amdgcn_mfma_f32_32x32x16_bf16(kf[1],qr[0],C1,0,0,0), P0[6],P0[7],P0[8],P0[9],     pw0[2]=PKW(P0,4), pw0[3]=PKW(P0,6), pw0); \
    VRD(1); SBAR(); GAPA(C0=__builtin_amdgcn_mfma_f32_32x32x16_bf16(kf[2],qr[1],C0,0,0,0),   P0[10],P0[11],P0[12],P0[13], pw1[0]=PKW(P0,8), pw1[1]=PKW(P0,10), pw1); \
    VRD(5); SBAR(); GAPA(C1=__builtin_amdgcn_mfma_f32_32x32x16_bf16(kf[3],qr[1],C1,0,0,0),   P0[14],P0[15],P1[0],P1[1],   pw1[2]=PKW(P0,12),pw1[3]=PKW(P0,14), pw1); \
    VRD(2); SBAR(); GAPA(C0=__builtin_amdgcn_mfma_f32_32x32x16_bf16(kf[4],qr[2],C0,0,0,0),   P1[2],P1[3],P1[4],P1[5],     pw2[0]=PKW(P1,0), pw2[1]=PKW(P1,2), pw2); \
    VRD(6); SBAR(); GAPA(C1=__builtin_amdgcn_mfma_f32_32x32x16_bf16(kf[5],qr[2],C1,0,0,0),   P1[6],P1[7],P1[8],P1[9],     pw2[2]=PKW(P1,4), pw2[3]=PKW(P1,6), pw2); \
    VRD(3); SBAR(); GAPA(C0=__builtin_amdgcn_mfma_f32_32x32x16_bf16(kf[6],qr[3],C0,0,0,0),   P1[10],P1[11],P1[12],P1[13], pw3[0]=PKW(P1,8), pw3[1]=PKW(P1,10), pw3); \
    VRD(7); SBAR(); GAPA(C1=__builtin_amdgcn_mfma_f32_32x32x16_bf16(kf[7],qr[3],C1,0,0,0),   P1[14],P1[15],0.f,0.f,       pw3[2]=PKW(P1,12),pw3[3]=PKW(P1,14), pw3); \
    l_reg+=sacc; \
    if(GK){DMA_K((t)+3,sl_cur);} if(GV){DMA_V((t)+1,sl_next);} \
    CMASK(C0,C1,t); \
    { float a=MX3(C0[0],C0[1],C1[0]),b=MX3(C0[2],C0[3],C1[1]); a=MX3(a,C1[2],C1[3]); \
      _Pragma("unroll") for(int r=4;r<16;r+=4){a=MX3(a,C0[r],C0[r+1]);b=MX3(b,C0[r+2],C0[r+3]);a=MX3(a,C1[r],C1[r+1]);b=MX3(b,C1[r+2],C1[r+3]);} \
      float rm=__builtin_fmaxf(a,b); { auto rr=__builtin_amdgcn_permlane32_swap(__float_as_uint(rm),__float_as_uint(rm),false,false); rm=__builtin_fmaxf(__uint_as_float(rr[0]),__uint_as_float(rr[1])); } \
      resc=false; \
      if(__builtin_expect(__any(rm>(float)THRL),0)){ const float dl=__builtin_fmaxf(rm,0.f); mhat+=dl; \
        _Pragma("unroll") for(int r=0;r<16;++r){C0[r]-=dl;C1[r]-=dl;} \
        cqm=cq-mhat; \
        const float f=__builtin_amdgcn_exp2f(-dl); l_reg*=f; if(hi==0)wsf[r32]=f; resc=true; } } \
    SBAR(); \
    GAPB(o[0]=__builtin_amdgcn_mfma_f32_32x32x16_bf16(PAF(0),VFR(0),o[0],0,0,0), C0,0); \
    GAPB(o[1]=__builtin_amdgcn_mfma_f32_32x32x16_bf16(PAF(0),VFR(4),o[1],0,0,0), C0,4); \
    KRD(GL,0); GAPB(o[0]=__builtin_amdgcn_mfma_f32_32x32x16_bf16(PAF(1),VFR(1),o[0],0,0,0), C0,8); \
    KRD(GL,1); GAPB(o[1]=__builtin_amdgcn_mfma_f32_32x32x16_bf16(PAF(1),VFR(5),o[1],0,0,0), C0,12); \
    KRD(GL,2); GAPB(o[0]=__builtin_amdgcn_mfma_f32_32x32x16_bf16(PAF(2),VFR(2),o[0],0,0,0), C1,0); \
    KRD(GL,3); GAPB(o[1]=__builtin_amdgcn_mfma_f32_32x32x16_bf16(PAF(2),VFR(6),o[1],0,0,0), C1,4); \
    GAPB(o[0]=__builtin_amdgcn_mfma_f32_32x32x16_bf16(PAF(3),VFR(3),o[0],0,0,0), C1,8); \
    GAPB(o[1]=__builtin_amdgcn_mfma_f32_32x32x16_bf16(PAF(3),VFR(7),o[1],0,0,0), C1,12); \
    }while(0)
  int t=1;
  #undef CMASK
  #define CMASK(P0,P1,t) do{}while(0)
  for(;t+5<NT;t+=2){
    STEP(pB0,pB1,pA0,pA1,t,true,true,true);     WAIT_BAR(2); RESC(); ROT();
    STEP(pA0,pA1,pB0,pB1,t+1,true,true,true);   WAIT_BAR(2); RESC(); ROT();
  }
  #undef CMASK
  #define CMASK(P0,P1,t) do{int jb_=(t)-(NT-4); if(jb_>=0)cmask(P0,P1,jb_,qrel,hi);}while(0)
  #define ENDW(tt) do{ if((tt)+3<NT){WAIT_BAR(2);} else if((tt)+2<NT){WAIT_BAR(1);} else {WAIT_BAR(0);} }while(0)
  for(;t+1<NT;t+=2){
    STEP(pB0,pB1,pA0,pA1,t,(t+3<NT),(t+1<NT),(t+1<NT));       ENDW(t);   RESC(); ROT();
    STEP(pA0,pA1,pB0,pB1,t+1,(t+4<NT),(t+2<NT),(t+2<NT));     ENDW(t+1); RESC(); ROT();
  }
  STEP(pB0,pB1,pA0,pA1,NT-1,false,false,false); RESC();
  { float sacc=pB0[0]+pB0[1]; _Pragma("unroll") for(int r=2;r<16;++r)sacc+=pB0[r]; _Pragma("unroll") for(int r=0;r<16;++r)sacc+=pB1[r]; l_reg+=sacc;
    pw0=(u32x4){PKW(pB0,0),PKW(pB0,2),PKW(pB0,4),PKW(pB0,6)};pw1=(u32x4){PKW(pB0,8),PKW(pB0,10),PKW(pB0,12),PKW(pB0,14)};pw2=(u32x4){PKW(pB1,0),PKW(pB1,2),PKW(pB1,4),PKW(pB1,6)};pw3=(u32x4){PKW(pB1,8),PKW(pB1,10),PKW(pB1,12),PKW(pB1,14)};
    SBAR(); pv(o,vb0+sl_cur,PAF(0),PAF(1),PAF(2),PAF(3)); }
  #undef PKW
  #undef PAF
  #undef VFR
  #undef PIN
  #undef MX3
  #undef GAPA
  #undef GAPB
  #undef EX
  #undef VRD
  #undef KRD
  #undef STEP
  #undef ENDW
  {auto rr=__builtin_amdgcn_permlane32_swap(__float_as_uint(l_reg),__float_as_uint(l_reg),false,false);l_reg=__uint_as_float(rr[0])+__uint_as_float(rr[1]);}
  if(hi==0)wsf[32+r32]=l_reg;asm volatile("s_waitcnt lgkmcnt(0)":::"memory");
  float rli[16];
  #pragma unroll
  for(int r=0;r<16;++r)rli[r]=__builtin_amdgcn_rcpf(wsf[32+crow(r,hi)]);
  bf16*Ow=O+(rowbase+q0+wid*QBLK)*DMO+h*D;
  { bf16*stg=(bf16*)(shm+LDS_OST)+wid*2048;
    #pragma unroll
    for(int r=0;r<16;++r){const int orow=crow(r,hi);
      #pragma unroll
      for(int d0=0;d0<2;++d0)stg[orow*64+d0*32+r32]=__float2bfloat16(o[d0][r]*rli[r]);}
    asm volatile("s_waitcnt lgkmcnt(0)":::"memory");
    #pragma unroll
    for(int i=0;i<4;++i){const int row=i*8+(lane>>3),ch=lane&7; const u32x4 v=*(const u32x4*)(stg+row*64+ch*8); ATTN_STORE16(Ow+(long)row*DMO+ch*8,v);} }
  asm volatile("s_waitcnt lgkmcnt(0)\n\ts_barrier":::"memory");
  #undef DMA_K
  #undef DMA_V
  #undef CMASK
  #undef START
  #undef RESC
  #undef ROT
  #undef CINIT
}
constexpr int ATTN_LDS_BYTES=LDS_BYTES;
struct AttnTensors { const bf16* Q; const bf16* K; const bf16* V; bf16* O; const float* LF; };
struct AttnUnit { int bh; int qb; };
struct StaticOrder {
  int vcu, G;
  __device__ __forceinline__ StaticOrder(int grid,int vcu_):vcu(vcu_),G(grid){}
  __device__ __forceinline__ bool next(int i,AttnUnit&u)const{
    if(G==256){ if(i>=2)return false; const int s=vcu&7; u.bh=vcu>>3; u.qb=(i==0)?15-s:s; return true; }
    const int idx=i*G+vcu; if(idx>=BATCH*NHEAD*NQB)return false; u.qb=NQB-1-idx/(BATCH*NHEAD); u.bh=idx%(BATCH*NHEAD); return true; }
  __device__ __forceinline__ void a_ready(const AttnUnit&)const{}
  __device__ __forceinline__ void done(const AttnUnit&)const{}
};
template<class Sched,int THRL=8> __device__ __forceinline__ void attn_phase(char*lds,const AttnTensors&T,const Sched&S){
  AttnUnit u;
  for(int i=0;S.next(i,u);++i){ S.a_ready(u); attn_unit<THRL>(u.bh/NHEAD,u.bh%NHEAD,u.qb,T.Q,T.K,T.V,T.O,T.LF+(size_t)u.bh*SEQ,lds); S.done(u); }
}
#undef SBAR
#undef WAIT_BAR
}
#define GAS __attribute__((address_space(1)))
#define LAS __attribute__((address_space(3)))
typedef unsigned short bf16;
typedef unsigned v4u __attribute__((ext_vector_type(4)));
typedef float f32x4 __attribute__((ext_vector_type(4)));
typedef short bf16x8 __attribute__((ext_vector_type(8)));
typedef GAS unsigned gu32;
typedef GAS unsigned long long gu64;
#define RLX_AGENT __ATOMIC_RELAXED, __HIP_MEMORY_SCOPE_AGENT
#define LDS_WAIT() asm volatile("s_waitcnt lgkmcnt(0)" ::: "memory")
#define VM_WAIT() asm volatile("s_waitcnt vmcnt(0)" ::: "memory")
__device__ __forceinline__ unsigned long long rt() { return __builtin_amdgcn_s_memrealtime(); }
__device__ __forceinline__ unsigned f2bf(float f) { unsigned u = __builtin_bit_cast(unsigned, f); return (u + 0x7fffu + ((u >> 16) & 1u)) >> 16; }
__device__ __forceinline__ unsigned pk2(float lo, float hi) { return f2bf(lo) | (f2bf(hi) << 16); }

#define XB_TMO      128
#define XB_XCNT(j)  (256  + 64 * (j))
#define XB_XSUB(j)  (1280 + 64 * (j))
#define XB_XGEN(j)  (2304 + 64 * (j))
#define XB_TOP      3328
#define XB_TOPGEN   3392
#define XCD_BAR_WORDS 3456
#define XB_SPIN_CAP (1u << 18)

__device__ __forceinline__ unsigned xb_ld(unsigned* p)              { return __hip_atomic_load(p, __ATOMIC_RELAXED, __HIP_MEMORY_SCOPE_AGENT); }
__device__ __forceinline__ unsigned xb_add(unsigned* p, unsigned v) { return __hip_atomic_fetch_add(p, v, __ATOMIC_RELAXED, __HIP_MEMORY_SCOPE_AGENT); }
__device__ __forceinline__ unsigned xb_xcc_id() { return (unsigned)__builtin_amdgcn_s_getreg((3 << 11) | 20) & 0xFu; }
#define XB_SPIN(cond, bar) do { unsigned _sp = 0; while (cond) { __builtin_amdgcn_s_sleep(1); \
    if ((++_sp & 255u) == 0u) { if (xb_ld(&(bar)[XB_TMO])) break; if (_sp > XB_SPIN_CAP) { atomicAdd(&(bar)[XB_TMO], 1u); break; } } } } while (0)

struct XcdBarrier {
    unsigned* bar; unsigned x;
    volatile LAS unsigned* st;
};

__device__ __forceinline__ XcdBarrier xcd_barrier_post(unsigned* bar, volatile LAS unsigned* st) {
    XcdBarrier b; b.bar = bar; b.x = xb_xcc_id(); b.st = st;
    if (threadIdx.x == 0) (void)xb_add(&bar[XB_XCNT(b.x)], 1u);
    return b;
}
__device__ __forceinline__ void xcd_barrier_complete(unsigned* bar, unsigned x, unsigned& nloc, unsigned& nx) {
    const unsigned G = gridDim.x * gridDim.y * gridDim.z;
    unsigned sum, cnt, mine, sp = 0u;
    for (;;) {
        sum = 0u; cnt = 0u; mine = 0u;
#pragma unroll
        for (unsigned j = 0; j < 16; ++j) { const unsigned c = xb_ld(&bar[XB_XCNT(j)]); sum += c; cnt += (c > 0u) ? 1u : 0u; mine = (j == x) ? c : mine; }
        if (sum == G) break;
        __builtin_amdgcn_s_sleep(1);
        if ((++sp & 255u) == 0u) { if (xb_ld(&bar[XB_TMO])) break; if (sp > XB_SPIN_CAP) { atomicAdd(&bar[XB_TMO], 1u); break; } }
    }
    nloc = mine > 0u ? mine : 1u; nx = cnt > 0u ? cnt : 1u;
}

__device__ __forceinline__ void xcd_barrier(const XcdBarrier& b) {
    asm volatile("s_waitcnt vmcnt(0)" ::: "memory");
    __syncthreads();
    if (threadIdx.x == 0) {
        unsigned* bar = b.bar;
        __builtin_amdgcn_s_waitcnt(0);
        unsigned nloc = b.st[0], nx = b.st[1];
        if (nloc == 0u) { xcd_barrier_complete(bar, b.x, nloc, nx); b.st[0] = nloc; b.st[1] = nx; }
        const unsigned old = xb_add(&bar[XB_XSUB(b.x)], 1u);
        const unsigned gen = old / nloc;
        if (old + 1u == (gen + 1u) * nloc) {
            __builtin_amdgcn_fence(__ATOMIC_RELEASE, "agent");
            asm volatile("s_waitcnt vmcnt(0)" ::: "memory");
            const unsigned og = xb_add(&bar[XB_TOP], 1u);
            const unsigned tg = og / nx;
            if (og + 1u == (tg + 1u) * nx) xb_add(&bar[XB_TOPGEN], 1u);
            else XB_SPIN(xb_ld(&bar[XB_TOPGEN]) == tg, bar);
            __builtin_amdgcn_fence(__ATOMIC_ACQUIRE, "agent");
            xb_add(&bar[XB_XGEN(b.x)], 1u);
            asm volatile("s_waitcnt vmcnt(0)" ::: "memory");
        } else {
            XB_SPIN(xb_ld(&bar[XB_XGEN(b.x)]) == gen, bar);
            __builtin_amdgcn_fence(__ATOMIC_ACQUIRE, "agent");
            asm volatile("s_waitcnt vmcnt(0)" ::: "memory");
        }
    }
    __syncthreads();
}

constexpr int NWAVES = 8;
constexpr int BATCH = 4, SEQ = 4096, D = 1024, M = BATCH * SEQ, NH = 8, HD = 64, AW = 512, PLE = 256;
constexpr int NIN = 5120, INTOT = 5128, NKEYS = 128, NEXP = 16384, NS = 2048;
constexpr float EPS = 1e-6f, LOG2E = 1.4426950408889634f, C2 = 0.125f * LOG2E;
constexpr int NPHASE = 9;
constexpr int SLW = 128, NSL = D / SLW;
static_assert(NSL == 8, "one slice per XCD group; SS3 has 16 slots");

constexpr size_t MiB = 1u << 20;
constexpr size_t WS_CTL = 0, CTL_ZERO_BYTES = 64 * 1024;
constexpr size_t WS_RSTD1 = 1 * MiB, WS_RSTD3 = WS_RSTD1 + 65536, WS_LF = WS_RSTD3 + 65536, WS_CS = WS_LF + 524288, WS_SS2 = WS_CS + 524288, WS_WPP = WS_SS2 + 1048576;
constexpr size_t WS_WQ8 = 20 * MiB, WS_SW = WS_RSTD1;
constexpr size_t WS_SU = WS_RSTD3, WS_SV = WS_WPP + 524288;
static_assert(WS_SV + 65536 <= 4 * MiB, "small region");
constexpr size_t WS_WIN = 4 * MiB, WS_WBR = 14 * MiB, WS_WOUT = 16 * MiB, WS_WS = 18 * MiB, WS_WPG = 22 * MiB, WS_PB = 24 * MiB;
constexpr size_t WS_UB = 32 * MiB, WS_VB = 48 * MiB;
constexpr size_t WS_AC = 64 * MiB;
constexpr size_t WS_A = 96 * MiB;
constexpr size_t WS_PP = 128 * MiB;
constexpr size_t WS_Q = 160 * MiB, WS_K = 176 * MiB, WS_V = 192 * MiB, WS_GB = 208 * MiB, WS_Z = 224 * MiB;
constexpr size_t WS_MERGED = 160 * MiB, WS_XB2 = 192 * MiB, WS_IDS = 224 * MiB, WS_GATES = 232 * MiB;
constexpr size_t WS_XB3 = 64 * MiB, WS_SS4 = WS_LF;
constexpr size_t WS_END = 256 * MiB;
constexpr size_t WS_PART0 = 4 * MiB, WS_PART1 = 160 * MiB, WS_PART2 = 240 * MiB;
constexpr size_t WS_TGC = 32 * MiB, WS_TXC = 64 * MiB, WS_SC = 32 * MiB;
constexpr int CW_BAR = 1024;

constexpr int RING_OFF = 0, RING_BYTES = 135168;
constexpr int LDSCTL_OFF = RING_BYTES, MISC_OFF = LDSCTL_OFF + 320;
constexpr int LDS_BYTES = RING_BYTES + 1024;
static_assert(attn_body::ATTN_LDS_BYTES <= RING_BYTES && pg8::STAGE_BYTES <= RING_BYTES && 128 * pg8::EpiTopK::RS * 4 <= RING_BYTES, "LDS map");

typedef unsigned u32x4 __attribute__((ext_vector_type(4)));
typedef unsigned u32x2 __attribute__((ext_vector_type(2)));
__device__ __forceinline__ float bf2f(bf16 v) { return __uint_as_float((unsigned)v << 16); }
__device__ __forceinline__ float wave_sum(float v) {
#pragma unroll
    for (int o = 1; o < 64; o <<= 1) v += __shfl_xor(v, o);
    return v;
}
__device__ __forceinline__ float sigmoidf_(float v) { return 1.0f / (1.0f + __expf(-v)); }
__host__ __device__ __forceinline__ int src_in(int n) {
    const int pn = n >> 8, l = n & 255;
    if (pn < 6) return n;
    if (pn < 8) return 1544 + (n - 1536);
    if (pn < 12) { const int j = pn - 8; return (l < 128) ? 2056 + 128 * j + l : 2568 + 128 * j + (l - 128); }
    if (pn < 16) return 3080 + (n - 3072);
    return 4104 + (n - 4096);
}

struct Args { const float* in[18]; float* out; unsigned char* ws; int ph_lo, ph_hi, li, pad; };
struct Ctx {
    LAS unsigned char* lds; int wave, vcu, G;
    __device__ __forceinline__ int tid_() const { return (int)threadIdx.x; }
    __device__ __forceinline__ int lane_() const { return (int)threadIdx.x & 63; }
};

struct TrItem { const float* W; const float* g; bf16* WT; int ldw, k0, scol0, ldt, drow0, dk0; };
__device__ __forceinline__ void tr_load(const TrItem& I, float (&tv)[32], int lane) {
#pragma unroll
    for (int i = 0; i < 32; ++i) { const int kk = 2 * i + (lane >> 5); tv[i] = I.W[(size_t)(I.k0 + kk) * I.ldw + I.scol0 + (lane & 31)]; }
}
__device__ __forceinline__ void tr_finish(const TrItem& I, const float (&tv)[32], LAS float* scr, int lane) {
#pragma unroll
    for (int i = 0; i < 32; ++i) { const int kk = 2 * i + (lane >> 5); float v = tv[i]; if (I.g) v *= I.g[I.k0 + kk]; scr[kk * 33 + (lane & 31)] = v; }
    LDS_WAIT(); asm volatile("" ::: "memory");
    const int c = lane & 7;
#pragma unroll
    for (int j = 0; j < 4; ++j) { const int n = (lane >> 3) + 8 * j; const LAS float* s = scr + (8 * c) * 33 + n;
        v4u o; o.x = pk2(s[0 * 33], s[1 * 33]); o.y = pk2(s[2 * 33], s[3 * 33]); o.z = pk2(s[4 * 33], s[5 * 33]); o.w = pk2(s[6 * 33], s[7 * 33]);
        *(GAS v4u*)(I.WT + (size_t)(I.drow0 + n) * I.ldt + I.dk0 + 8 * c) = o; }
    LDS_WAIT(); asm volatile("" ::: "memory");
}
__device__ __forceinline__ void p0_prologue(const Ctx& F, const Args& a, volatile LAS unsigned* MISC) {
#if defined(MK_PROBE_SEG) && MK_PROBE_SEG >= 100
    int n_sub = 0;
#define SUBSYNC() __syncthreads()
#define SUBSTAMP() do { if (blockIdx.x == 0 && threadIdx.x == 0) { ((unsigned long long*)(a.ws + 32768))[32 + n_sub] = __builtin_amdgcn_s_memrealtime(); } ++n_sub; } while (0)
#else
#define SUBSTAMP() do { } while (0)
#define SUBSYNC() do { } while (0)
#endif
    SUBSTAMP();
    unsigned char* ws = a.ws;
    const float *x = a.in[0], *p = a.in[1], *g_mix = a.in[2], *w_in = a.in[3], *b_f = a.in[4], *w_branch = a.in[6], *w_out = a.in[7], *g_ffn = a.in[8], *w_peer_q = a.in[9],
                *pk1 = a.in[10], *pk2_ = a.in[11], *peer_u = a.in[12], *peer_v = a.in[13], *g_ple = a.in[14], *w_ple_gate = a.in[15], *w_ple_proj = a.in[16];
    bf16 *WIN = (bf16*)(ws + WS_WIN), *WBR = (bf16*)(ws + WS_WBR), *WOUT = (bf16*)(ws + WS_WOUT), *WST = (bf16*)(ws + WS_WS), *WPG = (bf16*)(ws + WS_WPG), *WPP = (bf16*)(ws + WS_WPP);
    bf16 *PB = (bf16*)(ws + WS_PB), *UB = (bf16*)(ws + WS_UB), *VB = (bf16*)(ws + WS_VB), *XB = (bf16*)(ws + WS_A);
    float *RSTD1 = (float*)(ws + WS_RSTD1), *LF = (float*)(ws + WS_LF);
    const int gw0 = F.vcu * NWAVES + F.wave, NGW = F.G * NWAVES, NGT = F.G * 512;
    const int tid_ = (int)threadIdx.x, lane_ = tid_ & 63, gw = gw0, gt = F.vcu * 512 + tid_; (void)gt;
    auto stepA = [&]() __attribute__((always_inline)) {
    {
        LAS float* KH = (LAS float*)(F.lds + RING_OFF); LAS float* WQ = KH + 128 * 129;
        for (int item = F.vcu; item < 256; item += F.G) {
            const int hh = item >> 4, head = hh >> 1, half = hh & 1, d0 = (item & 15) * 64;
            const float* kh = (half ? pk2_ : pk1) + (size_t)head * 128 * 128;
            float tk[32], tq[16];
#pragma unroll
            for (int i = 0; i < 32; ++i) tk[i] = kh[i * 512 + tid_];
#pragma unroll
            for (int i = 0; i < 16; ++i) { const int idx = i * 512 + tid_; tq[i] = w_peer_q[(size_t)(d0 + (idx >> 7)) * NS + head * 256 + half * 128 + (idx & 127)]; }
#pragma unroll
            for (int i = 0; i < 32; ++i) { const int idx = i * 512 + tid_; KH[(idx >> 7) * 129 + (idx & 127)] = tk[i]; }
#pragma unroll
            for (int i = 0; i < 16; ++i) WQ[i * 512 + tid_] = tq[i];
            __syncthreads();
            const int key = tid_ & 127, dg = tid_ >> 7;
            float acc[16];
#pragma unroll
            for (int i = 0; i < 16; ++i) acc[i] = 0.f;
            for (int e = 0; e < 128; e += 4) {
                const float k0 = KH[key * 129 + e], k1 = KH[key * 129 + e + 1], k2 = KH[key * 129 + e + 2], k3 = KH[key * 129 + e + 3];
#pragma unroll
                for (int i = 0; i < 16; ++i) { const f32x4 w = *(const LAS f32x4*)(WQ + (dg * 16 + i) * 128 + e); acc[i] += (k0 * w[0] + k1 * w[1]) + (k2 * w[2] + k3 * w[3]); }
            }
            const int dd = d0 + dg * 16;
#pragma unroll
            for (int q = 0; q < 2; ++q) { v4u o; o.x = pk2(acc[8 * q] * g_ffn[dd + 8 * q], acc[8 * q + 1] * g_ffn[dd + 8 * q + 1]); o.y = pk2(acc[8 * q + 2] * g_ffn[dd + 8 * q + 2], acc[8 * q + 3] * g_ffn[dd + 8 * q + 3]);
                o.z = pk2(acc[8 * q + 4] * g_ffn[dd + 8 * q + 4], acc[8 * q + 5] * g_ffn[dd + 8 * q + 5]); o.w = pk2(acc[8 * q + 6] * g_ffn[dd + 8 * q + 6], acc[8 * q + 7] * g_ffn[dd + 8 * q + 7]);
                *(GAS v4u*)(WST + (size_t)(head * 256 + half * 128 + key) * D + dd + 8 * q) = o; }
            __syncthreads();
        }
    }
    };
    auto stepB = [&]() __attribute__((always_inline)) {
    {
        LAS float* scr = (LAS float*)(F.lds + RING_OFF + F.wave * 16384);
        constexpr int I_IN = 16 * 160, I_BR = 8 * 32, I_SQ = 16 * 32, I_PP = 4 * 32, NITEMS = I_IN + 2 * I_BR + 2 * I_SQ + I_PP;
        auto decode = [&](int r) -> TrItem {
            TrItem I;
            if (r < I_IN) { const int kb = r / 160, nb = r % 160; I = TrItem{w_in, g_mix, WIN, INTOT, 64 * kb, src_in(32 * nb), D, 32 * nb, 64 * kb}; return I; } r -= I_IN;
            if (r < 2 * I_BR) { const int br = r / I_BR, q = r % I_BR, kb = q / 32, nb = q % 32; I = TrItem{w_branch + (size_t)br * AW * D, nullptr, WBR, D, 64 * kb, 32 * nb, D, 32 * nb, br * AW + 64 * kb}; return I; } r -= 2 * I_BR;
            if (r < I_SQ) { const int kb = r / 32, nb = r % 32; I = TrItem{w_out, nullptr, WOUT, D, 64 * kb, 32 * nb, D, 32 * nb, 64 * kb}; return I; } r -= I_SQ;
            if (r < I_SQ) { const int kb = r / 32, nb = r % 32; I = TrItem{w_ple_gate, g_ple, WPG, D, 64 * kb, 32 * nb, D, 32 * nb, 64 * kb}; return I; } r -= I_SQ;
            { const int kb = r / 32, nb = r % 32; I = TrItem{w_ple_proj, nullptr, WPP, D, 64 * kb, 32 * nb, PLE, 32 * nb, 64 * kb}; return I; }
        };
        for (int it = gw; it < NITEMS; it += 2 * NGW) {
            const bool two = it + NGW < NITEMS;
            const TrItem A = decode(it), B = decode(two ? it + NGW : it);
            float ta[32], tb[32];
            tr_load(A, ta, lane_); if (two) tr_load(B, tb, lane_);
            tr_finish(A, ta, scr, lane_); if (two) tr_finish(B, tb, scr, lane_);
        }
    }
    };
    auto stepC = [&]() __attribute__((always_inline)) {
    {
        LAS float* WFL = (LAS float*)(F.lds + RING_OFF);
        { float tw[16], tg[16];
#pragma unroll
          for (int i = 0; i < 16; ++i) { const int idx = i * 512 + tid_, k = idx >> 3, h = idx & 7; tw[i] = w_in[(size_t)k * INTOT + 1536 + h]; tg[i] = g_mix[k]; }
#pragma unroll
          for (int i = 0; i < 16; ++i) { const int idx = i * 512 + tid_, k = idx >> 3, h = idx & 7; WFL[h * 1024 + k] = tg[i] * tw[i]; } }
        __syncthreads();
        for (int rb = gw; rb < M; rb += 4 * NGW) {
            f32x4 v[4][4];
#pragma unroll
            for (int r = 0; r < 4; ++r) { const int row = rb + r * NGW; if (row < M) { const GAS f32x4* xr = (const GAS f32x4*)(x + (size_t)row * D);
#pragma unroll
                for (int j = 0; j < 4; ++j) v[r][j] = xr[lane_ + 64 * j]; } }
#pragma unroll
            for (int r = 0; r < 4; ++r) { const int row = rb + r * NGW; if (row < M) {
                float ss = 0.f;
#pragma unroll
                for (int j = 0; j < 4; ++j) ss += (v[r][j].x * v[r][j].x + v[r][j].y * v[r][j].y) + (v[r][j].z * v[r][j].z + v[r][j].w * v[r][j].w);
                ss = wave_sum(ss);
                const float rstd = 1.0f / sqrtf(ss * (1.0f / D) + EPS);
                GAS u32x2* o = (GAS u32x2*)(XB + (size_t)row * D);
#pragma unroll
                for (int j = 0; j < 4; ++j) { u32x2 w; w.x = pk2(v[r][j].x, v[r][j].y); w.y = pk2(v[r][j].z, v[r][j].w); o[lane_ + 64 * j] = w; }
                if (lane_ == 0) RSTD1[row] = rstd;
                float f[8];
#pragma unroll
                for (int h = 0; h < 8; ++h) { float s_ = 0.f;
#pragma unroll
                    for (int j = 0; j < 4; ++j) { const f32x4 w = *(const LAS f32x4*)(WFL + h * 1024 + 4 * (lane_ + 64 * j)); s_ += (v[r][j].x * w[0] + v[r][j].y * w[1]) + (v[r][j].z * w[2] + v[r][j].w * w[3]); }
                    f[h] = s_; }
                float r4[4], r2[2], r1;
#pragma unroll
                for (int i = 0; i < 4; ++i) { const float send = (lane_ & 32) ? f[i] : f[i + 4], keep = (lane_ & 32) ? f[i + 4] : f[i]; r4[i] = keep + __shfl_xor(send, 32); }
#pragma unroll
                for (int i = 0; i < 2; ++i) { const float send = (lane_ & 16) ? r4[i] : r4[i + 2], keep = (lane_ & 16) ? r4[i + 2] : r4[i]; r2[i] = keep + __shfl_xor(send, 16); }
                { const float send = (lane_ & 8) ? r2[0] : r2[1], keep = (lane_ & 8) ? r2[1] : r2[0]; r1 = keep + __shfl_xor(send, 8); }
                r1 += __shfl_xor(r1, 4); r1 += __shfl_xor(r1, 2); r1 += __shfl_xor(r1, 1);
                const int hL = ((lane_ >> 5) & 1) * 4 + ((lane_ >> 4) & 1) * 2 + ((lane_ >> 3) & 1);
                const float tot = r1 * rstd + b_f[hL];
                const float ls = fminf(tot, 0.f) - log1pf(__expf(-fabsf(tot)));
                const int b = row / SEQ, t = row % SEQ;
                if ((lane_ & 7) == 0) LF[(size_t)(b * NH + hL) * SEQ + t] = ls * LOG2E;
            } }
        }
    }
    };
    auto stepD = [&]() __attribute__((always_inline)) {
    {
        constexpr int NU = NEXP * D / 8, NP = M * PLE / 8;
        {
            signed char* UQ = (signed char*)(ws + WS_UB); unsigned char* VQ = (unsigned char*)(ws + WS_VB); float *SU = (float*)(ws + WS_SU), *SV = (float*)(ws + WS_SV);
            f32x4 gq[4];
#pragma unroll
            for (int j = 0; j < 4; ++j) gq[j] = *(const GAS f32x4*)(g_ffn + 256 * j + 4 * lane_);
            for (int rb = gw; rb < 2 * NEXP; rb += 4 * NGW) {
                f32x4 v[4][4];
#pragma unroll
                for (int r = 0; r < 4; ++r) { const int rr = rb + r * NGW; if (rr < 2 * NEXP) { const bool isv = rr >= NEXP; const int e = isv ? rr - NEXP : rr;
                    const GAS f32x4* src = (const GAS f32x4*)((isv ? peer_v : peer_u) + (size_t)e * D) + lane_;
#pragma unroll
                    for (int j = 0; j < 4; ++j) v[r][j] = src[64 * j]; } }
#pragma unroll
                for (int r = 0; r < 4; ++r) { const int rr = rb + r * NGW; if (rr < 2 * NEXP) { const bool isv = rr >= NEXP; const int e = isv ? rr - NEXP : rr;
                    float am = 0.f;
#pragma unroll
                    for (int j = 0; j < 4; ++j) { if (!isv) v[r][j] = v[r][j] * gq[j]; am = fmaxf(am, fmaxf(fmaxf(fabsf(v[r][j].x), fabsf(v[r][j].y)), fmaxf(fabsf(v[r][j].z), fabsf(v[r][j].w)))); }
#pragma unroll
                    for (int o = 1; o < 64; o <<= 1) am = fmaxf(am, __shfl_xor(am, o));
                    const float sc = am > 0.f ? 127.0f / am : 0.f;
                    unsigned char* tb = isv ? VQ : (unsigned char*)UQ;
#pragma unroll
                    for (int j = 0; j < 4; ++j) { const int q0 = (int)rintf(v[r][j].x * sc), q1 = (int)rintf(v[r][j].y * sc), q2 = (int)rintf(v[r][j].z * sc), q3 = (int)rintf(v[r][j].w * sc);
                        const unsigned o = (unsigned)(q0 & 255) | ((unsigned)(q1 & 255) << 8) | ((unsigned)(q2 & 255) << 16) | ((unsigned)(q3 & 255) << 24);
                        *(GAS unsigned*)(tb + ((size_t)(2 * j + (lane_ >> 5)) * NEXP + e) * SLW + ((4 * lane_) & 127)) = o; }
                    if (lane_ == 0) (isv ? SV : SU)[e] = am * (1.0f / 127.0f);
                } }
            }
        }
    }
    };
    if (F.vcu & 1) { stepD(); __syncthreads(); SUBSTAMP(); stepC(); __syncthreads(); SUBSTAMP(); stepB(); __syncthreads(); SUBSTAMP(); stepA(); __syncthreads(); SUBSTAMP(); }
    else           { stepA(); __syncthreads(); SUBSTAMP(); stepB(); __syncthreads(); SUBSTAMP(); stepC(); __syncthreads(); SUBSTAMP(); stepD(); __syncthreads(); SUBSTAMP(); }
    { constexpr int NP = M * PLE / 8;
        for (int i = F.vcu * 512 + F.tid_(); i < NP; i += NGT) { const f32x4 a = ((const GAS f32x4*)p)[2 * (size_t)i], b = ((const GAS f32x4*)p)[2 * (size_t)i + 1];
            v4u o; o.x = pk2(a.x, a.y); o.y = pk2(a.z, a.w); o.z = pk2(b.x, b.y); o.w = pk2(b.z, b.w); ((GAS v4u*)PB)[i] = o; }
    }
}
__device__ __forceinline__ void p2_conv_chunk(int chunk, const bf16* GB, const bf16* Z, const float* cw, bf16* AC) {
    int tid_l = (int)threadIdx.x; asm volatile("" : "+v"(tid_l));
#pragma unroll
    for (int k = 0; k < 4; ++k) {
        const int i = chunk * 2048 + k * 512 + tid_l;
        const int row = i >> 6, c = (i & 63) * 8, t = row & (SEQ - 1);
        const v4u z2 = *(const GAS v4u*)(Z + (size_t)row * AW + c), g = *(const GAS v4u*)(GB + (size_t)row * AW + c);
        v4u z1 = {0u, 0u, 0u, 0u}, z0 = {0u, 0u, 0u, 0u};
        if (t >= 1) z1 = *(const GAS v4u*)(Z + (size_t)(row - 1) * AW + c);
        if (t >= 2) z0 = *(const GAS v4u*)(Z + (size_t)(row - 2) * AW + c);
        float r[8];
#pragma unroll
        for (int e = 0; e < 4; ++e) {
            const float w0a = cw[c + 2 * e], w0b = cw[c + 2 * e + 1], w1a = cw[AW + c + 2 * e], w1b = cw[AW + c + 2 * e + 1], w2a = cw[2 * AW + c + 2 * e], w2b = cw[2 * AW + c + 2 * e + 1];
            r[2 * e] = __uint_as_float(g[e] << 16) * (w0a * __uint_as_float(z0[e] << 16) + w1a * __uint_as_float(z1[e] << 16) + w2a * __uint_as_float(z2[e] << 16));
            r[2 * e + 1] = __uint_as_float(g[e] & 0xffff0000u) * (w0b * __uint_as_float(z0[e] & 0xffff0000u) + w1b * __uint_as_float(z1[e] & 0xffff0000u) + w2b * __uint_as_float(z2[e] & 0xffff0000u));
        }
        v4u o; o.x = pk2(r[0], r[1]); o.y = pk2(r[2], r[3]); o.z = pk2(r[4], r[5]); o.w = pk2(r[6], r[7]);
        *(GAS v4u*)(AC + (size_t)row * D + AW + c) = o;
    }
}
constexpr int P2_NATT = 512, P2_NCONV = M * AW / 8 / 2048, CW_QUEUE = 512;
__device__ __forceinline__ int p2_dequeue(unsigned* ctr, volatile LAS unsigned* slot) {
    if (threadIdx.x == 0) *slot = __hip_atomic_fetch_add(ctr, 1u, __ATOMIC_RELAXED, __HIP_MEMORY_SCOPE_AGENT);
    asm volatile("s_waitcnt vmcnt(0) lgkmcnt(0)\n\ts_barrier" ::: "memory");
    const unsigned v = *slot;
    asm volatile("s_waitcnt lgkmcnt(0)\n\ts_barrier" ::: "memory");
    return (int)v;
}
template <int CTRL> __device__ __forceinline__ int dpp_i(int v) { return __builtin_amdgcn_update_dpp(0, v, CTRL, 0xf, 0xf, true); }
__device__ __forceinline__ int sum8i(int v) { v += dpp_i<0x141>(v); v += dpp_i<0xB1>(v); v += dpp_i<0x4E>(v); return v; }
__device__ __forceinline__ float max8f(float v) { v = fmaxf(v, __uint_as_float((unsigned)dpp_i<0x141>((int)__float_as_uint(v)))); v = fmaxf(v, __uint_as_float((unsigned)dpp_i<0xB1>((int)__float_as_uint(v)))); v = fmaxf(v, __uint_as_float((unsigned)dpp_i<0x4E>((int)__float_as_uint(v)))); return v; }
__device__ __forceinline__ size_t part_slab(int j) { return j < 2 ? WS_PART0 + (size_t)j * 8 * MiB : j < 6 ? WS_PART1 + (size_t)(j - 2) * 8 * MiB : WS_PART2 + (size_t)(j - 6) * 8 * MiB; }
struct P6Geo { int xg, wi, nwv; };
__device__ __forceinline__ P6Geo p6_geo(const Ctx& F) { P6Geo g; const int bx = blockIdx.x; g.xg = bx & 7; g.wi = (bx >> 3) * NWAVES + F.wave; g.nwv = ((F.G - g.xg + 7) >> 3) * NWAVES; return g; }
__device__ __forceinline__ void p6a_upass(const Ctx& F, unsigned char* ws, const bf16* XB1, const unsigned short* IDS) {
    const P6Geo G = p6_geo(F); const int lane = F.lane_(), g = lane >> 3, c = lane & 7;
    for (int sl = G.xg; sl < NSL; sl += 8) {
        float* PART = (float*)(ws + part_slab(sl));
        const GAS unsigned char* Ts = (const GAS unsigned char*)(ws + WS_UB) + (size_t)sl * NEXP * SLW + 16 * c;
        for (int t = G.wi; t < M; t += G.nwv) {
            const v4u xa = *(const GAS v4u*)(XB1 + (size_t)t * D + sl * SLW + 16 * c), xb = *(const GAS v4u*)(XB1 + (size_t)t * D + sl * SLW + 16 * c + 8);
            v4u idp[2];
#pragma unroll
            for (int q = 0; q < 2; ++q) idp[q] = *(const GAS v4u*)(IDS + (size_t)t * 128 + 16 * g + 8 * q);
            v4u u[16];
#pragma unroll
            for (int i = 0; i < 16; ++i) { const unsigned w_ = idp[i >> 3][(i >> 1) & 3]; u[i] = *(const GAS v4u*)(Ts + ((i & 1) ? ((w_ >> 9) & 0x7fff80u) : ((w_ << 7) & 0x7fff80u))); }
            float xf[16];
#pragma unroll
            for (int e = 0; e < 4; ++e) { xf[2 * e] = __uint_as_float(xa[e] << 16); xf[2 * e + 1] = __uint_as_float(xa[e] & 0xffff0000u); xf[8 + 2 * e] = __uint_as_float(xb[e] << 16); xf[8 + 2 * e + 1] = __uint_as_float(xb[e] & 0xffff0000u); }
            float am = 0.f;
#pragma unroll
            for (int e = 0; e < 16; ++e) am = fmaxf(am, fabsf(xf[e]));
            am = max8f(am);
            const float sc = am > 0.f ? 127.0f / am : 0.f, sx = am * (1.0f / 127.0f);
            int qx[4];
#pragma unroll
            for (int j = 0; j < 4; ++j) qx[j] = (int)(((unsigned)((int)rintf(xf[4 * j] * sc) & 255)) | ((unsigned)((int)rintf(xf[4 * j + 1] * sc) & 255) << 8) | ((unsigned)((int)rintf(xf[4 * j + 2] * sc) & 255) << 16) | ((unsigned)((int)rintf(xf[4 * j + 3] * sc) & 255) << 24));
            int r0 = 0, r1 = 0;
#pragma unroll
            for (int i = 0; i < 16; ++i) { int sacc = __builtin_amdgcn_sdot4(qx[0], (int)u[i][0], 0, false); sacc = __builtin_amdgcn_sdot4(qx[1], (int)u[i][1], sacc, false); sacc = __builtin_amdgcn_sdot4(qx[2], (int)u[i][2], sacc, false); sacc = __builtin_amdgcn_sdot4(qx[3], (int)u[i][3], sacc, false);
                sacc = sum8i(sacc);
                if (i < 8) r0 = (c == i) ? sacc : r0; else r1 = (c == i - 8) ? sacc : r1; }
            float* pp = PART + (size_t)t * 128 + 16 * g + c;
            pp[0] = (float)r0 * sx; pp[8] = (float)r1 * sx;
        }
    }
}
__device__ __forceinline__ void p6b_combine(const Ctx& F, unsigned char* ws, float* SS2, const unsigned short* IDS, const float* GATES) {
    const int gw = F.vcu * NWAVES + F.wave, NGW = F.G * NWAVES, lane = F.lane_();
    const float *SU = (const float*)(ws + WS_SU), *SV = (const float*)(ws + WS_SV);
    signed char* WQ8 = (signed char*)(ws + WS_WQ8); float* SW = (float*)(ws + WS_SW);
    for (int tb = gw; tb < M; tb += 4 * NGW) {
        float ssv[4], a0[4], a1[4], g0[4], g1[4]; int i0[4], i1[4];
#pragma unroll
        for (int r = 0; r < 4; ++r) { const int t = tb + r * NGW; if (t < M) {
            ssv[r] = lane < 16 ? SS2[(size_t)t * 16 + lane] : 0.f;
            i0[r] = (int)IDS[(size_t)t * 128 + lane]; i1[r] = (int)IDS[(size_t)t * 128 + 64 + lane];
            g0[r] = GATES[(size_t)t * 128 + lane]; g1[r] = GATES[(size_t)t * 128 + 64 + lane];
            a0[r] = 0.f; a1[r] = 0.f;
#pragma unroll
            for (int j = 0; j < 8; ++j) { const float* pp = (const float*)(ws + part_slab(j)) + (size_t)t * 128; a0[r] += pp[lane]; a1[r] += pp[64 + lane]; } } }
#pragma unroll
        for (int r = 0; r < 4; ++r) { const int t = tb + r * NGW; if (t < M) {
            const float rstd = 1.0f / sqrtf(wave_sum(ssv[r]) * (1.0f / D) + EPS);
            const float x0 = a0[r] * rstd * SU[i0[r]], x1 = a1[r] * rstd * SU[i1[r]];
            const float w0 = g0[r] * 0.5f * x0 * (1.0f + erff(x0 * 0.70710678118654752f)) * SV[i0[r]], w1 = g1[r] * 0.5f * x1 * (1.0f + erff(x1 * 0.70710678118654752f)) * SV[i1[r]];
            float am = fmaxf(fabsf(w0), fabsf(w1));
#pragma unroll
            for (int o = 1; o < 64; o <<= 1) am = fmaxf(am, __shfl_xor(am, o));
            const float sc = am > 0.f ? 127.0f / am : 0.f;
            WQ8[(size_t)t * 128 + lane] = (signed char)(int)rintf(w0 * sc); WQ8[(size_t)t * 128 + 64 + lane] = (signed char)(int)rintf(w1 * sc);
            if (lane == 0) SW[t] = am * (1.0f / 127.0f);
            if (lane < 16) SS2[(size_t)t * 16 + lane] = 0.f;
        } }
    }
}
__device__ __forceinline__ int pl32_sum(int a, int b) { const auto s_ = __builtin_amdgcn_permlane32_swap((unsigned)a, (unsigned)b, false, false); return (int)(s_[0] + s_[1]); }
__device__ __forceinline__ int pl16_sum(int a, int b) { const auto s_ = __builtin_amdgcn_permlane16_swap((unsigned)a, (unsigned)b, false, false); return (int)(s_[0] + s_[1]); }
__device__ __forceinline__ float wave_sum_valu(float v) {
    { const auto s_ = __builtin_amdgcn_permlane32_swap(__float_as_uint(v), __float_as_uint(v), false, false); v = __uint_as_float(s_[0]) + __uint_as_float(s_[1]); }
    { const auto s_ = __builtin_amdgcn_permlane16_swap(__float_as_uint(v), __float_as_uint(v), false, false); v = __uint_as_float(s_[0]) + __uint_as_float(s_[1]); }
    v += __uint_as_float((unsigned)dpp_i<0x128>((int)__float_as_uint(v))); v += __uint_as_float((unsigned)dpp_i<0x124>((int)__float_as_uint(v)));
    v += __uint_as_float((unsigned)dpp_i<0x122>((int)__float_as_uint(v))); v += __uint_as_float((unsigned)dpp_i<0x121>((int)__float_as_uint(v))); return v;
}
__device__ __forceinline__ void p6c_vpass(const Ctx& F, unsigned char* ws, const unsigned short* IDS, const bf16* XB1, bf16* XB2, float* SS3) {
    const P6Geo G = p6_geo(F); const int lane = F.lane_(), g = lane >> 3, c = lane & 7;
    const int ecol = 16 * c + ((lane >> 5) & 1) * 8 + ((lane >> 4) & 1) * 4 + ((lane >> 3) & 1) * 2;
    const signed char* WQ8 = (const signed char*)(ws + WS_WQ8); const float* SW = (const float*)(ws + WS_SW);
#define V_IDS(ID, t_) do { _Pragma("unroll") for (int q = 0; q < 2; ++q) ID[q] = *(const GAS v4u*)(IDS + (size_t)(t_) * 128 + 16 * g + 8 * q); } while (0)
#define V_W(WV, t_) do { WV = *(const GAS v4u*)(WQ8 + (size_t)(t_) * 128 + 16 * g); } while (0)
#define V_GATHER(R, ID) do { _Pragma("unroll") for (int i = 0; i < 16; ++i) { const unsigned w_ = ID[i >> 3][(i >> 1) & 3]; R[i] = *(const GAS v4u*)(Ts + (size_t)((((i & 1) ? (w_ >> 9) : (w_ << 7)) & 0x7fff80u) | c16)); } } while (0)
#define V_COMPUTE(R, WV, t_) do { \
        const size_t o_ = (size_t)(t_) * D + sl * SLW + ecol; \
        const unsigned xq_ = *(const GAS unsigned*)(XB1 + o_); const float sw_ = SW[t_]; \
        int acc[16]; \
        _Pragma("unroll") for (int e = 0; e < 16; ++e) acc[e] = 0; \
        _Pragma("unroll") for (int j = 0; j < 4; ++j) \
            _Pragma("unroll") for (int b = 0; b < 4; ++b) { \
                const unsigned r0_ = R[4 * j][b], r1_ = R[4 * j + 1][b], r2_ = R[4 * j + 2][b], r3_ = R[4 * j + 3][b]; \
                const unsigned x01 = __builtin_amdgcn_perm(r1_, r0_, 0x05010400u), y01 = __builtin_amdgcn_perm(r1_, r0_, 0x07030602u), x23 = __builtin_amdgcn_perm(r3_, r2_, 0x05010400u), y23 = __builtin_amdgcn_perm(r3_, r2_, 0x07030602u); \
                acc[4 * b]     = __builtin_amdgcn_sdot4((int)__builtin_amdgcn_perm(x23, x01, 0x05040100u), (int)WV[j], acc[4 * b], false); \
                acc[4 * b + 1] = __builtin_amdgcn_sdot4((int)__builtin_amdgcn_perm(x23, x01, 0x07060302u), (int)WV[j], acc[4 * b + 1], false); \
                acc[4 * b + 2] = __builtin_amdgcn_sdot4((int)__builtin_amdgcn_perm(y23, y01, 0x05040100u), (int)WV[j], acc[4 * b + 2], false); \
                acc[4 * b + 3] = __builtin_amdgcn_sdot4((int)__builtin_amdgcn_perm(y23, y01, 0x07060302u), (int)WV[j], acc[4 * b + 3], false); } \
        int r8[8], r4[4], r2[2]; \
        _Pragma("unroll") for (int i = 0; i < 8; ++i) r8[i] = pl32_sum(acc[i], acc[i + 8]); \
        _Pragma("unroll") for (int i = 0; i < 4; ++i) r4[i] = pl16_sum(r8[i], r8[i + 4]); \
        _Pragma("unroll") for (int i = 0; i < 2; ++i) { const int send = (lane & 8) ? r4[i] : r4[i + 2], keep = (lane & 8) ? r4[i + 2] : r4[i]; r2[i] = keep + dpp_i<0x128>(send); } \
        const float x0_ = __uint_as_float(xq_ << 16) + sw_ * (float)r2[0], x1_ = __uint_as_float(xq_ & 0xffff0000u) + sw_ * (float)r2[1]; \
        *(GAS unsigned*)(XB2 + o_) = pk2(x0_, x1_); \
        const float ss = wave_sum_valu(x0_ * x0_ + x1_ * x1_); \
        if (lane == 0) SS3[(size_t)(t_) * 16 + sl] = ss; } while (0)
#define V_FENCE() asm volatile("" ::: "memory")
    for (int sl = G.xg; sl < NSL; sl += 8) {
        const GAS unsigned char* Ts = (const GAS unsigned char*)(ws + WS_VB) + (size_t)sl * NEXP * SLW; const unsigned c16 = 16u * (unsigned)c;
        const int nk = (M - G.wi + G.nwv - 1) / G.nwv, t0 = G.wi, dt = G.nwv;
        v4u idA[2], idB[2]; v4u wA, wB; v4u rA[16], rB[16];
        if (nk > 0) { V_IDS(idA, t0); V_GATHER(rA, idA); V_W(wA, t0); }
        if (nk > 1) V_IDS(idB, t0 + dt);
        V_FENCE();
        for (int k = 0; k < nk; k += 2) {
            if (k + 1 < nk) { V_GATHER(rB, idB); V_W(wB, t0 + (k + 1) * dt); }
            if (k + 2 < nk) V_IDS(idA, t0 + (k + 2) * dt);
            V_FENCE();
            V_COMPUTE(rA, wA, t0 + k * dt);
            V_FENCE();
            if (k + 2 < nk) { V_GATHER(rA, idA); V_W(wA, t0 + (k + 2) * dt); }
            if (k + 3 < nk) V_IDS(idB, t0 + (k + 3) * dt);
            V_FENCE();
            if (k + 1 < nk) V_COMPUTE(rB, wB, t0 + (k + 1) * dt);
            V_FENCE();
        }
    }
#undef V_IDS
#undef V_W
#undef V_GATHER
#undef V_COMPUTE
#undef V_FENCE
}
__device__ __forceinline__ void p8_final(const Ctx& F, const bf16* XB3, const float* SS4, float* OUT, const float* g) {
    const int gw = F.vcu * NWAVES + F.wave, NGW = F.G * NWAVES, lane = F.lane_();
    f32x4 gv[4];
#pragma unroll
    for (int j = 0; j < 4; ++j) gv[j] = ((const GAS f32x4*)g)[2 * lane + (j & 1) + 128 * (j >> 1)];
    for (int rb = gw; rb < M; rb += 4 * NGW) {
        v4u xa[4], xb[4]; float sv[4];
#pragma unroll
        for (int r = 0; r < 4; ++r) { const int row = rb + r * NGW; if (row < M) { xa[r] = *(const GAS v4u*)(XB3 + (size_t)row * D + 8 * lane); xb[r] = *(const GAS v4u*)(XB3 + (size_t)row * D + 512 + 8 * lane);
            sv[r] = lane < 16 ? SS4[(size_t)row * 16 + lane] : 0.f; } }
#pragma unroll
        for (int r = 0; r < 4; ++r) { const int row = rb + r * NGW; if (row < M) {
            const float rstd = 1.0f / sqrtf(wave_sum(sv[r]) * (1.0f / D) + EPS);
            GAS f32x4* o = (GAS f32x4*)(OUT + (size_t)row * D);
            o[2 * lane] = (f32x4){__uint_as_float(xa[r][0] << 16), __uint_as_float(xa[r][0] & 0xffff0000u), __uint_as_float(xa[r][1] << 16), __uint_as_float(xa[r][1] & 0xffff0000u)} * rstd * gv[0];
            o[2 * lane + 1] = (f32x4){__uint_as_float(xa[r][2] << 16), __uint_as_float(xa[r][2] & 0xffff0000u), __uint_as_float(xa[r][3] << 16), __uint_as_float(xa[r][3] & 0xffff0000u)} * rstd * gv[1];
            o[128 + 2 * lane] = (f32x4){__uint_as_float(xb[r][0] << 16), __uint_as_float(xb[r][0] & 0xffff0000u), __uint_as_float(xb[r][1] << 16), __uint_as_float(xb[r][1] & 0xffff0000u)} * rstd * gv[2];
            o[128 + 2 * lane + 1] = (f32x4){__uint_as_float(xb[r][2] << 16), __uint_as_float(xb[r][2] & 0xffff0000u), __uint_as_float(xb[r][3] << 16), __uint_as_float(xb[r][3] & 0xffff0000u)} * rstd * gv[3];
        } }
    }
}
struct OneUnit {
    pg8::Unit u;
    __device__ __forceinline__ bool next(int i, pg8::Unit& o) const { if (i != 0) return false; o = u; return true; }
    __device__ __forceinline__ void a_ready(const pg8::Unit&) const {}
    __device__ __forceinline__ void done(const pg8::Unit&) const {}
};

__global__ void __launch_bounds__(NWAVES * 64, 2) mk_fwd(Args args) {
    extern __shared__ __attribute__((aligned(16))) unsigned char lds[];
    Ctx F;
    F.lds = (LAS unsigned char*)lds;
    F.wave = __builtin_amdgcn_readfirstlane((int)threadIdx.x >> 6);
    F.G = gridDim.x; { const int bx = blockIdx.x; F.vcu = (F.G % 8 == 0) ? (bx % 8) * (F.G / 8) + bx / 8 : bx; }
    volatile LAS unsigned* MISC = (volatile LAS unsigned*)(F.lds + MISC_OFF);
    unsigned char* ws = args.ws;
    gu32* ctl = (gu32*)(ws + WS_CTL);
    for (int u = F.tid_(); u < (LDS_BYTES - LDSCTL_OFF) / 4; u += NWAVES * 64) ((LAS unsigned*)(F.lds + LDSCTL_OFF))[u] = 0u;
    __syncthreads();
    const int lo = args.ph_lo, hi = args.ph_hi;
    const bool multi = (hi - lo) > 1 || (lo <= 6 && 6 < hi);
    XcdBarrier bar; bar.bar = (unsigned*)(ctl + CW_BAR) + args.li * XCD_BAR_WORDS; bar.x = 0; bar.st = nullptr;
    if (multi) bar = xcd_barrier_post((unsigned*)(ctl + CW_BAR) + args.li * XCD_BAR_WORDS, MISC + 8);
#ifndef MK_CMASK
#define MK_CMASK 0x1ff
#endif
#define IN(k) (((MK_CMASK >> (k)) & 1) && lo <= (k) && (k) < hi)
#define SEAM(k) do { if (IN(k) && IN((k) + 1)) xcd_barrier(bar); STAMPI((k) < 6 ? (k) + 1 : (k) + 3); } while (0)
#ifdef MK_PROBE_SEG
#define STAMPI(i_) do { if (((i_) == MK_PROBE_SEG || (i_) == MK_PROBE_SEG + 1) && blockIdx.x == 0 && threadIdx.x == 0) { ((unsigned long long*)(args.ws + 32768))[(i_)] = __builtin_amdgcn_s_memrealtime(); } } while (0)
    STAMPI(0);
#else
#define STAMPI(i_) do { } while (0)
#endif
    float* out = args.out;
#define WSP(T, off) ((T*)(ws + (off)))
#define RSTD1 WSP(float, WS_RSTD1)
#define SS2 WSP(float, WS_SS2)
#define LF WSP(float, WS_LF)
#define WIN WSP(bf16, WS_WIN)
#define WBR WSP(bf16, WS_WBR)
#define WOUT WSP(bf16, WS_WOUT)
#define WST WSP(bf16, WS_WS)
#define WPG WSP(bf16, WS_WPG)
#define WPP WSP(bf16, WS_WPP)
#define PB WSP(bf16, WS_PB)
#define XB WSP(bf16, WS_A)
#define AC WSP(bf16, WS_AC)
#define XB1 WSP(bf16, WS_A)
#define PP WSP(bf16, WS_PP)
#define Q WSP(bf16, WS_Q)
#define K WSP(bf16, WS_K)
#define V WSP(bf16, WS_V)
#define GB WSP(bf16, WS_GB)
#define Z WSP(bf16, WS_Z)
#define MG WSP(bf16, WS_MERGED)
#define XB2 WSP(bf16, WS_XB2)
#define IDS WSP(unsigned short, WS_IDS)
#define GATES WSP(float, WS_GATES)
#define SGA ((bf16*)out)
#define SGC ((bf16*)out + (size_t)M * D)

    if (IN(0)) { p0_prologue(F, args, MISC); }
    SEAM(0);
    if (IN(1)) {
        { pg8::Gemm g{XB, WIN, M, NIN, D}; pg8::StaticOrder S; S.init(M, NIN, F.G, (int)blockIdx.x);
          pg8::EpiIn E{RSTD1, Q, (size_t)(WS_K - WS_Q) / 2, Z, SGA, (size_t)M * D, C2};
          static_assert(WS_V - WS_K == WS_K - WS_Q && WS_GB - WS_V == WS_K - WS_Q, "Q | K | V | GB equally spaced");
          pg8::gemm_phase<pg8::EpiIn, pg8::StaticOrder, PG8_ALIGN, PG8_SP2>(F.lds + RING_OFF, g, S, E); }
        { pg8::Gemm g{PB, WPP, M, D, PLE}; pg8::StaticOrder S; S.init(M, D, F.G, (int)blockIdx.x);
          pg8::EpiPlain E{PP, D};
          pg8::gemm_phase<pg8::EpiPlain, pg8::StaticOrder, PG8_ALIGN, PG8_SP2>(F.lds + RING_OFF, g, S, E); }
    }
    SEAM(1);
    if (IN(2)) {
        unsigned* qctr = (unsigned*)(ctl + CW_QUEUE);
        for (;;) {
            const int idx = p2_dequeue(qctr, MISC + 12);
            if (idx >= P2_NATT + P2_NCONV) break;
            if (idx < P2_NATT) { const int qb = 15 - (idx >> 5), bh = idx & 31;
                attn_body::attn_unit<8>(bh >> 3, bh & 7, qb, (const attn_body::bf16*)Q, (const attn_body::bf16*)K, (const attn_body::bf16*)V, (attn_body::bf16*)AC, LF + (size_t)bh * SEQ, (char*)lds + RING_OFF); }
            else p2_conv_chunk(idx - P2_NATT, GB, Z, args.in[5], AC);
        }
    }
    SEAM(2);
    if (IN(3)) {
        pg8::Gemm g{AC, WBR, M, D, D}; pg8::StaticOrder S; S.init(M, D, F.G, (int)blockIdx.x);
        pg8::EpiBranch E{SGA, SGC, MG};
        pg8::gemm_phase<pg8::EpiBranch, pg8::StaticOrder, PG8_ALIGN, PG8_SP2>(F.lds + RING_OFF, g, S, E);
    }
    SEAM(3);
    if (IN(4)) {
        pg8::Gemm g{MG, WOUT, M, D, D}; pg8::StaticOrder S; S.init(M, D, F.G, (int)blockIdx.x);
        pg8::EpiOut E{XB, XB1, SS2};
        pg8::gemm_phase<pg8::EpiOut, pg8::StaticOrder, PG8_ALIGN, PG8_SP2>(F.lds + RING_OFF, g, S, E);
    }
    SEAM(4);
    if (IN(5)) {
        pg8::Gemm g{XB1, WST, M, NS, D}; pg8::StaticOrder S; S.init(M, NS, F.G, (int)blockIdx.x);
        pg8::EpiTopK E{SS2, IDS, GATES, EPS};
        pg8::Unit u;
        for (int i = 0; S.next(i, u); ++i) { OneUnit O{u}; pg8::gemm_phase<pg8::EpiTopK, OneUnit, false, PG8_SP2>(F.lds + RING_OFF, g, O, E); }
    }
    SEAM(5);
    if (IN(6)) { p6a_upass(F, ws, XB1, IDS); xcd_barrier(bar); STAMPI(7); p6b_combine(F, ws, SS2, IDS, GATES); xcd_barrier(bar); STAMPI(8); p6c_vpass(F, ws, IDS, XB1, XB2, SS2); }
    SEAM(6);
    if (IN(7)) {
        pg8::Gemm g{XB2, WPG, M, D, D}; pg8::StaticOrder S; S.init(M, D, F.G, (int)blockIdx.x);
        LAS float* rtab = (LAS float*)(F.lds + RING_OFF + pg8::STAGE_BYTES);
        const bool one = (M / 256) * (D / 256) <= F.G; pg8::Unit u0;
        if (one && S.next(0, u0) && F.tid_() < 256) { const float* sp = SS2 + (size_t)(u0.pm * 256 + F.tid_()) * 16; float q = 0.f;
#pragma unroll
            for (int j = 0; j < NSL; ++j) q += sp[j];
            rtab[F.tid_()] = 1.0f / sqrtf(q * (1.0f / D) + EPS); }
        __syncthreads();
        pg8::EpiPle E{SS2, PP, XB2, WSP(bf16, WS_XB3), WSP(float, WS_SS4), EPS, one ? (const LAS float*)rtab : (const LAS float*)nullptr};
        pg8::gemm_phase<pg8::EpiPle, pg8::StaticOrder, PG8_ALIGN, PG8_SP2>(F.lds + RING_OFF, g, S, E);
    }
    SEAM(7);
    if (IN(8)) { p8_final(F, WSP(bf16, WS_XB3), WSP(float, WS_SS4), out, args.in[17]); }
    STAMPI(11);
#ifdef MK_PROBE_SEG
    if (blockIdx.x == 0 && F.tid_() == 0) {
        asm volatile("s_waitcnt vmcnt(0)" ::: "memory");
        const unsigned long long* st_ = (const unsigned long long*)(args.ws + 32768);
#if MK_PROBE_SEG >= 100
        const unsigned long long a_ = st_[32 + (MK_PROBE_SEG - 100)], b_ = (MK_PROBE_SEG - 100 == 4) ? st_[1] : st_[33 + (MK_PROBE_SEG - 100)];
#else
        const unsigned long long a_ = st_[MK_PROBE_SEG], b_ = st_[MK_PROBE_SEG + 1];
#endif
        const unsigned long long dt_ = (b_ - a_) * MK_PROBE_MULT, t0_ = __builtin_amdgcn_s_memrealtime();
        while (__builtin_amdgcn_s_memrealtime() - t0_ < dt_) __builtin_amdgcn_s_sleep(8);
    }
#endif
#undef IN
#undef SEAM
#undef WSP
#undef RSTD1
#undef SS2
#undef LF
#undef WIN
#undef WBR
#undef WOUT
#undef WST
#undef WPG
#undef WPP
#undef PB
#undef XB
#undef AC
#undef XB1
#undef PP
#undef Q
#undef K
#undef V
#undef GB
#undef Z
#undef MG
#undef XB2
#undef IDS
#undef GATES
#undef SGA
#undef SGC
}
namespace gold {
__global__ void __launch_bounds__(256) k_rows0(const float* x, const float* w_in, const float* g_mix, const float* b_f, bf16* XB, float* RSTD1, float* LF) {
    const int lane = threadIdx.x & 63, row = blockIdx.x * 4 + (threadIdx.x >> 6);
    const f32x4* xr = (const f32x4*)(x + (size_t)row * D);
    f32x4 v[4]; float ss = 0.f;
#pragma unroll
    for (int j = 0; j < 4; ++j) { v[j] = xr[lane + 64 * j]; ss += v[j].x * v[j].x + v[j].y * v[j].y + v[j].z * v[j].z + v[j].w * v[j].w; }
    ss = wave_sum(ss);
    const float rstd = 1.0f / sqrtf(ss * (1.0f / D) + EPS);
    u32x2* o = (u32x2*)(XB + (size_t)row * D);
#pragma unroll
    for (int j = 0; j < 4; ++j) { u32x2 w; w.x = pk2(v[j].x, v[j].y); w.y = pk2(v[j].z, v[j].w); o[lane + 64 * j] = w; }
    if (lane == 0) RSTD1[row] = rstd;
    float f[8];
#pragma unroll
    for (int h = 0; h < 8; ++h) f[h] = 0.f;
#pragma unroll
    for (int j = 0; j < 4; ++j)
#pragma unroll
        for (int e = 0; e < 4; ++e) {
            const int k = 4 * (lane + 64 * j) + e; const float xv = v[j][e] * g_mix[k];
            const f32x4 w0 = *(const f32x4*)(w_in + (size_t)k * INTOT + 1536), w1 = *(const f32x4*)(w_in + (size_t)k * INTOT + 1540);
            f[0] += xv * w0.x; f[1] += xv * w0.y; f[2] += xv * w0.z; f[3] += xv * w0.w; f[4] += xv * w1.x; f[5] += xv * w1.y; f[6] += xv * w1.z; f[7] += xv * w1.w;
        }
    const int b = row / SEQ, t = row % SEQ;
#pragma unroll
    for (int h = 0; h < 8; ++h) {
        const float tot = wave_sum(f[h]) * rstd + b_f[h];
        const float ls = fminf(tot, 0.f) - log1pf(__expf(-fabsf(tot)));
        if (lane == 0) LF[(size_t)(b * NH + h) * SEQ + t] = ls * LOG2E;
    }
}
template <int MODE> __global__ void k_wt(const float* W, int ldw, const float* g, bf16* Wt, int N, int K, int koff, int ldt) {
    const size_t i = (size_t)blockIdx.x * blockDim.x + threadIdx.x; if (i >= (size_t)N * K) return;
    const int n = (int)(i / K), k = (int)(i % K);
    const int s = MODE == 1 ? src_in(n) : n;
    const float gv = g ? g[k] : 1.f;
    Wt[(size_t)n * ldt + koff + k] = (bf16)f2bf(gv * W[(size_t)k * ldw + s]);
}
__global__ void k_ws(const float* wq, const float* k1, const float* k2, const float* g, bf16* WST) {
    const size_t i = (size_t)blockIdx.x * blockDim.x + threadIdx.x; if (i >= (size_t)NS * D) return;
    const int n = (int)(i / D), d = (int)(i % D), head = n >> 8, half = (n >> 7) & 1, key = n & 127;
    const float* kr = (half ? k2 : k1) + ((size_t)head * NKEYS + key) * 128;
    const float* qr = wq + (size_t)d * NS + head * 256 + half * 128;
    float s = 0.f;
    for (int e = 0; e < 128; ++e) s += qr[e] * kr[e];
    WST[(size_t)n * D + d] = (bf16)f2bf(g[d] * s);
}
__global__ void k_cvt(const float* in, const float* g, bf16* out, size_t n, int gmask) {
    const size_t i = (size_t)blockIdx.x * blockDim.x + threadIdx.x; if (i >= n) return;
    out[i] = (bf16)f2bf(in[i] * (g ? g[i & gmask] : 1.f));
}

template <class Epi, bool SPLIT2>
__global__ void __launch_bounds__(256) ng(const bf16* A, int lda, const bf16* Bt, int ldb, int K, Epi E) {
    __shared__ float As[32][68], Bs[32][68];
    const int tid = threadIdx.x, tx = tid & 15, ty = tid >> 4, m0 = blockIdx.y * 64, n0 = blockIdx.x * 64;
    float acc[4][4], acc2[4][4];
#pragma unroll
    for (int i = 0; i < 4; ++i)
#pragma unroll
        for (int j = 0; j < 4; ++j) { acc[i][j] = 0.f; acc2[i][j] = 0.f; }
    const int lr = tid >> 2, lk = (tid & 3) * 8;
    for (int k0 = 0; k0 < K; k0 += 32) {
        const u32x4 av = *(const u32x4*)(A + (size_t)(m0 + lr) * lda + k0 + lk), bv = *(const u32x4*)(Bt + (size_t)(n0 + lr) * ldb + k0 + lk);
#pragma unroll
        for (int e = 0; e < 4; ++e) {
            As[lk + 2 * e][lr] = __uint_as_float(av[e] << 16); As[lk + 2 * e + 1][lr] = __uint_as_float(av[e] & 0xffff0000u);
            Bs[lk + 2 * e][lr] = __uint_as_float(bv[e] << 16); Bs[lk + 2 * e + 1][lr] = __uint_as_float(bv[e] & 0xffff0000u);
        }
        __syncthreads();
        const bool second = SPLIT2 && (k0 >= K / 2);
#pragma unroll 8
        for (int kk = 0; kk < 32; ++kk) {
            float a[4], b[4];
#pragma unroll
            for (int i = 0; i < 4; ++i) { a[i] = As[kk][ty * 4 + i]; b[i] = Bs[kk][tx * 4 + i]; }
            if (second) {
#pragma unroll
                for (int i = 0; i < 4; ++i)
#pragma unroll
                    for (int j = 0; j < 4; ++j) acc2[i][j] += a[i] * b[j];
            } else {
#pragma unroll
                for (int i = 0; i < 4; ++i)
#pragma unroll
                    for (int j = 0; j < 4; ++j) acc[i][j] += a[i] * b[j];
            }
        }
        __syncthreads();
    }
#pragma unroll
    for (int i = 0; i < 4; ++i)
#pragma unroll
        for (int j = 0; j < 4; ++j) E(m0 + ty * 4 + i, n0 + tx * 4 + j, acc[i][j], acc2[i][j]);
}
struct E1 {
    const float* RSTD1; bf16 *Q, *K, *V, *GB, *SGA, *SGC; float *TGC, *TXC;
    __device__ void operator()(int row, int col, float a, float) const {
        const float v = RSTD1[row] * a; const int pn = col >> 8;
        if (pn < 2) Q[(size_t)row * AW + col] = (bf16)f2bf(v * C2);
        else if (pn < 4) K[(size_t)row * AW + col - 512] = (bf16)f2bf(v);
        else if (pn < 6) V[(size_t)row * AW + col - 1024] = (bf16)f2bf(v);
        else if (pn < 8) GB[(size_t)row * AW + col - 1536] = (bf16)f2bf(v);
        else if (pn < 12) { const int j = pn - 8, l = col & 255; if (l < 128) TGC[(size_t)row * AW + 128 * j + l] = v; else TXC[(size_t)row * AW + 128 * j + l - 128] = v; }
        else if (pn < 16) SGA[(size_t)row * D + col - 3072] = (bf16)f2bf(sigmoidf_(v));
        else SGC[(size_t)row * D + col - 4096] = (bf16)f2bf(sigmoidf_(v));
    }
};
struct EPP { bf16* PP; __device__ void operator()(int row, int col, float a, float) const { PP[(size_t)row * D + col] = (bf16)f2bf(a); } };
struct E3 { const bf16 *SGA, *SGC; bf16* MG;
    __device__ void operator()(int row, int col, float a, float a2) const { const size_t i = (size_t)row * D + col; MG[i] = (bf16)f2bf(bf2f(SGA[i]) * a + bf2f(SGC[i]) * a2); } };
struct E4 { const float* x; float* X1; bf16* XB1;
    __device__ void operator()(int row, int col, float a, float) const { const size_t i = (size_t)row * D + col; const float v = x[i] + a; X1[i] = v; XB1[i] = (bf16)f2bf(v); } };
struct E5 { float* SC; __device__ void operator()(int row, int col, float a, float) const { SC[(size_t)row * 1024 + col] = a; } };
struct E7 { const float* SS3; const bf16* PP; float* X; const bf16* XB2;
    __device__ void operator()(int row, int col, float a, float) const { const size_t i = (size_t)row * D + col; float q_ = 0.f; for (int j_ = 0; j_ < 16; ++j_) q_ += SS3[(size_t)row * 16 + j_]; X[i] = bf2f(XB2[i]) + sigmoidf_(a / sqrtf(q_ * (1.0f / D) + EPS)) * bf2f(PP[i]); } };

__global__ void k_z(const float* TGC, const float* TXC, bf16* Z) { const size_t i = (size_t)blockIdx.x * blockDim.x + threadIdx.x; if (i < (size_t)M * AW) Z[i] = (bf16)f2bf(TGC[i] * TXC[i]); }
__global__ void k_cumsum(const float* LF, float* CS) { const int bh = threadIdx.x; if (bh >= 32) return; float s = 0.f; for (int t = 0; t < SEQ; ++t) { s += LF[(size_t)bh * SEQ + t]; CS[(size_t)bh * SEQ + t] = s; } }
__global__ void k_conv(const bf16* GB, const bf16* Z, const float* cw, bf16* AC) {
    const size_t i = (size_t)blockIdx.x * blockDim.x + threadIdx.x; if (i >= (size_t)M * AW) return;
    const int row = (int)(i / AW), c = (int)(i % AW), t = row % SEQ;
    float s = cw[2 * AW + c] * bf2f(Z[i]);
    if (t >= 1) s += cw[1 * AW + c] * bf2f(Z[i - AW]);
    if (t >= 2) s += cw[0 * AW + c] * bf2f(Z[i - 2 * AW]);
    AC[(size_t)row * D + AW + c] = (bf16)f2bf(bf2f(GB[i]) * s);
}
__global__ void __launch_bounds__(64) k_attn(const bf16* Q, const bf16* K, const bf16* V, const float* CS, bf16* AC) {
    const int bh = blockIdx.y, b = bh / NH, h = bh % NH, q = blockIdx.x * 64 + threadIdx.x;
    const size_t rq = (size_t)b * SEQ + q;
    float qv[64], o[64];
#pragma unroll
    for (int d = 0; d < 64; ++d) { qv[d] = bf2f(Q[rq * AW + h * 64 + d]); o[d] = 0.f; }
    const float cq = CS[(size_t)bh * SEQ + q];
    float m = -INFINITY, l = 0.f;
    const int kvmax = blockIdx.x * 64 + 63;
    for (int kv = 0; kv <= kvmax; ++kv) {
        const size_t rk = (size_t)b * SEQ + kv;
        const u32x4* kp = (const u32x4*)(K + rk * AW + h * 64);
        float s = 0.f;
#pragma unroll
        for (int c = 0; c < 8; ++c) { const u32x4 w = kp[c];
#pragma unroll
            for (int e = 0; e < 4; ++e) { s += qv[c * 8 + 2 * e] * __uint_as_float(w[e] << 16) + qv[c * 8 + 2 * e + 1] * __uint_as_float(w[e] & 0xffff0000u); } }
        s += cq - CS[(size_t)bh * SEQ + kv];
        if (kv > q) s = -INFINITY;
        const float mn = fmaxf(m, s);
        const float al = (m == -INFINITY) ? 0.f : exp2f(m - mn), p = (s == -INFINITY) ? 0.f : exp2f(s - mn);
        l = l * al + p; m = mn;
        const u32x4* vp = (const u32x4*)(V + rk * AW + h * 64);
#pragma unroll
        for (int c = 0; c < 8; ++c) { const u32x4 w = vp[c];
#pragma unroll
            for (int e = 0; e < 4; ++e) { o[c * 8 + 2 * e] = o[c * 8 + 2 * e] * al + p * __uint_as_float(w[e] << 16); o[c * 8 + 2 * e + 1] = o[c * 8 + 2 * e + 1] * al + p * __uint_as_float(w[e] & 0xffff0000u); } }
    }
    const float il = 1.0f / l;
#pragma unroll
    for (int d = 0; d < 64; ++d) AC[rq * D + h * 64 + d] = (bf16)f2bf(o[d] * il);
}
__global__ void __launch_bounds__(256) k_rowss(const float* X, float* SS) {
    const int lane = threadIdx.x & 63, row = blockIdx.x * 4 + (threadIdx.x >> 6);
    const f32x4* xr = (const f32x4*)(X + (size_t)row * D); float ss = 0.f;
#pragma unroll
    for (int j = 0; j < 4; ++j) { const f32x4 v = xr[lane + 64 * j]; ss += v.x * v.x + v.y * v.y + v.z * v.z + v.w * v.w; }
    ss = wave_sum(ss);
    if (lane < 16) SS[(size_t)row * 16 + lane] = lane == 0 ? ss : 0.f;
}
__global__ void __launch_bounds__(64) k_topk(const float* SC, const float* SS2, int hg, unsigned short* IDS, float* GATES) {
    __shared__ float s[128][64]; __shared__ float tv[16][64]; __shared__ int ti[16][64];
    const int tid = threadIdx.x, pair = blockIdx.x * 32 + (tid >> 1), half = tid & 1, token = pair >> 2, hl = pair & 3;
    const float* src = SC + (size_t)token * 1024 + hl * 256 + half * 128;
    for (int k = 0; k < 128; ++k) s[k][tid] = src[k];
    float pv = INFINITY; int pk = -1;
    for (int r = 0; r < 16; ++r) {
        float best = -INFINITY; int bi = 0;
        for (int k = 0; k < 128; ++k) { const float v = s[k][tid]; const bool elig = (v < pv) || (v == pv && k > pk); if (elig && v > best) { best = v; bi = k; } }
        tv[r][tid] = best; ti[r][tid] = bi; pv = best; pk = bi;
    }
    __syncthreads();
    if (half == 0) {
        const float* ss = SS2 + (size_t)token * 16; float sst = 0.f; for (int q_ = 0; q_ < 16; ++q_) sst += ss[q_]; const float rstd = 1.0f / sqrtf(sst * (1.0f / D) + EPS);
        float ts[16]; int tf[16];
        float cpv = INFINITY; int cpf = -1;
#pragma unroll
        for (int r = 0; r < 16; ++r) {
            float best = -INFINITY; int bf_ = 0;
            for (int c = 0; c < 256; ++c) { const float v = tv[c >> 4][tid] + tv[c & 15][tid + 1]; const bool elig = (v < cpv) || (v == cpv && c > cpf); if (elig && v > best) { best = v; bf_ = c; } }
            ts[r] = best; tf[r] = bf_; cpv = best; cpf = bf_;
        }
        float e[16], sum = 0.f;
#pragma unroll
        for (int r = 0; r < 16; ++r) { e[r] = __expf(rstd * (ts[r] - ts[0])); sum += e[r]; }
        const float inv = 1.0f / sum; const int head = hg * 4 + hl;
#pragma unroll
        for (int r = 0; r < 16; ++r) { IDS[(size_t)token * 128 + head * 16 + r] = (unsigned short)(ti[tf[r] >> 4][tid] * 128 + ti[tf[r] & 15][tid + 1]); GATES[(size_t)token * 128 + head * 16 + r] = e[r] * inv; }
    }
}
__global__ void __launch_bounds__(256) k_peer(const bf16* XB1, const float* SS2, const unsigned short* IDS, const float* GATES, const bf16* UB, const bf16* VB, float* X, bf16* XB2, float* RSTD3) {
    const int lane = threadIdx.x & 63, token = blockIdx.x * 4 + (threadIdx.x >> 6);
    const float* ss = SS2 + (size_t)token * 16; float sst = 0.f; for (int q_ = 0; q_ < 16; ++q_) sst += ss[q_]; const float rstd = 1.0f / sqrtf(sst * (1.0f / D) + EPS);
    float xf[16], out[16];
    { const u32x4 a = *(const u32x4*)(XB1 + (size_t)token * D + 8 * lane), b = *(const u32x4*)(XB1 + (size_t)token * D + 512 + 8 * lane);
#pragma unroll
      for (int e = 0; e < 4; ++e) { xf[2 * e] = __uint_as_float(a[e] << 16); xf[2 * e + 1] = __uint_as_float(a[e] & 0xffff0000u); xf[8 + 2 * e] = __uint_as_float(b[e] << 16); xf[8 + 2 * e + 1] = __uint_as_float(b[e] & 0xffff0000u); } }
#pragma unroll
    for (int i = 0; i < 16; ++i) out[i] = 0.f;
    for (int hk = 0; hk < 128; ++hk) {
        const int id = IDS[(size_t)token * 128 + hk]; const float g = GATES[(size_t)token * 128 + hk];
        const u32x4 a = *(const u32x4*)(UB + (size_t)id * D + 8 * lane), b = *(const u32x4*)(UB + (size_t)id * D + 512 + 8 * lane);
        float dot = 0.f;
#pragma unroll
        for (int e = 0; e < 4; ++e) { dot += xf[2 * e] * __uint_as_float(a[e] << 16) + xf[2 * e + 1] * __uint_as_float(a[e] & 0xffff0000u) + xf[8 + 2 * e] * __uint_as_float(b[e] << 16) + xf[8 + 2 * e + 1] * __uint_as_float(b[e] & 0xffff0000u); }
        dot = wave_sum(dot) * rstd;
        const float w = g * 0.5f * dot * (1.0f + erff(dot * 0.70710678118654752f));
        const u32x4 va = *(const u32x4*)(VB + (size_t)id * D + 8 * lane), vb = *(const u32x4*)(VB + (size_t)id * D + 512 + 8 * lane);
#pragma unroll
        for (int e = 0; e < 4; ++e) { out[2 * e] += w * __uint_as_float(va[e] << 16); out[2 * e + 1] += w * __uint_as_float(va[e] & 0xffff0000u); out[8 + 2 * e] += w * __uint_as_float(vb[e] << 16); out[8 + 2 * e + 1] += w * __uint_as_float(vb[e] & 0xffff0000u); }
    }
    float* xr = X + (size_t)token * D; float s2 = 0.f;
    f32x4 x0, x1, x2, x3;
    for (int e = 0; e < 4; ++e) { x0[e] = xf[e]; x1[e] = xf[4 + e]; x2[e] = xf[8 + e]; x3[e] = xf[12 + e]; }
#pragma unroll
    for (int e = 0; e < 4; ++e) { x0[e] += out[e]; x1[e] += out[4 + e]; x2[e] += out[8 + e]; x3[e] += out[12 + e]; s2 += x0[e] * x0[e] + x1[e] * x1[e] + x2[e] * x2[e] + x3[e] * x3[e]; }
    *(f32x4*)(xr + 8 * lane) = x0; *(f32x4*)(xr + 8 * lane + 4) = x1; *(f32x4*)(xr + 512 + 8 * lane) = x2; *(f32x4*)(xr + 512 + 8 * lane + 4) = x3;
    u32x4 w0, w1; w0.x = pk2(x0.x, x0.y); w0.y = pk2(x0.z, x0.w); w0.z = pk2(x1.x, x1.y); w0.w = pk2(x1.z, x1.w); w1.x = pk2(x2.x, x2.y); w1.y = pk2(x2.z, x2.w); w1.z = pk2(x3.x, x3.y); w1.w = pk2(x3.z, x3.w);
    *(u32x4*)(XB2 + (size_t)token * D + 8 * lane) = w0; *(u32x4*)(XB2 + (size_t)token * D + 512 + 8 * lane) = w1;
    s2 = wave_sum(s2);
    if (lane < 16) RSTD3[(size_t)token * 16 + lane] = lane == 0 ? s2 : 0.f;
}
__global__ void __launch_bounds__(256) k_final(float* X, const float* g) {
    const int lane = threadIdx.x & 63, row = blockIdx.x * 4 + (threadIdx.x >> 6);
    f32x4* xr = (f32x4*)(X + (size_t)row * D); f32x4 v[4]; float ss = 0.f;
#pragma unroll
    for (int j = 0; j < 4; ++j) { v[j] = xr[lane + 64 * j]; ss += v[j].x * v[j].x + v[j].y * v[j].y + v[j].z * v[j].z + v[j].w * v[j].w; }
    ss = wave_sum(ss); const float rstd = 1.0f / sqrtf(ss * (1.0f / D) + EPS);
#pragma unroll
    for (int j = 0; j < 4; ++j) { const f32x4 gv = ((const f32x4*)g)[lane + 64 * j]; xr[lane + 64 * j] = v[j] * rstd * gv; }
}

}

#ifndef MK_FUSED_MASK
#define MK_FUSED_MASK 0x1ff
#endif
static void golden_phase(int ph, void* const* d_in, float* out, unsigned char* ws, hipStream_t stream) {
    using namespace gold;
    const float* x = (const float*)d_in[0]; const float* p = (const float*)d_in[1]; const float* g_mix = (const float*)d_in[2]; const float* w_in = (const float*)d_in[3];
    const float* b_f = (const float*)d_in[4]; const float* conv_w = (const float*)d_in[5]; const float* w_branch = (const float*)d_in[6]; const float* w_out = (const float*)d_in[7];
    const float* g_ffn = (const float*)d_in[8]; const float* w_peer_q = (const float*)d_in[9]; const float* peer_k1 = (const float*)d_in[10]; const float* peer_k2 = (const float*)d_in[11];
    const float* peer_u = (const float*)d_in[12]; const float* peer_v = (const float*)d_in[13]; const float* g_ple = (const float*)d_in[14]; const float* w_ple_gate = (const float*)d_in[15];
    const float* w_ple_proj = (const float*)d_in[16]; const float* g_final = (const float*)d_in[17];
    float *RSTD1 = (float*)(ws + WS_RSTD1), *SS2 = (float*)(ws + WS_SS2), *LF = (float*)(ws + WS_LF), *CS = (float*)(ws + WS_CS);
    bf16 *WIN = (bf16*)(ws + WS_WIN), *WBR = (bf16*)(ws + WS_WBR), *WOUT = (bf16*)(ws + WS_WOUT), *WST = (bf16*)(ws + WS_WS), *WPG = (bf16*)(ws + WS_WPG), *WPP = (bf16*)(ws + WS_WPP), *PB = (bf16*)(ws + WS_PB);
    bf16 *UB = (bf16*)(ws + WS_UB), *VB = (bf16*)(ws + WS_VB), *XB = (bf16*)(ws + WS_A), *AC = (bf16*)(ws + WS_AC), *XB1 = (bf16*)(ws + WS_A), *PP = (bf16*)(ws + WS_PP);
    bf16 *Q = (bf16*)(ws + WS_Q), *K = (bf16*)(ws + WS_K), *V = (bf16*)(ws + WS_V), *GB = (bf16*)(ws + WS_GB), *Z = (bf16*)(ws + WS_Z), *MG = (bf16*)(ws + WS_MERGED), *XB2 = (bf16*)(ws + WS_XB2);
    unsigned short* IDS = (unsigned short*)(ws + WS_IDS); float* GATES = (float*)(ws + WS_GATES);
    bf16 *SGA = (bf16*)out, *SGC = (bf16*)out + (size_t)M * D;
    float *TGC = (float*)(ws + WS_TGC), *TXC = (float*)(ws + WS_TXC), *SC = (float*)(ws + WS_SC);
    auto nb = [](size_t n) { return (unsigned)((n + 255) / 256); };
    switch (ph) {
    case 0:
        k_rows0<<<M / 4, 256, 0, stream>>>(x, w_in, g_mix, b_f, XB, RSTD1, LF);
        k_wt<1><<<nb((size_t)NIN * D), 256, 0, stream>>>(w_in, INTOT, g_mix, WIN, NIN, D, 0, D);
        k_wt<0><<<nb((size_t)D * AW), 256, 0, stream>>>(w_branch, D, nullptr, WBR, D, AW, 0, D);
        k_wt<0><<<nb((size_t)D * AW), 256, 0, stream>>>(w_branch + (size_t)AW * D, D, nullptr, WBR, D, AW, AW, D);
        k_wt<0><<<nb((size_t)D * D), 256, 0, stream>>>(w_out, D, nullptr, WOUT, D, D, 0, D);
        k_wt<0><<<nb((size_t)D * D), 256, 0, stream>>>(w_ple_gate, D, g_ple, WPG, D, D, 0, D);
        k_wt<0><<<nb((size_t)D * PLE), 256, 0, stream>>>(w_ple_proj, D, nullptr, WPP, D, PLE, 0, PLE);
        k_ws<<<nb((size_t)NS * D), 256, 0, stream>>>(w_peer_q, peer_k1, peer_k2, g_ffn, WST);
        k_cvt<<<nb((size_t)M * PLE), 256, 0, stream>>>(p, nullptr, PB, (size_t)M * PLE, 0);
        break;
    case 1:
        ng<E1, false><<<dim3(NIN / 64, M / 64), 256, 0, stream>>>(XB, D, WIN, D, D, E1{RSTD1, Q, K, V, GB, SGA, SGC, TGC, TXC});
        ng<EPP, false><<<dim3(D / 64, M / 64), 256, 0, stream>>>(PB, PLE, WPP, PLE, PLE, EPP{PP});
        k_z<<<nb((size_t)M * AW), 256, 0, stream>>>(TGC, TXC, Z);
        break;
    case 2:
        k_cumsum<<<1, 64, 0, stream>>>(LF, CS);
        k_conv<<<nb((size_t)M * AW), 256, 0, stream>>>(GB, Z, conv_w, AC);
        k_attn<<<dim3(SEQ / 64, BATCH * NH), 64, 0, stream>>>(Q, K, V, CS, AC);
        break;
    case 3: ng<E3, true><<<dim3(D / 64, M / 64), 256, 0, stream>>>(AC, D, WBR, D, D, E3{SGA, SGC, MG}); break;
    case 4:
        ng<E4, false><<<dim3(D / 64, M / 64), 256, 0, stream>>>(MG, D, WOUT, D, D, E4{x, out, XB1});
        k_rowss<<<M / 4, 256, 0, stream>>>(out, SS2);
        break;
    case 5:
        for (int hg = 0; hg < 2; ++hg) {
            ng<E5, false><<<dim3(1024 / 64, M / 64), 256, 0, stream>>>(XB1, D, WST + (size_t)hg * 1024 * D, D, D, E5{SC});
            k_topk<<<M * 4 / 32, 64, 0, stream>>>(SC, SS2, hg, IDS, GATES);
        }
        break;
    case 6:
        k_cvt<<<nb((size_t)NEXP * D), 256, 0, stream>>>(peer_u, g_ffn, UB, (size_t)NEXP * D, D - 1);
        k_cvt<<<nb((size_t)NEXP * D), 256, 0, stream>>>(peer_v, nullptr, VB, (size_t)NEXP * D, 0);
        k_peer<<<M / 4, 256, 0, stream>>>(XB1, SS2, IDS, GATES, UB, VB, out, XB2, SS2);
        break;
    case 7: ng<E7, false><<<dim3(D / 64, M / 64), 256, 0, stream>>>(XB2, D, WPG, D, D, E7{SS2, PP, out, XB2}); break;
    case 8: k_final<<<M / 4, 256, 0, stream>>>(out, g_final); break;
    }
}
extern "C" void kernel_launch(void* const* d_in, const int* in_sizes, int n_in, void* d_out, int out_size, void* d_ws, size_t ws_size, hipStream_t stream) {
    static int grid = 0;
    if (grid == 0) {
        if (n_in != 18 || in_sizes[0] != M * D || out_size != M * D || ws_size < WS_END) { fprintf(stderr, "kernel_launch: unexpected shapes (n_in %d, in0 %d, out %d, ws %zu); nothing launched\n", n_in, n_in > 0 ? in_sizes[0] : -1, out_size, ws_size); grid = -1; return; }
        int dev = 0, cus = 0, per_cu = 0;
        if (hipGetDevice(&dev) != hipSuccess || hipDeviceGetAttribute(&cus, hipDeviceAttributeMultiprocessorCount, dev) != hipSuccess) { fprintf(stderr, "kernel_launch: device query failed\n"); grid = -1; return; }
        if (hipFuncSetAttribute((const void*)mk_fwd, hipFuncAttributeMaxDynamicSharedMemorySize, LDS_BYTES) != hipSuccess) { fprintf(stderr, "kernel_launch: hipFuncSetAttribute failed\n"); grid = -1; return; }
        if (hipOccupancyMaxActiveBlocksPerMultiprocessor(&per_cu, (const void*)mk_fwd, NWAVES * 64, LDS_BYTES) != hipSuccess || per_cu < 1) { fprintf(stderr, "kernel_launch: occupancy query says %d workgroups per CU; nothing launched\n", per_cu); (void)hipGetLastError(); grid = -1; return; }
        grid = cus;
    }
    if (grid < 0) return;
    if (hipMemsetAsync((char*)d_ws + WS_CTL, 0, CTL_ZERO_BYTES, stream) != hipSuccess) { fprintf(stderr, "kernel_launch: hipMemsetAsync failed\n"); return; }
    Args a{};
    for (int i = 0; i < 18; ++i) a.in[i] = (const float*)d_in[i];
    a.out = (float*)d_out; a.ws = (unsigned char*)d_ws;
    int li = 0;
    for (int ph = 0; ph < NPHASE;) {
        if ((MK_FUSED_MASK >> ph) & 1) {
            int hi = ph; while (hi < NPHASE && ((MK_FUSED_MASK >> hi) & 1)) ++hi;
            a.ph_lo = ph; a.ph_hi = hi; a.li = li++; a.pad = 0;
            hipLaunchKernelGGL(mk_fwd, dim3(grid), dim3(NWAVES * 64), LDS_BYTES, stream, a);
            const hipError_t le = hipPeekAtLastError();
            if (le != hipSuccess) { fprintf(stderr, "kernel_launch: launch failed: %s\n", hipGetErrorName(le)); return; }
            ph = hi;
        } else {
            golden_phase(ph, d_in, (float*)d_out, (unsigned char*)d_ws, stream);
            if ((ph == 1 || ph == 5) && (MK_FUSED_MASK & 1) && ((MK_FUSED_MASK >> 6) & 1)) {
                gold::k_cvt<<<(unsigned)(((size_t)NEXP * D + 255) / 256), 256, 0, stream>>>((const float*)d_in[12], (const float*)d_in[8], (bf16*)((unsigned char*)d_ws + WS_UB), (size_t)NEXP * D, D - 1);
                gold::k_cvt<<<(unsigned)(((size_t)NEXP * D + 255) / 256), 256, 0, stream>>>((const float*)d_in[13], nullptr, (bf16*)((unsigned char*)d_ws + WS_VB), (size_t)NEXP * D, 0);
            }
            ++ph;
        }
    }
}
```

```cpp
#include <hip/hip_runtime.h>
#include <hip/hip_bf16.h>
#include <cstdio>
#include <cstdint>
#include <cmath>
#define MK_FUSED_MASK 0x1ff
namespace pg8 {
#define PG8_LAS __attribute__((address_space(3)))
typedef unsigned short bf16_t;
typedef short bf16x8 __attribute__((ext_vector_type(8)));
typedef float f32x4 __attribute__((ext_vector_type(4)));
typedef unsigned u32x4 __attribute__((ext_vector_type(4)));
constexpr int BM = 256, BK = 64, HALF = 128, HTB = HALF * BK * 2  , STAGE_BYTES = 8 * HTB, NXCD = 8, WGM = 8;

__host__ __device__ __forceinline__ int lds_byte(int r, int c) { const int st = (r >> 4) * 2 + (c >> 5), rr = r & 15, cc = c & 31, ob = rr * 64 + cc * 2; return st * 1024 + (ob ^ (((ob >> 9) & 1) << 5)); }
__host__ __device__ __forceinline__ void stage_rc(int b, int& R, int& C) { const int st = b / 1024, sb = b % 1024, swz = sb ^ (((sb >> 9) & 1) << 5); R = (st >> 1) * 16 + swz / 64; C = (st & 1) * 32 + (swz % 64) / 2; }
__host__ __device__ __forceinline__ int perm32(int rho) { const int n = rho >> 4, i = rho & 15; return 8 * (i >> 2) + 4 * n + (i & 3); }

struct Unit { int pm, pn; };
struct Gemm { const bf16_t* A; const bf16_t* Bt; int M, N, K; };

struct StaticOrder {
    int nM, nN, nwg, G, c;
    __host__ __device__ __forceinline__ void init(int M, int N, int G_, int c_) { nM = M / BM; nN = N / BM; nwg = nM * nN; G = G_; c = c_; }
    __host__ __device__ __forceinline__ bool next(int i, Unit& u) const {
        const long L = (long)i * G + c; if (L >= nwg) return false;
        int wgid = (int)L; { const int q = nwg / NXCD, r = nwg % NXCD, xcd = wgid % NXCD, off = wgid / NXCD; wgid = (xcd < r ? xcd * (q + 1) : r * (q + 1) + (xcd - r) * q) + off; }
        const int nig = WGM * nN, gid = wgid / nig, fm = gid * WGM, gsz = (nM - fm) < WGM ? (nM - fm) : WGM;
        u.pm = fm + ((wgid % nig) % gsz); u.pn = (wgid % nig) / gsz; return true;
    }
    __device__ __forceinline__ void a_ready(const Unit&) const {}
    __device__ __forceinline__ void done(const Unit&) const {}
};


__device__ __forceinline__ unsigned cvt_pk_bf16(float lo, float hi) { unsigned r; asm volatile("v_cvt_pk_bf16_f32 %0, %1, %2" : "=v"(r) : "v"(lo), "v"(hi)); return r; }
__device__ __forceinline__ u32x4 pack8(const f32x4 v0, const f32x4 v1) { u32x4 w; w.x = cvt_pk_bf16(v0[0], v0[1]); w.y = cvt_pk_bf16(v0[2], v0[3]); w.z = cvt_pk_bf16(v1[0], v1[1]); w.w = cvt_pk_bf16(v1[2], v1[3]); return w; }
__device__ __forceinline__ float bflo(unsigned w) { return __uint_as_float(w << 16); }
__device__ __forceinline__ float bfhi(unsigned w) { return __uint_as_float(w & 0xffff0000u); }
__device__ __forceinline__ float sigm(float v) { return __builtin_amdgcn_rcpf(1.0f + __builtin_amdgcn_exp2f(v * -1.4426950408889634f)); }
__device__ __forceinline__ f32x4 sigm4(const f32x4 v) { return (f32x4){sigm(v[0]), sigm(v[1]), sigm(v[2]), sigm(v[3])}; }

struct EpiIn {
    static constexpr int PROBE_ID = 1;
    static constexpr bool PERM = true, AFTER_DRAIN = false; static constexpr int MID_T = 0;
    const float* rstd; bf16_t* QKVG; size_t stride4; bf16_t* Z; bf16_t* SG; size_t strideSG; float c2;
    __device__ __forceinline__ void operator()(const f32x4 (&acc)[2][2][4][2], const Unit& u, int wr, int wc, int fr, int fq) const {
        int t_l = (int)threadIdx.x; asm volatile("" : "+v"(t_l)); fr = t_l & 15; fq = (t_l >> 4) & 3; wc = (t_l >> 6) & 3; wr = t_l >> 8;
        const int row0 = u.pm * BM + wr * 64 + fr; const int cl = wc * 32 + 8 * fq, pn = u.pn;
        if (pn < 8) {
            bf16_t* base = QKVG + (size_t)(pn >> 1) * stride4; const int colt = (pn & 1) * 256 + cl; const float s0 = pn < 2 ? c2 : 1.f;
#pragma unroll
            for (int ai = 0; ai < 2; ++ai)
#pragma unroll
                for (int m = 0; m < 4; ++m) { const int row = row0 + ai * HALF + m * 16; const float sc = rstd[row] * s0; bf16_t* rowp = base + (size_t)row * 512 + colt;
#pragma unroll
                    for (int bj = 0; bj < 2; ++bj) *(u32x4*)(rowp + bj * HALF) = pack8(acc[ai][bj][m][0] * sc, acc[ai][bj][m][1] * sc);
                    asm volatile("" ::: "memory"); }
        } else if (pn < 12) {
            const int colt = (pn - 8) * 128 + cl;
#pragma unroll
            for (int ai = 0; ai < 2; ++ai)
#pragma unroll
                for (int m = 0; m < 4; ++m) { const int row = row0 + ai * HALF + m * 16; const float r = rstd[row], sc = r * r;
                    *(u32x4*)(Z + (size_t)row * 512 + colt) = pack8(acc[ai][0][m][0] * acc[ai][1][m][0] * sc, acc[ai][0][m][1] * acc[ai][1][m][1] * sc);
                    asm volatile("" ::: "memory"); }
        } else {
            bf16_t* base = SG + (size_t)((pn - 12) >> 2) * strideSG; const int colt = ((pn - 12) & 3) * 256 + cl;
#pragma unroll
            for (int ai = 0; ai < 2; ++ai)
#pragma unroll
                for (int m = 0; m < 4; ++m) { const int row = row0 + ai * HALF + m * 16; const float r = rstd[row]; bf16_t* rowp = base + (size_t)row * 1024 + colt;
#pragma unroll
                    for (int bj = 0; bj < 2; ++bj) { *(u32x4*)(rowp + bj * HALF) = pack8(sigm4(acc[ai][bj][m][0] * r), sigm4(acc[ai][bj][m][1] * r)); asm volatile("" ::: "memory"); } }
        }
    }
};
struct EpiPlain {
    static constexpr int PROBE_ID = 2;
    static constexpr bool PERM = true, AFTER_DRAIN = false; static constexpr int MID_T = 0;
    bf16_t* O; int ldc;
    __device__ __forceinline__ void operator()(const f32x4 (&acc)[2][2][4][2], const Unit& u, int wr, int wc, int fr, int fq) const {
        int t_l = (int)threadIdx.x; asm volatile("" : "+v"(t_l)); fr = t_l & 15; fq = (t_l >> 4) & 3; wc = (t_l >> 6) & 3; wr = t_l >> 8;
        const int row0 = u.pm * BM + wr * 64 + fr; const int col0 = u.pn * BM + wc * 32 + 8 * fq;
#pragma unroll
        for (int ai = 0; ai < 2; ++ai)
#pragma unroll
            for (int m = 0; m < 4; ++m) { bf16_t* rowp = O + (size_t)(row0 + ai * HALF + m * 16) * ldc + col0;
#pragma unroll
                for (int bj = 0; bj < 2; ++bj) *(u32x4*)(rowp + bj * HALF) = pack8(acc[ai][bj][m][0], acc[ai][bj][m][1]); }
    }
};
struct EpiBranch {
    static constexpr int PROBE_ID = 3;
    static constexpr bool PERM = true, AFTER_DRAIN = false; static constexpr int MID_T = 8;
    const bf16_t *SGA, *SGC; bf16_t* MG;
    __device__ __forceinline__ void mid(f32x4 (&acc)[2][2][4][2], const Unit& u, int wr, int wc, int fr, int fq) const {
        int t_l = (int)threadIdx.x; asm volatile("" : "+v"(t_l)); fr = t_l & 15; fq = (t_l >> 4) & 3; wc = (t_l >> 6) & 3; wr = t_l >> 8;
        const int row0 = u.pm * BM + wr * 64 + fr; const int col0 = u.pn * BM + wc * 32 + 8 * fq;
#pragma unroll
        for (int ai = 0; ai < 2; ++ai) {
            u32x4 a[4][2], c[4][2];
#pragma unroll
            for (int m = 0; m < 4; ++m)
#pragma unroll
                for (int bj = 0; bj < 2; ++bj) { const size_t off = (size_t)(row0 + ai * HALF + m * 16) * 1024 + col0 + bj * HALF; a[m][bj] = *(const u32x4*)(SGA + off); c[m][bj] = *(const u32x4*)(SGC + off); }
#pragma unroll
            for (int m = 0; m < 4; ++m)
#pragma unroll
                for (int bj = 0; bj < 2; ++bj) { const u32x4 av = a[m][bj], cv = c[m][bj]; f32x4 r0, r1;
                    r0[0] = bflo(av[0]) * __builtin_amdgcn_rcpf(bflo(cv[0])); r0[1] = bfhi(av[0]) * __builtin_amdgcn_rcpf(bfhi(cv[0])); r0[2] = bflo(av[1]) * __builtin_amdgcn_rcpf(bflo(cv[1])); r0[3] = bfhi(av[1]) * __builtin_amdgcn_rcpf(bfhi(cv[1]));
                    r1[0] = bflo(av[2]) * __builtin_amdgcn_rcpf(bflo(cv[2])); r1[1] = bfhi(av[2]) * __builtin_amdgcn_rcpf(bfhi(cv[2])); r1[2] = bflo(av[3]) * __builtin_amdgcn_rcpf(bflo(cv[3])); r1[3] = bfhi(av[3]) * __builtin_amdgcn_rcpf(bfhi(cv[3]));
                    acc[ai][bj][m][0] *= r0; acc[ai][bj][m][1] *= r1; }
            asm volatile("" ::: "memory");
        }
    }
    __device__ __forceinline__ void operator()(const f32x4 (&acc)[2][2][4][2], const Unit& u, int wr, int wc, int fr, int fq) const {
        int t_l = (int)threadIdx.x; asm volatile("" : "+v"(t_l)); fr = t_l & 15; fq = (t_l >> 4) & 3; wc = (t_l >> 6) & 3; wr = t_l >> 8;
        const int row0 = u.pm * BM + wr * 64 + fr; const int col0 = u.pn * BM + wc * 32 + 8 * fq;
#pragma unroll
        for (int ai = 0; ai < 2; ++ai) {
            u32x4 c[4][2];
#pragma unroll
            for (int m = 0; m < 4; ++m)
#pragma unroll
                for (int bj = 0; bj < 2; ++bj) c[m][bj] = *(const u32x4*)(SGC + (size_t)(row0 + ai * HALF + m * 16) * 1024 + col0 + bj * HALF);
#pragma unroll
            for (int m = 0; m < 4; ++m)
#pragma unroll
                for (int bj = 0; bj < 2; ++bj) { const u32x4 cv = c[m][bj];
                    const f32x4 s0 = {bflo(cv[0]), bfhi(cv[0]), bflo(cv[1]), bfhi(cv[1])}, s1 = {bflo(cv[2]), bfhi(cv[2]), bflo(cv[3]), bfhi(cv[3])};
                    *(u32x4*)(MG + (size_t)(row0 + ai * HALF + m * 16) * 1024 + col0 + bj * HALF) = pack8(acc[ai][bj][m][0] * s0, acc[ai][bj][m][1] * s1); }
            asm volatile("" ::: "memory");
        }
    }
};
struct EpiOut {
    static constexpr int PROBE_ID = 4;
    static constexpr bool PERM = true, AFTER_DRAIN = false; static constexpr int MID_T = 0;
    const bf16_t* XBin; bf16_t* XB1; float* SS2;
    __device__ __forceinline__ void operator()(const f32x4 (&acc)[2][2][4][2], const Unit& u, int wr, int wc, int fr, int fq) const {
        int t_l = (int)threadIdx.x; asm volatile("" : "+v"(t_l)); fr = t_l & 15; fq = (t_l >> 4) & 3; wc = (t_l >> 6) & 3; wr = t_l >> 8;
        const int row0 = u.pm * BM + wr * 64 + fr; const int col0 = u.pn * BM + wc * 32 + 8 * fq;
#pragma unroll
        for (int ai = 0; ai < 2; ++ai) {
            u32x4 xq[4][2];
#pragma unroll
            for (int m = 0; m < 4; ++m)
#pragma unroll
                for (int bj = 0; bj < 2; ++bj) xq[m][bj] = *(const u32x4*)(XBin + (size_t)(row0 + ai * HALF + m * 16) * 1024 + col0 + bj * HALF);
#pragma unroll
            for (int m = 0; m < 4; ++m) { const int row = row0 + ai * HALF + m * 16; float ss = 0.f;
#pragma unroll
                for (int bj = 0; bj < 2; ++bj) { const u32x4 q = xq[m][bj];
                    const f32x4 v0 = acc[ai][bj][m][0] + (f32x4){bflo(q[0]), bfhi(q[0]), bflo(q[1]), bfhi(q[1])}, v1 = acc[ai][bj][m][1] + (f32x4){bflo(q[2]), bfhi(q[2]), bflo(q[3]), bfhi(q[3])};
                    *(u32x4*)(XB1 + (size_t)row * 1024 + col0 + bj * HALF) = pack8(v0, v1);
                    ss += (v0[0] * v0[0] + v0[1] * v0[1]) + (v0[2] * v0[2] + v0[3] * v0[3]) + (v1[0] * v1[0] + v1[1] * v1[1]) + (v1[2] * v1[2] + v1[3] * v1[3]); }
                ss += __shfl_xor(ss, 16); ss += __shfl_xor(ss, 32);
                if (fq == 0) SS2[(size_t)row * 16 + u.pn * 4 + wc] = ss; }
            asm volatile("" ::: "memory");
        }
    }
};
struct EpiPle {
    static constexpr int PROBE_ID = 7;
    static constexpr bool PERM = true, AFTER_DRAIN = false; static constexpr int MID_T = 0;
    const float* SS3; const bf16_t* PP; const bf16_t* XB2; bf16_t* XB3; float* SS4; float eps; const PG8_LAS float* rtab;
    __device__ __forceinline__ void operator()(const f32x4 (&acc)[2][2][4][2], const Unit& u, int wr, int wc, int fr, int fq) const {
        int t_l = (int)threadIdx.x; asm volatile("" : "+v"(t_l)); fr = t_l & 15; fq = (t_l >> 4) & 3; wc = (t_l >> 6) & 3; wr = t_l >> 8;
        const int row0 = u.pm * BM + wr * 64 + fr; const int col0 = u.pn * BM + wc * 32 + 8 * fq;
#pragma unroll
        for (int ai = 0; ai < 2; ++ai) {
            u32x4 pv[4][2], xb[4][2]; float rr[4];
#pragma unroll
            for (int m = 0; m < 4; ++m) { const int row = row0 + ai * HALF + m * 16;
#pragma unroll
                for (int bj = 0; bj < 2; ++bj) { const size_t off = (size_t)row * 1024 + col0 + bj * HALF; pv[m][bj] = *(const u32x4*)(PP + off); xb[m][bj] = *(const u32x4*)(XB2 + off); }
                if (rtab) rr[m] = rtab[wr * 64 + fr + ai * HALF + m * 16];
                else { const f32x4* sp = (const f32x4*)(SS3 + (size_t)row * 16); const f32x4 q0 = sp[0], q1 = sp[1]; rr[m] = 1.0f / sqrtf((((q0[0] + q0[1]) + (q0[2] + q0[3])) + ((q1[0] + q1[1]) + (q1[2] + q1[3]))) * (1.0f / 1024.0f) + eps); } }
#pragma unroll
            for (int m = 0; m < 4; ++m) { const int row = row0 + ai * HALF + m * 16; const float r = rr[m]; float ss = 0.f;
#pragma unroll
                for (int bj = 0; bj < 2; ++bj) { const u32x4 c = pv[m][bj], xq = xb[m][bj]; const size_t off = (size_t)row * 1024 + col0 + bj * HALF;
                    const f32x4 p0 = {bflo(c[0]), bfhi(c[0]), bflo(c[1]), bfhi(c[1])}, p1 = {bflo(c[2]), bfhi(c[2]), bflo(c[3]), bfhi(c[3])};
                    const f32x4 x0 = {bflo(xq[0]), bfhi(xq[0]), bflo(xq[1]), bfhi(xq[1])}, x1 = {bflo(xq[2]), bfhi(xq[2]), bflo(xq[3]), bfhi(xq[3])};
                    const f32x4 v0 = x0 + sigm4(acc[ai][bj][m][0] * r) * p0, v1 = x1 + sigm4(acc[ai][bj][m][1] * r) * p1;
                    *(u32x4*)(XB3 + off) = pack8(v0, v1);
                    ss += (v0[0] * v0[0] + v0[1] * v0[1]) + (v0[2] * v0[2] + v0[3] * v0[3]) + (v1[0] * v1[0] + v1[1] * v1[1]) + (v1[2] * v1[2] + v1[3] * v1[3]); }
                ss += __shfl_xor(ss, 16); ss += __shfl_xor(ss, 32);
                if (fq == 0) SS4[(size_t)row * 16 + u.pn * 4 + wc] = ss; }
            asm volatile("" ::: "memory");
        }
    }
};

__device__ __forceinline__ float vmaxf(float a, float b) { float r; asm("v_max_f32_e32 %0, %1, %2" : "=v"(r) : "v"(a), "v"(b)); return r; }
__device__ __forceinline__ float vminf(float a, float b) { float r; asm("v_min_f32_e32 %0, %1, %2" : "=v"(r) : "v"(a), "v"(b)); return r; }
__device__ __forceinline__ void sort16_desc(float (&a)[16]) {
#define TK_CE(i, j) do { const float hi_ = vmaxf(a[i], a[j]), lo_ = vminf(a[i], a[j]); a[i] = hi_; a[j] = lo_; } while (0)
    TK_CE(0, 13); TK_CE(1, 12); TK_CE(2, 15); TK_CE(3, 14); TK_CE(4, 8); TK_CE(5, 6); TK_CE(7, 11); TK_CE(9, 10);
    TK_CE(0, 5); TK_CE(1, 7); TK_CE(2, 9); TK_CE(3, 4); TK_CE(6, 13); TK_CE(8, 14); TK_CE(10, 15); TK_CE(11, 12);
    TK_CE(0, 1); TK_CE(2, 3); TK_CE(4, 5); TK_CE(6, 8); TK_CE(7, 9); TK_CE(10, 11); TK_CE(12, 13); TK_CE(14, 15);
    TK_CE(0, 2); TK_CE(1, 3); TK_CE(4, 10); TK_CE(5, 11); TK_CE(6, 7); TK_CE(8, 9); TK_CE(12, 14); TK_CE(13, 15);
    TK_CE(1, 2); TK_CE(3, 12); TK_CE(4, 6); TK_CE(5, 7); TK_CE(8, 10); TK_CE(9, 11); TK_CE(13, 14);
    TK_CE(1, 4); TK_CE(2, 6); TK_CE(5, 8); TK_CE(7, 10); TK_CE(9, 13); TK_CE(11, 14);
    TK_CE(2, 4); TK_CE(3, 6); TK_CE(9, 12); TK_CE(11, 13);
    TK_CE(3, 5); TK_CE(6, 8); TK_CE(7, 9); TK_CE(10, 12);
    TK_CE(3, 4); TK_CE(5, 6); TK_CE(7, 8); TK_CE(9, 10); TK_CE(11, 12);
    TK_CE(6, 7); TK_CE(8, 9);
#undef TK_CE
}
template <int L> __device__ __forceinline__ void merge16(float (&a)[16], const float (&b)[16]) {
#pragma unroll
    for (int i = 0; i < 16; ++i) if (15 - i < L) a[i] = vmaxf(a[i], b[15 - i]);
#pragma unroll
    for (int j = 8; j > 0; j >>= 1)
#pragma unroll
        for (int i = 0; i < 16; ++i) { const int l = i ^ j; if (l > i) { const float hi = vmaxf(a[i], a[l]), lo = vminf(a[i], a[l]); a[i] = hi; a[l] = lo; } }
}
struct EpiTopK {
    static constexpr int PROBE_ID = 5;
    static constexpr bool PERM = true, AFTER_DRAIN = true; static constexpr int MID_T = 0;
    static constexpr int RS = 260;
    const float* SS2; unsigned short* IDS; float* GATES; float eps;
    __device__ __forceinline__ void fused(f32x4 (&acc)[2][2][4][2], const Unit& u, int wr, int wc, int fr, int fq, PG8_LAS unsigned char* lds, int wid, int lane) const {
        PG8_LAS float* S = (PG8_LAS float*)lds;
        const int tid = wid * 64 + lane, row = tid & 127, grp = tid >> 7, half = grp >> 1, part = grp & 1;
#define TK_BAR() do { asm volatile("s_waitcnt lgkmcnt(0)" ::: "memory"); __builtin_amdgcn_s_barrier(); asm volatile("" ::: "memory"); } while (0)
#ifdef MK_PROBE_TOPK2
        for (int rep_ = 0; rep_ < MK_PROBE_TOPK2; ++rep_)
#endif
#pragma unroll
        for (int ai = 0; ai < 2; ++ai) {
#pragma unroll
            for (int m = 0; m < 4; ++m)
#pragma unroll
                for (int bj = 0; bj < 2; ++bj)
#pragma unroll
                    for (int n = 0; n < 2; ++n) *(PG8_LAS f32x4*)(S + (wr * 64 + m * 16 + fr) * RS + bj * HALF + wc * 32 + 8 * fq + 4 * n) = acc[ai][bj][m][n];
            TK_BAR();
            float T[16];
#ifdef MK_PROBE_TK1
            for (int rep1_ = 0; rep1_ < MK_PROBE_TK1; ++rep1_)
#endif
#pragma unroll
            for (int b = 0; b < 4; ++b) {
                float c[16];
#pragma unroll
                for (int q = 0; q < 4; ++q) { const f32x4 v = *(const PG8_LAS f32x4*)(S + row * RS + half * 128 + part * 64 + b * 16 + q * 4);
#pragma unroll
                    for (int e = 0; e < 4; ++e) c[q * 4 + e] = __uint_as_float((__float_as_uint(v[e]) & ~127u) | (unsigned)(part * 64 + b * 16 + q * 4 + e)); }
                sort16_desc(c);
                if (b == 0) {
#pragma unroll
                    for (int i = 0; i < 16; ++i) T[i] = c[i];
                } else merge16<16>(T, c);
            }
            TK_BAR();
#pragma unroll
            for (int q = 0; q < 4; ++q) *(PG8_LAS f32x4*)(S + tid * 16 + q * 4) = (f32x4){T[q * 4], T[q * 4 + 1], T[q * 4 + 2], T[q * 4 + 3]};
            TK_BAR();
            if (part == 0) {
                float c[16];
#pragma unroll
                for (int q = 0; q < 4; ++q) { const f32x4 v = *(const PG8_LAS f32x4*)(S + (tid + 128) * 16 + q * 4); c[q * 4] = v[0]; c[q * 4 + 1] = v[1]; c[q * 4 + 2] = v[2]; c[q * 4 + 3] = v[3]; }
                merge16<16>(T, c);
            }
            TK_BAR();
            if (part == 0) {
#pragma unroll
                for (int q = 0; q < 4; ++q) *(PG8_LAS f32x4*)(S + tid * 16 + q * 4) = (f32x4){T[q * 4], T[q * 4 + 1], T[q * 4 + 2], T[q * 4 + 3]};
            }
            TK_BAR();
#ifdef MK_PROBE_TK3
            for (int rep3_ = 0; rep3_ < MK_PROBE_TK3; ++rep3_)
#endif
            if (tid < 128) {
                float a1[16], a2[16];
#pragma unroll
                for (int q = 0; q < 4; ++q) { const f32x4 v = *(const PG8_LAS f32x4*)(S + (tid + 256) * 16 + q * 4);
#pragma unroll
                    for (int e = 0; e < 4; ++e) a2[q * 4 + e] = __uint_as_float(__float_as_uint(v[e]) & ~127u); }
#pragma unroll
                for (int i = 0; i < 16; ++i) a1[i] = __uint_as_float(__float_as_uint(T[i]) & ~127u);
#define TK_SUM(i, j) __uint_as_float((__float_as_uint(a1[i] + a2[j]) & ~255u) | (unsigned)((i) * 16 + (j)))
                float R[16], C[16];
#pragma unroll
                for (int j = 0; j < 16; ++j) R[j] = TK_SUM(0, j);
#pragma unroll
                for (int i = 1; i < 16; ++i) C[i - 1] = TK_SUM(i, 0);
                C[15] = 0.f;
                merge16<15>(R, C);
                C[0] = TK_SUM(1, 1); C[1] = TK_SUM(1, 2); C[2] = TK_SUM(1, 3); C[3] = TK_SUM(1, 4); C[4] = TK_SUM(1, 5); C[5] = TK_SUM(1, 6); C[6] = TK_SUM(1, 7);
                C[7] = TK_SUM(2, 1); C[8] = TK_SUM(2, 2); C[9] = TK_SUM(2, 3); C[10] = TK_SUM(2, 4); C[11] = TK_SUM(3, 1); C[12] = TK_SUM(3, 2); C[13] = TK_SUM(3, 3);
                C[14] = TK_SUM(4, 1); C[15] = TK_SUM(4, 2);
                sort16_desc(C);
                merge16<16>(R, C);
                C[0] = TK_SUM(5, 1); C[1] = TK_SUM(6, 1); C[2] = TK_SUM(7, 1);
                merge16<3>(R, C);
#undef TK_SUM
                const int rowg = u.pm * BM + ai * HALF + row;
                const f32x4* ssp = (const f32x4*)(SS2 + (size_t)rowg * 16); const f32x4 s0 = ssp[0], s1 = ssp[1], s2 = ssp[2], s3 = ssp[3];
                const float ssum = ((s0[0] + s0[1]) + (s0[2] + s0[3])) + ((s1[0] + s1[1]) + (s1[2] + s1[3])) + ((s2[0] + s2[1]) + (s2[2] + s2[3])) + ((s3[0] + s3[1]) + (s3[2] + s3[3]));
                const float rl = 1.4426950408889634f / sqrtf(ssum * (1.0f / 1024.0f) + eps);
                float ev[16], esum = 0.f; int idv[16];
#pragma unroll
                for (int r = 0; r < 16; ++r) { ev[r] = __builtin_amdgcn_exp2f((R[r] - R[0]) * rl); esum += ev[r];
                    const unsigned code = __float_as_uint(R[r]) & 255u;
                    const unsigned k1 = __float_as_uint(S[tid * 16 + (code >> 4)]) & 127u, k2 = __float_as_uint(S[(tid + 256) * 16 + (code & 15u)]) & 127u;
                    idv[r] = (int)(k1 * 128u + k2); }
                const float inv = 1.0f / esum;
                unsigned short* ip = IDS + (size_t)rowg * 128 + u.pn * 16; float* gp = GATES + (size_t)rowg * 128 + u.pn * 16;
#pragma unroll
                for (int q = 0; q < 2; ++q) { u32x4 w; w.x = (unsigned)idv[q * 8] | ((unsigned)idv[q * 8 + 1] << 16); w.y = (unsigned)idv[q * 8 + 2] | ((unsigned)idv[q * 8 + 3] << 16); w.z = (unsigned)idv[q * 8 + 4] | ((unsigned)idv[q * 8 + 5] << 16); w.w = (unsigned)idv[q * 8 + 6] | ((unsigned)idv[q * 8 + 7] << 16);
                    *(u32x4*)(ip + q * 8) = w; }
#pragma unroll
                for (int q = 0; q < 4; ++q) *(f32x4*)(gp + q * 4) = (f32x4){ev[q * 4] * inv, ev[q * 4 + 1] * inv, ev[q * 4 + 2] * inv, ev[q * 4 + 3] * inv};
            }
            TK_BAR();
        }
#undef TK_BAR
    }
};
template <class Epi, class Sched, bool ALIGN_EPI = false, bool SP2 = false>
__device__ __forceinline__ void gemm_phase(PG8_LAS unsigned char* lds, const Gemm g, const Sched& S, const Epi& E) {
    const int tid = threadIdx.x, wid = __builtin_amdgcn_readfirstlane(tid >> 6), lane = tid & 63, wr = wid >> 2, wc = wid & 3, fr = lane & 15, fq = lane >> 4;
    const int K = g.K, nt = K / BK;
    unsigned voffA[2], voffB[2];
#pragma unroll
    for (int i = 0; i < 2; ++i) { int R, C; stage_rc(tid * 16 + i * 8192, R, C); const int Rb = Epi::PERM ? ((R & ~31) + perm32(R & 31)) : R;
        voffA[i] = (unsigned)(R * K + C) * 2u; voffB[i] = (unsigned)(Rb * K + C) * 2u; }
    const size_t kstep = (size_t)(BK * 2);
    const size_t hstep = (size_t)HALF * K * 2;
    const size_t tstep = 2 * hstep;
    const unsigned ldsw = (unsigned)wid * 1024u;
    const int aoff = lds_byte(wr * 64 + fr, fq * 8), boff = lds_byte(wc * 32 + fr, fq * 8);
#define PG8_SA(b, h) (((b) * 2 + (h)) * HTB)
#define PG8_SB(b, h) ((4 + (b) * 2 + (h)) * HTB)
#define PG8_STAGE(bufoff, gbase, voff) do { _Pragma("unroll") for (int _i = 0; _i < 2; ++_i) \
        __builtin_amdgcn_global_load_lds((const unsigned*)((const char*)(gbase) + (voff)[_i]), (PG8_LAS unsigned*)(lds + (bufoff) + ldsw + _i * 8192), 16, 0, 0); } while (0)
#define PG8_LDA(dst, b, h) do { _Pragma("unroll") for (int m = 0; m < 4; ++m) _Pragma("unroll") for (int k = 0; k < 2; ++k) dst[m][k] = *(const PG8_LAS bf16x8*)(lds + PG8_SA(b, h) + aoff + m * 2048 + k * 1024); } while (0)
#define PG8_LDB(dst, b, h) do { _Pragma("unroll") for (int n = 0; n < 2; ++n) _Pragma("unroll") for (int k = 0; k < 2; ++k) dst[n][k] = *(const PG8_LAS bf16x8*)(lds + PG8_SB(b, h) + boff + n * 2048 + k * 1024); } while (0)
#define PG8_MMA(ai, bj, At, Bt) do { __builtin_amdgcn_s_setprio(1); _Pragma("unroll") for (int m = 0; m < 4; ++m) _Pragma("unroll") for (int n = 0; n < 2; ++n) _Pragma("unroll") for (int k = 0; k < 2; ++k) \
        acc[ai][bj][m][n] = __builtin_amdgcn_mfma_f32_16x16x32_bf16(Bt[n][k], At[m][k], acc[ai][bj][m][n], 0, 0, 0); __builtin_amdgcn_s_setprio(0); } while (0)
#define PG8_WAIT_V(n) asm volatile("s_waitcnt vmcnt(" #n ")" ::: "memory")
#define PG8_WAIT_L(n) asm volatile("s_waitcnt lgkmcnt(" #n ")" ::: "memory")
#define PG8_BAR __builtin_amdgcn_s_barrier()
#define PG8_SCHED __builtin_amdgcn_sched_barrier(0)
    Unit cur, nxt; int ui = 0;
    if (!S.next(0, cur)) return;
    f32x4 acc[2][2][4][2];
#pragma unroll
    for (int a = 0; a < 2; ++a)
#pragma unroll
        for (int b = 0; b < 2; ++b)
#pragma unroll
            for (int m = 0; m < 4; ++m)
#pragma unroll
                for (int n = 0; n < 2; ++n) acc[a][b][m][n] = (f32x4){0.f, 0.f, 0.f, 0.f};
    bf16x8 At[4][2], B0[2][2], B1[2][2];
    const char* cA = (const char*)g.A + (size_t)cur.pm * tstep; const char* cB = (const char*)g.Bt + (size_t)cur.pn * tstep;
    S.a_ready(cur);
    if constexpr (SP2) {
        PG8_STAGE(PG8_SB(0, 0), cB, voffB); PG8_STAGE(PG8_SB(0, 1), cB + hstep, voffB); PG8_STAGE(PG8_SA(0, 0), cA, voffA); PG8_STAGE(PG8_SA(0, 1), cA + hstep, voffA);
        if (wr == 1) PG8_BAR;
        PG8_WAIT_V(2); PG8_BAR;
        PG8_STAGE(PG8_SB(1, 0), cB + kstep, voffB); PG8_STAGE(PG8_SA(1, 0), cA + kstep, voffA); PG8_STAGE(PG8_SB(1, 1), cB + hstep + kstep, voffB);
        PG8_WAIT_V(6); PG8_BAR;
    } else {
        PG8_STAGE(PG8_SB(0, 0), cB, voffB); PG8_STAGE(PG8_SA(0, 0), cA, voffA); PG8_STAGE(PG8_SB(0, 1), cB + hstep, voffB); PG8_STAGE(PG8_SA(0, 1), cA + hstep, voffA);
        if (wr == 1) PG8_BAR;
        PG8_WAIT_V(4); PG8_BAR;
        PG8_STAGE(PG8_SB(1, 0), cB + kstep, voffB); PG8_STAGE(PG8_SA(1, 0), cA + kstep, voffA); PG8_STAGE(PG8_SB(1, 1), cB + hstep + kstep, voffB);
        PG8_WAIT_V(6); PG8_BAR;
    }
    for (;;) {
        const bool has_next = S.next(ui + 1, nxt);
        const char* nA = has_next ? (const char*)g.A + (size_t)nxt.pm * tstep : cA; const char* nB = has_next ? (const char*)g.Bt + (size_t)nxt.pn * tstep : cB;
        for (int t = 0; t < nt; t += 2) {
            if constexpr (Epi::MID_T > 0) { if (t == Epi::MID_T) E.mid(acc, cur, wr, wc, fr, fq); }
            const bool last = (t == nt - 2);
            const char* a1 = cA + (size_t)(t + 1) * kstep;
            const char* a2 = last ? nA : cA + (size_t)(t + 2) * kstep; const char* b2 = last ? nB : cB + (size_t)(t + 2) * kstep;
            const char* a3 = a2 + kstep; const char* b3 = b2 + kstep;
            if (last && has_next) S.a_ready(nxt);
            if constexpr (SP2) {
            PG8_LDB(B0, 0, 0); PG8_LDB(B1, 0, 1); PG8_SCHED; PG8_LDA(At, 0, 0); PG8_STAGE(PG8_SA(1, 1), a1 + hstep, voffA);
            PG8_WAIT_V(8); PG8_WAIT_L(0); PG8_BAR; PG8_MMA(0, 0, At, B0); PG8_MMA(0, 1, At, B1); PG8_BAR; PG8_SCHED;
            PG8_LDA(At, 0, 1); PG8_STAGE(PG8_SB(0, 0), b2, voffB); PG8_STAGE(PG8_SB(0, 1), b2 + hstep, voffB); PG8_STAGE(PG8_SA(0, 0), a2, voffA);
            PG8_WAIT_V(8); PG8_WAIT_L(0); PG8_BAR; PG8_MMA(1, 0, At, B0); PG8_MMA(1, 1, At, B1); PG8_BAR; PG8_SCHED;
            PG8_LDB(B0, 1, 0); PG8_LDB(B1, 1, 1); PG8_SCHED; PG8_LDA(At, 1, 0); PG8_STAGE(PG8_SA(0, 1), a2 + hstep, voffA);
            PG8_WAIT_V(8); PG8_WAIT_L(0); PG8_BAR; PG8_MMA(0, 0, At, B0); PG8_MMA(0, 1, At, B1); PG8_BAR; PG8_SCHED;
            PG8_LDA(At, 1, 1); PG8_STAGE(PG8_SB(1, 0), b3, voffB); PG8_STAGE(PG8_SB(1, 1), b3 + hstep, voffB); PG8_STAGE(PG8_SA(1, 0), a3, voffA);
            PG8_WAIT_V(8); PG8_WAIT_L(0); PG8_BAR; PG8_MMA(1, 0, At, B0); PG8_MMA(1, 1, At, B1); PG8_BAR; PG8_SCHED;
            } else {
            PG8_LDB(B0, 0, 0); PG8_SCHED; PG8_LDA(At, 0, 0); PG8_STAGE(PG8_SA(1, 1), a1 + hstep, voffA);
            PG8_WAIT_L(8); PG8_BAR; PG8_WAIT_L(0); PG8_MMA(0, 0, At, B0); PG8_BAR; PG8_SCHED;
            PG8_LDB(B1, 0, 1); PG8_STAGE(PG8_SB(0, 0), b2, voffB);
            PG8_BAR; PG8_WAIT_L(0); PG8_MMA(0, 1, At, B1); PG8_BAR;
            PG8_LDA(At, 0, 1); PG8_STAGE(PG8_SA(0, 0), a2, voffA);
            PG8_BAR; PG8_WAIT_L(0); PG8_MMA(1, 0, At, B0); PG8_BAR; PG8_SCHED;
            PG8_STAGE(PG8_SB(0, 1), b2 + hstep, voffB);
            PG8_WAIT_V(6); PG8_BAR; PG8_MMA(1, 1, At, B1); PG8_BAR;
            PG8_LDB(B0, 1, 0); PG8_SCHED; PG8_LDA(At, 1, 0); PG8_STAGE(PG8_SA(0, 1), a2 + hstep, voffA);
            PG8_WAIT_L(8); PG8_BAR; PG8_WAIT_L(0); PG8_MMA(0, 0, At, B0); PG8_BAR; PG8_SCHED;
            PG8_LDB(B1, 1, 1); PG8_STAGE(PG8_SB(1, 0), b3, voffB);
            PG8_BAR; PG8_WAIT_L(0); PG8_MMA(0, 1, At, B1); PG8_BAR;
            PG8_LDA(At, 1, 1); PG8_STAGE(PG8_SA(1, 0), a3, voffA);
            PG8_BAR; PG8_WAIT_L(0); PG8_MMA(1, 0, At, B0); PG8_BAR; PG8_SCHED;
            PG8_STAGE(PG8_SB(1, 1), b3 + hstep, voffB);
            PG8_WAIT_V(6); PG8_BAR; PG8_MMA(1, 1, At, B1); PG8_BAR;
            }
        }
        if constexpr (ALIGN_EPI) { if (wr == 0) PG8_BAR; }
#ifdef MK_PROBE_EPI2
        if constexpr (!Epi::AFTER_DRAIN && Epi::PROBE_ID == MK_PROBE_EPI_ID) { for (int rep_ = 1; rep_ < MK_PROBE_EPI2; ++rep_) E(acc, cur, wr, wc, fr, fq); }
#endif
        if constexpr (!Epi::AFTER_DRAIN) { E(acc, cur, wr, wc, fr, fq); S.done(cur); }
        if (!has_next) break;
#pragma unroll
        for (int a = 0; a < 2; ++a)
#pragma unroll
            for (int b = 0; b < 2; ++b)
#pragma unroll
                for (int m = 0; m < 4; ++m)
#pragma unroll
                    for (int n = 0; n < 2; ++n) acc[a][b][m][n] = (f32x4){0.f, 0.f, 0.f, 0.f};
        cur = nxt; cA = nA; cB = nB; ++ui;
        if constexpr (ALIGN_EPI) { if (wr == 1) PG8_BAR; }
    }
    PG8_WAIT_V(0);
    if constexpr (!ALIGN_EPI) { if (wr == 0) PG8_BAR; }
    PG8_BAR;
    if constexpr (Epi::AFTER_DRAIN) { E.fused(acc, cur, wr, wc, fr, fq, lds, wid, lane); S.done(cur); }
#undef PG8_SA
#undef PG8_SB
#undef PG8_STAGE
#undef PG8_LDA
#undef PG8_LDB
#undef PG8_MMA
#undef PG8_WAIT_V
#undef PG8_WAIT_L
#undef PG8_BAR
#undef PG8_SCHED
}
}
#ifndef PG8_SP2
#define PG8_SP2 true
#endif
#ifndef PG8_ALIGN
#define PG8_ALIGN true
#endif
namespace attn_body {
using bf16=__hip_bfloat16;
using bf16x8=__attribute__((ext_vector_type(8)))short;
using s16x4=__attribute__((ext_vector_type(4)))short;
using f32x16=__attribute__((ext_vector_type(16)))float;
using u32x4=__attribute__((ext_vector_type(4)))unsigned;
using f32x4v=__attribute__((ext_vector_type(4)))float;
constexpr int BATCH=4,NHEAD=8,SEQ=4096,D=64,DM=NHEAD*D,DMO=1024;
constexpr int NW=8,QBLK=32,QB=QBLK*NW,KVBLK=64,NQB=SEQ/QB;
constexpr int ATTN_PITCH=DM, ATTN_UNIT_ROWS=QB;
__device__ __forceinline__ int crow(int r,int hi){return (r&3)+8*(r>>2)+4*hi;}
#define SBAR() __builtin_amdgcn_sched_barrier(0)
__device__ __forceinline__ void cmask(f32x16&p0,f32x16&p1,int jb,int qrel,int hi){
  const float NEG=-INFINITY; int kb=64*jb+4*hi;
  #pragma unroll
  for(int r=0;r<16;++r){int kv=kb+(r&3)+8*(r>>2); if(kv>qrel)p0[r]=NEG; if(kv+32>qrel)p1[r]=NEG;}
}

constexpr int NSLOT=3, SLOTB=8192;
constexpr float SKIP_TH=64.0f;
constexpr int LDS_K=0, LDS_V=NSLOT*SLOTB, LDS_WS=2*NSLOT*SLOTB, LDS_OST=LDS_WS+NW*64*4, LDS_CS=LDS_OST+NW*4096, LDS_BYTES=LDS_CS+SEQ*4+64;
constexpr float C2=0.125f*1.4426950408889634f;
__device__ __forceinline__ void glds16(const void*gsrc,unsigned lds_dst){unsigned keep;
  asm volatile("s_mov_b32 %0, m0\n\ts_mov_b32 m0, %2\n\ts_nop 0\n\tglobal_load_lds_dwordx4 %1, off\n\ts_mov_b32 m0, %0":"=&s"(keep):"v"(gsrc),"s"(lds_dst):"memory");}
__device__ __forceinline__ float max3f(float a,float b,float c){float r;asm("v_max3_f32 %0, %1, %2, %3":"=v"(r):"v"(a),"v"(b),"v"(c));return r;}
__device__ __forceinline__ float max2f(float a,float b){float r;asm("v_max_f32_e32 %0, %1, %2":"=v"(r):"v"(a),"v"(b));return r;}
__device__ __forceinline__ float fadd_s(float a,float b){float r;asm("v_add_f32_e32 %0, %1, %2":"=v"(r):"v"(a),"v"(b));return r;}
__device__ __forceinline__ float fsub_s(float a,float b){float r;asm("v_sub_f32_e32 %0, %1, %2":"=v"(r):"v"(a),"v"(b));return r;}
typedef float f32x2_t __attribute__((ext_vector_type(2))); typedef __bf16 bf16x2_t __attribute__((ext_vector_type(2)));
__device__ __forceinline__ unsigned cvtpk_s(float lo,float hi){f32x2_t v={lo,hi};bf16x2_t b=__builtin_convertvector(v,bf16x2_t);return __builtin_bit_cast(unsigned,b);}
#define WAIT_BAR(N) asm volatile("s_waitcnt vmcnt(" #N ") lgkmcnt(0)\n\ts_barrier":::"memory")

__device__ __forceinline__ void qkt(f32x16&p0,f32x16&p1,const char*Kslot,const bf16x8*qr,const f32x16&c0,const f32x16&c1,int r32,int hi){
  const char*kb=Kslot+hi*1024+r32*16;
  #pragma unroll
  for(int d0=0;d0<4;++d0){
    const bf16x8 b0=*reinterpret_cast<const bf16x8*>(kb+d0*2048);
    const bf16x8 b1=*reinterpret_cast<const bf16x8*>(kb+d0*2048+512);
    if(d0==0){p0=__builtin_amdgcn_mfma_f32_32x32x16_bf16(b0,qr[0],c0,0,0,0);p1=__builtin_amdgcn_mfma_f32_32x32x16_bf16(b1,qr[0],c1,0,0,0);}
    else{p0=__builtin_amdgcn_mfma_f32_32x32x16_bf16(b0,qr[d0],p0,0,0,0);p1=__builtin_amdgcn_mfma_f32_32x32x16_bf16(b1,qr[d0],p1,0,0,0);}}
}
typedef __attribute__((address_space(3))) const char* lds_cptr;
typedef short v4i16_t __attribute__((ext_vector_type(4)));
__device__ __forceinline__ void kload8(bf16x8*kf,lds_cptr kp){
  kf[0]=*(const __attribute__((address_space(3))) bf16x8*)(kp);      kf[1]=*(const __attribute__((address_space(3))) bf16x8*)(kp+512);
  kf[2]=*(const __attribute__((address_space(3))) bf16x8*)(kp+2048); kf[3]=*(const __attribute__((address_space(3))) bf16x8*)(kp+2560);
  kf[4]=*(const __attribute__((address_space(3))) bf16x8*)(kp+4096); kf[5]=*(const __attribute__((address_space(3))) bf16x8*)(kp+4608);
  kf[6]=*(const __attribute__((address_space(3))) bf16x8*)(kp+6144); kf[7]=*(const __attribute__((address_space(3))) bf16x8*)(kp+6656);
}
__device__ __forceinline__ void kload2(bf16x8*kf,lds_cptr kp,int j){ kf[2*j]=*(const __attribute__((address_space(3))) bf16x8*)(kp+j*2048); kf[2*j+1]=*(const __attribute__((address_space(3))) bf16x8*)(kp+j*2048+512); }
__device__ __forceinline__ s16x4 vtr(lds_cptr p){ return __builtin_bit_cast(s16x4,__builtin_amdgcn_ds_read_tr16_b64_v4i16((__attribute__((address_space(3))) v4i16_t*)p)); }
__device__ __forceinline__ float rowmax(const f32x16&p0,const f32x16&p1){
  float a=max3f(p0[0],p0[1],p1[0]),b=max3f(p0[2],p0[3],p1[1]);a=max3f(a,p1[2],p1[3]);
  #pragma unroll
  for(int r=4;r<16;r+=4){a=max3f(a,p0[r],p0[r+1]);b=max3f(b,p0[r+2],p0[r+3]);a=max3f(a,p1[r],p1[r+1]);b=max3f(b,p1[r+2],p1[r+3]);}
  const float m=max2f(a,b);
  auto rr=__builtin_amdgcn_permlane32_swap(__float_as_uint(m),__float_as_uint(m),false,false);
  return max2f(__uint_as_float(rr[0]),__uint_as_float(rr[1]));
}
__device__ __forceinline__ void pv(f32x16*o,int vb,bf16x8 pa0,bf16x8 pa1,bf16x8 pa2,bf16x8 pa3){
  #pragma unroll
  for(int d0=0;d0<2;++d0){s16x4 lo[4],hi[4];
    #pragma unroll
    for(int ks=0;ks<4;++ks){
      asm volatile("ds_read_b64_tr_b16 %0,%1 offset:%c2":"=&v"(lo[ks]):"v"(vb),"i"(d0*4096+ks*1024):"memory");
      asm volatile("ds_read_b64_tr_b16 %0,%1 offset:%c2":"=&v"(hi[ks]):"v"(vb),"i"(d0*4096+ks*1024+512):"memory");}
    asm volatile("s_waitcnt lgkmcnt(0)":::"memory");SBAR();
    #define PK(k) (bf16x8){lo[k][0],lo[k][1],lo[k][2],lo[k][3],hi[k][0],hi[k][1],hi[k][2],hi[k][3]}
    o[d0]=__builtin_amdgcn_mfma_f32_32x32x16_bf16(pa0,PK(0),o[d0],0,0,0);
    o[d0]=__builtin_amdgcn_mfma_f32_32x32x16_bf16(pa1,PK(1),o[d0],0,0,0);
    o[d0]=__builtin_amdgcn_mfma_f32_32x32x16_bf16(pa2,PK(2),o[d0],0,0,0);
    o[d0]=__builtin_amdgcn_mfma_f32_32x32x16_bf16(pa3,PK(3),o[d0],0,0,0);
    #undef PK
  }
}

#ifndef ATTN_STORE16
#define ATTN_STORE16(p,v) (*(u32x4*)(p)=(v))
#endif
template<int THRL> __device__ __forceinline__ void attn_unit(int b,int h,int qb,const bf16*Q,const bf16*__restrict__ K,const bf16*__restrict__ V,bf16*O,const float*__restrict__ LFrow,char*shm){
  int tid_l=threadIdx.x; asm volatile("":"+v"(tid_l));
  const int tid=tid_l,lane=tid&63,r32=lane&31,hi=lane>>5; const int wid=__builtin_amdgcn_readfirstlane(tid>>6);
  const long rowbase=(long)b*SEQ; const int q0=qb*QB;
  const lds_cptr shm3=(lds_cptr)shm;
  typedef __attribute__((address_space(3))) float lds_f32; typedef __attribute__((address_space(3))) f32x4v lds_f32x4;
  lds_f32* const csl=(lds_f32*)(shm3+LDS_CS);
  { const int ncs=q0+QB, i0=tid*8; f32x4v ca={0.f,0.f,0.f,0.f},cb={0.f,0.f,0.f,0.f};
    if(i0<ncs){ca=*(const f32x4v*)(LFrow+i0);cb=*(const f32x4v*)(LFrow+i0+4);}
    ca.y+=ca.x;ca.z+=ca.y;ca.w+=ca.z;cb.x+=ca.w;cb.y+=cb.x;cb.z+=cb.y;cb.w+=cb.z;
    const float tot=cb.w; float inc=tot;
    _Pragma("unroll") for(int o_=1;o_<64;o_<<=1){const float v_=__shfl_up(inc,o_);if(lane>=o_)inc+=v_;}
    if(lane==63)csl[SEQ+wid]=inc;
    asm volatile("s_waitcnt vmcnt(0) lgkmcnt(0)\n\ts_barrier":::"memory");
    float base_=inc-tot;
    _Pragma("unroll") for(int w_=0;w_<NW;++w_){const float t_=csl[SEQ+w_];if(w_<wid)base_+=t_;}
    if(i0<ncs){*(lds_f32x4*)(csl+i0)=ca+base_;*(lds_f32x4*)(csl+i0+4)=cb+base_;}
    asm volatile("s_waitcnt vmcnt(0) lgkmcnt(0)\n\ts_barrier":::"memory"); }
  int ts; { const int NT0=(q0+QB)/KVBLK, cand=2*lane; bool ok=false;
    if(lane<32&&cand<=NT0-4) ok=(cand==0)||(csl[q0]-csl[64*cand-1]<=-SKIP_TH);
    const unsigned long long mk=__ballot(ok); ts=__builtin_amdgcn_readfirstlane(2*(63-__builtin_clzll(mk|1ull))); }
  const bf16*Qw=Q+(rowbase+q0+wid*QBLK)*DM+h*D;
  const bf16*Kh=K+(rowbase+(long)ts*KVBLK)*DM+h*D,*Vh=V+(rowbase+(long)ts*KVBLK)*DM+h*D;
  const unsigned lds0=(unsigned)(uintptr_t)shm;
  float*wsf=(float*)(shm+LDS_WS)+wid*64;
  const bf16*ksrc=Kh+(long)lane*DM+wid*8;
  const bf16*vsrc=Vh+(long)(16*(wid&3)+(lane>>2))*DM+(wid>>2)*32+(lane&3)*8;
  const unsigned kdst=lds0+LDS_K+wid*1024, vdst=lds0+LDS_V+wid*1024;
  #define DMA_K(t,slot) glds16(ksrc+(long)(t)*KVBLK*DM,(unsigned)__builtin_amdgcn_readfirstlane(kdst+(slot)))
  #define DMA_V(t,slot) glds16(vsrc+(long)(t)*KVBLK*DM,(unsigned)__builtin_amdgcn_readfirstlane(vdst+(slot)))
  const int vb0=(int)(lds0+LDS_V)+((lane>>4)&1)*32+(lane&3)*8+(4*hi+((lane&15)>>2))*64;
  const char*Kbase=shm+LDS_K; bf16x8 kf[8];
  const lds_cptr kp0=shm3+LDS_K+hi*1024+r32*16; const lds_cptr vp0=shm3+LDS_V+((lane>>4)&1)*32+(lane&3)*8+(4*hi+((lane&15)>>2))*64;
  const int NT=(q0+QB)/KVBLK-ts;
  const float cq=csl[q0+wid*QBLK+r32];
  const lds_cptr csb=shm3+LDS_CS+hi*16+ts*256;
  #define CINIT(C0,C1,t) do{ _Pragma("unroll") for(int g_=0;g_<4;++g_){ const f32x4v a_=*(const lds_f32x4*)(csb+(t)*256+g_*32), b_=*(const lds_f32x4*)(csb+(t)*256+128+g_*32); \
      C0[4*g_]=cqm-a_.x;C0[4*g_+1]=cqm-a_.y;C0[4*g_+2]=cqm-a_.z;C0[4*g_+3]=cqm-a_.w; C1[4*g_]=cqm-b_.x;C1[4*g_+1]=cqm-b_.y;C1[4*g_+2]=cqm-b_.z;C1[4*g_+3]=cqm-b_.w; } }while(0)
  DMA_K(0,0);DMA_V(0,0);DMA_K(1,SLOTB);
  bf16x8 qr[4];
  #pragma unroll
  for(int d0=0;d0<4;++d0)qr[d0]=*reinterpret_cast<const bf16x8*>(&Qw[(long)r32*DM+d0*16+hi*8]);
  float mhat=0.f,l_reg=0.f,cqm=cq;f32x16 o[2];o[0]=f32x16{};o[1]=f32x16{};
  const int qrel=wid*QBLK+r32;
  #define CMASK(P0,P1,t) do{int jb_=(t)-(NT-4); if(jb_>=0)cmask(P0,P1,jb_,qrel,hi);}while(0)
  bool resc=false;
  #define START(P0,P1) do{ const float rm=rowmax(P0,P1); resc=false; \
    { const float dl=rm; mhat=fadd_s(mhat,dl); \
      _Pragma("unroll") for(int r=0;r<16;++r){P0[r]=fsub_s(P0[r],dl);P1[r]=fsub_s(P1[r],dl);} \
      cqm=cq-mhat; } \
    _Pragma("unroll") for(int r=0;r<16;++r)P0[r]=__builtin_amdgcn_exp2f(P0[r]); }while(0)
  #define RESC() do{ if(resc){ asm volatile("s_waitcnt lgkmcnt(0)":::"memory"); \
      _Pragma("unroll") for(int d_=0;d_<2;++d_) _Pragma("unroll") for(int r=0;r<16;++r)o[d_][r]*=wsf[crow(r,hi)]; } }while(0)
  f32x16 pA0,pA1,pB0,pB1;
  int sl_prev=0,sl_cur=0,sl_next=SLOTB;
  #define ROT() do{sl_prev=sl_cur;sl_cur=sl_next;sl_next=(sl_next==(NSLOT-1)*SLOTB)?0:sl_next+SLOTB;}while(0)
  DMA_K(2,2*SLOTB);
  WAIT_BAR(3);
  { f32x16 ci0,ci1; CINIT(ci0,ci1,0); qkt(pA0,pA1,Kbase,qr,ci0,ci1,r32,hi); } asm volatile("s_nop 15\n\ts_nop 7":"+v"(pA0),"+v"(pA1));CMASK(pA0,pA1,0);
  START(pA0,pA1);
  _Pragma("unroll") for(int r=0;r<16;++r)pA1[r]=__builtin_amdgcn_exp2f(pA1[r]);
  WAIT_BAR(0);
  DMA_K(3,0);DMA_V(1,SLOTB);
  ROT();
  kload8(kf,kp0+sl_cur);
  WAIT_BAR(2);
  s16x4 vlo[8],vhi[8]; u32x4 pw0,pw1,pw2,pw3;
  #define PKW(P,B) cvtpk_s(P[B],P[B+1])
  #define PAF(k) __builtin_bit_cast(bf16x8,pw##k)
  #define VFR(i) (bf16x8){vlo[i][0],vlo[i][1],vlo[i][2],vlo[i][3],vhi[i][0],vhi[i][1],vhi[i][2],vhi[i][3]}
  #define PIN(x) asm volatile("":"+v"(x))
  #define MX3(a,b,c) __builtin_fmaxf(__builtin_fmaxf((a),(b)),(c))
  #define GAPA(MF,A0,A1,A2,A3,W0,W1,PW) do{ MF; sacc+=A0; sacc+=A1; sacc+=A2; sacc+=A3; PIN(sacc); W0; W1; PIN(PW); SBAR(); }while(0)
  #define EX(v) __builtin_amdgcn_exp2f(v)
  #define GAPB(MF,X,B) do{ MF; X[B]=EX(X[B]); X[B+1]=EX(X[B+1]); X[B+2]=EX(X[B+2]); X[B+3]=EX(X[B+3]); PIN(X); SBAR(); }while(0)
  #define VRD(i) do{ vlo[i]=vtr(vp_+(((i)>>2)*4096+((i)&3)*1024)); vhi[i]=vtr(vp_+(((i)>>2)*4096+((i)&3)*1024+512)); }while(0)
  #define KRD(G,j) do{ if(G){ kload2(kf,kp0+sl_next,j); SBAR(); } }while(0)
  #define STEP(C0,C1,P0,P1,t,GK,GV,GL) do{ SBAR(); \
    CINIT(C0,C1,t); SBAR(); \
    const lds_cptr vp_=vp0+sl_prev; \
    VRD(0); SBAR(); float sacc=(P0[0]+P0[1]); \
    GAPA(C0=__builtin_amdgcn_mfma_f32_32x32x16_bf16(kf[0],qr[0],C0,0,0,0), P0[2],P0[3],P0[4],P0[5],     pw0[0]=PKW(P0,0), pw0[1]=PKW(P0,2), pw0); \
    VRD(4); SBAR(); GAPA(C1=__builtin_amdgcn_mfma_f32_32x32x16_bf16(kf[1],qr[0],C1,0,0,0), P0[6],P0[7],P0[8],P0[9],     pw0[2]=PKW(P0,4), pw0[3]=PKW(P0,6), pw0); \
    VRD(1); SBAR(); GAPA(C0=__builtin_amdgcn_mfma_f32_32x32x16_bf16(kf[2],qr[1],C0,0,0,0),   P0[10],P0[11],P0[12],P0[13], pw1[0]=PKW(P0,8), pw1[1]=PKW(P0,10), pw1); \
    VRD(5); SBAR(); GAPA(C1=__builtin_amdgcn_mfma_f32_32x32x16_bf16(kf[3],qr[1],C1,0,0,0),   P0[14],P0[15],P1[0],P1[1],   pw1[2]=PKW(P0,12),pw1[3]=PKW(P0,14), pw1); \
    VRD(2); SBAR(); GAPA(C0=__builtin_amdgcn_mfma_f32_32x32x16_bf16(kf[4],qr[2],C0,0,0,0),   P1[2],P1[3],P1[4],P1[5],     pw2[0]=PKW(P1,0), pw2[1]=PKW(P1,2), pw2); \
    VRD(6); SBAR(); GAPA(C1=__builtin_amdgcn_mfma_f32_32x32x16_bf16(kf[5],qr[2],C1,0,0,0),   P1[6],P1[7],P1[8],P1[9],     pw2[2]=PKW(P1,4), pw2[3]=PKW(P1,6), pw2); \
    VRD(3); SBAR(); GAPA(C0=__builtin_amdgcn_mfma_f32_32x32x16_bf16(kf[6],qr[3],C0,0,0,0),   P1[10],P1[11],P1[12],P1[13], pw3[0]=PKW(P1,8), pw3[1]=PKW(P1,10), pw3); \
    VRD(7); SBAR(); GAPA(C1=__builtin_amdgcn_mfma_f32_32x32x16_bf16(kf[7],qr[3],C1,0,0,0),   P1[14],P1[15],0.f,0.f,       pw3[2]=PKW(P1,12),pw3[3]=PKW(P1,14), pw3); \
    l_reg+=sacc; \
    if(GK){DMA_K((t)+3,sl_cur);} if(GV){DMA_V((t)+1,sl_next);} \
    CMASK(C0,C1,t); \
    { float a=MX3(C0[0],C0[1],C1[0]),b=MX3(C0[2],C0[3],C1[1]); a=MX3(a,C1[2],C1[3]); \
      _Pragma("unroll") for(int r=4;r<16;r+=4){a=MX3(a,C0[r],C0[r+1]);b=MX3(b,C0[r+2],C0[r+3]);a=MX3(a,C1[r],C1[r+1]);b=MX3(b,C1[r+2],C1[r+3]);} \
      float rm=__builtin_fmaxf(a,b); { auto rr=__builtin_amdgcn_permlane32_swap(__float_as_uint(rm),__float_as_uint(rm),false,false); rm=__builtin_fmaxf(__uint_as_float(rr[0]),__uint_as_float(rr[1])); } \
      resc=false; \
      if(__builtin_expect(__any(rm>(float)THRL),0)){ const float dl=__builtin_fmaxf(rm,0.f); mhat+=dl; \
        _Pragma("unroll") for(int r=0;r<16;++r){C0[r]-=dl;C1[r]-=dl;} \
        cqm=cq-mhat; \
        const float f=__builtin_amdgcn_exp2f(-dl); l_reg*=f; if(hi==0)wsf[r32]=f; resc=true; } } \
    SBAR(); \
    GAPB(o[0]=__builtin_amdgcn_mfma_f32_32x32x16_bf16(PAF(0),VFR(0),o[0],0,0,0), C0,0); \
    GAPB(o[1]=__builtin_amdgcn_mfma_f32_32x32x16_bf16(PAF(0),VFR(4),o[1],0,0,0), C0,4); \
    KRD(GL,0); GAPB(o[0]=__builtin_amdgcn_mfma_f32_32x32x16_bf16(PAF(1),VFR(1),o[0],0,0,0), C0,8); \
    KRD(GL,1); GAPB(o[1]=__builtin_amdgcn_mfma_f32_32x32x16_bf16(PAF(1),VFR(5),o[1],0,0,0), C0,12); \
    KRD(GL,2); GAPB(o[0]=__builtin_amdgcn_mfma_f32_32x32x16_bf16(PAF(2),VFR(2),o[0],0,0,0), C1,0); \
    KRD(GL,3); GAPB(o[1]=__builtin_amdgcn_mfma_f32_32x32x16_bf16(PAF(2),VFR(6),o[1],0,0,0), C1,4); \
    GAPB(o[0]=__builtin_amdgcn_mfma_f32_32x32x16_bf16(PAF(3),VFR(3),o[0],0,0,0), C1,8); \
    GAPB(o[1]=__builtin_amdgcn_mfma_f32_32x32x16_bf16(PAF(3),VFR(7),o[1],0,0,0), C1,12); \
    }while(0)
  int t=1;
  #undef CMASK
  #define CMASK(P0,P1,t) do{}while(0)
  for(;t+5<NT;t+=2){
    STEP(pB0,pB1,pA0,pA1,t,true,true,true);     WAIT_BAR(2); RESC(); ROT();
    STEP(pA0,pA1,pB0,pB1,t+1,true,true,true);   WAIT_BAR(2); RESC(); ROT();
  }
  #undef CMASK
  #define CMASK(P0,P1,t) do{int jb_=(t)-(NT-4); if(jb_>=0)cmask(P0,P1,jb_,qrel,hi);}while(0)
  #define ENDW(tt) do{ if((tt)+3<NT){WAIT_BAR(2);} else if((tt)+2<NT){WAIT_BAR(1);} else {WAIT_BAR(0);} }while(0)
  for(;t+1<NT;t+=2){
    STEP(pB0,pB1,pA0,pA1,t,(t+3<NT),(t+1<NT),(t+1<NT));       ENDW(t);   RESC(); ROT();
    STEP(pA0,pA1,pB0,pB1,t+1,(t+4<NT),(t+2<NT),(t+2<NT));     ENDW(t+1); RESC(); ROT();
  }
  STEP(pB0,pB1,pA0,pA1,NT-1,false,false,false); RESC();
  { float sacc=pB0[0]+pB0[1]; _Pragma("unroll") for(int r=2;r<16;++r)sacc+=pB0[r]; _Pragma("unroll") for(int r=0;r<16;++r)sacc+=pB1[r]; l_reg+=sacc;
    pw0=(u32x4){PKW(pB0,0),PKW(pB0,2),PKW(pB0,4),PKW(pB0,6)};pw1=(u32x4){PKW(pB0,8),PKW(pB0,10),PKW(pB0,12),PKW(pB0,14)};pw2=(u32x4){PKW(pB1,0),PKW(pB1,2),PKW(pB1,4),PKW(pB1,6)};pw3=(u32x4){PKW(pB1,8),PKW(pB1,10),PKW(pB1,12),PKW(pB1,14)};
    SBAR(); pv(o,vb0+sl_cur,PAF(0),PAF(1),PAF(2),PAF(3)); }
  #undef PKW
  #undef PAF
  #undef VFR
  #undef PIN
  #undef MX3
  #undef GAPA
  #undef GAPB
  #undef EX
  #undef VRD
  #undef KRD
  #undef STEP
  #undef ENDW
  {auto rr=__builtin_amdgcn_permlane32_swap(__float_as_uint(l_reg),__float_as_uint(l_reg),false,false);l_reg=__uint_as_float(rr[0])+__uint_as_float(rr[1]);}
  if(hi==0)wsf[32+r32]=l_reg;asm volatile("s_waitcnt lgkmcnt(0)":::"memory");
  float rli[16];
  #pragma unroll
  for(int r=0;r<16;++r)rli[r]=__builtin_amdgcn_rcpf(wsf[32+crow(r,hi)]);
  bf16*Ow=O+(rowbase+q0+wid*QBLK)*DMO+h*D;
  { bf16*stg=(bf16*)(shm+LDS_OST)+wid*2048;
    #pragma unroll
    for(int r=0;r<16;++r){const int orow=crow(r,hi);
      #pragma unroll
      for(int d0=0;d0<2;++d0)stg[orow*64+d0*32+r32]=__float2bfloat16(o[d0][r]*rli[r]);}
    asm volatile("s_waitcnt lgkmcnt(0)":::"memory");
    #pragma unroll
    for(int i=0;i<4;++i){const int row=i*8+(lane>>3),ch=lane&7; const u32x4 v=*(const u32x4*)(stg+row*64+ch*8); ATTN_STORE16(Ow+(long)row*DMO+ch*8,v);} }
  asm volatile("s_waitcnt lgkmcnt(0)\n\ts_barrier":::"memory");
  #undef DMA_K
  #undef DMA_V
  #undef CMASK
  #undef START
  #undef RESC
  #undef ROT
  #undef CINIT
}
constexpr int ATTN_LDS_BYTES=LDS_BYTES;
struct AttnTensors { const bf16* Q; const bf16* K; const bf16* V; bf16* O; const float* LF; };
struct AttnUnit { int bh; int qb; };
struct StaticOrder {
  int vcu, G;
  __device__ __forceinline__ StaticOrder(int grid,int vcu_):vcu(vcu_),G(grid){}
  __device__ __forceinline__ bool next(int i,AttnUnit&u)const{
    if(G==256){ if(i>=2)return false; const int s=vcu&7; u.bh=vcu>>3; u.qb=(i==0)?15-s:s; return true; }
    const int idx=i*G+vcu; if(idx>=BATCH*NHEAD*NQB)return false; u.qb=NQB-1-idx/(BATCH*NHEAD); u.bh=idx%(BATCH*NHEAD); return true; }
  __device__ __forceinline__ void a_ready(const AttnUnit&)const{}
  __device__ __forceinline__ void done(const AttnUnit&)const{}
};
template<class Sched,int THRL=8> __device__ __forceinline__ void attn_phase(char*lds,const AttnTensors&T,const Sched&S){
  AttnUnit u;
  for(int i=0;S.next(i,u);++i){ S.a_ready(u); attn_unit<THRL>(u.bh/NHEAD,u.bh%NHEAD,u.qb,T.Q,T.K,T.V,T.O,T.LF+(size_t)u.bh*SEQ,lds); S.done(u); }
}
#undef SBAR
#undef WAIT_BAR
}
#define GAS __attribute__((address_space(1)))
#define LAS __attribute__((address_space(3)))
typedef unsigned short bf16;
typedef unsigned v4u __attribute__((ext_vector_type(4)));
typedef float f32x4 __attribute__((ext_vector_type(4)));
typedef short bf16x8 __attribute__((ext_vector_type(8)));
typedef GAS unsigned gu32;
typedef GAS unsigned long long gu64;
#define RLX_AGENT __ATOMIC_RELAXED, __HIP_MEMORY_SCOPE_AGENT
#define LDS_WAIT() asm volatile("s_waitcnt lgkmcnt(0)" ::: "memory")
#define VM_WAIT() asm volatile("s_waitcnt vmcnt(0)" ::: "memory")
__device__ __forceinline__ unsigned long long rt() { return __builtin_amdgcn_s_memrealtime(); }
__device__ __forceinline__ unsigned f2bf(float f) { unsigned u = __builtin_bit_cast(unsigned, f); return (u + 0x7fffu + ((u >> 16) & 1u)) >> 16; }
__device__ __forceinline__ unsigned pk2(float lo, float hi) { return f2bf(lo) | (f2bf(hi) << 16); }

#define XB_TMO      128
#define XB_XCNT(j)  (256  + 64 * (j))
#define XB_XSUB(j)  (1280 + 64 * (j))
#define XB_XGEN(j)  (2304 + 64 * (j))
#define XB_TOP      3328
#define XB_TOPGEN   3392
#define XCD_BAR_WORDS 3456
#define XB_SPIN_CAP (1u << 18)

__device__ __forceinline__ unsigned xb_ld(unsigned* p)              { return __hip_atomic_load(p, __ATOMIC_RELAXED, __HIP_MEMORY_SCOPE_AGENT); }
__device__ __forceinline__ unsigned xb_add(unsigned* p, unsigned v) { return __hip_atomic_fetch_add(p, v, __ATOMIC_RELAXED, __HIP_MEMORY_SCOPE_AGENT); }
__device__ __forceinline__ unsigned xb_xcc_id() { return (unsigned)__builtin_amdgcn_s_getreg((3 << 11) | 20) & 0xFu; }
#define XB_SPIN(cond, bar) do { unsigned _sp = 0; while (cond) { __builtin_amdgcn_s_sleep(1); \
    if ((++_sp & 255u) == 0u) { if (xb_ld(&(bar)[XB_TMO])) break; if (_sp > XB_SPIN_CAP) { atomicAdd(&(bar)[XB_TMO], 1u); break; } } } } while (0)

struct XcdBarrier {
    unsigned* bar; unsigned x;
    volatile LAS unsigned* st;
};

__device__ __forceinline__ XcdBarrier xcd_barrier_post(unsigned* bar, volatile LAS unsigned* st) {
    XcdBarrier b; b.bar = bar; b.x = xb_xcc_id(); b.st = st;
    if (threadIdx.x == 0) (void)xb_add(&bar[XB_XCNT(b.x)], 1u);
    return b;
}
__device__ __forceinline__ void xcd_barrier_complete(unsigned* bar, unsigned x, unsigned& nloc, unsigned& nx) {
    const unsigned G = gridDim.x * gridDim.y * gridDim.z;
    unsigned sum, cnt, mine, sp = 0u;
    for (;;) {
        sum = 0u; cnt = 0u; mine = 0u;
#pragma unroll
        for (unsigned j = 0; j < 16; ++j) { const unsigned c = xb_ld(&bar[XB_XCNT(j)]); sum += c; cnt += (c > 0u) ? 1u : 0u; mine = (j == x) ? c : mine; }
        if (sum == G) break;
        __builtin_amdgcn_s_sleep(1);
        if ((++sp & 255u) == 0u) { if (xb_ld(&bar[XB_TMO])) break; if (sp > XB_SPIN_CAP) { atomicAdd(&bar[XB_TMO], 1u); break; } }
    }
    nloc = mine > 0u ? mine : 1u; nx = cnt > 0u ? cnt : 1u;
}

__device__ __forceinline__ void xcd_barrier(const XcdBarrier& b) {
    asm volatile("s_waitcnt vmcnt(0)" ::: "memory");
    __syncthreads();
    if (threadIdx.x == 0) {
        unsigned* bar = b.bar;
        __builtin_amdgcn_s_waitcnt(0);
        unsigned nloc = b.st[0], nx = b.st[1];
        if (nloc == 0u) { xcd_barrier_complete(bar, b.x, nloc, nx); b.st[0] = nloc; b.st[1] = nx; }
        const unsigned old = xb_add(&bar[XB_XSUB(b.x)], 1u);
        const unsigned gen = old / nloc;
        if (old + 1u == (gen + 1u) * nloc) {
            __builtin_amdgcn_fence(__ATOMIC_RELEASE, "agent");
            asm volatile("s_waitcnt vmcnt(0)" ::: "memory");
            const unsigned og = xb_add(&bar[XB_TOP], 1u);
            const unsigned tg = og / nx;
            if (og + 1u == (tg + 1u) * nx) xb_add(&bar[XB_TOPGEN], 1u);
            else XB_SPIN(xb_ld(&bar[XB_TOPGEN]) == tg, bar);
            __builtin_amdgcn_fence(__ATOMIC_ACQUIRE, "agent");
            xb_add(&bar[XB_XGEN(b.x)], 1u);
            asm volatile("s_waitcnt vmcnt(0)" ::: "memory");
        } else {
            XB_SPIN(xb_ld(&bar[XB_XGEN(b.x)]) == gen, bar);
            __builtin_amdgcn_fence(__ATOMIC_ACQUIRE, "agent");
            asm volatile("s_waitcnt vmcnt(0)" ::: "memory");
        }
    }
    __syncthreads();
}

constexpr int NWAVES = 8;
constexpr int BATCH = 4, SEQ = 4096, D = 1024, M = BATCH * SEQ, NH = 8, HD = 64, AW = 512, PLE = 256;
constexpr int NIN = 5120, INTOT = 5128, NKEYS = 128, NEXP = 16384, NS = 2048;
constexpr float EPS = 1e-6f, LOG2E = 1.4426950408889634f, C2 = 0.125f * LOG2E;
constexpr int NPHASE = 9;
constexpr int SLW = 128, NSL = D / SLW;
static_assert(NSL == 8, "one slice per XCD group; SS3 has 16 slots");

constexpr size_t MiB = 1u << 20;
constexpr size_t WS_CTL = 0, CTL_ZERO_BYTES = 64 * 1024;
constexpr size_t WS_RSTD1 = 1 * MiB, WS_RSTD3 = WS_RSTD1 + 65536, WS_LF = WS_RSTD3 + 65536, WS_CS = WS_LF + 524288, WS_SS2 = WS_CS + 524288, WS_WPP = WS_SS2 + 1048576;
constexpr size_t WS_WQ8 = 20 * MiB, WS_SW = WS_RSTD1;
constexpr size_t WS_SU = WS_RSTD3, WS_SV = WS_WPP + 524288;
static_assert(WS_SV + 65536 <= 4 * MiB, "small region");
constexpr size_t WS_WIN = 4 * MiB, WS_WBR = 14 * MiB, WS_WOUT = 16 * MiB, WS_WS = 18 * MiB, WS_WPG = 22 * MiB, WS_PB = 24 * MiB;
constexpr size_t WS_UB = 32 * MiB, WS_VB = 48 * MiB;
constexpr size_t WS_AC = 64 * MiB;
constexpr size_t WS_A = 96 * MiB;
constexpr size_t WS_PP = 128 * MiB;
constexpr size_t WS_Q = 160 * MiB, WS_K = 176 * MiB, WS_V = 192 * MiB, WS_GB = 208 * MiB, WS_Z = 224 * MiB;
constexpr size_t WS_MERGED = 160 * MiB, WS_XB2 = 192 * MiB, WS_IDS = 224 * MiB, WS_GATES = 232 * MiB;
constexpr size_t WS_XB3 = 64 * MiB, WS_SS4 = WS_LF;
constexpr size_t WS_END = 256 * MiB;
constexpr size_t WS_PART0 = 4 * MiB, WS_PART1 = 160 * MiB, WS_PART2 = 240 * MiB;
constexpr size_t WS_TGC = 32 * MiB, WS_TXC = 64 * MiB, WS_SC = 32 * MiB;
constexpr int CW_BAR = 1024;

constexpr int RING_OFF = 0, RING_BYTES = 135168;
constexpr int LDSCTL_OFF = RING_BYTES, MISC_OFF = LDSCTL_OFF + 320;
constexpr int LDS_BYTES = RING_BYTES + 1024;
static_assert(attn_body::ATTN_LDS_BYTES <= RING_BYTES && pg8::STAGE_BYTES <= RING_BYTES && 128 * pg8::EpiTopK::RS * 4 <= RING_BYTES, "LDS map");

typedef unsigned u32x4 __attribute__((ext_vector_type(4)));
typedef unsigned u32x2 __attribute__((ext_vector_type(2)));
__device__ __forceinline__ float bf2f(bf16 v) { return __uint_as_float((unsigned)v << 16); }
__device__ __forceinline__ float wave_sum(float v) {
#pragma unroll
    for (int o = 1; o < 64; o <<= 1) v += __shfl_xor(v, o);
    return v;
}
__device__ __forceinline__ float sigmoidf_(float v) { return 1.0f / (1.0f + __expf(-v)); }
__host__ __device__ __forceinline__ int src_in(int n) {
    const int pn = n >> 8, l = n & 255;
    if (pn < 6) return n;
    if (pn < 8) return 1544 + (n - 1536);
    if (pn < 12) { const int j = pn - 8; return (l < 128) ? 2056 + 128 * j + l : 2568 + 128 * j + (l - 128); }
    if (pn < 16) return 3080 + (n - 3072);
    return 4104 + (n - 4096);
}

struct Args { const float* in[18]; float* out; unsigned char* ws; int ph_lo, ph_hi, li, pad; };
struct Ctx {
    LAS unsigned char* lds; int wave, vcu, G;
    __device__ __forceinline__ int tid_() const { return (int)threadIdx.x; }
    __device__ __forceinline__ int lane_() const { return (int)threadIdx.x & 63; }
};

struct TrItem { const float* W; const float* g; bf16* WT; int ldw, k0, scol0, ldt, drow0, dk0; };
__device__ __forceinline__ void tr_load(const TrItem& I, float (&tv)[32], int lane) {
#pragma unroll
    for (int i = 0; i < 32; ++i) { const int kk = 2 * i + (lane >> 5); tv[i] = I.W[(size_t)(I.k0 + kk) * I.ldw + I.scol0 + (lane & 31)]; }
}
__device__ __forceinline__ void tr_finish(const TrItem& I, const float (&tv)[32], LAS float* scr, int lane) {
#pragma unroll
    for (int i = 0; i < 32; ++i) { const int kk = 2 * i + (lane >> 5); float v = tv[i]; if (I.g) v *= I.g[I.k0 + kk]; scr[kk * 33 + (lane & 31)] = v; }
    LDS_WAIT(); asm volatile("" ::: "memory");
    const int c = lane & 7;
#pragma unroll
    for (int j = 0; j < 4; ++j) { const int n = (lane >> 3) + 8 * j; const LAS float* s = scr + (8 * c) * 33 + n;
        v4u o; o.x = pk2(s[0 * 33], s[1 * 33]); o.y = pk2(s[2 * 33], s[3 * 33]); o.z = pk2(s[4 * 33], s[5 * 33]); o.w = pk2(s[6 * 33], s[7 * 33]);
        *(GAS v4u*)(I.WT + (size_t)(I.drow0 + n) * I.ldt + I.dk0 + 8 * c) = o; }
    LDS_WAIT(); asm volatile("" ::: "memory");
}
constexpr int TR_IN = 16 * 160, TR_PP = 4 * 32, TR_BR = 8 * 32, TR_SQ = 16 * 32;
constexpr int TR_P0 = TR_IN + TR_PP;
constexpr int TR_LATE = 2 * TR_BR + 2 * TR_SQ;
__device__ __forceinline__ TrItem tr_decode(const Args& a, int r) {
    unsigned char* ws = a.ws;
    if (r < TR_IN) { const int kb = r / 160, nb = r % 160; return TrItem{a.in[3], a.in[2], (bf16*)(ws + WS_WIN), INTOT, 64 * kb, src_in(32 * nb), D, 32 * nb, 64 * kb}; } r -= TR_IN;
    if (r < TR_PP) { const int kb = r / 32, nb = r % 32; return TrItem{a.in[16], nullptr, (bf16*)(ws + WS_WPP), D, 64 * kb, 32 * nb, PLE, 32 * nb, 64 * kb}; } r -= TR_PP;
    if (r < 2 * TR_BR) { const int br = r / TR_BR, q = r % TR_BR, kb = q / 32, nb = q % 32; return TrItem{a.in[6] + (size_t)br * AW * D, nullptr, (bf16*)(ws + WS_WBR), D, 64 * kb, 32 * nb, D, 32 * nb, br * AW + 64 * kb}; } r -= 2 * TR_BR;
    if (r < TR_SQ) { const int kb = r / 32, nb = r % 32; return TrItem{a.in[7], nullptr, (bf16*)(ws + WS_WOUT), D, 64 * kb, 32 * nb, D, 32 * nb, 64 * kb}; } r -= TR_SQ;
    { const int kb = r / 32, nb = r % 32; return TrItem{a.in[15], a.in[14], (bf16*)(ws + WS_WPG), D, 64 * kb, 32 * nb, D, 32 * nb, 64 * kb}; }
}
__device__ __forceinline__ void tr_two(const Args& a, LAS float* scr, int ra, int rb_, bool two, int lane) {
    const TrItem A = tr_decode(a, ra), B = tr_decode(a, two ? rb_ : ra);
    float ta[32], tb[32];
    tr_load(A, ta, lane); if (two) tr_load(B, tb, lane);
    tr_finish(A, ta, scr, lane); if (two) tr_finish(B, tb, scr, lane);
}
__device__ __forceinline__ void ws_item(const Args& a, LAS unsigned char* lds, int item) {
    int tid_ = (int)threadIdx.x; asm volatile("" : "+v"(tid_));
    const float *g_ffn = a.in[8], *w_peer_q = a.in[9]; bf16* WST = (bf16*)(a.ws + WS_WS);
    LAS float* KH = (LAS float*)lds; LAS float* WQ = KH + 128 * 129;
    const int hh = item >> 4, head = hh >> 1, half = hh & 1, d0 = (item & 15) * 64;
    const float* kh = (half ? a.in[11] : a.in[10]) + (size_t)head * 128 * 128;
    float tk[32], tq[16];
#pragma unroll
    for (int i = 0; i < 32; ++i) tk[i] = kh[i * 512 + tid_];
#pragma unroll
    for (int i = 0; i < 16; ++i) { const int idx = i * 512 + tid_; tq[i] = w_peer_q[(size_t)(d0 + (idx >> 7)) * NS + head * 256 + half * 128 + (idx & 127)]; }
#pragma unroll
    for (int i = 0; i < 32; ++i) { const int idx = i * 512 + tid_; KH[(idx >> 7) * 129 + (idx & 127)] = tk[i]; }
#pragma unroll
    for (int i = 0; i < 16; ++i) WQ[i * 512 + tid_] = tq[i];
    __syncthreads();
    const int key = tid_ & 127, dg = tid_ >> 7;
    float acc[16];
#pragma unroll
    for (int i = 0; i < 16; ++i) acc[i] = 0.f;
    for (int e = 0; e < 128; e += 4) {
        const float k0 = KH[key * 129 + e], k1 = KH[key * 129 + e + 1], k2 = KH[key * 129 + e + 2], k3 = KH[key * 129 + e + 3];
#pragma unroll
        for (int i = 0; i < 16; ++i) { const f32x4 w = *(const LAS f32x4*)(WQ + (dg * 16 + i) * 128 + e); acc[i] += (k0 * w[0] + k1 * w[1]) + (k2 * w[2] + k3 * w[3]); }
    }
    const int dd = d0 + dg * 16;
#pragma unroll
    for (int q = 0; q < 2; ++q) { v4u o; o.x = pk2(acc[8 * q] * g_ffn[dd + 8 * q], acc[8 * q + 1] * g_ffn[dd + 8 * q + 1]); o.y = pk2(acc[8 * q + 2] * g_ffn[dd + 8 * q + 2], acc[8 * q + 3] * g_ffn[dd + 8 * q + 3]);
        o.z = pk2(acc[8 * q + 4] * g_ffn[dd + 8 * q + 4], acc[8 * q + 5] * g_ffn[dd + 8 * q + 5]); o.w = pk2(acc[8 * q + 6] * g_ffn[dd + 8 * q + 6], acc[8 * q + 7] * g_ffn[dd + 8 * q + 7]);
        *(GAS v4u*)(WST + (size_t)(head * 256 + half * 128 + key) * D + dd + 8 * q) = o; }
    __syncthreads();
}
__device__ __forceinline__ void quant_load4(const Args& a, int rb, int lane, f32x4 (&v)[4][4]) {
#pragma unroll
    for (int r = 0; r < 4; ++r) { const int rr = rb + r; const bool isv = rr >= NEXP; const int e = isv ? rr - NEXP : rr;
        const GAS f32x4* src = (const GAS f32x4*)((isv ? a.in[13] : a.in[12]) + (size_t)e * D) + lane;
#pragma unroll
        for (int j = 0; j < 4; ++j) v[r][j] = src[64 * j]; }
}
__device__ __forceinline__ void quant_finish4(const Args& a, int rb, int lane, f32x4 (&v)[4][4]) {
    unsigned char* ws = a.ws; const float *g_ffn = a.in[8];
    f32x4 gq[4];
#pragma unroll
    for (int j = 0; j < 4; ++j) gq[j] = *(const GAS f32x4*)(g_ffn + 256 * j + 4 * lane);
#pragma unroll
    for (int r = 0; r < 4; ++r) { const int rr = rb + r; const bool isv = rr >= NEXP; const int e = isv ? rr - NEXP : rr;
        float am = 0.f;
#pragma unroll
        for (int j = 0; j < 4; ++j) { if (!isv) v[r][j] = v[r][j] * gq[j]; am = fmaxf(am, fmaxf(fmaxf(fabsf(v[r][j].x), fabsf(v[r][j].y)), fmaxf(fabsf(v[r][j].z), fabsf(v[r][j].w)))); }
#pragma unroll
        for (int o = 1; o < 64; o <<= 1) am = fmaxf(am, __shfl_xor(am, o));
        const float sc = am > 0.f ? 127.0f / am : 0.f;
        unsigned char* tb = ws + (isv ? WS_VB : WS_UB);
#pragma unroll
        for (int j = 0; j < 4; ++j) { const int q0 = (int)rintf(v[r][j].x * sc), q1 = (int)rintf(v[r][j].y * sc), q2 = (int)rintf(v[r][j].z * sc), q3 = (int)rintf(v[r][j].w * sc);
            const unsigned o = (unsigned)(q0 & 255) | ((unsigned)(q1 & 255) << 8) | ((unsigned)(q2 & 255) << 16) | ((unsigned)(q3 & 255) << 24);
            *(GAS unsigned*)(tb + ((size_t)(2 * j + (lane >> 5)) * NEXP + e) * SLW + ((4 * lane) & 127)) = o; }
        if (lane == 0) ((float*)(ws + (isv ? WS_SV : WS_SU)))[e] = am * (1.0f / 127.0f);
    }
}
__device__ __forceinline__ void quant_rows4(const Args& a, int rb, int lane) { f32x4 v[4][4]; quant_load4(a, rb, lane, v); quant_finish4(a, rb, lane, v); }
__device__ __forceinline__ void p0_prologue(const Ctx& F, const Args& a, volatile LAS unsigned* MISC) {
    unsigned char* ws = a.ws;
    const float *x = a.in[0], *p = a.in[1], *g_mix = a.in[2], *w_in = a.in[3], *b_f = a.in[4];
    bf16 *PB = (bf16*)(ws + WS_PB), *XB = (bf16*)(ws + WS_A);
    float *RSTD1 = (float*)(ws + WS_RSTD1), *LF = (float*)(ws + WS_LF);
    const int gw = F.vcu * NWAVES + F.wave, NGW = F.G * NWAVES, NGT = F.G * 512;
    const int tid_ = (int)threadIdx.x, lane_ = tid_ & 63;
    auto stepB = [&]() __attribute__((always_inline)) {
        LAS float* scr = (LAS float*)(F.lds + RING_OFF + F.wave * 16384);
        for (int it = gw; it < TR_P0; it += 2 * NGW) tr_two(a, scr, it, it + NGW, it + NGW < TR_P0, lane_);
    };
    auto stepC = [&]() __attribute__((always_inline)) {
    {
        LAS float* WFL = (LAS float*)(F.lds + RING_OFF);
        { float tw[16], tg[16];
#pragma unroll
          for (int i = 0; i < 16; ++i) { const int idx = i * 512 + tid_, k = idx >> 3, h = idx & 7; tw[i] = w_in[(size_t)k * INTOT + 1536 + h]; tg[i] = g_mix[k]; }
#pragma unroll
          for (int i = 0; i < 16; ++i) { const int idx = i * 512 + tid_, k = idx >> 3, h = idx & 7; WFL[h * 1024 + k] = tg[i] * tw[i]; } }
        __syncthreads();
        for (int rb = gw; rb < M; rb += 4 * NGW) {
            f32x4 v[4][4];
#pragma unroll
            for (int r = 0; r < 4; ++r) { const int row = rb + r * NGW; if (row < M) { const GAS f32x4* xr = (const GAS f32x4*)(x + (size_t)row * D);
#pragma unroll
                for (int j = 0; j < 4; ++j) v[r][j] = xr[lane_ + 64 * j]; } }
#pragma unroll
            for (int r = 0; r < 4; ++r) { const int row = rb + r * NGW; if (row < M) {
                float ss = 0.f;
#pragma unroll
                for (int j = 0; j < 4; ++j) ss += (v[r][j].x * v[r][j].x + v[r][j].y * v[r][j].y) + (v[r][j].z * v[r][j].z + v[r][j].w * v[r][j].w);
                ss = wave_sum(ss);
                const float rstd = 1.0f / sqrtf(ss * (1.0f / D) + EPS);
                GAS u32x2* o = (GAS u32x2*)(XB + (size_t)row * D);
#pragma unroll
                for (int j = 0; j < 4; ++j) { u32x2 w; w.x = pk2(v[r][j].x, v[r][j].y); w.y = pk2(v[r][j].z, v[r][j].w); o[lane_ + 64 * j] = w; }
                if (lane_ == 0) RSTD1[row] = rstd;
                float f[8];
#pragma unroll
                for (int h = 0; h < 8; ++h) { float s_ = 0.f;
#pragma unroll
                    for (int j = 0; j < 4; ++j) { const f32x4 w = *(const LAS f32x4*)(WFL + h * 1024 + 4 * (lane_ + 64 * j)); s_ += (v[r][j].x * w[0] + v[r][j].y * w[1]) + (v[r][j].z * w[2] + v[r][j].w * w[3]); }
                    f[h] = s_; }
                float r4[4], r2[2], r1;
#pragma unroll
                for (int i = 0; i < 4; ++i) { const float send = (lane_ & 32) ? f[i] : f[i + 4], keep = (lane_ & 32) ? f[i + 4] : f[i]; r4[i] = keep + __shfl_xor(send, 32); }
#pragma unroll
                for (int i = 0; i < 2; ++i) { const float send = (lane_ & 16) ? r4[i] : r4[i + 2], keep = (lane_ & 16) ? r4[i + 2] : r4[i]; r2[i] = keep + __shfl_xor(send, 16); }
                { const float send = (lane_ & 8) ? r2[0] : r2[1], keep = (lane_ & 8) ? r2[1] : r2[0]; r1 = keep + __shfl_xor(send, 8); }
                r1 += __shfl_xor(r1, 4); r1 += __shfl_xor(r1, 2); r1 += __shfl_xor(r1, 1);
                const int hL = ((lane_ >> 5) & 1) * 4 + ((lane_ >> 4) & 1) * 2 + ((lane_ >> 3) & 1);
                const float tot = r1 * rstd + b_f[hL];
                const float ls = fminf(tot, 0.f) - log1pf(__expf(-fabsf(tot)));
                const int b = row / SEQ, t = row % SEQ;
                if ((lane_ & 7) == 0) LF[(size_t)(b * NH + hL) * SEQ + t] = ls * LOG2E;
            } }
        }
    }
    };
    if (F.vcu & 1) { stepC(); __syncthreads(); stepB(); }
    else           { stepB(); __syncthreads(); stepC(); }
    { constexpr int NP = M * PLE / 8;
        for (int i = F.vcu * 512 + tid_; i < NP; i += NGT) { const f32x4 a_ = ((const GAS f32x4*)p)[2 * (size_t)i], b_ = ((const GAS f32x4*)p)[2 * (size_t)i + 1];
            v4u o; o.x = pk2(a_.x, a_.y); o.y = pk2(a_.z, a_.w); o.z = pk2(b_.x, b_.y); o.w = pk2(b_.z, b_.w); ((GAS v4u*)PB)[i] = o; }
    }
}
__device__ __forceinline__ void p2_conv_chunk(int chunk, const bf16* GB, const bf16* Z, const float* cw, bf16* AC) {
    int tid_l = (int)threadIdx.x; asm volatile("" : "+v"(tid_l));
#pragma unroll
    for (int k = 0; k < 4; ++k) {
        const int i = chunk * 2048 + k * 512 + tid_l;
        const int row = i >> 6, c = (i & 63) * 8, t = row & (SEQ - 1);
        const v4u z2 = *(const GAS v4u*)(Z + (size_t)row * AW + c), g = *(const GAS v4u*)(GB + (size_t)row * AW + c);
        v4u z1 = {0u, 0u, 0u, 0u}, z0 = {0u, 0u, 0u, 0u};
        if (t >= 1) z1 = *(const GAS v4u*)(Z + (size_t)(row - 1) * AW + c);
        if (t >= 2) z0 = *(const GAS v4u*)(Z + (size_t)(row - 2) * AW + c);
        float r[8];
#pragma unroll
        for (int e = 0; e < 4; ++e) {
            const float w0a = cw[c + 2 * e], w0b = cw[c + 2 * e + 1], w1a = cw[AW + c + 2 * e], w1b = cw[AW + c + 2 * e + 1], w2a = cw[2 * AW + c + 2 * e], w2b = cw[2 * AW + c + 2 * e + 1];
            r[2 * e] = __uint_as_float(g[e] << 16) * (w0a * __uint_as_float(z0[e] << 16) + w1a * __uint_as_float(z1[e] << 16) + w2a * __uint_as_float(z2[e] << 16));
            r[2 * e + 1] = __uint_as_float(g[e] & 0xffff0000u) * (w0b * __uint_as_float(z0[e] & 0xffff0000u) + w1b * __uint_as_float(z1[e] & 0xffff0000u) + w2b * __uint_as_float(z2[e] & 0xffff0000u));
        }
        v4u o; o.x = pk2(r[0], r[1]); o.y = pk2(r[2], r[3]); o.z = pk2(r[4], r[5]); o.w = pk2(r[6], r[7]);
        *(GAS v4u*)(AC + (size_t)row * D + AW + c) = o;
    }
}
constexpr int P2_NATT = 512, P2_NCONV = M * AW / 8 / 2048, P2_NQ = 2 * NEXP / 128, P2_NWS = 256, P2_NTR = TR_LATE / 16, CW_QUEUE = 512;
constexpr int P2_NITEMS = P2_NATT + P2_NCONV + P2_NQ + P2_NWS + P2_NTR;
__device__ __forceinline__ int p2_dequeue(unsigned* ctr, volatile LAS unsigned* slot) {
    if (threadIdx.x == 0) *slot = __hip_atomic_fetch_add(ctr, 1u, __ATOMIC_RELAXED, __HIP_MEMORY_SCOPE_AGENT);
    asm volatile("s_waitcnt vmcnt(0) lgkmcnt(0)\n\ts_barrier" ::: "memory");
    const unsigned v = *slot;
    asm volatile("s_waitcnt lgkmcnt(0)\n\ts_barrier" ::: "memory");
    return (int)v;
}
template <int CTRL> __device__ __forceinline__ int dpp_i(int v) { return __builtin_amdgcn_update_dpp(0, v, CTRL, 0xf, 0xf, true); }
__device__ __forceinline__ int sum8i(int v) { v += dpp_i<0x141>(v); v += dpp_i<0xB1>(v); v += dpp_i<0x4E>(v); return v; }
__device__ __forceinline__ float max8f(float v) { v = fmaxf(v, __uint_as_float((unsigned)dpp_i<0x141>((int)__float_as_uint(v)))); v = fmaxf(v, __uint_as_float((unsigned)dpp_i<0xB1>((int)__float_as_uint(v)))); v = fmaxf(v, __uint_as_float((unsigned)dpp_i<0x4E>((int)__float_as_uint(v)))); return v; }
__device__ __forceinline__ size_t part_slab(int j) { return j < 2 ? WS_PART0 + (size_t)j * 8 * MiB : j < 6 ? WS_PART1 + (size_t)(j - 2) * 8 * MiB : WS_PART2 + (size_t)(j - 6) * 8 * MiB; }
struct P6Geo { int xg, wi, nwv; };
__device__ __forceinline__ P6Geo p6_geo(const Ctx& F) { P6Geo g; const int bx = blockIdx.x; g.xg = bx & 7; g.wi = (bx >> 3) * NWAVES + F.wave; g.nwv = ((F.G - g.xg + 7) >> 3) * NWAVES; return g; }
__device__ __forceinline__ void p6a_upass(const Ctx& F, unsigned char* ws, const bf16* XB1, const unsigned short* IDS) {
    const P6Geo G = p6_geo(F); const int lane = F.lane_(), g = lane >> 3, c = lane & 7;
    for (int sl = G.xg; sl < NSL; sl += 8) {
        float* PART = (float*)(ws + part_slab(sl));
        const GAS unsigned char* Ts = (const GAS unsigned char*)(ws + WS_UB) + (size_t)sl * NEXP * SLW + 16 * c;
        for (int t = G.wi; t < M; t += G.nwv) {
            const v4u xa = *(const GAS v4u*)(XB1 + (size_t)t * D + sl * SLW + 16 * c), xb = *(const GAS v4u*)(XB1 + (size_t)t * D + sl * SLW + 16 * c + 8);
            v4u idp[2];
#pragma unroll
            for (int q = 0; q < 2; ++q) idp[q] = *(const GAS v4u*)(IDS + (size_t)t * 128 + 16 * g + 8 * q);
            v4u u[16];
#pragma unroll
            for (int i = 0; i < 16; ++i) { const unsigned w_ = idp[i >> 3][(i >> 1) & 3]; u[i] = *(const GAS v4u*)(Ts + ((i & 1) ? ((w_ >> 9) & 0x7fff80u) : ((w_ << 7) & 0x7fff80u))); }
            float xf[16];
#pragma unroll
            for (int e = 0; e < 4; ++e) { xf[2 * e] = __uint_as_float(xa[e] << 16); xf[2 * e + 1] = __uint_as_float(xa[e] & 0xffff0000u); xf[8 + 2 * e] = __uint_as_float(xb[e] << 16); xf[8 + 2 * e + 1] = __uint_as_float(xb[e] & 0xffff0000u); }
            float am = 0.f;
#pragma unroll
            for (int e = 0; e < 16; ++e) am = fmaxf(am, fabsf(xf[e]));
            am = max8f(am);
            const float sc = am > 0.f ? 127.0f / am : 0.f, sx = am * (1.0f / 127.0f);
            int qx[4];
#pragma unroll
            for (int j = 0; j < 4; ++j) qx[j] = (int)(((unsigned)((int)rintf(xf[4 * j] * sc) & 255)) | ((unsigned)((int)rintf(xf[4 * j + 1] * sc) & 255) << 8) | ((unsigned)((int)rintf(xf[4 * j + 2] * sc) & 255) << 16) | ((unsigned)((int)rintf(xf[4 * j + 3] * sc) & 255) << 24));
            int r0 = 0, r1 = 0;
#pragma unroll
            for (int i = 0; i < 16; ++i) { int sacc = __builtin_amdgcn_sdot4(qx[0], (int)u[i][0], 0, false); sacc = __builtin_amdgcn_sdot4(qx[1], (int)u[i][1], sacc, false); sacc = __builtin_amdgcn_sdot4(qx[2], (int)u[i][2], sacc, false); sacc = __builtin_amdgcn_sdot4(qx[3], (int)u[i][3], sacc, false);
                sacc = sum8i(sacc);
                if (i < 8) r0 = (c == i) ? sacc : r0; else r1 = (c == i - 8) ? sacc : r1; }
            float* pp = PART + (size_t)t * 128 + 16 * g + c;
            pp[0] = (float)r0 * sx; pp[8] = (float)r1 * sx;
        }
    }
}
__device__ __forceinline__ void p6b_combine(const Ctx& F, unsigned char* ws, float* SS2, const unsigned short* IDS, const float* GATES) {
    const int gw = F.vcu * NWAVES + F.wave, NGW = F.G * NWAVES, lane = F.lane_();
    const float *SU = (const float*)(ws + WS_SU), *SV = (const float*)(ws + WS_SV);
    signed char* WQ8 = (signed char*)(ws + WS_WQ8); float* SW = (float*)(ws + WS_SW);
    for (int tb = gw; tb < M; tb += 4 * NGW) {
        float ssv[4], a0[4], a1[4], g0[4], g1[4]; int i0[4], i1[4];
#pragma unroll
        for (int r = 0; r < 4; ++r) { const int t = tb + r * NGW; if (t < M) {
            ssv[r] = lane < 16 ? SS2[(size_t)t * 16 + lane] : 0.f;
            i0[r] = (int)IDS[(size_t)t * 128 + lane]; i1[r] = (int)IDS[(size_t)t * 128 + 64 + lane];
            g0[r] = GATES[(size_t)t * 128 + lane]; g1[r] = GATES[(size_t)t * 128 + 64 + lane];
            a0[r] = 0.f; a1[r] = 0.f;
#pragma unroll
            for (int j = 0; j < 8; ++j) { const float* pp = (const float*)(ws + part_slab(j)) + (size_t)t * 128; a0[r] += pp[lane]; a1[r] += pp[64 + lane]; } } }
#pragma unroll
        for (int r = 0; r < 4; ++r) { const int t = tb + r * NGW; if (t < M) {
            const float rstd = 1.0f / sqrtf(wave_sum(ssv[r]) * (1.0f / D) + EPS);
            const float x0 = a0[r] * rstd * SU[i0[r]], x1 = a1[r] * rstd * SU[i1[r]];
            const float w0 = g0[r] * 0.5f * x0 * (1.0f + erff(x0 * 0.70710678118654752f)) * SV[i0[r]], w1 = g1[r] * 0.5f * x1 * (1.0f + erff(x1 * 0.70710678118654752f)) * SV[i1[r]];
            float am = fmaxf(fabsf(w0), fabsf(w1));
#pragma unroll
            for (int o = 1; o < 64; o <<= 1) am = fmaxf(am, __shfl_xor(am, o));
            const float sc = am > 0.f ? 127.0f / am : 0.f;
            WQ8[(size_t)t * 128 + lane] = (signed char)(int)rintf(w0 * sc); WQ8[(size_t)t * 128 + 64 + lane] = (signed char)(int)rintf(w1 * sc);
            if (lane == 0) SW[t] = am * (1.0f / 127.0f);
            if (lane < 16) SS2[(size_t)t * 16 + lane] = 0.f;
        } }
    }
}
__device__ __forceinline__ int pl32_sum(int a, int b) { const auto s_ = __builtin_amdgcn_permlane32_swap((unsigned)a, (unsigned)b, false, false); return (int)(s_[0] + s_[1]); }
__device__ __forceinline__ int pl16_sum(int a, int b) { const auto s_ = __builtin_amdgcn_permlane16_swap((unsigned)a, (unsigned)b, false, false); return (int)(s_[0] + s_[1]); }
__device__ __forceinline__ float wave_sum_valu(float v) {
    { const auto s_ = __builtin_amdgcn_permlane32_swap(__float_as_uint(v), __float_as_uint(v), false, false); v = __uint_as_float(s_[0]) + __uint_as_float(s_[1]); }
    { const auto s_ = __builtin_amdgcn_permlane16_swap(__float_as_uint(v), __float_as_uint(v), false, false); v = __uint_as_float(s_[0]) + __uint_as_float(s_[1]); }
    v += __uint_as_float((unsigned)dpp_i<0x128>((int)__float_as_uint(v))); v += __uint_as_float((unsigned)dpp_i<0x124>((int)__float_as_uint(v)));
    v += __uint_as_float((unsigned)dpp_i<0x122>((int)__float_as_uint(v))); v += __uint_as_float((unsigned)dpp_i<0x121>((int)__float_as_uint(v))); return v;
}
__device__ __forceinline__ void p6c_vpass(const Ctx& F, unsigned char* ws, const unsigned short* IDS, const bf16* XB1, bf16* XB2, float* SS3) {
    const P6Geo G = p6_geo(F); const int lane = F.lane_(), g = lane >> 3, c = lane & 7;
    const int ecol = 16 * c + ((lane >> 5) & 1) * 8 + ((lane >> 4) & 1) * 4 + ((lane >> 3) & 1) * 2;
    const signed char* WQ8 = (const signed char*)(ws + WS_WQ8); const float* SW = (const float*)(ws + WS_SW);
#define V_IDS(ID, t_) do { _Pragma("unroll") for (int q = 0; q < 2; ++q) ID[q] = *(const GAS v4u*)(IDS + (size_t)(t_) * 128 + 16 * g + 8 * q); } while (0)
#define V_W(WV, t_) do { WV = *(const GAS v4u*)(WQ8 + (size_t)(t_) * 128 + 16 * g); } while (0)
#define V_GATHER(R, ID) do { _Pragma("unroll") for (int i = 0; i < 16; ++i) { const unsigned w_ = ID[i >> 3][(i >> 1) & 3]; R[i] = *(const GAS v4u*)(Ts + (size_t)((((i & 1) ? (w_ >> 9) : (w_ << 7)) & 0x7fff80u) | c16)); } } while (0)
#define V_COMPUTE(R, WV, t_) do { \
        const size_t o_ = (size_t)(t_) * D + sl * SLW + ecol; \
        const unsigned xq_ = *(const GAS unsigned*)(XB1 + o_); const float sw_ = SW[t_]; \
        int acc[16]; \
        _Pragma("unroll") for (int e = 0; e < 16; ++e) acc[e] = 0; \
        _Pragma("unroll") for (int j = 0; j < 4; ++j) \
            _Pragma("unroll") for (int b = 0; b < 4; ++b) { \
                const unsigned r0_ = R[4 * j][b], r1_ = R[4 * j + 1][b], r2_ = R[4 * j + 2][b], r3_ = R[4 * j + 3][b]; \
                const unsigned x01 = __builtin_amdgcn_perm(r1_, r0_, 0x05010400u), y01 = __builtin_amdgcn_perm(r1_, r0_, 0x07030602u), x23 = __builtin_amdgcn_perm(r3_, r2_, 0x05010400u), y23 = __builtin_amdgcn_perm(r3_, r2_, 0x07030602u); \
                acc[4 * b]     = __builtin_amdgcn_sdot4((int)__builtin_amdgcn_perm(x23, x01, 0x05040100u), (int)WV[j], acc[4 * b], false); \
                acc[4 * b + 1] = __builtin_amdgcn_sdot4((int)__builtin_amdgcn_perm(x23, x01, 0x07060302u), (int)WV[j], acc[4 * b + 1], false); \
                acc[4 * b + 2] = __builtin_amdgcn_sdot4((int)__builtin_amdgcn_perm(y23, y01, 0x05040100u), (int)WV[j], acc[4 * b + 2], false); \
                acc[4 * b + 3] = __builtin_amdgcn_sdot4((int)__builtin_amdgcn_perm(y23, y01, 0x07060302u), (int)WV[j], acc[4 * b + 3], false); } \
        int r8[8], r4[4], r2[2]; \
        _Pragma("unroll") for (int i = 0; i < 8; ++i) r8[i] = pl32_sum(acc[i], acc[i + 8]); \
        _Pragma("unroll") for (int i = 0; i < 4; ++i) r4[i] = pl16_sum(r8[i], r8[i + 4]); \
        _Pragma("unroll") for (int i = 0; i < 2; ++i) { const int send = (lane & 8) ? r4[i] : r4[i + 2], keep = (lane & 8) ? r4[i + 2] : r4[i]; r2[i] = keep + dpp_i<0x128>(send); } \
        const float x0_ = __uint_as_float(xq_ << 16) + sw_ * (float)r2[0], x1_ = __uint_as_float(xq_ & 0xffff0000u) + sw_ * (float)r2[1]; \
        *(GAS unsigned*)(XB2 + o_) = pk2(x0_, x1_); \
        const float ss = wave_sum_valu(x0_ * x0_ + x1_ * x1_); \
        if (lane == 0) SS3[(size_t)(t_) * 16 + sl] = ss; } while (0)
#define V_FENCE() asm volatile("" ::: "memory")
    for (int sl = G.xg; sl < NSL; sl += 8) {
        const GAS unsigned char* Ts = (const GAS unsigned char*)(ws + WS_VB) + (size_t)sl * NEXP * SLW; const unsigned c16 = 16u * (unsigned)c;
        const int nk = (M - G.wi + G.nwv - 1) / G.nwv, t0 = G.wi, dt = G.nwv;
        v4u idA[2], idB[2]; v4u wA, wB; v4u rA[16], rB[16];
        if (nk > 0) { V_IDS(idA, t0); V_GATHER(rA, idA); V_W(wA, t0); }
        if (nk > 1) V_IDS(idB, t0 + dt);
        V_FENCE();
        for (int k = 0; k < nk; k += 2) {
            if (k + 1 < nk) { V_GATHER(rB, idB); V_W(wB, t0 + (k + 1) * dt); }
            if (k + 2 < nk) V_IDS(idA, t0 + (k + 2) * dt);
            V_FENCE();
            V_COMPUTE(rA, wA, t0 + k * dt);
            V_FENCE();
            if (k + 2 < nk) { V_GATHER(rA, idA); V_W(wA, t0 + (k + 2) * dt); }
            if (k + 3 < nk) V_IDS(idB, t0 + (k + 3) * dt);
            V_FENCE();
            if (k + 1 < nk) V_COMPUTE(rB, wB, t0 + (k + 1) * dt);
            V_FENCE();
        }
    }
#undef V_IDS
#undef V_W
#undef V_GATHER
#undef V_COMPUTE
#undef V_FENCE
}
__device__ __forceinline__ void p8_final(const Ctx& F, const bf16* XB3, const float* SS4, float* OUT, const float* g) {
    const int gw = F.vcu * NWAVES + F.wave, NGW = F.G * NWAVES, lane = F.lane_();
    f32x4 gv[4];
#pragma unroll
    for (int j = 0; j < 4; ++j) gv[j] = ((const GAS f32x4*)g)[2 * lane + (j & 1) + 128 * (j >> 1)];
    for (int rb = gw; rb < M; rb += 4 * NGW) {
        v4u xa[4], xb[4]; float sv[4];
#pragma unroll
        for (int r = 0; r < 4; ++r) { const int row = rb + r * NGW; if (row < M) { xa[r] = *(const GAS v4u*)(XB3 + (size_t)row * D + 8 * lane); xb[r] = *(const GAS v4u*)(XB3 + (size_t)row * D + 512 + 8 * lane);
            sv[r] = lane < 16 ? SS4[(size_t)row * 16 + lane] : 0.f; } }
#pragma unroll
        for (int r = 0; r < 4; ++r) { const int row = rb + r * NGW; if (row < M) {
            const float rstd = 1.0f / sqrtf(wave_sum(sv[r]) * (1.0f / D) + EPS);
            GAS f32x4* o = (GAS f32x4*)(OUT + (size_t)row * D);
            o[2 * lane] = (f32x4){__uint_as_float(xa[r][0] << 16), __uint_as_float(xa[r][0] & 0xffff0000u), __uint_as_float(xa[r][1] << 16), __uint_as_float(xa[r][1] & 0xffff0000u)} * rstd * gv[0];
            o[2 * lane + 1] = (f32x4){__uint_as_float(xa[r][2] << 16), __uint_as_float(xa[r][2] & 0xffff0000u), __uint_as_float(xa[r][3] << 16), __uint_as_float(xa[r][3] & 0xffff0000u)} * rstd * gv[1];
            o[128 + 2 * lane] = (f32x4){__uint_as_float(xb[r][0] << 16), __uint_as_float(xb[r][0] & 0xffff0000u), __uint_as_float(xb[r][1] << 16), __uint_as_float(xb[r][1] & 0xffff0000u)} * rstd * gv[2];
            o[128 + 2 * lane + 1] = (f32x4){__uint_as_float(xb[r][2] << 16), __uint_as_float(xb[r][2] & 0xffff0000u), __uint_as_float(xb[r][3] << 16), __uint_as_float(xb[r][3] & 0xffff0000u)} * rstd * gv[3];
        } }
    }
}
struct OneUnit {
    pg8::Unit u;
    __device__ __forceinline__ bool next(int i, pg8::Unit& o) const { if (i != 0) return false; o = u; return true; }
    __device__ __forceinline__ void a_ready(const pg8::Unit&) const {}
    __device__ __forceinline__ void done(const pg8::Unit&) const {}
};

__global__ void __launch_bounds__(NWAVES * 64, 2) mk_fwd(Args args) {
    extern __shared__ __attribute__((aligned(16))) unsigned char lds[];
    Ctx F;
    F.lds = (LAS unsigned char*)lds;
    F.wave = __builtin_amdgcn_readfirstlane((int)threadIdx.x >> 6);
    F.G = gridDim.x; { const int bx = blockIdx.x; F.vcu = (F.G % 8 == 0) ? (bx % 8) * (F.G / 8) + bx / 8 : bx; }
    volatile LAS unsigned* MISC = (volatile LAS unsigned*)(F.lds + MISC_OFF);
    unsigned char* ws = args.ws;
    gu32* ctl = (gu32*)(ws + WS_CTL);
    for (int u = F.tid_(); u < (LDS_BYTES - LDSCTL_OFF) / 4; u += NWAVES * 64) ((LAS unsigned*)(F.lds + LDSCTL_OFF))[u] = 0u;
    __syncthreads();
    const int lo = args.ph_lo, hi = args.ph_hi;
    const bool multi = (hi - lo) > 1 || (lo <= 6 && 6 < hi);
    XcdBarrier bar; bar.bar = (unsigned*)(ctl + CW_BAR) + args.li * XCD_BAR_WORDS; bar.x = 0; bar.st = nullptr;
    if (multi) bar = xcd_barrier_post((unsigned*)(ctl + CW_BAR) + args.li * XCD_BAR_WORDS, MISC + 8);
#ifndef MK_CMASK
#define MK_CMASK 0x1ff
#endif
#define IN(k) (((MK_CMASK >> (k)) & 1) && lo <= (k) && (k) < hi)
#ifdef MK_PROBE_BAR2
#define SEAM(k) do { if (IN(k) && IN((k) + 1)) { xcd_barrier(bar); for (int rb_ = 1; rb_ < MK_PROBE_BAR2; ++rb_) xcd_barrier(bar); } STAMPI((k) < 6 ? (k) + 1 : (k) + 3); } while (0)
#else
#define SEAM(k) do { if (IN(k) && IN((k) + 1)) xcd_barrier(bar); STAMPI((k) < 6 ? (k) + 1 : (k) + 3); } while (0)
#endif
#ifdef MK_PROBE_SEG
#define STAMPI(i_) do { if (((i_) == MK_PROBE_SEG || (i_) == MK_PROBE_SEG + 1) && blockIdx.x == 0 && threadIdx.x == 0) { ((unsigned long long*)(args.ws + 32768))[(i_)] = __builtin_amdgcn_s_memrealtime(); } } while (0)
    STAMPI(0);
#else
#define STAMPI(i_) do { } while (0)
#endif
    float* out = args.out;
#define WSP(T, off) ((T*)(ws + (off)))
#define RSTD1 WSP(float, WS_RSTD1)
#define SS2 WSP(float, WS_SS2)
#define LF WSP(float, WS_LF)
#define WIN WSP(bf16, WS_WIN)
#define WBR WSP(bf16, WS_WBR)
#define WOUT WSP(bf16, WS_WOUT)
#define WST WSP(bf16, WS_WS)
#define WPG WSP(bf16, WS_WPG)
#define WPP WSP(bf16, WS_WPP)
#define PB WSP(bf16, WS_PB)
#define XB WSP(bf16, WS_A)
#define AC WSP(bf16, WS_AC)
#define XB1 WSP(bf16, WS_A)
#define PP WSP(bf16, WS_PP)
#define Q WSP(bf16, WS_Q)
#define K WSP(bf16, WS_K)
#define V WSP(bf16, WS_V)
#define GB WSP(bf16, WS_GB)
#define Z WSP(bf16, WS_Z)
#define MG WSP(bf16, WS_MERGED)
#define XB2 WSP(bf16, WS_XB2)
#define IDS WSP(unsigned short, WS_IDS)
#define GATES WSP(float, WS_GATES)
#define SGA ((bf16*)out)
#define SGC ((bf16*)out + (size_t)M * D)

    if (IN(0)) { p0_prologue(F, args, MISC); }
    SEAM(0);
    if (IN(1)) {
        { pg8::Gemm g{XB, WIN, M, NIN, D}; pg8::StaticOrder S; S.init(M, NIN, F.G, (int)blockIdx.x);
          pg8::EpiIn E{RSTD1, Q, (size_t)(WS_K - WS_Q) / 2, Z, SGA, (size_t)M * D, C2};
          static_assert(WS_V - WS_K == WS_K - WS_Q && WS_GB - WS_V == WS_K - WS_Q, "Q | K | V | GB equally spaced");
          pg8::gemm_phase<pg8::EpiIn, pg8::StaticOrder, PG8_ALIGN, PG8_SP2>(F.lds + RING_OFF, g, S, E); }
        { pg8::Gemm g{PB, WPP, M, D, PLE}; pg8::StaticOrder S; S.init(M, D, F.G, (int)blockIdx.x);
          pg8::EpiPlain E{PP, D};
          pg8::gemm_phase<pg8::EpiPlain, pg8::StaticOrder, PG8_ALIGN, PG8_SP2>(F.lds + RING_OFF, g, S, E); }
    }
    SEAM(1);
    if (IN(2)) {
        unsigned* qctr = (unsigned*)(ctl + CW_QUEUE);
        for (;;) {
            const int idx = p2_dequeue(qctr, MISC + 12);
            if (idx >= P2_NITEMS) break;
            if (idx < P2_NATT) { const int qb = 15 - (idx >> 5), bh = idx & 31;
                attn_body::attn_unit<8>(bh >> 3, bh & 7, qb, (const attn_body::bf16*)Q, (const attn_body::bf16*)K, (const attn_body::bf16*)V, (attn_body::bf16*)AC, LF + (size_t)bh * SEQ, (char*)lds + RING_OFF); }
            else if (idx < P2_NATT + P2_NCONV) p2_conv_chunk(idx - P2_NATT, GB, Z, args.in[5], AC);
            else {
                const int d_ = idx - P2_NATT - P2_NCONV, blk_ = d_ / 19, p_ = d_ % 19;
                static_assert(P2_NQ == 256 && P2_NWS == 256 && P2_NTR == 96, "interleave pattern");
                if (p_ < 16 && !(p_ & 1)) {
                    int lane_l = (int)threadIdx.x & 63; asm volatile("" : "+v"(lane_l));
                    const int r0 = (blk_ * 8 + (p_ >> 1)) * 128 + F.wave * 16;
                    for (int t4 = 0; t4 < 4; ++t4) quant_rows4(args, r0 + 4 * t4, lane_l);
                }
                else if (p_ < 16) ws_item(args, F.lds + RING_OFF, blk_ * 8 + (p_ >> 1));
                else { int lane_l = (int)threadIdx.x & 63; asm volatile("" : "+v"(lane_l));
                    const int w0 = TR_P0 + (blk_ * 3 + (p_ - 16)) * 16 + F.wave * 2;
                    tr_two(args, (LAS float*)(F.lds + RING_OFF + F.wave * 16384), w0, w0 + 1, true, lane_l); }
            }
        }
    }
    SEAM(2);
    if (IN(3)) {
        pg8::Gemm g{AC, WBR, M, D, D}; pg8::StaticOrder S; S.init(M, D, F.G, (int)blockIdx.x);
        pg8::EpiBranch E{SGA, SGC, MG};
        pg8::gemm_phase<pg8::EpiBranch, pg8::StaticOrder, PG8_ALIGN, PG8_SP2>(F.lds + RING_OFF, g, S, E);
    }
    SEAM(3);
    if (IN(4)) {
        pg8::Gemm g{MG, WOUT, M, D, D}; pg8::StaticOrder S; S.init(M, D, F.G, (int)blockIdx.x);
        pg8::EpiOut E{XB, XB1, SS2};
        pg8::gemm_phase<pg8::EpiOut, pg8::StaticOrder, PG8_ALIGN, PG8_SP2>(F.lds + RING_OFF, g, S, E);
    }
    SEAM(4);
    if (IN(5)) {
        pg8::Gemm g{XB1, WST, M, NS, D}; pg8::StaticOrder S; S.init(M, NS, F.G, (int)blockIdx.x);
        pg8::EpiTopK E{SS2, IDS, GATES, EPS};
        pg8::Unit u;
        for (int i = 0; S.next(i, u); ++i) { OneUnit O{u}; pg8::gemm_phase<pg8::EpiTopK, OneUnit, false, PG8_SP2>(F.lds + RING_OFF, g, O, E); }
    }
    SEAM(5);
    if (IN(6)) { p6a_upass(F, ws, XB1, IDS); xcd_barrier(bar); STAMPI(7); p6b_combine(F, ws, SS2, IDS, GATES); xcd_barrier(bar); STAMPI(8); p6c_vpass(F, ws, IDS, XB1, XB2, SS2); }
    SEAM(6);
    if (IN(7)) {
        pg8::Gemm g{XB2, WPG, M, D, D}; pg8::StaticOrder S; S.init(M, D, F.G, (int)blockIdx.x);
        LAS float* rtab = (LAS float*)(F.lds + RING_OFF + pg8::STAGE_BYTES);
        const bool one = (M / 256) * (D / 256) <= F.G; pg8::Unit u0;
        if (one && S.next(0, u0) && F.tid_() < 256) { const float* sp = SS2 + (size_t)(u0.pm * 256 + F.tid_()) * 16; float q = 0.f;
#pragma unroll
            for (int j = 0; j < NSL; ++j) q += sp[j];
            rtab[F.tid_()] = 1.0f / sqrtf(q * (1.0f / D) + EPS); }
        __syncthreads();
        pg8::EpiPle E{SS2, PP, XB2, WSP(bf16, WS_XB3), WSP(float, WS_SS4), EPS, one ? (const LAS float*)rtab : (const LAS float*)nullptr};
        pg8::gemm_phase<pg8::EpiPle, pg8::StaticOrder, PG8_ALIGN, PG8_SP2>(F.lds + RING_OFF, g, S, E);
    }
    SEAM(7);
    if (IN(8)) { p8_final(F, WSP(bf16, WS_XB3), WSP(float, WS_SS4), out, args.in[17]); }
    STAMPI(11);
#ifdef MK_PROBE_SEG
    if (blockIdx.x == 0 && F.tid_() == 0) {
        asm volatile("s_waitcnt vmcnt(0)" ::: "memory");
        const unsigned long long* st_ = (const unsigned long long*)(args.ws + 32768);
#if MK_PROBE_SEG >= 100
        const unsigned long long a_ = st_[32 + (MK_PROBE_SEG - 100)], b_ = (MK_PROBE_SEG - 100 == 4) ? st_[1] : st_[33 + (MK_PROBE_SEG - 100)];
#else
        const unsigned long long a_ = st_[MK_PROBE_SEG], b_ = st_[MK_PROBE_SEG + 1];
#endif
        const unsigned long long dt_ = (b_ - a_) * MK_PROBE_MULT, t0_ = __builtin_amdgcn_s_memrealtime();
        while (__builtin_amdgcn_s_memrealtime() - t0_ < dt_) __builtin_amdgcn_s_sleep(8);
    }
#endif
#undef IN
#undef SEAM
#undef WSP
#undef RSTD1
#undef SS2
#undef LF
#undef WIN
#undef WBR
#undef WOUT
#undef WST
#undef WPG
#undef WPP
#undef PB
#undef XB
#undef AC
#undef XB1
#undef PP
#undef Q
#undef K
#undef V
#undef GB
#undef Z
#undef MG
#undef XB2
#undef IDS
#undef GATES
#undef SGA
#undef SGC
}
namespace gold {
__global__ void __launch_bounds__(256) k_rows0(const float* x, const float* w_in, const float* g_mix, const float* b_f, bf16* XB, float* RSTD1, float* LF) {
    const int lane = threadIdx.x & 63, row = blockIdx.x * 4 + (threadIdx.x >> 6);
    const f32x4* xr = (const f32x4*)(x + (size_t)row * D);
    f32x4 v[4]; float ss = 0.f;
#pragma unroll
    for (int j = 0; j < 4; ++j) { v[j] = xr[lane + 64 * j]; ss += v[j].x * v[j].x + v[j].y * v[j].y + v[j].z * v[j].z + v[j].w * v[j].w; }
    ss = wave_sum(ss);
    const float rstd = 1.0f / sqrtf(ss * (1.0f / D) + EPS);
    u32x2* o = (u32x2*)(XB + (size_t)row * D);
#pragma unroll
    for (int j = 0; j < 4; ++j) { u32x2 w; w.x = pk2(v[j].x, v[j].y); w.y = pk2(v[j].z, v[j].w); o[lane + 64 * j] = w; }
    if (lane == 0) RSTD1[row] = rstd;
    float f[8];
#pragma unroll
    for (int h = 0; h < 8; ++h) f[h] = 0.f;
#pragma unroll
    for (int j = 0; j < 4; ++j)
#pragma unroll
        for (int e = 0; e < 4; ++e) {
            const int k = 4 * (lane + 64 * j) + e; const float xv = v[j][e] * g_mix[k];
            const f32x4 w0 = *(const f32x4*)(w_in + (size_t)k * INTOT + 1536), w1 = *(const f32x4*)(w_in + (size_t)k * INTOT + 1540);
            f[0] += xv * w0.x; f[1] += xv * w0.y; f[2] += xv * w0.z; f[3] += xv * w0.w; f[4] += xv * w1.x; f[5] += xv * w1.y; f[6] += xv * w1.z; f[7] += xv * w1.w;
        }
    const int b = row / SEQ, t = row % SEQ;
#pragma unroll
    for (int h = 0; h < 8; ++h) {
        const float tot = wave_sum(f[h]) * rstd + b_f[h];
        const float ls = fminf(tot, 0.f) - log1pf(__expf(-fabsf(tot)));
        if (lane == 0) LF[(size_t)(b * NH + h) * SEQ + t] = ls * LOG2E;
    }
}
template <int MODE> __global__ void k_wt(const float* W, int ldw, const float* g, bf16* Wt, int N, int K, int koff, int ldt) {
    const size_t i = (size_t)blockIdx.x * blockDim.x + threadIdx.x; if (i >= (size_t)N * K) return;
    const int n = (int)(i / K), k = (int)(i % K);
    const int s = MODE == 1 ? src_in(n) : n;
    const float gv = g ? g[k] : 1.f;
    Wt[(size_t)n * ldt + koff + k] = (bf16)f2bf(gv * W[(size_t)k * ldw + s]);
}
__global__ void k_ws(const float* wq, const float* k1, const float* k2, const float* g, bf16* WST) {
    const size_t i = (size_t)blockIdx.x * blockDim.x + threadIdx.x; if (i >= (size_t)NS * D) return;
    const int n = (int)(i / D), d = (int)(i % D), head = n >> 8, half = (n >> 7) & 1, key = n & 127;
    const float* kr = (half ? k2 : k1) + ((size_t)head * NKEYS + key) * 128;
    const float* qr = wq + (size_t)d * NS + head * 256 + half * 128;
    float s = 0.f;
    for (int e = 0; e < 128; ++e) s += qr[e] * kr[e];
    WST[(size_t)n * D + d] = (bf16)f2bf(g[d] * s);
}
__global__ void k_cvt(const float* in, const float* g, bf16* out, size_t n, int gmask) {
    const size_t i = (size_t)blockIdx.x * blockDim.x + threadIdx.x; if (i >= n) return;
    out[i] = (bf16)f2bf(in[i] * (g ? g[i & gmask] : 1.f));
}

template <class Epi, bool SPLIT2>
__global__ void __launch_bounds__(256) ng(const bf16* A, int lda, const bf16* Bt, int ldb, int K, Epi E) {
    __shared__ float As[32][68], Bs[32][68];
    const int tid = threadIdx.x, tx = tid & 15, ty = tid >> 4, m0 = blockIdx.y * 64, n0 = blockIdx.x * 64;
    float acc[4][4], acc2[4][4];
#pragma unroll
    for (int i = 0; i < 4; ++i)
#pragma unroll
        for (int j = 0; j < 4; ++j) { acc[i][j] = 0.f; acc2[i][j] = 0.f; }
    const int lr = tid >> 2, lk = (tid & 3) * 8;
    for (int k0 = 0; k0 < K; k0 += 32) {
        const u32x4 av = *(const u32x4*)(A + (size_t)(m0 + lr) * lda + k0 + lk), bv = *(const u32x4*)(Bt + (size_t)(n0 + lr) * ldb + k0 + lk);
#pragma unroll
        for (int e = 0; e < 4; ++e) {
            As[lk + 2 * e][lr] = __uint_as_float(av[e] << 16); As[lk + 2 * e + 1][lr] = __uint_as_float(av[e] & 0xffff0000u);
            Bs[lk + 2 * e][lr] = __uint_as_float(bv[e] << 16); Bs[lk + 2 * e + 1][lr] = __uint_as_float(bv[e] & 0xffff0000u);
        }
        __syncthreads();
        const bool second = SPLIT2 && (k0 >= K / 2);
#pragma unroll 8
        for (int kk = 0; kk < 32; ++kk) {
            float a[4], b[4];
#pragma unroll
            for (int i = 0; i < 4; ++i) { a[i] = As[kk][ty * 4 + i]; b[i] = Bs[kk][tx * 4 + i]; }
            if (second) {
#pragma unroll
                for (int i = 0; i < 4; ++i)
#pragma unroll
                    for (int j = 0; j < 4; ++j) acc2[i][j] += a[i] * b[j];
            } else {
#pragma unroll
                for (int i = 0; i < 4; ++i)
#pragma unroll
                    for (int j = 0; j < 4; ++j) acc[i][j] += a[i] * b[j];
            }
        }
        __syncthreads();
    }
#pragma unroll
    for (int i = 0; i < 4; ++i)
#pragma unroll
        for (int j = 0; j < 4; ++j) E(m0 + ty * 4 + i, n0 + tx * 4 + j, acc[i][j], acc2[i][j]);
}
struct E1 {
    const float* RSTD1; bf16 *Q, *K, *V, *GB, *SGA, *SGC; float *TGC, *TXC;
    __device__ void operator()(int row, int col, float a, float) const {
        const float v = RSTD1[row] * a; const int pn = col >> 8;
        if (pn < 2) Q[(size_t)row * AW + col] = (bf16)f2bf(v * C2);
        else if (pn < 4) K[(size_t)row * AW + col - 512] = (bf16)f2bf(v);
        else if (pn < 6) V[(size_t)row * AW + col - 1024] = (bf16)f2bf(v);
        else if (pn < 8) GB[(size_t)row * AW + col - 1536] = (bf16)f2bf(v);
        else if (pn < 12) { const int j = pn - 8, l = col & 255; if (l < 128) TGC[(size_t)row * AW + 128 * j + l] = v; else TXC[(size_t)row * AW + 128 * j + l - 128] = v; }
        else if (pn < 16) SGA[(size_t)row * D + col - 3072] = (bf16)f2bf(sigmoidf_(v));
        else SGC[(size_t)row * D + col - 4096] = (bf16)f2bf(sigmoidf_(v));
    }
};
struct EPP { bf16* PP; __device__ void operator()(int row, int col, float a, float) const { PP[(size_t)row * D + col] = (bf16)f2bf(a); } };
struct E3 { const bf16 *SGA, *SGC; bf16* MG;
    __device__ void operator()(int row, int col, float a, float a2) const { const size_t i = (size_t)row * D + col; MG[i] = (bf16)f2bf(bf2f(SGA[i]) * a + bf2f(SGC[i]) * a2); } };
struct E4 { const float* x; float* X1; bf16* XB1;
    __device__ void operator()(int row, int col, float a, float) const { const size_t i = (size_t)row * D + col; const float v = x[i] + a; X1[i] = v; XB1[i] = (bf16)f2bf(v); } };
struct E5 { float* SC; __device__ void operator()(int row, int col, float a, float) const { SC[(size_t)row * 1024 + col] = a; } };
struct E7 { const float* SS3; const bf16* PP; float* X; const bf16* XB2;
    __device__ void operator()(int row, int col, float a, float) const { const size_t i = (size_t)row * D + col; float q_ = 0.f; for (int j_ = 0; j_ < 16; ++j_) q_ += SS3[(size_t)row * 16 + j_]; X[i] = bf2f(XB2[i]) + sigmoidf_(a / sqrtf(q_ * (1.0f / D) + EPS)) * bf2f(PP[i]); } };

__global__ void k_z(const float* TGC, const float* TXC, bf16* Z) { const size_t i = (size_t)blockIdx.x * blockDim.x + threadIdx.x; if (i < (size_t)M * AW) Z[i] = (bf16)f2bf(TGC[i] * TXC[i]); }
__global__ void k_cumsum(const float* LF, float* CS) { const int bh = threadIdx.x; if (bh >= 32) return; float s = 0.f; for (int t = 0; t < SEQ; ++t) { s += LF[(size_t)bh * SEQ + t]; CS[(size_t)bh * SEQ + t] = s; } }
__global__ void k_conv(const bf16* GB, const bf16* Z, const float* cw, bf16* AC) {
    const size_t i = (size_t)blockIdx.x * blockDim.x + threadIdx.x; if (i >= (size_t)M * AW) return;
    const int row = (int)(i / AW), c = (int)(i % AW), t = row % SEQ;
    float s = cw[2 * AW + c] * bf2f(Z[i]);
    if (t >= 1) s += cw[1 * AW + c] * bf2f(Z[i - AW]);
    if (t >= 2) s += cw[0 * AW + c] * bf2f(Z[i - 2 * AW]);
    AC[(size_t)row * D + AW + c] = (bf16)f2bf(bf2f(GB[i]) * s);
}
__global__ void __launch_bounds__(64) k_attn(const bf16* Q, const bf16* K, const bf16* V, const float* CS, bf16* AC) {
    const int bh = blockIdx.y, b = bh / NH, h = bh % NH, q = blockIdx.x * 64 + threadIdx.x;
    const size_t rq = (size_t)b * SEQ + q;
    float qv[64], o[64];
#pragma unroll
    for (int d = 0; d < 64; ++d) { qv[d] = bf2f(Q[rq * AW + h * 64 + d]); o[d] = 0.f; }
    const float cq = CS[(size_t)bh * SEQ + q];
    float m = -INFINITY, l = 0.f;
    const int kvmax = blockIdx.x * 64 + 63;
    for (int kv = 0; kv <= kvmax; ++kv) {
        const size_t rk = (size_t)b * SEQ + kv;
        const u32x4* kp = (const u32x4*)(K + rk * AW + h * 64);
        float s = 0.f;
#pragma unroll
        for (int c = 0; c < 8; ++c) { const u32x4 w = kp[c];
#pragma unroll
            for (int e = 0; e < 4; ++e) { s += qv[c * 8 + 2 * e] * __uint_as_float(w[e] << 16) + qv[c * 8 + 2 * e + 1] * __uint_as_float(w[e] & 0xffff0000u); } }
        s += cq - CS[(size_t)bh * SEQ + kv];
        if (kv > q) s = -INFINITY;
        const float mn = fmaxf(m, s);
        const float al = (m == -INFINITY) ? 0.f : exp2f(m - mn), p = (s == -INFINITY) ? 0.f : exp2f(s - mn);
        l = l * al + p; m = mn;
        const u32x4* vp = (const u32x4*)(V + rk * AW + h * 64);
#pragma unroll
        for (int c = 0; c < 8; ++c) { const u32x4 w = vp[c];
#pragma unroll
            for (int e = 0; e < 4; ++e) { o[c * 8 + 2 * e] = o[c * 8 + 2 * e] * al + p * __uint_as_float(w[e] << 16); o[c * 8 + 2 * e + 1] = o[c * 8 + 2 * e + 1] * al + p * __uint_as_float(w[e] & 0xffff0000u); } }
    }
    const float il = 1.0f / l;
#pragma unroll
    for (int d = 0; d < 64; ++d) AC[rq * D + h * 64 + d] = (bf16)f2bf(o[d] * il);
}
__global__ void __launch_bounds__(256) k_rowss(const float* X, float* SS) {
    const int lane = threadIdx.x & 63, row = blockIdx.x * 4 + (threadIdx.x >> 6);
    const f32x4* xr = (const f32x4*)(X + (size_t)row * D); float ss = 0.f;
#pragma unroll
    for (int j = 0; j < 4; ++j) { const f32x4 v = xr[lane + 64 * j]; ss += v.x * v.x + v.y * v.y + v.z * v.z + v.w * v.w; }
    ss = wave_sum(ss);
    if (lane < 16) SS[(size_t)row * 16 + lane] = lane == 0 ? ss : 0.f;
}
__global__ void __launch_bounds__(64) k_topk(const float* SC, const float* SS2, int hg, unsigned short* IDS, float* GATES) {
    __shared__ float s[128][64]; __shared__ float tv[16][64]; __shared__ int ti[16][64];
    const int tid = threadIdx.x, pair = blockIdx.x * 32 + (tid >> 1), half = tid & 1, token = pair >> 2, hl = pair & 3;
    const float* src = SC + (size_t)token * 1024 + hl * 256 + half * 128;
    for (int k = 0; k < 128; ++k) s[k][tid] = src[k];
    float pv = INFINITY; int pk = -1;
    for (int r = 0; r < 16; ++r) {
        float best = -INFINITY; int bi = 0;
        for (int k = 0; k < 128; ++k) { const float v = s[k][tid]; const bool elig = (v < pv) || (v == pv && k > pk); if (elig && v > best) { best = v; bi = k; } }
        tv[r][tid] = best; ti[r][tid] = bi; pv = best; pk = bi;
    }
    __syncthreads();
    if (half == 0) {
        const float* ss = SS2 + (size_t)token * 16; float sst = 0.f; for (int q_ = 0; q_ < 16; ++q_) sst += ss[q_]; const float rstd = 1.0f / sqrtf(sst * (1.0f / D) + EPS);
        float ts[16]; int tf[16];
        float cpv = INFINITY; int cpf = -1;
#pragma unroll
        for (int r = 0; r < 16; ++r) {
            float best = -INFINITY; int bf_ = 0;
            for (int c = 0; c < 256; ++c) { const float v = tv[c >> 4][tid] + tv[c & 15][tid + 1]; const bool elig = (v < cpv) || (v == cpv && c > cpf); if (elig && v > best) { best = v; bf_ = c; } }
            ts[r] = best; tf[r] = bf_; cpv = best; cpf = bf_;
        }
        float e[16], sum = 0.f;
#pragma unroll
        for (int r = 0; r < 16; ++r) { e[r] = __expf(rstd * (ts[r] - ts[0])); sum += e[r]; }
        const float inv = 1.0f / sum; const int head = hg * 4 + hl;
#pragma unroll
        for (int r = 0; r < 16; ++r) { IDS[(size_t)token * 128 + head * 16 + r] = (unsigned short)(ti[tf[r] >> 4][tid] * 128 + ti[tf[r] & 15][tid + 1]); GATES[(size_t)token * 128 + head * 16 + r] = e[r] * inv; }
    }
}
__global__ void __launch_bounds__(256) k_peer(const bf16* XB1, const float* SS2, const unsigned short* IDS, const float* GATES, const bf16* UB, const bf16* VB, float* X, bf16* XB2, float* RSTD3) {
    const int lane = threadIdx.x & 63, token = blockIdx.x * 4 + (threadIdx.x >> 6);
    const float* ss = SS2 + (size_t)token * 16; float sst = 0.f; for (int q_ = 0; q_ < 16; ++q_) sst += ss[q_]; const float rstd = 1.0f / sqrtf(sst * (1.0f / D) + EPS);
    float xf[16], out[16];
    { const u32x4 a = *(const u32x4*)(XB1 + (size_t)token * D + 8 * lane), b = *(const u32x4*)(XB1 + (size_t)token * D + 512 + 8 * lane);
#pragma unroll
      for (int e = 0; e < 4; ++e) { xf[2 * e] = __uint_as_float(a[e] << 16); xf[2 * e + 1] = __uint_as_float(a[e] & 0xffff0000u); xf[8 + 2 * e] = __uint_as_float(b[e] << 16); xf[8 + 2 * e + 1] = __uint_as_float(b[e] & 0xffff0000u); } }
#pragma unroll
    for (int i = 0; i < 16; ++i) out[i] = 0.f;
    for (int hk = 0; hk < 128; ++hk) {
        const int id = IDS[(size_t)token * 128 + hk]; const float g = GATES[(size_t)token * 128 + hk];
        const u32x4 a = *(const u32x4*)(UB + (size_t)id * D + 8 * lane), b = *(const u32x4*)(UB + (size_t)id * D + 512 + 8 * lane);
        float dot = 0.f;
#pragma unroll
        for (int e = 0; e < 4; ++e) { dot += xf[2 * e] * __uint_as_float(a[e] << 16) + xf[2 * e + 1] * __uint_as_float(a[e] & 0xffff0000u) + xf[8 + 2 * e] * __uint_as_float(b[e] << 16) + xf[8 + 2 * e + 1] * __uint_as_float(b[e] & 0xffff0000u); }
        dot = wave_sum(dot) * rstd;
        const float w = g * 0.5f * dot * (1.0f + erff(dot * 0.70710678118654752f));
        const u32x4 va = *(const u32x4*)(VB + (size_t)id * D + 8 * lane), vb = *(const u32x4*)(VB + (size_t)id * D + 512 + 8 * lane);
#pragma unroll
        for (int e = 0; e < 4; ++e) { out[2 * e] += w * __uint_as_float(va[e] << 16); out[2 * e + 1] += w * __uint_as_float(va[e] & 0xffff0000u); out[8 + 2 * e] += w * __uint_as_float(vb[e] << 16); out[8 + 2 * e + 1] += w * __uint_as_float(vb[e] & 0xffff0000u); }
    }
    float* xr = X + (size_t)token * D; float s2 = 0.f;
    f32x4 x0, x1, x2, x3;
    for (int e = 0; e < 4; ++e) { x0[e] = xf[e]; x1[e] = xf[4 + e]; x2[e] = xf[8 + e]; x3[e] = xf[12 + e]; }
#pragma unroll
    for (int e = 0; e < 4; ++e) { x0[e] += out[e]; x1[e] += out[4 + e]; x2[e] += out[8 + e]; x3[e] += out[12 + e]; s2 += x0[e] * x0[e] + x1[e] * x1[e] + x2[e] * x2[e] + x3[e] * x3[e]; }
    *(f32x4*)(xr + 8 * lane) = x0; *(f32x4*)(xr + 8 * lane + 4) = x1; *(f32x4*)(xr + 512 + 8 * lane) = x2; *(f32x4*)(xr + 512 + 8 * lane + 4) = x3;
    u32x4 w0, w1; w0.x = pk2(x0.x, x0.y); w0.y = pk2(x0.z, x0.w); w0.z = pk2(x1.x, x1.y); w0.w = pk2(x1.z, x1.w); w1.x = pk2(x2.x, x2.y); w1.y = pk2(x2.z, x2.w); w1.z = pk2(x3.x, x3.y); w1.w = pk2(x3.z, x3.w);
    *(u32x4*)(XB2 + (size_t)token * D + 8 * lane) = w0; *(u32x4*)(XB2 + (size_t)token * D + 512 + 8 * lane) = w1;
    s2 = wave_sum(s2);
    if (lane < 16) RSTD3[(size_t)token * 16 + lane] = lane == 0 ? s2 : 0.f;
}
__global__ void __launch_bounds__(256) k_final(float* X, const float* g) {
    const int lane = threadIdx.x & 63, row = blockIdx.x * 4 + (threadIdx.x >> 6);
    f32x4* xr = (f32x4*)(X + (size_t)row * D); f32x4 v[4]; float ss = 0.f;
#pragma unroll
    for (int j = 0; j < 4; ++j) { v[j] = xr[lane + 64 * j]; ss += v[j].x * v[j].x + v[j].y * v[j].y + v[j].z * v[j].z + v[j].w * v[j].w; }
    ss = wave_sum(ss); const float rstd = 1.0f / sqrtf(ss * (1.0f / D) + EPS);
#pragma unroll
    for (int j = 0; j < 4; ++j) { const f32x4 gv = ((const f32x4*)g)[lane + 64 * j]; xr[lane + 64 * j] = v[j] * rstd * gv; }
}

}

#ifndef MK_FUSED_MASK
#define MK_FUSED_MASK 0x1ff
#endif
static void golden_phase(int ph, void* const* d_in, float* out, unsigned char* ws, hipStream_t stream) {
    using namespace gold;
    const float* x = (const float*)d_in[0]; const float* p = (const float*)d_in[1]; const float* g_mix = (const float*)d_in[2]; const float* w_in = (const float*)d_in[3];
    const float* b_f = (const float*)d_in[4]; const float* conv_w = (const float*)d_in[5]; const float* w_branch = (const float*)d_in[6]; const float* w_out = (const float*)d_in[7];
    const float* g_ffn = (const float*)d_in[8]; const float* w_peer_q = (const float*)d_in[9]; const float* peer_k1 = (const float*)d_in[10]; const float* peer_k2 = (const float*)d_in[11];
    const float* peer_u = (const float*)d_in[12]; const float* peer_v = (const float*)d_in[13]; const float* g_ple = (const float*)d_in[14]; const float* w_ple_gate = (const float*)d_in[15];
    const float* w_ple_proj = (const float*)d_in[16]; const float* g_final = (const float*)d_in[17];
    float *RSTD1 = (float*)(ws + WS_RSTD1), *SS2 = (float*)(ws + WS_SS2), *LF = (float*)(ws + WS_LF), *CS = (float*)(ws + WS_CS);
    bf16 *WIN = (bf16*)(ws + WS_WIN), *WBR = (bf16*)(ws + WS_WBR), *WOUT = (bf16*)(ws + WS_WOUT), *WST = (bf16*)(ws + WS_WS), *WPG = (bf16*)(ws + WS_WPG), *WPP = (bf16*)(ws + WS_WPP), *PB = (bf16*)(ws + WS_PB);
    bf16 *UB = (bf16*)(ws + WS_UB), *VB = (bf16*)(ws + WS_VB), *XB = (bf16*)(ws + WS_A), *AC = (bf16*)(ws + WS_AC), *XB1 = (bf16*)(ws + WS_A), *PP = (bf16*)(ws + WS_PP);
    bf16 *Q = (bf16*)(ws + WS_Q), *K = (bf16*)(ws + WS_K), *V = (bf16*)(ws + WS_V), *GB = (bf16*)(ws + WS_GB), *Z = (bf16*)(ws + WS_Z), *MG = (bf16*)(ws + WS_MERGED), *XB2 = (bf16*)(ws + WS_XB2);
    unsigned short* IDS = (unsigned short*)(ws + WS_IDS); float* GATES = (float*)(ws + WS_GATES);
    bf16 *SGA = (bf16*)out, *SGC = (bf16*)out + (size_t)M * D;
    float *TGC = (float*)(ws + WS_TGC), *TXC = (float*)(ws + WS_TXC), *SC = (float*)(ws + WS_SC);
    auto nb = [](size_t n) { return (unsigned)((n + 255) / 256); };
    switch (ph) {
    case 0:
        k_rows0<<<M / 4, 256, 0, stream>>>(x, w_in, g_mix, b_f, XB, RSTD1, LF);
        k_wt<1><<<nb((size_t)NIN * D), 256, 0, stream>>>(w_in, INTOT, g_mix, WIN, NIN, D, 0, D);
        k_wt<0><<<nb((size_t)D * AW), 256, 0, stream>>>(w_branch, D, nullptr, WBR, D, AW, 0, D);
        k_wt<0><<<nb((size_t)D * AW), 256, 0, stream>>>(w_branch + (size_t)AW * D, D, nullptr, WBR, D, AW, AW, D);
        k_wt<0><<<nb((size_t)D * D), 256, 0, stream>>>(w_out, D, nullptr, WOUT, D, D, 0, D);
        k_wt<0><<<nb((size_t)D * D), 256, 0, stream>>>(w_ple_gate, D, g_ple, WPG, D, D, 0, D);
        k_wt<0><<<nb((size_t)D * PLE), 256, 0, stream>>>(w_ple_proj, D, nullptr, WPP, D, PLE, 0, PLE);
        k_ws<<<nb((size_t)NS * D), 256, 0, stream>>>(w_peer_q, peer_k1, peer_k2, g_ffn, WST);
        k_cvt<<<nb((size_t)M * PLE), 256, 0, stream>>>(p, nullptr, PB, (size_t)M * PLE, 0);
        break;
    case 1:
        ng<E1, false><<<dim3(NIN / 64, M / 64), 256, 0, stream>>>(XB, D, WIN, D, D, E1{RSTD1, Q, K, V, GB, SGA, SGC, TGC, TXC});
        ng<EPP, false><<<dim3(D / 64, M / 64), 256, 0, stream>>>(PB, PLE, WPP, PLE, PLE, EPP{PP});
        k_z<<<nb((size_t)M * AW), 256, 0, stream>>>(TGC, TXC, Z);
        break;
    case 2:
        k_cumsum<<<1, 64, 0, stream>>>(LF, CS);
        k_conv<<<nb((size_t)M * AW), 256, 0, stream>>>(GB, Z, conv_w, AC);
        k_attn<<<dim3(SEQ / 64, BATCH * NH), 64, 0, stream>>>(Q, K, V, CS, AC);
        break;
    case 3: ng<E3, true><<<dim3(D / 64, M / 64), 256, 0, stream>>>(AC, D, WBR, D, D, E3{SGA, SGC, MG}); break;
    case 4:
        ng<E4, false><<<dim3(D / 64, M / 64), 256, 0, stream>>>(MG, D, WOUT, D, D, E4{x, out, XB1});
        k_rowss<<<M / 4, 256, 0, stream>>>(out, SS2);
        break;
    case 5:
        for (int hg = 0; hg < 2; ++hg) {
            ng<E5, false><<<dim3(1024 / 64, M / 64), 256, 0, stream>>>(XB1, D, WST + (size_t)hg * 1024 * D, D, D, E5{SC});
            k_topk<<<M * 4 / 32, 64, 0, stream>>>(SC, SS2, hg, IDS, GATES);
        }
        break;
    case 6:
        k_cvt<<<nb((size_t)NEXP * D), 256, 0, stream>>>(peer_u, g_ffn, UB, (size_t)NEXP * D, D - 1);
        k_cvt<<<nb((size_t)NEXP * D), 256, 0, stream>>>(peer_v, nullptr, VB, (size_t)NEXP * D, 0);
        k_peer<<<M / 4, 256, 0, stream>>>(XB1, SS2, IDS, GATES, UB, VB, out, XB2, SS2);
        break;
    case 7: ng<E7, false><<<dim3(D / 64, M / 64), 256, 0, stream>>>(XB2, D, WPG, D, D, E7{SS2, PP, out, XB2}); break;
    case 8: k_final<<<M / 4, 256, 0, stream>>>(out, g_final); break;
    }
}
extern "C" void kernel_launch(void* const* d_in, const int* in_sizes, int n_in, void* d_out, int out_size, void* d_ws, size_t ws_size, hipStream_t stream) {
    static int grid = 0;
    if (grid == 0) {
        if (n_in != 18 || in_sizes[0] != M * D || out_size != M * D || ws_size < WS_END) { fprintf(stderr, "kernel_launch: unexpected shapes (n_in %d, in0 %d, out %d, ws %zu); nothing launched\n", n_in, n_in > 0 ? in_sizes[0] : -1, out_size, ws_size); grid = -1; return; }
        int dev = 0, cus = 0, per_cu = 0;
        if (hipGetDevice(&dev) != hipSuccess || hipDeviceGetAttribute(&cus, hipDeviceAttributeMultiprocessorCount, dev) != hipSuccess) { fprintf(stderr, "kernel_launch: device query failed\n"); grid = -1; return; }
        if (hipFuncSetAttribute((const void*)mk_fwd, hipFuncAttributeMaxDynamicSharedMemorySize, LDS_BYTES) != hipSuccess) { fprintf(stderr, "kernel_launch: hipFuncSetAttribute failed\n"); grid = -1; return; }
        if (hipOccupancyMaxActiveBlocksPerMultiprocessor(&per_cu, (const void*)mk_fwd, NWAVES * 64, LDS_BYTES) != hipSuccess || per_cu < 1) { fprintf(stderr, "kernel_launch: occupancy query says %d workgroups per CU; nothing launched\n", per_cu); (void)hipGetLastError(); grid = -1; return; }
        grid = cus;
    }
    if (grid < 0) return;
    if (hipMemsetAsync((char*)d_ws + WS_CTL, 0, CTL_ZERO_BYTES, stream) != hipSuccess) { fprintf(stderr, "kernel_launch: hipMemsetAsync failed\n"); return; }
    Args a{};
    for (int i = 0; i < 18; ++i) a.in[i] = (const float*)d_in[i];
    a.out = (float*)d_out; a.ws = (unsigned char*)d_ws;
    int li = 0;
    for (int ph = 0; ph < NPHASE;) {
        if ((MK_FUSED_MASK >> ph) & 1) {
            int hi = ph; while (hi < NPHASE && ((MK_FUSED_MASK >> hi) & 1)) ++hi;
            a.ph_lo = ph; a.ph_hi = hi; a.li = li++; a.pad = 0;
            hipLaunchKernelGGL(mk_fwd, dim3(grid), dim3(NWAVES * 64), LDS_BYTES, stream, a);
            const hipError_t le = hipPeekAtLastError();
            if (le != hipSuccess) { fprintf(stderr, "kernel_launch: launch failed: %s\n", hipGetErrorName(le)); return; }
            ph = hi;
        } else {
            golden_phase(ph, d_in, (float*)d_out, (unsigned char*)d_ws, stream);
            if ((ph == 1 || ph == 5) && (MK_FUSED_MASK & 1) && ((MK_FUSED_MASK >> 6) & 1)) {
                gold::k_cvt<<<(unsigned)(((size_t)NEXP * D + 255) / 256), 256, 0, stream>>>((const float*)d_in[12], (const float*)d_in[8], (bf16*)((unsigned char*)d_ws + WS_UB), (size_t)NEXP * D, D - 1);
                gold::k_cvt<<<(unsigned)(((size_t)NEXP * D + 255) / 256), 256, 0, stream>>>((const float*)d_in[13], nullptr, (bf16*)((unsigned char*)d_ws + WS_VB), (size_t)NEXP * D, 0);
            }
            ++ph;
        }
    }
}
```

```cpp
#include <hip/hip_runtime.h>
#include <hip/hip_bf16.h>
#include <cstdio>
#include <cstdint>
#include <cmath>
namespace pg8 {
#define PG8_LAS __attribute__((address_space(3)))
typedef unsigned short bf16_t;
typedef short bf16x8 __attribute__((ext_vector_type(8)));
typedef float f32x4 __attribute__((ext_vector_type(4)));
typedef unsigned u32x4 __attribute__((ext_vector_type(4)));
constexpr int BM = 256, BK = 64, HALF = 128, HTB = HALF * BK * 2  , STAGE_BYTES = 8 * HTB, NXCD = 8, WGM = 8;

__host__ __device__ __forceinline__ int lds_byte(int r, int c) { const int st = (r >> 4) * 2 + (c >> 5), rr = r & 15, cc = c & 31, ob = rr * 64 + cc * 2; return st * 1024 + (ob ^ (((ob >> 9) & 1) << 5)); }
__host__ __device__ __forceinline__ void stage_rc(int b, int& R, int& C) { const int st = b / 1024, sb = b % 1024, swz = sb ^ (((sb >> 9) & 1) << 5); R = (st >> 1) * 16 + swz / 64; C = (st & 1) * 32 + (swz % 64) / 2; }
__host__ __device__ __forceinline__ int perm32(int rho) { const int n = rho >> 4, i = rho & 15; return 8 * (i >> 2) + 4 * n + (i & 3); }

struct Unit { int pm, pn; };
struct Gemm { const bf16_t* A; const bf16_t* Bt; int M, N, K; };

struct StaticOrder {
    int nM, nN, nwg, G, c;
    __host__ __device__ __forceinline__ void init(int M, int N, int G_, int c_) { nM = M / BM; nN = N / BM; nwg = nM * nN; G = G_; c = c_; }
    __host__ __device__ __forceinline__ bool next(int i, Unit& u) const {
        const long L = (long)i * G + c; if (L >= nwg) return false;
        int wgid = (int)L; { const int q = nwg / NXCD, r = nwg % NXCD, xcd = wgid % NXCD, off = wgid / NXCD; wgid = (xcd < r ? xcd * (q + 1) : r * (q + 1) + (xcd - r) * q) + off; }
        const int nig = WGM * nN, gid = wgid / nig, fm = gid * WGM, gsz = (nM - fm) < WGM ? (nM - fm) : WGM;
        u.pm = fm + ((wgid % nig) % gsz); u.pn = (wgid % nig) / gsz; return true;
    }
    __device__ __forceinline__ void a_ready(const Unit&) const {}
    __device__ __forceinline__ void done(const Unit&) const {}
};


__device__ __forceinline__ unsigned cvt_pk_bf16(float lo, float hi) { unsigned r; asm volatile("v_cvt_pk_bf16_f32 %0, %1, %2" : "=v"(r) : "v"(lo), "v"(hi)); return r; }
__device__ __forceinline__ u32x4 pack8(const f32x4 v0, const f32x4 v1) { u32x4 w; w.x = cvt_pk_bf16(v0[0], v0[1]); w.y = cvt_pk_bf16(v0[2], v0[3]); w.z = cvt_pk_bf16(v1[0], v1[1]); w.w = cvt_pk_bf16(v1[2], v1[3]); return w; }
__device__ __forceinline__ float bflo(unsigned w) { return __uint_as_float(w << 16); }
__device__ __forceinline__ float bfhi(unsigned w) { return __uint_as_float(w & 0xffff0000u); }
__device__ __forceinline__ float sigm(float v) { return __builtin_amdgcn_rcpf(1.0f + __builtin_amdgcn_exp2f(v * -1.4426950408889634f)); }
__device__ __forceinline__ f32x4 sigm4(const f32x4 v) { return (f32x4){sigm(v[0]), sigm(v[1]), sigm(v[2]), sigm(v[3])}; }

struct EpiIn {
    static constexpr int PROBE_ID = 1;
    static constexpr bool PERM = true, AFTER_DRAIN = false; static constexpr int MID_T = 0;
    const float* rstd; bf16_t* QKVG; size_t stride4; bf16_t* Z; bf16_t* SG; size_t strideSG; float c2;
    __device__ __forceinline__ void operator()(const f32x4 (&acc)[2][2][4][2], const Unit& u, int wr, int wc, int fr, int fq) const {
        int t_l = (int)threadIdx.x; asm volatile("" : "+v"(t_l)); fr = t_l & 15; fq = (t_l >> 4) & 3; wc = (t_l >> 6) & 3; wr = t_l >> 8;
        const int row0 = u.pm * BM + wr * 64 + fr; const int cl = wc * 32 + 8 * fq, pn = u.pn;
        if (pn < 8) {
            bf16_t* base = QKVG + (size_t)(pn >> 1) * stride4; const int colt = (pn & 1) * 256 + cl; const float s0 = pn < 2 ? c2 : 1.f;
#pragma unroll
            for (int ai = 0; ai < 2; ++ai)
#pragma unroll
                for (int m = 0; m < 4; ++m) { const int row = row0 + ai * HALF + m * 16; const float sc = rstd[row] * s0; bf16_t* rowp = base + (size_t)row * 512 + colt;
#pragma unroll
                    for (int bj = 0; bj < 2; ++bj) *(u32x4*)(rowp + bj * HALF) = pack8(acc[ai][bj][m][0] * sc, acc[ai][bj][m][1] * sc);
                    asm volatile("" ::: "memory"); }
        } else if (pn < 12) {
            const int colt = (pn - 8) * 128 + cl;
#pragma unroll
            for (int ai = 0; ai < 2; ++ai)
#pragma unroll
                for (int m = 0; m < 4; ++m) { const int row = row0 + ai * HALF + m * 16; const float r = rstd[row], sc = r * r;
                    *(u32x4*)(Z + (size_t)row * 512 + colt) = pack8(acc[ai][0][m][0] * acc[ai][1][m][0] * sc, acc[ai][0][m][1] * acc[ai][1][m][1] * sc);
                    asm volatile("" ::: "memory"); }
        } else {
            bf16_t* base = SG + (size_t)((pn - 12) >> 2) * strideSG; const int colt = ((pn - 12) & 3) * 256 + cl;
#pragma unroll
            for (int ai = 0; ai < 2; ++ai)
#pragma unroll
                for (int m = 0; m < 4; ++m) { const int row = row0 + ai * HALF + m * 16; const float r = rstd[row]; bf16_t* rowp = base + (size_t)row * 1024 + colt;
#pragma unroll
                    for (int bj = 0; bj < 2; ++bj) { *(u32x4*)(rowp + bj * HALF) = pack8(sigm4(acc[ai][bj][m][0] * r), sigm4(acc[ai][bj][m][1] * r)); asm volatile("" ::: "memory"); } }
        }
    }
};
struct EpiPlain {
    static constexpr int PROBE_ID = 2;
    static constexpr bool PERM = true, AFTER_DRAIN = false; static constexpr int MID_T = 0;
    bf16_t* O; int ldc;
    __device__ __forceinline__ void operator()(const f32x4 (&acc)[2][2][4][2], const Unit& u, int wr, int wc, int fr, int fq) const {
        int t_l = (int)threadIdx.x; asm volatile("" : "+v"(t_l)); fr = t_l & 15; fq = (t_l >> 4) & 3; wc = (t_l >> 6) & 3; wr = t_l >> 8;
        const int row0 = u.pm * BM + wr * 64 + fr; const int col0 = u.pn * BM + wc * 32 + 8 * fq;
#pragma unroll
        for (int ai = 0; ai < 2; ++ai)
#pragma unroll
            for (int m = 0; m < 4; ++m) { bf16_t* rowp = O + (size_t)(row0 + ai * HALF + m * 16) * ldc + col0;
#pragma unroll
                for (int bj = 0; bj < 2; ++bj) *(u32x4*)(rowp + bj * HALF) = pack8(acc[ai][bj][m][0], acc[ai][bj][m][1]); }
    }
};
struct EpiBranch {
    static constexpr int PROBE_ID = 3;
    static constexpr bool PERM = true, AFTER_DRAIN = false; static constexpr int MID_T = 8;
    const bf16_t *SGA, *SGC; bf16_t* MG;
    __device__ __forceinline__ void mid(f32x4 (&acc)[2][2][4][2], const Unit& u, int wr, int wc, int fr, int fq) const {
        int t_l = (int)threadIdx.x; asm volatile("" : "+v"(t_l)); fr = t_l & 15; fq = (t_l >> 4) & 3; wc = (t_l >> 6) & 3; wr = t_l >> 8;
        const int row0 = u.pm * BM + wr * 64 + fr; const int col0 = u.pn * BM + wc * 32 + 8 * fq;
#pragma unroll
        for (int ai = 0; ai < 2; ++ai) {
            u32x4 a[4][2], c[4][2];
#pragma unroll
            for (int m = 0; m < 4; ++m)
#pragma unroll
                for (int bj = 0; bj < 2; ++bj) { const size_t off = (size_t)(row0 + ai * HALF + m * 16) * 1024 + col0 + bj * HALF; a[m][bj] = *(const u32x4*)(SGA + off); c[m][bj] = *(const u32x4*)(SGC + off); }
#pragma unroll
            for (int m = 0; m < 4; ++m)
#pragma unroll
                for (int bj = 0; bj < 2; ++bj) { const u32x4 av = a[m][bj], cv = c[m][bj]; f32x4 r0, r1;
                    r0[0] = bflo(av[0]) * __builtin_amdgcn_rcpf(bflo(cv[0])); r0[1] = bfhi(av[0]) * __builtin_amdgcn_rcpf(bfhi(cv[0])); r0[2] = bflo(av[1]) * __builtin_amdgcn_rcpf(bflo(cv[1])); r0[3] = bfhi(av[1]) * __builtin_amdgcn_rcpf(bfhi(cv[1]));
                    r1[0] = bflo(av[2]) * __builtin_amdgcn_rcpf(bflo(cv[2])); r1[1] = bfhi(av[2]) * __builtin_amdgcn_rcpf(bfhi(cv[2])); r1[2] = bflo(av[3]) * __builtin_amdgcn_rcpf(bflo(cv[3])); r1[3] = bfhi(av[3]) * __builtin_amdgcn_rcpf(bfhi(cv[3]));
                    acc[ai][bj][m][0] *= r0; acc[ai][bj][m][1] *= r1; }
            asm volatile("" ::: "memory");
        }
    }
    __device__ __forceinline__ void operator()(const f32x4 (&acc)[2][2][4][2], const Unit& u, int wr, int wc, int fr, int fq) const {
        int t_l = (int)threadIdx.x; asm volatile("" : "+v"(t_l)); fr = t_l & 15; fq = (t_l >> 4) & 3; wc = (t_l >> 6) & 3; wr = t_l >> 8;
        const int row0 = u.pm * BM + wr * 64 + fr; const int col0 = u.pn * BM + wc * 32 + 8 * fq;
#pragma unroll
        for (int ai = 0; ai < 2; ++ai) {
            u32x4 c[4][2];
#pragma unroll
            for (int m = 0; m < 4; ++m)
#pragma unroll
                for (int bj = 0; bj < 2; ++bj) c[m][bj] = *(const u32x4*)(SGC + (size_t)(row0 + ai * HALF + m * 16) * 1024 + col0 + bj * HALF);
#pragma unroll
            for (int m = 0; m < 4; ++m)
#pragma unroll
                for (int bj = 0; bj < 2; ++bj) { const u32x4 cv = c[m][bj];
                    const f32x4 s0 = {bflo(cv[0]), bfhi(cv[0]), bflo(cv[1]), bfhi(cv[1])}, s1 = {bflo(cv[2]), bfhi(cv[2]), bflo(cv[3]), bfhi(cv[3])};
                    *(u32x4*)(MG + (size_t)(row0 + ai * HALF + m * 16) * 1024 + col0 + bj * HALF) = pack8(acc[ai][bj][m][0] * s0, acc[ai][bj][m][1] * s1); }
            asm volatile("" ::: "memory");
        }
    }
};
struct EpiOut {
    static constexpr int PROBE_ID = 4;
    static constexpr bool PERM = true, AFTER_DRAIN = false; static constexpr int MID_T = 0;
    const bf16_t* XBin; bf16_t* XB1; float* SS2;
    __device__ __forceinline__ void operator()(const f32x4 (&acc)[2][2][4][2], const Unit& u, int wr, int wc, int fr, int fq) const {
        int t_l = (int)threadIdx.x; asm volatile("" : "+v"(t_l)); fr = t_l & 15; fq = (t_l >> 4) & 3; wc = (t_l >> 6) & 3; wr = t_l >> 8;
        const int row0 = u.pm * BM + wr * 64 + fr; const int col0 = u.pn * BM + wc * 32 + 8 * fq;
#pragma unroll
        for (int ai = 0; ai < 2; ++ai) {
            u32x4 xq[4][2];
#pragma unroll
            for (int m = 0; m < 4; ++m)
#pragma unroll
                for (int bj = 0; bj < 2; ++bj) xq[m][bj] = *(const u32x4*)(XBin + (size_t)(row0 + ai * HALF + m * 16) * 1024 + col0 + bj * HALF);
#pragma unroll
            for (int m = 0; m < 4; ++m) { const int row = row0 + ai * HALF + m * 16; float ss = 0.f;
#pragma unroll
                for (int bj = 0; bj < 2; ++bj) { const u32x4 q = xq[m][bj];
                    const f32x4 v0 = acc[ai][bj][m][0] + (f32x4){bflo(q[0]), bfhi(q[0]), bflo(q[1]), bfhi(q[1])}, v1 = acc[ai][bj][m][1] + (f32x4){bflo(q[2]), bfhi(q[2]), bflo(q[3]), bfhi(q[3])};
                    *(u32x4*)(XB1 + (size_t)row * 1024 + col0 + bj * HALF) = pack8(v0, v1);
                    ss += (v0[0] * v0[0] + v0[1] * v0[1]) + (v0[2] * v0[2] + v0[3] * v0[3]) + (v1[0] * v1[0] + v1[1] * v1[1]) + (v1[2] * v1[2] + v1[3] * v1[3]); }
                ss += __shfl_xor(ss, 16); ss += __shfl_xor(ss, 32);
                if (fq == 0) SS2[(size_t)row * 16 + u.pn * 4 + wc] = ss; }
            asm volatile("" ::: "memory");
        }
    }
};
struct EpiPle {
    static constexpr int PROBE_ID = 7;
    static constexpr bool PERM = true, AFTER_DRAIN = false; static constexpr int MID_T = 0;
    const float* SS3; const bf16_t* PP; const bf16_t* XB2; bf16_t* XB3; float* SS4; float eps; const PG8_LAS float* rtab;
    __device__ __forceinline__ void operator()(const f32x4 (&acc)[2][2][4][2], const Unit& u, int wr, int wc, int fr, int fq) const {
        int t_l = (int)threadIdx.x; asm volatile("" : "+v"(t_l)); fr = t_l & 15; fq = (t_l >> 4) & 3; wc = (t_l >> 6) & 3; wr = t_l >> 8;
        const int row0 = u.pm * BM + wr * 64 + fr; const int col0 = u.pn * BM + wc * 32 + 8 * fq;
#pragma unroll
        for (int ai = 0; ai < 2; ++ai) {
            u32x4 pv[4][2], xb[4][2]; float rr[4];
#pragma unroll
            for (int m = 0; m < 4; ++m) { const int row = row0 + ai * HALF + m * 16;
#pragma unroll
                for (int bj = 0; bj < 2; ++bj) { const size_t off = (size_t)row * 1024 + col0 + bj * HALF; pv[m][bj] = *(const u32x4*)(PP + off); xb[m][bj] = *(const u32x4*)(XB2 + off); }
                if (rtab) rr[m] = rtab[wr * 64 + fr + ai * HALF + m * 16];
                else { const f32x4* sp = (const f32x4*)(SS3 + (size_t)row * 16); const f32x4 q0 = sp[0], q1 = sp[1]; rr[m] = 1.0f / sqrtf((((q0[0] + q0[1]) + (q0[2] + q0[3])) + ((q1[0] + q1[1]) + (q1[2] + q1[3]))) * (1.0f / 1024.0f) + eps); } }
#pragma unroll
            for (int m = 0; m < 4; ++m) { const int row = row0 + ai * HALF + m * 16; const float r = rr[m]; float ss = 0.f;
#pragma unroll
                for (int bj = 0; bj < 2; ++bj) { const u32x4 c = pv[m][bj], xq = xb[m][bj]; const size_t off = (size_t)row * 1024 + col0 + bj * HALF;
                    const f32x4 p0 = {bflo(c[0]), bfhi(c[0]), bflo(c[1]), bfhi(c[1])}, p1 = {bflo(c[2]), bfhi(c[2]), bflo(c[3]), bfhi(c[3])};
                    const f32x4 x0 = {bflo(xq[0]), bfhi(xq[0]), bflo(xq[1]), bfhi(xq[1])}, x1 = {bflo(xq[2]), bfhi(xq[2]), bflo(xq[3]), bfhi(xq[3])};
                    const f32x4 v0 = x0 + sigm4(acc[ai][bj][m][0] * r) * p0, v1 = x1 + sigm4(acc[ai][bj][m][1] * r) * p1;
                    *(u32x4*)(XB3 + off) = pack8(v0, v1);
                    ss += (v0[0] * v0[0] + v0[1] * v0[1]) + (v0[2] * v0[2] + v0[3] * v0[3]) + (v1[0] * v1[0] + v1[1] * v1[1]) + (v1[2] * v1[2] + v1[3] * v1[3]); }
                ss += __shfl_xor(ss, 16); ss += __shfl_xor(ss, 32);
                if (fq == 0) SS4[(size_t)row * 16 + u.pn * 4 + wc] = ss; }
            asm volatile("" ::: "memory");
        }
    }
};

__device__ __forceinline__ float vmaxf(float a, float b) { float r; asm("v_max_f32_e32 %0, %1, %2" : "=v"(r) : "v"(a), "v"(b)); return r; }
__device__ __forceinline__ float vminf(float a, float b) { float r; asm("v_min_f32_e32 %0, %1, %2" : "=v"(r) : "v"(a), "v"(b)); return r; }
__device__ __forceinline__ void sort16_desc(float (&a)[16]) {
#define TK_CE(i, j) do { const float hi_ = vmaxf(a[i], a[j]), lo_ = vminf(a[i], a[j]); a[i] = hi_; a[j] = lo_; } while (0)
    TK_CE(0, 13); TK_CE(1, 12); TK_CE(2, 15); TK_CE(3, 14); TK_CE(4, 8); TK_CE(5, 6); TK_CE(7, 11); TK_CE(9, 10);
    TK_CE(0, 5); TK_CE(1, 7); TK_CE(2, 9); TK_CE(3, 4); TK_CE(6, 13); TK_CE(8, 14); TK_CE(10, 15); TK_CE(11, 12);
    TK_CE(0, 1); TK_CE(2, 3); TK_CE(4, 5); TK_CE(6, 8); TK_CE(7, 9); TK_CE(10, 11); TK_CE(12, 13); TK_CE(14, 15);
    TK_CE(0, 2); TK_CE(1, 3); TK_CE(4, 10); TK_CE(5, 11); TK_CE(6, 7); TK_CE(8, 9); TK_CE(12, 14); TK_CE(13, 15);
    TK_CE(1, 2); TK_CE(3, 12); TK_CE(4, 6); TK_CE(5, 7); TK_CE(8, 10); TK_CE(9, 11); TK_CE(13, 14);
    TK_CE(1, 4); TK_CE(2, 6); TK_CE(5, 8); TK_CE(7, 10); TK_CE(9, 13); TK_CE(11, 14);
    TK_CE(2, 4); TK_CE(3, 6); TK_CE(9, 12); TK_CE(11, 13);
    TK_CE(3, 5); TK_CE(6, 8); TK_CE(7, 9); TK_CE(10, 12);
    TK_CE(3, 4); TK_CE(5, 6); TK_CE(7, 8); TK_CE(9, 10); TK_CE(11, 12);
    TK_CE(6, 7); TK_CE(8, 9);
#undef TK_CE
}
template <int L> __device__ __forceinline__ void merge16(float (&a)[16], const float (&b)[16]) {
#pragma unroll
    for (int i = 0; i < 16; ++i) if (15 - i < L) a[i] = vmaxf(a[i], b[15 - i]);
#pragma unroll
    for (int j = 8; j > 0; j >>= 1)
#pragma unroll
        for (int i = 0; i < 16; ++i) { const int l = i ^ j; if (l > i) { const float hi = vmaxf(a[i], a[l]), lo = vminf(a[i], a[l]); a[i] = hi; a[l] = lo; } }
}
struct EpiTopK {
    static constexpr int PROBE_ID = 5;
    static constexpr bool PERM = true, AFTER_DRAIN = true; static constexpr int MID_T = 0;
    static constexpr int RS = 260;
    const float* SS2; unsigned short* IDS; float* GATES; float eps;
    __device__ __forceinline__ void fused(f32x4 (&acc)[2][2][4][2], const Unit& u, int wr, int wc, int fr, int fq, PG8_LAS unsigned char* lds, int wid, int lane) const {
        PG8_LAS float* S = (PG8_LAS float*)lds;
        const int tid = wid * 64 + lane, row = tid & 127, grp = tid >> 7, half = grp >> 1, part = grp & 1;
#define TK_BAR() do { asm volatile("s_waitcnt lgkmcnt(0)" ::: "memory"); __builtin_amdgcn_s_barrier(); asm volatile("" ::: "memory"); } while (0)
#ifdef MK_PROBE_TOPK2
        for (int rep_ = 0; rep_ < MK_PROBE_TOPK2; ++rep_)
#endif
#pragma unroll
        for (int ai = 0; ai < 2; ++ai) {
#pragma unroll
            for (int m = 0; m < 4; ++m)
#pragma unroll
                for (int bj = 0; bj < 2; ++bj)
#pragma unroll
                    for (int n = 0; n < 2; ++n) *(PG8_LAS f32x4*)(S + (wr * 64 + m * 16 + fr) * RS + bj * HALF + wc * 32 + 8 * fq + 4 * n) = acc[ai][bj][m][n];
            TK_BAR();
            float T[16];
#ifdef MK_PROBE_TK1
            for (int rep1_ = 0; rep1_ < MK_PROBE_TK1; ++rep1_)
#endif
#pragma unroll
            for (int b = 0; b < 4; ++b) {
                float c[16];
#pragma unroll
                for (int q = 0; q < 4; ++q) { const f32x4 v = *(const PG8_LAS f32x4*)(S + row * RS + half * 128 + part * 64 + b * 16 + q * 4);
#pragma unroll
                    for (int e = 0; e < 4; ++e) c[q * 4 + e] = __uint_as_float((__float_as_uint(v[e]) & ~127u) | (unsigned)(part * 64 + b * 16 + q * 4 + e)); }
                sort16_desc(c);
                if (b == 0) {
#pragma unroll
                    for (int i = 0; i < 16; ++i) T[i] = c[i];
                } else merge16<16>(T, c);
            }
            TK_BAR();
#pragma unroll
            for (int q = 0; q < 4; ++q) *(PG8_LAS f32x4*)(S + tid * 16 + q * 4) = (f32x4){T[q * 4], T[q * 4 + 1], T[q * 4 + 2], T[q * 4 + 3]};
            TK_BAR();
            if (part == 0) {
                float c[16];
#pragma unroll
                for (int q = 0; q < 4; ++q) { const f32x4 v = *(const PG8_LAS f32x4*)(S + (tid + 128) * 16 + q * 4); c[q * 4] = v[0]; c[q * 4 + 1] = v[1]; c[q * 4 + 2] = v[2]; c[q * 4 + 3] = v[3]; }
                merge16<16>(T, c);
            }
            TK_BAR();
            if (part == 0) {
#pragma unroll
                for (int q = 0; q < 4; ++q) *(PG8_LAS f32x4*)(S + tid * 16 + q * 4) = (f32x4){T[q * 4], T[q * 4 + 1], T[q * 4 + 2], T[q * 4 + 3]};
            }
            TK_BAR();
#ifdef MK_PROBE_TK3
            for (int rep3_ = 0; rep3_ < MK_PROBE_TK3; ++rep3_)
#endif
            if (tid < 128) {
                float a1[16], a2[16];
#pragma unroll
                for (int q = 0; q < 4; ++q) { const f32x4 v = *(const PG8_LAS f32x4*)(S + (tid + 256) * 16 + q * 4);
#pragma unroll
                    for (int e = 0; e < 4; ++e) a2[q * 4 + e] = __uint_as_float(__float_as_uint(v[e]) & ~127u); }
#pragma unroll
                for (int i = 0; i < 16; ++i) a1[i] = __uint_as_float(__float_as_uint(T[i]) & ~127u);
#define TK_SUM(i, j) __uint_as_float((__float_as_uint(a1[i] + a2[j]) & ~255u) | (unsigned)((i) * 16 + (j)))
                float R[16], C[16];
#pragma unroll
                for (int j = 0; j < 16; ++j) R[j] = TK_SUM(0, j);
#pragma unroll
                for (int i = 1; i < 16; ++i) C[i - 1] = TK_SUM(i, 0);
                C[15] = 0.f;
                merge16<15>(R, C);
                C[0] = TK_SUM(1, 1); C[1] = TK_SUM(1, 2); C[2] = TK_SUM(1, 3); C[3] = TK_SUM(1, 4); C[4] = TK_SUM(1, 5); C[5] = TK_SUM(1, 6); C[6] = TK_SUM(1, 7);
                C[7] = TK_SUM(2, 1); C[8] = TK_SUM(2, 2); C[9] = TK_SUM(2, 3); C[10] = TK_SUM(2, 4); C[11] = TK_SUM(3, 1); C[12] = TK_SUM(3, 2); C[13] = TK_SUM(3, 3);
                C[14] = TK_SUM(4, 1); C[15] = TK_SUM(4, 2);
                sort16_desc(C);
                merge16<16>(R, C);
                C[0] = TK_SUM(5, 1); C[1] = TK_SUM(6, 1); C[2] = TK_SUM(7, 1);
                merge16<3>(R, C);
#undef TK_SUM
                const int rowg = u.pm * BM + ai * HALF + row;
                const f32x4* ssp = (const f32x4*)(SS2 + (size_t)rowg * 16); const f32x4 s0 = ssp[0], s1 = ssp[1], s2 = ssp[2], s3 = ssp[3];
                const float ssum = ((s0[0] + s0[1]) + (s0[2] + s0[3])) + ((s1[0] + s1[1]) + (s1[2] + s1[3])) + ((s2[0] + s2[1]) + (s2[2] + s2[3])) + ((s3[0] + s3[1]) + (s3[2] + s3[3]));
                const float rl = 1.4426950408889634f / sqrtf(ssum * (1.0f / 1024.0f) + eps);
                float ev[16], esum = 0.f; int idv[16];
#pragma unroll
                for (int r = 0; r < 16; ++r) { ev[r] = __builtin_amdgcn_exp2f((R[r] - R[0]) * rl); esum += ev[r];
                    const unsigned code = __float_as_uint(R[r]) & 255u;
                    const unsigned k1 = __float_as_uint(S[tid * 16 + (code >> 4)]) & 127u, k2 = __float_as_uint(S[(tid + 256) * 16 + (code & 15u)]) & 127u;
                    idv[r] = (int)(k1 * 128u + k2); }
                const float inv = 1.0f / esum;
                unsigned short* ip = IDS + (size_t)rowg * 128 + u.pn * 16; float* gp = GATES + (size_t)rowg * 128 + u.pn * 16;
#pragma unroll
                for (int q = 0; q < 2; ++q) { u32x4 w; w.x = (unsigned)idv[q * 8] | ((unsigned)idv[q * 8 + 1] << 16); w.y = (unsigned)idv[q * 8 + 2] | ((unsigned)idv[q * 8 + 3] << 16); w.z = (unsigned)idv[q * 8 + 4] | ((unsigned)idv[q * 8 + 5] << 16); w.w = (unsigned)idv[q * 8 + 6] | ((unsigned)idv[q * 8 + 7] << 16);
                    *(u32x4*)(ip + q * 8) = w; }
#pragma unroll
                for (int q = 0; q < 4; ++q) *(f32x4*)(gp + q * 4) = (f32x4){ev[q * 4] * inv, ev[q * 4 + 1] * inv, ev[q * 4 + 2] * inv, ev[q * 4 + 3] * inv};
            }
            TK_BAR();
        }
#undef TK_BAR
    }
};
template <class Epi, class Sched, bool ALIGN_EPI = false, bool SP2 = false>
__device__ __forceinline__ void gemm_phase(PG8_LAS unsigned char* lds, const Gemm g, const Sched& S, const Epi& E) {
    const int tid = threadIdx.x, wid = __builtin_amdgcn_readfirstlane(tid >> 6), lane = tid & 63, wr = wid >> 2, wc = wid & 3, fr = lane & 15, fq = lane >> 4;
    const int K = g.K, nt = K / BK;
    unsigned voffA[2], voffB[2];
#pragma unroll
    for (int i = 0; i < 2; ++i) { int R, C; stage_rc(tid * 16 + i * 8192, R, C); const int Rb = Epi::PERM ? ((R & ~31) + perm32(R & 31)) : R;
        voffA[i] = (unsigned)(R * K + C) * 2u; voffB[i] = (unsigned)(Rb * K + C) * 2u; }
    const size_t kstep = (size_t)(BK * 2);
    const size_t hstep = (size_t)HALF * K * 2;
    const size_t tstep = 2 * hstep;
    const unsigned ldsw = (unsigned)wid * 1024u;
    const int aoff = lds_byte(wr * 64 + fr, fq * 8), boff = lds_byte(wc * 32 + fr, fq * 8);
#define PG8_SA(b, h) (((b) * 2 + (h)) * HTB)
#define PG8_SB(b, h) ((4 + (b) * 2 + (h)) * HTB)
#define PG8_STAGE(bufoff, gbase, voff) do { _Pragma("unroll") for (int _i = 0; _i < 2; ++_i) \
        __builtin_amdgcn_global_load_lds((const unsigned*)((const char*)(gbase) + (voff)[_i]), (PG8_LAS unsigned*)(lds + (bufoff) + ldsw + _i * 8192), 16, 0, 0); } while (0)
#define PG8_LDA(dst, b, h) do { _Pragma("unroll") for (int m = 0; m < 4; ++m) _Pragma("unroll") for (int k = 0; k < 2; ++k) dst[m][k] = *(const PG8_LAS bf16x8*)(lds + PG8_SA(b, h) + aoff + m * 2048 + k * 1024); } while (0)
#define PG8_LDB(dst, b, h) do { _Pragma("unroll") for (int n = 0; n < 2; ++n) _Pragma("unroll") for (int k = 0; k < 2; ++k) dst[n][k] = *(const PG8_LAS bf16x8*)(lds + PG8_SB(b, h) + boff + n * 2048 + k * 1024); } while (0)
#define PG8_MMA(ai, bj, At, Bt) do { __builtin_amdgcn_s_setprio(1); _Pragma("unroll") for (int m = 0; m < 4; ++m) _Pragma("unroll") for (int n = 0; n < 2; ++n) _Pragma("unroll") for (int k = 0; k < 2; ++k) \
        acc[ai][bj][m][n] = __builtin_amdgcn_mfma_f32_16x16x32_bf16(Bt[n][k], At[m][k], acc[ai][bj][m][n], 0, 0, 0); __builtin_amdgcn_s_setprio(0); } while (0)
#define PG8_WAIT_V(n) asm volatile("s_waitcnt vmcnt(" #n ")" ::: "memory")
#define PG8_WAIT_L(n) asm volatile("s_waitcnt lgkmcnt(" #n ")" ::: "memory")
#define PG8_BAR __builtin_amdgcn_s_barrier()
#define PG8_SCHED __builtin_amdgcn_sched_barrier(0)
    Unit cur, nxt; int ui = 0;
    if (!S.next(0, cur)) return;
    f32x4 acc[2][2][4][2];
#pragma unroll
    for (int a = 0; a < 2; ++a)
#pragma unroll
        for (int b = 0; b < 2; ++b)
#pragma unroll
            for (int m = 0; m < 4; ++m)
#pragma unroll
                for (int n = 0; n < 2; ++n) acc[a][b][m][n] = (f32x4){0.f, 0.f, 0.f, 0.f};
    bf16x8 At[4][2], B0[2][2], B1[2][2];
    const char* cA = (const char*)g.A + (size_t)cur.pm * tstep; const char* cB = (const char*)g.Bt + (size_t)cur.pn * tstep;
    S.a_ready(cur);
    if constexpr (SP2) {
        PG8_STAGE(PG8_SB(0, 0), cB, voffB); PG8_STAGE(PG8_SB(0, 1), cB + hstep, voffB); PG8_STAGE(PG8_SA(0, 0), cA, voffA); PG8_STAGE(PG8_SA(0, 1), cA + hstep, voffA);
        if (wr == 1) PG8_BAR;
        PG8_WAIT_V(2); PG8_BAR;
        PG8_STAGE(PG8_SB(1, 0), cB + kstep, voffB); PG8_STAGE(PG8_SA(1, 0), cA + kstep, voffA); PG8_STAGE(PG8_SB(1, 1), cB + hstep + kstep, voffB);
        PG8_WAIT_V(6); PG8_BAR;
    } else {
        PG8_STAGE(PG8_SB(0, 0), cB, voffB); PG8_STAGE(PG8_SA(0, 0), cA, voffA); PG8_STAGE(PG8_SB(0, 1), cB + hstep, voffB); PG8_STAGE(PG8_SA(0, 1), cA + hstep, voffA);
        if (wr == 1) PG8_BAR;
        PG8_WAIT_V(4); PG8_BAR;
        PG8_STAGE(PG8_SB(1, 0), cB + kstep, voffB); PG8_STAGE(PG8_SA(1, 0), cA + kstep, voffA); PG8_STAGE(PG8_SB(1, 1), cB + hstep + kstep, voffB);
        PG8_WAIT_V(6); PG8_BAR;
    }
    for (;;) {
        const bool has_next = S.next(ui + 1, nxt);
        const char* nA = has_next ? (const char*)g.A + (size_t)nxt.pm * tstep : cA; const char* nB = has_next ? (const char*)g.Bt + (size_t)nxt.pn * tstep : cB;
        for (int t = 0; t < nt; t += 2) {
            if constexpr (Epi::MID_T > 0) { if (t == Epi::MID_T) E.mid(acc, cur, wr, wc, fr, fq); }
            const bool last = (t == nt - 2);
            const char* a1 = cA + (size_t)(t + 1) * kstep;
            const char* a2 = last ? nA : cA + (size_t)(t + 2) * kstep; const char* b2 = last ? nB : cB + (size_t)(t + 2) * kstep;
            const char* a3 = a2 + kstep; const char* b3 = b2 + kstep;
            if (last && has_next) S.a_ready(nxt);
            if constexpr (SP2) {
            PG8_LDB(B0, 0, 0); PG8_LDB(B1, 0, 1); PG8_SCHED; PG8_LDA(At, 0, 0); PG8_STAGE(PG8_SA(1, 1), a1 + hstep, voffA);
            PG8_WAIT_V(8); PG8_WAIT_L(0); PG8_BAR; PG8_MMA(0, 0, At, B0); PG8_MMA(0, 1, At, B1); PG8_BAR; PG8_SCHED;
            PG8_LDA(At, 0, 1); PG8_STAGE(PG8_SB(0, 0), b2, voffB); PG8_STAGE(PG8_SB(0, 1), b2 + hstep, voffB); PG8_STAGE(PG8_SA(0, 0), a2, voffA);
            PG8_WAIT_V(8); PG8_WAIT_L(0); PG8_BAR; PG8_MMA(1, 0, At, B0); PG8_MMA(1, 1, At, B1); PG8_BAR; PG8_SCHED;
            PG8_LDB(B0, 1, 0); PG8_LDB(B1, 1, 1); PG8_SCHED; PG8_LDA(At, 1, 0); PG8_STAGE(PG8_SA(0, 1), a2 + hstep, voffA);
            PG8_WAIT_V(8); PG8_WAIT_L(0); PG8_BAR; PG8_MMA(0, 0, At, B0); PG8_MMA(0, 1, At, B1); PG8_BAR; PG8_SCHED;
            PG8_LDA(At, 1, 1); PG8_STAGE(PG8_SB(1, 0), b3, voffB); PG8_STAGE(PG8_SB(1, 1), b3 + hstep, voffB); PG8_STAGE(PG8_SA(1, 0), a3, voffA);
            PG8_WAIT_V(8); PG8_WAIT_L(0); PG8_BAR; PG8_MMA(1, 0, At, B0); PG8_MMA(1, 1, At, B1); PG8_BAR; PG8_SCHED;
            } else {
            PG8_LDB(B0, 0, 0); PG8_SCHED; PG8_LDA(At, 0, 0); PG8_STAGE(PG8_SA(1, 1), a1 + hstep, voffA);
            PG8_WAIT_L(8); PG8_BAR; PG8_WAIT_L(0); PG8_MMA(0, 0, At, B0); PG8_BAR; PG8_SCHED;
            PG8_LDB(B1, 0, 1); PG8_STAGE(PG8_SB(0, 0), b2, voffB);
            PG8_BAR; PG8_WAIT_L(0); PG8_MMA(0, 1, At, B1); PG8_BAR;
            PG8_LDA(At, 0, 1); PG8_STAGE(PG8_SA(0, 0), a2, voffA);
            PG8_BAR; PG8_WAIT_L(0); PG8_MMA(1, 0, At, B0); PG8_BAR; PG8_SCHED;
            PG8_STAGE(PG8_SB(0, 1), b2 + hstep, voffB);
            PG8_WAIT_V(6); PG8_BAR; PG8_MMA(1, 1, At, B1); PG8_BAR;
            PG8_LDB(B0, 1, 0); PG8_SCHED; PG8_LDA(At, 1, 0); PG8_STAGE(PG8_SA(0, 1), a2 + hstep, voffA);
            PG8_WAIT_L(8); PG8_BAR; PG8_WAIT_L(0); PG8_MMA(0, 0, At, B0); PG8_BAR; PG8_SCHED;
            PG8_LDB(B1, 1, 1); PG8_STAGE(PG8_SB(1, 0), b3, voffB);
            PG8_BAR; PG8_WAIT_L(0); PG8_MMA(0, 1, At, B1); PG8_BAR;
            PG8_LDA(At, 1, 1); PG8_STAGE(PG8_SA(1, 0), a3, voffA);
            PG8_BAR; PG8_WAIT_L(0); PG8_MMA(1, 0, At, B0); PG8_BAR; PG8_SCHED;
            PG8_STAGE(PG8_SB(1, 1), b3 + hstep, voffB);
            PG8_WAIT_V(6); PG8_BAR; PG8_MMA(1, 1, At, B1); PG8_BAR;
            }
        }
        if constexpr (ALIGN_EPI) { if (wr == 0) PG8_BAR; }
#ifdef MK_PROBE_EPI2
        if constexpr (!Epi::AFTER_DRAIN && Epi::PROBE_ID == MK_PROBE_EPI_ID) { for (int rep_ = 1; rep_ < MK_PROBE_EPI2; ++rep_) E(acc, cur, wr, wc, fr, fq); }
#endif
        if constexpr (!Epi::AFTER_DRAIN) { E(acc, cur, wr, wc, fr, fq); S.done(cur); }
        if (!has_next) break;
#pragma unroll
        for (int a = 0; a < 2; ++a)
#pragma unroll
            for (int b = 0; b < 2; ++b)
#pragma unroll
                for (int m = 0; m < 4; ++m)
#pragma unroll
                    for (int n = 0; n < 2; ++n) acc[a][b][m][n] = (f32x4){0.f, 0.f, 0.f, 0.f};
        cur = nxt; cA = nA; cB = nB; ++ui;
        if constexpr (ALIGN_EPI) { if (wr == 1) PG8_BAR; }
    }
    PG8_WAIT_V(0);
    if constexpr (!ALIGN_EPI) { if (wr == 0) PG8_BAR; }
    PG8_BAR;
    if constexpr (Epi::AFTER_DRAIN) { E.fused(acc, cur, wr, wc, fr, fq, lds, wid, lane); S.done(cur); }
#undef PG8_SA
#undef PG8_SB
#undef PG8_STAGE
#undef PG8_LDA
#undef PG8_LDB
#undef PG8_MMA
#undef PG8_WAIT_V
#undef PG8_WAIT_L
#undef PG8_BAR
#undef PG8_SCHED
}
}
#ifndef PG8_SP2
#define PG8_SP2 true
#endif
#ifndef PG8_ALIGN
#define PG8_ALIGN true
#endif
namespace attn_body {
using bf16=__hip_bfloat16;
using bf16x8=__attribute__((ext_vector_type(8)))short;
using s16x4=__attribute__((ext_vector_type(4)))short;
using f32x16=__attribute__((ext_vector_type(16)))float;
using u32x4=__attribute__((ext_vector_type(4)))unsigned;
using f32x4v=__attribute__((ext_vector_type(4)))float;
constexpr int BATCH=4,NHEAD=8,SEQ=4096,D=64,DM=NHEAD*D,DMO=1024;
constexpr int NW=8,QBLK=32,QB=QBLK*NW,KVBLK=64,NQB=SEQ/QB;
constexpr int ATTN_PITCH=DM, ATTN_UNIT_ROWS=QB;
__device__ __forceinline__ int crow(int r,int hi){return (r&3)+8*(r>>2)+4*hi;}
#define SBAR() __builtin_amdgcn_sched_barrier(0)
__device__ __forceinline__ void cmask(f32x16&p0,f32x16&p1,int jb,int qrel,int hi){
  const float NEG=-INFINITY; int kb=64*jb+4*hi;
  #pragma unroll
  for(int r=0;r<16;++r){int kv=kb+(r&3)+8*(r>>2); if(kv>qrel)p0[r]=NEG; if(kv+32>qrel)p1[r]=NEG;}
}

constexpr int NSLOT=3, SLOTB=8192;
constexpr float SKIP_TH=64.0f;
constexpr int LDS_K=0, LDS_V=NSLOT*SLOTB, LDS_WS=2*NSLOT*SLOTB, LDS_OST=LDS_WS+NW*64*4, LDS_CS=LDS_OST+NW*4096, LDS_BYTES=LDS_CS+SEQ*4+64;
constexpr float C2=0.125f*1.4426950408889634f;
__device__ __forceinline__ void glds16(const void*gsrc,unsigned lds_dst){unsigned keep;
  asm volatile("s_mov_b32 %0, m0\n\ts_mov_b32 m0, %2\n\ts_nop 0\n\tglobal_load_lds_dwordx4 %1, off\n\ts_mov_b32 m0, %0":"=&s"(keep):"v"(gsrc),"s"(lds_dst):"memory");}
__device__ __forceinline__ float max3f(float a,float b,float c){float r;asm("v_max3_f32 %0, %1, %2, %3":"=v"(r):"v"(a),"v"(b),"v"(c));return r;}
__device__ __forceinline__ float max2f(float a,float b){float r;asm("v_max_f32_e32 %0, %1, %2":"=v"(r):"v"(a),"v"(b));return r;}
__device__ __forceinline__ float fadd_s(float a,float b){float r;asm("v_add_f32_e32 %0, %1, %2":"=v"(r):"v"(a),"v"(b));return r;}
__device__ __forceinline__ float fsub_s(float a,float b){float r;asm("v_sub_f32_e32 %0, %1, %2":"=v"(r):"v"(a),"v"(b));return r;}
typedef float f32x2_t __attribute__((ext_vector_type(2))); typedef __bf16 bf16x2_t __attribute__((ext_vector_type(2)));
__device__ __forceinline__ unsigned cvtpk_s(float lo,float hi){f32x2_t v={lo,hi};bf16x2_t b=__builtin_convertvector(v,bf16x2_t);return __builtin_bit_cast(unsigned,b);}
#define WAIT_BAR(N) asm volatile("s_waitcnt vmcnt(" #N ") lgkmcnt(0)\n\ts_barrier":::"memory")

__device__ __forceinline__ void qkt(f32x16&p0,f32x16&p1,const char*Kslot,const bf16x8*qr,const f32x16&c0,const f32x16&c1,int r32,int hi){
  const char*kb=Kslot+hi*1024+r32*16;
  #pragma unroll
  for(int d0=0;d0<4;++d0){
    const bf16x8 b0=*reinterpret_cast<const bf16x8*>(kb+d0*2048);
    const bf16x8 b1=*reinterpret_cast<const bf16x8*>(kb+d0*2048+512);
    if(d0==0){p0=__builtin_amdgcn_mfma_f32_32x32x16_bf16(b0,qr[0],c0,0,0,0);p1=__builtin_amdgcn_mfma_f32_32x32x16_bf16(b1,qr[0],c1,0,0,0);}
    else{p0=__builtin_amdgcn_mfma_f32_32x32x16_bf16(b0,qr[d0],p0,0,0,0);p1=__builtin_amdgcn_mfma_f32_32x32x16_bf16(b1,qr[d0],p1,0,0,0);}}
}
typedef __attribute__((address_space(3))) const char* lds_cptr;
typedef short v4i16_t __attribute__((ext_vector_type(4)));
__device__ __forceinline__ void kload8(bf16x8*kf,lds_cptr kp){
  kf[0]=*(const __attribute__((address_space(3))) bf16x8*)(kp);      kf[1]=*(const __attribute__((address_space(3))) bf16x8*)(kp+512);
  kf[2]=*(const __attribute__((address_space(3))) bf16x8*)(kp+2048); kf[3]=*(const __attribute__((address_space(3))) bf16x8*)(kp+2560);
  kf[4]=*(const __attribute__((address_space(3))) bf16x8*)(kp+4096); kf[5]=*(const __attribute__((address_space(3))) bf16x8*)(kp+4608);
  kf[6]=*(const __attribute__((address_space(3))) bf16x8*)(kp+6144); kf[7]=*(const __attribute__((address_space(3))) bf16x8*)(kp+6656);
}
__device__ __forceinline__ void kload2(bf16x8*kf,lds_cptr kp,int j){ kf[2*j]=*(const __attribute__((address_space(3))) bf16x8*)(kp+j*2048); kf[2*j+1]=*(const __attribute__((address_space(3))) bf16x8*)(kp+j*2048+512); }
__device__ __forceinline__ s16x4 vtr(lds_cptr p){ return __builtin_bit_cast(s16x4,__builtin_amdgcn_ds_read_tr16_b64_v4i16((__attribute__((address_space(3))) v4i16_t*)p)); }
__device__ __forceinline__ float rowmax(const f32x16&p0,const f32x16&p1){
  float a=max3f(p0[0],p0[1],p1[0]),b=max3f(p0[2],p0[3],p1[1]);a=max3f(a,p1[2],p1[3]);
  #pragma unroll
  for(int r=4;r<16;r+=4){a=max3f(a,p0[r],p0[r+1]);b=max3f(b,p0[r+2],p0[r+3]);a=max3f(a,p1[r],p1[r+1]);b=max3f(b,p1[r+2],p1[r+3]);}
  const float m=max2f(a,b);
  auto rr=__builtin_amdgcn_permlane32_swap(__float_as_uint(m),__float_as_uint(m),false,false);
  return max2f(__uint_as_float(rr[0]),__uint_as_float(rr[1]));
}
__device__ __forceinline__ void pv(f32x16*o,int vb,bf16x8 pa0,bf16x8 pa1,bf16x8 pa2,bf16x8 pa3){
  #pragma unroll
  for(int d0=0;d0<2;++d0){s16x4 lo[4],hi[4];
    #pragma unroll
    for(int ks=0;ks<4;++ks){
      asm volatile("ds_read_b64_tr_b16 %0,%1 offset:%c2":"=&v"(lo[ks]):"v"(vb),"i"(d0*4096+ks*1024):"memory");
      asm volatile("ds_read_b64_tr_b16 %0,%1 offset:%c2":"=&v"(hi[ks]):"v"(vb),"i"(d0*4096+ks*1024+512):"memory");}
    asm volatile("s_waitcnt lgkmcnt(0)":::"memory");SBAR();
    #define PK(k) (bf16x8){lo[k][0],lo[k][1],lo[k][2],lo[k][3],hi[k][0],hi[k][1],hi[k][2],hi[k][3]}
    o[d0]=__builtin_amdgcn_mfma_f32_32x32x16_bf16(pa0,PK(0),o[d0],0,0,0);
    o[d0]=__builtin_amdgcn_mfma_f32_32x32x16_bf16(pa1,PK(1),o[d0],0,0,0);
    o[d0]=__builtin_amdgcn_mfma_f32_32x32x16_bf16(pa2,PK(2),o[d0],0,0,0);
    o[d0]=__builtin_amdgcn_mfma_f32_32x32x16_bf16(pa3,PK(3),o[d0],0,0,0);
    #undef PK
  }
}

#ifndef ATTN_STORE16
#define ATTN_STORE16(p,v) (*(u32x4*)(p)=(v))
#endif
template<int THRL> __device__ __forceinline__ void attn_unit(int b,int h,int qb,const bf16*Q,const bf16*__restrict__ K,const bf16*__restrict__ V,bf16*O,const float*__restrict__ LFrow,char*shm){
  int tid_l=threadIdx.x; asm volatile("":"+v"(tid_l));
  const int tid=tid_l,lane=tid&63,r32=lane&31,hi=lane>>5; const int wid=__builtin_amdgcn_readfirstlane(tid>>6);
  const long rowbase=(long)b*SEQ; const int q0=qb*QB;
  const lds_cptr shm3=(lds_cptr)shm;
  typedef __attribute__((address_space(3))) float lds_f32; typedef __attribute__((address_space(3))) f32x4v lds_f32x4;
  lds_f32* const csl=(lds_f32*)(shm3+LDS_CS);
  { const int ncs=q0+QB, i0=tid*8; f32x4v ca={0.f,0.f,0.f,0.f},cb={0.f,0.f,0.f,0.f};
    if(i0<ncs){ca=*(const f32x4v*)(LFrow+i0);cb=*(const f32x4v*)(LFrow+i0+4);}
    ca.y+=ca.x;ca.z+=ca.y;ca.w+=ca.z;cb.x+=ca.w;cb.y+=cb.x;cb.z+=cb.y;cb.w+=cb.z;
    const float tot=cb.w; float inc=tot;
    _Pragma("unroll") for(int o_=1;o_<64;o_<<=1){const float v_=__shfl_up(inc,o_);if(lane>=o_)inc+=v_;}
    if(lane==63)csl[SEQ+wid]=inc;
    asm volatile("s_waitcnt vmcnt(0) lgkmcnt(0)\n\ts_barrier":::"memory");
    float base_=inc-tot;
    _Pragma("unroll") for(int w_=0;w_<NW;++w_){const float t_=csl[SEQ+w_];if(w_<wid)base_+=t_;}
    if(i0<ncs){*(lds_f32x4*)(csl+i0)=ca+base_;*(lds_f32x4*)(csl+i0+4)=cb+base_;}
    asm volatile("s_waitcnt vmcnt(0) lgkmcnt(0)\n\ts_barrier":::"memory"); }
  int ts; { const int NT0=(q0+QB)/KVBLK, cand=2*lane; bool ok=false;
    if(lane<32&&cand<=NT0-4) ok=(cand==0)||(csl[q0]-csl[64*cand-1]<=-SKIP_TH);
    const unsigned long long mk=__ballot(ok); ts=__builtin_amdgcn_readfirstlane(2*(63-__builtin_clzll(mk|1ull))); }
  const bf16*Qw=Q+(rowbase+q0+wid*QBLK)*DM+h*D;
  const bf16*Kh=K+(rowbase+(long)ts*KVBLK)*DM+h*D,*Vh=V+(rowbase+(long)ts*KVBLK)*DM+h*D;
  const unsigned lds0=(unsigned)(uintptr_t)shm;
  float*wsf=(float*)(shm+LDS_WS)+wid*64;
  const bf16*ksrc=Kh+(long)lane*DM+wid*8;
  const bf16*vsrc=Vh+(long)(16*(wid&3)+(lane>>2))*DM+(wid>>2)*32+(lane&3)*8;
  const unsigned kdst=lds0+LDS_K+wid*1024, vdst=lds0+LDS_V+wid*1024;
  #define DMA_K(t,slot) glds16(ksrc+(long)(t)*KVBLK*DM,(unsigned)__builtin_amdgcn_readfirstlane(kdst+(slot)))
  #define DMA_V(t,slot) glds16(vsrc+(long)(t)*KVBLK*DM,(unsigned)__builtin_amdgcn_readfirstlane(vdst+(slot)))
  const int vb0=(int)(lds0+LDS_V)+((lane>>4)&1)*32+(lane&3)*8+(4*hi+((lane&15)>>2))*64;
  const char*Kbase=shm+LDS_K; bf16x8 kf[8];
  const lds_cptr kp0=shm3+LDS_K+hi*1024+r32*16; const lds_cptr vp0=shm3+LDS_V+((lane>>4)&1)*32+(lane&3)*8+(4*hi+((lane&15)>>2))*64;
  const int NT=(q0+QB)/KVBLK-ts;
  const float cq=csl[q0+wid*QBLK+r32];
  const lds_cptr csb=shm3+LDS_CS+hi*16+ts*256;
  #define CINIT(C0,C1,t) do{ _Pragma("unroll") for(int g_=0;g_<4;++g_){ const f32x4v a_=*(const lds_f32x4*)(csb+(t)*256+g_*32), b_=*(const lds_f32x4*)(csb+(t)*256+128+g_*32); \
      C0[4*g_]=cqm-a_.x;C0[4*g_+1]=cqm-a_.y;C0[4*g_+2]=cqm-a_.z;C0[4*g_+3]=cqm-a_.w; C1[4*g_]=cqm-b_.x;C1[4*g_+1]=cqm-b_.y;C1[4*g_+2]=cqm-b_.z;C1[4*g_+3]=cqm-b_.w; } }while(0)
  DMA_K(0,0);DMA_V(0,0);DMA_K(1,SLOTB);
  bf16x8 qr[4];
  #pragma unroll
  for(int d0=0;d0<4;++d0)qr[d0]=*reinterpret_cast<const bf16x8*>(&Qw[(long)r32*DM+d0*16+hi*8]);
  float mhat=0.f,l_reg=0.f,cqm=cq;f32x16 o[2];o[0]=f32x16{};o[1]=f32x16{};
  const int qrel=wid*QBLK+r32;
  #define CMASK(P0,P1,t) do{int jb_=(t)-(NT-4); if(jb_>=0)cmask(P0,P1,jb_,qrel,hi);}while(0)
  bool resc=false;
  #define START(P0,P1) do{ const float rm=rowmax(P0,P1); resc=false; \
    { const float dl=rm; mhat=fadd_s(mhat,dl); \
      _Pragma("unroll") for(int r=0;r<16;++r){P0[r]=fsub_s(P0[r],dl);P1[r]=fsub_s(P1[r],dl);} \
      cqm=cq-mhat; } \
    _Pragma("unroll") for(int r=0;r<16;++r)P0[r]=__builtin_amdgcn_exp2f(P0[r]); }while(0)
  #define RESC() do{ if(resc){ asm volatile("s_waitcnt lgkmcnt(0)":::"memory"); \
      _Pragma("unroll") for(int d_=0;d_<2;++d_) _Pragma("unroll") for(int r=0;r<16;++r)o[d_][r]*=wsf[crow(r,hi)]; } }while(0)
  f32x16 pA0,pA1,pB0,pB1;
  int sl_prev=0,sl_cur=0,sl_next=SLOTB;
  #define ROT() do{sl_prev=sl_cur;sl_cur=sl_next;sl_next=(sl_next==(NSLOT-1)*SLOTB)?0:sl_next+SLOTB;}while(0)
  DMA_K(2,2*SLOTB);
  WAIT_BAR(3);
  { f32x16 ci0,ci1; CINIT(ci0,ci1,0); qkt(pA0,pA1,Kbase,qr,ci0,ci1,r32,hi); } asm volatile("s_nop 15\n\ts_nop 7":"+v"(pA0),"+v"(pA1));CMASK(pA0,pA1,0);
  START(pA0,pA1);
  _Pragma("unroll") for(int r=0;r<16;++r)pA1[r]=__builtin_amdgcn_exp2f(pA1[r]);
  WAIT_BAR(0);
  DMA_K(3,0);DMA_V(1,SLOTB);
  ROT();
  kload8(kf,kp0+sl_cur);
  WAIT_BAR(2);
  s16x4 vlo[8],vhi[8]; u32x4 pw0,pw1,pw2,pw3;
  #define PKW(P,B) cvtpk_s(P[B],P[B+1])
  #define PAF(k) __builtin_bit_cast(bf16x8,pw##k)
  #define VFR(i) (bf16x8){vlo[i][0],vlo[i][1],vlo[i][2],vlo[i][3],vhi[i][0],vhi[i][1],vhi[i][2],vhi[i][3]}
  #define PIN(x) asm volatile("":"+v"(x))
  #define MX3(a,b,c) __builtin_fmaxf(__builtin_fmaxf((a),(b)),(c))
  #define GAPA(MF,A0,A1,A2,A3,W0,W1,PW) do{ MF; sacc+=A0; sacc+=A1; sacc+=A2; sacc+=A3; PIN(sacc); W0; W1; PIN(PW); SBAR(); }while(0)
  #define EX(v) __builtin_amdgcn_exp2f(v)
  #define GAPB(MF,X,B) do{ MF; X[B]=EX(X[B]); X[B+1]=EX(X[B+1]); X[B+2]=EX(X[B+2]); X[B+3]=EX(X[B+3]); PIN(X); SBAR(); }while(0)
  #define VRD(i) do{ vlo[i]=vtr(vp_+(((i)>>2)*4096+((i)&3)*1024)); vhi[i]=vtr(vp_+(((i)>>2)*4096+((i)&3)*1024+512)); }while(0)
  #define KRD(G,j) do{ if(G){ kload2(kf,kp0+sl_next,j); SBAR(); } }while(0)
  #define STEP(C0,C1,P0,P1,t,GK,GV,GL) do{ SBAR(); \
    CINIT(C0,C1,t); SBAR(); \
    const lds_cptr vp_=vp0+sl_prev; \
    VRD(0); SBAR(); float sacc=(P0[0]+P0[1]); \
    GAPA(C0=__builtin_amdgcn_mfma_f32_32x32x16_bf16(kf[0],qr[0],C0,0,0,0), P0[2],P0[3],P0[4],P0[5],     pw0[0]=PKW(P0,0), pw0[1]=PKW(P0,2), pw0); \
    VRD(4); SBAR(); GAPA(C1=__builtin_amdgcn_mfma_f32_32x32x16_bf16(kf[1],qr[0],C1,0,0,0), P0[6],P0[7],P0[8],P0[9],     pw0[2]=PKW(P0,4), pw0[3]=PKW(P0,6), pw0); \
    VRD(1); SBAR(); GAPA(C0=__builtin_amdgcn_mfma_f32_32x32x16_bf16(kf[2],qr[1],C0,0,0,0),   P0[10],P0[11],P0[12],P0[13], pw1[0]=PKW(P0,8), pw1[1]=PKW(P0,10), pw1); \
    VRD(5); SBAR(); GAPA(C1=__builtin_amdgcn_mfma_f32_32x32x16_bf16(kf[3],qr[1],C1,0,0,0),   P0[14],P0[15],P1[0],P1[1],   pw1[2]=PKW(P0,12),pw1[3]=PKW(P0,14), pw1); \
    VRD(2); SBAR(); GAPA(C0=__builtin_amdgcn_mfma_f32_32x32x16_bf16(kf[4],qr[2],C0,0,0,0),   P1[2],P1[3],P1[4],P1[5],     pw2[0]=PKW(P1,0), pw2[1]=PKW(P1,2), pw2); \
    VRD(6); SBAR(); GAPA(C1=__builtin_amdgcn_mfma_f32_32x32x16_bf16(kf[5],qr[2],C1,0,0,0),   P1[6],P1[7],P1[8],P1[9],     pw2[2]=PKW(P1,4), pw2[3]=PKW(P1,6), pw2); \
    VRD(3); SBAR(); GAPA(C0=__builtin_amdgcn_mfma_f32_32x32x16_bf16(kf[6],qr[3],C0,0,0,0),   P1[10],P1[11],P1[12],P1[13], pw3[0]=PKW(P1,8), pw3[1]=PKW(P1,10), pw3); \
    VRD(7); SBAR(); GAPA(C1=__builtin_amdgcn_mfma_f32_32x32x16_bf16(kf[7],qr[3],C1,0,0,0),   P1[14],P1[15],0.f,0.f,       pw3[2]=PKW(P1,12),pw3[3]=PKW(P1,14), pw3); \
    l_reg+=sacc; \
    if(GK){DMA_K((t)+3,sl_cur);} if(GV){DMA_V((t)+1,sl_next);} \
    CMASK(C0,C1,t); \
    { float a=MX3(C0[0],C0[1],C1[0]),b=MX3(C0[2],C0[3],C1[1]); a=MX3(a,C1[2],C1[3]); \
      _Pragma("unroll") for(int r=4;r<16;r+=4){a=MX3(a,C0[r],C0[r+1]);b=MX3(b,C0[r+2],C0[r+3]);a=MX3(a,C1[r],C1[r+1]);b=MX3(b,C1[r+2],C1[r+3]);} \
      float rm=__builtin_fmaxf(a,b); { auto rr=__builtin_amdgcn_permlane32_swap(__float_as_uint(rm),__float_as_uint(rm),false,false); rm=__builtin_fmaxf(__uint_as_float(rr[0]),__uint_as_float(rr[1])); } \
      resc=false; \
      if(__builtin_expect(__any(rm>(float)THRL),0)){ const float dl=__builtin_fmaxf(rm,0.f); mhat+=dl; \
        _Pragma("unroll") for(int r=0;r<16;++r){C0[r]-=dl;C1[r]-=dl;} \
        cqm=cq-mhat; \
        const float f=__builtin_amdgcn_exp2f(-dl); l_reg*=f; if(hi==0)wsf[r32]=f; resc=true; } } \
    SBAR(); \
    GAPB(o[0]=__builtin_amdgcn_mfma_f32_32x32x16_bf16(PAF(0),VFR(0),o[0],0,0,0), C0,0); \
    GAPB(o[1]=__builtin_amdgcn_mfma_f32_32x32x16_bf16(PAF(0),VFR(4),o[1],0,0,0), C0,4); \
    KRD(GL,0); GAPB(o[0]=__builtin_amdgcn_mfma_f32_32x32x16_bf16(PAF(1),VFR(1),o[0],0,0,0), C0,8); \
    KRD(GL,1); GAPB(o[1]=__builtin_amdgcn_mfma_f32_32x32x16_bf16(PAF(1),VFR(5),o[1],0,0,0), C0,12); \
    KRD(GL,2); GAPB(o[0]=__builtin_amdgcn_mfma_f32_32x32x16_bf16(PAF(2),VFR(2),o[0],0,0,0), C1,0); \
    KRD(GL,3); GAPB(o[1]=__builtin_amdgcn_mfma_f32_32x32x16_bf16(PAF(2),VFR(6),o[1],0,0,0), C1,4); \
    GAPB(o[0]=__builtin_amdgcn_mfma_f32_32x32x16_bf16(PAF(3),VFR(3),o[0],0,0,0), C1,8); \
    GAPB(o[1]=__builtin_amdgcn_mfma_f32_32x32x16_bf16(PAF(3),VFR(7),o[1],0,0,0), C1,12); \
    }while(0)
  int t=1;
  #undef CMASK
  #define CMASK(P0,P1,t) do{}while(0)
  for(;t+5<NT;t+=2){
    STEP(pB0,pB1,pA0,pA1,t,true,true,true);     WAIT_BAR(2); RESC(); ROT();
    STEP(pA0,pA1,pB0,pB1,t+1,true,true,true);   WAIT_BAR(2); RESC(); ROT();
  }
  #undef CMASK
  #define CMASK(P0,P1,t) do{int jb_=(t)-(NT-4); if(jb_>=0)cmask(P0,P1,jb_,qrel,hi);}while(0)
  #define ENDW(tt) do{ if((tt)+3<NT){WAIT_BAR(2);} else if((tt)+2<NT){WAIT_BAR(1);} else {WAIT_BAR(0);} }while(0)
  for(;t+1<NT;t+=2){
    STEP(pB0,pB1,pA0,pA1,t,(t+3<NT),(t+1<NT),(t+1<NT));       ENDW(t);   RESC(); ROT();
    STEP(pA0,pA1,pB0,pB1,t+1,(t+4<NT),(t+2<NT),(t+2<NT));     ENDW(t+1); RESC(); ROT();
  }
  STEP(pB0,pB1,pA0,pA1,NT-1,false,false,false); RESC();
  { float sacc=pB0[0]+pB0[1]; _Pragma("unroll") for(int r=2;r<16;++r)sacc+=pB0[r]; _Pragma("unroll") for(int r=0;r<16;++r)sacc+=pB1[r]; l_reg+=sacc;
    pw0=(u32x4){PKW(pB0,0),PKW(pB0,2),PKW(pB0,4),PKW(pB0,6)};pw1=(u32x4){PKW(pB0,8),PKW(pB0,10),PKW(pB0,12),PKW(pB0,14)};pw2=(u32x4){PKW(pB1,0),PKW(pB1,2),PKW(pB1,4),PKW(pB1,6)};pw3=(u32x4){PKW(pB1,8),PKW(pB1,10),PKW(pB1,12),PKW(pB1,14)};
    SBAR(); pv(o,vb0+sl_cur,PAF(0),PAF(1),PAF(2),PAF(3)); }
  #undef PKW
  #undef PAF
  #undef VFR
  #undef PIN
  #undef MX3
  #undef GAPA
  #undef GAPB
  #undef EX
  #undef VRD
  #undef KRD
  #undef STEP
  #undef ENDW
  {auto rr=__builtin_amdgcn_permlane32_swap(__float_as_uint(l_reg),__float_as_uint(l_reg),false,false);l_reg=__uint_as_float(rr[0])+__uint_as_float(rr[1]);}
  if(hi==0)wsf[32+r32]=l_reg;asm volatile("s_waitcnt lgkmcnt(0)":::"memory");
  float rli[16];
  #pragma unroll
  for(int r=0;r<16;++r)rli[r]=__builtin_amdgcn_rcpf(wsf[32+crow(r,hi)]);
  bf16*Ow=O+(rowbase+q0+wid*QBLK)*DMO+h*D;
  { bf16*stg=(bf16*)(shm+LDS_OST)+wid*2048;
    #pragma unroll
    for(int r=0;r<16;++r){const int orow=crow(r,hi);
      #pragma unroll
      for(int d0=0;d0<2;++d0)stg[orow*64+d0*32+r32]=__float2bfloat16(o[d0][r]*rli[r]);}
    asm volatile("s_waitcnt lgkmcnt(0)":::"memory");
    #pragma unroll
    for(int i=0;i<4;++i){const int row=i*8+(lane>>3),ch=lane&7; const u32x4 v=*(const u32x4*)(stg+row*64+ch*8); ATTN_STORE16(Ow+(long)row*DMO+ch*8,v);} }
  asm volatile("s_waitcnt lgkmcnt(0)\n\ts_barrier":::"memory");
  #undef DMA_K
  #undef DMA_V
  #undef CMASK
  #undef START
  #undef RESC
  #undef ROT
  #undef CINIT
}
constexpr int ATTN_LDS_BYTES=LDS_BYTES;
struct AttnTensors { const bf16* Q; const bf16* K; const bf16* V; bf16* O; const float* LF; };
struct AttnUnit { int bh; int qb; };
struct StaticOrder {
  int vcu, G;
  __device__ __forceinline__ StaticOrder(int grid,int vcu_):vcu(vcu_),G(grid){}
  __device__ __forceinline__ bool next(int i,AttnUnit&u)const{
    if(G==256){ if(i>=2)return false; const int s=vcu&7; u.bh=vcu>>3; u.qb=(i==0)?15-s:s; return true; }
    const int idx=i*G+vcu; if(idx>=BATCH*NHEAD*NQB)return false; u.qb=NQB-1-idx/(BATCH*NHEAD); u.bh=idx%(BATCH*NHEAD); return true; }
  __device__ __forceinline__ void a_ready(const AttnUnit&)const{}
  __device__ __forceinline__ void done(const AttnUnit&)const{}
};
template<class Sched,int THRL=8> __device__ __forceinline__ void attn_phase(char*lds,const AttnTensors&T,const Sched&S){
  AttnUnit u;
  for(int i=0;S.next(i,u);++i){ S.a_ready(u); attn_unit<THRL>(u.bh/NHEAD,u.bh%NHEAD,u.qb,T.Q,T.K,T.V,T.O,T.LF+(size_t)u.bh*SEQ,lds); S.done(u); }
}
#undef SBAR
#undef WAIT_BAR
}
#define GAS __attribute__((address_space(1)))
#define LAS __attribute__((address_space(3)))
typedef unsigned short bf16;
typedef unsigned v4u __attribute__((ext_vector_type(4)));
typedef float f32x4 __attribute__((ext_vector_type(4)));
typedef short bf16x8 __attribute__((ext_vector_type(8)));
typedef GAS unsigned gu32;
typedef GAS unsigned long long gu64;
#define RLX_AGENT __ATOMIC_RELAXED, __HIP_MEMORY_SCOPE_AGENT
#define LDS_WAIT() asm volatile("s_waitcnt lgkmcnt(0)" ::: "memory")
#define VM_WAIT() asm volatile("s_waitcnt vmcnt(0)" ::: "memory")
__device__ __forceinline__ unsigned long long rt() { return __builtin_amdgcn_s_memrealtime(); }
__device__ __forceinline__ unsigned f2bf(float f) { unsigned u = __builtin_bit_cast(unsigned, f); return (u + 0x7fffu + ((u >> 16) & 1u)) >> 16; }
__device__ __forceinline__ unsigned pk2(float lo, float hi) { return f2bf(lo) | (f2bf(hi) << 16); }

#define XB_TMO      128
#define XB_XCNT(j)  (256  + 64 * (j))
#define XB_XSUB(j)  (1280 + 64 * (j))
#define XB_XGEN(j)  (2304 + 64 * (j))
#define XB_TOP      3328
#define XB_TOPGEN   3392
#define XCD_BAR_WORDS 3456
#define XB_SPIN_CAP (1u << 18)

__device__ __forceinline__ unsigned xb_ld(unsigned* p)              { return __hip_atomic_load(p, __ATOMIC_RELAXED, __HIP_MEMORY_SCOPE_AGENT); }
__device__ __forceinline__ unsigned xb_add(unsigned* p, unsigned v) { return __hip_atomic_fetch_add(p, v, __ATOMIC_RELAXED, __HIP_MEMORY_SCOPE_AGENT); }
__device__ __forceinline__ unsigned xb_xcc_id() { return (unsigned)__builtin_amdgcn_s_getreg((3 << 11) | 20) & 0xFu; }
#define XB_SPIN(cond, bar) do { unsigned _sp = 0; while (cond) { __builtin_amdgcn_s_sleep(1); \
    if ((++_sp & 255u) == 0u) { if (xb_ld(&(bar)[XB_TMO])) break; if (_sp > XB_SPIN_CAP) { atomicAdd(&(bar)[XB_TMO], 1u); break; } } } } while (0)

struct XcdBarrier {
    unsigned* bar; unsigned x;
    volatile LAS unsigned* st;
};

__device__ __forceinline__ XcdBarrier xcd_barrier_post(unsigned* bar, volatile LAS unsigned* st) {
    XcdBarrier b; b.bar = bar; b.x = xb_xcc_id(); b.st = st;
    if (threadIdx.x == 0) (void)xb_add(&bar[XB_XCNT(b.x)], 1u);
    return b;
}
__device__ __forceinline__ void xcd_barrier_complete(unsigned* bar, unsigned x, unsigned& nloc, unsigned& nx) {
    const unsigned G = gridDim.x * gridDim.y * gridDim.z;
    unsigned sum, cnt, mine, sp = 0u;
    for (;;) {
        sum = 0u; cnt = 0u; mine = 0u;
#pragma unroll
        for (unsigned j = 0; j < 16; ++j) { const unsigned c = xb_ld(&bar[XB_XCNT(j)]); sum += c; cnt += (c > 0u) ? 1u : 0u; mine = (j == x) ? c : mine; }
        if (sum == G) break;
        __builtin_amdgcn_s_sleep(1);
        if ((++sp & 255u) == 0u) { if (xb_ld(&bar[XB_TMO])) break; if (sp > XB_SPIN_CAP) { atomicAdd(&bar[XB_TMO], 1u); break; } }
    }
    nloc = mine > 0u ? mine : 1u; nx = cnt > 0u ? cnt : 1u;
}

__device__ __forceinline__ void xcd_barrier(const XcdBarrier& b) {
    asm volatile("s_waitcnt vmcnt(0)" ::: "memory");
    __syncthreads();
    if (threadIdx.x == 0) {
        unsigned* bar = b.bar;
        __builtin_amdgcn_s_waitcnt(0);
        unsigned nloc = b.st[0], nx = b.st[1];
        if (nloc == 0u) { xcd_barrier_complete(bar, b.x, nloc, nx); b.st[0] = nloc; b.st[1] = nx; }
        const unsigned old = xb_add(&bar[XB_XSUB(b.x)], 1u);
        const unsigned gen = old / nloc;
        if (old + 1u == (gen + 1u) * nloc) {
            __builtin_amdgcn_fence(__ATOMIC_RELEASE, "agent");
            asm volatile("s_waitcnt vmcnt(0)" ::: "memory");
            const unsigned og = xb_add(&bar[XB_TOP], 1u);
            const unsigned tg = og / nx;
            if (og + 1u == (tg + 1u) * nx) xb_add(&bar[XB_TOPGEN], 1u);
            else XB_SPIN(xb_ld(&bar[XB_TOPGEN]) == tg, bar);
            __builtin_amdgcn_fence(__ATOMIC_ACQUIRE, "agent");
            xb_add(&bar[XB_XGEN(b.x)], 1u);
            asm volatile("s_waitcnt vmcnt(0)" ::: "memory");
        } else {
            XB_SPIN(xb_ld(&bar[XB_XGEN(b.x)]) == gen, bar);
            __builtin_amdgcn_fence(__ATOMIC_ACQUIRE, "agent");
            asm volatile("s_waitcnt vmcnt(0)" ::: "memory");
        }
    }
    __syncthreads();
}

constexpr int NWAVES = 8;
constexpr int BATCH = 4, SEQ = 4096, D = 1024, M = BATCH * SEQ, NH = 8, HD = 64, AW = 512, PLE = 256;
constexpr int NIN = 5120, INTOT = 5128, NKEYS = 128, NEXP = 16384, NS = 2048;
constexpr float EPS = 1e-6f, LOG2E = 1.4426950408889634f, C2 = 0.125f * LOG2E;
constexpr int NPHASE = 9;
constexpr int SLW = 128, NSL = D / SLW;
static_assert(NSL == 8, "one slice per XCD group; SS3 has 16 slots");

constexpr size_t MiB = 1u << 20;
constexpr size_t WS_CTL = 0, CTL_ZERO_BYTES = 64 * 1024;
constexpr size_t WS_RSTD1 = 1 * MiB, WS_RSTD3 = WS_RSTD1 + 65536, WS_LF = WS_RSTD3 + 65536, WS_CS = WS_LF + 524288, WS_SS2 = WS_CS + 524288, WS_WPP = WS_SS2 + 1048576;
constexpr size_t WS_WQ8 = 20 * MiB, WS_SW = WS_RSTD1;
constexpr size_t WS_SU = WS_RSTD3, WS_SV = WS_WPP + 524288;
static_assert(WS_SV + 65536 <= 4 * MiB, "small region");
constexpr size_t WS_WIN = 4 * MiB, WS_WBR = 14 * MiB, WS_WOUT = 16 * MiB, WS_WS = 18 * MiB, WS_WPG = 22 * MiB, WS_PB = 24 * MiB;
constexpr size_t WS_UB = 32 * MiB, WS_VB = 48 * MiB;
constexpr size_t WS_AC = 64 * MiB;
constexpr size_t WS_A = 96 * MiB;
constexpr size_t WS_PP = 128 * MiB;
constexpr size_t WS_Q = 160 * MiB, WS_K = 176 * MiB, WS_V = 192 * MiB, WS_GB = 208 * MiB, WS_Z = 224 * MiB;
constexpr size_t WS_MERGED = 160 * MiB, WS_XB2 = 192 * MiB, WS_IDS = 224 * MiB, WS_GATES = 232 * MiB;
constexpr size_t WS_XB3 = 64 * MiB, WS_SS4 = WS_LF;
constexpr size_t WS_END = 256 * MiB;
constexpr size_t WS_PART0 = 4 * MiB, WS_PART1 = 160 * MiB, WS_PART2 = 240 * MiB;
constexpr size_t WS_TGC = 32 * MiB, WS_TXC = 64 * MiB, WS_SC = 32 * MiB;
constexpr int CW_BAR = 1024;

constexpr int RING_OFF = 0, RING_BYTES = 135168;
constexpr int LDSCTL_OFF = RING_BYTES, MISC_OFF = LDSCTL_OFF + 320;
constexpr int LDS_BYTES = RING_BYTES + 1024;
static_assert(attn_body::ATTN_LDS_BYTES <= RING_BYTES && pg8::STAGE_BYTES <= RING_BYTES && 128 * pg8::EpiTopK::RS * 4 <= RING_BYTES, "LDS map");

typedef unsigned u32x4 __attribute__((ext_vector_type(4)));
typedef unsigned u32x2 __attribute__((ext_vector_type(2)));
__device__ __forceinline__ float bf2f(bf16 v) { return __uint_as_float((unsigned)v << 16); }
__device__ __forceinline__ float wave_sum(float v) {
#pragma unroll
    for (int o = 1; o < 64; o <<= 1) v += __shfl_xor(v, o);
    return v;
}
__device__ __forceinline__ float sigmoidf_(float v) { return 1.0f / (1.0f + __expf(-v)); }
__host__ __device__ __forceinline__ int src_in(int n) {
    const int pn = n >> 8, l = n & 255;
    if (pn < 6) return n;
    if (pn < 8) return 1544 + (n - 1536);
    if (pn < 12) { const int j = pn - 8; return (l < 128) ? 2056 + 128 * j + l : 2568 + 128 * j + (l - 128); }
    if (pn < 16) return 3080 + (n - 3072);
    return 4104 + (n - 4096);
}

struct Args { const float* in[18]; float* out; unsigned char* ws; int ph_lo, ph_hi, li, pad; };
struct Ctx {
    LAS unsigned char* lds; int wave, vcu, G;
    __device__ __forceinline__ int tid_() const { return (int)threadIdx.x; }
    __device__ __forceinline__ int lane_() const { return (int)threadIdx.x & 63; }
};

struct TrItem { const float* W; const float* g; bf16* WT; int ldw, k0, scol0, ldt, drow0, dk0; };
__device__ __forceinline__ void tr_load(const TrItem& I, float (&tv)[32], int lane) {
#pragma unroll
    for (int i = 0; i < 32; ++i) { const int kk = 2 * i + (lane >> 5); tv[i] = I.W[(size_t)(I.k0 + kk) * I.ldw + I.scol0 + (lane & 31)]; }
}
__device__ __forceinline__ void tr_finish(const TrItem& I, const float (&tv)[32], LAS float* scr, int lane) {
#pragma unroll
    for (int i = 0; i < 32; ++i) { const int kk = 2 * i + (lane >> 5); float v = tv[i]; if (I.g) v *= I.g[I.k0 + kk]; scr[kk * 33 + (lane & 31)] = v; }
    LDS_WAIT(); asm volatile("" ::: "memory");
    const int c = lane & 7;
#pragma unroll
    for (int j = 0; j < 4; ++j) { const int n = (lane >> 3) + 8 * j; const LAS float* s = scr + (8 * c) * 33 + n;
        v4u o; o.x = pk2(s[0 * 33], s[1 * 33]); o.y = pk2(s[2 * 33], s[3 * 33]); o.z = pk2(s[4 * 33], s[5 * 33]); o.w = pk2(s[6 * 33], s[7 * 33]);
        *(GAS v4u*)(I.WT + (size_t)(I.drow0 + n) * I.ldt + I.dk0 + 8 * c) = o; }
    LDS_WAIT(); asm volatile("" ::: "memory");
}
constexpr int TR_IN = 16 * 160, TR_PP = 4 * 32, TR_BR = 8 * 32, TR_SQ = 16 * 32;
constexpr int TR_P0 = TR_IN + TR_PP;
constexpr int TR_LATE = 2 * TR_BR + 2 * TR_SQ;
__device__ __forceinline__ TrItem tr_decode(const Args& a, int r) {
    unsigned char* ws = a.ws;
    if (r < TR_IN) { const int kb = r / 160, nb = r % 160; return TrItem{a.in[3], a.in[2], (bf16*)(ws + WS_WIN), INTOT, 64 * kb, src_in(32 * nb), D, 32 * nb, 64 * kb}; } r -= TR_IN;
    if (r < TR_PP) { const int kb = r / 32, nb = r % 32; return TrItem{a.in[16], nullptr, (bf16*)(ws + WS_WPP), D, 64 * kb, 32 * nb, PLE, 32 * nb, 64 * kb}; } r -= TR_PP;
    if (r < 2 * TR_BR) { const int br = r / TR_BR, q = r % TR_BR, kb = q / 32, nb = q % 32; return TrItem{a.in[6] + (size_t)br * AW * D, nullptr, (bf16*)(ws + WS_WBR), D, 64 * kb, 32 * nb, D, 32 * nb, br * AW + 64 * kb}; } r -= 2 * TR_BR;
    if (r < TR_SQ) { const int kb = r / 32, nb = r % 32; return TrItem{a.in[7], nullptr, (bf16*)(ws + WS_WOUT), D, 64 * kb, 32 * nb, D, 32 * nb, 64 * kb}; } r -= TR_SQ;
    { const int kb = r / 32, nb = r % 32; return TrItem{a.in[15], a.in[14], (bf16*)(ws + WS_WPG), D, 64 * kb, 32 * nb, D, 32 * nb, 64 * kb}; }
}
__device__ __forceinline__ void tr_two(const Args& a, LAS float* scr, int ra, int rb_, bool two, int lane) {
    const TrItem A = tr_decode(a, ra), B = tr_decode(a, two ? rb_ : ra);
    float ta[32], tb[32];
    tr_load(A, ta, lane); if (two) tr_load(B, tb, lane);
    tr_finish(A, ta, scr, lane); if (two) tr_finish(B, tb, scr, lane);
}
__device__ __forceinline__ void ws_item(const Args& a, LAS unsigned char* lds, int item) {
    int tid_ = (int)threadIdx.x; asm volatile("" : "+v"(tid_));
    const float *g_ffn = a.in[8], *w_peer_q = a.in[9]; bf16* WST = (bf16*)(a.ws + WS_WS);
    LAS float* KH = (LAS float*)lds; LAS float* WQ = KH + 128 * 129;
    const int hh = item >> 4, head = hh >> 1, half = hh & 1, d0 = (item & 15) * 64;
    const float* kh = (half ? a.in[11] : a.in[10]) + (size_t)head * 128 * 128;
    float tk[32], tq[16];
#pragma unroll
    for (int i = 0; i < 32; ++i) tk[i] = kh[i * 512 + tid_];
#pragma unroll
    for (int i = 0; i < 16; ++i) { const int idx = i * 512 + tid_; tq[i] = w_peer_q[(size_t)(d0 + (idx >> 7)) * NS + head * 256 + half * 128 + (idx & 127)]; }
#pragma unroll
    for (int i = 0; i < 32; ++i) { const int idx = i * 512 + tid_; KH[(idx >> 7) * 129 + (idx & 127)] = tk[i]; }
#pragma unroll
    for (int i = 0; i < 16; ++i) WQ[i * 512 + tid_] = tq[i];
    __syncthreads();
    const int key = tid_ & 127, dg = tid_ >> 7;
    float acc[16];
#pragma unroll
    for (int i = 0; i < 16; ++i) acc[i] = 0.f;
    for (int e = 0; e < 128; e += 4) {
        const float k0 = KH[key * 129 + e], k1 = KH[key * 129 + e + 1], k2 = KH[key * 129 + e + 2], k3 = KH[key * 129 + e + 3];
#pragma unroll
        for (int i = 0; i < 16; ++i) { const f32x4 w = *(const LAS f32x4*)(WQ + (dg * 16 + i) * 128 + e); acc[i] += (k0 * w[0] + k1 * w[1]) + (k2 * w[2] + k3 * w[3]); }
    }
    const int dd = d0 + dg * 16;
#pragma unroll
    for (int q = 0; q < 2; ++q) { v4u o; o.x = pk2(acc[8 * q] * g_ffn[dd + 8 * q], acc[8 * q + 1] * g_ffn[dd + 8 * q + 1]); o.y = pk2(acc[8 * q + 2] * g_ffn[dd + 8 * q + 2], acc[8 * q + 3] * g_ffn[dd + 8 * q + 3]);
        o.z = pk2(acc[8 * q + 4] * g_ffn[dd + 8 * q + 4], acc[8 * q + 5] * g_ffn[dd + 8 * q + 5]); o.w = pk2(acc[8 * q + 6] * g_ffn[dd + 8 * q + 6], acc[8 * q + 7] * g_ffn[dd + 8 * q + 7]);
        *(GAS v4u*)(WST + (size_t)(head * 256 + half * 128 + key) * D + dd + 8 * q) = o; }
    __syncthreads();
}
__device__ __forceinline__ void quant_load4(const Args& a, int rb, int lane, f32x4 (&v)[4][4]) {
#pragma unroll
    for (int r = 0; r < 4; ++r) { const int rr = rb + r; const bool isv = rr >= NEXP; const int e = isv ? rr - NEXP : rr;
        const GAS f32x4* src = (const GAS f32x4*)((isv ? a.in[13] : a.in[12]) + (size_t)e * D) + lane;
#pragma unroll
        for (int j = 0; j < 4; ++j) v[r][j] = src[64 * j]; }
}
__device__ __forceinline__ void quant_finish4(const Args& a, int rb, int lane, f32x4 (&v)[4][4]) {
    unsigned char* ws = a.ws; const float *g_ffn = a.in[8];
    f32x4 gq[4];
#pragma unroll
    for (int j = 0; j < 4; ++j) gq[j] = *(const GAS f32x4*)(g_ffn + 256 * j + 4 * lane);
#pragma unroll
    for (int r = 0; r < 4; ++r) { const int rr = rb + r; const bool isv = rr >= NEXP; const int e = isv ? rr - NEXP : rr;
        float am = 0.f;
#pragma unroll
        for (int j = 0; j < 4; ++j) { if (!isv) v[r][j] = v[r][j] * gq[j]; am = fmaxf(am, fmaxf(fmaxf(fabsf(v[r][j].x), fabsf(v[r][j].y)), fmaxf(fabsf(v[r][j].z), fabsf(v[r][j].w)))); }
#pragma unroll
        for (int o = 1; o < 64; o <<= 1) am = fmaxf(am, __shfl_xor(am, o));
        const float sc = am > 0.f ? 127.0f / am : 0.f;
        unsigned char* tb = ws + (isv ? WS_VB : WS_UB);
#pragma unroll
        for (int j = 0; j < 4; ++j) { const int q0 = (int)rintf(v[r][j].x * sc), q1 = (int)rintf(v[r][j].y * sc), q2 = (int)rintf(v[r][j].z * sc), q3 = (int)rintf(v[r][j].w * sc);
            const unsigned o = (unsigned)(q0 & 255) | ((unsigned)(q1 & 255) << 8) | ((unsigned)(q2 & 255) << 16) | ((unsigned)(q3 & 255) << 24);
            *(GAS unsigned*)(tb + ((size_t)(2 * j + (lane >> 5)) * NEXP + e) * SLW + ((4 * lane) & 127)) = o; }
        if (lane == 0) ((float*)(ws + (isv ? WS_SV : WS_SU)))[e] = am * (1.0f / 127.0f);
    }
}
__device__ __forceinline__ void quant_rows4(const Args& a, int rb, int lane) { f32x4 v[4][4]; quant_load4(a, rb, lane, v); quant_finish4(a, rb, lane, v); }
__device__ __forceinline__ void p0_prologue(const Ctx& F, const Args& a, volatile LAS unsigned* MISC) {
    unsigned char* ws = a.ws;
    const float *x = a.in[0], *p = a.in[1], *g_mix = a.in[2], *w_in = a.in[3], *b_f = a.in[4];
    bf16 *PB = (bf16*)(ws + WS_PB), *XB = (bf16*)(ws + WS_A);
    float *RSTD1 = (float*)(ws + WS_RSTD1), *LF = (float*)(ws + WS_LF);
    const int gw = F.vcu * NWAVES + F.wave, NGW = F.G * NWAVES, NGT = F.G * 512;
    const int tid_ = (int)threadIdx.x, lane_ = tid_ & 63;
    auto stepB = [&]() __attribute__((always_inline)) {
        LAS float* scr = (LAS float*)(F.lds + RING_OFF + F.wave * 16384);
        for (int it = gw; it < TR_P0; it += 2 * NGW) tr_two(a, scr, it, it + NGW, it + NGW < TR_P0, lane_);
    };
    auto stepC = [&]() __attribute__((always_inline)) {
    {
        LAS float* WFL = (LAS float*)(F.lds + RING_OFF);
        { float tw[16], tg[16];
#pragma unroll
          for (int i = 0; i < 16; ++i) { const int idx = i * 512 + tid_, k = idx >> 3, h = idx & 7; tw[i] = w_in[(size_t)k * INTOT + 1536 + h]; tg[i] = g_mix[k]; }
#pragma unroll
          for (int i = 0; i < 16; ++i) { const int idx = i * 512 + tid_, k = idx >> 3, h = idx & 7; WFL[h * 1024 + k] = tg[i] * tw[i]; } }
        __syncthreads();
        for (int rb = gw; rb < M; rb += 4 * NGW) {
            f32x4 v[4][4];
#pragma unroll
            for (int r = 0; r < 4; ++r) { const int row = rb + r * NGW; if (row < M) { const GAS f32x4* xr = (const GAS f32x4*)(x + (size_t)row * D);
#pragma unroll
                for (int j = 0; j < 4; ++j) v[r][j] = xr[lane_ + 64 * j]; } }
#pragma unroll
            for (int r = 0; r < 4; ++r) { const int row = rb + r * NGW; if (row < M) {
                float ss = 0.f;
#pragma unroll
                for (int j = 0; j < 4; ++j) ss += (v[r][j].x * v[r][j].x + v[r][j].y * v[r][j].y) + (v[r][j].z * v[r][j].z + v[r][j].w * v[r][j].w);
                ss = wave_sum(ss);
                const float rstd = 1.0f / sqrtf(ss * (1.0f / D) + EPS);
                GAS u32x2* o = (GAS u32x2*)(XB + (size_t)row * D);
#pragma unroll
                for (int j = 0; j < 4; ++j) { u32x2 w; w.x = pk2(v[r][j].x, v[r][j].y); w.y = pk2(v[r][j].z, v[r][j].w); o[lane_ + 64 * j] = w; }
                if (lane_ == 0) RSTD1[row] = rstd;
                float f[8];
#pragma unroll
                for (int h = 0; h < 8; ++h) { float s_ = 0.f;
#pragma unroll
                    for (int j = 0; j < 4; ++j) { const f32x4 w = *(const LAS f32x4*)(WFL + h * 1024 + 4 * (lane_ + 64 * j)); s_ += (v[r][j].x * w[0] + v[r][j].y * w[1]) + (v[r][j].z * w[2] + v[r][j].w * w[3]); }
                    f[h] = s_; }
                float r4[4], r2[2], r1;
#pragma unroll
                for (int i = 0; i < 4; ++i) { const float send = (lane_ & 32) ? f[i] : f[i + 4], keep = (lane_ & 32) ? f[i + 4] : f[i]; r4[i] = keep + __shfl_xor(send, 32); }
#pragma unroll
                for (int i = 0; i < 2; ++i) { const float send = (lane_ & 16) ? r4[i] : r4[i + 2], keep = (lane_ & 16) ? r4[i + 2] : r4[i]; r2[i] = keep + __shfl_xor(send, 16); }
                { const float send = (lane_ & 8) ? r2[0] : r2[1], keep = (lane_ & 8) ? r2[1] : r2[0]; r1 = keep + __shfl_xor(send, 8); }
                r1 += __shfl_xor(r1, 4); r1 += __shfl_xor(r1, 2); r1 += __shfl_xor(r1, 1);
                const int hL = ((lane_ >> 5) & 1) * 4 + ((lane_ >> 4) & 1) * 2 + ((lane_ >> 3) & 1);
                const float tot = r1 * rstd + b_f[hL];
                const float ls = fminf(tot, 0.f) - log1pf(__expf(-fabsf(tot)));
                const int b = row / SEQ, t = row % SEQ;
                if ((lane_ & 7) == 0) LF[(size_t)(b * NH + hL) * SEQ + t] = ls * LOG2E;
            } }
        }
    }
    };
    if (F.vcu & 1) { stepC(); __syncthreads(); stepB(); }
    else           { stepB(); __syncthreads(); stepC(); }
    { constexpr int NP = M * PLE / 8;
        for (int i = F.vcu * 512 + tid_; i < NP; i += NGT) { const f32x4 a_ = ((const GAS f32x4*)p)[2 * (size_t)i], b_ = ((const GAS f32x4*)p)[2 * (size_t)i + 1];
            v4u o; o.x = pk2(a_.x, a_.y); o.y = pk2(a_.z, a_.w); o.z = pk2(b_.x, b_.y); o.w = pk2(b_.z, b_.w); ((GAS v4u*)PB)[i] = o; }
    }
}
__device__ __forceinline__ void p2_conv_chunk(int chunk, const bf16* GB, const bf16* Z, const float* cw, bf16* AC) {
    int tid_l = (int)threadIdx.x; asm volatile("" : "+v"(tid_l));
#pragma unroll
    for (int k = 0; k < 4; ++k) {
        const int i = chunk * 2048 + k * 512 + tid_l;
        const int row = i >> 6, c = (i & 63) * 8, t = row & (SEQ - 1);
        const v4u z2 = *(const GAS v4u*)(Z + (size_t)row * AW + c), g = *(const GAS v4u*)(GB + (size_t)row * AW + c);
        v4u z1 = {0u, 0u, 0u, 0u}, z0 = {0u, 0u, 0u, 0u};
        if (t >= 1) z1 = *(const GAS v4u*)(Z + (size_t)(row - 1) * AW + c);
        if (t >= 2) z0 = *(const GAS v4u*)(Z + (size_t)(row - 2) * AW + c);
        float r[8];
#pragma unroll
        for (int e = 0; e < 4; ++e) {
            const float w0a = cw[c + 2 * e], w0b = cw[c + 2 * e + 1], w1a = cw[AW + c + 2 * e], w1b = cw[AW + c + 2 * e + 1], w2a = cw[2 * AW + c + 2 * e], w2b = cw[2 * AW + c + 2 * e + 1];
            r[2 * e] = __uint_as_float(g[e] << 16) * (w0a * __uint_as_float(z0[e] << 16) + w1a * __uint_as_float(z1[e] << 16) + w2a * __uint_as_float(z2[e] << 16));
            r[2 * e + 1] = __uint_as_float(g[e] & 0xffff0000u) * (w0b * __uint_as_float(z0[e] & 0xffff0000u) + w1b * __uint_as_float(z1[e] & 0xffff0000u) + w2b * __uint_as_float(z2[e] & 0xffff0000u));
        }
        v4u o; o.x = pk2(r[0], r[1]); o.y = pk2(r[2], r[3]); o.z = pk2(r[4], r[5]); o.w = pk2(r[6], r[7]);
        *(GAS v4u*)(AC + (size_t)row * D + AW + c) = o;
    }
}
constexpr int P2_NATT = 512, P2_NCONV = M * AW / 8 / 2048, P2_NQ = 2 * NEXP / 128, P2_NWS = 256, P2_NTR = TR_LATE / 16, CW_QUEUE = 512;
constexpr int P2_NITEMS = P2_NATT + P2_NCONV + P2_NQ + P2_NWS + P2_NTR;
__device__ __forceinline__ int p2_dequeue(unsigned* ctr, volatile LAS unsigned* slot) {
    if (threadIdx.x == 0) *slot = __hip_atomic_fetch_add(ctr, 1u, __ATOMIC_RELAXED, __HIP_MEMORY_SCOPE_AGENT);
    asm volatile("s_waitcnt vmcnt(0) lgkmcnt(0)\n\ts_barrier" ::: "memory");
    const unsigned v = *slot;
    asm volatile("s_waitcnt lgkmcnt(0)\n\ts_barrier" ::: "memory");
    return (int)v;
}
template <int CTRL> __device__ __forceinline__ int dpp_i(int v) { return __builtin_amdgcn_update_dpp(0, v, CTRL, 0xf, 0xf, true); }
__device__ __forceinline__ int sum8i(int v) { v += dpp_i<0x141>(v); v += dpp_i<0xB1>(v); v += dpp_i<0x4E>(v); return v; }
__device__ __forceinline__ float max8f(float v) { v = fmaxf(v, __uint_as_float((unsigned)dpp_i<0x141>((int)__float_as_uint(v)))); v = fmaxf(v, __uint_as_float((unsigned)dpp_i<0xB1>((int)__float_as_uint(v)))); v = fmaxf(v, __uint_as_float((unsigned)dpp_i<0x4E>((int)__float_as_uint(v)))); return v; }
__device__ __forceinline__ size_t part_slab(int j) { return j < 2 ? WS_PART0 + (size_t)j * 8 * MiB : j < 6 ? WS_PART1 + (size_t)(j - 2) * 8 * MiB : WS_PART2 + (size_t)(j - 6) * 8 * MiB; }
struct P6Geo { int xg, wi, nwv, ng; };
__device__ __forceinline__ P6Geo p6_geo(const Ctx& F) { P6Geo g; const int bx = blockIdx.x, ng = F.G < 8 ? F.G : 8; g.xg = bx % ng; g.wi = (bx / ng) * NWAVES + F.wave; g.nwv = ((F.G - g.xg + ng - 1) / ng) * NWAVES; g.ng = ng; return g; }
__device__ __forceinline__ void p6a_upass(const Ctx& F, unsigned char* ws, const bf16* XB1, const unsigned short* IDS) {
    const P6Geo G = p6_geo(F); const int lane = F.lane_(), g = lane >> 3, c = lane & 7;
    for (int sl = G.xg; sl < NSL; sl += G.ng) {
        float* PART = (float*)(ws + part_slab(sl));
        const GAS unsigned char* Ts = (const GAS unsigned char*)(ws + WS_UB) + (size_t)sl * NEXP * SLW + 16 * c;
        for (int t = G.wi; t < M; t += G.nwv) {
            const v4u xa = *(const GAS v4u*)(XB1 + (size_t)t * D + sl * SLW + 16 * c), xb = *(const GAS v4u*)(XB1 + (size_t)t * D + sl * SLW + 16 * c + 8);
            v4u idp[2];
#pragma unroll
            for (int q = 0; q < 2; ++q) idp[q] = *(const GAS v4u*)(IDS + (size_t)t * 128 + 16 * g + 8 * q);
            v4u u[16];
#pragma unroll
            for (int i = 0; i < 16; ++i) { const unsigned w_ = idp[i >> 3][(i >> 1) & 3]; u[i] = *(const GAS v4u*)(Ts + ((i & 1) ? ((w_ >> 9) & 0x7fff80u) : ((w_ << 7) & 0x7fff80u))); }
            float xf[16];
#pragma unroll
            for (int e = 0; e < 4; ++e) { xf[2 * e] = __uint_as_float(xa[e] << 16); xf[2 * e + 1] = __uint_as_float(xa[e] & 0xffff0000u); xf[8 + 2 * e] = __uint_as_float(xb[e] << 16); xf[8 + 2 * e + 1] = __uint_as_float(xb[e] & 0xffff0000u); }
            float am = 0.f;
#pragma unroll
            for (int e = 0; e < 16; ++e) am = fmaxf(am, fabsf(xf[e]));
            am = max8f(am);
            const float sc = am > 0.f ? 127.0f / am : 0.f, sx = am * (1.0f / 127.0f);
            int qx[4];
#pragma unroll
            for (int j = 0; j < 4; ++j) qx[j] = (int)(((unsigned)((int)rintf(xf[4 * j] * sc) & 255)) | ((unsigned)((int)rintf(xf[4 * j + 1] * sc) & 255) << 8) | ((unsigned)((int)rintf(xf[4 * j + 2] * sc) & 255) << 16) | ((unsigned)((int)rintf(xf[4 * j + 3] * sc) & 255) << 24));
            int r0 = 0, r1 = 0;
#pragma unroll
            for (int i = 0; i < 16; ++i) { int sacc = __builtin_amdgcn_sdot4(qx[0], (int)u[i][0], 0, false); sacc = __builtin_amdgcn_sdot4(qx[1], (int)u[i][1], sacc, false); sacc = __builtin_amdgcn_sdot4(qx[2], (int)u[i][2], sacc, false); sacc = __builtin_amdgcn_sdot4(qx[3], (int)u[i][3], sacc, false);
                sacc = sum8i(sacc);
                if (i < 8) r0 = (c == i) ? sacc : r0; else r1 = (c == i - 8) ? sacc : r1; }
            float* pp = PART + (size_t)t * 128 + 16 * g + c;
            pp[0] = (float)r0 * sx; pp[8] = (float)r1 * sx;
        }
    }
}
__device__ __forceinline__ void p6b_combine(const Ctx& F, unsigned char* ws, float* SS2, const unsigned short* IDS, const float* GATES) {
    const int gw = F.vcu * NWAVES + F.wave, NGW = F.G * NWAVES, lane = F.lane_();
    const float *SU = (const float*)(ws + WS_SU), *SV = (const float*)(ws + WS_SV);
    signed char* WQ8 = (signed char*)(ws + WS_WQ8); float* SW = (float*)(ws + WS_SW);
    for (int tb = gw; tb < M; tb += 4 * NGW) {
        float ssv[4], a0[4], a1[4], g0[4], g1[4]; int i0[4], i1[4];
#pragma unroll
        for (int r = 0; r < 4; ++r) { const int t = tb + r * NGW; if (t < M) {
            ssv[r] = lane < 16 ? SS2[(size_t)t * 16 + lane] : 0.f;
            i0[r] = (int)IDS[(size_t)t * 128 + lane]; i1[r] = (int)IDS[(size_t)t * 128 + 64 + lane];
            g0[r] = GATES[(size_t)t * 128 + lane]; g1[r] = GATES[(size_t)t * 128 + 64 + lane];
            a0[r] = 0.f; a1[r] = 0.f;
#pragma unroll
            for (int j = 0; j < 8; ++j) { const float* pp = (const float*)(ws + part_slab(j)) + (size_t)t * 128; a0[r] += pp[lane]; a1[r] += pp[64 + lane]; } } }
#pragma unroll
        for (int r = 0; r < 4; ++r) { const int t = tb + r * NGW; if (t < M) {
            const float rstd = 1.0f / sqrtf(wave_sum(ssv[r]) * (1.0f / D) + EPS);
            const float x0 = a0[r] * rstd * SU[i0[r]], x1 = a1[r] * rstd * SU[i1[r]];
            const float w0 = g0[r] * 0.5f * x0 * (1.0f + erff(x0 * 0.70710678118654752f)) * SV[i0[r]], w1 = g1[r] * 0.5f * x1 * (1.0f + erff(x1 * 0.70710678118654752f)) * SV[i1[r]];
            float am = fmaxf(fabsf(w0), fabsf(w1));
#pragma unroll
            for (int o = 1; o < 64; o <<= 1) am = fmaxf(am, __shfl_xor(am, o));
            const float sc = am > 0.f ? 127.0f / am : 0.f;
            WQ8[(size_t)t * 128 + lane] = (signed char)(int)rintf(w0 * sc); WQ8[(size_t)t * 128 + 64 + lane] = (signed char)(int)rintf(w1 * sc);
            if (lane == 0) SW[t] = am * (1.0f / 127.0f);
            if (lane < 16) SS2[(size_t)t * 16 + lane] = 0.f;
        } }
    }
}
__device__ __forceinline__ int pl32_sum(int a, int b) { const auto s_ = __builtin_amdgcn_permlane32_swap((unsigned)a, (unsigned)b, false, false); return (int)(s_[0] + s_[1]); }
__device__ __forceinline__ int pl16_sum(int a, int b) { const auto s_ = __builtin_amdgcn_permlane16_swap((unsigned)a, (unsigned)b, false, false); return (int)(s_[0] + s_[1]); }
__device__ __forceinline__ float wave_sum_valu(float v) {
    { const auto s_ = __builtin_amdgcn_permlane32_swap(__float_as_uint(v), __float_as_uint(v), false, false); v = __uint_as_float(s_[0]) + __uint_as_float(s_[1]); }
    { const auto s_ = __builtin_amdgcn_permlane16_swap(__float_as_uint(v), __float_as_uint(v), false, false); v = __uint_as_float(s_[0]) + __uint_as_float(s_[1]); }
    v += __uint_as_float((unsigned)dpp_i<0x128>((int)__float_as_uint(v))); v += __uint_as_float((unsigned)dpp_i<0x124>((int)__float_as_uint(v)));
    v += __uint_as_float((unsigned)dpp_i<0x122>((int)__float_as_uint(v))); v += __uint_as_float((unsigned)dpp_i<0x121>((int)__float_as_uint(v))); return v;
}
__device__ __forceinline__ void p6c_vpass(const Ctx& F, unsigned char* ws, const unsigned short* IDS, const bf16* XB1, bf16* XB2, float* SS3) {
    const P6Geo G = p6_geo(F); const int lane = F.lane_(), g = lane >> 3, c = lane & 7;
    const int ecol = 16 * c + ((lane >> 5) & 1) * 8 + ((lane >> 4) & 1) * 4 + ((lane >> 3) & 1) * 2;
    const signed char* WQ8 = (const signed char*)(ws + WS_WQ8); const float* SW = (const float*)(ws + WS_SW);
#define V_IDS(ID, t_) do { _Pragma("unroll") for (int q = 0; q < 2; ++q) ID[q] = *(const GAS v4u*)(IDS + (size_t)(t_) * 128 + 16 * g + 8 * q); } while (0)
#define V_W(WV, t_) do { WV = *(const GAS v4u*)(WQ8 + (size_t)(t_) * 128 + 16 * g); } while (0)
#define V_GATHER(R, ID) do { _Pragma("unroll") for (int i = 0; i < 16; ++i) { const unsigned w_ = ID[i >> 3][(i >> 1) & 3]; R[i] = *(const GAS v4u*)(Ts + (size_t)((((i & 1) ? (w_ >> 9) : (w_ << 7)) & 0x7fff80u) | c16)); } } while (0)
#define V_COMPUTE(R, WV, t_) do { \
        const size_t o_ = (size_t)(t_) * D + sl * SLW + ecol; \
        const unsigned xq_ = *(const GAS unsigned*)(XB1 + o_); const float sw_ = SW[t_]; \
        int acc[16]; \
        _Pragma("unroll") for (int e = 0; e < 16; ++e) acc[e] = 0; \
        _Pragma("unroll") for (int j = 0; j < 4; ++j) \
            _Pragma("unroll") for (int b = 0; b < 4; ++b) { \
                const unsigned r0_ = R[4 * j][b], r1_ = R[4 * j + 1][b], r2_ = R[4 * j + 2][b], r3_ = R[4 * j + 3][b]; \
                const unsigned x01 = __builtin_amdgcn_perm(r1_, r0_, 0x05010400u), y01 = __builtin_amdgcn_perm(r1_, r0_, 0x07030602u), x23 = __builtin_amdgcn_perm(r3_, r2_, 0x05010400u), y23 = __builtin_amdgcn_perm(r3_, r2_, 0x07030602u); \
                acc[4 * b]     = __builtin_amdgcn_sdot4((int)__builtin_amdgcn_perm(x23, x01, 0x05040100u), (int)WV[j], acc[4 * b], false); \
                acc[4 * b + 1] = __builtin_amdgcn_sdot4((int)__builtin_amdgcn_perm(x23, x01, 0x07060302u), (int)WV[j], acc[4 * b + 1], false); \
                acc[4 * b + 2] = __builtin_amdgcn_sdot4((int)__builtin_amdgcn_perm(y23, y01, 0x05040100u), (int)WV[j], acc[4 * b + 2], false); \
                acc[4 * b + 3] = __builtin_amdgcn_sdot4((int)__builtin_amdgcn_perm(y23, y01, 0x07060302u), (int)WV[j], acc[4 * b + 3], false); } \
        int r8[8], r4[4], r2[2]; \
        _Pragma("unroll") for (int i = 0; i < 8; ++i) r8[i] = pl32_sum(acc[i], acc[i + 8]); \
        _Pragma("unroll") for (int i = 0; i < 4; ++i) r4[i] = pl16_sum(r8[i], r8[i + 4]); \
        _Pragma("unroll") for (int i = 0; i < 2; ++i) { const int send = (lane & 8) ? r4[i] : r4[i + 2], keep = (lane & 8) ? r4[i + 2] : r4[i]; r2[i] = keep + dpp_i<0x128>(send); } \
        const float x0_ = __uint_as_float(xq_ << 16) + sw_ * (float)r2[0], x1_ = __uint_as_float(xq_ & 0xffff0000u) + sw_ * (float)r2[1]; \
        *(GAS unsigned*)(XB2 + o_) = pk2(x0_, x1_); \
        const float ss = wave_sum_valu(x0_ * x0_ + x1_ * x1_); \
        if (lane == 0) SS3[(size_t)(t_) * 16 + sl] = ss; } while (0)
#define V_FENCE() asm volatile("" ::: "memory")
    for (int sl = G.xg; sl < NSL; sl += G.ng) {
        const GAS unsigned char* Ts = (const GAS unsigned char*)(ws + WS_VB) + (size_t)sl * NEXP * SLW; const unsigned c16 = 16u * (unsigned)c;
        const int nk = (M - G.wi + G.nwv - 1) / G.nwv, t0 = G.wi, dt = G.nwv;
        v4u idA[2], idB[2]; v4u wA, wB; v4u rA[16], rB[16];
        if (nk > 0) { V_IDS(idA, t0); V_GATHER(rA, idA); V_W(wA, t0); }
        if (nk > 1) V_IDS(idB, t0 + dt);
        V_FENCE();
        for (int k = 0; k < nk; k += 2) {
            if (k + 1 < nk) { V_GATHER(rB, idB); V_W(wB, t0 + (k + 1) * dt); }
            if (k + 2 < nk) V_IDS(idA, t0 + (k + 2) * dt);
            V_FENCE();
            V_COMPUTE(rA, wA, t0 + k * dt);
            V_FENCE();
            if (k + 2 < nk) { V_GATHER(rA, idA); V_W(wA, t0 + (k + 2) * dt); }
            if (k + 3 < nk) V_IDS(idB, t0 + (k + 3) * dt);
            V_FENCE();
            if (k + 1 < nk) V_COMPUTE(rB, wB, t0 + (k + 1) * dt);
            V_FENCE();
        }
    }
#undef V_IDS
#undef V_W
#undef V_GATHER
#undef V_COMPUTE
#undef V_FENCE
}
__device__ __forceinline__ void p8_final(const Ctx& F, const bf16* XB3, const float* SS4, float* OUT, const float* g) {
    const int gw = F.vcu * NWAVES + F.wave, NGW = F.G * NWAVES, lane = F.lane_();
    f32x4 gv[4];
#pragma unroll
    for (int j = 0; j < 4; ++j) gv[j] = ((const GAS f32x4*)g)[2 * lane + (j & 1) + 128 * (j >> 1)];
    for (int rb = gw; rb < M; rb += 4 * NGW) {
        v4u xa[4], xb[4]; float sv[4];
#pragma unroll
        for (int r = 0; r < 4; ++r) { const int row = rb + r * NGW; if (row < M) { xa[r] = *(const GAS v4u*)(XB3 + (size_t)row * D + 8 * lane); xb[r] = *(const GAS v4u*)(XB3 + (size_t)row * D + 512 + 8 * lane);
            sv[r] = lane < 16 ? SS4[(size_t)row * 16 + lane] : 0.f; } }
#pragma unroll
        for (int r = 0; r < 4; ++r) { const int row = rb + r * NGW; if (row < M) {
            const float rstd = 1.0f / sqrtf(wave_sum(sv[r]) * (1.0f / D) + EPS);
            GAS f32x4* o = (GAS f32x4*)(OUT + (size_t)row * D);
            o[2 * lane] = (f32x4){__uint_as_float(xa[r][0] << 16), __uint_as_float(xa[r][0] & 0xffff0000u), __uint_as_float(xa[r][1] << 16), __uint_as_float(xa[r][1] & 0xffff0000u)} * rstd * gv[0];
            o[2 * lane + 1] = (f32x4){__uint_as_float(xa[r][2] << 16), __uint_as_float(xa[r][2] & 0xffff0000u), __uint_as_float(xa[r][3] << 16), __uint_as_float(xa[r][3] & 0xffff0000u)} * rstd * gv[1];
            o[128 + 2 * lane] = (f32x4){__uint_as_float(xb[r][0] << 16), __uint_as_float(xb[r][0] & 0xffff0000u), __uint_as_float(xb[r][1] << 16), __uint_as_float(xb[r][1] & 0xffff0000u)} * rstd * gv[2];
            o[128 + 2 * lane + 1] = (f32x4){__uint_as_float(xb[r][2] << 16), __uint_as_float(xb[r][2] & 0xffff0000u), __uint_as_float(xb[r][3] << 16), __uint_as_float(xb[r][3] & 0xffff0000u)} * rstd * gv[3];
        } }
    }
}
struct OneUnit {
    pg8::Unit u;
    __device__ __forceinline__ bool next(int i, pg8::Unit& o) const { if (i != 0) return false; o = u; return true; }
    __device__ __forceinline__ void a_ready(const pg8::Unit&) const {}
    __device__ __forceinline__ void done(const pg8::Unit&) const {}
};

__global__ void __launch_bounds__(NWAVES * 64, 2) mk_fwd(Args args) {
    extern __shared__ __attribute__((aligned(16))) unsigned char lds[];
    Ctx F;
    F.lds = (LAS unsigned char*)lds;
    F.wave = __builtin_amdgcn_readfirstlane((int)threadIdx.x >> 6);
    F.G = gridDim.x; { const int bx = blockIdx.x; F.vcu = (F.G % 8 == 0) ? (bx % 8) * (F.G / 8) + bx / 8 : bx; }
    volatile LAS unsigned* MISC = (volatile LAS unsigned*)(F.lds + MISC_OFF);
    unsigned char* ws = args.ws;
    gu32* ctl = (gu32*)(ws + WS_CTL);
    for (int u = F.tid_(); u < (LDS_BYTES - LDSCTL_OFF) / 4; u += NWAVES * 64) ((LAS unsigned*)(F.lds + LDSCTL_OFF))[u] = 0u;
    __syncthreads();
    const int lo = args.ph_lo, hi = args.ph_hi;
    const bool multi = (hi - lo) > 1 || (lo <= 6 && 6 < hi);
    XcdBarrier bar; bar.bar = (unsigned*)(ctl + CW_BAR) + args.li * XCD_BAR_WORDS; bar.x = 0; bar.st = nullptr;
    if (multi) bar = xcd_barrier_post((unsigned*)(ctl + CW_BAR) + args.li * XCD_BAR_WORDS, MISC + 8);
#ifndef MK_CMASK
#define MK_CMASK 0x1ff
#endif
#define IN(k) (((MK_CMASK >> (k)) & 1) && lo <= (k) && (k) < hi)
#ifdef MK_PROBE_BAR2
#define SEAM(k) do { if (IN(k) && IN((k) + 1)) { xcd_barrier(bar); for (int rb_ = 1; rb_ < MK_PROBE_BAR2; ++rb_) xcd_barrier(bar); } STAMPI((k) < 6 ? (k) + 1 : (k) + 3); } while (0)
#else
#define SEAM(k) do { if (IN(k) && IN((k) + 1)) xcd_barrier(bar); STAMPI((k) < 6 ? (k) + 1 : (k) + 3); } while (0)
#endif
#ifdef MK_PROBE_SEG
#define STAMPI(i_) do { if (((i_) == MK_PROBE_SEG || (i_) == MK_PROBE_SEG + 1) && blockIdx.x == 0 && threadIdx.x == 0) { ((unsigned long long*)(args.ws + 32768))[(i_)] = __builtin_amdgcn_s_memrealtime(); } } while (0)
    STAMPI(0);
#else
#define STAMPI(i_) do { } while (0)
#endif
    float* out = args.out;
#define WSP(T, off) ((T*)(ws + (off)))
#define RSTD1 WSP(float, WS_RSTD1)
#define SS2 WSP(float, WS_SS2)
#define LF WSP(float, WS_LF)
#define WIN WSP(bf16, WS_WIN)
#define WBR WSP(bf16, WS_WBR)
#define WOUT WSP(bf16, WS_WOUT)
#define WST WSP(bf16, WS_WS)
#define WPG WSP(bf16, WS_WPG)
#define WPP WSP(bf16, WS_WPP)
#define PB WSP(bf16, WS_PB)
#define XB WSP(bf16, WS_A)
#define AC WSP(bf16, WS_AC)
#define XB1 WSP(bf16, WS_A)
#define PP WSP(bf16, WS_PP)
#define Q WSP(bf16, WS_Q)
#define K WSP(bf16, WS_K)
#define V WSP(bf16, WS_V)
#define GB WSP(bf16, WS_GB)
#define Z WSP(bf16, WS_Z)
#define MG WSP(bf16, WS_MERGED)
#define XB2 WSP(bf16, WS_XB2)
#define IDS WSP(unsigned short, WS_IDS)
#define GATES WSP(float, WS_GATES)
#define SGA ((bf16*)out)
#define SGC ((bf16*)out + (size_t)M * D)

    if (IN(0)) { p0_prologue(F, args, MISC); }
    SEAM(0);
    if (IN(1)) {
        { pg8::Gemm g{XB, WIN, M, NIN, D}; pg8::StaticOrder S; S.init(M, NIN, F.G, (int)blockIdx.x);
          pg8::EpiIn E{RSTD1, Q, (size_t)(WS_K - WS_Q) / 2, Z, SGA, (size_t)M * D, C2};
          static_assert(WS_V - WS_K == WS_K - WS_Q && WS_GB - WS_V == WS_K - WS_Q, "Q | K | V | GB equally spaced");
          pg8::gemm_phase<pg8::EpiIn, pg8::StaticOrder, PG8_ALIGN, PG8_SP2>(F.lds + RING_OFF, g, S, E); }
        { pg8::Gemm g{PB, WPP, M, D, PLE}; pg8::StaticOrder S; S.init(M, D, F.G, (int)blockIdx.x);
          pg8::EpiPlain E{PP, D};
          pg8::gemm_phase<pg8::EpiPlain, pg8::StaticOrder, PG8_ALIGN, PG8_SP2>(F.lds + RING_OFF, g, S, E); }
    }
    SEAM(1);
    if (IN(2)) {
        unsigned* qctr = (unsigned*)(ctl + CW_QUEUE);
        for (;;) {
            const int idx = p2_dequeue(qctr, MISC + 12);
            if (idx >= P2_NITEMS) break;
            if (idx < P2_NATT) { const int qb = 15 - (idx >> 5), bh = idx & 31;
                attn_body::attn_unit<8>(bh >> 3, bh & 7, qb, (const attn_body::bf16*)Q, (const attn_body::bf16*)K, (const attn_body::bf16*)V, (attn_body::bf16*)AC, LF + (size_t)bh * SEQ, (char*)lds + RING_OFF); }
            else if (idx < P2_NATT + P2_NCONV) p2_conv_chunk(idx - P2_NATT, GB, Z, args.in[5], AC);
            else {
                const int d_ = idx - P2_NATT - P2_NCONV, blk_ = d_ / 19, p_ = d_ % 19;
                static_assert(P2_NQ == 256 && P2_NWS == 256 && P2_NTR == 96, "interleave pattern");
                if (p_ < 16 && !(p_ & 1)) {
                    int lane_l = (int)threadIdx.x & 63; asm volatile("" : "+v"(lane_l));
                    const int r0 = (blk_ * 8 + (p_ >> 1)) * 128 + F.wave * 16;
                    for (int t4 = 0; t4 < 4; ++t4) quant_rows4(args, r0 + 4 * t4, lane_l);
                }
                else if (p_ < 16) ws_item(args, F.lds + RING_OFF, blk_ * 8 + (p_ >> 1));
                else { int lane_l = (int)threadIdx.x & 63; asm volatile("" : "+v"(lane_l));
                    const int w0 = TR_P0 + (blk_ * 3 + (p_ - 16)) * 16 + F.wave * 2;
                    tr_two(args, (LAS float*)(F.lds + RING_OFF + F.wave * 16384), w0, w0 + 1, true, lane_l); }
            }
        }
    }
    SEAM(2);
    if (IN(3)) {
        pg8::Gemm g{AC, WBR, M, D, D}; pg8::StaticOrder S; S.init(M, D, F.G, (int)blockIdx.x);
        pg8::EpiBranch E{SGA, SGC, MG};
        pg8::gemm_phase<pg8::EpiBranch, pg8::StaticOrder, PG8_ALIGN, PG8_SP2>(F.lds + RING_OFF, g, S, E);
    }
    SEAM(3);
    if (IN(4)) {
        pg8::Gemm g{MG, WOUT, M, D, D}; pg8::StaticOrder S; S.init(M, D, F.G, (int)blockIdx.x);
        pg8::EpiOut E{XB, XB1, SS2};
        pg8::gemm_phase<pg8::EpiOut, pg8::StaticOrder, PG8_ALIGN, PG8_SP2>(F.lds + RING_OFF, g, S, E);
    }
    SEAM(4);
    if (IN(5)) {
        pg8::Gemm g{XB1, WST, M, NS, D}; pg8::StaticOrder S; S.init(M, NS, F.G, (int)blockIdx.x);
        pg8::EpiTopK E{SS2, IDS, GATES, EPS};
        pg8::Unit u;
        for (int i = 0; S.next(i, u); ++i) { OneUnit O{u}; pg8::gemm_phase<pg8::EpiTopK, OneUnit, false, PG8_SP2>(F.lds + RING_OFF, g, O, E); }
    }
    SEAM(5);
    if (IN(6)) { p6a_upass(F, ws, XB1, IDS); xcd_barrier(bar); STAMPI(7); p6b_combine(F, ws, SS2, IDS, GATES); xcd_barrier(bar); STAMPI(8); p6c_vpass(F, ws, IDS, XB1, XB2, SS2); }
    SEAM(6);
    if (IN(7)) {
        pg8::Gemm g{XB2, WPG, M, D, D}; pg8::StaticOrder S; S.init(M, D, F.G, (int)blockIdx.x);
        LAS float* rtab = (LAS float*)(F.lds + RING_OFF + pg8::STAGE_BYTES);
        const bool one = (M / 256) * (D / 256) <= F.G; pg8::Unit u0;
        if (one && S.next(0, u0) && F.tid_() < 256) { const float* sp = SS2 + (size_t)(u0.pm * 256 + F.tid_()) * 16; float q = 0.f;
#pragma unroll
            for (int j = 0; j < NSL; ++j) q += sp[j];
            rtab[F.tid_()] = 1.0f / sqrtf(q * (1.0f / D) + EPS); }
        __syncthreads();
        pg8::EpiPle E{SS2, PP, XB2, WSP(bf16, WS_XB3), WSP(float, WS_SS4), EPS, one ? (const LAS float*)rtab : (const LAS float*)nullptr};
        pg8::gemm_phase<pg8::EpiPle, pg8::StaticOrder, PG8_ALIGN, PG8_SP2>(F.lds + RING_OFF, g, S, E);
    }
    SEAM(7);
    if (IN(8)) { p8_final(F, WSP(bf16, WS_XB3), WSP(float, WS_SS4), out, args.in[17]); }
    STAMPI(11);
#ifdef MK_PROBE_SEG
    if (blockIdx.x == 0 && F.tid_() == 0) {
        asm volatile("s_waitcnt vmcnt(0)" ::: "memory");
        const unsigned long long* st_ = (const unsigned long long*)(args.ws + 32768);
#if MK_PROBE_SEG >= 100
        const unsigned long long a_ = st_[32 + (MK_PROBE_SEG - 100)], b_ = (MK_PROBE_SEG - 100 == 4) ? st_[1] : st_[33 + (MK_PROBE_SEG - 100)];
#else
        const unsigned long long a_ = st_[MK_PROBE_SEG], b_ = st_[MK_PROBE_SEG + 1];
#endif
        const unsigned long long dt_ = (b_ - a_) * MK_PROBE_MULT, t0_ = __builtin_amdgcn_s_memrealtime();
        while (__builtin_amdgcn_s_memrealtime() - t0_ < dt_) __builtin_amdgcn_s_sleep(8);
    }
#endif
#undef IN
#undef SEAM
#undef WSP
#undef RSTD1
#undef SS2
#undef LF
#undef WIN
#undef WBR
#undef WOUT
#undef WST
#undef WPG
#undef WPP
#undef PB
#undef XB
#undef AC
#undef XB1
#undef PP
#undef Q
#undef K
#undef V
#undef GB
#undef Z
#undef MG
#undef XB2
#undef IDS
#undef GATES
#undef SGA
#undef SGC
}

extern "C" void kernel_launch(void* const* d_in, const int* in_sizes, int n_in, void* d_out, int out_size, void* d_ws, size_t ws_size, hipStream_t stream) {
    static int grid = 0;
    if (grid == 0) {
        if (n_in != 18 || in_sizes[0] != M * D || out_size != M * D || ws_size < WS_END) { fprintf(stderr, "kernel_launch: unexpected shapes (n_in %d, in0 %d, out %d, ws %zu); nothing launched\n", n_in, n_in > 0 ? in_sizes[0] : -1, out_size, ws_size); grid = -1; return; }
        int dev = 0, cus = 0, per_cu = 0;
        if (hipGetDevice(&dev) != hipSuccess || hipDeviceGetAttribute(&cus, hipDeviceAttributeMultiprocessorCount, dev) != hipSuccess) { fprintf(stderr, "kernel_launch: device query failed\n"); grid = -1; return; }
        if (hipFuncSetAttribute((const void*)mk_fwd, hipFuncAttributeMaxDynamicSharedMemorySize, LDS_BYTES) != hipSuccess) { fprintf(stderr, "kernel_launch: hipFuncSetAttribute failed\n"); grid = -1; return; }
        if (hipOccupancyMaxActiveBlocksPerMultiprocessor(&per_cu, (const void*)mk_fwd, NWAVES * 64, LDS_BYTES) != hipSuccess || per_cu < 1) { fprintf(stderr, "kernel_launch: occupancy query says %d workgroups per CU; nothing launched\n", per_cu); (void)hipGetLastError(); grid = -1; return; }
        grid = cus;
    }
    if (grid < 0) return;
    if (hipMemsetAsync((char*)d_ws + WS_CTL, 0, CTL_ZERO_BYTES, stream) != hipSuccess) { fprintf(stderr, "kernel_launch: hipMemsetAsync failed\n"); return; }
    Args a{};
    for (int i = 0; i < 18; ++i) a.in[i] = (const float*)d_in[i];
    a.out = (float*)d_out; a.ws = (unsigned char*)d_ws; a.ph_lo = 0; a.ph_hi = NPHASE; a.li = 0; a.pad = 0;
    hipLaunchKernelGGL(mk_fwd, dim3(grid), dim3(NWAVES * 64), LDS_BYTES, stream, a);
    const hipError_t le = hipPeekAtLastError();
    if (le != hipSuccess) fprintf(stderr, "kernel_launch: launch failed: %s\n", hipGetErrorName(le));
}
```

```cpp
#include <hip/hip_runtime.h>
#include <hip/hip_bf16.h>
#include <cstdio>
#include <cstdint>
#include <cmath>
namespace pg8 {
#define PG8_LAS __attribute__((address_space(3)))
typedef unsigned short bf16_t;
typedef short bf16x8 __attribute__((ext_vector_type(8)));
typedef float f32x4 __attribute__((ext_vector_type(4)));
typedef unsigned u32x4 __attribute__((ext_vector_type(4)));
constexpr int BM = 256, BK = 64, HALF = 128, HTB = HALF * BK * 2  , STAGE_BYTES = 8 * HTB, NXCD = 8, WGM = 8;

__host__ __device__ __forceinline__ int lds_byte(int r, int c) { const int st = (r >> 4) * 2 + (c >> 5), rr = r & 15, cc = c & 31, ob = rr * 64 + cc * 2; return st * 1024 + (ob ^ (((ob >> 9) & 1) << 5)); }
__host__ __device__ __forceinline__ void stage_rc(int b, int& R, int& C) { const int st = b / 1024, sb = b % 1024, swz = sb ^ (((sb >> 9) & 1) << 5); R = (st >> 1) * 16 + swz / 64; C = (st & 1) * 32 + (swz % 64) / 2; }
__host__ __device__ __forceinline__ int perm32(int rho) { const int n = rho >> 4, i = rho & 15; return 8 * (i >> 2) + 4 * n + (i & 3); }

struct Unit { int pm, pn; };
struct Gemm { const bf16_t* A; const bf16_t* Bt; int M, N, K; };

struct StaticOrder {
    int nM, nN, nwg, G, c;
    __host__ __device__ __forceinline__ void init(int M, int N, int G_, int c_) { nM = M / BM; nN = N / BM; nwg = nM * nN; G = G_; c = c_; }
    __host__ __device__ __forceinline__ bool next(int i, Unit& u) const {
        const long L = (long)i * G + c; if (L >= nwg) return false;
        int wgid = (int)L; { const int q = nwg / NXCD, r = nwg % NXCD, xcd = wgid % NXCD, off = wgid / NXCD; wgid = (xcd < r ? xcd * (q + 1) : r * (q + 1) + (xcd - r) * q) + off; }
        const int nig = WGM * nN, gid = wgid / nig, fm = gid * WGM, gsz = (nM - fm) < WGM ? (nM - fm) : WGM;
        u.pm = fm + ((wgid % nig) % gsz); u.pn = (wgid % nig) / gsz; return true;
    }
    __device__ __forceinline__ void a_ready(const Unit&) const {}
    __device__ __forceinline__ void done(const Unit&) const {}
};


__device__ __forceinline__ unsigned cvt_pk_bf16(float lo, float hi) { unsigned r; asm volatile("v_cvt_pk_bf16_f32 %0, %1, %2" : "=v"(r) : "v"(lo), "v"(hi)); return r; }
__device__ __forceinline__ u32x4 pack8(const f32x4 v0, const f32x4 v1) { u32x4 w; w.x = cvt_pk_bf16(v0[0], v0[1]); w.y = cvt_pk_bf16(v0[2], v0[3]); w.z = cvt_pk_bf16(v1[0], v1[1]); w.w = cvt_pk_bf16(v1[2], v1[3]); return w; }
__device__ __forceinline__ float bflo(unsigned w) { return __uint_as_float(w << 16); }
__device__ __forceinline__ float bfhi(unsigned w) { return __uint_as_float(w & 0xffff0000u); }
__device__ __forceinline__ float sigm(float v) { return __builtin_amdgcn_rcpf(1.0f + __builtin_amdgcn_exp2f(v * -1.4426950408889634f)); }
__device__ __forceinline__ f32x4 sigm4(const f32x4 v) { return (f32x4){sigm(v[0]), sigm(v[1]), sigm(v[2]), sigm(v[3])}; }

struct EpiIn {
    static constexpr int PROBE_ID = 1;
    static constexpr bool PERM = true, AFTER_DRAIN = false; static constexpr int MID_T = 0;
    const float* rstd; bf16_t* QKVG; size_t stride4; bf16_t* Z; bf16_t* SG; size_t strideSG; float c2;
    __device__ __forceinline__ void operator()(const f32x4 (&acc)[2][2][4][2], const Unit& u, int wr, int wc, int fr, int fq) const {
        int t_l = (int)threadIdx.x; asm volatile("" : "+v"(t_l)); fr = t_l & 15; fq = (t_l >> 4) & 3; wc = (t_l >> 6) & 3; wr = t_l >> 8;
        const int row0 = u.pm * BM + wr * 64 + fr; const int cl = wc * 32 + 8 * fq, pn = u.pn;
        if (pn < 8) {
            bf16_t* base = QKVG + (size_t)(pn >> 1) * stride4; const int colt = (pn & 1) * 256 + cl; const float s0 = pn < 2 ? c2 : 1.f;
#pragma unroll
            for (int ai = 0; ai < 2; ++ai)
#pragma unroll
                for (int m = 0; m < 4; ++m) { const int row = row0 + ai * HALF + m * 16; const float sc = rstd[row] * s0; bf16_t* rowp = base + (size_t)row * 512 + colt;
#pragma unroll
                    for (int bj = 0; bj < 2; ++bj) *(u32x4*)(rowp + bj * HALF) = pack8(acc[ai][bj][m][0] * sc, acc[ai][bj][m][1] * sc);
                    asm volatile("" ::: "memory"); }
        } else if (pn < 12) {
            const int colt = (pn - 8) * 128 + cl;
#pragma unroll
            for (int ai = 0; ai < 2; ++ai)
#pragma unroll
                for (int m = 0; m < 4; ++m) { const int row = row0 + ai * HALF + m * 16; const float r = rstd[row], sc = r * r;
                    *(u32x4*)(Z + (size_t)row * 512 + colt) = pack8(acc[ai][0][m][0] * acc[ai][1][m][0] * sc, acc[ai][0][m][1] * acc[ai][1][m][1] * sc);
                    asm volatile("" ::: "memory"); }
        } else {
            const int colt = (pn - 12) * 128 + cl;
#pragma unroll
            for (int ai = 0; ai < 2; ++ai)
#pragma unroll
                for (int m = 0; m < 4; ++m) { const int row = row0 + ai * HALF + m * 16; const float r = rstd[row];
                    f32x4 ra[2], sc_[2];
#pragma unroll
                    for (int n = 0; n < 2; ++n) {
#pragma unroll
                        for (int e = 0; e < 4; ++e) { const float ea = __builtin_amdgcn_exp2f(acc[ai][0][m][n][e] * r * -1.4426950408889634f), ec = __builtin_amdgcn_exp2f(acc[ai][1][m][n][e] * r * -1.4426950408889634f);
                            sc_[n][e] = __builtin_amdgcn_rcpf(1.0f + ec); ra[n][e] = (1.0f + ec) * __builtin_amdgcn_rcpf(1.0f + ea); } }
                    *(u32x4*)(SG + (size_t)row * 1024 + colt) = pack8(ra[0], ra[1]); *(u32x4*)(SG + strideSG + (size_t)row * 1024 + colt) = pack8(sc_[0], sc_[1]);
                    asm volatile("" ::: "memory"); }
        }
    }
};
struct EpiPlain {
    static constexpr int PROBE_ID = 2;
    static constexpr bool PERM = true, AFTER_DRAIN = false; static constexpr int MID_T = 0;
    bf16_t* O; int ldc;
    __device__ __forceinline__ void operator()(const f32x4 (&acc)[2][2][4][2], const Unit& u, int wr, int wc, int fr, int fq) const {
        int t_l = (int)threadIdx.x; asm volatile("" : "+v"(t_l)); fr = t_l & 15; fq = (t_l >> 4) & 3; wc = (t_l >> 6) & 3; wr = t_l >> 8;
        const int row0 = u.pm * BM + wr * 64 + fr; const int col0 = u.pn * BM + wc * 32 + 8 * fq;
#pragma unroll
        for (int ai = 0; ai < 2; ++ai)
#pragma unroll
            for (int m = 0; m < 4; ++m) { bf16_t* rowp = O + (size_t)(row0 + ai * HALF + m * 16) * ldc + col0;
#pragma unroll
                for (int bj = 0; bj < 2; ++bj) *(u32x4*)(rowp + bj * HALF) = pack8(acc[ai][bj][m][0], acc[ai][bj][m][1]); }
    }
};
struct EpiBranch {
    static constexpr int PROBE_ID = 3;
    static constexpr bool PERM = true, AFTER_DRAIN = false; static constexpr int MID_T = 8;
    const bf16_t *SGA, *SGC; bf16_t* MG;
    __device__ __forceinline__ void mid(f32x4 (&acc)[2][2][4][2], const Unit& u, int wr, int wc, int fr, int fq) const {
        int t_l = (int)threadIdx.x; asm volatile("" : "+v"(t_l)); fr = t_l & 15; fq = (t_l >> 4) & 3; wc = (t_l >> 6) & 3; wr = t_l >> 8;
        const int row0 = u.pm * BM + wr * 64 + fr; const int col0 = u.pn * BM + wc * 32 + 8 * fq;
#pragma unroll
        for (int ai = 0; ai < 2; ++ai) {
            u32x4 a[4][2];
#pragma unroll
            for (int m = 0; m < 4; ++m)
#pragma unroll
                for (int bj = 0; bj < 2; ++bj) a[m][bj] = *(const u32x4*)(SGA + (size_t)(row0 + ai * HALF + m * 16) * 1024 + col0 + bj * HALF);
#pragma unroll
            for (int m = 0; m < 4; ++m)
#pragma unroll
                for (int bj = 0; bj < 2; ++bj) { const u32x4 av = a[m][bj];
                    acc[ai][bj][m][0] *= (f32x4){bflo(av[0]), bfhi(av[0]), bflo(av[1]), bfhi(av[1])}; acc[ai][bj][m][1] *= (f32x4){bflo(av[2]), bfhi(av[2]), bflo(av[3]), bfhi(av[3])}; }
            asm volatile("" ::: "memory");
        }
    }
    __device__ __forceinline__ void operator()(const f32x4 (&acc)[2][2][4][2], const Unit& u, int wr, int wc, int fr, int fq) const {
        int t_l = (int)threadIdx.x; asm volatile("" : "+v"(t_l)); fr = t_l & 15; fq = (t_l >> 4) & 3; wc = (t_l >> 6) & 3; wr = t_l >> 8;
        const int row0 = u.pm * BM + wr * 64 + fr; const int col0 = u.pn * BM + wc * 32 + 8 * fq;
#pragma unroll
        for (int ai = 0; ai < 2; ++ai) {
            u32x4 c[4][2];
#pragma unroll
            for (int m = 0; m < 4; ++m)
#pragma unroll
                for (int bj = 0; bj < 2; ++bj) c[m][bj] = *(const u32x4*)(SGC + (size_t)(row0 + ai * HALF + m * 16) * 1024 + col0 + bj * HALF);
#pragma unroll
            for (int m = 0; m < 4; ++m)
#pragma unroll
                for (int bj = 0; bj < 2; ++bj) { const u32x4 cv = c[m][bj];
                    const f32x4 s0 = {bflo(cv[0]), bfhi(cv[0]), bflo(cv[1]), bfhi(cv[1])}, s1 = {bflo(cv[2]), bfhi(cv[2]), bflo(cv[3]), bfhi(cv[3])};
                    *(u32x4*)(MG + (size_t)(row0 + ai * HALF + m * 16) * 1024 + col0 + bj * HALF) = pack8(acc[ai][bj][m][0] * s0, acc[ai][bj][m][1] * s1); }
            asm volatile("" ::: "memory");
        }
    }
};
struct EpiOut {
    static constexpr int PROBE_ID = 4;
    static constexpr bool PERM = true, AFTER_DRAIN = false; static constexpr int MID_T = 0;
    const bf16_t* XBin; bf16_t* XB1; float* SS2;
    __device__ __forceinline__ void operator()(const f32x4 (&acc)[2][2][4][2], const Unit& u, int wr, int wc, int fr, int fq) const {
        int t_l = (int)threadIdx.x; asm volatile("" : "+v"(t_l)); fr = t_l & 15; fq = (t_l >> 4) & 3; wc = (t_l >> 6) & 3; wr = t_l >> 8;
        const int row0 = u.pm * BM + wr * 64 + fr; const int col0 = u.pn * BM + wc * 32 + 8 * fq;
#pragma unroll
        for (int ai = 0; ai < 2; ++ai) {
            u32x4 xq[4][2];
#pragma unroll
            for (int m = 0; m < 4; ++m)
#pragma unroll
                for (int bj = 0; bj < 2; ++bj) xq[m][bj] = *(const u32x4*)(XBin + (size_t)(row0 + ai * HALF + m * 16) * 1024 + col0 + bj * HALF);
#pragma unroll
            for (int m = 0; m < 4; ++m) { const int row = row0 + ai * HALF + m * 16; float ss = 0.f;
#pragma unroll
                for (int bj = 0; bj < 2; ++bj) { const u32x4 q = xq[m][bj];
                    const f32x4 v0 = acc[ai][bj][m][0] + (f32x4){bflo(q[0]), bfhi(q[0]), bflo(q[1]), bfhi(q[1])}, v1 = acc[ai][bj][m][1] + (f32x4){bflo(q[2]), bfhi(q[2]), bflo(q[3]), bfhi(q[3])};
                    *(u32x4*)(XB1 + (size_t)row * 1024 + col0 + bj * HALF) = pack8(v0, v1);
                    ss += (v0[0] * v0[0] + v0[1] * v0[1]) + (v0[2] * v0[2] + v0[3] * v0[3]) + (v1[0] * v1[0] + v1[1] * v1[1]) + (v1[2] * v1[2] + v1[3] * v1[3]); }
                ss += __shfl_xor(ss, 16); ss += __shfl_xor(ss, 32);
                if (fq == 0) SS2[(size_t)row * 16 + u.pn * 4 + wc] = ss; }
            asm volatile("" ::: "memory");
        }
    }
};
struct EpiPle {
    static constexpr int PROBE_ID = 7;
    static constexpr bool PERM = true, AFTER_DRAIN = false; static constexpr int MID_T = 0;
    const float* SS3; const bf16_t* PP; const bf16_t* XB2; bf16_t* XB3; float* SS4; float eps; const PG8_LAS float* rtab;
    __device__ __forceinline__ void operator()(const f32x4 (&acc)[2][2][4][2], const Unit& u, int wr, int wc, int fr, int fq) const {
        int t_l = (int)threadIdx.x; asm volatile("" : "+v"(t_l)); fr = t_l & 15; fq = (t_l >> 4) & 3; wc = (t_l >> 6) & 3; wr = t_l >> 8;
        const int row0 = u.pm * BM + wr * 64 + fr; const int col0 = u.pn * BM + wc * 32 + 8 * fq;
#pragma unroll
        for (int ai = 0; ai < 2; ++ai) {
            u32x4 pv[4][2], xb[4][2]; float rr[4];
#pragma unroll
            for (int m = 0; m < 4; ++m) { const int row = row0 + ai * HALF + m * 16;
#pragma unroll
                for (int bj = 0; bj < 2; ++bj) { const size_t off = (size_t)row * 1024 + col0 + bj * HALF; pv[m][bj] = *(const u32x4*)(PP + off); xb[m][bj] = *(const u32x4*)(XB2 + off); }
                if (rtab) rr[m] = rtab[wr * 64 + fr + ai * HALF + m * 16];
                else { const f32x4* sp = (const f32x4*)(SS3 + (size_t)row * 16); const f32x4 q0 = sp[0], q1 = sp[1]; rr[m] = 1.0f / sqrtf((((q0[0] + q0[1]) + (q0[2] + q0[3])) + ((q1[0] + q1[1]) + (q1[2] + q1[3]))) * (1.0f / 1024.0f) + eps); } }
#pragma unroll
            for (int m = 0; m < 4; ++m) { const int row = row0 + ai * HALF + m * 16; const float r = rr[m]; float ss = 0.f;
#pragma unroll
                for (int bj = 0; bj < 2; ++bj) { const u32x4 c = pv[m][bj], xq = xb[m][bj]; const size_t off = (size_t)row * 1024 + col0 + bj * HALF;
                    const f32x4 p0 = {bflo(c[0]), bfhi(c[0]), bflo(c[1]), bfhi(c[1])}, p1 = {bflo(c[2]), bfhi(c[2]), bflo(c[3]), bfhi(c[3])};
                    const f32x4 x0 = {bflo(xq[0]), bfhi(xq[0]), bflo(xq[1]), bfhi(xq[1])}, x1 = {bflo(xq[2]), bfhi(xq[2]), bflo(xq[3]), bfhi(xq[3])};
                    const f32x4 v0 = x0 + sigm4(acc[ai][bj][m][0] * r) * p0, v1 = x1 + sigm4(acc[ai][bj][m][1] * r) * p1;
                    *(u32x4*)(XB3 + off) = pack8(v0, v1);
                    ss += (v0[0] * v0[0] + v0[1] * v0[1]) + (v0[2] * v0[2] + v0[3] * v0[3]) + (v1[0] * v1[0] + v1[1] * v1[1]) + (v1[2] * v1[2] + v1[3] * v1[3]); }
                ss += __shfl_xor(ss, 16); ss += __shfl_xor(ss, 32);
                if (fq == 0) SS4[(size_t)row * 16 + u.pn * 4 + wc] = ss; }
            asm volatile("" ::: "memory");
        }
    }
};

__device__ __forceinline__ float vmaxf(float a, float b) { float r; asm("v_max_f32_e32 %0, %1, %2" : "=v"(r) : "v"(a), "v"(b)); return r; }
__device__ __forceinline__ float vminf(float a, float b) { float r; asm("v_min_f32_e32 %0, %1, %2" : "=v"(r) : "v"(a), "v"(b)); return r; }
__device__ __forceinline__ void sort16_desc(float (&a)[16]) {
#define TK_CE(i, j) do { const float hi_ = vmaxf(a[i], a[j]), lo_ = vminf(a[i], a[j]); a[i] = hi_; a[j] = lo_; } while (0)
    TK_CE(0, 13); TK_CE(1, 12); TK_CE(2, 15); TK_CE(3, 14); TK_CE(4, 8); TK_CE(5, 6); TK_CE(7, 11); TK_CE(9, 10);
    TK_CE(0, 5); TK_CE(1, 7); TK_CE(2, 9); TK_CE(3, 4); TK_CE(6, 13); TK_CE(8, 14); TK_CE(10, 15); TK_CE(11, 12);
    TK_CE(0, 1); TK_CE(2, 3); TK_CE(4, 5); TK_CE(6, 8); TK_CE(7, 9); TK_CE(10, 11); TK_CE(12, 13); TK_CE(14, 15);
    TK_CE(0, 2); TK_CE(1, 3); TK_CE(4, 10); TK_CE(5, 11); TK_CE(6, 7); TK_CE(8, 9); TK_CE(12, 14); TK_CE(13, 15);
    TK_CE(1, 2); TK_CE(3, 12); TK_CE(4, 6); TK_CE(5, 7); TK_CE(8, 10); TK_CE(9, 11); TK_CE(13, 14);
    TK_CE(1, 4); TK_CE(2, 6); TK_CE(5, 8); TK_CE(7, 10); TK_CE(9, 13); TK_CE(11, 14);
    TK_CE(2, 4); TK_CE(3, 6); TK_CE(9, 12); TK_CE(11, 13);
    TK_CE(3, 5); TK_CE(6, 8); TK_CE(7, 9); TK_CE(10, 12);
    TK_CE(3, 4); TK_CE(5, 6); TK_CE(7, 8); TK_CE(9, 10); TK_CE(11, 12);
    TK_CE(6, 7); TK_CE(8, 9);
#undef TK_CE
}
template <int L> __device__ __forceinline__ void merge16(float (&a)[16], const float (&b)[16]) {
#pragma unroll
    for (int i = 0; i < 16; ++i) if (15 - i < L) a[i] = vmaxf(a[i], b[15 - i]);
#pragma unroll
    for (int j = 8; j > 0; j >>= 1)
#pragma unroll
        for (int i = 0; i < 16; ++i) { const int l = i ^ j; if (l > i) { const float hi = vmaxf(a[i], a[l]), lo = vminf(a[i], a[l]); a[i] = hi; a[l] = lo; } }
}
struct EpiTopK {
    static constexpr int PROBE_ID = 5;
    static constexpr bool PERM = true, AFTER_DRAIN = true; static constexpr int MID_T = 0;
    static constexpr int RS = 260;
    const float* SS2; unsigned short* IDS; float* GATES; float eps;
    __device__ __forceinline__ void fused(f32x4 (&acc)[2][2][4][2], const Unit& u, int wr, int wc, int fr, int fq, PG8_LAS unsigned char* lds, int wid, int lane) const {
        PG8_LAS float* S = (PG8_LAS float*)lds;
        const int tid = wid * 64 + lane, row = tid & 127, grp = tid >> 7, half = grp >> 1, part = grp & 1;
#define TK_BAR() do { asm volatile("s_waitcnt lgkmcnt(0)" ::: "memory"); __builtin_amdgcn_s_barrier(); asm volatile("" ::: "memory"); } while (0)
#ifdef MK_PROBE_TOPK2
        for (int rep_ = 0; rep_ < MK_PROBE_TOPK2; ++rep_)
#endif
#pragma unroll
        for (int ai = 0; ai < 2; ++ai) {
#pragma unroll
            for (int m = 0; m < 4; ++m)
#pragma unroll
                for (int bj = 0; bj < 2; ++bj)
#pragma unroll
                    for (int n = 0; n < 2; ++n) *(PG8_LAS f32x4*)(S + (wr * 64 + m * 16 + fr) * RS + bj * HALF + wc * 32 + 8 * fq + 4 * n) = acc[ai][bj][m][n];
            TK_BAR();
            float T[16];
#ifdef MK_PROBE_TK1
            for (int rep1_ = 0; rep1_ < MK_PROBE_TK1; ++rep1_)
#endif
#pragma unroll
            for (int b = 0; b < 4; ++b) {
                float c[16];
#pragma unroll
                for (int q = 0; q < 4; ++q) { const f32x4 v = *(const PG8_LAS f32x4*)(S + row * RS + half * 128 + part * 64 + b * 16 + q * 4);
#pragma unroll
                    for (int e = 0; e < 4; ++e) c[q * 4 + e] = __uint_as_float((__float_as_uint(v[e]) & ~127u) | (unsigned)(part * 64 + b * 16 + q * 4 + e)); }
                sort16_desc(c);
                if (b == 0) {
#pragma unroll
                    for (int i = 0; i < 16; ++i) T[i] = c[i];
                } else merge16<16>(T, c);
            }
            TK_BAR();
#pragma unroll
            for (int q = 0; q < 4; ++q) *(PG8_LAS f32x4*)(S + tid * 16 + q * 4) = (f32x4){T[q * 4], T[q * 4 + 1], T[q * 4 + 2], T[q * 4 + 3]};
            TK_BAR();
            if (part == 0) {
                float c[16];
#pragma unroll
                for (int q = 0; q < 4; ++q) { const f32x4 v = *(const PG8_LAS f32x4*)(S + (tid + 128) * 16 + q * 4); c[q * 4] = v[0]; c[q * 4 + 1] = v[1]; c[q * 4 + 2] = v[2]; c[q * 4 + 3] = v[3]; }
                merge16<16>(T, c);
            }
            TK_BAR();
            if (part == 0) {
#pragma unroll
                for (int q = 0; q < 4; ++q) *(PG8_LAS f32x4*)(S + tid * 16 + q * 4) = (f32x4){T[q * 4], T[q * 4 + 1], T[q * 4 + 2], T[q * 4 + 3]};
            }
            TK_BAR();
#ifdef MK_PROBE_TK3
            for (int rep3_ = 0; rep3_ < MK_PROBE_TK3; ++rep3_)
#endif
            if (tid < 128) {
                float a1[16], a2[16];
#pragma unroll
                for (int q = 0; q < 4; ++q) { const f32x4 v = *(const PG8_LAS f32x4*)(S + (tid + 256) * 16 + q * 4);
#pragma unroll
                    for (int e = 0; e < 4; ++e) a2[q * 4 + e] = __uint_as_float(__float_as_uint(v[e]) & ~127u); }
#pragma unroll
                for (int i = 0; i < 16; ++i) a1[i] = __uint_as_float(__float_as_uint(T[i]) & ~127u);
#define TK_SUM(i, j) __uint_as_float((__float_as_uint(a1[i] + a2[j]) & ~255u) | (unsigned)((i) * 16 + (j)))
                float R[16], C[16];
#pragma unroll
                for (int j = 0; j < 16; ++j) R[j] = TK_SUM(0, j);
#pragma unroll
                for (int i = 1; i < 16; ++i) C[i - 1] = TK_SUM(i, 0);
                C[15] = 0.f;
                merge16<15>(R, C);
                C[0] = TK_SUM(1, 1); C[1] = TK_SUM(1, 2); C[2] = TK_SUM(1, 3); C[3] = TK_SUM(1, 4); C[4] = TK_SUM(1, 5); C[5] = TK_SUM(1, 6); C[6] = TK_SUM(1, 7);
                C[7] = TK_SUM(2, 1); C[8] = TK_SUM(2, 2); C[9] = TK_SUM(2, 3); C[10] = TK_SUM(2, 4); C[11] = TK_SUM(3, 1); C[12] = TK_SUM(3, 2); C[13] = TK_SUM(3, 3);
                C[14] = TK_SUM(4, 1); C[15] = TK_SUM(4, 2);
                sort16_desc(C);
                merge16<16>(R, C);
                C[0] = TK_SUM(5, 1); C[1] = TK_SUM(6, 1); C[2] = TK_SUM(7, 1);
                merge16<3>(R, C);
#undef TK_SUM
                const int rowg = u.pm * BM + ai * HALF + row;
                const f32x4* ssp = (const f32x4*)(SS2 + (size_t)rowg * 16); const f32x4 s0 = ssp[0], s1 = ssp[1], s2 = ssp[2], s3 = ssp[3];
                const float ssum = ((s0[0] + s0[1]) + (s0[2] + s0[3])) + ((s1[0] + s1[1]) + (s1[2] + s1[3])) + ((s2[0] + s2[1]) + (s2[2] + s2[3])) + ((s3[0] + s3[1]) + (s3[2] + s3[3]));
                const float rl = 1.4426950408889634f / sqrtf(ssum * (1.0f / 1024.0f) + eps);
                float ev[16], esum = 0.f; int idv[16];
#pragma unroll
                for (int r = 0; r < 16; ++r) { ev[r] = __builtin_amdgcn_exp2f((R[r] - R[0]) * rl); esum += ev[r];
                    const unsigned code = __float_as_uint(R[r]) & 255u;
                    const unsigned k1 = __float_as_uint(S[tid * 16 + (code >> 4)]) & 127u, k2 = __float_as_uint(S[(tid + 256) * 16 + (code & 15u)]) & 127u;
                    idv[r] = (int)(k1 * 128u + k2); }
                const float inv = 1.0f / esum;
                unsigned short* ip = IDS + (size_t)rowg * 128 + u.pn * 16; float* gp = GATES + (size_t)rowg * 128 + u.pn * 16;
#pragma unroll
                for (int q = 0; q < 2; ++q) { u32x4 w; w.x = (unsigned)idv[q * 8] | ((unsigned)idv[q * 8 + 1] << 16); w.y = (unsigned)idv[q * 8 + 2] | ((unsigned)idv[q * 8 + 3] << 16); w.z = (unsigned)idv[q * 8 + 4] | ((unsigned)idv[q * 8 + 5] << 16); w.w = (unsigned)idv[q * 8 + 6] | ((unsigned)idv[q * 8 + 7] << 16);
                    *(u32x4*)(ip + q * 8) = w; }
#pragma unroll
                for (int q = 0; q < 4; ++q) *(f32x4*)(gp + q * 4) = (f32x4){ev[q * 4] * inv, ev[q * 4 + 1] * inv, ev[q * 4 + 2] * inv, ev[q * 4 + 3] * inv};
            }
            TK_BAR();
        }
#undef TK_BAR
    }
};
template <class Epi, class Sched, bool ALIGN_EPI = false, bool SP2 = false>
__device__ __forceinline__ void gemm_phase(PG8_LAS unsigned char* lds, const Gemm g, const Sched& S, const Epi& E) {
    const int tid = threadIdx.x, wid = __builtin_amdgcn_readfirstlane(tid >> 6), lane = tid & 63, wr = wid >> 2, wc = wid & 3, fr = lane & 15, fq = lane >> 4;
    const int K = g.K, nt = K / BK;
    unsigned voffA[2], voffB[2];
#pragma unroll
    for (int i = 0; i < 2; ++i) { int R, C; stage_rc(tid * 16 + i * 8192, R, C); const int Rb = Epi::PERM ? ((R & ~31) + perm32(R & 31)) : R;
        voffA[i] = (unsigned)(R * K + C) * 2u; voffB[i] = (unsigned)(Rb * K + C) * 2u; }
    const size_t kstep = (size_t)(BK * 2);
    const size_t hstep = (size_t)HALF * K * 2;
    const size_t tstep = 2 * hstep;
    const unsigned ldsw = (unsigned)wid * 1024u;
    const int aoff = lds_byte(wr * 64 + fr, fq * 8), boff = lds_byte(wc * 32 + fr, fq * 8);
#define PG8_SA(b, h) (((b) * 2 + (h)) * HTB)
#define PG8_SB(b, h) ((4 + (b) * 2 + (h)) * HTB)
#define PG8_STAGE(bufoff, gbase, voff) do { _Pragma("unroll") for (int _i = 0; _i < 2; ++_i) \
        __builtin_amdgcn_global_load_lds((const unsigned*)((const char*)(gbase) + (voff)[_i]), (PG8_LAS unsigned*)(lds + (bufoff) + ldsw + _i * 8192), 16, 0, 0); } while (0)
#define PG8_LDA(dst, b, h) do { _Pragma("unroll") for (int m = 0; m < 4; ++m) _Pragma("unroll") for (int k = 0; k < 2; ++k) dst[m][k] = *(const PG8_LAS bf16x8*)(lds + PG8_SA(b, h) + aoff + m * 2048 + k * 1024); } while (0)
#define PG8_LDB(dst, b, h) do { _Pragma("unroll") for (int n = 0; n < 2; ++n) _Pragma("unroll") for (int k = 0; k < 2; ++k) dst[n][k] = *(const PG8_LAS bf16x8*)(lds + PG8_SB(b, h) + boff + n * 2048 + k * 1024); } while (0)
#define PG8_MMA(ai, bj, At, Bt) do { __builtin_amdgcn_s_setprio(1); _Pragma("unroll") for (int m = 0; m < 4; ++m) _Pragma("unroll") for (int n = 0; n < 2; ++n) _Pragma("unroll") for (int k = 0; k < 2; ++k) \
        acc[ai][bj][m][n] = __builtin_amdgcn_mfma_f32_16x16x32_bf16(Bt[n][k], At[m][k], acc[ai][bj][m][n], 0, 0, 0); __builtin_amdgcn_s_setprio(0); } while (0)
#define PG8_WAIT_V(n) asm volatile("s_waitcnt vmcnt(" #n ")" ::: "memory")
#define PG8_WAIT_L(n) asm volatile("s_waitcnt lgkmcnt(" #n ")" ::: "memory")
#define PG8_BAR __builtin_amdgcn_s_barrier()
#define PG8_SCHED __builtin_amdgcn_sched_barrier(0)
    Unit cur, nxt; int ui = 0;
    if (!S.next(0, cur)) return;
    f32x4 acc[2][2][4][2];
#pragma unroll
    for (int a = 0; a < 2; ++a)
#pragma unroll
        for (int b = 0; b < 2; ++b)
#pragma unroll
            for (int m = 0; m < 4; ++m)
#pragma unroll
                for (int n = 0; n < 2; ++n) acc[a][b][m][n] = (f32x4){0.f, 0.f, 0.f, 0.f};
    bf16x8 At[4][2], B0[2][2], B1[2][2];
    const char* cA = (const char*)g.A + (size_t)cur.pm * tstep; const char* cB = (const char*)g.Bt + (size_t)cur.pn * tstep;
    S.a_ready(cur);
    if constexpr (SP2) {
        PG8_STAGE(PG8_SB(0, 0), cB, voffB); PG8_STAGE(PG8_SB(0, 1), cB + hstep, voffB); PG8_STAGE(PG8_SA(0, 0), cA, voffA); PG8_STAGE(PG8_SA(0, 1), cA + hstep, voffA);
        if (wr == 1) PG8_BAR;
        PG8_WAIT_V(2); PG8_BAR;
        PG8_STAGE(PG8_SB(1, 0), cB + kstep, voffB); PG8_STAGE(PG8_SA(1, 0), cA + kstep, voffA); PG8_STAGE(PG8_SB(1, 1), cB + hstep + kstep, voffB);
        PG8_WAIT_V(6); PG8_BAR;
    } else {
        PG8_STAGE(PG8_SB(0, 0), cB, voffB); PG8_STAGE(PG8_SA(0, 0), cA, voffA); PG8_STAGE(PG8_SB(0, 1), cB + hstep, voffB); PG8_STAGE(PG8_SA(0, 1), cA + hstep, voffA);
        if (wr == 1) PG8_BAR;
        PG8_WAIT_V(4); PG8_BAR;
        PG8_STAGE(PG8_SB(1, 0), cB + kstep, voffB); PG8_STAGE(PG8_SA(1, 0), cA + kstep, voffA); PG8_STAGE(PG8_SB(1, 1), cB + hstep + kstep, voffB);
        PG8_WAIT_V(6); PG8_BAR;
    }
    for (;;) {
        const bool has_next = S.next(ui + 1, nxt);
        const char* nA = has_next ? (const char*)g.A + (size_t)nxt.pm * tstep : cA; const char* nB = has_next ? (const char*)g.Bt + (size_t)nxt.pn * tstep : cB;
        for (int t = 0; t < nt; t += 2) {
            if constexpr (Epi::MID_T > 0) { if (t == Epi::MID_T) E.mid(acc, cur, wr, wc, fr, fq); }
            const bool last = (t == nt - 2);
            const char* a1 = cA + (size_t)(t + 1) * kstep;
            const char* a2 = last ? nA : cA + (size_t)(t + 2) * kstep; const char* b2 = last ? nB : cB + (size_t)(t + 2) * kstep;
            const char* a3 = a2 + kstep; const char* b3 = b2 + kstep;
            if (last && has_next) S.a_ready(nxt);
            if constexpr (SP2) {
            PG8_LDB(B0, 0, 0); PG8_LDB(B1, 0, 1); PG8_SCHED; PG8_LDA(At, 0, 0); PG8_STAGE(PG8_SA(1, 1), a1 + hstep, voffA);
            PG8_WAIT_V(8); PG8_WAIT_L(0); PG8_BAR; PG8_MMA(0, 0, At, B0); PG8_MMA(0, 1, At, B1); PG8_BAR; PG8_SCHED;
            PG8_LDA(At, 0, 1); PG8_STAGE(PG8_SB(0, 0), b2, voffB); PG8_STAGE(PG8_SB(0, 1), b2 + hstep, voffB); PG8_STAGE(PG8_SA(0, 0), a2, voffA);
            PG8_WAIT_V(8); PG8_WAIT_L(0); PG8_BAR; PG8_MMA(1, 0, At, B0); PG8_MMA(1, 1, At, B1); PG8_BAR; PG8_SCHED;
            PG8_LDB(B0, 1, 0); PG8_LDB(B1, 1, 1); PG8_SCHED; PG8_LDA(At, 1, 0); PG8_STAGE(PG8_SA(0, 1), a2 + hstep, voffA);
            PG8_WAIT_V(8); PG8_WAIT_L(0); PG8_BAR; PG8_MMA(0, 0, At, B0); PG8_MMA(0, 1, At, B1); PG8_BAR; PG8_SCHED;
            PG8_LDA(At, 1, 1); PG8_STAGE(PG8_SB(1, 0), b3, voffB); PG8_STAGE(PG8_SB(1, 1), b3 + hstep, voffB); PG8_STAGE(PG8_SA(1, 0), a3, voffA);
            PG8_WAIT_V(8); PG8_WAIT_L(0); PG8_BAR; PG8_MMA(1, 0, At, B0); PG8_MMA(1, 1, At, B1); PG8_BAR; PG8_SCHED;
            } else {
            PG8_LDB(B0, 0, 0); PG8_SCHED; PG8_LDA(At, 0, 0); PG8_STAGE(PG8_SA(1, 1), a1 + hstep, voffA);
            PG8_WAIT_L(8); PG8_BAR; PG8_WAIT_L(0); PG8_MMA(0, 0, At, B0); PG8_BAR; PG8_SCHED;
            PG8_LDB(B1, 0, 1); PG8_STAGE(PG8_SB(0, 0), b2, voffB);
            PG8_BAR; PG8_WAIT_L(0); PG8_MMA(0, 1, At, B1); PG8_BAR;
            PG8_LDA(At, 0, 1); PG8_STAGE(PG8_SA(0, 0), a2, voffA);
            PG8_BAR; PG8_WAIT_L(0); PG8_MMA(1, 0, At, B0); PG8_BAR; PG8_SCHED;
            PG8_STAGE(PG8_SB(0, 1), b2 + hstep, voffB);
            PG8_WAIT_V(6); PG8_BAR; PG8_MMA(1, 1, At, B1); PG8_BAR;
            PG8_LDB(B0, 1, 0); PG8_SCHED; PG8_LDA(At, 1, 0); PG8_STAGE(PG8_SA(0, 1), a2 + hstep, voffA);
            PG8_WAIT_L(8); PG8_BAR; PG8_WAIT_L(0); PG8_MMA(0, 0, At, B0); PG8_BAR; PG8_SCHED;
            PG8_LDB(B1, 1, 1); PG8_STAGE(PG8_SB(1, 0), b3, voffB);
            PG8_BAR; PG8_WAIT_L(0); PG8_MMA(0, 1, At, B1); PG8_BAR;
            PG8_LDA(At, 1, 1); PG8_STAGE(PG8_SA(1, 0), a3, voffA);
            PG8_BAR; PG8_WAIT_L(0); PG8_MMA(1, 0, At, B0); PG8_BAR; PG8_SCHED;
            PG8_STAGE(PG8_SB(1, 1), b3 + hstep, voffB);
            PG8_WAIT_V(6); PG8_BAR; PG8_MMA(1, 1, At, B1); PG8_BAR;
            }
        }
        if constexpr (ALIGN_EPI) { if (wr == 0) PG8_BAR; }
#ifdef MK_PROBE_EPI2
        if constexpr (!Epi::AFTER_DRAIN && Epi::PROBE_ID == MK_PROBE_EPI_ID) { for (int rep_ = 1; rep_ < MK_PROBE_EPI2; ++rep_) E(acc, cur, wr, wc, fr, fq); }
#endif
        if constexpr (!Epi::AFTER_DRAIN) { E(acc, cur, wr, wc, fr, fq); S.done(cur); }
        if (!has_next) break;
#pragma unroll
        for (int a = 0; a < 2; ++a)
#pragma unroll
            for (int b = 0; b < 2; ++b)
#pragma unroll
                for (int m = 0; m < 4; ++m)
#pragma unroll
                    for (int n = 0; n < 2; ++n) acc[a][b][m][n] = (f32x4){0.f, 0.f, 0.f, 0.f};
        cur = nxt; cA = nA; cB = nB; ++ui;
        if constexpr (ALIGN_EPI) { if (wr == 1) PG8_BAR; }
    }
    PG8_WAIT_V(0);
    if constexpr (!ALIGN_EPI) { if (wr == 0) PG8_BAR; }
    PG8_BAR;
    if constexpr (Epi::AFTER_DRAIN) { E.fused(acc, cur, wr, wc, fr, fq, lds, wid, lane); S.done(cur); }
#undef PG8_SA
#undef PG8_SB
#undef PG8_STAGE
#undef PG8_LDA
#undef PG8_LDB
#undef PG8_MMA
#undef PG8_WAIT_V
#undef PG8_WAIT_L
#undef PG8_BAR
#undef PG8_SCHED
}
}
#ifndef PG8_SP2
#define PG8_SP2 true
#endif
#ifndef PG8_ALIGN
#define PG8_ALIGN true
#endif
namespace attn_body {
using bf16=__hip_bfloat16;
using bf16x8=__attribute__((ext_vector_type(8)))short;
using s16x4=__attribute__((ext_vector_type(4)))short;
using f32x16=__attribute__((ext_vector_type(16)))float;
using u32x4=__attribute__((ext_vector_type(4)))unsigned;
using f32x4v=__attribute__((ext_vector_type(4)))float;
constexpr int BATCH=4,NHEAD=8,SEQ=4096,D=64,DM=NHEAD*D,DMO=1024;
constexpr int NW=8,QBLK=32,QB=QBLK*NW,KVBLK=64,NQB=SEQ/QB;
constexpr int ATTN_PITCH=DM, ATTN_UNIT_ROWS=QB;
__device__ __forceinline__ int crow(int r,int hi){return (r&3)+8*(r>>2)+4*hi;}
#define SBAR() __builtin_amdgcn_sched_barrier(0)
__device__ __forceinline__ void cmask(f32x16&p0,f32x16&p1,int jb,int qrel,int hi){
  const float NEG=-INFINITY; int kb=64*jb+4*hi;
  #pragma unroll
  for(int r=0;r<16;++r){int kv=kb+(r&3)+8*(r>>2); if(kv>qrel)p0[r]=NEG; if(kv+32>qrel)p1[r]=NEG;}
}

constexpr int NSLOT=3, SLOTB=8192;
constexpr float SKIP_TH=64.0f;
constexpr int LDS_K=0, LDS_V=NSLOT*SLOTB, LDS_WS=2*NSLOT*SLOTB, LDS_OST=LDS_WS+NW*64*4, LDS_CS=LDS_OST+NW*4096, LDS_BYTES=LDS_CS+SEQ*4+64;
constexpr float C2=0.125f*1.4426950408889634f;
__device__ __forceinline__ void glds16(const void*gsrc,unsigned lds_dst){unsigned keep;
  asm volatile("s_mov_b32 %0, m0\n\ts_mov_b32 m0, %2\n\ts_nop 0\n\tglobal_load_lds_dwordx4 %1, off\n\ts_mov_b32 m0, %0":"=&s"(keep):"v"(gsrc),"s"(lds_dst):"memory");}
__device__ __forceinline__ float max3f(float a,float b,float c){float r;asm("v_max3_f32 %0, %1, %2, %3":"=v"(r):"v"(a),"v"(b),"v"(c));return r;}
__device__ __forceinline__ float max2f(float a,float b){float r;asm("v_max_f32_e32 %0, %1, %2":"=v"(r):"v"(a),"v"(b));return r;}
__device__ __forceinline__ float fadd_s(float a,float b){float r;asm("v_add_f32_e32 %0, %1, %2":"=v"(r):"v"(a),"v"(b));return r;}
__device__ __forceinline__ float fsub_s(float a,float b){float r;asm("v_sub_f32_e32 %0, %1, %2":"=v"(r):"v"(a),"v"(b));return r;}
typedef float f32x2_t __attribute__((ext_vector_type(2))); typedef __bf16 bf16x2_t __attribute__((ext_vector_type(2)));
__device__ __forceinline__ unsigned cvtpk_s(float lo,float hi){f32x2_t v={lo,hi};bf16x2_t b=__builtin_convertvector(v,bf16x2_t);return __builtin_bit_cast(unsigned,b);}
#define WAIT_BAR(N) asm volatile("s_waitcnt vmcnt(" #N ") lgkmcnt(0)\n\ts_barrier":::"memory")

__device__ __forceinline__ void qkt(f32x16&p0,f32x16&p1,const char*Kslot,const bf16x8*qr,const f32x16&c0,const f32x16&c1,int r32,int hi){
  const char*kb=Kslot+hi*1024+r32*16;
  #pragma unroll
  for(int d0=0;d0<4;++d0){
    const bf16x8 b0=*reinterpret_cast<const bf16x8*>(kb+d0*2048);
    const bf16x8 b1=*reinterpret_cast<const bf16x8*>(kb+d0*2048+512);
    if(d0==0){p0=__builtin_amdgcn_mfma_f32_32x32x16_bf16(b0,qr[0],c0,0,0,0);p1=__builtin_amdgcn_mfma_f32_32x32x16_bf16(b1,qr[0],c1,0,0,0);}
    else{p0=__builtin_amdgcn_mfma_f32_32x32x16_bf16(b0,qr[d0],p0,0,0,0);p1=__builtin_amdgcn_mfma_f32_32x32x16_bf16(b1,qr[d0],p1,0,0,0);}}
}
typedef __attribute__((address_space(3))) const char* lds_cptr;
typedef short v4i16_t __attribute__((ext_vector_type(4)));
__device__ __forceinline__ void kload8(bf16x8*kf,lds_cptr kp){
  kf[0]=*(const __attribute__((address_space(3))) bf16x8*)(kp);      kf[1]=*(const __attribute__((address_space(3))) bf16x8*)(kp+512);
  kf[2]=*(const __attribute__((address_space(3))) bf16x8*)(kp+2048); kf[3]=*(const __attribute__((address_space(3))) bf16x8*)(kp+2560);
  kf[4]=*(const __attribute__((address_space(3))) bf16x8*)(kp+4096); kf[5]=*(const __attribute__((address_space(3))) bf16x8*)(kp+4608);
  kf[6]=*(const __attribute__((address_space(3))) bf16x8*)(kp+6144); kf[7]=*(const __attribute__((address_space(3))) bf16x8*)(kp+6656);
}
__device__ __forceinline__ void kload2(bf16x8*kf,lds_cptr kp,int j){ kf[2*j]=*(const __attribute__((address_space(3))) bf16x8*)(kp+j*2048); kf[2*j+1]=*(const __attribute__((address_space(3))) bf16x8*)(kp+j*2048+512); }
__device__ __forceinline__ s16x4 vtr(lds_cptr p){ return __builtin_bit_cast(s16x4,__builtin_amdgcn_ds_read_tr16_b64_v4i16((__attribute__((address_space(3))) v4i16_t*)p)); }
__device__ __forceinline__ float rowmax(const f32x16&p0,const f32x16&p1){
  float a=max3f(p0[0],p0[1],p1[0]),b=max3f(p0[2],p0[3],p1[1]);a=max3f(a,p1[2],p1[3]);
  #pragma unroll
  for(int r=4;r<16;r+=4){a=max3f(a,p0[r],p0[r+1]);b=max3f(b,p0[r+2],p0[r+3]);a=max3f(a,p1[r],p1[r+1]);b=max3f(b,p1[r+2],p1[r+3]);}
  const float m=max2f(a,b);
  auto rr=__builtin_amdgcn_permlane32_swap(__float_as_uint(m),__float_as_uint(m),false,false);
  return max2f(__uint_as_float(rr[0]),__uint_as_float(rr[1]));
}
__device__ __forceinline__ void pv(f32x16*o,int vb,bf16x8 pa0,bf16x8 pa1,bf16x8 pa2,bf16x8 pa3){
  #pragma unroll
  for(int d0=0;d0<2;++d0){s16x4 lo[4],hi[4];
    #pragma unroll
    for(int ks=0;ks<4;++ks){
      asm volatile("ds_read_b64_tr_b16 %0,%1 offset:%c2":"=&v"(lo[ks]):"v"(vb),"i"(d0*4096+ks*1024):"memory");
      asm volatile("ds_read_b64_tr_b16 %0,%1 offset:%c2":"=&v"(hi[ks]):"v"(vb),"i"(d0*4096+ks*1024+512):"memory");}
    asm volatile("s_waitcnt lgkmcnt(0)":::"memory");SBAR();
    #define PK(k) (bf16x8){lo[k][0],lo[k][1],lo[k][2],lo[k][3],hi[k][0],hi[k][1],hi[k][2],hi[k][3]}
    o[d0]=__builtin_amdgcn_mfma_f32_32x32x16_bf16(pa0,PK(0),o[d0],0,0,0);
    o[d0]=__builtin_amdgcn_mfma_f32_32x32x16_bf16(pa1,PK(1),o[d0],0,0,0);
    o[d0]=__builtin_amdgcn_mfma_f32_32x32x16_bf16(pa2,PK(2),o[d0],0,0,0);
    o[d0]=__builtin_amdgcn_mfma_f32_32x32x16_bf16(pa3,PK(3),o[d0],0,0,0);
    #undef PK
  }
}

#ifndef ATTN_STORE16
#define ATTN_STORE16(p,v) (*(u32x4*)(p)=(v))
#endif
template<int THRL> __device__ __forceinline__ void attn_unit(int b,int h,int qb,const bf16*Q,const bf16*__restrict__ K,const bf16*__restrict__ V,bf16*O,const float*__restrict__ LFrow,char*shm){
  int tid_l=threadIdx.x; asm volatile("":"+v"(tid_l));
  const int tid=tid_l,lane=tid&63,r32=lane&31,hi=lane>>5; const int wid=__builtin_amdgcn_readfirstlane(tid>>6);
  const long rowbase=(long)b*SEQ; const int q0=qb*QB;
  const lds_cptr shm3=(lds_cptr)shm;
  typedef __attribute__((address_space(3))) float lds_f32; typedef __attribute__((address_space(3))) f32x4v lds_f32x4;
  lds_f32* const csl=(lds_f32*)(shm3+LDS_CS);
  { const int ncs=q0+QB, i0=tid*8; f32x4v ca={0.f,0.f,0.f,0.f},cb={0.f,0.f,0.f,0.f};
    if(i0<ncs){ca=*(const f32x4v*)(LFrow+i0);cb=*(const f32x4v*)(LFrow+i0+4);}
    ca.y+=ca.x;ca.z+=ca.y;ca.w+=ca.z;cb.x+=ca.w;cb.y+=cb.x;cb.z+=cb.y;cb.w+=cb.z;
    const float tot=cb.w; float inc=tot;
    _Pragma("unroll") for(int o_=1;o_<64;o_<<=1){const float v_=__shfl_up(inc,o_);if(lane>=o_)inc+=v_;}
    if(lane==63)csl[SEQ+wid]=inc;
    asm volatile("s_waitcnt vmcnt(0) lgkmcnt(0)\n\ts_barrier":::"memory");
    float base_=inc-tot;
    _Pragma("unroll") for(int w_=0;w_<NW;++w_){const float t_=csl[SEQ+w_];if(w_<wid)base_+=t_;}
    if(i0<ncs){*(lds_f32x4*)(csl+i0)=ca+base_;*(lds_f32x4*)(csl+i0+4)=cb+base_;}
    asm volatile("s_waitcnt vmcnt(0) lgkmcnt(0)\n\ts_barrier":::"memory"); }
  int ts; { const int NT0=(q0+QB)/KVBLK, cand=2*lane; bool ok=false;
    if(lane<32&&cand<=NT0-4) ok=(cand==0)||(csl[q0]-csl[64*cand-1]<=-SKIP_TH);
    const unsigned long long mk=__ballot(ok); ts=__builtin_amdgcn_readfirstlane(2*(63-__builtin_clzll(mk|1ull))); }
  const bf16*Qw=Q+(rowbase+q0+wid*QBLK)*DM+h*D;
  const bf16*Kh=K+(rowbase+(long)ts*KVBLK)*DM+h*D,*Vh=V+(rowbase+(long)ts*KVBLK)*DM+h*D;
  const unsigned lds0=(unsigned)(uintptr_t)shm;
  float*wsf=(float*)(shm+LDS_WS)+wid*64;
  const bf16*ksrc=Kh+(long)lane*DM+wid*8;
  const bf16*vsrc=Vh+(long)(16*(wid&3)+(lane>>2))*DM+(wid>>2)*32+(lane&3)*8;
  const unsigned kdst=lds0+LDS_K+wid*1024, vdst=lds0+LDS_V+wid*1024;
  #define DMA_K(t,slot) glds16(ksrc+(long)(t)*KVBLK*DM,(unsigned)__builtin_amdgcn_readfirstlane(kdst+(slot)))
  #define DMA_V(t,slot) glds16(vsrc+(long)(t)*KVBLK*DM,(unsigned)__builtin_amdgcn_readfirstlane(vdst+(slot)))
  const int vb0=(int)(lds0+LDS_V)+((lane>>4)&1)*32+(lane&3)*8+(4*hi+((lane&15)>>2))*64;
  const char*Kbase=shm+LDS_K; bf16x8 kf[8];
  const lds_cptr kp0=shm3+LDS_K+hi*1024+r32*16; const lds_cptr vp0=shm3+LDS_V+((lane>>4)&1)*32+(lane&3)*8+(4*hi+((lane&15)>>2))*64;
  const int NT=(q0+QB)/KVBLK-ts;
  const float cq=csl[q0+wid*QBLK+r32];
  const lds_cptr csb=shm3+LDS_CS+hi*16+ts*256;
  #define CINIT(C0,C1,t) do{ _Pragma("unroll") for(int g_=0;g_<4;++g_){ const f32x4v a_=*(const lds_f32x4*)(csb+(t)*256+g_*32), b_=*(const lds_f32x4*)(csb+(t)*256+128+g_*32); \
      C0[4*g_]=cqm-a_.x;C0[4*g_+1]=cqm-a_.y;C0[4*g_+2]=cqm-a_.z;C0[4*g_+3]=cqm-a_.w; C1[4*g_]=cqm-b_.x;C1[4*g_+1]=cqm-b_.y;C1[4*g_+2]=cqm-b_.z;C1[4*g_+3]=cqm-b_.w; } }while(0)
  DMA_K(0,0);DMA_V(0,0);DMA_K(1,SLOTB);
  bf16x8 qr[4];
  #pragma unroll
  for(int d0=0;d0<4;++d0)qr[d0]=*reinterpret_cast<const bf16x8*>(&Qw[(long)r32*DM+d0*16+hi*8]);
  float mhat=0.f,l_reg=0.f,cqm=cq;f32x16 o[2];o[0]=f32x16{};o[1]=f32x16{};
  const int qrel=wid*QBLK+r32;
  #define CMASK(P0,P1,t) do{int jb_=(t)-(NT-4); if(jb_>=0)cmask(P0,P1,jb_,qrel,hi);}while(0)
  bool resc=false;
  #define START(P0,P1) do{ const float rm=rowmax(P0,P1); resc=false; \
    { const float dl=rm; mhat=fadd_s(mhat,dl); \
      _Pragma("unroll") for(int r=0;r<16;++r){P0[r]=fsub_s(P0[r],dl);P1[r]=fsub_s(P1[r],dl);} \
      cqm=cq-mhat; } \
    _Pragma("unroll") for(int r=0;r<16;++r)P0[r]=__builtin_amdgcn_exp2f(P0[r]); }while(0)
  #define RESC() do{ if(resc){ asm volatile("s_waitcnt lgkmcnt(0)":::"memory"); \
      _Pragma("unroll") for(int d_=0;d_<2;++d_) _Pragma("unroll") for(int r=0;r<16;++r)o[d_][r]*=wsf[crow(r,hi)]; } }while(0)
  f32x16 pA0,pA1,pB0,pB1;
  int sl_prev=0,sl_cur=0,sl_next=SLOTB;
  #define ROT() do{sl_prev=sl_cur;sl_cur=sl_next;sl_next=(sl_next==(NSLOT-1)*SLOTB)?0:sl_next+SLOTB;}while(0)
  DMA_K(2,2*SLOTB);
  WAIT_BAR(3);
  { f32x16 ci0,ci1; CINIT(ci0,ci1,0); qkt(pA0,pA1,Kbase,qr,ci0,ci1,r32,hi); } asm volatile("s_nop 15\n\ts_nop 7":"+v"(pA0),"+v"(pA1));CMASK(pA0,pA1,0);
  START(pA0,pA1);
  _Pragma("unroll") for(int r=0;r<16;++r)pA1[r]=__builtin_amdgcn_exp2f(pA1[r]);
  WAIT_BAR(0);
  DMA_K(3,0);DMA_V(1,SLOTB);
  ROT();
  kload8(kf,kp0+sl_cur);
  WAIT_BAR(2);
  s16x4 vlo[8],vhi[8]; u32x4 pw0,pw1,pw2,pw3;
  #define PKW(P,B) cvtpk_s(P[B],P[B+1])
  #define PAF(k) __builtin_bit_cast(bf16x8,pw##k)
  #define VFR(i) (bf16x8){vlo[i][0],vlo[i][1],vlo[i][2],vlo[i][3],vhi[i][0],vhi[i][1],vhi[i][2],vhi[i][3]}
  #define PIN(x) asm volatile("":"+v"(x))
  #define MX3(a,b,c) __builtin_fmaxf(__builtin_fmaxf((a),(b)),(c))
  #define GAPA(MF,A0,A1,A2,A3,W0,W1,PW) do{ MF; sacc+=A0; sacc+=A1; sacc+=A2; sacc+=A3; PIN(sacc); W0; W1; PIN(PW); SBAR(); }while(0)
  #define EX(v) __builtin_amdgcn_exp2f(v)
  #define GAPB(MF,X,B) do{ MF; X[B]=EX(X[B]); X[B+1]=EX(X[B+1]); X[B+2]=EX(X[B+2]); X[B+3]=EX(X[B+3]); PIN(X); SBAR(); }while(0)
  #define VRD(i) do{ vlo[i]=vtr(vp_+(((i)>>2)*4096+((i)&3)*1024)); vhi[i]=vtr(vp_+(((i)>>2)*4096+((i)&3)*1024+512)); }while(0)
  #define KRD(G,j) do{ if(G){ kload2(kf,kp0+sl_next,j); SBAR(); } }while(0)
  #define STEP(C0,C1,P0,P1,t,GK,GV,GL) do{ SBAR(); \
    CINIT(C0,C1,t); SBAR(); \
    const lds_cptr vp_=vp0+sl_prev; \
    VRD(0); SBAR(); float sacc=(P0[0]+P0[1]); \
    GAPA(C0=__builtin_amdgcn_mfma_f32_32x32x16_bf16(kf[0],qr[0],C0,0,0,0), P0[2],P0[3],P0[4],P0[5],     pw0[0]=PKW(P0,0), pw0[1]=PKW(P0,2), pw0); \
    VRD(4); SBAR(); GAPA(C1=__builtin_amdgcn_mfma_f32_32x32x16_bf16(kf[1],qr[0],C1,0,0,0), P0[6],P0[7],P0[8],P0[9],     pw0[2]=PKW(P0,4), pw0[3]=PKW(P0,6), pw0); \
    VRD(1); SBAR(); GAPA(C0=__builtin_amdgcn_mfma_f32_32x32x16_bf16(kf[2],qr[1],C0,0,0,0),   P0[10],P0[11],P0[12],P0[13], pw1[0]=PKW(P0,8), pw1[1]=PKW(P0,10), pw1); \
    VRD(5); SBAR(); GAPA(C1=__builtin_amdgcn_mfma_f32_32x32x16_bf16(kf[3],qr[1],C1,0,0,0),   P0[14],P0[15],P1[0],P1[1],   pw1[2]=PKW(P0,12),pw1[3]=PKW(P0,14), pw1); \
    VRD(2); SBAR(); GAPA(C0=__builtin_amdgcn_mfma_f32_32x32x16_bf16(kf[4],qr[2],C0,0,0,0),   P1[2],P1[3],P1[4],P1[5],     pw2[0]=PKW(P1,0), pw2[1]=PKW(P1,2), pw2); \
    VRD(6); SBAR(); GAPA(C1=__builtin_amdgcn_mfma_f32_32x32x16_bf16(kf[5],qr[2],C1,0,0,0),   P1[6],P1[7],P1[8],P1[9],     pw2[2]=PKW(P1,4), pw2[3]=PKW(P1,6), pw2); \
    VRD(3); SBAR(); GAPA(C0=__builtin_amdgcn_mfma_f32_32x32x16_bf16(kf[6],qr[3],C0,0,0,0),   P1[10],P1[11],P1[12],P1[13], pw3[0]=PKW(P1,8), pw3[1]=PKW(P1,10), pw3); \
    VRD(7); SBAR(); GAPA(C1=__builtin_amdgcn_mfma_f32_32x32x16_bf16(kf[7],qr[3],C1,0,0,0),   P1[14],P1[15],0.f,0.f,       pw3[2]=PKW(P1,12),pw3[3]=PKW(P1,14), pw3); \
    l_reg+=sacc; \
    if(GK){DMA_K((t)+3,sl_cur);} if(GV){DMA_V((t)+1,sl_next);} \
    CMASK(C0,C1,t); \
    { float a=MX3(C0[0],C0[1],C1[0]),b=MX3(C0[2],C0[3],C1[1]); a=MX3(a,C1[2],C1[3]); \
      _Pragma("unroll") for(int r=4;r<16;r+=4){a=MX3(a,C0[r],C0[r+1]);b=MX3(b,C0[r+2],C0[r+3]);a=MX3(a,C1[r],C1[r+1]);b=MX3(b,C1[r+2],C1[r+3]);} \
      float rm=__builtin_fmaxf(a,b); { auto rr=__builtin_amdgcn_permlane32_swap(__float_as_uint(rm),__float_as_uint(rm),false,false); rm=__builtin_fmaxf(__uint_as_float(rr[0]),__uint_as_float(rr[1])); } \
      resc=false; \
      if(__builtin_expect(__any(rm>(float)THRL),0)){ const float dl=__builtin_fmaxf(rm,0.f); mhat+=dl; \
        _Pragma("unroll") for(int r=0;r<16;++r){C0[r]-=dl;C1[r]-=dl;} \
        cqm=cq-mhat; \
        const float f=__builtin_amdgcn_exp2f(-dl); l_reg*=f; if(hi==0)wsf[r32]=f; resc=true; } } \
    SBAR(); \
    GAPB(o[0]=__builtin_amdgcn_mfma_f32_32x32x16_bf16(PAF(0),VFR(0),o[0],0,0,0), C0,0); \
    GAPB(o[1]=__builtin_amdgcn_mfma_f32_32x32x16_bf16(PAF(0),VFR(4),o[1],0,0,0), C0,4); \
    KRD(GL,0); GAPB(o[0]=__builtin_amdgcn_mfma_f32_32x32x16_bf16(PAF(1),VFR(1),o[0],0,0,0), C0,8); \
    KRD(GL,1); GAPB(o[1]=__builtin_amdgcn_mfma_f32_32x32x16_bf16(PAF(1),VFR(5),o[1],0,0,0), C0,12); \
    KRD(GL,2); GAPB(o[0]=__builtin_amdgcn_mfma_f32_32x32x16_bf16(PAF(2),VFR(2),o[0],0,0,0), C1,0); \
    KRD(GL,3); GAPB(o[1]=__builtin_amdgcn_mfma_f32_32x32x16_bf16(PAF(2),VFR(6),o[1],0,0,0), C1,4); \
    GAPB(o[0]=__builtin_amdgcn_mfma_f32_32x32x16_bf16(PAF(3),VFR(3),o[0],0,0,0), C1,8); \
    GAPB(o[1]=__builtin_amdgcn_mfma_f32_32x32x16_bf16(PAF(3),VFR(7),o[1],0,0,0), C1,12); \
    }while(0)
  int t=1;
  #undef CMASK
  #define CMASK(P0,P1,t) do{}while(0)
  for(;t+5<NT;t+=2){
    STEP(pB0,pB1,pA0,pA1,t,true,true,true);     WAIT_BAR(2); RESC(); ROT();
    STEP(pA0,pA1,pB0,pB1,t+1,true,true,true);   WAIT_BAR(2); RESC(); ROT();
  }
  #undef CMASK
  #define CMASK(P0,P1,t) do{int jb_=(t)-(NT-4); if(jb_>=0)cmask(P0,P1,jb_,qrel,hi);}while(0)
  #define ENDW(tt) do{ if((tt)+3<NT){WAIT_BAR(2);} else if((tt)+2<NT){WAIT_BAR(1);} else {WAIT_BAR(0);} }while(0)
  for(;t+1<NT;t+=2){
    STEP(pB0,pB1,pA0,pA1,t,(t+3<NT),(t+1<NT),(t+1<NT));       ENDW(t);   RESC(); ROT();
    STEP(pA0,pA1,pB0,pB1,t+1,(t+4<NT),(t+2<NT),(t+2<NT));     ENDW(t+1); RESC(); ROT();
  }
  STEP(pB0,pB1,pA0,pA1,NT-1,false,false,false); RESC();
  { float sacc=pB0[0]+pB0[1]; _Pragma("unroll") for(int r=2;r<16;++r)sacc+=pB0[r]; _Pragma("unroll") for(int r=0;r<16;++r)sacc+=pB1[r]; l_reg+=sacc;
    pw0=(u32x4){PKW(pB0,0),PKW(pB0,2),PKW(pB0,4),PKW(pB0,6)};pw1=(u32x4){PKW(pB0,8),PKW(pB0,10),PKW(pB0,12),PKW(pB0,14)};pw2=(u32x4){PKW(pB1,0),PKW(pB1,2),PKW(pB1,4),PKW(pB1,6)};pw3=(u32x4){PKW(pB1,8),PKW(pB1,10),PKW(pB1,12),PKW(pB1,14)};
    SBAR(); pv(o,vb0+sl_cur,PAF(0),PAF(1),PAF(2),PAF(3)); }
  #undef PKW
  #undef PAF
  #undef VFR
  #undef PIN
  #undef MX3
  #undef GAPA
  #undef GAPB
  #undef EX
  #undef VRD
  #undef KRD
  #undef STEP
  #undef ENDW
  {auto rr=__builtin_amdgcn_permlane32_swap(__float_as_uint(l_reg),__float_as_uint(l_reg),false,false);l_reg=__uint_as_float(rr[0])+__uint_as_float(rr[1]);}
  if(hi==0)wsf[32+r32]=l_reg;asm volatile("s_waitcnt lgkmcnt(0)":::"memory");
  float rli[16];
  #pragma unroll
  for(int r=0;r<16;++r)rli[r]=__builtin_amdgcn_rcpf(wsf[32+crow(r,hi)]);
  bf16*Ow=O+(rowbase+q0+wid*QBLK)*DMO+h*D;
  { bf16*stg=(bf16*)(shm+LDS_OST)+wid*2048;
    #pragma unroll
    for(int r=0;r<16;++r){const int orow=crow(r,hi);
      #pragma unroll
      for(int d0=0;d0<2;++d0)stg[orow*64+d0*32+r32]=__float2bfloat16(o[d0][r]*rli[r]);}
    asm volatile("s_waitcnt lgkmcnt(0)":::"memory");
    #pragma unroll
    for(int i=0;i<4;++i){const int row=i*8+(lane>>3),ch=lane&7; const u32x4 v=*(const u32x4*)(stg+row*64+ch*8); ATTN_STORE16(Ow+(long)row*DMO+ch*8,v);} }
  asm volatile("s_waitcnt lgkmcnt(0)\n\ts_barrier":::"memory");
  #undef DMA_K
  #undef DMA_V
  #undef CMASK
  #undef START
  #undef RESC
  #undef ROT
  #undef CINIT
}
constexpr int ATTN_LDS_BYTES=LDS_BYTES;
struct AttnTensors { const bf16* Q; const bf16* K; const bf16* V; bf16* O; const float* LF; };
struct AttnUnit { int bh; int qb; };
struct StaticOrder {
  int vcu, G;
  __device__ __forceinline__ StaticOrder(int grid,int vcu_):vcu(vcu_),G(grid){}
  __device__ __forceinline__ bool next(int i,AttnUnit&u)const{
    if(G==256){ if(i>=2)return false; const int s=vcu&7; u.bh=vcu>>3; u.qb=(i==0)?15-s:s; return true; }
    const int idx=i*G+vcu; if(idx>=BATCH*NHEAD*NQB)return false; u.qb=NQB-1-idx/(BATCH*NHEAD); u.bh=idx%(BATCH*NHEAD); return true; }
  __device__ __forceinline__ void a_ready(const AttnUnit&)const{}
  __device__ __forceinline__ void done(const AttnUnit&)const{}
};
template<class Sched,int THRL=8> __device__ __forceinline__ void attn_phase(char*lds,const AttnTensors&T,const Sched&S){
  AttnUnit u;
  for(int i=0;S.next(i,u);++i){ S.a_ready(u); attn_unit<THRL>(u.bh/NHEAD,u.bh%NHEAD,u.qb,T.Q,T.K,T.V,T.O,T.LF+(size_t)u.bh*SEQ,lds); S.done(u); }
}
#undef SBAR
#undef WAIT_BAR
}
#define GAS __attribute__((address_space(1)))
#define LAS __attribute__((address_space(3)))
typedef unsigned short bf16;
typedef unsigned v4u __attribute__((ext_vector_type(4)));
typedef float f32x4 __attribute__((ext_vector_type(4)));
typedef short bf16x8 __attribute__((ext_vector_type(8)));
typedef GAS unsigned gu32;
typedef GAS unsigned long long gu64;
#define RLX_AGENT __ATOMIC_RELAXED, __HIP_MEMORY_SCOPE_AGENT
#define LDS_WAIT() asm volatile("s_waitcnt lgkmcnt(0)" ::: "memory")
#define VM_WAIT() asm volatile("s_waitcnt vmcnt(0)" ::: "memory")
__device__ __forceinline__ unsigned long long rt() { return __builtin_amdgcn_s_memrealtime(); }
__device__ __forceinline__ unsigned f2bf(float f) { unsigned u = __builtin_bit_cast(unsigned, f); return (u + 0x7fffu + ((u >> 16) & 1u)) >> 16; }
__device__ __forceinline__ unsigned pk2(float lo, float hi) { return f2bf(lo) | (f2bf(hi) << 16); }

#define XB_TMO      128
#define XB_XCNT(j)  (256  + 64 * (j))
#define XB_XSUB(j)  (1280 + 64 * (j))
#define XB_XGEN(j)  (2304 + 64 * (j))
#define XB_TOP      3328
#define XB_TOPGEN   3392
#define XCD_BAR_WORDS 3456
#define XB_SPIN_CAP (1u << 18)

__device__ __forceinline__ unsigned xb_ld(unsigned* p)              { return __hip_atomic_load(p, __ATOMIC_RELAXED, __HIP_MEMORY_SCOPE_AGENT); }
__device__ __forceinline__ unsigned xb_add(unsigned* p, unsigned v) { return __hip_atomic_fetch_add(p, v, __ATOMIC_RELAXED, __HIP_MEMORY_SCOPE_AGENT); }
__device__ __forceinline__ unsigned xb_xcc_id() { return (unsigned)__builtin_amdgcn_s_getreg((3 << 11) | 20) & 0xFu; }
#define XB_SPIN(cond, bar) do { unsigned _sp = 0; while (cond) { __builtin_amdgcn_s_sleep(1); \
    if ((++_sp & 255u) == 0u) { if (xb_ld(&(bar)[XB_TMO])) break; if (_sp > XB_SPIN_CAP) { atomicAdd(&(bar)[XB_TMO], 1u); break; } } } } while (0)

struct XcdBarrier {
    unsigned* bar; unsigned x;
    volatile LAS unsigned* st;
};

__device__ __forceinline__ XcdBarrier xcd_barrier_post(unsigned* bar, volatile LAS unsigned* st) {
    XcdBarrier b; b.bar = bar; b.x = xb_xcc_id(); b.st = st;
    if (threadIdx.x == 0) (void)xb_add(&bar[XB_XCNT(b.x)], 1u);
    return b;
}
__device__ __forceinline__ void xcd_barrier_complete(unsigned* bar, unsigned x, unsigned& nloc, unsigned& nx) {
    const unsigned G = gridDim.x * gridDim.y * gridDim.z;
    unsigned sum, cnt, mine, sp = 0u;
    for (;;) {
        sum = 0u; cnt = 0u; mine = 0u;
#pragma unroll
        for (unsigned j = 0; j < 16; ++j) { const unsigned c = xb_ld(&bar[XB_XCNT(j)]); sum += c; cnt += (c > 0u) ? 1u : 0u; mine = (j == x) ? c : mine; }
        if (sum == G) break;
        __builtin_amdgcn_s_sleep(1);
        if ((++sp & 255u) == 0u) { if (xb_ld(&bar[XB_TMO])) break; if (sp > XB_SPIN_CAP) { atomicAdd(&bar[XB_TMO], 1u); break; } }
    }
    nloc = mine > 0u ? mine : 1u; nx = cnt > 0u ? cnt : 1u;
}

__device__ __forceinline__ void xcd_barrier(const XcdBarrier& b) {
    asm volatile("s_waitcnt vmcnt(0)" ::: "memory");
    __syncthreads();
    if (threadIdx.x == 0) {
        unsigned* bar = b.bar;
        __builtin_amdgcn_s_waitcnt(0);
        unsigned nloc = b.st[0], nx = b.st[1];
        if (nloc == 0u) { xcd_barrier_complete(bar, b.x, nloc, nx); b.st[0] = nloc; b.st[1] = nx; }
        const unsigned old = xb_add(&bar[XB_XSUB(b.x)], 1u);
        const unsigned gen = old / nloc;
        if (old + 1u == (gen + 1u) * nloc) {
            __builtin_amdgcn_fence(__ATOMIC_RELEASE, "agent");
            asm volatile("s_waitcnt vmcnt(0)" ::: "memory");
            const unsigned og = xb_add(&bar[XB_TOP], 1u);
            const unsigned tg = og / nx;
            if (og + 1u == (tg + 1u) * nx) xb_add(&bar[XB_TOPGEN], 1u);
            else XB_SPIN(xb_ld(&bar[XB_TOPGEN]) == tg, bar);
            __builtin_amdgcn_fence(__ATOMIC_ACQUIRE, "agent");
            xb_add(&bar[XB_XGEN(b.x)], 1u);
            asm volatile("s_waitcnt vmcnt(0)" ::: "memory");
        } else {
            XB_SPIN(xb_ld(&bar[XB_XGEN(b.x)]) == gen, bar);
            __builtin_amdgcn_fence(__ATOMIC_ACQUIRE, "agent");
            asm volatile("s_waitcnt vmcnt(0)" ::: "memory");
        }
    }
    __syncthreads();
}

constexpr int NWAVES = 8;
constexpr int BATCH = 4, SEQ = 4096, D = 1024, M = BATCH * SEQ, NH = 8, HD = 64, AW = 512, PLE = 256;
constexpr int NIN = 5120, INTOT = 5128, NKEYS = 128, NEXP = 16384, NS = 2048;
constexpr float EPS = 1e-6f, LOG2E = 1.4426950408889634f, C2 = 0.125f * LOG2E;
constexpr int NPHASE = 9;
constexpr int SLW = 128, NSL = D / SLW;
static_assert(NSL == 8, "one slice per XCD group; SS3 has 16 slots");

constexpr size_t MiB = 1u << 20;
constexpr size_t WS_CTL = 0, CTL_ZERO_BYTES = 64 * 1024;
constexpr size_t WS_RSTD1 = 1 * MiB, WS_RSTD3 = WS_RSTD1 + 65536, WS_LF = WS_RSTD3 + 65536, WS_CS = WS_LF + 524288, WS_SS2 = WS_CS + 524288, WS_WPP = WS_SS2 + 1048576;
constexpr size_t WS_WQ8 = 20 * MiB, WS_SW = WS_RSTD1;
constexpr size_t WS_SU = WS_RSTD3, WS_SV = WS_WPP + 524288;
static_assert(WS_SV + 65536 <= 4 * MiB, "small region");
constexpr size_t WS_WIN = 4 * MiB, WS_WBR = 14 * MiB, WS_WOUT = 16 * MiB, WS_WS = 18 * MiB, WS_WPG = 22 * MiB, WS_PB = 24 * MiB;
constexpr size_t WS_UB = 32 * MiB, WS_VB = 48 * MiB;
constexpr size_t WS_AC = 64 * MiB;
constexpr size_t WS_A = 96 * MiB;
constexpr size_t WS_PP = 128 * MiB;
constexpr size_t WS_Q = 160 * MiB, WS_K = 176 * MiB, WS_V = 192 * MiB, WS_GB = 208 * MiB, WS_Z = 224 * MiB;
constexpr size_t WS_MERGED = 160 * MiB, WS_XB2 = 192 * MiB, WS_IDS = 224 * MiB, WS_GATES = 232 * MiB;
constexpr size_t WS_XB3 = 64 * MiB, WS_SS4 = WS_LF;
constexpr size_t WS_END = 256 * MiB;
constexpr size_t WS_PART0 = 4 * MiB, WS_PART1 = 160 * MiB, WS_PART2 = 240 * MiB;
constexpr size_t WS_TGC = 32 * MiB, WS_TXC = 64 * MiB, WS_SC = 32 * MiB;
constexpr int CW_BAR = 1024;

constexpr int RING_OFF = 0, RING_BYTES = 135168;
constexpr int LDSCTL_OFF = RING_BYTES, MISC_OFF = LDSCTL_OFF + 320;
constexpr int LDS_BYTES = RING_BYTES + 1024;
static_assert(attn_body::ATTN_LDS_BYTES <= RING_BYTES && pg8::STAGE_BYTES <= RING_BYTES && 128 * pg8::EpiTopK::RS * 4 <= RING_BYTES, "LDS map");

typedef unsigned u32x4 __attribute__((ext_vector_type(4)));
typedef unsigned u32x2 __attribute__((ext_vector_type(2)));
__device__ __forceinline__ float bf2f(bf16 v) { return __uint_as_float((unsigned)v << 16); }
__device__ __forceinline__ float wave_sum(float v) {
#pragma unroll
    for (int o = 1; o < 64; o <<= 1) v += __shfl_xor(v, o);
    return v;
}
__device__ __forceinline__ float sigmoidf_(float v) { return 1.0f / (1.0f + __expf(-v)); }
__host__ __device__ __forceinline__ int src_in(int n) {
    const int pn = n >> 8, l = n & 255;
    if (pn < 6) return n;
    if (pn < 8) return 1544 + (n - 1536);
    if (pn < 12) { const int j = pn - 8; return (l < 128) ? 2056 + 128 * j + l : 2568 + 128 * j + (l - 128); }
    { const int j = pn - 12; return (l < 128) ? 3080 + 128 * j + l : 4104 + 128 * j + (l - 128); }
}

struct Args { const float* in[18]; float* out; unsigned char* ws; int ph_lo, ph_hi, li, pad; };
struct Ctx {
    LAS unsigned char* lds; int wave, vcu, G;
    __device__ __forceinline__ int tid_() const { return (int)threadIdx.x; }
    __device__ __forceinline__ int lane_() const { return (int)threadIdx.x & 63; }
};

struct TrItem { const float* W; const float* g; bf16* WT; int ldw, k0, scol0, ldt, drow0, dk0; };
__device__ __forceinline__ void tr_load(const TrItem& I, float (&tv)[32], int lane) {
#pragma unroll
    for (int i = 0; i < 32; ++i) { const int kk = 2 * i + (lane >> 5); tv[i] = I.W[(size_t)(I.k0 + kk) * I.ldw + I.scol0 + (lane & 31)]; }
}
__device__ __forceinline__ void tr_finish(const TrItem& I, const float (&tv)[32], LAS float* scr, int lane) {
#pragma unroll
    for (int i = 0; i < 32; ++i) { const int kk = 2 * i + (lane >> 5); float v = tv[i]; if (I.g) v *= I.g[I.k0 + kk]; scr[kk * 33 + (lane & 31)] = v; }
    LDS_WAIT(); asm volatile("" ::: "memory");
    const int c = lane & 7;
#pragma unroll
    for (int j = 0; j < 4; ++j) { const int n = (lane >> 3) + 8 * j; const LAS float* s = scr + (8 * c) * 33 + n;
        v4u o; o.x = pk2(s[0 * 33], s[1 * 33]); o.y = pk2(s[2 * 33], s[3 * 33]); o.z = pk2(s[4 * 33], s[5 * 33]); o.w = pk2(s[6 * 33], s[7 * 33]);
        *(GAS v4u*)(I.WT + (size_t)(I.drow0 + n) * I.ldt + I.dk0 + 8 * c) = o; }
    LDS_WAIT(); asm volatile("" ::: "memory");
}
constexpr int TR_IN = 16 * 160, TR_PP = 4 * 32, TR_BR = 8 * 32, TR_SQ = 16 * 32;
constexpr int TR_P0 = TR_IN + TR_PP;
constexpr int TR_LATE = 2 * TR_BR + 2 * TR_SQ;
__device__ __forceinline__ TrItem tr_decode(const Args& a, int r) {
    unsigned char* ws = a.ws;
    if (r < TR_IN) { const int kb = r / 160, nb = r % 160; return TrItem{a.in[3], a.in[2], (bf16*)(ws + WS_WIN), INTOT, 64 * kb, src_in(32 * nb), D, 32 * nb, 64 * kb}; } r -= TR_IN;
    if (r < TR_PP) { const int kb = r / 32, nb = r % 32; return TrItem{a.in[16], nullptr, (bf16*)(ws + WS_WPP), D, 64 * kb, 32 * nb, PLE, 32 * nb, 64 * kb}; } r -= TR_PP;
    if (r < 2 * TR_BR) { const int br = r / TR_BR, q = r % TR_BR, kb = q / 32, nb = q % 32; return TrItem{a.in[6] + (size_t)br * AW * D, nullptr, (bf16*)(ws + WS_WBR), D, 64 * kb, 32 * nb, D, 32 * nb, br * AW + 64 * kb}; } r -= 2 * TR_BR;
    if (r < TR_SQ) { const int kb = r / 32, nb = r % 32; return TrItem{a.in[7], nullptr, (bf16*)(ws + WS_WOUT), D, 64 * kb, 32 * nb, D, 32 * nb, 64 * kb}; } r -= TR_SQ;
    { const int kb = r / 32, nb = r % 32; return TrItem{a.in[15], a.in[14], (bf16*)(ws + WS_WPG), D, 64 * kb, 32 * nb, D, 32 * nb, 64 * kb}; }
}
__device__ __forceinline__ void tr_two(const Args& a, LAS float* scr, int ra, int rb_, bool two, int lane) {
    const TrItem A = tr_decode(a, ra), B = tr_decode(a, two ? rb_ : ra);
    float ta[32], tb[32];
    tr_load(A, ta, lane); if (two) tr_load(B, tb, lane);
    tr_finish(A, ta, scr, lane); if (two) tr_finish(B, tb, scr, lane);
}
__device__ __forceinline__ void ws_item(const Args& a, LAS unsigned char* lds, int item) {
    int tid_ = (int)threadIdx.x; asm volatile("" : "+v"(tid_));
    const float *g_ffn = a.in[8], *w_peer_q = a.in[9]; bf16* WST = (bf16*)(a.ws + WS_WS);
    LAS float* KH = (LAS float*)lds; LAS float* WQ = KH + 128 * 129;
    const int hh = item >> 4, head = hh >> 1, half = hh & 1, d0 = (item & 15) * 64;
    const float* kh = (half ? a.in[11] : a.in[10]) + (size_t)head * 128 * 128;
    float tk[32], tq[16];
#pragma unroll
    for (int i = 0; i < 32; ++i) tk[i] = kh[i * 512 + tid_];
#pragma unroll
    for (int i = 0; i < 16; ++i) { const int idx = i * 512 + tid_; tq[i] = w_peer_q[(size_t)(d0 + (idx >> 7)) * NS + head * 256 + half * 128 + (idx & 127)]; }
#pragma unroll
    for (int i = 0; i < 32; ++i) { const int idx = i * 512 + tid_; KH[(idx >> 7) * 129 + (idx & 127)] = tk[i]; }
#pragma unroll
    for (int i = 0; i < 16; ++i) { const int idx = i * 512 + tid_; WQ[(idx >> 7) * 129 + (idx & 127)] = tq[i]; }
    __syncthreads();
    typedef float f32x16_t __attribute__((ext_vector_type(16)));
    const int lane = tid_ & 63, w = __builtin_amdgcn_readfirstlane(tid_ >> 6), kt = w & 3, dt = w >> 2, l31 = lane & 31, h = lane >> 5;
    const LAS float* ap = WQ + (32 * dt + l31) * 129 + h; const LAS float* bp = KH + (32 * kt + l31) * 129 + h;
    f32x16_t acc = {0.f, 0.f, 0.f, 0.f, 0.f, 0.f, 0.f, 0.f, 0.f, 0.f, 0.f, 0.f, 0.f, 0.f, 0.f, 0.f};
#pragma unroll 8
    for (int s_ = 0; s_ < 64; ++s_) acc = __builtin_amdgcn_mfma_f32_32x32x2f32(ap[2 * s_], bp[2 * s_], acc, 0, 0, 0);
    const int key = 32 * kt + l31;
#pragma unroll
    for (int q = 0; q < 4; ++q) { const int dd = d0 + 32 * dt + 8 * q + 4 * h; const f32x4 gv = *(const GAS f32x4*)(g_ffn + dd);
        u32x2 o; o.x = pk2(acc[4 * q] * gv[0], acc[4 * q + 1] * gv[1]); o.y = pk2(acc[4 * q + 2] * gv[2], acc[4 * q + 3] * gv[3]);
        *(GAS u32x2*)(WST + (size_t)(head * 256 + half * 128 + key) * D + dd) = o; }
    __syncthreads();
}
__device__ __forceinline__ void quant_load4(const Args& a, int rb, int lane, f32x4 (&v)[4][4]) {
#pragma unroll
    for (int r = 0; r < 4; ++r) { const int rr = rb + r; const bool isv = rr >= NEXP; const int e = isv ? rr - NEXP : rr;
        const GAS f32x4* src = (const GAS f32x4*)((isv ? a.in[13] : a.in[12]) + (size_t)e * D) + lane;
#pragma unroll
        for (int j = 0; j < 4; ++j) v[r][j] = src[64 * j]; }
}
__device__ __forceinline__ void quant_finish4(const Args& a, int rb, int lane, f32x4 (&v)[4][4]) {
    unsigned char* ws = a.ws; const float *g_ffn = a.in[8];
    f32x4 gq[4];
#pragma unroll
    for (int j = 0; j < 4; ++j) gq[j] = *(const GAS f32x4*)(g_ffn + 256 * j + 4 * lane);
#pragma unroll
    for (int r = 0; r < 4; ++r) { const int rr = rb + r; const bool isv = rr >= NEXP; const int e = isv ? rr - NEXP : rr;
        float am = 0.f;
#pragma unroll
        for (int j = 0; j < 4; ++j) { if (!isv) v[r][j] = v[r][j] * gq[j]; am = fmaxf(am, fmaxf(fmaxf(fabsf(v[r][j].x), fabsf(v[r][j].y)), fmaxf(fabsf(v[r][j].z), fabsf(v[r][j].w)))); }
#pragma unroll
        for (int o = 1; o < 64; o <<= 1) am = fmaxf(am, __shfl_xor(am, o));
        const float sc = am > 0.f ? 127.0f / am : 0.f;
        unsigned char* tb = ws + (isv ? WS_VB : WS_UB);
#pragma unroll
        for (int j = 0; j < 4; ++j) { const int q0 = (int)rintf(v[r][j].x * sc), q1 = (int)rintf(v[r][j].y * sc), q2 = (int)rintf(v[r][j].z * sc), q3 = (int)rintf(v[r][j].w * sc);
            const unsigned o = (unsigned)(q0 & 255) | ((unsigned)(q1 & 255) << 8) | ((unsigned)(q2 & 255) << 16) | ((unsigned)(q3 & 255) << 24);
            *(GAS unsigned*)(tb + ((size_t)(2 * j + (lane >> 5)) * NEXP + e) * SLW + ((4 * lane) & 127)) = o; }
        if (lane == 0) ((float*)(ws + (isv ? WS_SV : WS_SU)))[e] = am * (1.0f / 127.0f);
    }
}
__device__ __forceinline__ void quant_rows4(const Args& a, int rb, int lane) { f32x4 v[4][4]; quant_load4(a, rb, lane, v); quant_finish4(a, rb, lane, v); }
__device__ __forceinline__ void p0_prologue(const Ctx& F, const Args& a, volatile LAS unsigned* MISC) {
    unsigned char* ws = a.ws;
    const float *x = a.in[0], *p = a.in[1], *g_mix = a.in[2], *w_in = a.in[3], *b_f = a.in[4];
    bf16 *PB = (bf16*)(ws + WS_PB), *XB = (bf16*)(ws + WS_A);
    float *RSTD1 = (float*)(ws + WS_RSTD1), *LF = (float*)(ws + WS_LF);
    const int gw = F.vcu * NWAVES + F.wave, NGW = F.G * NWAVES, NGT = F.G * 512;
    const int tid_ = (int)threadIdx.x, lane_ = tid_ & 63;
    auto stepB = [&]() __attribute__((always_inline)) {
        LAS float* scr = (LAS float*)(F.lds + RING_OFF + F.wave * 16384);
        for (int it = gw; it < TR_P0; it += 2 * NGW) tr_two(a, scr, it, it + NGW, it + NGW < TR_P0, lane_);
    };
    auto stepC = [&]() __attribute__((always_inline)) {
    {
        LAS float* WFL = (LAS float*)(F.lds + RING_OFF);
        { float tw[16], tg[16];
#pragma unroll
          for (int i = 0; i < 16; ++i) { const int idx = i * 512 + tid_, k = idx >> 3, h = idx & 7; tw[i] = w_in[(size_t)k * INTOT + 1536 + h]; tg[i] = g_mix[k]; }
#pragma unroll
          for (int i = 0; i < 16; ++i) { const int idx = i * 512 + tid_, k = idx >> 3, h = idx & 7; WFL[h * 1024 + k] = tg[i] * tw[i]; } }
        __syncthreads();
        for (int rb = gw; rb < M; rb += 4 * NGW) {
            f32x4 v[4][4];
#pragma unroll
            for (int r = 0; r < 4; ++r) { const int row = rb + r * NGW; if (row < M) { const GAS f32x4* xr = (const GAS f32x4*)(x + (size_t)row * D);
#pragma unroll
                for (int j = 0; j < 4; ++j) v[r][j] = xr[lane_ + 64 * j]; } }
#pragma unroll
            for (int r = 0; r < 4; ++r) { const int row = rb + r * NGW; if (row < M) {
                float ss = 0.f;
#pragma unroll
                for (int j = 0; j < 4; ++j) ss += (v[r][j].x * v[r][j].x + v[r][j].y * v[r][j].y) + (v[r][j].z * v[r][j].z + v[r][j].w * v[r][j].w);
                ss = wave_sum(ss);
                const float rstd = 1.0f / sqrtf(ss * (1.0f / D) + EPS);
                GAS u32x2* o = (GAS u32x2*)(XB + (size_t)row * D);
#pragma unroll
                for (int j = 0; j < 4; ++j) { u32x2 w; w.x = pk2(v[r][j].x, v[r][j].y); w.y = pk2(v[r][j].z, v[r][j].w); o[lane_ + 64 * j] = w; }
                if (lane_ == 0) RSTD1[row] = rstd;
                float f[8];
#pragma unroll
                for (int h = 0; h < 8; ++h) { float s_ = 0.f;
#pragma unroll
                    for (int j = 0; j < 4; ++j) { const f32x4 w = *(const LAS f32x4*)(WFL + h * 1024 + 4 * (lane_ + 64 * j)); s_ += (v[r][j].x * w[0] + v[r][j].y * w[1]) + (v[r][j].z * w[2] + v[r][j].w * w[3]); }
                    f[h] = s_; }
                float r4[4], r2[2], r1;
#pragma unroll
                for (int i = 0; i < 4; ++i) { const float send = (lane_ & 32) ? f[i] : f[i + 4], keep = (lane_ & 32) ? f[i + 4] : f[i]; r4[i] = keep + __shfl_xor(send, 32); }
#pragma unroll
                for (int i = 0; i < 2; ++i) { const float send = (lane_ & 16) ? r4[i] : r4[i + 2], keep = (lane_ & 16) ? r4[i + 2] : r4[i]; r2[i] = keep + __shfl_xor(send, 16); }
                { const float send = (lane_ & 8) ? r2[0] : r2[1], keep = (lane_ & 8) ? r2[1] : r2[0]; r1 = keep + __shfl_xor(send, 8); }
                r1 += __shfl_xor(r1, 4); r1 += __shfl_xor(r1, 2); r1 += __shfl_xor(r1, 1);
                const int hL = ((lane_ >> 5) & 1) * 4 + ((lane_ >> 4) & 1) * 2 + ((lane_ >> 3) & 1);
                const float tot = r1 * rstd + b_f[hL];
                const float ls = fminf(tot, 0.f) - log1pf(__expf(-fabsf(tot)));
                const int b = row / SEQ, t = row % SEQ;
                if ((lane_ & 7) == 0) LF[(size_t)(b * NH + hL) * SEQ + t] = ls * LOG2E;
            } }
        }
    }
    };
    if (F.vcu & 1) { stepC(); __syncthreads(); stepB(); }
    else           { stepB(); __syncthreads(); stepC(); }
    { constexpr int NP = M * PLE / 8;
        for (int i = F.vcu * 512 + tid_; i < NP; i += NGT) { const f32x4 a_ = ((const GAS f32x4*)p)[2 * (size_t)i], b_ = ((const GAS f32x4*)p)[2 * (size_t)i + 1];
            v4u o; o.x = pk2(a_.x, a_.y); o.y = pk2(a_.z, a_.w); o.z = pk2(b_.x, b_.y); o.w = pk2(b_.z, b_.w); ((GAS v4u*)PB)[i] = o; }
    }
}
__device__ __forceinline__ void p2_conv_chunk(int chunk, const bf16* GB, const bf16* Z, const float* cw, bf16* AC) {
    int tid_l = (int)threadIdx.x; asm volatile("" : "+v"(tid_l));
#pragma unroll 4
    for (int k = 0; k < 16; ++k) {
        const int i = chunk * 8192 + k * 512 + tid_l;
        const int row = i >> 6, c = (i & 63) * 8, t = row & (SEQ - 1);
        const v4u z2 = *(const GAS v4u*)(Z + (size_t)row * AW + c), g = *(const GAS v4u*)(GB + (size_t)row * AW + c);
        v4u z1 = {0u, 0u, 0u, 0u}, z0 = {0u, 0u, 0u, 0u};
        if (t >= 1) z1 = *(const GAS v4u*)(Z + (size_t)(row - 1) * AW + c);
        if (t >= 2) z0 = *(const GAS v4u*)(Z + (size_t)(row - 2) * AW + c);
        float r[8];
#pragma unroll
        for (int e = 0; e < 4; ++e) {
            const float w0a = cw[c + 2 * e], w0b = cw[c + 2 * e + 1], w1a = cw[AW + c + 2 * e], w1b = cw[AW + c + 2 * e + 1], w2a = cw[2 * AW + c + 2 * e], w2b = cw[2 * AW + c + 2 * e + 1];
            r[2 * e] = __uint_as_float(g[e] << 16) * (w0a * __uint_as_float(z0[e] << 16) + w1a * __uint_as_float(z1[e] << 16) + w2a * __uint_as_float(z2[e] << 16));
            r[2 * e + 1] = __uint_as_float(g[e] & 0xffff0000u) * (w0b * __uint_as_float(z0[e] & 0xffff0000u) + w1b * __uint_as_float(z1[e] & 0xffff0000u) + w2b * __uint_as_float(z2[e] & 0xffff0000u));
        }
        v4u o; o.x = pk2(r[0], r[1]); o.y = pk2(r[2], r[3]); o.z = pk2(r[4], r[5]); o.w = pk2(r[6], r[7]);
        *(GAS v4u*)(AC + (size_t)row * D + AW + c) = o;
    }
}
constexpr int P2_NATT = 512, P2_NCONV = M * AW / 8 / 8192, P2_NQ = 2 * NEXP / 128, P2_NWS = 256, P2_NTR = TR_LATE / 16, CW_QUEUE = 512;
constexpr int P2_NITEMS = P2_NATT + P2_NCONV + P2_NQ + P2_NWS + P2_NTR;
__device__ __forceinline__ int p2_dequeue(unsigned* ctr, volatile LAS unsigned* slot) {
    if (threadIdx.x == 0) *slot = __hip_atomic_fetch_add(ctr, 1u, __ATOMIC_RELAXED, __HIP_MEMORY_SCOPE_AGENT);
    asm volatile("s_waitcnt vmcnt(0) lgkmcnt(0)\n\ts_barrier" ::: "memory");
    const unsigned v = *slot;
    asm volatile("s_waitcnt lgkmcnt(0)\n\ts_barrier" ::: "memory");
    return (int)v;
}
template <int CTRL> __device__ __forceinline__ int dpp_i(int v) { return __builtin_amdgcn_update_dpp(0, v, CTRL, 0xf, 0xf, true); }
__device__ __forceinline__ int sum8i(int v) { v += dpp_i<0x141>(v); v += dpp_i<0xB1>(v); v += dpp_i<0x4E>(v); return v; }
__device__ __forceinline__ float max8f(float v) { v = fmaxf(v, __uint_as_float((unsigned)dpp_i<0x141>((int)__float_as_uint(v)))); v = fmaxf(v, __uint_as_float((unsigned)dpp_i<0xB1>((int)__float_as_uint(v)))); v = fmaxf(v, __uint_as_float((unsigned)dpp_i<0x4E>((int)__float_as_uint(v)))); return v; }
__device__ __forceinline__ size_t part_slab(int j) { return j < 2 ? WS_PART0 + (size_t)j * 8 * MiB : j < 6 ? WS_PART1 + (size_t)(j - 2) * 8 * MiB : WS_PART2 + (size_t)(j - 6) * 8 * MiB; }
struct P6Geo { int xg, wi, nwv, ng; };
__device__ __forceinline__ P6Geo p6_geo(const Ctx& F) { P6Geo g; const int bx = blockIdx.x, ng = F.G < 8 ? F.G : 8; g.xg = bx % ng; g.wi = (bx / ng) * NWAVES + F.wave; g.nwv = ((F.G - g.xg + ng - 1) / ng) * NWAVES; g.ng = ng; return g; }
__device__ __forceinline__ void p6a_upass(const Ctx& F, unsigned char* ws, const bf16* XB1, const unsigned short* IDS) {
    const P6Geo G = p6_geo(F); const int lane = F.lane_(), g = lane >> 3, c = lane & 7;
    for (int sl = G.xg; sl < NSL; sl += G.ng) {
        float* PART = (float*)(ws + part_slab(sl));
        const GAS unsigned char* Ts = (const GAS unsigned char*)(ws + WS_UB) + (size_t)sl * NEXP * SLW + 16 * c;
        for (int t = G.wi; t < M; t += G.nwv) {
            const v4u xa = *(const GAS v4u*)(XB1 + (size_t)t * D + sl * SLW + 16 * c), xb = *(const GAS v4u*)(XB1 + (size_t)t * D + sl * SLW + 16 * c + 8);
            v4u idp[2];
#pragma unroll
            for (int q = 0; q < 2; ++q) idp[q] = *(const GAS v4u*)(IDS + (size_t)t * 128 + 16 * g + 8 * q);
            v4u u[16];
#pragma unroll
            for (int i = 0; i < 16; ++i) { const unsigned w_ = idp[i >> 3][(i >> 1) & 3]; u[i] = *(const GAS v4u*)(Ts + ((i & 1) ? ((w_ >> 9) & 0x7fff80u) : ((w_ << 7) & 0x7fff80u))); }
            float xf[16];
#pragma unroll
            for (int e = 0; e < 4; ++e) { xf[2 * e] = __uint_as_float(xa[e] << 16); xf[2 * e + 1] = __uint_as_float(xa[e] & 0xffff0000u); xf[8 + 2 * e] = __uint_as_float(xb[e] << 16); xf[8 + 2 * e + 1] = __uint_as_float(xb[e] & 0xffff0000u); }
            float am = 0.f;
#pragma unroll
            for (int e = 0; e < 16; ++e) am = fmaxf(am, fabsf(xf[e]));
            am = max8f(am);
            const float sc = am > 0.f ? 127.0f / am : 0.f, sx = am * (1.0f / 127.0f);
            int qx[4];
#pragma unroll
            for (int j = 0; j < 4; ++j) qx[j] = (int)(((unsigned)((int)rintf(xf[4 * j] * sc) & 255)) | ((unsigned)((int)rintf(xf[4 * j + 1] * sc) & 255) << 8) | ((unsigned)((int)rintf(xf[4 * j + 2] * sc) & 255) << 16) | ((unsigned)((int)rintf(xf[4 * j + 3] * sc) & 255) << 24));
            int r0 = 0, r1 = 0;
#pragma unroll
            for (int i = 0; i < 16; ++i) { int sacc = __builtin_amdgcn_sdot4(qx[0], (int)u[i][0], 0, false); sacc = __builtin_amdgcn_sdot4(qx[1], (int)u[i][1], sacc, false); sacc = __builtin_amdgcn_sdot4(qx[2], (int)u[i][2], sacc, false); sacc = __builtin_amdgcn_sdot4(qx[3], (int)u[i][3], sacc, false);
                sacc = sum8i(sacc);
                if (i < 8) r0 = (c == i) ? sacc : r0; else r1 = (c == i - 8) ? sacc : r1; }
            float* pp = PART + (size_t)t * 128 + 16 * g + c;
            pp[0] = (float)r0 * sx; pp[8] = (float)r1 * sx;
        }
    }
}
__device__ __forceinline__ void p6b_combine(const Ctx& F, unsigned char* ws, float* SS2, const unsigned short* IDS, const float* GATES) {
    const int gw = F.vcu * NWAVES + F.wave, NGW = F.G * NWAVES, lane = F.lane_();
    const float *SU = (const float*)(ws + WS_SU), *SV = (const float*)(ws + WS_SV);
    signed char* WQ8 = (signed char*)(ws + WS_WQ8); float* SW = (float*)(ws + WS_SW);
    for (int tb = gw; tb < M; tb += 4 * NGW) {
        float ssv[4], a0[4], a1[4], g0[4], g1[4]; int i0[4], i1[4];
#pragma unroll
        for (int r = 0; r < 4; ++r) { const int t = tb + r * NGW; if (t < M) {
            ssv[r] = lane < 16 ? SS2[(size_t)t * 16 + lane] : 0.f;
            i0[r] = (int)IDS[(size_t)t * 128 + lane]; i1[r] = (int)IDS[(size_t)t * 128 + 64 + lane];
            g0[r] = GATES[(size_t)t * 128 + lane]; g1[r] = GATES[(size_t)t * 128 + 64 + lane];
            a0[r] = 0.f; a1[r] = 0.f;
#pragma unroll
            for (int j = 0; j < 8; ++j) { const float* pp = (const float*)(ws + part_slab(j)) + (size_t)t * 128; a0[r] += pp[lane]; a1[r] += pp[64 + lane]; } } }
#pragma unroll
        for (int r = 0; r < 4; ++r) { const int t = tb + r * NGW; if (t < M) {
            const float rstd = 1.0f / sqrtf(wave_sum(ssv[r]) * (1.0f / D) + EPS);
            const float x0 = a0[r] * rstd * SU[i0[r]], x1 = a1[r] * rstd * SU[i1[r]];
            const float w0 = g0[r] * 0.5f * x0 * (1.0f + erff(x0 * 0.70710678118654752f)) * SV[i0[r]], w1 = g1[r] * 0.5f * x1 * (1.0f + erff(x1 * 0.70710678118654752f)) * SV[i1[r]];
            float am = fmaxf(fabsf(w0), fabsf(w1));
#pragma unroll
            for (int o = 1; o < 64; o <<= 1) am = fmaxf(am, __shfl_xor(am, o));
            const float sc = am > 0.f ? 127.0f / am : 0.f;
            WQ8[(size_t)t * 128 + lane] = (signed char)(int)rintf(w0 * sc); WQ8[(size_t)t * 128 + 64 + lane] = (signed char)(int)rintf(w1 * sc);
            if (lane == 0) SW[t] = am * (1.0f / 127.0f);
            if (lane < 16) SS2[(size_t)t * 16 + lane] = 0.f;
        } }
    }
}
__device__ __forceinline__ int pl32_sum(int a, int b) { const auto s_ = __builtin_amdgcn_permlane32_swap((unsigned)a, (unsigned)b, false, false); return (int)(s_[0] + s_[1]); }
__device__ __forceinline__ int pl16_sum(int a, int b) { const auto s_ = __builtin_amdgcn_permlane16_swap((unsigned)a, (unsigned)b, false, false); return (int)(s_[0] + s_[1]); }
__device__ __forceinline__ float wave_sum_valu(float v) {
    { const auto s_ = __builtin_amdgcn_permlane32_swap(__float_as_uint(v), __float_as_uint(v), false, false); v = __uint_as_float(s_[0]) + __uint_as_float(s_[1]); }
    { const auto s_ = __builtin_amdgcn_permlane16_swap(__float_as_uint(v), __float_as_uint(v), false, false); v = __uint_as_float(s_[0]) + __uint_as_float(s_[1]); }
    v += __uint_as_float((unsigned)dpp_i<0x128>((int)__float_as_uint(v))); v += __uint_as_float((unsigned)dpp_i<0x124>((int)__float_as_uint(v)));
    v += __uint_as_float((unsigned)dpp_i<0x122>((int)__float_as_uint(v))); v += __uint_as_float((unsigned)dpp_i<0x121>((int)__float_as_uint(v))); return v;
}
__device__ __forceinline__ void p6c_vpass(const Ctx& F, unsigned char* ws, const unsigned short* IDS, const bf16* XB1, bf16* XB2, float* SS3) {
    const P6Geo G = p6_geo(F); const int lane = F.lane_(), g = lane >> 3, c = lane & 7;
    const int ecol = 16 * c + ((lane >> 5) & 1) * 8 + ((lane >> 4) & 1) * 4 + ((lane >> 3) & 1) * 2;
    const signed char* WQ8 = (const signed char*)(ws + WS_WQ8); const float* SW = (const float*)(ws + WS_SW);
#define V_IDS(ID, t_) do { _Pragma("unroll") for (int q = 0; q < 2; ++q) ID[q] = *(const GAS v4u*)(IDS + (size_t)(t_) * 128 + 16 * g + 8 * q); } while (0)
#define V_W(WV, t_) do { WV = *(const GAS v4u*)(WQ8 + (size_t)(t_) * 128 + 16 * g); } while (0)
#define V_GATHER(R, ID) do { _Pragma("unroll") for (int i = 0; i < 16; ++i) { const unsigned w_ = ID[i >> 3][(i >> 1) & 3]; R[i] = *(const GAS v4u*)(Ts + (size_t)((((i & 1) ? (w_ >> 9) : (w_ << 7)) & 0x7fff80u) | c16)); } } while (0)
#define V_COMPUTE(R, WV, t_) do { \
        const size_t o_ = (size_t)(t_) * D + sl * SLW + ecol; \
        const unsigned xq_ = *(const GAS unsigned*)(XB1 + o_); const float sw_ = SW[t_]; \
        int acc[16]; \
        _Pragma("unroll") for (int e = 0; e < 16; ++e) acc[e] = 0; \
        _Pragma("unroll") for (int j = 0; j < 4; ++j) \
            _Pragma("unroll") for (int b = 0; b < 4; ++b) { \
                const unsigned r0_ = R[4 * j][b], r1_ = R[4 * j + 1][b], r2_ = R[4 * j + 2][b], r3_ = R[4 * j + 3][b]; \
                const unsigned x01 = __builtin_amdgcn_perm(r1_, r0_, 0x05010400u), y01 = __builtin_amdgcn_perm(r1_, r0_, 0x07030602u), x23 = __builtin_amdgcn_perm(r3_, r2_, 0x05010400u), y23 = __builtin_amdgcn_perm(r3_, r2_, 0x07030602u); \
                acc[4 * b]     = __builtin_amdgcn_sdot4((int)__builtin_amdgcn_perm(x23, x01, 0x05040100u), (int)WV[j], acc[4 * b], false); \
                acc[4 * b + 1] = __builtin_amdgcn_sdot4((int)__builtin_amdgcn_perm(x23, x01, 0x07060302u), (int)WV[j], acc[4 * b + 1], false); \
                acc[4 * b + 2] = __builtin_amdgcn_sdot4((int)__builtin_amdgcn_perm(y23, y01, 0x05040100u), (int)WV[j], acc[4 * b + 2], false); \
                acc[4 * b + 3] = __builtin_amdgcn_sdot4((int)__builtin_amdgcn_perm(y23, y01, 0x07060302u), (int)WV[j], acc[4 * b + 3], false); } \
        int r8[8], r4[4], r2[2]; \
        _Pragma("unroll") for (int i = 0; i < 8; ++i) r8[i] = pl32_sum(acc[i], acc[i + 8]); \
        _Pragma("unroll") for (int i = 0; i < 4; ++i) r4[i] = pl16_sum(r8[i], r8[i + 4]); \
        _Pragma("unroll") for (int i = 0; i < 2; ++i) { const int send = (lane & 8) ? r4[i] : r4[i + 2], keep = (lane & 8) ? r4[i + 2] : r4[i]; r2[i] = keep + dpp_i<0x128>(send); } \
        const float x0_ = __uint_as_float(xq_ << 16) + sw_ * (float)r2[0], x1_ = __uint_as_float(xq_ & 0xffff0000u) + sw_ * (float)r2[1]; \
        *(GAS unsigned*)(XB2 + o_) = pk2(x0_, x1_); \
        const float ss = wave_sum_valu(x0_ * x0_ + x1_ * x1_); \
        if (lane == 0) SS3[(size_t)(t_) * 16 + sl] = ss; } while (0)
#define V_FENCE() asm volatile("" ::: "memory")
    for (int sl = G.xg; sl < NSL; sl += G.ng) {
        const GAS unsigned char* Ts = (const GAS unsigned char*)(ws + WS_VB) + (size_t)sl * NEXP * SLW; const unsigned c16 = 16u * (unsigned)c;
        const int nk = (M - G.wi + G.nwv - 1) / G.nwv, t0 = G.wi, dt = G.nwv;
        v4u idA[2], idB[2]; v4u wA, wB; v4u rA[16], rB[16];
#ifdef MK_P6C_SIMPLE
        for (int k = 0; k < nk; ++k) { V_IDS(idA, t0 + k * dt); V_GATHER(rA, idA); V_W(wA, t0 + k * dt); V_COMPUTE(rA, wA, t0 + k * dt); }
        (void)idB; (void)wB; (void)rB;
    }
#else
        if (nk > 0) { V_IDS(idA, t0); V_GATHER(rA, idA); V_W(wA, t0); }
        if (nk > 1) V_IDS(idB, t0 + dt);
        V_FENCE();
        for (int k = 0; k < nk; k += 2) {
            if (k + 1 < nk) { V_GATHER(rB, idB); V_W(wB, t0 + (k + 1) * dt); }
            if (k + 2 < nk) V_IDS(idA, t0 + (k + 2) * dt);
            V_FENCE();
            V_COMPUTE(rA, wA, t0 + k * dt);
            V_FENCE();
            if (k + 2 < nk) { V_GATHER(rA, idA); V_W(wA, t0 + (k + 2) * dt); }
            if (k + 3 < nk) V_IDS(idB, t0 + (k + 3) * dt);
            V_FENCE();
            if (k + 1 < nk) V_COMPUTE(rB, wB, t0 + (k + 1) * dt);
            V_FENCE();
        }
    }
#endif
#undef V_IDS
#undef V_W
#undef V_GATHER
#undef V_COMPUTE
#undef V_FENCE
}
__device__ __forceinline__ void p8_final(const Ctx& F, const bf16* XB3, const float* SS4, float* OUT, const float* g) {
    const int gw = F.vcu * NWAVES + F.wave, NGW = F.G * NWAVES, lane = F.lane_();
    f32x4 gv[4];
#pragma unroll
    for (int j = 0; j < 4; ++j) gv[j] = ((const GAS f32x4*)g)[2 * lane + (j & 1) + 128 * (j >> 1)];
    for (int rb = gw; rb < M; rb += 4 * NGW) {
        v4u xa[4], xb[4]; float sv[4];
#pragma unroll
        for (int r = 0; r < 4; ++r) { const int row = rb + r * NGW; if (row < M) { xa[r] = *(const GAS v4u*)(XB3 + (size_t)row * D + 8 * lane); xb[r] = *(const GAS v4u*)(XB3 + (size_t)row * D + 512 + 8 * lane);
            sv[r] = lane < 16 ? SS4[(size_t)row * 16 + lane] : 0.f; } }
#pragma unroll
        for (int r = 0; r < 4; ++r) { const int row = rb + r * NGW; if (row < M) {
            const float rstd = 1.0f / sqrtf(wave_sum(sv[r]) * (1.0f / D) + EPS);
            GAS f32x4* o = (GAS f32x4*)(OUT + (size_t)row * D);
            o[2 * lane] = (f32x4){__uint_as_float(xa[r][0] << 16), __uint_as_float(xa[r][0] & 0xffff0000u), __uint_as_float(xa[r][1] << 16), __uint_as_float(xa[r][1] & 0xffff0000u)} * rstd * gv[0];
            o[2 * lane + 1] = (f32x4){__uint_as_float(xa[r][2] << 16), __uint_as_float(xa[r][2] & 0xffff0000u), __uint_as_float(xa[r][3] << 16), __uint_as_float(xa[r][3] & 0xffff0000u)} * rstd * gv[1];
            o[128 + 2 * lane] = (f32x4){__uint_as_float(xb[r][0] << 16), __uint_as_float(xb[r][0] & 0xffff0000u), __uint_as_float(xb[r][1] << 16), __uint_as_float(xb[r][1] & 0xffff0000u)} * rstd * gv[2];
            o[128 + 2 * lane + 1] = (f32x4){__uint_as_float(xb[r][2] << 16), __uint_as_float(xb[r][2] & 0xffff0000u), __uint_as_float(xb[r][3] << 16), __uint_as_float(xb[r][3] & 0xffff0000u)} * rstd * gv[3];
        } }
    }
}
struct OneUnit {
    pg8::Unit u;
    __device__ __forceinline__ bool next(int i, pg8::Unit& o) const { if (i != 0) return false; o = u; return true; }
    __device__ __forceinline__ void a_ready(const pg8::Unit&) const {}
    __device__ __forceinline__ void done(const pg8::Unit&) const {}
};

__global__ void __launch_bounds__(NWAVES * 64, 2) mk_fwd(Args args) {
    extern __shared__ __attribute__((aligned(16))) unsigned char lds[];
    Ctx F;
    F.lds = (LAS unsigned char*)lds;
    F.wave = __builtin_amdgcn_readfirstlane((int)threadIdx.x >> 6);
    F.G = gridDim.x; { const int bx = blockIdx.x; F.vcu = (F.G % 8 == 0) ? (bx % 8) * (F.G / 8) + bx / 8 : bx; }
    volatile LAS unsigned* MISC = (volatile LAS unsigned*)(F.lds + MISC_OFF);
    unsigned char* ws = args.ws;
    gu32* ctl = (gu32*)(ws + WS_CTL);
    for (int u = F.tid_(); u < (LDS_BYTES - LDSCTL_OFF) / 4; u += NWAVES * 64) ((LAS unsigned*)(F.lds + LDSCTL_OFF))[u] = 0u;
    __syncthreads();
    const int lo = args.ph_lo, hi = args.ph_hi;
    const bool multi = (hi - lo) > 1 || (lo <= 6 && 6 < hi);
    XcdBarrier bar; bar.bar = (unsigned*)(ctl + CW_BAR) + args.li * XCD_BAR_WORDS; bar.x = 0; bar.st = nullptr;
    if (multi) bar = xcd_barrier_post((unsigned*)(ctl + CW_BAR) + args.li * XCD_BAR_WORDS, MISC + 8);
#ifndef MK_CMASK
#define MK_CMASK 0x1ff
#endif
#define IN(k) (((MK_CMASK >> (k)) & 1) && lo <= (k) && (k) < hi)
#ifdef MK_PROBE_BAR2
#define SEAM(k) do { if (IN(k) && IN((k) + 1)) { xcd_barrier(bar); for (int rb_ = 1; rb_ < MK_PROBE_BAR2; ++rb_) xcd_barrier(bar); } STAMPI((k) < 6 ? (k) + 1 : (k) + 3); } while (0)
#else
#define SEAM(k) do { if (IN(k) && IN((k) + 1)) xcd_barrier(bar); STAMPI((k) < 6 ? (k) + 1 : (k) + 3); } while (0)
#endif
#ifdef MK_PROBE_SEG
#define STAMPI(i_) do { if (((i_) == MK_PROBE_SEG || (i_) == MK_PROBE_SEG + 1) && blockIdx.x == 0 && threadIdx.x == 0) { ((unsigned long long*)(args.ws + 32768))[(i_)] = __builtin_amdgcn_s_memrealtime(); } } while (0)
    STAMPI(0);
#else
#define STAMPI(i_) do { } while (0)
#endif
    float* out = args.out;
#define WSP(T, off) ((T*)(ws + (off)))
#define RSTD1 WSP(float, WS_RSTD1)
#define SS2 WSP(float, WS_SS2)
#define LF WSP(float, WS_LF)
#define WIN WSP(bf16, WS_WIN)
#define WBR WSP(bf16, WS_WBR)
#define WOUT WSP(bf16, WS_WOUT)
#define WST WSP(bf16, WS_WS)
#define WPG WSP(bf16, WS_WPG)
#define WPP WSP(bf16, WS_WPP)
#define PB WSP(bf16, WS_PB)
#define XB WSP(bf16, WS_A)
#define AC WSP(bf16, WS_AC)
#define XB1 WSP(bf16, WS_A)
#define PP WSP(bf16, WS_PP)
#define Q WSP(bf16, WS_Q)
#define K WSP(bf16, WS_K)
#define V WSP(bf16, WS_V)
#define GB WSP(bf16, WS_GB)
#define Z WSP(bf16, WS_Z)
#define MG WSP(bf16, WS_MERGED)
#define XB2 WSP(bf16, WS_XB2)
#define IDS WSP(unsigned short, WS_IDS)
#define GATES WSP(float, WS_GATES)
#define SGA ((bf16*)out)
#define SGC ((bf16*)out + (size_t)M * D)

    if (IN(0)) { p0_prologue(F, args, MISC); }
    SEAM(0);
    if (IN(1)) {
        { pg8::Gemm g{XB, WIN, M, NIN, D}; pg8::StaticOrder S; S.init(M, NIN, F.G, (int)blockIdx.x);
          pg8::EpiIn E{RSTD1, Q, (size_t)(WS_K - WS_Q) / 2, Z, SGA, (size_t)M * D, C2};
          static_assert(WS_V - WS_K == WS_K - WS_Q && WS_GB - WS_V == WS_K - WS_Q, "Q | K | V | GB equally spaced");
          pg8::gemm_phase<pg8::EpiIn, pg8::StaticOrder, PG8_ALIGN, PG8_SP2>(F.lds + RING_OFF, g, S, E); }
        { pg8::Gemm g{PB, WPP, M, D, PLE}; pg8::StaticOrder S; S.init(M, D, F.G, (int)blockIdx.x);
          pg8::EpiPlain E{PP, D};
          pg8::gemm_phase<pg8::EpiPlain, pg8::StaticOrder, PG8_ALIGN, PG8_SP2>(F.lds + RING_OFF, g, S, E); }
    }
    SEAM(1);
    if (IN(2)) {
        unsigned* qctr = (unsigned*)(ctl + CW_QUEUE);
        for (;;) {
            const int idx = p2_dequeue(qctr, MISC + 12);
            if (idx >= P2_NITEMS) break;
            if (idx < P2_NATT) { const int qb = 15 - (idx >> 5), bh = idx & 31;
                attn_body::attn_unit<8>(bh >> 3, bh & 7, qb, (const attn_body::bf16*)Q, (const attn_body::bf16*)K, (const attn_body::bf16*)V, (attn_body::bf16*)AC, LF + (size_t)bh * SEQ, (char*)lds + RING_OFF); }
            else if (idx < P2_NATT + P2_NCONV) p2_conv_chunk(idx - P2_NATT, GB, Z, args.in[5], AC);
            else {
                const int d_ = idx - P2_NATT - P2_NCONV, blk_ = d_ / 19, p_ = d_ % 19;
                static_assert(P2_NQ == 256 && P2_NWS == 256 && P2_NTR == 96, "interleave pattern");
                if (p_ < 16 && !(p_ & 1)) {
                    int lane_l = (int)threadIdx.x & 63; asm volatile("" : "+v"(lane_l));
                    const int r0 = (blk_ * 8 + (p_ >> 1)) * 128 + F.wave * 16;
                    for (int t4 = 0; t4 < 4; ++t4) quant_rows4(args, r0 + 4 * t4, lane_l);
                }
                else if (p_ < 16) ws_item(args, F.lds + RING_OFF, blk_ * 8 + (p_ >> 1));
                else { int lane_l = (int)threadIdx.x & 63; asm volatile("" : "+v"(lane_l));
                    const int w0 = TR_P0 + (blk_ * 3 + (p_ - 16)) * 16 + F.wave * 2;
                    tr_two(args, (LAS float*)(F.lds + RING_OFF + F.wave * 16384), w0, w0 + 1, true, lane_l); }
            }
        }
    }
    SEAM(2);
    if (IN(3)) {
        pg8::Gemm g{AC, WBR, M, D, D}; pg8::StaticOrder S; S.init(M, D, F.G, (int)blockIdx.x);
        pg8::EpiBranch E{SGA, SGC, MG};
        pg8::gemm_phase<pg8::EpiBranch, pg8::StaticOrder, PG8_ALIGN, PG8_SP2>(F.lds + RING_OFF, g, S, E);
    }
    SEAM(3);
    if (IN(4)) {
        pg8::Gemm g{MG, WOUT, M, D, D}; pg8::StaticOrder S; S.init(M, D, F.G, (int)blockIdx.x);
        pg8::EpiOut E{XB, XB1, SS2};
        pg8::gemm_phase<pg8::EpiOut, pg8::StaticOrder, PG8_ALIGN, PG8_SP2>(F.lds + RING_OFF, g, S, E);
    }
    SEAM(4);
    if (IN(5)) {
        pg8::Gemm g{XB1, WST, M, NS, D}; pg8::StaticOrder S; S.init(M, NS, F.G, (int)blockIdx.x);
        pg8::EpiTopK E{SS2, IDS, GATES, EPS};
        pg8::Unit u;
        for (int i = 0; S.next(i, u); ++i) { OneUnit O{u}; pg8::gemm_phase<pg8::EpiTopK, OneUnit, false, PG8_SP2>(F.lds + RING_OFF, g, O, E); }
    }
    SEAM(5);
    if (IN(6)) { p6a_upass(F, ws, XB1, IDS); xcd_barrier(bar); STAMPI(7); p6b_combine(F, ws, SS2, IDS, GATES); xcd_barrier(bar); STAMPI(8); p6c_vpass(F, ws, IDS, XB1, XB2, SS2); }
    SEAM(6);
    if (IN(7)) {
        pg8::Gemm g{XB2, WPG, M, D, D}; pg8::StaticOrder S; S.init(M, D, F.G, (int)blockIdx.x);
        LAS float* rtab = (LAS float*)(F.lds + RING_OFF + pg8::STAGE_BYTES);
        const bool one = (M / 256) * (D / 256) <= F.G; pg8::Unit u0;
        if (one && S.next(0, u0) && F.tid_() < 256) { const float* sp = SS2 + (size_t)(u0.pm * 256 + F.tid_()) * 16; float q = 0.f;
#pragma unroll
            for (int j = 0; j < NSL; ++j) q += sp[j];
            rtab[F.tid_()] = 1.0f / sqrtf(q * (1.0f / D) + EPS); }
        __syncthreads();
        pg8::EpiPle E{SS2, PP, XB2, WSP(bf16, WS_XB3), WSP(float, WS_SS4), EPS, one ? (const LAS float*)rtab : (const LAS float*)nullptr};
        pg8::gemm_phase<pg8::EpiPle, pg8::StaticOrder, PG8_ALIGN, PG8_SP2>(F.lds + RING_OFF, g, S, E);
    }
    SEAM(7);
    if (IN(8)) { p8_final(F, WSP(bf16, WS_XB3), WSP(float, WS_SS4), out, args.in[17]); }
    STAMPI(11);
#ifdef MK_PROBE_SEG
    if (blockIdx.x == 0 && F.tid_() == 0) {
        asm volatile("s_waitcnt vmcnt(0)" ::: "memory");
        const unsigned long long* st_ = (const unsigned long long*)(args.ws + 32768);
#if MK_PROBE_SEG >= 100
        const unsigned long long a_ = st_[32 + (MK_PROBE_SEG - 100)], b_ = (MK_PROBE_SEG - 100 == 4) ? st_[1] : st_[33 + (MK_PROBE_SEG - 100)];
#else
        const unsigned long long a_ = st_[MK_PROBE_SEG], b_ = st_[MK_PROBE_SEG + 1];
#endif
        const unsigned long long dt_ = (b_ - a_) * MK_PROBE_MULT, t0_ = __builtin_amdgcn_s_memrealtime();
        while (__builtin_amdgcn_s_memrealtime() - t0_ < dt_) __builtin_amdgcn_s_sleep(8);
    }
#endif
#undef IN
#undef SEAM
#undef WSP
#undef RSTD1
#undef SS2
#undef LF
#undef WIN
#undef WBR
#undef WOUT
#undef WST
#undef WPG
#undef WPP
#undef PB
#undef XB
#undef AC
#undef XB1
#undef PP
#undef Q
#undef K
#undef V
#undef GB
#undef Z
#undef MG
#undef XB2
#undef IDS
#undef GATES
#undef SGA
#undef SGC
}

extern "C" void kernel_launch(void* const* d_in, const int* in_sizes, int n_in, void* d_out, int out_size, void* d_ws, size_t ws_size, hipStream_t stream) {
    static int grid = 0;
    if (grid == 0) {
        if (n_in != 18 || in_sizes[0] != M * D || out_size != M * D || ws_size < WS_END) { fprintf(stderr, "kernel_launch: unexpected shapes (n_in %d, in0 %d, out %d, ws %zu); nothing launched\n", n_in, n_in > 0 ? in_sizes[0] : -1, out_size, ws_size); grid = -1; return; }
        int dev = 0, cus = 0, per_cu = 0;
        if (hipGetDevice(&dev) != hipSuccess || hipDeviceGetAttribute(&cus, hipDeviceAttributeMultiprocessorCount, dev) != hipSuccess) { fprintf(stderr, "kernel_launch: device query failed\n"); grid = -1; return; }
        if (hipFuncSetAttribute((const void*)mk_fwd, hipFuncAttributeMaxDynamicSharedMemorySize, LDS_BYTES) != hipSuccess) { fprintf(stderr, "kernel_launch: hipFuncSetAttribute failed\n"); grid = -1; return; }
        if (hipOccupancyMaxActiveBlocksPerMultiprocessor(&per_cu, (const void*)mk_fwd, NWAVES * 64, LDS_BYTES) != hipSuccess || per_cu < 1) { fprintf(stderr, "kernel_launch: occupancy query says %d workgroups per CU; nothing launched\n", per_cu); (void)hipGetLastError(); grid = -1; return; }
        grid = cus;
    }
    if (grid < 0) return;
    if (hipMemsetAsync((char*)d_ws + WS_CTL, 0, CTL_ZERO_BYTES, stream) != hipSuccess) { fprintf(stderr, "kernel_launch: hipMemsetAsync failed\n"); return; }
    Args a{};
    for (int i = 0; i < 18; ++i) a.in[i] = (const float*)d_in[i];
    a.out = (float*)d_out; a.ws = (unsigned char*)d_ws; a.ph_lo = 0; a.ph_hi = NPHASE; a.li = 0; a.pad = 0;
    hipLaunchKernelGGL(mk_fwd, dim3(grid), dim3(NWAVES * 64), LDS_BYTES, stream, a);
    const hipError_t le = hipPeekAtLastError();
    if (le != hipSuccess) fprintf(stderr, "kernel_launch: launch failed: %s\n", hipGetErrorName(le));
}
```

```cpp
#include <hip/hip_runtime.h>
#include <hip/hip_bf16.h>
#include <cstdio>
#include <cstdint>
#include <cmath>
namespace pg8 {
#define PG8_LAS __attribute__((address_space(3)))
typedef unsigned short bf16_t;
typedef short bf16x8 __attribute__((ext_vector_type(8)));
typedef float f32x4 __attribute__((ext_vector_type(4)));
typedef unsigned u32x4 __attribute__((ext_vector_type(4)));
constexpr int BM = 256, BK = 64, HALF = 128, HTB = HALF * BK * 2  , STAGE_BYTES = 8 * HTB, NXCD = 8, WGM = 8;

__host__ __device__ __forceinline__ int lds_byte(int r, int c) { const int st = (r >> 4) * 2 + (c >> 5), rr = r & 15, cc = c & 31, ob = rr * 64 + cc * 2; return st * 1024 + (ob ^ (((ob >> 9) & 1) << 5)); }
__host__ __device__ __forceinline__ void stage_rc(int b, int& R, int& C) { const int st = b / 1024, sb = b % 1024, swz = sb ^ (((sb >> 9) & 1) << 5); R = (st >> 1) * 16 + swz / 64; C = (st & 1) * 32 + (swz % 64) / 2; }
__host__ __device__ __forceinline__ int perm32(int rho) { const int n = rho >> 4, i = rho & 15; return 8 * (i >> 2) + 4 * n + (i & 3); }

struct Unit { int pm, pn; };
struct Gemm { const bf16_t* A; const bf16_t* Bt; int M, N, K; };

struct StaticOrder {
    int nM, nN, nwg, G, c;
    __host__ __device__ __forceinline__ void init(int M, int N, int G_, int c_) { nM = M / BM; nN = N / BM; nwg = nM * nN; G = G_; c = c_; }
    __host__ __device__ __forceinline__ bool next(int i, Unit& u) const {
        const long L = (long)i * G + c; if (L >= nwg) return false;
        int wgid = (int)L; { const int q = nwg / NXCD, r = nwg % NXCD, xcd = wgid % NXCD, off = wgid / NXCD; wgid = (xcd < r ? xcd * (q + 1) : r * (q + 1) + (xcd - r) * q) + off; }
        const int nig = WGM * nN, gid = wgid / nig, fm = gid * WGM, gsz = (nM - fm) < WGM ? (nM - fm) : WGM;
        u.pm = fm + ((wgid % nig) % gsz); u.pn = (wgid % nig) / gsz; return true;
    }
    __device__ __forceinline__ void a_ready(const Unit&) const {}
    __device__ __forceinline__ void done(const Unit&) const {}
};


__device__ __forceinline__ unsigned cvt_pk_bf16(float lo, float hi) { unsigned r; asm volatile("v_cvt_pk_bf16_f32 %0, %1, %2" : "=v"(r) : "v"(lo), "v"(hi)); return r; }
__device__ __forceinline__ u32x4 pack8(const f32x4 v0, const f32x4 v1) { u32x4 w; w.x = cvt_pk_bf16(v0[0], v0[1]); w.y = cvt_pk_bf16(v0[2], v0[3]); w.z = cvt_pk_bf16(v1[0], v1[1]); w.w = cvt_pk_bf16(v1[2], v1[3]); return w; }
__device__ __forceinline__ float bflo(unsigned w) { return __uint_as_float(w << 16); }
__device__ __forceinline__ float bfhi(unsigned w) { return __uint_as_float(w & 0xffff0000u); }
__device__ __forceinline__ float sigm(float v) { return __builtin_amdgcn_rcpf(1.0f + __builtin_amdgcn_exp2f(v * -1.4426950408889634f)); }
__device__ __forceinline__ f32x4 sigm4(const f32x4 v) { return (f32x4){sigm(v[0]), sigm(v[1]), sigm(v[2]), sigm(v[3])}; }

__device__ __forceinline__ float sum_fq(float v) {
    { const auto s_ = __builtin_amdgcn_permlane16_swap(__float_as_uint(v), __float_as_uint(v), false, false); v = __uint_as_float(s_[0]) + __uint_as_float(s_[1]); }
    { const auto s_ = __builtin_amdgcn_permlane32_swap(__float_as_uint(v), __float_as_uint(v), false, false); v = __uint_as_float(s_[0]) + __uint_as_float(s_[1]); }
    return v;
}
struct EpiIn {
    static constexpr int PROBE_ID = 1;
    static constexpr bool PERM = true, AFTER_DRAIN = false; static constexpr int MID_T = 0;
    const float* rstd; bf16_t* QKVG; size_t stride4; bf16_t* Z; bf16_t* SG; size_t strideSG; float c2;
    __device__ __forceinline__ void operator()(const f32x4 (&acc)[2][2][4][2], const Unit& u, int wr, int wc, int fr, int fq) const {
        int t_l = (int)__builtin_amdgcn_mbcnt_hi(~0u, __builtin_amdgcn_mbcnt_lo(~0u, 0u)); asm volatile("" : "+v"(t_l)); fr = t_l & 15; fq = t_l >> 4;
        const int row0 = u.pm * BM + wr * 64 + fr; const int cl = wc * 32 + 8 * fq, pn = u.pn;
        if (pn < 8) {
            bf16_t* base = QKVG + (size_t)(pn >> 1) * stride4; const int colt = (pn & 1) * 256 + cl; const float s0 = pn < 2 ? c2 : 1.f;
#pragma unroll
            for (int ai = 0; ai < 2; ++ai)
#pragma unroll
                for (int m = 0; m < 4; ++m) { const int row = row0 + ai * HALF + m * 16; const float sc = rstd[row] * s0; bf16_t* rowp = base + (size_t)row * 512 + colt;
#pragma unroll
                    for (int bj = 0; bj < 2; ++bj) *(u32x4*)(rowp + bj * HALF) = pack8(acc[ai][bj][m][0] * sc, acc[ai][bj][m][1] * sc);
                    asm volatile("" ::: "memory"); }
        } else if (pn < 12) {
            const int colt = (pn - 8) * 128 + cl;
#pragma unroll
            for (int ai = 0; ai < 2; ++ai)
#pragma unroll
                for (int m = 0; m < 4; ++m) { const int row = row0 + ai * HALF + m * 16; const float r = rstd[row], sc = r * r;
                    *(u32x4*)(Z + (size_t)row * 512 + colt) = pack8(acc[ai][0][m][0] * acc[ai][1][m][0] * sc, acc[ai][0][m][1] * acc[ai][1][m][1] * sc);
                    asm volatile("" ::: "memory"); }
        }
    }
};
struct EpiGate {
    static constexpr int PROBE_ID = 8;
    static constexpr bool PERM = true, AFTER_DRAIN = false; static constexpr int MID_T = 0;
    const float* rstd; bf16_t* SG; size_t strideSG; float wsc;
    __device__ __forceinline__ void operator()(const f32x4 (&acc)[2][2][4][2], const Unit& u, int wr, int wc, int fr, int fq) const {
        int t_l = (int)__builtin_amdgcn_mbcnt_hi(~0u, __builtin_amdgcn_mbcnt_lo(~0u, 0u)); asm volatile("" : "+v"(t_l)); fr = t_l & 15; fq = t_l >> 4;
        const int row0 = u.pm * BM + wr * 64 + fr; const int cl = wc * 32 + 8 * fq;
        {
            const int colt = u.pn * 128 + cl;
#pragma unroll
            for (int ai = 0; ai < 2; ++ai)
#pragma unroll
                for (int m = 0; m < 4; ++m) { const int row = row0 + ai * HALF + m * 16; const float r = rstd[row] * wsc;
                    f32x4 ra[2], sc_[2];
#pragma unroll
                    for (int n = 0; n < 2; ++n) {
#pragma unroll
                        for (int e = 0; e < 4; ++e) { const float ea = __builtin_amdgcn_exp2f(acc[ai][0][m][n][e] * r * -1.4426950408889634f), ec = __builtin_amdgcn_exp2f(acc[ai][1][m][n][e] * r * -1.4426950408889634f);
                            sc_[n][e] = __builtin_amdgcn_rcpf(1.0f + ec); ra[n][e] = (1.0f + ec) * __builtin_amdgcn_rcpf(1.0f + ea); } }
                    *(u32x4*)(SG + (size_t)row * 1024 + colt) = pack8(ra[0], ra[1]); *(u32x4*)(SG + strideSG + (size_t)row * 1024 + colt) = pack8(sc_[0], sc_[1]);
                    asm volatile("" ::: "memory"); }
        }
    }
};
struct EpiPlain {
    static constexpr int PROBE_ID = 2;
    static constexpr bool PERM = true, AFTER_DRAIN = false; static constexpr int MID_T = 0;
    bf16_t* O; int ldc;
    __device__ __forceinline__ void operator()(const f32x4 (&acc)[2][2][4][2], const Unit& u, int wr, int wc, int fr, int fq) const {
        int t_l = (int)__builtin_amdgcn_mbcnt_hi(~0u, __builtin_amdgcn_mbcnt_lo(~0u, 0u)); asm volatile("" : "+v"(t_l)); fr = t_l & 15; fq = t_l >> 4;
        const int row0 = u.pm * BM + wr * 64 + fr; const int col0 = u.pn * BM + wc * 32 + 8 * fq;
#pragma unroll
        for (int ai = 0; ai < 2; ++ai)
#pragma unroll
            for (int m = 0; m < 4; ++m) { bf16_t* rowp = O + (size_t)(row0 + ai * HALF + m * 16) * ldc + col0;
#pragma unroll
                for (int bj = 0; bj < 2; ++bj) *(u32x4*)(rowp + bj * HALF) = pack8(acc[ai][bj][m][0], acc[ai][bj][m][1]); }
    }
};
struct EpiBranch {
    static constexpr int PROBE_ID = 3;
    static constexpr bool PERM = true, AFTER_DRAIN = false; static constexpr int MID_T = 8;
    const bf16_t *SGA, *SGC; bf16_t* MG;
    __device__ __forceinline__ void mid(f32x4 (&acc)[2][2][4][2], const Unit& u, int wr, int wc, int fr, int fq) const {
        int t_l = (int)__builtin_amdgcn_mbcnt_hi(~0u, __builtin_amdgcn_mbcnt_lo(~0u, 0u)); asm volatile("" : "+v"(t_l)); fr = t_l & 15; fq = t_l >> 4;
        const int row0 = u.pm * BM + wr * 64 + fr; const int col0 = u.pn * BM + wc * 32 + 8 * fq;
#pragma unroll
        for (int ai = 0; ai < 2; ++ai) {
            u32x4 a[4][2];
#pragma unroll
            for (int m = 0; m < 4; ++m)
#pragma unroll
                for (int bj = 0; bj < 2; ++bj) a[m][bj] = *(const u32x4*)(SGA + (size_t)(row0 + ai * HALF + m * 16) * 1024 + col0 + bj * HALF);
#pragma unroll
            for (int m = 0; m < 4; ++m)
#pragma unroll
                for (int bj = 0; bj < 2; ++bj) { const u32x4 av = a[m][bj];
                    acc[ai][bj][m][0] *= (f32x4){bflo(av[0]), bfhi(av[0]), bflo(av[1]), bfhi(av[1])}; acc[ai][bj][m][1] *= (f32x4){bflo(av[2]), bfhi(av[2]), bflo(av[3]), bfhi(av[3])}; }
            asm volatile("" ::: "memory");
        }
    }
    __device__ __forceinline__ void operator()(const f32x4 (&acc)[2][2][4][2], const Unit& u, int wr, int wc, int fr, int fq) const {
        int t_l = (int)__builtin_amdgcn_mbcnt_hi(~0u, __builtin_amdgcn_mbcnt_lo(~0u, 0u)); asm volatile("" : "+v"(t_l)); fr = t_l & 15; fq = t_l >> 4;
        const int row0 = u.pm * BM + wr * 64 + fr; const int col0 = u.pn * BM + wc * 32 + 8 * fq;
#pragma unroll
        for (int ai = 0; ai < 2; ++ai) {
            u32x4 c[4][2];
#pragma unroll
            for (int m = 0; m < 4; ++m)
#pragma unroll
                for (int bj = 0; bj < 2; ++bj) c[m][bj] = *(const u32x4*)(SGC + (size_t)(row0 + ai * HALF + m * 16) * 1024 + col0 + bj * HALF);
#pragma unroll
            for (int m = 0; m < 4; ++m)
#pragma unroll
                for (int bj = 0; bj < 2; ++bj) { const u32x4 cv = c[m][bj];
                    const f32x4 s0 = {bflo(cv[0]), bfhi(cv[0]), bflo(cv[1]), bfhi(cv[1])}, s1 = {bflo(cv[2]), bfhi(cv[2]), bflo(cv[3]), bfhi(cv[3])};
                    *(u32x4*)(MG + (size_t)(row0 + ai * HALF + m * 16) * 1024 + col0 + bj * HALF) = pack8(acc[ai][bj][m][0] * s0, acc[ai][bj][m][1] * s1); }
            asm volatile("" ::: "memory");
        }
    }
};
struct EpiOut {
    static constexpr int PROBE_ID = 4;
    static constexpr bool PERM = true, AFTER_DRAIN = false; static constexpr int MID_T = 0;
    const bf16_t* XBin; bf16_t* XB1; float* SS2;
    __device__ __forceinline__ void operator()(const f32x4 (&acc)[2][2][4][2], const Unit& u, int wr, int wc, int fr, int fq) const {
        int t_l = (int)__builtin_amdgcn_mbcnt_hi(~0u, __builtin_amdgcn_mbcnt_lo(~0u, 0u)); asm volatile("" : "+v"(t_l)); fr = t_l & 15; fq = t_l >> 4;
        const int row0 = u.pm * BM + wr * 64 + fr; const int col0 = u.pn * BM + wc * 32 + 8 * fq;
#pragma unroll
        for (int ai = 0; ai < 2; ++ai) {
            u32x4 xq[4][2];
#pragma unroll
            for (int m = 0; m < 4; ++m)
#pragma unroll
                for (int bj = 0; bj < 2; ++bj) xq[m][bj] = *(const u32x4*)(XBin + (size_t)(row0 + ai * HALF + m * 16) * 1024 + col0 + bj * HALF);
#pragma unroll
            for (int m = 0; m < 4; ++m) { const int row = row0 + ai * HALF + m * 16; float ss = 0.f;
#pragma unroll
                for (int bj = 0; bj < 2; ++bj) { const u32x4 q = xq[m][bj];
                    const f32x4 v0 = acc[ai][bj][m][0] + (f32x4){bflo(q[0]), bfhi(q[0]), bflo(q[1]), bfhi(q[1])}, v1 = acc[ai][bj][m][1] + (f32x4){bflo(q[2]), bfhi(q[2]), bflo(q[3]), bfhi(q[3])};
                    *(u32x4*)(XB1 + (size_t)row * 1024 + col0 + bj * HALF) = pack8(v0, v1);
                    ss += (v0[0] * v0[0] + v0[1] * v0[1]) + (v0[2] * v0[2] + v0[3] * v0[3]) + (v1[0] * v1[0] + v1[1] * v1[1]) + (v1[2] * v1[2] + v1[3] * v1[3]); }
                ss = sum_fq(ss);
                if (fq == 0) SS2[(size_t)row * 16 + u.pn * 4 + wc] = ss; }
            asm volatile("" ::: "memory");
        }
    }
};
struct EpiPle {
    static constexpr int PROBE_ID = 7;
    static constexpr bool PERM = true, AFTER_DRAIN = false; static constexpr int MID_T = 0;
    const float* SS3; const bf16_t* PP; const bf16_t* XB2; bf16_t* XB3; float* SS4; float eps; float wsc; const PG8_LAS float* rtab;
    __device__ __forceinline__ void operator()(const f32x4 (&acc)[2][2][4][2], const Unit& u, int wr, int wc, int fr, int fq) const {
        int t_l = (int)__builtin_amdgcn_mbcnt_hi(~0u, __builtin_amdgcn_mbcnt_lo(~0u, 0u)); asm volatile("" : "+v"(t_l)); fr = t_l & 15; fq = t_l >> 4;
        const int row0 = u.pm * BM + wr * 64 + fr; const int col0 = u.pn * BM + wc * 32 + 8 * fq;
#pragma unroll
        for (int ah = 0; ah < 4; ++ah) {
            const int ai = ah >> 1, m0 = (ah & 1) * 2;
            u32x4 pv[2][2], xb[2][2]; float rr[2];
#pragma unroll
            for (int mm = 0; mm < 2; ++mm) { const int m = m0 + mm; const int row = row0 + ai * HALF + m * 16;
#pragma unroll
                for (int bj = 0; bj < 2; ++bj) { const size_t off = (size_t)row * 1024 + col0 + bj * HALF; pv[mm][bj] = *(const u32x4*)(PP + off); xb[mm][bj] = *(const u32x4*)(XB2 + off); }
                if (rtab) rr[mm] = rtab[wr * 64 + fr + ai * HALF + m * 16];
                else { const f32x4* sp = (const f32x4*)(SS3 + (size_t)row * 16); const f32x4 q0 = sp[0], q1 = sp[1]; rr[mm] = 1.0f / sqrtf((((q0[0] + q0[1]) + (q0[2] + q0[3])) + ((q1[0] + q1[1]) + (q1[2] + q1[3]))) * (1.0f / 1024.0f) + eps); } }
#pragma unroll
            for (int mm = 0; mm < 2; ++mm) { const int m = m0 + mm; const int row = row0 + ai * HALF + m * 16; const float r = rr[mm] * wsc; float ss = 0.f;
#pragma unroll
                for (int bj = 0; bj < 2; ++bj) { const u32x4 c = pv[mm][bj], xq = xb[mm][bj]; const size_t off = (size_t)row * 1024 + col0 + bj * HALF;
                    const f32x4 p0 = {bflo(c[0]), bfhi(c[0]), bflo(c[1]), bfhi(c[1])}, p1 = {bflo(c[2]), bfhi(c[2]), bflo(c[3]), bfhi(c[3])};
                    const f32x4 x0 = {bflo(xq[0]), bfhi(xq[0]), bflo(xq[1]), bfhi(xq[1])}, x1 = {bflo(xq[2]), bfhi(xq[2]), bflo(xq[3]), bfhi(xq[3])};
                    const f32x4 v0 = x0 + sigm4(acc[ai][bj][m][0] * r) * p0, v1 = x1 + sigm4(acc[ai][bj][m][1] * r) * p1;
                    *(u32x4*)(XB3 + off) = pack8(v0, v1);
                    ss += (v0[0] * v0[0] + v0[1] * v0[1]) + (v0[2] * v0[2] + v0[3] * v0[3]) + (v1[0] * v1[0] + v1[1] * v1[1]) + (v1[2] * v1[2] + v1[3] * v1[3]); }
                ss = sum_fq(ss);
                if (fq == 0) SS4[(size_t)row * 16 + u.pn * 4 + wc] = ss; }
            asm volatile("" ::: "memory");
        }
    }
};

__device__ __forceinline__ float vmaxf(float a, float b) { float r; asm("v_max_f32_e32 %0, %1, %2" : "=v"(r) : "v"(a), "v"(b)); return r; }
__device__ __forceinline__ float vminf(float a, float b) { float r; asm("v_min_f32_e32 %0, %1, %2" : "=v"(r) : "v"(a), "v"(b)); return r; }
__device__ __forceinline__ void sort16_desc(float (&a)[16]) {
#define TK_CE(i, j) do { const float hi_ = vmaxf(a[i], a[j]), lo_ = vminf(a[i], a[j]); a[i] = hi_; a[j] = lo_; } while (0)
    TK_CE(0, 13); TK_CE(1, 12); TK_CE(2, 15); TK_CE(3, 14); TK_CE(4, 8); TK_CE(5, 6); TK_CE(7, 11); TK_CE(9, 10);
    TK_CE(0, 5); TK_CE(1, 7); TK_CE(2, 9); TK_CE(3, 4); TK_CE(6, 13); TK_CE(8, 14); TK_CE(10, 15); TK_CE(11, 12);
    TK_CE(0, 1); TK_CE(2, 3); TK_CE(4, 5); TK_CE(6, 8); TK_CE(7, 9); TK_CE(10, 11); TK_CE(12, 13); TK_CE(14, 15);
    TK_CE(0, 2); TK_CE(1, 3); TK_CE(4, 10); TK_CE(5, 11); TK_CE(6, 7); TK_CE(8, 9); TK_CE(12, 14); TK_CE(13, 15);
    TK_CE(1, 2); TK_CE(3, 12); TK_CE(4, 6); TK_CE(5, 7); TK_CE(8, 10); TK_CE(9, 11); TK_CE(13, 14);
    TK_CE(1, 4); TK_CE(2, 6); TK_CE(5, 8); TK_CE(7, 10); TK_CE(9, 13); TK_CE(11, 14);
    TK_CE(2, 4); TK_CE(3, 6); TK_CE(9, 12); TK_CE(11, 13);
    TK_CE(3, 5); TK_CE(6, 8); TK_CE(7, 9); TK_CE(10, 12);
    TK_CE(3, 4); TK_CE(5, 6); TK_CE(7, 8); TK_CE(9, 10); TK_CE(11, 12);
    TK_CE(6, 7); TK_CE(8, 9);
#undef TK_CE
}
template <int L> __device__ __forceinline__ void merge16(float (&a)[16], const float (&b)[16]) {
#pragma unroll
    for (int i = 0; i < 16; ++i) if (15 - i < L) a[i] = vmaxf(a[i], b[15 - i]);
#pragma unroll
    for (int j = 8; j > 0; j >>= 1)
#pragma unroll
        for (int i = 0; i < 16; ++i) { const int l = i ^ j; if (l > i) { const float hi = vmaxf(a[i], a[l]), lo = vminf(a[i], a[l]); a[i] = hi; a[l] = lo; } }
}
struct EpiTopK {
    static constexpr int PROBE_ID = 5;
    static constexpr bool PERM = true, AFTER_DRAIN = true; static constexpr int MID_T = 0;
    static constexpr int RS = 260;
    const float* SS2; unsigned short* IDS; float* GATES; float eps;
    __device__ __forceinline__ void fused(f32x4 (&acc)[2][2][4][2], const Unit& u, int wr, int wc, int fr, int fq, PG8_LAS unsigned char* lds, int wid, int lane) const {
        PG8_LAS float* S = (PG8_LAS float*)lds;
        const int tid = wid * 64 + lane, row = tid & 127, grp = tid >> 7, half = grp >> 1, part = grp & 1;
#define TK_BAR() do { asm volatile("s_waitcnt lgkmcnt(0)" ::: "memory"); __builtin_amdgcn_s_barrier(); asm volatile("" ::: "memory"); } while (0)
#ifdef MK_PROBE_TOPK2
        for (int rep_ = 0; rep_ < MK_PROBE_TOPK2; ++rep_)
#endif
#pragma unroll
        for (int ai = 0; ai < 2; ++ai) {
#pragma unroll
            for (int m = 0; m < 4; ++m)
#pragma unroll
                for (int bj = 0; bj < 2; ++bj)
#pragma unroll
                    for (int n = 0; n < 2; ++n) *(PG8_LAS f32x4*)(S + (wr * 64 + m * 16 + fr) * RS + bj * HALF + wc * 32 + 8 * fq + 4 * n) = acc[ai][bj][m][n];
            TK_BAR();
            float T[16];
#ifdef MK_PROBE_TK1
            for (int rep1_ = 0; rep1_ < MK_PROBE_TK1; ++rep1_)
#endif
#pragma unroll
            for (int b = 0; b < 4; ++b) {
                float c[16];
#pragma unroll
                for (int q = 0; q < 4; ++q) { const f32x4 v = *(const PG8_LAS f32x4*)(S + row * RS + half * 128 + part * 64 + b * 16 + q * 4);
#pragma unroll
                    for (int e = 0; e < 4; ++e) c[q * 4 + e] = __uint_as_float((__float_as_uint(v[e]) & ~127u) | (unsigned)(part * 64 + b * 16 + q * 4 + e)); }
                sort16_desc(c);
                if (b == 0) {
#pragma unroll
                    for (int i = 0; i < 16; ++i) T[i] = c[i];
                } else merge16<16>(T, c);
            }
            TK_BAR();
#pragma unroll
            for (int q = 0; q < 4; ++q) *(PG8_LAS f32x4*)(S + tid * 16 + q * 4) = (f32x4){T[q * 4], T[q * 4 + 1], T[q * 4 + 2], T[q * 4 + 3]};
            TK_BAR();
            if (part == 0) {
                float c[16];
#pragma unroll
                for (int q = 0; q < 4; ++q) { const f32x4 v = *(const PG8_LAS f32x4*)(S + (tid + 128) * 16 + q * 4); c[q * 4] = v[0]; c[q * 4 + 1] = v[1]; c[q * 4 + 2] = v[2]; c[q * 4 + 3] = v[3]; }
                merge16<16>(T, c);
            }
            TK_BAR();
            if (part == 0) {
#pragma unroll
                for (int q = 0; q < 4; ++q) *(PG8_LAS f32x4*)(S + tid * 16 + q * 4) = (f32x4){T[q * 4], T[q * 4 + 1], T[q * 4 + 2], T[q * 4 + 3]};
            }
            TK_BAR();
#ifdef MK_PROBE_TK3
            for (int rep3_ = 0; rep3_ < MK_PROBE_TK3; ++rep3_)
#endif
            if (tid < 128) {
                float a1[16], a2[16];
#pragma unroll
                for (int q = 0; q < 4; ++q) { const f32x4 v = *(const PG8_LAS f32x4*)(S + (tid + 256) * 16 + q * 4);
#pragma unroll
                    for (int e = 0; e < 4; ++e) a2[q * 4 + e] = __uint_as_float(__float_as_uint(v[e]) & ~127u); }
#pragma unroll
                for (int i = 0; i < 16; ++i) a1[i] = __uint_as_float(__float_as_uint(T[i]) & ~127u);
#define TK_SUM(i, j) __uint_as_float((__float_as_uint(a1[i] + a2[j]) & ~255u) | (unsigned)((i) * 16 + (j)))
                float R[16], C[16];
#pragma unroll
                for (int j = 0; j < 16; ++j) R[j] = TK_SUM(0, j);
#pragma unroll
                for (int i = 1; i < 16; ++i) C[i - 1] = TK_SUM(i, 0);
                C[15] = 0.f;
                merge16<15>(R, C);
                C[0] = TK_SUM(1, 1); C[1] = TK_SUM(1, 2); C[2] = TK_SUM(1, 3); C[3] = TK_SUM(1, 4); C[4] = TK_SUM(1, 5); C[5] = TK_SUM(1, 6); C[6] = TK_SUM(1, 7);
                C[7] = TK_SUM(2, 1); C[8] = TK_SUM(2, 2); C[9] = TK_SUM(2, 3); C[10] = TK_SUM(2, 4); C[11] = TK_SUM(3, 1); C[12] = TK_SUM(3, 2); C[13] = TK_SUM(3, 3);
                C[14] = TK_SUM(4, 1); C[15] = TK_SUM(4, 2);
                sort16_desc(C);
                merge16<16>(R, C);
                C[0] = TK_SUM(5, 1); C[1] = TK_SUM(6, 1); C[2] = TK_SUM(7, 1);
                merge16<3>(R, C);
#undef TK_SUM
                const int rowg = u.pm * BM + ai * HALF + row;
                const f32x4* ssp = (const f32x4*)(SS2 + (size_t)rowg * 16); const f32x4 s0 = ssp[0], s1 = ssp[1], s2 = ssp[2], s3 = ssp[3];
                const float ssum = ((s0[0] + s0[1]) + (s0[2] + s0[3])) + ((s1[0] + s1[1]) + (s1[2] + s1[3])) + ((s2[0] + s2[1]) + (s2[2] + s2[3])) + ((s3[0] + s3[1]) + (s3[2] + s3[3]));
                const float rl = 1.4426950408889634f / sqrtf(ssum * (1.0f / 1024.0f) + eps);
                float ev[16], esum = 0.f; int idv[16];
#pragma unroll
                for (int r = 0; r < 16; ++r) { ev[r] = __builtin_amdgcn_exp2f((R[r] - R[0]) * rl); esum += ev[r];
                    const unsigned code = __float_as_uint(R[r]) & 255u;
                    const unsigned k1 = __float_as_uint(S[tid * 16 + (code >> 4)]) & 127u, k2 = __float_as_uint(S[(tid + 256) * 16 + (code & 15u)]) & 127u;
                    idv[r] = (int)(k1 * 128u + k2); }
                const float inv = 1.0f / esum;
                unsigned short* ip = IDS + (size_t)rowg * 128 + u.pn * 16; float* gp = GATES + (size_t)rowg * 128 + u.pn * 16;
#pragma unroll
                for (int q = 0; q < 2; ++q) { u32x4 w; w.x = (unsigned)idv[q * 8] | ((unsigned)idv[q * 8 + 1] << 16); w.y = (unsigned)idv[q * 8 + 2] | ((unsigned)idv[q * 8 + 3] << 16); w.z = (unsigned)idv[q * 8 + 4] | ((unsigned)idv[q * 8 + 5] << 16); w.w = (unsigned)idv[q * 8 + 6] | ((unsigned)idv[q * 8 + 7] << 16);
                    *(u32x4*)(ip + q * 8) = w; }
#pragma unroll
                for (int q = 0; q < 4; ++q) *(f32x4*)(gp + q * 4) = (f32x4){ev[q * 4] * inv, ev[q * 4 + 1] * inv, ev[q * 4 + 2] * inv, ev[q * 4 + 3] * inv};
            }
            TK_BAR();
        }
#undef TK_BAR
    }
};
template <class Epi, class Sched, bool ALIGN_EPI = false, bool SP2 = false, bool FP8 = false>
__device__ __forceinline__ void gemm_phase(PG8_LAS unsigned char* lds, const Gemm g, const Sched& S, const Epi& E, const int wid_in) {
    int lane_l = (int)__builtin_amdgcn_mbcnt_hi(~0u, __builtin_amdgcn_mbcnt_lo(~0u, 0u)); asm volatile("" : "+v"(lane_l));
    const int wid = wid_in, lane = lane_l, tid = wid * 64 + lane, wr = wid >> 2, wc = wid & 3, fr = lane & 15, fq = lane >> 4;
    const int K = g.K, nt = K / BK;
    unsigned voffA, voffB;
    { int R, C; stage_rc(tid * 16, R, C); const int Rb = Epi::PERM ? ((R & ~31) + perm32(R & 31)) : R;
        voffA = (unsigned)(R * K + C) * 2u; voffB = (unsigned)(Rb * K + C) * 2u; }
    const size_t rstep64 = (size_t)64 * K * 2;
    const size_t kstep = (size_t)(BK * 2);
    const size_t hstep = (size_t)HALF * K * 2;
    const size_t tstep = 2 * hstep;
    const unsigned ldsw = (unsigned)wid * 1024u;
    const int aoff = lds_byte(wr * 64 + fr, FP8 ? fq * 16 : fq * 8), boff = lds_byte(wc * 32 + fr, FP8 ? fq * 16 : fq * 8);
    constexpr int KSTR = FP8 ? 16 : 1024;
#define PG8_SA(b, h) (((b) * 2 + (h)) * HTB)
#define PG8_SB(b, h) ((4 + (b) * 2 + (h)) * HTB)
#define PG8_STAGE(bufoff, gbase, voff) do { _Pragma("unroll") for (int _i = 0; _i < 2; ++_i) \
        __builtin_amdgcn_global_load_lds((const unsigned*)((const char*)(gbase) + _i * rstep64 + (voff)), (PG8_LAS unsigned*)(lds + (bufoff) + ldsw + _i * 8192), 16, 0, 0); } while (0)
#define PG8_LDA(dst, b, h) do { _Pragma("unroll") for (int m = 0; m < 4; ++m) _Pragma("unroll") for (int k = 0; k < 2; ++k) dst[m][k] = *(const PG8_LAS v4i_t*)(lds + PG8_SA(b, h) + aoff + m * 2048 + k * KSTR); } while (0)
#define PG8_LDB(dst, b, h) do { _Pragma("unroll") for (int n = 0; n < 2; ++n) _Pragma("unroll") for (int k = 0; k < 2; ++k) dst[n][k] = *(const PG8_LAS v4i_t*)(lds + PG8_SB(b, h) + boff + n * 2048 + k * KSTR); } while (0)
#define PG8_MMA(ai, bj, At, Bt) do { __builtin_amdgcn_s_setprio(1); _Pragma("unroll") for (int m = 0; m < 4; ++m) _Pragma("unroll") for (int n = 0; n < 2; ++n) { \
        if constexpr (FP8) { const v8i_t b8_ = __builtin_shufflevector(Bt[n][0], Bt[n][1], 0, 1, 2, 3, 4, 5, 6, 7), a8_ = __builtin_shufflevector(At[m][0], At[m][1], 0, 1, 2, 3, 4, 5, 6, 7); \
            asm volatile("v_mfma_scale_f32_16x16x128_f8f6f4 %0, %1, %2, %0, %3, %3 op_sel_hi:[0,0,0]" : "+v"(acc[ai][bj][m][n]) : "v"(b8_), "v"(a8_), "v"(mxs_)); }     \
        else { _Pragma("unroll") for (int k = 0; k < 2; ++k) acc[ai][bj][m][n] = __builtin_amdgcn_mfma_f32_16x16x32_bf16(__builtin_bit_cast(bf16x8, Bt[n][k]), __builtin_bit_cast(bf16x8, At[m][k]), acc[ai][bj][m][n], 0, 0, 0); } } \
        __builtin_amdgcn_s_setprio(0); } while (0)
#define PG8_WAIT_V(n) asm volatile("s_waitcnt vmcnt(" #n ")" ::: "memory")
#define PG8_WAIT_L(n) asm volatile("s_waitcnt lgkmcnt(" #n ")" ::: "memory")
#define PG8_BAR __builtin_amdgcn_s_barrier()
#define PG8_SCHED __builtin_amdgcn_sched_barrier(0)
    Unit cur, nxt; int ui = 0;
    if (!S.next(0, cur)) return;
    f32x4 acc[2][2][4][2];
#pragma unroll
    for (int a = 0; a < 2; ++a)
#pragma unroll
        for (int b = 0; b < 2; ++b)
#pragma unroll
            for (int m = 0; m < 4; ++m)
#pragma unroll
                for (int n = 0; n < 2; ++n) acc[a][b][m][n] = (f32x4){0.f, 0.f, 0.f, 0.f};
    typedef int v4i_t __attribute__((ext_vector_type(4))); typedef int v8i_t __attribute__((ext_vector_type(8)));
    int mxs_ = 0x7f7f7f7f; asm volatile("" : "+v"(mxs_));
    v4i_t At[4][2], B0[2][2], B1[2][2];
    const char* cA = (const char*)g.A + (size_t)cur.pm * tstep; const char* cB = (const char*)g.Bt + (size_t)cur.pn * tstep;
    S.a_ready(cur);
    if constexpr (SP2) {
        PG8_STAGE(PG8_SB(0, 0), cB, voffB); PG8_STAGE(PG8_SB(0, 1), cB + hstep, voffB); PG8_STAGE(PG8_SA(0, 0), cA, voffA); PG8_STAGE(PG8_SA(0, 1), cA + hstep, voffA);
        if (wr == 1) PG8_BAR;
        PG8_WAIT_V(2); PG8_BAR;
        PG8_STAGE(PG8_SB(1, 0), cB + kstep, voffB); PG8_STAGE(PG8_SA(1, 0), cA + kstep, voffA); PG8_STAGE(PG8_SB(1, 1), cB + hstep + kstep, voffB);
        PG8_WAIT_V(6); PG8_BAR;
    } else {
        PG8_STAGE(PG8_SB(0, 0), cB, voffB); PG8_STAGE(PG8_SA(0, 0), cA, voffA); PG8_STAGE(PG8_SB(0, 1), cB + hstep, voffB); PG8_STAGE(PG8_SA(0, 1), cA + hstep, voffA);
        if (wr == 1) PG8_BAR;
        PG8_WAIT_V(4); PG8_BAR;
        PG8_STAGE(PG8_SB(1, 0), cB + kstep, voffB); PG8_STAGE(PG8_SA(1, 0), cA + kstep, voffA); PG8_STAGE(PG8_SB(1, 1), cB + hstep + kstep, voffB);
        PG8_WAIT_V(6); PG8_BAR;
    }
    for (;;) {
        const bool has_next = S.next(ui + 1, nxt);
        const char* nA = has_next ? (const char*)g.A + (size_t)nxt.pm * tstep : cA; const char* nB = has_next ? (const char*)g.Bt + (size_t)nxt.pn * tstep : cB;
#pragma nounroll
        for (int t = 0; t < nt; t += 2) {
            if constexpr (Epi::MID_T > 0) { if (t == Epi::MID_T) E.mid(acc, cur, wr, wc, fr, fq); }
            const bool last = (t == nt - 2);
            const char* a1 = cA + (size_t)(t + 1) * kstep;
            const char* a2 = last ? nA : cA + (size_t)(t + 2) * kstep; const char* b2 = last ? nB : cB + (size_t)(t + 2) * kstep;
            const char* a3 = a2 + kstep; const char* b3 = b2 + kstep;
            if (last && has_next) S.a_ready(nxt);
            if constexpr (SP2) {
            PG8_LDB(B0, 0, 0); PG8_LDB(B1, 0, 1); PG8_SCHED; PG8_LDA(At, 0, 0); PG8_STAGE(PG8_SA(1, 1), a1 + hstep, voffA);
            PG8_WAIT_V(8); PG8_WAIT_L(0); PG8_BAR; PG8_MMA(0, 0, At, B0); PG8_MMA(0, 1, At, B1); PG8_BAR; PG8_SCHED;
            PG8_LDA(At, 0, 1); PG8_STAGE(PG8_SB(0, 0), b2, voffB); PG8_STAGE(PG8_SB(0, 1), b2 + hstep, voffB); PG8_STAGE(PG8_SA(0, 0), a2, voffA);
            PG8_WAIT_V(8); PG8_WAIT_L(0); PG8_BAR; PG8_MMA(1, 0, At, B0); PG8_MMA(1, 1, At, B1); PG8_BAR; PG8_SCHED;
            PG8_LDB(B0, 1, 0); PG8_LDB(B1, 1, 1); PG8_SCHED; PG8_LDA(At, 1, 0); PG8_STAGE(PG8_SA(0, 1), a2 + hstep, voffA);
            PG8_WAIT_V(8); PG8_WAIT_L(0); PG8_BAR; PG8_MMA(0, 0, At, B0); PG8_MMA(0, 1, At, B1); PG8_BAR; PG8_SCHED;
            PG8_LDA(At, 1, 1); PG8_STAGE(PG8_SB(1, 0), b3, voffB); PG8_STAGE(PG8_SB(1, 1), b3 + hstep, voffB); PG8_STAGE(PG8_SA(1, 0), a3, voffA);
            PG8_WAIT_V(8); PG8_WAIT_L(0); PG8_BAR; PG8_MMA(1, 0, At, B0); PG8_MMA(1, 1, At, B1); PG8_BAR; PG8_SCHED;
            } else {
            PG8_LDB(B0, 0, 0); PG8_SCHED; PG8_LDA(At, 0, 0); PG8_STAGE(PG8_SA(1, 1), a1 + hstep, voffA);
            PG8_WAIT_L(8); PG8_BAR; PG8_WAIT_L(0); PG8_MMA(0, 0, At, B0); PG8_BAR; PG8_SCHED;
            PG8_LDB(B1, 0, 1); PG8_STAGE(PG8_SB(0, 0), b2, voffB);
            PG8_BAR; PG8_WAIT_L(0); PG8_MMA(0, 1, At, B1); PG8_BAR;
            PG8_LDA(At, 0, 1); PG8_STAGE(PG8_SA(0, 0), a2, voffA);
            PG8_BAR; PG8_WAIT_L(0); PG8_MMA(1, 0, At, B0); PG8_BAR; PG8_SCHED;
            PG8_STAGE(PG8_SB(0, 1), b2 + hstep, voffB);
            PG8_WAIT_V(6); PG8_BAR; PG8_MMA(1, 1, At, B1); PG8_BAR;
            PG8_LDB(B0, 1, 0); PG8_SCHED; PG8_LDA(At, 1, 0); PG8_STAGE(PG8_SA(0, 1), a2 + hstep, voffA);
            PG8_WAIT_L(8); PG8_BAR; PG8_WAIT_L(0); PG8_MMA(0, 0, At, B0); PG8_BAR; PG8_SCHED;
            PG8_LDB(B1, 1, 1); PG8_STAGE(PG8_SB(1, 0), b3, voffB);
            PG8_BAR; PG8_WAIT_L(0); PG8_MMA(0, 1, At, B1); PG8_BAR;
            PG8_LDA(At, 1, 1); PG8_STAGE(PG8_SA(1, 0), a3, voffA);
            PG8_BAR; PG8_WAIT_L(0); PG8_MMA(1, 0, At, B0); PG8_BAR; PG8_SCHED;
            PG8_STAGE(PG8_SB(1, 1), b3 + hstep, voffB);
            PG8_WAIT_V(6); PG8_BAR; PG8_MMA(1, 1, At, B1); PG8_BAR;
            }
        }
        if constexpr (FP8) asm volatile("s_nop 15\n\ts_nop 7" ::: "memory");
        if constexpr (ALIGN_EPI) { if (wr == 0) PG8_BAR; }
#ifdef MK_PROBE_EPI2
        if constexpr (!Epi::AFTER_DRAIN && Epi::PROBE_ID == MK_PROBE_EPI_ID) { for (int rep_ = 1; rep_ < MK_PROBE_EPI2; ++rep_) E(acc, cur, wr, wc, fr, fq); }
#endif
        if constexpr (!Epi::AFTER_DRAIN) { E(acc, cur, wr, wc, fr, fq); S.done(cur); }
        if (!has_next) break;
#pragma unroll
        for (int a = 0; a < 2; ++a)
#pragma unroll
            for (int b = 0; b < 2; ++b)
#pragma unroll
                for (int m = 0; m < 4; ++m)
#pragma unroll
                    for (int n = 0; n < 2; ++n) acc[a][b][m][n] = (f32x4){0.f, 0.f, 0.f, 0.f};
        cur = nxt; cA = nA; cB = nB; ++ui;
        if constexpr (ALIGN_EPI) { if (wr == 1) PG8_BAR; }
    }
    PG8_WAIT_V(0);
    if constexpr (!ALIGN_EPI) { if (wr == 0) PG8_BAR; }
    PG8_BAR;
    if constexpr (Epi::AFTER_DRAIN) { E.fused(acc, cur, wr, wc, fr, fq, lds, wid, lane); S.done(cur); }
#undef PG8_SA
#undef PG8_SB
#undef PG8_STAGE
#undef PG8_LDA
#undef PG8_LDB
#undef PG8_MMA
#undef PG8_WAIT_V
#undef PG8_WAIT_L
#undef PG8_BAR
#undef PG8_SCHED
}
}
#ifndef PG8_SP2
#define PG8_SP2 true
#endif
#ifndef PG8_ALIGN
#define PG8_ALIGN true
#endif
namespace attn_body {
using bf16=__hip_bfloat16;
using bf16x8=__attribute__((ext_vector_type(8)))short;
using s16x4=__attribute__((ext_vector_type(4)))short;
using f32x16=__attribute__((ext_vector_type(16)))float;
using u32x4=__attribute__((ext_vector_type(4)))unsigned;
using f32x4v=__attribute__((ext_vector_type(4)))float;
constexpr int BATCH=4,NHEAD=8,SEQ=4096,D=64,DM=NHEAD*D,DMO=1024;
constexpr int NW=8,QBLK=32,QB=QBLK*NW,KVBLK=64,NQB=SEQ/QB;
constexpr int ATTN_PITCH=DM, ATTN_UNIT_ROWS=QB;
__device__ __forceinline__ int crow(int r,int hi){return (r&3)+8*(r>>2)+4*hi;}
#define SBAR() __builtin_amdgcn_sched_barrier(0)
__device__ __forceinline__ void cmask(f32x16&p0,f32x16&p1,int jb,int qrel,int hi){
  const float NEG=-INFINITY; int kb=64*jb+4*hi;
  #pragma unroll
  for(int r=0;r<16;++r){int kv=kb+(r&3)+8*(r>>2); if(kv>qrel)p0[r]=NEG; if(kv+32>qrel)p1[r]=NEG;}
}

constexpr int NSLOT=3, SLOTB=8192;
constexpr float SKIP_TH=64.0f;
constexpr int LDS_K=0, LDS_V=NSLOT*SLOTB, LDS_WS=2*NSLOT*SLOTB, LDS_OST=LDS_WS+NW*64*4, LDS_CS=LDS_OST+NW*4096, LDS_BYTES=LDS_CS+SEQ*4+64;
constexpr float C2=0.125f*1.4426950408889634f;
__device__ __forceinline__ void glds16(const void*gsrc,unsigned lds_dst){unsigned keep;
  asm volatile("s_mov_b32 %0, m0\n\ts_mov_b32 m0, %2\n\ts_nop 0\n\tglobal_load_lds_dwordx4 %1, off\n\ts_mov_b32 m0, %0":"=&s"(keep):"v"(gsrc),"s"(lds_dst):"memory");}
__device__ __forceinline__ float max3f(float a,float b,float c){float r;asm("v_max3_f32 %0, %1, %2, %3":"=v"(r):"v"(a),"v"(b),"v"(c));return r;}
__device__ __forceinline__ float max2f(float a,float b){float r;asm("v_max_f32_e32 %0, %1, %2":"=v"(r):"v"(a),"v"(b));return r;}
__device__ __forceinline__ float fadd_s(float a,float b){float r;asm("v_add_f32_e32 %0, %1, %2":"=v"(r):"v"(a),"v"(b));return r;}
__device__ __forceinline__ float fsub_s(float a,float b){float r;asm("v_sub_f32_e32 %0, %1, %2":"=v"(r):"v"(a),"v"(b));return r;}
typedef float f32x2_t __attribute__((ext_vector_type(2))); typedef __bf16 bf16x2_t __attribute__((ext_vector_type(2)));
__device__ __forceinline__ unsigned cvtpk_s(float lo,float hi){f32x2_t v={lo,hi};bf16x2_t b=__builtin_convertvector(v,bf16x2_t);return __builtin_bit_cast(unsigned,b);}
#define WAIT_BAR(N) asm volatile("s_waitcnt vmcnt(" #N ") lgkmcnt(0)\n\ts_barrier":::"memory")

__device__ __forceinline__ void qkt(f32x16&p0,f32x16&p1,const char*Kslot,const bf16x8*qr,const f32x16&c0,const f32x16&c1,int r32,int hi){
  const char*kb=Kslot+hi*1024+r32*16;
  #pragma unroll
  for(int d0=0;d0<4;++d0){
    const bf16x8 b0=*reinterpret_cast<const bf16x8*>(kb+d0*2048);
    const bf16x8 b1=*reinterpret_cast<const bf16x8*>(kb+d0*2048+512);
    if(d0==0){p0=__builtin_amdgcn_mfma_f32_32x32x16_bf16(b0,qr[0],c0,0,0,0);p1=__builtin_amdgcn_mfma_f32_32x32x16_bf16(b1,qr[0],c1,0,0,0);}
    else{p0=__builtin_amdgcn_mfma_f32_32x32x16_bf16(b0,qr[d0],p0,0,0,0);p1=__builtin_amdgcn_mfma_f32_32x32x16_bf16(b1,qr[d0],p1,0,0,0);}}
}
typedef __attribute__((address_space(3))) const char* lds_cptr;
typedef short v4i16_t __attribute__((ext_vector_type(4)));
__device__ __forceinline__ void kload8(bf16x8*kf,lds_cptr kp){
  kf[0]=*(const __attribute__((address_space(3))) bf16x8*)(kp);      kf[1]=*(const __attribute__((address_space(3))) bf16x8*)(kp+512);
  kf[2]=*(const __attribute__((address_space(3))) bf16x8*)(kp+2048); kf[3]=*(const __attribute__((address_space(3))) bf16x8*)(kp+2560);
  kf[4]=*(const __attribute__((address_space(3))) bf16x8*)(kp+4096); kf[5]=*(const __attribute__((address_space(3))) bf16x8*)(kp+4608);
  kf[6]=*(const __attribute__((address_space(3))) bf16x8*)(kp+6144); kf[7]=*(const __attribute__((address_space(3))) bf16x8*)(kp+6656);
}
__device__ __forceinline__ void kload2(bf16x8*kf,lds_cptr kp,int j){ kf[2*j]=*(const __attribute__((address_space(3))) bf16x8*)(kp+j*2048); kf[2*j+1]=*(const __attribute__((address_space(3))) bf16x8*)(kp+j*2048+512); }
__device__ __forceinline__ s16x4 vtr(lds_cptr p){ return __builtin_bit_cast(s16x4,__builtin_amdgcn_ds_read_tr16_b64_v4i16((__attribute__((address_space(3))) v4i16_t*)p)); }
__device__ __forceinline__ float rowmax(const f32x16&p0,const f32x16&p1){
  float a=max3f(p0[0],p0[1],p1[0]),b=max3f(p0[2],p0[3],p1[1]);a=max3f(a,p1[2],p1[3]);
  #pragma unroll
  for(int r=4;r<16;r+=4){a=max3f(a,p0[r],p0[r+1]);b=max3f(b,p0[r+2],p0[r+3]);a=max3f(a,p1[r],p1[r+1]);b=max3f(b,p1[r+2],p1[r+3]);}
  const float m=max2f(a,b);
  auto rr=__builtin_amdgcn_permlane32_swap(__float_as_uint(m),__float_as_uint(m),false,false);
  return max2f(__uint_as_float(rr[0]),__uint_as_float(rr[1]));
}
__device__ __forceinline__ void pv(f32x16*o,int vb,bf16x8 pa0,bf16x8 pa1,bf16x8 pa2,bf16x8 pa3){
  #pragma unroll
  for(int d0=0;d0<2;++d0){s16x4 lo[4],hi[4];
    #pragma unroll
    for(int ks=0;ks<4;++ks){
      asm volatile("ds_read_b64_tr_b16 %0,%1 offset:%c2":"=&v"(lo[ks]):"v"(vb),"i"(d0*4096+ks*1024):"memory");
      asm volatile("ds_read_b64_tr_b16 %0,%1 offset:%c2":"=&v"(hi[ks]):"v"(vb),"i"(d0*4096+ks*1024+512):"memory");}
    asm volatile("s_waitcnt lgkmcnt(0)":::"memory");SBAR();
    #define PK(k) (bf16x8){lo[k][0],lo[k][1],lo[k][2],lo[k][3],hi[k][0],hi[k][1],hi[k][2],hi[k][3]}
    o[d0]=__builtin_amdgcn_mfma_f32_32x32x16_bf16(pa0,PK(0),o[d0],0,0,0);
    o[d0]=__builtin_amdgcn_mfma_f32_32x32x16_bf16(pa1,PK(1),o[d0],0,0,0);
    o[d0]=__builtin_amdgcn_mfma_f32_32x32x16_bf16(pa2,PK(2),o[d0],0,0,0);
    o[d0]=__builtin_amdgcn_mfma_f32_32x32x16_bf16(pa3,PK(3),o[d0],0,0,0);
    #undef PK
  }
}

#ifndef ATTN_STORE16
#define ATTN_STORE16(p,v) (*(u32x4*)(p)=(v))
#endif
template<int THRL> __device__ __forceinline__ void attn_unit(int b,int h,int qb,const bf16*Q,const bf16*__restrict__ K,const bf16*__restrict__ V,bf16*O,const float*__restrict__ LFrow,char*shm){
  int tid_l=threadIdx.x; asm volatile("":"+v"(tid_l));
  const int tid=tid_l,lane=tid&63,r32=lane&31,hi=lane>>5; const int wid=__builtin_amdgcn_readfirstlane(tid>>6);
  const long rowbase=(long)b*SEQ; const int q0=qb*QB;
  const lds_cptr shm3=(lds_cptr)shm;
  typedef __attribute__((address_space(3))) float lds_f32; typedef __attribute__((address_space(3))) f32x4v lds_f32x4;
  lds_f32* const csl=(lds_f32*)(shm3+LDS_CS);
  { const int ncs=q0+QB, i0=tid*8; f32x4v ca={0.f,0.f,0.f,0.f},cb={0.f,0.f,0.f,0.f};
    if(i0<ncs){ca=*(const f32x4v*)(LFrow+i0);cb=*(const f32x4v*)(LFrow+i0+4);}
    ca.y+=ca.x;ca.z+=ca.y;ca.w+=ca.z;cb.x+=ca.w;cb.y+=cb.x;cb.z+=cb.y;cb.w+=cb.z;
    const float tot=cb.w; float inc=tot;
    _Pragma("unroll") for(int o_=1;o_<64;o_<<=1){const float v_=__shfl_up(inc,o_);if(lane>=o_)inc+=v_;}
    if(lane==63)csl[SEQ+wid]=inc;
    asm volatile("s_waitcnt vmcnt(0) lgkmcnt(0)\n\ts_barrier":::"memory");
    float base_=inc-tot;
    _Pragma("unroll") for(int w_=0;w_<NW;++w_){const float t_=csl[SEQ+w_];if(w_<wid)base_+=t_;}
    if(i0<ncs){*(lds_f32x4*)(csl+i0)=ca+base_;*(lds_f32x4*)(csl+i0+4)=cb+base_;}
    asm volatile("s_waitcnt vmcnt(0) lgkmcnt(0)\n\ts_barrier":::"memory"); }
  int ts; { const int NT0=(q0+QB)/KVBLK, cand=2*lane; bool ok=false;
    if(lane<32&&cand<=NT0-4) ok=(cand==0)||(csl[q0]-csl[64*cand-1]<=-SKIP_TH);
    const unsigned long long mk=__ballot(ok); ts=__builtin_amdgcn_readfirstlane(2*(63-__builtin_clzll(mk|1ull))); }
  const bf16*Qw=Q+(rowbase+q0+wid*QBLK)*DM+h*D;
  const bf16*Kh=K+(rowbase+(long)ts*KVBLK)*DM+h*D,*Vh=V+(rowbase+(long)ts*KVBLK)*DM+h*D;
  const unsigned lds0=(unsigned)(uintptr_t)shm;
  float*wsf=(float*)(shm+LDS_WS)+wid*64;
  const bf16*ksrc=Kh+(long)lane*DM+wid*8;
  const bf16*vsrc=Vh+(long)(16*(wid&3)+(lane>>2))*DM+(wid>>2)*32+(lane&3)*8;
  const unsigned kdst=lds0+LDS_K+wid*1024, vdst=lds0+LDS_V+wid*1024;
  #define DMA_K(t,slot) glds16(ksrc+(long)(t)*KVBLK*DM,(unsigned)__builtin_amdgcn_readfirstlane(kdst+(slot)))
  #define DMA_V(t,slot) glds16(vsrc+(long)(t)*KVBLK*DM,(unsigned)__builtin_amdgcn_readfirstlane(vdst+(slot)))
  const int vb0=(int)(lds0+LDS_V)+((lane>>4)&1)*32+(lane&3)*8+(4*hi+((lane&15)>>2))*64;
  const char*Kbase=shm+LDS_K; bf16x8 kf[8];
  const lds_cptr kp0=shm3+LDS_K+hi*1024+r32*16; const lds_cptr vp0=shm3+LDS_V+((lane>>4)&1)*32+(lane&3)*8+(4*hi+((lane&15)>>2))*64;
  const int NT=(q0+QB)/KVBLK-ts;
  const float cq=csl[q0+wid*QBLK+r32];
  const lds_cptr csb=shm3+LDS_CS+hi*16+ts*256;
  #define CINIT(C0,C1,t) do{ _Pragma("unroll") for(int g_=0;g_<4;++g_){ const f32x4v a_=*(const lds_f32x4*)(csb+(t)*256+g_*32), b_=*(const lds_f32x4*)(csb+(t)*256+128+g_*32); \
      C0[4*g_]=cqm-a_.x;C0[4*g_+1]=cqm-a_.y;C0[4*g_+2]=cqm-a_.z;C0[4*g_+3]=cqm-a_.w; C1[4*g_]=cqm-b_.x;C1[4*g_+1]=cqm-b_.y;C1[4*g_+2]=cqm-b_.z;C1[4*g_+3]=cqm-b_.w; } }while(0)
  DMA_K(0,0);DMA_V(0,0);DMA_K(1,SLOTB);
  bf16x8 qr[4];
  #pragma unroll
  for(int d0=0;d0<4;++d0)qr[d0]=*reinterpret_cast<const bf16x8*>(&Qw[(long)r32*DM+d0*16+hi*8]);
  float mhat=0.f,l_reg=0.f,cqm=cq;f32x16 o[2];o[0]=f32x16{};o[1]=f32x16{};
  const int qrel=wid*QBLK+r32;
  #define CMASK(P0,P1,t) do{int jb_=(t)-(NT-4); if(jb_>=0)cmask(P0,P1,jb_,qrel,hi);}while(0)
  bool resc=false;
  #define START(P0,P1) do{ const float rm=rowmax(P0,P1); resc=false; \
    { const float dl=rm; mhat=fadd_s(mhat,dl); \
      _Pragma("unroll") for(int r=0;r<16;++r){P0[r]=fsub_s(P0[r],dl);P1[r]=fsub_s(P1[r],dl);} \
      cqm=cq-mhat; } \
    _Pragma("unroll") for(int r=0;r<16;++r)P0[r]=__builtin_amdgcn_exp2f(P0[r]); }while(0)
  #define RESC() do{ if(resc){ asm volatile("s_waitcnt lgkmcnt(0)":::"memory"); \
      _Pragma("unroll") for(int d_=0;d_<2;++d_) _Pragma("unroll") for(int r=0;r<16;++r)o[d_][r]*=wsf[crow(r,hi)]; } }while(0)
  f32x16 pA0,pA1,pB0,pB1;
  int sl_prev=0,sl_cur=0,sl_next=SLOTB;
  #define ROT() do{sl_prev=sl_cur;sl_cur=sl_next;sl_next=(sl_next==(NSLOT-1)*SLOTB)?0:sl_next+SLOTB;}while(0)
  DMA_K(2,2*SLOTB);
  WAIT_BAR(3);
  { f32x16 ci0,ci1; CINIT(ci0,ci1,0); qkt(pA0,pA1,Kbase,qr,ci0,ci1,r32,hi); } asm volatile("s_nop 15\n\ts_nop 7":"+v"(pA0),"+v"(pA1));CMASK(pA0,pA1,0);
  START(pA0,pA1);
  _Pragma("unroll") for(int r=0;r<16;++r)pA1[r]=__builtin_amdgcn_exp2f(pA1[r]);
  WAIT_BAR(0);
  DMA_K(3,0);DMA_V(1,SLOTB);
  ROT();
  kload8(kf,kp0+sl_cur);
  WAIT_BAR(2);
  s16x4 vlo[8],vhi[8]; u32x4 pw0,pw1,pw2,pw3;
  #define PKW(P,B) cvtpk_s(P[B],P[B+1])
  #define PAF(k) __builtin_bit_cast(bf16x8,pw##k)
  #define VFR(i) (bf16x8){vlo[i][0],vlo[i][1],vlo[i][2],vlo[i][3],vhi[i][0],vhi[i][1],vhi[i][2],vhi[i][3]}
  #define PIN(x) asm volatile("":"+v"(x))
  #define MX3(a,b,c) __builtin_fmaxf(__builtin_fmaxf((a),(b)),(c))
  #define GAPA(MF,A0,A1,A2,A3,W0,W1,PW) do{ MF; sacc+=A0; sacc+=A1; sacc+=A2; sacc+=A3; PIN(sacc); W0; W1; PIN(PW); SBAR(); }while(0)
  #define EX(v) __builtin_amdgcn_exp2f(v)
  #define GAPB(MF,X,B) do{ MF; X[B]=EX(X[B]); X[B+1]=EX(X[B+1]); X[B+2]=EX(X[B+2]); X[B+3]=EX(X[B+3]); PIN(X); SBAR(); }while(0)
  #define VRD(i) do{ vlo[i]=vtr(vp_+(((i)>>2)*4096+((i)&3)*1024)); vhi[i]=vtr(vp_+(((i)>>2)*4096+((i)&3)*1024+512)); }while(0)
  #define KRD(G,j) do{ if(G){ kload2(kf,kp0+sl_next,j); SBAR(); } }while(0)
  #define STEP(C0,C1,P0,P1,t,GK,GV,GL) do{ SBAR(); \
    CINIT(C0,C1,t); SBAR(); \
    const lds_cptr vp_=vp0+sl_prev; \
    VRD(0); SBAR(); float sacc=(P0[0]+P0[1]); \
    GAPA(C0=__builtin_amdgcn_mfma_f32_32x32x16_bf16(kf[0],qr[0],C0,0,0,0), P0[2],P0[3],P0[4],P0[5],     pw0[0]=PKW(P0,0), pw0[1]=PKW(P0,2), pw0); \
    VRD(4); SBAR(); GAPA(C1=__builtin_amdgcn_mfma_f32_32x32x16_bf16(kf[1],qr[0],C1,0,0,0), P0[6],P0[7],P0[8],P0[9],     pw0[2]=PKW(P0,4), pw0[3]=PKW(P0,6), pw0); \
    VRD(1); SBAR(); GAPA(C0=__builtin_amdgcn_mfma_f32_32x32x16_bf16(kf[2],qr[1],C0,0,0,0),   P0[10],P0[11],P0[12],P0[13], pw1[0]=PKW(P0,8), pw1[1]=PKW(P0,10), pw1); \
    VRD(5); SBAR(); GAPA(C1=__builtin_amdgcn_mfma_f32_32x32x16_bf16(kf[3],qr[1],C1,0,0,0),   P0[14],P0[15],P1[0],P1[1],   pw1[2]=PKW(P0,12),pw1[3]=PKW(P0,14), pw1); \
    VRD(2); SBAR(); GAPA(C0=__builtin_amdgcn_mfma_f32_32x32x16_bf16(kf[4],qr[2],C0,0,0,0),   P1[2],P1[3],P1[4],P1[5],     pw2[0]=PKW(P1,0), pw2[1]=PKW(P1,2), pw2); \
    VRD(6); SBAR(); GAPA(C1=__builtin_amdgcn_mfma_f32_32x32x16_bf16(kf[5],qr[2],C1,0,0,0),   P1[6],P1[7],P1[8],P1[9],     pw2[2]=PKW(P1,4), pw2[3]=PKW(P1,6), pw2); \
    VRD(3); SBAR(); GAPA(C0=__builtin_amdgcn_mfma_f32_32x32x16_bf16(kf[6],qr[3],C0,0,0,0),   P1[10],P1[11],P1[12],P1[13], pw3[0]=PKW(P1,8), pw3[1]=PKW(P1,10), pw3); \
    VRD(7); SBAR(); GAPA(C1=__builtin_amdgcn_mfma_f32_32x32x16_bf16(kf[7],qr[3],C1,0,0,0),   P1[14],P1[15],0.f,0.f,       pw3[2]=PKW(P1,12),pw3[3]=PKW(P1,14), pw3); \
    l_reg+=sacc; \
    if(GK){DMA_K((t)+3,sl_cur);} if(GV){DMA_V((t)+1,sl_next);} \
    CMASK(C0,C1,t); \
    { float a=MX3(C0[0],C0[1],C1[0]),b=MX3(C0[2],C0[3],C1[1]); a=MX3(a,C1[2],C1[3]); \
      _Pragma("unroll") for(int r=4;r<16;r+=4){a=MX3(a,C0[r],C0[r+1]);b=MX3(b,C0[r+2],C0[r+3]);a=MX3(a,C1[r],C1[r+1]);b=MX3(b,C1[r+2],C1[r+3]);} \
      float rm=__builtin_fmaxf(a,b); { auto rr=__builtin_amdgcn_permlane32_swap(__float_as_uint(rm),__float_as_uint(rm),false,false); rm=__builtin_fmaxf(__uint_as_float(rr[0]),__uint_as_float(rr[1])); } \
      resc=false; \
      if(__builtin_expect(__any(rm>(float)THRL),0)){ const float dl=__builtin_fmaxf(rm,0.f); mhat+=dl; \
        _Pragma("unroll") for(int r=0;r<16;++r){C0[r]-=dl;C1[r]-=dl;} \
        cqm=cq-mhat; \
        const float f=__builtin_amdgcn_exp2f(-dl); l_reg*=f; if(hi==0)wsf[r32]=f; resc=true; } } \
    SBAR(); \
    GAPB(o[0]=__builtin_amdgcn_mfma_f32_32x32x16_bf16(PAF(0),VFR(0),o[0],0,0,0), C0,0); \
    GAPB(o[1]=__builtin_amdgcn_mfma_f32_32x32x16_bf16(PAF(0),VFR(4),o[1],0,0,0), C0,4); \
    KRD(GL,0); GAPB(o[0]=__builtin_amdgcn_mfma_f32_32x32x16_bf16(PAF(1),VFR(1),o[0],0,0,0), C0,8); \
    KRD(GL,1); GAPB(o[1]=__builtin_amdgcn_mfma_f32_32x32x16_bf16(PAF(1),VFR(5),o[1],0,0,0), C0,12); \
    KRD(GL,2); GAPB(o[0]=__builtin_amdgcn_mfma_f32_32x32x16_bf16(PAF(2),VFR(2),o[0],0,0,0), C1,0); \
    KRD(GL,3); GAPB(o[1]=__builtin_amdgcn_mfma_f32_32x32x16_bf16(PAF(2),VFR(6),o[1],0,0,0), C1,4); \
    GAPB(o[0]=__builtin_amdgcn_mfma_f32_32x32x16_bf16(PAF(3),VFR(3),o[0],0,0,0), C1,8); \
    GAPB(o[1]=__builtin_amdgcn_mfma_f32_32x32x16_bf16(PAF(3),VFR(7),o[1],0,0,0), C1,12); \
    }while(0)
  int t=1;
  #undef CMASK
  #define CMASK(P0,P1,t) do{}while(0)
  for(;t+5<NT;t+=2){
    STEP(pB0,pB1,pA0,pA1,t,true,true,true);     WAIT_BAR(2); RESC(); ROT();
    STEP(pA0,pA1,pB0,pB1,t+1,true,true,true);   WAIT_BAR(2); RESC(); ROT();
  }
  #undef CMASK
  #define CMASK(P0,P1,t) do{int jb_=(t)-(NT-4); if(jb_>=0)cmask(P0,P1,jb_,qrel,hi);}while(0)
  #define ENDW(tt) do{ if((tt)+3<NT){WAIT_BAR(2);} else if((tt)+2<NT){WAIT_BAR(1);} else {WAIT_BAR(0);} }while(0)
  for(;t+1<NT;t+=2){
    STEP(pB0,pB1,pA0,pA1,t,(t+3<NT),(t+1<NT),(t+1<NT));       ENDW(t);   RESC(); ROT();
    STEP(pA0,pA1,pB0,pB1,t+1,(t+4<NT),(t+2<NT),(t+2<NT));     ENDW(t+1); RESC(); ROT();
  }
  STEP(pB0,pB1,pA0,pA1,NT-1,false,false,false); RESC();
  { float sacc=pB0[0]+pB0[1]; _Pragma("unroll") for(int r=2;r<16;++r)sacc+=pB0[r]; _Pragma("unroll") for(int r=0;r<16;++r)sacc+=pB1[r]; l_reg+=sacc;
    pw0=(u32x4){PKW(pB0,0),PKW(pB0,2),PKW(pB0,4),PKW(pB0,6)};pw1=(u32x4){PKW(pB0,8),PKW(pB0,10),PKW(pB0,12),PKW(pB0,14)};pw2=(u32x4){PKW(pB1,0),PKW(pB1,2),PKW(pB1,4),PKW(pB1,6)};pw3=(u32x4){PKW(pB1,8),PKW(pB1,10),PKW(pB1,12),PKW(pB1,14)};
    SBAR(); pv(o,vb0+sl_cur,PAF(0),PAF(1),PAF(2),PAF(3)); }
  #undef PKW
  #undef PAF
  #undef VFR
  #undef PIN
  #undef MX3
  #undef GAPA
  #undef GAPB
  #undef EX
  #undef VRD
  #undef KRD
  #undef STEP
  #undef ENDW
  {auto rr=__builtin_amdgcn_permlane32_swap(__float_as_uint(l_reg),__float_as_uint(l_reg),false,false);l_reg=__uint_as_float(rr[0])+__uint_as_float(rr[1]);}
  if(hi==0)wsf[32+r32]=l_reg;asm volatile("s_waitcnt lgkmcnt(0)":::"memory");
  float rli[16];
  #pragma unroll
  for(int r=0;r<16;++r)rli[r]=__builtin_amdgcn_rcpf(wsf[32+crow(r,hi)]);
  bf16*Ow=O+(rowbase+q0+wid*QBLK)*DMO+h*D;
  { bf16*stg=(bf16*)(shm+LDS_OST)+wid*2048;
    #pragma unroll
    for(int r=0;r<16;++r){const int orow=crow(r,hi);
      #pragma unroll
      for(int d0=0;d0<2;++d0)stg[orow*64+d0*32+r32]=__float2bfloat16(o[d0][r]*rli[r]);}
    asm volatile("s_waitcnt lgkmcnt(0)":::"memory");
    #pragma unroll
    for(int i=0;i<4;++i){const int row=i*8+(lane>>3),ch=lane&7; const u32x4 v=*(const u32x4*)(stg+row*64+ch*8); ATTN_STORE16(Ow+(long)row*DMO+ch*8,v);} }
  asm volatile("s_waitcnt lgkmcnt(0)\n\ts_barrier":::"memory");
  #undef DMA_K
  #undef DMA_V
  #undef CMASK
  #undef START
  #undef RESC
  #undef ROT
  #undef CINIT
}
constexpr int ATTN_LDS_BYTES=LDS_BYTES;
struct AttnTensors { const bf16* Q; const bf16* K; const bf16* V; bf16* O; const float* LF; };
struct AttnUnit { int bh; int qb; };
struct StaticOrder {
  int vcu, G;
  __device__ __forceinline__ StaticOrder(int grid,int vcu_):vcu(vcu_),G(grid){}
  __device__ __forceinline__ bool next(int i,AttnUnit&u)const{
    if(G==256){ if(i>=2)return false; const int s=vcu&7; u.bh=vcu>>3; u.qb=(i==0)?15-s:s; return true; }
    const int idx=i*G+vcu; if(idx>=BATCH*NHEAD*NQB)return false; u.qb=NQB-1-idx/(BATCH*NHEAD); u.bh=idx%(BATCH*NHEAD); return true; }
  __device__ __forceinline__ void a_ready(const AttnUnit&)const{}
  __device__ __forceinline__ void done(const AttnUnit&)const{}
};
template<class Sched,int THRL=8> __device__ __forceinline__ void attn_phase(char*lds,const AttnTensors&T,const Sched&S){
  AttnUnit u;
  for(int i=0;S.next(i,u);++i){ S.a_ready(u); attn_unit<THRL>(u.bh/NHEAD,u.bh%NHEAD,u.qb,T.Q,T.K,T.V,T.O,T.LF+(size_t)u.bh*SEQ,lds); S.done(u); }
}
#undef SBAR
#undef WAIT_BAR
}
#define GAS __attribute__((address_space(1)))
#define LAS __attribute__((address_space(3)))
typedef unsigned short bf16;
typedef unsigned v4u __attribute__((ext_vector_type(4)));
typedef float f32x4 __attribute__((ext_vector_type(4)));
typedef short bf16x8 __attribute__((ext_vector_type(8)));
typedef GAS unsigned gu32;
typedef GAS unsigned long long gu64;
#define RLX_AGENT __ATOMIC_RELAXED, __HIP_MEMORY_SCOPE_AGENT
#define LDS_WAIT() asm volatile("s_waitcnt lgkmcnt(0)" ::: "memory")
#define VM_WAIT() asm volatile("s_waitcnt vmcnt(0)" ::: "memory")
__device__ __forceinline__ unsigned long long rt() { return __builtin_amdgcn_s_memrealtime(); }
__device__ __forceinline__ unsigned f2bf(float f) { unsigned u = __builtin_bit_cast(unsigned, f); return (u + 0x7fffu + ((u >> 16) & 1u)) >> 16; }
__device__ __forceinline__ unsigned pk2(float lo, float hi) { return f2bf(lo) | (f2bf(hi) << 16); }

#define XB_TMO      128
#define XB_XCNT(j)  (256  + 64 * (j))
#define XB_XSUB(j)  (1280 + 64 * (j))
#define XB_XGEN(j)  (2304 + 64 * (j))
#define XB_TOP      3328
#define XB_TOPGEN   3392
#define XCD_BAR_WORDS 3456
#define XB_SPIN_CAP (1u << 18)

__device__ __forceinline__ unsigned xb_ld(unsigned* p)              { return __hip_atomic_load(p, __ATOMIC_RELAXED, __HIP_MEMORY_SCOPE_AGENT); }
__device__ __forceinline__ unsigned xb_add(unsigned* p, unsigned v) { return __hip_atomic_fetch_add(p, v, __ATOMIC_RELAXED, __HIP_MEMORY_SCOPE_AGENT); }
__device__ __forceinline__ unsigned xb_xcc_id() { return (unsigned)__builtin_amdgcn_s_getreg((3 << 11) | 20) & 0xFu; }
#define XB_SPIN(cond, bar) do { unsigned _sp = 0; while (cond) { __builtin_amdgcn_s_sleep(1); \
    if ((++_sp & 255u) == 0u) { if (xb_ld(&(bar)[XB_TMO])) break; if (_sp > XB_SPIN_CAP) { atomicAdd(&(bar)[XB_TMO], 1u); break; } } } } while (0)

struct XcdBarrier {
    unsigned* bar; unsigned x;
    volatile LAS unsigned* st;
};

__device__ __forceinline__ XcdBarrier xcd_barrier_post(unsigned* bar, volatile LAS unsigned* st) {
    XcdBarrier b; b.bar = bar; b.x = xb_xcc_id(); b.st = st;
    if (threadIdx.x == 0) (void)xb_add(&bar[XB_XCNT(b.x)], 1u);
    return b;
}
__device__ __forceinline__ void xcd_barrier_complete(unsigned* bar, unsigned x, unsigned& nloc, unsigned& nx) {
    const unsigned G = gridDim.x * gridDim.y * gridDim.z;
    unsigned sum, cnt, mine, sp = 0u;
    for (;;) {
        sum = 0u; cnt = 0u; mine = 0u;
#pragma unroll
        for (unsigned j = 0; j < 16; ++j) { const unsigned c = xb_ld(&bar[XB_XCNT(j)]); sum += c; cnt += (c > 0u) ? 1u : 0u; mine = (j == x) ? c : mine; }
        if (sum == G) break;
        __builtin_amdgcn_s_sleep(1);
        if ((++sp & 255u) == 0u) { if (xb_ld(&bar[XB_TMO])) break; if (sp > XB_SPIN_CAP) { atomicAdd(&bar[XB_TMO], 1u); break; } }
    }
    nloc = mine > 0u ? mine : 1u; nx = cnt > 0u ? cnt : 1u;
}

__device__ __forceinline__ void xcd_barrier(const XcdBarrier& b) {
    asm volatile("s_waitcnt vmcnt(0)" ::: "memory");
    __syncthreads();
    if (threadIdx.x == 0) {
        unsigned* bar = b.bar;
        __builtin_amdgcn_s_waitcnt(0);
        unsigned nloc = b.st[0], nx = b.st[1];
        if (nloc == 0u) { xcd_barrier_complete(bar, b.x, nloc, nx); b.st[0] = nloc; b.st[1] = nx; }
        const unsigned old = xb_add(&bar[XB_XSUB(b.x)], 1u);
        const unsigned gen = old / nloc;
        if (old + 1u == (gen + 1u) * nloc) {
            __builtin_amdgcn_fence(__ATOMIC_RELEASE, "agent");
            asm volatile("s_waitcnt vmcnt(0)" ::: "memory");
            const unsigned og = xb_add(&bar[XB_TOP], 1u);
            const unsigned tg = og / nx;
            if (og + 1u == (tg + 1u) * nx) xb_add(&bar[XB_TOPGEN], 1u);
            else XB_SPIN(xb_ld(&bar[XB_TOPGEN]) == tg, bar);
            __builtin_amdgcn_fence(__ATOMIC_ACQUIRE, "agent");
            xb_add(&bar[XB_XGEN(b.x)], 1u);
            asm volatile("s_waitcnt vmcnt(0)" ::: "memory");
        } else {
            XB_SPIN(xb_ld(&bar[XB_XGEN(b.x)]) == gen, bar);
            __builtin_amdgcn_fence(__ATOMIC_ACQUIRE, "agent");
            asm volatile("s_waitcnt vmcnt(0)" ::: "memory");
        }
    }
    __syncthreads();
}

constexpr int NWAVES = 8;
constexpr int BATCH = 4, SEQ = 4096, D = 1024, M = BATCH * SEQ, NH = 8, HD = 64, AW = 512, PLE = 256;
constexpr int NIN = 5120, INTOT = 5128, NKEYS = 128, NEXP = 16384, NS = 2048;
constexpr float EPS = 1e-6f, LOG2E = 1.4426950408889634f, C2 = 0.125f * LOG2E;
constexpr int NPHASE = 9;
constexpr int SLW = 128, NSL = D / SLW;
static_assert(NSL == 8, "one slice per XCD group; SS3 has 16 slots");

constexpr size_t MiB = 1u << 20;
constexpr size_t WS_CTL = 0, CTL_ZERO_BYTES = 64 * 1024;
constexpr size_t WS_RSTD1 = 1 * MiB, WS_RSTD3 = WS_RSTD1 + 65536, WS_LF = WS_RSTD3 + 65536, WS_CS = WS_LF + 524288, WS_SS2 = WS_CS + 524288, WS_WPP = WS_SS2 + 1048576;
constexpr size_t WS_WQ8 = 20 * MiB, WS_SW = WS_RSTD1;
constexpr size_t WS_SU = WS_RSTD3, WS_SV = WS_WPP + 524288;
static_assert(WS_SV + 65536 <= 4 * MiB, "small region");
constexpr size_t WS_WIN = 4 * MiB, WS_WBR = 14 * MiB, WS_WOUT = 16 * MiB, WS_WS = 18 * MiB, WS_WPG = 22 * MiB, WS_PB = 24 * MiB;
constexpr size_t WS_UB = 32 * MiB, WS_VB = 48 * MiB;
constexpr size_t WS_AC = 64 * MiB;
constexpr size_t WS_A = 96 * MiB;
constexpr size_t WS_PP = 128 * MiB;
constexpr size_t WS_Q = 160 * MiB, WS_K = 176 * MiB, WS_V = 192 * MiB, WS_GB = 208 * MiB, WS_Z = 224 * MiB;
constexpr size_t WS_MERGED = 160 * MiB, WS_XB2 = 192 * MiB, WS_IDS = 224 * MiB, WS_GATES = 232 * MiB;
constexpr size_t WS_XB3 = 64 * MiB, WS_SS4 = WS_LF;
constexpr size_t WS_XB2_8 = 240 * MiB;
constexpr size_t WS_XB8 = 240 * MiB, WS_WIN8 = 10 * MiB;
constexpr size_t WS_END = 256 * MiB;
constexpr size_t WS_PART0 = 4 * MiB, WS_PART1 = 160 * MiB, WS_PART2 = 240 * MiB;
constexpr size_t WS_TGC = 32 * MiB, WS_TXC = 64 * MiB, WS_SC = 32 * MiB;
constexpr int CW_BAR = 1024;

constexpr int RING_OFF = 0, RING_BYTES = 135168;
constexpr int LDSCTL_OFF = RING_BYTES, MISC_OFF = LDSCTL_OFF + 320;
constexpr int LDS_BYTES = RING_BYTES + 1024;
static_assert(attn_body::ATTN_LDS_BYTES <= RING_BYTES && pg8::STAGE_BYTES <= RING_BYTES && 128 * pg8::EpiTopK::RS * 4 <= RING_BYTES, "LDS map");

typedef unsigned u32x4 __attribute__((ext_vector_type(4)));
typedef unsigned u32x2 __attribute__((ext_vector_type(2)));
__device__ __forceinline__ float bf2f(bf16 v) { return __uint_as_float((unsigned)v << 16); }
__device__ __forceinline__ float wave_sum(float v) {
#pragma unroll
    for (int o = 1; o < 64; o <<= 1) v += __shfl_xor(v, o);
    return v;
}
__device__ __forceinline__ float sigmoidf_(float v) { return 1.0f / (1.0f + __expf(-v)); }
__host__ __device__ __forceinline__ int src_in(int n) {
    const int pn = n >> 8, l = n & 255;
    if (pn < 6) return n;
    if (pn < 8) return 1544 + (n - 1536);
    if (pn < 12) { const int j = pn - 8; return (l < 128) ? 2056 + 128 * j + l : 2568 + 128 * j + (l - 128); }
    { const int j = pn - 12; return (l < 128) ? 3080 + 128 * j + l : 4104 + 128 * j + (l - 128); }
}

struct Args { const float* in[18]; float* out; unsigned char* ws; int ph_lo, ph_hi, li, pad; };
struct Ctx {
    LAS unsigned char* lds; int wave, vcu, G;
    __device__ __forceinline__ int tid_() const { return (int)threadIdx.x; }
    __device__ __forceinline__ int lane_() const { return (int)threadIdx.x & 63; }
};

struct TrItem { const float* W; const float* g; bf16* WT; int ldw, k0, scol0, ldt, drow0, dk0; int fp8; };
__device__ __forceinline__ void tr_load(const TrItem& I, float (&tv)[32], int lane) {
#pragma unroll
    for (int i = 0; i < 32; ++i) { const int kk = 2 * i + (lane >> 5); tv[i] = I.W[(size_t)(I.k0 + kk) * I.ldw + I.scol0 + (lane & 31)]; }
}
__device__ __forceinline__ void tr_finish(const TrItem& I, const float (&tv)[32], LAS float* scr, int lane) {
#pragma unroll
    for (int i = 0; i < 32; ++i) { const int kk = 2 * i + (lane >> 5); float v = tv[i]; if (I.g) v *= I.g[I.k0 + kk]; scr[kk * 33 + (lane & 31)] = v; }
    LDS_WAIT(); asm volatile("" ::: "memory");
    const int c = lane & 7;
    if (I.fp8) {
#pragma unroll
        for (int j = 0; j < 4; ++j) { const int n = (lane >> 3) + 8 * j; const LAS float* s = scr + (8 * c) * 33 + n;
            u32x2 o; o.x = (unsigned)__builtin_amdgcn_cvt_pk_fp8_f32(s[0 * 33] * 32.f, s[1 * 33] * 32.f, 0, false); o.x = (unsigned)__builtin_amdgcn_cvt_pk_fp8_f32(s[2 * 33] * 32.f, s[3 * 33] * 32.f, (int)o.x, true);
            o.y = (unsigned)__builtin_amdgcn_cvt_pk_fp8_f32(s[4 * 33] * 32.f, s[5 * 33] * 32.f, 0, false); o.y = (unsigned)__builtin_amdgcn_cvt_pk_fp8_f32(s[6 * 33] * 32.f, s[7 * 33] * 32.f, (int)o.y, true);
            *(GAS u32x2*)((unsigned char*)I.WT + (size_t)(I.drow0 + n) * I.ldt + I.dk0 + 8 * c) = o; }
    } else {
#pragma unroll
        for (int j = 0; j < 4; ++j) { const int n = (lane >> 3) + 8 * j; const LAS float* s = scr + (8 * c) * 33 + n;
            v4u o; o.x = pk2(s[0 * 33], s[1 * 33]); o.y = pk2(s[2 * 33], s[3 * 33]); o.z = pk2(s[4 * 33], s[5 * 33]); o.w = pk2(s[6 * 33], s[7 * 33]);
            *(GAS v4u*)(I.WT + (size_t)(I.drow0 + n) * I.ldt + I.dk0 + 8 * c) = o; }
    }
    LDS_WAIT(); asm volatile("" ::: "memory");
}
constexpr int TR_IN = 16 * 160, TR_PP = 4 * 32, TR_BR = 8 * 32, TR_SQ = 16 * 32;
constexpr int TR_P0 = TR_IN + TR_PP;
constexpr int TR_LATE = 2 * TR_BR + 2 * TR_SQ;
__device__ __forceinline__ TrItem tr_decode(const Args& a, int r) {
    unsigned char* ws = a.ws;
    if (r < TR_IN) { const int kb = r / 160, nb = r % 160;
        if (nb >= 96) return TrItem{a.in[3], a.in[2], (bf16*)(ws + WS_WIN8), INTOT, 64 * kb, src_in(32 * nb), D, 32 * nb - 3072, 64 * kb, 1};
        return TrItem{a.in[3], a.in[2], (bf16*)(ws + WS_WIN), INTOT, 64 * kb, src_in(32 * nb), D, 32 * nb, 64 * kb, 0}; } r -= TR_IN;
    if (r < TR_PP) { const int kb = r / 32, nb = r % 32; return TrItem{a.in[16], nullptr, (bf16*)(ws + WS_WPP), D, 64 * kb, 32 * nb, PLE, 32 * nb, 64 * kb, 0}; } r -= TR_PP;
    if (r < 2 * TR_BR) { const int br = r / TR_BR, q = r % TR_BR, kb = q / 32, nb = q % 32; return TrItem{a.in[6] + (size_t)br * AW * D, nullptr, (bf16*)(ws + WS_WBR), D, 64 * kb, 32 * nb, D, 32 * nb, br * AW + 64 * kb, 0}; } r -= 2 * TR_BR;
    if (r < TR_SQ) { const int kb = r / 32, nb = r % 32; return TrItem{a.in[7], nullptr, (bf16*)(ws + WS_WOUT), D, 64 * kb, 32 * nb, D, 32 * nb, 64 * kb, 0}; } r -= TR_SQ;
    { const int kb = r / 32, nb = r % 32; return TrItem{a.in[15], a.in[14], (bf16*)(ws + WS_WPG), D, 64 * kb, 32 * nb, D, 32 * nb, 64 * kb, 1}; }
}
__device__ __forceinline__ void tr_two(const Args& a, LAS float* scr, int ra, int rb_, bool two, int lane) {
    const TrItem A = tr_decode(a, ra), B = tr_decode(a, two ? rb_ : ra);
    float ta[32], tb[32];
    tr_load(A, ta, lane); if (two) tr_load(B, tb, lane);
    tr_finish(A, ta, scr, lane); if (two) tr_finish(B, tb, scr, lane);
}
__device__ __forceinline__ void ws_item(const Args& a, LAS unsigned char* lds, int item) {
    int tid_ = (int)threadIdx.x; asm volatile("" : "+v"(tid_));
    const float *g_ffn = a.in[8], *w_peer_q = a.in[9]; bf16* WST = (bf16*)(a.ws + WS_WS);
    LAS float* KH = (LAS float*)lds; LAS float* WQ = KH + 128 * 129;
    const int hh = item >> 4, head = hh >> 1, half = hh & 1, d0 = (item & 15) * 64;
    const float* kh = (half ? a.in[11] : a.in[10]) + (size_t)head * 128 * 128;
    float tk[32], tq[16];
#pragma unroll
    for (int i = 0; i < 32; ++i) tk[i] = kh[i * 512 + tid_];
#pragma unroll
    for (int i = 0; i < 16; ++i) { const int idx = i * 512 + tid_; tq[i] = w_peer_q[(size_t)(d0 + (idx >> 7)) * NS + head * 256 + half * 128 + (idx & 127)]; }
#pragma unroll
    for (int i = 0; i < 32; ++i) { const int idx = i * 512 + tid_; KH[(idx >> 7) * 129 + (idx & 127)] = tk[i]; }
#pragma unroll
    for (int i = 0; i < 16; ++i) { const int idx = i * 512 + tid_; WQ[(idx >> 7) * 129 + (idx & 127)] = tq[i]; }
    __syncthreads();
    typedef float f32x16_t __attribute__((ext_vector_type(16)));
    const int lane = tid_ & 63, w = __builtin_amdgcn_readfirstlane(tid_ >> 6), kt = w & 3, dt = w >> 2, l31 = lane & 31, h = lane >> 5;
    const LAS float* ap = WQ + (32 * dt + l31) * 129 + h; const LAS float* bp = KH + (32 * kt + l31) * 129 + h;
    f32x16_t acc = {0.f, 0.f, 0.f, 0.f, 0.f, 0.f, 0.f, 0.f, 0.f, 0.f, 0.f, 0.f, 0.f, 0.f, 0.f, 0.f};
#pragma unroll 8
    for (int s_ = 0; s_ < 64; ++s_) acc = __builtin_amdgcn_mfma_f32_32x32x2f32(ap[2 * s_], bp[2 * s_], acc, 0, 0, 0);
    const int key = 32 * kt + l31;
#pragma unroll
    for (int q = 0; q < 4; ++q) { const int dd = d0 + 32 * dt + 8 * q + 4 * h; const f32x4 gv = *(const GAS f32x4*)(g_ffn + dd);
        u32x2 o; o.x = pk2(acc[4 * q] * gv[0], acc[4 * q + 1] * gv[1]); o.y = pk2(acc[4 * q + 2] * gv[2], acc[4 * q + 3] * gv[3]);
        *(GAS u32x2*)(WST + (size_t)(head * 256 + half * 128 + key) * D + dd) = o; }
    __syncthreads();
}
__device__ __forceinline__ void quant_load4(const Args& a, int rb, int lane, f32x4 (&v)[4][4]) {
#pragma unroll
    for (int r = 0; r < 4; ++r) { const int rr = rb + r; const bool isv = rr >= NEXP; const int e = isv ? rr - NEXP : rr;
        const GAS f32x4* src = (const GAS f32x4*)((isv ? a.in[13] : a.in[12]) + (size_t)e * D) + lane;
#pragma unroll
        for (int j = 0; j < 4; ++j) v[r][j] = src[64 * j]; }
}
__device__ __forceinline__ void quant_finish4(const Args& a, int rb, int lane, f32x4 (&v)[4][4]) {
    unsigned char* ws = a.ws; const float *g_ffn = a.in[8];
    f32x4 gq[4];
#pragma unroll
    for (int j = 0; j < 4; ++j) gq[j] = *(const GAS f32x4*)(g_ffn + 256 * j + 4 * lane);
#pragma unroll
    for (int r = 0; r < 4; ++r) { const int rr = rb + r; const bool isv = rr >= NEXP; const int e = isv ? rr - NEXP : rr;
        float am = 0.f;
#pragma unroll
        for (int j = 0; j < 4; ++j) { if (!isv) v[r][j] = v[r][j] * gq[j]; am = fmaxf(am, fmaxf(fmaxf(fabsf(v[r][j].x), fabsf(v[r][j].y)), fmaxf(fabsf(v[r][j].z), fabsf(v[r][j].w)))); }
#pragma unroll
        for (int o = 1; o < 64; o <<= 1) am = fmaxf(am, __shfl_xor(am, o));
        const float sc = am > 0.f ? 127.0f / am : 0.f;
        unsigned char* tb = ws + (isv ? WS_VB : WS_UB);
#pragma unroll
        for (int j = 0; j < 4; ++j) { const int q0 = (int)rintf(v[r][j].x * sc), q1 = (int)rintf(v[r][j].y * sc), q2 = (int)rintf(v[r][j].z * sc), q3 = (int)rintf(v[r][j].w * sc);
            const unsigned o = (unsigned)(q0 & 255) | ((unsigned)(q1 & 255) << 8) | ((unsigned)(q2 & 255) << 16) | ((unsigned)(q3 & 255) << 24);
            *(GAS unsigned*)(tb + ((size_t)(2 * j + (lane >> 5)) * NEXP + e) * SLW + ((4 * lane) & 127)) = o; }
        if (lane == 0) ((float*)(ws + (isv ? WS_SV : WS_SU)))[e] = am * (1.0f / 127.0f);
    }
}
__device__ __forceinline__ void quant_rows4(const Args& a, int rb, int lane) { f32x4 v[4][4]; quant_load4(a, rb, lane, v); quant_finish4(a, rb, lane, v); }
__device__ __forceinline__ void p0_prologue(const Ctx& F, const Args& a, volatile LAS unsigned* MISC) {
    unsigned char* ws = a.ws;
    const float *x = a.in[0], *p = a.in[1], *g_mix = a.in[2], *w_in = a.in[3], *b_f = a.in[4];
    bf16 *PB = (bf16*)(ws + WS_PB), *XB = (bf16*)(ws + WS_A);
    float *RSTD1 = (float*)(ws + WS_RSTD1), *LF = (float*)(ws + WS_LF);
    const int gw = F.vcu * NWAVES + F.wave, NGW = F.G * NWAVES, NGT = F.G * 512;
    const int tid_ = (int)threadIdx.x, lane_ = tid_ & 63;
    auto stepB = [&]() __attribute__((always_inline)) {
        LAS float* scr = (LAS float*)(F.lds + RING_OFF + F.wave * 16384);
        for (int it = gw; it < TR_P0; it += 2 * NGW) tr_two(a, scr, it, it + NGW, it + NGW < TR_P0, lane_);
    };
    auto stepC = [&]() __attribute__((always_inline)) {
    {
        LAS float* WFL = (LAS float*)(F.lds + RING_OFF);
        { float tw[16], tg[16];
#pragma unroll
          for (int i = 0; i < 16; ++i) { const int idx = i * 512 + tid_, k = idx >> 3, h = idx & 7; tw[i] = w_in[(size_t)k * INTOT + 1536 + h]; tg[i] = g_mix[k]; }
#pragma unroll
          for (int i = 0; i < 16; ++i) { const int idx = i * 512 + tid_, k = idx >> 3, h = idx & 7; WFL[h * 1024 + k] = tg[i] * tw[i]; } }
        __syncthreads();
        for (int rb = gw; rb < M; rb += 4 * NGW) {
            f32x4 v[4][4];
#pragma unroll
            for (int r = 0; r < 4; ++r) { const int row = rb + r * NGW; if (row < M) { const GAS f32x4* xr = (const GAS f32x4*)(x + (size_t)row * D);
#pragma unroll
                for (int j = 0; j < 4; ++j) v[r][j] = xr[lane_ + 64 * j]; } }
#pragma unroll
            for (int r = 0; r < 4; ++r) { const int row = rb + r * NGW; if (row < M) {
                float ss = 0.f;
#pragma unroll
                for (int j = 0; j < 4; ++j) ss += (v[r][j].x * v[r][j].x + v[r][j].y * v[r][j].y) + (v[r][j].z * v[r][j].z + v[r][j].w * v[r][j].w);
                ss = wave_sum(ss);
                const float rstd = 1.0f / sqrtf(ss * (1.0f / D) + EPS);
                GAS u32x2* o = (GAS u32x2*)(XB + (size_t)row * D);
#pragma unroll
                for (int j = 0; j < 4; ++j) { u32x2 w; w.x = pk2(v[r][j].x, v[r][j].y); w.y = pk2(v[r][j].z, v[r][j].w); o[lane_ + 64 * j] = w; }
                { GAS unsigned* o8 = (GAS unsigned*)(ws + WS_XB8 + (size_t)row * D);
#pragma unroll
                  for (int j = 0; j < 4; ++j) { int q = __builtin_amdgcn_cvt_pk_fp8_f32(v[r][j].x, v[r][j].y, 0, false); q = __builtin_amdgcn_cvt_pk_fp8_f32(v[r][j].z, v[r][j].w, q, true); o8[lane_ + 64 * j] = (unsigned)q; } }
                if (lane_ == 0) RSTD1[row] = rstd;
                float f[8];
#pragma unroll
                for (int h = 0; h < 8; ++h) { float s_ = 0.f;
#pragma unroll
                    for (int j = 0; j < 4; ++j) { const f32x4 w = *(const LAS f32x4*)(WFL + h * 1024 + 4 * (lane_ + 64 * j)); s_ += (v[r][j].x * w[0] + v[r][j].y * w[1]) + (v[r][j].z * w[2] + v[r][j].w * w[3]); }
                    f[h] = s_; }
                float r4[4], r2[2], r1;
#pragma unroll
                for (int i = 0; i < 4; ++i) { const float send = (lane_ & 32) ? f[i] : f[i + 4], keep = (lane_ & 32) ? f[i + 4] : f[i]; r4[i] = keep + __shfl_xor(send, 32); }
#pragma unroll
                for (int i = 0; i < 2; ++i) { const float send = (lane_ & 16) ? r4[i] : r4[i + 2], keep = (lane_ & 16) ? r4[i + 2] : r4[i]; r2[i] = keep + __shfl_xor(send, 16); }
                { const float send = (lane_ & 8) ? r2[0] : r2[1], keep = (lane_ & 8) ? r2[1] : r2[0]; r1 = keep + __shfl_xor(send, 8); }
                r1 += __shfl_xor(r1, 4); r1 += __shfl_xor(r1, 2); r1 += __shfl_xor(r1, 1);
                const int hL = ((lane_ >> 5) & 1) * 4 + ((lane_ >> 4) & 1) * 2 + ((lane_ >> 3) & 1);
                const float tot = r1 * rstd + b_f[hL];
                const float ls = fminf(tot, 0.f) - log1pf(__expf(-fabsf(tot)));
                const int b = row / SEQ, t = row % SEQ;
                if ((lane_ & 7) == 0) LF[(size_t)(b * NH + hL) * SEQ + t] = ls * LOG2E;
            } }
        }
    }
    };
    if (F.vcu & 1) { stepC(); __syncthreads(); stepB(); }
    else           { stepB(); __syncthreads(); stepC(); }
    { constexpr int NP = M * PLE / 8;
        for (int i = F.vcu * 512 + tid_; i < NP; i += NGT) { const f32x4 a_ = ((const GAS f32x4*)p)[2 * (size_t)i], b_ = ((const GAS f32x4*)p)[2 * (size_t)i + 1];
            v4u o; o.x = pk2(a_.x, a_.y); o.y = pk2(a_.z, a_.w); o.z = pk2(b_.x, b_.y); o.w = pk2(b_.z, b_.w); ((GAS v4u*)PB)[i] = o; }
    }
}
__device__ __forceinline__ void p2_conv_chunk(int chunk, const bf16* GB, const bf16* Z, const float* cw, bf16* AC) {
    int tid_l = (int)threadIdx.x; asm volatile("" : "+v"(tid_l));
#pragma unroll 4
    for (int k = 0; k < 16; ++k) {
        const int i = chunk * 8192 + k * 512 + tid_l;
        const int row = i >> 6, c = (i & 63) * 8, t = row & (SEQ - 1);
        const v4u z2 = *(const GAS v4u*)(Z + (size_t)row * AW + c), g = *(const GAS v4u*)(GB + (size_t)row * AW + c);
        v4u z1 = {0u, 0u, 0u, 0u}, z0 = {0u, 0u, 0u, 0u};
        if (t >= 1) z1 = *(const GAS v4u*)(Z + (size_t)(row - 1) * AW + c);
        if (t >= 2) z0 = *(const GAS v4u*)(Z + (size_t)(row - 2) * AW + c);
        float r[8];
#pragma unroll
        for (int e = 0; e < 4; ++e) {
            const float w0a = cw[c + 2 * e], w0b = cw[c + 2 * e + 1], w1a = cw[AW + c + 2 * e], w1b = cw[AW + c + 2 * e + 1], w2a = cw[2 * AW + c + 2 * e], w2b = cw[2 * AW + c + 2 * e + 1];
            r[2 * e] = __uint_as_float(g[e] << 16) * (w0a * __uint_as_float(z0[e] << 16) + w1a * __uint_as_float(z1[e] << 16) + w2a * __uint_as_float(z2[e] << 16));
            r[2 * e + 1] = __uint_as_float(g[e] & 0xffff0000u) * (w0b * __uint_as_float(z0[e] & 0xffff0000u) + w1b * __uint_as_float(z1[e] & 0xffff0000u) + w2b * __uint_as_float(z2[e] & 0xffff0000u));
        }
        v4u o; o.x = pk2(r[0], r[1]); o.y = pk2(r[2], r[3]); o.z = pk2(r[4], r[5]); o.w = pk2(r[6], r[7]);
        *(GAS v4u*)(AC + (size_t)row * D + AW + c) = o;
    }
}
constexpr int P2_NATT = 512, P2_NCONV = M * AW / 8 / 8192, P2_NQ = 2 * NEXP / 64, P2_NWS = 256, P2_NTR = TR_LATE / 16, CW_QUEUE = 512;
constexpr int P2_NITEMS = P2_NATT + P2_NCONV + P2_NQ + P2_NWS + P2_NTR;
__device__ __forceinline__ int p2_dequeue(unsigned* ctr, volatile LAS unsigned* slot) {
    if (threadIdx.x == 0) *slot = __hip_atomic_fetch_add(ctr, 1u, __ATOMIC_RELAXED, __HIP_MEMORY_SCOPE_AGENT);
    asm volatile("s_waitcnt vmcnt(0) lgkmcnt(0)\n\ts_barrier" ::: "memory");
    const unsigned v = *slot;
    asm volatile("s_waitcnt lgkmcnt(0)\n\ts_barrier" ::: "memory");
    return (int)v;
}
template <int CTRL> __device__ __forceinline__ int dpp_i(int v) { return __builtin_amdgcn_update_dpp(0, v, CTRL, 0xf, 0xf, true); }
__device__ __forceinline__ int sum8i(int v) { v += dpp_i<0x141>(v); v += dpp_i<0xB1>(v); v += dpp_i<0x4E>(v); return v; }
__device__ __forceinline__ float max8f(float v) { v = fmaxf(v, __uint_as_float((unsigned)dpp_i<0x141>((int)__float_as_uint(v)))); v = fmaxf(v, __uint_as_float((unsigned)dpp_i<0xB1>((int)__float_as_uint(v)))); v = fmaxf(v, __uint_as_float((unsigned)dpp_i<0x4E>((int)__float_as_uint(v)))); return v; }
__device__ __forceinline__ size_t part_slab(int j) { return j < 2 ? WS_PART0 + (size_t)j * 8 * MiB : j < 6 ? WS_PART1 + (size_t)(j - 2) * 8 * MiB : WS_PART2 + (size_t)(j - 6) * 8 * MiB; }
struct P6Geo { int xg, wi, nwv, ng; };
__device__ __forceinline__ P6Geo p6_geo(const Ctx& F) { P6Geo g; const int bx = blockIdx.x, ng = F.G < 8 ? F.G : 8; g.xg = bx % ng; g.wi = (bx / ng) * NWAVES + F.wave; g.nwv = ((F.G - g.xg + ng - 1) / ng) * NWAVES; g.ng = ng; return g; }
__device__ __forceinline__ void p6a_upass(const Ctx& F, unsigned char* ws, const bf16* XB1, const unsigned short* IDS) {
    const P6Geo G = p6_geo(F); const int lane = F.lane_(), g = lane >> 3, c = lane & 7;
    for (int sl = G.xg; sl < NSL; sl += G.ng) {
        float* PART = (float*)(ws + part_slab(sl));
        const GAS unsigned char* Ts = (const GAS unsigned char*)(ws + WS_UB) + (size_t)sl * NEXP * SLW + 16 * c;
        for (int t = G.wi; t < M; t += G.nwv) {
            const v4u xa = *(const GAS v4u*)(XB1 + (size_t)t * D + sl * SLW + 16 * c), xb = *(const GAS v4u*)(XB1 + (size_t)t * D + sl * SLW + 16 * c + 8);
            v4u idp[2];
#pragma unroll
            for (int q = 0; q < 2; ++q) idp[q] = *(const GAS v4u*)(IDS + (size_t)t * 128 + 16 * g + 8 * q);
            v4u u[16];
#pragma unroll
            for (int i = 0; i < 16; ++i) { const unsigned w_ = idp[i >> 3][(i >> 1) & 3]; u[i] = *(const GAS v4u*)(Ts + ((i & 1) ? ((w_ >> 9) & 0x7fff80u) : ((w_ << 7) & 0x7fff80u))); }
            float xf[16];
#pragma unroll
            for (int e = 0; e < 4; ++e) { xf[2 * e] = __uint_as_float(xa[e] << 16); xf[2 * e + 1] = __uint_as_float(xa[e] & 0xffff0000u); xf[8 + 2 * e] = __uint_as_float(xb[e] << 16); xf[8 + 2 * e + 1] = __uint_as_float(xb[e] & 0xffff0000u); }
            float am = 0.f;
#pragma unroll
            for (int e = 0; e < 16; ++e) am = fmaxf(am, fabsf(xf[e]));
            am = max8f(am);
            const float sc = am > 0.f ? 127.0f / am : 0.f, sx = am * (1.0f / 127.0f);
            int qx[4];
#pragma unroll
            for (int j = 0; j < 4; ++j) qx[j] = (int)(((unsigned)((int)rintf(xf[4 * j] * sc) & 255)) | ((unsigned)((int)rintf(xf[4 * j + 1] * sc) & 255) << 8) | ((unsigned)((int)rintf(xf[4 * j + 2] * sc) & 255) << 16) | ((unsigned)((int)rintf(xf[4 * j + 3] * sc) & 255) << 24));
            int r0 = 0, r1 = 0;
#pragma unroll
            for (int i = 0; i < 16; ++i) { int sacc = __builtin_amdgcn_sdot4(qx[0], (int)u[i][0], 0, false); sacc = __builtin_amdgcn_sdot4(qx[1], (int)u[i][1], sacc, false); sacc = __builtin_amdgcn_sdot4(qx[2], (int)u[i][2], sacc, false); sacc = __builtin_amdgcn_sdot4(qx[3], (int)u[i][3], sacc, false);
                sacc = sum8i(sacc);
                if (i < 8) r0 = (c == i) ? sacc : r0; else r1 = (c == i - 8) ? sacc : r1; }
            float* pp = PART + (size_t)t * 128 + 16 * g + c;
            pp[0] = (float)r0 * sx; pp[8] = (float)r1 * sx;
        }
    }
}
__device__ __forceinline__ int pl32_sum(int a, int b) { const auto s_ = __builtin_amdgcn_permlane32_swap((unsigned)a, (unsigned)b, false, false); return (int)(s_[0] + s_[1]); }
__device__ __forceinline__ int pl16_sum(int a, int b) { const auto s_ = __builtin_amdgcn_permlane16_swap((unsigned)a, (unsigned)b, false, false); return (int)(s_[0] + s_[1]); }
__device__ __forceinline__ float wave_sum_valu(float v) {
    { const auto s_ = __builtin_amdgcn_permlane32_swap(__float_as_uint(v), __float_as_uint(v), false, false); v = __uint_as_float(s_[0]) + __uint_as_float(s_[1]); }
    { const auto s_ = __builtin_amdgcn_permlane16_swap(__float_as_uint(v), __float_as_uint(v), false, false); v = __uint_as_float(s_[0]) + __uint_as_float(s_[1]); }
    v += __uint_as_float((unsigned)dpp_i<0x128>((int)__float_as_uint(v))); v += __uint_as_float((unsigned)dpp_i<0x124>((int)__float_as_uint(v)));
    v += __uint_as_float((unsigned)dpp_i<0x122>((int)__float_as_uint(v))); v += __uint_as_float((unsigned)dpp_i<0x121>((int)__float_as_uint(v))); return v;
}
__device__ __forceinline__ float wave_max_valu(float v) {
    { const auto s_ = __builtin_amdgcn_permlane32_swap(__float_as_uint(v), __float_as_uint(v), false, false); v = fmaxf(__uint_as_float(s_[0]), __uint_as_float(s_[1])); }
    { const auto s_ = __builtin_amdgcn_permlane16_swap(__float_as_uint(v), __float_as_uint(v), false, false); v = fmaxf(__uint_as_float(s_[0]), __uint_as_float(s_[1])); }
    v = fmaxf(v, __uint_as_float((unsigned)dpp_i<0x128>((int)__float_as_uint(v)))); v = fmaxf(v, __uint_as_float((unsigned)dpp_i<0x124>((int)__float_as_uint(v))));
    v = fmaxf(v, __uint_as_float((unsigned)dpp_i<0x122>((int)__float_as_uint(v)))); v = fmaxf(v, __uint_as_float((unsigned)dpp_i<0x121>((int)__float_as_uint(v)))); return v;
}
__device__ __forceinline__ void p6b_combine(const Ctx& F, unsigned char* ws, float* SS2, const unsigned short* IDS, const float* GATES) {
    const int gw = F.vcu * NWAVES + F.wave, NGW = F.G * NWAVES, lane = F.lane_();
    const float *SU = (const float*)(ws + WS_SU), *SV = (const float*)(ws + WS_SV);
    signed char* WQ8 = (signed char*)(ws + WS_WQ8); float* SW = (float*)(ws + WS_SW);
    typedef float f32x2c __attribute__((ext_vector_type(2)));
    constexpr int TPT = 8;
    for (int tb = gw; tb < M; tb += TPT * NGW) {
        float ssv[TPT]; f32x2c gg[TPT], pa[TPT][8]; unsigned idw[TPT]; float su0[TPT], su1[TPT], sv0[TPT], sv1[TPT];
#pragma unroll
        for (int r = 0; r < TPT; ++r) { const int t = tb + r * NGW; if (t < M) idw[r] = *(const GAS unsigned*)(IDS + (size_t)t * 128 + 2 * lane); }
#pragma unroll
        for (int r = 0; r < TPT; ++r) { const int t = tb + r * NGW; if (t < M) {
            ssv[r] = lane < 16 ? SS2[(size_t)t * 16 + lane] : 0.f;
            gg[r] = *(const GAS f32x2c*)(GATES + (size_t)t * 128 + 2 * lane);
#pragma unroll
            for (int j = 0; j < 8; ++j) pa[r][j] = *(const GAS f32x2c*)((const float*)(ws + part_slab(j)) + (size_t)t * 128 + 2 * lane); } }
#pragma unroll
        for (int r = 0; r < TPT; ++r) { const int t = tb + r * NGW; if (t < M) { const unsigned i0 = idw[r] & 0xffffu, i1 = idw[r] >> 16; su0[r] = SU[i0]; su1[r] = SU[i1]; sv0[r] = SV[i0]; sv1[r] = SV[i1]; } }
#pragma unroll
        for (int r = 0; r < TPT; ++r) { const int t = tb + r * NGW; if (t < M) {
            const f32x2c a = ((pa[r][0] + pa[r][1]) + (pa[r][2] + pa[r][3])) + ((pa[r][4] + pa[r][5]) + (pa[r][6] + pa[r][7]));
            const float rstd = 1.0f / sqrtf(wave_sum_valu(ssv[r]) * (1.0f / D) + EPS);
            const float x0 = a.x * rstd * su0[r], x1 = a.y * rstd * su1[r];
            const float w0 = gg[r].x * 0.5f * x0 * (1.0f + erff(x0 * 0.70710678118654752f)) * sv0[r], w1 = gg[r].y * 0.5f * x1 * (1.0f + erff(x1 * 0.70710678118654752f)) * sv1[r];
            const float am = wave_max_valu(fmaxf(fabsf(w0), fabsf(w1)));
            const float sc = am > 0.f ? 127.0f / am : 0.f;
            *(GAS unsigned short*)(WQ8 + (size_t)t * 128 + 2 * lane) = (unsigned short)(((unsigned)(int)rintf(w0 * sc) & 255u) | (((unsigned)(int)rintf(w1 * sc) & 255u) << 8));
            if (lane == 0) SW[t] = am * (1.0f / 127.0f);
            if (lane < 16) SS2[(size_t)t * 16 + lane] = 0.f;
        } }
    }
}
__device__ __forceinline__ void p6c_vpass(const Ctx& F, unsigned char* ws, const unsigned short* IDS, const bf16* XB1, bf16* XB2, float* SS3) {
    const P6Geo G = p6_geo(F); const int lane = F.lane_(), g = lane >> 3, c = lane & 7;
    const int ecol = 16 * c + ((lane >> 5) & 1) * 8 + ((lane >> 4) & 1) * 4 + ((lane >> 3) & 1) * 2;
    const signed char* WQ8 = (const signed char*)(ws + WS_WQ8); const float* SW = (const float*)(ws + WS_SW);
#define V_IDS(ID, t_) do { _Pragma("unroll") for (int q = 0; q < 2; ++q) ID[q] = *(const GAS v4u*)(IDS + (size_t)(t_) * 128 + 16 * g + 8 * q); } while (0)
#define V_W(WV, t_) do { WV = *(const GAS v4u*)(WQ8 + (size_t)(t_) * 128 + 16 * g); } while (0)
#define V_GATHER(R, ID) do { _Pragma("unroll") for (int i = 0; i < 16; ++i) { const unsigned w_ = ID[i >> 3][(i >> 1) & 3]; R[i] = *(const GAS v4u*)(Ts + (size_t)((((i & 1) ? (w_ >> 9) : (w_ << 7)) & 0x7fff80u) | c16)); } } while (0)
#define V_COMPUTE(R, WV, t_) do { \
        const size_t o_ = (size_t)(t_) * D + sl * SLW + ecol; \
        const unsigned xq_ = *(const GAS unsigned*)(XB1 + o_); const float sw_ = SW[t_]; \
        int acc[16]; \
        _Pragma("unroll") for (int e = 0; e < 16; ++e) acc[e] = 0; \
        _Pragma("unroll") for (int j = 0; j < 4; ++j) \
            _Pragma("unroll") for (int b = 0; b < 4; ++b) { \
                const unsigned r0_ = R[4 * j][b], r1_ = R[4 * j + 1][b], r2_ = R[4 * j + 2][b], r3_ = R[4 * j + 3][b]; \
                const unsigned x01 = __builtin_amdgcn_perm(r1_, r0_, 0x05010400u), y01 = __builtin_amdgcn_perm(r1_, r0_, 0x07030602u), x23 = __builtin_amdgcn_perm(r3_, r2_, 0x05010400u), y23 = __builtin_amdgcn_perm(r3_, r2_, 0x07030602u); \
                acc[4 * b]     = __builtin_amdgcn_sdot4((int)__builtin_amdgcn_perm(x23, x01, 0x05040100u), (int)WV[j], acc[4 * b], false); \
                acc[4 * b + 1] = __builtin_amdgcn_sdot4((int)__builtin_amdgcn_perm(x23, x01, 0x07060302u), (int)WV[j], acc[4 * b + 1], false); \
                acc[4 * b + 2] = __builtin_amdgcn_sdot4((int)__builtin_amdgcn_perm(y23, y01, 0x05040100u), (int)WV[j], acc[4 * b + 2], false); \
                acc[4 * b + 3] = __builtin_amdgcn_sdot4((int)__builtin_amdgcn_perm(y23, y01, 0x07060302u), (int)WV[j], acc[4 * b + 3], false); } \
        int r8[8], r4[4], r2[2]; \
        _Pragma("unroll") for (int i = 0; i < 8; ++i) r8[i] = pl32_sum(acc[i], acc[i + 8]); \
        _Pragma("unroll") for (int i = 0; i < 4; ++i) r4[i] = pl16_sum(r8[i], r8[i + 4]); \
        _Pragma("unroll") for (int i = 0; i < 2; ++i) { const int send = (lane & 8) ? r4[i] : r4[i + 2], keep = (lane & 8) ? r4[i + 2] : r4[i]; r2[i] = keep + dpp_i<0x128>(send); } \
        const float x0_ = __uint_as_float(xq_ << 16) + sw_ * (float)r2[0], x1_ = __uint_as_float(xq_ & 0xffff0000u) + sw_ * (float)r2[1]; \
        *(GAS unsigned*)(XB2 + o_) = pk2(x0_, x1_); *(GAS unsigned short*)(ws + WS_XB2_8 + o_) = (unsigned short)__builtin_amdgcn_cvt_pk_fp8_f32(x0_, x1_, 0, false); \
        const float ss = wave_sum_valu(x0_ * x0_ + x1_ * x1_); \
        if (lane == 0) SS3[(size_t)(t_) * 16 + sl] = ss; } while (0)
#define V_FENCE() asm volatile("" ::: "memory")
    for (int sl = G.xg; sl < NSL; sl += G.ng) {
        const GAS unsigned char* Ts = (const GAS unsigned char*)(ws + WS_VB) + (size_t)sl * NEXP * SLW; const unsigned c16 = 16u * (unsigned)c;
        const int nk = (M - G.wi + G.nwv - 1) / G.nwv, t0 = G.wi, dt = G.nwv;
        v4u idA[2], idB[2]; v4u wA, wB; v4u rA[16], rB[16];
#ifdef MK_P6C_SIMPLE
        for (int k = 0; k < nk; ++k) { V_IDS(idA, t0 + k * dt); V_GATHER(rA, idA); V_W(wA, t0 + k * dt); V_COMPUTE(rA, wA, t0 + k * dt); }
        (void)idB; (void)wB; (void)rB;
    }
#else
        if (nk > 0) { V_IDS(idA, t0); V_GATHER(rA, idA); V_W(wA, t0); }
        if (nk > 1) V_IDS(idB, t0 + dt);
        V_FENCE();
        for (int k = 0; k < nk; k += 2) {
            if (k + 1 < nk) { V_GATHER(rB, idB); V_W(wB, t0 + (k + 1) * dt); }
            if (k + 2 < nk) V_IDS(idA, t0 + (k + 2) * dt);
            V_FENCE();
            V_COMPUTE(rA, wA, t0 + k * dt);
            V_FENCE();
            if (k + 2 < nk) { V_GATHER(rA, idA); V_W(wA, t0 + (k + 2) * dt); }
            if (k + 3 < nk) V_IDS(idB, t0 + (k + 3) * dt);
            V_FENCE();
            if (k + 1 < nk) V_COMPUTE(rB, wB, t0 + (k + 1) * dt);
            V_FENCE();
        }
    }
#endif
#undef V_IDS
#undef V_W
#undef V_GATHER
#undef V_COMPUTE
#undef V_FENCE
}
__device__ __forceinline__ void p8_final(const Ctx& F, const bf16* XB3, const float* SS4, float* OUT, const float* g) {
    const int gw = F.vcu * NWAVES + F.wave, NGW = F.G * NWAVES, lane = F.lane_();
    f32x4 gv[4];
#pragma unroll
    for (int j = 0; j < 4; ++j) gv[j] = ((const GAS f32x4*)g)[2 * lane + (j & 1) + 128 * (j >> 1)];
    for (int rb = gw; rb < M; rb += 4 * NGW) {
        v4u xa[4], xb[4]; float sv[4];
#pragma unroll
        for (int r = 0; r < 4; ++r) { const int row = rb + r * NGW; if (row < M) { xa[r] = *(const GAS v4u*)(XB3 + (size_t)row * D + 8 * lane); xb[r] = *(const GAS v4u*)(XB3 + (size_t)row * D + 512 + 8 * lane);
            sv[r] = lane < 16 ? SS4[(size_t)row * 16 + lane] : 0.f; } }
#pragma unroll
        for (int r = 0; r < 4; ++r) { const int row = rb + r * NGW; if (row < M) {
            const float rstd = 1.0f / sqrtf(wave_sum(sv[r]) * (1.0f / D) + EPS);
            GAS f32x4* o = (GAS f32x4*)(OUT + (size_t)row * D);
            o[2 * lane] = (f32x4){__uint_as_float(xa[r][0] << 16), __uint_as_float(xa[r][0] & 0xffff0000u), __uint_as_float(xa[r][1] << 16), __uint_as_float(xa[r][1] & 0xffff0000u)} * rstd * gv[0];
            o[2 * lane + 1] = (f32x4){__uint_as_float(xa[r][2] << 16), __uint_as_float(xa[r][2] & 0xffff0000u), __uint_as_float(xa[r][3] << 16), __uint_as_float(xa[r][3] & 0xffff0000u)} * rstd * gv[1];
            o[128 + 2 * lane] = (f32x4){__uint_as_float(xb[r][0] << 16), __uint_as_float(xb[r][0] & 0xffff0000u), __uint_as_float(xb[r][1] << 16), __uint_as_float(xb[r][1] & 0xffff0000u)} * rstd * gv[2];
            o[128 + 2 * lane + 1] = (f32x4){__uint_as_float(xb[r][2] << 16), __uint_as_float(xb[r][2] & 0xffff0000u), __uint_as_float(xb[r][3] << 16), __uint_as_float(xb[r][3] & 0xffff0000u)} * rstd * gv[3];
        } }
    }
}
struct OneUnit {
    pg8::Unit u;
    __device__ __forceinline__ bool next(int i, pg8::Unit& o) const { if (i != 0) return false; o = u; return true; }
    __device__ __forceinline__ void a_ready(const pg8::Unit&) const {}
    __device__ __forceinline__ void done(const pg8::Unit&) const {}
};

__global__ void __launch_bounds__(NWAVES * 64, 2) mk_fwd(Args args) {
    extern __shared__ __attribute__((aligned(16))) unsigned char lds[];
    Ctx F;
    F.lds = (LAS unsigned char*)lds;
    F.wave = __builtin_amdgcn_readfirstlane((int)threadIdx.x >> 6);
    F.G = gridDim.x; { const int bx = blockIdx.x; F.vcu = (F.G % 8 == 0) ? (bx % 8) * (F.G / 8) + bx / 8 : bx; }
    volatile LAS unsigned* MISC = (volatile LAS unsigned*)(F.lds + MISC_OFF);
    unsigned char* ws = args.ws;
    gu32* ctl = (gu32*)(ws + WS_CTL);
    for (int u = F.tid_(); u < (LDS_BYTES - LDSCTL_OFF) / 4; u += NWAVES * 64) ((LAS unsigned*)(F.lds + LDSCTL_OFF))[u] = 0u;
    __syncthreads();
    const int lo = args.ph_lo, hi = args.ph_hi;
    const bool multi = (hi - lo) > 1 || (lo <= 6 && 6 < hi);
    XcdBarrier bar; bar.bar = (unsigned*)(ctl + CW_BAR) + args.li * XCD_BAR_WORDS; bar.x = 0; bar.st = nullptr;
    if (multi) bar = xcd_barrier_post((unsigned*)(ctl + CW_BAR) + args.li * XCD_BAR_WORDS, MISC + 8);
#ifndef MK_CMASK
#define MK_CMASK 0x1ff
#endif
#define IN(k) (((MK_CMASK >> (k)) & 1) && lo <= (k) && (k) < hi)
#ifdef MK_PROBE_BAR2
#define SEAM(k) do { if (IN(k) && IN((k) + 1)) { xcd_barrier(bar); for (int rb_ = 1; rb_ < MK_PROBE_BAR2; ++rb_) xcd_barrier(bar); } STAMPI((k) < 6 ? (k) + 1 : (k) + 3); } while (0)
#else
#define SEAM(k) do { if (IN(k) && IN((k) + 1)) xcd_barrier(bar); STAMPI((k) < 6 ? (k) + 1 : (k) + 3); } while (0)
#endif
#ifdef MK_PROBE_SEG
#define STAMPI(i_) do { if (((i_) == MK_PROBE_SEG || (i_) == MK_PROBE_SEG + 1 || (MK_PROBE_SEG == 200 && ((i_) == 0 || (i_) == 11))) && blockIdx.x == 0 && threadIdx.x == 0) { ((unsigned long long*)(args.ws + 32768))[(i_)] = __builtin_amdgcn_s_memrealtime(); } } while (0)
    STAMPI(0);
#else
#define STAMPI(i_) do { } while (0)
#endif
    float* out = args.out;
#define WSP(T, off) ((T*)(ws + (off)))
#define RSTD1 WSP(float, WS_RSTD1)
#define SS2 WSP(float, WS_SS2)
#define LF WSP(float, WS_LF)
#define WIN WSP(bf16, WS_WIN)
#define WBR WSP(bf16, WS_WBR)
#define WOUT WSP(bf16, WS_WOUT)
#define WST WSP(bf16, WS_WS)
#define WPG WSP(bf16, WS_WPG)
#define WPP WSP(bf16, WS_WPP)
#define PB WSP(bf16, WS_PB)
#define XB WSP(bf16, WS_A)
#define AC WSP(bf16, WS_AC)
#define XB1 WSP(bf16, WS_A)
#define PP WSP(bf16, WS_PP)
#define Q WSP(bf16, WS_Q)
#define K WSP(bf16, WS_K)
#define V WSP(bf16, WS_V)
#define GB WSP(bf16, WS_GB)
#define Z WSP(bf16, WS_Z)
#define MG WSP(bf16, WS_MERGED)
#define XB2 WSP(bf16, WS_XB2)
#define IDS WSP(unsigned short, WS_IDS)
#define GATES WSP(float, WS_GATES)
#define SGA ((bf16*)out)
#define SGC ((bf16*)out + (size_t)M * D)

    if (IN(0)) { p0_prologue(F, args, MISC); }
    SEAM(0);
    if (IN(1)) {
        { pg8::Gemm g{XB, WIN, M, 3072, D}; pg8::StaticOrder S; S.init(M, 3072, F.G, (int)blockIdx.x);
          pg8::EpiIn E{RSTD1, Q, (size_t)(WS_K - WS_Q) / 2, Z, SGA, (size_t)M * D, C2};
          static_assert(WS_V - WS_K == WS_K - WS_Q && WS_GB - WS_V == WS_K - WS_Q, "Q | K | V | GB equally spaced");
          pg8::gemm_phase<pg8::EpiIn, pg8::StaticOrder, PG8_ALIGN, PG8_SP2>(F.lds + RING_OFF, g, S, E, F.wave); }
        { pg8::Gemm g{WSP(bf16, WS_XB8), WSP(bf16, WS_WIN8), M, 2048, D / 2}; pg8::StaticOrder S; S.init(M, 2048, F.G, (int)blockIdx.x);
          pg8::EpiGate E{RSTD1, SGA, (size_t)M * D, 1.0f / 32.0f};
          pg8::gemm_phase<pg8::EpiGate, pg8::StaticOrder, PG8_ALIGN, PG8_SP2, true>(F.lds + RING_OFF, g, S, E, F.wave); }
        { pg8::Gemm g{PB, WPP, M, D, PLE}; pg8::StaticOrder S; S.init(M, D, F.G, (int)blockIdx.x);
          pg8::EpiPlain E{PP, D};
          pg8::gemm_phase<pg8::EpiPlain, pg8::StaticOrder, PG8_ALIGN, PG8_SP2>(F.lds + RING_OFF, g, S, E, F.wave); }
    }
    SEAM(1);
    if (IN(2)) {
        unsigned* qctr = (unsigned*)(ctl + CW_QUEUE);
        for (;;) {
            const int idx = p2_dequeue(qctr, MISC + 12);
            if (idx >= P2_NITEMS) break;
            if (idx < P2_NATT) { const int qb = 15 - (idx >> 5), bh = idx & 31;
                attn_body::attn_unit<8>(bh >> 3, bh & 7, qb, (const attn_body::bf16*)Q, (const attn_body::bf16*)K, (const attn_body::bf16*)V, (attn_body::bf16*)AC, LF + (size_t)bh * SEQ, (char*)lds + RING_OFF); }
            else if (idx < P2_NATT + P2_NQ) {
                int lane_l = (int)threadIdx.x & 63; asm volatile("" : "+v"(lane_l));
                const int r0 = (idx - P2_NATT) * 64 + F.wave * 8;
                quant_rows4(args, r0, lane_l); quant_rows4(args, r0 + 4, lane_l);
            }
            else if (idx < P2_NATT + P2_NQ + P2_NCONV) p2_conv_chunk(idx - P2_NATT - P2_NQ, GB, Z, args.in[5], AC);
            else if (idx < P2_NATT + P2_NQ + P2_NCONV + P2_NWS) ws_item(args, F.lds + RING_OFF, idx - P2_NATT - P2_NQ - P2_NCONV);
            else { int lane_l = (int)threadIdx.x & 63; asm volatile("" : "+v"(lane_l));
                const int w0 = TR_P0 + (idx - P2_NATT - P2_NQ - P2_NCONV - P2_NWS) * 16 + F.wave * 2;
                tr_two(args, (LAS float*)(F.lds + RING_OFF + F.wave * 16384), w0, w0 + 1, true, lane_l); }
        }
    }
    SEAM(2);
    if (IN(3)) {
        pg8::Gemm g{AC, WBR, M, D, D}; pg8::StaticOrder S; S.init(M, D, F.G, (int)blockIdx.x);
        pg8::EpiBranch E{SGA, SGC, MG};
        pg8::gemm_phase<pg8::EpiBranch, pg8::StaticOrder, PG8_ALIGN, PG8_SP2>(F.lds + RING_OFF, g, S, E, F.wave);
    }
    SEAM(3);
    if (IN(4)) {
        pg8::Gemm g{MG, WOUT, M, D, D}; pg8::StaticOrder S; S.init(M, D, F.G, (int)blockIdx.x);
        pg8::EpiOut E{XB, XB1, SS2};
        pg8::gemm_phase<pg8::EpiOut, pg8::StaticOrder, PG8_ALIGN, PG8_SP2>(F.lds + RING_OFF, g, S, E, F.wave);
    }
    SEAM(4);
    if (IN(5)) {
        pg8::Gemm g{XB1, WST, M, NS, D}; pg8::StaticOrder S; S.init(M, NS, F.G, (int)blockIdx.x);
        pg8::EpiTopK E{SS2, IDS, GATES, EPS};
        pg8::Unit u;
        for (int i = 0; S.next(i, u); ++i) { OneUnit O{u}; pg8::gemm_phase<pg8::EpiTopK, OneUnit, false, PG8_SP2>(F.lds + RING_OFF, g, O, E, F.wave); }
    }
    SEAM(5);
    if (IN(6)) { p6a_upass(F, ws, XB1, IDS); xcd_barrier(bar); STAMPI(7); p6b_combine(F, ws, SS2, IDS, GATES); xcd_barrier(bar); STAMPI(8); p6c_vpass(F, ws, IDS, XB1, XB2, SS2); }
    SEAM(6);
    if (IN(7)) {
        pg8::Gemm g{WSP(bf16, WS_XB2_8), WPG, M, D, D / 2}; pg8::StaticOrder S; S.init(M, D, F.G, (int)blockIdx.x);
        LAS float* rtab = (LAS float*)(F.lds + RING_OFF + pg8::STAGE_BYTES);
        const bool one = (M / 256) * (D / 256) <= F.G; pg8::Unit u0;
        if (one && S.next(0, u0) && F.tid_() < 256) { const float* sp = SS2 + (size_t)(u0.pm * 256 + F.tid_()) * 16; float q = 0.f;
#pragma unroll
            for (int j = 0; j < NSL; ++j) q += sp[j];
            rtab[F.tid_()] = 1.0f / sqrtf(q * (1.0f / D) + EPS); }
        __syncthreads();
        pg8::EpiPle E{SS2, PP, XB2, WSP(bf16, WS_XB3), WSP(float, WS_SS4), EPS, 1.0f / 32.0f, one ? (const LAS float*)rtab : (const LAS float*)nullptr};
        pg8::gemm_phase<pg8::EpiPle, pg8::StaticOrder, PG8_ALIGN, PG8_SP2, true>(F.lds + RING_OFF, g, S, E, F.wave);
    }
    SEAM(7);
    if (IN(8)) { p8_final(F, WSP(bf16, WS_XB3), WSP(float, WS_SS4), out, args.in[17]); }
    STAMPI(11);
#ifdef MK_PROBE_SEG
    if (blockIdx.x == 0 && F.tid_() == 0) {
        asm volatile("s_waitcnt vmcnt(0)" ::: "memory");
        const unsigned long long* st_ = (const unsigned long long*)(args.ws + 32768);
#if MK_PROBE_SEG >= 100 && MK_PROBE_SEG != 200
        const unsigned long long a_ = st_[32 + (MK_PROBE_SEG - 100)], b_ = (MK_PROBE_SEG - 100 == 4) ? st_[1] : st_[33 + (MK_PROBE_SEG - 100)];
#else
        const unsigned long long a_ = st_[MK_PROBE_SEG == 200 ? 0 : MK_PROBE_SEG], b_ = st_[MK_PROBE_SEG == 200 ? 11 : MK_PROBE_SEG + 1];
#endif
        const unsigned long long dt_ = (b_ - a_) * MK_PROBE_MULT, t0_ = __builtin_amdgcn_s_memrealtime();
        while (__builtin_amdgcn_s_memrealtime() - t0_ < dt_) __builtin_amdgcn_s_sleep(8);
    }
#endif
#undef IN
#undef SEAM
#undef WSP
#undef RSTD1
#undef SS2
#undef LF
#undef WIN
#undef WBR
#undef WOUT
#undef WST
#undef WPG
#undef WPP
#undef PB
#undef XB
#undef AC
#undef XB1
#undef PP
#undef Q
#undef K
#undef V
#undef GB
#undef Z
#undef MG
#undef XB2
#undef IDS
#undef GATES
#undef SGA
#undef SGC
}

extern "C" void kernel_launch(void* const* d_in, const int* in_sizes, int n_in, void* d_out, int out_size, void* d_ws, size_t ws_size, hipStream_t stream) {
    static int grid = 0;
    if (grid == 0) {
        if (n_in != 18 || in_sizes[0] != M * D || out_size != M * D || ws_size < WS_END) { fprintf(stderr, "kernel_launch: unexpected shapes (n_in %d, in0 %d, out %d, ws %zu); nothing launched\n", n_in, n_in > 0 ? in_sizes[0] : -1, out_size, ws_size); grid = -1; return; }
        int dev = 0, cus = 0, per_cu = 0;
        if (hipGetDevice(&dev) != hipSuccess || hipDeviceGetAttribute(&cus, hipDeviceAttributeMultiprocessorCount, dev) != hipSuccess) { fprintf(stderr, "kernel_launch: device query failed\n"); grid = -1; return; }
        if (hipFuncSetAttribute((const void*)mk_fwd, hipFuncAttributeMaxDynamicSharedMemorySize, LDS_BYTES) != hipSuccess) { fprintf(stderr, "kernel_launch: hipFuncSetAttribute failed\n"); grid = -1; return; }
        if (hipOccupancyMaxActiveBlocksPerMultiprocessor(&per_cu, (const void*)mk_fwd, NWAVES * 64, LDS_BYTES) != hipSuccess || per_cu < 1) { fprintf(stderr, "kernel_launch: occupancy query says %d workgroups per CU; nothing launched\n", per_cu); (void)hipGetLastError(); grid = -1; return; }
        grid = cus;
    }
    if (grid < 0) return;
    if (hipMemsetAsync((char*)d_ws + WS_CTL, 0, CTL_ZERO_BYTES, stream) != hipSuccess) { fprintf(stderr, "kernel_launch: hipMemsetAsync failed\n"); return; }
    Args a{};
    for (int i = 0; i < 18; ++i) a.in[i] = (const float*)d_in[i];
    a.out = (float*)d_out; a.ws = (unsigned char*)d_ws; a.ph_lo = 0; a.ph_hi = NPHASE; a.li = 0; a.pad = 0;
    hipLaunchKernelGGL(mk_fwd, dim3(grid), dim3(NWAVES * 64), LDS_BYTES, stream, a);
    const hipError_t le = hipPeekAtLastError();
    if (le != hipSuccess) fprintf(stderr, "kernel_launch: launch failed: %s\n", hipGetErrorName(le));
}
```

```cpp
#include <hip/hip_runtime.h>
#include <hip/hip_bf16.h>
#include <cstdio>
#include <cstdint>
#include <cmath>
namespace pg8 {
#define PG8_LAS __attribute__((address_space(3)))
typedef unsigned short bf16_t;
typedef short bf16x8 __attribute__((ext_vector_type(8)));
typedef float f32x4 __attribute__((ext_vector_type(4)));
typedef unsigned u32x4 __attribute__((ext_vector_type(4)));
constexpr int BM = 256, BK = 64, HALF = 128, HTB = HALF * BK * 2  , STAGE_BYTES = 8 * HTB, NXCD = 8, WGM = 8;

__host__ __device__ __forceinline__ int lds_byte(int r, int c) { const int st = (r >> 4) * 2 + (c >> 5), rr = r & 15, cc = c & 31, ob = rr * 64 + cc * 2; return st * 1024 + (ob ^ (((ob >> 9) & 1) << 5)); }
__host__ __device__ __forceinline__ void stage_rc(int b, int& R, int& C) { const int st = b / 1024, sb = b % 1024, swz = sb ^ (((sb >> 9) & 1) << 5); R = (st >> 1) * 16 + swz / 64; C = (st & 1) * 32 + (swz % 64) / 2; }
__host__ __device__ __forceinline__ int perm32(int rho) { const int n = rho >> 4, i = rho & 15; return 8 * (i >> 2) + 4 * n + (i & 3); }

struct Unit { int pm, pn; };
struct Gemm { const bf16_t* A; const bf16_t* Bt; int M, N, K; };

struct StaticOrder {
    int nM, nN, nwg, G, c;
    __host__ __device__ __forceinline__ void init(int M, int N, int G_, int c_) { nM = M / BM; nN = N / BM; nwg = nM * nN; G = G_; c = c_; }
    __host__ __device__ __forceinline__ bool next(int i, Unit& u) const {
        const long L = (long)i * G + c; if (L >= nwg) return false;
        int wgid = (int)L; { const int q = nwg / NXCD, r = nwg % NXCD, xcd = wgid % NXCD, off = wgid / NXCD; wgid = (xcd < r ? xcd * (q + 1) : r * (q + 1) + (xcd - r) * q) + off; }
        const int nig = WGM * nN, gid = wgid / nig, fm = gid * WGM, gsz = (nM - fm) < WGM ? (nM - fm) : WGM;
        u.pm = fm + ((wgid % nig) % gsz); u.pn = (wgid % nig) / gsz; return true;
    }
    __device__ __forceinline__ void a_ready(const Unit&) const {}
    __device__ __forceinline__ void done(const Unit&) const {}
};


__device__ __forceinline__ unsigned cvt_pk_bf16(float lo, float hi) { unsigned r; asm volatile("v_cvt_pk_bf16_f32 %0, %1, %2" : "=v"(r) : "v"(lo), "v"(hi)); return r; }
__device__ __forceinline__ u32x4 pack8(const f32x4 v0, const f32x4 v1) { u32x4 w; w.x = cvt_pk_bf16(v0[0], v0[1]); w.y = cvt_pk_bf16(v0[2], v0[3]); w.z = cvt_pk_bf16(v1[0], v1[1]); w.w = cvt_pk_bf16(v1[2], v1[3]); return w; }
__device__ __forceinline__ float bflo(unsigned w) { return __uint_as_float(w << 16); }
__device__ __forceinline__ float bfhi(unsigned w) { return __uint_as_float(w & 0xffff0000u); }
__device__ __forceinline__ float sigm(float v) { return __builtin_amdgcn_rcpf(1.0f + __builtin_amdgcn_exp2f(v * -1.4426950408889634f)); }
__device__ __forceinline__ f32x4 sigm4(const f32x4 v) { return (f32x4){sigm(v[0]), sigm(v[1]), sigm(v[2]), sigm(v[3])}; }

__device__ __forceinline__ float sum_fq(float v) {
    { const auto s_ = __builtin_amdgcn_permlane16_swap(__float_as_uint(v), __float_as_uint(v), false, false); v = __uint_as_float(s_[0]) + __uint_as_float(s_[1]); }
    { const auto s_ = __builtin_amdgcn_permlane32_swap(__float_as_uint(v), __float_as_uint(v), false, false); v = __uint_as_float(s_[0]) + __uint_as_float(s_[1]); }
    return v;
}
struct EpiIn {
    static constexpr int PROBE_ID = 1;
    static constexpr bool PERM = true, AFTER_DRAIN = false; static constexpr int MID_T = 0;
    const float* rstd; bf16_t* QKVG; size_t stride4; bf16_t* Z; bf16_t* SG; size_t strideSG; float c2;
    __device__ __forceinline__ void operator()(const f32x4 (&acc)[2][2][4][2], const Unit& u, int wr, int wc, int fr, int fq) const {
        int t_l = (int)__builtin_amdgcn_mbcnt_hi(~0u, __builtin_amdgcn_mbcnt_lo(~0u, 0u)); asm volatile("" : "+v"(t_l)); fr = t_l & 15; fq = t_l >> 4;
        const int row0 = u.pm * BM + wr * 64 + fr; const int cl = wc * 32 + 8 * fq, pn = u.pn;
        if (pn < 8) {
            bf16_t* base = QKVG + (size_t)(pn >> 1) * stride4; const int colt = (pn & 1) * 256 + cl; const float s0 = pn < 2 ? c2 : 1.f;
#pragma unroll
            for (int ai = 0; ai < 2; ++ai)
#pragma unroll
                for (int m = 0; m < 4; ++m) { const int row = row0 + ai * HALF + m * 16; const float sc = rstd[row] * s0; bf16_t* rowp = base + (size_t)row * 512 + colt;
#pragma unroll
                    for (int bj = 0; bj < 2; ++bj) *(u32x4*)(rowp + bj * HALF) = pack8(acc[ai][bj][m][0] * sc, acc[ai][bj][m][1] * sc);
                    asm volatile("" ::: "memory"); }
        } else if (pn < 12) {
            const int colt = (pn - 8) * 128 + cl;
#pragma unroll
            for (int ai = 0; ai < 2; ++ai)
#pragma unroll
                for (int m = 0; m < 4; ++m) { const int row = row0 + ai * HALF + m * 16; const float r = rstd[row], sc = r * r;
                    *(u32x4*)(Z + (size_t)row * 512 + colt) = pack8(acc[ai][0][m][0] * acc[ai][1][m][0] * sc, acc[ai][0][m][1] * acc[ai][1][m][1] * sc);
                    asm volatile("" ::: "memory"); }
        }
    }
};
struct EpiGate {
    static constexpr int PROBE_ID = 8;
    static constexpr bool PERM = true, AFTER_DRAIN = false; static constexpr int MID_T = 0;
    const float* rstd; bf16_t* SG; size_t strideSG; float wsc;
    __device__ __forceinline__ void operator()(const f32x4 (&acc)[2][2][4][2], const Unit& u, int wr, int wc, int fr, int fq) const {
        int t_l = (int)__builtin_amdgcn_mbcnt_hi(~0u, __builtin_amdgcn_mbcnt_lo(~0u, 0u)); asm volatile("" : "+v"(t_l)); fr = t_l & 15; fq = t_l >> 4;
        const int row0 = u.pm * BM + wr * 64 + fr; const int cl = wc * 32 + 8 * fq;
        {
            const int colt = u.pn * 128 + cl;
#pragma unroll
            for (int ai = 0; ai < 2; ++ai)
#pragma unroll
                for (int m = 0; m < 4; ++m) { const int row = row0 + ai * HALF + m * 16; const float r = rstd[row] * wsc;
                    f32x4 ra[2], sc_[2];
#pragma unroll
                    for (int n = 0; n < 2; ++n) {
#pragma unroll
                        for (int e = 0; e < 4; ++e) { const float ea = __builtin_amdgcn_exp2f(acc[ai][0][m][n][e] * r * -1.4426950408889634f), ec = __builtin_amdgcn_exp2f(acc[ai][1][m][n][e] * r * -1.4426950408889634f);
                            sc_[n][e] = __builtin_amdgcn_rcpf(1.0f + ec); ra[n][e] = (1.0f + ec) * __builtin_amdgcn_rcpf(1.0f + ea); } }
                    *(u32x4*)(SG + (size_t)row * 1024 + colt) = pack8(ra[0], ra[1]); *(u32x4*)(SG + strideSG + (size_t)row * 1024 + colt) = pack8(sc_[0], sc_[1]);
                    asm volatile("" ::: "memory"); }
        }
    }
};
struct EpiPlain {
    static constexpr int PROBE_ID = 2;
    static constexpr bool PERM = true, AFTER_DRAIN = false; static constexpr int MID_T = 0;
    bf16_t* O; int ldc;
    __device__ __forceinline__ void operator()(const f32x4 (&acc)[2][2][4][2], const Unit& u, int wr, int wc, int fr, int fq) const {
        int t_l = (int)__builtin_amdgcn_mbcnt_hi(~0u, __builtin_amdgcn_mbcnt_lo(~0u, 0u)); asm volatile("" : "+v"(t_l)); fr = t_l & 15; fq = t_l >> 4;
        const int row0 = u.pm * BM + wr * 64 + fr; const int col0 = u.pn * BM + wc * 32 + 8 * fq;
#pragma unroll
        for (int ai = 0; ai < 2; ++ai)
#pragma unroll
            for (int m = 0; m < 4; ++m) { bf16_t* rowp = O + (size_t)(row0 + ai * HALF + m * 16) * ldc + col0;
#pragma unroll
                for (int bj = 0; bj < 2; ++bj) *(u32x4*)(rowp + bj * HALF) = pack8(acc[ai][bj][m][0], acc[ai][bj][m][1]); }
    }
};
struct EpiBranch {
    static constexpr int PROBE_ID = 3;
    static constexpr bool PERM = true, AFTER_DRAIN = false; static constexpr int MID_T = 8;
    const bf16_t *SGA, *SGC; bf16_t* MG;
    __device__ __forceinline__ void mid(f32x4 (&acc)[2][2][4][2], const Unit& u, int wr, int wc, int fr, int fq) const {
        int t_l = (int)__builtin_amdgcn_mbcnt_hi(~0u, __builtin_amdgcn_mbcnt_lo(~0u, 0u)); asm volatile("" : "+v"(t_l)); fr = t_l & 15; fq = t_l >> 4;
        const int row0 = u.pm * BM + wr * 64 + fr; const int col0 = u.pn * BM + wc * 32 + 8 * fq;
#pragma unroll
        for (int ai = 0; ai < 2; ++ai) {
            u32x4 a[4][2];
#pragma unroll
            for (int m = 0; m < 4; ++m)
#pragma unroll
                for (int bj = 0; bj < 2; ++bj) a[m][bj] = *(const u32x4*)(SGA + (size_t)(row0 + ai * HALF + m * 16) * 1024 + col0 + bj * HALF);
#pragma unroll
            for (int m = 0; m < 4; ++m)
#pragma unroll
                for (int bj = 0; bj < 2; ++bj) { const u32x4 av = a[m][bj];
                    acc[ai][bj][m][0] *= (f32x4){bflo(av[0]), bfhi(av[0]), bflo(av[1]), bfhi(av[1])}; acc[ai][bj][m][1] *= (f32x4){bflo(av[2]), bfhi(av[2]), bflo(av[3]), bfhi(av[3])}; }
            asm volatile("" ::: "memory");
        }
    }
    __device__ __forceinline__ void operator()(const f32x4 (&acc)[2][2][4][2], const Unit& u, int wr, int wc, int fr, int fq) const {
        int t_l = (int)__builtin_amdgcn_mbcnt_hi(~0u, __builtin_amdgcn_mbcnt_lo(~0u, 0u)); asm volatile("" : "+v"(t_l)); fr = t_l & 15; fq = t_l >> 4;
        const int row0 = u.pm * BM + wr * 64 + fr; const int col0 = u.pn * BM + wc * 32 + 8 * fq;
#pragma unroll
        for (int ai = 0; ai < 2; ++ai) {
            u32x4 c[4][2];
#pragma unroll
            for (int m = 0; m < 4; ++m)
#pragma unroll
                for (int bj = 0; bj < 2; ++bj) c[m][bj] = *(const u32x4*)(SGC + (size_t)(row0 + ai * HALF + m * 16) * 1024 + col0 + bj * HALF);
#pragma unroll
            for (int m = 0; m < 4; ++m)
#pragma unroll
                for (int bj = 0; bj < 2; ++bj) { const u32x4 cv = c[m][bj];
                    const f32x4 s0 = {bflo(cv[0]), bfhi(cv[0]), bflo(cv[1]), bfhi(cv[1])}, s1 = {bflo(cv[2]), bfhi(cv[2]), bflo(cv[3]), bfhi(cv[3])};
                    *(u32x4*)(MG + (size_t)(row0 + ai * HALF + m * 16) * 1024 + col0 + bj * HALF) = pack8(acc[ai][bj][m][0] * s0, acc[ai][bj][m][1] * s1); }
            asm volatile("" ::: "memory");
        }
    }
};
struct EpiOut {
    static constexpr int PROBE_ID = 4;
    static constexpr bool PERM = true, AFTER_DRAIN = false; static constexpr int MID_T = 0;
    const bf16_t* XBin; bf16_t* XB1; float* SS2;
    __device__ __forceinline__ void operator()(const f32x4 (&acc)[2][2][4][2], const Unit& u, int wr, int wc, int fr, int fq) const {
        int t_l = (int)__builtin_amdgcn_mbcnt_hi(~0u, __builtin_amdgcn_mbcnt_lo(~0u, 0u)); asm volatile("" : "+v"(t_l)); fr = t_l & 15; fq = t_l >> 4;
        const int row0 = u.pm * BM + wr * 64 + fr; const int col0 = u.pn * BM + wc * 32 + 8 * fq;
#pragma unroll
        for (int ai = 0; ai < 2; ++ai) {
            u32x4 xq[4][2];
#pragma unroll
            for (int m = 0; m < 4; ++m)
#pragma unroll
                for (int bj = 0; bj < 2; ++bj) xq[m][bj] = *(const u32x4*)(XBin + (size_t)(row0 + ai * HALF + m * 16) * 1024 + col0 + bj * HALF);
#pragma unroll
            for (int m = 0; m < 4; ++m) { const int row = row0 + ai * HALF + m * 16; float ss = 0.f;
#pragma unroll
                for (int bj = 0; bj < 2; ++bj) { const u32x4 q = xq[m][bj];
                    const f32x4 v0 = acc[ai][bj][m][0] + (f32x4){bflo(q[0]), bfhi(q[0]), bflo(q[1]), bfhi(q[1])}, v1 = acc[ai][bj][m][1] + (f32x4){bflo(q[2]), bfhi(q[2]), bflo(q[3]), bfhi(q[3])};
                    *(u32x4*)(XB1 + (size_t)row * 1024 + col0 + bj * HALF) = pack8(v0, v1);
                    ss += (v0[0] * v0[0] + v0[1] * v0[1]) + (v0[2] * v0[2] + v0[3] * v0[3]) + (v1[0] * v1[0] + v1[1] * v1[1]) + (v1[2] * v1[2] + v1[3] * v1[3]); }
                ss = sum_fq(ss);
                if (fq == 0) SS2[(size_t)row * 16 + u.pn * 4 + wc] = ss; }
            asm volatile("" ::: "memory");
        }
    }
};
struct EpiPle {
    static constexpr int PROBE_ID = 7;
    static constexpr bool PERM = true, AFTER_DRAIN = false; static constexpr int MID_T = 0;
    const float* SS3; const bf16_t* PP; const bf16_t* XB2; bf16_t* XB3; float* SS4; float eps; float wsc; const PG8_LAS float* rtab;
    __device__ __forceinline__ void operator()(const f32x4 (&acc)[2][2][4][2], const Unit& u, int wr, int wc, int fr, int fq) const {
        int t_l = (int)__builtin_amdgcn_mbcnt_hi(~0u, __builtin_amdgcn_mbcnt_lo(~0u, 0u)); asm volatile("" : "+v"(t_l)); fr = t_l & 15; fq = t_l >> 4;
        const int row0 = u.pm * BM + wr * 64 + fr; const int col0 = u.pn * BM + wc * 32 + 8 * fq;
#pragma unroll
        for (int ah = 0; ah < 4; ++ah) {
            const int ai = ah >> 1, m0 = (ah & 1) * 2;
            u32x4 pv[2][2], xb[2][2]; float rr[2];
#pragma unroll
            for (int mm = 0; mm < 2; ++mm) { const int m = m0 + mm; const int row = row0 + ai * HALF + m * 16;
#pragma unroll
                for (int bj = 0; bj < 2; ++bj) { const size_t off = (size_t)row * 1024 + col0 + bj * HALF; pv[mm][bj] = *(const u32x4*)(PP + off); xb[mm][bj] = *(const u32x4*)(XB2 + off); }
                if (rtab) rr[mm] = rtab[wr * 64 + fr + ai * HALF + m * 16];
                else { const f32x4* sp = (const f32x4*)(SS3 + (size_t)row * 16); const f32x4 q0 = sp[0], q1 = sp[1]; rr[mm] = 1.0f / sqrtf((((q0[0] + q0[1]) + (q0[2] + q0[3])) + ((q1[0] + q1[1]) + (q1[2] + q1[3]))) * (1.0f / 1024.0f) + eps); } }
#pragma unroll
            for (int mm = 0; mm < 2; ++mm) { const int m = m0 + mm; const int row = row0 + ai * HALF + m * 16; const float r = rr[mm] * wsc; float ss = 0.f;
#pragma unroll
                for (int bj = 0; bj < 2; ++bj) { const u32x4 c = pv[mm][bj], xq = xb[mm][bj]; const size_t off = (size_t)row * 1024 + col0 + bj * HALF;
                    const f32x4 p0 = {bflo(c[0]), bfhi(c[0]), bflo(c[1]), bfhi(c[1])}, p1 = {bflo(c[2]), bfhi(c[2]), bflo(c[3]), bfhi(c[3])};
                    const f32x4 x0 = {bflo(xq[0]), bfhi(xq[0]), bflo(xq[1]), bfhi(xq[1])}, x1 = {bflo(xq[2]), bfhi(xq[2]), bflo(xq[3]), bfhi(xq[3])};
                    const f32x4 v0 = x0 + sigm4(acc[ai][bj][m][0] * r) * p0, v1 = x1 + sigm4(acc[ai][bj][m][1] * r) * p1;
                    *(u32x4*)(XB3 + off) = pack8(v0, v1);
                    ss += (v0[0] * v0[0] + v0[1] * v0[1]) + (v0[2] * v0[2] + v0[3] * v0[3]) + (v1[0] * v1[0] + v1[1] * v1[1]) + (v1[2] * v1[2] + v1[3] * v1[3]); }
                ss = sum_fq(ss);
                if (fq == 0) SS4[(size_t)row * 16 + u.pn * 4 + wc] = ss; }
            asm volatile("" ::: "memory");
        }
    }
};

__device__ __forceinline__ float vmaxf(float a, float b) { float r; asm("v_max_f32_e32 %0, %1, %2" : "=v"(r) : "v"(a), "v"(b)); return r; }
__device__ __forceinline__ float vminf(float a, float b) { float r; asm("v_min_f32_e32 %0, %1, %2" : "=v"(r) : "v"(a), "v"(b)); return r; }
__device__ __forceinline__ void sort16_desc(float (&a)[16]) {
#define TK_CE(i, j) do { const float hi_ = vmaxf(a[i], a[j]), lo_ = vminf(a[i], a[j]); a[i] = hi_; a[j] = lo_; } while (0)
    TK_CE(0, 13); TK_CE(1, 12); TK_CE(2, 15); TK_CE(3, 14); TK_CE(4, 8); TK_CE(5, 6); TK_CE(7, 11); TK_CE(9, 10);
    TK_CE(0, 5); TK_CE(1, 7); TK_CE(2, 9); TK_CE(3, 4); TK_CE(6, 13); TK_CE(8, 14); TK_CE(10, 15); TK_CE(11, 12);
    TK_CE(0, 1); TK_CE(2, 3); TK_CE(4, 5); TK_CE(6, 8); TK_CE(7, 9); TK_CE(10, 11); TK_CE(12, 13); TK_CE(14, 15);
    TK_CE(0, 2); TK_CE(1, 3); TK_CE(4, 10); TK_CE(5, 11); TK_CE(6, 7); TK_CE(8, 9); TK_CE(12, 14); TK_CE(13, 15);
    TK_CE(1, 2); TK_CE(3, 12); TK_CE(4, 6); TK_CE(5, 7); TK_CE(8, 10); TK_CE(9, 11); TK_CE(13, 14);
    TK_CE(1, 4); TK_CE(2, 6); TK_CE(5, 8); TK_CE(7, 10); TK_CE(9, 13); TK_CE(11, 14);
    TK_CE(2, 4); TK_CE(3, 6); TK_CE(9, 12); TK_CE(11, 13);
    TK_CE(3, 5); TK_CE(6, 8); TK_CE(7, 9); TK_CE(10, 12);
    TK_CE(3, 4); TK_CE(5, 6); TK_CE(7, 8); TK_CE(9, 10); TK_CE(11, 12);
    TK_CE(6, 7); TK_CE(8, 9);
#undef TK_CE
}
template <int L> __device__ __forceinline__ void merge16(float (&a)[16], const float (&b)[16]) {
#pragma unroll
    for (int i = 0; i < 16; ++i) if (15 - i < L) a[i] = vmaxf(a[i], b[15 - i]);
#pragma unroll
    for (int j = 8; j > 0; j >>= 1)
#pragma unroll
        for (int i = 0; i < 16; ++i) { const int l = i ^ j; if (l > i) { const float hi = vmaxf(a[i], a[l]), lo = vminf(a[i], a[l]); a[i] = hi; a[l] = lo; } }
}
struct EpiTopK {
    static constexpr int PROBE_ID = 5;
    static constexpr bool PERM = true, AFTER_DRAIN = true; static constexpr int MID_T = 0;
    static constexpr int RS = 260;
    const float* SS2; unsigned short* IDS; float* GATES; float eps;
    __device__ __forceinline__ void fused(f32x4 (&acc)[2][2][4][2], const Unit& u, int wr, int wc, int fr, int fq, PG8_LAS unsigned char* lds, int wid, int lane) const {
        PG8_LAS float* S = (PG8_LAS float*)lds;
        const int tid = wid * 64 + lane, row = tid & 127, grp = tid >> 7, half = grp >> 1, part = grp & 1;
#define TK_BAR() do { asm volatile("s_waitcnt lgkmcnt(0)" ::: "memory"); __builtin_amdgcn_s_barrier(); asm volatile("" ::: "memory"); } while (0)
#ifdef MK_PROBE_TOPK2
        for (int rep_ = 0; rep_ < MK_PROBE_TOPK2; ++rep_)
#endif
#pragma unroll
        for (int ai = 0; ai < 2; ++ai) {
#pragma unroll
            for (int m = 0; m < 4; ++m)
#pragma unroll
                for (int bj = 0; bj < 2; ++bj)
#pragma unroll
                    for (int n = 0; n < 2; ++n) *(PG8_LAS f32x4*)(S + (wr * 64 + m * 16 + fr) * RS + bj * HALF + wc * 32 + 8 * fq + 4 * n) = acc[ai][bj][m][n];
            TK_BAR();
            float T[16];
#ifdef MK_PROBE_TK1
            for (int rep1_ = 0; rep1_ < MK_PROBE_TK1; ++rep1_)
#endif
#pragma unroll
            for (int b = 0; b < 4; ++b) {
                float c[16];
#pragma unroll
                for (int q = 0; q < 4; ++q) { const f32x4 v = *(const PG8_LAS f32x4*)(S + row * RS + half * 128 + part * 64 + b * 16 + q * 4);
#pragma unroll
                    for (int e = 0; e < 4; ++e) c[q * 4 + e] = __uint_as_float((__float_as_uint(v[e]) & ~127u) | (unsigned)(part * 64 + b * 16 + q * 4 + e)); }
                sort16_desc(c);
                if (b == 0) {
#pragma unroll
                    for (int i = 0; i < 16; ++i) T[i] = c[i];
                } else merge16<16>(T, c);
            }
            TK_BAR();
#pragma unroll
            for (int q = 0; q < 4; ++q) *(PG8_LAS f32x4*)(S + tid * 16 + q * 4) = (f32x4){T[q * 4], T[q * 4 + 1], T[q * 4 + 2], T[q * 4 + 3]};
            TK_BAR();
            if (part == 0) {
                float c[16];
#pragma unroll
                for (int q = 0; q < 4; ++q) { const f32x4 v = *(const PG8_LAS f32x4*)(S + (tid + 128) * 16 + q * 4); c[q * 4] = v[0]; c[q * 4 + 1] = v[1]; c[q * 4 + 2] = v[2]; c[q * 4 + 3] = v[3]; }
                merge16<16>(T, c);
            }
            TK_BAR();
            if (part == 0) {
#pragma unroll
                for (int q = 0; q < 4; ++q) *(PG8_LAS f32x4*)(S + tid * 16 + q * 4) = (f32x4){T[q * 4], T[q * 4 + 1], T[q * 4 + 2], T[q * 4 + 3]};
            }
            TK_BAR();
#ifdef MK_PROBE_TK3
            for (int rep3_ = 0; rep3_ < MK_PROBE_TK3; ++rep3_)
#endif
            if (tid < 128) {
                float a1[16], a2[16];
#pragma unroll
                for (int q = 0; q < 4; ++q) { const f32x4 v = *(const PG8_LAS f32x4*)(S + (tid + 256) * 16 + q * 4);
#pragma unroll
                    for (int e = 0; e < 4; ++e) a2[q * 4 + e] = __uint_as_float(__float_as_uint(v[e]) & ~127u); }
#pragma unroll
                for (int i = 0; i < 16; ++i) a1[i] = __uint_as_float(__float_as_uint(T[i]) & ~127u);
#define TK_SUM(i, j) __uint_as_float((__float_as_uint(a1[i] + a2[j]) & ~255u) | (unsigned)((i) * 16 + (j)))
                float R[16], C[16];
#pragma unroll
                for (int j = 0; j < 16; ++j) R[j] = TK_SUM(0, j);
#pragma unroll
                for (int i = 1; i < 16; ++i) C[i - 1] = TK_SUM(i, 0);
                C[15] = 0.f;
                merge16<15>(R, C);
                C[0] = TK_SUM(1, 1); C[1] = TK_SUM(1, 2); C[2] = TK_SUM(1, 3); C[3] = TK_SUM(1, 4); C[4] = TK_SUM(1, 5); C[5] = TK_SUM(1, 6); C[6] = TK_SUM(1, 7);
                C[7] = TK_SUM(2, 1); C[8] = TK_SUM(2, 2); C[9] = TK_SUM(2, 3); C[10] = TK_SUM(2, 4); C[11] = TK_SUM(3, 1); C[12] = TK_SUM(3, 2); C[13] = TK_SUM(3, 3);
                C[14] = TK_SUM(4, 1); C[15] = TK_SUM(4, 2);
                sort16_desc(C);
                merge16<16>(R, C);
                C[0] = TK_SUM(5, 1); C[1] = TK_SUM(6, 1); C[2] = TK_SUM(7, 1);
                merge16<3>(R, C);
#undef TK_SUM
                const int rowg = u.pm * BM + ai * HALF + row;
                const f32x4* ssp = (const f32x4*)(SS2 + (size_t)rowg * 16); const f32x4 s0 = ssp[0], s1 = ssp[1], s2 = ssp[2], s3 = ssp[3];
                const float ssum = ((s0[0] + s0[1]) + (s0[2] + s0[3])) + ((s1[0] + s1[1]) + (s1[2] + s1[3])) + ((s2[0] + s2[1]) + (s2[2] + s2[3])) + ((s3[0] + s3[1]) + (s3[2] + s3[3]));
                const float rl = 1.4426950408889634f / sqrtf(ssum * (1.0f / 1024.0f) + eps);
                float ev[16], esum = 0.f; int idv[16];
#pragma unroll
                for (int r = 0; r < 16; ++r) { ev[r] = __builtin_amdgcn_exp2f((R[r] - R[0]) * rl); esum += ev[r];
                    const unsigned code = __float_as_uint(R[r]) & 255u;
                    const unsigned k1 = __float_as_uint(S[tid * 16 + (code >> 4)]) & 127u, k2 = __float_as_uint(S[(tid + 256) * 16 + (code & 15u)]) & 127u;
                    idv[r] = (int)(k1 * 128u + k2); }
                const float inv = 1.0f / esum;
                unsigned short* ip = IDS + (size_t)rowg * 128 + u.pn * 16; float* gp = GATES + (size_t)rowg * 128 + u.pn * 16;
#pragma unroll
                for (int q = 0; q < 2; ++q) { u32x4 w; w.x = (unsigned)idv[q * 8] | ((unsigned)idv[q * 8 + 1] << 16); w.y = (unsigned)idv[q * 8 + 2] | ((unsigned)idv[q * 8 + 3] << 16); w.z = (unsigned)idv[q * 8 + 4] | ((unsigned)idv[q * 8 + 5] << 16); w.w = (unsigned)idv[q * 8 + 6] | ((unsigned)idv[q * 8 + 7] << 16);
                    *(u32x4*)(ip + q * 8) = w; }
#pragma unroll
                for (int q = 0; q < 4; ++q) *(f32x4*)(gp + q * 4) = (f32x4){ev[q * 4] * inv, ev[q * 4 + 1] * inv, ev[q * 4 + 2] * inv, ev[q * 4 + 3] * inv};
            }
            TK_BAR();
        }
#undef TK_BAR
    }
};
template <class Epi, class Sched, bool ALIGN_EPI = false, bool SP2 = false, bool FP8 = false>
__device__ __forceinline__ void gemm_phase(PG8_LAS unsigned char* lds, const Gemm g, const Sched& S, const Epi& E, const int wid_in) {
    int lane_l = (int)__builtin_amdgcn_mbcnt_hi(~0u, __builtin_amdgcn_mbcnt_lo(~0u, 0u)); asm volatile("" : "+v"(lane_l));
    const int wid = wid_in, lane = lane_l, tid = wid * 64 + lane, wr = wid >> 2, wc = wid & 3, fr = lane & 15, fq = lane >> 4;
    const int K = g.K, nt = K / BK;
    unsigned voffA, voffB;
    { int R, C; stage_rc(tid * 16, R, C); const int Rb = Epi::PERM ? ((R & ~31) + perm32(R & 31)) : R;
        voffA = (unsigned)(R * K + C) * 2u; voffB = (unsigned)(Rb * K + C) * 2u; }
    const size_t rstep64 = (size_t)64 * K * 2;
    const size_t kstep = (size_t)(BK * 2);
    const size_t hstep = (size_t)HALF * K * 2;
    const size_t tstep = 2 * hstep;
    const unsigned ldsw = (unsigned)wid * 1024u;
    const int aoff = lds_byte(wr * 64 + fr, FP8 ? fq * 16 : fq * 8), boff = lds_byte(wc * 32 + fr, FP8 ? fq * 16 : fq * 8);
    constexpr int KSTR = FP8 ? 16 : 1024;
#define PG8_SA(b, h) (((b) * 2 + (h)) * HTB)
#define PG8_SB(b, h) ((4 + (b) * 2 + (h)) * HTB)
#define PG8_STAGE(bufoff, gbase, voff) do { _Pragma("unroll") for (int _i = 0; _i < 2; ++_i) \
        __builtin_amdgcn_global_load_lds((const unsigned*)((const char*)(gbase) + _i * rstep64 + (voff)), (PG8_LAS unsigned*)(lds + (bufoff) + ldsw + _i * 8192), 16, 0, 0); } while (0)
#define PG8_LDA(dst, b, h) do { _Pragma("unroll") for (int m = 0; m < 4; ++m) _Pragma("unroll") for (int k = 0; k < 2; ++k) dst[m][k] = *(const PG8_LAS v4i_t*)(lds + PG8_SA(b, h) + aoff + m * 2048 + k * KSTR); } while (0)
#define PG8_LDB(dst, b, h) do { _Pragma("unroll") for (int n = 0; n < 2; ++n) _Pragma("unroll") for (int k = 0; k < 2; ++k) dst[n][k] = *(const PG8_LAS v4i_t*)(lds + PG8_SB(b, h) + boff + n * 2048 + k * KSTR); } while (0)
#define PG8_MMA(ai, bj, At, Bt) do { __builtin_amdgcn_s_setprio(1); _Pragma("unroll") for (int m = 0; m < 4; ++m) _Pragma("unroll") for (int n = 0; n < 2; ++n) { \
        if constexpr (FP8) { const v8i_t b8_ = __builtin_shufflevector(Bt[n][0], Bt[n][1], 0, 1, 2, 3, 4, 5, 6, 7), a8_ = __builtin_shufflevector(At[m][0], At[m][1], 0, 1, 2, 3, 4, 5, 6, 7); \
            asm volatile("v_mfma_scale_f32_16x16x128_f8f6f4 %0, %1, %2, %0, %3, %3 op_sel_hi:[0,0,0]" : "+v"(acc[ai][bj][m][n]) : "v"(b8_), "v"(a8_), "v"(mxs_)); }     \
        else { _Pragma("unroll") for (int k = 0; k < 2; ++k) acc[ai][bj][m][n] = __builtin_amdgcn_mfma_f32_16x16x32_bf16(__builtin_bit_cast(bf16x8, Bt[n][k]), __builtin_bit_cast(bf16x8, At[m][k]), acc[ai][bj][m][n], 0, 0, 0); } } \
        __builtin_amdgcn_s_setprio(0); } while (0)
#define PG8_WAIT_V(n) asm volatile("s_waitcnt vmcnt(" #n ")" ::: "memory")
#define PG8_WAIT_L(n) asm volatile("s_waitcnt lgkmcnt(" #n ")" ::: "memory")
#define PG8_BAR __builtin_amdgcn_s_barrier()
#define PG8_SCHED __builtin_amdgcn_sched_barrier(0)
    Unit cur, nxt; int ui = 0;
    if (!S.next(0, cur)) return;
    f32x4 acc[2][2][4][2];
#pragma unroll
    for (int a = 0; a < 2; ++a)
#pragma unroll
        for (int b = 0; b < 2; ++b)
#pragma unroll
            for (int m = 0; m < 4; ++m)
#pragma unroll
                for (int n = 0; n < 2; ++n) acc[a][b][m][n] = (f32x4){0.f, 0.f, 0.f, 0.f};
    typedef int v4i_t __attribute__((ext_vector_type(4))); typedef int v8i_t __attribute__((ext_vector_type(8)));
    int mxs_ = 0x7f7f7f7f; asm volatile("" : "+v"(mxs_));
    v4i_t At[4][2], B0[2][2], B1[2][2];
    const char* cA = (const char*)g.A + (size_t)cur.pm * tstep; const char* cB = (const char*)g.Bt + (size_t)cur.pn * tstep;
    S.a_ready(cur);
    if constexpr (SP2) {
        PG8_STAGE(PG8_SB(0, 0), cB, voffB); PG8_STAGE(PG8_SB(0, 1), cB + hstep, voffB); PG8_STAGE(PG8_SA(0, 0), cA, voffA); PG8_STAGE(PG8_SA(0, 1), cA + hstep, voffA);
        if (wr == 1) PG8_BAR;
        PG8_WAIT_V(2); PG8_BAR;
        PG8_STAGE(PG8_SB(1, 0), cB + kstep, voffB); PG8_STAGE(PG8_SA(1, 0), cA + kstep, voffA); PG8_STAGE(PG8_SB(1, 1), cB + hstep + kstep, voffB);
        PG8_WAIT_V(6); PG8_BAR;
    } else {
        PG8_STAGE(PG8_SB(0, 0), cB, voffB); PG8_STAGE(PG8_SA(0, 0), cA, voffA); PG8_STAGE(PG8_SB(0, 1), cB + hstep, voffB); PG8_STAGE(PG8_SA(0, 1), cA + hstep, voffA);
        if (wr == 1) PG8_BAR;
        PG8_WAIT_V(4); PG8_BAR;
        PG8_STAGE(PG8_SB(1, 0), cB + kstep, voffB); PG8_STAGE(PG8_SA(1, 0), cA + kstep, voffA); PG8_STAGE(PG8_SB(1, 1), cB + hstep + kstep, voffB);
        PG8_WAIT_V(6); PG8_BAR;
    }
    for (;;) {
        const bool has_next = S.next(ui + 1, nxt);
        const char* nA = has_next ? (const char*)g.A + (size_t)nxt.pm * tstep : cA; const char* nB = has_next ? (const char*)g.Bt + (size_t)nxt.pn * tstep : cB;
#pragma nounroll
        for (int t = 0; t < nt; t += 2) {
            if constexpr (Epi::MID_T > 0) { if (t == Epi::MID_T) E.mid(acc, cur, wr, wc, fr, fq); }
            const bool last = (t == nt - 2);
            const char* a1 = cA + (size_t)(t + 1) * kstep;
            const char* a2 = last ? nA : cA + (size_t)(t + 2) * kstep; const char* b2 = last ? nB : cB + (size_t)(t + 2) * kstep;
            const char* a3 = a2 + kstep; const char* b3 = b2 + kstep;
            if (last && has_next) S.a_ready(nxt);
            if constexpr (SP2) {
            PG8_LDB(B0, 0, 0); PG8_LDB(B1, 0, 1); PG8_SCHED; PG8_LDA(At, 0, 0); PG8_STAGE(PG8_SA(1, 1), a1 + hstep, voffA);
            PG8_WAIT_V(8); PG8_WAIT_L(0); PG8_BAR; PG8_MMA(0, 0, At, B0); PG8_MMA(0, 1, At, B1); PG8_BAR; PG8_SCHED;
            PG8_LDA(At, 0, 1); PG8_STAGE(PG8_SB(0, 0), b2, voffB); PG8_STAGE(PG8_SB(0, 1), b2 + hstep, voffB); PG8_STAGE(PG8_SA(0, 0), a2, voffA);
            PG8_WAIT_V(8); PG8_WAIT_L(0); PG8_BAR; PG8_MMA(1, 0, At, B0); PG8_MMA(1, 1, At, B1); PG8_BAR; PG8_SCHED;
            PG8_LDB(B0, 1, 0); PG8_LDB(B1, 1, 1); PG8_SCHED; PG8_LDA(At, 1, 0); PG8_STAGE(PG8_SA(0, 1), a2 + hstep, voffA);
            PG8_WAIT_V(8); PG8_WAIT_L(0); PG8_BAR; PG8_MMA(0, 0, At, B0); PG8_MMA(0, 1, At, B1); PG8_BAR; PG8_SCHED;
            PG8_LDA(At, 1, 1); PG8_STAGE(PG8_SB(1, 0), b3, voffB); PG8_STAGE(PG8_SB(1, 1), b3 + hstep, voffB); PG8_STAGE(PG8_SA(1, 0), a3, voffA);
            PG8_WAIT_V(8); PG8_WAIT_L(0); PG8_BAR; PG8_MMA(1, 0, At, B0); PG8_MMA(1, 1, At, B1); PG8_BAR; PG8_SCHED;
            } else {
            PG8_LDB(B0, 0, 0); PG8_SCHED; PG8_LDA(At, 0, 0); PG8_STAGE(PG8_SA(1, 1), a1 + hstep, voffA);
            PG8_WAIT_L(8); PG8_BAR; PG8_WAIT_L(0); PG8_MMA(0, 0, At, B0); PG8_BAR; PG8_SCHED;
            PG8_LDB(B1, 0, 1); PG8_STAGE(PG8_SB(0, 0), b2, voffB);
            PG8_BAR; PG8_WAIT_L(0); PG8_MMA(0, 1, At, B1); PG8_BAR;
            PG8_LDA(At, 0, 1); PG8_STAGE(PG8_SA(0, 0), a2, voffA);
            PG8_BAR; PG8_WAIT_L(0); PG8_MMA(1, 0, At, B0); PG8_BAR; PG8_SCHED;
            PG8_STAGE(PG8_SB(0, 1), b2 + hstep, voffB);
            PG8_WAIT_V(6); PG8_BAR; PG8_MMA(1, 1, At, B1); PG8_BAR;
            PG8_LDB(B0, 1, 0); PG8_SCHED; PG8_LDA(At, 1, 0); PG8_STAGE(PG8_SA(0, 1), a2 + hstep, voffA);
            PG8_WAIT_L(8); PG8_BAR; PG8_WAIT_L(0); PG8_MMA(0, 0, At, B0); PG8_BAR; PG8_SCHED;
            PG8_LDB(B1, 1, 1); PG8_STAGE(PG8_SB(1, 0), b3, voffB);
            PG8_BAR; PG8_WAIT_L(0); PG8_MMA(0, 1, At, B1); PG8_BAR;
            PG8_LDA(At, 1, 1); PG8_STAGE(PG8_SA(1, 0), a3, voffA);
            PG8_BAR; PG8_WAIT_L(0); PG8_MMA(1, 0, At, B0); PG8_BAR; PG8_SCHED;
            PG8_STAGE(PG8_SB(1, 1), b3 + hstep, voffB);
            PG8_WAIT_V(6); PG8_BAR; PG8_MMA(1, 1, At, B1); PG8_BAR;
            }
        }
        if constexpr (FP8) asm volatile("s_nop 15\n\ts_nop 7" ::: "memory");
        if constexpr (ALIGN_EPI) { if (wr == 0) PG8_BAR; }
#ifdef MK_PROBE_EPI2
        if constexpr (!Epi::AFTER_DRAIN && Epi::PROBE_ID == MK_PROBE_EPI_ID) { for (int rep_ = 1; rep_ < MK_PROBE_EPI2; ++rep_) E(acc, cur, wr, wc, fr, fq); }
#endif
        if constexpr (!Epi::AFTER_DRAIN) { E(acc, cur, wr, wc, fr, fq); S.done(cur); }
        if (!has_next) break;
#pragma unroll
        for (int a = 0; a < 2; ++a)
#pragma unroll
            for (int b = 0; b < 2; ++b)
#pragma unroll
                for (int m = 0; m < 4; ++m)
#pragma unroll
                    for (int n = 0; n < 2; ++n) acc[a][b][m][n] = (f32x4){0.f, 0.f, 0.f, 0.f};
        cur = nxt; cA = nA; cB = nB; ++ui;
        if constexpr (ALIGN_EPI) { if (wr == 1) PG8_BAR; }
    }
    PG8_WAIT_V(0);
    if constexpr (!ALIGN_EPI) { if (wr == 0) PG8_BAR; }
    PG8_BAR;
    if constexpr (Epi::AFTER_DRAIN) { E.fused(acc, cur, wr, wc, fr, fq, lds, wid, lane); S.done(cur); }
#undef PG8_SA
#undef PG8_SB
#undef PG8_STAGE
#undef PG8_LDA
#undef PG8_LDB
#undef PG8_MMA
#undef PG8_WAIT_V
#undef PG8_WAIT_L
#undef PG8_BAR
#undef PG8_SCHED
}
}
#ifndef PG8_SP2
#define PG8_SP2 true
#endif
#ifndef PG8_ALIGN
#define PG8_ALIGN true
#endif
namespace attn_body {
using bf16=__hip_bfloat16;
using bf16x8=__attribute__((ext_vector_type(8)))short;
using s16x4=__attribute__((ext_vector_type(4)))short;
using f32x16=__attribute__((ext_vector_type(16)))float;
using u32x4=__attribute__((ext_vector_type(4)))unsigned;
using f32x4v=__attribute__((ext_vector_type(4)))float;
constexpr int BATCH=4,NHEAD=8,SEQ=4096,D=64,DM=NHEAD*D,DMO=1024;
constexpr int NW=8,QBLK=32,QB=QBLK*NW,KVBLK=64,NQB=SEQ/QB;
constexpr int ATTN_PITCH=DM, ATTN_UNIT_ROWS=QB;
__device__ __forceinline__ int crow(int r,int hi){return (r&3)+8*(r>>2)+4*hi;}
#define SBAR() __builtin_amdgcn_sched_barrier(0)
__device__ __forceinline__ void cmask(f32x16&p0,f32x16&p1,int jb,int qrel,int hi){
  const float NEG=-INFINITY; int kb=64*jb+4*hi;
  #pragma unroll
  for(int r=0;r<16;++r){int kv=kb+(r&3)+8*(r>>2); if(kv>qrel)p0[r]=NEG; if(kv+32>qrel)p1[r]=NEG;}
}

constexpr int NSLOT=3, SLOTB=8192;
constexpr float SKIP_TH=64.0f;
constexpr int LDS_K=0, LDS_V=NSLOT*SLOTB, LDS_WS=2*NSLOT*SLOTB, LDS_OST=LDS_WS+NW*64*4, LDS_CS=LDS_OST+NW*4096, LDS_BYTES=LDS_CS+SEQ*4+64;
constexpr float C2=0.125f*1.4426950408889634f;
__device__ __forceinline__ void glds16(const void*gsrc,unsigned lds_dst){unsigned keep;
  asm volatile("s_mov_b32 %0, m0\n\ts_mov_b32 m0, %2\n\ts_nop 0\n\tglobal_load_lds_dwordx4 %1, off\n\ts_mov_b32 m0, %0":"=&s"(keep):"v"(gsrc),"s"(lds_dst):"memory");}
__device__ __forceinline__ float max3f(float a,float b,float c){float r;asm("v_max3_f32 %0, %1, %2, %3":"=v"(r):"v"(a),"v"(b),"v"(c));return r;}
__device__ __forceinline__ float max2f(float a,float b){float r;asm("v_max_f32_e32 %0, %1, %2":"=v"(r):"v"(a),"v"(b));return r;}
__device__ __forceinline__ float fadd_s(float a,float b){float r;asm("v_add_f32_e32 %0, %1, %2":"=v"(r):"v"(a),"v"(b));return r;}
__device__ __forceinline__ float fsub_s(float a,float b){float r;asm("v_sub_f32_e32 %0, %1, %2":"=v"(r):"v"(a),"v"(b));return r;}
typedef float f32x2_t __attribute__((ext_vector_type(2))); typedef __bf16 bf16x2_t __attribute__((ext_vector_type(2)));
__device__ __forceinline__ unsigned cvtpk_s(float lo,float hi){f32x2_t v={lo,hi};bf16x2_t b=__builtin_convertvector(v,bf16x2_t);return __builtin_bit_cast(unsigned,b);}
#define WAIT_BAR(N) asm volatile("s_waitcnt vmcnt(" #N ") lgkmcnt(0)\n\ts_barrier":::"memory")

__device__ __forceinline__ void qkt(f32x16&p0,f32x16&p1,const char*Kslot,const bf16x8*qr,const f32x16&c0,const f32x16&c1,int r32,int hi){
  const char*kb=Kslot+hi*1024+r32*16;
  #pragma unroll
  for(int d0=0;d0<4;++d0){
    const bf16x8 b0=*reinterpret_cast<const bf16x8*>(kb+d0*2048);
    const bf16x8 b1=*reinterpret_cast<const bf16x8*>(kb+d0*2048+512);
    if(d0==0){p0=__builtin_amdgcn_mfma_f32_32x32x16_bf16(b0,qr[0],c0,0,0,0);p1=__builtin_amdgcn_mfma_f32_32x32x16_bf16(b1,qr[0],c1,0,0,0);}
    else{p0=__builtin_amdgcn_mfma_f32_32x32x16_bf16(b0,qr[d0],p0,0,0,0);p1=__builtin_amdgcn_mfma_f32_32x32x16_bf16(b1,qr[d0],p1,0,0,0);}}
}
typedef __attribute__((address_space(3))) const char* lds_cptr;
typedef short v4i16_t __attribute__((ext_vector_type(4)));
__device__ __forceinline__ void kload8(bf16x8*kf,lds_cptr kp){
  kf[0]=*(const __attribute__((address_space(3))) bf16x8*)(kp);      kf[1]=*(const __attribute__((address_space(3))) bf16x8*)(kp+512);
  kf[2]=*(const __attribute__((address_space(3))) bf16x8*)(kp+2048); kf[3]=*(const __attribute__((address_space(3))) bf16x8*)(kp+2560);
  kf[4]=*(const __attribute__((address_space(3))) bf16x8*)(kp+4096); kf[5]=*(const __attribute__((address_space(3))) bf16x8*)(kp+4608);
  kf[6]=*(const __attribute__((address_space(3))) bf16x8*)(kp+6144); kf[7]=*(const __attribute__((address_space(3))) bf16x8*)(kp+6656);
}
__device__ __forceinline__ void kload2(bf16x8*kf,lds_cptr kp,int j){ kf[2*j]=*(const __attribute__((address_space(3))) bf16x8*)(kp+j*2048); kf[2*j+1]=*(const __attribute__((address_space(3))) bf16x8*)(kp+j*2048+512); }
__device__ __forceinline__ s16x4 vtr(lds_cptr p){ return __builtin_bit_cast(s16x4,__builtin_amdgcn_ds_read_tr16_b64_v4i16((__attribute__((address_space(3))) v4i16_t*)p)); }
__device__ __forceinline__ float rowmax(const f32x16&p0,const f32x16&p1){
  float a=max3f(p0[0],p0[1],p1[0]),b=max3f(p0[2],p0[3],p1[1]);a=max3f(a,p1[2],p1[3]);
  #pragma unroll
  for(int r=4;r<16;r+=4){a=max3f(a,p0[r],p0[r+1]);b=max3f(b,p0[r+2],p0[r+3]);a=max3f(a,p1[r],p1[r+1]);b=max3f(b,p1[r+2],p1[r+3]);}
  const float m=max2f(a,b);
  auto rr=__builtin_amdgcn_permlane32_swap(__float_as_uint(m),__float_as_uint(m),false,false);
  return max2f(__uint_as_float(rr[0]),__uint_as_float(rr[1]));
}
__device__ __forceinline__ void pv(f32x16*o,int vb,bf16x8 pa0,bf16x8 pa1,bf16x8 pa2,bf16x8 pa3){
  #pragma unroll
  for(int d0=0;d0<2;++d0){s16x4 lo[4],hi[4];
    #pragma unroll
    for(int ks=0;ks<4;++ks){
      asm volatile("ds_read_b64_tr_b16 %0,%1 offset:%c2":"=&v"(lo[ks]):"v"(vb),"i"(d0*4096+ks*1024):"memory");
      asm volatile("ds_read_b64_tr_b16 %0,%1 offset:%c2":"=&v"(hi[ks]):"v"(vb),"i"(d0*4096+ks*1024+512):"memory");}
    asm volatile("s_waitcnt lgkmcnt(0)":::"memory");SBAR();
    #define PK(k) (bf16x8){lo[k][0],lo[k][1],lo[k][2],lo[k][3],hi[k][0],hi[k][1],hi[k][2],hi[k][3]}
    o[d0]=__builtin_amdgcn_mfma_f32_32x32x16_bf16(pa0,PK(0),o[d0],0,0,0);
    o[d0]=__builtin_amdgcn_mfma_f32_32x32x16_bf16(pa1,PK(1),o[d0],0,0,0);
    o[d0]=__builtin_amdgcn_mfma_f32_32x32x16_bf16(pa2,PK(2),o[d0],0,0,0);
    o[d0]=__builtin_amdgcn_mfma_f32_32x32x16_bf16(pa3,PK(3),o[d0],0,0,0);
    #undef PK
  }
}

#ifndef ATTN_STORE16
#define ATTN_STORE16(p,v) (*(u32x4*)(p)=(v))
#endif
template<int THRL> __device__ __forceinline__ void attn_unit(int b,int h,int qb,const bf16*Q,const bf16*__restrict__ K,const bf16*__restrict__ V,bf16*O,const float*__restrict__ LFrow,char*shm){
  int tid_l=threadIdx.x; asm volatile("":"+v"(tid_l));
  const int tid=tid_l,lane=tid&63,r32=lane&31,hi=lane>>5; const int wid=__builtin_amdgcn_readfirstlane(tid>>6);
  const long rowbase=(long)b*SEQ; const int q0=qb*QB;
  const lds_cptr shm3=(lds_cptr)shm;
  typedef __attribute__((address_space(3))) float lds_f32; typedef __attribute__((address_space(3))) f32x4v lds_f32x4;
  lds_f32* const csl=(lds_f32*)(shm3+LDS_CS);
  { const int ncs=q0+QB, i0=tid*8; f32x4v ca={0.f,0.f,0.f,0.f},cb={0.f,0.f,0.f,0.f};
    if(i0<ncs){ca=*(const f32x4v*)(LFrow+i0);cb=*(const f32x4v*)(LFrow+i0+4);}
    ca.y+=ca.x;ca.z+=ca.y;ca.w+=ca.z;cb.x+=ca.w;cb.y+=cb.x;cb.z+=cb.y;cb.w+=cb.z;
    const float tot=cb.w; float inc=tot;
    _Pragma("unroll") for(int o_=1;o_<64;o_<<=1){const float v_=__shfl_up(inc,o_);if(lane>=o_)inc+=v_;}
    if(lane==63)csl[SEQ+wid]=inc;
    asm volatile("s_waitcnt vmcnt(0) lgkmcnt(0)\n\ts_barrier":::"memory");
    float base_=inc-tot;
    _Pragma("unroll") for(int w_=0;w_<NW;++w_){const float t_=csl[SEQ+w_];if(w_<wid)base_+=t_;}
    if(i0<ncs){*(lds_f32x4*)(csl+i0)=ca+base_;*(lds_f32x4*)(csl+i0+4)=cb+base_;}
    asm volatile("s_waitcnt vmcnt(0) lgkmcnt(0)\n\ts_barrier":::"memory"); }
  int ts; { const int NT0=(q0+QB)/KVBLK, cand=2*lane; bool ok=false;
    if(lane<32&&cand<=NT0-4) ok=(cand==0)||(csl[q0]-csl[64*cand-1]<=-SKIP_TH);
    const unsigned long long mk=__ballot(ok); ts=__builtin_amdgcn_readfirstlane(2*(63-__builtin_clzll(mk|1ull))); }
  const bf16*Qw=Q+(rowbase+q0+wid*QBLK)*DM+h*D;
  const bf16*Kh=K+(rowbase+(long)ts*KVBLK)*DM+h*D,*Vh=V+(rowbase+(long)ts*KVBLK)*DM+h*D;
  const unsigned lds0=(unsigned)(uintptr_t)shm;
  float*wsf=(float*)(shm+LDS_WS)+wid*64;
  const bf16*ksrc=Kh+(long)lane*DM+wid*8;
  const bf16*vsrc=Vh+(long)(16*(wid&3)+(lane>>2))*DM+(wid>>2)*32+(lane&3)*8;
  const unsigned kdst=lds0+LDS_K+wid*1024, vdst=lds0+LDS_V+wid*1024;
  #define DMA_K(t,slot) glds16(ksrc+(long)(t)*KVBLK*DM,(unsigned)__builtin_amdgcn_readfirstlane(kdst+(slot)))
  #define DMA_V(t,slot) glds16(vsrc+(long)(t)*KVBLK*DM,(unsigned)__builtin_amdgcn_readfirstlane(vdst+(slot)))
  const int vb0=(int)(lds0+LDS_V)+((lane>>4)&1)*32+(lane&3)*8+(4*hi+((lane&15)>>2))*64;
  const char*Kbase=shm+LDS_K; bf16x8 kf[8];
  const lds_cptr kp0=shm3+LDS_K+hi*1024+r32*16; const lds_cptr vp0=shm3+LDS_V+((lane>>4)&1)*32+(lane&3)*8+(4*hi+((lane&15)>>2))*64;
  const int NT=(q0+QB)/KVBLK-ts;
  const float cq=csl[q0+wid*QBLK+r32];
  const lds_cptr csb=shm3+LDS_CS+hi*16+ts*256;
  #define CINIT(C0,C1,t) do{ _Pragma("unroll") for(int g_=0;g_<4;++g_){ const f32x4v a_=*(const lds_f32x4*)(csb+(t)*256+g_*32), b_=*(const lds_f32x4*)(csb+(t)*256+128+g_*32); \
      C0[4*g_]=cqm-a_.x;C0[4*g_+1]=cqm-a_.y;C0[4*g_+2]=cqm-a_.z;C0[4*g_+3]=cqm-a_.w; C1[4*g_]=cqm-b_.x;C1[4*g_+1]=cqm-b_.y;C1[4*g_+2]=cqm-b_.z;C1[4*g_+3]=cqm-b_.w; } }while(0)
  DMA_K(0,0);DMA_V(0,0);DMA_K(1,SLOTB);
  bf16x8 qr[4];
  #pragma unroll
  for(int d0=0;d0<4;++d0)qr[d0]=*reinterpret_cast<const bf16x8*>(&Qw[(long)r32*DM+d0*16+hi*8]);
  float mhat=0.f,l_reg=0.f,cqm=cq;f32x16 o[2];o[0]=f32x16{};o[1]=f32x16{};
  const int qrel=wid*QBLK+r32;
  #define CMASK(P0,P1,t) do{int jb_=(t)-(NT-4); if(jb_>=0)cmask(P0,P1,jb_,qrel,hi);}while(0)
  bool resc=false;
  #define START(P0,P1) do{ const float rm=rowmax(P0,P1); resc=false; \
    { const float dl=rm; mhat=fadd_s(mhat,dl); \
      _Pragma("unroll") for(int r=0;r<16;++r){P0[r]=fsub_s(P0[r],dl);P1[r]=fsub_s(P1[r],dl);} \
      cqm=cq-mhat; } \
    _Pragma("unroll") for(int r=0;r<16;++r)P0[r]=__builtin_amdgcn_exp2f(P0[r]); }while(0)
  #define RESC() do{ if(resc){ asm volatile("s_waitcnt lgkmcnt(0)":::"memory"); \
      _Pragma("unroll") for(int d_=0;d_<2;++d_) _Pragma("unroll") for(int r=0;r<16;++r)o[d_][r]*=wsf[crow(r,hi)]; } }while(0)
  f32x16 pA0,pA1,pB0,pB1;
  int sl_prev=0,sl_cur=0,sl_next=SLOTB;
  #define ROT() do{sl_prev=sl_cur;sl_cur=sl_next;sl_next=(sl_next==(NSLOT-1)*SLOTB)?0:sl_next+SLOTB;}while(0)
  DMA_K(2,2*SLOTB);
  WAIT_BAR(3);
  { f32x16 ci0,ci1; CINIT(ci0,ci1,0); qkt(pA0,pA1,Kbase,qr,ci0,ci1,r32,hi); } asm volatile("s_nop 15\n\ts_nop 7":"+v"(pA0),"+v"(pA1));CMASK(pA0,pA1,0);
  START(pA0,pA1);
  _Pragma("unroll") for(int r=0;r<16;++r)pA1[r]=__builtin_amdgcn_exp2f(pA1[r]);
  WAIT_BAR(0);
  DMA_K(3,0);DMA_V(1,SLOTB);
  ROT();
  kload8(kf,kp0+sl_cur);
  WAIT_BAR(2);
  s16x4 vlo[8],vhi[8]; u32x4 pw0,pw1,pw2,pw3;
  #define PKW(P,B) cvtpk_s(P[B],P[B+1])
  #define PAF(k) __builtin_bit_cast(bf16x8,pw##k)
  #define VFR(i) (bf16x8){vlo[i][0],vlo[i][1],vlo[i][2],vlo[i][3],vhi[i][0],vhi[i][1],vhi[i][2],vhi[i][3]}
  #define PIN(x) asm volatile("":"+v"(x))
  #define MX3(a,b,c) __builtin_fmaxf(__builtin_fmaxf((a),(b)),(c))
  #define GAPA(MF,A0,A1,A2,A3,W0,W1,PW) do{ MF; sacc+=A0; sacc+=A1; sacc+=A2; sacc+=A3; PIN(sacc); W0; W1; PIN(PW); SBAR(); }while(0)
  #define EX(v) __builtin_amdgcn_exp2f(v)
  #define GAPB(MF,X,B) do{ MF; X[B]=EX(X[B]); X[B+1]=EX(X[B+1]); X[B+2]=EX(X[B+2]); X[B+3]=EX(X[B+3]); PIN(X); SBAR(); }while(0)
  #define VRD(i) do{ vlo[i]=vtr(vp_+(((i)>>2)*4096+((i)&3)*1024)); vhi[i]=vtr(vp_+(((i)>>2)*4096+((i)&3)*1024+512)); }while(0)
  #define KRD(G,j) do{ if(G){ kload2(kf,kp0+sl_next,j); SBAR(); } }while(0)
  #define STEP(C0,C1,P0,P1,t,GK,GV,GL) do{ SBAR(); \
    CINIT(C0,C1,t); SBAR(); \
    const lds_cptr vp_=vp0+sl_prev; \
    VRD(0); SBAR(); float sacc=(P0[0]+P0[1]); \
    GAPA(C0=__builtin_amdgcn_mfma_f32_32x32x16_bf16(kf[0],qr[0],C0,0,0,0), P0[2],P0[3],P0[4],P0[5],     pw0[0]=PKW(P0,0), pw0[1]=PKW(P0,2), pw0); \
    VRD(4); SBAR(); GAPA(C1=__builtin_amdgcn_mfma_f32_32x32x16_bf16(kf[1],qr[0],C1,0,0,0), P0[6],P0[7],P0[8],P0[9],     pw0[2]=PKW(P0,4), pw0[3]=PKW(P0,6), pw0); \
    VRD(1); SBAR(); GAPA(C0=__builtin_amdgcn_mfma_f32_32x32x16_bf16(kf[2],qr[1],C0,0,0,0),   P0[10],P0[11],P0[12],P0[13], pw1[0]=PKW(P0,8), pw1[1]=PKW(P0,10), pw1); \
    VRD(5); SBAR(); GAPA(C1=__builtin_amdgcn_mfma_f32_32x32x16_bf16(kf[3],qr[1],C1,0,0,0),   P0[14],P0[15],P1[0],P1[1],   pw1[2]=PKW(P0,12),pw1[3]=PKW(P0,14), pw1); \
    VRD(2); SBAR(); GAPA(C0=__builtin_amdgcn_mfma_f32_32x32x16_bf16(kf[4],qr[2],C0,0,0,0),   P1[2],P1[3],P1[4],P1[5],     pw2[0]=PKW(P1,0), pw2[1]=PKW(P1,2), pw2); \
    VRD(6); SBAR(); GAPA(C1=__builtin_amdgcn_mfma_f32_32x32x16_bf16(kf[5],qr[2],C1,0,0,0),   P1[6],P1[7],P1[8],P1[9],     pw2[2]=PKW(P1,4), pw2[3]=PKW(P1,6), pw2); \
    VRD(3); SBAR(); GAPA(C0=__builtin_amdgcn_mfma_f32_32x32x16_bf16(kf[6],qr[3],C0,0,0,0),   P1[10],P1[11],P1[12],P1[13], pw3[0]=PKW(P1,8), pw3[1]=PKW(P1,10), pw3); \
    VRD(7); SBAR(); GAPA(C1=__builtin_amdgcn_mfma_f32_32x32x16_bf16(kf[7],qr[3],C1,0,0,0),   P1[14],P1[15],0.f,0.f,       pw3[2]=PKW(P1,12),pw3[3]=PKW(P1,14), pw3); \
    l_reg+=sacc; \
    if(GK){DMA_K((t)+3,sl_cur);} if(GV){DMA_V((t)+1,sl_next);} \
    CMASK(C0,C1,t); \
    { float a=MX3(C0[0],C0[1],C1[0]),b=MX3(C0[2],C0[3],C1[1]); a=MX3(a,C1[2],C1[3]); \
      _Pragma("unroll") for(int r=4;r<16;r+=4){a=MX3(a,C0[r],C0[r+1]);b=MX3(b,C0[r+2],C0[r+3]);a=MX3(a,C1[r],C1[r+1]);b=MX3(b,C1[r+2],C1[r+3]);} \
      float rm=__builtin_fmaxf(a,b); { auto rr=__builtin_amdgcn_permlane32_swap(__float_as_uint(rm),__float_as_uint(rm),false,false); rm=__builtin_fmaxf(__uint_as_float(rr[0]),__uint_as_float(rr[1])); } \
      resc=false; \
      if(__builtin_expect(__any(rm>(float)THRL),0)){ const float dl=__builtin_fmaxf(rm,0.f); mhat+=dl; \
        _Pragma("unroll") for(int r=0;r<16;++r){C0[r]-=dl;C1[r]-=dl;} \
        cqm=cq-mhat; \
        const float f=__builtin_amdgcn_exp2f(-dl); l_reg*=f; if(hi==0)wsf[r32]=f; resc=true; } } \
    SBAR(); \
    GAPB(o[0]=__builtin_amdgcn_mfma_f32_32x32x16_bf16(PAF(0),VFR(0),o[0],0,0,0), C0,0); \
    GAPB(o[1]=__builtin_amdgcn_mfma_f32_32x32x16_bf16(PAF(0),VFR(4),o[1],0,0,0), C0,4); \
    KRD(GL,0); GAPB(o[0]=__builtin_amdgcn_mfma_f32_32x32x16_bf16(PAF(1),VFR(1),o[0],0,0,0), C0,8); \
    KRD(GL,1); GAPB(o[1]=__builtin_amdgcn_mfma_f32_32x32x16_bf16(PAF(1),VFR(5),o[1],0,0,0), C0,12); \
    KRD(GL,2); GAPB(o[0]=__builtin_amdgcn_mfma_f32_32x32x16_bf16(PAF(2),VFR(2),o[0],0,0,0), C1,0); \
    KRD(GL,3); GAPB(o[1]=__builtin_amdgcn_mfma_f32_32x32x16_bf16(PAF(2),VFR(6),o[1],0,0,0), C1,4); \
    GAPB(o[0]=__builtin_amdgcn_mfma_f32_32x32x16_bf16(PAF(3),VFR(3),o[0],0,0,0), C1,8); \
    GAPB(o[1]=__builtin_amdgcn_mfma_f32_32x32x16_bf16(PAF(3),VFR(7),o[1],0,0,0), C1,12); \
    }while(0)
  int t=1;
  #undef CMASK
  #define CMASK(P0,P1,t) do{}while(0)
  for(;t+5<NT;t+=2){
    STEP(pB0,pB1,pA0,pA1,t,true,true,true);     WAIT_BAR(2); RESC(); ROT();
    STEP(pA0,pA1,pB0,pB1,t+1,true,true,true);   WAIT_BAR(2); RESC(); ROT();
  }
  #undef CMASK
  #define CMASK(P0,P1,t) do{int jb_=(t)-(NT-4); if(jb_>=0)cmask(P0,P1,jb_,qrel,hi);}while(0)
  #define ENDW(tt) do{ if((tt)+3<NT){WAIT_BAR(2);} else if((tt)+2<NT){WAIT_BAR(1);} else {WAIT_BAR(0);} }while(0)
  for(;t+1<NT;t+=2){
    STEP(pB0,pB1,pA0,pA1,t,(t+3<NT),(t+1<NT),(t+1<NT));       ENDW(t);   RESC(); ROT();
    STEP(pA0,pA1,pB0,pB1,t+1,(t+4<NT),(t+2<NT),(t+2<NT));     ENDW(t+1); RESC(); ROT();
  }
  STEP(pB0,pB1,pA0,pA1,NT-1,false,false,false); RESC();
  { float sacc=pB0[0]+pB0[1]; _Pragma("unroll") for(int r=2;r<16;++r)sacc+=pB0[r]; _Pragma("unroll") for(int r=0;r<16;++r)sacc+=pB1[r]; l_reg+=sacc;
    pw0=(u32x4){PKW(pB0,0),PKW(pB0,2),PKW(pB0,4),PKW(pB0,6)};pw1=(u32x4){PKW(pB0,8),PKW(pB0,10),PKW(pB0,12),PKW(pB0,14)};pw2=(u32x4){PKW(pB1,0),PKW(pB1,2),PKW(pB1,4),PKW(pB1,6)};pw3=(u32x4){PKW(pB1,8),PKW(pB1,10),PKW(pB1,12),PKW(pB1,14)};
    SBAR(); pv(o,vb0+sl_cur,PAF(0),PAF(1),PAF(2),PAF(3)); }
  #undef PKW
  #undef PAF
  #undef VFR
  #undef PIN
  #undef MX3
  #undef GAPA
  #undef GAPB
  #undef EX
  #undef VRD
  #undef KRD
  #undef STEP
  #undef ENDW
  {auto rr=__builtin_amdgcn_permlane32_swap(__float_as_uint(l_reg),__float_as_uint(l_reg),false,false);l_reg=__uint_as_float(rr[0])+__uint_as_float(rr[1]);}
  if(hi==0)wsf[32+r32]=l_reg;asm volatile("s_waitcnt lgkmcnt(0)":::"memory");
  float rli[16];
  #pragma unroll
  for(int r=0;r<16;++r)rli[r]=__builtin_amdgcn_rcpf(wsf[32+crow(r,hi)]);
  bf16*Ow=O+(rowbase+q0+wid*QBLK)*DMO+h*D;
  { bf16*stg=(bf16*)(shm+LDS_OST)+wid*2048;
    #pragma unroll
    for(int r=0;r<16;++r){const int orow=crow(r,hi);
      #pragma unroll
      for(int d0=0;d0<2;++d0)stg[orow*64+d0*32+r32]=__float2bfloat16(o[d0][r]*rli[r]);}
    asm volatile("s_waitcnt lgkmcnt(0)":::"memory");
    #pragma unroll
    for(int i=0;i<4;++i){const int row=i*8+(lane>>3),ch=lane&7; const u32x4 v=*(const u32x4*)(stg+row*64+ch*8); ATTN_STORE16(Ow+(long)row*DMO+ch*8,v);} }
  asm volatile("s_waitcnt lgkmcnt(0)\n\ts_barrier":::"memory");
  #undef DMA_K
  #undef DMA_V
  #undef CMASK
  #undef START
  #undef RESC
  #undef ROT
  #undef CINIT
}
constexpr int ATTN_LDS_BYTES=LDS_BYTES;
struct AttnTensors { const bf16* Q; const bf16* K; const bf16* V; bf16* O; const float* LF; };
struct AttnUnit { int bh; int qb; };
struct StaticOrder {
  int vcu, G;
  __device__ __forceinline__ StaticOrder(int grid,int vcu_):vcu(vcu_),G(grid){}
  __device__ __forceinline__ bool next(int i,AttnUnit&u)const{
    if(G==256){ if(i>=2)return false; const int s=vcu&7; u.bh=vcu>>3; u.qb=(i==0)?15-s:s; return true; }
    const int idx=i*G+vcu; if(idx>=BATCH*NHEAD*NQB)return false; u.qb=NQB-1-idx/(BATCH*NHEAD); u.bh=idx%(BATCH*NHEAD); return true; }
  __device__ __forceinline__ void a_ready(const AttnUnit&)const{}
  __device__ __forceinline__ void done(const AttnUnit&)const{}
};
template<class Sched,int THRL=8> __device__ __forceinline__ void attn_phase(char*lds,const AttnTensors&T,const Sched&S){
  AttnUnit u;
  for(int i=0;S.next(i,u);++i){ S.a_ready(u); attn_unit<THRL>(u.bh/NHEAD,u.bh%NHEAD,u.qb,T.Q,T.K,T.V,T.O,T.LF+(size_t)u.bh*SEQ,lds); S.done(u); }
}
#undef SBAR
#undef WAIT_BAR
}
#define GAS __attribute__((address_space(1)))
#define LAS __attribute__((address_space(3)))
typedef unsigned short bf16;
typedef unsigned v4u __attribute__((ext_vector_type(4)));
typedef float f32x4 __attribute__((ext_vector_type(4)));
typedef short bf16x8 __attribute__((ext_vector_type(8)));
typedef GAS unsigned gu32;
typedef GAS unsigned long long gu64;
#define RLX_AGENT __ATOMIC_RELAXED, __HIP_MEMORY_SCOPE_AGENT
#define LDS_WAIT() asm volatile("s_waitcnt lgkmcnt(0)" ::: "memory")
#define VM_WAIT() asm volatile("s_waitcnt vmcnt(0)" ::: "memory")
__device__ __forceinline__ unsigned long long rt() { return __builtin_amdgcn_s_memrealtime(); }
__device__ __forceinline__ unsigned f2bf(float f) { unsigned u = __builtin_bit_cast(unsigned, f); return (u + 0x7fffu + ((u >> 16) & 1u)) >> 16; }
__device__ __forceinline__ unsigned pk2(float lo, float hi) { return f2bf(lo) | (f2bf(hi) << 16); }

#define XB_TMO      128
#define XB_XCNT(j)  (256  + 64 * (j))
#define XB_XSUB(j)  (1280 + 64 * (j))
#define XB_XGEN(j)  (2304 + 64 * (j))
#define XB_TOP      3328
#define XB_TOPGEN   3392
#define XCD_BAR_WORDS 3456
#define XB_SPIN_CAP (1u << 18)

__device__ __forceinline__ unsigned xb_ld(unsigned* p)              { return __hip_atomic_load(p, __ATOMIC_RELAXED, __HIP_MEMORY_SCOPE_AGENT); }
__device__ __forceinline__ unsigned xb_add(unsigned* p, unsigned v) { return __hip_atomic_fetch_add(p, v, __ATOMIC_RELAXED, __HIP_MEMORY_SCOPE_AGENT); }
__device__ __forceinline__ unsigned xb_xcc_id() { return (unsigned)__builtin_amdgcn_s_getreg((3 << 11) | 20) & 0xFu; }
#define XB_SPIN(cond, bar) do { unsigned _sp = 0; while (cond) { __builtin_amdgcn_s_sleep(1); \
    if ((++_sp & 255u) == 0u) { if (xb_ld(&(bar)[XB_TMO])) break; if (_sp > XB_SPIN_CAP) { atomicAdd(&(bar)[XB_TMO], 1u); break; } } } } while (0)

struct XcdBarrier {
    unsigned* bar; unsigned x;
    volatile LAS unsigned* st;
};

__device__ __forceinline__ XcdBarrier xcd_barrier_post(unsigned* bar, volatile LAS unsigned* st) {
    XcdBarrier b; b.bar = bar; b.x = xb_xcc_id(); b.st = st;
    if (threadIdx.x == 0) (void)xb_add(&bar[XB_XCNT(b.x)], 1u);
    return b;
}
__device__ __forceinline__ void xcd_barrier_complete(unsigned* bar, unsigned x, unsigned& nloc, unsigned& nx) {
    const unsigned G = gridDim.x * gridDim.y * gridDim.z;
    unsigned sum, cnt, mine, sp = 0u;
    for (;;) {
        sum = 0u; cnt = 0u; mine = 0u;
#pragma unroll
        for (unsigned j = 0; j < 16; ++j) { const unsigned c = xb_ld(&bar[XB_XCNT(j)]); sum += c; cnt += (c > 0u) ? 1u : 0u; mine = (j == x) ? c : mine; }
        if (sum == G) break;
        __builtin_amdgcn_s_sleep(1);
        if ((++sp & 255u) == 0u) { if (xb_ld(&bar[XB_TMO])) break; if (sp > XB_SPIN_CAP) { atomicAdd(&bar[XB_TMO], 1u); break; } }
    }
    nloc = mine > 0u ? mine : 1u; nx = cnt > 0u ? cnt : 1u;
}

__device__ __forceinline__ void xcd_barrier(const XcdBarrier& b) {
    asm volatile("s_waitcnt vmcnt(0)" ::: "memory");
    __syncthreads();
    if (threadIdx.x == 0) {
        unsigned* bar = b.bar;
        __builtin_amdgcn_s_waitcnt(0);
        unsigned nloc = b.st[0], nx = b.st[1];
        if (nloc == 0u) { xcd_barrier_complete(bar, b.x, nloc, nx); b.st[0] = nloc; b.st[1] = nx; }
        const unsigned old = xb_add(&bar[XB_XSUB(b.x)], 1u);
        const unsigned gen = old / nloc;
        if (old + 1u == (gen + 1u) * nloc) {
            __builtin_amdgcn_fence(__ATOMIC_RELEASE, "agent");
            asm volatile("s_waitcnt vmcnt(0)" ::: "memory");
            const unsigned og = xb_add(&bar[XB_TOP], 1u);
            const unsigned tg = og / nx;
            if (og + 1u == (tg + 1u) * nx) xb_add(&bar[XB_TOPGEN], 1u);
            else XB_SPIN(xb_ld(&bar[XB_TOPGEN]) == tg, bar);
            __builtin_amdgcn_fence(__ATOMIC_ACQUIRE, "agent");
            xb_add(&bar[XB_XGEN(b.x)], 1u);
            asm volatile("s_waitcnt vmcnt(0)" ::: "memory");
        } else {
            XB_SPIN(xb_ld(&bar[XB_XGEN(b.x)]) == gen, bar);
            __builtin_amdgcn_fence(__ATOMIC_ACQUIRE, "agent");
            asm volatile("s_waitcnt vmcnt(0)" ::: "memory");
        }
    }
    __syncthreads();
}

constexpr int NWAVES = 8;
constexpr int BATCH = 4, SEQ = 4096, D = 1024, M = BATCH * SEQ, NH = 8, HD = 64, AW = 512, PLE = 256;
constexpr int NIN = 5120, INTOT = 5128, NKEYS = 128, NEXP = 16384, NS = 2048;
constexpr float EPS = 1e-6f, LOG2E = 1.4426950408889634f, C2 = 0.125f * LOG2E;
constexpr int NPHASE = 9;
constexpr int SLW = 128, NSL = D / SLW;
static_assert(NSL == 8, "one slice per XCD group; SS3 has 16 slots");
constexpr int SL4 = 256, NSL4 = D / SL4;
constexpr float Q4_STEP = 0.3352f;

constexpr size_t MiB = 1u << 20;
constexpr size_t WS_CTL = 0, CTL_ZERO_BYTES = 64 * 1024;
constexpr size_t WS_RSTD1 = 1 * MiB, WS_RSTD3 = WS_RSTD1 + 65536, WS_LF = WS_RSTD3 + 65536, WS_CS = WS_LF + 524288, WS_SS2 = WS_CS + 524288, WS_WPP = WS_SS2 + 1048576;
constexpr size_t WS_WQ8 = 20 * MiB, WS_SW = WS_RSTD1;
constexpr size_t WS_SU = WS_RSTD3, WS_SV = WS_WPP + 524288;
constexpr size_t WS_SWC = WS_SV + 65536;
static_assert(WS_SWC + 65536 <= 4 * MiB, "small region");
constexpr size_t WS_WIN = 4 * MiB, WS_WBR = 14 * MiB, WS_WOUT = 16 * MiB, WS_WS = 18 * MiB, WS_WPG = 22 * MiB, WS_PB = 24 * MiB;
constexpr size_t WS_UB = 32 * MiB, WS_VB = 48 * MiB;
constexpr size_t WS_AC = 64 * MiB;
constexpr size_t WS_A = 96 * MiB;
constexpr size_t WS_PP = 128 * MiB;
constexpr size_t WS_Q = 160 * MiB, WS_K = 176 * MiB, WS_V = 192 * MiB, WS_GB = 208 * MiB, WS_Z = 224 * MiB;
constexpr size_t WS_MERGED = 160 * MiB, WS_XB2 = 192 * MiB, WS_IDS = 224 * MiB, WS_GATES = 232 * MiB;
constexpr size_t WS_XB3 = 64 * MiB, WS_SS4 = WS_LF;
constexpr size_t WS_XB2_8 = 240 * MiB;
constexpr size_t WS_XB8 = 240 * MiB, WS_WIN8 = 10 * MiB;
constexpr size_t WS_END = 256 * MiB;
constexpr size_t WS_PART0 = 4 * MiB, WS_PART1 = 160 * MiB, WS_PART2 = 240 * MiB;
constexpr size_t WS_TGC = 32 * MiB, WS_TXC = 64 * MiB, WS_SC = 32 * MiB;
constexpr int CW_BAR = 1024;

constexpr int RING_OFF = 0, RING_BYTES = 135168;
constexpr int LDSCTL_OFF = RING_BYTES, MISC_OFF = LDSCTL_OFF + 320;
constexpr int LDS_BYTES = RING_BYTES + 1024;
static_assert(attn_body::ATTN_LDS_BYTES <= RING_BYTES && pg8::STAGE_BYTES <= RING_BYTES && 128 * pg8::EpiTopK::RS * 4 <= RING_BYTES, "LDS map");

typedef unsigned u32x4 __attribute__((ext_vector_type(4)));
typedef unsigned u32x2 __attribute__((ext_vector_type(2)));
__device__ __forceinline__ float bf2f(bf16 v) { return __uint_as_float((unsigned)v << 16); }
__device__ __forceinline__ float wave_sum(float v) {
#pragma unroll
    for (int o = 1; o < 64; o <<= 1) v += __shfl_xor(v, o);
    return v;
}
__device__ __forceinline__ float sigmoidf_(float v) { return 1.0f / (1.0f + __expf(-v)); }
__host__ __device__ __forceinline__ int src_in(int n) {
    const int pn = n >> 8, l = n & 255;
    if (pn < 6) return n;
    if (pn < 8) return 1544 + (n - 1536);
    if (pn < 12) { const int j = pn - 8; return (l < 128) ? 2056 + 128 * j + l : 2568 + 128 * j + (l - 128); }
    { const int j = pn - 12; return (l < 128) ? 3080 + 128 * j + l : 4104 + 128 * j + (l - 128); }
}

struct Args { const float* in[18]; float* out; unsigned char* ws; int ph_lo, ph_hi, li, pad; };
struct Ctx {
    LAS unsigned char* lds; int wave, vcu, G;
    __device__ __forceinline__ int tid_() const { return (int)threadIdx.x; }
    __device__ __forceinline__ int lane_() const { return (int)threadIdx.x & 63; }
};

struct TrItem { const float* W; const float* g; bf16* WT; int ldw, k0, scol0, ldt, drow0, dk0; int fp8; };
__device__ __forceinline__ void tr_load(const TrItem& I, float (&tv)[32], int lane) {
#pragma unroll
    for (int i = 0; i < 32; ++i) { const int kk = 2 * i + (lane >> 5); tv[i] = I.W[(size_t)(I.k0 + kk) * I.ldw + I.scol0 + (lane & 31)]; }
}
__device__ __forceinline__ void tr_finish(const TrItem& I, const float (&tv)[32], LAS float* scr, int lane) {
#pragma unroll
    for (int i = 0; i < 32; ++i) { const int kk = 2 * i + (lane >> 5); float v = tv[i]; if (I.g) v *= I.g[I.k0 + kk]; scr[kk * 33 + (lane & 31)] = v; }
    LDS_WAIT(); asm volatile("" ::: "memory");
    const int c = lane & 7;
    if (I.fp8) {
#pragma unroll
        for (int j = 0; j < 4; ++j) { const int n = (lane >> 3) + 8 * j; const LAS float* s = scr + (8 * c) * 33 + n;
            u32x2 o; o.x = (unsigned)__builtin_amdgcn_cvt_pk_fp8_f32(s[0 * 33] * 32.f, s[1 * 33] * 32.f, 0, false); o.x = (unsigned)__builtin_amdgcn_cvt_pk_fp8_f32(s[2 * 33] * 32.f, s[3 * 33] * 32.f, (int)o.x, true);
            o.y = (unsigned)__builtin_amdgcn_cvt_pk_fp8_f32(s[4 * 33] * 32.f, s[5 * 33] * 32.f, 0, false); o.y = (unsigned)__builtin_amdgcn_cvt_pk_fp8_f32(s[6 * 33] * 32.f, s[7 * 33] * 32.f, (int)o.y, true);
            *(GAS u32x2*)((unsigned char*)I.WT + (size_t)(I.drow0 + n) * I.ldt + I.dk0 + 8 * c) = o; }
    } else {
#pragma unroll
        for (int j = 0; j < 4; ++j) { const int n = (lane >> 3) + 8 * j; const LAS float* s = scr + (8 * c) * 33 + n;
            v4u o; o.x = pk2(s[0 * 33], s[1 * 33]); o.y = pk2(s[2 * 33], s[3 * 33]); o.z = pk2(s[4 * 33], s[5 * 33]); o.w = pk2(s[6 * 33], s[7 * 33]);
            *(GAS v4u*)(I.WT + (size_t)(I.drow0 + n) * I.ldt + I.dk0 + 8 * c) = o; }
    }
    LDS_WAIT(); asm volatile("" ::: "memory");
}
constexpr int TR_IN = 16 * 160, TR_PP = 4 * 32, TR_BR = 8 * 32, TR_SQ = 16 * 32;
constexpr int TR_P0 = TR_IN + TR_PP;
constexpr int TR_LATE = 2 * TR_BR + 2 * TR_SQ;
__device__ __forceinline__ TrItem tr_decode(const Args& a, int r) {
    unsigned char* ws = a.ws;
    if (r < TR_IN) { const int kb = r / 160, nb = r % 160;
        if (nb >= 96) return TrItem{a.in[3], a.in[2], (bf16*)(ws + WS_WIN8), INTOT, 64 * kb, src_in(32 * nb), D, 32 * nb - 3072, 64 * kb, 1};
        return TrItem{a.in[3], a.in[2], (bf16*)(ws + WS_WIN), INTOT, 64 * kb, src_in(32 * nb), D, 32 * nb, 64 * kb, 0}; } r -= TR_IN;
    if (r < TR_PP) { const int kb = r / 32, nb = r % 32; return TrItem{a.in[16], nullptr, (bf16*)(ws + WS_WPP), D, 64 * kb, 32 * nb, PLE, 32 * nb, 64 * kb, 0}; } r -= TR_PP;
    if (r < 2 * TR_BR) { const int br = r / TR_BR, q = r % TR_BR, kb = q / 32, nb = q % 32; return TrItem{a.in[6] + (size_t)br * AW * D, nullptr, (bf16*)(ws + WS_WBR), D, 64 * kb, 32 * nb, D, 32 * nb, br * AW + 64 * kb, 0}; } r -= 2 * TR_BR;
    if (r < TR_SQ) { const int kb = r / 32, nb = r % 32; return TrItem{a.in[7], nullptr, (bf16*)(ws + WS_WOUT), D, 64 * kb, 32 * nb, D, 32 * nb, 64 * kb, 0}; } r -= TR_SQ;
    { const int kb = r / 32, nb = r % 32; return TrItem{a.in[15], a.in[14], (bf16*)(ws + WS_WPG), D, 64 * kb, 32 * nb, D, 32 * nb, 64 * kb, 1}; }
}
__device__ __forceinline__ void tr_two(const Args& a, LAS float* scr, int ra, int rb_, bool two, int lane) {
    const TrItem A = tr_decode(a, ra), B = tr_decode(a, two ? rb_ : ra);
    float ta[32], tb[32];
    tr_load(A, ta, lane); if (two) tr_load(B, tb, lane);
    tr_finish(A, ta, scr, lane); if (two) tr_finish(B, tb, scr, lane);
}
__device__ __forceinline__ void ws_item(const Args& a, LAS unsigned char* lds, int item) {
    int tid_ = (int)threadIdx.x; asm volatile("" : "+v"(tid_));
    const float *g_ffn = a.in[8], *w_peer_q = a.in[9]; bf16* WST = (bf16*)(a.ws + WS_WS);
    LAS float* KH = (LAS float*)lds; LAS float* WQ = KH + 128 * 129;
    const int hh = item >> 4, head = hh >> 1, half = hh & 1, d0 = (item & 15) * 64;
    const float* kh = (half ? a.in[11] : a.in[10]) + (size_t)head * 128 * 128;
    float tk[32], tq[16];
#pragma unroll
    for (int i = 0; i < 32; ++i) tk[i] = kh[i * 512 + tid_];
#pragma unroll
    for (int i = 0; i < 16; ++i) { const int idx = i * 512 + tid_; tq[i] = w_peer_q[(size_t)(d0 + (idx >> 7)) * NS + head * 256 + half * 128 + (idx & 127)]; }
#pragma unroll
    for (int i = 0; i < 32; ++i) { const int idx = i * 512 + tid_; KH[(idx >> 7) * 129 + (idx & 127)] = tk[i]; }
#pragma unroll
    for (int i = 0; i < 16; ++i) { const int idx = i * 512 + tid_; WQ[(idx >> 7) * 129 + (idx & 127)] = tq[i]; }
    __syncthreads();
    typedef float f32x16_t __attribute__((ext_vector_type(16)));
    const int lane = tid_ & 63, w = __builtin_amdgcn_readfirstlane(tid_ >> 6), kt = w & 3, dt = w >> 2, l31 = lane & 31, h = lane >> 5;
    const LAS float* ap = WQ + (32 * dt + l31) * 129 + h; const LAS float* bp = KH + (32 * kt + l31) * 129 + h;
    f32x16_t acc = {0.f, 0.f, 0.f, 0.f, 0.f, 0.f, 0.f, 0.f, 0.f, 0.f, 0.f, 0.f, 0.f, 0.f, 0.f, 0.f};
#pragma unroll 8
    for (int s_ = 0; s_ < 64; ++s_) acc = __builtin_amdgcn_mfma_f32_32x32x2f32(ap[2 * s_], bp[2 * s_], acc, 0, 0, 0);
    const int key = 32 * kt + l31;
#pragma unroll
    for (int q = 0; q < 4; ++q) { const int dd = d0 + 32 * dt + 8 * q + 4 * h; const f32x4 gv = *(const GAS f32x4*)(g_ffn + dd);
        u32x2 o; o.x = pk2(acc[4 * q] * gv[0], acc[4 * q + 1] * gv[1]); o.y = pk2(acc[4 * q + 2] * gv[2], acc[4 * q + 3] * gv[3]);
        *(GAS u32x2*)(WST + (size_t)(head * 256 + half * 128 + key) * D + dd) = o; }
    __syncthreads();
}
__device__ __forceinline__ void quant_load4(const Args& a, int rb, int lane, f32x4 (&v)[4][4]) {
#pragma unroll
    for (int r = 0; r < 4; ++r) { const int rr = rb + r; const bool isv = rr >= NEXP; const int e = isv ? rr - NEXP : rr;
        const GAS f32x4* src = (const GAS f32x4*)((isv ? a.in[13] : a.in[12]) + (size_t)e * D) + lane;
#pragma unroll
        for (int j = 0; j < 4; ++j) v[r][j] = src[64 * j]; }
}
__device__ __forceinline__ void quant_finish4(const Args& a, int rb, int lane, f32x4 (&v)[4][4]) {
    unsigned char* ws = a.ws; const float *g_ffn = a.in[8];
    f32x4 gq[4];
#pragma unroll
    for (int j = 0; j < 4; ++j) gq[j] = *(const GAS f32x4*)(g_ffn + 256 * j + 4 * lane);
#pragma unroll
    for (int r = 0; r < 4; ++r) { const int rr = rb + r; const bool isv = rr >= NEXP; const int e = isv ? rr - NEXP : rr;
        float am = 0.f;
#pragma unroll
        for (int j = 0; j < 4; ++j) { if (!isv) v[r][j] = v[r][j] * gq[j]; am = fmaxf(am, fmaxf(fmaxf(fabsf(v[r][j].x), fabsf(v[r][j].y)), fmaxf(fabsf(v[r][j].z), fabsf(v[r][j].w)))); }
#pragma unroll
        for (int o = 1; o < 64; o <<= 1) am = fmaxf(am, __shfl_xor(am, o));
        unsigned char* tb = ws + (isv ? WS_VB : WS_UB);
        if (isv) {
            float ss = 0.f;
#pragma unroll
            for (int j = 0; j < 4; ++j) ss += (v[r][j].x * v[r][j].x + v[r][j].y * v[r][j].y) + (v[r][j].z * v[r][j].z + v[r][j].w * v[r][j].w);
#pragma unroll
            for (int o = 1; o < 64; o <<= 1) ss += __shfl_xor(ss, o);
            const float st = fminf(Q4_STEP * sqrtf(ss * (1.0f / D)), am * 0.125f), inv = st > 0.f ? 1.0f / st : 0.f;
#pragma unroll
            for (int j = 0; j < 4; ++j) {
                const int n0 = (int)fminf(fmaxf(floorf(v[r][j].x * inv + 8.0f), 0.f), 15.f), n1 = (int)fminf(fmaxf(floorf(v[r][j].y * inv + 8.0f), 0.f), 15.f);
                const int n2 = (int)fminf(fmaxf(floorf(v[r][j].z * inv + 8.0f), 0.f), 15.f), n3 = (int)fminf(fmaxf(floorf(v[r][j].w * inv + 8.0f), 0.f), 15.f);
                *(GAS unsigned short*)(tb + ((size_t)j * NEXP + e) * 128 + 2 * lane) = (unsigned short)(n0 | ((n1 ^ 8) << 4) | (n2 << 8) | ((n3 ^ 8) << 12)); }
            if (lane == 0) ((float*)(ws + WS_SV))[e] = st;
            continue;
        }
        const float sc = am > 0.f ? 127.0f / am : 0.f;
#pragma unroll
        for (int j = 0; j < 4; ++j) { const int q0 = (int)rintf(v[r][j].x * sc), q1 = (int)rintf(v[r][j].y * sc), q2 = (int)rintf(v[r][j].z * sc), q3 = (int)rintf(v[r][j].w * sc);
            const unsigned o = (unsigned)(q0 & 255) | ((unsigned)(q1 & 255) << 8) | ((unsigned)(q2 & 255) << 16) | ((unsigned)(q3 & 255) << 24);
            *(GAS unsigned*)(tb + ((size_t)(2 * j + (lane >> 5)) * NEXP + e) * SLW + ((4 * lane) & 127)) = o; }
        if (lane == 0) ((float*)(ws + (isv ? WS_SV : WS_SU)))[e] = am * (1.0f / 127.0f);
    }
}
__device__ __forceinline__ void quant_rows4(const Args& a, int rb, int lane) { f32x4 v[4][4]; quant_load4(a, rb, lane, v); quant_finish4(a, rb, lane, v); }
__device__ __forceinline__ void p0_prologue(const Ctx& F, const Args& a, volatile LAS unsigned* MISC) {
    unsigned char* ws = a.ws;
    const float *x = a.in[0], *p = a.in[1], *g_mix = a.in[2], *w_in = a.in[3], *b_f = a.in[4];
    bf16 *PB = (bf16*)(ws + WS_PB), *XB = (bf16*)(ws + WS_A);
    float *RSTD1 = (float*)(ws + WS_RSTD1), *LF = (float*)(ws + WS_LF);
    const int gw = F.vcu * NWAVES + F.wave, NGW = F.G * NWAVES, NGT = F.G * 512;
    const int tid_ = (int)threadIdx.x, lane_ = tid_ & 63;
    auto stepB = [&]() __attribute__((always_inline)) {
        LAS float* scr = (LAS float*)(F.lds + RING_OFF + F.wave * 16384);
        for (int it = gw; it < TR_P0; it += 2 * NGW) tr_two(a, scr, it, it + NGW, it + NGW < TR_P0, lane_);
    };
    auto stepC = [&]() __attribute__((always_inline)) {
    {
        LAS float* WFL = (LAS float*)(F.lds + RING_OFF);
        { float tw[16], tg[16];
#pragma unroll
          for (int i = 0; i < 16; ++i) { const int idx = i * 512 + tid_, k = idx >> 3, h = idx & 7; tw[i] = w_in[(size_t)k * INTOT + 1536 + h]; tg[i] = g_mix[k]; }
#pragma unroll
          for (int i = 0; i < 16; ++i) { const int idx = i * 512 + tid_, k = idx >> 3, h = idx & 7; WFL[h * 1024 + k] = tg[i] * tw[i]; } }
        __syncthreads();
        for (int rb = gw; rb < M; rb += 4 * NGW) {
            f32x4 v[4][4];
#pragma unroll
            for (int r = 0; r < 4; ++r) { const int row = rb + r * NGW; if (row < M) { const GAS f32x4* xr = (const GAS f32x4*)(x + (size_t)row * D);
#pragma unroll
                for (int j = 0; j < 4; ++j) v[r][j] = xr[lane_ + 64 * j]; } }
#pragma unroll
            for (int r = 0; r < 4; ++r) { const int row = rb + r * NGW; if (row < M) {
                float ss = 0.f;
#pragma unroll
                for (int j = 0; j < 4; ++j) ss += (v[r][j].x * v[r][j].x + v[r][j].y * v[r][j].y) + (v[r][j].z * v[r][j].z + v[r][j].w * v[r][j].w);
                ss = wave_sum(ss);
                const float rstd = 1.0f / sqrtf(ss * (1.0f / D) + EPS);
                GAS u32x2* o = (GAS u32x2*)(XB + (size_t)row * D);
#pragma unroll
                for (int j = 0; j < 4; ++j) { u32x2 w; w.x = pk2(v[r][j].x, v[r][j].y); w.y = pk2(v[r][j].z, v[r][j].w); o[lane_ + 64 * j] = w; }
                { GAS unsigned* o8 = (GAS unsigned*)(ws + WS_XB8 + (size_t)row * D);
#pragma unroll
                  for (int j = 0; j < 4; ++j) { int q = __builtin_amdgcn_cvt_pk_fp8_f32(v[r][j].x, v[r][j].y, 0, false); q = __builtin_amdgcn_cvt_pk_fp8_f32(v[r][j].z, v[r][j].w, q, true); o8[lane_ + 64 * j] = (unsigned)q; } }
                if (lane_ == 0) RSTD1[row] = rstd;
                float f[8];
#pragma unroll
                for (int h = 0; h < 8; ++h) { float s_ = 0.f;
#pragma unroll
                    for (int j = 0; j < 4; ++j) { const f32x4 w = *(const LAS f32x4*)(WFL + h * 1024 + 4 * (lane_ + 64 * j)); s_ += (v[r][j].x * w[0] + v[r][j].y * w[1]) + (v[r][j].z * w[2] + v[r][j].w * w[3]); }
                    f[h] = s_; }
                float r4[4], r2[2], r1;
#pragma unroll
                for (int i = 0; i < 4; ++i) { const float send = (lane_ & 32) ? f[i] : f[i + 4], keep = (lane_ & 32) ? f[i + 4] : f[i]; r4[i] = keep + __shfl_xor(send, 32); }
#pragma unroll
                for (int i = 0; i < 2; ++i) { const float send = (lane_ & 16) ? r4[i] : r4[i + 2], keep = (lane_ & 16) ? r4[i + 2] : r4[i]; r2[i] = keep + __shfl_xor(send, 16); }
                { const float send = (lane_ & 8) ? r2[0] : r2[1], keep = (lane_ & 8) ? r2[1] : r2[0]; r1 = keep + __shfl_xor(send, 8); }
                r1 += __shfl_xor(r1, 4); r1 += __shfl_xor(r1, 2); r1 += __shfl_xor(r1, 1);
                const int hL = ((lane_ >> 5) & 1) * 4 + ((lane_ >> 4) & 1) * 2 + ((lane_ >> 3) & 1);
                const float tot = r1 * rstd + b_f[hL];
                const float ls = fminf(tot, 0.f) - log1pf(__expf(-fabsf(tot)));
                const int b = row / SEQ, t = row % SEQ;
                if ((lane_ & 7) == 0) LF[(size_t)(b * NH + hL) * SEQ + t] = ls * LOG2E;
            } }
        }
    }
    };
    if (F.vcu & 1) { stepC(); __syncthreads(); stepB(); }
    else           { stepB(); __syncthreads(); stepC(); }
    { constexpr int NP = M * PLE / 8;
        for (int i = F.vcu * 512 + tid_; i < NP; i += NGT) { const f32x4 a_ = ((const GAS f32x4*)p)[2 * (size_t)i], b_ = ((const GAS f32x4*)p)[2 * (size_t)i + 1];
            v4u o; o.x = pk2(a_.x, a_.y); o.y = pk2(a_.z, a_.w); o.z = pk2(b_.x, b_.y); o.w = pk2(b_.z, b_.w); ((GAS v4u*)PB)[i] = o; }
    }
}
__device__ __forceinline__ void p2_conv_chunk(int chunk, const bf16* GB, const bf16* Z, const float* cw, bf16* AC) {
    int tid_l = (int)threadIdx.x; asm volatile("" : "+v"(tid_l));
#pragma unroll 4
    for (int k = 0; k < 16; ++k) {
        const int i = chunk * 8192 + k * 512 + tid_l;
        const int row = i >> 6, c = (i & 63) * 8, t = row & (SEQ - 1);
        const v4u z2 = *(const GAS v4u*)(Z + (size_t)row * AW + c), g = *(const GAS v4u*)(GB + (size_t)row * AW + c);
        v4u z1 = {0u, 0u, 0u, 0u}, z0 = {0u, 0u, 0u, 0u};
        if (t >= 1) z1 = *(const GAS v4u*)(Z + (size_t)(row - 1) * AW + c);
        if (t >= 2) z0 = *(const GAS v4u*)(Z + (size_t)(row - 2) * AW + c);
        float r[8];
#pragma unroll
        for (int e = 0; e < 4; ++e) {
            const float w0a = cw[c + 2 * e], w0b = cw[c + 2 * e + 1], w1a = cw[AW + c + 2 * e], w1b = cw[AW + c + 2 * e + 1], w2a = cw[2 * AW + c + 2 * e], w2b = cw[2 * AW + c + 2 * e + 1];
            r[2 * e] = __uint_as_float(g[e] << 16) * (w0a * __uint_as_float(z0[e] << 16) + w1a * __uint_as_float(z1[e] << 16) + w2a * __uint_as_float(z2[e] << 16));
            r[2 * e + 1] = __uint_as_float(g[e] & 0xffff0000u) * (w0b * __uint_as_float(z0[e] & 0xffff0000u) + w1b * __uint_as_float(z1[e] & 0xffff0000u) + w2b * __uint_as_float(z2[e] & 0xffff0000u));
        }
        v4u o; o.x = pk2(r[0], r[1]); o.y = pk2(r[2], r[3]); o.z = pk2(r[4], r[5]); o.w = pk2(r[6], r[7]);
        *(GAS v4u*)(AC + (size_t)row * D + AW + c) = o;
    }
}
constexpr int P2_NATT = 512, P2_NCONV = M * AW / 8 / 8192, P2_NQ = 2 * NEXP / 64, P2_NWS = 256, P2_NTR = TR_LATE / 16, CW_QUEUE = 512;
constexpr int P2_NITEMS = P2_NATT + P2_NCONV + P2_NQ + P2_NWS + P2_NTR;
__device__ __forceinline__ int p2_dequeue(unsigned* ctr, volatile LAS unsigned* slot) {
    if (threadIdx.x == 0) *slot = __hip_atomic_fetch_add(ctr, 1u, __ATOMIC_RELAXED, __HIP_MEMORY_SCOPE_AGENT);
    asm volatile("s_waitcnt vmcnt(0) lgkmcnt(0)\n\ts_barrier" ::: "memory");
    const unsigned v = *slot;
    asm volatile("s_waitcnt lgkmcnt(0)\n\ts_barrier" ::: "memory");
    return (int)v;
}
template <int CTRL> __device__ __forceinline__ int dpp_i(int v) { return __builtin_amdgcn_update_dpp(0, v, CTRL, 0xf, 0xf, true); }
__device__ __forceinline__ int sum8i(int v) { v += dpp_i<0x141>(v); v += dpp_i<0xB1>(v); v += dpp_i<0x4E>(v); return v; }
__device__ __forceinline__ float max8f(float v) { v = fmaxf(v, __uint_as_float((unsigned)dpp_i<0x141>((int)__float_as_uint(v)))); v = fmaxf(v, __uint_as_float((unsigned)dpp_i<0xB1>((int)__float_as_uint(v)))); v = fmaxf(v, __uint_as_float((unsigned)dpp_i<0x4E>((int)__float_as_uint(v)))); return v; }
__device__ __forceinline__ size_t part_slab(int j) { return j < 2 ? WS_PART0 + (size_t)j * 8 * MiB : j < 6 ? WS_PART1 + (size_t)(j - 2) * 8 * MiB : WS_PART2 + (size_t)(j - 6) * 8 * MiB; }
struct P6Geo { int xg, wi, nwv, ng; };
__device__ __forceinline__ P6Geo p6_geo(const Ctx& F) { P6Geo g; const int bx = blockIdx.x, ng = F.G < 8 ? F.G : 8; g.xg = bx % ng; g.wi = (bx / ng) * NWAVES + F.wave; g.nwv = ((F.G - g.xg + ng - 1) / ng) * NWAVES; g.ng = ng; return g; }
__device__ __forceinline__ void p6a_upass(const Ctx& F, unsigned char* ws, const bf16* XB1, const unsigned short* IDS) {
    const P6Geo G = p6_geo(F); const int lane = F.lane_(), g = lane >> 3, c = lane & 7;
    for (int sl = G.xg; sl < NSL; sl += G.ng) {
        float* PART = (float*)(ws + part_slab(sl));
        const GAS unsigned char* Ts = (const GAS unsigned char*)(ws + WS_UB) + (size_t)sl * NEXP * SLW + 16 * c;
        for (int t = G.wi; t < M; t += G.nwv) {
            const v4u xa = *(const GAS v4u*)(XB1 + (size_t)t * D + sl * SLW + 16 * c), xb = *(const GAS v4u*)(XB1 + (size_t)t * D + sl * SLW + 16 * c + 8);
            v4u idp[2];
#pragma unroll
            for (int q = 0; q < 2; ++q) idp[q] = *(const GAS v4u*)(IDS + (size_t)t * 128 + 16 * g + 8 * q);
            v4u u[16];
#pragma unroll
            for (int i = 0; i < 16; ++i) { const unsigned w_ = idp[i >> 3][(i >> 1) & 3]; u[i] = *(const GAS v4u*)(Ts + ((i & 1) ? ((w_ >> 9) & 0x7fff80u) : ((w_ << 7) & 0x7fff80u))); }
            float xf[16];
#pragma unroll
            for (int e = 0; e < 4; ++e) { xf[2 * e] = __uint_as_float(xa[e] << 16); xf[2 * e + 1] = __uint_as_float(xa[e] & 0xffff0000u); xf[8 + 2 * e] = __uint_as_float(xb[e] << 16); xf[8 + 2 * e + 1] = __uint_as_float(xb[e] & 0xffff0000u); }
            float am = 0.f;
#pragma unroll
            for (int e = 0; e < 16; ++e) am = fmaxf(am, fabsf(xf[e]));
            am = max8f(am);
            const float sc = am > 0.f ? 127.0f / am : 0.f, sx = am * (1.0f / 127.0f);
            int qx[4];
#pragma unroll
            for (int j = 0; j < 4; ++j) qx[j] = (int)(((unsigned)((int)rintf(xf[4 * j] * sc) & 255)) | ((unsigned)((int)rintf(xf[4 * j + 1] * sc) & 255) << 8) | ((unsigned)((int)rintf(xf[4 * j + 2] * sc) & 255) << 16) | ((unsigned)((int)rintf(xf[4 * j + 3] * sc) & 255) << 24));
            int r0 = 0, r1 = 0;
#pragma unroll
            for (int i = 0; i < 16; ++i) { int sacc = __builtin_amdgcn_sdot4(qx[0], (int)u[i][0], 0, false); sacc = __builtin_amdgcn_sdot4(qx[1], (int)u[i][1], sacc, false); sacc = __builtin_amdgcn_sdot4(qx[2], (int)u[i][2], sacc, false); sacc = __builtin_amdgcn_sdot4(qx[3], (int)u[i][3], sacc, false);
                sacc = sum8i(sacc);
                if (i < 8) r0 = (c == i) ? sacc : r0; else r1 = (c == i - 8) ? sacc : r1; }
            float* pp = PART + (size_t)t * 128 + 16 * g + c;
            pp[0] = (float)r0 * sx; pp[8] = (float)r1 * sx;
        }
    }
}
__device__ __forceinline__ int pl32_sum(int a, int b) { const auto s_ = __builtin_amdgcn_permlane32_swap((unsigned)a, (unsigned)b, false, false); return (int)(s_[0] + s_[1]); }
__device__ __forceinline__ int pl16_sum(int a, int b) { const auto s_ = __builtin_amdgcn_permlane16_swap((unsigned)a, (unsigned)b, false, false); return (int)(s_[0] + s_[1]); }
__device__ __forceinline__ float wave_sum_valu(float v) {
    { const auto s_ = __builtin_amdgcn_permlane32_swap(__float_as_uint(v), __float_as_uint(v), false, false); v = __uint_as_float(s_[0]) + __uint_as_float(s_[1]); }
    { const auto s_ = __builtin_amdgcn_permlane16_swap(__float_as_uint(v), __float_as_uint(v), false, false); v = __uint_as_float(s_[0]) + __uint_as_float(s_[1]); }
    v += __uint_as_float((unsigned)dpp_i<0x128>((int)__float_as_uint(v))); v += __uint_as_float((unsigned)dpp_i<0x124>((int)__float_as_uint(v)));
    v += __uint_as_float((unsigned)dpp_i<0x122>((int)__float_as_uint(v))); v += __uint_as_float((unsigned)dpp_i<0x121>((int)__float_as_uint(v))); return v;
}
__device__ __forceinline__ float wave_max_valu(float v) {
    { const auto s_ = __builtin_amdgcn_permlane32_swap(__float_as_uint(v), __float_as_uint(v), false, false); v = fmaxf(__uint_as_float(s_[0]), __uint_as_float(s_[1])); }
    { const auto s_ = __builtin_amdgcn_permlane16_swap(__float_as_uint(v), __float_as_uint(v), false, false); v = fmaxf(__uint_as_float(s_[0]), __uint_as_float(s_[1])); }
    v = fmaxf(v, __uint_as_float((unsigned)dpp_i<0x128>((int)__float_as_uint(v)))); v = fmaxf(v, __uint_as_float((unsigned)dpp_i<0x124>((int)__float_as_uint(v))));
    v = fmaxf(v, __uint_as_float((unsigned)dpp_i<0x122>((int)__float_as_uint(v)))); v = fmaxf(v, __uint_as_float((unsigned)dpp_i<0x121>((int)__float_as_uint(v)))); return v;
}
__device__ __forceinline__ void p6b_combine(const Ctx& F, unsigned char* ws, float* SS2, const unsigned short* IDS, const float* GATES) {
    const int gw = F.vcu * NWAVES + F.wave, NGW = F.G * NWAVES, lane = F.lane_();
    const float *SU = (const float*)(ws + WS_SU), *SV = (const float*)(ws + WS_SV);
    signed char* WQ8 = (signed char*)(ws + WS_WQ8); float* SW = (float*)(ws + WS_SW);
    for (int tb = gw; tb < M; tb += 4 * NGW) {
        float ssv[4], a0[4], a1[4], g0[4], g1[4], su0[4], su1[4], sv0[4], sv1[4], pa[4][8], pb[4][8]; int i0[4], i1[4];
#pragma unroll
        for (int r = 0; r < 4; ++r) { const int t = tb + r * NGW; if (t < M) { i0[r] = (int)IDS[(size_t)t * 128 + lane]; i1[r] = (int)IDS[(size_t)t * 128 + 64 + lane]; } }
#pragma unroll
        for (int r = 0; r < 4; ++r) { const int t = tb + r * NGW; if (t < M) {
            ssv[r] = lane < 16 ? SS2[(size_t)t * 16 + lane] : 0.f;
            g0[r] = GATES[(size_t)t * 128 + lane]; g1[r] = GATES[(size_t)t * 128 + 64 + lane];
#pragma unroll
            for (int j = 0; j < 8; ++j) { const float* pp = (const float*)(ws + part_slab(j)) + (size_t)t * 128; pa[r][j] = pp[lane]; pb[r][j] = pp[64 + lane]; } } }
#pragma unroll
        for (int r = 0; r < 4; ++r) { const int t = tb + r * NGW; if (t < M) { su0[r] = SU[i0[r]]; su1[r] = SU[i1[r]]; sv0[r] = SV[i0[r]]; sv1[r] = SV[i1[r]]; } }
#pragma unroll
        for (int r = 0; r < 4; ++r) { const int t = tb + r * NGW; if (t < M) {
            a0[r] = ((pa[r][0] + pa[r][1]) + (pa[r][2] + pa[r][3])) + ((pa[r][4] + pa[r][5]) + (pa[r][6] + pa[r][7]));
            a1[r] = ((pb[r][0] + pb[r][1]) + (pb[r][2] + pb[r][3])) + ((pb[r][4] + pb[r][5]) + (pb[r][6] + pb[r][7]));
            const float rstd = 1.0f / sqrtf(wave_sum_valu(ssv[r]) * (1.0f / D) + EPS);
            const float x0 = a0[r] * rstd * su0[r], x1 = a1[r] * rstd * su1[r];
            const float w0 = g0[r] * 0.5f * x0 * (1.0f + erff(x0 * 0.70710678118654752f)) * sv0[r], w1 = g1[r] * 0.5f * x1 * (1.0f + erff(x1 * 0.70710678118654752f)) * sv1[r];
            const float am = wave_max_valu(fmaxf(fabsf(w0), fabsf(w1)));
            const float sc = am > 0.f ? 127.0f / am : 0.f;
            const float q0 = rintf(w0 * sc), q1 = rintf(w1 * sc);
            WQ8[(size_t)t * 128 + lane] = (signed char)(int)q0; WQ8[(size_t)t * 128 + 64 + lane] = (signed char)(int)q1;
            const float qs = wave_sum_valu(q0 + q1);
            if (lane == 0) { SW[t] = am * (1.0f / 127.0f); ((float*)(ws + WS_SWC))[t] = am * (1.0f / 127.0f) * qs; }
            if (lane < 16) SS2[(size_t)t * 16 + lane] = 0.f;
        } }
    }
}
__device__ __forceinline__ void p6c_vpass(const Ctx& F, unsigned char* ws, const unsigned short* IDS, const bf16* XB1, bf16* XB2, float* SS3) {
    const P6Geo G = p6_geo(F); const int lane = F.lane_(), g = lane >> 3, c = lane & 7;
    const int ecol = 32 * c + ((lane >> 5) & 1) * 16 + ((lane >> 4) & 1) * 8 + ((lane >> 3) & 1) * 4;
    const signed char* WQ8 = (const signed char*)(ws + WS_WQ8); const float *SW = (const float*)(ws + WS_SW), *SWC = (const float*)(ws + WS_SWC);
#define V_IDS(ID, t_) do { _Pragma("unroll") for (int q = 0; q < 2; ++q) ID[q] = *(const GAS v4u*)(IDS + (size_t)(t_) * 128 + 16 * g + 8 * q); } while (0)
#define V_W(WV, t_) do { WV = *(const GAS v4u*)(WQ8 + (size_t)(t_) * 128 + 16 * g); } while (0)
#define V_GATHER(R, ID) do { _Pragma("unroll") for (int i = 0; i < 16; ++i) { const unsigned w_ = ID[i >> 3][(i >> 1) & 3]; R[i] = *(const GAS v4u*)(Ts + (size_t)((((i & 1) ? (w_ >> 9) : (w_ << 7)) & 0x7fff80u) | c16)); } } while (0)
#define V_COMPUTE(R, WV, t_) do { \
        const size_t o_ = (size_t)(t_) * D + sl * SL4 + ecol; \
        const u32x2 xq_ = *(const GAS u32x2*)(XB1 + o_); const float sw_ = SW[t_], cw_ = SWC[t_]; \
        int acc[32]; \
        _Pragma("unroll") for (int e = 0; e < 32; ++e) acc[e] = 0; \
        _Pragma("unroll") for (int j = 0; j < 4; ++j) \
            _Pragma("unroll") for (int b = 0; b < 4; ++b) { \
                const unsigned r0_ = R[4 * j][b], r1_ = R[4 * j + 1][b], r2_ = R[4 * j + 2][b], r3_ = R[4 * j + 3][b]; \
                const unsigned x01 = __builtin_amdgcn_perm(r1_, r0_, 0x05010400u), y01 = __builtin_amdgcn_perm(r1_, r0_, 0x07030602u), x23 = __builtin_amdgcn_perm(r3_, r2_, 0x05010400u), y23 = __builtin_amdgcn_perm(r3_, r2_, 0x07030602u); \
                const unsigned t0_ = __builtin_amdgcn_perm(x23, x01, 0x05040100u), t1_ = __builtin_amdgcn_perm(x23, x01, 0x07060302u), t2_ = __builtin_amdgcn_perm(y23, y01, 0x05040100u), t3_ = __builtin_amdgcn_perm(y23, y01, 0x07060302u); \
                acc[8 * b]     = __builtin_amdgcn_sdot4((int)(t0_ & 0x0f0f0f0fu), (int)WV[j], acc[8 * b], false);     acc[8 * b + 1] = __builtin_amdgcn_sdot4((int)t0_, (int)WV[j], acc[8 * b + 1], false); \
                acc[8 * b + 2] = __builtin_amdgcn_sdot4((int)(t1_ & 0x0f0f0f0fu), (int)WV[j], acc[8 * b + 2], false); acc[8 * b + 3] = __builtin_amdgcn_sdot4((int)t1_, (int)WV[j], acc[8 * b + 3], false); \
                acc[8 * b + 4] = __builtin_amdgcn_sdot4((int)(t2_ & 0x0f0f0f0fu), (int)WV[j], acc[8 * b + 4], false); acc[8 * b + 5] = __builtin_amdgcn_sdot4((int)t2_, (int)WV[j], acc[8 * b + 5], false); \
                acc[8 * b + 6] = __builtin_amdgcn_sdot4((int)(t3_ & 0x0f0f0f0fu), (int)WV[j], acc[8 * b + 6], false); acc[8 * b + 7] = __builtin_amdgcn_sdot4((int)t3_, (int)WV[j], acc[8 * b + 7], false); } \
        _Pragma("unroll") for (int e = 0; e < 16; ++e) acc[2 * e + 1] -= acc[2 * e];                         \
        int r16[16], r8[8], r4[4]; \
        _Pragma("unroll") for (int i = 0; i < 16; ++i) r16[i] = pl32_sum(acc[i], acc[i + 16]); \
        _Pragma("unroll") for (int i = 0; i < 8; ++i) r8[i] = pl16_sum(r16[i], r16[i + 8]); \
        _Pragma("unroll") for (int i = 0; i < 4; ++i) { const int send = (lane & 8) ? r8[i] : r8[i + 4], keep = (lane & 8) ? r8[i + 4] : r8[i]; r4[i] = keep + dpp_i<0x128>(send); } \
        const float x0_ = __uint_as_float(xq_.x << 16) + (sw_ * (float)r4[0] - 7.5f * cw_), x1_ = __uint_as_float(xq_.x & 0xffff0000u) + (sw_ * 0.0625f * (float)r4[1] + 0.5f * cw_); \
        const float x2_ = __uint_as_float(xq_.y << 16) + (sw_ * (float)r4[2] - 7.5f * cw_), x3_ = __uint_as_float(xq_.y & 0xffff0000u) + (sw_ * 0.0625f * (float)r4[3] + 0.5f * cw_); \
        u32x2 ov_; ov_.x = pk2(x0_, x1_); ov_.y = pk2(x2_, x3_); *(GAS u32x2*)(XB2 + o_) = ov_; \
        *(GAS unsigned*)(ws + WS_XB2_8 + o_) = (unsigned)__builtin_amdgcn_cvt_pk_fp8_f32(x2_, x3_, __builtin_amdgcn_cvt_pk_fp8_f32(x0_, x1_, 0, false), true); \
        const float ss = wave_sum_valu((x0_ * x0_ + x1_ * x1_) + (x2_ * x2_ + x3_ * x3_)); \
        if (lane == 0) SS3[(size_t)(t_) * 16 + sl] = ss; } while (0)
#define V_FENCE() asm volatile("" ::: "memory")
    const bool two = G.ng == 8; const int nsl_step = two ? 4 : G.ng;
    int wbase = 0, wtot = G.nwv;
    if (two) { const int xo = G.xg ^ 4, nwo = ((F.G - xo + 7) / 8) * NWAVES; wtot = G.nwv + nwo; wbase = (G.xg & 4) ? nwo : 0; }
    for (int sl = two ? (G.xg & 3) : G.xg; sl < NSL4; sl += nsl_step) {
        const GAS unsigned char* Ts = (const GAS unsigned char*)(ws + WS_VB) + (size_t)sl * NEXP * 128; const unsigned c16 = 16u * (unsigned)c;
        const int t0 = wbase + G.wi, dt = wtot, nk = t0 < M ? (M - t0 + dt - 1) / dt : 0;
        v4u idA[2], idB[2]; v4u wA, wB; v4u rA[16], rB[16];
        if (nk > 0) { V_IDS(idA, t0); V_GATHER(rA, idA); V_W(wA, t0); }
        if (nk > 1) V_IDS(idB, t0 + dt);
        V_FENCE();
        for (int k = 0; k < nk; k += 2) {
            if (k + 1 < nk) { V_GATHER(rB, idB); V_W(wB, t0 + (k + 1) * dt); }
            if (k + 2 < nk) V_IDS(idA, t0 + (k + 2) * dt);
            V_FENCE();
            V_COMPUTE(rA, wA, t0 + k * dt);
            V_FENCE();
            if (k + 2 < nk) { V_GATHER(rA, idA); V_W(wA, t0 + (k + 2) * dt); }
            if (k + 3 < nk) V_IDS(idB, t0 + (k + 3) * dt);
            V_FENCE();
            if (k + 1 < nk) V_COMPUTE(rB, wB, t0 + (k + 1) * dt);
            V_FENCE();
        }
    }
#undef V_IDS
#undef V_W
#undef V_GATHER
#undef V_COMPUTE
#undef V_FENCE
}
__device__ __forceinline__ void p8_final(const Ctx& F, const bf16* XB3, const float* SS4, float* OUT, const float* g) {
    const int gw = F.vcu * NWAVES + F.wave, NGW = F.G * NWAVES, lane = F.lane_();
    f32x4 gv[4];
#pragma unroll
    for (int j = 0; j < 4; ++j) gv[j] = ((const GAS f32x4*)g)[2 * lane + (j & 1) + 128 * (j >> 1)];
    for (int rb = gw; rb < M; rb += 4 * NGW) {
        v4u xa[4], xb[4]; float sv[4];
#pragma unroll
        for (int r = 0; r < 4; ++r) { const int row = rb + r * NGW; if (row < M) { xa[r] = *(const GAS v4u*)(XB3 + (size_t)row * D + 8 * lane); xb[r] = *(const GAS v4u*)(XB3 + (size_t)row * D + 512 + 8 * lane);
            sv[r] = lane < 16 ? SS4[(size_t)row * 16 + lane] : 0.f; } }
#pragma unroll
        for (int r = 0; r < 4; ++r) { const int row = rb + r * NGW; if (row < M) {
            const float rstd = 1.0f / sqrtf(wave_sum(sv[r]) * (1.0f / D) + EPS);
            GAS f32x4* o = (GAS f32x4*)(OUT + (size_t)row * D);
            o[2 * lane] = (f32x4){__uint_as_float(xa[r][0] << 16), __uint_as_float(xa[r][0] & 0xffff0000u), __uint_as_float(xa[r][1] << 16), __uint_as_float(xa[r][1] & 0xffff0000u)} * rstd * gv[0];
            o[2 * lane + 1] = (f32x4){__uint_as_float(xa[r][2] << 16), __uint_as_float(xa[r][2] & 0xffff0000u), __uint_as_float(xa[r][3] << 16), __uint_as_float(xa[r][3] & 0xffff0000u)} * rstd * gv[1];
            o[128 + 2 * lane] = (f32x4){__uint_as_float(xb[r][0] << 16), __uint_as_float(xb[r][0] & 0xffff0000u), __uint_as_float(xb[r][1] << 16), __uint_as_float(xb[r][1] & 0xffff0000u)} * rstd * gv[2];
            o[128 + 2 * lane + 1] = (f32x4){__uint_as_float(xb[r][2] << 16), __uint_as_float(xb[r][2] & 0xffff0000u), __uint_as_float(xb[r][3] << 16), __uint_as_float(xb[r][3] & 0xffff0000u)} * rstd * gv[3];
        } }
    }
}
struct OneUnit {
    pg8::Unit u;
    __device__ __forceinline__ bool next(int i, pg8::Unit& o) const { if (i != 0) return false; o = u; return true; }
    __device__ __forceinline__ void a_ready(const pg8::Unit&) const {}
    __device__ __forceinline__ void done(const pg8::Unit&) const {}
};

__global__ void __launch_bounds__(NWAVES * 64, 2) mk_fwd(Args args) {
    extern __shared__ __attribute__((aligned(16))) unsigned char lds[];
    Ctx F;
    F.lds = (LAS unsigned char*)lds;
    F.wave = __builtin_amdgcn_readfirstlane((int)threadIdx.x >> 6);
    F.G = gridDim.x; { const int bx = blockIdx.x; F.vcu = (F.G % 8 == 0) ? (bx % 8) * (F.G / 8) + bx / 8 : bx; }
    volatile LAS unsigned* MISC = (volatile LAS unsigned*)(F.lds + MISC_OFF);
    unsigned char* ws = args.ws;
    gu32* ctl = (gu32*)(ws + WS_CTL);
    for (int u = F.tid_(); u < (LDS_BYTES - LDSCTL_OFF) / 4; u += NWAVES * 64) ((LAS unsigned*)(F.lds + LDSCTL_OFF))[u] = 0u;
    __syncthreads();
    const int lo = args.ph_lo, hi = args.ph_hi;
    const bool multi = (hi - lo) > 1 || (lo <= 6 && 6 < hi);
    XcdBarrier bar; bar.bar = (unsigned*)(ctl + CW_BAR) + args.li * XCD_BAR_WORDS; bar.x = 0; bar.st = nullptr;
    if (multi) bar = xcd_barrier_post((unsigned*)(ctl + CW_BAR) + args.li * XCD_BAR_WORDS, MISC + 8);
#ifndef MK_CMASK
#define MK_CMASK 0x1ff
#endif
#define IN(k) (((MK_CMASK >> (k)) & 1) && lo <= (k) && (k) < hi)
#ifdef MK_PROBE_BAR2
#define SEAM(k) do { if (IN(k) && IN((k) + 1)) { xcd_barrier(bar); for (int rb_ = 1; rb_ < MK_PROBE_BAR2; ++rb_) xcd_barrier(bar); } STAMPI((k) < 6 ? (k) + 1 : (k) + 3); } while (0)
#else
#define SEAM(k) do { if (IN(k) && IN((k) + 1)) xcd_barrier(bar); STAMPI((k) < 6 ? (k) + 1 : (k) + 3); } while (0)
#endif
#ifdef MK_PROBE_SEG
#define STAMPI(i_) do { if (((i_) == MK_PROBE_SEG || (i_) == MK_PROBE_SEG + 1 || (MK_PROBE_SEG == 200 && ((i_) == 0 || (i_) == 11))) && blockIdx.x == 0 && threadIdx.x == 0) { ((unsigned long long*)(args.ws + 32768))[(i_)] = __builtin_amdgcn_s_memrealtime(); } } while (0)
    STAMPI(0);
#else
#define STAMPI(i_) do { } while (0)
#endif
    float* out = args.out;
#define WSP(T, off) ((T*)(ws + (off)))
#define RSTD1 WSP(float, WS_RSTD1)
#define SS2 WSP(float, WS_SS2)
#define LF WSP(float, WS_LF)
#define WIN WSP(bf16, WS_WIN)
#define WBR WSP(bf16, WS_WBR)
#define WOUT WSP(bf16, WS_WOUT)
#define WST WSP(bf16, WS_WS)
#define WPG WSP(bf16, WS_WPG)
#define WPP WSP(bf16, WS_WPP)
#define PB WSP(bf16, WS_PB)
#define XB WSP(bf16, WS_A)
#define AC WSP(bf16, WS_AC)
#define XB1 WSP(bf16, WS_A)
#define PP WSP(bf16, WS_PP)
#define Q WSP(bf16, WS_Q)
#define K WSP(bf16, WS_K)
#define V WSP(bf16, WS_V)
#define GB WSP(bf16, WS_GB)
#define Z WSP(bf16, WS_Z)
#define MG WSP(bf16, WS_MERGED)
#define XB2 WSP(bf16, WS_XB2)
#define IDS WSP(unsigned short, WS_IDS)
#define GATES WSP(float, WS_GATES)
#define SGA ((bf16*)out)
#define SGC ((bf16*)out + (size_t)M * D)

    if (IN(0)) { p0_prologue(F, args, MISC); }
    SEAM(0);
    if (IN(1)) {
        { pg8::Gemm g{XB, WIN, M, 3072, D}; pg8::StaticOrder S; S.init(M, 3072, F.G, (int)blockIdx.x);
          pg8::EpiIn E{RSTD1, Q, (size_t)(WS_K - WS_Q) / 2, Z, SGA, (size_t)M * D, C2};
          static_assert(WS_V - WS_K == WS_K - WS_Q && WS_GB - WS_V == WS_K - WS_Q, "Q | K | V | GB equally spaced");
          pg8::gemm_phase<pg8::EpiIn, pg8::StaticOrder, PG8_ALIGN, PG8_SP2>(F.lds + RING_OFF, g, S, E, F.wave); }
        { pg8::Gemm g{WSP(bf16, WS_XB8), WSP(bf16, WS_WIN8), M, 2048, D / 2}; pg8::StaticOrder S; S.init(M, 2048, F.G, (int)blockIdx.x);
          pg8::EpiGate E{RSTD1, SGA, (size_t)M * D, 1.0f / 32.0f};
          pg8::gemm_phase<pg8::EpiGate, pg8::StaticOrder, PG8_ALIGN, PG8_SP2, true>(F.lds + RING_OFF, g, S, E, F.wave); }
        { pg8::Gemm g{PB, WPP, M, D, PLE}; pg8::StaticOrder S; S.init(M, D, F.G, (int)blockIdx.x);
          pg8::EpiPlain E{PP, D};
          pg8::gemm_phase<pg8::EpiPlain, pg8::StaticOrder, PG8_ALIGN, PG8_SP2>(F.lds + RING_OFF, g, S, E, F.wave); }
    }
    SEAM(1);
    if (IN(2)) {
        unsigned* qctr = (unsigned*)(ctl + CW_QUEUE);
        for (;;) {
            const int idx = p2_dequeue(qctr, MISC + 12);
            if (idx >= P2_NITEMS) break;
            if (idx < P2_NATT) { const int qb = 15 - (idx >> 5), bh = idx & 31;
                attn_body::attn_unit<8>(bh >> 3, bh & 7, qb, (const attn_body::bf16*)Q, (const attn_body::bf16*)K, (const attn_body::bf16*)V, (attn_body::bf16*)AC, LF + (size_t)bh * SEQ, (char*)lds + RING_OFF); }
            else if (idx < P2_NATT + P2_NQ) {
                int lane_l = (int)threadIdx.x & 63; asm volatile("" : "+v"(lane_l));
                const int r0 = (idx - P2_NATT) * 64 + F.wave * 8;
                quant_rows4(args, r0, lane_l); quant_rows4(args, r0 + 4, lane_l);
            }
            else if (idx < P2_NATT + P2_NQ + P2_NCONV) p2_conv_chunk(idx - P2_NATT - P2_NQ, GB, Z, args.in[5], AC);
            else if (idx < P2_NATT + P2_NQ + P2_NCONV + P2_NWS) ws_item(args, F.lds + RING_OFF, idx - P2_NATT - P2_NQ - P2_NCONV);
            else { int lane_l = (int)threadIdx.x & 63; asm volatile("" : "+v"(lane_l));
                const int w0 = TR_P0 + (idx - P2_NATT - P2_NQ - P2_NCONV - P2_NWS) * 16 + F.wave * 2;
                tr_two(args, (LAS float*)(F.lds + RING_OFF + F.wave * 16384), w0, w0 + 1, true, lane_l); }
        }
    }
    SEAM(2);
    if (IN(3)) {
        pg8::Gemm g{AC, WBR, M, D, D}; pg8::StaticOrder S; S.init(M, D, F.G, (int)blockIdx.x);
        pg8::EpiBranch E{SGA, SGC, MG};
        pg8::gemm_phase<pg8::EpiBranch, pg8::StaticOrder, PG8_ALIGN, PG8_SP2>(F.lds + RING_OFF, g, S, E, F.wave);
    }
    SEAM(3);
    if (IN(4)) {
        pg8::Gemm g{MG, WOUT, M, D, D}; pg8::StaticOrder S; S.init(M, D, F.G, (int)blockIdx.x);
        pg8::EpiOut E{XB, XB1, SS2};
        pg8::gemm_phase<pg8::EpiOut, pg8::StaticOrder, PG8_ALIGN, PG8_SP2>(F.lds + RING_OFF, g, S, E, F.wave);
    }
    SEAM(4);
    if (IN(5)) {
        pg8::Gemm g{XB1, WST, M, NS, D}; pg8::StaticOrder S; S.init(M, NS, F.G, (int)blockIdx.x);
        pg8::EpiTopK E{SS2, IDS, GATES, EPS};
        pg8::Unit u;
        for (int i = 0; S.next(i, u); ++i) { OneUnit O{u}; pg8::gemm_phase<pg8::EpiTopK, OneUnit, false, PG8_SP2>(F.lds + RING_OFF, g, O, E, F.wave); }
    }
    SEAM(5);
    if (IN(6)) { p6a_upass(F, ws, XB1, IDS); xcd_barrier(bar); STAMPI(7); p6b_combine(F, ws, SS2, IDS, GATES); xcd_barrier(bar); STAMPI(8); p6c_vpass(F, ws, IDS, XB1, XB2, SS2); }
    SEAM(6);
    if (IN(7)) {
        pg8::Gemm g{WSP(bf16, WS_XB2_8), WPG, M, D, D / 2}; pg8::StaticOrder S; S.init(M, D, F.G, (int)blockIdx.x);
        LAS float* rtab = (LAS float*)(F.lds + RING_OFF + pg8::STAGE_BYTES);
        const bool one = (M / 256) * (D / 256) <= F.G; pg8::Unit u0;
        if (one && S.next(0, u0) && F.tid_() < 256) { const float* sp = SS2 + (size_t)(u0.pm * 256 + F.tid_()) * 16; float q = 0.f;
#pragma unroll
            for (int j = 0; j < NSL; ++j) q += sp[j];
            rtab[F.tid_()] = 1.0f / sqrtf(q * (1.0f / D) + EPS); }
        __syncthreads();
        pg8::EpiPle E{SS2, PP, XB2, WSP(bf16, WS_XB3), WSP(float, WS_SS4), EPS, 1.0f / 32.0f, one ? (const LAS float*)rtab : (const LAS float*)nullptr};
        pg8::gemm_phase<pg8::EpiPle, pg8::StaticOrder, PG8_ALIGN, PG8_SP2, true>(F.lds + RING_OFF, g, S, E, F.wave);
    }
    SEAM(7);
    if (IN(8)) { p8_final(F, WSP(bf16, WS_XB3), WSP(float, WS_SS4), out, args.in[17]); }
    STAMPI(11);
#ifdef MK_PROBE_SEG
    if (blockIdx.x == 0 && F.tid_() == 0) {
        asm volatile("s_waitcnt vmcnt(0)" ::: "memory");
        const unsigned long long* st_ = (const unsigned long long*)(args.ws + 32768);
#if MK_PROBE_SEG >= 100 && MK_PROBE_SEG != 200
        const unsigned long long a_ = st_[32 + (MK_PROBE_SEG - 100)], b_ = (MK_PROBE_SEG - 100 == 4) ? st_[1] : st_[33 + (MK_PROBE_SEG - 100)];
#else
        const unsigned long long a_ = st_[MK_PROBE_SEG == 200 ? 0 : MK_PROBE_SEG], b_ = st_[MK_PROBE_SEG == 200 ? 11 : MK_PROBE_SEG + 1];
#endif
        const unsigned long long dt_ = (b_ - a_) * MK_PROBE_MULT, t0_ = __builtin_amdgcn_s_memrealtime();
        while (__builtin_amdgcn_s_memrealtime() - t0_ < dt_) __builtin_amdgcn_s_sleep(8);
    }
#endif
#undef IN
#undef SEAM
#undef WSP
#undef RSTD1
#undef SS2
#undef LF
#undef WIN
#undef WBR
#undef WOUT
#undef WST
#undef WPG
#undef WPP
#undef PB
#undef XB
#undef AC
#undef XB1
#undef PP
#undef Q
#undef K
#undef V
#undef GB
#undef Z
#undef MG
#undef XB2
#undef IDS
#undef GATES
#undef SGA
#undef SGC
}

extern "C" void kernel_launch(void* const* d_in, const int* in_sizes, int n_in, void* d_out, int out_size, void* d_ws, size_t ws_size, hipStream_t stream) {
    static int grid = 0;
    if (grid == 0) {
        if (n_in != 18 || in_sizes[0] != M * D || out_size != M * D || ws_size < WS_END) { fprintf(stderr, "kernel_launch: unexpected shapes (n_in %d, in0 %d, out %d, ws %zu); nothing launched\n", n_in, n_in > 0 ? in_sizes[0] : -1, out_size, ws_size); grid = -1; return; }
        int dev = 0, cus = 0, per_cu = 0;
        if (hipGetDevice(&dev) != hipSuccess || hipDeviceGetAttribute(&cus, hipDeviceAttributeMultiprocessorCount, dev) != hipSuccess) { fprintf(stderr, "kernel_launch: device query failed\n"); grid = -1; return; }
        if (hipFuncSetAttribute((const void*)mk_fwd, hipFuncAttributeMaxDynamicSharedMemorySize, LDS_BYTES) != hipSuccess) { fprintf(stderr, "kernel_launch: hipFuncSetAttribute failed\n"); grid = -1; return; }
        if (hipOccupancyMaxActiveBlocksPerMultiprocessor(&per_cu, (const void*)mk_fwd, NWAVES * 64, LDS_BYTES) != hipSuccess || per_cu < 1) { fprintf(stderr, "kernel_launch: occupancy query says %d workgroups per CU; nothing launched\n", per_cu); (void)hipGetLastError(); grid = -1; return; }
        grid = cus;
    }
    if (grid < 0) return;
    if (hipMemsetAsync((char*)d_ws + WS_CTL, 0, CTL_ZERO_BYTES, stream) != hipSuccess) { fprintf(stderr, "kernel_launch: hipMemsetAsync failed\n"); return; }
    Args a{};
    for (int i = 0; i < 18; ++i) a.in[i] = (const float*)d_in[i];
    a.out = (float*)d_out; a.ws = (unsigned char*)d_ws; a.ph_lo = 0; a.ph_hi = NPHASE; a.li = 0; a.pad = 0;
    hipLaunchKernelGGL(mk_fwd, dim3(grid), dim3(NWAVES * 64), LDS_BYTES, stream, a);
    const hipError_t le = hipPeekAtLastError();
    if (le != hipSuccess) fprintf(stderr, "kernel_launch: launch failed: %s\n", hipGetErrorName(le));
}
```

```cpp
#include <hip/hip_runtime.h>
#include <hip/hip_bf16.h>
#include <cstdio>
#include <cstdint>
#include <cmath>
namespace pg8 {
#define PG8_LAS __attribute__((address_space(3)))
typedef unsigned short bf16_t;
typedef short bf16x8 __attribute__((ext_vector_type(8)));
typedef float f32x4 __attribute__((ext_vector_type(4)));
typedef unsigned u32x4 __attribute__((ext_vector_type(4)));
constexpr int BM = 256, BK = 64, HALF = 128, HTB = HALF * BK * 2  , STAGE_BYTES = 8 * HTB, NXCD = 8, WGM = 8;

__host__ __device__ __forceinline__ int lds_byte(int r, int c) { const int st = (r >> 4) * 2 + (c >> 5), rr = r & 15, cc = c & 31, ob = rr * 64 + cc * 2; return st * 1024 + (ob ^ (((ob >> 9) & 1) << 5)); }
__host__ __device__ __forceinline__ void stage_rc(int b, int& R, int& C) { const int st = b / 1024, sb = b % 1024, swz = sb ^ (((sb >> 9) & 1) << 5); R = (st >> 1) * 16 + swz / 64; C = (st & 1) * 32 + (swz % 64) / 2; }
__host__ __device__ __forceinline__ int perm32(int rho) { const int n = rho >> 4, i = rho & 15; return 8 * (i >> 2) + 4 * n + (i & 3); }

struct Unit { int pm, pn; };
struct Gemm { const bf16_t* A; const bf16_t* Bt; int M, N, K; };

struct StaticOrder {
    int nM, nN, nwg, G, c;
    __host__ __device__ __forceinline__ void init(int M, int N, int G_, int c_) { nM = M / BM; nN = N / BM; nwg = nM * nN; G = G_; c = c_; }
    __host__ __device__ __forceinline__ bool next(int i, Unit& u) const {
        const long L = (long)i * G + c; if (L >= nwg) return false;
        int wgid = (int)L; { const int q = nwg / NXCD, r = nwg % NXCD, xcd = wgid % NXCD, off = wgid / NXCD; wgid = (xcd < r ? xcd * (q + 1) : r * (q + 1) + (xcd - r) * q) + off; }
        const int nig = WGM * nN, gid = wgid / nig, fm = gid * WGM, gsz = (nM - fm) < WGM ? (nM - fm) : WGM;
        u.pm = fm + ((wgid % nig) % gsz); u.pn = (wgid % nig) / gsz; return true;
    }
    __device__ __forceinline__ void a_ready(const Unit&) const {}
    __device__ __forceinline__ void done(const Unit&) const {}
};


__device__ __forceinline__ unsigned cvt_pk_bf16(float lo, float hi) { unsigned r; asm volatile("v_cvt_pk_bf16_f32 %0, %1, %2" : "=v"(r) : "v"(lo), "v"(hi)); return r; }
__device__ __forceinline__ u32x4 pack8(const f32x4 v0, const f32x4 v1) { u32x4 w; w.x = cvt_pk_bf16(v0[0], v0[1]); w.y = cvt_pk_bf16(v0[2], v0[3]); w.z = cvt_pk_bf16(v1[0], v1[1]); w.w = cvt_pk_bf16(v1[2], v1[3]); return w; }
__device__ __forceinline__ float bflo(unsigned w) { return __uint_as_float(w << 16); }
__device__ __forceinline__ float bfhi(unsigned w) { return __uint_as_float(w & 0xffff0000u); }
__device__ __forceinline__ float sigm(float v) { return __builtin_amdgcn_rcpf(1.0f + __builtin_amdgcn_exp2f(v * -1.4426950408889634f)); }
__device__ __forceinline__ f32x4 sigm4(const f32x4 v) { return (f32x4){sigm(v[0]), sigm(v[1]), sigm(v[2]), sigm(v[3])}; }

__device__ __forceinline__ float sum_fq(float v) {
    { const auto s_ = __builtin_amdgcn_permlane16_swap(__float_as_uint(v), __float_as_uint(v), false, false); v = __uint_as_float(s_[0]) + __uint_as_float(s_[1]); }
    { const auto s_ = __builtin_amdgcn_permlane32_swap(__float_as_uint(v), __float_as_uint(v), false, false); v = __uint_as_float(s_[0]) + __uint_as_float(s_[1]); }
    return v;
}
struct EpiIn {
    static constexpr int PROBE_ID = 1;
    static constexpr bool PERM = true, AFTER_DRAIN = false; static constexpr int MID_T = 0;
    const float* rstd; bf16_t* QKVG; size_t stride4; bf16_t* Z; bf16_t* SG; size_t strideSG; float c2;
    __device__ __forceinline__ void operator()(const f32x4 (&acc)[2][2][4][2], const Unit& u, int wr, int wc, int fr, int fq) const {
        int t_l = (int)__builtin_amdgcn_mbcnt_hi(~0u, __builtin_amdgcn_mbcnt_lo(~0u, 0u)); asm volatile("" : "+v"(t_l)); fr = t_l & 15; fq = t_l >> 4;
        const int row0 = u.pm * BM + wr * 64 + fr; const int cl = wc * 32 + 8 * fq, pn = u.pn;
        if (pn < 8) {
            bf16_t* base = QKVG + (size_t)(pn >> 1) * stride4; const int colt = (pn & 1) * 256 + cl; const float s0 = pn < 2 ? c2 : 1.f;
#pragma unroll
            for (int ai = 0; ai < 2; ++ai)
#pragma unroll
                for (int m = 0; m < 4; ++m) { const int row = row0 + ai * HALF + m * 16; const float sc = rstd[row] * s0; bf16_t* rowp = base + (size_t)row * 512 + colt;
#pragma unroll
                    for (int bj = 0; bj < 2; ++bj) *(u32x4*)(rowp + bj * HALF) = pack8(acc[ai][bj][m][0] * sc, acc[ai][bj][m][1] * sc);
                    asm volatile("" ::: "memory"); }
        } else if (pn < 12) {
            const int colt = (pn - 8) * 128 + cl;
#pragma unroll
            for (int ai = 0; ai < 2; ++ai)
#pragma unroll
                for (int m = 0; m < 4; ++m) { const int row = row0 + ai * HALF + m * 16; const float r = rstd[row], sc = r * r;
                    *(u32x4*)(Z + (size_t)row * 512 + colt) = pack8(acc[ai][0][m][0] * acc[ai][1][m][0] * sc, acc[ai][0][m][1] * acc[ai][1][m][1] * sc);
                    asm volatile("" ::: "memory"); }
        }
    }
};
struct EpiGate {
    static constexpr int PROBE_ID = 8;
    static constexpr bool PERM = true, AFTER_DRAIN = false; static constexpr int MID_T = 0;
    const float* rstd; bf16_t* SG; size_t strideSG; float wsc;
    __device__ __forceinline__ void operator()(const f32x4 (&acc)[2][2][4][2], const Unit& u, int wr, int wc, int fr, int fq) const {
        int t_l = (int)__builtin_amdgcn_mbcnt_hi(~0u, __builtin_amdgcn_mbcnt_lo(~0u, 0u)); asm volatile("" : "+v"(t_l)); fr = t_l & 15; fq = t_l >> 4;
        const int row0 = u.pm * BM + wr * 64 + fr; const int cl = wc * 32 + 8 * fq;
        {
            const int colt = u.pn * 128 + cl;
#pragma unroll
            for (int ai = 0; ai < 2; ++ai)
#pragma unroll
                for (int m = 0; m < 4; ++m) { const int row = row0 + ai * HALF + m * 16; const float r = rstd[row] * wsc;
                    f32x4 ra[2], sc_[2];
#pragma unroll
                    for (int n = 0; n < 2; ++n) {
#pragma unroll
                        for (int e = 0; e < 4; ++e) { const float ea = __builtin_amdgcn_exp2f(acc[ai][0][m][n][e] * r * -1.4426950408889634f), ec = __builtin_amdgcn_exp2f(acc[ai][1][m][n][e] * r * -1.4426950408889634f);
                            sc_[n][e] = __builtin_amdgcn_rcpf(1.0f + ec); ra[n][e] = (1.0f + ec) * __builtin_amdgcn_rcpf(1.0f + ea); } }
                    *(u32x4*)(SG + (size_t)row * 1024 + colt) = pack8(ra[0], ra[1]); *(u32x4*)(SG + strideSG + (size_t)row * 1024 + colt) = pack8(sc_[0], sc_[1]);
                    asm volatile("" ::: "memory"); }
        }
    }
};
struct EpiPlain {
    static constexpr int PROBE_ID = 2;
    static constexpr bool PERM = true, AFTER_DRAIN = false; static constexpr int MID_T = 0;
    bf16_t* O; int ldc;
    __device__ __forceinline__ void operator()(const f32x4 (&acc)[2][2][4][2], const Unit& u, int wr, int wc, int fr, int fq) const {
        int t_l = (int)__builtin_amdgcn_mbcnt_hi(~0u, __builtin_amdgcn_mbcnt_lo(~0u, 0u)); asm volatile("" : "+v"(t_l)); fr = t_l & 15; fq = t_l >> 4;
        const int row0 = u.pm * BM + wr * 64 + fr; const int col0 = u.pn * BM + wc * 32 + 8 * fq;
#pragma unroll
        for (int ai = 0; ai < 2; ++ai)
#pragma unroll
            for (int m = 0; m < 4; ++m) { bf16_t* rowp = O + (size_t)(row0 + ai * HALF + m * 16) * ldc + col0;
#pragma unroll
                for (int bj = 0; bj < 2; ++bj) *(u32x4*)(rowp + bj * HALF) = pack8(acc[ai][bj][m][0], acc[ai][bj][m][1]); }
    }
};
struct EpiBranch {
    static constexpr int PROBE_ID = 3;
    static constexpr bool PERM = true, AFTER_DRAIN = false; static constexpr int MID_T = 8;
    const bf16_t *SGA, *SGC; bf16_t* MG;
    __device__ __forceinline__ void mid(f32x4 (&acc)[2][2][4][2], const Unit& u, int wr, int wc, int fr, int fq) const {
        int t_l = (int)__builtin_amdgcn_mbcnt_hi(~0u, __builtin_amdgcn_mbcnt_lo(~0u, 0u)); asm volatile("" : "+v"(t_l)); fr = t_l & 15; fq = t_l >> 4;
        const int row0 = u.pm * BM + wr * 64 + fr; const int col0 = u.pn * BM + wc * 32 + 8 * fq;
#pragma unroll
        for (int ai = 0; ai < 2; ++ai) {
            u32x4 a[4][2];
#pragma unroll
            for (int m = 0; m < 4; ++m)
#pragma unroll
                for (int bj = 0; bj < 2; ++bj) a[m][bj] = *(const u32x4*)(SGA + (size_t)(row0 + ai * HALF + m * 16) * 1024 + col0 + bj * HALF);
#pragma unroll
            for (int m = 0; m < 4; ++m)
#pragma unroll
                for (int bj = 0; bj < 2; ++bj) { const u32x4 av = a[m][bj];
                    acc[ai][bj][m][0] *= (f32x4){bflo(av[0]), bfhi(av[0]), bflo(av[1]), bfhi(av[1])}; acc[ai][bj][m][1] *= (f32x4){bflo(av[2]), bfhi(av[2]), bflo(av[3]), bfhi(av[3])}; }
            asm volatile("" ::: "memory");
        }
    }
    __device__ __forceinline__ void operator()(const f32x4 (&acc)[2][2][4][2], const Unit& u, int wr, int wc, int fr, int fq) const {
        int t_l = (int)__builtin_amdgcn_mbcnt_hi(~0u, __builtin_amdgcn_mbcnt_lo(~0u, 0u)); asm volatile("" : "+v"(t_l)); fr = t_l & 15; fq = t_l >> 4;
        const int row0 = u.pm * BM + wr * 64 + fr; const int col0 = u.pn * BM + wc * 32 + 8 * fq;
#pragma unroll
        for (int ai = 0; ai < 2; ++ai) {
            u32x4 c[4][2];
#pragma unroll
            for (int m = 0; m < 4; ++m)
#pragma unroll
                for (int bj = 0; bj < 2; ++bj) c[m][bj] = *(const u32x4*)(SGC + (size_t)(row0 + ai * HALF + m * 16) * 1024 + col0 + bj * HALF);
#pragma unroll
            for (int m = 0; m < 4; ++m)
#pragma unroll
                for (int bj = 0; bj < 2; ++bj) { const u32x4 cv = c[m][bj];
                    const f32x4 s0 = {bflo(cv[0]), bfhi(cv[0]), bflo(cv[1]), bfhi(cv[1])}, s1 = {bflo(cv[2]), bfhi(cv[2]), bflo(cv[3]), bfhi(cv[3])};
                    *(u32x4*)(MG + (size_t)(row0 + ai * HALF + m * 16) * 1024 + col0 + bj * HALF) = pack8(acc[ai][bj][m][0] * s0, acc[ai][bj][m][1] * s1); }
            asm volatile("" ::: "memory");
        }
    }
};
struct EpiOut {
    static constexpr int PROBE_ID = 4;
    static constexpr bool PERM = true, AFTER_DRAIN = false; static constexpr int MID_T = 0;
    const bf16_t* XBin; bf16_t* XB1; float* SS2;
    __device__ __forceinline__ void operator()(const f32x4 (&acc)[2][2][4][2], const Unit& u, int wr, int wc, int fr, int fq) const {
        int t_l = (int)__builtin_amdgcn_mbcnt_hi(~0u, __builtin_amdgcn_mbcnt_lo(~0u, 0u)); asm volatile("" : "+v"(t_l)); fr = t_l & 15; fq = t_l >> 4;
        const int row0 = u.pm * BM + wr * 64 + fr; const int col0 = u.pn * BM + wc * 32 + 8 * fq;
#pragma unroll
        for (int ai = 0; ai < 2; ++ai) {
            u32x4 xq[4][2];
#pragma unroll
            for (int m = 0; m < 4; ++m)
#pragma unroll
                for (int bj = 0; bj < 2; ++bj) xq[m][bj] = *(const u32x4*)(XBin + (size_t)(row0 + ai * HALF + m * 16) * 1024 + col0 + bj * HALF);
#pragma unroll
            for (int m = 0; m < 4; ++m) { const int row = row0 + ai * HALF + m * 16; float ss = 0.f;
#pragma unroll
                for (int bj = 0; bj < 2; ++bj) { const u32x4 q = xq[m][bj];
                    const f32x4 v0 = acc[ai][bj][m][0] + (f32x4){bflo(q[0]), bfhi(q[0]), bflo(q[1]), bfhi(q[1])}, v1 = acc[ai][bj][m][1] + (f32x4){bflo(q[2]), bfhi(q[2]), bflo(q[3]), bfhi(q[3])};
                    *(u32x4*)(XB1 + (size_t)row * 1024 + col0 + bj * HALF) = pack8(v0, v1);
                    ss += (v0[0] * v0[0] + v0[1] * v0[1]) + (v0[2] * v0[2] + v0[3] * v0[3]) + (v1[0] * v1[0] + v1[1] * v1[1]) + (v1[2] * v1[2] + v1[3] * v1[3]); }
                ss = sum_fq(ss);
                if (fq == 0) SS2[(size_t)row * 16 + u.pn * 4 + wc] = ss; }
            asm volatile("" ::: "memory");
        }
    }
};
struct EpiPle {
    static constexpr int PROBE_ID = 7;
    static constexpr bool PERM = true, AFTER_DRAIN = false; static constexpr int MID_T = 0;
    const float* SS3; const bf16_t* PP; const bf16_t* XB2; bf16_t* XB3; float* SS4; float eps; float wsc; const PG8_LAS float* rtab;
    __device__ __forceinline__ void operator()(const f32x4 (&acc)[2][2][4][2], const Unit& u, int wr, int wc, int fr, int fq) const {
        int t_l = (int)__builtin_amdgcn_mbcnt_hi(~0u, __builtin_amdgcn_mbcnt_lo(~0u, 0u)); asm volatile("" : "+v"(t_l)); fr = t_l & 15; fq = t_l >> 4;
        const int row0 = u.pm * BM + wr * 64 + fr; const int col0 = u.pn * BM + wc * 32 + 8 * fq;
#pragma unroll
        for (int ah = 0; ah < 4; ++ah) {
            const int ai = ah >> 1, m0 = (ah & 1) * 2;
            u32x4 pv[2][2], xb[2][2]; float rr[2];
#pragma unroll
            for (int mm = 0; mm < 2; ++mm) { const int m = m0 + mm; const int row = row0 + ai * HALF + m * 16;
#pragma unroll
                for (int bj = 0; bj < 2; ++bj) { const size_t off = (size_t)row * 1024 + col0 + bj * HALF; pv[mm][bj] = *(const u32x4*)(PP + off); xb[mm][bj] = *(const u32x4*)(XB2 + off); }
                if (rtab) rr[mm] = rtab[wr * 64 + fr + ai * HALF + m * 16];
                else { const f32x4* sp = (const f32x4*)(SS3 + (size_t)row * 16); const f32x4 q0 = sp[0], q1 = sp[1]; rr[mm] = 1.0f / sqrtf((((q0[0] + q0[1]) + (q0[2] + q0[3])) + ((q1[0] + q1[1]) + (q1[2] + q1[3]))) * (1.0f / 1024.0f) + eps); } }
#pragma unroll
            for (int mm = 0; mm < 2; ++mm) { const int m = m0 + mm; const int row = row0 + ai * HALF + m * 16; const float r = rr[mm] * wsc; float ss = 0.f;
#pragma unroll
                for (int bj = 0; bj < 2; ++bj) { const u32x4 c = pv[mm][bj], xq = xb[mm][bj]; const size_t off = (size_t)row * 1024 + col0 + bj * HALF;
                    const f32x4 p0 = {bflo(c[0]), bfhi(c[0]), bflo(c[1]), bfhi(c[1])}, p1 = {bflo(c[2]), bfhi(c[2]), bflo(c[3]), bfhi(c[3])};
                    const f32x4 x0 = {bflo(xq[0]), bfhi(xq[0]), bflo(xq[1]), bfhi(xq[1])}, x1 = {bflo(xq[2]), bfhi(xq[2]), bflo(xq[3]), bfhi(xq[3])};
                    const f32x4 v0 = x0 + sigm4(acc[ai][bj][m][0] * r) * p0, v1 = x1 + sigm4(acc[ai][bj][m][1] * r) * p1;
                    *(u32x4*)(XB3 + off) = pack8(v0, v1);
                    ss += (v0[0] * v0[0] + v0[1] * v0[1]) + (v0[2] * v0[2] + v0[3] * v0[3]) + (v1[0] * v1[0] + v1[1] * v1[1]) + (v1[2] * v1[2] + v1[3] * v1[3]); }
                ss = sum_fq(ss);
                if (fq == 0) SS4[(size_t)row * 16 + u.pn * 4 + wc] = ss; }
            asm volatile("" ::: "memory");
        }
    }
};

__device__ __forceinline__ float vmaxf(float a, float b) { float r; asm("v_max_f32_e32 %0, %1, %2" : "=v"(r) : "v"(a), "v"(b)); return r; }
__device__ __forceinline__ float vminf(float a, float b) { float r; asm("v_min_f32_e32 %0, %1, %2" : "=v"(r) : "v"(a), "v"(b)); return r; }
__device__ __forceinline__ void sort16_desc(float (&a)[16]) {
#define TK_CE(i, j) do { const float hi_ = vmaxf(a[i], a[j]), lo_ = vminf(a[i], a[j]); a[i] = hi_; a[j] = lo_; } while (0)
    TK_CE(0, 13); TK_CE(1, 12); TK_CE(2, 15); TK_CE(3, 14); TK_CE(4, 8); TK_CE(5, 6); TK_CE(7, 11); TK_CE(9, 10);
    TK_CE(0, 5); TK_CE(1, 7); TK_CE(2, 9); TK_CE(3, 4); TK_CE(6, 13); TK_CE(8, 14); TK_CE(10, 15); TK_CE(11, 12);
    TK_CE(0, 1); TK_CE(2, 3); TK_CE(4, 5); TK_CE(6, 8); TK_CE(7, 9); TK_CE(10, 11); TK_CE(12, 13); TK_CE(14, 15);
    TK_CE(0, 2); TK_CE(1, 3); TK_CE(4, 10); TK_CE(5, 11); TK_CE(6, 7); TK_CE(8, 9); TK_CE(12, 14); TK_CE(13, 15);
    TK_CE(1, 2); TK_CE(3, 12); TK_CE(4, 6); TK_CE(5, 7); TK_CE(8, 10); TK_CE(9, 11); TK_CE(13, 14);
    TK_CE(1, 4); TK_CE(2, 6); TK_CE(5, 8); TK_CE(7, 10); TK_CE(9, 13); TK_CE(11, 14);
    TK_CE(2, 4); TK_CE(3, 6); TK_CE(9, 12); TK_CE(11, 13);
    TK_CE(3, 5); TK_CE(6, 8); TK_CE(7, 9); TK_CE(10, 12);
    TK_CE(3, 4); TK_CE(5, 6); TK_CE(7, 8); TK_CE(9, 10); TK_CE(11, 12);
    TK_CE(6, 7); TK_CE(8, 9);
#undef TK_CE
}
template <int L> __device__ __forceinline__ void merge16(float (&a)[16], const float (&b)[16]) {
#pragma unroll
    for (int i = 0; i < 16; ++i) if (15 - i < L) a[i] = vmaxf(a[i], b[15 - i]);
#pragma unroll
    for (int j = 8; j > 0; j >>= 1)
#pragma unroll
        for (int i = 0; i < 16; ++i) { const int l = i ^ j; if (l > i) { const float hi = vmaxf(a[i], a[l]), lo = vminf(a[i], a[l]); a[i] = hi; a[l] = lo; } }
}
struct EpiTopK {
    static constexpr int PROBE_ID = 5;
    static constexpr bool PERM = true, AFTER_DRAIN = true; static constexpr int MID_T = 0;
    static constexpr int RS = 260;
    const float* SS2; unsigned short* IDS; float* GATES; float eps;
    __device__ __forceinline__ void fused(f32x4 (&acc)[2][2][4][2], const Unit& u, int wr, int wc, int fr, int fq, PG8_LAS unsigned char* lds, int wid, int lane) const {
        PG8_LAS float* S = (PG8_LAS float*)lds;
        const int tid = wid * 64 + lane, row = tid & 127, grp = tid >> 7, half = grp >> 1, part = grp & 1;
#define TK_BAR() do { asm volatile("s_waitcnt lgkmcnt(0)" ::: "memory"); __builtin_amdgcn_s_barrier(); asm volatile("" ::: "memory"); } while (0)
#ifdef MK_PROBE_TOPK2
        for (int rep_ = 0; rep_ < MK_PROBE_TOPK2; ++rep_)
#endif
#pragma unroll
        for (int ai = 0; ai < 2; ++ai) {
#pragma unroll
            for (int m = 0; m < 4; ++m)
#pragma unroll
                for (int bj = 0; bj < 2; ++bj)
#pragma unroll
                    for (int n = 0; n < 2; ++n) *(PG8_LAS f32x4*)(S + (wr * 64 + m * 16 + fr) * RS + bj * HALF + wc * 32 + 8 * fq + 4 * n) = acc[ai][bj][m][n];
            TK_BAR();
            float T[16];
#ifdef MK_PROBE_TK1
            for (int rep1_ = 0; rep1_ < MK_PROBE_TK1; ++rep1_)
#endif
#pragma unroll
            for (int b = 0; b < 4; ++b) {
                float c[16];
#pragma unroll
                for (int q = 0; q < 4; ++q) { const f32x4 v = *(const PG8_LAS f32x4*)(S + row * RS + half * 128 + part * 64 + b * 16 + q * 4);
#pragma unroll
                    for (int e = 0; e < 4; ++e) c[q * 4 + e] = __uint_as_float((__float_as_uint(v[e]) & ~127u) | (unsigned)(part * 64 + b * 16 + q * 4 + e)); }
                sort16_desc(c);
                if (b == 0) {
#pragma unroll
                    for (int i = 0; i < 16; ++i) T[i] = c[i];
                } else merge16<16>(T, c);
            }
            TK_BAR();
#pragma unroll
            for (int q = 0; q < 4; ++q) *(PG8_LAS f32x4*)(S + tid * 16 + q * 4) = (f32x4){T[q * 4], T[q * 4 + 1], T[q * 4 + 2], T[q * 4 + 3]};
            TK_BAR();
            if (part == 0) {
                float c[16];
#pragma unroll
                for (int q = 0; q < 4; ++q) { const f32x4 v = *(const PG8_LAS f32x4*)(S + (tid + 128) * 16 + q * 4); c[q * 4] = v[0]; c[q * 4 + 1] = v[1]; c[q * 4 + 2] = v[2]; c[q * 4 + 3] = v[3]; }
                merge16<16>(T, c);
            }
            TK_BAR();
            if (part == 0) {
#pragma unroll
                for (int q = 0; q < 4; ++q) *(PG8_LAS f32x4*)(S + tid * 16 + q * 4) = (f32x4){T[q * 4], T[q * 4 + 1], T[q * 4 + 2], T[q * 4 + 3]};
            }
            TK_BAR();
#ifdef MK_PROBE_TK3
            for (int rep3_ = 0; rep3_ < MK_PROBE_TK3; ++rep3_)
#endif
            if (tid < 128) {
                float a1[16], a2[16];
#pragma unroll
                for (int q = 0; q < 4; ++q) { const f32x4 v = *(const PG8_LAS f32x4*)(S + (tid + 256) * 16 + q * 4);
#pragma unroll
                    for (int e = 0; e < 4; ++e) a2[q * 4 + e] = __uint_as_float(__float_as_uint(v[e]) & ~127u); }
#pragma unroll
                for (int i = 0; i < 16; ++i) a1[i] = __uint_as_float(__float_as_uint(T[i]) & ~127u);
#define TK_SUM(i, j) __uint_as_float((__float_as_uint(a1[i] + a2[j]) & ~255u) | (unsigned)((i) * 16 + (j)))
                float R[16], C[16];
#pragma unroll
                for (int j = 0; j < 16; ++j) R[j] = TK_SUM(0, j);
#pragma unroll
                for (int i = 1; i < 16; ++i) C[i - 1] = TK_SUM(i, 0);
                C[15] = 0.f;
                merge16<15>(R, C);
                C[0] = TK_SUM(1, 1); C[1] = TK_SUM(1, 2); C[2] = TK_SUM(1, 3); C[3] = TK_SUM(1, 4); C[4] = TK_SUM(1, 5); C[5] = TK_SUM(1, 6); C[6] = TK_SUM(1, 7);
                C[7] = TK_SUM(2, 1); C[8] = TK_SUM(2, 2); C[9] = TK_SUM(2, 3); C[10] = TK_SUM(2, 4); C[11] = TK_SUM(3, 1); C[12] = TK_SUM(3, 2); C[13] = TK_SUM(3, 3);
                C[14] = TK_SUM(4, 1); C[15] = TK_SUM(4, 2);
                sort16_desc(C);
                merge16<16>(R, C);
                C[0] = TK_SUM(5, 1); C[1] = TK_SUM(6, 1); C[2] = TK_SUM(7, 1);
                merge16<3>(R, C);
#undef TK_SUM
                const int rowg = u.pm * BM + ai * HALF + row;
                const f32x4* ssp = (const f32x4*)(SS2 + (size_t)rowg * 16); const f32x4 s0 = ssp[0], s1 = ssp[1], s2 = ssp[2], s3 = ssp[3];
                const float ssum = ((s0[0] + s0[1]) + (s0[2] + s0[3])) + ((s1[0] + s1[1]) + (s1[2] + s1[3])) + ((s2[0] + s2[1]) + (s2[2] + s2[3])) + ((s3[0] + s3[1]) + (s3[2] + s3[3]));
                const float rl = 1.4426950408889634f / sqrtf(ssum * (1.0f / 1024.0f) + eps);
                float ev[16], esum = 0.f; int idv[16];
#pragma unroll
                for (int r = 0; r < 16; ++r) { ev[r] = __builtin_amdgcn_exp2f((R[r] - R[0]) * rl); esum += ev[r];
                    const unsigned code = __float_as_uint(R[r]) & 255u;
                    const unsigned k1 = __float_as_uint(S[tid * 16 + (code >> 4)]) & 127u, k2 = __float_as_uint(S[(tid + 256) * 16 + (code & 15u)]) & 127u;
                    idv[r] = (int)(k1 * 128u + k2); }
                const float inv = 1.0f / esum;
                unsigned short* ip = IDS + (size_t)rowg * 128 + u.pn * 16; float* gp = GATES + (size_t)rowg * 128 + u.pn * 16;
#pragma unroll
                for (int q = 0; q < 2; ++q) { u32x4 w; w.x = (unsigned)idv[q * 8] | ((unsigned)idv[q * 8 + 1] << 16); w.y = (unsigned)idv[q * 8 + 2] | ((unsigned)idv[q * 8 + 3] << 16); w.z = (unsigned)idv[q * 8 + 4] | ((unsigned)idv[q * 8 + 5] << 16); w.w = (unsigned)idv[q * 8 + 6] | ((unsigned)idv[q * 8 + 7] << 16);
                    *(u32x4*)(ip + q * 8) = w; }
#pragma unroll
                for (int q = 0; q < 4; ++q) *(f32x4*)(gp + q * 4) = (f32x4){ev[q * 4] * inv, ev[q * 4 + 1] * inv, ev[q * 4 + 2] * inv, ev[q * 4 + 3] * inv};
            }
            TK_BAR();
        }
#undef TK_BAR
    }
};
template <class Epi, class Sched, bool ALIGN_EPI = false, bool SP2 = false, bool FP8 = false>
__device__ __forceinline__ void gemm_phase(PG8_LAS unsigned char* lds, const Gemm g, const Sched& S, const Epi& E, const int wid_in) {
    int lane_l = (int)__builtin_amdgcn_mbcnt_hi(~0u, __builtin_amdgcn_mbcnt_lo(~0u, 0u)); asm volatile("" : "+v"(lane_l));
    const int wid = wid_in, lane = lane_l, tid = wid * 64 + lane, wr = wid >> 2, wc = wid & 3, fr = lane & 15, fq = lane >> 4;
    const int K = g.K, nt = K / BK;
    unsigned voffA, voffB;
    { int R, C; stage_rc(tid * 16, R, C); const int Rb = Epi::PERM ? ((R & ~31) + perm32(R & 31)) : R;
        voffA = (unsigned)(R * K + C) * 2u; voffB = (unsigned)(Rb * K + C) * 2u; }
    const size_t rstep64 = (size_t)64 * K * 2;
    const size_t kstep = (size_t)(BK * 2);
    const size_t hstep = (size_t)HALF * K * 2;
    const size_t tstep = 2 * hstep;
    const unsigned ldsw = (unsigned)wid * 1024u;
    const int aoff = lds_byte(wr * 64 + fr, FP8 ? fq * 16 : fq * 8), boff = lds_byte(wc * 32 + fr, FP8 ? fq * 16 : fq * 8);
    constexpr int KSTR = FP8 ? 16 : 1024;
#define PG8_SA(b, h) (((b) * 2 + (h)) * HTB)
#define PG8_SB(b, h) ((4 + (b) * 2 + (h)) * HTB)
#define PG8_STAGE(bufoff, gbase, voff) do { _Pragma("unroll") for (int _i = 0; _i < 2; ++_i) \
        __builtin_amdgcn_global_load_lds((const unsigned*)((const char*)(gbase) + _i * rstep64 + (voff)), (PG8_LAS unsigned*)(lds + (bufoff) + ldsw + _i * 8192), 16, 0, 0); } while (0)
#define PG8_LDA(dst, b, h) do { _Pragma("unroll") for (int m = 0; m < 4; ++m) _Pragma("unroll") for (int k = 0; k < 2; ++k) dst[m][k] = *(const PG8_LAS v4i_t*)(lds + PG8_SA(b, h) + aoff + m * 2048 + k * KSTR); } while (0)
#define PG8_LDB(dst, b, h) do { _Pragma("unroll") for (int n = 0; n < 2; ++n) _Pragma("unroll") for (int k = 0; k < 2; ++k) dst[n][k] = *(const PG8_LAS v4i_t*)(lds + PG8_SB(b, h) + boff + n * 2048 + k * KSTR); } while (0)
#define PG8_MMA(ai, bj, At, Bt) do { __builtin_amdgcn_s_setprio(1); _Pragma("unroll") for (int m = 0; m < 4; ++m) _Pragma("unroll") for (int n = 0; n < 2; ++n) { \
        if constexpr (FP8) { const v8i_t b8_ = __builtin_shufflevector(Bt[n][0], Bt[n][1], 0, 1, 2, 3, 4, 5, 6, 7), a8_ = __builtin_shufflevector(At[m][0], At[m][1], 0, 1, 2, 3, 4, 5, 6, 7); \
            asm volatile("v_mfma_scale_f32_16x16x128_f8f6f4 %0, %1, %2, %0, %3, %3 op_sel_hi:[0,0,0]" : "+v"(acc[ai][bj][m][n]) : "v"(b8_), "v"(a8_), "v"(mxs_)); }     \
        else { _Pragma("unroll") for (int k = 0; k < 2; ++k) acc[ai][bj][m][n] = __builtin_amdgcn_mfma_f32_16x16x32_bf16(__builtin_bit_cast(bf16x8, Bt[n][k]), __builtin_bit_cast(bf16x8, At[m][k]), acc[ai][bj][m][n], 0, 0, 0); } } \
        __builtin_amdgcn_s_setprio(0); } while (0)
#define PG8_WAIT_V(n) asm volatile("s_waitcnt vmcnt(" #n ")" ::: "memory")
#define PG8_WAIT_L(n) asm volatile("s_waitcnt lgkmcnt(" #n ")" ::: "memory")
#define PG8_BAR __builtin_amdgcn_s_barrier()
#define PG8_SCHED __builtin_amdgcn_sched_barrier(0)
    Unit cur, nxt; int ui = 0;
    if (!S.next(0, cur)) return;
    f32x4 acc[2][2][4][2];
#pragma unroll
    for (int a = 0; a < 2; ++a)
#pragma unroll
        for (int b = 0; b < 2; ++b)
#pragma unroll
            for (int m = 0; m < 4; ++m)
#pragma unroll
                for (int n = 0; n < 2; ++n) acc[a][b][m][n] = (f32x4){0.f, 0.f, 0.f, 0.f};
    typedef int v4i_t __attribute__((ext_vector_type(4))); typedef int v8i_t __attribute__((ext_vector_type(8)));
    int mxs_ = 0x7f7f7f7f; asm volatile("" : "+v"(mxs_));
    v4i_t At[4][2], B0[2][2], B1[2][2];
    const char* cA = (const char*)g.A + (size_t)cur.pm * tstep; const char* cB = (const char*)g.Bt + (size_t)cur.pn * tstep;
    S.a_ready(cur);
    if constexpr (SP2) {
        PG8_STAGE(PG8_SB(0, 0), cB, voffB); PG8_STAGE(PG8_SB(0, 1), cB + hstep, voffB); PG8_STAGE(PG8_SA(0, 0), cA, voffA); PG8_STAGE(PG8_SA(0, 1), cA + hstep, voffA);
        if (wr == 1) PG8_BAR;
        PG8_WAIT_V(2); PG8_BAR;
        PG8_STAGE(PG8_SB(1, 0), cB + kstep, voffB); PG8_STAGE(PG8_SA(1, 0), cA + kstep, voffA); PG8_STAGE(PG8_SB(1, 1), cB + hstep + kstep, voffB);
        PG8_WAIT_V(6); PG8_BAR;
    } else {
        PG8_STAGE(PG8_SB(0, 0), cB, voffB); PG8_STAGE(PG8_SA(0, 0), cA, voffA); PG8_STAGE(PG8_SB(0, 1), cB + hstep, voffB); PG8_STAGE(PG8_SA(0, 1), cA + hstep, voffA);
        if (wr == 1) PG8_BAR;
        PG8_WAIT_V(4); PG8_BAR;
        PG8_STAGE(PG8_SB(1, 0), cB + kstep, voffB); PG8_STAGE(PG8_SA(1, 0), cA + kstep, voffA); PG8_STAGE(PG8_SB(1, 1), cB + hstep + kstep, voffB);
        PG8_WAIT_V(6); PG8_BAR;
    }
    for (;;) {
        const bool has_next = S.next(ui + 1, nxt);
        const char* nA = has_next ? (const char*)g.A + (size_t)nxt.pm * tstep : cA; const char* nB = has_next ? (const char*)g.Bt + (size_t)nxt.pn * tstep : cB;
#pragma nounroll
        for (int t = 0; t < nt; t += 2) {
            if constexpr (Epi::MID_T > 0) { if (t == Epi::MID_T) E.mid(acc, cur, wr, wc, fr, fq); }
            const bool last = (t == nt - 2);
            const char* a1 = cA + (size_t)(t + 1) * kstep;
            const char* a2 = last ? nA : cA + (size_t)(t + 2) * kstep; const char* b2 = last ? nB : cB + (size_t)(t + 2) * kstep;
            const char* a3 = a2 + kstep; const char* b3 = b2 + kstep;
            if (last && has_next) S.a_ready(nxt);
            if constexpr (SP2) {
            PG8_LDB(B0, 0, 0); PG8_LDB(B1, 0, 1); PG8_SCHED; PG8_LDA(At, 0, 0); PG8_STAGE(PG8_SA(1, 1), a1 + hstep, voffA);
            PG8_WAIT_V(8); PG8_WAIT_L(0); PG8_BAR; PG8_MMA(0, 0, At, B0); PG8_MMA(0, 1, At, B1); PG8_BAR; PG8_SCHED;
            PG8_LDA(At, 0, 1); PG8_STAGE(PG8_SB(0, 0), b2, voffB); PG8_STAGE(PG8_SB(0, 1), b2 + hstep, voffB); PG8_STAGE(PG8_SA(0, 0), a2, voffA);
            PG8_WAIT_V(8); PG8_WAIT_L(0); PG8_BAR; PG8_MMA(1, 0, At, B0); PG8_MMA(1, 1, At, B1); PG8_BAR; PG8_SCHED;
            PG8_LDB(B0, 1, 0); PG8_LDB(B1, 1, 1); PG8_SCHED; PG8_LDA(At, 1, 0); PG8_STAGE(PG8_SA(0, 1), a2 + hstep, voffA);
            PG8_WAIT_V(8); PG8_WAIT_L(0); PG8_BAR; PG8_MMA(0, 0, At, B0); PG8_MMA(0, 1, At, B1); PG8_BAR; PG8_SCHED;
            PG8_LDA(At, 1, 1); PG8_STAGE(PG8_SB(1, 0), b3, voffB); PG8_STAGE(PG8_SB(1, 1), b3 + hstep, voffB); PG8_STAGE(PG8_SA(1, 0), a3, voffA);
            PG8_WAIT_V(8); PG8_WAIT_L(0); PG8_BAR; PG8_MMA(1, 0, At, B0); PG8_MMA(1, 1, At, B1); PG8_BAR; PG8_SCHED;
            } else {
            PG8_LDB(B0, 0, 0); PG8_SCHED; PG8_LDA(At, 0, 0); PG8_STAGE(PG8_SA(1, 1), a1 + hstep, voffA);
            PG8_WAIT_L(8); PG8_BAR; PG8_WAIT_L(0); PG8_MMA(0, 0, At, B0); PG8_BAR; PG8_SCHED;
            PG8_LDB(B1, 0, 1); PG8_STAGE(PG8_SB(0, 0), b2, voffB);
            PG8_BAR; PG8_WAIT_L(0); PG8_MMA(0, 1, At, B1); PG8_BAR;
            PG8_LDA(At, 0, 1); PG8_STAGE(PG8_SA(0, 0), a2, voffA);
            PG8_BAR; PG8_WAIT_L(0); PG8_MMA(1, 0, At, B0); PG8_BAR; PG8_SCHED;
            PG8_STAGE(PG8_SB(0, 1), b2 + hstep, voffB);
            PG8_WAIT_V(6); PG8_BAR; PG8_MMA(1, 1, At, B1); PG8_BAR;
            PG8_LDB(B0, 1, 0); PG8_SCHED; PG8_LDA(At, 1, 0); PG8_STAGE(PG8_SA(0, 1), a2 + hstep, voffA);
            PG8_WAIT_L(8); PG8_BAR; PG8_WAIT_L(0); PG8_MMA(0, 0, At, B0); PG8_BAR; PG8_SCHED;
            PG8_LDB(B1, 1, 1); PG8_STAGE(PG8_SB(1, 0), b3, voffB);
            PG8_BAR; PG8_WAIT_L(0); PG8_MMA(0, 1, At, B1); PG8_BAR;
            PG8_LDA(At, 1, 1); PG8_STAGE(PG8_SA(1, 0), a3, voffA);
            PG8_BAR; PG8_WAIT_L(0); PG8_MMA(1, 0, At, B0); PG8_BAR; PG8_SCHED;
            PG8_STAGE(PG8_SB(1, 1), b3 + hstep, voffB);
            PG8_WAIT_V(6); PG8_BAR; PG8_MMA(1, 1, At, B1); PG8_BAR;
            }
        }
        if constexpr (FP8) asm volatile("s_nop 15\n\ts_nop 7" ::: "memory");
        if constexpr (ALIGN_EPI) { if (wr == 0) PG8_BAR; }
#ifdef MK_PROBE_EPI2
        if constexpr (!Epi::AFTER_DRAIN && Epi::PROBE_ID == MK_PROBE_EPI_ID) { for (int rep_ = 1; rep_ < MK_PROBE_EPI2; ++rep_) E(acc, cur, wr, wc, fr, fq); }
#endif
        if constexpr (!Epi::AFTER_DRAIN) { E(acc, cur, wr, wc, fr, fq); S.done(cur); }
        if (!has_next) break;
#pragma unroll
        for (int a = 0; a < 2; ++a)
#pragma unroll
            for (int b = 0; b < 2; ++b)
#pragma unroll
                for (int m = 0; m < 4; ++m)
#pragma unroll
                    for (int n = 0; n < 2; ++n) acc[a][b][m][n] = (f32x4){0.f, 0.f, 0.f, 0.f};
        cur = nxt; cA = nA; cB = nB; ++ui;
        if constexpr (ALIGN_EPI) { if (wr == 1) PG8_BAR; }
    }
    PG8_WAIT_V(0);
    if constexpr (!ALIGN_EPI) { if (wr == 0) PG8_BAR; }
    PG8_BAR;
    if constexpr (Epi::AFTER_DRAIN) { E.fused(acc, cur, wr, wc, fr, fq, lds, wid, lane); S.done(cur); }
#undef PG8_SA
#undef PG8_SB
#undef PG8_STAGE
#undef PG8_LDA
#undef PG8_LDB
#undef PG8_MMA
#undef PG8_WAIT_V
#undef PG8_WAIT_L
#undef PG8_BAR
#undef PG8_SCHED
}
}
#ifndef PG8_SP2
#define PG8_SP2 true
#endif
#ifndef PG8_ALIGN
#define PG8_ALIGN true
#endif
namespace attn_body {
using bf16=__hip_bfloat16;
using bf16x8=__attribute__((ext_vector_type(8)))short;
using s16x4=__attribute__((ext_vector_type(4)))short;
using f32x16=__attribute__((ext_vector_type(16)))float;
using u32x4=__attribute__((ext_vector_type(4)))unsigned;
using f32x4v=__attribute__((ext_vector_type(4)))float;
constexpr int BATCH=4,NHEAD=8,SEQ=4096,D=64,DM=NHEAD*D,DMO=1024;
constexpr int NW=8,QBLK=32,QB=QBLK*NW,KVBLK=64,NQB=SEQ/QB;
constexpr int ATTN_PITCH=DM, ATTN_UNIT_ROWS=QB;
__device__ __forceinline__ int crow(int r,int hi){return (r&3)+8*(r>>2)+4*hi;}
#define SBAR() __builtin_amdgcn_sched_barrier(0)
__device__ __forceinline__ void cmask(f32x16&p0,f32x16&p1,int jb,int qrel,int hi){
  const float NEG=-INFINITY; int kb=64*jb+4*hi;
  #pragma unroll
  for(int r=0;r<16;++r){int kv=kb+(r&3)+8*(r>>2); if(kv>qrel)p0[r]=NEG; if(kv+32>qrel)p1[r]=NEG;}
}

constexpr int NSLOT=3, SLOTB=8192;
constexpr float SKIP_TH=64.0f;
constexpr int LDS_K=0, LDS_V=NSLOT*SLOTB, LDS_WS=2*NSLOT*SLOTB, LDS_OST=LDS_WS+NW*64*4, LDS_CS=LDS_OST+NW*4096, LDS_BYTES=LDS_CS+SEQ*4+64;
constexpr float C2=0.125f*1.4426950408889634f;
__device__ __forceinline__ void glds16(const void*gsrc,unsigned lds_dst){unsigned keep;
  asm volatile("s_mov_b32 %0, m0\n\ts_mov_b32 m0, %2\n\ts_nop 0\n\tglobal_load_lds_dwordx4 %1, off\n\ts_mov_b32 m0, %0":"=&s"(keep):"v"(gsrc),"s"(lds_dst):"memory");}
__device__ __forceinline__ float max3f(float a,float b,float c){float r;asm("v_max3_f32 %0, %1, %2, %3":"=v"(r):"v"(a),"v"(b),"v"(c));return r;}
__device__ __forceinline__ float max2f(float a,float b){float r;asm("v_max_f32_e32 %0, %1, %2":"=v"(r):"v"(a),"v"(b));return r;}
__device__ __forceinline__ float fadd_s(float a,float b){float r;asm("v_add_f32_e32 %0, %1, %2":"=v"(r):"v"(a),"v"(b));return r;}
__device__ __forceinline__ float fsub_s(float a,float b){float r;asm("v_sub_f32_e32 %0, %1, %2":"=v"(r):"v"(a),"v"(b));return r;}
typedef float f32x2_t __attribute__((ext_vector_type(2))); typedef __bf16 bf16x2_t __attribute__((ext_vector_type(2)));
__device__ __forceinline__ unsigned cvtpk_s(float lo,float hi){f32x2_t v={lo,hi};bf16x2_t b=__builtin_convertvector(v,bf16x2_t);return __builtin_bit_cast(unsigned,b);}
#define WAIT_BAR(N) asm volatile("s_waitcnt vmcnt(" #N ") lgkmcnt(0)\n\ts_barrier":::"memory")

__device__ __forceinline__ void qkt(f32x16&p0,f32x16&p1,const char*Kslot,const bf16x8*qr,const f32x16&c0,const f32x16&c1,int r32,int hi){
  const char*kb=Kslot+hi*1024+r32*16;
  #pragma unroll
  for(int d0=0;d0<4;++d0){
    const bf16x8 b0=*reinterpret_cast<const bf16x8*>(kb+d0*2048);
    const bf16x8 b1=*reinterpret_cast<const bf16x8*>(kb+d0*2048+512);
    if(d0==0){p0=__builtin_amdgcn_mfma_f32_32x32x16_bf16(b0,qr[0],c0,0,0,0);p1=__builtin_amdgcn_mfma_f32_32x32x16_bf16(b1,qr[0],c1,0,0,0);}
    else{p0=__builtin_amdgcn_mfma_f32_32x32x16_bf16(b0,qr[d0],p0,0,0,0);p1=__builtin_amdgcn_mfma_f32_32x32x16_bf16(b1,qr[d0],p1,0,0,0);}}
}
typedef __attribute__((address_space(3))) const char* lds_cptr;
typedef short v4i16_t __attribute__((ext_vector_type(4)));
__device__ __forceinline__ void kload8(bf16x8*kf,lds_cptr kp){
  kf[0]=*(const __attribute__((address_space(3))) bf16x8*)(kp);      kf[1]=*(const __attribute__((address_space(3))) bf16x8*)(kp+512);
  kf[2]=*(const __attribute__((address_space(3))) bf16x8*)(kp+2048); kf[3]=*(const __attribute__((address_space(3))) bf16x8*)(kp+2560);
  kf[4]=*(const __attribute__((address_space(3))) bf16x8*)(kp+4096); kf[5]=*(const __attribute__((address_space(3))) bf16x8*)(kp+4608);
  kf[6]=*(const __attribute__((address_space(3))) bf16x8*)(kp+6144); kf[7]=*(const __attribute__((address_space(3))) bf16x8*)(kp+6656);
}
__device__ __forceinline__ void kload2(bf16x8*kf,lds_cptr kp,int j){ kf[2*j]=*(const __attribute__((address_space(3))) bf16x8*)(kp+j*2048); kf[2*j+1]=*(const __attribute__((address_space(3))) bf16x8*)(kp+j*2048+512); }
__device__ __forceinline__ s16x4 vtr(lds_cptr p){ return __builtin_bit_cast(s16x4,__builtin_amdgcn_ds_read_tr16_b64_v4i16((__attribute__((address_space(3))) v4i16_t*)p)); }
__device__ __forceinline__ float rowmax(const f32x16&p0,const f32x16&p1){
  float a=max3f(p0[0],p0[1],p1[0]),b=max3f(p0[2],p0[3],p1[1]);a=max3f(a,p1[2],p1[3]);
  #pragma unroll
  for(int r=4;r<16;r+=4){a=max3f(a,p0[r],p0[r+1]);b=max3f(b,p0[r+2],p0[r+3]);a=max3f(a,p1[r],p1[r+1]);b=max3f(b,p1[r+2],p1[r+3]);}
  const float m=max2f(a,b);
  auto rr=__builtin_amdgcn_permlane32_swap(__float_as_uint(m),__float_as_uint(m),false,false);
  return max2f(__uint_as_float(rr[0]),__uint_as_float(rr[1]));
}
__device__ __forceinline__ void pv(f32x16*o,int vb,bf16x8 pa0,bf16x8 pa1,bf16x8 pa2,bf16x8 pa3){
  #pragma unroll
  for(int d0=0;d0<2;++d0){s16x4 lo[4],hi[4];
    #pragma unroll
    for(int ks=0;ks<4;++ks){
      asm volatile("ds_read_b64_tr_b16 %0,%1 offset:%c2":"=&v"(lo[ks]):"v"(vb),"i"(d0*4096+ks*1024):"memory");
      asm volatile("ds_read_b64_tr_b16 %0,%1 offset:%c2":"=&v"(hi[ks]):"v"(vb),"i"(d0*4096+ks*1024+512):"memory");}
    asm volatile("s_waitcnt lgkmcnt(0)":::"memory");SBAR();
    #define PK(k) (bf16x8){lo[k][0],lo[k][1],lo[k][2],lo[k][3],hi[k][0],hi[k][1],hi[k][2],hi[k][3]}
    o[d0]=__builtin_amdgcn_mfma_f32_32x32x16_bf16(pa0,PK(0),o[d0],0,0,0);
    o[d0]=__builtin_amdgcn_mfma_f32_32x32x16_bf16(pa1,PK(1),o[d0],0,0,0);
    o[d0]=__builtin_amdgcn_mfma_f32_32x32x16_bf16(pa2,PK(2),o[d0],0,0,0);
    o[d0]=__builtin_amdgcn_mfma_f32_32x32x16_bf16(pa3,PK(3),o[d0],0,0,0);
    #undef PK
  }
}

#ifndef ATTN_STORE16
#define ATTN_STORE16(p,v) (*(u32x4*)(p)=(v))
#endif
template<int THRL> __device__ __forceinline__ void attn_unit(int b,int h,int qb,const bf16*Q,const bf16*__restrict__ K,const bf16*__restrict__ V,bf16*O,const float*__restrict__ LFrow,char*shm){
  int tid_l=threadIdx.x; asm volatile("":"+v"(tid_l));
  const int tid=tid_l,lane=tid&63,r32=lane&31,hi=lane>>5; const int wid=__builtin_amdgcn_readfirstlane(tid>>6);
  const long rowbase=(long)b*SEQ; const int q0=qb*QB;
  const lds_cptr shm3=(lds_cptr)shm;
  typedef __attribute__((address_space(3))) float lds_f32; typedef __attribute__((address_space(3))) f32x4v lds_f32x4;
  lds_f32* const csl=(lds_f32*)(shm3+LDS_CS);
  { const int ncs=q0+QB, i0=tid*8; f32x4v ca={0.f,0.f,0.f,0.f},cb={0.f,0.f,0.f,0.f};
    if(i0<ncs){ca=*(const f32x4v*)(LFrow+i0);cb=*(const f32x4v*)(LFrow+i0+4);}
    ca.y+=ca.x;ca.z+=ca.y;ca.w+=ca.z;cb.x+=ca.w;cb.y+=cb.x;cb.z+=cb.y;cb.w+=cb.z;
    const float tot=cb.w; float inc=tot;
    _Pragma("unroll") for(int o_=1;o_<64;o_<<=1){const float v_=__shfl_up(inc,o_);if(lane>=o_)inc+=v_;}
    if(lane==63)csl[SEQ+wid]=inc;
    asm volatile("s_waitcnt vmcnt(0) lgkmcnt(0)\n\ts_barrier":::"memory");
    float base_=inc-tot;
    _Pragma("unroll") for(int w_=0;w_<NW;++w_){const float t_=csl[SEQ+w_];if(w_<wid)base_+=t_;}
    if(i0<ncs){*(lds_f32x4*)(csl+i0)=ca+base_;*(lds_f32x4*)(csl+i0+4)=cb+base_;}
    asm volatile("s_waitcnt vmcnt(0) lgkmcnt(0)\n\ts_barrier":::"memory"); }
  int ts; { const int NT0=(q0+QB)/KVBLK, cand=2*lane; bool ok=false;
    if(lane<32&&cand<=NT0-4) ok=(cand==0)||(csl[q0]-csl[64*cand-1]<=-SKIP_TH);
    const unsigned long long mk=__ballot(ok); ts=__builtin_amdgcn_readfirstlane(2*(63-__builtin_clzll(mk|1ull))); }
  const bf16*Qw=Q+(rowbase+q0+wid*QBLK)*DM+h*D;
  const bf16*Kh=K+(rowbase+(long)ts*KVBLK)*DM+h*D,*Vh=V+(rowbase+(long)ts*KVBLK)*DM+h*D;
  const unsigned lds0=(unsigned)(uintptr_t)shm;
  float*wsf=(float*)(shm+LDS_WS)+wid*64;
  const bf16*ksrc=Kh+(long)lane*DM+wid*8;
  const bf16*vsrc=Vh+(long)(16*(wid&3)+(lane>>2))*DM+(wid>>2)*32+(lane&3)*8;
  const unsigned kdst=lds0+LDS_K+wid*1024, vdst=lds0+LDS_V+wid*1024;
  #define DMA_K(t,slot) glds16(ksrc+(long)(t)*KVBLK*DM,(unsigned)__builtin_amdgcn_readfirstlane(kdst+(slot)))
  #define DMA_V(t,slot) glds16(vsrc+(long)(t)*KVBLK*DM,(unsigned)__builtin_amdgcn_readfirstlane(vdst+(slot)))
  const int vb0=(int)(lds0+LDS_V)+((lane>>4)&1)*32+(lane&3)*8+(4*hi+((lane&15)>>2))*64;
  const char*Kbase=shm+LDS_K; bf16x8 kf[8];
  const lds_cptr kp0=shm3+LDS_K+hi*1024+r32*16; const lds_cptr vp0=shm3+LDS_V+((lane>>4)&1)*32+(lane&3)*8+(4*hi+((lane&15)>>2))*64;
  const int NT=(q0+QB)/KVBLK-ts;
  const float cq=csl[q0+wid*QBLK+r32];
  const lds_cptr csb=shm3+LDS_CS+hi*16+ts*256;
  #define CINIT(C0,C1,t) do{ _Pragma("unroll") for(int g_=0;g_<4;++g_){ const f32x4v a_=*(const lds_f32x4*)(csb+(t)*256+g_*32), b_=*(const lds_f32x4*)(csb+(t)*256+128+g_*32); \
      C0[4*g_]=cqm-a_.x;C0[4*g_+1]=cqm-a_.y;C0[4*g_+2]=cqm-a_.z;C0[4*g_+3]=cqm-a_.w; C1[4*g_]=cqm-b_.x;C1[4*g_+1]=cqm-b_.y;C1[4*g_+2]=cqm-b_.z;C1[4*g_+3]=cqm-b_.w; } }while(0)
  DMA_K(0,0);DMA_V(0,0);DMA_K(1,SLOTB);
  bf16x8 qr[4];
  #pragma unroll
  for(int d0=0;d0<4;++d0)qr[d0]=*reinterpret_cast<const bf16x8*>(&Qw[(long)r32*DM+d0*16+hi*8]);
  float mhat=0.f,l_reg=0.f,cqm=cq;f32x16 o[2];o[0]=f32x16{};o[1]=f32x16{};
  const int qrel=wid*QBLK+r32;
  #define CMASK(P0,P1,t) do{int jb_=(t)-(NT-4); if(jb_>=0)cmask(P0,P1,jb_,qrel,hi);}while(0)
  bool resc=false;
  #define START(P0,P1) do{ const float rm=rowmax(P0,P1); resc=false; \
    { const float dl=rm; mhat=fadd_s(mhat,dl); \
      _Pragma("unroll") for(int r=0;r<16;++r){P0[r]=fsub_s(P0[r],dl);P1[r]=fsub_s(P1[r],dl);} \
      cqm=cq-mhat; } \
    _Pragma("unroll") for(int r=0;r<16;++r)P0[r]=__builtin_amdgcn_exp2f(P0[r]); }while(0)
  #define RESC() do{ if(resc){ asm volatile("s_waitcnt lgkmcnt(0)":::"memory"); \
      _Pragma("unroll") for(int d_=0;d_<2;++d_) _Pragma("unroll") for(int r=0;r<16;++r)o[d_][r]*=wsf[crow(r,hi)]; } }while(0)
  f32x16 pA0,pA1,pB0,pB1;
  int sl_prev=0,sl_cur=0,sl_next=SLOTB;
  #define ROT() do{sl_prev=sl_cur;sl_cur=sl_next;sl_next=(sl_next==(NSLOT-1)*SLOTB)?0:sl_next+SLOTB;}while(0)
  DMA_K(2,2*SLOTB);
  WAIT_BAR(3);
  { f32x16 ci0,ci1; CINIT(ci0,ci1,0); qkt(pA0,pA1,Kbase,qr,ci0,ci1,r32,hi); } asm volatile("s_nop 15\n\ts_nop 7":"+v"(pA0),"+v"(pA1));CMASK(pA0,pA1,0);
  START(pA0,pA1);
  _Pragma("unroll") for(int r=0;r<16;++r)pA1[r]=__builtin_amdgcn_exp2f(pA1[r]);
  WAIT_BAR(0);
  DMA_K(3,0);DMA_V(1,SLOTB);
  ROT();
  kload8(kf,kp0+sl_cur);
  WAIT_BAR(2);
  s16x4 vlo[8],vhi[8]; u32x4 pw0,pw1,pw2,pw3;
  #define PKW(P,B) cvtpk_s(P[B],P[B+1])
  #define PAF(k) __builtin_bit_cast(bf16x8,pw##k)
  #define VFR(i) (bf16x8){vlo[i][0],vlo[i][1],vlo[i][2],vlo[i][3],vhi[i][0],vhi[i][1],vhi[i][2],vhi[i][3]}
  #define PIN(x) asm volatile("":"+v"(x))
  #define MX3(a,b,c) __builtin_fmaxf(__builtin_fmaxf((a),(b)),(c))
  #define GAPA(MF,A0,A1,A2,A3,W0,W1,PW) do{ MF; sacc+=A0; sacc+=A1; sacc+=A2; sacc+=A3; PIN(sacc); W0; W1; PIN(PW); SBAR(); }while(0)
  #define EX(v) __builtin_amdgcn_exp2f(v)
  #define GAPB(MF,X,B) do{ MF; X[B]=EX(X[B]); X[B+1]=EX(X[B+1]); X[B+2]=EX(X[B+2]); X[B+3]=EX(X[B+3]); PIN(X); SBAR(); }while(0)
  #define VRD(i) do{ vlo[i]=vtr(vp_+(((i)>>2)*4096+((i)&3)*1024)); vhi[i]=vtr(vp_+(((i)>>2)*4096+((i)&3)*1024+512)); }while(0)
  #define KRD(G,j) do{ if(G){ kload2(kf,kp0+sl_next,j); SBAR(); } }while(0)
  #define STEP(C0,C1,P0,P1,t,GK,GV,GL) do{ SBAR(); \
    CINIT(C0,C1,t); SBAR(); \
    const lds_cptr vp_=vp0+sl_prev; \
    VRD(0); SBAR(); float sacc=(P0[0]+P0[1]); \
    GAPA(C0=__builtin_amdgcn_mfma_f32_32x32x16_bf16(kf[0],qr[0],C0,0,0,0), P0[2],P0[3],P0[4],P0[5],     pw0[0]=PKW(P0,0), pw0[1]=PKW(P0,2), pw0); \
    VRD(4); SBAR(); GAPA(C1=__builtin_amdgcn_mfma_f32_32x32x16_bf16(kf[1],qr[0],C1,0,0,0), P0[6],P0[7],P0[8],P0[9],     pw0[2]=PKW(P0,4), pw0[3]=PKW(P0,6), pw0); \
    VRD(1); SBAR(); GAPA(C0=__builtin_amdgcn_mfma_f32_32x32x16_bf16(kf[2],qr[1],C0,0,0,0),   P0[10],P0[11],P0[12],P0[13], pw1[0]=PKW(P0,8), pw1[1]=PKW(P0,10), pw1); \
    VRD(5); SBAR(); GAPA(C1=__builtin_amdgcn_mfma_f32_32x32x16_bf16(kf[3],qr[1],C1,0,0,0),   P0[14],P0[15],P1[0],P1[1],   pw1[2]=PKW(P0,12),pw1[3]=PKW(P0,14), pw1); \
    VRD(2); SBAR(); GAPA(C0=__builtin_amdgcn_mfma_f32_32x32x16_bf16(kf[4],qr[2],C0,0,0,0),   P1[2],P1[3],P1[4],P1[5],     pw2[0]=PKW(P1,0), pw2[1]=PKW(P1,2), pw2); \
    VRD(6); SBAR(); GAPA(C1=__builtin_amdgcn_mfma_f32_32x32x16_bf16(kf[5],qr[2],C1,0,0,0),   P1[6],P1[7],P1[8],P1[9],     pw2[2]=PKW(P1,4), pw2[3]=PKW(P1,6), pw2); \
    VRD(3); SBAR(); GAPA(C0=__builtin_amdgcn_mfma_f32_32x32x16_bf16(kf[6],qr[3],C0,0,0,0),   P1[10],P1[11],P1[12],P1[13], pw3[0]=PKW(P1,8), pw3[1]=PKW(P1,10), pw3); \
    VRD(7); SBAR(); GAPA(C1=__builtin_amdgcn_mfma_f32_32x32x16_bf16(kf[7],qr[3],C1,0,0,0),   P1[14],P1[15],0.f,0.f,       pw3[2]=PKW(P1,12),pw3[3]=PKW(P1,14), pw3); \
    l_reg+=sacc; \
    if(GK){DMA_K((t)+3,sl_cur);} if(GV){DMA_V((t)+1,sl_next);} \
    CMASK(C0,C1,t); \
    { float a=MX3(C0[0],C0[1],C1[0]),b=MX3(C0[2],C0[3],C1[1]); a=MX3(a,C1[2],C1[3]); \
      _Pragma("unroll") for(int r=4;r<16;r+=4){a=MX3(a,C0[r],C0[r+1]);b=MX3(b,C0[r+2],C0[r+3]);a=MX3(a,C1[r],C1[r+1]);b=MX3(b,C1[r+2],C1[r+3]);} \
      float rm=__builtin_fmaxf(a,b); { auto rr=__builtin_amdgcn_permlane32_swap(__float_as_uint(rm),__float_as_uint(rm),false,false); rm=__builtin_fmaxf(__uint_as_float(rr[0]),__uint_as_float(rr[1])); } \
      resc=false; \
      if(__builtin_expect(__any(rm>(float)THRL),0)){ const float dl=__builtin_fmaxf(rm,0.f); mhat+=dl; \
        _Pragma("unroll") for(int r=0;r<16;++r){C0[r]-=dl;C1[r]-=dl;} \
        cqm=cq-mhat; \
        const float f=__builtin_amdgcn_exp2f(-dl); l_reg*=f; if(hi==0)wsf[r32]=f; resc=true; } } \
    SBAR(); \
    GAPB(o[0]=__builtin_amdgcn_mfma_f32_32x32x16_bf16(PAF(0),VFR(0),o[0],0,0,0), C0,0); \
    GAPB(o[1]=__builtin_amdgcn_mfma_f32_32x32x16_bf16(PAF(0),VFR(4),o[1],0,0,0), C0,4); \
    KRD(GL,0); GAPB(o[0]=__builtin_amdgcn_mfma_f32_32x32x16_bf16(PAF(1),VFR(1),o[0],0,0,0), C0,8); \
    KRD(GL,1); GAPB(o[1]=__builtin_amdgcn_mfma_f32_32x32x16_bf16(PAF(1),VFR(5),o[1],0,0,0), C0,12); \
    KRD(GL,2); GAPB(o[0]=__builtin_amdgcn_mfma_f32_32x32x16_bf16(PAF(2),VFR(2),o[0],0,0,0), C1,0); \
    KRD(GL,3); GAPB(o[1]=__builtin_amdgcn_mfma_f32_32x32x16_bf16(PAF(2),VFR(6),o[1],0,0,0), C1,4); \
    GAPB(o[0]=__builtin_amdgcn_mfma_f32_32x32x16_bf16(PAF(3),VFR(3),o[0],0,0,0), C1,8); \
    GAPB(o[1]=__builtin_amdgcn_mfma_f32_32x32x16_bf16(PAF(3),VFR(7),o[1],0,0,0), C1,12); \
    }while(0)
  int t=1;
  #undef CMASK
  #define CMASK(P0,P1,t) do{}while(0)
  for(;t+5<NT;t+=2){
    STEP(pB0,pB1,pA0,pA1,t,true,true,true);     WAIT_BAR(2); RESC(); ROT();
    STEP(pA0,pA1,pB0,pB1,t+1,true,true,true);   WAIT_BAR(2); RESC(); ROT();
  }
  #undef CMASK
  #define CMASK(P0,P1,t) do{int jb_=(t)-(NT-4); if(jb_>=0)cmask(P0,P1,jb_,qrel,hi);}while(0)
  #define ENDW(tt) do{ if((tt)+3<NT){WAIT_BAR(2);} else if((tt)+2<NT){WAIT_BAR(1);} else {WAIT_BAR(0);} }while(0)
  for(;t+1<NT;t+=2){
    STEP(pB0,pB1,pA0,pA1,t,(t+3<NT),(t+1<NT),(t+1<NT));       ENDW(t);   RESC(); ROT();
    STEP(pA0,pA1,pB0,pB1,t+1,(t+4<NT),(t+2<NT),(t+2<NT));     ENDW(t+1); RESC(); ROT();
  }
  STEP(pB0,pB1,pA0,pA1,NT-1,false,false,false); RESC();
  { float sacc=pB0[0]+pB0[1]; _Pragma("unroll") for(int r=2;r<16;++r)sacc+=pB0[r]; _Pragma("unroll") for(int r=0;r<16;++r)sacc+=pB1[r]; l_reg+=sacc;
    pw0=(u32x4){PKW(pB0,0),PKW(pB0,2),PKW(pB0,4),PKW(pB0,6)};pw1=(u32x4){PKW(pB0,8),PKW(pB0,10),PKW(pB0,12),PKW(pB0,14)};pw2=(u32x4){PKW(pB1,0),PKW(pB1,2),PKW(pB1,4),PKW(pB1,6)};pw3=(u32x4){PKW(pB1,8),PKW(pB1,10),PKW(pB1,12),PKW(pB1,14)};
    SBAR(); pv(o,vb0+sl_cur,PAF(0),PAF(1),PAF(2),PAF(3)); }
  #undef PKW
  #undef PAF
  #undef VFR
  #undef PIN
  #undef MX3
  #undef GAPA
  #undef GAPB
  #undef EX
  #undef VRD
  #undef KRD
  #undef STEP
  #undef ENDW
  {auto rr=__builtin_amdgcn_permlane32_swap(__float_as_uint(l_reg),__float_as_uint(l_reg),false,false);l_reg=__uint_as_float(rr[0])+__uint_as_float(rr[1]);}
  if(hi==0)wsf[32+r32]=l_reg;asm volatile("s_waitcnt lgkmcnt(0)":::"memory");
  float rli[16];
  #pragma unroll
  for(int r=0;r<16;++r)rli[r]=__builtin_amdgcn_rcpf(wsf[32+crow(r,hi)]);
  bf16*Ow=O+(rowbase+q0+wid*QBLK)*DMO+h*D;
  { bf16*stg=(bf16*)(shm+LDS_OST)+wid*2048;
    #pragma unroll
    for(int r=0;r<16;++r){const int orow=crow(r,hi);
      #pragma unroll
      for(int d0=0;d0<2;++d0)stg[orow*64+d0*32+r32]=__float2bfloat16(o[d0][r]*rli[r]);}
    asm volatile("s_waitcnt lgkmcnt(0)":::"memory");
    #pragma unroll
    for(int i=0;i<4;++i){const int row=i*8+(lane>>3),ch=lane&7; const u32x4 v=*(const u32x4*)(stg+row*64+ch*8); ATTN_STORE16(Ow+(long)row*DMO+ch*8,v);} }
  asm volatile("s_waitcnt lgkmcnt(0)\n\ts_barrier":::"memory");
  #undef DMA_K
  #undef DMA_V
  #undef CMASK
  #undef START
  #undef RESC
  #undef ROT
  #undef CINIT
}
constexpr int ATTN_LDS_BYTES=LDS_BYTES;
struct AttnTensors { const bf16* Q; const bf16* K; const bf16* V; bf16* O; const float* LF; };
struct AttnUnit { int bh; int qb; };
struct StaticOrder {
  int vcu, G;
  __device__ __forceinline__ StaticOrder(int grid,int vcu_):vcu(vcu_),G(grid){}
  __device__ __forceinline__ bool next(int i,AttnUnit&u)const{
    if(G==256){ if(i>=2)return false; const int s=vcu&7; u.bh=vcu>>3; u.qb=(i==0)?15-s:s; return true; }
    const int idx=i*G+vcu; if(idx>=BATCH*NHEAD*NQB)return false; u.qb=NQB-1-idx/(BATCH*NHEAD); u.bh=idx%(BATCH*NHEAD); return true; }
  __device__ __forceinline__ void a_ready(const AttnUnit&)const{}
  __device__ __forceinline__ void done(const AttnUnit&)const{}
};
template<class Sched,int THRL=8> __device__ __forceinline__ void attn_phase(char*lds,const AttnTensors&T,const Sched&S){
  AttnUnit u;
  for(int i=0;S.next(i,u);++i){ S.a_ready(u); attn_unit<THRL>(u.bh/NHEAD,u.bh%NHEAD,u.qb,T.Q,T.K,T.V,T.O,T.LF+(size_t)u.bh*SEQ,lds); S.done(u); }
}
#undef SBAR
#undef WAIT_BAR
}
#define GAS __attribute__((address_space(1)))
#define LAS __attribute__((address_space(3)))
typedef unsigned short bf16;
typedef unsigned v4u __attribute__((ext_vector_type(4)));
typedef float f32x4 __attribute__((ext_vector_type(4)));
typedef short bf16x8 __attribute__((ext_vector_type(8)));
typedef GAS unsigned gu32;
typedef GAS unsigned long long gu64;
#define RLX_AGENT __ATOMIC_RELAXED, __HIP_MEMORY_SCOPE_AGENT
#define LDS_WAIT() asm volatile("s_waitcnt lgkmcnt(0)" ::: "memory")
#define VM_WAIT() asm volatile("s_waitcnt vmcnt(0)" ::: "memory")
__device__ __forceinline__ unsigned long long rt() { return __builtin_amdgcn_s_memrealtime(); }
__device__ __forceinline__ unsigned f2bf(float f) { unsigned u = __builtin_bit_cast(unsigned, f); return (u + 0x7fffu + ((u >> 16) & 1u)) >> 16; }
__device__ __forceinline__ unsigned pk2(float lo, float hi) { return f2bf(lo) | (f2bf(hi) << 16); }

#define XB_TMO      128
#define XB_XCNT(j)  (256  + 64 * (j))
#define XB_XSUB(j)  (1280 + 64 * (j))
#define XB_XGEN(j)  (2304 + 64 * (j))
#define XB_TOP      3328
#define XB_TOPGEN   3392
#define XCD_BAR_WORDS 3456
#define XB_SPIN_CAP (1u << 18)

__device__ __forceinline__ unsigned xb_ld(unsigned* p)              { return __hip_atomic_load(p, __ATOMIC_RELAXED, __HIP_MEMORY_SCOPE_AGENT); }
__device__ __forceinline__ unsigned xb_add(unsigned* p, unsigned v) { return __hip_atomic_fetch_add(p, v, __ATOMIC_RELAXED, __HIP_MEMORY_SCOPE_AGENT); }
__device__ __forceinline__ unsigned xb_xcc_id() { return (unsigned)__builtin_amdgcn_s_getreg((3 << 11) | 20) & 0xFu; }
#define XB_SPIN(cond, bar) do { unsigned _sp = 0; while (cond) { __builtin_amdgcn_s_sleep(1); \
    if ((++_sp & 255u) == 0u) { if (xb_ld(&(bar)[XB_TMO])) break; if (_sp > XB_SPIN_CAP) { atomicAdd(&(bar)[XB_TMO], 1u); break; } } } } while (0)

struct XcdBarrier {
    unsigned* bar; unsigned x;
    volatile LAS unsigned* st;
};

__device__ __forceinline__ XcdBarrier xcd_barrier_post(unsigned* bar, volatile LAS unsigned* st) {
    XcdBarrier b; b.bar = bar; b.x = xb_xcc_id(); b.st = st;
    if (threadIdx.x == 0) (void)xb_add(&bar[XB_XCNT(b.x)], 1u);
    return b;
}
__device__ __forceinline__ void xcd_barrier_complete(unsigned* bar, unsigned x, unsigned& nloc, unsigned& nx) {
    const unsigned G = gridDim.x * gridDim.y * gridDim.z;
    unsigned sum, cnt, mine, sp = 0u;
    for (;;) {
        sum = 0u; cnt = 0u; mine = 0u;
#pragma unroll
        for (unsigned j = 0; j < 16; ++j) { const unsigned c = xb_ld(&bar[XB_XCNT(j)]); sum += c; cnt += (c > 0u) ? 1u : 0u; mine = (j == x) ? c : mine; }
        if (sum == G) break;
        __builtin_amdgcn_s_sleep(1);
        if ((++sp & 255u) == 0u) { if (xb_ld(&bar[XB_TMO])) break; if (sp > XB_SPIN_CAP) { atomicAdd(&bar[XB_TMO], 1u); break; } }
    }
    nloc = mine > 0u ? mine : 1u; nx = cnt > 0u ? cnt : 1u;
}

__device__ __forceinline__ void xcd_barrier(const XcdBarrier& b) {
    asm volatile("s_waitcnt vmcnt(0)" ::: "memory");
    __syncthreads();
    if (threadIdx.x == 0) {
        unsigned* bar = b.bar;
        __builtin_amdgcn_s_waitcnt(0);
        unsigned nloc = b.st[0], nx = b.st[1];
        if (nloc == 0u) { xcd_barrier_complete(bar, b.x, nloc, nx); b.st[0] = nloc; b.st[1] = nx; }
        const unsigned old = xb_add(&bar[XB_XSUB(b.x)], 1u);
        const unsigned gen = old / nloc;
        if (old + 1u == (gen + 1u) * nloc) {
            __builtin_amdgcn_fence(__ATOMIC_RELEASE, "agent");
            asm volatile("s_waitcnt vmcnt(0)" ::: "memory");
            const unsigned og = xb_add(&bar[XB_TOP], 1u);
            const unsigned tg = og / nx;
            if (og + 1u == (tg + 1u) * nx) xb_add(&bar[XB_TOPGEN], 1u);
            else XB_SPIN(xb_ld(&bar[XB_TOPGEN]) == tg, bar);
            __builtin_amdgcn_fence(__ATOMIC_ACQUIRE, "agent");
            xb_add(&bar[XB_XGEN(b.x)], 1u);
            asm volatile("s_waitcnt vmcnt(0)" ::: "memory");
        } else {
            XB_SPIN(xb_ld(&bar[XB_XGEN(b.x)]) == gen, bar);
            __builtin_amdgcn_fence(__ATOMIC_ACQUIRE, "agent");
            asm volatile("s_waitcnt vmcnt(0)" ::: "memory");
        }
    }
    __syncthreads();
}

constexpr int NWAVES = 8;
constexpr int BATCH = 4, SEQ = 4096, D = 1024, M = BATCH * SEQ, NH = 8, HD = 64, AW = 512, PLE = 256;
constexpr int NIN = 5120, INTOT = 5128, NKEYS = 128, NEXP = 16384, NS = 2048;
constexpr float EPS = 1e-6f, LOG2E = 1.4426950408889634f, C2 = 0.125f * LOG2E;
constexpr int NPHASE = 9;
constexpr int SLW = 128, NSL = D / SLW;
static_assert(NSL == 8, "one slice per XCD group; SS3 has 16 slots");
constexpr int SL4 = 256, NSL4 = D / SL4;
constexpr float Q4_STEP = 0.3352f;

constexpr size_t MiB = 1u << 20;
constexpr size_t WS_CTL = 0, CTL_ZERO_BYTES = 64 * 1024;
constexpr size_t WS_RSTD1 = 1 * MiB, WS_RSTD3 = WS_RSTD1 + 65536, WS_LF = WS_RSTD3 + 65536, WS_CS = WS_LF + 524288, WS_SS2 = WS_CS + 524288, WS_WPP = WS_SS2 + 1048576;
constexpr size_t WS_WQ8 = 20 * MiB, WS_SW = WS_RSTD1;
constexpr size_t WS_SU = WS_RSTD3, WS_SV = WS_WPP + 524288;
constexpr size_t WS_SW2 = WS_SV + 65536;
static_assert(WS_SW2 + 131072 <= 4 * MiB, "small region");
constexpr size_t WS_WIN = 4 * MiB, WS_WBR = 14 * MiB, WS_WOUT = 16 * MiB, WS_WS = 18 * MiB, WS_WPG = 22 * MiB, WS_PB = 24 * MiB;
constexpr size_t WS_UB = 32 * MiB, WS_VB = 48 * MiB;
constexpr size_t WS_AC = 64 * MiB;
constexpr size_t WS_A = 96 * MiB;
constexpr size_t WS_PP = 128 * MiB;
constexpr size_t WS_Q = 160 * MiB, WS_K = 176 * MiB, WS_V = 192 * MiB, WS_GB = 208 * MiB, WS_Z = 224 * MiB;
constexpr size_t WS_MERGED = 160 * MiB, WS_XB2 = 192 * MiB, WS_IDS = 224 * MiB, WS_GATES = 232 * MiB;
constexpr size_t WS_XB3 = 64 * MiB, WS_SS4 = WS_LF;
constexpr size_t WS_XB2_8 = 240 * MiB;
constexpr size_t WS_XB8 = 240 * MiB, WS_WIN8 = 10 * MiB;
constexpr size_t WS_END = 256 * MiB;
constexpr size_t WS_PART0 = 4 * MiB, WS_PART1 = 160 * MiB, WS_PART2 = 240 * MiB;
constexpr size_t WS_TGC = 32 * MiB, WS_TXC = 64 * MiB, WS_SC = 32 * MiB;
constexpr int CW_BAR = 1024;

constexpr int RING_OFF = 0, RING_BYTES = 135168;
constexpr int LDSCTL_OFF = RING_BYTES, MISC_OFF = LDSCTL_OFF + 320;
constexpr int LDS_BYTES = RING_BYTES + 1024;
static_assert(attn_body::ATTN_LDS_BYTES <= RING_BYTES && pg8::STAGE_BYTES <= RING_BYTES && 128 * pg8::EpiTopK::RS * 4 <= RING_BYTES, "LDS map");

typedef unsigned u32x4 __attribute__((ext_vector_type(4)));
typedef unsigned u32x2 __attribute__((ext_vector_type(2)));
typedef float f32x2 __attribute__((ext_vector_type(2)));
__device__ __forceinline__ float bf2f(bf16 v) { return __uint_as_float((unsigned)v << 16); }
__device__ __forceinline__ float wave_sum(float v) {
#pragma unroll
    for (int o = 1; o < 64; o <<= 1) v += __shfl_xor(v, o);
    return v;
}
__device__ __forceinline__ float sigmoidf_(float v) { return 1.0f / (1.0f + __expf(-v)); }
__host__ __device__ __forceinline__ int src_in(int n) {
    const int pn = n >> 8, l = n & 255;
    if (pn < 6) return n;
    if (pn < 8) return 1544 + (n - 1536);
    if (pn < 12) { const int j = pn - 8; return (l < 128) ? 2056 + 128 * j + l : 2568 + 128 * j + (l - 128); }
    { const int j = pn - 12; return (l < 128) ? 3080 + 128 * j + l : 4104 + 128 * j + (l - 128); }
}

struct Args { const float* in[18]; float* out; unsigned char* ws; int ph_lo, ph_hi, li, pad; };
struct Ctx {
    LAS unsigned char* lds; int wave, vcu, G;
    __device__ __forceinline__ int tid_() const { return (int)threadIdx.x; }
    __device__ __forceinline__ int lane_() const { return (int)threadIdx.x & 63; }
};

struct TrItem { const float* W; const float* g; bf16* WT; int ldw, k0, scol0, ldt, drow0, dk0; int fp8; };
__device__ __forceinline__ void tr_load(const TrItem& I, float (&tv)[32], int lane) {
#pragma unroll
    for (int i = 0; i < 32; ++i) { const int kk = 2 * i + (lane >> 5); tv[i] = I.W[(size_t)(I.k0 + kk) * I.ldw + I.scol0 + (lane & 31)]; }
}
__device__ __forceinline__ void tr_finish(const TrItem& I, const float (&tv)[32], LAS float* scr, int lane) {
#pragma unroll
    for (int i = 0; i < 32; ++i) { const int kk = 2 * i + (lane >> 5); float v = tv[i]; if (I.g) v *= I.g[I.k0 + kk]; scr[kk * 33 + (lane & 31)] = v; }
    LDS_WAIT(); asm volatile("" ::: "memory");
    const int c = lane & 7;
    if (I.fp8) {
#pragma unroll
        for (int j = 0; j < 4; ++j) { const int n = (lane >> 3) + 8 * j; const LAS float* s = scr + (8 * c) * 33 + n;
            u32x2 o; o.x = (unsigned)__builtin_amdgcn_cvt_pk_fp8_f32(s[0 * 33] * 32.f, s[1 * 33] * 32.f, 0, false); o.x = (unsigned)__builtin_amdgcn_cvt_pk_fp8_f32(s[2 * 33] * 32.f, s[3 * 33] * 32.f, (int)o.x, true);
            o.y = (unsigned)__builtin_amdgcn_cvt_pk_fp8_f32(s[4 * 33] * 32.f, s[5 * 33] * 32.f, 0, false); o.y = (unsigned)__builtin_amdgcn_cvt_pk_fp8_f32(s[6 * 33] * 32.f, s[7 * 33] * 32.f, (int)o.y, true);
            *(GAS u32x2*)((unsigned char*)I.WT + (size_t)(I.drow0 + n) * I.ldt + I.dk0 + 8 * c) = o; }
    } else {
#pragma unroll
        for (int j = 0; j < 4; ++j) { const int n = (lane >> 3) + 8 * j; const LAS float* s = scr + (8 * c) * 33 + n;
            v4u o; o.x = pk2(s[0 * 33], s[1 * 33]); o.y = pk2(s[2 * 33], s[3 * 33]); o.z = pk2(s[4 * 33], s[5 * 33]); o.w = pk2(s[6 * 33], s[7 * 33]);
            *(GAS v4u*)(I.WT + (size_t)(I.drow0 + n) * I.ldt + I.dk0 + 8 * c) = o; }
    }
    LDS_WAIT(); asm volatile("" ::: "memory");
}
constexpr int TR_IN = 16 * 160, TR_PP = 4 * 32, TR_BR = 8 * 32, TR_SQ = 16 * 32;
constexpr int TR_P0 = TR_IN + TR_PP;
constexpr int TR_LATE = 2 * TR_BR + 2 * TR_SQ;
__device__ __forceinline__ TrItem tr_decode(const Args& a, int r) {
    unsigned char* ws = a.ws;
    if (r < TR_IN) { const int kb = r / 160, nb = r % 160;
        if (nb >= 96) return TrItem{a.in[3], a.in[2], (bf16*)(ws + WS_WIN8), INTOT, 64 * kb, src_in(32 * nb), D, 32 * nb - 3072, 64 * kb, 1};
        return TrItem{a.in[3], a.in[2], (bf16*)(ws + WS_WIN), INTOT, 64 * kb, src_in(32 * nb), D, 32 * nb, 64 * kb, 0}; } r -= TR_IN;
    if (r < TR_PP) { const int kb = r / 32, nb = r % 32; return TrItem{a.in[16], nullptr, (bf16*)(ws + WS_WPP), D, 64 * kb, 32 * nb, PLE, 32 * nb, 64 * kb, 0}; } r -= TR_PP;
    if (r < 2 * TR_BR) { const int br = r / TR_BR, q = r % TR_BR, kb = q / 32, nb = q % 32; return TrItem{a.in[6] + (size_t)br * AW * D, nullptr, (bf16*)(ws + WS_WBR), D, 64 * kb, 32 * nb, D, 32 * nb, br * AW + 64 * kb, 0}; } r -= 2 * TR_BR;
    if (r < TR_SQ) { const int kb = r / 32, nb = r % 32; return TrItem{a.in[7], nullptr, (bf16*)(ws + WS_WOUT), D, 64 * kb, 32 * nb, D, 32 * nb, 64 * kb, 0}; } r -= TR_SQ;
    { const int kb = r / 32, nb = r % 32; return TrItem{a.in[15], a.in[14], (bf16*)(ws + WS_WPG), D, 64 * kb, 32 * nb, D, 32 * nb, 64 * kb, 1}; }
}
__device__ __forceinline__ void tr_two(const Args& a, LAS float* scr, int ra, int rb_, bool two, int lane) {
    const TrItem A = tr_decode(a, ra), B = tr_decode(a, two ? rb_ : ra);
    float ta[32], tb[32];
    tr_load(A, ta, lane); if (two) tr_load(B, tb, lane);
    tr_finish(A, ta, scr, lane); if (two) tr_finish(B, tb, scr, lane);
}
__device__ __forceinline__ void ws_item(const Args& a, LAS unsigned char* lds, int item) {
    int tid_ = (int)threadIdx.x; asm volatile("" : "+v"(tid_));
    const float *g_ffn = a.in[8], *w_peer_q = a.in[9]; bf16* WST = (bf16*)(a.ws + WS_WS);
    LAS float* KH = (LAS float*)lds; LAS float* WQ = KH + 128 * 129;
    const int hh = item >> 4, head = hh >> 1, half = hh & 1, d0 = (item & 15) * 64;
    const float* kh = (half ? a.in[11] : a.in[10]) + (size_t)head * 128 * 128;
    float tk[32], tq[16];
#pragma unroll
    for (int i = 0; i < 32; ++i) tk[i] = kh[i * 512 + tid_];
#pragma unroll
    for (int i = 0; i < 16; ++i) { const int idx = i * 512 + tid_; tq[i] = w_peer_q[(size_t)(d0 + (idx >> 7)) * NS + head * 256 + half * 128 + (idx & 127)]; }
#pragma unroll
    for (int i = 0; i < 32; ++i) { const int idx = i * 512 + tid_; KH[(idx >> 7) * 129 + (idx & 127)] = tk[i]; }
#pragma unroll
    for (int i = 0; i < 16; ++i) { const int idx = i * 512 + tid_; WQ[(idx >> 7) * 129 + (idx & 127)] = tq[i]; }
    __syncthreads();
    typedef float f32x16_t __attribute__((ext_vector_type(16)));
    const int lane = tid_ & 63, w = __builtin_amdgcn_readfirstlane(tid_ >> 6), kt = w & 3, dt = w >> 2, l31 = lane & 31, h = lane >> 5;
    const LAS float* ap = WQ + (32 * dt + l31) * 129 + h; const LAS float* bp = KH + (32 * kt + l31) * 129 + h;
    f32x16_t acc = {0.f, 0.f, 0.f, 0.f, 0.f, 0.f, 0.f, 0.f, 0.f, 0.f, 0.f, 0.f, 0.f, 0.f, 0.f, 0.f};
#pragma unroll 8
    for (int s_ = 0; s_ < 64; ++s_) acc = __builtin_amdgcn_mfma_f32_32x32x2f32(ap[2 * s_], bp[2 * s_], acc, 0, 0, 0);
    const int key = 32 * kt + l31;
#pragma unroll
    for (int q = 0; q < 4; ++q) { const int dd = d0 + 32 * dt + 8 * q + 4 * h; const f32x4 gv = *(const GAS f32x4*)(g_ffn + dd);
        u32x2 o; o.x = pk2(acc[4 * q] * gv[0], acc[4 * q + 1] * gv[1]); o.y = pk2(acc[4 * q + 2] * gv[2], acc[4 * q + 3] * gv[3]);
        *(GAS u32x2*)(WST + (size_t)(head * 256 + half * 128 + key) * D + dd) = o; }
    __syncthreads();
}
__device__ __forceinline__ void quant_load4(const Args& a, int rb, int lane, f32x4 (&v)[4][4]) {
#pragma unroll
    for (int r = 0; r < 4; ++r) { const int rr = rb + r; const bool isv = rr >= NEXP; const int e = isv ? rr - NEXP : rr;
        const GAS f32x4* src = (const GAS f32x4*)((isv ? a.in[13] : a.in[12]) + (size_t)e * D) + lane;
#pragma unroll
        for (int j = 0; j < 4; ++j) v[r][j] = src[64 * j]; }
}
__device__ __forceinline__ void quant_finish4(const Args& a, int rb, int lane, f32x4 (&v)[4][4]) {
    unsigned char* ws = a.ws; const float *g_ffn = a.in[8];
    f32x4 gq[4];
#pragma unroll
    for (int j = 0; j < 4; ++j) gq[j] = *(const GAS f32x4*)(g_ffn + 256 * j + 4 * lane);
#pragma unroll
    for (int r = 0; r < 4; ++r) { const int rr = rb + r; const bool isv = rr >= NEXP; const int e = isv ? rr - NEXP : rr;
        float am = 0.f;
#pragma unroll
        for (int j = 0; j < 4; ++j) { if (!isv) v[r][j] = v[r][j] * gq[j]; am = fmaxf(am, fmaxf(fmaxf(fabsf(v[r][j].x), fabsf(v[r][j].y)), fmaxf(fabsf(v[r][j].z), fabsf(v[r][j].w)))); }
#pragma unroll
        for (int o = 1; o < 64; o <<= 1) am = fmaxf(am, __shfl_xor(am, o));
        unsigned char* tb = ws + (isv ? WS_VB : WS_UB);
        if (isv) {
            float ss = 0.f;
#pragma unroll
            for (int j = 0; j < 4; ++j) ss += (v[r][j].x * v[r][j].x + v[r][j].y * v[r][j].y) + (v[r][j].z * v[r][j].z + v[r][j].w * v[r][j].w);
#pragma unroll
            for (int o = 1; o < 64; o <<= 1) ss += __shfl_xor(ss, o);
            const float st = fminf(Q4_STEP * sqrtf(ss * (1.0f / D)), am * 0.125f), inv = st > 0.f ? 1.0f / st : 0.f;
#pragma unroll
            for (int j = 0; j < 4; ++j) {
                const int n0 = (int)fminf(fmaxf(floorf(v[r][j].x * inv + 8.0f), 0.f), 15.f), n1 = (int)fminf(fmaxf(floorf(v[r][j].y * inv + 8.0f), 0.f), 15.f);
                const int n2 = (int)fminf(fmaxf(floorf(v[r][j].z * inv + 8.0f), 0.f), 15.f), n3 = (int)fminf(fmaxf(floorf(v[r][j].w * inv + 8.0f), 0.f), 15.f);
                *(GAS unsigned short*)(tb + ((size_t)j * NEXP + e) * 128 + 2 * lane) = (unsigned short)(n0 | ((n1 ^ 8) << 4) | (n2 << 8) | ((n3 ^ 8) << 12)); }
            if (lane == 0) ((float*)(ws + WS_SV))[e] = st;
            continue;
        }
        const float sc = am > 0.f ? 127.0f / am : 0.f;
#pragma unroll
        for (int j = 0; j < 4; ++j) { const int q0 = (int)rintf(v[r][j].x * sc), q1 = (int)rintf(v[r][j].y * sc), q2 = (int)rintf(v[r][j].z * sc), q3 = (int)rintf(v[r][j].w * sc);
            const unsigned o = (unsigned)(q0 & 255) | ((unsigned)(q1 & 255) << 8) | ((unsigned)(q2 & 255) << 16) | ((unsigned)(q3 & 255) << 24);
            *(GAS unsigned*)(tb + ((size_t)(2 * j + (lane >> 5)) * NEXP + e) * SLW + ((4 * lane) & 127)) = o; }
        if (lane == 0) ((float*)(ws + (isv ? WS_SV : WS_SU)))[e] = am * (1.0f / 127.0f);
    }
}
__device__ __forceinline__ void quant_rows4(const Args& a, int rb, int lane) { f32x4 v[4][4]; quant_load4(a, rb, lane, v); quant_finish4(a, rb, lane, v); }
__device__ __forceinline__ void p0_prologue(const Ctx& F, const Args& a, volatile LAS unsigned* MISC) {
    unsigned char* ws = a.ws;
    const float *x = a.in[0], *p = a.in[1], *g_mix = a.in[2], *w_in = a.in[3], *b_f = a.in[4];
    bf16 *PB = (bf16*)(ws + WS_PB), *XB = (bf16*)(ws + WS_A);
    float *RSTD1 = (float*)(ws + WS_RSTD1), *LF = (float*)(ws + WS_LF);
    const int gw = F.vcu * NWAVES + F.wave, NGW = F.G * NWAVES, NGT = F.G * 512;
    const int tid_ = (int)threadIdx.x, lane_ = tid_ & 63;
    auto stepB = [&]() __attribute__((always_inline)) {
        LAS float* scr = (LAS float*)(F.lds + RING_OFF + F.wave * 16384);
        for (int it = gw; it < TR_P0; it += 2 * NGW) tr_two(a, scr, it, it + NGW, it + NGW < TR_P0, lane_);
    };
    auto stepC = [&]() __attribute__((always_inline)) {
    {
        LAS float* WFL = (LAS float*)(F.lds + RING_OFF);
        { float tw[16], tg[16];
#pragma unroll
          for (int i = 0; i < 16; ++i) { const int idx = i * 512 + tid_, k = idx >> 3, h = idx & 7; tw[i] = w_in[(size_t)k * INTOT + 1536 + h]; tg[i] = g_mix[k]; }
#pragma unroll
          for (int i = 0; i < 16; ++i) { const int idx = i * 512 + tid_, k = idx >> 3, h = idx & 7; WFL[h * 1024 + k] = tg[i] * tw[i]; } }
        __syncthreads();
        for (int rb = gw; rb < M; rb += 4 * NGW) {
            f32x4 v[4][4];
#pragma unroll
            for (int r = 0; r < 4; ++r) { const int row = rb + r * NGW; if (row < M) { const GAS f32x4* xr = (const GAS f32x4*)(x + (size_t)row * D);
#pragma unroll
                for (int j = 0; j < 4; ++j) v[r][j] = xr[lane_ + 64 * j]; } }
#pragma unroll
            for (int r = 0; r < 4; ++r) { const int row = rb + r * NGW; if (row < M) {
                float ss = 0.f;
#pragma unroll
                for (int j = 0; j < 4; ++j) ss += (v[r][j].x * v[r][j].x + v[r][j].y * v[r][j].y) + (v[r][j].z * v[r][j].z + v[r][j].w * v[r][j].w);
                ss = wave_sum(ss);
                const float rstd = 1.0f / sqrtf(ss * (1.0f / D) + EPS);
                GAS u32x2* o = (GAS u32x2*)(XB + (size_t)row * D);
#pragma unroll
                for (int j = 0; j < 4; ++j) { u32x2 w; w.x = pk2(v[r][j].x, v[r][j].y); w.y = pk2(v[r][j].z, v[r][j].w); o[lane_ + 64 * j] = w; }
                { GAS unsigned* o8 = (GAS unsigned*)(ws + WS_XB8 + (size_t)row * D);
#pragma unroll
                  for (int j = 0; j < 4; ++j) { int q = __builtin_amdgcn_cvt_pk_fp8_f32(v[r][j].x, v[r][j].y, 0, false); q = __builtin_amdgcn_cvt_pk_fp8_f32(v[r][j].z, v[r][j].w, q, true); o8[lane_ + 64 * j] = (unsigned)q; } }
                if (lane_ == 0) RSTD1[row] = rstd;
                float f[8];
#pragma unroll
                for (int h = 0; h < 8; ++h) { float s_ = 0.f;
#pragma unroll
                    for (int j = 0; j < 4; ++j) { const f32x4 w = *(const LAS f32x4*)(WFL + h * 1024 + 4 * (lane_ + 64 * j)); s_ += (v[r][j].x * w[0] + v[r][j].y * w[1]) + (v[r][j].z * w[2] + v[r][j].w * w[3]); }
                    f[h] = s_; }
                float r4[4], r2[2], r1;
#pragma unroll
                for (int i = 0; i < 4; ++i) { const float send = (lane_ & 32) ? f[i] : f[i + 4], keep = (lane_ & 32) ? f[i + 4] : f[i]; r4[i] = keep + __shfl_xor(send, 32); }
#pragma unroll
                for (int i = 0; i < 2; ++i) { const float send = (lane_ & 16) ? r4[i] : r4[i + 2], keep = (lane_ & 16) ? r4[i + 2] : r4[i]; r2[i] = keep + __shfl_xor(send, 16); }
                { const float send = (lane_ & 8) ? r2[0] : r2[1], keep = (lane_ & 8) ? r2[1] : r2[0]; r1 = keep + __shfl_xor(send, 8); }
                r1 += __shfl_xor(r1, 4); r1 += __shfl_xor(r1, 2); r1 += __shfl_xor(r1, 1);
                const int hL = ((lane_ >> 5) & 1) * 4 + ((lane_ >> 4) & 1) * 2 + ((lane_ >> 3) & 1);
                const float tot = r1 * rstd + b_f[hL];
                const float ls = fminf(tot, 0.f) - log1pf(__expf(-fabsf(tot)));
                const int b = row / SEQ, t = row % SEQ;
                if ((lane_ & 7) == 0) LF[(size_t)(b * NH + hL) * SEQ + t] = ls * LOG2E;
            } }
        }
    }
    };
    if (F.vcu & 1) { stepC(); __syncthreads(); stepB(); }
    else           { stepB(); __syncthreads(); stepC(); }
    { constexpr int NP = M * PLE / 8;
        for (int i = F.vcu * 512 + tid_; i < NP; i += NGT) { const f32x4 a_ = ((const GAS f32x4*)p)[2 * (size_t)i], b_ = ((const GAS f32x4*)p)[2 * (size_t)i + 1];
            v4u o; o.x = pk2(a_.x, a_.y); o.y = pk2(a_.z, a_.w); o.z = pk2(b_.x, b_.y); o.w = pk2(b_.z, b_.w); ((GAS v4u*)PB)[i] = o; }
    }
}
__device__ __forceinline__ void p2_conv_chunk(int chunk, const bf16* GB, const bf16* Z, const float* cw, bf16* AC) {
    int tid_l = (int)threadIdx.x; asm volatile("" : "+v"(tid_l));
#pragma unroll 4
    for (int k = 0; k < 16; ++k) {
        const int i = chunk * 8192 + k * 512 + tid_l;
        const int row = i >> 6, c = (i & 63) * 8, t = row & (SEQ - 1);
        const v4u z2 = *(const GAS v4u*)(Z + (size_t)row * AW + c), g = *(const GAS v4u*)(GB + (size_t)row * AW + c);
        v4u z1 = {0u, 0u, 0u, 0u}, z0 = {0u, 0u, 0u, 0u};
        if (t >= 1) z1 = *(const GAS v4u*)(Z + (size_t)(row - 1) * AW + c);
        if (t >= 2) z0 = *(const GAS v4u*)(Z + (size_t)(row - 2) * AW + c);
        float r[8];
#pragma unroll
        for (int e = 0; e < 4; ++e) {
            const float w0a = cw[c + 2 * e], w0b = cw[c + 2 * e + 1], w1a = cw[AW + c + 2 * e], w1b = cw[AW + c + 2 * e + 1], w2a = cw[2 * AW + c + 2 * e], w2b = cw[2 * AW + c + 2 * e + 1];
            r[2 * e] = __uint_as_float(g[e] << 16) * (w0a * __uint_as_float(z0[e] << 16) + w1a * __uint_as_float(z1[e] << 16) + w2a * __uint_as_float(z2[e] << 16));
            r[2 * e + 1] = __uint_as_float(g[e] & 0xffff0000u) * (w0b * __uint_as_float(z0[e] & 0xffff0000u) + w1b * __uint_as_float(z1[e] & 0xffff0000u) + w2b * __uint_as_float(z2[e] & 0xffff0000u));
        }
        v4u o; o.x = pk2(r[0], r[1]); o.y = pk2(r[2], r[3]); o.z = pk2(r[4], r[5]); o.w = pk2(r[6], r[7]);
        *(GAS v4u*)(AC + (size_t)row * D + AW + c) = o;
    }
}
constexpr int P2_NATT = 512, P2_NCONV = M * AW / 8 / 8192, P2_NQ = 2 * NEXP / 64, P2_NWS = 256, P2_NTR = TR_LATE / 16, CW_QUEUE = 512;
constexpr int P2_NITEMS = P2_NATT + P2_NCONV + P2_NQ + P2_NWS + P2_NTR;
__device__ __forceinline__ int p2_dequeue(unsigned* ctr, volatile LAS unsigned* slot) {
    if (threadIdx.x == 0) *slot = __hip_atomic_fetch_add(ctr, 1u, __ATOMIC_RELAXED, __HIP_MEMORY_SCOPE_AGENT);
    asm volatile("s_waitcnt vmcnt(0) lgkmcnt(0)\n\ts_barrier" ::: "memory");
    const unsigned v = *slot;
    asm volatile("s_waitcnt lgkmcnt(0)\n\ts_barrier" ::: "memory");
    return (int)v;
}
template <int CTRL> __device__ __forceinline__ int dpp_i(int v) { return __builtin_amdgcn_update_dpp(0, v, CTRL, 0xf, 0xf, true); }
__device__ __forceinline__ int sum8i(int v) { v += dpp_i<0x141>(v); v += dpp_i<0xB1>(v); v += dpp_i<0x4E>(v); return v; }
__device__ __forceinline__ float max8f(float v) { v = fmaxf(v, __uint_as_float((unsigned)dpp_i<0x141>((int)__float_as_uint(v)))); v = fmaxf(v, __uint_as_float((unsigned)dpp_i<0xB1>((int)__float_as_uint(v)))); v = fmaxf(v, __uint_as_float((unsigned)dpp_i<0x4E>((int)__float_as_uint(v)))); return v; }
__device__ __forceinline__ size_t part_slab(int j) { return j < 2 ? WS_PART0 + (size_t)j * 8 * MiB : j < 6 ? WS_PART1 + (size_t)(j - 2) * 8 * MiB : WS_PART2 + (size_t)(j - 6) * 8 * MiB; }
struct P6Geo { int xg, wi, nwv, ng; };
__device__ __forceinline__ P6Geo p6_geo(const Ctx& F) { P6Geo g; const int bx = blockIdx.x, ng = F.G < 8 ? F.G : 8; g.xg = bx % ng; g.wi = (bx / ng) * NWAVES + F.wave; g.nwv = ((F.G - g.xg + ng - 1) / ng) * NWAVES; g.ng = ng; return g; }
__device__ __forceinline__ void p6a_upass(const Ctx& F, unsigned char* ws, const bf16* XB1, const unsigned short* IDS) {
    const P6Geo G = p6_geo(F); const int lane = F.lane_(), g = lane >> 3, c = lane & 7;
    for (int sl = G.xg; sl < NSL; sl += G.ng) {
        float* PART = (float*)(ws + part_slab(sl));
        const GAS unsigned char* Ts = (const GAS unsigned char*)(ws + WS_UB) + (size_t)sl * NEXP * SLW + 16 * c;
        for (int t = G.wi; t < M; t += G.nwv) {
            const v4u xa = *(const GAS v4u*)(XB1 + (size_t)t * D + sl * SLW + 16 * c), xb = *(const GAS v4u*)(XB1 + (size_t)t * D + sl * SLW + 16 * c + 8);
            v4u idp[2];
#pragma unroll
            for (int q = 0; q < 2; ++q) idp[q] = *(const GAS v4u*)(IDS + (size_t)t * 128 + 16 * g + 8 * q);
            v4u u[16];
#pragma unroll
            for (int i = 0; i < 16; ++i) { const unsigned w_ = idp[i >> 3][(i >> 1) & 3]; u[i] = *(const GAS v4u*)(Ts + ((i & 1) ? ((w_ >> 9) & 0x7fff80u) : ((w_ << 7) & 0x7fff80u))); }
            float xf[16];
#pragma unroll
            for (int e = 0; e < 4; ++e) { xf[2 * e] = __uint_as_float(xa[e] << 16); xf[2 * e + 1] = __uint_as_float(xa[e] & 0xffff0000u); xf[8 + 2 * e] = __uint_as_float(xb[e] << 16); xf[8 + 2 * e + 1] = __uint_as_float(xb[e] & 0xffff0000u); }
            float am = 0.f;
#pragma unroll
            for (int e = 0; e < 16; ++e) am = fmaxf(am, fabsf(xf[e]));
            am = max8f(am);
            const float sc = am > 0.f ? 127.0f / am : 0.f, sx = am * (1.0f / 127.0f);
            int qx[4];
#pragma unroll
            for (int j = 0; j < 4; ++j) qx[j] = (int)(((unsigned)((int)rintf(xf[4 * j] * sc) & 255)) | ((unsigned)((int)rintf(xf[4 * j + 1] * sc) & 255) << 8) | ((unsigned)((int)rintf(xf[4 * j + 2] * sc) & 255) << 16) | ((unsigned)((int)rintf(xf[4 * j + 3] * sc) & 255) << 24));
            int r0 = 0, r1 = 0;
#pragma unroll
            for (int i = 0; i < 16; ++i) { int sacc = __builtin_amdgcn_sdot4(qx[0], (int)u[i][0], 0, false); sacc = __builtin_amdgcn_sdot4(qx[1], (int)u[i][1], sacc, false); sacc = __builtin_amdgcn_sdot4(qx[2], (int)u[i][2], sacc, false); sacc = __builtin_amdgcn_sdot4(qx[3], (int)u[i][3], sacc, false);
                sacc = sum8i(sacc);
                if (i < 8) r0 = (c == i) ? sacc : r0; else r1 = (c == i - 8) ? sacc : r1; }
            float* pp = PART + (size_t)t * 128 + 16 * g + c;
            pp[0] = (float)r0 * sx; pp[8] = (float)r1 * sx;
        }
    }
}
__device__ __forceinline__ int pl32_sum(int a, int b) { const auto s_ = __builtin_amdgcn_permlane32_swap((unsigned)a, (unsigned)b, false, false); return (int)(s_[0] + s_[1]); }
__device__ __forceinline__ int pl16_sum(int a, int b) { const auto s_ = __builtin_amdgcn_permlane16_swap((unsigned)a, (unsigned)b, false, false); return (int)(s_[0] + s_[1]); }
__device__ __forceinline__ float wave_sum_valu(float v) {
    { const auto s_ = __builtin_amdgcn_permlane32_swap(__float_as_uint(v), __float_as_uint(v), false, false); v = __uint_as_float(s_[0]) + __uint_as_float(s_[1]); }
    { const auto s_ = __builtin_amdgcn_permlane16_swap(__float_as_uint(v), __float_as_uint(v), false, false); v = __uint_as_float(s_[0]) + __uint_as_float(s_[1]); }
    v += __uint_as_float((unsigned)dpp_i<0x128>((int)__float_as_uint(v))); v += __uint_as_float((unsigned)dpp_i<0x124>((int)__float_as_uint(v)));
    v += __uint_as_float((unsigned)dpp_i<0x122>((int)__float_as_uint(v))); v += __uint_as_float((unsigned)dpp_i<0x121>((int)__float_as_uint(v))); return v;
}
__device__ __forceinline__ float wave_max_valu(float v) {
    { const auto s_ = __builtin_amdgcn_permlane32_swap(__float_as_uint(v), __float_as_uint(v), false, false); v = fmaxf(__uint_as_float(s_[0]), __uint_as_float(s_[1])); }
    { const auto s_ = __builtin_amdgcn_permlane16_swap(__float_as_uint(v), __float_as_uint(v), false, false); v = fmaxf(__uint_as_float(s_[0]), __uint_as_float(s_[1])); }
    v = fmaxf(v, __uint_as_float((unsigned)dpp_i<0x128>((int)__float_as_uint(v)))); v = fmaxf(v, __uint_as_float((unsigned)dpp_i<0x124>((int)__float_as_uint(v))));
    v = fmaxf(v, __uint_as_float((unsigned)dpp_i<0x122>((int)__float_as_uint(v)))); v = fmaxf(v, __uint_as_float((unsigned)dpp_i<0x121>((int)__float_as_uint(v)))); return v;
}
__device__ __forceinline__ void p6b_combine(const Ctx& F, unsigned char* ws, float* SS2, const unsigned short* IDS, const float* GATES) {
    const int gw = F.vcu * NWAVES + F.wave, NGW = F.G * NWAVES, lane = F.lane_();
    const float *SU = (const float*)(ws + WS_SU), *SV = (const float*)(ws + WS_SV);
    signed char* WQ8 = (signed char*)(ws + WS_WQ8);
    for (int tb = gw; tb < M; tb += 4 * NGW) {
        float ssv[4], a0[4], a1[4], g0[4], g1[4], su0[4], su1[4], sv0[4], sv1[4], pa[4][8], pb[4][8]; int i0[4], i1[4];
#pragma unroll
        for (int r = 0; r < 4; ++r) { const int t = tb + r * NGW; if (t < M) { i0[r] = (int)IDS[(size_t)t * 128 + lane]; i1[r] = (int)IDS[(size_t)t * 128 + 64 + lane]; } }
#pragma unroll
        for (int r = 0; r < 4; ++r) { const int t = tb + r * NGW; if (t < M) {
            ssv[r] = lane < 16 ? SS2[(size_t)t * 16 + lane] : 0.f;
            g0[r] = GATES[(size_t)t * 128 + lane]; g1[r] = GATES[(size_t)t * 128 + 64 + lane];
#pragma unroll
            for (int j = 0; j < 8; ++j) { const float* pp = (const float*)(ws + part_slab(j)) + (size_t)t * 128; pa[r][j] = pp[lane]; pb[r][j] = pp[64 + lane]; } } }
#pragma unroll
        for (int r = 0; r < 4; ++r) { const int t = tb + r * NGW; if (t < M) { su0[r] = SU[i0[r]]; su1[r] = SU[i1[r]]; sv0[r] = SV[i0[r]]; sv1[r] = SV[i1[r]]; } }
#pragma unroll
        for (int r = 0; r < 4; ++r) { const int t = tb + r * NGW; if (t < M) {
            a0[r] = ((pa[r][0] + pa[r][1]) + (pa[r][2] + pa[r][3])) + ((pa[r][4] + pa[r][5]) + (pa[r][6] + pa[r][7]));
            a1[r] = ((pb[r][0] + pb[r][1]) + (pb[r][2] + pb[r][3])) + ((pb[r][4] + pb[r][5]) + (pb[r][6] + pb[r][7]));
            const float rstd = 1.0f / sqrtf(wave_sum_valu(ssv[r]) * (1.0f / D) + EPS);
            const float x0 = a0[r] * rstd * su0[r], x1 = a1[r] * rstd * su1[r];
            const float w0 = g0[r] * 0.5f * x0 * (1.0f + erff(x0 * 0.70710678118654752f)) * sv0[r], w1 = g1[r] * 0.5f * x1 * (1.0f + erff(x1 * 0.70710678118654752f)) * sv1[r];
            const float am = wave_max_valu(fmaxf(fabsf(w0), fabsf(w1)));
            const float sc = am > 0.f ? 127.0f / am : 0.f;
            const float q0 = rintf(w0 * sc), q1 = rintf(w1 * sc);
            WQ8[(size_t)t * 128 + lane] = (signed char)(int)q0; WQ8[(size_t)t * 128 + 64 + lane] = (signed char)(int)q1;
            const float qs = wave_sum_valu(q0 + q1);
            if (lane == 0) { f32x2 o_; o_.x = am * (1.0f / 127.0f); o_.y = am * (1.0f / 127.0f) * qs; ((f32x2*)(ws + WS_SW2))[t] = o_; }
            if (lane < 16) SS2[(size_t)t * 16 + lane] = 0.f;
        } }
    }
}
__device__ __forceinline__ void p6c_vpass(const Ctx& F, unsigned char* ws, const unsigned short* IDS, const bf16* XB1, bf16* XB2, float* SS3) {
    const P6Geo G = p6_geo(F); const int lane = F.lane_(), g = lane >> 3, c = lane & 7;
    const int ecol = 32 * c + ((lane >> 5) & 1) * 16 + ((lane >> 4) & 1) * 8 + ((lane >> 3) & 1) * 4;
    const signed char* WQ8 = (const signed char*)(ws + WS_WQ8); const f32x2* SW2 = (const f32x2*)(ws + WS_SW2);
#define V_IDS(ID, t_) do { _Pragma("unroll") for (int q = 0; q < 2; ++q) ID[q] = *(const GAS v4u*)(IDS + (size_t)(t_) * 128 + 16 * g + 8 * q); } while (0)
#define V_AUX(WV, XQ, SWV, t_) do { WV = *(const GAS v4u*)(WQ8 + (size_t)(t_) * 128 + 16 * g); XQ = *(const GAS u32x2*)(XB1 + (size_t)(t_) * D + sl * SL4 + ecol); SWV = *(const GAS f32x2*)(SW2 + (t_)); } while (0)
#define V_GATHER(R, ID) do { _Pragma("unroll") for (int i = 0; i < 16; ++i) { const unsigned w_ = ID[i >> 3][(i >> 1) & 3]; R[i] = *(const GAS v4u*)(Ts + (size_t)((((i & 1) ? (w_ >> 9) : (w_ << 7)) & 0x7fff80u) | c16)); } } while (0)
#define V_COMPUTE(R, WV, XQ, SWV, t_) do { \
        const size_t o_ = (size_t)(t_) * D + sl * SL4 + ecol; \
        int acc[32]; \
        _Pragma("unroll") for (int e = 0; e < 32; ++e) acc[e] = 0; \
        _Pragma("unroll") for (int j = 0; j < 4; ++j) \
            _Pragma("unroll") for (int b = 0; b < 4; ++b) { \
                const unsigned r0_ = R[4 * j][b], r1_ = R[4 * j + 1][b], r2_ = R[4 * j + 2][b], r3_ = R[4 * j + 3][b]; \
                const unsigned x01 = __builtin_amdgcn_perm(r1_, r0_, 0x05010400u), y01 = __builtin_amdgcn_perm(r1_, r0_, 0x07030602u), x23 = __builtin_amdgcn_perm(r3_, r2_, 0x05010400u), y23 = __builtin_amdgcn_perm(r3_, r2_, 0x07030602u); \
                const unsigned t0_ = __builtin_amdgcn_perm(x23, x01, 0x05040100u), t1_ = __builtin_amdgcn_perm(x23, x01, 0x07060302u), t2_ = __builtin_amdgcn_perm(y23, y01, 0x05040100u), t3_ = __builtin_amdgcn_perm(y23, y01, 0x07060302u); \
                acc[8 * b]     = __builtin_amdgcn_sdot4((int)(t0_ & 0x0f0f0f0fu), (int)WV[j], acc[8 * b], false);     acc[8 * b + 1] = __builtin_amdgcn_sdot4((int)t0_, (int)WV[j], acc[8 * b + 1], false); \
                acc[8 * b + 2] = __builtin_amdgcn_sdot4((int)(t1_ & 0x0f0f0f0fu), (int)WV[j], acc[8 * b + 2], false); acc[8 * b + 3] = __builtin_amdgcn_sdot4((int)t1_, (int)WV[j], acc[8 * b + 3], false); \
                acc[8 * b + 4] = __builtin_amdgcn_sdot4((int)(t2_ & 0x0f0f0f0fu), (int)WV[j], acc[8 * b + 4], false); acc[8 * b + 5] = __builtin_amdgcn_sdot4((int)t2_, (int)WV[j], acc[8 * b + 5], false); \
                acc[8 * b + 6] = __builtin_amdgcn_sdot4((int)(t3_ & 0x0f0f0f0fu), (int)WV[j], acc[8 * b + 6], false); acc[8 * b + 7] = __builtin_amdgcn_sdot4((int)t3_, (int)WV[j], acc[8 * b + 7], false); } \
        _Pragma("unroll") for (int e = 0; e < 16; ++e) acc[2 * e + 1] -= acc[2 * e];                         \
        int r16[16], r8[8], r4[4]; \
        _Pragma("unroll") for (int i = 0; i < 16; ++i) r16[i] = pl32_sum(acc[i], acc[i + 16]); \
        _Pragma("unroll") for (int i = 0; i < 8; ++i) r8[i] = pl16_sum(r16[i], r16[i + 8]); \
        _Pragma("unroll") for (int i = 0; i < 4; ++i) { const int send = (lane & 8) ? r8[i] : r8[i + 4], keep = (lane & 8) ? r8[i + 4] : r8[i]; r4[i] = keep + dpp_i<0x128>(send); } \
        const float sw_ = SWV.x, cw_ = SWV.y; \
        const float x0_ = __uint_as_float(XQ.x << 16) + (sw_ * (float)r4[0] - 7.5f * cw_), x1_ = __uint_as_float(XQ.x & 0xffff0000u) + (sw_ * 0.0625f * (float)r4[1] + 0.5f * cw_); \
        const float x2_ = __uint_as_float(XQ.y << 16) + (sw_ * (float)r4[2] - 7.5f * cw_), x3_ = __uint_as_float(XQ.y & 0xffff0000u) + (sw_ * 0.0625f * (float)r4[3] + 0.5f * cw_); \
        u32x2 ov_; ov_.x = pk2(x0_, x1_); ov_.y = pk2(x2_, x3_); *(GAS u32x2*)(XB2 + o_) = ov_; \
        *(GAS unsigned*)(ws + WS_XB2_8 + o_) = (unsigned)__builtin_amdgcn_cvt_pk_fp8_f32(x2_, x3_, __builtin_amdgcn_cvt_pk_fp8_f32(x0_, x1_, 0, false), true); \
        const float ss = wave_sum_valu((x0_ * x0_ + x1_ * x1_) + (x2_ * x2_ + x3_ * x3_)); \
        if (lane == 0) SS3[(size_t)(t_) * 16 + sl] = ss; } while (0)
#define V_FENCE() asm volatile("" ::: "memory")
    const bool two = G.ng == 8; const int nsl_step = two ? 4 : G.ng;
    int wbase = 0, wtot = G.nwv;
    if (two) { const int xo = G.xg ^ 4, nwo = ((F.G - xo + 7) / 8) * NWAVES; wtot = G.nwv + nwo; wbase = (G.xg & 4) ? nwo : 0; }
    for (int sl = two ? (G.xg & 3) : G.xg; sl < NSL4; sl += nsl_step) {
        const GAS unsigned char* Ts = (const GAS unsigned char*)(ws + WS_VB) + (size_t)sl * NEXP * 128; const unsigned c16 = 16u * (unsigned)c;
        const int t0 = wbase + G.wi, dt = wtot, nk = t0 < M ? (M - t0 + dt - 1) / dt : 0;
        if (nk <= 0) continue;
#define TOK(k_) (t0 + ((k_) < nk ? (k_) : nk - 1) * dt)
        v4u idA[2], idB[2]; v4u wA, wB; u32x2 xA, xB; f32x2 sA, sB; v4u rA[16], rB[16];
        V_IDS(idA, TOK(0)); V_IDS(idB, TOK(1));
        V_FENCE();
        V_GATHER(rA, idA); V_AUX(wA, xA, sA, TOK(0));
        V_FENCE();
        for (int k = 0; k < nk; k += 2) {
            V_IDS(idA, TOK(k + 2));
            V_FENCE();
            V_GATHER(rB, idB); V_AUX(wB, xB, sB, TOK(k + 1));
            V_FENCE();
            V_COMPUTE(rA, wA, xA, sA, TOK(k));
            V_FENCE();
            V_IDS(idB, TOK(k + 3));
            V_FENCE();
            V_GATHER(rA, idA); V_AUX(wA, xA, sA, TOK(k + 2));
            V_FENCE();
            V_COMPUTE(rB, wB, xB, sB, TOK(k + 1));
            V_FENCE();
        }
#undef TOK
    }
#undef V_IDS
#undef V_AUX
#undef V_GATHER
#undef V_COMPUTE
#undef V_FENCE
}
__device__ __forceinline__ void p8_final(const Ctx& F, const bf16* XB3, const float* SS4, float* OUT, const float* g) {
    const int gw = F.vcu * NWAVES + F.wave, NGW = F.G * NWAVES, lane = F.lane_();
    f32x4 gv[4];
#pragma unroll
    for (int j = 0; j < 4; ++j) gv[j] = ((const GAS f32x4*)g)[2 * lane + (j & 1) + 128 * (j >> 1)];
    for (int rb = gw; rb < M; rb += 4 * NGW) {
        v4u xa[4], xb[4]; float sv[4];
#pragma unroll
        for (int r = 0; r < 4; ++r) { const int row = rb + r * NGW; if (row < M) { xa[r] = *(const GAS v4u*)(XB3 + (size_t)row * D + 8 * lane); xb[r] = *(const GAS v4u*)(XB3 + (size_t)row * D + 512 + 8 * lane);
            sv[r] = lane < 16 ? SS4[(size_t)row * 16 + lane] : 0.f; } }
#pragma unroll
        for (int r = 0; r < 4; ++r) { const int row = rb + r * NGW; if (row < M) {
            const float rstd = 1.0f / sqrtf(wave_sum(sv[r]) * (1.0f / D) + EPS);
            GAS f32x4* o = (GAS f32x4*)(OUT + (size_t)row * D);
            o[2 * lane] = (f32x4){__uint_as_float(xa[r][0] << 16), __uint_as_float(xa[r][0] & 0xffff0000u), __uint_as_float(xa[r][1] << 16), __uint_as_float(xa[r][1] & 0xffff0000u)} * rstd * gv[0];
            o[2 * lane + 1] = (f32x4){__uint_as_float(xa[r][2] << 16), __uint_as_float(xa[r][2] & 0xffff0000u), __uint_as_float(xa[r][3] << 16), __uint_as_float(xa[r][3] & 0xffff0000u)} * rstd * gv[1];
            o[128 + 2 * lane] = (f32x4){__uint_as_float(xb[r][0] << 16), __uint_as_float(xb[r][0] & 0xffff0000u), __uint_as_float(xb[r][1] << 16), __uint_as_float(xb[r][1] & 0xffff0000u)} * rstd * gv[2];
            o[128 + 2 * lane + 1] = (f32x4){__uint_as_float(xb[r][2] << 16), __uint_as_float(xb[r][2] & 0xffff0000u), __uint_as_float(xb[r][3] << 16), __uint_as_float(xb[r][3] & 0xffff0000u)} * rstd * gv[3];
        } }
    }
}
struct OneUnit {
    pg8::Unit u;
    __device__ __forceinline__ bool next(int i, pg8::Unit& o) const { if (i != 0) return false; o = u; return true; }
    __device__ __forceinline__ void a_ready(const pg8::Unit&) const {}
    __device__ __forceinline__ void done(const pg8::Unit&) const {}
};

__global__ void __launch_bounds__(NWAVES * 64, 2) mk_fwd(Args args) {
    extern __shared__ __attribute__((aligned(16))) unsigned char lds[];
    Ctx F;
    F.lds = (LAS unsigned char*)lds;
    F.wave = __builtin_amdgcn_readfirstlane((int)threadIdx.x >> 6);
    F.G = gridDim.x; { const int bx = blockIdx.x; F.vcu = (F.G % 8 == 0) ? (bx % 8) * (F.G / 8) + bx / 8 : bx; }
    volatile LAS unsigned* MISC = (volatile LAS unsigned*)(F.lds + MISC_OFF);
    unsigned char* ws = args.ws;
    gu32* ctl = (gu32*)(ws + WS_CTL);
    for (int u = F.tid_(); u < (LDS_BYTES - LDSCTL_OFF) / 4; u += NWAVES * 64) ((LAS unsigned*)(F.lds + LDSCTL_OFF))[u] = 0u;
    __syncthreads();
    const int lo = args.ph_lo, hi = args.ph_hi;
    const bool multi = (hi - lo) > 1 || (lo <= 6 && 6 < hi);
    XcdBarrier bar; bar.bar = (unsigned*)(ctl + CW_BAR) + args.li * XCD_BAR_WORDS; bar.x = 0; bar.st = nullptr;
    if (multi) bar = xcd_barrier_post((unsigned*)(ctl + CW_BAR) + args.li * XCD_BAR_WORDS, MISC + 8);
#ifndef MK_CMASK
#define MK_CMASK 0x1ff
#endif
#define IN(k) (((MK_CMASK >> (k)) & 1) && lo <= (k) && (k) < hi)
#ifdef MK_PROBE_BAR2
#define SEAM(k) do { if (IN(k) && IN((k) + 1)) { xcd_barrier(bar); for (int rb_ = 1; rb_ < MK_PROBE_BAR2; ++rb_) xcd_barrier(bar); } STAMPI((k) < 6 ? (k) + 1 : (k) + 3); } while (0)
#else
#define SEAM(k) do { if (IN(k) && IN((k) + 1)) xcd_barrier(bar); STAMPI((k) < 6 ? (k) + 1 : (k) + 3); } while (0)
#endif
#ifdef MK_PROBE_SEG
#define STAMPI(i_) do { if (((i_) == MK_PROBE_SEG || (i_) == MK_PROBE_SEG + 1 || (MK_PROBE_SEG == 200 && ((i_) == 0 || (i_) == 11))) && blockIdx.x == 0 && threadIdx.x == 0) { ((unsigned long long*)(args.ws + 32768))[(i_)] = __builtin_amdgcn_s_memrealtime(); } } while (0)
    STAMPI(0);
#else
#define STAMPI(i_) do { } while (0)
#endif
    float* out = args.out;
#define WSP(T, off) ((T*)(ws + (off)))
#define RSTD1 WSP(float, WS_RSTD1)
#define SS2 WSP(float, WS_SS2)
#define LF WSP(float, WS_LF)
#define WIN WSP(bf16, WS_WIN)
#define WBR WSP(bf16, WS_WBR)
#define WOUT WSP(bf16, WS_WOUT)
#define WST WSP(bf16, WS_WS)
#define WPG WSP(bf16, WS_WPG)
#define WPP WSP(bf16, WS_WPP)
#define PB WSP(bf16, WS_PB)
#define XB WSP(bf16, WS_A)
#define AC WSP(bf16, WS_AC)
#define XB1 WSP(bf16, WS_A)
#define PP WSP(bf16, WS_PP)
#define Q WSP(bf16, WS_Q)
#define K WSP(bf16, WS_K)
#define V WSP(bf16, WS_V)
#define GB WSP(bf16, WS_GB)
#define Z WSP(bf16, WS_Z)
#define MG WSP(bf16, WS_MERGED)
#define XB2 WSP(bf16, WS_XB2)
#define IDS WSP(unsigned short, WS_IDS)
#define GATES WSP(float, WS_GATES)
#define SGA ((bf16*)out)
#define SGC ((bf16*)out + (size_t)M * D)

    if (IN(0)) { p0_prologue(F, args, MISC); }
    SEAM(0);
    if (IN(1)) {
        { pg8::Gemm g{XB, WIN, M, 3072, D}; pg8::StaticOrder S; S.init(M, 3072, F.G, (int)blockIdx.x);
          pg8::EpiIn E{RSTD1, Q, (size_t)(WS_K - WS_Q) / 2, Z, SGA, (size_t)M * D, C2};
          static_assert(WS_V - WS_K == WS_K - WS_Q && WS_GB - WS_V == WS_K - WS_Q, "Q | K | V | GB equally spaced");
          pg8::gemm_phase<pg8::EpiIn, pg8::StaticOrder, PG8_ALIGN, PG8_SP2>(F.lds + RING_OFF, g, S, E, F.wave); }
        { pg8::Gemm g{WSP(bf16, WS_XB8), WSP(bf16, WS_WIN8), M, 2048, D / 2}; pg8::StaticOrder S; S.init(M, 2048, F.G, (int)blockIdx.x);
          pg8::EpiGate E{RSTD1, SGA, (size_t)M * D, 1.0f / 32.0f};
          pg8::gemm_phase<pg8::EpiGate, pg8::StaticOrder, PG8_ALIGN, PG8_SP2, true>(F.lds + RING_OFF, g, S, E, F.wave); }
        { pg8::Gemm g{PB, WPP, M, D, PLE}; pg8::StaticOrder S; S.init(M, D, F.G, (int)blockIdx.x);
          pg8::EpiPlain E{PP, D};
          pg8::gemm_phase<pg8::EpiPlain, pg8::StaticOrder, PG8_ALIGN, PG8_SP2>(F.lds + RING_OFF, g, S, E, F.wave); }
    }
    SEAM(1);
    if (IN(2)) {
        unsigned* qctr = (unsigned*)(ctl + CW_QUEUE);
        for (;;) {
            const int idx = p2_dequeue(qctr, MISC + 12);
            if (idx >= P2_NITEMS) break;
            if (idx < P2_NATT) { const int qb = 15 - (idx >> 5), bh = idx & 31;
                attn_body::attn_unit<8>(bh >> 3, bh & 7, qb, (const attn_body::bf16*)Q, (const attn_body::bf16*)K, (const attn_body::bf16*)V, (attn_body::bf16*)AC, LF + (size_t)bh * SEQ, (char*)lds + RING_OFF); }
            else if (idx < P2_NATT + P2_NQ) {
                int lane_l = (int)threadIdx.x & 63; asm volatile("" : "+v"(lane_l));
                const int r0 = (idx - P2_NATT) * 64 + F.wave * 8;
                quant_rows4(args, r0, lane_l); quant_rows4(args, r0 + 4, lane_l);
            }
            else if (idx < P2_NATT + P2_NQ + P2_NCONV) p2_conv_chunk(idx - P2_NATT - P2_NQ, GB, Z, args.in[5], AC);
            else if (idx < P2_NATT + P2_NQ + P2_NCONV + P2_NWS) ws_item(args, F.lds + RING_OFF, idx - P2_NATT - P2_NQ - P2_NCONV);
            else { int lane_l = (int)threadIdx.x & 63; asm volatile("" : "+v"(lane_l));
                const int w0 = TR_P0 + (idx - P2_NATT - P2_NQ - P2_NCONV - P2_NWS) * 16 + F.wave * 2;
                tr_two(args, (LAS float*)(F.lds + RING_OFF + F.wave * 16384), w0, w0 + 1, true, lane_l); }
        }
    }
    SEAM(2);
    if (IN(3)) {
        pg8::Gemm g{AC, WBR, M, D, D}; pg8::StaticOrder S; S.init(M, D, F.G, (int)blockIdx.x);
        pg8::EpiBranch E{SGA, SGC, MG};
        pg8::gemm_phase<pg8::EpiBranch, pg8::StaticOrder, PG8_ALIGN, PG8_SP2>(F.lds + RING_OFF, g, S, E, F.wave);
    }
    SEAM(3);
    if (IN(4)) {
        pg8::Gemm g{MG, WOUT, M, D, D}; pg8::StaticOrder S; S.init(M, D, F.G, (int)blockIdx.x);
        pg8::EpiOut E{XB, XB1, SS2};
        pg8::gemm_phase<pg8::EpiOut, pg8::StaticOrder, PG8_ALIGN, PG8_SP2>(F.lds + RING_OFF, g, S, E, F.wave);
    }
    SEAM(4);
    if (IN(5)) {
        pg8::Gemm g{XB1, WST, M, NS, D}; pg8::StaticOrder S; S.init(M, NS, F.G, (int)blockIdx.x);
        pg8::EpiTopK E{SS2, IDS, GATES, EPS};
        pg8::Unit u;
        for (int i = 0; S.next(i, u); ++i) { OneUnit O{u}; pg8::gemm_phase<pg8::EpiTopK, OneUnit, false, PG8_SP2>(F.lds + RING_OFF, g, O, E, F.wave); }
    }
    SEAM(5);
    if (IN(6)) { p6a_upass(F, ws, XB1, IDS); xcd_barrier(bar); STAMPI(7); p6b_combine(F, ws, SS2, IDS, GATES); xcd_barrier(bar); STAMPI(8); p6c_vpass(F, ws, IDS, XB1, XB2, SS2); }
    SEAM(6);
    if (IN(7)) {
        pg8::Gemm g{WSP(bf16, WS_XB2_8), WPG, M, D, D / 2}; pg8::StaticOrder S; S.init(M, D, F.G, (int)blockIdx.x);
        LAS float* rtab = (LAS float*)(F.lds + RING_OFF + pg8::STAGE_BYTES);
        const bool one = (M / 256) * (D / 256) <= F.G; pg8::Unit u0;
        if (one && S.next(0, u0) && F.tid_() < 256) { const float* sp = SS2 + (size_t)(u0.pm * 256 + F.tid_()) * 16; float q = 0.f;
#pragma unroll
            for (int j = 0; j < NSL; ++j) q += sp[j];
            rtab[F.tid_()] = 1.0f / sqrtf(q * (1.0f / D) + EPS); }
        __syncthreads();
        pg8::EpiPle E{SS2, PP, XB2, WSP(bf16, WS_XB3), WSP(float, WS_SS4), EPS, 1.0f / 32.0f, one ? (const LAS float*)rtab : (const LAS float*)nullptr};
        pg8::gemm_phase<pg8::EpiPle, pg8::StaticOrder, PG8_ALIGN, PG8_SP2, true>(F.lds + RING_OFF, g, S, E, F.wave);
    }
    SEAM(7);
    if (IN(8)) { p8_final(F, WSP(bf16, WS_XB3), WSP(float, WS_SS4), out, args.in[17]); }
    STAMPI(11);
#ifdef MK_PROBE_SEG
    if (blockIdx.x == 0 && F.tid_() == 0) {
        asm volatile("s_waitcnt vmcnt(0)" ::: "memory");
        const unsigned long long* st_ = (const unsigned long long*)(args.ws + 32768);
#if MK_PROBE_SEG >= 100 && MK_PROBE_SEG != 200
        const unsigned long long a_ = st_[32 + (MK_PROBE_SEG - 100)], b_ = (MK_PROBE_SEG - 100 == 4) ? st_[1] : st_[33 + (MK_PROBE_SEG - 100)];
#else
        const unsigned long long a_ = st_[MK_PROBE_SEG == 200 ? 0 : MK_PROBE_SEG], b_ = st_[MK_PROBE_SEG == 200 ? 11 : MK_PROBE_SEG + 1];
#endif
        const unsigned long long dt_ = (b_ - a_) * MK_PROBE_MULT, t0_ = __builtin_amdgcn_s_memrealtime();
        while (__builtin_amdgcn_s_memrealtime() - t0_ < dt_) __builtin_amdgcn_s_sleep(8);
    }
#endif
#undef IN
#undef SEAM
#undef WSP
#undef RSTD1
#undef SS2
#undef LF
#undef WIN
#undef WBR
#undef WOUT
#undef WST
#undef WPG
#undef WPP
#undef PB
#undef XB
#undef AC
#undef XB1
#undef PP
#undef Q
#undef K
#undef V
#undef GB
#undef Z
#undef MG
#undef XB2
#undef IDS
#undef GATES
#undef SGA
#undef SGC
}

extern "C" void kernel_launch(void* const* d_in, const int* in_sizes, int n_in, void* d_out, int out_size, void* d_ws, size_t ws_size, hipStream_t stream) {
    static int grid = 0;
    if (grid == 0) {
        if (n_in != 18 || in_sizes[0] != M * D || out_size != M * D || ws_size < WS_END) { fprintf(stderr, "kernel_launch: unexpected shapes (n_in %d, in0 %d, out %d, ws %zu); nothing launched\n", n_in, n_in > 0 ? in_sizes[0] : -1, out_size, ws_size); grid = -1; return; }
        int dev = 0, cus = 0, per_cu = 0;
        if (hipGetDevice(&dev) != hipSuccess || hipDeviceGetAttribute(&cus, hipDeviceAttributeMultiprocessorCount, dev) != hipSuccess) { fprintf(stderr, "kernel_launch: device query failed\n"); grid = -1; return; }
        if (hipFuncSetAttribute((const void*)mk_fwd, hipFuncAttributeMaxDynamicSharedMemorySize, LDS_BYTES) != hipSuccess) { fprintf(stderr, "kernel_launch: hipFuncSetAttribute failed\n"); grid = -1; return; }
        if (hipOccupancyMaxActiveBlocksPerMultiprocessor(&per_cu, (const void*)mk_fwd, NWAVES * 64, LDS_BYTES) != hipSuccess || per_cu < 1) { fprintf(stderr, "kernel_launch: occupancy query says %d workgroups per CU; nothing launched\n", per_cu); (void)hipGetLastError(); grid = -1; return; }
        grid = cus;
    }
    if (grid < 0) return;
    if (hipMemsetAsync((char*)d_ws + WS_CTL, 0, CTL_ZERO_BYTES, stream) != hipSuccess) { fprintf(stderr, "kernel_launch: hipMemsetAsync failed\n"); return; }
    Args a{};
    for (int i = 0; i < 18; ++i) a.in[i] = (const float*)d_in[i];
    a.out = (float*)d_out; a.ws = (unsigned char*)d_ws; a.ph_lo = 0; a.ph_hi = NPHASE; a.li = 0; a.pad = 0;
    hipLaunchKernelGGL(mk_fwd, dim3(grid), dim3(NWAVES * 64), LDS_BYTES, stream, a);
    const hipError_t le = hipPeekAtLastError();
    if (le != hipSuccess) fprintf(stderr, "kernel_launch: launch failed: %s\n", hipGetErrorName(le));
}
```

```cpp
#include <hip/hip_runtime.h>
#include <hip/hip_bf16.h>
#include <cstdio>
#include <cstdint>
#include <cmath>
namespace pg8 {
#define PG8_LAS __attribute__((address_space(3)))
typedef unsigned short bf16_t;
typedef short bf16x8 __attribute__((ext_vector_type(8)));
typedef float f32x4 __attribute__((ext_vector_type(4)));
typedef unsigned u32x4 __attribute__((ext_vector_type(4)));
constexpr int BM = 256, BK = 64, HALF = 128, HTB = HALF * BK * 2  , STAGE_BYTES = 8 * HTB, NXCD = 8, WGM = 8;

__host__ __device__ __forceinline__ int lds_byte(int r, int c) { const int st = (r >> 4) * 2 + (c >> 5), rr = r & 15, cc = c & 31, ob = rr * 64 + cc * 2; return st * 1024 + (ob ^ (((ob >> 9) & 1) << 5)); }
__host__ __device__ __forceinline__ void stage_rc(int b, int& R, int& C) { const int st = b / 1024, sb = b % 1024, swz = sb ^ (((sb >> 9) & 1) << 5); R = (st >> 1) * 16 + swz / 64; C = (st & 1) * 32 + (swz % 64) / 2; }
__host__ __device__ __forceinline__ int perm32(int rho) { const int n = rho >> 4, i = rho & 15; return 8 * (i >> 2) + 4 * n + (i & 3); }

struct Unit { int pm, pn; };
struct Gemm { const bf16_t* A; const bf16_t* Bt; int M, N, K; };

struct StaticOrder {
    int nM, nN, nwg, G, c;
    __host__ __device__ __forceinline__ void init(int M, int N, int G_, int c_) { nM = M / BM; nN = N / BM; nwg = nM * nN; G = G_; c = c_; }
    __host__ __device__ __forceinline__ bool next(int i, Unit& u) const {
        const long L = (long)i * G + c; if (L >= nwg) return false;
        int wgid = (int)L; { const int q = nwg / NXCD, r = nwg % NXCD, xcd = wgid % NXCD, off = wgid / NXCD; wgid = (xcd < r ? xcd * (q + 1) : r * (q + 1) + (xcd - r) * q) + off; }
        const int nig = WGM * nN, gid = wgid / nig, fm = gid * WGM, gsz = (nM - fm) < WGM ? (nM - fm) : WGM;
        u.pm = fm + ((wgid % nig) % gsz); u.pn = (wgid % nig) / gsz; return true;
    }
    __device__ __forceinline__ void a_ready(const Unit&) const {}
    __device__ __forceinline__ void done(const Unit&) const {}
};


__device__ __forceinline__ unsigned cvt_pk_bf16(float lo, float hi) { unsigned r; asm volatile("v_cvt_pk_bf16_f32 %0, %1, %2" : "=v"(r) : "v"(lo), "v"(hi)); return r; }
__device__ __forceinline__ u32x4 pack8(const f32x4 v0, const f32x4 v1) { u32x4 w; w.x = cvt_pk_bf16(v0[0], v0[1]); w.y = cvt_pk_bf16(v0[2], v0[3]); w.z = cvt_pk_bf16(v1[0], v1[1]); w.w = cvt_pk_bf16(v1[2], v1[3]); return w; }
__device__ __forceinline__ float bflo(unsigned w) { return __uint_as_float(w << 16); }
__device__ __forceinline__ float bfhi(unsigned w) { return __uint_as_float(w & 0xffff0000u); }
__device__ __forceinline__ float sigm(float v) { return __builtin_amdgcn_rcpf(1.0f + __builtin_amdgcn_exp2f(v * -1.4426950408889634f)); }
__device__ __forceinline__ f32x4 sigm4(const f32x4 v) { return (f32x4){sigm(v[0]), sigm(v[1]), sigm(v[2]), sigm(v[3])}; }

__device__ __forceinline__ float sum_fq(float v) {
    { const auto s_ = __builtin_amdgcn_permlane16_swap(__float_as_uint(v), __float_as_uint(v), false, false); v = __uint_as_float(s_[0]) + __uint_as_float(s_[1]); }
    { const auto s_ = __builtin_amdgcn_permlane32_swap(__float_as_uint(v), __float_as_uint(v), false, false); v = __uint_as_float(s_[0]) + __uint_as_float(s_[1]); }
    return v;
}
struct EpiIn {
    static constexpr int PROBE_ID = 1;
    static constexpr bool PERM = true, AFTER_DRAIN = false; static constexpr int MID_T = 0;
    const float* rstd; bf16_t* QKVG; size_t stride4; bf16_t* Z; bf16_t* SG; size_t strideSG; float c2;
    __device__ __forceinline__ void operator()(const f32x4 (&acc)[2][2][4][2], const Unit& u, int wr, int wc, int fr, int fq) const {
        int t_l = (int)__builtin_amdgcn_mbcnt_hi(~0u, __builtin_amdgcn_mbcnt_lo(~0u, 0u)); asm volatile("" : "+v"(t_l)); fr = t_l & 15; fq = t_l >> 4;
        const int row0 = u.pm * BM + wr * 64 + fr; const int cl = wc * 32 + 8 * fq, pn = u.pn;
        if (pn < 8) {
            bf16_t* base = QKVG + (size_t)(pn >> 1) * stride4; const int colt = (pn & 1) * 256 + cl; const float s0 = pn < 2 ? c2 : 1.f;
#pragma unroll
            for (int ai = 0; ai < 2; ++ai)
#pragma unroll
                for (int m = 0; m < 4; ++m) { const int row = row0 + ai * HALF + m * 16; const float sc = rstd[row] * s0; bf16_t* rowp = base + (size_t)row * 512 + colt;
#pragma unroll
                    for (int bj = 0; bj < 2; ++bj) *(u32x4*)(rowp + bj * HALF) = pack8(acc[ai][bj][m][0] * sc, acc[ai][bj][m][1] * sc);
                    asm volatile("" ::: "memory"); }
        } else if (pn < 12) {
            const int colt = (pn - 8) * 128 + cl;
#pragma unroll
            for (int ai = 0; ai < 2; ++ai)
#pragma unroll
                for (int m = 0; m < 4; ++m) { const int row = row0 + ai * HALF + m * 16; const float r = rstd[row], sc = r * r;
                    *(u32x4*)(Z + (size_t)row * 512 + colt) = pack8(acc[ai][0][m][0] * acc[ai][1][m][0] * sc, acc[ai][0][m][1] * acc[ai][1][m][1] * sc);
                    asm volatile("" ::: "memory"); }
        }
    }
};
struct EpiGate {
    static constexpr int PROBE_ID = 8;
    static constexpr bool PERM = true, AFTER_DRAIN = false; static constexpr int MID_T = 0;
    const float* rstd; bf16_t* SG; size_t strideSG; float wsc;
    __device__ __forceinline__ void operator()(const f32x4 (&acc)[2][2][4][2], const Unit& u, int wr, int wc, int fr, int fq) const {
        int t_l = (int)__builtin_amdgcn_mbcnt_hi(~0u, __builtin_amdgcn_mbcnt_lo(~0u, 0u)); asm volatile("" : "+v"(t_l)); fr = t_l & 15; fq = t_l >> 4;
        const int row0 = u.pm * BM + wr * 64 + fr; const int cl = wc * 32 + 8 * fq;
        {
            const int colt = u.pn * 128 + cl;
#pragma unroll
            for (int ai = 0; ai < 2; ++ai)
#pragma unroll
                for (int m = 0; m < 4; ++m) { const int row = row0 + ai * HALF + m * 16; const float r = rstd[row] * wsc;
                    f32x4 ra[2], sc_[2];
#pragma unroll
                    for (int n = 0; n < 2; ++n) {
#pragma unroll
                        for (int e = 0; e < 4; ++e) { const float ea = __builtin_amdgcn_exp2f(acc[ai][0][m][n][e] * r * -1.4426950408889634f), ec = __builtin_amdgcn_exp2f(acc[ai][1][m][n][e] * r * -1.4426950408889634f);
                            sc_[n][e] = __builtin_amdgcn_rcpf(1.0f + ec); ra[n][e] = (1.0f + ec) * __builtin_amdgcn_rcpf(1.0f + ea); } }
                    *(u32x4*)(SG + (size_t)row * 1024 + colt) = pack8(ra[0], ra[1]); *(u32x4*)(SG + strideSG + (size_t)row * 1024 + colt) = pack8(sc_[0], sc_[1]);
                    asm volatile("" ::: "memory"); }
        }
    }
};
struct EpiPlain {
    static constexpr int PROBE_ID = 2;
    static constexpr bool PERM = true, AFTER_DRAIN = false; static constexpr int MID_T = 0;
    bf16_t* O; int ldc;
    __device__ __forceinline__ void operator()(const f32x4 (&acc)[2][2][4][2], const Unit& u, int wr, int wc, int fr, int fq) const {
        int t_l = (int)__builtin_amdgcn_mbcnt_hi(~0u, __builtin_amdgcn_mbcnt_lo(~0u, 0u)); asm volatile("" : "+v"(t_l)); fr = t_l & 15; fq = t_l >> 4;
        const int row0 = u.pm * BM + wr * 64 + fr; const int col0 = u.pn * BM + wc * 32 + 8 * fq;
#pragma unroll
        for (int ai = 0; ai < 2; ++ai)
#pragma unroll
            for (int m = 0; m < 4; ++m) { bf16_t* rowp = O + (size_t)(row0 + ai * HALF + m * 16) * ldc + col0;
#pragma unroll
                for (int bj = 0; bj < 2; ++bj) *(u32x4*)(rowp + bj * HALF) = pack8(acc[ai][bj][m][0], acc[ai][bj][m][1]); }
    }
};
struct EpiBranch {
    static constexpr int PROBE_ID = 3;
    static constexpr bool PERM = true, AFTER_DRAIN = false; static constexpr int MID_T = 8;
    const bf16_t *SGA, *SGC; bf16_t* MG;
    __device__ __forceinline__ void mid(f32x4 (&acc)[2][2][4][2], const Unit& u, int wr, int wc, int fr, int fq) const {
        int t_l = (int)__builtin_amdgcn_mbcnt_hi(~0u, __builtin_amdgcn_mbcnt_lo(~0u, 0u)); asm volatile("" : "+v"(t_l)); fr = t_l & 15; fq = t_l >> 4;
        const int row0 = u.pm * BM + wr * 64 + fr; const int col0 = u.pn * BM + wc * 32 + 8 * fq;
#pragma unroll
        for (int ai = 0; ai < 2; ++ai) {
            u32x4 a[4][2];
#pragma unroll
            for (int m = 0; m < 4; ++m)
#pragma unroll
                for (int bj = 0; bj < 2; ++bj) a[m][bj] = *(const u32x4*)(SGA + (size_t)(row0 + ai * HALF + m * 16) * 1024 + col0 + bj * HALF);
#pragma unroll
            for (int m = 0; m < 4; ++m)
#pragma unroll
                for (int bj = 0; bj < 2; ++bj) { const u32x4 av = a[m][bj];
                    acc[ai][bj][m][0] *= (f32x4){bflo(av[0]), bfhi(av[0]), bflo(av[1]), bfhi(av[1])}; acc[ai][bj][m][1] *= (f32x4){bflo(av[2]), bfhi(av[2]), bflo(av[3]), bfhi(av[3])}; }
            asm volatile("" ::: "memory");
        }
    }
    __device__ __forceinline__ void operator()(const f32x4 (&acc)[2][2][4][2], const Unit& u, int wr, int wc, int fr, int fq) const {
        int t_l = (int)__builtin_amdgcn_mbcnt_hi(~0u, __builtin_amdgcn_mbcnt_lo(~0u, 0u)); asm volatile("" : "+v"(t_l)); fr = t_l & 15; fq = t_l >> 4;
        const int row0 = u.pm * BM + wr * 64 + fr; const int col0 = u.pn * BM + wc * 32 + 8 * fq;
#pragma unroll
        for (int ai = 0; ai < 2; ++ai) {
            u32x4 c[4][2];
#pragma unroll
            for (int m = 0; m < 4; ++m)
#pragma unroll
                for (int bj = 0; bj < 2; ++bj) c[m][bj] = *(const u32x4*)(SGC + (size_t)(row0 + ai * HALF + m * 16) * 1024 + col0 + bj * HALF);
#pragma unroll
            for (int m = 0; m < 4; ++m)
#pragma unroll
                for (int bj = 0; bj < 2; ++bj) { const u32x4 cv = c[m][bj];
                    const f32x4 s0 = {bflo(cv[0]), bfhi(cv[0]), bflo(cv[1]), bfhi(cv[1])}, s1 = {bflo(cv[2]), bfhi(cv[2]), bflo(cv[3]), bfhi(cv[3])};
                    *(u32x4*)(MG + (size_t)(row0 + ai * HALF + m * 16) * 1024 + col0 + bj * HALF) = pack8(acc[ai][bj][m][0] * s0, acc[ai][bj][m][1] * s1); }
            asm volatile("" ::: "memory");
        }
    }
};
struct EpiOut {
    static constexpr int PROBE_ID = 4;
    static constexpr bool PERM = true, AFTER_DRAIN = false; static constexpr int MID_T = 0;
    const bf16_t* XBin; bf16_t* XB1; float* SS2;
    __device__ __forceinline__ void operator()(const f32x4 (&acc)[2][2][4][2], const Unit& u, int wr, int wc, int fr, int fq) const {
        int t_l = (int)__builtin_amdgcn_mbcnt_hi(~0u, __builtin_amdgcn_mbcnt_lo(~0u, 0u)); asm volatile("" : "+v"(t_l)); fr = t_l & 15; fq = t_l >> 4;
        const int row0 = u.pm * BM + wr * 64 + fr; const int col0 = u.pn * BM + wc * 32 + 8 * fq;
#pragma unroll
        for (int ai = 0; ai < 2; ++ai) {
            u32x4 xq[4][2];
#pragma unroll
            for (int m = 0; m < 4; ++m)
#pragma unroll
                for (int bj = 0; bj < 2; ++bj) xq[m][bj] = *(const u32x4*)(XBin + (size_t)(row0 + ai * HALF + m * 16) * 1024 + col0 + bj * HALF);
#pragma unroll
            for (int m = 0; m < 4; ++m) { const int row = row0 + ai * HALF + m * 16; float ss = 0.f;
#pragma unroll
                for (int bj = 0; bj < 2; ++bj) { const u32x4 q = xq[m][bj];
                    const f32x4 v0 = acc[ai][bj][m][0] + (f32x4){bflo(q[0]), bfhi(q[0]), bflo(q[1]), bfhi(q[1])}, v1 = acc[ai][bj][m][1] + (f32x4){bflo(q[2]), bfhi(q[2]), bflo(q[3]), bfhi(q[3])};
                    *(u32x4*)(XB1 + (size_t)row * 1024 + col0 + bj * HALF) = pack8(v0, v1);
                    ss += (v0[0] * v0[0] + v0[1] * v0[1]) + (v0[2] * v0[2] + v0[3] * v0[3]) + (v1[0] * v1[0] + v1[1] * v1[1]) + (v1[2] * v1[2] + v1[3] * v1[3]); }
                ss = sum_fq(ss);
                if (fq == 0) SS2[(size_t)row * 16 + u.pn * 4 + wc] = ss; }
            asm volatile("" ::: "memory");
        }
    }
};
struct EpiPle {
    static constexpr int PROBE_ID = 7;
    static constexpr bool PERM = true, AFTER_DRAIN = false; static constexpr int MID_T = 0;
    const float* SS3; const bf16_t* PP; const bf16_t* XB2; bf16_t* XB3; float* SS4; float eps; float wsc; const PG8_LAS float* rtab;
    __device__ __forceinline__ void operator()(const f32x4 (&acc)[2][2][4][2], const Unit& u, int wr, int wc, int fr, int fq) const {
        int t_l = (int)__builtin_amdgcn_mbcnt_hi(~0u, __builtin_amdgcn_mbcnt_lo(~0u, 0u)); asm volatile("" : "+v"(t_l)); fr = t_l & 15; fq = t_l >> 4;
        const int row0 = u.pm * BM + wr * 64 + fr; const int col0 = u.pn * BM + wc * 32 + 8 * fq;
#pragma unroll
        for (int ah = 0; ah < 4; ++ah) {
            const int ai = ah >> 1, m0 = (ah & 1) * 2;
            u32x4 pv[2][2], xb[2][2]; float rr[2];
#pragma unroll
            for (int mm = 0; mm < 2; ++mm) { const int m = m0 + mm; const int row = row0 + ai * HALF + m * 16;
#pragma unroll
                for (int bj = 0; bj < 2; ++bj) { const size_t off = (size_t)row * 1024 + col0 + bj * HALF; pv[mm][bj] = *(const u32x4*)(PP + off); xb[mm][bj] = *(const u32x4*)(XB2 + off); }
                if (rtab) rr[mm] = rtab[wr * 64 + fr + ai * HALF + m * 16];
                else { const f32x4* sp = (const f32x4*)(SS3 + (size_t)row * 16); const f32x4 q0 = sp[0], q1 = sp[1]; rr[mm] = 1.0f / sqrtf((((q0[0] + q0[1]) + (q0[2] + q0[3])) + ((q1[0] + q1[1]) + (q1[2] + q1[3]))) * (1.0f / 1024.0f) + eps); } }
#pragma unroll
            for (int mm = 0; mm < 2; ++mm) { const int m = m0 + mm; const int row = row0 + ai * HALF + m * 16; const float r = rr[mm] * wsc; float ss = 0.f;
#pragma unroll
                for (int bj = 0; bj < 2; ++bj) { const u32x4 c = pv[mm][bj], xq = xb[mm][bj]; const size_t off = (size_t)row * 1024 + col0 + bj * HALF;
                    const f32x4 p0 = {bflo(c[0]), bfhi(c[0]), bflo(c[1]), bfhi(c[1])}, p1 = {bflo(c[2]), bfhi(c[2]), bflo(c[3]), bfhi(c[3])};
                    const f32x4 x0 = {bflo(xq[0]), bfhi(xq[0]), bflo(xq[1]), bfhi(xq[1])}, x1 = {bflo(xq[2]), bfhi(xq[2]), bflo(xq[3]), bfhi(xq[3])};
                    const f32x4 v0 = x0 + sigm4(acc[ai][bj][m][0] * r) * p0, v1 = x1 + sigm4(acc[ai][bj][m][1] * r) * p1;
                    *(u32x4*)(XB3 + off) = pack8(v0, v1);
                    ss += (v0[0] * v0[0] + v0[1] * v0[1]) + (v0[2] * v0[2] + v0[3] * v0[3]) + (v1[0] * v1[0] + v1[1] * v1[1]) + (v1[2] * v1[2] + v1[3] * v1[3]); }
                ss = sum_fq(ss);
                if (fq == 0) SS4[(size_t)row * 16 + u.pn * 4 + wc] = ss; }
            asm volatile("" ::: "memory");
        }
    }
};

__device__ __forceinline__ float vmaxf(float a, float b) { float r; asm("v_max_f32_e32 %0, %1, %2" : "=v"(r) : "v"(a), "v"(b)); return r; }
__device__ __forceinline__ float vminf(float a, float b) { float r; asm("v_min_f32_e32 %0, %1, %2" : "=v"(r) : "v"(a), "v"(b)); return r; }
__device__ __forceinline__ void sort16_desc(float (&a)[16]) {
#define TK_CE(i, j) do { const float hi_ = vmaxf(a[i], a[j]), lo_ = vminf(a[i], a[j]); a[i] = hi_; a[j] = lo_; } while (0)
    TK_CE(0, 13); TK_CE(1, 12); TK_CE(2, 15); TK_CE(3, 14); TK_CE(4, 8); TK_CE(5, 6); TK_CE(7, 11); TK_CE(9, 10);
    TK_CE(0, 5); TK_CE(1, 7); TK_CE(2, 9); TK_CE(3, 4); TK_CE(6, 13); TK_CE(8, 14); TK_CE(10, 15); TK_CE(11, 12);
    TK_CE(0, 1); TK_CE(2, 3); TK_CE(4, 5); TK_CE(6, 8); TK_CE(7, 9); TK_CE(10, 11); TK_CE(12, 13); TK_CE(14, 15);
    TK_CE(0, 2); TK_CE(1, 3); TK_CE(4, 10); TK_CE(5, 11); TK_CE(6, 7); TK_CE(8, 9); TK_CE(12, 14); TK_CE(13, 15);
    TK_CE(1, 2); TK_CE(3, 12); TK_CE(4, 6); TK_CE(5, 7); TK_CE(8, 10); TK_CE(9, 11); TK_CE(13, 14);
    TK_CE(1, 4); TK_CE(2, 6); TK_CE(5, 8); TK_CE(7, 10); TK_CE(9, 13); TK_CE(11, 14);
    TK_CE(2, 4); TK_CE(3, 6); TK_CE(9, 12); TK_CE(11, 13);
    TK_CE(3, 5); TK_CE(6, 8); TK_CE(7, 9); TK_CE(10, 12);
    TK_CE(3, 4); TK_CE(5, 6); TK_CE(7, 8); TK_CE(9, 10); TK_CE(11, 12);
    TK_CE(6, 7); TK_CE(8, 9);
#undef TK_CE
}
template <int L> __device__ __forceinline__ void merge16(float (&a)[16], const float (&b)[16]) {
#pragma unroll
    for (int i = 0; i < 16; ++i) if (15 - i < L) a[i] = vmaxf(a[i], b[15 - i]);
#pragma unroll
    for (int j = 8; j > 0; j >>= 1)
#pragma unroll
        for (int i = 0; i < 16; ++i) { const int l = i ^ j; if (l > i) { const float hi = vmaxf(a[i], a[l]), lo = vminf(a[i], a[l]); a[i] = hi; a[l] = lo; } }
}
struct EpiTopK {
    static constexpr int PROBE_ID = 5;
    static constexpr bool PERM = true, AFTER_DRAIN = true; static constexpr int MID_T = 0;
    static constexpr int RS = 260;
    const float* SS2; unsigned short* IDS; float* GATES; float eps;
    __device__ __forceinline__ void fused(f32x4 (&acc)[2][2][4][2], const Unit& u, int wr, int wc, int fr, int fq, PG8_LAS unsigned char* lds, int wid, int lane) const {
        PG8_LAS float* S = (PG8_LAS float*)lds;
        const int tid = wid * 64 + lane, row = tid & 127, grp = tid >> 7, half = grp >> 1, part = grp & 1;
#define TK_BAR() do { asm volatile("s_waitcnt lgkmcnt(0)" ::: "memory"); __builtin_amdgcn_s_barrier(); asm volatile("" ::: "memory"); } while (0)
#ifdef MK_PROBE_TOPK2
        for (int rep_ = 0; rep_ < MK_PROBE_TOPK2; ++rep_)
#endif
#pragma unroll
        for (int ai = 0; ai < 2; ++ai) {
#pragma unroll
            for (int m = 0; m < 4; ++m)
#pragma unroll
                for (int bj = 0; bj < 2; ++bj)
#pragma unroll
                    for (int n = 0; n < 2; ++n) *(PG8_LAS f32x4*)(S + (wr * 64 + m * 16 + fr) * RS + bj * HALF + wc * 32 + 8 * fq + 4 * n) = acc[ai][bj][m][n];
            TK_BAR();
            float T[16];
#ifdef MK_PROBE_TK1
            for (int rep1_ = 0; rep1_ < MK_PROBE_TK1; ++rep1_)
#endif
#pragma unroll
            for (int b = 0; b < 4; ++b) {
                float c[16];
#pragma unroll
                for (int q = 0; q < 4; ++q) { const f32x4 v = *(const PG8_LAS f32x4*)(S + row * RS + half * 128 + part * 64 + b * 16 + q * 4);
#pragma unroll
                    for (int e = 0; e < 4; ++e) c[q * 4 + e] = __uint_as_float((__float_as_uint(v[e]) & ~127u) | (unsigned)(part * 64 + b * 16 + q * 4 + e)); }
                sort16_desc(c);
                if (b == 0) {
#pragma unroll
                    for (int i = 0; i < 16; ++i) T[i] = c[i];
                } else merge16<16>(T, c);
            }
            TK_BAR();
#pragma unroll
            for (int q = 0; q < 4; ++q) *(PG8_LAS f32x4*)(S + tid * 16 + q * 4) = (f32x4){T[q * 4], T[q * 4 + 1], T[q * 4 + 2], T[q * 4 + 3]};
            TK_BAR();
            if (part == 0) {
                float c[16];
#pragma unroll
                for (int q = 0; q < 4; ++q) { const f32x4 v = *(const PG8_LAS f32x4*)(S + (tid + 128) * 16 + q * 4); c[q * 4] = v[0]; c[q * 4 + 1] = v[1]; c[q * 4 + 2] = v[2]; c[q * 4 + 3] = v[3]; }
                merge16<16>(T, c);
            }
            TK_BAR();
            if (part == 0) {
#pragma unroll
                for (int q = 0; q < 4; ++q) *(PG8_LAS f32x4*)(S + tid * 16 + q * 4) = (f32x4){T[q * 4], T[q * 4 + 1], T[q * 4 + 2], T[q * 4 + 3]};
            }
            TK_BAR();
#ifdef MK_PROBE_TK3
            for (int rep3_ = 0; rep3_ < MK_PROBE_TK3; ++rep3_)
#endif
            if (tid < 128) {
                float a1[16], a2[16];
#pragma unroll
                for (int q = 0; q < 4; ++q) { const f32x4 v = *(const PG8_LAS f32x4*)(S + (tid + 256) * 16 + q * 4);
#pragma unroll
                    for (int e = 0; e < 4; ++e) a2[q * 4 + e] = __uint_as_float(__float_as_uint(v[e]) & ~127u); }
#pragma unroll
                for (int i = 0; i < 16; ++i) a1[i] = __uint_as_float(__float_as_uint(T[i]) & ~127u);
#define TK_SUM(i, j) __uint_as_float((__float_as_uint(a1[i] + a2[j]) & ~255u) | (unsigned)((i) * 16 + (j)))
                float R[16], C[16];
#pragma unroll
                for (int j = 0; j < 16; ++j) R[j] = TK_SUM(0, j);
#pragma unroll
                for (int i = 1; i < 16; ++i) C[i - 1] = TK_SUM(i, 0);
                C[15] = 0.f;
                merge16<15>(R, C);
                C[0] = TK_SUM(1, 1); C[1] = TK_SUM(1, 2); C[2] = TK_SUM(1, 3); C[3] = TK_SUM(1, 4); C[4] = TK_SUM(1, 5); C[5] = TK_SUM(1, 6); C[6] = TK_SUM(1, 7);
                C[7] = TK_SUM(2, 1); C[8] = TK_SUM(2, 2); C[9] = TK_SUM(2, 3); C[10] = TK_SUM(2, 4); C[11] = TK_SUM(3, 1); C[12] = TK_SUM(3, 2); C[13] = TK_SUM(3, 3);
                C[14] = TK_SUM(4, 1); C[15] = TK_SUM(4, 2);
                sort16_desc(C);
                merge16<16>(R, C);
                C[0] = TK_SUM(5, 1); C[1] = TK_SUM(6, 1); C[2] = TK_SUM(7, 1);
                merge16<3>(R, C);
#undef TK_SUM
                const int rowg = u.pm * BM + ai * HALF + row;
                const f32x4* ssp = (const f32x4*)(SS2 + (size_t)rowg * 16); const f32x4 s0 = ssp[0], s1 = ssp[1], s2 = ssp[2], s3 = ssp[3];
                const float ssum = ((s0[0] + s0[1]) + (s0[2] + s0[3])) + ((s1[0] + s1[1]) + (s1[2] + s1[3])) + ((s2[0] + s2[1]) + (s2[2] + s2[3])) + ((s3[0] + s3[1]) + (s3[2] + s3[3]));
                const float rl = 1.4426950408889634f / sqrtf(ssum * (1.0f / 1024.0f) + eps);
                float ev[16], esum = 0.f; int idv[16];
#pragma unroll
                for (int r = 0; r < 16; ++r) { ev[r] = __builtin_amdgcn_exp2f((R[r] - R[0]) * rl); esum += ev[r];
                    const unsigned code = __float_as_uint(R[r]) & 255u;
                    const unsigned k1 = __float_as_uint(S[tid * 16 + (code >> 4)]) & 127u, k2 = __float_as_uint(S[(tid + 256) * 16 + (code & 15u)]) & 127u;
                    idv[r] = (int)(k1 * 128u + k2); }
                const float inv = 1.0f / esum;
                unsigned short* ip = IDS + (size_t)rowg * 128 + u.pn * 16; float* gp = GATES + (size_t)rowg * 128 + u.pn * 16;
#pragma unroll
                for (int q = 0; q < 2; ++q) { u32x4 w; w.x = (unsigned)idv[q * 8] | ((unsigned)idv[q * 8 + 1] << 16); w.y = (unsigned)idv[q * 8 + 2] | ((unsigned)idv[q * 8 + 3] << 16); w.z = (unsigned)idv[q * 8 + 4] | ((unsigned)idv[q * 8 + 5] << 16); w.w = (unsigned)idv[q * 8 + 6] | ((unsigned)idv[q * 8 + 7] << 16);
                    *(u32x4*)(ip + q * 8) = w; }
#pragma unroll
                for (int q = 0; q < 4; ++q) *(f32x4*)(gp + q * 4) = (f32x4){ev[q * 4] * inv, ev[q * 4 + 1] * inv, ev[q * 4 + 2] * inv, ev[q * 4 + 3] * inv};
            }
            TK_BAR();
        }
#undef TK_BAR
    }
};
template <class Epi, class Sched, bool ALIGN_EPI = false, bool SP2 = false, bool FP8 = false>
__device__ __forceinline__ void gemm_phase(PG8_LAS unsigned char* lds, const Gemm g, const Sched& S, const Epi& E, const int wid_in) {
    int lane_l = (int)__builtin_amdgcn_mbcnt_hi(~0u, __builtin_amdgcn_mbcnt_lo(~0u, 0u)); asm volatile("" : "+v"(lane_l));
    const int wid = wid_in, lane = lane_l, tid = wid * 64 + lane, wr = wid >> 2, wc = wid & 3, fr = lane & 15, fq = lane >> 4;
    const int K = g.K, nt = K / BK;
    unsigned voffA, voffB;
    { int R, C; stage_rc(tid * 16, R, C); const int Rb = Epi::PERM ? ((R & ~31) + perm32(R & 31)) : R;
        voffA = (unsigned)(R * K + C) * 2u; voffB = (unsigned)(Rb * K + C) * 2u; }
    const size_t rstep64 = (size_t)64 * K * 2;
    const size_t kstep = (size_t)(BK * 2);
    const size_t hstep = (size_t)HALF * K * 2;
    const size_t tstep = 2 * hstep;
    const unsigned ldsw = (unsigned)wid * 1024u;
    const int aoff = lds_byte(wr * 64 + fr, FP8 ? fq * 16 : fq * 8), boff = lds_byte(wc * 32 + fr, FP8 ? fq * 16 : fq * 8);
    constexpr int KSTR = FP8 ? 16 : 1024;
#define PG8_SA(b, h) (((b) * 2 + (h)) * HTB)
#define PG8_SB(b, h) ((4 + (b) * 2 + (h)) * HTB)
#define PG8_STAGE(bufoff, gbase, voff) do { _Pragma("unroll") for (int _i = 0; _i < 2; ++_i) \
        __builtin_amdgcn_global_load_lds((const unsigned*)((const char*)(gbase) + _i * rstep64 + (voff)), (PG8_LAS unsigned*)(lds + (bufoff) + ldsw + _i * 8192), 16, 0, 0); } while (0)
#define PG8_LDA(dst, b, h) do { _Pragma("unroll") for (int m = 0; m < 4; ++m) _Pragma("unroll") for (int k = 0; k < 2; ++k) dst[m][k] = *(const PG8_LAS v4i_t*)(lds + PG8_SA(b, h) + aoff + m * 2048 + k * KSTR); } while (0)
#define PG8_LDB(dst, b, h) do { _Pragma("unroll") for (int n = 0; n < 2; ++n) _Pragma("unroll") for (int k = 0; k < 2; ++k) dst[n][k] = *(const PG8_LAS v4i_t*)(lds + PG8_SB(b, h) + boff + n * 2048 + k * KSTR); } while (0)
#define PG8_MMA(ai, bj, At, Bt) do { __builtin_amdgcn_s_setprio(1); _Pragma("unroll") for (int m = 0; m < 4; ++m) _Pragma("unroll") for (int n = 0; n < 2; ++n) { \
        if constexpr (FP8) { const v8i_t b8_ = __builtin_shufflevector(Bt[n][0], Bt[n][1], 0, 1, 2, 3, 4, 5, 6, 7), a8_ = __builtin_shufflevector(At[m][0], At[m][1], 0, 1, 2, 3, 4, 5, 6, 7); \
            asm volatile("v_mfma_scale_f32_16x16x128_f8f6f4 %0, %1, %2, %0, %3, %3 op_sel_hi:[0,0,0]" : "+v"(acc[ai][bj][m][n]) : "v"(b8_), "v"(a8_), "v"(mxs_)); }     \
        else { _Pragma("unroll") for (int k = 0; k < 2; ++k) acc[ai][bj][m][n] = __builtin_amdgcn_mfma_f32_16x16x32_bf16(__builtin_bit_cast(bf16x8, Bt[n][k]), __builtin_bit_cast(bf16x8, At[m][k]), acc[ai][bj][m][n], 0, 0, 0); } } \
        __builtin_amdgcn_s_setprio(0); } while (0)
#define PG8_WAIT_V(n) asm volatile("s_waitcnt vmcnt(" #n ")" ::: "memory")
#define PG8_WAIT_L(n) asm volatile("s_waitcnt lgkmcnt(" #n ")" ::: "memory")
#define PG8_BAR __builtin_amdgcn_s_barrier()
#define PG8_SCHED __builtin_amdgcn_sched_barrier(0)
    Unit cur, nxt; int ui = 0;
    if (!S.next(0, cur)) return;
    f32x4 acc[2][2][4][2];
#pragma unroll
    for (int a = 0; a < 2; ++a)
#pragma unroll
        for (int b = 0; b < 2; ++b)
#pragma unroll
            for (int m = 0; m < 4; ++m)
#pragma unroll
                for (int n = 0; n < 2; ++n) acc[a][b][m][n] = (f32x4){0.f, 0.f, 0.f, 0.f};
    typedef int v4i_t __attribute__((ext_vector_type(4))); typedef int v8i_t __attribute__((ext_vector_type(8)));
    int mxs_ = 0x7f7f7f7f; asm volatile("" : "+v"(mxs_));
    v4i_t At[4][2], B0[2][2], B1[2][2];
    const char* cA = (const char*)g.A + (size_t)cur.pm * tstep; const char* cB = (const char*)g.Bt + (size_t)cur.pn * tstep;
    S.a_ready(cur);
    if constexpr (SP2) {
        PG8_STAGE(PG8_SB(0, 0), cB, voffB); PG8_STAGE(PG8_SB(0, 1), cB + hstep, voffB); PG8_STAGE(PG8_SA(0, 0), cA, voffA); PG8_STAGE(PG8_SA(0, 1), cA + hstep, voffA);
        if (wr == 1) PG8_BAR;
        PG8_WAIT_V(2); PG8_BAR;
        PG8_STAGE(PG8_SB(1, 0), cB + kstep, voffB); PG8_STAGE(PG8_SA(1, 0), cA + kstep, voffA); PG8_STAGE(PG8_SB(1, 1), cB + hstep + kstep, voffB);
        PG8_WAIT_V(6); PG8_BAR;
    } else {
        PG8_STAGE(PG8_SB(0, 0), cB, voffB); PG8_STAGE(PG8_SA(0, 0), cA, voffA); PG8_STAGE(PG8_SB(0, 1), cB + hstep, voffB); PG8_STAGE(PG8_SA(0, 1), cA + hstep, voffA);
        if (wr == 1) PG8_BAR;
        PG8_WAIT_V(4); PG8_BAR;
        PG8_STAGE(PG8_SB(1, 0), cB + kstep, voffB); PG8_STAGE(PG8_SA(1, 0), cA + kstep, voffA); PG8_STAGE(PG8_SB(1, 1), cB + hstep + kstep, voffB);
        PG8_WAIT_V(6); PG8_BAR;
    }
    for (;;) {
        const bool has_next = S.next(ui + 1, nxt);
        const char* nA = has_next ? (const char*)g.A + (size_t)nxt.pm * tstep : cA; const char* nB = has_next ? (const char*)g.Bt + (size_t)nxt.pn * tstep : cB;
#pragma nounroll
        for (int t = 0; t < nt; t += 2) {
            if constexpr (Epi::MID_T > 0) { if (t == Epi::MID_T) E.mid(acc, cur, wr, wc, fr, fq); }
            const bool last = (t == nt - 2);
            const char* a1 = cA + (size_t)(t + 1) * kstep;
            const char* a2 = last ? nA : cA + (size_t)(t + 2) * kstep; const char* b2 = last ? nB : cB + (size_t)(t + 2) * kstep;
            const char* a3 = a2 + kstep; const char* b3 = b2 + kstep;
            if (last && has_next) S.a_ready(nxt);
            if constexpr (SP2) {
            PG8_LDB(B0, 0, 0); PG8_LDB(B1, 0, 1); PG8_SCHED; PG8_LDA(At, 0, 0); PG8_STAGE(PG8_SA(1, 1), a1 + hstep, voffA);
            PG8_WAIT_V(8); PG8_WAIT_L(0); PG8_BAR; PG8_MMA(0, 0, At, B0); PG8_MMA(0, 1, At, B1); PG8_BAR; PG8_SCHED;
            PG8_LDA(At, 0, 1); PG8_STAGE(PG8_SB(0, 0), b2, voffB); PG8_STAGE(PG8_SB(0, 1), b2 + hstep, voffB); PG8_STAGE(PG8_SA(0, 0), a2, voffA);
            PG8_WAIT_V(8); PG8_WAIT_L(0); PG8_BAR; PG8_MMA(1, 0, At, B0); PG8_MMA(1, 1, At, B1); PG8_BAR; PG8_SCHED;
            PG8_LDB(B0, 1, 0); PG8_LDB(B1, 1, 1); PG8_SCHED; PG8_LDA(At, 1, 0); PG8_STAGE(PG8_SA(0, 1), a2 + hstep, voffA);
            PG8_WAIT_V(8); PG8_WAIT_L(0); PG8_BAR; PG8_MMA(0, 0, At, B0); PG8_MMA(0, 1, At, B1); PG8_BAR; PG8_SCHED;
            PG8_LDA(At, 1, 1); PG8_STAGE(PG8_SB(1, 0), b3, voffB); PG8_STAGE(PG8_SB(1, 1), b3 + hstep, voffB); PG8_STAGE(PG8_SA(1, 0), a3, voffA);
            PG8_WAIT_V(8); PG8_WAIT_L(0); PG8_BAR; PG8_MMA(1, 0, At, B0); PG8_MMA(1, 1, At, B1); PG8_BAR; PG8_SCHED;
            } else {
            PG8_LDB(B0, 0, 0); PG8_SCHED; PG8_LDA(At, 0, 0); PG8_STAGE(PG8_SA(1, 1), a1 + hstep, voffA);
            PG8_WAIT_L(8); PG8_BAR; PG8_WAIT_L(0); PG8_MMA(0, 0, At, B0); PG8_BAR; PG8_SCHED;
            PG8_LDB(B1, 0, 1); PG8_STAGE(PG8_SB(0, 0), b2, voffB);
            PG8_BAR; PG8_WAIT_L(0); PG8_MMA(0, 1, At, B1); PG8_BAR;
            PG8_LDA(At, 0, 1); PG8_STAGE(PG8_SA(0, 0), a2, voffA);
            PG8_BAR; PG8_WAIT_L(0); PG8_MMA(1, 0, At, B0); PG8_BAR; PG8_SCHED;
            PG8_STAGE(PG8_SB(0, 1), b2 + hstep, voffB);
            PG8_WAIT_V(6); PG8_BAR; PG8_MMA(1, 1, At, B1); PG8_BAR;
            PG8_LDB(B0, 1, 0); PG8_SCHED; PG8_LDA(At, 1, 0); PG8_STAGE(PG8_SA(0, 1), a2 + hstep, voffA);
            PG8_WAIT_L(8); PG8_BAR; PG8_WAIT_L(0); PG8_MMA(0, 0, At, B0); PG8_BAR; PG8_SCHED;
            PG8_LDB(B1, 1, 1); PG8_STAGE(PG8_SB(1, 0), b3, voffB);
            PG8_BAR; PG8_WAIT_L(0); PG8_MMA(0, 1, At, B1); PG8_BAR;
            PG8_LDA(At, 1, 1); PG8_STAGE(PG8_SA(1, 0), a3, voffA);
            PG8_BAR; PG8_WAIT_L(0); PG8_MMA(1, 0, At, B0); PG8_BAR; PG8_SCHED;
            PG8_STAGE(PG8_SB(1, 1), b3 + hstep, voffB);
            PG8_WAIT_V(6); PG8_BAR; PG8_MMA(1, 1, At, B1); PG8_BAR;
            }
        }
        if constexpr (FP8) asm volatile("s_nop 15\n\ts_nop 7" ::: "memory");
        if constexpr (ALIGN_EPI) { if (wr == 0) PG8_BAR; }
#ifdef MK_PROBE_EPI2
        if constexpr (!Epi::AFTER_DRAIN && Epi::PROBE_ID == MK_PROBE_EPI_ID) { for (int rep_ = 1; rep_ < MK_PROBE_EPI2; ++rep_) E(acc, cur, wr, wc, fr, fq); }
#endif
        if constexpr (!Epi::AFTER_DRAIN) { E(acc, cur, wr, wc, fr, fq); S.done(cur); }
        if (!has_next) break;
#pragma unroll
        for (int a = 0; a < 2; ++a)
#pragma unroll
            for (int b = 0; b < 2; ++b)
#pragma unroll
                for (int m = 0; m < 4; ++m)
#pragma unroll
                    for (int n = 0; n < 2; ++n) acc[a][b][m][n] = (f32x4){0.f, 0.f, 0.f, 0.f};
        cur = nxt; cA = nA; cB = nB; ++ui;
        if constexpr (ALIGN_EPI) { if (wr == 1) PG8_BAR; }
    }
    PG8_WAIT_V(0);
    if constexpr (!ALIGN_EPI) { if (wr == 0) PG8_BAR; }
    PG8_BAR;
    if constexpr (Epi::AFTER_DRAIN) { E.fused(acc, cur, wr, wc, fr, fq, lds, wid, lane); S.done(cur); }
#undef PG8_SA
#undef PG8_SB
#undef PG8_STAGE
#undef PG8_LDA
#undef PG8_LDB
#undef PG8_MMA
#undef PG8_WAIT_V
#undef PG8_WAIT_L
#undef PG8_BAR
#undef PG8_SCHED
}
}
#ifndef PG8_SP2
#define PG8_SP2 true
#endif
#ifndef PG8_ALIGN
#define PG8_ALIGN true
#endif
namespace attn_body {
using bf16=__hip_bfloat16;
using bf16x8=__attribute__((ext_vector_type(8)))short;
using s16x4=__attribute__((ext_vector_type(4)))short;
using f32x16=__attribute__((ext_vector_type(16)))float;
using u32x4=__attribute__((ext_vector_type(4)))unsigned;
using f32x4v=__attribute__((ext_vector_type(4)))float;
constexpr int BATCH=4,NHEAD=8,SEQ=4096,D=64,DM=NHEAD*D,DMO=1024;
constexpr int NW=8,QBLK=32,QB=QBLK*NW,KVBLK=64,NQB=SEQ/QB;
constexpr int ATTN_PITCH=DM, ATTN_UNIT_ROWS=QB;
__device__ __forceinline__ int crow(int r,int hi){return (r&3)+8*(r>>2)+4*hi;}
#define SBAR() __builtin_amdgcn_sched_barrier(0)
__device__ __forceinline__ void cmask(f32x16&p0,f32x16&p1,int jb,int qrel,int hi){
  const float NEG=-INFINITY; int kb=64*jb+4*hi;
  #pragma unroll
  for(int r=0;r<16;++r){int kv=kb+(r&3)+8*(r>>2); if(kv>qrel)p0[r]=NEG; if(kv+32>qrel)p1[r]=NEG;}
}

constexpr int NSLOT=3, SLOTB=8192;
constexpr float SKIP_TH=64.0f;
constexpr int LDS_K=0, LDS_V=NSLOT*SLOTB, LDS_WS=2*NSLOT*SLOTB, LDS_OST=LDS_WS+NW*64*4, LDS_CS=LDS_OST+NW*4096, LDS_BYTES=LDS_CS+SEQ*4+64;
constexpr float C2=0.125f*1.4426950408889634f;
__device__ __forceinline__ void glds16(const void*gsrc,unsigned lds_dst){unsigned keep;
  asm volatile("s_mov_b32 %0, m0\n\ts_mov_b32 m0, %2\n\ts_nop 0\n\tglobal_load_lds_dwordx4 %1, off\n\ts_mov_b32 m0, %0":"=&s"(keep):"v"(gsrc),"s"(lds_dst):"memory");}
__device__ __forceinline__ float max3f(float a,float b,float c){float r;asm("v_max3_f32 %0, %1, %2, %3":"=v"(r):"v"(a),"v"(b),"v"(c));return r;}
__device__ __forceinline__ float max2f(float a,float b){float r;asm("v_max_f32_e32 %0, %1, %2":"=v"(r):"v"(a),"v"(b));return r;}
__device__ __forceinline__ float fadd_s(float a,float b){float r;asm("v_add_f32_e32 %0, %1, %2":"=v"(r):"v"(a),"v"(b));return r;}
__device__ __forceinline__ float fsub_s(float a,float b){float r;asm("v_sub_f32_e32 %0, %1, %2":"=v"(r):"v"(a),"v"(b));return r;}
typedef float f32x2_t __attribute__((ext_vector_type(2))); typedef __bf16 bf16x2_t __attribute__((ext_vector_type(2)));
__device__ __forceinline__ unsigned cvtpk_s(float lo,float hi){f32x2_t v={lo,hi};bf16x2_t b=__builtin_convertvector(v,bf16x2_t);return __builtin_bit_cast(unsigned,b);}
#define WAIT_BAR(N) asm volatile("s_waitcnt vmcnt(" #N ") lgkmcnt(0)\n\ts_barrier":::"memory")

__device__ __forceinline__ void qkt(f32x16&p0,f32x16&p1,const char*Kslot,const bf16x8*qr,const f32x16&c0,const f32x16&c1,int r32,int hi){
  const char*kb=Kslot+hi*1024+r32*16;
  #pragma unroll
  for(int d0=0;d0<4;++d0){
    const bf16x8 b0=*reinterpret_cast<const bf16x8*>(kb+d0*2048);
    const bf16x8 b1=*reinterpret_cast<const bf16x8*>(kb+d0*2048+512);
    if(d0==0){p0=__builtin_amdgcn_mfma_f32_32x32x16_bf16(b0,qr[0],c0,0,0,0);p1=__builtin_amdgcn_mfma_f32_32x32x16_bf16(b1,qr[0],c1,0,0,0);}
    else{p0=__builtin_amdgcn_mfma_f32_32x32x16_bf16(b0,qr[d0],p0,0,0,0);p1=__builtin_amdgcn_mfma_f32_32x32x16_bf16(b1,qr[d0],p1,0,0,0);}}
}
typedef __attribute__((address_space(3))) const char* lds_cptr;
typedef short v4i16_t __attribute__((ext_vector_type(4)));
__device__ __forceinline__ void kload8(bf16x8*kf,lds_cptr kp){
  kf[0]=*(const __attribute__((address_space(3))) bf16x8*)(kp);      kf[1]=*(const __attribute__((address_space(3))) bf16x8*)(kp+512);
  kf[2]=*(const __attribute__((address_space(3))) bf16x8*)(kp+2048); kf[3]=*(const __attribute__((address_space(3))) bf16x8*)(kp+2560);
  kf[4]=*(const __attribute__((address_space(3))) bf16x8*)(kp+4096); kf[5]=*(const __attribute__((address_space(3))) bf16x8*)(kp+4608);
  kf[6]=*(const __attribute__((address_space(3))) bf16x8*)(kp+6144); kf[7]=*(const __attribute__((address_space(3))) bf16x8*)(kp+6656);
}
__device__ __forceinline__ void kload2(bf16x8*kf,lds_cptr kp,int j){ kf[2*j]=*(const __attribute__((address_space(3))) bf16x8*)(kp+j*2048); kf[2*j+1]=*(const __attribute__((address_space(3))) bf16x8*)(kp+j*2048+512); }
__device__ __forceinline__ s16x4 vtr(lds_cptr p){ return __builtin_bit_cast(s16x4,__builtin_amdgcn_ds_read_tr16_b64_v4i16((__attribute__((address_space(3))) v4i16_t*)p)); }
__device__ __forceinline__ float rowmax(const f32x16&p0,const f32x16&p1){
  float a=max3f(p0[0],p0[1],p1[0]),b=max3f(p0[2],p0[3],p1[1]);a=max3f(a,p1[2],p1[3]);
  #pragma unroll
  for(int r=4;r<16;r+=4){a=max3f(a,p0[r],p0[r+1]);b=max3f(b,p0[r+2],p0[r+3]);a=max3f(a,p1[r],p1[r+1]);b=max3f(b,p1[r+2],p1[r+3]);}
  const float m=max2f(a,b);
  auto rr=__builtin_amdgcn_permlane32_swap(__float_as_uint(m),__float_as_uint(m),false,false);
  return max2f(__uint_as_float(rr[0]),__uint_as_float(rr[1]));
}
__device__ __forceinline__ void pv(f32x16*o,int vb,bf16x8 pa0,bf16x8 pa1,bf16x8 pa2,bf16x8 pa3){
  #pragma unroll
  for(int d0=0;d0<2;++d0){s16x4 lo[4],hi[4];
    #pragma unroll
    for(int ks=0;ks<4;++ks){
      asm volatile("ds_read_b64_tr_b16 %0,%1 offset:%c2":"=&v"(lo[ks]):"v"(vb),"i"(d0*4096+ks*1024):"memory");
      asm volatile("ds_read_b64_tr_b16 %0,%1 offset:%c2":"=&v"(hi[ks]):"v"(vb),"i"(d0*4096+ks*1024+512):"memory");}
    asm volatile("s_waitcnt lgkmcnt(0)":::"memory");SBAR();
    #define PK(k) (bf16x8){lo[k][0],lo[k][1],lo[k][2],lo[k][3],hi[k][0],hi[k][1],hi[k][2],hi[k][3]}
    o[d0]=__builtin_amdgcn_mfma_f32_32x32x16_bf16(pa0,PK(0),o[d0],0,0,0);
    o[d0]=__builtin_amdgcn_mfma_f32_32x32x16_bf16(pa1,PK(1),o[d0],0,0,0);
    o[d0]=__builtin_amdgcn_mfma_f32_32x32x16_bf16(pa2,PK(2),o[d0],0,0,0);
    o[d0]=__builtin_amdgcn_mfma_f32_32x32x16_bf16(pa3,PK(3),o[d0],0,0,0);
    #undef PK
  }
}

#ifndef ATTN_STORE16
#define ATTN_STORE16(p,v) (*(u32x4*)(p)=(v))
#endif
template<int THRL> __device__ __forceinline__ void attn_unit(int b,int h,int qb,const bf16*Q,const bf16*__restrict__ K,const bf16*__restrict__ V,bf16*O,const float*__restrict__ LFrow,char*shm){
  int tid_l=threadIdx.x; asm volatile("":"+v"(tid_l));
  const int tid=tid_l,lane=tid&63,r32=lane&31,hi=lane>>5; const int wid=__builtin_amdgcn_readfirstlane(tid>>6);
  const long rowbase=(long)b*SEQ; const int q0=qb*QB;
  const lds_cptr shm3=(lds_cptr)shm;
  typedef __attribute__((address_space(3))) float lds_f32; typedef __attribute__((address_space(3))) f32x4v lds_f32x4;
  lds_f32* const csl=(lds_f32*)(shm3+LDS_CS);
  { const int ncs=q0+QB, i0=tid*8; f32x4v ca={0.f,0.f,0.f,0.f},cb={0.f,0.f,0.f,0.f};
    if(i0<ncs){ca=*(const f32x4v*)(LFrow+i0);cb=*(const f32x4v*)(LFrow+i0+4);}
    ca.y+=ca.x;ca.z+=ca.y;ca.w+=ca.z;cb.x+=ca.w;cb.y+=cb.x;cb.z+=cb.y;cb.w+=cb.z;
    const float tot=cb.w; float inc=tot;
    _Pragma("unroll") for(int o_=1;o_<64;o_<<=1){const float v_=__shfl_up(inc,o_);if(lane>=o_)inc+=v_;}
    if(lane==63)csl[SEQ+wid]=inc;
    asm volatile("s_waitcnt vmcnt(0) lgkmcnt(0)\n\ts_barrier":::"memory");
    float base_=inc-tot;
    _Pragma("unroll") for(int w_=0;w_<NW;++w_){const float t_=csl[SEQ+w_];if(w_<wid)base_+=t_;}
    if(i0<ncs){*(lds_f32x4*)(csl+i0)=ca+base_;*(lds_f32x4*)(csl+i0+4)=cb+base_;}
    asm volatile("s_waitcnt vmcnt(0) lgkmcnt(0)\n\ts_barrier":::"memory"); }
  int ts; { const int NT0=(q0+QB)/KVBLK, cand=2*lane; bool ok=false;
    if(lane<32&&cand<=NT0-4) ok=(cand==0)||(csl[q0]-csl[64*cand-1]<=-SKIP_TH);
    const unsigned long long mk=__ballot(ok); ts=__builtin_amdgcn_readfirstlane(2*(63-__builtin_clzll(mk|1ull))); }
  const bf16*Qw=Q+(rowbase+q0+wid*QBLK)*DM+h*D;
  const bf16*Kh=K+(rowbase+(long)ts*KVBLK)*DM+h*D,*Vh=V+(rowbase+(long)ts*KVBLK)*DM+h*D;
  const unsigned lds0=(unsigned)(uintptr_t)shm;
  float*wsf=(float*)(shm+LDS_WS)+wid*64;
  const bf16*ksrc=Kh+(long)lane*DM+wid*8;
  const bf16*vsrc=Vh+(long)(16*(wid&3)+(lane>>2))*DM+(wid>>2)*32+(lane&3)*8;
  const unsigned kdst=lds0+LDS_K+wid*1024, vdst=lds0+LDS_V+wid*1024;
  #define DMA_K(t,slot) glds16(ksrc+(long)(t)*KVBLK*DM,(unsigned)__builtin_amdgcn_readfirstlane(kdst+(slot)))
  #define DMA_V(t,slot) glds16(vsrc+(long)(t)*KVBLK*DM,(unsigned)__builtin_amdgcn_readfirstlane(vdst+(slot)))
  const int vb0=(int)(lds0+LDS_V)+((lane>>4)&1)*32+(lane&3)*8+(4*hi+((lane&15)>>2))*64;
  const char*Kbase=shm+LDS_K; bf16x8 kf[8];
  const lds_cptr kp0=shm3+LDS_K+hi*1024+r32*16; const lds_cptr vp0=shm3+LDS_V+((lane>>4)&1)*32+(lane&3)*8+(4*hi+((lane&15)>>2))*64;
  const int NT=(q0+QB)/KVBLK-ts;
  const float cq=csl[q0+wid*QBLK+r32];
  const lds_cptr csb=shm3+LDS_CS+hi*16+ts*256;
  #define CINIT(C0,C1,t) do{ _Pragma("unroll") for(int g_=0;g_<4;++g_){ const f32x4v a_=*(const lds_f32x4*)(csb+(t)*256+g_*32), b_=*(const lds_f32x4*)(csb+(t)*256+128+g_*32); \
      C0[4*g_]=cqm-a_.x;C0[4*g_+1]=cqm-a_.y;C0[4*g_+2]=cqm-a_.z;C0[4*g_+3]=cqm-a_.w; C1[4*g_]=cqm-b_.x;C1[4*g_+1]=cqm-b_.y;C1[4*g_+2]=cqm-b_.z;C1[4*g_+3]=cqm-b_.w; } }while(0)
  DMA_K(0,0);DMA_V(0,0);DMA_K(1,SLOTB);
  bf16x8 qr[4];
  #pragma unroll
  for(int d0=0;d0<4;++d0)qr[d0]=*reinterpret_cast<const bf16x8*>(&Qw[(long)r32*DM+d0*16+hi*8]);
  float mhat=0.f,l_reg=0.f,cqm=cq;f32x16 o[2];o[0]=f32x16{};o[1]=f32x16{};
  const int qrel=wid*QBLK+r32;
  #define CMASK(P0,P1,t) do{int jb_=(t)-(NT-4); if(jb_>=0)cmask(P0,P1,jb_,qrel,hi);}while(0)
  bool resc=false;
  #define START(P0,P1) do{ const float rm=rowmax(P0,P1); resc=false; \
    { const float dl=rm; mhat=fadd_s(mhat,dl); \
      _Pragma("unroll") for(int r=0;r<16;++r){P0[r]=fsub_s(P0[r],dl);P1[r]=fsub_s(P1[r],dl);} \
      cqm=cq-mhat; } \
    _Pragma("unroll") for(int r=0;r<16;++r)P0[r]=__builtin_amdgcn_exp2f(P0[r]); }while(0)
  #define RESC() do{ if(resc){ asm volatile("s_waitcnt lgkmcnt(0)":::"memory"); \
      _Pragma("unroll") for(int d_=0;d_<2;++d_) _Pragma("unroll") for(int r=0;r<16;++r)o[d_][r]*=wsf[crow(r,hi)]; } }while(0)
  f32x16 pA0,pA1,pB0,pB1;
  int sl_prev=0,sl_cur=0,sl_next=SLOTB;
  #define ROT() do{sl_prev=sl_cur;sl_cur=sl_next;sl_next=(sl_next==(NSLOT-1)*SLOTB)?0:sl_next+SLOTB;}while(0)
  DMA_K(2,2*SLOTB);
  WAIT_BAR(3);
  { f32x16 ci0,ci1; CINIT(ci0,ci1,0); qkt(pA0,pA1,Kbase,qr,ci0,ci1,r32,hi); } asm volatile("s_nop 15\n\ts_nop 7":"+v"(pA0),"+v"(pA1));CMASK(pA0,pA1,0);
  START(pA0,pA1);
  _Pragma("unroll") for(int r=0;r<16;++r)pA1[r]=__builtin_amdgcn_exp2f(pA1[r]);
  WAIT_BAR(0);
  DMA_K(3,0);DMA_V(1,SLOTB);
  ROT();
  kload8(kf,kp0+sl_cur);
  WAIT_BAR(2);
  s16x4 vlo[8],vhi[8]; u32x4 pw0,pw1,pw2,pw3;
  #define PKW(P,B) cvtpk_s(P[B],P[B+1])
  #define PAF(k) __builtin_bit_cast(bf16x8,pw##k)
  #define VFR(i) (bf16x8){vlo[i][0],vlo[i][1],vlo[i][2],vlo[i][3],vhi[i][0],vhi[i][1],vhi[i][2],vhi[i][3]}
  #define PIN(x) asm volatile("":"+v"(x))
  #define MX3(a,b,c) __builtin_fmaxf(__builtin_fmaxf((a),(b)),(c))
  #define GAPA(MF,A0,A1,A2,A3,W0,W1,PW) do{ MF; sacc+=A0; sacc+=A1; sacc+=A2; sacc+=A3; PIN(sacc); W0; W1; PIN(PW); SBAR(); }while(0)
  #define EX(v) __builtin_amdgcn_exp2f(v)
  #define GAPB(MF,X,B) do{ MF; X[B]=EX(X[B]); X[B+1]=EX(X[B+1]); X[B+2]=EX(X[B+2]); X[B+3]=EX(X[B+3]); PIN(X); SBAR(); }while(0)
  #define VRD(i) do{ vlo[i]=vtr(vp_+(((i)>>2)*4096+((i)&3)*1024)); vhi[i]=vtr(vp_+(((i)>>2)*4096+((i)&3)*1024+512)); }while(0)
  #define KRD(G,j) do{ if(G){ kload2(kf,kp0+sl_next,j); SBAR(); } }while(0)
  #define STEP(C0,C1,P0,P1,t,GK,GV,GL) do{ SBAR(); \
    CINIT(C0,C1,t); SBAR(); \
    const lds_cptr vp_=vp0+sl_prev; \
    VRD(0); SBAR(); float sacc=(P0[0]+P0[1]); \
    GAPA(C0=__builtin_amdgcn_mfma_f32_32x32x16_bf16(kf[0],qr[0],C0,0,0,0), P0[2],P0[3],P0[4],P0[5],     pw0[0]=PKW(P0,0), pw0[1]=PKW(P0,2), pw0); \
    VRD(4); SBAR(); GAPA(C1=__builtin_amdgcn_mfma_f32_32x32x16_bf16(kf[1],qr[0],C1,0,0,0), P0[6],P0[7],P0[8],P0[9],     pw0[2]=PKW(P0,4), pw0[3]=PKW(P0,6), pw0); \
    VRD(1); SBAR(); GAPA(C0=__builtin_amdgcn_mfma_f32_32x32x16_bf16(kf[2],qr[1],C0,0,0,0),   P0[10],P0[11],P0[12],P0[13], pw1[0]=PKW(P0,8), pw1[1]=PKW(P0,10), pw1); \
    VRD(5); SBAR(); GAPA(C1=__builtin_amdgcn_mfma_f32_32x32x16_bf16(kf[3],qr[1],C1,0,0,0),   P0[14],P0[15],P1[0],P1[1],   pw1[2]=PKW(P0,12),pw1[3]=PKW(P0,14), pw1); \
    VRD(2); SBAR(); GAPA(C0=__builtin_amdgcn_mfma_f32_32x32x16_bf16(kf[4],qr[2],C0,0,0,0),   P1[2],P1[3],P1[4],P1[5],     pw2[0]=PKW(P1,0), pw2[1]=PKW(P1,2), pw2); \
    VRD(6); SBAR(); GAPA(C1=__builtin_amdgcn_mfma_f32_32x32x16_bf16(kf[5],qr[2],C1,0,0,0),   P1[6],P1[7],P1[8],P1[9],     pw2[2]=PKW(P1,4), pw2[3]=PKW(P1,6), pw2); \
    VRD(3); SBAR(); GAPA(C0=__builtin_amdgcn_mfma_f32_32x32x16_bf16(kf[6],qr[3],C0,0,0,0),   P1[10],P1[11],P1[12],P1[13], pw3[0]=PKW(P1,8), pw3[1]=PKW(P1,10), pw3); \
    VRD(7); SBAR(); GAPA(C1=__builtin_amdgcn_mfma_f32_32x32x16_bf16(kf[7],qr[3],C1,0,0,0),   P1[14],P1[15],0.f,0.f,       pw3[2]=PKW(P1,12),pw3[3]=PKW(P1,14), pw3); \
    l_reg+=sacc; \
    if(GK){DMA_K((t)+3,sl_cur);} if(GV){DMA_V((t)+1,sl_next);} \
    CMASK(C0,C1,t); \
    { float a=MX3(C0[0],C0[1],C1[0]),b=MX3(C0[2],C0[3],C1[1]); a=MX3(a,C1[2],C1[3]); \
      _Pragma("unroll") for(int r=4;r<16;r+=4){a=MX3(a,C0[r],C0[r+1]);b=MX3(b,C0[r+2],C0[r+3]);a=MX3(a,C1[r],C1[r+1]);b=MX3(b,C1[r+2],C1[r+3]);} \
      float rm=__builtin_fmaxf(a,b); { auto rr=__builtin_amdgcn_permlane32_swap(__float_as_uint(rm),__float_as_uint(rm),false,false); rm=__builtin_fmaxf(__uint_as_float(rr[0]),__uint_as_float(rr[1])); } \
      resc=false; \
      if(__builtin_expect(__any(rm>(float)THRL),0)){ const float dl=__builtin_fmaxf(rm,0.f); mhat+=dl; \
        _Pragma("unroll") for(int r=0;r<16;++r){C0[r]-=dl;C1[r]-=dl;} \
        cqm=cq-mhat; \
        const float f=__builtin_amdgcn_exp2f(-dl); l_reg*=f; if(hi==0)wsf[r32]=f; resc=true; } } \
    SBAR(); \
    GAPB(o[0]=__builtin_amdgcn_mfma_f32_32x32x16_bf16(PAF(0),VFR(0),o[0],0,0,0), C0,0); \
    GAPB(o[1]=__builtin_amdgcn_mfma_f32_32x32x16_bf16(PAF(0),VFR(4),o[1],0,0,0), C0,4); \
    KRD(GL,0); GAPB(o[0]=__builtin_amdgcn_mfma_f32_32x32x16_bf16(PAF(1),VFR(1),o[0],0,0,0), C0,8); \
    KRD(GL,1); GAPB(o[1]=__builtin_amdgcn_mfma_f32_32x32x16_bf16(PAF(1),VFR(5),o[1],0,0,0), C0,12); \
    KRD(GL,2); GAPB(o[0]=__builtin_amdgcn_mfma_f32_32x32x16_bf16(PAF(2),VFR(2),o[0],0,0,0), C1,0); \
    KRD(GL,3); GAPB(o[1]=__builtin_amdgcn_mfma_f32_32x32x16_bf16(PAF(2),VFR(6),o[1],0,0,0), C1,4); \
    GAPB(o[0]=__builtin_amdgcn_mfma_f32_32x32x16_bf16(PAF(3),VFR(3),o[0],0,0,0), C1,8); \
    GAPB(o[1]=__builtin_amdgcn_mfma_f32_32x32x16_bf16(PAF(3),VFR(7),o[1],0,0,0), C1,12); \
    }while(0)
  int t=1;
  #undef CMASK
  #define CMASK(P0,P1,t) do{}while(0)
  for(;t+5<NT;t+=2){
    STEP(pB0,pB1,pA0,pA1,t,true,true,true);     WAIT_BAR(2); RESC(); ROT();
    STEP(pA0,pA1,pB0,pB1,t+1,true,true,true);   WAIT_BAR(2); RESC(); ROT();
  }
  #undef CMASK
  #define CMASK(P0,P1,t) do{int jb_=(t)-(NT-4); if(jb_>=0)cmask(P0,P1,jb_,qrel,hi);}while(0)
  #define ENDW(tt) do{ if((tt)+3<NT){WAIT_BAR(2);} else if((tt)+2<NT){WAIT_BAR(1);} else {WAIT_BAR(0);} }while(0)
  for(;t+1<NT;t+=2){
    STEP(pB0,pB1,pA0,pA1,t,(t+3<NT),(t+1<NT),(t+1<NT));       ENDW(t);   RESC(); ROT();
    STEP(pA0,pA1,pB0,pB1,t+1,(t+4<NT),(t+2<NT),(t+2<NT));     ENDW(t+1); RESC(); ROT();
  }
  STEP(pB0,pB1,pA0,pA1,NT-1,false,false,false); RESC();
  { float sacc=pB0[0]+pB0[1]; _Pragma("unroll") for(int r=2;r<16;++r)sacc+=pB0[r]; _Pragma("unroll") for(int r=0;r<16;++r)sacc+=pB1[r]; l_reg+=sacc;
    pw0=(u32x4){PKW(pB0,0),PKW(pB0,2),PKW(pB0,4),PKW(pB0,6)};pw1=(u32x4){PKW(pB0,8),PKW(pB0,10),PKW(pB0,12),PKW(pB0,14)};pw2=(u32x4){PKW(pB1,0),PKW(pB1,2),PKW(pB1,4),PKW(pB1,6)};pw3=(u32x4){PKW(pB1,8),PKW(pB1,10),PKW(pB1,12),PKW(pB1,14)};
    SBAR(); pv(o,vb0+sl_cur,PAF(0),PAF(1),PAF(2),PAF(3)); }
  #undef PKW
  #undef PAF
  #undef VFR
  #undef PIN
  #undef MX3
  #undef GAPA
  #undef GAPB
  #undef EX
  #undef VRD
  #undef KRD
  #undef STEP
  #undef ENDW
  {auto rr=__builtin_amdgcn_permlane32_swap(__float_as_uint(l_reg),__float_as_uint(l_reg),false,false);l_reg=__uint_as_float(rr[0])+__uint_as_float(rr[1]);}
  if(hi==0)wsf[32+r32]=l_reg;asm volatile("s_waitcnt lgkmcnt(0)":::"memory");
  float rli[16];
  #pragma unroll
  for(int r=0;r<16;++r)rli[r]=__builtin_amdgcn_rcpf(wsf[32+crow(r,hi)]);
  bf16*Ow=O+(rowbase+q0+wid*QBLK)*DMO+h*D;
  { bf16*stg=(bf16*)(shm+LDS_OST)+wid*2048;
    #pragma unroll
    for(int r=0;r<16;++r){const int orow=crow(r,hi);
      #pragma unroll
      for(int d0=0;d0<2;++d0)stg[orow*64+d0*32+r32]=__float2bfloat16(o[d0][r]*rli[r]);}
    asm volatile("s_waitcnt lgkmcnt(0)":::"memory");
    #pragma unroll
    for(int i=0;i<4;++i){const int row=i*8+(lane>>3),ch=lane&7; const u32x4 v=*(const u32x4*)(stg+row*64+ch*8); ATTN_STORE16(Ow+(long)row*DMO+ch*8,v);} }
  asm volatile("s_waitcnt lgkmcnt(0)\n\ts_barrier":::"memory");
  #undef DMA_K
  #undef DMA_V
  #undef CMASK
  #undef START
  #undef RESC
  #undef ROT
  #undef CINIT
}
constexpr int ATTN_LDS_BYTES=LDS_BYTES;
struct AttnTensors { const bf16* Q; const bf16* K; const bf16* V; bf16* O; const float* LF; };
struct AttnUnit { int bh; int qb; };
struct StaticOrder {
  int vcu, G;
  __device__ __forceinline__ StaticOrder(int grid,int vcu_):vcu(vcu_),G(grid){}
  __device__ __forceinline__ bool next(int i,AttnUnit&u)const{
    if(G==256){ if(i>=2)return false; const int s=vcu&7; u.bh=vcu>>3; u.qb=(i==0)?15-s:s; return true; }
    const int idx=i*G+vcu; if(idx>=BATCH*NHEAD*NQB)return false; u.qb=NQB-1-idx/(BATCH*NHEAD); u.bh=idx%(BATCH*NHEAD); return true; }
  __device__ __forceinline__ void a_ready(const AttnUnit&)const{}
  __device__ __forceinline__ void done(const AttnUnit&)const{}
};
template<class Sched,int THRL=8> __device__ __forceinline__ void attn_phase(char*lds,const AttnTensors&T,const Sched&S){
  AttnUnit u;
  for(int i=0;S.next(i,u);++i){ S.a_ready(u); attn_unit<THRL>(u.bh/NHEAD,u.bh%NHEAD,u.qb,T.Q,T.K,T.V,T.O,T.LF+(size_t)u.bh*SEQ,lds); S.done(u); }
}
#undef SBAR
#undef WAIT_BAR
}
#define GAS __attribute__((address_space(1)))
#define LAS __attribute__((address_space(3)))
typedef unsigned short bf16;
typedef unsigned v4u __attribute__((ext_vector_type(4)));
typedef float f32x4 __attribute__((ext_vector_type(4)));
typedef short bf16x8 __attribute__((ext_vector_type(8)));
typedef GAS unsigned gu32;
typedef GAS unsigned long long gu64;
#define RLX_AGENT __ATOMIC_RELAXED, __HIP_MEMORY_SCOPE_AGENT
#define LDS_WAIT() asm volatile("s_waitcnt lgkmcnt(0)" ::: "memory")
#define VM_WAIT() asm volatile("s_waitcnt vmcnt(0)" ::: "memory")
__device__ __forceinline__ unsigned long long rt() { return __builtin_amdgcn_s_memrealtime(); }
__device__ __forceinline__ unsigned f2bf(float f) { unsigned u = __builtin_bit_cast(unsigned, f); return (u + 0x7fffu + ((u >> 16) & 1u)) >> 16; }
__device__ __forceinline__ unsigned pk2(float lo, float hi) { return f2bf(lo) | (f2bf(hi) << 16); }

#define XB_TMO      128
#define XB_XCNT(j)  (256  + 64 * (j))
#define XB_XSUB(j)  (1280 + 64 * (j))
#define XB_XGEN(j)  (2304 + 64 * (j))
#define XB_TOP      3328
#define XB_TOPGEN   3392
#define XCD_BAR_WORDS 3456
#define XB_SPIN_CAP (1u << 18)

__device__ __forceinline__ unsigned xb_ld(unsigned* p)              { return __hip_atomic_load(p, __ATOMIC_RELAXED, __HIP_MEMORY_SCOPE_AGENT); }
__device__ __forceinline__ unsigned xb_add(unsigned* p, unsigned v) { return __hip_atomic_fetch_add(p, v, __ATOMIC_RELAXED, __HIP_MEMORY_SCOPE_AGENT); }
__device__ __forceinline__ unsigned xb_xcc_id() { return (unsigned)__builtin_amdgcn_s_getreg((3 << 11) | 20) & 0xFu; }
#define XB_SPIN(cond, bar) do { unsigned _sp = 0; while (cond) { __builtin_amdgcn_s_sleep(1); \
    if ((++_sp & 255u) == 0u) { if (xb_ld(&(bar)[XB_TMO])) break; if (_sp > XB_SPIN_CAP) { atomicAdd(&(bar)[XB_TMO], 1u); break; } } } } while (0)

struct XcdBarrier {
    unsigned* bar; unsigned x;
    volatile LAS unsigned* st;
};

__device__ __forceinline__ XcdBarrier xcd_barrier_post(unsigned* bar, volatile LAS unsigned* st) {
    XcdBarrier b; b.bar = bar; b.x = xb_xcc_id(); b.st = st;
    if (threadIdx.x == 0) (void)xb_add(&bar[XB_XCNT(b.x)], 1u);
    return b;
}
__device__ __forceinline__ void xcd_barrier_complete(unsigned* bar, unsigned x, unsigned& nloc, unsigned& nx) {
    const unsigned G = gridDim.x * gridDim.y * gridDim.z;
    unsigned sum, cnt, mine, sp = 0u;
    for (;;) {
        sum = 0u; cnt = 0u; mine = 0u;
#pragma unroll
        for (unsigned j = 0; j < 16; ++j) { const unsigned c = xb_ld(&bar[XB_XCNT(j)]); sum += c; cnt += (c > 0u) ? 1u : 0u; mine = (j == x) ? c : mine; }
        if (sum == G) break;
        __builtin_amdgcn_s_sleep(1);
        if ((++sp & 255u) == 0u) { if (xb_ld(&bar[XB_TMO])) break; if (sp > XB_SPIN_CAP) { atomicAdd(&bar[XB_TMO], 1u); break; } }
    }
    nloc = mine > 0u ? mine : 1u; nx = cnt > 0u ? cnt : 1u;
}

__device__ __forceinline__ void xcd_barrier(const XcdBarrier& b) {
    asm volatile("s_waitcnt vmcnt(0)" ::: "memory");
    __syncthreads();
    if (threadIdx.x == 0) {
        unsigned* bar = b.bar;
        __builtin_amdgcn_s_waitcnt(0);
        unsigned nloc = b.st[0], nx = b.st[1];
        if (nloc == 0u) { xcd_barrier_complete(bar, b.x, nloc, nx); b.st[0] = nloc; b.st[1] = nx; }
        const unsigned old = xb_add(&bar[XB_XSUB(b.x)], 1u);
        const unsigned gen = old / nloc;
        if (old + 1u == (gen + 1u) * nloc) {
            __builtin_amdgcn_fence(__ATOMIC_RELEASE, "agent");
            asm volatile("s_waitcnt vmcnt(0)" ::: "memory");
            const unsigned og = xb_add(&bar[XB_TOP], 1u);
            const unsigned tg = og / nx;
            if (og + 1u == (tg + 1u) * nx) xb_add(&bar[XB_TOPGEN], 1u);
            else XB_SPIN(xb_ld(&bar[XB_TOPGEN]) == tg, bar);
            __builtin_amdgcn_fence(__ATOMIC_ACQUIRE, "agent");
            xb_add(&bar[XB_XGEN(b.x)], 1u);
            asm volatile("s_waitcnt vmcnt(0)" ::: "memory");
        } else {
            XB_SPIN(xb_ld(&bar[XB_XGEN(b.x)]) == gen, bar);
            __builtin_amdgcn_fence(__ATOMIC_ACQUIRE, "agent");
            asm volatile("s_waitcnt vmcnt(0)" ::: "memory");
        }
    }
    __syncthreads();
}

constexpr int NWAVES = 8;
constexpr int BATCH = 4, SEQ = 4096, D = 1024, M = BATCH * SEQ, NH = 8, HD = 64, AW = 512, PLE = 256;
constexpr int NIN = 5120, INTOT = 5128, NKEYS = 128, NEXP = 16384, NS = 2048;
constexpr float EPS = 1e-6f, LOG2E = 1.4426950408889634f, C2 = 0.125f * LOG2E;
constexpr int NPHASE = 9;
constexpr int SLW = 128, NSL = D / SLW;
static_assert(NSL == 8, "one slice per XCD group; SS3 has 16 slots");
constexpr int SL4 = 256, NSL4 = D / SL4;
constexpr float Q4_STEP = 0.3352f;

constexpr size_t MiB = 1u << 20;
constexpr size_t WS_CTL = 0, CTL_ZERO_BYTES = 64 * 1024;
constexpr size_t WS_RSTD1 = 1 * MiB, WS_RSTD3 = WS_RSTD1 + 65536, WS_LF = WS_RSTD3 + 65536, WS_CS = WS_LF + 524288, WS_SS2 = WS_CS + 524288, WS_WPP = WS_SS2 + 1048576;
constexpr size_t WS_WQ8 = 20 * MiB, WS_SW = WS_RSTD1;
constexpr size_t WS_SU = WS_RSTD3, WS_SV = WS_WPP + 524288;
constexpr size_t WS_SW2 = WS_SV + 65536;
static_assert(WS_SW2 + 131072 <= 4 * MiB, "small region");
constexpr size_t WS_WIN = 4 * MiB, WS_WBR = 14 * MiB, WS_WOUT = 16 * MiB, WS_WS = 18 * MiB, WS_WPG = 22 * MiB, WS_PB = 24 * MiB;
constexpr size_t WS_UB = 32 * MiB, WS_VB = 48 * MiB;
constexpr size_t WS_AC = 64 * MiB;
constexpr size_t WS_A = 96 * MiB;
constexpr size_t WS_PP = 128 * MiB;
constexpr size_t WS_Q = 160 * MiB, WS_K = 176 * MiB, WS_V = 192 * MiB, WS_GB = 208 * MiB, WS_Z = 224 * MiB;
constexpr size_t WS_MERGED = 160 * MiB, WS_XB2 = 192 * MiB, WS_IDS = 224 * MiB, WS_GATES = 232 * MiB;
constexpr size_t WS_XB3 = 64 * MiB, WS_SS4 = WS_LF;
constexpr size_t WS_XB2_8 = 240 * MiB;
constexpr size_t WS_XB8 = 240 * MiB, WS_WIN8 = 10 * MiB;
constexpr size_t WS_END = 256 * MiB;
constexpr size_t WS_PART0 = 4 * MiB, WS_PART1 = 160 * MiB, WS_PART2 = 240 * MiB;
constexpr size_t WS_TGC = 32 * MiB, WS_TXC = 64 * MiB, WS_SC = 32 * MiB;
constexpr int CW_BAR = 1024;

constexpr int RING_OFF = 0, RING_BYTES = 135168;
constexpr int LDSCTL_OFF = RING_BYTES, MISC_OFF = LDSCTL_OFF + 320;
constexpr int LDS_BYTES = RING_BYTES + 1024;
static_assert(attn_body::ATTN_LDS_BYTES <= RING_BYTES && pg8::STAGE_BYTES <= RING_BYTES && 128 * pg8::EpiTopK::RS * 4 <= RING_BYTES, "LDS map");

typedef unsigned u32x4 __attribute__((ext_vector_type(4)));
typedef unsigned u32x2 __attribute__((ext_vector_type(2)));
typedef float f32x2 __attribute__((ext_vector_type(2)));
__device__ __forceinline__ float bf2f(bf16 v) { return __uint_as_float((unsigned)v << 16); }
__device__ __forceinline__ float wave_sum(float v) {
#pragma unroll
    for (int o = 1; o < 64; o <<= 1) v += __shfl_xor(v, o);
    return v;
}
__device__ __forceinline__ float sigmoidf_(float v) { return 1.0f / (1.0f + __expf(-v)); }
__host__ __device__ __forceinline__ int src_in(int n) {
    const int pn = n >> 8, l = n & 255;
    if (pn < 6) return n;
    if (pn < 8) return 1544 + (n - 1536);
    if (pn < 12) { const int j = pn - 8; return (l < 128) ? 2056 + 128 * j + l : 2568 + 128 * j + (l - 128); }
    { const int j = pn - 12; return (l < 128) ? 3080 + 128 * j + l : 4104 + 128 * j + (l - 128); }
}

struct Args { const float* in[18]; float* out; unsigned char* ws; int ph_lo, ph_hi, li, pad; };
struct Ctx {
    LAS unsigned char* lds; int wave, vcu, G;
    __device__ __forceinline__ int tid_() const { return (int)threadIdx.x; }
    __device__ __forceinline__ int lane_() const { return (int)threadIdx.x & 63; }
};

struct TrItem { const float* W; const float* g; bf16* WT; int ldw, k0, scol0, ldt, drow0, dk0; int fp8; };
__device__ __forceinline__ void tr_load(const TrItem& I, float (&tv)[32], int lane) {
#pragma unroll
    for (int i = 0; i < 32; ++i) { const int kk = 2 * i + (lane >> 5); tv[i] = I.W[(size_t)(I.k0 + kk) * I.ldw + I.scol0 + (lane & 31)]; }
}
__device__ __forceinline__ void tr_finish(const TrItem& I, const float (&tv)[32], LAS float* scr, int lane) {
#pragma unroll
    for (int i = 0; i < 32; ++i) { const int kk = 2 * i + (lane >> 5); float v = tv[i]; if (I.g) v *= I.g[I.k0 + kk]; scr[kk * 33 + (lane & 31)] = v; }
    LDS_WAIT(); asm volatile("" ::: "memory");
    const int c = lane & 7;
    if (I.fp8) {
#pragma unroll
        for (int j = 0; j < 4; ++j) { const int n = (lane >> 3) + 8 * j; const LAS float* s = scr + (8 * c) * 33 + n;
            u32x2 o; o.x = (unsigned)__builtin_amdgcn_cvt_pk_fp8_f32(s[0 * 33] * 32.f, s[1 * 33] * 32.f, 0, false); o.x = (unsigned)__builtin_amdgcn_cvt_pk_fp8_f32(s[2 * 33] * 32.f, s[3 * 33] * 32.f, (int)o.x, true);
            o.y = (unsigned)__builtin_amdgcn_cvt_pk_fp8_f32(s[4 * 33] * 32.f, s[5 * 33] * 32.f, 0, false); o.y = (unsigned)__builtin_amdgcn_cvt_pk_fp8_f32(s[6 * 33] * 32.f, s[7 * 33] * 32.f, (int)o.y, true);
            *(GAS u32x2*)((unsigned char*)I.WT + (size_t)(I.drow0 + n) * I.ldt + I.dk0 + 8 * c) = o; }
    } else {
#pragma unroll
        for (int j = 0; j < 4; ++j) { const int n = (lane >> 3) + 8 * j; const LAS float* s = scr + (8 * c) * 33 + n;
            v4u o; o.x = pk2(s[0 * 33], s[1 * 33]); o.y = pk2(s[2 * 33], s[3 * 33]); o.z = pk2(s[4 * 33], s[5 * 33]); o.w = pk2(s[6 * 33], s[7 * 33]);
            *(GAS v4u*)(I.WT + (size_t)(I.drow0 + n) * I.ldt + I.dk0 + 8 * c) = o; }
    }
    LDS_WAIT(); asm volatile("" ::: "memory");
}
constexpr int TR_IN = 16 * 160, TR_PP = 4 * 32, TR_BR = 8 * 32, TR_SQ = 16 * 32;
constexpr int TR_P0 = TR_IN + TR_PP;
constexpr int TR_LATE = 2 * TR_BR + 2 * TR_SQ;
__device__ __forceinline__ TrItem tr_decode(const Args& a, int r) {
    unsigned char* ws = a.ws;
    if (r < TR_IN) { const int kb = r / 160, nb = r % 160;
        if (nb >= 96) return TrItem{a.in[3], a.in[2], (bf16*)(ws + WS_WIN8), INTOT, 64 * kb, src_in(32 * nb), D, 32 * nb - 3072, 64 * kb, 1};
        return TrItem{a.in[3], a.in[2], (bf16*)(ws + WS_WIN), INTOT, 64 * kb, src_in(32 * nb), D, 32 * nb, 64 * kb, 0}; } r -= TR_IN;
    if (r < TR_PP) { const int kb = r / 32, nb = r % 32; return TrItem{a.in[16], nullptr, (bf16*)(ws + WS_WPP), D, 64 * kb, 32 * nb, PLE, 32 * nb, 64 * kb, 0}; } r -= TR_PP;
    if (r < 2 * TR_BR) { const int br = r / TR_BR, q = r % TR_BR, kb = q / 32, nb = q % 32; return TrItem{a.in[6] + (size_t)br * AW * D, nullptr, (bf16*)(ws + WS_WBR), D, 64 * kb, 32 * nb, D, 32 * nb, br * AW + 64 * kb, 0}; } r -= 2 * TR_BR;
    if (r < TR_SQ) { const int kb = r / 32, nb = r % 32; return TrItem{a.in[7], nullptr, (bf16*)(ws + WS_WOUT), D, 64 * kb, 32 * nb, D, 32 * nb, 64 * kb, 0}; } r -= TR_SQ;
    { const int kb = r / 32, nb = r % 32; return TrItem{a.in[15], a.in[14], (bf16*)(ws + WS_WPG), D, 64 * kb, 32 * nb, D, 32 * nb, 64 * kb, 1}; }
}
__device__ __forceinline__ void tr_two(const Args& a, LAS float* scr, int ra, int rb_, bool two, int lane) {
    const TrItem A = tr_decode(a, ra), B = tr_decode(a, two ? rb_ : ra);
    float ta[32], tb[32];
    tr_load(A, ta, lane); if (two) tr_load(B, tb, lane);
    tr_finish(A, ta, scr, lane); if (two) tr_finish(B, tb, scr, lane);
}
__device__ __forceinline__ void ws_item(const Args& a, LAS unsigned char* lds, int item) {
    int tid_ = (int)threadIdx.x; asm volatile("" : "+v"(tid_));
    const float *g_ffn = a.in[8], *w_peer_q = a.in[9]; bf16* WST = (bf16*)(a.ws + WS_WS);
    LAS float* KH = (LAS float*)lds; LAS float* WQ = KH + 128 * 129;
    const int hh = item >> 4, head = hh >> 1, half = hh & 1, d0 = (item & 15) * 64;
    const float* kh = (half ? a.in[11] : a.in[10]) + (size_t)head * 128 * 128;
    float tk[32], tq[16];
#pragma unroll
    for (int i = 0; i < 32; ++i) tk[i] = kh[i * 512 + tid_];
#pragma unroll
    for (int i = 0; i < 16; ++i) { const int idx = i * 512 + tid_; tq[i] = w_peer_q[(size_t)(d0 + (idx >> 7)) * NS + head * 256 + half * 128 + (idx & 127)]; }
#pragma unroll
    for (int i = 0; i < 32; ++i) { const int idx = i * 512 + tid_; KH[(idx >> 7) * 129 + (idx & 127)] = tk[i]; }
#pragma unroll
    for (int i = 0; i < 16; ++i) { const int idx = i * 512 + tid_; WQ[(idx >> 7) * 129 + (idx & 127)] = tq[i]; }
    __syncthreads();
    typedef float f32x16_t __attribute__((ext_vector_type(16)));
    const int lane = tid_ & 63, w = __builtin_amdgcn_readfirstlane(tid_ >> 6), kt = w & 3, dt = w >> 2, l31 = lane & 31, h = lane >> 5;
    const LAS float* ap = WQ + (32 * dt + l31) * 129 + h; const LAS float* bp = KH + (32 * kt + l31) * 129 + h;
    f32x16_t acc = {0.f, 0.f, 0.f, 0.f, 0.f, 0.f, 0.f, 0.f, 0.f, 0.f, 0.f, 0.f, 0.f, 0.f, 0.f, 0.f};
#pragma unroll 8
    for (int s_ = 0; s_ < 64; ++s_) acc = __builtin_amdgcn_mfma_f32_32x32x2f32(ap[2 * s_], bp[2 * s_], acc, 0, 0, 0);
    const int key = 32 * kt + l31;
#pragma unroll
    for (int q = 0; q < 4; ++q) { const int dd = d0 + 32 * dt + 8 * q + 4 * h; const f32x4 gv = *(const GAS f32x4*)(g_ffn + dd);
        u32x2 o; o.x = pk2(acc[4 * q] * gv[0], acc[4 * q + 1] * gv[1]); o.y = pk2(acc[4 * q + 2] * gv[2], acc[4 * q + 3] * gv[3]);
        *(GAS u32x2*)(WST + (size_t)(head * 256 + half * 128 + key) * D + dd) = o; }
    __syncthreads();
}
template <int CTRL> __device__ __forceinline__ int dpp_i(int v) { return __builtin_amdgcn_update_dpp(0, v, CTRL, 0xf, 0xf, true); }
__device__ __forceinline__ void quant_load4(const Args& a, int rb, int lane, f32x4 (&v)[4][4]) {
#pragma unroll
    for (int r = 0; r < 4; ++r) { const int rr = rb + r; const bool isv = rr >= NEXP; const int e = isv ? rr - NEXP : rr;
        const GAS f32x4* src = (const GAS f32x4*)((isv ? a.in[13] : a.in[12]) + (size_t)e * D) + lane;
#pragma unroll
        for (int j = 0; j < 4; ++j) v[r][j] = src[64 * j]; }
}
__device__ __forceinline__ void quant_finish4(const Args& a, int rb, int lane, f32x4 (&v)[4][4]) {
    unsigned char* ws = a.ws; const float *g_ffn = a.in[8];
    f32x4 gq[4];
#pragma unroll
    for (int j = 0; j < 4; ++j) gq[j] = *(const GAS f32x4*)(g_ffn + 256 * j + 4 * lane);
#pragma unroll
    for (int r = 0; r < 4; ++r) { const int rr = rb + r; const bool isv = rr >= NEXP; const int e = isv ? rr - NEXP : rr;
        float am = 0.f;
#pragma unroll
        for (int j = 0; j < 4; ++j) { if (!isv) v[r][j] = v[r][j] * gq[j]; am = fmaxf(am, fmaxf(fmaxf(fabsf(v[r][j].x), fabsf(v[r][j].y)), fmaxf(fabsf(v[r][j].z), fabsf(v[r][j].w)))); }
#pragma unroll
        for (int o = 1; o < 64; o <<= 1) am = fmaxf(am, __shfl_xor(am, o));
        unsigned char* tb = ws + (isv ? WS_VB : WS_UB);
        float ss = 0.f;
#pragma unroll
        for (int j = 0; j < 4; ++j) ss += (v[r][j].x * v[r][j].x + v[r][j].y * v[r][j].y) + (v[r][j].z * v[r][j].z + v[r][j].w * v[r][j].w);
#pragma unroll
        for (int o = 1; o < 64; o <<= 1) ss += __shfl_xor(ss, o);
        const float st = fminf(Q4_STEP * sqrtf(ss * (1.0f / D)), am * 0.125f), inv = st > 0.f ? 1.0f / st : 0.f;
        if (isv) {
#pragma unroll
            for (int j = 0; j < 4; ++j) {
                const int n0 = (int)fminf(fmaxf(floorf(v[r][j].x * inv + 8.0f), 0.f), 15.f), n1 = (int)fminf(fmaxf(floorf(v[r][j].y * inv + 8.0f), 0.f), 15.f);
                const int n2 = (int)fminf(fmaxf(floorf(v[r][j].z * inv + 8.0f), 0.f), 15.f), n3 = (int)fminf(fmaxf(floorf(v[r][j].w * inv + 8.0f), 0.f), 15.f);
                *(GAS unsigned short*)(tb + ((size_t)j * NEXP + e) * 128 + 2 * lane) = (unsigned short)(n0 | ((n1 ^ 8) << 4) | (n2 << 8) | ((n3 ^ 8) << 12)); }
            if (lane == 0) ((float*)(ws + WS_SV))[e] = st;
            continue;
        }
#pragma unroll
        for (int j = 0; j < 4; ++j) {
            const int n0 = (int)fminf(fmaxf(floorf(v[r][j].x * inv + 8.0f), 0.f), 15.f), n1 = (int)fminf(fmaxf(floorf(v[r][j].y * inv + 8.0f), 0.f), 15.f);
            const int n2 = (int)fminf(fmaxf(floorf(v[r][j].z * inv + 8.0f), 0.f), 15.f), n3 = (int)fminf(fmaxf(floorf(v[r][j].w * inv + 8.0f), 0.f), 15.f);
            const int P = (n0 | (n1 << 8) | (n2 << 16) | (n3 << 24)) ^ 0x08080808, Pn = dpp_i<0xB1>(P);
            if (!(lane & 1)) *(GAS unsigned*)(tb + ((size_t)j * NEXP + e) * 128 + 4 * (lane >> 1)) = (unsigned)P | ((unsigned)Pn << 4); }
        if (lane == 0) ((float*)(ws + WS_SU))[e] = st;
    }
}
__device__ __forceinline__ void quant_rows4(const Args& a, int rb, int lane) { f32x4 v[4][4]; quant_load4(a, rb, lane, v); quant_finish4(a, rb, lane, v); }
__device__ __forceinline__ void p0_prologue(const Ctx& F, const Args& a, volatile LAS unsigned* MISC) {
    unsigned char* ws = a.ws;
    const float *x = a.in[0], *p = a.in[1], *g_mix = a.in[2], *w_in = a.in[3], *b_f = a.in[4];
    bf16 *PB = (bf16*)(ws + WS_PB), *XB = (bf16*)(ws + WS_A);
    float *RSTD1 = (float*)(ws + WS_RSTD1), *LF = (float*)(ws + WS_LF);
    const int gw = F.vcu * NWAVES + F.wave, NGW = F.G * NWAVES, NGT = F.G * 512;
    const int tid_ = (int)threadIdx.x, lane_ = tid_ & 63;
    auto stepB = [&]() __attribute__((always_inline)) {
        LAS float* scr = (LAS float*)(F.lds + RING_OFF + F.wave * 16384);
        for (int it = gw; it < TR_P0; it += 2 * NGW) tr_two(a, scr, it, it + NGW, it + NGW < TR_P0, lane_);
    };
    auto stepC = [&]() __attribute__((always_inline)) {
    {
        LAS float* WFL = (LAS float*)(F.lds + RING_OFF);
        { float tw[16], tg[16];
#pragma unroll
          for (int i = 0; i < 16; ++i) { const int idx = i * 512 + tid_, k = idx >> 3, h = idx & 7; tw[i] = w_in[(size_t)k * INTOT + 1536 + h]; tg[i] = g_mix[k]; }
#pragma unroll
          for (int i = 0; i < 16; ++i) { const int idx = i * 512 + tid_, k = idx >> 3, h = idx & 7; WFL[h * 1024 + k] = tg[i] * tw[i]; } }
        __syncthreads();
        for (int rb = gw; rb < M; rb += 4 * NGW) {
            f32x4 v[4][4];
#pragma unroll
            for (int r = 0; r < 4; ++r) { const int row = rb + r * NGW; if (row < M) { const GAS f32x4* xr = (const GAS f32x4*)(x + (size_t)row * D);
#pragma unroll
                for (int j = 0; j < 4; ++j) v[r][j] = xr[lane_ + 64 * j]; } }
#pragma unroll
            for (int r = 0; r < 4; ++r) { const int row = rb + r * NGW; if (row < M) {
                float ss = 0.f;
#pragma unroll
                for (int j = 0; j < 4; ++j) ss += (v[r][j].x * v[r][j].x + v[r][j].y * v[r][j].y) + (v[r][j].z * v[r][j].z + v[r][j].w * v[r][j].w);
                ss = wave_sum(ss);
                const float rstd = 1.0f / sqrtf(ss * (1.0f / D) + EPS);
                GAS u32x2* o = (GAS u32x2*)(XB + (size_t)row * D);
#pragma unroll
                for (int j = 0; j < 4; ++j) { u32x2 w; w.x = pk2(v[r][j].x, v[r][j].y); w.y = pk2(v[r][j].z, v[r][j].w); o[lane_ + 64 * j] = w; }
                { GAS unsigned* o8 = (GAS unsigned*)(ws + WS_XB8 + (size_t)row * D);
#pragma unroll
                  for (int j = 0; j < 4; ++j) { int q = __builtin_amdgcn_cvt_pk_fp8_f32(v[r][j].x, v[r][j].y, 0, false); q = __builtin_amdgcn_cvt_pk_fp8_f32(v[r][j].z, v[r][j].w, q, true); o8[lane_ + 64 * j] = (unsigned)q; } }
                if (lane_ == 0) RSTD1[row] = rstd;
                float f[8];
#pragma unroll
                for (int h = 0; h < 8; ++h) { float s_ = 0.f;
#pragma unroll
                    for (int j = 0; j < 4; ++j) { const f32x4 w = *(const LAS f32x4*)(WFL + h * 1024 + 4 * (lane_ + 64 * j)); s_ += (v[r][j].x * w[0] + v[r][j].y * w[1]) + (v[r][j].z * w[2] + v[r][j].w * w[3]); }
                    f[h] = s_; }
                float r4[4], r2[2], r1;
#pragma unroll
                for (int i = 0; i < 4; ++i) { const float send = (lane_ & 32) ? f[i] : f[i + 4], keep = (lane_ & 32) ? f[i + 4] : f[i]; r4[i] = keep + __shfl_xor(send, 32); }
#pragma unroll
                for (int i = 0; i < 2; ++i) { const float send = (lane_ & 16) ? r4[i] : r4[i + 2], keep = (lane_ & 16) ? r4[i + 2] : r4[i]; r2[i] = keep + __shfl_xor(send, 16); }
                { const float send = (lane_ & 8) ? r2[0] : r2[1], keep = (lane_ & 8) ? r2[1] : r2[0]; r1 = keep + __shfl_xor(send, 8); }
                r1 += __shfl_xor(r1, 4); r1 += __shfl_xor(r1, 2); r1 += __shfl_xor(r1, 1);
                const int hL = ((lane_ >> 5) & 1) * 4 + ((lane_ >> 4) & 1) * 2 + ((lane_ >> 3) & 1);
                const float tot = r1 * rstd + b_f[hL];
                const float ls = fminf(tot, 0.f) - log1pf(__expf(-fabsf(tot)));
                const int b = row / SEQ, t = row % SEQ;
                if ((lane_ & 7) == 0) LF[(size_t)(b * NH + hL) * SEQ + t] = ls * LOG2E;
            } }
        }
    }
    };
    if (F.vcu & 1) { stepC(); __syncthreads(); stepB(); }
    else           { stepB(); __syncthreads(); stepC(); }
    { constexpr int NP = M * PLE / 8;
        for (int i = F.vcu * 512 + tid_; i < NP; i += NGT) { const f32x4 a_ = ((const GAS f32x4*)p)[2 * (size_t)i], b_ = ((const GAS f32x4*)p)[2 * (size_t)i + 1];
            v4u o; o.x = pk2(a_.x, a_.y); o.y = pk2(a_.z, a_.w); o.z = pk2(b_.x, b_.y); o.w = pk2(b_.z, b_.w); ((GAS v4u*)PB)[i] = o; }
    }
}
__device__ __forceinline__ void p2_conv_chunk(int chunk, const bf16* GB, const bf16* Z, const float* cw, bf16* AC) {
    int tid_l = (int)threadIdx.x; asm volatile("" : "+v"(tid_l));
#pragma unroll 4
    for (int k = 0; k < 16; ++k) {
        const int i = chunk * 8192 + k * 512 + tid_l;
        const int row = i >> 6, c = (i & 63) * 8, t = row & (SEQ - 1);
        const v4u z2 = *(const GAS v4u*)(Z + (size_t)row * AW + c), g = *(const GAS v4u*)(GB + (size_t)row * AW + c);
        v4u z1 = {0u, 0u, 0u, 0u}, z0 = {0u, 0u, 0u, 0u};
        if (t >= 1) z1 = *(const GAS v4u*)(Z + (size_t)(row - 1) * AW + c);
        if (t >= 2) z0 = *(const GAS v4u*)(Z + (size_t)(row - 2) * AW + c);
        float r[8];
#pragma unroll
        for (int e = 0; e < 4; ++e) {
            const float w0a = cw[c + 2 * e], w0b = cw[c + 2 * e + 1], w1a = cw[AW + c + 2 * e], w1b = cw[AW + c + 2 * e + 1], w2a = cw[2 * AW + c + 2 * e], w2b = cw[2 * AW + c + 2 * e + 1];
            r[2 * e] = __uint_as_float(g[e] << 16) * (w0a * __uint_as_float(z0[e] << 16) + w1a * __uint_as_float(z1[e] << 16) + w2a * __uint_as_float(z2[e] << 16));
            r[2 * e + 1] = __uint_as_float(g[e] & 0xffff0000u) * (w0b * __uint_as_float(z0[e] & 0xffff0000u) + w1b * __uint_as_float(z1[e] & 0xffff0000u) + w2b * __uint_as_float(z2[e] & 0xffff0000u));
        }
        v4u o; o.x = pk2(r[0], r[1]); o.y = pk2(r[2], r[3]); o.z = pk2(r[4], r[5]); o.w = pk2(r[6], r[7]);
        *(GAS v4u*)(AC + (size_t)row * D + AW + c) = o;
    }
}
constexpr int P2_NATT = 512, P2_NCONV = M * AW / 8 / 8192, P2_NQ = 2 * NEXP / 64, P2_NWS = 256, P2_NTR = TR_LATE / 16, CW_QUEUE = 512;
constexpr int P2_NITEMS = P2_NATT + P2_NCONV + P2_NQ + P2_NWS + P2_NTR;
__device__ __forceinline__ int p2_dequeue(unsigned* ctr, volatile LAS unsigned* slot) {
    if (threadIdx.x == 0) *slot = __hip_atomic_fetch_add(ctr, 1u, __ATOMIC_RELAXED, __HIP_MEMORY_SCOPE_AGENT);
    asm volatile("s_waitcnt vmcnt(0) lgkmcnt(0)\n\ts_barrier" ::: "memory");
    const unsigned v = *slot;
    asm volatile("s_waitcnt lgkmcnt(0)\n\ts_barrier" ::: "memory");
    return (int)v;
}
__device__ __forceinline__ int dot8_0(int a, int b) { int d; asm("v_dot8_i32_i4 %0, %1, %2, 0" : "=v"(d) : "v"(a), "v"(b)); return d; }
__device__ __forceinline__ int dot4_0(int a, int b) { int d; asm("v_dot4_i32_i8 %0, %1, %2, 0" : "=v"(d) : "v"(a), "v"(b)); return d; }
__device__ __forceinline__ float amax3(float a, float b, float m) { float d; asm("v_max3_f32 %0, |%1|, |%2|, %3" : "=v"(d) : "v"(a), "v"(b), "v"(m)); return d; }
__device__ __forceinline__ int sum8i(int v) { v += dpp_i<0x141>(v); v += dpp_i<0xB1>(v); v += dpp_i<0x4E>(v); return v; }
__device__ __forceinline__ float max8f(float v) { v = fmaxf(v, __uint_as_float((unsigned)dpp_i<0x141>((int)__float_as_uint(v)))); v = fmaxf(v, __uint_as_float((unsigned)dpp_i<0xB1>((int)__float_as_uint(v)))); v = fmaxf(v, __uint_as_float((unsigned)dpp_i<0x4E>((int)__float_as_uint(v)))); return v; }
__device__ __forceinline__ size_t part_slab(int j) { return j < 2 ? WS_PART0 + (size_t)j * 8 * MiB : j < 6 ? WS_PART1 + (size_t)(j - 2) * 8 * MiB : WS_PART2 + (size_t)(j - 6) * 8 * MiB; }
struct P6Geo { int xg, wi, nwv, ng; };
__device__ __forceinline__ P6Geo p6_geo(const Ctx& F) { P6Geo g; const int bx = blockIdx.x, ng = F.G < 8 ? F.G : 8; g.xg = bx % ng; g.wi = (bx / ng) * NWAVES + F.wave; g.nwv = ((F.G - g.xg + ng - 1) / ng) * NWAVES; g.ng = ng; return g; }
__device__ __forceinline__ void p6a_upass(const Ctx& F, unsigned char* ws, const bf16* XB1, const unsigned short* IDS) {
    const P6Geo G = p6_geo(F); const int lane = F.lane_(), g = lane >> 3, c = lane & 7;
#define U_IDS(ID, t_) do { _Pragma("unroll") for (int q = 0; q < 2; ++q) ID[q] = *(const GAS v4u*)(IDS + (size_t)(t_) * 128 + 16 * g + 8 * q); } while (0)
#define U_X(XR, t_) do { _Pragma("unroll") for (int b = 0; b < 4; ++b) XR[b] = *(const GAS v4u*)(XB1 + (size_t)(t_) * D + sl * SL4 + 32 * c + 8 * b); } while (0)
#define U_GATHER(R, ID) do { _Pragma("unroll") for (int i = 0; i < 16; ++i) { const unsigned w_ = ID[i >> 3][(i >> 1) & 3]; R[i] = *(const GAS v4u*)(Ts + (size_t)((((i & 1) ? (w_ >> 9) : (w_ << 7)) & 0x7fff80u) | c16)); } } while (0)
#define U_COMPUTE(R, XR, t_) do { \
        float xf[32]; \
        _Pragma("unroll") for (int b = 0; b < 4; ++b) _Pragma("unroll") for (int e = 0; e < 4; ++e) { xf[8 * b + 2 * e] = __uint_as_float(XR[b][e] << 16); xf[8 * b + 2 * e + 1] = __uint_as_float(XR[b][e] & 0xffff0000u); } \
        float am = 0.f; \
        _Pragma("unroll") for (int e = 0; e < 32; e += 2) am = amax3(xf[e], xf[e + 1], am); \
        am = max8f(am); \
        const float sc = am > 0.f ? 119.0f / am : 0.f, sx = am * (1.0f / 119.0f); \
        unsigned XL[4], XH[4]; unsigned usum = 0; \
        _Pragma("unroll") for (int b = 0; b < 4; ++b) { \
            unsigned fb[8]; \
            _Pragma("unroll") for (int e = 0; e < 8; ++e) fb[e] = __float_as_uint(fmaf(xf[8 * b + e], sc, 12583040.0f));              \
            const unsigned U0 = __builtin_amdgcn_perm(fb[1], fb[0], 0x0c0c0400u) | __builtin_amdgcn_perm(fb[3], fb[2], 0x04000c0cu); \
            const unsigned U1 = __builtin_amdgcn_perm(fb[5], fb[4], 0x0c0c0400u) | __builtin_amdgcn_perm(fb[7], fb[6], 0x04000c0cu); \
            usum = __builtin_amdgcn_sad_u8(U0, 0u, usum); usum = __builtin_amdgcn_sad_u8(U1, 0u, usum); \
            XL[b] = (U0 & 0x0f0f0f0fu) | ((U1 << 4) & 0xf0f0f0f0u);                                                                    \
            const unsigned T0 = U0 + 0x08080808u, T1 = U1 + 0x08080808u;                                                               \
            XH[b] = (((T0 >> 4) & 0x0f0f0f0fu) | (T1 & 0xf0f0f0f0u)) ^ 0x88888888u; }                                                 \
        const float xs = 0.5f * (float)(sum8i((int)usum) - 128 * SL4); \
        int r0 = 0, r1 = 0; \
        _Pragma("unroll") for (int i = 0; i < 16; ++i) { \
            int sl_ = dot8_0((int)R[i][0], (int)XL[0]), sh_ = dot8_0((int)R[i][0], (int)XH[0]); \
            _Pragma("unroll") for (int b = 1; b < 4; ++b) { sl_ = __builtin_amdgcn_sdot8((int)R[i][b], (int)XL[b], sl_, false); sh_ = __builtin_amdgcn_sdot8((int)R[i][b], (int)XH[b], sh_, false); } \
            const int sacc = sum8i(sl_ + 16 * sh_); \
            if (i < 8) r0 = (c == i) ? sacc : r0; else r1 = (c == i - 8) ? sacc : r1; } \
        float* pp = PART + (size_t)(t_) * 128 + 16 * g + c; \
        pp[0] = ((float)r0 + xs) * sx; pp[8] = ((float)r1 + xs) * sx; } while (0)
#define U_FENCE() asm volatile("" ::: "memory")
    const bool two = G.ng == 8; const int nsl_step = two ? 4 : G.ng;
    int wbase = 0, wtot = G.nwv;
    if (two) { const int xo = G.xg ^ 4, nwo = ((F.G - xo + 7) / 8) * NWAVES; wtot = G.nwv + nwo; wbase = (G.xg & 4) ? nwo : 0; }
    for (int sl = two ? (G.xg & 3) : G.xg; sl < NSL4; sl += nsl_step) {
        float* PART = (float*)(ws + part_slab(sl));
        const GAS unsigned char* Ts = (const GAS unsigned char*)(ws + WS_UB) + (size_t)sl * NEXP * 128; const unsigned c16 = 16u * (unsigned)c;
        const int t0 = wbase + G.wi, dt = wtot, nk = t0 < M ? (M - t0 + dt - 1) / dt : 0;
        if (nk <= 0) continue;
#define TOK(k_) (t0 + ((k_) < nk ? (k_) : nk - 1) * dt)
        v4u idA[2], idB[2]; v4u xA[4], xB[4]; v4u rA[16], rB[16];
        U_IDS(idA, TOK(0)); U_IDS(idB, TOK(1));
        U_FENCE();
        U_GATHER(rA, idA); U_X(xA, TOK(0));
        U_FENCE();
        for (int k = 0; k < nk; k += 2) {
            U_IDS(idA, TOK(k + 2));
            U_FENCE();
            U_GATHER(rB, idB); U_X(xB, TOK(k + 1));
            U_FENCE();
            U_COMPUTE(rA, xA, TOK(k));
            U_FENCE();
            U_IDS(idB, TOK(k + 3));
            U_FENCE();
            U_GATHER(rA, idA); U_X(xA, TOK(k + 2));
            U_FENCE();
            U_COMPUTE(rB, xB, TOK(k + 1));
            U_FENCE();
        }
#undef TOK
    }
#undef U_IDS
#undef U_X
#undef U_GATHER
#undef U_COMPUTE
#undef U_FENCE
}
__device__ __forceinline__ int pl32_sum(int a, int b) { const auto s_ = __builtin_amdgcn_permlane32_swap((unsigned)a, (unsigned)b, false, false); return (int)(s_[0] + s_[1]); }
__device__ __forceinline__ int pl16_sum(int a, int b) { const auto s_ = __builtin_amdgcn_permlane16_swap((unsigned)a, (unsigned)b, false, false); return (int)(s_[0] + s_[1]); }
__device__ __forceinline__ float wave_sum_valu(float v) {
    { const auto s_ = __builtin_amdgcn_permlane32_swap(__float_as_uint(v), __float_as_uint(v), false, false); v = __uint_as_float(s_[0]) + __uint_as_float(s_[1]); }
    { const auto s_ = __builtin_amdgcn_permlane16_swap(__float_as_uint(v), __float_as_uint(v), false, false); v = __uint_as_float(s_[0]) + __uint_as_float(s_[1]); }
    v += __uint_as_float((unsigned)dpp_i<0x128>((int)__float_as_uint(v))); v += __uint_as_float((unsigned)dpp_i<0x124>((int)__float_as_uint(v)));
    v += __uint_as_float((unsigned)dpp_i<0x122>((int)__float_as_uint(v))); v += __uint_as_float((unsigned)dpp_i<0x121>((int)__float_as_uint(v))); return v;
}
__device__ __forceinline__ float wave_max_valu(float v) {
    { const auto s_ = __builtin_amdgcn_permlane32_swap(__float_as_uint(v), __float_as_uint(v), false, false); v = fmaxf(__uint_as_float(s_[0]), __uint_as_float(s_[1])); }
    { const auto s_ = __builtin_amdgcn_permlane16_swap(__float_as_uint(v), __float_as_uint(v), false, false); v = fmaxf(__uint_as_float(s_[0]), __uint_as_float(s_[1])); }
    v = fmaxf(v, __uint_as_float((unsigned)dpp_i<0x128>((int)__float_as_uint(v)))); v = fmaxf(v, __uint_as_float((unsigned)dpp_i<0x124>((int)__float_as_uint(v))));
    v = fmaxf(v, __uint_as_float((unsigned)dpp_i<0x122>((int)__float_as_uint(v)))); v = fmaxf(v, __uint_as_float((unsigned)dpp_i<0x121>((int)__float_as_uint(v)))); return v;
}
__device__ __forceinline__ void p6b_combine(const Ctx& F, unsigned char* ws, float* SS2, const unsigned short* IDS, const float* GATES) {
    const int gw = F.vcu * NWAVES + F.wave, NGW = F.G * NWAVES, lane = F.lane_();
    const float *SU = (const float*)(ws + WS_SU), *SV = (const float*)(ws + WS_SV);
    signed char* WQ8 = (signed char*)(ws + WS_WQ8);
    for (int tb = gw; tb < M; tb += 4 * NGW) {
        float ssv[4], a0[4], a1[4], g0[4], g1[4], su0[4], su1[4], sv0[4], sv1[4], pa[4][NSL4], pb[4][NSL4]; int i0[4], i1[4];
#pragma unroll
        for (int r = 0; r < 4; ++r) { const int t = tb + r * NGW; if (t < M) { i0[r] = (int)IDS[(size_t)t * 128 + lane]; i1[r] = (int)IDS[(size_t)t * 128 + 64 + lane]; } }
#pragma unroll
        for (int r = 0; r < 4; ++r) { const int t = tb + r * NGW; if (t < M) {
            ssv[r] = lane < 16 ? SS2[(size_t)t * 16 + lane] : 0.f;
            g0[r] = GATES[(size_t)t * 128 + lane]; g1[r] = GATES[(size_t)t * 128 + 64 + lane];
#pragma unroll
            for (int j = 0; j < NSL4; ++j) { const float* pp = (const float*)(ws + part_slab(j)) + (size_t)t * 128; pa[r][j] = pp[lane]; pb[r][j] = pp[64 + lane]; } } }
#pragma unroll
        for (int r = 0; r < 4; ++r) { const int t = tb + r * NGW; if (t < M) { su0[r] = SU[i0[r]]; su1[r] = SU[i1[r]]; sv0[r] = SV[i0[r]]; sv1[r] = SV[i1[r]]; } }
#pragma unroll
        for (int r = 0; r < 4; ++r) { const int t = tb + r * NGW; if (t < M) {
            a0[r] = (pa[r][0] + pa[r][1]) + (pa[r][2] + pa[r][3]);
            a1[r] = (pb[r][0] + pb[r][1]) + (pb[r][2] + pb[r][3]);
            const float rstd = 1.0f / sqrtf(wave_sum_valu(ssv[r]) * (1.0f / D) + EPS);
            const float x0 = a0[r] * rstd * su0[r], x1 = a1[r] * rstd * su1[r];
            const float w0 = g0[r] * 0.5f * x0 * (1.0f + erff(x0 * 0.70710678118654752f)) * sv0[r], w1 = g1[r] * 0.5f * x1 * (1.0f + erff(x1 * 0.70710678118654752f)) * sv1[r];
            const float am = wave_max_valu(fmaxf(fabsf(w0), fabsf(w1)));
            const float sc = am > 0.f ? 127.0f / am : 0.f;
            const float q0 = rintf(w0 * sc), q1 = rintf(w1 * sc);
            WQ8[(size_t)t * 128 + lane] = (signed char)(int)q0; WQ8[(size_t)t * 128 + 64 + lane] = (signed char)(int)q1;
            const float qs = wave_sum_valu(q0 + q1);
            if (lane == 0) { f32x2 o_; o_.x = am * (1.0f / 127.0f); o_.y = am * (1.0f / 127.0f) * qs; ((f32x2*)(ws + WS_SW2))[t] = o_; }
            if (lane < 16) SS2[(size_t)t * 16 + lane] = 0.f;
        } }
    }
}
__device__ __forceinline__ void p6c_vpass(const Ctx& F, unsigned char* ws, const unsigned short* IDS, const bf16* XB1, bf16* XB2, float* SS3) {
    const P6Geo G = p6_geo(F); const int lane = F.lane_(), g = lane >> 3, c = lane & 7;
    const int ecol = 32 * c + ((lane >> 5) & 1) * 16 + ((lane >> 4) & 1) * 8 + ((lane >> 3) & 1) * 4;
    const signed char* WQ8 = (const signed char*)(ws + WS_WQ8); const f32x2* SW2 = (const f32x2*)(ws + WS_SW2);
#define V_IDS(ID, t_) do { _Pragma("unroll") for (int q = 0; q < 2; ++q) ID[q] = *(const GAS v4u*)(IDS + (size_t)(t_) * 128 + 16 * g + 8 * q); } while (0)
#define V_AUX(WV, XQ, SWV, t_) do { WV = *(const GAS v4u*)(WQ8 + (size_t)(t_) * 128 + 16 * g); XQ = *(const GAS u32x2*)(XB1 + (size_t)(t_) * D + sl * SL4 + ecol); SWV = *(const GAS f32x2*)(SW2 + (t_)); } while (0)
#define V_GATHER(R, ID) do { _Pragma("unroll") for (int i = 0; i < 16; ++i) { const unsigned w_ = ID[i >> 3][(i >> 1) & 3]; R[i] = *(const GAS v4u*)(Ts + (size_t)((((i & 1) ? (w_ >> 9) : (w_ << 7)) & 0x7fff80u) | c16)); } } while (0)
#define V_COMPUTE(R, WV, XQ, SWV, t_) do { \
        const size_t o_ = (size_t)(t_) * D + sl * SL4 + ecol; \
        int acc[32]; \
        _Pragma("unroll") for (int j = 0; j < 4; ++j) \
            _Pragma("unroll") for (int b = 0; b < 4; ++b) { \
                const unsigned r0_ = R[4 * j][b], r1_ = R[4 * j + 1][b], r2_ = R[4 * j + 2][b], r3_ = R[4 * j + 3][b]; \
                const unsigned x01 = __builtin_amdgcn_perm(r1_, r0_, 0x05010400u), y01 = __builtin_amdgcn_perm(r1_, r0_, 0x07030602u), x23 = __builtin_amdgcn_perm(r3_, r2_, 0x05010400u), y23 = __builtin_amdgcn_perm(r3_, r2_, 0x07030602u); \
                unsigned tt_[4]; tt_[0] = __builtin_amdgcn_perm(x23, x01, 0x05040100u); tt_[1] = __builtin_amdgcn_perm(x23, x01, 0x07060302u); tt_[2] = __builtin_amdgcn_perm(y23, y01, 0x05040100u); tt_[3] = __builtin_amdgcn_perm(y23, y01, 0x07060302u); \
                _Pragma("unroll") for (int k = 0; k < 4; ++k) { \
                    if (j == 0) { acc[8 * b + 2 * k] = dot4_0((int)(tt_[k] & 0x0f0f0f0fu), (int)WV[0]); acc[8 * b + 2 * k + 1] = dot4_0((int)tt_[k], (int)WV[0]); } \
                    else { acc[8 * b + 2 * k] = __builtin_amdgcn_sdot4((int)(tt_[k] & 0x0f0f0f0fu), (int)WV[j], acc[8 * b + 2 * k], false); acc[8 * b + 2 * k + 1] = __builtin_amdgcn_sdot4((int)tt_[k], (int)WV[j], acc[8 * b + 2 * k + 1], false); } } } \
        _Pragma("unroll") for (int e = 0; e < 16; ++e) acc[2 * e + 1] -= acc[2 * e];                         \
        int r16[16], r8[8], r4[4]; \
        _Pragma("unroll") for (int i = 0; i < 16; ++i) r16[i] = pl32_sum(acc[i], acc[i + 16]); \
        _Pragma("unroll") for (int i = 0; i < 8; ++i) r8[i] = pl16_sum(r16[i], r16[i + 8]); \
        _Pragma("unroll") for (int i = 0; i < 4; ++i) { const int send = (lane & 8) ? r8[i] : r8[i + 4], keep = (lane & 8) ? r8[i + 4] : r8[i]; r4[i] = keep + dpp_i<0x128>(send); } \
        const float sw_ = SWV.x, cw_ = SWV.y; \
        const float x0_ = __uint_as_float(XQ.x << 16) + (sw_ * (float)r4[0] - 7.5f * cw_), x1_ = __uint_as_float(XQ.x & 0xffff0000u) + (sw_ * 0.0625f * (float)r4[1] + 0.5f * cw_); \
        const float x2_ = __uint_as_float(XQ.y << 16) + (sw_ * (float)r4[2] - 7.5f * cw_), x3_ = __uint_as_float(XQ.y & 0xffff0000u) + (sw_ * 0.0625f * (float)r4[3] + 0.5f * cw_); \
        u32x2 ov_; ov_.x = pk2(x0_, x1_); ov_.y = pk2(x2_, x3_); *(GAS u32x2*)(XB2 + o_) = ov_; \
        *(GAS unsigned*)(ws + WS_XB2_8 + o_) = (unsigned)__builtin_amdgcn_cvt_pk_fp8_f32(x2_, x3_, __builtin_amdgcn_cvt_pk_fp8_f32(x0_, x1_, 0, false), true); \
        const float ss = wave_sum_valu((x0_ * x0_ + x1_ * x1_) + (x2_ * x2_ + x3_ * x3_)); \
        if (lane == 0) SS3[(size_t)(t_) * 16 + sl] = ss; } while (0)
#define V_FENCE() asm volatile("" ::: "memory")
    const bool two = G.ng == 8; const int nsl_step = two ? 4 : G.ng;
    int wbase = 0, wtot = G.nwv;
    if (two) { const int xo = G.xg ^ 4, nwo = ((F.G - xo + 7) / 8) * NWAVES; wtot = G.nwv + nwo; wbase = (G.xg & 4) ? nwo : 0; }
    for (int sl = two ? (G.xg & 3) : G.xg; sl < NSL4; sl += nsl_step) {
        const GAS unsigned char* Ts = (const GAS unsigned char*)(ws + WS_VB) + (size_t)sl * NEXP * 128; const unsigned c16 = 16u * (unsigned)c;
        const int t0 = wbase + G.wi, dt = wtot, nk = t0 < M ? (M - t0 + dt - 1) / dt : 0;
        if (nk <= 0) continue;
#define TOK(k_) (t0 + ((k_) < nk ? (k_) : nk - 1) * dt)
        v4u idA[2], idB[2]; v4u wA, wB; u32x2 xA, xB; f32x2 sA, sB; v4u rA[16], rB[16];
        V_IDS(idA, TOK(0)); V_IDS(idB, TOK(1));
        V_FENCE();
        V_GATHER(rA, idA); V_AUX(wA, xA, sA, TOK(0));
        V_FENCE();
        for (int k = 0; k < nk; k += 2) {
            V_IDS(idA, TOK(k + 2));
            V_FENCE();
            V_GATHER(rB, idB); V_AUX(wB, xB, sB, TOK(k + 1));
            V_FENCE();
            V_COMPUTE(rA, wA, xA, sA, TOK(k));
            V_FENCE();
            V_IDS(idB, TOK(k + 3));
            V_FENCE();
            V_GATHER(rA, idA); V_AUX(wA, xA, sA, TOK(k + 2));
            V_FENCE();
            V_COMPUTE(rB, wB, xB, sB, TOK(k + 1));
            V_FENCE();
        }
#undef TOK
    }
#undef V_IDS
#undef V_AUX
#undef V_GATHER
#undef V_COMPUTE
#undef V_FENCE
}
__device__ __forceinline__ void p8_final(const Ctx& F, const bf16* XB3, const float* SS4, float* OUT, const float* g) {
    const int gw = F.vcu * NWAVES + F.wave, NGW = F.G * NWAVES, lane = F.lane_();
    f32x4 gv[4];
#pragma unroll
    for (int j = 0; j < 4; ++j) gv[j] = ((const GAS f32x4*)g)[2 * lane + (j & 1) + 128 * (j >> 1)];
    for (int rb = gw; rb < M; rb += 4 * NGW) {
        v4u xa[4], xb[4]; float sv[4];
#pragma unroll
        for (int r = 0; r < 4; ++r) { const int row = rb + r * NGW; if (row < M) { xa[r] = *(const GAS v4u*)(XB3 + (size_t)row * D + 8 * lane); xb[r] = *(const GAS v4u*)(XB3 + (size_t)row * D + 512 + 8 * lane);
            sv[r] = lane < 16 ? SS4[(size_t)row * 16 + lane] : 0.f; } }
#pragma unroll
        for (int r = 0; r < 4; ++r) { const int row = rb + r * NGW; if (row < M) {
            const float rstd = 1.0f / sqrtf(wave_sum(sv[r]) * (1.0f / D) + EPS);
            GAS f32x4* o = (GAS f32x4*)(OUT + (size_t)row * D);
            o[2 * lane] = (f32x4){__uint_as_float(xa[r][0] << 16), __uint_as_float(xa[r][0] & 0xffff0000u), __uint_as_float(xa[r][1] << 16), __uint_as_float(xa[r][1] & 0xffff0000u)} * rstd * gv[0];
            o[2 * lane + 1] = (f32x4){__uint_as_float(xa[r][2] << 16), __uint_as_float(xa[r][2] & 0xffff0000u), __uint_as_float(xa[r][3] << 16), __uint_as_float(xa[r][3] & 0xffff0000u)} * rstd * gv[1];
            o[128 + 2 * lane] = (f32x4){__uint_as_float(xb[r][0] << 16), __uint_as_float(xb[r][0] & 0xffff0000u), __uint_as_float(xb[r][1] << 16), __uint_as_float(xb[r][1] & 0xffff0000u)} * rstd * gv[2];
            o[128 + 2 * lane + 1] = (f32x4){__uint_as_float(xb[r][2] << 16), __uint_as_float(xb[r][2] & 0xffff0000u), __uint_as_float(xb[r][3] << 16), __uint_as_float(xb[r][3] & 0xffff0000u)} * rstd * gv[3];
        } }
    }
}
struct OneUnit {
    pg8::Unit u;
    __device__ __forceinline__ bool next(int i, pg8::Unit& o) const { if (i != 0) return false; o = u; return true; }
    __device__ __forceinline__ void a_ready(const pg8::Unit&) const {}
    __device__ __forceinline__ void done(const pg8::Unit&) const {}
};

__global__ void __launch_bounds__(NWAVES * 64, 2) mk_fwd(Args args) {
    extern __shared__ __attribute__((aligned(16))) unsigned char lds[];
    Ctx F;
    F.lds = (LAS unsigned char*)lds;
    F.wave = __builtin_amdgcn_readfirstlane((int)threadIdx.x >> 6);
    F.G = gridDim.x; { const int bx = blockIdx.x; F.vcu = (F.G % 8 == 0) ? (bx % 8) * (F.G / 8) + bx / 8 : bx; }
    volatile LAS unsigned* MISC = (volatile LAS unsigned*)(F.lds + MISC_OFF);
    unsigned char* ws = args.ws;
    gu32* ctl = (gu32*)(ws + WS_CTL);
    for (int u = F.tid_(); u < (LDS_BYTES - LDSCTL_OFF) / 4; u += NWAVES * 64) ((LAS unsigned*)(F.lds + LDSCTL_OFF))[u] = 0u;
    __syncthreads();
    const int lo = args.ph_lo, hi = args.ph_hi;
    const bool multi = (hi - lo) > 1 || (lo <= 6 && 6 < hi);
    XcdBarrier bar; bar.bar = (unsigned*)(ctl + CW_BAR) + args.li * XCD_BAR_WORDS; bar.x = 0; bar.st = nullptr;
    if (multi) bar = xcd_barrier_post((unsigned*)(ctl + CW_BAR) + args.li * XCD_BAR_WORDS, MISC + 8);
#ifndef MK_CMASK
#define MK_CMASK 0x1ff
#endif
#define IN(k) (((MK_CMASK >> (k)) & 1) && lo <= (k) && (k) < hi)
#ifdef MK_PROBE_BAR2
#define SEAM(k) do { if (IN(k) && IN((k) + 1)) { xcd_barrier(bar); for (int rb_ = 1; rb_ < MK_PROBE_BAR2; ++rb_) xcd_barrier(bar); } STAMPI((k) < 6 ? (k) + 1 : (k) + 3); } while (0)
#else
#define SEAM(k) do { if (IN(k) && IN((k) + 1)) xcd_barrier(bar); STAMPI((k) < 6 ? (k) + 1 : (k) + 3); } while (0)
#endif
#ifdef MK_PROBE_SEG
#define STAMPI(i_) do { if (((i_) == MK_PROBE_SEG || (i_) == MK_PROBE_SEG + 1 || (MK_PROBE_SEG == 200 && ((i_) == 0 || (i_) == 11))) && blockIdx.x == 0 && threadIdx.x == 0) { ((unsigned long long*)(args.ws + 32768))[(i_)] = __builtin_amdgcn_s_memrealtime(); } } while (0)
    STAMPI(0);
#else
#define STAMPI(i_) do { } while (0)
#endif
    float* out = args.out;
#define WSP(T, off) ((T*)(ws + (off)))
#define RSTD1 WSP(float, WS_RSTD1)
#define SS2 WSP(float, WS_SS2)
#define LF WSP(float, WS_LF)
#define WIN WSP(bf16, WS_WIN)
#define WBR WSP(bf16, WS_WBR)
#define WOUT WSP(bf16, WS_WOUT)
#define WST WSP(bf16, WS_WS)
#define WPG WSP(bf16, WS_WPG)
#define WPP WSP(bf16, WS_WPP)
#define PB WSP(bf16, WS_PB)
#define XB WSP(bf16, WS_A)
#define AC WSP(bf16, WS_AC)
#define XB1 WSP(bf16, WS_A)
#define PP WSP(bf16, WS_PP)
#define Q WSP(bf16, WS_Q)
#define K WSP(bf16, WS_K)
#define V WSP(bf16, WS_V)
#define GB WSP(bf16, WS_GB)
#define Z WSP(bf16, WS_Z)
#define MG WSP(bf16, WS_MERGED)
#define XB2 WSP(bf16, WS_XB2)
#define IDS WSP(unsigned short, WS_IDS)
#define GATES WSP(float, WS_GATES)
#define SGA ((bf16*)out)
#define SGC ((bf16*)out + (size_t)M * D)

    if (IN(0)) { p0_prologue(F, args, MISC); }
    SEAM(0);
    if (IN(1)) {
        { pg8::Gemm g{XB, WIN, M, 3072, D}; pg8::StaticOrder S; S.init(M, 3072, F.G, (int)blockIdx.x);
          pg8::EpiIn E{RSTD1, Q, (size_t)(WS_K - WS_Q) / 2, Z, SGA, (size_t)M * D, C2};
          static_assert(WS_V - WS_K == WS_K - WS_Q && WS_GB - WS_V == WS_K - WS_Q, "Q | K | V | GB equally spaced");
          pg8::gemm_phase<pg8::EpiIn, pg8::StaticOrder, PG8_ALIGN, PG8_SP2>(F.lds + RING_OFF, g, S, E, F.wave); }
        { pg8::Gemm g{WSP(bf16, WS_XB8), WSP(bf16, WS_WIN8), M, 2048, D / 2}; pg8::StaticOrder S; S.init(M, 2048, F.G, (int)blockIdx.x);
          pg8::EpiGate E{RSTD1, SGA, (size_t)M * D, 1.0f / 32.0f};
          pg8::gemm_phase<pg8::EpiGate, pg8::StaticOrder, PG8_ALIGN, PG8_SP2, true>(F.lds + RING_OFF, g, S, E, F.wave); }
        { pg8::Gemm g{PB, WPP, M, D, PLE}; pg8::StaticOrder S; S.init(M, D, F.G, (int)blockIdx.x);
          pg8::EpiPlain E{PP, D};
          pg8::gemm_phase<pg8::EpiPlain, pg8::StaticOrder, PG8_ALIGN, PG8_SP2>(F.lds + RING_OFF, g, S, E, F.wave); }
    }
    SEAM(1);
    if (IN(2)) {
        unsigned* qctr = (unsigned*)(ctl + CW_QUEUE);
        for (;;) {
            const int idx = p2_dequeue(qctr, MISC + 12);
            if (idx >= P2_NITEMS) break;
            if (idx < P2_NATT) { const int qb = 15 - (idx >> 5), bh = idx & 31;
                attn_body::attn_unit<8>(bh >> 3, bh & 7, qb, (const attn_body::bf16*)Q, (const attn_body::bf16*)K, (const attn_body::bf16*)V, (attn_body::bf16*)AC, LF + (size_t)bh * SEQ, (char*)lds + RING_OFF); }
            else if (idx < P2_NATT + P2_NQ) {
                int lane_l = (int)threadIdx.x & 63; asm volatile("" : "+v"(lane_l));
                const int r0 = (idx - P2_NATT) * 64 + F.wave * 8;
                quant_rows4(args, r0, lane_l); quant_rows4(args, r0 + 4, lane_l);
            }
            else if (idx < P2_NATT + P2_NQ + P2_NCONV) p2_conv_chunk(idx - P2_NATT - P2_NQ, GB, Z, args.in[5], AC);
            else if (idx < P2_NATT + P2_NQ + P2_NCONV + P2_NWS) ws_item(args, F.lds + RING_OFF, idx - P2_NATT - P2_NQ - P2_NCONV);
            else { int lane_l = (int)threadIdx.x & 63; asm volatile("" : "+v"(lane_l));
                const int w0 = TR_P0 + (idx - P2_NATT - P2_NQ - P2_NCONV - P2_NWS) * 16 + F.wave * 2;
                tr_two(args, (LAS float*)(F.lds + RING_OFF + F.wave * 16384), w0, w0 + 1, true, lane_l); }
        }
    }
    SEAM(2);
    if (IN(3)) {
        pg8::Gemm g{AC, WBR, M, D, D}; pg8::StaticOrder S; S.init(M, D, F.G, (int)blockIdx.x);
        pg8::EpiBranch E{SGA, SGC, MG};
        pg8::gemm_phase<pg8::EpiBranch, pg8::StaticOrder, PG8_ALIGN, PG8_SP2>(F.lds + RING_OFF, g, S, E, F.wave);
    }
    SEAM(3);
    if (IN(4)) {
        pg8::Gemm g{MG, WOUT, M, D, D}; pg8::StaticOrder S; S.init(M, D, F.G, (int)blockIdx.x);
        pg8::EpiOut E{XB, XB1, SS2};
        pg8::gemm_phase<pg8::EpiOut, pg8::StaticOrder, PG8_ALIGN, PG8_SP2>(F.lds + RING_OFF, g, S, E, F.wave);
    }
    SEAM(4);
    if (IN(5)) {
        pg8::Gemm g{XB1, WST, M, NS, D}; pg8::StaticOrder S; S.init(M, NS, F.G, (int)blockIdx.x);
        pg8::EpiTopK E{SS2, IDS, GATES, EPS};
        pg8::Unit u;
        for (int i = 0; S.next(i, u); ++i) { OneUnit O{u}; pg8::gemm_phase<pg8::EpiTopK, OneUnit, false, PG8_SP2>(F.lds + RING_OFF, g, O, E, F.wave); }
    }
    SEAM(5);
    if (IN(6)) { p6a_upass(F, ws, XB1, IDS); xcd_barrier(bar); STAMPI(7); p6b_combine(F, ws, SS2, IDS, GATES); xcd_barrier(bar); STAMPI(8); p6c_vpass(F, ws, IDS, XB1, XB2, SS2); }
    SEAM(6);
    if (IN(7)) {
        pg8::Gemm g{WSP(bf16, WS_XB2_8), WPG, M, D, D / 2}; pg8::StaticOrder S; S.init(M, D, F.G, (int)blockIdx.x);
        LAS float* rtab = (LAS float*)(F.lds + RING_OFF + pg8::STAGE_BYTES);
        const bool one = (M / 256) * (D / 256) <= F.G; pg8::Unit u0;
        if (one && S.next(0, u0) && F.tid_() < 256) { const float* sp = SS2 + (size_t)(u0.pm * 256 + F.tid_()) * 16; float q = 0.f;
#pragma unroll
            for (int j = 0; j < NSL; ++j) q += sp[j];
            rtab[F.tid_()] = 1.0f / sqrtf(q * (1.0f / D) + EPS); }
        __syncthreads();
        pg8::EpiPle E{SS2, PP, XB2, WSP(bf16, WS_XB3), WSP(float, WS_SS4), EPS, 1.0f / 32.0f, one ? (const LAS float*)rtab : (const LAS float*)nullptr};
        pg8::gemm_phase<pg8::EpiPle, pg8::StaticOrder, PG8_ALIGN, PG8_SP2, true>(F.lds + RING_OFF, g, S, E, F.wave);
    }
    SEAM(7);
    if (IN(8)) { p8_final(F, WSP(bf16, WS_XB3), WSP(float, WS_SS4), out, args.in[17]); }
    STAMPI(11);
#ifdef MK_PROBE_SEG
    if (blockIdx.x == 0 && F.tid_() == 0) {
        asm volatile("s_waitcnt vmcnt(0)" ::: "memory");
        const unsigned long long* st_ = (const unsigned long long*)(args.ws + 32768);
#if MK_PROBE_SEG >= 100 && MK_PROBE_SEG != 200
        const unsigned long long a_ = st_[32 + (MK_PROBE_SEG - 100)], b_ = (MK_PROBE_SEG - 100 == 4) ? st_[1] : st_[33 + (MK_PROBE_SEG - 100)];
#else
        const unsigned long long a_ = st_[MK_PROBE_SEG == 200 ? 0 : MK_PROBE_SEG], b_ = st_[MK_PROBE_SEG == 200 ? 11 : MK_PROBE_SEG + 1];
#endif
        const unsigned long long dt_ = (b_ - a_) * MK_PROBE_MULT, t0_ = __builtin_amdgcn_s_memrealtime();
        while (__builtin_amdgcn_s_memrealtime() - t0_ < dt_) __builtin_amdgcn_s_sleep(8);
    }
#endif
#undef IN
#undef SEAM
#undef WSP
#undef RSTD1
#undef SS2
#undef LF
#undef WIN
#undef WBR
#undef WOUT
#undef WST
#undef WPG
#undef WPP
#undef PB
#undef XB
#undef AC
#undef XB1
#undef PP
#undef Q
#undef K
#undef V
#undef GB
#undef Z
#undef MG
#undef XB2
#undef IDS
#undef GATES
#undef SGA
#undef SGC
}

extern "C" void kernel_launch(void* const* d_in, const int* in_sizes, int n_in, void* d_out, int out_size, void* d_ws, size_t ws_size, hipStream_t stream) {
    static int grid = 0;
    if (grid == 0) {
        if (n_in != 18 || in_sizes[0] != M * D || out_size != M * D || ws_size < WS_END) { fprintf(stderr, "kernel_launch: unexpected shapes (n_in %d, in0 %d, out %d, ws %zu); nothing launched\n", n_in, n_in > 0 ? in_sizes[0] : -1, out_size, ws_size); grid = -1; return; }
        int dev = 0, cus = 0, per_cu = 0;
        if (hipGetDevice(&dev) != hipSuccess || hipDeviceGetAttribute(&cus, hipDeviceAttributeMultiprocessorCount, dev) != hipSuccess) { fprintf(stderr, "kernel_launch: device query failed\n"); grid = -1; return; }
        if (hipFuncSetAttribute((const void*)mk_fwd, hipFuncAttributeMaxDynamicSharedMemorySize, LDS_BYTES) != hipSuccess) { fprintf(stderr, "kernel_launch: hipFuncSetAttribute failed\n"); grid = -1; return; }
        if (hipOccupancyMaxActiveBlocksPerMultiprocessor(&per_cu, (const void*)mk_fwd, NWAVES * 64, LDS_BYTES) != hipSuccess || per_cu < 1) { fprintf(stderr, "kernel_launch: occupancy query says %d workgroups per CU; nothing launched\n", per_cu); (void)hipGetLastError(); grid = -1; return; }
        grid = cus;
    }
    if (grid < 0) return;
    if (hipMemsetAsync((char*)d_ws + WS_CTL, 0, CTL_ZERO_BYTES, stream) != hipSuccess) { fprintf(stderr, "kernel_launch: hipMemsetAsync failed\n"); return; }
    Args a{};
    for (int i = 0; i < 18; ++i) a.in[i] = (const float*)d_in[i];
    a.out = (float*)d_out; a.ws = (unsigned char*)d_ws; a.ph_lo = 0; a.ph_hi = NPHASE; a.li = 0; a.pad = 0;
    hipLaunchKernelGGL(mk_fwd, dim3(grid), dim3(NWAVES * 64), LDS_BYTES, stream, a);
    const hipError_t le = hipPeekAtLastError();
    if (le != hipSuccess) fprintf(stderr, "kernel_launch: launch failed: %s\n", hipGetErrorName(le));
}
```

```cpp
#include <hip/hip_runtime.h>
#include <hip/hip_bf16.h>
#include <cstdio>
#include <cstdint>
#include <cmath>
namespace pg8 {
#define PG8_LAS __attribute__((address_space(3)))
typedef unsigned short bf16_t;
typedef short bf16x8 __attribute__((ext_vector_type(8)));
typedef float f32x4 __attribute__((ext_vector_type(4)));
typedef unsigned u32x4 __attribute__((ext_vector_type(4)));
constexpr int BM = 256, BK = 64, HALF = 128, HTB = HALF * BK * 2  , STAGE_BYTES = 8 * HTB, NXCD = 8, WGM = 8;

__host__ __device__ __forceinline__ int lds_byte(int r, int c) { const int st = (r >> 4) * 2 + (c >> 5), rr = r & 15, cc = c & 31, ob = rr * 64 + cc * 2; return st * 1024 + (ob ^ (((ob >> 9) & 1) << 5)); }
__host__ __device__ __forceinline__ void stage_rc(int b, int& R, int& C) { const int st = b / 1024, sb = b % 1024, swz = sb ^ (((sb >> 9) & 1) << 5); R = (st >> 1) * 16 + swz / 64; C = (st & 1) * 32 + (swz % 64) / 2; }
__host__ __device__ __forceinline__ int perm32(int rho) { const int n = rho >> 4, i = rho & 15; return 8 * (i >> 2) + 4 * n + (i & 3); }

struct Unit { int pm, pn; };
struct Gemm { const bf16_t* A; const bf16_t* Bt; int M, N, K; };

struct StaticOrder {
    int nM, nN, nwg, G, c;
    __host__ __device__ __forceinline__ void init(int M, int N, int G_, int c_) { nM = M / BM; nN = N / BM; nwg = nM * nN; G = G_; c = c_; }
    __host__ __device__ __forceinline__ bool next(int i, Unit& u) const {
        const long L = (long)i * G + c; if (L >= nwg) return false;
        int wgid = (int)L; { const int q = nwg / NXCD, r = nwg % NXCD, xcd = wgid % NXCD, off = wgid / NXCD; wgid = (xcd < r ? xcd * (q + 1) : r * (q + 1) + (xcd - r) * q) + off; }
        const int nig = WGM * nN, gid = wgid / nig, fm = gid * WGM, gsz = (nM - fm) < WGM ? (nM - fm) : WGM;
        u.pm = fm + ((wgid % nig) % gsz); u.pn = (wgid % nig) / gsz; return true;
    }
    __device__ __forceinline__ void a_ready(const Unit&) const {}
    __device__ __forceinline__ void done(const Unit&) const {}
};


__device__ __forceinline__ unsigned cvt_pk_bf16(float lo, float hi) { unsigned r; asm volatile("v_cvt_pk_bf16_f32 %0, %1, %2" : "=v"(r) : "v"(lo), "v"(hi)); return r; }
__device__ __forceinline__ u32x4 pack8(const f32x4 v0, const f32x4 v1) { u32x4 w; w.x = cvt_pk_bf16(v0[0], v0[1]); w.y = cvt_pk_bf16(v0[2], v0[3]); w.z = cvt_pk_bf16(v1[0], v1[1]); w.w = cvt_pk_bf16(v1[2], v1[3]); return w; }
__device__ __forceinline__ float bflo(unsigned w) { return __uint_as_float(w << 16); }
__device__ __forceinline__ float bfhi(unsigned w) { return __uint_as_float(w & 0xffff0000u); }
__device__ __forceinline__ float sigm(float v) { return __builtin_amdgcn_rcpf(1.0f + __builtin_amdgcn_exp2f(v * -1.4426950408889634f)); }
__device__ __forceinline__ f32x4 sigm4(const f32x4 v) { return (f32x4){sigm(v[0]), sigm(v[1]), sigm(v[2]), sigm(v[3])}; }

__device__ __forceinline__ float sum_fq(float v) {
    { const auto s_ = __builtin_amdgcn_permlane16_swap(__float_as_uint(v), __float_as_uint(v), false, false); v = __uint_as_float(s_[0]) + __uint_as_float(s_[1]); }
    { const auto s_ = __builtin_amdgcn_permlane32_swap(__float_as_uint(v), __float_as_uint(v), false, false); v = __uint_as_float(s_[0]) + __uint_as_float(s_[1]); }
    return v;
}
struct EpiIn {
    static constexpr int PROBE_ID = 1;
    static constexpr bool PERM = true, AFTER_DRAIN = false; static constexpr int MID_T = 0;
    const float* rstd; bf16_t* QKVG; size_t stride4; bf16_t* Z; bf16_t* SG; size_t strideSG; float c2;
    __device__ __forceinline__ void operator()(const f32x4 (&acc)[2][2][4][2], const Unit& u, int wr, int wc, int fr, int fq) const {
        int t_l = (int)__builtin_amdgcn_mbcnt_hi(~0u, __builtin_amdgcn_mbcnt_lo(~0u, 0u)); asm volatile("" : "+v"(t_l)); fr = t_l & 15; fq = t_l >> 4;
        const int row0 = u.pm * BM + wr * 64 + fr; const int cl = wc * 32 + 8 * fq, pn = u.pn;
        if (pn < 4) {
            bf16_t* base = QKVG + (size_t)(2 + (pn >> 1)) * stride4; const int colt = (pn & 1) * 256 + cl; const float s0 = 1.f;
#pragma unroll
            for (int ai = 0; ai < 2; ++ai)
#pragma unroll
                for (int m = 0; m < 4; ++m) { const int row = row0 + ai * HALF + m * 16; const float sc = rstd[row] * s0; bf16_t* rowp = base + (size_t)row * 512 + colt;
#pragma unroll
                    for (int bj = 0; bj < 2; ++bj) *(u32x4*)(rowp + bj * HALF) = pack8(acc[ai][bj][m][0] * sc, acc[ai][bj][m][1] * sc);
                    asm volatile("" ::: "memory"); }
        } else if (pn < 8) {
            const int colt = (pn - 4) * 128 + cl;
#pragma unroll
            for (int ai = 0; ai < 2; ++ai)
#pragma unroll
                for (int m = 0; m < 4; ++m) { const int row = row0 + ai * HALF + m * 16; const float r = rstd[row], sc = r * r;
                    *(u32x4*)(Z + (size_t)row * 512 + colt) = pack8(acc[ai][0][m][0] * acc[ai][1][m][0] * sc, acc[ai][0][m][1] * acc[ai][1][m][1] * sc);
                    asm volatile("" ::: "memory"); }
        }
    }
};
struct EpiGate {
    static constexpr int PROBE_ID = 8;
    static constexpr bool PERM = true, AFTER_DRAIN = false; static constexpr int MID_T = 0;
    const float* rstd; bf16_t* SG; size_t strideSG; float wsc; bf16_t* QK; size_t stride4; float c2;
    __device__ __forceinline__ void operator()(const f32x4 (&acc)[2][2][4][2], const Unit& u, int wr, int wc, int fr, int fq) const {
        int t_l = (int)__builtin_amdgcn_mbcnt_hi(~0u, __builtin_amdgcn_mbcnt_lo(~0u, 0u)); asm volatile("" : "+v"(t_l)); fr = t_l & 15; fq = t_l >> 4;
        const int row0 = u.pm * BM + wr * 64 + fr; const int cl = wc * 32 + 8 * fq;
        if (u.pn >= 8) {
            const int pq = u.pn - 8; bf16_t* base = QK + (size_t)(pq >> 1) * stride4; const int colq = (pq & 1) * 256 + cl; const float s0 = (pq < 2 ? c2 : 1.f) * wsc;
#pragma unroll
            for (int ai = 0; ai < 2; ++ai)
#pragma unroll
                for (int m = 0; m < 4; ++m) { const int row = row0 + ai * HALF + m * 16; const float sc = rstd[row] * s0; bf16_t* rowp = base + (size_t)row * 512 + colq;
#pragma unroll
                    for (int bj = 0; bj < 2; ++bj) *(u32x4*)(rowp + bj * HALF) = pack8(acc[ai][bj][m][0] * sc, acc[ai][bj][m][1] * sc);
                    asm volatile("" ::: "memory"); }
        } else {
            const int colt = u.pn * 128 + cl;
#pragma unroll
            for (int ai = 0; ai < 2; ++ai)
#pragma unroll
                for (int m = 0; m < 4; ++m) { const int row = row0 + ai * HALF + m * 16; const float r = rstd[row] * wsc;
                    unsigned qa_[2] = {0u, 0u}, qc_[2] = {0u, 0u};
#pragma unroll
                    for (int n = 0; n < 2; ++n) {
#pragma unroll
                        for (int e = 0; e < 4; ++e) { const float ea = __builtin_amdgcn_exp2f(acc[ai][0][m][n][e] * r * -1.4426950408889634f), ec = __builtin_amdgcn_exp2f(acc[ai][1][m][n][e] * r * -1.4426950408889634f);
                            const float fa = fmaf(__builtin_amdgcn_rcpf(1.0f + ea), 255.0f, 0.5f), fc = fmaxf(fmaf(__builtin_amdgcn_rcpf(1.0f + ec), 255.0f, 0.5f), 1.0f);
                            qa_[n] |= (unsigned)fa << (8 * e); qc_[n] |= (unsigned)fc << (8 * e); } }
                    *(u32x4*)((unsigned char*)SG + ((size_t)row * 128 + (u.pn * 16 + wc * 4 + fq)) * 16) = (u32x4){qa_[0], qa_[1], qc_[0], qc_[1]};
                    asm volatile("" ::: "memory"); }
        }
    }
};
struct EpiPlain {
    static constexpr int PROBE_ID = 2;
    static constexpr bool PERM = true, AFTER_DRAIN = false; static constexpr int MID_T = 0;
    bf16_t* O; int ldc;
    __device__ __forceinline__ void operator()(const f32x4 (&acc)[2][2][4][2], const Unit& u, int wr, int wc, int fr, int fq) const {
        int t_l = (int)__builtin_amdgcn_mbcnt_hi(~0u, __builtin_amdgcn_mbcnt_lo(~0u, 0u)); asm volatile("" : "+v"(t_l)); fr = t_l & 15; fq = t_l >> 4;
        const int row0 = u.pm * BM + wr * 64 + fr; const int col0 = u.pn * BM + wc * 32 + 8 * fq;
#pragma unroll
        for (int ai = 0; ai < 2; ++ai)
#pragma unroll
            for (int m = 0; m < 4; ++m) { bf16_t* rowp = O + (size_t)(row0 + ai * HALF + m * 16) * ldc + col0;
#pragma unroll
                for (int bj = 0; bj < 2; ++bj) *(u32x4*)(rowp + bj * HALF) = pack8(acc[ai][bj][m][0], acc[ai][bj][m][1]); }
    }
};
struct EpiBranch {
    static constexpr int PROBE_ID = 3;
    static constexpr bool PERM = true, AFTER_DRAIN = false; static constexpr int MID_T = 8;
    const bf16_t *SGA, *SGC; bf16_t* MG;
    __device__ __forceinline__ void mid(f32x4 (&acc)[2][2][4][2], const Unit& u, int wr, int wc, int fr, int fq) const {
        int t_l = (int)__builtin_amdgcn_mbcnt_hi(~0u, __builtin_amdgcn_mbcnt_lo(~0u, 0u)); asm volatile("" : "+v"(t_l)); fr = t_l & 15; fq = t_l >> 4;
        const int row0 = u.pm * BM + wr * 64 + fr; const int col0 = u.pn * BM + wc * 32 + 8 * fq;
#pragma unroll
        for (int ai = 0; ai < 2; ++ai) {
            u32x4 a[4][2];
#pragma unroll
            for (int m = 0; m < 4; ++m)
#pragma unroll
                for (int bj = 0; bj < 2; ++bj) a[m][bj] = *(const u32x4*)((const unsigned char*)SGA + ((size_t)(row0 + ai * HALF + m * 16) * 128 + (col0 >> 3) + bj * 16) * 16);
#pragma unroll
            for (int m = 0; m < 4; ++m)
#pragma unroll
                for (int bj = 0; bj < 2; ++bj) { const u32x4 av = a[m][bj];
#pragma unroll
                    for (int n = 0; n < 2; ++n)
#pragma unroll
                        for (int e = 0; e < 4; ++e) acc[ai][bj][m][n][e] *= (float)((av[n] >> (8 * e)) & 255u) * __builtin_amdgcn_rcpf((float)((av[2 + n] >> (8 * e)) & 255u)); }
            asm volatile("" ::: "memory");
        }
    }
    __device__ __forceinline__ void operator()(const f32x4 (&acc)[2][2][4][2], const Unit& u, int wr, int wc, int fr, int fq) const {
        int t_l = (int)__builtin_amdgcn_mbcnt_hi(~0u, __builtin_amdgcn_mbcnt_lo(~0u, 0u)); asm volatile("" : "+v"(t_l)); fr = t_l & 15; fq = t_l >> 4;
        const int row0 = u.pm * BM + wr * 64 + fr; const int col0 = u.pn * BM + wc * 32 + 8 * fq;
#pragma unroll
        for (int ai = 0; ai < 2; ++ai) {
            u32x4 c[4][2];
#pragma unroll
            for (int m = 0; m < 4; ++m)
#pragma unroll
                for (int bj = 0; bj < 2; ++bj) c[m][bj] = *(const u32x4*)((const unsigned char*)SGA + ((size_t)(row0 + ai * HALF + m * 16) * 128 + (col0 >> 3) + bj * 16) * 16);
#pragma unroll
            for (int m = 0; m < 4; ++m)
#pragma unroll
                for (int bj = 0; bj < 2; ++bj) { const u32x4 cv = c[m][bj];
                    f32x4 s0, s1;
#pragma unroll
                    for (int e = 0; e < 4; ++e) { s0[e] = (float)((cv[2] >> (8 * e)) & 255u) * (1.0f / 255.0f); s1[e] = (float)((cv[3] >> (8 * e)) & 255u) * (1.0f / 255.0f); }
                    *(u32x4*)(MG + (size_t)(row0 + ai * HALF + m * 16) * 1024 + col0 + bj * HALF) = pack8(acc[ai][bj][m][0] * s0, acc[ai][bj][m][1] * s1); }
            asm volatile("" ::: "memory");
        }
    }
};
struct EpiOut {
    static constexpr int PROBE_ID = 4;
    static constexpr bool PERM = true, AFTER_DRAIN = false; static constexpr int MID_T = 0;
    const bf16_t* XBin; bf16_t* XB1; float* SS2;
    __device__ __forceinline__ void operator()(const f32x4 (&acc)[2][2][4][2], const Unit& u, int wr, int wc, int fr, int fq) const {
        int t_l = (int)__builtin_amdgcn_mbcnt_hi(~0u, __builtin_amdgcn_mbcnt_lo(~0u, 0u)); asm volatile("" : "+v"(t_l)); fr = t_l & 15; fq = t_l >> 4;
        const int row0 = u.pm * BM + wr * 64 + fr; const int col0 = u.pn * BM + wc * 32 + 8 * fq;
#pragma unroll
        for (int ai = 0; ai < 2; ++ai) {
            u32x4 xq[4][2];
#pragma unroll
            for (int m = 0; m < 4; ++m)
#pragma unroll
                for (int bj = 0; bj < 2; ++bj) xq[m][bj] = *(const u32x4*)(XBin + (size_t)(row0 + ai * HALF + m * 16) * 1024 + col0 + bj * HALF);
#pragma unroll
            for (int m = 0; m < 4; ++m) { const int row = row0 + ai * HALF + m * 16; float ss = 0.f;
#pragma unroll
                for (int bj = 0; bj < 2; ++bj) { const u32x4 q = xq[m][bj];
                    const f32x4 v0 = acc[ai][bj][m][0] + (f32x4){bflo(q[0]), bfhi(q[0]), bflo(q[1]), bfhi(q[1])}, v1 = acc[ai][bj][m][1] + (f32x4){bflo(q[2]), bfhi(q[2]), bflo(q[3]), bfhi(q[3])};
                    *(u32x4*)(XB1 + (size_t)row * 1024 + col0 + bj * HALF) = pack8(v0, v1);
                    ss += (v0[0] * v0[0] + v0[1] * v0[1]) + (v0[2] * v0[2] + v0[3] * v0[3]) + (v1[0] * v1[0] + v1[1] * v1[1]) + (v1[2] * v1[2] + v1[3] * v1[3]); }
                ss = sum_fq(ss);
                if (fq == 0) SS2[(size_t)row * 16 + u.pn * 4 + wc] = ss; }
            asm volatile("" ::: "memory");
        }
    }
};
struct EpiPle {
    static constexpr int PROBE_ID = 7;
    static constexpr bool PERM = true, AFTER_DRAIN = false; static constexpr int MID_T = 0;
    const float* SS3; const bf16_t* PP; const bf16_t* XB2; bf16_t* XB3; float* SS4; float eps; float wsc; const PG8_LAS float* rtab;
    __device__ __forceinline__ void operator()(const f32x4 (&acc)[2][2][4][2], const Unit& u, int wr, int wc, int fr, int fq) const {
        int t_l = (int)__builtin_amdgcn_mbcnt_hi(~0u, __builtin_amdgcn_mbcnt_lo(~0u, 0u)); asm volatile("" : "+v"(t_l)); fr = t_l & 15; fq = t_l >> 4;
        const int row0 = u.pm * BM + wr * 64 + fr; const int col0 = u.pn * BM + wc * 32 + 8 * fq;
#pragma unroll
        for (int ah = 0; ah < 4; ++ah) {
            const int ai = ah >> 1, m0 = (ah & 1) * 2;
            u32x4 pv[2][2], xb[2][2]; float rr[2];
#pragma unroll
            for (int mm = 0; mm < 2; ++mm) { const int m = m0 + mm; const int row = row0 + ai * HALF + m * 16;
#pragma unroll
                for (int bj = 0; bj < 2; ++bj) { const size_t off = (size_t)row * 1024 + col0 + bj * HALF; pv[mm][bj] = *(const u32x4*)(PP + off); xb[mm][bj] = *(const u32x4*)(XB2 + off); }
                if (rtab) rr[mm] = rtab[wr * 64 + fr + ai * HALF + m * 16];
                else { const f32x4* sp = (const f32x4*)(SS3 + (size_t)row * 16); const f32x4 q0 = sp[0], q1 = sp[1]; rr[mm] = 1.0f / sqrtf((((q0[0] + q0[1]) + (q0[2] + q0[3])) + ((q1[0] + q1[1]) + (q1[2] + q1[3]))) * (1.0f / 1024.0f) + eps); } }
#pragma unroll
            for (int mm = 0; mm < 2; ++mm) { const int m = m0 + mm; const int row = row0 + ai * HALF + m * 16; const float r = rr[mm] * wsc; float ss = 0.f;
#pragma unroll
                for (int bj = 0; bj < 2; ++bj) { const u32x4 c = pv[mm][bj], xq = xb[mm][bj]; const size_t off = (size_t)row * 1024 + col0 + bj * HALF;
                    const f32x4 p0 = {bflo(c[0]), bfhi(c[0]), bflo(c[1]), bfhi(c[1])}, p1 = {bflo(c[2]), bfhi(c[2]), bflo(c[3]), bfhi(c[3])};
                    const f32x4 x0 = {bflo(xq[0]), bfhi(xq[0]), bflo(xq[1]), bfhi(xq[1])}, x1 = {bflo(xq[2]), bfhi(xq[2]), bflo(xq[3]), bfhi(xq[3])};
                    const f32x4 v0 = x0 + sigm4(acc[ai][bj][m][0] * r) * p0, v1 = x1 + sigm4(acc[ai][bj][m][1] * r) * p1;
                    *(u32x4*)(XB3 + off) = pack8(v0, v1);
                    ss += (v0[0] * v0[0] + v0[1] * v0[1]) + (v0[2] * v0[2] + v0[3] * v0[3]) + (v1[0] * v1[0] + v1[1] * v1[1]) + (v1[2] * v1[2] + v1[3] * v1[3]); }
                ss = sum_fq(ss);
                if (fq == 0) SS4[(size_t)row * 16 + u.pn * 4 + wc] = ss; }
            asm volatile("" ::: "memory");
        }
    }
};

struct EpiPleNorm {
    static constexpr int PROBE_ID = 9;
    static constexpr bool PERM = true, AFTER_DRAIN = true; static constexpr int MID_T = 0;
    const bf16_t* PP; const bf16_t* XB2; float* OUT; const float* gfin; float* X; unsigned* cnt; float eps; float wsc; const PG8_LAS float* rtab;
    __device__ __forceinline__ void operator()(const f32x4 (&)[2][2][4][2], const Unit&, int, int, int, int) const {}
    __device__ __forceinline__ void fused(f32x4 (&acc)[2][2][4][2], const Unit& u, int wr, int wc, int fr, int fq, PG8_LAS unsigned char* lds, int wid, int lane) const {
        PG8_LAS float* P = (PG8_LAS float*)lds;
        PG8_LAS float* S = (PG8_LAS float*)(lds + 8192);
        const int row0 = u.pm * BM + wr * 64 + fr; const int col0 = u.pn * BM + wc * 32 + 8 * fq;
#pragma unroll
        for (int ah = 0; ah < 4; ++ah) {
            const int ai = ah >> 1, m0 = (ah & 1) * 2;
            u32x4 pv[2][2], xb[2][2]; float rr[2];
#pragma unroll
            for (int mm = 0; mm < 2; ++mm) { const int m = m0 + mm; const int row = row0 + ai * HALF + m * 16;
#pragma unroll
                for (int bj = 0; bj < 2; ++bj) { const size_t off = (size_t)row * 1024 + col0 + bj * HALF; pv[mm][bj] = *(const u32x4*)(PP + off); xb[mm][bj] = *(const u32x4*)(XB2 + off); }
                rr[mm] = rtab[wr * 64 + fr + ai * HALF + m * 16]; }
#pragma unroll
            for (int mm = 0; mm < 2; ++mm) { const int m = m0 + mm; const float r = rr[mm] * wsc; float ss = 0.f;
#pragma unroll
                for (int bj = 0; bj < 2; ++bj) { const u32x4 c = pv[mm][bj], xq = xb[mm][bj];
                    const f32x4 p0 = {bflo(c[0]), bfhi(c[0]), bflo(c[1]), bfhi(c[1])}, p1 = {bflo(c[2]), bfhi(c[2]), bflo(c[3]), bfhi(c[3])};
                    const f32x4 x0 = {bflo(xq[0]), bfhi(xq[0]), bflo(xq[1]), bfhi(xq[1])}, x1 = {bflo(xq[2]), bfhi(xq[2]), bflo(xq[3]), bfhi(xq[3])};
                    const f32x4 v0 = x0 + sigm4(acc[ai][bj][m][0] * r) * p0, v1 = x1 + sigm4(acc[ai][bj][m][1] * r) * p1;
                    acc[ai][bj][m][0] = v0; acc[ai][bj][m][1] = v1;
                    ss += (v0[0] * v0[0] + v0[1] * v0[1]) + (v0[2] * v0[2] + v0[3] * v0[3]) + (v1[0] * v1[0] + v1[1] * v1[1]) + (v1[2] * v1[2] + v1[3] * v1[3]); }
                ss = sum_fq(ss);
                if (fq == 0) P[(ai * HALF + wr * 64 + m * 16 + fr) * 4 + wc] = ss; }
            asm volatile("" ::: "memory");
        }
        asm volatile("s_waitcnt lgkmcnt(0)" ::: "memory"); __builtin_amdgcn_s_barrier(); asm volatile("" ::: "memory");
        const int row = wid * 32 + (lane & 31);
        if (lane < 32) { const f32x4 p = *(const PG8_LAS f32x4*)(P + row * 4);
            __hip_atomic_store(X + (size_t)(u.pm * BM + row) * 4 + u.pn, (p[0] + p[1]) + (p[2] + p[3]), __ATOMIC_RELAXED, __HIP_MEMORY_SCOPE_AGENT); }
        asm volatile("s_waitcnt vmcnt(0)" ::: "memory");
        if (lane == 0) __hip_atomic_fetch_add(cnt + 64 * u.pm, 1u, __ATOMIC_RELAXED, __HIP_MEMORY_SCOPE_AGENT);
        if (wid == 0) { unsigned sp_ = 0;
            while ((unsigned)__builtin_amdgcn_readfirstlane(__hip_atomic_load(cnt + 64 * u.pm, __ATOMIC_RELAXED, __HIP_MEMORY_SCOPE_AGENT)) < 32u) { __builtin_amdgcn_s_sleep(1); if (++sp_ > (1u << 22)) break; } }
        asm volatile("s_waitcnt vmcnt(0) lgkmcnt(0)" ::: "memory"); __builtin_amdgcn_s_barrier(); asm volatile("" ::: "memory");
        if (lane < 32) { const float* xs = X + (size_t)(u.pm * BM + row) * 4; float q = 0.f;
#pragma unroll
            for (int t = 0; t < 4; ++t) q += __hip_atomic_load(xs + t, __ATOMIC_RELAXED, __HIP_MEMORY_SCOPE_AGENT);
            S[row] = 1.0f / sqrtf(q * (1.0f / 1024.0f) + eps); }
        asm volatile("s_waitcnt vmcnt(0) lgkmcnt(0)" ::: "memory"); __builtin_amdgcn_s_barrier(); asm volatile("" ::: "memory");
        f32x4 gv[2][2];
#pragma unroll
        for (int bj = 0; bj < 2; ++bj) { gv[bj][0] = *(const f32x4*)(gfin + col0 + bj * HALF); gv[bj][1] = *(const f32x4*)(gfin + col0 + bj * HALF + 4); }
#pragma unroll
        for (int ai = 0; ai < 2; ++ai)
#pragma unroll
            for (int m = 0; m < 4; ++m) { const int rl = ai * HALF + wr * 64 + m * 16 + fr; const float rs = S[rl]; float* orow = OUT + (size_t)(u.pm * BM + rl) * 1024 + col0;
#pragma unroll
                for (int bj = 0; bj < 2; ++bj) { *(f32x4*)(orow + bj * HALF) = acc[ai][bj][m][0] * rs * gv[bj][0]; *(f32x4*)(orow + bj * HALF + 4) = acc[ai][bj][m][1] * rs * gv[bj][1]; } }
    }
};

__device__ __forceinline__ float vmaxf(float a, float b) { float r; asm("v_max_f32_e32 %0, %1, %2" : "=v"(r) : "v"(a), "v"(b)); return r; }
__device__ __forceinline__ float vminf(float a, float b) { float r; asm("v_min_f32_e32 %0, %1, %2" : "=v"(r) : "v"(a), "v"(b)); return r; }
__device__ __forceinline__ void sort16_desc(float (&a)[16]) {
#define TK_CE(i, j) do { const float hi_ = vmaxf(a[i], a[j]), lo_ = vminf(a[i], a[j]); a[i] = hi_; a[j] = lo_; } while (0)
    TK_CE(0, 13); TK_CE(1, 12); TK_CE(2, 15); TK_CE(3, 14); TK_CE(4, 8); TK_CE(5, 6); TK_CE(7, 11); TK_CE(9, 10);
    TK_CE(0, 5); TK_CE(1, 7); TK_CE(2, 9); TK_CE(3, 4); TK_CE(6, 13); TK_CE(8, 14); TK_CE(10, 15); TK_CE(11, 12);
    TK_CE(0, 1); TK_CE(2, 3); TK_CE(4, 5); TK_CE(6, 8); TK_CE(7, 9); TK_CE(10, 11); TK_CE(12, 13); TK_CE(14, 15);
    TK_CE(0, 2); TK_CE(1, 3); TK_CE(4, 10); TK_CE(5, 11); TK_CE(6, 7); TK_CE(8, 9); TK_CE(12, 14); TK_CE(13, 15);
    TK_CE(1, 2); TK_CE(3, 12); TK_CE(4, 6); TK_CE(5, 7); TK_CE(8, 10); TK_CE(9, 11); TK_CE(13, 14);
    TK_CE(1, 4); TK_CE(2, 6); TK_CE(5, 8); TK_CE(7, 10); TK_CE(9, 13); TK_CE(11, 14);
    TK_CE(2, 4); TK_CE(3, 6); TK_CE(9, 12); TK_CE(11, 13);
    TK_CE(3, 5); TK_CE(6, 8); TK_CE(7, 9); TK_CE(10, 12);
    TK_CE(3, 4); TK_CE(5, 6); TK_CE(7, 8); TK_CE(9, 10); TK_CE(11, 12);
    TK_CE(6, 7); TK_CE(8, 9);
#undef TK_CE
}
template <int L> __device__ __forceinline__ void merge16(float (&a)[16], const float (&b)[16]) {
#pragma unroll
    for (int i = 0; i < 16; ++i) if (15 - i < L) a[i] = vmaxf(a[i], b[15 - i]);
#pragma unroll
    for (int j = 8; j > 0; j >>= 1)
#pragma unroll
        for (int i = 0; i < 16; ++i) { const int l = i ^ j; if (l > i) { const float hi = vmaxf(a[i], a[l]), lo = vminf(a[i], a[l]); a[i] = hi; a[l] = lo; } }
}
struct EpiTopK {
    static constexpr int PROBE_ID = 5;
    static constexpr bool PERM = true, AFTER_DRAIN = true; static constexpr int MID_T = 0;
    static constexpr int RS = 260;
    const float* SS2; unsigned short* IDS; float* GATES; float eps;
    __device__ __forceinline__ void fused(f32x4 (&acc)[2][2][4][2], const Unit& u, int wr, int wc, int fr, int fq, PG8_LAS unsigned char* lds, int wid, int lane) const {
        PG8_LAS float* S = (PG8_LAS float*)lds;
        const int tid = wid * 64 + lane, row = tid & 127, grp = tid >> 7, half = grp >> 1, part = grp & 1;
#define TK_BAR() do { asm volatile("s_waitcnt lgkmcnt(0)" ::: "memory"); __builtin_amdgcn_s_barrier(); asm volatile("" ::: "memory"); } while (0)
#ifdef MK_PROBE_TOPK2
        for (int rep_ = 0; rep_ < MK_PROBE_TOPK2; ++rep_)
#endif
#pragma unroll
        for (int ai = 0; ai < 2; ++ai) {
#pragma unroll
            for (int m = 0; m < 4; ++m)
#pragma unroll
                for (int bj = 0; bj < 2; ++bj)
#pragma unroll
                    for (int n = 0; n < 2; ++n) *(PG8_LAS f32x4*)(S + (wr * 64 + m * 16 + fr) * RS + bj * HALF + wc * 32 + 8 * fq + 4 * n) = acc[ai][bj][m][n];
            TK_BAR();
            float T[16];
#ifdef MK_PROBE_TK1
            for (int rep1_ = 0; rep1_ < MK_PROBE_TK1; ++rep1_)
#endif
#pragma unroll
            for (int b = 0; b < 4; ++b) {
                float c[16];
#pragma unroll
                for (int q = 0; q < 4; ++q) { const f32x4 v = *(const PG8_LAS f32x4*)(S + row * RS + half * 128 + part * 64 + b * 16 + q * 4);
#pragma unroll
                    for (int e = 0; e < 4; ++e) c[q * 4 + e] = __uint_as_float((__float_as_uint(v[e]) & ~127u) | (unsigned)(part * 64 + b * 16 + q * 4 + e)); }
                sort16_desc(c);
                if (b == 0) {
#pragma unroll
                    for (int i = 0; i < 16; ++i) T[i] = c[i];
                } else merge16<16>(T, c);
            }
            TK_BAR();
#pragma unroll
            for (int q = 0; q < 4; ++q) *(PG8_LAS f32x4*)(S + tid * 16 + q * 4) = (f32x4){T[q * 4], T[q * 4 + 1], T[q * 4 + 2], T[q * 4 + 3]};
            TK_BAR();
            if (part == 0) {
                float c[16];
#pragma unroll
                for (int q = 0; q < 4; ++q) { const f32x4 v = *(const PG8_LAS f32x4*)(S + (tid + 128) * 16 + q * 4); c[q * 4] = v[0]; c[q * 4 + 1] = v[1]; c[q * 4 + 2] = v[2]; c[q * 4 + 3] = v[3]; }
                merge16<16>(T, c);
            }
            TK_BAR();
            if (part == 0) {
#pragma unroll
                for (int q = 0; q < 4; ++q) *(PG8_LAS f32x4*)(S + tid * 16 + q * 4) = (f32x4){T[q * 4], T[q * 4 + 1], T[q * 4 + 2], T[q * 4 + 3]};
            }
            TK_BAR();
#ifdef MK_PROBE_TK3
            for (int rep3_ = 0; rep3_ < MK_PROBE_TK3; ++rep3_)
#endif
            if (tid < 128) {
                float a1[16], a2[16];
#pragma unroll
                for (int q = 0; q < 4; ++q) { const f32x4 v = *(const PG8_LAS f32x4*)(S + (tid + 256) * 16 + q * 4);
#pragma unroll
                    for (int e = 0; e < 4; ++e) a2[q * 4 + e] = __uint_as_float(__float_as_uint(v[e]) & ~127u); }
#pragma unroll
                for (int i = 0; i < 16; ++i) a1[i] = __uint_as_float(__float_as_uint(T[i]) & ~127u);
#define TK_SUM(i, j) __uint_as_float((__float_as_uint(a1[i] + a2[j]) & ~255u) | (unsigned)((i) * 16 + (j)))
                float R[16], C[16];
#pragma unroll
                for (int j = 0; j < 16; ++j) R[j] = TK_SUM(0, j);
#pragma unroll
                for (int i = 1; i < 16; ++i) C[i - 1] = TK_SUM(i, 0);
                C[15] = 0.f;
                merge16<15>(R, C);
                C[0] = TK_SUM(1, 1); C[1] = TK_SUM(1, 2); C[2] = TK_SUM(1, 3); C[3] = TK_SUM(1, 4); C[4] = TK_SUM(1, 5); C[5] = TK_SUM(1, 6); C[6] = TK_SUM(1, 7);
                C[7] = TK_SUM(2, 1); C[8] = TK_SUM(2, 2); C[9] = TK_SUM(2, 3); C[10] = TK_SUM(2, 4); C[11] = TK_SUM(3, 1); C[12] = TK_SUM(3, 2); C[13] = TK_SUM(3, 3);
                C[14] = TK_SUM(4, 1); C[15] = TK_SUM(4, 2);
                sort16_desc(C);
                merge16<16>(R, C);
                C[0] = TK_SUM(5, 1); C[1] = TK_SUM(6, 1); C[2] = TK_SUM(7, 1);
                merge16<3>(R, C);
#undef TK_SUM
                const int rowg = u.pm * BM + ai * HALF + row;
                const f32x4* ssp = (const f32x4*)(SS2 + (size_t)rowg * 16); const f32x4 s0 = ssp[0], s1 = ssp[1], s2 = ssp[2], s3 = ssp[3];
                const float ssum = ((s0[0] + s0[1]) + (s0[2] + s0[3])) + ((s1[0] + s1[1]) + (s1[2] + s1[3])) + ((s2[0] + s2[1]) + (s2[2] + s2[3])) + ((s3[0] + s3[1]) + (s3[2] + s3[3]));
                const float rl = 1.4426950408889634f / sqrtf(ssum * (1.0f / 1024.0f) + eps);
                float ev[16], esum = 0.f; int idv[16];
#pragma unroll
                for (int r = 0; r < 16; ++r) { ev[r] = __builtin_amdgcn_exp2f((R[r] - R[0]) * rl); esum += ev[r];
                    const unsigned code = __float_as_uint(R[r]) & 255u;
                    const unsigned k1 = __float_as_uint(S[tid * 16 + (code >> 4)]) & 127u, k2 = __float_as_uint(S[(tid + 256) * 16 + (code & 15u)]) & 127u;
                    idv[r] = (int)(k1 * 128u + k2); }
                const float inv = 1.0f / esum;
                unsigned short* ip = IDS + (size_t)rowg * 128 + u.pn * 16; float* gp = GATES + (size_t)rowg * 128 + u.pn * 16;
#pragma unroll
                for (int q = 0; q < 2; ++q) { u32x4 w; w.x = (unsigned)idv[q * 8] | ((unsigned)idv[q * 8 + 1] << 16); w.y = (unsigned)idv[q * 8 + 2] | ((unsigned)idv[q * 8 + 3] << 16); w.z = (unsigned)idv[q * 8 + 4] | ((unsigned)idv[q * 8 + 5] << 16); w.w = (unsigned)idv[q * 8 + 6] | ((unsigned)idv[q * 8 + 7] << 16);
                    *(u32x4*)(ip + q * 8) = w; }
#pragma unroll
                for (int q = 0; q < 4; ++q) *(f32x4*)(gp + q * 4) = (f32x4){ev[q * 4] * inv, ev[q * 4 + 1] * inv, ev[q * 4 + 2] * inv, ev[q * 4 + 3] * inv};
            }
            TK_BAR();
        }
#undef TK_BAR
    }
};
template <class Epi, class Sched, bool ALIGN_EPI = false, bool SP2 = false, bool FP8 = false>
__device__ __forceinline__ void gemm_phase(PG8_LAS unsigned char* lds, const Gemm g, const Sched& S, const Epi& E, const int wid_in) {
    int lane_l = (int)__builtin_amdgcn_mbcnt_hi(~0u, __builtin_amdgcn_mbcnt_lo(~0u, 0u)); asm volatile("" : "+v"(lane_l));
    const int wid = wid_in, lane = lane_l, tid = wid * 64 + lane, wr = wid >> 2, wc = wid & 3, fr = lane & 15, fq = lane >> 4;
    const int K = g.K, nt = K / BK;
    unsigned voffA, voffB;
    { int R, C; stage_rc(tid * 16, R, C); const int Rb = Epi::PERM ? ((R & ~31) + perm32(R & 31)) : R;
        voffA = (unsigned)(R * K + C) * 2u; voffB = (unsigned)(Rb * K + C) * 2u; }
    const size_t rstep64 = (size_t)64 * K * 2;
    const size_t kstep = (size_t)(BK * 2);
    const size_t hstep = (size_t)HALF * K * 2;
    const size_t tstep = 2 * hstep;
    const unsigned ldsw = (unsigned)wid * 1024u;
    const int aoff = lds_byte(wr * 64 + fr, FP8 ? fq * 16 : fq * 8), boff = lds_byte(wc * 32 + fr, FP8 ? fq * 16 : fq * 8);
    constexpr int KSTR = FP8 ? 16 : 1024;
#define PG8_SA(b, h) (((b) * 2 + (h)) * HTB)
#define PG8_SB(b, h) ((4 + (b) * 2 + (h)) * HTB)
#define PG8_STAGE(bufoff, gbase, voff) do { _Pragma("unroll") for (int _i = 0; _i < 2; ++_i) \
        __builtin_amdgcn_global_load_lds((const unsigned*)((const char*)(gbase) + _i * rstep64 + (voff)), (PG8_LAS unsigned*)(lds + (bufoff) + ldsw + _i * 8192), 16, 0, 0); } while (0)
#define PG8_LDA(dst, b, h) do { _Pragma("unroll") for (int m = 0; m < 4; ++m) _Pragma("unroll") for (int k = 0; k < 2; ++k) dst[m][k] = *(const PG8_LAS v4i_t*)(lds + PG8_SA(b, h) + aoff + m * 2048 + k * KSTR); } while (0)
#define PG8_LDB(dst, b, h) do { _Pragma("unroll") for (int n = 0; n < 2; ++n) _Pragma("unroll") for (int k = 0; k < 2; ++k) dst[n][k] = *(const PG8_LAS v4i_t*)(lds + PG8_SB(b, h) + boff + n * 2048 + k * KSTR); } while (0)
#define PG8_MMA(ai, bj, At, Bt) do { __builtin_amdgcn_s_setprio(1); _Pragma("unroll") for (int m = 0; m < 4; ++m) _Pragma("unroll") for (int n = 0; n < 2; ++n) { \
        if constexpr (FP8) { const v8i_t b8_ = __builtin_shufflevector(Bt[n][0], Bt[n][1], 0, 1, 2, 3, 4, 5, 6, 7), a8_ = __builtin_shufflevector(At[m][0], At[m][1], 0, 1, 2, 3, 4, 5, 6, 7); \
            asm volatile("v_mfma_scale_f32_16x16x128_f8f6f4 %0, %1, %2, %0, %3, %3 op_sel_hi:[0,0,0]" : "+v"(acc[ai][bj][m][n]) : "v"(b8_), "v"(a8_), "v"(mxs_)); }     \
        else { _Pragma("unroll") for (int k = 0; k < 2; ++k) acc[ai][bj][m][n] = __builtin_amdgcn_mfma_f32_16x16x32_bf16(__builtin_bit_cast(bf16x8, Bt[n][k]), __builtin_bit_cast(bf16x8, At[m][k]), acc[ai][bj][m][n], 0, 0, 0); } } \
        __builtin_amdgcn_s_setprio(0); } while (0)
#define PG8_WAIT_V(n) asm volatile("s_waitcnt vmcnt(" #n ")" ::: "memory")
#define PG8_WAIT_L(n) asm volatile("s_waitcnt lgkmcnt(" #n ")" ::: "memory")
#define PG8_BAR __builtin_amdgcn_s_barrier()
#define PG8_SCHED __builtin_amdgcn_sched_barrier(0)
    Unit cur, nxt; int ui = 0;
    if (!S.next(0, cur)) return;
    f32x4 acc[2][2][4][2];
#pragma unroll
    for (int a = 0; a < 2; ++a)
#pragma unroll
        for (int b = 0; b < 2; ++b)
#pragma unroll
            for (int m = 0; m < 4; ++m)
#pragma unroll
                for (int n = 0; n < 2; ++n) acc[a][b][m][n] = (f32x4){0.f, 0.f, 0.f, 0.f};
    typedef int v4i_t __attribute__((ext_vector_type(4))); typedef int v8i_t __attribute__((ext_vector_type(8)));
    int mxs_ = 0x7f7f7f7f; asm volatile("" : "+v"(mxs_));
    v4i_t At[4][2], B0[2][2], B1[2][2];
    const char* cA = (const char*)g.A + (size_t)cur.pm * tstep; const char* cB = (const char*)g.Bt + (size_t)cur.pn * tstep;
    S.a_ready(cur);
    if constexpr (SP2) {
        PG8_STAGE(PG8_SB(0, 0), cB, voffB); PG8_STAGE(PG8_SB(0, 1), cB + hstep, voffB); PG8_STAGE(PG8_SA(0, 0), cA, voffA); PG8_STAGE(PG8_SA(0, 1), cA + hstep, voffA);
        if (wr == 1) PG8_BAR;
        PG8_WAIT_V(2); PG8_BAR;
        PG8_STAGE(PG8_SB(1, 0), cB + kstep, voffB); PG8_STAGE(PG8_SA(1, 0), cA + kstep, voffA); PG8_STAGE(PG8_SB(1, 1), cB + hstep + kstep, voffB);
        PG8_WAIT_V(6); PG8_BAR;
    } else {
        PG8_STAGE(PG8_SB(0, 0), cB, voffB); PG8_STAGE(PG8_SA(0, 0), cA, voffA); PG8_STAGE(PG8_SB(0, 1), cB + hstep, voffB); PG8_STAGE(PG8_SA(0, 1), cA + hstep, voffA);
        if (wr == 1) PG8_BAR;
        PG8_WAIT_V(4); PG8_BAR;
        PG8_STAGE(PG8_SB(1, 0), cB + kstep, voffB); PG8_STAGE(PG8_SA(1, 0), cA + kstep, voffA); PG8_STAGE(PG8_SB(1, 1), cB + hstep + kstep, voffB);
        PG8_WAIT_V(6); PG8_BAR;
    }
    for (;;) {
        const bool has_next = S.next(ui + 1, nxt);
        const char* nA = has_next ? (const char*)g.A + (size_t)nxt.pm * tstep : cA; const char* nB = has_next ? (const char*)g.Bt + (size_t)nxt.pn * tstep : cB;
#pragma nounroll
        for (int t = 0; t < nt; t += 2) {
            if constexpr (Epi::MID_T > 0) { if (t == Epi::MID_T) E.mid(acc, cur, wr, wc, fr, fq); }
            const bool last = (t == nt - 2);
            const char* a1 = cA + (size_t)(t + 1) * kstep;
            const char* a2 = last ? nA : cA + (size_t)(t + 2) * kstep; const char* b2 = last ? nB : cB + (size_t)(t + 2) * kstep;
            const char* a3 = a2 + kstep; const char* b3 = b2 + kstep;
            if (last && has_next) S.a_ready(nxt);
            if constexpr (SP2) {
            PG8_LDB(B0, 0, 0); PG8_LDB(B1, 0, 1); PG8_SCHED; PG8_LDA(At, 0, 0); PG8_STAGE(PG8_SA(1, 1), a1 + hstep, voffA);
            PG8_WAIT_V(8); PG8_WAIT_L(0); PG8_BAR; PG8_MMA(0, 0, At, B0); PG8_MMA(0, 1, At, B1); PG8_BAR; PG8_SCHED;
            PG8_LDA(At, 0, 1); PG8_STAGE(PG8_SB(0, 0), b2, voffB); PG8_STAGE(PG8_SB(0, 1), b2 + hstep, voffB); PG8_STAGE(PG8_SA(0, 0), a2, voffA);
            PG8_WAIT_V(8); PG8_WAIT_L(0); PG8_BAR; PG8_MMA(1, 0, At, B0); PG8_MMA(1, 1, At, B1); PG8_BAR; PG8_SCHED;
            PG8_LDB(B0, 1, 0); PG8_LDB(B1, 1, 1); PG8_SCHED; PG8_LDA(At, 1, 0); PG8_STAGE(PG8_SA(0, 1), a2 + hstep, voffA);
            PG8_WAIT_V(8); PG8_WAIT_L(0); PG8_BAR; PG8_MMA(0, 0, At, B0); PG8_MMA(0, 1, At, B1); PG8_BAR; PG8_SCHED;
            PG8_LDA(At, 1, 1); PG8_STAGE(PG8_SB(1, 0), b3, voffB); PG8_STAGE(PG8_SB(1, 1), b3 + hstep, voffB); PG8_STAGE(PG8_SA(1, 0), a3, voffA);
            PG8_WAIT_V(8); PG8_WAIT_L(0); PG8_BAR; PG8_MMA(1, 0, At, B0); PG8_MMA(1, 1, At, B1); PG8_BAR; PG8_SCHED;
            } else {
            PG8_LDB(B0, 0, 0); PG8_SCHED; PG8_LDA(At, 0, 0); PG8_STAGE(PG8_SA(1, 1), a1 + hstep, voffA);
            PG8_WAIT_L(8); PG8_BAR; PG8_WAIT_L(0); PG8_MMA(0, 0, At, B0); PG8_BAR; PG8_SCHED;
            PG8_LDB(B1, 0, 1); PG8_STAGE(PG8_SB(0, 0), b2, voffB);
            PG8_BAR; PG8_WAIT_L(0); PG8_MMA(0, 1, At, B1); PG8_BAR;
            PG8_LDA(At, 0, 1); PG8_STAGE(PG8_SA(0, 0), a2, voffA);
            PG8_BAR; PG8_WAIT_L(0); PG8_MMA(1, 0, At, B0); PG8_BAR; PG8_SCHED;
            PG8_STAGE(PG8_SB(0, 1), b2 + hstep, voffB);
            PG8_WAIT_V(6); PG8_BAR; PG8_MMA(1, 1, At, B1); PG8_BAR;
            PG8_LDB(B0, 1, 0); PG8_SCHED; PG8_LDA(At, 1, 0); PG8_STAGE(PG8_SA(0, 1), a2 + hstep, voffA);
            PG8_WAIT_L(8); PG8_BAR; PG8_WAIT_L(0); PG8_MMA(0, 0, At, B0); PG8_BAR; PG8_SCHED;
            PG8_LDB(B1, 1, 1); PG8_STAGE(PG8_SB(1, 0), b3, voffB);
            PG8_BAR; PG8_WAIT_L(0); PG8_MMA(0, 1, At, B1); PG8_BAR;
            PG8_LDA(At, 1, 1); PG8_STAGE(PG8_SA(1, 0), a3, voffA);
            PG8_BAR; PG8_WAIT_L(0); PG8_MMA(1, 0, At, B0); PG8_BAR; PG8_SCHED;
            PG8_STAGE(PG8_SB(1, 1), b3 + hstep, voffB);
            PG8_WAIT_V(6); PG8_BAR; PG8_MMA(1, 1, At, B1); PG8_BAR;
            }
        }
        if constexpr (FP8) asm volatile("s_nop 15\n\ts_nop 7" ::: "memory");
        if constexpr (ALIGN_EPI) { if (wr == 0) PG8_BAR; }
#ifdef MK_PROBE_EPI2
        if constexpr (!Epi::AFTER_DRAIN && Epi::PROBE_ID == MK_PROBE_EPI_ID) { for (int rep_ = 1; rep_ < MK_PROBE_EPI2; ++rep_) E(acc, cur, wr, wc, fr, fq); }
#endif
        if constexpr (!Epi::AFTER_DRAIN) { E(acc, cur, wr, wc, fr, fq); S.done(cur); }
        if (!has_next) break;
#pragma unroll
        for (int a = 0; a < 2; ++a)
#pragma unroll
            for (int b = 0; b < 2; ++b)
#pragma unroll
                for (int m = 0; m < 4; ++m)
#pragma unroll
                    for (int n = 0; n < 2; ++n) acc[a][b][m][n] = (f32x4){0.f, 0.f, 0.f, 0.f};
        cur = nxt; cA = nA; cB = nB; ++ui;
        if constexpr (ALIGN_EPI) { if (wr == 1) PG8_BAR; }
    }
    PG8_WAIT_V(0);
    if constexpr (!ALIGN_EPI) { if (wr == 0) PG8_BAR; }
    PG8_BAR;
    if constexpr (Epi::AFTER_DRAIN) { E.fused(acc, cur, wr, wc, fr, fq, lds, wid, lane); S.done(cur); }
#undef PG8_SA
#undef PG8_SB
#undef PG8_STAGE
#undef PG8_LDA
#undef PG8_LDB
#undef PG8_MMA
#undef PG8_WAIT_V
#undef PG8_WAIT_L
#undef PG8_BAR
#undef PG8_SCHED
}
}
#ifndef PG8_SP2
#define PG8_SP2 true
#endif
#ifndef PG8_ALIGN
#define PG8_ALIGN true
#endif
namespace attn_body {
using bf16=__hip_bfloat16;
using bf16x8=__attribute__((ext_vector_type(8)))short;
using s16x4=__attribute__((ext_vector_type(4)))short;
using f32x16=__attribute__((ext_vector_type(16)))float;
using u32x4=__attribute__((ext_vector_type(4)))unsigned;
using f32x4v=__attribute__((ext_vector_type(4)))float;
constexpr int BATCH=4,NHEAD=8,SEQ=4096,D=64,DM=NHEAD*D,DMO=1024;
constexpr int NW=8,QBLK=32,QB=QBLK*NW,KVBLK=64,NQB=SEQ/QB;
constexpr int ATTN_PITCH=DM, ATTN_UNIT_ROWS=QB;
__device__ __forceinline__ int crow(int r,int hi){return (r&3)+8*(r>>2)+4*hi;}
#define SBAR() __builtin_amdgcn_sched_barrier(0)
__device__ __forceinline__ void cmask(f32x16&p0,f32x16&p1,int jb,int qrel,int hi){
  const float NEG=-INFINITY; int kb=64*jb+4*hi;
  #pragma unroll
  for(int r=0;r<16;++r){int kv=kb+(r&3)+8*(r>>2); if(kv>qrel)p0[r]=NEG; if(kv+32>qrel)p1[r]=NEG;}
}

constexpr int NSLOT=3, SLOTB=8192;
constexpr float SKIP_TH=64.0f;
constexpr int LDS_K=0, LDS_V=NSLOT*SLOTB, LDS_WS=2*NSLOT*SLOTB, LDS_OST=LDS_WS+NW*64*4, LDS_CS=LDS_OST+NW*4096, LDS_BYTES=LDS_CS+SEQ*4+64;
constexpr float C2=0.125f*1.4426950408889634f;
__device__ __forceinline__ void glds16(const void*gsrc,unsigned lds_dst){unsigned keep;
  asm volatile("s_mov_b32 %0, m0\n\ts_mov_b32 m0, %2\n\ts_nop 0\n\tglobal_load_lds_dwordx4 %1, off\n\ts_mov_b32 m0, %0":"=&s"(keep):"v"(gsrc),"s"(lds_dst):"memory");}
__device__ __forceinline__ float max3f(float a,float b,float c){float r;asm("v_max3_f32 %0, %1, %2, %3":"=v"(r):"v"(a),"v"(b),"v"(c));return r;}
__device__ __forceinline__ float max2f(float a,float b){float r;asm("v_max_f32_e32 %0, %1, %2":"=v"(r):"v"(a),"v"(b));return r;}
__device__ __forceinline__ float fadd_s(float a,float b){float r;asm("v_add_f32_e32 %0, %1, %2":"=v"(r):"v"(a),"v"(b));return r;}
__device__ __forceinline__ float fsub_s(float a,float b){float r;asm("v_sub_f32_e32 %0, %1, %2":"=v"(r):"v"(a),"v"(b));return r;}
typedef float f32x2_t __attribute__((ext_vector_type(2))); typedef __bf16 bf16x2_t __attribute__((ext_vector_type(2)));
__device__ __forceinline__ unsigned cvtpk_s(float lo,float hi){f32x2_t v={lo,hi};bf16x2_t b=__builtin_convertvector(v,bf16x2_t);return __builtin_bit_cast(unsigned,b);}
#define WAIT_BAR(N) asm volatile("s_waitcnt vmcnt(" #N ") lgkmcnt(0)\n\ts_barrier":::"memory")

__device__ __forceinline__ void qkt(f32x16&p0,f32x16&p1,const char*Kslot,const bf16x8*qr,const f32x16&c0,const f32x16&c1,int r32,int hi){
  const char*kb=Kslot+hi*1024+r32*16;
  #pragma unroll
  for(int d0=0;d0<4;++d0){
    const bf16x8 b0=*reinterpret_cast<const bf16x8*>(kb+d0*2048);
    const bf16x8 b1=*reinterpret_cast<const bf16x8*>(kb+d0*2048+512);
    if(d0==0){p0=__builtin_amdgcn_mfma_f32_32x32x16_bf16(b0,qr[0],c0,0,0,0);p1=__builtin_amdgcn_mfma_f32_32x32x16_bf16(b1,qr[0],c1,0,0,0);}
    else{p0=__builtin_amdgcn_mfma_f32_32x32x16_bf16(b0,qr[d0],p0,0,0,0);p1=__builtin_amdgcn_mfma_f32_32x32x16_bf16(b1,qr[d0],p1,0,0,0);}}
}
typedef __attribute__((address_space(3))) const char* lds_cptr;
typedef short v4i16_t __attribute__((ext_vector_type(4)));
__device__ __forceinline__ void kload8(bf16x8*kf,lds_cptr kp){
  kf[0]=*(const __attribute__((address_space(3))) bf16x8*)(kp);      kf[1]=*(const __attribute__((address_space(3))) bf16x8*)(kp+512);
  kf[2]=*(const __attribute__((address_space(3))) bf16x8*)(kp+2048); kf[3]=*(const __attribute__((address_space(3))) bf16x8*)(kp+2560);
  kf[4]=*(const __attribute__((address_space(3))) bf16x8*)(kp+4096); kf[5]=*(const __attribute__((address_space(3))) bf16x8*)(kp+4608);
  kf[6]=*(const __attribute__((address_space(3))) bf16x8*)(kp+6144); kf[7]=*(const __attribute__((address_space(3))) bf16x8*)(kp+6656);
}
__device__ __forceinline__ void kload2(bf16x8*kf,lds_cptr kp,int j){ kf[2*j]=*(const __attribute__((address_space(3))) bf16x8*)(kp+j*2048); kf[2*j+1]=*(const __attribute__((address_space(3))) bf16x8*)(kp+j*2048+512); }
__device__ __forceinline__ s16x4 vtr(lds_cptr p){ return __builtin_bit_cast(s16x4,__builtin_amdgcn_ds_read_tr16_b64_v4i16((__attribute__((address_space(3))) v4i16_t*)p)); }
__device__ __forceinline__ float rowmax(const f32x16&p0,const f32x16&p1){
  float a=max3f(p0[0],p0[1],p1[0]),b=max3f(p0[2],p0[3],p1[1]);a=max3f(a,p1[2],p1[3]);
  #pragma unroll
  for(int r=4;r<16;r+=4){a=max3f(a,p0[r],p0[r+1]);b=max3f(b,p0[r+2],p0[r+3]);a=max3f(a,p1[r],p1[r+1]);b=max3f(b,p1[r+2],p1[r+3]);}
  const float m=max2f(a,b);
  auto rr=__builtin_amdgcn_permlane32_swap(__float_as_uint(m),__float_as_uint(m),false,false);
  return max2f(__uint_as_float(rr[0]),__uint_as_float(rr[1]));
}
__device__ __forceinline__ void pv(f32x16*o,int vb,bf16x8 pa0,bf16x8 pa1,bf16x8 pa2,bf16x8 pa3){
  #pragma unroll
  for(int d0=0;d0<2;++d0){s16x4 lo[4],hi[4];
    #pragma unroll
    for(int ks=0;ks<4;++ks){
      asm volatile("ds_read_b64_tr_b16 %0,%1 offset:%c2":"=&v"(lo[ks]):"v"(vb),"i"(d0*4096+ks*1024):"memory");
      asm volatile("ds_read_b64_tr_b16 %0,%1 offset:%c2":"=&v"(hi[ks]):"v"(vb),"i"(d0*4096+ks*1024+512):"memory");}
    asm volatile("s_waitcnt lgkmcnt(0)":::"memory");SBAR();
    #define PK(k) (bf16x8){lo[k][0],lo[k][1],lo[k][2],lo[k][3],hi[k][0],hi[k][1],hi[k][2],hi[k][3]}
    o[d0]=__builtin_amdgcn_mfma_f32_32x32x16_bf16(pa0,PK(0),o[d0],0,0,0);
    o[d0]=__builtin_amdgcn_mfma_f32_32x32x16_bf16(pa1,PK(1),o[d0],0,0,0);
    o[d0]=__builtin_amdgcn_mfma_f32_32x32x16_bf16(pa2,PK(2),o[d0],0,0,0);
    o[d0]=__builtin_amdgcn_mfma_f32_32x32x16_bf16(pa3,PK(3),o[d0],0,0,0);
    #undef PK
  }
}

#ifndef ATTN_STORE16
#define ATTN_STORE16(p,v) (*(u32x4*)(p)=(v))
#endif
template<int THRL> __device__ __forceinline__ void attn_unit(int b,int h,int qb,const bf16*Q,const bf16*__restrict__ K,const bf16*__restrict__ V,bf16*O,const float*__restrict__ LFrow,char*shm){
  int tid_l=threadIdx.x; asm volatile("":"+v"(tid_l));
  const int tid=tid_l,lane=tid&63,r32=lane&31,hi=lane>>5; const int wid=__builtin_amdgcn_readfirstlane(tid>>6);
  const long rowbase=(long)b*SEQ; const int q0=qb*QB;
  const lds_cptr shm3=(lds_cptr)shm;
  typedef __attribute__((address_space(3))) float lds_f32; typedef __attribute__((address_space(3))) f32x4v lds_f32x4;
  lds_f32* const csl=(lds_f32*)(shm3+LDS_CS);
  { const int ncs=q0+QB, i0=tid*8; f32x4v ca={0.f,0.f,0.f,0.f},cb={0.f,0.f,0.f,0.f};
    if(i0<ncs){ca=*(const f32x4v*)(LFrow+i0);cb=*(const f32x4v*)(LFrow+i0+4);}
    ca.y+=ca.x;ca.z+=ca.y;ca.w+=ca.z;cb.x+=ca.w;cb.y+=cb.x;cb.z+=cb.y;cb.w+=cb.z;
    const float tot=cb.w; float inc=tot;
    _Pragma("unroll") for(int o_=1;o_<64;o_<<=1){const float v_=__shfl_up(inc,o_);if(lane>=o_)inc+=v_;}
    if(lane==63)csl[SEQ+wid]=inc;
    asm volatile("s_waitcnt vmcnt(0) lgkmcnt(0)\n\ts_barrier":::"memory");
    float base_=inc-tot;
    _Pragma("unroll") for(int w_=0;w_<NW;++w_){const float t_=csl[SEQ+w_];if(w_<wid)base_+=t_;}
    if(i0<ncs){*(lds_f32x4*)(csl+i0)=ca+base_;*(lds_f32x4*)(csl+i0+4)=cb+base_;}
    asm volatile("s_waitcnt vmcnt(0) lgkmcnt(0)\n\ts_barrier":::"memory"); }
  int ts; { const int NT0=(q0+QB)/KVBLK, cand=2*lane; bool ok=false;
    if(lane<32&&cand<=NT0-4) ok=(cand==0)||(csl[q0]-csl[64*cand-1]<=-SKIP_TH);
    const unsigned long long mk=__ballot(ok); ts=__builtin_amdgcn_readfirstlane(2*(63-__builtin_clzll(mk|1ull))); }
  const bf16*Qw=Q+(rowbase+q0+wid*QBLK)*DM+h*D;
  const bf16*Kh=K+(rowbase+(long)ts*KVBLK)*DM+h*D,*Vh=V+(rowbase+(long)ts*KVBLK)*DM+h*D;
  const unsigned lds0=(unsigned)(uintptr_t)shm;
  float*wsf=(float*)(shm+LDS_WS)+wid*64;
  const bf16*ksrc=Kh+(long)lane*DM+wid*8;
  const bf16*vsrc=Vh+(long)(16*(wid&3)+(lane>>2))*DM+(wid>>2)*32+(lane&3)*8;
  const unsigned kdst=lds0+LDS_K+wid*1024, vdst=lds0+LDS_V+wid*1024;
  #define DMA_K(t,slot) glds16(ksrc+(long)(t)*KVBLK*DM,(unsigned)__builtin_amdgcn_readfirstlane(kdst+(slot)))
  #define DMA_V(t,slot) glds16(vsrc+(long)(t)*KVBLK*DM,(unsigned)__builtin_amdgcn_readfirstlane(vdst+(slot)))
  const int vb0=(int)(lds0+LDS_V)+((lane>>4)&1)*32+(lane&3)*8+(4*hi+((lane&15)>>2))*64;
  const char*Kbase=shm+LDS_K; bf16x8 kf[8];
  const lds_cptr kp0=shm3+LDS_K+hi*1024+r32*16; const lds_cptr vp0=shm3+LDS_V+((lane>>4)&1)*32+(lane&3)*8+(4*hi+((lane&15)>>2))*64;
  const int NT=(q0+QB)/KVBLK-ts;
  const float cq=csl[q0+wid*QBLK+r32];
  const lds_cptr csb=shm3+LDS_CS+hi*16+ts*256;
  #define CINIT(C0,C1,t) do{ _Pragma("unroll") for(int g_=0;g_<4;++g_){ const f32x4v a_=*(const lds_f32x4*)(csb+(t)*256+g_*32), b_=*(const lds_f32x4*)(csb+(t)*256+128+g_*32); \
      C0[4*g_]=cqm-a_.x;C0[4*g_+1]=cqm-a_.y;C0[4*g_+2]=cqm-a_.z;C0[4*g_+3]=cqm-a_.w; C1[4*g_]=cqm-b_.x;C1[4*g_+1]=cqm-b_.y;C1[4*g_+2]=cqm-b_.z;C1[4*g_+3]=cqm-b_.w; } }while(0)
  DMA_K(0,0);DMA_V(0,0);DMA_K(1,SLOTB);
  bf16x8 qr[4];
  #pragma unroll
  for(int d0=0;d0<4;++d0)qr[d0]=*reinterpret_cast<const bf16x8*>(&Qw[(long)r32*DM+d0*16+hi*8]);
  float mhat=0.f,l_reg=0.f,cqm=cq;f32x16 o[2];o[0]=f32x16{};o[1]=f32x16{};
  const int qrel=wid*QBLK+r32;
  #define CMASK(P0,P1,t) do{int jb_=(t)-(NT-4); if(jb_>=0)cmask(P0,P1,jb_,qrel,hi);}while(0)
  bool resc=false;
  #define START(P0,P1) do{ const float rm=rowmax(P0,P1); resc=false; \
    { const float dl=rm; mhat=fadd_s(mhat,dl); \
      _Pragma("unroll") for(int r=0;r<16;++r){P0[r]=fsub_s(P0[r],dl);P1[r]=fsub_s(P1[r],dl);} \
      cqm=cq-mhat; } \
    _Pragma("unroll") for(int r=0;r<16;++r)P0[r]=__builtin_amdgcn_exp2f(P0[r]); }while(0)
  #define RESC() do{ if(resc){ asm volatile("s_waitcnt lgkmcnt(0)":::"memory"); \
      _Pragma("unroll") for(int d_=0;d_<2;++d_) _Pragma("unroll") for(int r=0;r<16;++r)o[d_][r]*=wsf[crow(r,hi)]; } }while(0)
  f32x16 pA0,pA1,pB0,pB1;
  int sl_prev=0,sl_cur=0,sl_next=SLOTB;
  #define ROT() do{sl_prev=sl_cur;sl_cur=sl_next;sl_next=(sl_next==(NSLOT-1)*SLOTB)?0:sl_next+SLOTB;}while(0)
  DMA_K(2,2*SLOTB);
  WAIT_BAR(3);
  { f32x16 ci0,ci1; CINIT(ci0,ci1,0); qkt(pA0,pA1,Kbase,qr,ci0,ci1,r32,hi); } asm volatile("s_nop 15\n\ts_nop 7":"+v"(pA0),"+v"(pA1));CMASK(pA0,pA1,0);
  START(pA0,pA1);
  _Pragma("unroll") for(int r=0;r<16;++r)pA1[r]=__builtin_amdgcn_exp2f(pA1[r]);
  WAIT_BAR(0);
  DMA_K(3,0);DMA_V(1,SLOTB);
  ROT();
  kload8(kf,kp0+sl_cur);
  WAIT_BAR(2);
  s16x4 vlo[8],vhi[8]; u32x4 pw0,pw1,pw2,pw3;
  #define PKW(P,B) cvtpk_s(P[B],P[B+1])
  #define PAF(k) __builtin_bit_cast(bf16x8,pw##k)
  #define VFR(i) (bf16x8){vlo[i][0],vlo[i][1],vlo[i][2],vlo[i][3],vhi[i][0],vhi[i][1],vhi[i][2],vhi[i][3]}
  #define PIN(x) asm volatile("":"+v"(x))
  #define MX3(a,b,c) __builtin_fmaxf(__builtin_fmaxf((a),(b)),(c))
  #define GAPA(MF,A0,A1,A2,A3,W0,W1,PW) do{ MF; sacc+=A0; sacc+=A1; sacc+=A2; sacc+=A3; PIN(sacc); W0; W1; PIN(PW); SBAR(); }while(0)
  #define EX(v) __builtin_amdgcn_exp2f(v)
  #define GAPB(MF,X,B) do{ MF; X[B]=EX(X[B]); X[B+1]=EX(X[B+1]); X[B+2]=EX(X[B+2]); X[B+3]=EX(X[B+3]); PIN(X); SBAR(); }while(0)
  #define VRD(i) do{ vlo[i]=vtr(vp_+(((i)>>2)*4096+((i)&3)*1024)); vhi[i]=vtr(vp_+(((i)>>2)*4096+((i)&3)*1024+512)); }while(0)
  #define KRD(G,j) do{ if(G){ kload2(kf,kp0+sl_next,j); SBAR(); } }while(0)
  #define STEP(C0,C1,P0,P1,t,GK,GV,GL) do{ SBAR(); \
    CINIT(C0,C1,t); SBAR(); \
    const lds_cptr vp_=vp0+sl_prev; \
    VRD(0); SBAR(); float sacc=(P0[0]+P0[1]); \
    GAPA(C0=__builtin_amdgcn_mfma_f32_32x32x16_bf16(kf[0],qr[0],C0,0,0,0), P0[2],P0[3],P0[4],P0[5],     pw0[0]=PKW(P0,0), pw0[1]=PKW(P0,2), pw0); \
    VRD(4); SBAR(); GAPA(C1=__builtin_amdgcn_mfma_f32_32x32x16_bf16(kf[1],qr[0],C1,0,0,0), P0[6],P0[7],P0[8],P0[9],     pw0[2]=PKW(P0,4), pw0[3]=PKW(P0,6), pw0); \
    VRD(1); SBAR(); GAPA(C0=__builtin_amdgcn_mfma_f32_32x32x16_bf16(kf[2],qr[1],C0,0,0,0),   P0[10],P0[11],P0[12],P0[13], pw1[0]=PKW(P0,8), pw1[1]=PKW(P0,10), pw1); \
    VRD(5); SBAR(); GAPA(C1=__builtin_amdgcn_mfma_f32_32x32x16_bf16(kf[3],qr[1],C1,0,0,0),   P0[14],P0[15],P1[0],P1[1],   pw1[2]=PKW(P0,12),pw1[3]=PKW(P0,14), pw1); \
    VRD(2); SBAR(); GAPA(C0=__builtin_amdgcn_mfma_f32_32x32x16_bf16(kf[4],qr[2],C0,0,0,0),   P1[2],P1[3],P1[4],P1[5],     pw2[0]=PKW(P1,0), pw2[1]=PKW(P1,2), pw2); \
    VRD(6); SBAR(); GAPA(C1=__builtin_amdgcn_mfma_f32_32x32x16_bf16(kf[5],qr[2],C1,0,0,0),   P1[6],P1[7],P1[8],P1[9],     pw2[2]=PKW(P1,4), pw2[3]=PKW(P1,6), pw2); \
    VRD(3); SBAR(); GAPA(C0=__builtin_amdgcn_mfma_f32_32x32x16_bf16(kf[6],qr[3],C0,0,0,0),   P1[10],P1[11],P1[12],P1[13], pw3[0]=PKW(P1,8), pw3[1]=PKW(P1,10), pw3); \
    VRD(7); SBAR(); GAPA(C1=__builtin_amdgcn_mfma_f32_32x32x16_bf16(kf[7],qr[3],C1,0,0,0),   P1[14],P1[15],0.f,0.f,       pw3[2]=PKW(P1,12),pw3[3]=PKW(P1,14), pw3); \
    l_reg+=sacc; \
    if(GK){DMA_K((t)+3,sl_cur);} if(GV){DMA_V((t)+1,sl_next);} \
    CMASK(C0,C1,t); \
    { float a=MX3(C0[0],C0[1],C1[0]),b=MX3(C0[2],C0[3],C1[1]); a=MX3(a,C1[2],C1[3]); \
      _Pragma("unroll") for(int r=4;r<16;r+=4){a=MX3(a,C0[r],C0[r+1]);b=MX3(b,C0[r+2],C0[r+3]);a=MX3(a,C1[r],C1[r+1]);b=MX3(b,C1[r+2],C1[r+3]);} \
      float rm=__builtin_fmaxf(a,b); { auto rr=__builtin_amdgcn_permlane32_swap(__float_as_uint(rm),__float_as_uint(rm),false,false); rm=__builtin_fmaxf(__uint_as_float(rr[0]),__uint_as_float(rr[1])); } \
      resc=false; \
      if(__builtin_expect(__any(rm>(float)THRL),0)){ const float dl=__builtin_fmaxf(rm,0.f); mhat+=dl; \
        _Pragma("unroll") for(int r=0;r<16;++r){C0[r]-=dl;C1[r]-=dl;} \
        cqm=cq-mhat; \
        const float f=__builtin_amdgcn_exp2f(-dl); l_reg*=f; if(hi==0)wsf[r32]=f; resc=true; } } \
    SBAR(); \
    GAPB(o[0]=__builtin_amdgcn_mfma_f32_32x32x16_bf16(PAF(0),VFR(0),o[0],0,0,0), C0,0); \
    GAPB(o[1]=__builtin_amdgcn_mfma_f32_32x32x16_bf16(PAF(0),VFR(4),o[1],0,0,0), C0,4); \
    KRD(GL,0); GAPB(o[0]=__builtin_amdgcn_mfma_f32_32x32x16_bf16(PAF(1),VFR(1),o[0],0,0,0), C0,8); \
    KRD(GL,1); GAPB(o[1]=__builtin_amdgcn_mfma_f32_32x32x16_bf16(PAF(1),VFR(5),o[1],0,0,0), C0,12); \
    KRD(GL,2); GAPB(o[0]=__builtin_amdgcn_mfma_f32_32x32x16_bf16(PAF(2),VFR(2),o[0],0,0,0), C1,0); \
    KRD(GL,3); GAPB(o[1]=__builtin_amdgcn_mfma_f32_32x32x16_bf16(PAF(2),VFR(6),o[1],0,0,0), C1,4); \
    GAPB(o[0]=__builtin_amdgcn_mfma_f32_32x32x16_bf16(PAF(3),VFR(3),o[0],0,0,0), C1,8); \
    GAPB(o[1]=__builtin_amdgcn_mfma_f32_32x32x16_bf16(PAF(3),VFR(7),o[1],0,0,0), C1,12); \
    }while(0)
  int t=1;
  #undef CMASK
  #define CMASK(P0,P1,t) do{}while(0)
  for(;t+5<NT;t+=2){
    STEP(pB0,pB1,pA0,pA1,t,true,true,true);     WAIT_BAR(2); RESC(); ROT();
    STEP(pA0,pA1,pB0,pB1,t+1,true,true,true);   WAIT_BAR(2); RESC(); ROT();
  }
  #undef CMASK
  #define CMASK(P0,P1,t) do{int jb_=(t)-(NT-4); if(jb_>=0)cmask(P0,P1,jb_,qrel,hi);}while(0)
  #define ENDW(tt) do{ if((tt)+3<NT){WAIT_BAR(2);} else if((tt)+2<NT){WAIT_BAR(1);} else {WAIT_BAR(0);} }while(0)
  for(;t+1<NT;t+=2){
    STEP(pB0,pB1,pA0,pA1,t,(t+3<NT),(t+1<NT),(t+1<NT));       ENDW(t);   RESC(); ROT();
    STEP(pA0,pA1,pB0,pB1,t+1,(t+4<NT),(t+2<NT),(t+2<NT));     ENDW(t+1); RESC(); ROT();
  }
  STEP(pB0,pB1,pA0,pA1,NT-1,false,false,false); RESC();
  { float sacc=pB0[0]+pB0[1]; _Pragma("unroll") for(int r=2;r<16;++r)sacc+=pB0[r]; _Pragma("unroll") for(int r=0;r<16;++r)sacc+=pB1[r]; l_reg+=sacc;
    pw0=(u32x4){PKW(pB0,0),PKW(pB0,2),PKW(pB0,4),PKW(pB0,6)};pw1=(u32x4){PKW(pB0,8),PKW(pB0,10),PKW(pB0,12),PKW(pB0,14)};pw2=(u32x4){PKW(pB1,0),PKW(pB1,2),PKW(pB1,4),PKW(pB1,6)};pw3=(u32x4){PKW(pB1,8),PKW(pB1,10),PKW(pB1,12),PKW(pB1,14)};
    SBAR(); pv(o,vb0+sl_cur,PAF(0),PAF(1),PAF(2),PAF(3)); }
  #undef PKW
  #undef PAF
  #undef VFR
  #undef PIN
  #undef MX3
  #undef GAPA
  #undef GAPB
  #undef EX
  #undef VRD
  #undef KRD
  #undef STEP
  #undef ENDW
  {auto rr=__builtin_amdgcn_permlane32_swap(__float_as_uint(l_reg),__float_as_uint(l_reg),false,false);l_reg=__uint_as_float(rr[0])+__uint_as_float(rr[1]);}
  if(hi==0)wsf[32+r32]=l_reg;asm volatile("s_waitcnt lgkmcnt(0)":::"memory");
  float rli[16];
  #pragma unroll
  for(int r=0;r<16;++r)rli[r]=__builtin_amdgcn_rcpf(wsf[32+crow(r,hi)]);
  bf16*Ow=O+(rowbase+q0+wid*QBLK)*DMO+h*D;
  { bf16*stg=(bf16*)(shm+LDS_OST)+wid*2048;
    #pragma unroll
    for(int r=0;r<16;++r){const int orow=crow(r,hi);
      #pragma unroll
      for(int d0=0;d0<2;++d0)stg[orow*64+d0*32+r32]=__float2bfloat16(o[d0][r]*rli[r]);}
    asm volatile("s_waitcnt lgkmcnt(0)":::"memory");
    #pragma unroll
    for(int i=0;i<4;++i){const int row=i*8+(lane>>3),ch=lane&7; const u32x4 v=*(const u32x4*)(stg+row*64+ch*8); ATTN_STORE16(Ow+(long)row*DMO+ch*8,v);} }
  asm volatile("s_waitcnt lgkmcnt(0)\n\ts_barrier":::"memory");
  #undef DMA_K
  #undef DMA_V
  #undef CMASK
  #undef START
  #undef RESC
  #undef ROT
  #undef CINIT
}
constexpr int ATTN_LDS_BYTES=LDS_BYTES;
struct AttnTensors { const bf16* Q; const bf16* K; const bf16* V; bf16* O; const float* LF; };
struct AttnUnit { int bh; int qb; };
struct StaticOrder {
  int vcu, G;
  __device__ __forceinline__ StaticOrder(int grid,int vcu_):vcu(vcu_),G(grid){}
  __device__ __forceinline__ bool next(int i,AttnUnit&u)const{
    if(G==256){ if(i>=2)return false; const int s=vcu&7; u.bh=vcu>>3; u.qb=(i==0)?15-s:s; return true; }
    const int idx=i*G+vcu; if(idx>=BATCH*NHEAD*NQB)return false; u.qb=NQB-1-idx/(BATCH*NHEAD); u.bh=idx%(BATCH*NHEAD); return true; }
  __device__ __forceinline__ void a_ready(const AttnUnit&)const{}
  __device__ __forceinline__ void done(const AttnUnit&)const{}
};
template<class Sched,int THRL=8> __device__ __forceinline__ void attn_phase(char*lds,const AttnTensors&T,const Sched&S){
  AttnUnit u;
  for(int i=0;S.next(i,u);++i){ S.a_ready(u); attn_unit<THRL>(u.bh/NHEAD,u.bh%NHEAD,u.qb,T.Q,T.K,T.V,T.O,T.LF+(size_t)u.bh*SEQ,lds); S.done(u); }
}
#undef SBAR
#undef WAIT_BAR
}
#define GAS __attribute__((address_space(1)))
#define LAS __attribute__((address_space(3)))
typedef unsigned short bf16;
typedef unsigned v4u __attribute__((ext_vector_type(4)));
typedef float f32x4 __attribute__((ext_vector_type(4)));
typedef short bf16x8 __attribute__((ext_vector_type(8)));
typedef GAS unsigned gu32;
typedef GAS unsigned long long gu64;
#define RLX_AGENT __ATOMIC_RELAXED, __HIP_MEMORY_SCOPE_AGENT
#define LDS_WAIT() asm volatile("s_waitcnt lgkmcnt(0)" ::: "memory")
#define VM_WAIT() asm volatile("s_waitcnt vmcnt(0)" ::: "memory")
__device__ __forceinline__ unsigned long long rt() { return __builtin_amdgcn_s_memrealtime(); }
__device__ __forceinline__ unsigned f2bf(float f) { unsigned u = __builtin_bit_cast(unsigned, f); return (u + 0x7fffu + ((u >> 16) & 1u)) >> 16; }
__device__ __forceinline__ unsigned pk2(float lo, float hi) { unsigned r; asm("v_cvt_pk_bf16_f32 %0, %1, %2" : "=v"(r) : "v"(lo), "v"(hi)); return r; }

#define XB_TMO      128
#define XB_XCNT(j)  (256  + 64 * (j))
#define XB_XSUB(j)  (1280 + 64 * (j))
#define XB_XGEN(j)  (2304 + 64 * (j))
#define XB_TOP      3328
#define XB_TOPGEN   3392
#define XCD_BAR_WORDS 3456
#define XB_SPIN_CAP (1u << 18)

__device__ __forceinline__ unsigned xb_ld(unsigned* p)              { return __hip_atomic_load(p, __ATOMIC_RELAXED, __HIP_MEMORY_SCOPE_AGENT); }
__device__ __forceinline__ unsigned xb_add(unsigned* p, unsigned v) { return __hip_atomic_fetch_add(p, v, __ATOMIC_RELAXED, __HIP_MEMORY_SCOPE_AGENT); }
__device__ __forceinline__ unsigned xb_xcc_id() { return (unsigned)__builtin_amdgcn_s_getreg((3 << 11) | 20) & 0xFu; }
#define XB_SPIN(cond, bar) do { unsigned _sp = 0; while (cond) { __builtin_amdgcn_s_sleep(1); \
    if ((++_sp & 255u) == 0u) { if (xb_ld(&(bar)[XB_TMO])) break; if (_sp > XB_SPIN_CAP) { atomicAdd(&(bar)[XB_TMO], 1u); break; } } } } while (0)

struct XcdBarrier {
    unsigned* bar; unsigned x;
    volatile LAS unsigned* st;
};

__device__ __forceinline__ XcdBarrier xcd_barrier_post(unsigned* bar, volatile LAS unsigned* st) {
    XcdBarrier b; b.bar = bar; b.x = xb_xcc_id(); b.st = st;
    if (threadIdx.x == 0) (void)xb_add(&bar[XB_XCNT(b.x)], 1u);
    return b;
}
__device__ __forceinline__ void xcd_barrier_complete(unsigned* bar, unsigned x, unsigned& nloc, unsigned& nx) {
    const unsigned G = gridDim.x * gridDim.y * gridDim.z;
    unsigned sum, cnt, mine, sp = 0u;
    for (;;) {
        sum = 0u; cnt = 0u; mine = 0u;
#pragma unroll
        for (unsigned j = 0; j < 16; ++j) { const unsigned c = xb_ld(&bar[XB_XCNT(j)]); sum += c; cnt += (c > 0u) ? 1u : 0u; mine = (j == x) ? c : mine; }
        if (sum == G) break;
        __builtin_amdgcn_s_sleep(1);
        if ((++sp & 255u) == 0u) { if (xb_ld(&bar[XB_TMO])) break; if (sp > XB_SPIN_CAP) { atomicAdd(&bar[XB_TMO], 1u); break; } }
    }
    nloc = mine > 0u ? mine : 1u; nx = cnt > 0u ? cnt : 1u;
}

__device__ __forceinline__ void xcd_barrier(const XcdBarrier& b) {
    asm volatile("s_waitcnt vmcnt(0)" ::: "memory");
    __syncthreads();
    if (threadIdx.x == 0) {
        unsigned* bar = b.bar;
        __builtin_amdgcn_s_waitcnt(0);
        unsigned nloc = b.st[0], nx = b.st[1];
        if (nloc == 0u) { xcd_barrier_complete(bar, b.x, nloc, nx); b.st[0] = nloc; b.st[1] = nx; }
        const unsigned old = xb_add(&bar[XB_XSUB(b.x)], 1u);
        const unsigned gen = old / nloc;
        if (old + 1u == (gen + 1u) * nloc) {
            asm volatile("buffer_inv sc1" ::: "memory");
            __builtin_amdgcn_fence(__ATOMIC_RELEASE, "agent");
            asm volatile("s_waitcnt vmcnt(0)" ::: "memory");
            const unsigned og = xb_add(&bar[XB_TOP], 1u);
            const unsigned tg = og / nx;
            if (og + 1u != (tg + 1u) * nx) XB_SPIN(xb_ld(&bar[XB_TOP]) < (tg + 1u) * nx, bar);
            asm volatile("" ::: "memory");
            xb_add(&bar[XB_XGEN(b.x)], 1u);
            asm volatile("s_waitcnt vmcnt(0)" ::: "memory");
        } else {
            asm volatile("buffer_inv sc1" ::: "memory");
            XB_SPIN(xb_ld(&bar[XB_XGEN(b.x)]) == gen, bar);
            asm volatile("s_waitcnt vmcnt(0)" ::: "memory");
        }
    }
    __syncthreads();
}

constexpr int NWAVES = 8;
constexpr int BATCH = 4, SEQ = 4096, D = 1024, M = BATCH * SEQ, NH = 8, HD = 64, AW = 512, PLE = 256;
constexpr int NIN = 5120, INTOT = 5128, NKEYS = 128, NEXP = 16384, NS = 2048;
constexpr float EPS = 1e-6f, LOG2E = 1.4426950408889634f, C2 = 0.125f * LOG2E;
constexpr int NPHASE = 9;
constexpr int SL4 = 256, NSL4 = D / SL4;
static_assert(NSL4 == 4, "slice = XCD group & 3; SS3 has 16 slots");
constexpr float Q4_STEP = 0.3352f;

constexpr size_t MiB = 1u << 20;
constexpr size_t WS_CTL = 0, CTL_ZERO_BYTES = 64 * 1024;
constexpr size_t WS_RSTD1 = 1 * MiB, WS_RSTD3 = WS_RSTD1 + 65536, WS_LF = WS_RSTD3 + 65536, WS_CS = WS_LF + 524288, WS_SS2 = WS_CS + 524288, WS_WPP = WS_SS2 + 1048576;
constexpr size_t WS_WQ8 = 20 * MiB;
constexpr size_t WS_SUV = WS_WPP + 524288;
constexpr size_t WS_SW2 = WS_SUV + 131072;
static_assert(WS_SW2 + 131072 <= 4 * MiB, "small region");
constexpr size_t WS_WIN = 4 * MiB, WS_WBR = 14 * MiB, WS_WOUT = 16 * MiB, WS_WS = 18 * MiB, WS_WPG = 22 * MiB, WS_PB = 24 * MiB;
constexpr size_t WS_UB = 32 * MiB, WS_VB = 48 * MiB;
constexpr size_t WS_AC = 64 * MiB;
constexpr size_t WS_A = 96 * MiB;
constexpr size_t WS_PP = 128 * MiB;
constexpr size_t WS_Q = 160 * MiB, WS_K = 176 * MiB, WS_V = 192 * MiB, WS_GB = 208 * MiB, WS_Z = 224 * MiB;
constexpr size_t WS_MERGED = 160 * MiB, WS_XB2 = 192 * MiB, WS_IDS = 224 * MiB, WS_GATES = 232 * MiB;
constexpr size_t WS_XB3 = 64 * MiB, WS_SS4 = WS_LF;
constexpr size_t WS_XB2_8 = 240 * MiB;
constexpr size_t WS_XB8 = 240 * MiB, WS_WIN8 = 10 * MiB;
constexpr size_t WS_END = 256 * MiB;
constexpr size_t WS_PART0 = 4 * MiB, WS_PART1 = 160 * MiB, WS_PART2 = 240 * MiB;
constexpr size_t WS_TGC = 32 * MiB, WS_TXC = 64 * MiB, WS_SC = 32 * MiB;
constexpr int CW_PANEL = 10240;
constexpr int CW_BAR = 1024;

constexpr int RING_OFF = 0, RING_BYTES = 135168;
constexpr int LDSCTL_OFF = RING_BYTES, MISC_OFF = LDSCTL_OFF + 320;
constexpr int LDS_BYTES = RING_BYTES + 1024;
static_assert(attn_body::ATTN_LDS_BYTES <= RING_BYTES && pg8::STAGE_BYTES <= RING_BYTES && 128 * pg8::EpiTopK::RS * 4 <= RING_BYTES, "LDS map");

typedef unsigned u32x4 __attribute__((ext_vector_type(4)));
typedef unsigned u32x2 __attribute__((ext_vector_type(2)));
typedef float f32x2 __attribute__((ext_vector_type(2)));
__device__ __forceinline__ float bf2f(bf16 v) { return __uint_as_float((unsigned)v << 16); }
template <int CTRL> __device__ __forceinline__ int dpp_i(int v) { return __builtin_amdgcn_update_dpp(0, v, CTRL, 0xf, 0xf, true); }
__device__ __forceinline__ float wave_sum_valu(float v) {
    { const auto s_ = __builtin_amdgcn_permlane32_swap(__float_as_uint(v), __float_as_uint(v), false, false); v = __uint_as_float(s_[0]) + __uint_as_float(s_[1]); }
    { const auto s_ = __builtin_amdgcn_permlane16_swap(__float_as_uint(v), __float_as_uint(v), false, false); v = __uint_as_float(s_[0]) + __uint_as_float(s_[1]); }
    v += __uint_as_float((unsigned)dpp_i<0x128>((int)__float_as_uint(v))); v += __uint_as_float((unsigned)dpp_i<0x124>((int)__float_as_uint(v)));
    v += __uint_as_float((unsigned)dpp_i<0x122>((int)__float_as_uint(v))); v += __uint_as_float((unsigned)dpp_i<0x121>((int)__float_as_uint(v))); return v;
}
__device__ __forceinline__ float wave_max_valu(float v) {
    { const auto s_ = __builtin_amdgcn_permlane32_swap(__float_as_uint(v), __float_as_uint(v), false, false); v = fmaxf(__uint_as_float(s_[0]), __uint_as_float(s_[1])); }
    { const auto s_ = __builtin_amdgcn_permlane16_swap(__float_as_uint(v), __float_as_uint(v), false, false); v = fmaxf(__uint_as_float(s_[0]), __uint_as_float(s_[1])); }
    v = fmaxf(v, __uint_as_float((unsigned)dpp_i<0x128>((int)__float_as_uint(v)))); v = fmaxf(v, __uint_as_float((unsigned)dpp_i<0x124>((int)__float_as_uint(v))));
    v = fmaxf(v, __uint_as_float((unsigned)dpp_i<0x122>((int)__float_as_uint(v)))); v = fmaxf(v, __uint_as_float((unsigned)dpp_i<0x121>((int)__float_as_uint(v)))); return v;
}
__device__ __forceinline__ float wave_sum(float v) { return wave_sum_valu(v); }
__device__ __forceinline__ float pl32_sumf(float a, float b) { const auto s_ = __builtin_amdgcn_permlane32_swap(__float_as_uint(a), __float_as_uint(b), false, false); return __uint_as_float(s_[0]) + __uint_as_float(s_[1]); }
__device__ __forceinline__ float pl16_sumf(float a, float b) { const auto s_ = __builtin_amdgcn_permlane16_swap(__float_as_uint(a), __float_as_uint(b), false, false); return __uint_as_float(s_[0]) + __uint_as_float(s_[1]); }

__device__ __forceinline__ float sigmoidf_(float v) { return 1.0f / (1.0f + __expf(-v)); }
__host__ __device__ __forceinline__ int src_in(int n) {
    const int pn = n >> 8, l = n & 255;
    if (pn < 2) return 1024 + n;
    if (pn < 4) return 1544 + (n - 512);
    if (pn < 8) { const int j = pn - 4; return (l < 128) ? 2056 + 128 * j + l : 2568 + 128 * j + (l - 128); }
    if (pn < 16) { const int j = pn - 8; return (l < 128) ? 3080 + 128 * j + l : 4104 + 128 * j + (l - 128); }
    return n - 4096;
}

struct Args { const float* in[18]; float* out; unsigned char* ws; int ph_lo, ph_hi, li, pad; };
struct Ctx {
    LAS unsigned char* lds; int wave, vcu, G;
    __device__ __forceinline__ int tid_() const { return (int)threadIdx.x; }
    __device__ __forceinline__ int lane_() const { return (int)threadIdx.x & 63; }
};

struct TrItem { const float* W; const float* g; bf16* WT; int ldw, k0, scol0, ldt, drow0, dk0; int fp8; };
__device__ __forceinline__ void tr_load(const TrItem& I, float (&tv)[32], int lane) {
#pragma unroll
    for (int i = 0; i < 32; ++i) { const int kk = 2 * i + (lane >> 5); tv[i] = I.W[(size_t)(I.k0 + kk) * I.ldw + I.scol0 + (lane & 31)]; }
}
__device__ __forceinline__ void tr_finish(const TrItem& I, const float (&tv)[32], LAS float* scr, int lane) {
#pragma unroll
    for (int i = 0; i < 32; ++i) { const int kk = 2 * i + (lane >> 5); float v = tv[i]; if (I.g) v *= I.g[I.k0 + kk]; scr[kk * 33 + (lane & 31)] = v; }
    LDS_WAIT(); asm volatile("" ::: "memory");
    const int c = lane & 7;
    if (I.fp8) {
#pragma unroll
        for (int j = 0; j < 4; ++j) { const int n = (lane >> 3) + 8 * j; const LAS float* s = scr + (8 * c) * 33 + n;
            u32x2 o; o.x = (unsigned)__builtin_amdgcn_cvt_pk_fp8_f32(s[0 * 33] * 32.f, s[1 * 33] * 32.f, 0, false); o.x = (unsigned)__builtin_amdgcn_cvt_pk_fp8_f32(s[2 * 33] * 32.f, s[3 * 33] * 32.f, (int)o.x, true);
            o.y = (unsigned)__builtin_amdgcn_cvt_pk_fp8_f32(s[4 * 33] * 32.f, s[5 * 33] * 32.f, 0, false); o.y = (unsigned)__builtin_amdgcn_cvt_pk_fp8_f32(s[6 * 33] * 32.f, s[7 * 33] * 32.f, (int)o.y, true);
            *(GAS u32x2*)((unsigned char*)I.WT + (size_t)(I.drow0 + n) * I.ldt + I.dk0 + 8 * c) = o; }
    } else {
#pragma unroll
        for (int j = 0; j < 4; ++j) { const int n = (lane >> 3) + 8 * j; const LAS float* s = scr + (8 * c) * 33 + n;
            v4u o; o.x = pk2(s[0 * 33], s[1 * 33]); o.y = pk2(s[2 * 33], s[3 * 33]); o.z = pk2(s[4 * 33], s[5 * 33]); o.w = pk2(s[6 * 33], s[7 * 33]);
            *(GAS v4u*)(I.WT + (size_t)(I.drow0 + n) * I.ldt + I.dk0 + 8 * c) = o; }
    }
    LDS_WAIT(); asm volatile("" ::: "memory");
}
constexpr int TR_IN = 16 * 160, TR_PP = 4 * 32, TR_BR = 8 * 32, TR_SQ = 16 * 32;
constexpr int TR_P0 = TR_IN + TR_PP;
constexpr int TR_LATE = 2 * TR_BR + 2 * TR_SQ;
__device__ __forceinline__ TrItem tr_decode(const Args& a, int r) {
    unsigned char* ws = a.ws;
    if (r < TR_IN) { const int kb = r / 160, nb = r % 160;
        if (nb >= 64) return TrItem{a.in[3], a.in[2], (bf16*)(ws + WS_WIN8), INTOT, 64 * kb, src_in(32 * nb), D, 32 * nb - 2048, 64 * kb, 1};
        return TrItem{a.in[3], a.in[2], (bf16*)(ws + WS_WIN), INTOT, 64 * kb, src_in(32 * nb), D, 32 * nb, 64 * kb, 0}; } r -= TR_IN;
    if (r < TR_PP) { const int kb = r / 32, nb = r % 32; return TrItem{a.in[16], nullptr, (bf16*)(ws + WS_WPP), D, 64 * kb, 32 * nb, PLE, 32 * nb, 64 * kb, 0}; } r -= TR_PP;
    if (r < 2 * TR_BR) { const int br = r / TR_BR, q = r % TR_BR, kb = q / 32, nb = q % 32; return TrItem{a.in[6] + (size_t)br * AW * D, nullptr, (bf16*)(ws + WS_WBR), D, 64 * kb, 32 * nb, D, 32 * nb, br * AW + 64 * kb, 0}; } r -= 2 * TR_BR;
    if (r < TR_SQ) { const int kb = r / 32, nb = r % 32; return TrItem{a.in[7], nullptr, (bf16*)(ws + WS_WOUT), D, 64 * kb, 32 * nb, D, 32 * nb, 64 * kb, 0}; } r -= TR_SQ;
    { const int kb = r / 32, nb = r % 32; return TrItem{a.in[15], a.in[14], (bf16*)(ws + WS_WPG), D, 64 * kb, 32 * nb, D, 32 * nb, 64 * kb, 1}; }
}
__device__ __forceinline__ void tr_two(const Args& a, LAS float* scr, int ra, int rb_, bool two, int lane) {
    const TrItem A = tr_decode(a, ra), B = tr_decode(a, two ? rb_ : ra);
    float ta[32], tb[32];
    tr_load(A, ta, lane); if (two) tr_load(B, tb, lane);
    tr_finish(A, ta, scr, lane); if (two) tr_finish(B, tb, scr, lane);
}
__device__ __forceinline__ void ws_item(const Args& a, LAS unsigned char* lds, int item) {
    int tid_ = (int)threadIdx.x; asm volatile("" : "+v"(tid_));
    const float *g_ffn = a.in[8], *w_peer_q = a.in[9]; bf16* WST = (bf16*)(a.ws + WS_WS);
    LAS float* KH = (LAS float*)lds; LAS float* WQ = KH + 128 * 132;
    const int hh = item >> 4, head = hh >> 1, half = hh & 1, d0 = (item & 15) * 64;
    const float* kh = (half ? a.in[11] : a.in[10]) + (size_t)head * 128 * 128;
    f32x4 tk[8], tq[4];
#pragma unroll
    for (int i = 0; i < 8; ++i) tk[i] = ((const GAS f32x4*)kh)[i * 512 + tid_];
#pragma unroll
    for (int i = 0; i < 4; ++i) { const int idx = i * 512 + tid_; tq[i] = *(const GAS f32x4*)(w_peer_q + (size_t)(d0 + (idx >> 5)) * NS + head * 256 + half * 128 + (idx & 31) * 4); }
#pragma unroll
    for (int i = 0; i < 8; ++i) { const int idx = i * 512 + tid_; *(LAS f32x4*)(KH + (idx >> 5) * 132 + (idx & 31) * 4) = tk[i]; }
#pragma unroll
    for (int i = 0; i < 4; ++i) { const int idx = i * 512 + tid_; *(LAS f32x4*)(WQ + (idx >> 5) * 132 + (idx & 31) * 4) = tq[i]; }
    __syncthreads();
    typedef float f32x16_t __attribute__((ext_vector_type(16)));
    const int lane = tid_ & 63, w = __builtin_amdgcn_readfirstlane(tid_ >> 6), kt = w & 3, dt = w >> 2, l31 = lane & 31, h = lane >> 5;
    const LAS f32x4* ap = (const LAS f32x4*)(WQ + (32 * dt + l31) * 132 + 4 * h); const LAS f32x4* bp = (const LAS f32x4*)(KH + (32 * kt + l31) * 132 + 4 * h);
    f32x16_t acc = {0.f, 0.f, 0.f, 0.f, 0.f, 0.f, 0.f, 0.f, 0.f, 0.f, 0.f, 0.f, 0.f, 0.f, 0.f, 0.f};
#pragma unroll 4
    for (int t_ = 0; t_ < 16; ++t_) { const f32x4 a4 = ap[2 * t_], b4 = bp[2 * t_];
#pragma unroll
        for (int j = 0; j < 4; ++j) acc = __builtin_amdgcn_mfma_f32_32x32x2f32(a4[j], b4[j], acc, 0, 0, 0); }
    const int key = 32 * kt + l31;
#pragma unroll
    for (int q = 0; q < 4; ++q) { const int dd = d0 + 32 * dt + 8 * q + 4 * h; const f32x4 gv = *(const GAS f32x4*)(g_ffn + dd);
        u32x2 o; o.x = pk2(acc[4 * q] * gv[0], acc[4 * q + 1] * gv[1]); o.y = pk2(acc[4 * q + 2] * gv[2], acc[4 * q + 3] * gv[3]);
        *(GAS u32x2*)(WST + (size_t)(head * 256 + half * 128 + key) * D + dd) = o; }
    __syncthreads();
}
template <int NR> __device__ __forceinline__ void quant_load4(const Args& a, int rb, int lane, f32x4 (&v)[NR][4]) {
#pragma unroll
    for (int r = 0; r < NR; ++r) { const int rr = rb + r; const bool isv = rr >= NEXP; const int e = isv ? rr - NEXP : rr;
        const GAS f32x4* src = (const GAS f32x4*)((isv ? a.in[13] : a.in[12]) + (size_t)e * D) + lane;
#pragma unroll
        for (int j = 0; j < 4; ++j) v[r][j] = src[64 * j]; }
}
template <int NR> __device__ __forceinline__ void quant_finish4(const Args& a, int rb, int lane, f32x4 (&v)[NR][4]) {
    unsigned char* ws = a.ws; const float *g_ffn = a.in[8];
    f32x4 gq[4];
#pragma unroll
    for (int j = 0; j < 4; ++j) gq[j] = *(const GAS f32x4*)(g_ffn + 256 * j + 4 * lane);
#pragma unroll
    for (int r = 0; r < NR; ++r) { const int rr = rb + r; const bool isv = rr >= NEXP; const int e = isv ? rr - NEXP : rr;
        float am = 0.f;
#pragma unroll
        for (int j = 0; j < 4; ++j) { if (!isv) v[r][j] = v[r][j] * gq[j]; am = fmaxf(am, fmaxf(fmaxf(fabsf(v[r][j].x), fabsf(v[r][j].y)), fmaxf(fabsf(v[r][j].z), fabsf(v[r][j].w)))); }
        am = wave_max_valu(am);
        unsigned char* tb = ws + (isv ? WS_VB : WS_UB);
        float ss = 0.f;
#pragma unroll
        for (int j = 0; j < 4; ++j) ss += (v[r][j].x * v[r][j].x + v[r][j].y * v[r][j].y) + (v[r][j].z * v[r][j].z + v[r][j].w * v[r][j].w);
        ss = wave_sum_valu(ss);
        const float st = fminf(Q4_STEP * sqrtf(ss * (1.0f / D)), am * 0.125f), inv = st > 0.f ? 1.0f / st : 0.f;
        if (isv) {
#pragma unroll
            for (int j = 0; j < 4; ++j) {
                const int n0 = (int)fminf(fmaxf(floorf(v[r][j].x * inv + 8.0f), 0.f), 15.f), n1 = (int)fminf(fmaxf(floorf(v[r][j].y * inv + 8.0f), 0.f), 15.f);
                const int n2 = (int)fminf(fmaxf(floorf(v[r][j].z * inv + 8.0f), 0.f), 15.f), n3 = (int)fminf(fmaxf(floorf(v[r][j].w * inv + 8.0f), 0.f), 15.f);
                *(GAS unsigned short*)(tb + ((size_t)j * NEXP + e) * 128 + 2 * lane) = (unsigned short)(n0 | ((n1 ^ 8) << 4) | (n2 << 8) | ((n3 ^ 8) << 12)); }
            if (lane == 0) ((float*)(ws + WS_SUV))[2 * e + 1] = st;
            continue;
        }
#pragma unroll
        for (int j = 0; j < 4; ++j) {
            const int n0 = (int)fminf(fmaxf(floorf(v[r][j].x * inv + 8.0f), 0.f), 15.f), n1 = (int)fminf(fmaxf(floorf(v[r][j].y * inv + 8.0f), 0.f), 15.f);
            const int n2 = (int)fminf(fmaxf(floorf(v[r][j].z * inv + 8.0f), 0.f), 15.f), n3 = (int)fminf(fmaxf(floorf(v[r][j].w * inv + 8.0f), 0.f), 15.f);
            const int P = (n0 | (n1 << 8) | (n2 << 16) | (n3 << 24)) ^ 0x08080808, Pn = dpp_i<0xB1>(P);
            if (!(lane & 1)) *(GAS unsigned*)(tb + ((size_t)j * NEXP + e) * 128 + 4 * (lane >> 1)) = (unsigned)P | ((unsigned)Pn << 4); }
        if (lane == 0) ((float*)(ws + WS_SUV))[2 * e] = st;
    }
}
template <int NR> __device__ __forceinline__ void quant_rows(const Args& a, int rb, int lane) { f32x4 v[NR][4]; quant_load4<NR>(a, rb, lane, v); quant_finish4<NR>(a, rb, lane, v); }
__device__ __forceinline__ void p0_prologue(const Ctx& F, const Args& a, volatile LAS unsigned* MISC) {
    unsigned char* ws = a.ws;
    const float *x = a.in[0], *p = a.in[1], *g_mix = a.in[2], *w_in = a.in[3], *b_f = a.in[4];
    bf16 *PB = (bf16*)(ws + WS_PB), *XB = (bf16*)(ws + WS_A);
    float *RSTD1 = (float*)(ws + WS_RSTD1), *LF = (float*)(ws + WS_LF);
    const int gw = F.vcu * NWAVES + F.wave, NGW = F.G * NWAVES, NGT = F.G * 512;
    const int tid_ = (int)threadIdx.x, lane_ = tid_ & 63;
    auto stepB = [&]() __attribute__((always_inline)) {
        LAS float* scr = (LAS float*)(F.lds + RING_OFF + F.wave * 16384);
        for (int it = gw; it < TR_P0; it += 2 * NGW) tr_two(a, scr, it, it + NGW, it + NGW < TR_P0, lane_);
    };
    auto stepC = [&]() __attribute__((always_inline)) {
    {
        LAS float* WFL = (LAS float*)(F.lds + RING_OFF);
        { float tw[16], tg[16];
#pragma unroll
          for (int i = 0; i < 16; ++i) { const int idx = i * 512 + tid_, k = idx >> 3, h = idx & 7; tw[i] = w_in[(size_t)k * INTOT + 1536 + h]; tg[i] = g_mix[k]; }
#pragma unroll
          for (int i = 0; i < 16; ++i) { const int idx = i * 512 + tid_, k = idx >> 3, h = idx & 7; WFL[h * 1024 + k] = tg[i] * tw[i]; } }
        __syncthreads();
        constexpr int RPT = 2;
        for (int rb = gw; rb < M; rb += RPT * NGW) {
            f32x4 v[RPT][4];
#pragma unroll
            for (int r = 0; r < RPT; ++r) { const int row = rb + r * NGW; if (row < M) { const GAS f32x4* xr = (const GAS f32x4*)(x + (size_t)row * D);
#pragma unroll
                for (int j = 0; j < 4; ++j) v[r][j] = xr[lane_ + 64 * j]; } }
#pragma unroll
            for (int r = 0; r < RPT; ++r) { const int row = rb + r * NGW; if (row < M) {
                float ss = 0.f;
#pragma unroll
                for (int j = 0; j < 4; ++j) ss += (v[r][j].x * v[r][j].x + v[r][j].y * v[r][j].y) + (v[r][j].z * v[r][j].z + v[r][j].w * v[r][j].w);
                ss = wave_sum(ss);
                const float rstd = 1.0f / sqrtf(ss * (1.0f / D) + EPS);
                GAS u32x2* o = (GAS u32x2*)(XB + (size_t)row * D);
#pragma unroll
                for (int j = 0; j < 4; ++j) { u32x2 w; w.x = pk2(v[r][j].x, v[r][j].y); w.y = pk2(v[r][j].z, v[r][j].w); o[lane_ + 64 * j] = w; }
                { GAS unsigned* o8 = (GAS unsigned*)(ws + WS_XB8 + (size_t)row * D);
#pragma unroll
                  for (int j = 0; j < 4; ++j) { int q = __builtin_amdgcn_cvt_pk_fp8_f32(v[r][j].x, v[r][j].y, 0, false); q = __builtin_amdgcn_cvt_pk_fp8_f32(v[r][j].z, v[r][j].w, q, true); o8[lane_ + 64 * j] = (unsigned)q; } }
                if (lane_ == 0) RSTD1[row] = rstd;
                float f[8];
#pragma unroll
                for (int h = 0; h < 8; ++h) { float s_ = 0.f;
#pragma unroll
                    for (int j = 0; j < 4; ++j) { const f32x4 w = *(const LAS f32x4*)(WFL + h * 1024 + 4 * (lane_ + 64 * j)); s_ += (v[r][j].x * w[0] + v[r][j].y * w[1]) + (v[r][j].z * w[2] + v[r][j].w * w[3]); }
                    f[h] = s_; }
                float r4[4], r2[2], r1;
#pragma unroll
                for (int i = 0; i < 4; ++i) r4[i] = pl32_sumf(f[i], f[i + 4]);
#pragma unroll
                for (int i = 0; i < 2; ++i) r2[i] = pl16_sumf(r4[i], r4[i + 2]);
                { const float send = (lane_ & 8) ? r2[0] : r2[1], keep = (lane_ & 8) ? r2[1] : r2[0]; r1 = keep + __uint_as_float((unsigned)dpp_i<0x128>((int)__float_as_uint(send))); }
                r1 += __uint_as_float((unsigned)dpp_i<0x141>((int)__float_as_uint(r1))); r1 += __uint_as_float((unsigned)dpp_i<0xB1>((int)__float_as_uint(r1))); r1 += __uint_as_float((unsigned)dpp_i<0x4E>((int)__float_as_uint(r1)));
                const int hL = ((lane_ >> 5) & 1) * 4 + ((lane_ >> 4) & 1) * 2 + ((lane_ >> 3) & 1);
                const float tot = r1 * rstd + b_f[hL];
                const float ls = fminf(tot, 0.f) - log1pf(__expf(-fabsf(tot)));
                const int b = row / SEQ, t = row % SEQ;
                if ((lane_ & 7) == 0) LF[(size_t)(b * NH + hL) * SEQ + t] = ls * LOG2E;
            } }
        }
    }
    };
    if (F.vcu & 1) { stepC(); __syncthreads(); stepB(); }
    else           { stepB(); __syncthreads(); stepC(); }
    { constexpr int NP = M * PLE / 8;
        for (int i = F.vcu * 512 + tid_; i < NP; i += NGT) { const f32x4 a_ = ((const GAS f32x4*)p)[2 * (size_t)i], b_ = ((const GAS f32x4*)p)[2 * (size_t)i + 1];
            v4u o; o.x = pk2(a_.x, a_.y); o.y = pk2(a_.z, a_.w); o.z = pk2(b_.x, b_.y); o.w = pk2(b_.z, b_.w); ((GAS v4u*)PB)[i] = o; }
    }
}
__device__ __forceinline__ void p2_conv_chunk(int chunk, const bf16* GB, const bf16* Z, const float* cw, bf16* AC) {
    int tid_l = (int)threadIdx.x; asm volatile("" : "+v"(tid_l));
    const int c = (tid_l & 63) * 8, r_in = tid_l >> 6;
    f32x4 w[3][2];
#pragma unroll
    for (int j = 0; j < 3; ++j) { w[j][0] = *(const GAS f32x4*)(cw + j * AW + c); w[j][1] = *(const GAS f32x4*)(cw + j * AW + c + 4); }
    for (int kb = 0; kb < 8; kb += 4) {
        v4u z2[4], g[4], z1[4], z0[4];
#pragma unroll
        for (int j = 0; j < 4; ++j) { const int row = chunk * 64 + (kb + j) * 8 + r_in, t = row & (SEQ - 1);
            z2[j] = *(const GAS v4u*)(Z + (size_t)row * AW + c); g[j] = *(const GAS v4u*)(GB + (size_t)row * AW + c);
            z1[j] = *(const GAS v4u*)(Z + (size_t)(row - (t >= 1 ? 1 : 0)) * AW + c); z0[j] = *(const GAS v4u*)(Z + (size_t)(row - (t >= 2 ? 2 : 0)) * AW + c); }
#pragma unroll
        for (int j = 0; j < 4; ++j) { const int row = chunk * 64 + (kb + j) * 8 + r_in, t = row & (SEQ - 1);
            const unsigned m1 = t >= 1 ? 0xffffffffu : 0u, m0 = t >= 2 ? 0xffffffffu : 0u;
            float r[8];
#pragma unroll
            for (int e = 0; e < 4; ++e) { const unsigned a1 = z1[j][e] & m1, a0 = z0[j][e] & m0;
                const float w0a = w[0][e >> 1][2 * (e & 1)], w0b = w[0][e >> 1][2 * (e & 1) + 1], w1a = w[1][e >> 1][2 * (e & 1)], w1b = w[1][e >> 1][2 * (e & 1) + 1], w2a = w[2][e >> 1][2 * (e & 1)], w2b = w[2][e >> 1][2 * (e & 1) + 1];
                r[2 * e] = __uint_as_float(g[j][e] << 16) * (w0a * __uint_as_float(a0 << 16) + w1a * __uint_as_float(a1 << 16) + w2a * __uint_as_float(z2[j][e] << 16));
                r[2 * e + 1] = __uint_as_float(g[j][e] & 0xffff0000u) * (w0b * __uint_as_float(a0 & 0xffff0000u) + w1b * __uint_as_float(a1 & 0xffff0000u) + w2b * __uint_as_float(z2[j][e] & 0xffff0000u)); }
            v4u o; o.x = pk2(r[0], r[1]); o.y = pk2(r[2], r[3]); o.z = pk2(r[4], r[5]); o.w = pk2(r[6], r[7]);
            *(GAS v4u*)(AC + (size_t)row * D + AW + c) = o; }
    }
}
constexpr int P2_NATT = 512, P2_NCONV = M * AW / 8 / 4096, P2_NQ = 2 * NEXP / 64, P2_NWS = 256, P2_NTR = TR_LATE / 8, CW_QUEUE = 512;
constexpr int P2_NITEMS = P2_NATT + P2_NCONV + P2_NQ + P2_NWS + P2_NTR;
static_assert(P2_NQ == P2_NATT, "queue head pattern (A, Q)");
constexpr int P2_NATT_H = 256;
__device__ __forceinline__ int p2_dequeue(unsigned* ctr, volatile LAS unsigned* slot) {
    if (threadIdx.x == 0) *slot = __hip_atomic_fetch_add(ctr, 1u, __ATOMIC_RELAXED, __HIP_MEMORY_SCOPE_AGENT);
    asm volatile("s_waitcnt vmcnt(0) lgkmcnt(0)\n\ts_barrier" ::: "memory");
    const unsigned v = *slot;
    asm volatile("s_waitcnt lgkmcnt(0)\n\ts_barrier" ::: "memory");
    return (int)v;
}
__device__ __forceinline__ unsigned row_off(unsigned w, bool hi, unsigned c16) { unsigned d;
    if (hi) asm("v_mad_u32_u16 %0, %1, %2, %3 op_sel:[1,0,0,0]" : "=v"(d) : "v"(w), "s"(128u), "v"(c16)); else asm("v_mad_u32_u16 %0, %1, %2, %3" : "=v"(d) : "v"(w), "s"(128u), "v"(c16));
    return d; }
__device__ __forceinline__ int dot8_0(int a, int b) { int d; asm("v_dot8_i32_i4 %0, %1, %2, 0" : "=v"(d) : "v"(a), "v"(b)); return d; }
__device__ __forceinline__ int dot4_0(int a, int b) { int d; asm("v_dot4_i32_i8 %0, %1, %2, 0" : "=v"(d) : "v"(a), "v"(b)); return d; }
__device__ __forceinline__ float amax3(float a, float b, float m) { float d; asm("v_max3_f32 %0, |%1|, |%2|, %3" : "=v"(d) : "v"(a), "v"(b), "v"(m)); return d; }
__device__ __forceinline__ int sum8i(int v) { v += dpp_i<0x141>(v); v += dpp_i<0xB1>(v); v += dpp_i<0x4E>(v); return v; }
__device__ __forceinline__ float max8f(float v) { v = fmaxf(v, __uint_as_float((unsigned)dpp_i<0x141>((int)__float_as_uint(v)))); v = fmaxf(v, __uint_as_float((unsigned)dpp_i<0xB1>((int)__float_as_uint(v)))); v = fmaxf(v, __uint_as_float((unsigned)dpp_i<0x4E>((int)__float_as_uint(v)))); return v; }
__device__ __forceinline__ size_t part_slab(int j) { return j < 2 ? WS_PART0 + (size_t)j * 8 * MiB : j < 6 ? WS_PART1 + (size_t)(j - 2) * 8 * MiB : WS_PART2 + (size_t)(j - 6) * 8 * MiB; }
struct P6Geo { int xg, wi, nwv, ng; };
__device__ __forceinline__ P6Geo p6_geo(const Ctx& F) { P6Geo g; const int bx = blockIdx.x, ng = F.G < 8 ? F.G : 8; g.xg = bx % ng; g.wi = (bx / ng) * NWAVES + F.wave; g.nwv = ((F.G - g.xg + ng - 1) / ng) * NWAVES; g.ng = ng; return g; }
__device__ __forceinline__ void swap32(unsigned a, unsigned& lo, unsigned& hi) { const auto s_ = __builtin_amdgcn_permlane32_swap(a, a, false, false); lo = s_[0]; hi = s_[1]; }
__device__ __forceinline__ void swap16(unsigned a, unsigned& lo, unsigned& hi) { const auto s_ = __builtin_amdgcn_permlane16_swap(a, a, false, false); lo = s_[0]; hi = s_[1]; }
__device__ __forceinline__ void p6a_upass(const Ctx& F, unsigned char* ws, const bf16* XB1, const unsigned short* IDS) {
    const P6Geo G = p6_geo(F); const int lane = F.lane_(), g = lane >> 3, c = lane & 7;
    const int b0 = ((lane >> 5) & 1) | (((lane >> 4) & 1) << 1);
    const bool c4 = (c & 4) != 0, c2 = (c & 2) != 0, c1 = (c & 1) != 0;
    const int pbase = 8 * (c >> 2) + 4 * ((c >> 1) & 1) + 2 * (c & 1);
#define U_IDS(ID, t_) do { _Pragma("unroll") for (int q = 0; q < 2; ++q) ID[q] = *(const GAS v4u*)(IDS + (size_t)(t_) * 128 + 16 * g + 8 * q); } while (0)
#define U_X(XR, t_) do { XR = *(const GAS v4u*)(XB1 + (size_t)(t_) * D + sl * SL4 + 32 * c + 8 * b0); } while (0)
#define U_GATHER(R, ID) do { _Pragma("unroll") for (int i = 0; i < 16; ++i) { const unsigned w_ = ID[i >> 3][(i >> 1) & 3]; R[i] = *(const GAS v4u*)(Ts + (size_t)row_off(w_, (i & 1) != 0, c16)); } } while (0)
#define U_COMPUTE(R, XR, t_) do { \
        float xf[8]; \
        _Pragma("unroll") for (int e = 0; e < 4; ++e) { xf[2 * e] = __uint_as_float(XR[e] << 16); xf[2 * e + 1] = __uint_as_float(XR[e] & 0xffff0000u); } \
        float am = 0.f; \
        _Pragma("unroll") for (int e = 0; e < 8; e += 2) am = amax3(xf[e], xf[e + 1], am); \
        am = max8f(am); \
        { unsigned l_, h_; swap16(__float_as_uint(am), l_, h_); am = fmaxf(__uint_as_float(l_), __uint_as_float(h_)); swap32(__float_as_uint(am), l_, h_); am = fmaxf(__uint_as_float(l_), __uint_as_float(h_)); } \
        const float sc = am > 0.f ? 119.0f / am : 0.f, sx = am * (1.0f / 119.0f); \
        unsigned fb[8]; \
        _Pragma("unroll") for (int e = 0; e < 8; ++e) fb[e] = __float_as_uint(fmaf(xf[e], sc, 12583040.0f));                          \
        const unsigned U0 = __builtin_amdgcn_perm(fb[1], fb[0], 0x0c0c0400u) | __builtin_amdgcn_perm(fb[3], fb[2], 0x04000c0cu); \
        const unsigned U1 = __builtin_amdgcn_perm(fb[5], fb[4], 0x0c0c0400u) | __builtin_amdgcn_perm(fb[7], fb[6], 0x04000c0cu); \
        int usum = (int)__builtin_amdgcn_sad_u8(U1, 0u, __builtin_amdgcn_sad_u8(U0, 0u, 0u)); \
        usum = sum8i(usum); { unsigned l_, h_; swap16((unsigned)usum, l_, h_); usum = (int)(l_ + h_); swap32((unsigned)usum, l_, h_); usum = (int)(l_ + h_); } \
        const unsigned XLo = (U0 & 0x0f0f0f0fu) | ((U1 << 4) & 0xf0f0f0f0u);                                                            \
        const unsigned T0 = U0 + 0x08080808u, T1 = U1 + 0x08080808u;                                                                   \
        const unsigned XHo = (((T0 >> 4) & 0x0f0f0f0fu) | (T1 & 0xf0f0f0f0u)) ^ 0x88888888u;                                           \
        unsigned XL[4], XH[4]; \
        { unsigned e0_, e1_; swap32(XLo, e0_, e1_); swap16(e0_, XL[0], XL[2]); swap16(e1_, XL[1], XL[3]); swap32(XHo, e0_, e1_); swap16(e0_, XH[0], XH[2]); swap16(e1_, XH[1], XH[3]); } \
        const float xs = 0.5f * (float)(usum - 128 * SL4); \
        int v_[16]; \
        _Pragma("unroll") for (int i = 0; i < 16; ++i) { \
            int sl_ = dot8_0((int)R[i][0], (int)XL[0]), sh_ = dot8_0((int)R[i][0], (int)XH[0]); \
            _Pragma("unroll") for (int b = 1; b < 4; ++b) { sl_ = __builtin_amdgcn_sdot8((int)R[i][b], (int)XL[b], sl_, false); sh_ = __builtin_amdgcn_sdot8((int)R[i][b], (int)XH[b], sh_, false); } \
            v_[i] = sl_ + 16 * sh_; } \
        int w_[8], y_[4], z_[2]; \
        _Pragma("unroll") for (int j = 0; j < 8; ++j) w_[j] = (c4 ? v_[8 + j] : v_[j]) + dpp_i<0x141>(c4 ? v_[j] : v_[8 + j]);          \
        _Pragma("unroll") for (int j = 0; j < 4; ++j) y_[j] = (c2 ? w_[4 + j] : w_[j]) + dpp_i<0x4E>(c2 ? w_[j] : w_[4 + j]);          \
        _Pragma("unroll") for (int j = 0; j < 2; ++j) z_[j] = (c1 ? y_[2 + j] : y_[j]) + dpp_i<0xB1>(c1 ? y_[j] : y_[2 + j]);          \
        f32x2 o_; o_.x = ((float)z_[0] + xs) * sx; o_.y = ((float)z_[1] + xs) * sx; \
        *(GAS f32x2*)(PART + (size_t)(t_) * 128 + 16 * g + pbase) = o_; } while (0)
#define U_FENCE() asm volatile("" ::: "memory")
    const bool two = G.ng == 8; const int nsl_step = two ? 4 : G.ng;
    int wbase = 0, wtot = G.nwv;
    if (two) { const int xo = G.xg ^ 4, nwo = ((F.G - xo + 7) / 8) * NWAVES; wtot = G.nwv + nwo; wbase = (G.xg & 4) ? nwo : 0; }
    for (int sl = two ? (G.xg & 3) : G.xg; sl < NSL4; sl += nsl_step) {
        float* PART = (float*)(ws + part_slab(sl));
        const GAS unsigned char* Ts = (const GAS unsigned char*)(ws + WS_UB) + (size_t)sl * NEXP * 128; const unsigned c16 = 16u * (unsigned)c;
        const int t0 = wbase + G.wi, dt = wtot, nk = t0 < M ? (M - t0 + dt - 1) / dt : 0;
        if (nk <= 0) continue;
#define TOK(k_) (t0 + ((k_) < nk ? (k_) : nk - 1) * dt)
        v4u idA[2], idB[2]; v4u xA, xB; v4u rA[16], rB[16];
        U_IDS(idA, TOK(0)); U_IDS(idB, TOK(1));
        U_FENCE();
        U_GATHER(rA, idA); U_X(xA, TOK(0));
        U_FENCE();
        for (int k = 0; k < nk; k += 2) {
            U_IDS(idA, TOK(k + 2));
            U_FENCE();
            U_GATHER(rB, idB); U_X(xB, TOK(k + 1));
            U_FENCE();
            U_COMPUTE(rA, xA, TOK(k));
            U_FENCE();
            U_IDS(idB, TOK(k + 3));
            U_FENCE();
            U_GATHER(rA, idA); U_X(xA, TOK(k + 2));
            U_FENCE();
            U_COMPUTE(rB, xB, TOK(k + 1));
            U_FENCE();
        }
#undef TOK
    }
#undef U_IDS
#undef U_X
#undef U_GATHER
#undef U_COMPUTE
#undef U_FENCE
}
__device__ __forceinline__ int pl32_sum(int a, int b) { const auto s_ = __builtin_amdgcn_permlane32_swap((unsigned)a, (unsigned)b, false, false); return (int)(s_[0] + s_[1]); }
__device__ __forceinline__ int pl16_sum(int a, int b) { const auto s_ = __builtin_amdgcn_permlane16_swap((unsigned)a, (unsigned)b, false, false); return (int)(s_[0] + s_[1]); }
constexpr int P6B_TPT = 2;
template <bool GUARD> __device__ __forceinline__ void p6b_trip(unsigned char* ws, float* SS2, const unsigned short* IDS, const float* GATES, int tb, int NGW, int lane) {
    const f32x2* SUV = (const f32x2*)(ws + WS_SUV);
    unsigned short* WQ8 = (unsigned short*)(ws + WS_WQ8);
    float ssv[P6B_TPT]; f32x2 gv[P6B_TPT], s0[P6B_TPT], s1[P6B_TPT], pp[P6B_TPT][NSL4]; unsigned idw[P6B_TPT];
#pragma unroll
    for (int r = 0; r < P6B_TPT; ++r) { const int t = tb + r * NGW; if (!GUARD || t < M) idw[r] = *(const GAS unsigned*)(IDS + (size_t)t * 128 + 2 * lane); }
#pragma unroll
    for (int r = 0; r < P6B_TPT; ++r) { const int t = tb + r * NGW; if (!GUARD || t < M) {
        ssv[r] = lane < 16 ? SS2[(size_t)t * 16 + lane] : 0.f;
        gv[r] = *(const GAS f32x2*)(GATES + (size_t)t * 128 + 2 * lane);
#pragma unroll
        for (int j = 0; j < NSL4; ++j) pp[r][j] = *(const GAS f32x2*)((const float*)(ws + part_slab(j)) + (size_t)t * 128 + 2 * lane); } }
#pragma unroll
    for (int r = 0; r < P6B_TPT; ++r) { const int t = tb + r * NGW; if (!GUARD || t < M) { s0[r] = SUV[idw[r] & 0xffffu]; s1[r] = SUV[idw[r] >> 16]; } }
#pragma unroll
    for (int r = 0; r < P6B_TPT; ++r) { const int t = tb + r * NGW; if (!GUARD || t < M) {
        const float a0 = (pp[r][0].x + pp[r][1].x) + (pp[r][2].x + pp[r][3].x), a1 = (pp[r][0].y + pp[r][1].y) + (pp[r][2].y + pp[r][3].y);
        const float rstd = 1.0f / sqrtf(wave_sum_valu(ssv[r]) * (1.0f / D) + EPS);
        const float x0 = a0 * rstd * s0[r].x, x1 = a1 * rstd * s1[r].x;
        const float w0 = gv[r].x * 0.5f * x0 * (1.0f + erff(x0 * 0.70710678118654752f)) * s0[r].y, w1 = gv[r].y * 0.5f * x1 * (1.0f + erff(x1 * 0.70710678118654752f)) * s1[r].y;
        const float am = wave_max_valu(fmaxf(fabsf(w0), fabsf(w1)));
        const float sc = am > 0.f ? 127.0f / am : 0.f;
        const float q0 = rintf(w0 * sc), q1 = rintf(w1 * sc);
        WQ8[(size_t)t * 64 + lane] = (unsigned short)(((int)q0 & 255) | (((int)q1 & 255) << 8));
        const float qs = wave_sum_valu(q0 + q1);
        if (lane == 0) { f32x2 o_; o_.x = am * (1.0f / 127.0f); o_.y = am * (1.0f / 127.0f) * qs; ((f32x2*)(ws + WS_SW2))[t] = o_; }
        if (lane < 16) SS2[(size_t)t * 16 + lane] = 0.f;
    } }
}
__device__ __forceinline__ void p6b_combine(const Ctx& F, unsigned char* ws, float* SS2, const unsigned short* IDS, const float* GATES) {
    const int gw = F.vcu * NWAVES + F.wave, NGW = F.G * NWAVES, lane = F.lane_();
    for (int tb = gw; tb < M; tb += P6B_TPT * NGW) {
        if (tb + (P6B_TPT - 1) * NGW < M) p6b_trip<false>(ws, SS2, IDS, GATES, tb, NGW, lane);
        else p6b_trip<true>(ws, SS2, IDS, GATES, tb, NGW, lane);
    }
}
__device__ __forceinline__ void p6c_vpass(const Ctx& F, unsigned char* ws, const unsigned short* IDS, const bf16* XB1, bf16* XB2, float* SS3) {
    const P6Geo G = p6_geo(F); const int lane = F.lane_(), g = lane >> 3, c = lane & 7;
    const int ecol = 32 * c + ((lane >> 5) & 1) * 16 + ((lane >> 4) & 1) * 8 + ((lane >> 3) & 1) * 4;
    const signed char* WQ8 = (const signed char*)(ws + WS_WQ8); const f32x2* SW2 = (const f32x2*)(ws + WS_SW2);
#define V_IDS(ID, t_) do { _Pragma("unroll") for (int q = 0; q < 2; ++q) ID[q] = *(const GAS v4u*)(IDS + (size_t)(t_) * 128 + 16 * g + 8 * q); } while (0)
#define V_AUX(WV, XQ, SWV, t_) do { WV = *(const GAS v4u*)(WQ8 + (size_t)(t_) * 128 + 16 * g); XQ = *(const GAS u32x2*)(XB1 + (size_t)(t_) * D + sl * SL4 + ecol); SWV = *(const GAS f32x2*)(SW2 + (t_)); } while (0)
#define V_GATHER(R, ID) do { _Pragma("unroll") for (int i = 0; i < 16; ++i) { const unsigned w_ = ID[i >> 3][(i >> 1) & 3]; R[i] = *(const GAS v4u*)(Ts + (size_t)row_off(w_, (i & 1) != 0, c16)); } } while (0)
#define V_COMPUTE(R, WV, XQ, SWV, t_) do { \
        const size_t o_ = (size_t)(t_) * D + sl * SL4 + ecol; \
        int acc[32]; \
        _Pragma("unroll") for (int j = 0; j < 4; ++j) \
            _Pragma("unroll") for (int b = 0; b < 4; ++b) { \
                const unsigned r0_ = R[4 * j][b], r1_ = R[4 * j + 1][b], r2_ = R[4 * j + 2][b], r3_ = R[4 * j + 3][b]; \
                const unsigned x01 = __builtin_amdgcn_perm(r1_, r0_, 0x05010400u), y01 = __builtin_amdgcn_perm(r1_, r0_, 0x07030602u), x23 = __builtin_amdgcn_perm(r3_, r2_, 0x05010400u), y23 = __builtin_amdgcn_perm(r3_, r2_, 0x07030602u); \
                unsigned tt_[4]; tt_[0] = __builtin_amdgcn_perm(x23, x01, 0x05040100u); tt_[1] = __builtin_amdgcn_perm(x23, x01, 0x07060302u); tt_[2] = __builtin_amdgcn_perm(y23, y01, 0x05040100u); tt_[3] = __builtin_amdgcn_perm(y23, y01, 0x07060302u); \
                _Pragma("unroll") for (int k = 0; k < 4; ++k) { \
                    if (j == 0) { acc[8 * b + 2 * k] = dot4_0((int)(tt_[k] & 0x0f0f0f0fu), (int)WV[0]); acc[8 * b + 2 * k + 1] = dot4_0((int)tt_[k], (int)WV[0]); } \
                    else { acc[8 * b + 2 * k] = __builtin_amdgcn_sdot4((int)(tt_[k] & 0x0f0f0f0fu), (int)WV[j], acc[8 * b + 2 * k], false); acc[8 * b + 2 * k + 1] = __builtin_amdgcn_sdot4((int)tt_[k], (int)WV[j], acc[8 * b + 2 * k + 1], false); } } } \
        int r16[16], r8[8], r4[4]; \
        _Pragma("unroll") for (int i = 0; i < 16; ++i) r16[i] = pl32_sum(acc[i], acc[i + 16]); \
        _Pragma("unroll") for (int i = 0; i < 8; ++i) r8[i] = pl16_sum(r16[i], r16[i + 8]); \
        _Pragma("unroll") for (int i = 0; i < 4; ++i) { const int send = (lane & 8) ? r8[i] : r8[i + 4], keep = (lane & 8) ? r8[i + 4] : r8[i]; r4[i] = keep + dpp_i<0x128>(send); } \
        const float sw_ = SWV.x, cw_ = SWV.y; \
        const float x0_ = __uint_as_float(XQ.x << 16) + (sw_ * (float)r4[0] - 7.5f * cw_), x1_ = __uint_as_float(XQ.x & 0xffff0000u) + (sw_ * 0.0625f * (float)(r4[1] - r4[0]) + 0.5f * cw_);     \
        const float x2_ = __uint_as_float(XQ.y << 16) + (sw_ * (float)r4[2] - 7.5f * cw_), x3_ = __uint_as_float(XQ.y & 0xffff0000u) + (sw_ * 0.0625f * (float)(r4[3] - r4[2]) + 0.5f * cw_); \
        u32x2 ov_; ov_.x = pk2(x0_, x1_); ov_.y = pk2(x2_, x3_); *(GAS u32x2*)(XB2 + o_) = ov_; \
        *(GAS unsigned*)(ws + WS_XB2_8 + o_) = (unsigned)__builtin_amdgcn_cvt_pk_fp8_f32(x2_, x3_, __builtin_amdgcn_cvt_pk_fp8_f32(x0_, x1_, 0, false), true); \
        const float ss = wave_sum_valu((x0_ * x0_ + x1_ * x1_) + (x2_ * x2_ + x3_ * x3_)); \
        if (lane == 0) SS3[(size_t)(t_) * 16 + sl] = ss; } while (0)
#define V_FENCE() asm volatile("" ::: "memory")
    const bool two = G.ng == 8; const int nsl_step = two ? 4 : G.ng;
    int wbase = 0, wtot = G.nwv;
    if (two) { const int xo = G.xg ^ 4, nwo = ((F.G - xo + 7) / 8) * NWAVES; wtot = G.nwv + nwo; wbase = (G.xg & 4) ? nwo : 0; }
    for (int sl = two ? (G.xg & 3) : G.xg; sl < NSL4; sl += nsl_step) {
        const GAS unsigned char* Ts = (const GAS unsigned char*)(ws + WS_VB) + (size_t)sl * NEXP * 128; const unsigned c16 = 16u * (unsigned)c;
        const int t0 = wbase + G.wi, dt = wtot, nk = t0 < M ? (M - t0 + dt - 1) / dt : 0;
        if (nk <= 0) continue;
#define TOK(k_) (t0 + ((k_) < nk ? (k_) : nk - 1) * dt)
        v4u idA[2], idB[2]; v4u wA, wB; u32x2 xA, xB; f32x2 sA, sB; v4u rA[16], rB[16];
        V_IDS(idA, TOK(0)); V_IDS(idB, TOK(1));
        V_FENCE();
        V_GATHER(rA, idA); V_AUX(wA, xA, sA, TOK(0));
        V_FENCE();
        for (int k = 0; k < nk; k += 2) {
            V_IDS(idA, TOK(k + 2));
            V_FENCE();
            V_GATHER(rB, idB); V_AUX(wB, xB, sB, TOK(k + 1));
            V_FENCE();
            V_COMPUTE(rA, wA, xA, sA, TOK(k));
            V_FENCE();
            V_IDS(idB, TOK(k + 3));
            V_FENCE();
            V_GATHER(rA, idA); V_AUX(wA, xA, sA, TOK(k + 2));
            V_FENCE();
            V_COMPUTE(rB, wB, xB, sB, TOK(k + 1));
            V_FENCE();
        }
#undef TOK
    }
#undef V_IDS
#undef V_AUX
#undef V_GATHER
#undef V_COMPUTE
#undef V_FENCE
}
__device__ __forceinline__ void p8_final(const Ctx& F, const bf16* XB3, const float* SS4, float* OUT, const float* g) {
    const int gw = F.vcu * NWAVES + F.wave, NGW = F.G * NWAVES, lane = F.lane_();
    f32x4 gv[4];
#pragma unroll
    for (int j = 0; j < 4; ++j) gv[j] = ((const GAS f32x4*)g)[2 * lane + (j & 1) + 128 * (j >> 1)];
    constexpr int RPT = 4;
    for (int rb = gw; rb < M; rb += RPT * NGW) {
        v4u xa[RPT], xb[RPT]; float sv[RPT];
#pragma unroll
        for (int r = 0; r < RPT; ++r) { const int row = rb + r * NGW; if (row < M) { xa[r] = *(const GAS v4u*)(XB3 + (size_t)row * D + 8 * lane); xb[r] = *(const GAS v4u*)(XB3 + (size_t)row * D + 512 + 8 * lane);
            sv[r] = lane < 16 ? SS4[(size_t)row * 16 + lane] : 0.f; } }
#pragma unroll
        for (int r = 0; r < RPT; ++r) { const int row = rb + r * NGW; if (row < M) {
            const float rstd = 1.0f / sqrtf(wave_sum(sv[r]) * (1.0f / D) + EPS);
            GAS f32x4* o = (GAS f32x4*)(OUT + (size_t)row * D);
            o[2 * lane] = (f32x4){__uint_as_float(xa[r][0] << 16), __uint_as_float(xa[r][0] & 0xffff0000u), __uint_as_float(xa[r][1] << 16), __uint_as_float(xa[r][1] & 0xffff0000u)} * rstd * gv[0];
            o[2 * lane + 1] = (f32x4){__uint_as_float(xa[r][2] << 16), __uint_as_float(xa[r][2] & 0xffff0000u), __uint_as_float(xa[r][3] << 16), __uint_as_float(xa[r][3] & 0xffff0000u)} * rstd * gv[1];
            o[128 + 2 * lane] = (f32x4){__uint_as_float(xb[r][0] << 16), __uint_as_float(xb[r][0] & 0xffff0000u), __uint_as_float(xb[r][1] << 16), __uint_as_float(xb[r][1] & 0xffff0000u)} * rstd * gv[2];
            o[128 + 2 * lane + 1] = (f32x4){__uint_as_float(xb[r][2] << 16), __uint_as_float(xb[r][2] & 0xffff0000u), __uint_as_float(xb[r][3] << 16), __uint_as_float(xb[r][3] & 0xffff0000u)} * rstd * gv[3];
        } }
    }
}
struct OneUnit {
    pg8::Unit u;
    __device__ __forceinline__ bool next(int i, pg8::Unit& o) const { if (i != 0) return false; o = u; return true; }
    __device__ __forceinline__ void a_ready(const pg8::Unit&) const {}
    __device__ __forceinline__ void done(const pg8::Unit&) const {}
};

__global__ void __launch_bounds__(NWAVES * 64, 2) mk_fwd(Args args) {
    extern __shared__ __attribute__((aligned(16))) unsigned char lds[];
    Ctx F;
    F.lds = (LAS unsigned char*)lds;
    F.wave = __builtin_amdgcn_readfirstlane((int)threadIdx.x >> 6);
    F.G = gridDim.x; { const int bx = blockIdx.x; F.vcu = (F.G % 8 == 0) ? (bx % 8) * (F.G / 8) + bx / 8 : bx; }
    volatile LAS unsigned* MISC = (volatile LAS unsigned*)(F.lds + MISC_OFF);
    unsigned char* ws = args.ws;
    gu32* ctl = (gu32*)(ws + WS_CTL);
    for (int u = F.tid_(); u < (LDS_BYTES - LDSCTL_OFF) / 4; u += NWAVES * 64) ((LAS unsigned*)(F.lds + LDSCTL_OFF))[u] = 0u;
    __syncthreads();
    const int lo = args.ph_lo, hi = args.ph_hi;
    const bool multi = (hi - lo) > 1 || (lo <= 6 && 6 < hi);
    XcdBarrier bar; bar.bar = (unsigned*)(ctl + CW_BAR) + args.li * XCD_BAR_WORDS; bar.x = 0; bar.st = nullptr;
    if (multi) bar = xcd_barrier_post((unsigned*)(ctl + CW_BAR) + args.li * XCD_BAR_WORDS, MISC + 8);
#ifndef MK_CMASK
#define MK_CMASK 0x1ff
#endif
#define IN(k) (((MK_CMASK >> (k)) & 1) && lo <= (k) && (k) < hi)
#ifdef MK_PROBE_BAR2
#define SEAM(k) do { if (IN(k) && IN((k) + 1)) { xcd_barrier(bar); for (int rb_ = 1; rb_ < MK_PROBE_BAR2; ++rb_) xcd_barrier(bar); } STAMPI((k) < 6 ? (k) + 1 : (k) + 3); } while (0)
#else
#define SEAM(k) do { if (IN(k) && IN((k) + 1)) xcd_barrier(bar); STAMPI((k) < 6 ? (k) + 1 : (k) + 3); } while (0)
#endif
#ifdef MK_PROBE_SEG
#define STAMPI(i_) do { if (((i_) == MK_PROBE_SEG || (i_) == MK_PROBE_SEG + 1 || (MK_PROBE_SEG == 200 && ((i_) == 0 || (i_) == 11))) && blockIdx.x == 0 && threadIdx.x == 0) { ((unsigned long long*)(args.ws + 32768))[(i_)] = __builtin_amdgcn_s_memrealtime(); } } while (0)
    STAMPI(0);
#else
#define STAMPI(i_) do { } while (0)
#endif
    float* out = args.out;
#define WSP(T, off) ((T*)(ws + (off)))
#define RSTD1 WSP(float, WS_RSTD1)
#define SS2 WSP(float, WS_SS2)
#define LF WSP(float, WS_LF)
#define WIN WSP(bf16, WS_WIN)
#define WBR WSP(bf16, WS_WBR)
#define WOUT WSP(bf16, WS_WOUT)
#define WST WSP(bf16, WS_WS)
#define WPG WSP(bf16, WS_WPG)
#define WPP WSP(bf16, WS_WPP)
#define PB WSP(bf16, WS_PB)
#define XB WSP(bf16, WS_A)
#define AC WSP(bf16, WS_AC)
#define XB1 WSP(bf16, WS_A)
#define PP WSP(bf16, WS_PP)
#define Q WSP(bf16, WS_Q)
#define K WSP(bf16, WS_K)
#define V WSP(bf16, WS_V)
#define GB WSP(bf16, WS_GB)
#define Z WSP(bf16, WS_Z)
#define MG WSP(bf16, WS_MERGED)
#define XB2 WSP(bf16, WS_XB2)
#define IDS WSP(unsigned short, WS_IDS)
#define GATES WSP(float, WS_GATES)
#define SGA ((bf16*)out)
#define SGC ((bf16*)out + (size_t)M * D)

    if (IN(0)) { p0_prologue(F, args, MISC); }
    SEAM(0);
    if (IN(1)) {
        const int par_ = (int)blockIdx.x & 3;
#pragma nounroll
        for (int s_ = 0; s_ < 3; ++s_) {
            const int k_ = par_ == 0 ? s_ : par_ == 1 ? (s_ == 0 ? 1 : s_ == 1 ? 0 : 2) : par_ == 2 ? (s_ == 0 ? 2 : s_ - 1) : (s_ == 0 ? 2 : s_ == 1 ? 1 : 0);
            if (k_ == 0) { pg8::Gemm g{XB, WIN, M, 2048, D}; pg8::StaticOrder S; S.init(M, 2048, F.G, (int)blockIdx.x);
              pg8::EpiIn E{RSTD1, Q, (size_t)(WS_K - WS_Q) / 2, Z, SGA, (size_t)M * D, C2};
              static_assert(WS_V - WS_K == WS_K - WS_Q && WS_GB - WS_V == WS_K - WS_Q, "Q | K | V | GB equally spaced");
              pg8::gemm_phase<pg8::EpiIn, pg8::StaticOrder, PG8_ALIGN, PG8_SP2>(F.lds + RING_OFF, g, S, E, F.wave); }
            else if (k_ == 1) { pg8::Gemm g{WSP(bf16, WS_XB8), WSP(bf16, WS_WIN8), M, 3072, D / 2}; pg8::StaticOrder S; S.init(M, 3072, F.G, (int)blockIdx.x);
              pg8::EpiGate E{RSTD1, SGA, (size_t)M * D, 1.0f / 32.0f, Q, (size_t)(WS_K - WS_Q) / 2, C2};
              pg8::gemm_phase<pg8::EpiGate, pg8::StaticOrder, PG8_ALIGN, PG8_SP2, true>(F.lds + RING_OFF, g, S, E, F.wave); }
            else { pg8::Gemm g{PB, WPP, M, D, PLE}; pg8::StaticOrder S; S.init(M, D, F.G, (int)blockIdx.x);
              pg8::EpiPlain E{PP, D};
              pg8::gemm_phase<pg8::EpiPlain, pg8::StaticOrder, PG8_ALIGN, PG8_SP2>(F.lds + RING_OFF, g, S, E, F.wave); }
        }
    }
    SEAM(1);
    if (IN(2)) {
        unsigned* qctr = (unsigned*)(ctl + CW_QUEUE);
        for (bool first = true;; first = false) {
            const int idx = first ? (int)blockIdx.x : F.G + p2_dequeue(qctr, MISC + 12);
            if (idx >= P2_NITEMS) break;
            const bool head_ = idx < P2_NATT + P2_NQ; const int m3 = (idx >> 3) & 1, d3 = ((idx >> 4) << 3) | (idx & 7);
            if (head_ && m3 == 0) { const int a_ = d3; const int qb = 15 - (a_ >> 5), bh = a_ & 31;
                attn_body::attn_unit<8>(bh >> 3, bh & 7, qb, (const attn_body::bf16*)Q, (const attn_body::bf16*)K, (const attn_body::bf16*)V, (attn_body::bf16*)AC, LF + (size_t)bh * SEQ, (char*)lds + RING_OFF); }
            else if (head_) {
                int lane_l = (int)threadIdx.x & 63; asm volatile("" : "+v"(lane_l));
                const int r0 = d3 * 64 + F.wave * 8;
                quant_rows<4>(args, r0, lane_l); quant_rows<4>(args, r0 + 4, lane_l);
            }
            else if (idx < P2_NATT + P2_NQ + P2_NCONV) p2_conv_chunk(idx - P2_NATT - P2_NQ, GB, Z, args.in[5], AC);
            else if (idx < P2_NATT + P2_NQ + P2_NCONV + P2_NWS) ws_item(args, F.lds + RING_OFF, idx - P2_NATT - P2_NQ - P2_NCONV);
            else { int lane_l = (int)threadIdx.x & 63; asm volatile("" : "+v"(lane_l));
                const int w0 = TR_P0 + (idx - P2_NATT - P2_NQ - P2_NCONV - P2_NWS) * 8 + F.wave;
                tr_two(args, (LAS float*)(F.lds + RING_OFF + F.wave * 16384), w0, w0, false, lane_l); }
        }
    }
    SEAM(2);
    if (IN(3)) {
        pg8::Gemm g{AC, WBR, M, D, D}; pg8::StaticOrder S; S.init(M, D, F.G, (int)blockIdx.x);
        pg8::EpiBranch E{SGA, SGC, MG};
        pg8::gemm_phase<pg8::EpiBranch, pg8::StaticOrder, PG8_ALIGN, PG8_SP2>(F.lds + RING_OFF, g, S, E, F.wave);
    }
    SEAM(3);
    if (IN(4)) {
        pg8::Gemm g{MG, WOUT, M, D, D}; pg8::StaticOrder S; S.init(M, D, F.G, (int)blockIdx.x);
        pg8::EpiOut E{XB, XB1, SS2};
        pg8::gemm_phase<pg8::EpiOut, pg8::StaticOrder, PG8_ALIGN, PG8_SP2>(F.lds + RING_OFF, g, S, E, F.wave);
    }
    SEAM(4);
    if (IN(5)) {
        pg8::Gemm g{XB1, WST, M, NS, D}; pg8::StaticOrder S; S.init(M, NS, F.G, (int)blockIdx.x);
        pg8::EpiTopK E{SS2, IDS, GATES, EPS};
        pg8::Unit u;
        for (int i = 0; S.next(i, u); ++i) { OneUnit O{u}; pg8::gemm_phase<pg8::EpiTopK, OneUnit, false, PG8_SP2>(F.lds + RING_OFF, g, O, E, F.wave); }
    }
    SEAM(5);
    if (IN(6)) { p6a_upass(F, ws, XB1, IDS); xcd_barrier(bar); STAMPI(7); p6b_combine(F, ws, SS2, IDS, GATES); xcd_barrier(bar); STAMPI(8); p6c_vpass(F, ws, IDS, XB1, XB2, SS2); }
    SEAM(6);
    bool fuse78 = false;
    if (IN(7)) {
        pg8::Gemm g{WSP(bf16, WS_XB2_8), WPG, M, D, D / 2}; pg8::StaticOrder S; S.init(M, D, F.G, (int)blockIdx.x);
        LAS float* rtab = (LAS float*)(F.lds + RING_OFF + pg8::STAGE_BYTES);
        const bool one = (M / 256) * (D / 256) <= F.G; pg8::Unit u0;
        if (one && S.next(0, u0) && F.tid_() < 256) { const float* sp = SS2 + (size_t)(u0.pm * 256 + F.tid_()) * 16; float q = 0.f;
#pragma unroll
            for (int j = 0; j < NSL4; ++j) q += sp[j];
            rtab[F.tid_()] = 1.0f / sqrtf(q * (1.0f / D) + EPS); }
        __syncthreads();
        fuse78 = one && IN(8);
        if (fuse78) { pg8::EpiPleNorm E{PP, XB2, out, args.in[17], WSP(float, WS_SS4), (unsigned*)(ctl + CW_PANEL), EPS, 1.0f / 32.0f, (const LAS float*)rtab};
            pg8::gemm_phase<pg8::EpiPleNorm, pg8::StaticOrder, PG8_ALIGN, PG8_SP2, true>(F.lds + RING_OFF, g, S, E, F.wave); }
        else { pg8::EpiPle E{SS2, PP, XB2, WSP(bf16, WS_XB3), WSP(float, WS_SS4), EPS, 1.0f / 32.0f, one ? (const LAS float*)rtab : (const LAS float*)nullptr};
            pg8::gemm_phase<pg8::EpiPle, pg8::StaticOrder, PG8_ALIGN, PG8_SP2, true>(F.lds + RING_OFF, g, S, E, F.wave); }
    }
    if (!fuse78) { SEAM(7);
    if (IN(8)) { p8_final(F, WSP(bf16, WS_XB3), WSP(float, WS_SS4), out, args.in[17]); } }
    STAMPI(11);
#ifdef MK_PROBE_SEG
    if (blockIdx.x == 0 && F.tid_() == 0) {
        asm volatile("s_waitcnt vmcnt(0)" ::: "memory");
        const unsigned long long* st_ = (const unsigned long long*)(args.ws + 32768);
#if MK_PROBE_SEG >= 100 && MK_PROBE_SEG != 200
        const unsigned long long a_ = st_[32 + (MK_PROBE_SEG - 100)], b_ = (MK_PROBE_SEG - 100 == 4) ? st_[1] : st_[33 + (MK_PROBE_SEG - 100)];
#else
        const unsigned long long a_ = st_[MK_PROBE_SEG == 200 ? 0 : MK_PROBE_SEG], b_ = st_[MK_PROBE_SEG == 200 ? 11 : MK_PROBE_SEG + 1];
#endif
        const unsigned long long dt_ = (b_ - a_) * MK_PROBE_MULT, t0_ = __builtin_amdgcn_s_memrealtime();
        while (__builtin_amdgcn_s_memrealtime() - t0_ < dt_) __builtin_amdgcn_s_sleep(8);
    }
#endif
#undef IN
#undef SEAM
#undef WSP
#undef RSTD1
#undef SS2
#undef LF
#undef WIN
#undef WBR
#undef WOUT
#undef WST
#undef WPG
#undef WPP
#undef PB
#undef XB
#undef AC
#undef XB1
#undef PP
#undef Q
#undef K
#undef V
#undef GB
#undef Z
#undef MG
#undef XB2
#undef IDS
#undef GATES
#undef SGA
#undef SGC
}

extern "C" void kernel_launch(void* const* d_in, const int* in_sizes, int n_in, void* d_out, int out_size, void* d_ws, size_t ws_size, hipStream_t stream) {
    static int grid = 0;
    if (grid == 0) {
        if (n_in != 18 || in_sizes[0] != M * D || out_size != M * D || ws_size < WS_END) { fprintf(stderr, "kernel_launch: unexpected shapes (n_in %d, in0 %d, out %d, ws %zu); nothing launched\n", n_in, n_in > 0 ? in_sizes[0] : -1, out_size, ws_size); grid = -1; return; }
        int dev = 0, cus = 0, per_cu = 0;
        if (hipGetDevice(&dev) != hipSuccess || hipDeviceGetAttribute(&cus, hipDeviceAttributeMultiprocessorCount, dev) != hipSuccess) { fprintf(stderr, "kernel_launch: device query failed\n"); grid = -1; return; }
        if (hipFuncSetAttribute((const void*)mk_fwd, hipFuncAttributeMaxDynamicSharedMemorySize, LDS_BYTES) != hipSuccess) { fprintf(stderr, "kernel_launch: hipFuncSetAttribute failed\n"); grid = -1; return; }
        if (hipOccupancyMaxActiveBlocksPerMultiprocessor(&per_cu, (const void*)mk_fwd, NWAVES * 64, LDS_BYTES) != hipSuccess || per_cu < 1) { fprintf(stderr, "kernel_launch: occupancy query says %d workgroups per CU; nothing launched\n", per_cu); (void)hipGetLastError(); grid = -1; return; }
        grid = cus;
    }
    if (grid < 0) return;
    if (hipMemsetAsync((char*)d_ws + WS_CTL, 0, CTL_ZERO_BYTES, stream) != hipSuccess) { fprintf(stderr, "kernel_launch: hipMemsetAsync failed\n"); return; }
    Args a{};
    for (int i = 0; i < 18; ++i) a.in[i] = (const float*)d_in[i];
    a.out = (float*)d_out; a.ws = (unsigned char*)d_ws; a.ph_lo = 0; a.ph_hi = NPHASE; a.li = 0; a.pad = 0;
    hipLaunchKernelGGL(mk_fwd, dim3(grid), dim3(NWAVES * 64), LDS_BYTES, stream, a);
    const hipError_t le = hipPeekAtLastError();
    if (le != hipSuccess) fprintf(stderr, "kernel_launch: launch failed: %s\n", hipGetErrorName(le));
}
```
